# Optimizing an MI355X kernel written in HIP

```python
import jax, jax.numpy as jnp
from jax import lax
import numpy as np

D_MODEL = 1024
BATCH = 16
SEQ = 4096
DEPTH = 2

MEM_LEN = 256
ML_HEADS = 4
ML_DQK = 64
ML_DV = 128
ML_CONV = 4
ML_CHUNK = 64
ML_W = ML_HEADS * ML_DV
ML_QK_W = 2 * ML_HEADS * ML_DQK
RW_HEADS = 8
RW_DH = 64
RW_W = RW_HEADS * RW_DH
RW_DECAY_LORA = 64
RW_AAA_LORA = 64
RW_GATE_LORA = 128
RW_IN_W = 3 * RW_W + RW_DECAY_LORA + RW_AAA_LORA + RW_GATE_LORA
RW_SIZES = (RW_W, RW_W, RW_W, RW_DECAY_LORA, RW_AAA_LORA, RW_GATE_LORA)
RW_GN_EPS = 64e-5
CA_HEADS = 4
CA_DH = 128
CA_W = CA_HEADS * CA_DH
N_BRANCH = 3
IN_SIZES = (ML_QK_W, ML_W, ML_W, ML_HEADS, ML_HEADS, RW_IN_W, CA_W, N_BRANCH * D_MODEL)
D_IN = sum(IN_SIZES)
N_EXPERTS = 32
TOP_K = 4
D_FF = 1024
SWIGLU_LIMIT = 7.0
SWIGLU_ALPHA = 1.702
MOE_BLOCK = 128
DN_ALPHA = (2 * DEPTH) ** 0.25
DN_BETA = (8 * DEPTH) ** -0.25
LN_EPS = 1e-5

kernel_name = 'hybrid_mlstm_rwkv7_xattn_moe_deepnorm'


def split_cols(u, sizes):
    idx, acc = [], 0
    for s in sizes[:-1]:
        acc += s
        idx.append(acc)
    return jnp.split(u, idx, axis=-1)


def layer_norm(x, g, b, eps=LN_EPS):
    xf = x.astype(jnp.float32)
    mu = jnp.mean(xf, axis=-1, keepdims=True)
    var = jnp.mean(jnp.square(xf - mu), axis=-1, keepdims=True)
    return ((xf - mu) * lax.rsqrt(var + eps) * g + b).astype(x.dtype)


def head_norm(h, eps):
    hf = h.astype(jnp.float32)
    mu = jnp.mean(hf, axis=-1, keepdims=True)
    var = jnp.mean(jnp.square(hf - mu), axis=-1, keepdims=True)
    y = (hf - mu) * lax.rsqrt(var + eps)
    return y.reshape(*h.shape[:-2], h.shape[-2] * h.shape[-1])


def causal_dwconv(u, w, b):
    c = u.shape[-1]
    y = lax.conv_general_dilated(u, w[:, None, :].astype(u.dtype), window_strides=(1,),
                                 padding=[(w.shape[0] - 1, 0)],
                                 dimension_numbers=('NWC', 'WIO', 'NWC'),
                                 feature_group_count=c)
    return y + b


def token_shift(u, mu):
    u_prev = jnp.pad(u[:, :-1], ((0, 0), (1, 0), (0, 0)))
    return u + (u_prev - u) * mu


def mlstm_chunkwise(q, k, v, ig, lf):
    B, S, H, dk = q.shape
    L = ML_CHUNK
    nc = S // L

    def to_chunks(t):
        t = t.reshape(B, nc, L, H, *t.shape[3:])
        return jnp.moveaxis(t, (1, 3), (0, 2))

    causal = jnp.tril(jnp.ones((L, L), dtype=bool))

    def step(carry, inp):
        C, n, m = carry
        qc, kc, vc, ic, fc = inp
        bcum = jnp.cumsum(fc, axis=-1)
        dmat = bcum[..., :, None] - bcum[..., None, :] + ic[..., None, :]
        dmat = jnp.where(causal, dmat, -jnp.inf)
        m_inter = bcum + m[..., None]
        m_t = jnp.maximum(m_inter, jnp.max(dmat, axis=-1))
        w_intra = jnp.exp(dmat - m_t[..., None]) * jnp.einsum('bhtk,bhsk->bhts', qc, kc)
        s_inter = jnp.exp(m_inter - m_t)
        num = (s_inter[..., None] * jnp.einsum('bhvk,bhtk->bhtv', C, qc)
               + jnp.einsum('bhts,bhsv->bhtv', w_intra, vc))
        den = s_inter * jnp.einsum('bhk,bhtk->bht', n, qc) + jnp.sum(w_intra, axis=-1)
        h = num / jnp.maximum(jnp.abs(den), jnp.exp(-m_t))[..., None]
        b_last = bcum[..., -1]
        g = b_last[..., None] - bcum + ic
        m_new = jnp.maximum(b_last + m, jnp.max(g, axis=-1))
        carry_scale = jnp.exp(b_last + m - m_new)
        wg = jnp.exp(g - m_new[..., None])
        C_new = carry_scale[..., None, None] * C + jnp.einsum('bhs,bhsv,bhsk->bhvk', wg, vc, kc)
        n_new = carry_scale[..., None] * n + jnp.einsum('bhs,bhsk->bhk', wg, kc)
        return (C_new, n_new, m_new), h

    dv = v.shape[-1]
    init = (jnp.zeros((B, H, dv, dk), jnp.float32), jnp.zeros((B, H, dk), jnp.float32),
            jnp.zeros((B, H), jnp.float32))
    xs = (to_chunks(q), to_chunks(k), to_chunks(v), to_chunks(ig), to_chunks(lf))
    _, h = lax.scan(step, init, xs)
    return jnp.moveaxis(h, (0, 2), (1, 3)).reshape(B, S, H, dv)


def rwkv7_scan(r, w, k, v, kk, a):
    B, S, H, N = r.shape

    def step(state, inp):
        rt, wt, kt, vt, kkt, at = inp
        sa = jnp.einsum('bhvk,bhk->bhv', state, kkt)
        state = (state * wt[:, :, None, :] - sa[..., None] * (kkt * at)[:, :, None, :]
                 + vt[..., None] * kt[:, :, None, :])
        return state, jnp.einsum('bhvk,bhk->bhv', state, rt)

    xs = tuple(jnp.moveaxis(t, 1, 0) for t in (r, w, k, v, kk, a))
    _, out = lax.scan(step, jnp.zeros((B, H, N, N), jnp.float32), xs)
    return jnp.moveaxis(out, 0, 1)


def hybrid_mixer(x, mem_n, w_in, ml_conv_w, ml_conv_b, ml_ig_b, ml_fg_b, ml_norm_g,
                 rw_mu, rw_w0, rw_w_up, rw_a0, rw_a_up, rw_g_up, rw_kk, rw_ka, rw_rk,
                 rw_ln_g, rw_ln_b, ca_w_kv, gate_b, w_br_ml, w_br_rw, w_br_ca, w_o):
    B, S, _ = x.shape
    f32 = jnp.float32
    u = x @ w_in
    u_qk, ml_v, ml_og, ml_ig, ml_fg, u_rw, ca_q, u_gate = split_cols(u, IN_SIZES)

    qk = jax.nn.silu(causal_dwconv(u_qk, ml_conv_w, ml_conv_b))
    q, k = jnp.split(qk, 2, axis=-1)
    q = q.reshape(B, S, ML_HEADS, ML_DQK).astype(f32) * (ML_DQK ** -0.5)
    k = k.reshape(B, S, ML_HEADS, ML_DQK).astype(f32)
    v = ml_v.reshape(B, S, ML_HEADS, ML_DV).astype(f32)
    ig = (ml_ig + ml_ig_b).astype(f32)
    lf = jax.nn.log_sigmoid((ml_fg + ml_fg_b).astype(f32))
    h = mlstm_chunkwise(q, k, v, ig, lf)
    h_ml = jax.nn.sigmoid(ml_og) * (head_norm(h, LN_EPS) * ml_norm_g).astype(x.dtype)

    u_rw = token_shift(u_rw, rw_mu)
    r, kr, vr, wd, ad, gd = split_cols(u_rw, RW_SIZES)
    w_log = -jax.nn.softplus(-(rw_w0 + jnp.tanh(wd) @ rw_w_up)) - 0.5
    decay = jnp.exp(-jnp.exp(w_log.astype(f32)))
    a = jax.nn.sigmoid(rw_a0 + ad @ rw_a_up)
    g = jax.nn.sigmoid(gd) @ rw_g_up

    def heads(t):
        return t.reshape(B, S, RW_HEADS, RW_DH).astype(f32)

    kk = heads(kr * rw_kk)
    kk = kk * lax.rsqrt(jnp.maximum(jnp.sum(jnp.square(kk), axis=-1, keepdims=True), 1e-24))
    kr = kr * (1.0 + (a - 1.0) * rw_ka)
    rh, kh, vh, ah, wh = heads(r), heads(kr), heads(vr), heads(a), heads(decay)
    o = rwkv7_scan(rh, wh, kh, vh, kk, ah)
    bonus = (jnp.sum(rh * kh * rw_rk, axis=-1, keepdims=True) * vh).reshape(B, S, RW_W)
    h_rw = ((head_norm(o, RW_GN_EPS) * rw_ln_g + rw_ln_b) + bonus).astype(x.dtype) * g

    km, vm = jnp.split(mem_n @ ca_w_kv, 2, axis=-1)
    km = km.reshape(B, MEM_LEN, CA_HEADS, CA_DH).astype(f32)
    vm = vm.reshape(B, MEM_LEN, CA_HEADS, CA_DH).astype(f32)
    qc = ca_q.reshape(B, S, CA_HEADS, CA_DH).astype(f32)
    p = jax.nn.softmax(jnp.einsum('bshd,bmhd->bhsm', qc, km) * (CA_DH ** -0.5), axis=-1)
    h_ca = jnp.einsum('bhsm,bmhd->bshd', p, vm).reshape(B, S, CA_W).astype(x.dtype)

    gates = jax.nn.sigmoid(u_gate + gate_b).reshape(B, S, N_BRANCH, D_MODEL)
    y = (gates[:, :, 0] * (h_ml @ w_br_ml) + gates[:, :, 1] * (h_rw @ w_br_rw)
         + gates[:, :, 2] * (h_ca @ w_br_ca))
    return y @ w_o


def clamped_swiglu(h):
    x_glu = jnp.minimum(h[..., ::2], SWIGLU_LIMIT)
    x_lin = jnp.clip(h[..., 1::2], -SWIGLU_LIMIT, SWIGLU_LIMIT)
    return x_glu * jax.nn.sigmoid(SWIGLU_ALPHA * x_glu) * (x_lin + 1.0)


def moe_ffn(x, router_w, router_b, w_gu, b_gu, w_dn, b_dn):
    B, S, D = x.shape
    n_tok = B * S
    xt = x.reshape(n_tok, D)
    logits = (xt @ router_w + router_b).astype(jnp.float32)
    top_val, top_idx = lax.top_k(logits, TOP_K)
    gate = jax.nn.softmax(top_val, axis=-1)
    n_asg = n_tok * TOP_K
    e_flat = top_idx.reshape(n_asg).astype(jnp.int32)
    tok_flat = jnp.arange(n_asg, dtype=jnp.int32) // TOP_K
    counts = jax.ops.segment_sum(jnp.ones((n_asg,), jnp.int32), e_flat, num_segments=N_EXPERTS)
    padded = (counts + MOE_BLOCK - 1) // MOE_BLOCK * MOE_BLOCK
    pad_end = jnp.cumsum(padded)
    pad_start = pad_end - padded
    start = jnp.cumsum(counts) - counts
    order = jnp.argsort(e_flat)
    e_sorted = e_flat[order]
    dest_sorted = pad_start[e_sorted] + (jnp.arange(n_asg, dtype=jnp.int32) - start[e_sorted])
    n_blocks = -(-n_asg // MOE_BLOCK) + N_EXPERTS
    n_rows = n_blocks * MOE_BLOCK
    disp_tok = jnp.full((n_rows,), n_tok, jnp.int32).at[dest_sorted].set(tok_flat[order])
    x_pad = jnp.concatenate([xt, jnp.zeros((1, D), xt.dtype)], axis=0)
    x_disp = x_pad[disp_tok].reshape(n_blocks, MOE_BLOCK, D)
    blk_start = jnp.arange(n_blocks, dtype=jnp.int32) * MOE_BLOCK
    blk_e = jnp.minimum(jnp.searchsorted(pad_end, blk_start, side='right'), N_EXPERTS - 1).astype(jnp.int32)

    def expert_block(args):
        xb, e = args
        h = clamped_swiglu(xb @ w_gu[e] + b_gu[e])
        return h @ w_dn[e] + b_dn[e]

    y_disp = lax.map(expert_block, (x_disp, blk_e)).reshape(n_rows, D)
    dest = jnp.zeros((n_asg,), jnp.int32).at[order].set(dest_sorted)
    y = y_disp[dest].reshape(n_tok, TOP_K, D)
    out = jnp.einsum('nkd,nk->nd', y, gate.astype(y.dtype))
    return out.reshape(B, S, D)


def setup_inputs(seed: int = 0) -> dict:
    key = jax.random.key(seed)
    ks = iter(jax.random.split(key, 48))
    f32 = jnp.float32
    L, D = DEPTH, D_MODEL

    def nrm(shape, scale):
        return jax.random.normal(next(ks), shape, f32) * scale

    def gain(shape):
        return 1.0 + nrm(shape, 0.02)

    return {
        'x': nrm((BATCH, SEQ, D), 1.0),
        'mem': nrm((BATCH, MEM_LEN, D), 1.0),
        'ln_in_g': gain((D,)),
        'ln_in_b': nrm((D,), 0.02),
        'mem_ln_g': gain((D,)),
        'mem_ln_b': nrm((D,), 0.02),
        'w_in': nrm((L, D, D_IN), D ** -0.5),
        'ml_conv_w': nrm((L, ML_CONV, ML_QK_W), ML_CONV ** -0.5),
        'ml_conv_b': nrm((L, ML_QK_W), 0.02),
        'ml_ig_b': nrm((L, ML_HEADS), 0.1),
        'ml_fg_b': jnp.linspace(3.0, 6.0, ML_HEADS, dtype=f32)[None] + nrm((L, ML_HEADS), 0.1),
        'ml_norm_g': gain((L, ML_W)),
        'rw_mu': jax.random.uniform(next(ks), (L, RW_IN_W), f32, 0.1, 0.9),
        'rw_w0': jnp.linspace(-6.5, -1.5, RW_W, dtype=f32)[None] + nrm((L, RW_W), 0.1),
        'rw_w_up': nrm((L, RW_DECAY_LORA, RW_W), 0.5 * RW_DECAY_LORA ** -0.5),
        'rw_a0': nrm((L, RW_W), 0.1),
        'rw_a_up': nrm((L, RW_AAA_LORA, RW_W), 0.5 * RW_AAA_LORA ** -0.5),
        'rw_g_up': nrm((L, RW_GATE_LORA, RW_W), RW_GATE_LORA ** -0.5),
        'rw_kk': 0.85 + nrm((L, RW_W), 0.05),
        'rw_ka': 1.0 + nrm((L, RW_W), 0.05),
        'rw_rk': nrm((L, RW_HEADS, RW_DH), 0.1),
        'rw_ln_g': gain((L, RW_W)),
        'rw_ln_b': nrm((L, RW_W), 0.02),
        'ca_w_kv': nrm((L, D, 2 * CA_W), D ** -0.5),
        'gate_b': nrm((L, N_BRANCH * D), 0.1),
        'w_br_ml': nrm((L, ML_W, D), DN_BETA * ML_W ** -0.5),
        'w_br_rw': nrm((L, RW_W, D), DN_BETA * RW_W ** -0.5),
        'w_br_ca': nrm((L, CA_W, D), DN_BETA * CA_W ** -0.5),
        'w_o': nrm((L, D, D), DN_BETA * D ** -0.5),
        'ln1_g': gain((L, D)),
        'ln1_b': nrm((L, D), 0.02),
        'router_w': nrm((L, D, N_EXPERTS), D ** -0.5),
        'router_b': nrm((L, N_EXPERTS), 0.01),
        'w_gu': nrm((L, N_EXPERTS, D, 2 * D_FF), D ** -0.5),
        'b_gu': nrm((L, N_EXPERTS, 2 * D_FF), 0.02),
        'w_dn': nrm((L, N_EXPERTS, D_FF, D), DN_BETA * D_FF ** -0.5),
        'b_dn': nrm((L, N_EXPERTS, D), 0.02),
        'ln2_g': gain((L, D)),
        'ln2_b': nrm((L, D), 0.02),
    }


def reference(x, mem, ln_in_g, ln_in_b, mem_ln_g, mem_ln_b, w_in, ml_conv_w, ml_conv_b,
              ml_ig_b, ml_fg_b, ml_norm_g, rw_mu, rw_w0, rw_w_up, rw_a0, rw_a_up, rw_g_up,
              rw_kk, rw_ka, rw_rk, rw_ln_g, rw_ln_b, ca_w_kv, gate_b, w_br_ml, w_br_rw,
              w_br_ca, w_o, ln1_g, ln1_b, router_w, router_b, w_gu, b_gu, w_dn, b_dn,
              ln2_g, ln2_b):
    x = layer_norm(x, ln_in_g, ln_in_b)
    mem_n = layer_norm(mem, mem_ln_g, mem_ln_b)
    for l in range(DEPTH):
        y = hybrid_mixer(x, mem_n, w_in[l], ml_conv_w[l], ml_conv_b[l], ml_ig_b[l], ml_fg_b[l],
                         ml_norm_g[l], rw_mu[l], rw_w0[l], rw_w_up[l], rw_a0[l], rw_a_up[l],
                         rw_g_up[l], rw_kk[l], rw_ka[l], rw_rk[l], rw_ln_g[l], rw_ln_b[l],
                         ca_w_kv[l], gate_b[l], w_br_ml[l], w_br_rw[l], w_br_ca[l], w_o[l])
        x = layer_norm(DN_ALPHA * x + y, ln1_g[l], ln1_b[l])
        y = moe_ffn(x, router_w[l], router_b[l], w_gu[l], b_gu[l], w_dn[l], b_dn[l])
        x = layer_norm(DN_ALPHA * x + y, ln2_g[l], ln2_b[l])
    return x
```

```cpp
#include <hip/hip_runtime.h>
#include <cstdio>
#include <cstdint>

#ifndef MK_ONE_LAUNCH
#define MK_ONE_LAUNCH 1
#endif

#define LAS __attribute__((address_space(3)))
#define GAS __attribute__((address_space(1)))
typedef unsigned short bf16;
typedef short bf16x8 __attribute__((ext_vector_type(8)));
typedef float f32x4 __attribute__((ext_vector_type(4)));
typedef float f32x2 __attribute__((ext_vector_type(2)));
typedef float f32x16 __attribute__((ext_vector_type(16)));
typedef unsigned u32x4 __attribute__((ext_vector_type(4)));
typedef unsigned u32x2 __attribute__((ext_vector_type(2)));
typedef __bf16 bf16x2_t __attribute__((ext_vector_type(2)));
typedef GAS unsigned gu32;
#define RLX_AGENT __ATOMIC_RELAXED, __HIP_MEMORY_SCOPE_AGENT
#define DI __device__ __forceinline__

constexpr int NWAVES = 8, NTHR = 512;
constexpr int D = 1024, BATCH = 16, SEQ = 4096, M = BATCH * SEQ, DEPTH = 2, MEML = 256, MROWS = BATCH * MEML;
constexpr int DIN = 6920, NU = 6912;
constexpr int UC_QK = 0, UC_V = 512, UC_OG = 1024, UC_RW = 1536, UC_CAQ = 3328, UC_GATE = 3840;
constexpr int NEXP = 32, TOPK = 4;
constexpr int PMAX = M * TOPK / 256 + NEXP;
constexpr float LN_EPS = 1e-5f, RW_GN_EPS = 64e-5f, DN_ALPHA = 1.41421356237f;

enum { I_X = 0, I_MEM, I_LNIN_G, I_LNIN_B, I_MEMLN_G, I_MEMLN_B, I_WIN, I_CONVW, I_CONVB, I_IGB, I_FGB, I_MLNORMG, I_RWMU, I_RWW0, I_RWWUP, I_RWA0, I_RWAUP, I_RWGUP,
       I_RWKK, I_RWKA, I_RWRK, I_RWLNG, I_RWLNB, I_CAWKV, I_GATEB, I_WBRML, I_WBRRW, I_WBRCA, I_WO, I_LN1G, I_LN1B, I_RTW, I_RTB, I_WGU, I_BGU, I_WDN, I_BDN, I_LN2G, I_LN2B, N_IN };

constexpr size_t MiB = 1u << 20;
constexpr size_t WS_CTL = 0, CTL_ZERO_BYTES = 1 * MiB;
constexpr size_t WS_WIN = 1 * MiB;
constexpr size_t WS_WKV = 28 * MiB;
constexpr size_t WS_WBR = 32 * MiB;
constexpr size_t WS_WO = 38 * MiB;
constexpr size_t WS_WLORA = 42 * MiB;
constexpr size_t WS_WGU = 45 * MiB;
constexpr size_t WS_WDN = 173 * MiB;
constexpr size_t WS_X = 237 * MiB;
constexpr size_t WS_MEMN = 365 * MiB;
constexpr size_t WS_KV = 373 * MiB;
constexpr size_t WS_GIF = 389 * MiB;
constexpr size_t WS_TKE = 391 * MiB, WS_TKG = 392 * MiB, WS_TKP = 393 * MiB;
constexpr size_t WS_ROWTOK = 394 * MiB;
constexpr size_t WS_HML = 402 * MiB;
constexpr size_t WS_R1 = 466 * MiB;
constexpr size_t WS_R2 = 1330 * MiB;
constexpr size_t WS_END = 1858 * MiB;
constexpr size_t R2_LORA_OUT = 0, R2_HCAT = 192 * MiB, R2_LORA_IN = 384 * MiB, R2_YPRE = 0, R2_Z = 192 * MiB, R2_HMID = 0;
constexpr int CW_TMO = 0, CW_BAR = 4096, CW_CNT = 16384;

constexpr int LDS_BYTES = 155648;
constexpr int LDSCTL_OFF = 153600;

DI unsigned f2bf(float f) { unsigned u = __builtin_bit_cast(unsigned, f); return (u + 0x7fffu + ((u >> 16) & 1u)) >> 16; }
DI unsigned pk2(float lo, float hi) { bf16x2_t b = __builtin_convertvector((f32x2){lo, hi}, bf16x2_t); return __builtin_bit_cast(unsigned, b); }
DI float bflo(unsigned u) { return __builtin_bit_cast(float, u << 16); }
DI float bfhi(unsigned u) { return __builtin_bit_cast(float, u & 0xffff0000u); }
DI float sigmoidf_(float x) { return __builtin_amdgcn_rcpf(1.f + __builtin_amdgcn_exp2f(-1.4426950408889634f * x)); }
template <int CTRL> DI float dppf(float x) { return __builtin_bit_cast(float, __builtin_amdgcn_update_dpp(0, __builtin_bit_cast(int, x), CTRL, 0xF, 0xF, true)); }
DI float red4(float x) { x += dppf<0xB1>(x); x += dppf<0x4E>(x); return x; }
DI float red8(float x) { x = red4(x); x += dppf<0x141>(x); return x; }
DI float red16(float x) { x = red8(x); x += dppf<0x140>(x); return x; }
DI float wave_sum(float v) {
#pragma unroll
    for (int o = 1; o < 64; o <<= 1) v += __shfl_xor(v, o);
    return v;
}
#define LDS_WAIT() asm volatile("s_waitcnt lgkmcnt(0)" ::: "memory")

namespace pg8 {
constexpr int BM = 256, BK = 64, HALF = 128, HTB = HALF * BK * 2, STAGE_BYTES = 8 * HTB, NXCD = 8, WGM = 8;
__host__ __device__ __forceinline__ int lds_byte(int r, int c) { const int st = (r >> 4) * 2 + (c >> 5), rr = r & 15, cc = c & 31, ob = rr * 64 + cc * 2; return st * 1024 + (ob ^ (((ob >> 9) & 1) << 5)); }
__host__ __device__ __forceinline__ void stage_rc(int b, int& R, int& C) { const int st = b / 1024, sb = b % 1024, swz = sb ^ (((sb >> 9) & 1) << 5); R = (st >> 1) * 16 + swz / 64; C = (st & 1) * 32 + (swz % 64) / 2; }
__host__ __device__ __forceinline__ int perm32(int rho) { const int n = rho >> 4, i = rho & 15; return 8 * (i >> 2) + 4 * n + (i & 3); }

struct Unit { const char* a; const char* b; char* c; int ldc; int r0, c0, e, sub; };

struct TileOrder {
    int nM, nN, nwg;
    DI void init(int nM_, int nN_) { nM = nM_; nN = nN_; nwg = nM * nN; }
    DI bool tile(long L, int& pm, int& pn) const {
        if (L >= nwg) return false;
        int wgid = (int)L; { const int q = nwg / NXCD, r = nwg % NXCD, xcd = wgid % NXCD, off = wgid / NXCD; wgid = (xcd < r ? xcd * (q + 1) : r * (q + 1) + (xcd - r) * q) + off; }
        const int nig = WGM * nN, gid = wgid / nig, fm = gid * WGM, gsz = (nM - fm) < WGM ? (nM - fm) : WGM;
        pm = fm + ((wgid % nig) % gsz); pn = (wgid % nig) / gsz; return true;
    }
};

DI u32x4 pack8(const f32x4& v0, const f32x4& v1) { u32x4 w; w.x = pk2(v0[0], v0[1]); w.y = pk2(v0[2], v0[3]); w.z = pk2(v1[0], v1[1]); w.w = pk2(v1[2], v1[3]); return w; }

struct EpiStore {
    DI void operator()(const f32x4 (&acc)[2][2][4][2], const Unit& u, int wr, int wc, int fr, int fq) const {
#pragma unroll
        for (int ai = 0; ai < 2; ++ai)
#pragma unroll
            for (int m = 0; m < 4; ++m) { char* rowp = u.c + ((size_t)(ai * HALF + wr * 64 + m * 16 + fr) * u.ldc + wc * 32 + 8 * fq) * 2;
#pragma unroll
                for (int bj = 0; bj < 2; ++bj) *(u32x4*)(rowp + bj * 256) = pack8(acc[ai][bj][m][0], acc[ai][bj][m][1]); }
    }
};
struct EpiMerge {
    const char* U; const float* gate_b;
    DI void operator()(const f32x4 (&acc)[2][2][4][2], const Unit& u, int wr, int wc, int fr, int fq) const {
        f32x4 gb[2][2];
#pragma unroll
        for (int bj = 0; bj < 2; ++bj) { const float* g = gate_b + u.sub * 1024 + u.c0 + bj * HALF + wc * 32 + 8 * fq; gb[bj][0] = *(const f32x4*)g; gb[bj][1] = *(const f32x4*)(g + 4); }
#pragma unroll
        for (int ai = 0; ai < 2; ++ai)
#pragma unroll
            for (int m = 0; m < 4; ++m) { const int lr = ai * HALF + wr * 64 + m * 16 + fr; char* rowp = u.c + ((size_t)lr * u.ldc + wc * 32 + 8 * fq) * 2;
                const char* gp = U + ((size_t)(u.r0 + lr) * NU + UC_GATE + u.sub * 1024 + u.c0 + wc * 32 + 8 * fq) * 2;
#pragma unroll
                for (int bj = 0; bj < 2; ++bj) { const u32x4 gw = *(const u32x4*)(gp + bj * 256);
                    f32x4 v0 = acc[ai][bj][m][0], v1 = acc[ai][bj][m][1];
                    v0[0] *= sigmoidf_(bflo(gw.x) + gb[bj][0][0]); v0[1] *= sigmoidf_(bfhi(gw.x) + gb[bj][0][1]); v0[2] *= sigmoidf_(bflo(gw.y) + gb[bj][0][2]); v0[3] *= sigmoidf_(bfhi(gw.y) + gb[bj][0][3]);
                    v1[0] *= sigmoidf_(bflo(gw.z) + gb[bj][1][0]); v1[1] *= sigmoidf_(bfhi(gw.z) + gb[bj][1][1]); v1[2] *= sigmoidf_(bflo(gw.w) + gb[bj][1][2]); v1[3] *= sigmoidf_(bfhi(gw.w) + gb[bj][1][3]);
                    if (u.sub) { u32x4 pw; { const unsigned long long q0 = __hip_atomic_load((const unsigned long long*)(rowp + bj * 256), RLX_AGENT), q1 = __hip_atomic_load((const unsigned long long*)(rowp + bj * 256 + 8), RLX_AGENT);
                            pw.x = (unsigned)q0; pw.y = (unsigned)(q0 >> 32); pw.z = (unsigned)q1; pw.w = (unsigned)(q1 >> 32); }
                        v0[0] += bflo(pw.x); v0[1] += bfhi(pw.x); v0[2] += bflo(pw.y); v0[3] += bfhi(pw.y); v1[0] += bflo(pw.z); v1[1] += bfhi(pw.z); v1[2] += bflo(pw.w); v1[3] += bfhi(pw.w); }
                    *(u32x4*)(rowp + bj * 256) = pack8(v0, v1); }
                asm volatile("" ::: "memory"); }
    }
};
struct EpiWo {
    const char* X;
    DI void operator()(const f32x4 (&acc)[2][2][4][2], const Unit& u, int wr, int wc, int fr, int fq) const {
#pragma unroll
        for (int ai = 0; ai < 2; ++ai)
#pragma unroll
            for (int m = 0; m < 4; ++m) { const int lr = ai * HALF + wr * 64 + m * 16 + fr; char* rowp = u.c + ((size_t)lr * u.ldc + wc * 32 + 8 * fq) * 2;
                const char* xp = X + ((size_t)(u.r0 + lr) * D + u.c0 + wc * 32 + 8 * fq) * 2;
#pragma unroll
                for (int bj = 0; bj < 2; ++bj) { const u32x4 xw = *(const u32x4*)(xp + bj * 256);
                    f32x4 v0 = acc[ai][bj][m][0], v1 = acc[ai][bj][m][1];
                    v0[0] += DN_ALPHA * bflo(xw.x); v0[1] += DN_ALPHA * bfhi(xw.x); v0[2] += DN_ALPHA * bflo(xw.y); v0[3] += DN_ALPHA * bfhi(xw.y);
                    v1[0] += DN_ALPHA * bflo(xw.z); v1[1] += DN_ALPHA * bfhi(xw.z); v1[2] += DN_ALPHA * bflo(xw.w); v1[3] += DN_ALPHA * bfhi(xw.w);
                    *(u32x4*)(rowp + bj * 256) = pack8(v0, v1); }
                asm volatile("" ::: "memory"); }
    }
};
DI float swiglu1(float a, float b) { const float g = fminf(a, 7.f), l = fminf(fmaxf(b, -7.f), 7.f); return g * sigmoidf_(1.702f * g) * (l + 1.f); }
struct EpiMoe1 {
    const float* bgu;
    DI void operator()(const f32x4 (&acc)[2][2][4][2], const Unit& u, int wr, int wc, int fr, int fq) const {
        f32x4 bv[2][2];
#pragma unroll
        for (int bj = 0; bj < 2; ++bj) { const float* b = bgu + u.e * 2048 + u.c0 + bj * HALF + wc * 32 + 8 * fq; bv[bj][0] = *(const f32x4*)b; bv[bj][1] = *(const f32x4*)(b + 4); }
#pragma unroll
        for (int ai = 0; ai < 2; ++ai)
#pragma unroll
            for (int m = 0; m < 4; ++m) { const int lr = ai * HALF + wr * 64 + m * 16 + fr; char* rowp = u.c + ((size_t)lr * u.ldc + wc * 16 + 4 * fq) * 2;
#pragma unroll
                for (int bj = 0; bj < 2; ++bj) { const f32x4 v0 = acc[ai][bj][m][0] + bv[bj][0], v1 = acc[ai][bj][m][1] + bv[bj][1];
                    u32x2 w; w.x = pk2(swiglu1(v0[0], v0[1]), swiglu1(v0[2], v0[3])); w.y = pk2(swiglu1(v1[0], v1[1]), swiglu1(v1[2], v1[3]));
                    *(u32x2*)(rowp + bj * 128) = w; } }
    }
};
struct EpiMoe2 {
    const float* bdn;
    DI void operator()(const f32x4 (&acc)[2][2][4][2], const Unit& u, int wr, int wc, int fr, int fq) const {
        f32x4 bv[2][2];
#pragma unroll
        for (int bj = 0; bj < 2; ++bj) { const float* b = bdn + u.e * 1024 + u.c0 + bj * HALF + wc * 32 + 8 * fq; bv[bj][0] = *(const f32x4*)b; bv[bj][1] = *(const f32x4*)(b + 4); }
#pragma unroll
        for (int ai = 0; ai < 2; ++ai)
#pragma unroll
            for (int m = 0; m < 4; ++m) { char* rowp = u.c + ((size_t)(ai * HALF + wr * 64 + m * 16 + fr) * u.ldc + wc * 32 + 8 * fq) * 2;
#pragma unroll
                for (int bj = 0; bj < 2; ++bj) *(u32x4*)(rowp + bj * 256) = pack8(acc[ai][bj][m][0] + bv[bj][0], acc[ai][bj][m][1] + bv[bj][1]); }
    }
};

template <class Epi, class Sched>
DI void gemm_phase(LAS unsigned char* lds, const int K, const int ldaB, const int ldbB, const Sched& S, const Epi& E) {
    int tid = threadIdx.x; asm volatile("" : "+v"(tid));
    const int wid = __builtin_amdgcn_readfirstlane(tid >> 6), lane = tid & 63, wr = wid >> 2, wc = wid & 3, fr = lane & 15, fq = lane >> 4;
    const int nt = K / BK;
    unsigned voffA[2], voffB[2];
#pragma unroll
    for (int i = 0; i < 2; ++i) { int R, C; stage_rc(tid * 16 + i * 8192, R, C); const int Rb = (R & ~31) + perm32(R & 31);
        voffA[i] = (unsigned)(R * ldaB + C * 2); voffB[i] = (unsigned)(Rb * ldbB + C * 2); }
    const size_t kstep = (size_t)(BK * 2);
    const size_t hstepA = (size_t)HALF * ldaB, hstepB = (size_t)HALF * ldbB;
    const unsigned ldsw = (unsigned)wid * 1024u;
    const int aoff = lds_byte(wr * 64 + fr, fq * 8), boff = lds_byte(wc * 32 + fr, fq * 8);
#define PG8_SA(b, h) (((b) * 2 + (h)) * HTB)
#define PG8_SB(b, h) ((4 + (b) * 2 + (h)) * HTB)
#define PG8_STAGE(bufoff, gbase, voff) do { _Pragma("unroll") for (int _i = 0; _i < 2; ++_i) \
        __builtin_amdgcn_global_load_lds((const unsigned*)((const char*)(gbase) + (voff)[_i]), (LAS unsigned*)(lds + (bufoff) + ldsw + _i * 8192), 16, 0, 0); } while (0)
#define PG8_LDA(dst, b, h) do { _Pragma("unroll") for (int m = 0; m < 4; ++m) _Pragma("unroll") for (int k = 0; k < 2; ++k) dst[m][k] = *(const LAS bf16x8*)(lds + PG8_SA(b, h) + aoff + m * 2048 + k * 1024); } while (0)
#define PG8_LDB(dst, b, h) do { _Pragma("unroll") for (int n = 0; n < 2; ++n) _Pragma("unroll") for (int k = 0; k < 2; ++k) dst[n][k] = *(const LAS bf16x8*)(lds + PG8_SB(b, h) + boff + n * 2048 + k * 1024); } while (0)
#define PG8_MMA(ai, bj, At, Bt) do { __builtin_amdgcn_s_setprio(1); _Pragma("unroll") for (int m = 0; m < 4; ++m) _Pragma("unroll") for (int n = 0; n < 2; ++n) _Pragma("unroll") for (int k = 0; k < 2; ++k) \
        acc[ai][bj][m][n] = __builtin_amdgcn_mfma_f32_16x16x32_bf16(Bt[n][k], At[m][k], acc[ai][bj][m][n], 0, 0, 0); __builtin_amdgcn_s_setprio(0); } while (0)
#define PG8_WAIT_V(n) asm volatile("s_waitcnt vmcnt(" #n ")" ::: "memory")
#define PG8_WAIT_L(n) asm volatile("s_waitcnt lgkmcnt(" #n ")" ::: "memory")
#define PG8_BAR __builtin_amdgcn_s_barrier()
#define PG8_SCHED __builtin_amdgcn_sched_barrier(0)
    Unit cur, nxt; int ui = 0;
    if (!S.next(0, cur)) return;
    f32x4 acc[2][2][4][2];
#pragma unroll
    for (int a = 0; a < 2; ++a)
#pragma unroll
        for (int b = 0; b < 2; ++b)
#pragma unroll
            for (int m = 0; m < 4; ++m)
#pragma unroll
                for (int n = 0; n < 2; ++n) acc[a][b][m][n] = (f32x4){0.f, 0.f, 0.f, 0.f};
    bf16x8 At[4][2], B0[2][2], B1[2][2];
    const char* cA = cur.a; const char* cB = cur.b;
    PG8_STAGE(PG8_SB(0, 0), cB, voffB); PG8_STAGE(PG8_SB(0, 1), cB + hstepB, voffB); PG8_STAGE(PG8_SA(0, 0), cA, voffA); PG8_STAGE(PG8_SA(0, 1), cA + hstepA, voffA);
    if (wr == 1) PG8_BAR;
    PG8_WAIT_V(2); PG8_BAR;
    PG8_STAGE(PG8_SB(1, 0), cB + kstep, voffB); PG8_STAGE(PG8_SA(1, 0), cA + kstep, voffA); PG8_STAGE(PG8_SB(1, 1), cB + hstepB + kstep, voffB);
    PG8_WAIT_V(6); PG8_BAR;
    for (;;) {
        const bool has_next = S.next(ui + 1, nxt);
        const char* nA = has_next ? nxt.a : cA; const char* nB = has_next ? nxt.b : cB;
#pragma unroll 1
        for (int t = 0; t < nt; t += 2) {
            const bool last = (t == nt - 2);
            const char* a1 = cA + (size_t)(t + 1) * kstep;
            const char* a2 = last ? nA : cA + (size_t)(t + 2) * kstep; const char* b2 = last ? nB : cB + (size_t)(t + 2) * kstep;
            const char* a3 = a2 + kstep; const char* b3 = b2 + kstep;
            PG8_LDB(B0, 0, 0); PG8_LDB(B1, 0, 1); PG8_SCHED; PG8_LDA(At, 0, 0); PG8_STAGE(PG8_SA(1, 1), a1 + hstepA, voffA);
            PG8_WAIT_V(8); PG8_WAIT_L(0); PG8_BAR; PG8_MMA(0, 0, At, B0); PG8_MMA(0, 1, At, B1); PG8_BAR; PG8_SCHED;
            PG8_LDA(At, 0, 1); PG8_STAGE(PG8_SB(0, 0), b2, voffB); PG8_STAGE(PG8_SB(0, 1), b2 + hstepB, voffB); PG8_STAGE(PG8_SA(0, 0), a2, voffA);
            PG8_WAIT_V(8); PG8_WAIT_L(0); PG8_BAR; PG8_MMA(1, 0, At, B0); PG8_MMA(1, 1, At, B1); PG8_BAR; PG8_SCHED;
            PG8_LDB(B0, 1, 0); PG8_LDB(B1, 1, 1); PG8_SCHED; PG8_LDA(At, 1, 0); PG8_STAGE(PG8_SA(0, 1), a2 + hstepA, voffA);
            PG8_WAIT_V(8); PG8_WAIT_L(0); PG8_BAR; PG8_MMA(0, 0, At, B0); PG8_MMA(0, 1, At, B1); PG8_BAR; PG8_SCHED;
            PG8_LDA(At, 1, 1); PG8_STAGE(PG8_SB(1, 0), b3, voffB); PG8_STAGE(PG8_SB(1, 1), b3 + hstepB, voffB); PG8_STAGE(PG8_SA(1, 0), a3, voffA);
            PG8_WAIT_V(8); PG8_WAIT_L(0); PG8_BAR; PG8_MMA(1, 0, At, B0); PG8_MMA(1, 1, At, B1); PG8_BAR; PG8_SCHED;
        }
        if (wr == 0) PG8_BAR;
        { int fr_ = fr, fq_ = fq; asm volatile("" : "+v"(fr_), "+v"(fq_));
          E(acc, cur, wr, wc, fr_, fq_); }
        if (!has_next) break;
#pragma unroll
        for (int a = 0; a < 2; ++a)
#pragma unroll
            for (int b = 0; b < 2; ++b)
#pragma unroll
                for (int m = 0; m < 4; ++m)
#pragma unroll
                    for (int n = 0; n < 2; ++n) acc[a][b][m][n] = (f32x4){0.f, 0.f, 0.f, 0.f};
        cur = nxt; cA = nA; cB = nB; ++ui;
        if (wr == 1) PG8_BAR;
    }
    PG8_WAIT_V(0);
    PG8_BAR;
#undef PG8_SA
#undef PG8_SB
#undef PG8_STAGE
#undef PG8_LDA
#undef PG8_LDB
#undef PG8_MMA
#undef PG8_WAIT_V
#undef PG8_WAIT_L
#undef PG8_BAR
#undef PG8_SCHED
}
}

#define XB_TMO      128
#define XB_XCNT(j)  (256  + 64 * (j))
#define XB_XSUB(j)  (1280 + 64 * (j))
#define XB_XGEN(j)  (2304 + 64 * (j))
#define XB_TOP      3328
#define XB_TOPGEN   3392
#define XCD_BAR_WORDS 3456
#define XB_SPIN_CAP (1u << 22)
DI unsigned xb_ld(unsigned* p)              { return __hip_atomic_load(p, __ATOMIC_RELAXED, __HIP_MEMORY_SCOPE_AGENT); }
DI unsigned xb_add(unsigned* p, unsigned v) { return __hip_atomic_fetch_add(p, v, __ATOMIC_RELAXED, __HIP_MEMORY_SCOPE_AGENT); }
DI unsigned xb_xcc_id() { return (unsigned)__builtin_amdgcn_s_getreg((3 << 11) | 20) & 0xFu; }
#define XB_SPIN(cond, bar) do { unsigned _sp = 0; while (cond) { __builtin_amdgcn_s_sleep(1); \
    if ((++_sp & 255u) == 0u) { if (xb_ld(&(bar)[XB_TMO])) break; if (_sp > XB_SPIN_CAP) { atomicAdd(&(bar)[XB_TMO], 1u); break; } } } } while (0)
struct XcdBarrier { unsigned* bar; unsigned x; volatile LAS unsigned* st; };
DI XcdBarrier xcd_barrier_post(unsigned* bar, volatile LAS unsigned* st) {
    XcdBarrier b; b.bar = bar; b.x = xb_xcc_id(); b.st = st;
    if (threadIdx.x == 0) (void)xb_add(&bar[XB_XCNT(b.x)], 1u);
    return b;
}
DI void xcd_barrier_complete(unsigned* bar, unsigned x, unsigned& nloc, unsigned& nx) {
    const unsigned G = gridDim.x * gridDim.y * gridDim.z;
    unsigned sum, cnt, mine, sp = 0u;
    for (;;) {
        sum = 0u; cnt = 0u; mine = 0u;
#pragma unroll
        for (unsigned j = 0; j < 16; ++j) { const unsigned c = xb_ld(&bar[XB_XCNT(j)]); sum += c; cnt += (c > 0u) ? 1u : 0u; mine = (j == x) ? c : mine; }
        if (sum == G) break;
        __builtin_amdgcn_s_sleep(1);
        if ((++sp & 255u) == 0u) { if (xb_ld(&bar[XB_TMO])) break; if (sp > XB_SPIN_CAP) { atomicAdd(&bar[XB_TMO], 1u); break; } }
    }
    nloc = mine > 0u ? mine : 1u; nx = cnt > 0u ? cnt : 1u;
}
DI void xcd_barrier(const XcdBarrier& b) {
    asm volatile("s_waitcnt vmcnt(0)" ::: "memory");
    __syncthreads();
    if (threadIdx.x == 0) {
        unsigned* bar = b.bar;
        __builtin_amdgcn_s_waitcnt(0);
        unsigned nloc = b.st[0], nx = b.st[1];
        if (nloc == 0u) { xcd_barrier_complete(bar, b.x, nloc, nx); b.st[0] = nloc; b.st[1] = nx; }
        const unsigned old = xb_add(&bar[XB_XSUB(b.x)], 1u);
        const unsigned gen = old / nloc;
        if (old + 1u == (gen + 1u) * nloc) {
            __builtin_amdgcn_fence(__ATOMIC_RELEASE, "agent");
            asm volatile("s_waitcnt vmcnt(0)" ::: "memory");
            const unsigned og = xb_add(&bar[XB_TOP], 1u);
            const unsigned tg = og / nx;
            if (og + 1u == (tg + 1u) * nx) xb_add(&bar[XB_TOPGEN], 1u);
            else XB_SPIN(xb_ld(&bar[XB_TOPGEN]) == tg, bar);
            __builtin_amdgcn_fence(__ATOMIC_ACQUIRE, "agent");
            xb_add(&bar[XB_XGEN(b.x)], 1u);
            asm volatile("s_waitcnt vmcnt(0)" ::: "memory");
        } else {
            XB_SPIN(xb_ld(&bar[XB_XGEN(b.x)]) == gen, bar);
            __builtin_amdgcn_fence(__ATOMIC_ACQUIRE, "agent");
            asm volatile("s_waitcnt vmcnt(0)" ::: "memory");
        }
    }
    __syncthreads();
}

DI void transpose_item(const float* W, int ldw, bf16* WT, int ldt, LAS float* scr, int lane) {
#pragma unroll 8
    for (int i = 0; i < 32; ++i) { const int kk = 2 * i + (lane >> 5); scr[kk * 33 + (lane & 31)] = W[(size_t)kk * ldw + (lane & 31)]; }
    LDS_WAIT(); asm volatile("" ::: "memory");
    const int c = lane & 7;
#pragma unroll
    for (int j = 0; j < 4; ++j) { const int n = (lane >> 3) + 8 * j; const LAS float* s = scr + (8 * c) * 33 + n;
        u32x4 o; o.x = pk2(s[0 * 33], s[1 * 33]); o.y = pk2(s[2 * 33], s[3 * 33]); o.z = pk2(s[4 * 33], s[5 * 33]); o.w = pk2(s[6 * 33], s[7 * 33]);
        *(u32x4*)(WT + (size_t)n * ldt + 8 * c) = o; }
    LDS_WAIT(); asm volatile("" ::: "memory");
}
DI void ln16(f32x4 (&v)[4], const f32x4 (&g)[4], const f32x4 (&b)[4]) {
    float s = 0.f;
#pragma unroll
    for (int j = 0; j < 4; ++j) s += (v[j].x + v[j].y) + (v[j].z + v[j].w);
    const float mean = wave_sum(s) * (1.f / D); float s2 = 0.f;
#pragma unroll
    for (int j = 0; j < 4; ++j) { v[j] = v[j] - mean; s2 += (v[j].x * v[j].x + v[j].y * v[j].y) + (v[j].z * v[j].z + v[j].w * v[j].w); }
    const float rstd = 1.f / sqrtf(wave_sum(s2) * (1.f / D) + LN_EPS);
#pragma unroll
    for (int j = 0; j < 4; ++j) v[j] = v[j] * rstd * g[j] + b[j];
}
DI void gates8(const f32x4 (&y)[4], const LAS float* wgt, float* gif_row, int lane) {
    float p[8];
#pragma unroll
    for (int j = 0; j < 8; ++j) { float s = 0.f;
#pragma unroll
        for (int jj = 0; jj < 4; ++jj) { const f32x4 w = *(const LAS f32x4*)(wgt + j * 1024 + 256 * jj + 4 * lane); s += (y[jj].x * w.x + y[jj].y * w.y) + (y[jj].z * w.z + y[jj].w * w.w); }
        p[j] = wave_sum(s); }
    if (lane == 0) { *(f32x4*)gif_row = (f32x4){p[0], p[1], p[2], p[3]}; *(f32x4*)(gif_row + 4) = (f32x4){p[4], p[5], p[6], p[7]}; }
}
DI void load_gate_table(LAS float* wgt, const float* win_l, int tid) {
    for (int i = tid; i < 8192; i += NTHR) { const int k = i >> 3, j = i & 7; wgt[j * 1024 + k] = win_l[(size_t)k * DIN + 1536 + j]; }
}
DI f32x4 ld4bf(const char* p) { const u32x2 w = *(const u32x2*)p; return (f32x4){bflo(w.x), bfhi(w.x), bflo(w.y), bfhi(w.y)}; }
DI void st4bf(char* p, const f32x4& v) { u32x2 w; w.x = pk2(v.x, v.y); w.y = pk2(v.z, v.w); *(u32x2*)p = w; }

struct Args { const float* in[N_IN]; float* out; unsigned char* ws; int ph_lo, ph_hi; };
constexpr int NP_LAYER = 12, NPH = 1 + DEPTH * NP_LAYER;

struct SchedInproj {
    pg8::TileOrder T; int G, c; const char *X, *W; char* U; bool kv; const char *MEMN, *WKV; char* KV;
    DI bool next(int i, pg8::Unit& u) const {
        const long L = (long)i * G + c; int pm, pn;
        if (T.tile(L, pm, pn)) { u.a = X + (size_t)pm * 256 * D * 2; u.b = W + (size_t)pn * 256 * D * 2; u.r0 = pm * 256; u.c0 = pn * 256; u.c = U + ((size_t)u.r0 * NU + u.c0) * 2; u.ldc = NU; u.e = 0; u.sub = 0; return true; }
        if (!kv) return false;
        const long L2 = L - T.nwg; if (L2 < 0 || L2 >= 128) return false;
        const int l = (int)L2 >> 6, t = (int)L2 & 63; pm = t >> 2; pn = t & 3;
        u.a = MEMN + (size_t)pm * 256 * D * 2; u.b = WKV + ((size_t)l * 1024 + pn * 256) * D * 2; u.r0 = pm * 256; u.c0 = pn * 256; u.c = KV + (((size_t)l * MROWS + u.r0) * D + u.c0) * 2; u.ldc = D; u.e = 0; u.sub = 0; return true;
    }
};
struct SchedPlain {
    pg8::TileOrder T; int G, c; const char *A, *B; char* C; int lda, ldb, ldc;
    DI bool next(int i, pg8::Unit& u) const {
        const long L = (long)i * G + c; int pm, pn; if (!T.tile(L, pm, pn)) return false;
        u.a = A + (size_t)pm * 256 * lda * 2; u.b = B + (size_t)pn * 256 * ldb * 2; u.r0 = pm * 256; u.c0 = pn * 256; u.c = C + ((size_t)u.r0 * ldc + u.c0) * 2; u.ldc = ldc; u.e = 0; u.sub = 0; return true;
    }
};
struct SchedMerge {
    pg8::TileOrder T; int G, c; const char *H, *W; char* Y;
    DI bool next(int i, pg8::Unit& u) const {
        const int ti = i / 3, br = i - 3 * ti; const long L = (long)ti * G + c; int pm, pn; if (!T.tile(L, pm, pn)) return false;
        u.a = H + ((size_t)pm * 256 * 1536 + br * 512) * 2; u.b = W + ((size_t)br * 1024 + pn * 256) * 512 * 2; u.r0 = pm * 256; u.c0 = pn * 256; u.c = Y + ((size_t)u.r0 * D + u.c0) * 2; u.ldc = D; u.e = 0; u.sub = br; return true;
    }
};
struct SchedMoe {
    pg8::TileOrder T; int G, c; const char *A, *W; char* C; const LAS int* PB; int wrows  , ldc, cdiv;
    DI bool next(int i, pg8::Unit& u) const {
        const long L = (long)i * G + c; int pm, pn; if (!T.tile(L, pm, pn)) return false;
        int e = 0;
#pragma unroll 1
        for (int j = 1; j < NEXP; ++j) e += (PB[j] <= pm) ? 1 : 0;
        u.a = A + (size_t)pm * 256 * 1024 * 2; u.b = W + ((size_t)e * wrows + pn * 256) * 1024 * 2; u.r0 = pm * 256; u.c0 = pn * 256; u.c = C + ((size_t)u.r0 * ldc + u.c0 / cdiv) * 2; u.ldc = ldc; u.e = e; u.sub = 0; return true;
    }
};

__global__ void __launch_bounds__(NTHR, 2) fwd_kernel(Args args) {
    extern __shared__ __attribute__((aligned(16))) unsigned char lds_raw[];
    LAS unsigned char* lds = (LAS unsigned char*)lds_raw;
    volatile LAS unsigned* LCTL = (volatile LAS unsigned*)(lds + LDSCTL_OFF);
    const int tid0 = threadIdx.x, wave = __builtin_amdgcn_readfirstlane(tid0 >> 6);
#define PHASE_TID int tid = tid0; asm volatile("" : "+v"(tid)); const int lane = tid & 63; (void)lane;
    const int G = gridDim.x, bx = blockIdx.x;
    const int gw = bx * NWAVES + wave, NGW = G * NWAVES;
    unsigned char* ws = args.ws;
    gu32* ctl = (gu32*)(ws + WS_CTL);
    for (int u = tid0; u < (LDS_BYTES - LDSCTL_OFF) / 4; u += NTHR) ((LAS unsigned*)(lds + LDSCTL_OFF))[u] = 0u;
    __syncthreads();
    XcdBarrier bar; bar.bar = (unsigned*)ctl + CW_BAR; bar.x = 0; bar.st = nullptr;
    if (MK_ONE_LAUNCH) bar = xcd_barrier_post((unsigned*)ctl + CW_BAR, LCTL);
    const int lo = args.ph_lo, hi = args.ph_hi;
#ifndef SUBMASK
#define SUBMASK 7
#endif
#ifndef PHMASK
#define PHMASK 0xFFFF
#endif
#define IN(k) (lo <= (k) && (k) < hi)
#define SEAM(k) do { if (IN(k) && IN((k) + 1)) xcd_barrier(bar); } while (0)

    char* const Xb = (char*)(ws + WS_X);
    char* const Ub = (char*)(ws + WS_R1);
    float* const GIF = (float*)(ws + WS_GIF);
    LAS int* const PB = (LAS int*)(lds + LDSCTL_OFF + 64);
    LAS int* const CNT = (LAS int*)(lds + LDSCTL_OFF + 256);

    if (((PHMASK>>12)&1) && IN(0)) { PHASE_TID
        LAS float* scr = (LAS float*)(lds + wave * 8448);
        LAS float* wgt = (LAS float*)(lds + 73728);
        load_gate_table(wgt, args.in[I_WIN], tid);
        constexpr int IT_IN = 16 * 216, IT_KV = 16 * 32, IT_BR = 8 * 32, IT_O = 16 * 32, IT_L = IT_IN + IT_KV + 3 * IT_BR + IT_O;
        for (int it = gw; it < DEPTH * IT_L; it += NGW) {
            const int l = it / IT_L; int r = it - l * IT_L;
            if (r < IT_IN) { const int kb = r / 216, nb = r % 216, n0 = 32 * nb, sc = n0 + (n0 >= 1536 ? 8 : 0);
                transpose_item(args.in[I_WIN] + ((size_t)l * D + 64 * kb) * DIN + sc, DIN, (bf16*)(ws + WS_WIN) + ((size_t)l * NU + n0) * D + 64 * kb, D, scr, lane); continue; }
            r -= IT_IN;
            if (r < IT_KV) { const int kb = r / 32, nb = r % 32;
                transpose_item(args.in[I_CAWKV] + ((size_t)l * D + 64 * kb) * 1024 + 32 * nb, 1024, (bf16*)(ws + WS_WKV) + ((size_t)l * 1024 + 32 * nb) * D + 64 * kb, D, scr, lane); continue; }
            r -= IT_KV;
            if (r < 3 * IT_BR) { const int br = r / IT_BR, q = r % IT_BR, kb = q / 32, nb = q % 32;
                const float* src = args.in[br == 0 ? I_WBRML : (br == 1 ? I_WBRRW : I_WBRCA)];
                transpose_item(src + ((size_t)l * 512 + 64 * kb) * 1024 + 32 * nb, 1024, (bf16*)(ws + WS_WBR) + (((size_t)l * 3 + br) * 1024 + 32 * nb) * 512 + 64 * kb, 512, scr, lane); continue; }
            r -= 3 * IT_BR;
            { const int kb = r / 32, nb = r % 32;
                transpose_item(args.in[I_WO] + ((size_t)l * D + 64 * kb) * 1024 + 32 * nb, 1024, (bf16*)(ws + WS_WO) + ((size_t)l * 1024 + 32 * nb) * D + 64 * kb, D, scr, lane); }
        }
        for (int i = bx * NTHR + tid; i < DEPTH * 1536 * 256; i += G * NTHR) {
            const int l = i / (1536 * 256), r = i % (1536 * 256), n = r >> 8, k = r & 255; float v = 0.f;
            if (n < 512) { if (k < 64) v = args.in[I_RWWUP][((size_t)l * 64 + k) * 512 + n]; }
            else if (n < 1024) { if (k >= 64 && k < 128) v = args.in[I_RWAUP][((size_t)l * 64 + (k - 64)) * 512 + (n - 512)]; }
            else { if (k >= 128) v = args.in[I_RWGUP][((size_t)l * 128 + (k - 128)) * 512 + (n - 1024)]; }
            ((bf16*)(ws + WS_WLORA))[i] = (bf16)f2bf(v);
        }
        __syncthreads();
        {
            f32x4 g[4], b[4];
#pragma unroll
            for (int j = 0; j < 4; ++j) { g[j] = *(const f32x4*)(args.in[I_LNIN_G] + 256 * j + 4 * lane); b[j] = *(const f32x4*)(args.in[I_LNIN_B] + 256 * j + 4 * lane); }
            for (int m = gw; m < M; m += NGW) {
                f32x4 v[4]; const float* xr = args.in[I_X] + (size_t)m * D;
#pragma unroll
                for (int j = 0; j < 4; ++j) v[j] = *(const f32x4*)(xr + 256 * j + 4 * lane);
                ln16(v, g, b);
#pragma unroll
                for (int j = 0; j < 4; ++j) st4bf(Xb + ((size_t)m * D + 256 * j + 4 * lane) * 2, v[j]);
                gates8(v, wgt, GIF + (size_t)m * 8, lane);
            }
#pragma unroll
            for (int j = 0; j < 4; ++j) { g[j] = *(const f32x4*)(args.in[I_MEMLN_G] + 256 * j + 4 * lane); b[j] = *(const f32x4*)(args.in[I_MEMLN_B] + 256 * j + 4 * lane); }
            for (int m = gw; m < MROWS; m += NGW) {
                f32x4 v[4]; const float* xr = args.in[I_MEM] + (size_t)m * D;
#pragma unroll
                for (int j = 0; j < 4; ++j) v[j] = *(const f32x4*)(xr + 256 * j + 4 * lane);
                ln16(v, g, b);
#pragma unroll
                for (int j = 0; j < 4; ++j) st4bf((char*)(ws + WS_MEMN) + ((size_t)m * D + 256 * j + 4 * lane) * 2, v[j]);
            }
        }
        __syncthreads();
    }
    SEAM(0);

#pragma unroll 1
    for (int l = 0; l < DEPTH; ++l) {
        const int pb = 1 + l * NP_LAYER;
        if (((PHMASK>>0)&1) && IN(pb + 0)) {
            SchedInproj S; S.T.init(M / 256, NU / 256); S.G = G; S.c = bx; S.X = Xb; S.W = (const char*)(ws + WS_WIN) + (size_t)l * NU * D * 2; S.U = Ub;
            S.kv = (l == 0); S.MEMN = (const char*)(ws + WS_MEMN); S.WKV = (const char*)(ws + WS_WKV); S.KV = (char*)(ws + WS_KV);
            pg8::EpiStore E;
            pg8::gemm_phase(lds, D, D * 2, D * 2, S, E);
        }
        SEAM(pb + 0);
        if (((PHMASK>>1)&1) && IN(pb + 1)) { PHASE_TID
            const float* mu = args.in[I_RWMU] + (size_t)l * 1792 + 1536;
            char* LIN = (char*)(ws + WS_R2 + R2_LORA_IN);
            for (int it = bx * NTHR + tid; it < M * 32; it += G * NTHR) {
                const int row = it >> 5, c = (it & 31) * 8;
                const u32x4 cw = *(const u32x4*)(Ub + ((size_t)row * NU + UC_RW + 1536 + c) * 2);
                u32x4 pw = (u32x4){0u, 0u, 0u, 0u};
                if ((row & (SEQ - 1)) != 0) pw = *(const u32x4*)(Ub + ((size_t)(row - 1) * NU + UC_RW + 1536 + c) * 2);
                const f32x4 m0 = *(const f32x4*)(mu + c), m1 = *(const f32x4*)(mu + c + 4);
                float x[8] = {bflo(cw.x), bfhi(cw.x), bflo(cw.y), bfhi(cw.y), bflo(cw.z), bfhi(cw.z), bflo(cw.w), bfhi(cw.w)};
                const float p[8] = {bflo(pw.x), bfhi(pw.x), bflo(pw.y), bfhi(pw.y), bflo(pw.z), bfhi(pw.z), bflo(pw.w), bfhi(pw.w)};
                const float mm[8] = {m0.x, m0.y, m0.z, m0.w, m1.x, m1.y, m1.z, m1.w};
#pragma unroll
                for (int i = 0; i < 8; ++i) { float xs = x[i] + (p[i] - x[i]) * mm[i];
                    if (c < 64) xs = 1.f - 2.f * __builtin_amdgcn_rcpf(1.f + __builtin_amdgcn_exp2f(2.8853900817779268f * xs));
                    else if (c >= 128) xs = sigmoidf_(xs);
                    x[i] = xs; }
                u32x4 o; o.x = pk2(x[0], x[1]); o.y = pk2(x[2], x[3]); o.z = pk2(x[4], x[5]); o.w = pk2(x[6], x[7]);
                *(u32x4*)(LIN + ((size_t)row * 256 + c) * 2) = o;
            }
        }
        SEAM(pb + 1);
        if (((PHMASK>>2)&1) && IN(pb + 2)) {
            SchedPlain S; S.T.init(M / 256, 6); S.G = G; S.c = bx; S.A = (const char*)(ws + WS_R2 + R2_LORA_IN); S.B = (const char*)(ws + WS_WLORA) + (size_t)l * 1536 * 256 * 2; S.C = (char*)(ws + WS_R2 + R2_LORA_OUT);
            S.lda = 256; S.ldb = 256; S.ldc = 1536;
            pg8::EpiStore E;
            pg8::gemm_phase(lds, 256, 512, 512, S, E);
        }
        SEAM(pb + 2);
        if (((PHMASK>>3)&1) && IN(pb + 3)) { PHASE_TID
            const char* LO = (const char*)(ws + WS_R2 + R2_LORA_OUT);
            char* HC = (char*)(ws + WS_R2 + R2_HCAT);
#pragma unroll 1
            for (int job = bx; job < 256; job += G) {
                if (((SUBMASK>>0)&1) && job < 128) {
                    const int b = job >> 3, h = job & 7;
                    LAS float* OPS = (LAS float*)lds;
                    LAS float* OUTB = OPS + 32 * 384;
                    LAS float* BON = OUTB + 32 * 64;
                    const int pt = tid >> 4, pc = (tid & 15) * 4, cs = tid & 15;
                    const int hc = h * 64 + pc;
                    const f32x4 mu_r = *(const f32x4*)(args.in[I_RWMU] + (size_t)l * 1792 + hc), mu_k = *(const f32x4*)(args.in[I_RWMU] + (size_t)l * 1792 + 512 + hc), mu_v = *(const f32x4*)(args.in[I_RWMU] + (size_t)l * 1792 + 1024 + hc);
                    const f32x4 w0 = *(const f32x4*)(args.in[I_RWW0] + l * 512 + hc), a0 = *(const f32x4*)(args.in[I_RWA0] + l * 512 + hc), kkw = *(const f32x4*)(args.in[I_RWKK] + l * 512 + hc);
                    const f32x4 kaw = *(const f32x4*)(args.in[I_RWKA] + l * 512 + hc), rkw = *(const f32x4*)(args.in[I_RWRK] + l * 512 + hc);
                    const f32x4 lng = *(const f32x4*)(args.in[I_RWLNG] + l * 512 + hc), lnb = *(const f32x4*)(args.in[I_RWLNB] + l * 512 + hc);
                    f32x4 S0 = (f32x4){0.f, 0.f, 0.f, 0.f}, S1 = S0;
                    f32x4 ur, uk, uv, urp, ukp, uvp, lw, la, lg;
                    auto LOADC = [&](int t0) {
                        const size_t row = (size_t)b * SEQ + t0 + pt; const char* up = Ub + (row * NU + UC_RW + hc) * 2;
                        ur = ld4bf(up); uk = ld4bf(up + 1024); uv = ld4bf(up + 2048);
                        if (t0 + pt > 0) { const char* pp = up - (size_t)NU * 2; urp = ld4bf(pp); ukp = ld4bf(pp + 1024); uvp = ld4bf(pp + 2048); }
                        else { urp = (f32x4){0.f, 0.f, 0.f, 0.f}; ukp = urp; uvp = urp; }
                        const char* lp = LO + (row * 1536 + hc) * 2; lw = ld4bf(lp); la = ld4bf(lp + 1024); lg = ld4bf(lp + 2048);
                    };
                    LOADC(0);
#pragma unroll 1
                    for (int t0 = 0; t0 < SEQ; t0 += 32) {
                        f32x4 xr = ur + (urp - ur) * mu_r, xk = uk + (ukp - uk) * mu_k, xv = uv + (uvp - uv) * mu_v;
                        f32x4 dec, av, kkv, kp; float ss = 0.f, bsum = 0.f;
#pragma unroll
                        for (int i = 0; i < 4; ++i) {
                            const float y = -(w0[i] + lw[i]);
                            const float sp = fmaxf(y, 0.f) + __logf(1.f + __expf(-fabsf(y)));
                            const float wlog = -sp - 0.5f;
                            dec[i] = __expf(-__expf(wlog));
                            av[i] = sigmoidf_(a0[i] + la[i]);
                            kkv[i] = xk[i] * kkw[i]; ss += kkv[i] * kkv[i];
                            kp[i] = xk[i] * (1.f + (av[i] - 1.f) * kaw[i]);
                            bsum += xr[i] * kp[i] * rkw[i];
                        }
                        ss = red16(ss); bsum = red16(bsum);
                        const float inv = 1.f / sqrtf(fmaxf(ss, 1e-24f));
                        const f32x4 kk = kkv * inv, kka = kk * av;
                        LAS float* o = OPS + pt * 384 + pc;
                        *(LAS f32x4*)(o) = dec; *(LAS f32x4*)(o + 64) = kk; *(LAS f32x4*)(o + 128) = kka; *(LAS f32x4*)(o + 192) = kp; *(LAS f32x4*)(o + 256) = xr; *(LAS f32x4*)(o + 320) = xv;
                        if (cs == 0) BON[pt] = bsum;
                        const f32x4 gk = lg;
                        if (t0 + 32 < SEQ) LOADC(t0 + 32);
                        __syncthreads();
#pragma unroll 4
                        for (int s = 0; s < 32; ++s) {
                            const LAS float* q = OPS + s * 384 + pc;
                            const f32x4 w4 = *(const LAS f32x4*)(q), k4 = *(const LAS f32x4*)(q + 64), ka4 = *(const LAS f32x4*)(q + 128), kp4 = *(const LAS f32x4*)(q + 192), r4 = *(const LAS f32x4*)(q + 256);
                            const f32x2 v2 = *(const LAS f32x2*)(OPS + s * 384 + 320 + 2 * pt);
                            float p0 = (S0.x * k4.x + S0.y * k4.y) + (S0.z * k4.z + S0.w * k4.w), p1 = (S1.x * k4.x + S1.y * k4.y) + (S1.z * k4.z + S1.w * k4.w);
                            p0 = red16(p0); p1 = red16(p1);
                            S0 = S0 * w4 + (kp4 * v2.x - ka4 * p0); S1 = S1 * w4 + (kp4 * v2.y - ka4 * p1);
                            float o0 = (S0.x * r4.x + S0.y * r4.y) + (S0.z * r4.z + S0.w * r4.w), o1 = (S1.x * r4.x + S1.y * r4.y) + (S1.z * r4.z + S1.w * r4.w);
                            o0 = red16(o0); o1 = red16(o1);
                            if (cs == 0) *(LAS f32x2*)(OUTB + s * 64 + 2 * pt) = (f32x2){o0, o1};
                        }
                        __syncthreads();
                        {
                            const f32x4 o4 = *(const LAS f32x4*)(OUTB + pt * 64 + pc), v4 = *(const LAS f32x4*)(OPS + pt * 384 + 320 + pc);
                            const float mean = red16((o4.x + o4.y) + (o4.z + o4.w)) * (1.f / 64.f);
                            const f32x4 dv = o4 - mean;
                            const float var = red16((dv.x * dv.x + dv.y * dv.y) + (dv.z * dv.z + dv.w * dv.w)) * (1.f / 64.f);
                            const float rstd = 1.f / sqrtf(var + RW_GN_EPS), bo = BON[pt];
                            const f32x4 y = (dv * rstd * lng + lnb + v4 * bo) * gk;
                            st4bf(HC + (((size_t)b * SEQ + t0 + pt) * 1536 + 512 + hc) * 2, y);
                        }
                        __syncthreads();
                    }
                } else {
                    const int idx = job - 128, bh = idx >> 1, half = idx & 1, b = bh >> 2, h = bh & 3;
                    if ((SUBMASK>>1)&1) {
                        LAS float* QK = (LAS float*)lds;
                        LAS float* VV = QK + 32 * 128;
                        LAS float* FI = VV + 32 * 64;
                        LAS float* NUM = FI + 32 * 4;
                        LAS float* DENP = NUM + 32 * 64;
                        const int pt = tid >> 4, cg = tid & 15;
                        const int ccol = (cg < 8) ? (h * 64 + 8 * cg) : (256 + h * 64 + 8 * (cg - 8));
                        float cw[4][8], cb[8];
#pragma unroll
                        for (int j = 0; j < 4; ++j) { const f32x4 a = *(const f32x4*)(args.in[I_CONVW] + ((size_t)l * 4 + j) * 512 + ccol), c2 = *(const f32x4*)(args.in[I_CONVW] + ((size_t)l * 4 + j) * 512 + ccol + 4);
                            cw[j][0] = a.x; cw[j][1] = a.y; cw[j][2] = a.z; cw[j][3] = a.w; cw[j][4] = c2.x; cw[j][5] = c2.y; cw[j][6] = c2.z; cw[j][7] = c2.w; }
                        { const f32x4 a = *(const f32x4*)(args.in[I_CONVB] + l * 512 + ccol), c2 = *(const f32x4*)(args.in[I_CONVB] + l * 512 + ccol + 4);
                            cb[0] = a.x; cb[1] = a.y; cb[2] = a.z; cb[3] = a.w; cb[4] = c2.x; cb[5] = c2.y; cb[6] = c2.z; cb[7] = c2.w; }
                        const float qsc = (cg < 8) ? 0.125f : 1.f;
                        const float igb = args.in[I_IGB][l * 4 + h], fgb = args.in[I_FGB][l * 4 + h];
                        const int r = tid >> 3, cs8 = (tid & 7) * 8;
                        const int ne = 8 * wave + (lane & 7);
                        float C[8] = {0.f, 0.f, 0.f, 0.f, 0.f, 0.f, 0.f, 0.f}; float nreg = 0.f, mprev = 0.f;
                        u32x4 cu[4]; u32x2 vu; float gi = 0.f, gf = 0.f;
                        auto LOADM = [&](int t0) {
                            const int t = t0 + pt; const size_t row = (size_t)b * SEQ + t;
#pragma unroll
                            for (int j = 0; j < 4; ++j) { if (t - 3 + j >= 0) cu[j] = *(const u32x4*)(Ub + ((row - 3 + j) * NU + UC_QK + ccol) * 2); else cu[j] = (u32x4){0u, 0u, 0u, 0u}; }
                            vu = *(const u32x2*)(Ub + (row * NU + UC_V + h * 128 + half * 64 + 4 * cg) * 2);
                            if (wave == 0) { const size_t rg = (size_t)b * SEQ + t0 + (lane & 31); gi = GIF[rg * 8 + h]; gf = GIF[rg * 8 + 4 + h]; }
                        };
                        LOADM(0);
#pragma unroll 1
                        for (int t0 = 0; t0 < SEQ; t0 += 32) {
                            { float y[8];
#pragma unroll
                                for (int i = 0; i < 8; ++i) y[i] = cb[i];
#pragma unroll
                                for (int j = 0; j < 4; ++j) { const float x[8] = {bflo(cu[j].x), bfhi(cu[j].x), bflo(cu[j].y), bfhi(cu[j].y), bflo(cu[j].z), bfhi(cu[j].z), bflo(cu[j].w), bfhi(cu[j].w)};
#pragma unroll
                                    for (int i = 0; i < 8; ++i) y[i] += cw[j][i] * x[i]; }
#pragma unroll
                                for (int i = 0; i < 8; ++i) y[i] = y[i] * sigmoidf_(y[i]) * qsc;
                                LAS float* o = QK + pt * 128 + 8 * cg;
                                *(LAS f32x4*)o = (f32x4){y[0], y[1], y[2], y[3]}; *(LAS f32x4*)(o + 4) = (f32x4){y[4], y[5], y[6], y[7]};
                                *(LAS f32x4*)(VV + pt * 64 + 4 * cg) = (f32x4){bflo(vu.x), bfhi(vu.x), bflo(vu.y), bfhi(vu.y)};
                            }
                            if (wave == 0) {
                                const int tl = lane & 31;
                                const float ig = gi + igb, fp = gf + fgb;
                                const float lf = -(fmaxf(-fp, 0.f) + __logf(1.f + __expf(-fabsf(fp))));
                                float bc = lf;
#pragma unroll
                                for (int o = 1; o < 32; o <<= 1) { const float t = __shfl_up(bc, o); if (tl >= o) bc += t; }
                                float pm = ig - bc;
#pragma unroll
                                for (int o = 1; o < 32; o <<= 1) { const float t = __shfl_up(pm, o); if (tl >= o) pm = fmaxf(pm, t); }
                                const float mt = bc + fmaxf(mprev, pm);
                                float mp1 = __shfl_up(mt, 1); if (tl == 0) mp1 = mprev;
                                const float fpr = __expf(lf + mp1 - mt), ipr = __expf(ig - mt), em = __expf(-mt);
                                if (lane < 32) *(LAS f32x4*)(FI + tl * 4) = (f32x4){fpr, ipr, em, 0.f};
                                mprev = __shfl(mt, 31);
                            }
                            if (t0 + 32 < SEQ) LOADM(t0 + 32);
                            __syncthreads();
#pragma unroll 2
                            for (int s = 0; s < 32; ++s) {
                                const LAS float* qp = QK + s * 128 + cs8;
                                const f32x4 q0 = *(const LAS f32x4*)qp, q1 = *(const LAS f32x4*)(qp + 4), k0 = *(const LAS f32x4*)(qp + 64), k1 = *(const LAS f32x4*)(qp + 68);
                                const float vv = VV[s * 64 + r]; const f32x4 fi = *(const LAS f32x4*)(FI + s * 4);
                                const float nk = QK[s * 128 + 64 + ne], nq = QK[s * 128 + ne];
                                const float tv = fi.y * vv;
                                C[0] = fi.x * C[0] + tv * k0.x; C[1] = fi.x * C[1] + tv * k0.y; C[2] = fi.x * C[2] + tv * k0.z; C[3] = fi.x * C[3] + tv * k0.w;
                                C[4] = fi.x * C[4] + tv * k1.x; C[5] = fi.x * C[5] + tv * k1.y; C[6] = fi.x * C[6] + tv * k1.z; C[7] = fi.x * C[7] + tv * k1.w;
                                float p = ((C[0] * q0.x + C[1] * q0.y) + (C[2] * q0.z + C[3] * q0.w)) + ((C[4] * q1.x + C[5] * q1.y) + (C[6] * q1.z + C[7] * q1.w));
                                p = red8(p);
                                nreg = fi.x * nreg + fi.y * nk;
                                const float dp = red8(nreg * nq);
                                if ((tid & 7) == 0) NUM[s * 64 + r] = p;
                                if (lane == 0) DENP[s * 8 + wave] = dp;
                            }
                            __syncthreads();
                            {
                                const f32x4 d0 = *(const LAS f32x4*)(DENP + pt * 8), d1 = *(const LAS f32x4*)(DENP + pt * 8 + 4);
                                const float den = ((d0.x + d0.y) + (d0.z + d0.w)) + ((d1.x + d1.y) + (d1.z + d1.w)), em = FI[pt * 4 + 2];
                                const float rdn = 1.f / fmaxf(fabsf(den), em);
                                const f32x4 nv = *(const LAS f32x4*)(NUM + pt * 64 + 4 * cg);
                                st4bf((char*)(ws + WS_HML) + (((size_t)b * SEQ + t0 + pt) * 512 + h * 128 + half * 64 + 4 * cg) * 2, nv * rdn);
                            }
                            __syncthreads();
                        }
                    }
                    if ((SUBMASK>>2)&1) {
                        constexpr int KST = 272, VST = 520;
                        LAS unsigned char* KI = lds; LAS unsigned char* VI = lds + 256 * KST;
                        const char* kvb = (const char*)(ws + WS_KV) + (((size_t)l * MROWS + (size_t)b * MEML) * D) * 2;
                        for (int p = tid; p < 4096; p += NTHR) { const int key = p >> 4, c16 = p & 15;
                            *(LAS u32x4*)(KI + key * KST + c16 * 16) = *(const u32x4*)(kvb + ((size_t)key * D + h * 128 + c16 * 8) * 2); }
                        for (int p = tid; p < 4096; p += NTHR) { const int key = p & 255, d8 = p >> 8;
                            const u32x4 w = *(const u32x4*)(kvb + ((size_t)key * D + 512 + h * 128 + d8 * 8) * 2);
                            LAS unsigned char* o = VI + (d8 * 8) * VST + key * 2;
                            *(LAS bf16*)(o) = (bf16)(w.x & 0xffff); *(LAS bf16*)(o + VST) = (bf16)(w.x >> 16); *(LAS bf16*)(o + 2 * VST) = (bf16)(w.y & 0xffff); *(LAS bf16*)(o + 3 * VST) = (bf16)(w.y >> 16);
                            *(LAS bf16*)(o + 4 * VST) = (bf16)(w.z & 0xffff); *(LAS bf16*)(o + 5 * VST) = (bf16)(w.z >> 16); *(LAS bf16*)(o + 6 * VST) = (bf16)(w.w & 0xffff); *(LAS bf16*)(o + 7 * VST) = (bf16)(w.w >> 16); }
                        __syncthreads();
                        const int r31 = lane & 31, h2 = lane >> 5;
                        constexpr float SC = 0.08838834764831845f * 1.4426950408889634f;
#pragma unroll 1
                        for (int rd = 0; rd < 8; ++rd) {
                            const size_t qrow = (size_t)b * SEQ + half * 2048 + rd * 256 + wave * 32 + r31;
                            bf16x8 qf[8];
#pragma unroll
                            for (int ks = 0; ks < 8; ++ks) qf[ks] = *(const bf16x8*)(Ub + (qrow * NU + UC_CAQ + h * 128 + 16 * ks + 8 * h2) * 2);
                            f32x16 O[4];
#pragma unroll
                            for (int db = 0; db < 4; ++db)
#pragma unroll
                                for (int i = 0; i < 16; ++i) O[db][i] = 0.f;
                            float mrun = -1e30f, lrun = 0.f;
#pragma unroll 1
                            for (int hf = 0; hf < 2; ++hf) {
                                f32x16 X[4];
#pragma unroll
                                for (int kb = 0; kb < 4; ++kb) {
#pragma unroll
                                    for (int i = 0; i < 16; ++i) X[kb][i] = 0.f;
#pragma unroll
                                    for (int ks = 0; ks < 8; ++ks) { const bf16x8 kf = *(const LAS bf16x8*)(KI + (hf * 128 + kb * 32 + r31) * KST + (16 * ks + 8 * h2) * 2);
                                        X[kb] = __builtin_amdgcn_mfma_f32_32x32x16_bf16(kf, qf[ks], X[kb], 0, 0, 0); }
                                    __builtin_amdgcn_sched_barrier(0);
                                }
                                float mx = -1e30f;
#pragma unroll
                                for (int kb = 0; kb < 4; ++kb)
#pragma unroll
                                    for (int i = 0; i < 16; ++i) mx = fmaxf(mx, X[kb][i]);
                                mx = fmaxf(mx, __shfl_xor(mx, 32));
                                const float mnew = fmaxf(mrun, mx), alpha = __builtin_amdgcn_exp2f((mrun - mnew) * SC);
                                float ls = 0.f;
#pragma unroll
                                for (int kb = 0; kb < 4; ++kb)
#pragma unroll
                                    for (int i = 0; i < 16; ++i) { const float p = __builtin_amdgcn_exp2f((X[kb][i] - mnew) * SC); X[kb][i] = p; ls += p; }
                                ls += __shfl_xor(ls, 32);
                                lrun = lrun * alpha + ls; mrun = mnew;
#pragma unroll
                                for (int db = 0; db < 4; ++db)
#pragma unroll
                                    for (int i = 0; i < 16; ++i) O[db][i] *= alpha;
#pragma unroll
                                for (int kb = 0; kb < 4; ++kb)
#pragma unroll
                                    for (int s = 0; s < 2; ++s) {
                                        u32x4 pw; pw.x = pk2(X[kb][8 * s], X[kb][8 * s + 1]); pw.y = pk2(X[kb][8 * s + 2], X[kb][8 * s + 3]); pw.z = pk2(X[kb][8 * s + 4], X[kb][8 * s + 5]); pw.w = pk2(X[kb][8 * s + 6], X[kb][8 * s + 7]);
                                        const bf16x8 pf = __builtin_bit_cast(bf16x8, pw);
#pragma unroll
                                        for (int db = 0; db < 4; ++db) {
                                            const LAS unsigned char* vp = VI + (db * 32 + r31) * VST + (hf * 128 + kb * 32 + 16 * s + 4 * h2) * 2;
                                            const u32x2 lo = *(const LAS u32x2*)vp, hi = *(const LAS u32x2*)(vp + 16);
                                            const bf16x8 vf = __builtin_bit_cast(bf16x8, (u32x4){lo.x, lo.y, hi.x, hi.y});
                                            O[db] = __builtin_amdgcn_mfma_f32_32x32x16_bf16(vf, pf, O[db], 0, 0, 0);
                                        }
                                        __builtin_amdgcn_sched_barrier(0);
                                    }
                            }
                            const float rl = 1.f / lrun;
                            char* op = HC + (qrow * 1536 + 1024 + h * 128) * 2;
#pragma unroll
                            for (int db = 0; db < 4; ++db)
#pragma unroll
                                for (int g4 = 0; g4 < 4; ++g4) { u32x2 w; w.x = pk2(O[db][4 * g4] * rl, O[db][4 * g4 + 1] * rl); w.y = pk2(O[db][4 * g4 + 2] * rl, O[db][4 * g4 + 3] * rl);
                                    *(u32x2*)(op + (db * 32 + 8 * g4 + 4 * h2) * 2) = w; }
                        }
                        __syncthreads();
                    }
                }
            }
        }
        SEAM(pb + 3);
        if (((PHMASK>>4)&1) && IN(pb + 4)) { PHASE_TID
            char* HC = (char*)(ws + WS_R2 + R2_HCAT);
            const int hd = lane >> 4, sb = (lane & 15) * 8;
            const f32x4 g0 = *(const f32x4*)(args.in[I_MLNORMG] + l * 512 + hd * 128 + sb), g1 = *(const f32x4*)(args.in[I_MLNORMG] + l * 512 + hd * 128 + sb + 4);
            for (int m = gw; m < M; m += NGW) {
                const u32x4 hw = *(const u32x4*)((const char*)(ws + WS_HML) + ((size_t)m * 512 + hd * 128 + sb) * 2);
                const u32x4 ow = *(const u32x4*)(Ub + ((size_t)m * NU + UC_OG + hd * 128 + sb) * 2);
                float v[8] = {bflo(hw.x), bfhi(hw.x), bflo(hw.y), bfhi(hw.y), bflo(hw.z), bfhi(hw.z), bflo(hw.w), bfhi(hw.w)};
                const float og[8] = {bflo(ow.x), bfhi(ow.x), bflo(ow.y), bfhi(ow.y), bflo(ow.z), bfhi(ow.z), bflo(ow.w), bfhi(ow.w)};
                const float gg[8] = {g0.x, g0.y, g0.z, g0.w, g1.x, g1.y, g1.z, g1.w};
                float s = 0.f;
#pragma unroll
                for (int i = 0; i < 8; ++i) s += v[i];
                const float mean = red16(s) * (1.f / 128.f); float s2 = 0.f;
#pragma unroll
                for (int i = 0; i < 8; ++i) { v[i] -= mean; s2 += v[i] * v[i]; }
                const float rstd = 1.f / sqrtf(red16(s2) * (1.f / 128.f) + LN_EPS);
#pragma unroll
                for (int i = 0; i < 8; ++i) v[i] = sigmoidf_(og[i]) * (v[i] * rstd * gg[i]);
                u32x4 o; o.x = pk2(v[0], v[1]); o.y = pk2(v[2], v[3]); o.z = pk2(v[4], v[5]); o.w = pk2(v[6], v[7]);
                *(u32x4*)(HC + ((size_t)m * 1536 + hd * 128 + sb) * 2) = o;
            }
        }
        SEAM(pb + 4);
        if (((PHMASK>>5)&1) && IN(pb + 5)) {
            SchedMerge S; S.T.init(M / 256, 4); S.G = G; S.c = bx; S.H = (const char*)(ws + WS_R2 + R2_HCAT); S.W = (const char*)(ws + WS_WBR) + (size_t)l * 3 * 1024 * 512 * 2; S.Y = (char*)(ws + WS_R2 + R2_YPRE);
            pg8::EpiMerge E; E.U = Ub; E.gate_b = args.in[I_GATEB] + (size_t)l * 3072;
            pg8::gemm_phase(lds, 512, 1536 * 2, 512 * 2, S, E);
        }
        SEAM(pb + 5);
        if (((PHMASK>>6)&1) && IN(pb + 6)) {
            SchedPlain S; S.T.init(M / 256, 4); S.G = G; S.c = bx; S.A = (const char*)(ws + WS_R2 + R2_YPRE); S.B = (const char*)(ws + WS_WO) + (size_t)l * D * D * 2; S.C = (char*)(ws + WS_R2 + R2_Z);
            S.lda = D; S.ldb = D; S.ldc = D;
            pg8::EpiWo E; E.X = Xb;
            pg8::gemm_phase(lds, D, D * 2, D * 2, S, E);
        }
        SEAM(pb + 6);
        if (((PHMASK>>7)&1) && IN(pb + 7)) { PHASE_TID
            LAS float* WR = (LAS float*)lds;
            for (int i = tid; i < 32768; i += NTHR) { const int k = i >> 5, e = i & 31; WR[e * 1024 + k] = args.in[I_RTW][((size_t)l * D + k) * 32 + e]; }
            __syncthreads();
            f32x4 g[4], bb[4];
#pragma unroll
            for (int j = 0; j < 4; ++j) { g[j] = *(const f32x4*)(args.in[I_LN1G] + l * D + 256 * j + 4 * lane); bb[j] = *(const f32x4*)(args.in[I_LN1B] + l * D + 256 * j + 4 * lane); }
            const float rbias = args.in[I_RTB][l * 32 + (lane & 31)];
            const char* Zb = (const char*)(ws + WS_R2 + R2_Z);
            int* TKE = (int*)(ws + WS_TKE); float* TKG = (float*)(ws + WS_TKG); int* TKP = (int*)(ws + WS_TKP); int* ROWTOK = (int*)(ws + WS_ROWTOK);
#pragma unroll 1
            for (int pp = gw; pp < M / 2; pp += NGW) {
                f32x4 y0[4], y1[4];
#pragma unroll
                for (int j = 0; j < 4; ++j) { y0[j] = ld4bf(Zb + ((size_t)(2 * pp) * D + 256 * j + 4 * lane) * 2); y1[j] = ld4bf(Zb + ((size_t)(2 * pp + 1) * D + 256 * j + 4 * lane) * 2); }
                ln16(y0, g, bb); ln16(y1, g, bb);
#pragma unroll
                for (int j = 0; j < 4; ++j) { st4bf(Xb + ((size_t)(2 * pp) * D + 256 * j + 4 * lane) * 2, y0[j]); st4bf(Xb + ((size_t)(2 * pp + 1) * D + 256 * j + 4 * lane) * 2, y1[j]); }
                float v[64];
#pragma unroll
                for (int e = 0; e < 32; ++e) { float s0 = 0.f, s1 = 0.f;
#pragma unroll
                    for (int j = 0; j < 4; ++j) { const f32x4 w = *(const LAS f32x4*)(WR + e * 1024 + 256 * j + 4 * lane);
                        s0 += (y0[j].x * w.x + y0[j].y * w.y) + (y0[j].z * w.z + y0[j].w * w.w); s1 += (y1[j].x * w.x + y1[j].y * w.y) + (y1[j].z * w.z + y1[j].w * w.w); }
                    v[e] = s0; v[32 + e] = s1; if ((e & 3) == 3) __builtin_amdgcn_sched_barrier(0); }
#pragma unroll
                for (int bsh = 5; bsh >= 0; --bsh) { const int n2 = 1 << bsh; const bool up = (lane >> bsh) & 1;
#pragma unroll
                    for (int i = 0; i < n2; ++i) { const float send = up ? v[i] : v[i + n2], keep = up ? v[i + n2] : v[i]; v[i] = keep + __shfl_xor(send, n2); } }
                float cur = v[0] + rbias;
                const int half = lane >> 5, el = lane & 31;
                float tv[4]; int te[4];
#pragma unroll
                for (int k = 0; k < 4; ++k) { float mx = cur;
#pragma unroll
                    for (int o = 1; o < 32; o <<= 1) mx = fmaxf(mx, __shfl_xor(mx, o));
                    const unsigned long long bal = __ballot(cur == mx); const unsigned hm = (unsigned)(bal >> (32 * half));
                    const int win = __builtin_ctz(hm); tv[k] = mx; te[k] = win; if (el == win) cur = -3.0e38f; }
                const float e1 = __expf(tv[1] - tv[0]), e2 = __expf(tv[2] - tv[0]), e3 = __expf(tv[3] - tv[0]), rs = 1.f / (1.f + e1 + e2 + e3);
                const float gt[4] = {rs, e1 * rs, e2 * rs, e3 * rs};
                const int token = 2 * pp + half;
#pragma unroll
                for (int k = 0; k < 4; ++k) if (el == te[k]) {
                    const int pos = (int)__hip_atomic_fetch_add((unsigned*)ctl + CW_CNT + (l * 32 + el) * 64, 1u, RLX_AGENT);
                    ROWTOK[(size_t)el * M + pos] = token; TKE[token * 4 + k] = el; TKP[token * 4 + k] = pos; TKG[token * 4 + k] = gt[k]; }
            }
            __syncthreads();
        }
        SEAM(pb + 7);
        if (((PHMASK>>8)&1) && IN(pb + 8)) { PHASE_TID
            if (tid < 32) CNT[tid] = (int)__hip_atomic_load((unsigned*)ctl + CW_CNT + (l * 32 + tid) * 64, RLX_AGENT);
            __syncthreads();
            if (tid == 0) { int a = 0; for (int e = 0; e < 32; ++e) { PB[e] = a; a += (CNT[e] + 255) >> 8; } PB[32] = a; }
            __syncthreads();
            const int P = PB[32];
            const int* ROWTOK = (const int*)(ws + WS_ROWTOK);
            char* XD = (char*)(ws + WS_R1);
            for (int s = gw; s < P * 256; s += NGW) {
                const int pm = s >> 8; int e = 0;
#pragma unroll 1
                for (int j = 1; j < NEXP; ++j) e += (PB[j] <= pm) ? 1 : 0;
                const int pos = s - PB[e] * 256;
                if (pos < CNT[e]) { const int tok = ROWTOK[(size_t)e * M + pos];
                    const u32x4 a = *(const u32x4*)(Xb + (size_t)tok * 2048 + lane * 16), b2 = *(const u32x4*)(Xb + (size_t)tok * 2048 + 1024 + lane * 16);
                    *(u32x4*)(XD + (size_t)s * 2048 + lane * 16) = a; *(u32x4*)(XD + (size_t)s * 2048 + 1024 + lane * 16) = b2; }
            }
            LAS float* scr = (LAS float*)(lds + wave * 8448);
            constexpr int IT_GU = 32 * 16 * 64, IT_DN = 32 * 16 * 32;
            for (int it = gw; it < IT_GU + IT_DN; it += NGW) {
                if (it < IT_GU) { const int e = it >> 10, q = it & 1023, kb = q >> 6, nb = q & 63;
                    transpose_item(args.in[I_WGU] + (((size_t)l * 32 + e) * D + 64 * kb) * 2048 + 32 * nb, 2048, (bf16*)(ws + WS_WGU) + ((size_t)e * 2048 + 32 * nb) * D + 64 * kb, D, scr, lane); }
                else { const int r = it - IT_GU, e = r >> 9, q = r & 511, kb = q >> 5, nb = q & 31;
                    transpose_item(args.in[I_WDN] + (((size_t)l * 32 + e) * D + 64 * kb) * 1024 + 32 * nb, 1024, (bf16*)(ws + WS_WDN) + ((size_t)e * 1024 + 32 * nb) * D + 64 * kb, D, scr, lane); }
            }
            __syncthreads();
        }
        SEAM(pb + 8);
        if (IN(pb + 9) || IN(pb + 10)) { PHASE_TID
            if (tid < 32) CNT[tid] = (int)__hip_atomic_load((unsigned*)ctl + CW_CNT + (l * 32 + tid) * 64, RLX_AGENT);
            __syncthreads();
            if (tid == 0) { int a = 0; for (int e = 0; e < 32; ++e) { PB[e] = a; a += (CNT[e] + 255) >> 8; } PB[32] = a; }
            __syncthreads();
        }
        if (((PHMASK>>9)&1) && IN(pb + 9)) {
            SchedMoe S; S.T.init(PB[32], 8); S.G = G; S.c = bx; S.A = (const char*)(ws + WS_R1); S.W = (const char*)(ws + WS_WGU); S.C = (char*)(ws + WS_R2 + R2_HMID); S.PB = PB; S.wrows = 2048; S.ldc = 1024; S.cdiv = 2;
            pg8::EpiMoe1 E; E.bgu = args.in[I_BGU] + (size_t)l * 32 * 2048;
            pg8::gemm_phase(lds, D, D * 2, D * 2, S, E);
        }
        SEAM(pb + 9);
        if (((PHMASK>>10)&1) && IN(pb + 10)) {
            SchedMoe S; S.T.init(PB[32], 4); S.G = G; S.c = bx; S.A = (const char*)(ws + WS_R2 + R2_HMID); S.W = (const char*)(ws + WS_WDN); S.C = (char*)(ws + WS_R1); S.PB = PB; S.wrows = 1024; S.ldc = 1024; S.cdiv = 1;
            pg8::EpiMoe2 E; E.bdn = args.in[I_BDN] + (size_t)l * 32 * 1024;
            pg8::gemm_phase(lds, D, D * 2, D * 2, S, E);
        }
        SEAM(pb + 10);
        if (((PHMASK>>11)&1) && IN(pb + 11)) { PHASE_TID
            if (tid < 32) CNT[tid] = (int)__hip_atomic_load((unsigned*)ctl + CW_CNT + (l * 32 + tid) * 64, RLX_AGENT);
            LAS float* wgt = (LAS float*)(lds + 73728);
            const bool lastl = (l == DEPTH - 1);
            if (!lastl) load_gate_table(wgt, args.in[I_WIN] + (size_t)(l + 1) * D * DIN, tid);
            __syncthreads();
            if (tid == 0) { int a = 0; for (int e = 0; e < 32; ++e) { PB[e] = a; a += (CNT[e] + 255) >> 8; } PB[32] = a; }
            __syncthreads();
            f32x4 g[4], bb[4];
#pragma unroll
            for (int j = 0; j < 4; ++j) { g[j] = *(const f32x4*)(args.in[I_LN2G] + l * D + 256 * j + 4 * lane); bb[j] = *(const f32x4*)(args.in[I_LN2B] + l * D + 256 * j + 4 * lane); }
            const char* YA = (const char*)(ws + WS_R1);
            const int* TKE = (const int*)(ws + WS_TKE); const float* TKG = (const float*)(ws + WS_TKG); const int* TKP = (const int*)(ws + WS_TKP);
            for (int m = gw; m < M; m += NGW) {
                f32x4 v[4];
#pragma unroll
                for (int j = 0; j < 4; ++j) v[j] = ld4bf(Xb + ((size_t)m * D + 256 * j + 4 * lane) * 2) * DN_ALPHA;
#pragma unroll
                for (int k = 0; k < 4; ++k) { const int e = TKE[m * 4 + k], pos = TKP[m * 4 + k]; const float gk = TKG[m * 4 + k];
                    const size_t row = (size_t)PB[e] * 256 + pos;
#pragma unroll
                    for (int j = 0; j < 4; ++j) v[j] = v[j] + ld4bf(YA + (row * D + 256 * j + 4 * lane) * 2) * gk; }
                ln16(v, g, bb);
                if (lastl) {
#pragma unroll
                    for (int j = 0; j < 4; ++j) *(f32x4*)(args.out + (size_t)m * D + 256 * j + 4 * lane) = v[j];
                } else {
#pragma unroll
                    for (int j = 0; j < 4; ++j) st4bf(Xb + ((size_t)m * D + 256 * j + 4 * lane) * 2, v[j]);
                    gates8(v, wgt, GIF + (size_t)m * 8, lane);
                }
            }
            __syncthreads();
        }
        SEAM(pb + 11);
    }
#undef IN
#undef SEAM
}

extern "C" void kernel_launch(void* const* d_in, const int* in_sizes, int n_in, void* d_out, int out_size, void* d_ws, size_t ws_size, hipStream_t stream) {
    static int grid = 0;
    if (grid == 0) {
        if (n_in != N_IN || out_size != M * D || ws_size < WS_END) { fprintf(stderr, "kernel_launch: unexpected shapes (n_in %d, out %d, ws %zu)\n", n_in, out_size, ws_size); grid = -1; return; }
        int dev = 0, cus = 0, per_cu = 0;
        if (hipGetDevice(&dev) != hipSuccess || hipDeviceGetAttribute(&cus, hipDeviceAttributeMultiprocessorCount, dev) != hipSuccess) { grid = -1; return; }
        if (hipFuncSetAttribute((const void*)fwd_kernel, hipFuncAttributeMaxDynamicSharedMemorySize, LDS_BYTES) != hipSuccess) { fprintf(stderr, "kernel_launch: hipFuncSetAttribute failed\n"); grid = -1; return; }
        if (hipOccupancyMaxActiveBlocksPerMultiprocessor(&per_cu, (const void*)fwd_kernel, NTHR, LDS_BYTES) != hipSuccess || per_cu < 1) fprintf(stderr, "kernel_launch: occupancy query reports %d\n", per_cu);
        (void)hipGetLastError();
        grid = cus;
    }
    if (grid < 0) return;
    (void)hipMemsetAsync((char*)d_ws + WS_CTL, 0, CTL_ZERO_BYTES, stream);
    Args a{};
    for (int i = 0; i < N_IN; ++i) a.in[i] = (const float*)d_in[i];
    a.out = (float*)d_out; a.ws = (unsigned char*)d_ws;
#if MK_ONE_LAUNCH
    a.ph_lo = 0; a.ph_hi = NPH;
    hipLaunchKernelGGL(fwd_kernel, dim3(grid), dim3(NTHR), LDS_BYTES, stream, a);
#else
    for (int p = 0; p < NPH; ++p) { a.ph_lo = p; a.ph_hi = p + 1; hipLaunchKernelGGL(fwd_kernel, dim3(grid), dim3(NTHR), LDS_BYTES, stream, a); }
#endif
    const hipError_t le = hipPeekAtLastError();
    if (le != hipSuccess) fprintf(stderr, "kernel_launch: launch failed: %s\n", hipGetErrorName(le));
}
```

```cpp
#include <hip/hip_runtime.h>
#include <cstdio>
#include <cstdint>

#ifndef MK_ONE_LAUNCH
#define MK_ONE_LAUNCH 1
#endif

#define LAS __attribute__((address_space(3)))
#define GAS __attribute__((address_space(1)))
typedef unsigned short bf16;
typedef short bf16x8 __attribute__((ext_vector_type(8)));
typedef float f32x4 __attribute__((ext_vector_type(4)));
typedef float f32x2 __attribute__((ext_vector_type(2)));
typedef float f32x16 __attribute__((ext_vector_type(16)));
typedef unsigned u32x4 __attribute__((ext_vector_type(4)));
typedef unsigned u32x2 __attribute__((ext_vector_type(2)));
typedef __bf16 bf16x2_t __attribute__((ext_vector_type(2)));
typedef GAS unsigned gu32;
#define RLX_AGENT __ATOMIC_RELAXED, __HIP_MEMORY_SCOPE_AGENT
#define DI __device__ __forceinline__

constexpr int NWAVES = 8, NTHR = 512;
constexpr int D = 1024, BATCH = 16, SEQ = 4096, M = BATCH * SEQ, DEPTH = 2, MEML = 256, MROWS = BATCH * MEML;
constexpr int DIN = 6920, NU = 6912;
constexpr int UC_QK = 0, UC_V = 512, UC_OG = 1024, UC_RW = 1536, UC_CAQ = 3328, UC_GATE = 3840;
constexpr int NEXP = 32, TOPK = 4;
constexpr int PMAX = M * TOPK / 256 + NEXP;
constexpr float LN_EPS = 1e-5f, RW_GN_EPS = 64e-5f, DN_ALPHA = 1.41421356237f;

enum { I_X = 0, I_MEM, I_LNIN_G, I_LNIN_B, I_MEMLN_G, I_MEMLN_B, I_WIN, I_CONVW, I_CONVB, I_IGB, I_FGB, I_MLNORMG, I_RWMU, I_RWW0, I_RWWUP, I_RWA0, I_RWAUP, I_RWGUP,
       I_RWKK, I_RWKA, I_RWRK, I_RWLNG, I_RWLNB, I_CAWKV, I_GATEB, I_WBRML, I_WBRRW, I_WBRCA, I_WO, I_LN1G, I_LN1B, I_RTW, I_RTB, I_WGU, I_BGU, I_WDN, I_BDN, I_LN2G, I_LN2B, N_IN };

constexpr size_t MiB = 1u << 20;
constexpr size_t WS_CTL = 0, CTL_ZERO_BYTES = 1 * MiB;
constexpr size_t WS_WIN = 1 * MiB;
constexpr size_t WS_WKV = 28 * MiB;
constexpr size_t WS_WBR = 32 * MiB;
constexpr size_t WS_WO = 38 * MiB;
constexpr size_t WS_WLORA = 42 * MiB;
constexpr size_t WS_WGU = 45 * MiB;
constexpr size_t WS_WDN = 173 * MiB;
constexpr size_t WS_X = 237 * MiB;
constexpr size_t WS_MEMN = 365 * MiB;
constexpr size_t WS_KV = 373 * MiB;
constexpr size_t WS_GIF = 389 * MiB;
constexpr size_t WS_TKE = 391 * MiB, WS_TKG = 392 * MiB, WS_TKP = 393 * MiB;
constexpr size_t WS_ROWTOK = 394 * MiB;
constexpr size_t WS_HML = 402 * MiB;
constexpr size_t WS_R1 = 466 * MiB;
constexpr size_t WS_R2 = 1330 * MiB;
constexpr size_t WS_END = 1858 * MiB;
constexpr size_t R2_LORA_OUT = 0, R2_HCAT = 192 * MiB, R2_LORA_IN = 384 * MiB, R2_YPRE = 0, R2_Z = 192 * MiB, R2_HMID = 0;
constexpr int CW_TMO = 0, CW_BAR = 4096, CW_CNT = 16384;

constexpr int LDS_BYTES = 155648;
constexpr int LDSCTL_OFF = 153600;

DI unsigned f2bf(float f) { unsigned u = __builtin_bit_cast(unsigned, f); return (u + 0x7fffu + ((u >> 16) & 1u)) >> 16; }
DI unsigned pk2(float lo, float hi) { bf16x2_t b = __builtin_convertvector((f32x2){lo, hi}, bf16x2_t); return __builtin_bit_cast(unsigned, b); }
DI float bflo(unsigned u) { return __builtin_bit_cast(float, u << 16); }
DI float bfhi(unsigned u) { return __builtin_bit_cast(float, u & 0xffff0000u); }
DI unsigned pk4_f8(float a, float b, float c, float d) {
    a = __builtin_amdgcn_fmed3f(a, -448.f, 448.f); b = __builtin_amdgcn_fmed3f(b, -448.f, 448.f); c = __builtin_amdgcn_fmed3f(c, -448.f, 448.f); d = __builtin_amdgcn_fmed3f(d, -448.f, 448.f);
    int w = 0; w = __builtin_amdgcn_cvt_pk_fp8_f32(a, b, w, false); w = __builtin_amdgcn_cvt_pk_fp8_f32(c, d, w, true); return (unsigned)w; }
DI float sigmoidf_(float x) { return __builtin_amdgcn_rcpf(1.f + __builtin_amdgcn_exp2f(-1.4426950408889634f * x)); }
template <int CTRL> DI float dppf(float x) { return __builtin_bit_cast(float, __builtin_amdgcn_update_dpp(0, __builtin_bit_cast(int, x), CTRL, 0xF, 0xF, true)); }
DI float red4(float x) { x += dppf<0xB1>(x); x += dppf<0x4E>(x); return x; }
DI float red8(float x) { x = red4(x); x += dppf<0x141>(x); return x; }
DI float red16(float x) { x = red8(x); x += dppf<0x140>(x); return x; }
DI float wave_sum(float v) {
    v = red16(v);
    const int vi = __builtin_bit_cast(int, v);
    const float a = __builtin_bit_cast(float, __builtin_amdgcn_readlane(vi, 0)), b = __builtin_bit_cast(float, __builtin_amdgcn_readlane(vi, 16));
    const float c = __builtin_bit_cast(float, __builtin_amdgcn_readlane(vi, 32)), d = __builtin_bit_cast(float, __builtin_amdgcn_readlane(vi, 48));
    return (a + b) + (c + d);
}
#define LDS_WAIT() asm volatile("s_waitcnt lgkmcnt(0)" ::: "memory")

constexpr float F8_SX = 8.f, F8_SWGU = 512.f, F8_SH = 4.f, F8_SWDN = 1024.f, F8_INV1 = 1.f / (F8_SX * F8_SWGU), F8_INV2 = 1.f / (F8_SH * F8_SWDN);
namespace pg8 {
constexpr int BM = 256, BK = 64, HALF = 128, HTB = HALF * BK * 2, STAGE_BYTES = 8 * HTB, NXCD = 8, WGM = 8;
__host__ __device__ __forceinline__ int lds_byte(int r, int c) { const int st = (r >> 4) * 2 + (c >> 5), rr = r & 15, cc = c & 31, ob = rr * 64 + cc * 2; return st * 1024 + (ob ^ (((ob >> 9) & 1) << 5)); }
__host__ __device__ __forceinline__ void stage_rc(int b, int& R, int& C) { const int st = b / 1024, sb = b % 1024, swz = sb ^ (((sb >> 9) & 1) << 5); R = (st >> 1) * 16 + swz / 64; C = (st & 1) * 32 + (swz % 64) / 2; }
__host__ __device__ __forceinline__ int perm32(int rho) { const int n = rho >> 4, i = rho & 15; return 8 * (i >> 2) + 4 * n + (i & 3); }

struct Unit { const char* a; const char* b; char* c; int ldc; int r0, c0, e, sub; };

struct TileOrder {
    int nM, nN, nwg;
    DI void init(int nM_, int nN_) { nM = nM_; nN = nN_; nwg = nM * nN; }
    DI bool tile(long L, int& pm, int& pn) const {
        if (L >= nwg) return false;
        int wgid = (int)L; { const int q = nwg / NXCD, r = nwg % NXCD, xcd = wgid % NXCD, off = wgid / NXCD; wgid = (xcd < r ? xcd * (q + 1) : r * (q + 1) + (xcd - r) * q) + off; }
        const int nig = WGM * nN, gid = wgid / nig, fm = gid * WGM, gsz = (nM - fm) < WGM ? (nM - fm) : WGM;
        pm = fm + ((wgid % nig) % gsz); pn = (wgid % nig) / gsz; return true;
    }
};

DI u32x4 pack8(const f32x4& v0, const f32x4& v1) { u32x4 w; w.x = pk2(v0[0], v0[1]); w.y = pk2(v0[2], v0[3]); w.z = pk2(v1[0], v1[1]); w.w = pk2(v1[2], v1[3]); return w; }

struct EpiStore {
    DI void operator()(const f32x4 (&acc)[2][2][4][2], const Unit& u, int wr, int wc, int fr, int fq) const {
#pragma unroll
        for (int ai = 0; ai < 2; ++ai)
#pragma unroll
            for (int m = 0; m < 4; ++m) { char* rowp = u.c + ((size_t)(ai * HALF + wr * 64 + m * 16 + fr) * u.ldc + wc * 32 + 8 * fq) * 2;
#pragma unroll
                for (int bj = 0; bj < 2; ++bj) *(u32x4*)(rowp + bj * 256) = pack8(acc[ai][bj][m][0], acc[ai][bj][m][1]); }
    }
};
struct EpiMerge {
    const char* U; const float* gate_b;
    DI void operator()(const f32x4 (&acc)[2][2][4][2], const Unit& u, int wr, int wc, int fr, int fq) const {
        f32x4 gb[2][2];
#pragma unroll
        for (int bj = 0; bj < 2; ++bj) { const float* g = gate_b + u.sub * 1024 + u.c0 + bj * HALF + wc * 32 + 8 * fq; gb[bj][0] = *(const f32x4*)g; gb[bj][1] = *(const f32x4*)(g + 4); }
#pragma unroll
        for (int ai = 0; ai < 2; ++ai)
#pragma unroll
            for (int m = 0; m < 4; ++m) { const int lr = ai * HALF + wr * 64 + m * 16 + fr; char* rowp = u.c + ((size_t)lr * u.ldc + wc * 32 + 8 * fq) * 2;
                const char* gp = U + ((size_t)(u.r0 + lr) * NU + UC_GATE + u.sub * 1024 + u.c0 + wc * 32 + 8 * fq) * 2;
#pragma unroll
                for (int bj = 0; bj < 2; ++bj) { const u32x4 gw = *(const u32x4*)(gp + bj * 256);
                    f32x4 v0 = acc[ai][bj][m][0], v1 = acc[ai][bj][m][1];
                    v0[0] *= sigmoidf_(bflo(gw.x) + gb[bj][0][0]); v0[1] *= sigmoidf_(bfhi(gw.x) + gb[bj][0][1]); v0[2] *= sigmoidf_(bflo(gw.y) + gb[bj][0][2]); v0[3] *= sigmoidf_(bfhi(gw.y) + gb[bj][0][3]);
                    v1[0] *= sigmoidf_(bflo(gw.z) + gb[bj][1][0]); v1[1] *= sigmoidf_(bfhi(gw.z) + gb[bj][1][1]); v1[2] *= sigmoidf_(bflo(gw.w) + gb[bj][1][2]); v1[3] *= sigmoidf_(bfhi(gw.w) + gb[bj][1][3]);
                    if (u.sub) { u32x4 pw; { const unsigned long long q0 = __hip_atomic_load((const unsigned long long*)(rowp + bj * 256), RLX_AGENT), q1 = __hip_atomic_load((const unsigned long long*)(rowp + bj * 256 + 8), RLX_AGENT);
                            pw.x = (unsigned)q0; pw.y = (unsigned)(q0 >> 32); pw.z = (unsigned)q1; pw.w = (unsigned)(q1 >> 32); }
                        v0[0] += bflo(pw.x); v0[1] += bfhi(pw.x); v0[2] += bflo(pw.y); v0[3] += bfhi(pw.y); v1[0] += bflo(pw.z); v1[1] += bfhi(pw.z); v1[2] += bflo(pw.w); v1[3] += bfhi(pw.w); }
                    *(u32x4*)(rowp + bj * 256) = pack8(v0, v1); }
                asm volatile("" ::: "memory"); }
    }
};
struct EpiWo {
    const char* X;
    DI void operator()(const f32x4 (&acc)[2][2][4][2], const Unit& u, int wr, int wc, int fr, int fq) const {
#pragma unroll
        for (int ai = 0; ai < 2; ++ai)
#pragma unroll
            for (int m = 0; m < 4; ++m) { const int lr = ai * HALF + wr * 64 + m * 16 + fr; char* rowp = u.c + ((size_t)lr * u.ldc + wc * 32 + 8 * fq) * 2;
                const char* xp = X + ((size_t)(u.r0 + lr) * D + u.c0 + wc * 32 + 8 * fq) * 2;
#pragma unroll
                for (int bj = 0; bj < 2; ++bj) { const u32x4 xw = *(const u32x4*)(xp + bj * 256);
                    f32x4 v0 = acc[ai][bj][m][0], v1 = acc[ai][bj][m][1];
                    v0[0] += DN_ALPHA * bflo(xw.x); v0[1] += DN_ALPHA * bfhi(xw.x); v0[2] += DN_ALPHA * bflo(xw.y); v0[3] += DN_ALPHA * bfhi(xw.y);
                    v1[0] += DN_ALPHA * bflo(xw.z); v1[1] += DN_ALPHA * bfhi(xw.z); v1[2] += DN_ALPHA * bflo(xw.w); v1[3] += DN_ALPHA * bfhi(xw.w);
                    *(u32x4*)(rowp + bj * 256) = pack8(v0, v1); }
                asm volatile("" ::: "memory"); }
    }
};
DI float swiglu1(float a, float b) { const float g = fminf(a, 7.f), l = fminf(fmaxf(b, -7.f), 7.f); return g * sigmoidf_(1.702f * g) * (l + 1.f); }
struct EpiMoe1 {
    const float* bgu;
    DI void operator()(const f32x4 (&acc)[2][2][4][2], const Unit& u, int wr, int wc, int fr, int fq) const {
        f32x4 bv[2][2];
#pragma unroll
        for (int bj = 0; bj < 2; ++bj) { const float* b = bgu + u.e * 2048 + u.c0 + bj * HALF + wc * 32 + 8 * fq; bv[bj][0] = *(const f32x4*)b; bv[bj][1] = *(const f32x4*)(b + 4); }
#pragma unroll
        for (int ai = 0; ai < 2; ++ai)
#pragma unroll
            for (int m = 0; m < 4; ++m) { const int lr = ai * HALF + wr * 64 + m * 16 + fr; char* rowp = u.c + ((size_t)lr * u.ldc + wc * 16 + 4 * fq);
#pragma unroll
                for (int bj = 0; bj < 2; ++bj) { const f32x4 v0 = acc[ai][bj][m][0] * F8_INV1 + bv[bj][0], v1 = acc[ai][bj][m][1] * F8_INV1 + bv[bj][1];
                    *(unsigned*)(rowp + bj * 64) = pk4_f8(swiglu1(v0[0], v0[1]) * F8_SH, swiglu1(v0[2], v0[3]) * F8_SH, swiglu1(v1[0], v1[1]) * F8_SH, swiglu1(v1[2], v1[3]) * F8_SH); } }
    }
};
struct EpiMoe2 {
    const float* bdn;
    DI void operator()(const f32x4 (&acc)[2][2][4][2], const Unit& u, int wr, int wc, int fr, int fq) const {
        f32x4 bv[2][2];
#pragma unroll
        for (int bj = 0; bj < 2; ++bj) { const float* b = bdn + u.e * 1024 + u.c0 + bj * HALF + wc * 32 + 8 * fq; bv[bj][0] = *(const f32x4*)b; bv[bj][1] = *(const f32x4*)(b + 4); }
#pragma unroll
        for (int ai = 0; ai < 2; ++ai)
#pragma unroll
            for (int m = 0; m < 4; ++m) { char* rowp = u.c + ((size_t)(ai * HALF + wr * 64 + m * 16 + fr) * u.ldc + wc * 32 + 8 * fq) * 2;
#pragma unroll
                for (int bj = 0; bj < 2; ++bj) *(u32x4*)(rowp + bj * 256) = pack8(acc[ai][bj][m][0] * F8_INV2 + bv[bj][0], acc[ai][bj][m][1] * F8_INV2 + bv[bj][1]); }
    }
};

typedef int i32x8 __attribute__((ext_vector_type(8)));
typedef int i32x4 __attribute__((ext_vector_type(4)));
template <bool F8, class Epi, class Sched>
DI void gemm_phase(LAS unsigned char* lds, const int KB  , const int ldaB, const int ldbB, const Sched& S, const Epi& E) {
    int tid = threadIdx.x; asm volatile("" : "+v"(tid));
    const int wid = __builtin_amdgcn_readfirstlane(tid >> 6), lane = tid & 63, wr = wid >> 2, wc = wid & 3, fr = lane & 15, fq = lane >> 4;
    const int nt = KB / (BK * 2);
    unsigned voffA[2], voffB[2];
#pragma unroll
    for (int i = 0; i < 2; ++i) { int R, C; stage_rc(tid * 16 + i * 8192, R, C); const int Rb = (R & ~31) + perm32(R & 31);
        voffA[i] = (unsigned)(R * ldaB + C * 2); voffB[i] = (unsigned)(Rb * ldbB + C * 2); }
    const size_t kstep = (size_t)(BK * 2);
    const size_t hstepA = (size_t)HALF * ldaB, hstepB = (size_t)HALF * ldbB;
    const unsigned ldsw = (unsigned)wid * 1024u;
    const int aoff = lds_byte(wr * 64 + fr, fq * 8), boff = lds_byte(wc * 32 + fr, fq * 8);
#define PG8_SA(b, h) (((b) * 2 + (h)) * HTB)
#define PG8_SB(b, h) ((4 + (b) * 2 + (h)) * HTB)
#define PG8_STAGE(bufoff, gbase, voff) do { _Pragma("unroll") for (int _i = 0; _i < 2; ++_i) \
        __builtin_amdgcn_global_load_lds((const unsigned*)((const char*)(gbase) + (voff)[_i]), (LAS unsigned*)(lds + (bufoff) + ldsw + _i * 8192), 16, 0, 0); } while (0)
#define PG8_LD8(p) __builtin_shufflevector(*(const LAS i32x4*)(p), *(const LAS i32x4*)((p) + 1024), 0, 1, 2, 3, 4, 5, 6, 7)
#define PG8_LDA8(dst, b, h) do { _Pragma("unroll") for (int m = 0; m < 4; ++m) dst[m] = PG8_LD8(lds + PG8_SA(b, h) + aoff + m * 2048); } while (0)
#define PG8_LDB8(dst, b, h) do { _Pragma("unroll") for (int n = 0; n < 2; ++n) dst[n] = PG8_LD8(lds + PG8_SB(b, h) + boff + n * 2048); } while (0)
#define PG8_MMA8(ai, bj, A8, B8) do { __builtin_amdgcn_s_setprio(1); _Pragma("unroll") for (int m = 0; m < 4; ++m) _Pragma("unroll") for (int n = 0; n < 2; ++n) \
        asm volatile("v_mfma_f32_16x16x128_f8f6f4 %0, %1, %2, %0" : "+v"(acc[ai][bj][m][n]) : "v"(B8[n]), "v"(A8[m])); __builtin_amdgcn_s_setprio(0); } while (0)
#define PG8_LDA(dst, b, h) do { _Pragma("unroll") for (int m = 0; m < 4; ++m) _Pragma("unroll") for (int k = 0; k < 2; ++k) dst[m][k] = *(const LAS bf16x8*)(lds + PG8_SA(b, h) + aoff + m * 2048 + k * 1024); } while (0)
#define PG8_LDB(dst, b, h) do { _Pragma("unroll") for (int n = 0; n < 2; ++n) _Pragma("unroll") for (int k = 0; k < 2; ++k) dst[n][k] = *(const LAS bf16x8*)(lds + PG8_SB(b, h) + boff + n * 2048 + k * 1024); } while (0)
#define PG8_CAT(x) __builtin_shufflevector(__builtin_bit_cast(i32x4, (x)[0]), __builtin_bit_cast(i32x4, (x)[1]), 0, 1, 2, 3, 4, 5, 6, 7)
#define PG8_MMA(ai, bj, At, Bt) do { __builtin_amdgcn_s_setprio(1); _Pragma("unroll") for (int m = 0; m < 4; ++m) _Pragma("unroll") for (int n = 0; n < 2; ++n) _Pragma("unroll") for (int k = 0; k < 2; ++k) \
        acc[ai][bj][m][n] = __builtin_amdgcn_mfma_f32_16x16x32_bf16(Bt[n][k], At[m][k], acc[ai][bj][m][n], 0, 0, 0); __builtin_amdgcn_s_setprio(0); } while (0)
#define PG8_WAIT_V(n) asm volatile("s_waitcnt vmcnt(" #n ")" ::: "memory")
#define PG8_WAIT_L(n) asm volatile("s_waitcnt lgkmcnt(" #n ")" ::: "memory")
#define PG8_BAR __builtin_amdgcn_s_barrier()
#define PG8_SCHED __builtin_amdgcn_sched_barrier(0)
    Unit cur, nxt; int ui = 0;
    if (!S.next(0, cur)) return;
    f32x4 acc[2][2][4][2];
#pragma unroll
    for (int a = 0; a < 2; ++a)
#pragma unroll
        for (int b = 0; b < 2; ++b)
#pragma unroll
            for (int m = 0; m < 4; ++m)
#pragma unroll
                for (int n = 0; n < 2; ++n) acc[a][b][m][n] = (f32x4){0.f, 0.f, 0.f, 0.f};
    bf16x8 At[4][2], B0[2][2], B1[2][2]; i32x8 A8[4], B80[2], B81[2];
    const char* cA = cur.a; const char* cB = cur.b;
    PG8_STAGE(PG8_SB(0, 0), cB, voffB); PG8_STAGE(PG8_SB(0, 1), cB + hstepB, voffB); PG8_STAGE(PG8_SA(0, 0), cA, voffA); PG8_STAGE(PG8_SA(0, 1), cA + hstepA, voffA);
    if (wr == 1) PG8_BAR;
    PG8_WAIT_V(2); PG8_BAR;
    PG8_STAGE(PG8_SB(1, 0), cB + kstep, voffB); PG8_STAGE(PG8_SA(1, 0), cA + kstep, voffA); PG8_STAGE(PG8_SB(1, 1), cB + hstepB + kstep, voffB);
    PG8_WAIT_V(6); PG8_BAR;
    for (;;) {
        const bool has_next = S.next(ui + 1, nxt);
        const char* nA = has_next ? nxt.a : cA; const char* nB = has_next ? nxt.b : cB;
#pragma unroll 1
        for (int t = 0; t < nt; t += 2) {
            const bool last = (t == nt - 2);
            const char* a1 = cA + (size_t)(t + 1) * kstep;
            const char* a2 = last ? nA : cA + (size_t)(t + 2) * kstep; const char* b2 = last ? nB : cB + (size_t)(t + 2) * kstep;
            const char* a3 = a2 + kstep; const char* b3 = b2 + kstep;
            if constexpr (F8) {
            PG8_LDB8(B80, 0, 0); PG8_LDB8(B81, 0, 1); PG8_SCHED; PG8_LDA8(A8, 0, 0); PG8_STAGE(PG8_SA(1, 1), a1 + hstepA, voffA);
            PG8_WAIT_V(8); PG8_WAIT_L(0); PG8_BAR; PG8_MMA8(0, 0, A8, B80); PG8_MMA8(0, 1, A8, B81); PG8_BAR; PG8_SCHED;
            PG8_LDA8(A8, 0, 1); PG8_STAGE(PG8_SB(0, 0), b2, voffB); PG8_STAGE(PG8_SB(0, 1), b2 + hstepB, voffB); PG8_STAGE(PG8_SA(0, 0), a2, voffA);
            PG8_WAIT_V(8); PG8_WAIT_L(0); PG8_BAR; PG8_MMA8(1, 0, A8, B80); PG8_MMA8(1, 1, A8, B81); PG8_BAR; PG8_SCHED;
            PG8_LDB8(B80, 1, 0); PG8_LDB8(B81, 1, 1); PG8_SCHED; PG8_LDA8(A8, 1, 0); PG8_STAGE(PG8_SA(0, 1), a2 + hstepA, voffA);
            PG8_WAIT_V(8); PG8_WAIT_L(0); PG8_BAR; PG8_MMA8(0, 0, A8, B80); PG8_MMA8(0, 1, A8, B81); PG8_BAR; PG8_SCHED;
            PG8_LDA8(A8, 1, 1); PG8_STAGE(PG8_SB(1, 0), b3, voffB); PG8_STAGE(PG8_SB(1, 1), b3 + hstepB, voffB); PG8_STAGE(PG8_SA(1, 0), a3, voffA);
            PG8_WAIT_V(8); PG8_WAIT_L(0); PG8_BAR; PG8_MMA8(1, 0, A8, B80); PG8_MMA8(1, 1, A8, B81); PG8_BAR; PG8_SCHED;
            } else {
            PG8_LDB(B0, 0, 0); PG8_LDB(B1, 0, 1); PG8_SCHED; PG8_LDA(At, 0, 0); PG8_STAGE(PG8_SA(1, 1), a1 + hstepA, voffA);
            PG8_WAIT_V(8); PG8_WAIT_L(0); PG8_BAR; PG8_MMA(0, 0, At, B0); PG8_MMA(0, 1, At, B1); PG8_BAR; PG8_SCHED;
            PG8_LDA(At, 0, 1); PG8_STAGE(PG8_SB(0, 0), b2, voffB); PG8_STAGE(PG8_SB(0, 1), b2 + hstepB, voffB); PG8_STAGE(PG8_SA(0, 0), a2, voffA);
            PG8_WAIT_V(8); PG8_WAIT_L(0); PG8_BAR; PG8_MMA(1, 0, At, B0); PG8_MMA(1, 1, At, B1); PG8_BAR; PG8_SCHED;
            PG8_LDB(B0, 1, 0); PG8_LDB(B1, 1, 1); PG8_SCHED; PG8_LDA(At, 1, 0); PG8_STAGE(PG8_SA(0, 1), a2 + hstepA, voffA);
            PG8_WAIT_V(8); PG8_WAIT_L(0); PG8_BAR; PG8_MMA(0, 0, At, B0); PG8_MMA(0, 1, At, B1); PG8_BAR; PG8_SCHED;
            PG8_LDA(At, 1, 1); PG8_STAGE(PG8_SB(1, 0), b3, voffB); PG8_STAGE(PG8_SB(1, 1), b3 + hstepB, voffB); PG8_STAGE(PG8_SA(1, 0), a3, voffA);
            PG8_WAIT_V(8); PG8_WAIT_L(0); PG8_BAR; PG8_MMA(1, 0, At, B0); PG8_MMA(1, 1, At, B1); PG8_BAR; PG8_SCHED;
            }
        }
        if (wr == 0) PG8_BAR;
        if constexpr (F8) asm volatile("s_nop 15\n\ts_nop 15" ::: "memory");
        { int fr_ = fr, fq_ = fq; asm volatile("" : "+v"(fr_), "+v"(fq_));
          E(acc, cur, wr, wc, fr_, fq_); }
        if (!has_next) break;
#pragma unroll
        for (int a = 0; a < 2; ++a)
#pragma unroll
            for (int b = 0; b < 2; ++b)
#pragma unroll
                for (int m = 0; m < 4; ++m)
#pragma unroll
                    for (int n = 0; n < 2; ++n) acc[a][b][m][n] = (f32x4){0.f, 0.f, 0.f, 0.f};
        cur = nxt; cA = nA; cB = nB; ++ui;
        if (wr == 1) PG8_BAR;
    }
    PG8_WAIT_V(0);
    PG8_BAR;
#undef PG8_SA
#undef PG8_SB
#undef PG8_STAGE
#undef PG8_LDA
#undef PG8_LDB
#undef PG8_MMA
#undef PG8_CAT
#undef PG8_LD8
#undef PG8_LDA8
#undef PG8_LDB8
#undef PG8_MMA8
#undef PG8_WAIT_V
#undef PG8_WAIT_L
#undef PG8_BAR
#undef PG8_SCHED
}
}

#define XB_TMO      128
#define XB_XCNT(j)  (256  + 64 * (j))
#define XB_XSUB(j)  (1280 + 64 * (j))
#define XB_XGEN(j)  (2304 + 64 * (j))
#define XB_TOP      3328
#define XB_TOPGEN   3392
#define XCD_BAR_WORDS 3456
#define XB_SPIN_CAP (1u << 22)
DI unsigned xb_ld(unsigned* p)              { return __hip_atomic_load(p, __ATOMIC_RELAXED, __HIP_MEMORY_SCOPE_AGENT); }
DI unsigned xb_add(unsigned* p, unsigned v) { return __hip_atomic_fetch_add(p, v, __ATOMIC_RELAXED, __HIP_MEMORY_SCOPE_AGENT); }
DI unsigned xb_xcc_id() { return (unsigned)__builtin_amdgcn_s_getreg((3 << 11) | 20) & 0xFu; }
#define XB_SPIN(cond, bar) do { unsigned _sp = 0; while (cond) { __builtin_amdgcn_s_sleep(1); \
    if ((++_sp & 255u) == 0u) { if (xb_ld(&(bar)[XB_TMO])) break; if (_sp > XB_SPIN_CAP) { atomicAdd(&(bar)[XB_TMO], 1u); break; } } } } while (0)
struct XcdBarrier { unsigned* bar; unsigned x; volatile LAS unsigned* st; };
DI XcdBarrier xcd_barrier_post(unsigned* bar, volatile LAS unsigned* st) {
    XcdBarrier b; b.bar = bar; b.x = xb_xcc_id(); b.st = st;
    if (threadIdx.x == 0) (void)xb_add(&bar[XB_XCNT(b.x)], 1u);
    return b;
}
DI void xcd_barrier_complete(unsigned* bar, unsigned x, unsigned& nloc, unsigned& nx) {
    const unsigned G = gridDim.x * gridDim.y * gridDim.z;
    unsigned sum, cnt, mine, sp = 0u;
    for (;;) {
        sum = 0u; cnt = 0u; mine = 0u;
#pragma unroll
        for (unsigned j = 0; j < 16; ++j) { const unsigned c = xb_ld(&bar[XB_XCNT(j)]); sum += c; cnt += (c > 0u) ? 1u : 0u; mine = (j == x) ? c : mine; }
        if (sum == G) break;
        __builtin_amdgcn_s_sleep(1);
        if ((++sp & 255u) == 0u) { if (xb_ld(&bar[XB_TMO])) break; if (sp > XB_SPIN_CAP) { atomicAdd(&bar[XB_TMO], 1u); break; } }
    }
    nloc = mine > 0u ? mine : 1u; nx = cnt > 0u ? cnt : 1u;
}
DI void xcd_barrier(const XcdBarrier& b) {
    asm volatile("s_waitcnt vmcnt(0)" ::: "memory");
    __syncthreads();
    if (threadIdx.x == 0) {
        unsigned* bar = b.bar;
        __builtin_amdgcn_s_waitcnt(0);
        unsigned nloc = b.st[0], nx = b.st[1];
        if (nloc == 0u) { xcd_barrier_complete(bar, b.x, nloc, nx); b.st[0] = nloc; b.st[1] = nx; }
        const unsigned old = xb_add(&bar[XB_XSUB(b.x)], 1u);
        const unsigned gen = old / nloc;
        if (old + 1u == (gen + 1u) * nloc) {
            __builtin_amdgcn_fence(__ATOMIC_RELEASE, "agent");
            asm volatile("s_waitcnt vmcnt(0)" ::: "memory");
            const unsigned og = xb_add(&bar[XB_TOP], 1u);
            const unsigned tg = og / nx;
            if (og + 1u == (tg + 1u) * nx) xb_add(&bar[XB_TOPGEN], 1u);
            else XB_SPIN(xb_ld(&bar[XB_TOPGEN]) == tg, bar);
            __builtin_amdgcn_fence(__ATOMIC_ACQUIRE, "agent");
            xb_add(&bar[XB_XGEN(b.x)], 1u);
            asm volatile("s_waitcnt vmcnt(0)" ::: "memory");
        } else {
            XB_SPIN(xb_ld(&bar[XB_XGEN(b.x)]) == gen, bar);
            __builtin_amdgcn_fence(__ATOMIC_ACQUIRE, "agent");
            asm volatile("s_waitcnt vmcnt(0)" ::: "memory");
        }
    }
    __syncthreads();
}

DI void transpose_item(const float* W, int ldw, bf16* WT, int ldt, LAS float* scr, int lane) {
#pragma unroll 8
    for (int i = 0; i < 32; ++i) { const int kk = 2 * i + (lane >> 5); scr[kk * 33 + (lane & 31)] = W[(size_t)kk * ldw + (lane & 31)]; }
    LDS_WAIT(); asm volatile("" ::: "memory");
    const int c = lane & 7;
#pragma unroll
    for (int j = 0; j < 4; ++j) { const int n = (lane >> 3) + 8 * j; const LAS float* s = scr + (8 * c) * 33 + n;
        u32x4 o; o.x = pk2(s[0 * 33], s[1 * 33]); o.y = pk2(s[2 * 33], s[3 * 33]); o.z = pk2(s[4 * 33], s[5 * 33]); o.w = pk2(s[6 * 33], s[7 * 33]);
        *(u32x4*)(WT + (size_t)n * ldt + 8 * c) = o; }
    LDS_WAIT(); asm volatile("" ::: "memory");
}
DI void transpose_item_f8(const float* W, int ldw, unsigned char* WT, int ldt, float scale, LAS float* scr, int lane) {
#pragma unroll 8
    for (int i = 0; i < 32; ++i) { const int kk = 2 * i + (lane >> 5); scr[kk * 33 + (lane & 31)] = W[(size_t)kk * ldw + (lane & 31)]; }
    LDS_WAIT(); asm volatile("" ::: "memory");
    const int c = lane & 3;
#pragma unroll
    for (int j = 0; j < 2; ++j) { const int n = (lane >> 2) + 16 * j; const LAS float* s = scr + (16 * c) * 33 + n;
        u32x4 o; o.x = pk4_f8(s[0 * 33] * scale, s[1 * 33] * scale, s[2 * 33] * scale, s[3 * 33] * scale); o.y = pk4_f8(s[4 * 33] * scale, s[5 * 33] * scale, s[6 * 33] * scale, s[7 * 33] * scale);
        o.z = pk4_f8(s[8 * 33] * scale, s[9 * 33] * scale, s[10 * 33] * scale, s[11 * 33] * scale); o.w = pk4_f8(s[12 * 33] * scale, s[13 * 33] * scale, s[14 * 33] * scale, s[15 * 33] * scale);
        *(u32x4*)(WT + (size_t)n * ldt + 16 * c) = o; }
    LDS_WAIT(); asm volatile("" ::: "memory");
}
DI void ln16(f32x4 (&v)[4], const f32x4 (&g)[4], const f32x4 (&b)[4]) {
    float s = 0.f;
#pragma unroll
    for (int j = 0; j < 4; ++j) s += (v[j].x + v[j].y) + (v[j].z + v[j].w);
    const float mean = wave_sum(s) * (1.f / D); float s2 = 0.f;
#pragma unroll
    for (int j = 0; j < 4; ++j) { v[j] = v[j] - mean; s2 += (v[j].x * v[j].x + v[j].y * v[j].y) + (v[j].z * v[j].z + v[j].w * v[j].w); }
    const float rstd = 1.f / sqrtf(wave_sum(s2) * (1.f / D) + LN_EPS);
#pragma unroll
    for (int j = 0; j < 4; ++j) v[j] = v[j] * rstd * g[j] + b[j];
}
DI void gates8(const f32x4 (&y)[4], const LAS float* wgt, float* gif_row, int lane) {
    float p[8];
#pragma unroll
    for (int j = 0; j < 8; ++j) { float s = 0.f;
#pragma unroll
        for (int jj = 0; jj < 4; ++jj) { const f32x4 w = *(const LAS f32x4*)(wgt + j * 1024 + 256 * jj + 4 * lane); s += (y[jj].x * w.x + y[jj].y * w.y) + (y[jj].z * w.z + y[jj].w * w.w); }
        p[j] = wave_sum(s); }
    if (lane == 0) { *(f32x4*)gif_row = (f32x4){p[0], p[1], p[2], p[3]}; *(f32x4*)(gif_row + 4) = (f32x4){p[4], p[5], p[6], p[7]}; }
}
DI void load_gate_table(LAS float* wgt, const float* win_l, int tid) {
    for (int i = tid; i < 8192; i += NTHR) { const int k = i >> 3, j = i & 7; wgt[j * 1024 + k] = win_l[(size_t)k * DIN + 1536 + j]; }
}
DI f32x4 ld4bf(const char* p) { const u32x2 w = *(const u32x2*)p; return (f32x4){bflo(w.x), bfhi(w.x), bflo(w.y), bfhi(w.y)}; }
DI void st4bf(char* p, const f32x4& v) { u32x2 w; w.x = pk2(v.x, v.y); w.y = pk2(v.z, v.w); *(u32x2*)p = w; }

struct Args { const float* in[N_IN]; float* out; unsigned char* ws; int ph_lo, ph_hi; };
constexpr int NP_LAYER = 12, NPH = 1 + DEPTH * NP_LAYER;

struct SchedInproj {
    pg8::TileOrder T; int G, c; const char *X, *W; char* U; bool kv; const char *MEMN, *WKV; char* KV;
    DI bool next(int i, pg8::Unit& u) const {
        const long L = (long)i * G + c; int pm, pn;
        if (T.tile(L, pm, pn)) { u.a = X + (size_t)pm * 256 * D * 2; u.b = W + (size_t)pn * 256 * D * 2; u.r0 = pm * 256; u.c0 = pn * 256; u.c = U + ((size_t)u.r0 * NU + u.c0) * 2; u.ldc = NU; u.e = 0; u.sub = 0; return true; }
        if (!kv) return false;
        const long L2 = L - T.nwg; if (L2 < 0 || L2 >= 128) return false;
        const int l = (int)L2 >> 6, t = (int)L2 & 63; pm = t >> 2; pn = t & 3;
        u.a = MEMN + (size_t)pm * 256 * D * 2; u.b = WKV + ((size_t)l * 1024 + pn * 256) * D * 2; u.r0 = pm * 256; u.c0 = pn * 256; u.c = KV + (((size_t)l * MROWS + u.r0) * D + u.c0) * 2; u.ldc = D; u.e = 0; u.sub = 0; return true;
    }
};
struct SchedPlain {
    pg8::TileOrder T; int G, c; const char *A, *B; char* C; int lda, ldb, ldc;
    DI bool next(int i, pg8::Unit& u) const {
        const long L = (long)i * G + c; int pm, pn; if (!T.tile(L, pm, pn)) return false;
        u.a = A + (size_t)pm * 256 * lda * 2; u.b = B + (size_t)pn * 256 * ldb * 2; u.r0 = pm * 256; u.c0 = pn * 256; u.c = C + ((size_t)u.r0 * ldc + u.c0) * 2; u.ldc = ldc; u.e = 0; u.sub = 0; return true;
    }
};
struct SchedMerge {
    pg8::TileOrder T; int G, c; const char *H, *W; char* Y;
    DI bool next(int i, pg8::Unit& u) const {
        const int ti = i / 3, br = i - 3 * ti; const long L = (long)ti * G + c; int pm, pn; if (!T.tile(L, pm, pn)) return false;
        u.a = H + ((size_t)pm * 256 * 1536 + br * 512) * 2; u.b = W + ((size_t)br * 1024 + pn * 256) * 512 * 2; u.r0 = pm * 256; u.c0 = pn * 256; u.c = Y + ((size_t)u.r0 * D + u.c0) * 2; u.ldc = D; u.e = 0; u.sub = br; return true;
    }
};
struct SchedMoe {
    pg8::TileOrder T; int G, c; const char *A, *W; char* C; const LAS int* PB; int wrows  , ldc, cdiv, osz;
    DI bool next(int i, pg8::Unit& u) const {
        const long L = (long)i * G + c; int pm, pn; if (!T.tile(L, pm, pn)) return false;
        int e = 0;
#pragma unroll 1
        for (int j = 1; j < NEXP; ++j) e += (PB[j] <= pm) ? 1 : 0;
        u.a = A + (size_t)pm * 256 * 1024; u.b = W + ((size_t)e * wrows + pn * 256) * 1024; u.r0 = pm * 256; u.c0 = pn * 256; u.c = C + ((size_t)u.r0 * ldc + u.c0 / cdiv) * osz; u.ldc = ldc; u.e = e; u.sub = 0; return true;
    }
};

__global__ void __launch_bounds__(NTHR, 2) fwd_kernel(Args args) {
    extern __shared__ __attribute__((aligned(16))) unsigned char lds_raw[];
    LAS unsigned char* lds = (LAS unsigned char*)lds_raw;
    volatile LAS unsigned* LCTL = (volatile LAS unsigned*)(lds + LDSCTL_OFF);
    const int tid0 = threadIdx.x, wave = __builtin_amdgcn_readfirstlane(tid0 >> 6);
#define PHASE_TID int tid = tid0; asm volatile("" : "+v"(tid)); const int lane = tid & 63; (void)lane;
    const int G = gridDim.x, bx = blockIdx.x;
    const int gw = bx * NWAVES + wave, NGW = G * NWAVES;
    unsigned char* ws = args.ws;
    gu32* ctl = (gu32*)(ws + WS_CTL);
    for (int u = tid0; u < (LDS_BYTES - LDSCTL_OFF) / 4; u += NTHR) ((LAS unsigned*)(lds + LDSCTL_OFF))[u] = 0u;
    __syncthreads();
    XcdBarrier bar; bar.bar = (unsigned*)ctl + CW_BAR; bar.x = 0; bar.st = nullptr;
    if (MK_ONE_LAUNCH) bar = xcd_barrier_post((unsigned*)ctl + CW_BAR, LCTL);
    const int lo = args.ph_lo, hi = args.ph_hi;
#ifndef SUBMASK
#define SUBMASK 7
#endif
#ifndef SUBDUP
#define SUBDUP 0
#endif
#define NSUB(k) ((((SUBDUP) >> (k)) & 1) ? 2 : 1)
#ifndef DUPMASK
#define DUPMASK 0
#endif
#define NREP(k) ((((DUPMASK) >> (k)) & 1) ? 2 : 1)
#ifndef PHMASK
#define PHMASK 0xFFFF
#endif
#define IN(k) (lo <= (k) && (k) < hi)
#define SEAM(k) do { if (IN(k) && IN((k) + 1)) xcd_barrier(bar); } while (0)

    char* const Xb = (char*)(ws + WS_X);
    char* const Ub = (char*)(ws + WS_R1);
    float* const GIF = (float*)(ws + WS_GIF);
    LAS int* const PB = (LAS int*)(lds + LDSCTL_OFF + 64);
    LAS int* const CNT = (LAS int*)(lds + LDSCTL_OFF + 256);

    _Pragma("unroll 1") for (int rep_ = 0; rep_ < NREP(12); ++rep_) if (((PHMASK>>12)&1) && IN(0)) { PHASE_TID
        LAS float* scr = (LAS float*)(lds + wave * 8448);
        LAS float* wgt = (LAS float*)(lds + 73728);
        load_gate_table(wgt, args.in[I_WIN], tid);
        constexpr int IT_IN = 16 * 216, IT_KV = 16 * 32, IT_BR = 8 * 32, IT_O = 16 * 32, IT_L = IT_IN + IT_KV + 3 * IT_BR + IT_O;
        for (int it = gw; it < DEPTH * IT_L; it += NGW) {
            const int l = it / IT_L; int r = it - l * IT_L;
            if (r < IT_IN) { const int kb = r / 216, nb = r % 216, n0 = 32 * nb, sc = n0 + (n0 >= 1536 ? 8 : 0);
                transpose_item(args.in[I_WIN] + ((size_t)l * D + 64 * kb) * DIN + sc, DIN, (bf16*)(ws + WS_WIN) + ((size_t)l * NU + n0) * D + 64 * kb, D, scr, lane); continue; }
            r -= IT_IN;
            if (r < IT_KV) { const int kb = r / 32, nb = r % 32;
                transpose_item(args.in[I_CAWKV] + ((size_t)l * D + 64 * kb) * 1024 + 32 * nb, 1024, (bf16*)(ws + WS_WKV) + ((size_t)l * 1024 + 32 * nb) * D + 64 * kb, D, scr, lane); continue; }
            r -= IT_KV;
            if (r < 3 * IT_BR) { const int br = r / IT_BR, q = r % IT_BR, kb = q / 32, nb = q % 32;
                const float* src = args.in[br == 0 ? I_WBRML : (br == 1 ? I_WBRRW : I_WBRCA)];
                transpose_item(src + ((size_t)l * 512 + 64 * kb) * 1024 + 32 * nb, 1024, (bf16*)(ws + WS_WBR) + (((size_t)l * 3 + br) * 1024 + 32 * nb) * 512 + 64 * kb, 512, scr, lane); continue; }
            r -= 3 * IT_BR;
            { const int kb = r / 32, nb = r % 32;
                transpose_item(args.in[I_WO] + ((size_t)l * D + 64 * kb) * 1024 + 32 * nb, 1024, (bf16*)(ws + WS_WO) + ((size_t)l * 1024 + 32 * nb) * D + 64 * kb, D, scr, lane); }
        }
        for (int i = bx * NTHR + tid; i < DEPTH * 1536 * 256; i += G * NTHR) {
            const int l = i / (1536 * 256), r = i % (1536 * 256), n = r >> 8, k = r & 255; float v = 0.f;
            if (n < 512) { if (k < 64) v = args.in[I_RWWUP][((size_t)l * 64 + k) * 512 + n]; }
            else if (n < 1024) { if (k >= 64 && k < 128) v = args.in[I_RWAUP][((size_t)l * 64 + (k - 64)) * 512 + (n - 512)]; }
            else { if (k >= 128) v = args.in[I_RWGUP][((size_t)l * 128 + (k - 128)) * 512 + (n - 1024)]; }
            ((bf16*)(ws + WS_WLORA))[i] = (bf16)f2bf(v);
        }
        __syncthreads();
        {
            f32x4 g[4], b[4];
#pragma unroll
            for (int j = 0; j < 4; ++j) { g[j] = *(const f32x4*)(args.in[I_LNIN_G] + 256 * j + 4 * lane); b[j] = *(const f32x4*)(args.in[I_LNIN_B] + 256 * j + 4 * lane); }
            for (int m = gw; m < M; m += NGW) {
                f32x4 v[4]; const float* xr = args.in[I_X] + (size_t)m * D;
#pragma unroll
                for (int j = 0; j < 4; ++j) v[j] = *(const f32x4*)(xr + 256 * j + 4 * lane);
                ln16(v, g, b);
#pragma unroll
                for (int j = 0; j < 4; ++j) st4bf(Xb + ((size_t)m * D + 256 * j + 4 * lane) * 2, v[j]);
                gates8(v, wgt, GIF + (size_t)m * 8, lane);
            }
#pragma unroll
            for (int j = 0; j < 4; ++j) { g[j] = *(const f32x4*)(args.in[I_MEMLN_G] + 256 * j + 4 * lane); b[j] = *(const f32x4*)(args.in[I_MEMLN_B] + 256 * j + 4 * lane); }
            for (int m = gw; m < MROWS; m += NGW) {
                f32x4 v[4]; const float* xr = args.in[I_MEM] + (size_t)m * D;
#pragma unroll
                for (int j = 0; j < 4; ++j) v[j] = *(const f32x4*)(xr + 256 * j + 4 * lane);
                ln16(v, g, b);
#pragma unroll
                for (int j = 0; j < 4; ++j) st4bf((char*)(ws + WS_MEMN) + ((size_t)m * D + 256 * j + 4 * lane) * 2, v[j]);
            }
        }
        __syncthreads();
    }
    SEAM(0);

#pragma unroll 1
    for (int l = 0; l < DEPTH; ++l) {
        const int pb = 1 + l * NP_LAYER;
        _Pragma("unroll 1") for (int rep_ = 0; rep_ < NREP(0); ++rep_) if (((PHMASK>>0)&1) && IN(pb + 0)) {
            SchedInproj S; S.T.init(M / 256, NU / 256); S.G = G; S.c = bx; S.X = Xb; S.W = (const char*)(ws + WS_WIN) + (size_t)l * NU * D * 2; S.U = Ub;
            S.kv = (l == 0); S.MEMN = (const char*)(ws + WS_MEMN); S.WKV = (const char*)(ws + WS_WKV); S.KV = (char*)(ws + WS_KV);
            pg8::EpiStore E;
            pg8::gemm_phase<false>(lds, D * 2, D * 2, D * 2, S, E);
        }
        SEAM(pb + 0);
        _Pragma("unroll 1") for (int rep_ = 0; rep_ < NREP(1); ++rep_) if (((PHMASK>>1)&1) && IN(pb + 1)) { PHASE_TID
            const float* mu = args.in[I_RWMU] + (size_t)l * 1792 + 1536;
            char* LIN = (char*)(ws + WS_R2 + R2_LORA_IN);
            for (int it = bx * NTHR + tid; it < M * 32; it += G * NTHR) {
                const int row = it >> 5, c = (it & 31) * 8;
                const u32x4 cw = *(const u32x4*)(Ub + ((size_t)row * NU + UC_RW + 1536 + c) * 2);
                u32x4 pw = (u32x4){0u, 0u, 0u, 0u};
                if ((row & (SEQ - 1)) != 0) pw = *(const u32x4*)(Ub + ((size_t)(row - 1) * NU + UC_RW + 1536 + c) * 2);
                const f32x4 m0 = *(const f32x4*)(mu + c), m1 = *(const f32x4*)(mu + c + 4);
                float x[8] = {bflo(cw.x), bfhi(cw.x), bflo(cw.y), bfhi(cw.y), bflo(cw.z), bfhi(cw.z), bflo(cw.w), bfhi(cw.w)};
                const float p[8] = {bflo(pw.x), bfhi(pw.x), bflo(pw.y), bfhi(pw.y), bflo(pw.z), bfhi(pw.z), bflo(pw.w), bfhi(pw.w)};
                const float mm[8] = {m0.x, m0.y, m0.z, m0.w, m1.x, m1.y, m1.z, m1.w};
#pragma unroll
                for (int i = 0; i < 8; ++i) { float xs = x[i] + (p[i] - x[i]) * mm[i];
                    if (c < 64) xs = 1.f - 2.f * __builtin_amdgcn_rcpf(1.f + __builtin_amdgcn_exp2f(2.8853900817779268f * xs));
                    else if (c >= 128) xs = sigmoidf_(xs);
                    x[i] = xs; }
                u32x4 o; o.x = pk2(x[0], x[1]); o.y = pk2(x[2], x[3]); o.z = pk2(x[4], x[5]); o.w = pk2(x[6], x[7]);
                *(u32x4*)(LIN + ((size_t)row * 256 + c) * 2) = o;
            }
        }
        SEAM(pb + 1);
        _Pragma("unroll 1") for (int rep_ = 0; rep_ < NREP(2); ++rep_) if (((PHMASK>>2)&1) && IN(pb + 2)) {
            SchedPlain S; S.T.init(M / 256, 6); S.G = G; S.c = bx; S.A = (const char*)(ws + WS_R2 + R2_LORA_IN); S.B = (const char*)(ws + WS_WLORA) + (size_t)l * 1536 * 256 * 2; S.C = (char*)(ws + WS_R2 + R2_LORA_OUT);
            S.lda = 256; S.ldb = 256; S.ldc = 1536;
            pg8::EpiStore E;
            pg8::gemm_phase<false>(lds, 512, 512, 512, S, E);
        }
        SEAM(pb + 2);
        _Pragma("unroll 1") for (int rep_ = 0; rep_ < NREP(3); ++rep_) if (((PHMASK>>3)&1) && IN(pb + 3)) { PHASE_TID
            const char* LO = (const char*)(ws + WS_R2 + R2_LORA_OUT);
            char* HC = (char*)(ws + WS_R2 + R2_HCAT);
            const int tid_ph = tid;
#define SUB_TID int tid = tid_ph; asm volatile("" : "+v"(tid)); const int lane = tid & 63; (void)lane;
#pragma unroll 1
            for (int job = bx; job < 256; job += G) {
                if (job < 128) { _Pragma("unroll 1") for (int sr_ = 0; sr_ < NSUB(0); ++sr_) if ((SUBMASK>>0)&1) {
                    SUB_TID
                    const int b = job >> 3, h = job & 7;
                    constexpr int TC = 64;
                    LAS float* OPS = (LAS float*)lds;
                    LAS float* OUTB = OPS + TC * 384;
                    LAS float* BON = OUTB + TC * 64;
                    LAS float* C12 = BON + TC;
                    LAS float* PREV = C12 + 2 * TC;
                    const int pt = tid >> 4, cs = tid & 15, pc = cs * 4, hc = h * 64 + pc;
                    if (tid < 192) PREV[tid] = 0.f;
                    f32x4 S0 = (f32x4){0.f, 0.f, 0.f, 0.f}, S1 = S0, So0 = S0, So1 = S0; float sap0 = 0.f, sap1 = 0.f; f32x2 vprev = (f32x2){0.f, 0.f};
                    u32x2 pu[2][9];
                    auto LOADC = [&](int t0) {
#pragma unroll
                        for (int tt = 0; tt < 2; ++tt) { const int t = t0 + pt + 32 * tt; const size_t row = (size_t)b * SEQ + t; const char* up = Ub + (row * NU + UC_RW + hc) * 2;
                            pu[tt][0] = *(const u32x2*)up; pu[tt][1] = *(const u32x2*)(up + 1024); pu[tt][2] = *(const u32x2*)(up + 2048);
                            if (t > 0) { const char* pp = up - (size_t)NU * 2; pu[tt][3] = *(const u32x2*)pp; pu[tt][4] = *(const u32x2*)(pp + 1024); pu[tt][5] = *(const u32x2*)(pp + 2048); }
                            else { pu[tt][3] = (u32x2){0u, 0u}; pu[tt][4] = pu[tt][3]; pu[tt][5] = pu[tt][3]; }
                            const char* lp = LO + (row * 1536 + hc) * 2; pu[tt][6] = *(const u32x2*)lp; pu[tt][7] = *(const u32x2*)(lp + 1024); pu[tt][8] = *(const u32x2*)(lp + 2048); }
                    };
#define UNP4(w) ((f32x4){bflo((w).x), bfhi((w).x), bflo((w).y), bfhi((w).y)})
#define DOT4(a, b) (((a).x * (b).x + (a).y * (b).y) + ((a).z * (b).z + (a).w * (b).w))
                    LOADC(0);
#pragma unroll 1
                    for (int t0 = 0; t0 < SEQ; t0 += TC) {
                        f32x4 gk[2];
                        int hcv = hc; asm volatile("" : "+v"(hcv));
                        const f32x4 mu_r = *(const f32x4*)(args.in[I_RWMU] + (size_t)l * 1792 + hcv), mu_k = *(const f32x4*)(args.in[I_RWMU] + (size_t)l * 1792 + 512 + hcv), mu_v = *(const f32x4*)(args.in[I_RWMU] + (size_t)l * 1792 + 1024 + hcv);
                        const f32x4 w0 = *(const f32x4*)(args.in[I_RWW0] + l * 512 + hcv), a0 = *(const f32x4*)(args.in[I_RWA0] + l * 512 + hcv), kkw = *(const f32x4*)(args.in[I_RWKK] + l * 512 + hcv);
                        const f32x4 kaw = *(const f32x4*)(args.in[I_RWKA] + l * 512 + hcv), rkw = *(const f32x4*)(args.in[I_RWRK] + l * 512 + hcv);
#pragma unroll
                        for (int tt = 0; tt < 2; ++tt) { const int tok = pt + 32 * tt;
                            const f32x4 ur = UNP4(pu[tt][0]), uk = UNP4(pu[tt][1]), uv = UNP4(pu[tt][2]), urp = UNP4(pu[tt][3]), ukp = UNP4(pu[tt][4]), uvp = UNP4(pu[tt][5]), lw = UNP4(pu[tt][6]), la = UNP4(pu[tt][7]);
                            gk[tt] = UNP4(pu[tt][8]);
                            const f32x4 xr = ur + (urp - ur) * mu_r, xk = uk + (ukp - uk) * mu_k, xv = uv + (uvp - uv) * mu_v;
                            f32x4 dec, av, kkv, kp; float ss = 0.f, bsum = 0.f;
#pragma unroll
                            for (int i = 0; i < 4; ++i) {
                                const float y = -(w0[i] + lw[i]);
                                const float sp = fmaxf(y, 0.f) + __logf(1.f + __expf(-fabsf(y)));
                                dec[i] = __expf(-__expf(-sp - 0.5f));
                                av[i] = sigmoidf_(a0[i] + la[i]);
                                kkv[i] = xk[i] * kkw[i]; ss += kkv[i] * kkv[i];
                                kp[i] = xk[i] * (1.f + (av[i] - 1.f) * kaw[i]);
                                bsum += xr[i] * kp[i] * rkw[i];
                            }
                            ss = red16(ss); bsum = red16(bsum);
                            const float inv = __builtin_amdgcn_rsqf(fmaxf(ss, 1e-24f));
                            const f32x4 kk = kkv * inv, kka = kk * av;
                            LAS float* o = OPS + tok * 384 + pc;
                            *(LAS f32x4*)(o) = dec; *(LAS f32x4*)(o + 64) = kk; *(LAS f32x4*)(o + 128) = kka; *(LAS f32x4*)(o + 192) = kp; *(LAS f32x4*)(o + 256) = xr; *(LAS f32x4*)(o + 320) = xv;
                            if (cs == 0) BON[tok] = bsum;
                        }
                        if (t0 + TC < SEQ) LOADC(t0 + TC);
                        __syncthreads();
#pragma unroll
                        for (int tt = 0; tt < 2; ++tt) { const int tok = pt + 32 * tt;
                            const LAS float* pr = OPS + (tok - 1) * 384 + pc;
                            f32x4 pw, pkp, pka;
                            if (tok > 0) { pw = *(const LAS f32x4*)pr; pkp = *(const LAS f32x4*)(pr + 192); pka = *(const LAS f32x4*)(pr + 128); }
                            else { pw = *(const LAS f32x4*)(PREV + pc); pkp = *(const LAS f32x4*)(PREV + 64 + pc); pka = *(const LAS f32x4*)(PREV + 128 + pc); }
                            LAS float* zp = OPS + tok * 384 + 64 + pc;
                            const f32x4 z = *(const LAS f32x4*)zp;
                            const float c1 = red16(DOT4(pkp, z)), c2 = red16(DOT4(pka, z));
                            *(LAS f32x4*)zp = pw * z;
                            if (cs == 0) *(LAS f32x2*)(C12 + 2 * tok) = (f32x2){c1, c2};
                        }
                        __syncthreads();
                        {
                            const LAS float* qb = OPS + pc; const LAS float* vb = OPS + 320 + 2 * pt;
                            float dc0, dc1;
                            { const f32x4 y0 = *(const LAS f32x4*)(qb + 64); dc0 = red16(DOT4(So0, y0)); dc1 = red16(DOT4(So1, y0)); }
                            f32x4 w4 = *(const LAS f32x4*)(qb), ka4 = *(const LAS f32x4*)(qb + 128), kp4 = *(const LAS f32x4*)(qb + 192), r4 = *(const LAS f32x4*)(qb + 256), yn = *(const LAS f32x4*)(qb + 384 + 64);
                            f32x2 v2 = *(const LAS f32x2*)vb, c12 = *(const LAS f32x2*)C12;
#define RW_STEP(s, LASTSTEP) do { \
                                const int s1 = (s) + 1 < TC ? (s) + 1 : TC - 1, s2 = (s) + 2 < TC ? (s) + 2 : TC - 1; \
                                const f32x4 nw4 = *(const LAS f32x4*)(qb + s1 * 384), nka4 = *(const LAS f32x4*)(qb + s1 * 384 + 128), nkp4 = *(const LAS f32x4*)(qb + s1 * 384 + 192), nr4 = *(const LAS f32x4*)(qb + s1 * 384 + 256), nyn = *(const LAS f32x4*)(qb + s2 * 384 + 64); \
                                const f32x2 nv2 = *(const LAS f32x2*)(vb + s1 * 384), nc12 = *(const LAS f32x2*)(C12 + 2 * s1); \
                                const float sa0 = dc0 + (vprev.x * c12.x - sap0 * c12.y), sa1 = dc1 + (vprev.y * c12.x - sap1 * c12.y); \
                                float dn0 = 0.f, dn1 = 0.f; \
                                if (LASTSTEP) { So0 = S0; So1 = S1; } else { dn0 = red16(DOT4(S0, yn)); dn1 = red16(DOT4(S1, yn)); } \
                                S0 = S0 * w4 + (kp4 * v2.x - ka4 * sa0); S1 = S1 * w4 + (kp4 * v2.y - ka4 * sa1); \
                                float o0 = red16(DOT4(S0, r4)), o1 = red16(DOT4(S1, r4)); \
                                if (cs == 0) *(LAS f32x2*)(OUTB + (s) * 64 + 2 * pt) = (f32x2){o0, o1}; \
                                sap0 = sa0; sap1 = sa1; vprev = v2; dc0 = dn0; dc1 = dn1; \
                                w4 = nw4; ka4 = nka4; kp4 = nkp4; r4 = nr4; yn = nyn; v2 = nv2; c12 = nc12; __builtin_amdgcn_sched_barrier(0); } while (0)
#pragma unroll 1
                            for (int s = 0; s < TC - 2; s += 2) { RW_STEP(s, false); RW_STEP(s + 1, false); }
                            RW_STEP(TC - 2, false);
                            RW_STEP(TC - 1, true);
#undef RW_STEP
                        }
                        __syncthreads();
                        int hcw = hc; asm volatile("" : "+v"(hcw));
                        const f32x4 lng = *(const f32x4*)(args.in[I_RWLNG] + l * 512 + hcw), lnb = *(const f32x4*)(args.in[I_RWLNB] + l * 512 + hcw);
#pragma unroll
                        for (int tt = 0; tt < 2; ++tt) { const int tok = pt + 32 * tt;
                            const f32x4 o4 = *(const LAS f32x4*)(OUTB + tok * 64 + pc), v4 = *(const LAS f32x4*)(OPS + tok * 384 + 320 + pc);
                            const float mean = red16((o4.x + o4.y) + (o4.z + o4.w)) * (1.f / 64.f);
                            const f32x4 dv = o4 - mean;
                            const float var = red16(DOT4(dv, dv)) * (1.f / 64.f);
                            const float rstd = __builtin_amdgcn_rsqf(var + RW_GN_EPS), bo = BON[tok];
                            const f32x4 y = (dv * rstd * lng + lnb + v4 * bo) * gk[tt];
                            st4bf(HC + (((size_t)b * SEQ + t0 + tok) * 1536 + 512 + hc) * 2, y);
                        }
                        if (tid < 192) { const int j = tid >> 6, c = tid & 63; PREV[tid] = OPS[(TC - 1) * 384 + (j == 0 ? 0 : (j == 1 ? 192 : 128)) + c]; }
                        __syncthreads();
                    }
                } } else {
                    const int idx = job - 128, bh = idx >> 1, half = idx & 1, b = bh >> 2, h = bh & 3;
                    _Pragma("unroll 1") for (int sr_ = 0; sr_ < NSUB(1); ++sr_) if ((SUBMASK>>1)&1) {
                        SUB_TID
                        constexpr int TC = 64;
                        LAS float* QK = (LAS float*)lds;
                        LAS float* VV = QK + TC * 128;
                        LAS float* FI = VV + TC * 64;
                        LAS float* NUM = FI + TC * 4;
                        LAS float* DENP = NUM + TC * 64;
                        const int pt = tid >> 4, cg = tid & 15;
                        const int ccol = (cg < 8) ? (h * 64 + 8 * cg) : (256 + h * 64 + 8 * (cg - 8));
                        float cw[4][8], cb[8];
#pragma unroll
                        for (int j = 0; j < 4; ++j) { const f32x4 a = *(const f32x4*)(args.in[I_CONVW] + ((size_t)l * 4 + j) * 512 + ccol), c2 = *(const f32x4*)(args.in[I_CONVW] + ((size_t)l * 4 + j) * 512 + ccol + 4);
                            cw[j][0] = a.x; cw[j][1] = a.y; cw[j][2] = a.z; cw[j][3] = a.w; cw[j][4] = c2.x; cw[j][5] = c2.y; cw[j][6] = c2.z; cw[j][7] = c2.w; }
                        { const f32x4 a = *(const f32x4*)(args.in[I_CONVB] + l * 512 + ccol), c2 = *(const f32x4*)(args.in[I_CONVB] + l * 512 + ccol + 4);
                            cb[0] = a.x; cb[1] = a.y; cb[2] = a.z; cb[3] = a.w; cb[4] = c2.x; cb[5] = c2.y; cb[6] = c2.z; cb[7] = c2.w; }
                        const float qsc = (cg < 8) ? 0.125f : 1.f;
                        const float igb = args.in[I_IGB][l * 4 + h], fgb = args.in[I_FGB][l * 4 + h];
                        const int r = tid >> 3, cs8 = (tid & 7) * 8;
                        const int ne = 8 * wave + (lane & 7);
                        float C[8] = {0.f, 0.f, 0.f, 0.f, 0.f, 0.f, 0.f, 0.f}; float nreg = 0.f, mprev = 0.f;
                        u32x4 cu[2][4]; u32x2 vu[2]; float gi = 0.f, gf = 0.f;
                        auto LOADM = [&](int t0) {
#pragma unroll
                            for (int tt = 0; tt < 2; ++tt) { const int t = t0 + pt + 32 * tt; const size_t row = (size_t)b * SEQ + t;
#pragma unroll
                                for (int j = 0; j < 4; ++j) { if (t - 3 + j >= 0) cu[tt][j] = *(const u32x4*)(Ub + ((row - 3 + j) * NU + UC_QK + ccol) * 2); else cu[tt][j] = (u32x4){0u, 0u, 0u, 0u}; }
                                vu[tt] = *(const u32x2*)(Ub + (row * NU + UC_V + h * 128 + half * 64 + 4 * cg) * 2); }
                            if (wave == 0) { const size_t rg = (size_t)b * SEQ + t0 + lane; gi = GIF[rg * 8 + h]; gf = GIF[rg * 8 + 4 + h]; }
                        };
                        LOADM(0);
#pragma unroll 1
                        for (int t0 = 0; t0 < SEQ; t0 += TC) {
#pragma unroll
                            for (int tt = 0; tt < 2; ++tt) { const int tok = pt + 32 * tt; float y[8];
#pragma unroll
                                for (int i = 0; i < 8; ++i) y[i] = cb[i];
#pragma unroll
                                for (int j = 0; j < 4; ++j) { const u32x4 w = cu[tt][j]; const float x[8] = {bflo(w.x), bfhi(w.x), bflo(w.y), bfhi(w.y), bflo(w.z), bfhi(w.z), bflo(w.w), bfhi(w.w)};
#pragma unroll
                                    for (int i = 0; i < 8; ++i) y[i] += cw[j][i] * x[i]; }
#pragma unroll
                                for (int i = 0; i < 8; ++i) y[i] = y[i] * sigmoidf_(y[i]) * qsc;
                                LAS float* o = QK + tok * 128 + 8 * cg;
                                *(LAS f32x4*)o = (f32x4){y[0], y[1], y[2], y[3]}; *(LAS f32x4*)(o + 4) = (f32x4){y[4], y[5], y[6], y[7]};
                                *(LAS f32x4*)(VV + tok * 64 + 4 * cg) = (f32x4){bflo(vu[tt].x), bfhi(vu[tt].x), bflo(vu[tt].y), bfhi(vu[tt].y)};
                            }
                            if (wave == 0) {
                                const float ig = gi + igb, fp = gf + fgb;
                                const float lf = -(fmaxf(-fp, 0.f) + __logf(1.f + __expf(-fabsf(fp))));
                                float bc = lf;
#pragma unroll
                                for (int o = 1; o < 64; o <<= 1) { const float t = __shfl_up(bc, o); if (lane >= o) bc += t; }
                                float pm = ig - bc;
#pragma unroll
                                for (int o = 1; o < 64; o <<= 1) { const float t = __shfl_up(pm, o); if (lane >= o) pm = fmaxf(pm, t); }
                                const float mt = bc + fmaxf(mprev, pm);
                                float mp1 = __shfl_up(mt, 1); if (lane == 0) mp1 = mprev;
                                const float fpr = __expf(lf + mp1 - mt), ipr = __expf(ig - mt), em = __expf(-mt);
                                *(LAS f32x4*)(FI + lane * 4) = (f32x4){fpr, ipr, em, 0.f};
                                mprev = __shfl(mt, 63);
                            }
                            if (t0 + TC < SEQ) LOADM(t0 + TC);
                            __syncthreads();
                            {
                                const LAS float* qp0 = QK + cs8;
                                f32x4 q0 = *(const LAS f32x4*)qp0, q1 = *(const LAS f32x4*)(qp0 + 4), k0 = *(const LAS f32x4*)(qp0 + 64), k1 = *(const LAS f32x4*)(qp0 + 68), fi = *(const LAS f32x4*)FI;
                                float vv = VV[r], nk = QK[64 + ne], nq = QK[ne];
#pragma unroll 1
                                for (int s = 0; s < TC; ++s) {
                                    const int s1 = s + 1 < TC ? s + 1 : TC - 1; const LAS float* qp = qp0 + s1 * 128;
                                    const f32x4 nq0 = *(const LAS f32x4*)qp, nq1 = *(const LAS f32x4*)(qp + 4), nk0 = *(const LAS f32x4*)(qp + 64), nk1 = *(const LAS f32x4*)(qp + 68), nfi = *(const LAS f32x4*)(FI + s1 * 4);
                                    const float nvv = VV[s1 * 64 + r], nnk = QK[s1 * 128 + 64 + ne], nnq = QK[s1 * 128 + ne];
                                    const float tv = fi.y * vv;
                                    C[0] = fi.x * C[0] + tv * k0.x; C[1] = fi.x * C[1] + tv * k0.y; C[2] = fi.x * C[2] + tv * k0.z; C[3] = fi.x * C[3] + tv * k0.w;
                                    C[4] = fi.x * C[4] + tv * k1.x; C[5] = fi.x * C[5] + tv * k1.y; C[6] = fi.x * C[6] + tv * k1.z; C[7] = fi.x * C[7] + tv * k1.w;
                                    float p = ((C[0] * q0.x + C[1] * q0.y) + (C[2] * q0.z + C[3] * q0.w)) + ((C[4] * q1.x + C[5] * q1.y) + (C[6] * q1.z + C[7] * q1.w));
                                    p = red8(p);
                                    nreg = fi.x * nreg + fi.y * nk;
                                    const float dp = red8(nreg * nq);
                                    if ((tid & 7) == 0) NUM[s * 64 + r] = p;
                                    if (lane == 0) DENP[s * 8 + wave] = dp;
                                    q0 = nq0; q1 = nq1; k0 = nk0; k1 = nk1; fi = nfi; vv = nvv; nk = nnk; nq = nnq;
                                }
                            }
                            __syncthreads();
#pragma unroll
                            for (int tt = 0; tt < 2; ++tt) { const int tok = pt + 32 * tt;
                                const f32x4 d0 = *(const LAS f32x4*)(DENP + tok * 8), d1 = *(const LAS f32x4*)(DENP + tok * 8 + 4);
                                const float den = ((d0.x + d0.y) + (d0.z + d0.w)) + ((d1.x + d1.y) + (d1.z + d1.w)), em = FI[tok * 4 + 2];
                                const float rdn = 1.f / fmaxf(fabsf(den), em);
                                const f32x4 nv = *(const LAS f32x4*)(NUM + tok * 64 + 4 * cg);
                                st4bf((char*)(ws + WS_HML) + (((size_t)b * SEQ + t0 + tok) * 512 + h * 128 + half * 64 + 4 * cg) * 2, nv * rdn);
                            }
                            __syncthreads();
                        }
                    }
                    _Pragma("unroll 1") for (int sr_ = 0; sr_ < NSUB(2); ++sr_) if ((SUBMASK>>2)&1) {
                        SUB_TID
                        constexpr int KST = 272, VST = 520;
                        LAS unsigned char* KI = lds; LAS unsigned char* VI = lds + 256 * KST;
                        const char* kvb = (const char*)(ws + WS_KV) + (((size_t)l * MROWS + (size_t)b * MEML) * D) * 2;
                        for (int p = tid; p < 4096; p += NTHR) { const int key = p >> 4, c16 = p & 15;
                            *(LAS u32x4*)(KI + key * KST + c16 * 16) = *(const u32x4*)(kvb + ((size_t)key * D + h * 128 + c16 * 8) * 2); }
                        for (int p = tid; p < 4096; p += NTHR) { const int key = p & 255, d8 = p >> 8;
                            const u32x4 w = *(const u32x4*)(kvb + ((size_t)key * D + 512 + h * 128 + d8 * 8) * 2);
                            LAS unsigned char* o = VI + (d8 * 8) * VST + key * 2;
                            *(LAS bf16*)(o) = (bf16)(w.x & 0xffff); *(LAS bf16*)(o + VST) = (bf16)(w.x >> 16); *(LAS bf16*)(o + 2 * VST) = (bf16)(w.y & 0xffff); *(LAS bf16*)(o + 3 * VST) = (bf16)(w.y >> 16);
                            *(LAS bf16*)(o + 4 * VST) = (bf16)(w.z & 0xffff); *(LAS bf16*)(o + 5 * VST) = (bf16)(w.z >> 16); *(LAS bf16*)(o + 6 * VST) = (bf16)(w.w & 0xffff); *(LAS bf16*)(o + 7 * VST) = (bf16)(w.w >> 16); }
                        __syncthreads();
                        const int r31 = lane & 31, h2 = lane >> 5;
                        constexpr float SC = 0.08838834764831845f * 1.4426950408889634f;
#pragma unroll 1
                        for (int rd = 0; rd < 8; ++rd) {
                            const size_t qrow = (size_t)b * SEQ + half * 2048 + rd * 256 + wave * 32 + r31;
                            bf16x8 qf[8];
#pragma unroll
                            for (int ks = 0; ks < 8; ++ks) qf[ks] = *(const bf16x8*)(Ub + (qrow * NU + UC_CAQ + h * 128 + 16 * ks + 8 * h2) * 2);
                            f32x16 O[4];
#pragma unroll
                            for (int db = 0; db < 4; ++db)
#pragma unroll
                                for (int i = 0; i < 16; ++i) O[db][i] = 0.f;
                            float mrun = -1e30f, lrun = 0.f;
#pragma unroll 1
                            for (int hf = 0; hf < 2; ++hf) {
                                f32x16 X[4];
#pragma unroll
                                for (int kb = 0; kb < 4; ++kb) {
                                    bf16x8 kf[8];
#pragma unroll
                                    for (int ks = 0; ks < 8; ++ks) kf[ks] = *(const LAS bf16x8*)(KI + (hf * 128 + kb * 32 + r31) * KST + (16 * ks + 8 * h2) * 2);
                                    __builtin_amdgcn_sched_barrier(0);
#pragma unroll
                                    for (int i = 0; i < 16; ++i) X[kb][i] = 0.f;
#pragma unroll
                                    for (int ks = 0; ks < 8; ++ks) X[kb] = __builtin_amdgcn_mfma_f32_32x32x16_bf16(kf[ks], qf[ks], X[kb], 0, 0, 0);
                                    __builtin_amdgcn_sched_barrier(0);
                                }
                                float mx = -1e30f;
#pragma unroll
                                for (int kb = 0; kb < 4; ++kb)
#pragma unroll
                                    for (int i = 0; i < 16; ++i) mx = fmaxf(mx, X[kb][i]);
                                mx = fmaxf(mx, __shfl_xor(mx, 32));
                                const float mnew = fmaxf(mrun, mx), alpha = __builtin_amdgcn_exp2f((mrun - mnew) * SC);
                                float ls = 0.f;
#pragma unroll
                                for (int kb = 0; kb < 4; ++kb)
#pragma unroll
                                    for (int i = 0; i < 16; ++i) { const float p = __builtin_amdgcn_exp2f((X[kb][i] - mnew) * SC); X[kb][i] = p; ls += p; }
                                ls += __shfl_xor(ls, 32);
                                lrun = lrun * alpha + ls; mrun = mnew;
#pragma unroll
                                for (int db = 0; db < 4; ++db)
#pragma unroll
                                    for (int i = 0; i < 16; ++i) O[db][i] *= alpha;
#pragma unroll
                                for (int kb = 0; kb < 4; ++kb) {
                                    bf16x8 vf[2][4], pf[2];
#pragma unroll
                                    for (int s = 0; s < 2; ++s) {
                                        u32x4 pw; pw.x = pk2(X[kb][8 * s], X[kb][8 * s + 1]); pw.y = pk2(X[kb][8 * s + 2], X[kb][8 * s + 3]); pw.z = pk2(X[kb][8 * s + 4], X[kb][8 * s + 5]); pw.w = pk2(X[kb][8 * s + 6], X[kb][8 * s + 7]);
                                        pf[s] = __builtin_bit_cast(bf16x8, pw);
#pragma unroll
                                        for (int db = 0; db < 4; ++db) {
                                            const LAS unsigned char* vp = VI + (db * 32 + r31) * VST + (hf * 128 + kb * 32 + 16 * s + 4 * h2) * 2;
                                            const u32x2 lo = *(const LAS u32x2*)vp, hi = *(const LAS u32x2*)(vp + 16);
                                            vf[s][db] = __builtin_bit_cast(bf16x8, (u32x4){lo.x, lo.y, hi.x, hi.y});
                                        }
                                    }
                                    __builtin_amdgcn_sched_barrier(0);
#pragma unroll
                                    for (int s = 0; s < 2; ++s)
#pragma unroll
                                        for (int db = 0; db < 4; ++db) O[db] = __builtin_amdgcn_mfma_f32_32x32x16_bf16(vf[s][db], pf[s], O[db], 0, 0, 0);
                                    __builtin_amdgcn_sched_barrier(0);
                                }
                            }
                            const float rl = 1.f / lrun;
                            char* op = HC + (qrow * 1536 + 1024 + h * 128) * 2;
#pragma unroll
                            for (int db = 0; db < 4; ++db)
#pragma unroll
                                for (int g4 = 0; g4 < 4; ++g4) { u32x2 w; w.x = pk2(O[db][4 * g4] * rl, O[db][4 * g4 + 1] * rl); w.y = pk2(O[db][4 * g4 + 2] * rl, O[db][4 * g4 + 3] * rl);
                                    *(u32x2*)(op + (db * 32 + 8 * g4 + 4 * h2) * 2) = w; }
                        }
                        __syncthreads();
                    }
                }
            }
#undef UNP4
#undef DOT4
#undef SUB_TID
        }
        SEAM(pb + 3);
        _Pragma("unroll 1") for (int rep_ = 0; rep_ < NREP(4); ++rep_) if (((PHMASK>>4)&1) && IN(pb + 4)) { PHASE_TID
            char* HC = (char*)(ws + WS_R2 + R2_HCAT);
            const int hd = lane >> 4, sb = (lane & 15) * 8;
            const f32x4 g0 = *(const f32x4*)(args.in[I_MLNORMG] + l * 512 + hd * 128 + sb), g1 = *(const f32x4*)(args.in[I_MLNORMG] + l * 512 + hd * 128 + sb + 4);
            for (int m = gw; m < M; m += NGW) {
                const u32x4 hw = *(const u32x4*)((const char*)(ws + WS_HML) + ((size_t)m * 512 + hd * 128 + sb) * 2);
                const u32x4 ow = *(const u32x4*)(Ub + ((size_t)m * NU + UC_OG + hd * 128 + sb) * 2);
                float v[8] = {bflo(hw.x), bfhi(hw.x), bflo(hw.y), bfhi(hw.y), bflo(hw.z), bfhi(hw.z), bflo(hw.w), bfhi(hw.w)};
                const float og[8] = {bflo(ow.x), bfhi(ow.x), bflo(ow.y), bfhi(ow.y), bflo(ow.z), bfhi(ow.z), bflo(ow.w), bfhi(ow.w)};
                const float gg[8] = {g0.x, g0.y, g0.z, g0.w, g1.x, g1.y, g1.z, g1.w};
                float s = 0.f;
#pragma unroll
                for (int i = 0; i < 8; ++i) s += v[i];
                const float mean = red16(s) * (1.f / 128.f); float s2 = 0.f;
#pragma unroll
                for (int i = 0; i < 8; ++i) { v[i] -= mean; s2 += v[i] * v[i]; }
                const float rstd = 1.f / sqrtf(red16(s2) * (1.f / 128.f) + LN_EPS);
#pragma unroll
                for (int i = 0; i < 8; ++i) v[i] = sigmoidf_(og[i]) * (v[i] * rstd * gg[i]);
                u32x4 o; o.x = pk2(v[0], v[1]); o.y = pk2(v[2], v[3]); o.z = pk2(v[4], v[5]); o.w = pk2(v[6], v[7]);
                *(u32x4*)(HC + ((size_t)m * 1536 + hd * 128 + sb) * 2) = o;
            }
        }
        SEAM(pb + 4);
        _Pragma("unroll 1") for (int rep_ = 0; rep_ < NREP(5); ++rep_) if (((PHMASK>>5)&1) && IN(pb + 5)) {
            SchedMerge S; S.T.init(M / 256, 4); S.G = G; S.c = bx; S.H = (const char*)(ws + WS_R2 + R2_HCAT); S.W = (const char*)(ws + WS_WBR) + (size_t)l * 3 * 1024 * 512 * 2; S.Y = (char*)(ws + WS_R2 + R2_YPRE);
            pg8::EpiMerge E; E.U = Ub; E.gate_b = args.in[I_GATEB] + (size_t)l * 3072;
            pg8::gemm_phase<false>(lds, 1024, 1536 * 2, 512 * 2, S, E);
        }
        SEAM(pb + 5);
        _Pragma("unroll 1") for (int rep_ = 0; rep_ < NREP(6); ++rep_) if (((PHMASK>>6)&1) && IN(pb + 6)) {
            SchedPlain S; S.T.init(M / 256, 4); S.G = G; S.c = bx; S.A = (const char*)(ws + WS_R2 + R2_YPRE); S.B = (const char*)(ws + WS_WO) + (size_t)l * D * D * 2; S.C = (char*)(ws + WS_R2 + R2_Z);
            S.lda = D; S.ldb = D; S.ldc = D;
            pg8::EpiWo E; E.X = Xb;
            pg8::gemm_phase<false>(lds, D * 2, D * 2, D * 2, S, E);
        }
        SEAM(pb + 6);
        _Pragma("unroll 1") for (int rep_ = 0; rep_ < NREP(7); ++rep_) if (((PHMASK>>7)&1) && IN(pb + 7)) { PHASE_TID
            LAS float* WR = (LAS float*)lds;
            for (int i = tid; i < 32768; i += NTHR) { const int k = i >> 5, e = i & 31; WR[e * 1024 + k] = args.in[I_RTW][((size_t)l * D + k) * 32 + e]; }
            __syncthreads();
            f32x4 g[4], bb[4];
#pragma unroll
            for (int j = 0; j < 4; ++j) { g[j] = *(const f32x4*)(args.in[I_LN1G] + l * D + 256 * j + 4 * lane); bb[j] = *(const f32x4*)(args.in[I_LN1B] + l * D + 256 * j + 4 * lane); }
            const float rbias = args.in[I_RTB][l * 32 + (lane & 31)];
            const char* Zb = (const char*)(ws + WS_R2 + R2_Z);
            int* TKE = (int*)(ws + WS_TKE); float* TKG = (float*)(ws + WS_TKG); int* TKP = (int*)(ws + WS_TKP); int* ROWTOK = (int*)(ws + WS_ROWTOK);
            LAS unsigned* LCNT = (LAS unsigned*)(lds + 131072);
            LAS unsigned* GBASE = LCNT + 32; LAS unsigned* LLEN = LCNT + 64; LAS unsigned* LIST = LCNT + 128;
            if (tid < 65) LCNT[tid] = 0u;
            __syncthreads();
#pragma unroll 1
            for (int pp = gw; pp < M / 2; pp += NGW) {
                f32x4 y0[4], y1[4];
#pragma unroll
                for (int j = 0; j < 4; ++j) { y0[j] = ld4bf(Zb + ((size_t)(2 * pp) * D + 256 * j + 4 * lane) * 2); y1[j] = ld4bf(Zb + ((size_t)(2 * pp + 1) * D + 256 * j + 4 * lane) * 2); }
                ln16(y0, g, bb); ln16(y1, g, bb);
#pragma unroll
                for (int j = 0; j < 4; ++j) { st4bf(Xb + ((size_t)(2 * pp) * D + 256 * j + 4 * lane) * 2, y0[j]); st4bf(Xb + ((size_t)(2 * pp + 1) * D + 256 * j + 4 * lane) * 2, y1[j]); }
                float v[64];
#pragma unroll
                for (int e = 0; e < 32; ++e) { float s0 = 0.f, s1 = 0.f;
#pragma unroll
                    for (int j = 0; j < 4; ++j) { const f32x4 w = *(const LAS f32x4*)(WR + e * 1024 + 256 * j + 4 * lane);
                        s0 += (y0[j].x * w.x + y0[j].y * w.y) + (y0[j].z * w.z + y0[j].w * w.w); s1 += (y1[j].x * w.x + y1[j].y * w.y) + (y1[j].z * w.z + y1[j].w * w.w); }
                    v[e] = s0; v[32 + e] = s1; if ((e & 3) == 3) __builtin_amdgcn_sched_barrier(0); }
#pragma unroll
                for (int bsh = 5; bsh >= 0; --bsh) { const int n2 = 1 << bsh; const bool up = (lane >> bsh) & 1;
#pragma unroll
                    for (int i = 0; i < n2; ++i) { const float send = up ? v[i] : v[i + n2], keep = up ? v[i + n2] : v[i]; v[i] = keep + __shfl_xor(send, n2); } }
                float cur = v[0] + rbias;
                const int half = lane >> 5, el = lane & 31;
                float tv[4]; int te[4];
#pragma unroll
                for (int k = 0; k < 4; ++k) { float mx = cur;
#pragma unroll
                    for (int o = 1; o < 32; o <<= 1) mx = fmaxf(mx, __shfl_xor(mx, o));
                    const unsigned long long bal = __ballot(cur == mx); const unsigned hm = (unsigned)(bal >> (32 * half));
                    const int win = __builtin_ctz(hm); tv[k] = mx; te[k] = win; if (el == win) cur = -3.0e38f; }
                const float e1 = __expf(tv[1] - tv[0]), e2 = __expf(tv[2] - tv[0]), e3 = __expf(tv[3] - tv[0]), rs = 1.f / (1.f + e1 + e2 + e3);
                const float gt[4] = {rs, e1 * rs, e2 * rs, e3 * rs};
                const int token = 2 * pp + half;
#pragma unroll
                for (int k = 0; k < 4; ++k) if (el == te[k] && rep_ == 0) {
                    const unsigned lpos = __hip_atomic_fetch_add(LCNT + el, 1u, __ATOMIC_RELAXED, __HIP_MEMORY_SCOPE_WORKGROUP);
                    const unsigned li = __hip_atomic_fetch_add(LLEN, 1u, __ATOMIC_RELAXED, __HIP_MEMORY_SCOPE_WORKGROUP);
                    LIST[2 * li] = (unsigned)(token * 4 + k); LIST[2 * li + 1] = (unsigned)el | (lpos << 8);
                    TKE[token * 4 + k] = el; TKG[token * 4 + k] = gt[k]; }
            }
            __syncthreads();
            if (tid < 32 && rep_ == 0) GBASE[tid] = __hip_atomic_fetch_add((unsigned*)ctl + CW_CNT + (l * 32 + tid) * 64, LCNT[tid], RLX_AGENT);
            __syncthreads();
            if (rep_ == 0) { const unsigned n = LLEN[0];
                for (unsigned i = tid; i < n; i += NTHR) { const unsigned tk = LIST[2 * i], ev = LIST[2 * i + 1], e = ev & 255u, pos = GBASE[e] + (ev >> 8);
                    TKP[tk] = (int)pos; ROWTOK[(size_t)e * M + pos] = (int)(tk >> 2); } }
            __syncthreads();
        }
        SEAM(pb + 7);
        _Pragma("unroll 1") for (int rep_ = 0; rep_ < NREP(8); ++rep_) if (((PHMASK>>8)&1) && IN(pb + 8)) { PHASE_TID
            if (tid < 32) CNT[tid] = (int)__hip_atomic_load((unsigned*)ctl + CW_CNT + (l * 32 + tid) * 64, RLX_AGENT);
            __syncthreads();
            if (tid == 0) { int a = 0; for (int e = 0; e < 32; ++e) { PB[e] = a; a += (CNT[e] + 255) >> 8; } PB[32] = a; }
            __syncthreads();
            const int P = PB[32];
            const int* ROWTOK = (const int*)(ws + WS_ROWTOK);
            char* XD = (char*)(ws + WS_R1);
            for (int s = gw; s < P * 256; s += NGW) {
                const int pm = s >> 8; int e = 0;
#pragma unroll 1
                for (int j = 1; j < NEXP; ++j) e += (PB[j] <= pm) ? 1 : 0;
                const int pos = s - PB[e] * 256;
                if (pos < CNT[e]) { const int tok = ROWTOK[(size_t)e * M + pos];
                    const u32x4 a = *(const u32x4*)(Xb + (size_t)tok * 2048 + lane * 32), b2 = *(const u32x4*)(Xb + (size_t)tok * 2048 + lane * 32 + 16);
                    u32x4 o; o.x = pk4_f8(bflo(a.x) * F8_SX, bfhi(a.x) * F8_SX, bflo(a.y) * F8_SX, bfhi(a.y) * F8_SX); o.y = pk4_f8(bflo(a.z) * F8_SX, bfhi(a.z) * F8_SX, bflo(a.w) * F8_SX, bfhi(a.w) * F8_SX);
                    o.z = pk4_f8(bflo(b2.x) * F8_SX, bfhi(b2.x) * F8_SX, bflo(b2.y) * F8_SX, bfhi(b2.y) * F8_SX); o.w = pk4_f8(bflo(b2.z) * F8_SX, bfhi(b2.z) * F8_SX, bflo(b2.w) * F8_SX, bfhi(b2.w) * F8_SX);
                    *(u32x4*)(XD + (size_t)s * 1024 + lane * 16) = o; }
            }
            LAS float* scr = (LAS float*)(lds + wave * 8448);
            constexpr int IT_GU = 32 * 16 * 64, IT_DN = 32 * 16 * 32;
            for (int it = gw; it < IT_GU + IT_DN; it += NGW) {
                if (it < IT_GU) { const int e = it >> 10, q = it & 1023, kb = q >> 6, nb = q & 63;
                    transpose_item_f8(args.in[I_WGU] + (((size_t)l * 32 + e) * D + 64 * kb) * 2048 + 32 * nb, 2048, (unsigned char*)(ws + WS_WGU) + ((size_t)e * 2048 + 32 * nb) * D + 64 * kb, D, F8_SWGU, scr, lane); }
                else { const int r = it - IT_GU, e = r >> 9, q = r & 511, kb = q >> 5, nb = q & 31;
                    transpose_item_f8(args.in[I_WDN] + (((size_t)l * 32 + e) * D + 64 * kb) * 1024 + 32 * nb, 1024, (unsigned char*)(ws + WS_WDN) + ((size_t)e * 1024 + 32 * nb) * D + 64 * kb, D, F8_SWDN, scr, lane); }
            }
            __syncthreads();
        }
        SEAM(pb + 8);
        if (IN(pb + 9) || IN(pb + 10)) { PHASE_TID
            if (tid < 32) CNT[tid] = (int)__hip_atomic_load((unsigned*)ctl + CW_CNT + (l * 32 + tid) * 64, RLX_AGENT);
            __syncthreads();
            if (tid == 0) { int a = 0; for (int e = 0; e < 32; ++e) { PB[e] = a; a += (CNT[e] + 255) >> 8; } PB[32] = a; }
            __syncthreads();
        }
        _Pragma("unroll 1") for (int rep_ = 0; rep_ < NREP(9); ++rep_) if (((PHMASK>>9)&1) && IN(pb + 9)) {
            SchedMoe S; S.T.init(PB[32], 8); S.G = G; S.c = bx; S.A = (const char*)(ws + WS_R1); S.W = (const char*)(ws + WS_WGU); S.C = (char*)(ws + WS_R2 + R2_HMID); S.PB = PB; S.wrows = 2048; S.ldc = 1024; S.cdiv = 2; S.osz = 1;
            pg8::EpiMoe1 E; E.bgu = args.in[I_BGU] + (size_t)l * 32 * 2048;
            pg8::gemm_phase<true>(lds, D, D, D, S, E);
        }
        SEAM(pb + 9);
        _Pragma("unroll 1") for (int rep_ = 0; rep_ < NREP(10); ++rep_) if (((PHMASK>>10)&1) && IN(pb + 10)) {
            SchedMoe S; S.T.init(PB[32], 4); S.G = G; S.c = bx; S.A = (const char*)(ws + WS_R2 + R2_HMID); S.W = (const char*)(ws + WS_WDN); S.C = (char*)(ws + WS_R1); S.PB = PB; S.wrows = 1024; S.ldc = 1024; S.cdiv = 1; S.osz = 2;
            pg8::EpiMoe2 E; E.bdn = args.in[I_BDN] + (size_t)l * 32 * 1024;
            pg8::gemm_phase<true>(lds, D, D, D, S, E);
        }
        SEAM(pb + 10);
        _Pragma("unroll 1") for (int rep_ = 0; rep_ < NREP(11); ++rep_) if (((PHMASK>>11)&1) && IN(pb + 11)) { PHASE_TID
            if (tid < 32) CNT[tid] = (int)__hip_atomic_load((unsigned*)ctl + CW_CNT + (l * 32 + tid) * 64, RLX_AGENT);
            LAS float* wgt = (LAS float*)(lds + 73728);
            const bool lastl = (l == DEPTH - 1);
            if (!lastl) load_gate_table(wgt, args.in[I_WIN] + (size_t)(l + 1) * D * DIN, tid);
            __syncthreads();
            if (tid == 0) { int a = 0; for (int e = 0; e < 32; ++e) { PB[e] = a; a += (CNT[e] + 255) >> 8; } PB[32] = a; }
            __syncthreads();
            f32x4 g[4], bb[4];
#pragma unroll
            for (int j = 0; j < 4; ++j) { g[j] = *(const f32x4*)(args.in[I_LN2G] + l * D + 256 * j + 4 * lane); bb[j] = *(const f32x4*)(args.in[I_LN2B] + l * D + 256 * j + 4 * lane); }
            const char* YA = (const char*)(ws + WS_R1);
            const bool dummy_ = (rep_ + 1 < NREP(11)); char* const Xo = dummy_ ? (char*)(ws + WS_R2) : Xb; float* const Fo = dummy_ ? (float*)(ws + WS_R2 + 256 * MiB) : args.out; float* const Go = dummy_ ? (float*)(ws + WS_R2 + 200 * MiB) : GIF;
            const int* TKE = (const int*)(ws + WS_TKE); const float* TKG = (const float*)(ws + WS_TKG); const int* TKP = (const int*)(ws + WS_TKP);
            for (int m = gw; m < M; m += NGW) {
                f32x4 v[4];
#pragma unroll
                for (int j = 0; j < 4; ++j) v[j] = ld4bf(Xb + ((size_t)m * D + 256 * j + 4 * lane) * 2) * DN_ALPHA;
#pragma unroll
                for (int k = 0; k < 4; ++k) { const int e = TKE[m * 4 + k], pos = TKP[m * 4 + k]; const float gk = TKG[m * 4 + k];
                    const size_t row = (size_t)PB[e] * 256 + pos;
#pragma unroll
                    for (int j = 0; j < 4; ++j) v[j] = v[j] + ld4bf(YA + (row * D + 256 * j + 4 * lane) * 2) * gk; }
                ln16(v, g, bb);
                if (lastl) {
#pragma unroll
                    for (int j = 0; j < 4; ++j) *(f32x4*)(Fo + (size_t)m * D + 256 * j + 4 * lane) = v[j];
                } else {
#pragma unroll
                    for (int j = 0; j < 4; ++j) st4bf(Xo + ((size_t)m * D + 256 * j + 4 * lane) * 2, v[j]);
                    gates8(v, wgt, Go + (size_t)m * 8, lane);
                }
            }
            __syncthreads();
        }
        SEAM(pb + 11);
    }
#undef IN
#undef SEAM
}

extern "C" void kernel_launch(void* const* d_in, const int* in_sizes, int n_in, void* d_out, int out_size, void* d_ws, size_t ws_size, hipStream_t stream) {
    static int grid = 0;
    if (grid == 0) {
        if (n_in != N_IN || out_size != M * D || ws_size < WS_END) { fprintf(stderr, "kernel_launch: unexpected shapes (n_in %d, out %d, ws %zu)\n", n_in, out_size, ws_size); grid = -1; return; }
        int dev = 0, cus = 0, per_cu = 0;
        if (hipGetDevice(&dev) != hipSuccess || hipDeviceGetAttribute(&cus, hipDeviceAttributeMultiprocessorCount, dev) != hipSuccess) { grid = -1; return; }
        if (hipFuncSetAttribute((const void*)fwd_kernel, hipFuncAttributeMaxDynamicSharedMemorySize, LDS_BYTES) != hipSuccess) { fprintf(stderr, "kernel_launch: hipFuncSetAttribute failed\n"); grid = -1; return; }
        if (hipOccupancyMaxActiveBlocksPerMultiprocessor(&per_cu, (const void*)fwd_kernel, NTHR, LDS_BYTES) != hipSuccess || per_cu < 1) fprintf(stderr, "kernel_launch: occupancy query reports %d\n", per_cu);
        (void)hipGetLastError();
        grid = cus;
    }
    if (grid < 0) return;
    (void)hipMemsetAsync((char*)d_ws + WS_CTL, 0, CTL_ZERO_BYTES, stream);
    Args a{};
    for (int i = 0; i < N_IN; ++i) a.in[i] = (const float*)d_in[i];
    a.out = (float*)d_out; a.ws = (unsigned char*)d_ws;
#if MK_ONE_LAUNCH
    a.ph_lo = 0; a.ph_hi = NPH;
    hipLaunchKernelGGL(fwd_kernel, dim3(grid), dim3(NTHR), LDS_BYTES, stream, a);
#else
    for (int p = 0; p < NPH; ++p) { a.ph_lo = p; a.ph_hi = p + 1; hipLaunchKernelGGL(fwd_kernel, dim3(grid), dim3(NTHR), LDS_BYTES, stream, a); }
#endif
    const hipError_t le = hipPeekAtLastError();
    if (le != hipSuccess) fprintf(stderr, "kernel_launch: launch failed: %s\n", hipGetErrorName(le));
}
```

```cpp
#include <hip/hip_runtime.h>
#include <cstdio>
#include <cstdint>

#ifndef MK_ONE_LAUNCH
#define MK_ONE_LAUNCH 1
#endif

#define LAS __attribute__((address_space(3)))
#define GAS __attribute__((address_space(1)))
typedef unsigned short bf16;
typedef short bf16x8 __attribute__((ext_vector_type(8)));
typedef float f32x4 __attribute__((ext_vector_type(4)));
typedef float f32x2 __attribute__((ext_vector_type(2)));
typedef float f32x16 __attribute__((ext_vector_type(16)));
typedef unsigned u32x4 __attribute__((ext_vector_type(4)));
typedef unsigned u32x2 __attribute__((ext_vector_type(2)));
typedef __bf16 bf16x2_t __attribute__((ext_vector_type(2)));
typedef GAS unsigned gu32;
#define RLX_AGENT __ATOMIC_RELAXED, __HIP_MEMORY_SCOPE_AGENT
#define DI __device__ __forceinline__

constexpr int NWAVES = 8, NTHR = 512;
constexpr int D = 1024, BATCH = 16, SEQ = 4096, M = BATCH * SEQ, DEPTH = 2, MEML = 256, MROWS = BATCH * MEML;
constexpr int DIN = 6920, NU = 6912;
constexpr int UC_QK = 0, UC_V = 512, UC_OG = 1024, UC_RW = 1536, UC_CAQ = 3328, UC_GATE = 3840;
constexpr int NEXP = 32, TOPK = 4;
constexpr int PMAX = M * TOPK / 256 + NEXP;
constexpr float LN_EPS = 1e-5f, RW_GN_EPS = 64e-5f, DN_ALPHA = 1.41421356237f;

enum { I_X = 0, I_MEM, I_LNIN_G, I_LNIN_B, I_MEMLN_G, I_MEMLN_B, I_WIN, I_CONVW, I_CONVB, I_IGB, I_FGB, I_MLNORMG, I_RWMU, I_RWW0, I_RWWUP, I_RWA0, I_RWAUP, I_RWGUP,
       I_RWKK, I_RWKA, I_RWRK, I_RWLNG, I_RWLNB, I_CAWKV, I_GATEB, I_WBRML, I_WBRRW, I_WBRCA, I_WO, I_LN1G, I_LN1B, I_RTW, I_RTB, I_WGU, I_BGU, I_WDN, I_BDN, I_LN2G, I_LN2B, N_IN };

constexpr size_t MiB = 1u << 20;
constexpr size_t WS_CTL = 0, CTL_ZERO_BYTES = 1 * MiB;
constexpr size_t WS_WIN = 1 * MiB;
constexpr size_t WS_WKV = 28 * MiB;
constexpr size_t WS_WBR = 32 * MiB;
constexpr size_t WS_WO = 38 * MiB;
constexpr size_t WS_WLORA = 42 * MiB;
constexpr size_t WS_WGU = 45 * MiB;
constexpr size_t WS_WDN = 173 * MiB;
constexpr size_t WS_X = 237 * MiB;
constexpr size_t WS_MEMN = 365 * MiB;
constexpr size_t WS_KV = 373 * MiB;
constexpr size_t WS_GIF = 389 * MiB;
constexpr size_t WS_TKE = 391 * MiB, WS_TKG = 392 * MiB, WS_TKP = 393 * MiB;
constexpr size_t WS_ROWTOK = 394 * MiB;
constexpr size_t WS_HML = 402 * MiB;
constexpr size_t WS_R1 = 466 * MiB;
constexpr size_t WS_R2 = 1330 * MiB;
constexpr size_t WS_END = 1858 * MiB;
constexpr size_t R2_LORA_OUT = 0, R2_HCAT = 192 * MiB, R2_LORA_IN = 384 * MiB, R2_YPRE = 0, R2_Z = 192 * MiB, R2_HMID = 0;
constexpr int CW_TMO = 0, CW_BAR = 4096, CW_CNT = 16384;

constexpr int LDS_BYTES = 155648;
constexpr int LDSCTL_OFF = 153600;

DI unsigned f2bf(float f) { unsigned u = __builtin_bit_cast(unsigned, f); return (u + 0x7fffu + ((u >> 16) & 1u)) >> 16; }
DI unsigned pk2(float lo, float hi) { bf16x2_t b = __builtin_convertvector((f32x2){lo, hi}, bf16x2_t); return __builtin_bit_cast(unsigned, b); }
DI float bflo(unsigned u) { return __builtin_bit_cast(float, u << 16); }
DI float bfhi(unsigned u) { return __builtin_bit_cast(float, u & 0xffff0000u); }
DI unsigned pk4_f8(float a, float b, float c, float d) {
    a = __builtin_amdgcn_fmed3f(a, -448.f, 448.f); b = __builtin_amdgcn_fmed3f(b, -448.f, 448.f); c = __builtin_amdgcn_fmed3f(c, -448.f, 448.f); d = __builtin_amdgcn_fmed3f(d, -448.f, 448.f);
    int w = 0; w = __builtin_amdgcn_cvt_pk_fp8_f32(a, b, w, false); w = __builtin_amdgcn_cvt_pk_fp8_f32(c, d, w, true); return (unsigned)w; }
DI float sigmoidf_(float x) { return __builtin_amdgcn_rcpf(1.f + __builtin_amdgcn_exp2f(-1.4426950408889634f * x)); }
template <int CTRL> DI float dppf(float x) { return __builtin_bit_cast(float, __builtin_amdgcn_update_dpp(0, __builtin_bit_cast(int, x), CTRL, 0xF, 0xF, true)); }
DI float red4(float x) { x += dppf<0xB1>(x); x += dppf<0x4E>(x); return x; }
DI float red8(float x) { x = red4(x); x += dppf<0x141>(x); return x; }
DI float red16(float x) { x = red8(x); x += dppf<0x140>(x); return x; }
DI float wave_sum(float v) {
    v = red16(v);
    const int vi = __builtin_bit_cast(int, v);
    const float a = __builtin_bit_cast(float, __builtin_amdgcn_readlane(vi, 0)), b = __builtin_bit_cast(float, __builtin_amdgcn_readlane(vi, 16));
    const float c = __builtin_bit_cast(float, __builtin_amdgcn_readlane(vi, 32)), d = __builtin_bit_cast(float, __builtin_amdgcn_readlane(vi, 48));
    return (a + b) + (c + d);
}
#define LDS_WAIT() asm volatile("s_waitcnt lgkmcnt(0)" ::: "memory")

constexpr float F8_SX = 8.f, F8_SWGU = 512.f, F8_SH = 4.f, F8_SWDN = 1024.f, F8_INV1 = 1.f / (F8_SX * F8_SWGU), F8_INV2 = 1.f / (F8_SH * F8_SWDN);
namespace pg8 {
constexpr int BM = 256, BK = 64, HALF = 128, HTB = HALF * BK * 2, STAGE_BYTES = 8 * HTB, NXCD = 8, WGM = 8;
__host__ __device__ __forceinline__ int lds_byte(int r, int c) { const int st = (r >> 4) * 2 + (c >> 5), rr = r & 15, cc = c & 31, ob = rr * 64 + cc * 2; return st * 1024 + (ob ^ (((ob >> 9) & 1) << 5)); }
__host__ __device__ __forceinline__ void stage_rc(int b, int& R, int& C) { const int st = b / 1024, sb = b % 1024, swz = sb ^ (((sb >> 9) & 1) << 5); R = (st >> 1) * 16 + swz / 64; C = (st & 1) * 32 + (swz % 64) / 2; }
__host__ __device__ __forceinline__ int perm32(int rho) { const int n = rho >> 4, i = rho & 15; return 8 * (i >> 2) + 4 * n + (i & 3); }

struct Unit { const char* a; const char* b; char* c; int ldc; int r0, c0, e, sub; };

struct TileOrder {
    int nM, nN, nwg;
    DI void init(int nM_, int nN_) { nM = nM_; nN = nN_; nwg = nM * nN; }
    DI bool tile(long L, int& pm, int& pn) const {
        if (L >= nwg) return false;
        int wgid = (int)L; { const int q = nwg / NXCD, r = nwg % NXCD, xcd = wgid % NXCD, off = wgid / NXCD; wgid = (xcd < r ? xcd * (q + 1) : r * (q + 1) + (xcd - r) * q) + off; }
        const int nig = WGM * nN, gid = wgid / nig, fm = gid * WGM, gsz = (nM - fm) < WGM ? (nM - fm) : WGM;
        pm = fm + ((wgid % nig) % gsz); pn = (wgid % nig) / gsz; return true;
    }
};

DI u32x4 pack8(const f32x4& v0, const f32x4& v1) { u32x4 w; w.x = pk2(v0[0], v0[1]); w.y = pk2(v0[2], v0[3]); w.z = pk2(v1[0], v1[1]); w.w = pk2(v1[2], v1[3]); return w; }

struct EpiStore {
    DI void operator()(const f32x4 (&acc)[2][2][4][2], const Unit& u, int wr, int wc, int fr, int fq) const {
#pragma unroll
        for (int ai = 0; ai < 2; ++ai)
#pragma unroll
            for (int m = 0; m < 4; ++m) { char* rowp = u.c + ((size_t)(ai * HALF + wr * 64 + m * 16 + fr) * u.ldc + wc * 32 + 8 * fq) * 2;
#pragma unroll
                for (int bj = 0; bj < 2; ++bj) *(u32x4*)(rowp + bj * 256) = pack8(acc[ai][bj][m][0], acc[ai][bj][m][1]); }
    }
};
struct EpiMerge {
    static constexpr bool MIDK = true;
    const char* U; const float* gate_b;
    DI void mid(f32x4 (&acc)[2][2][4][2], const Unit& u, int which, int wr, int wc, int fr, int fq) const {
        const float L2E = 1.4426950408889634f;
#pragma unroll
        for (int bj = 0; bj < 2; ++bj) {
            const float* g = gate_b + which * 1024 + u.c0 + bj * HALF + wc * 32 + 8 * fq;
            const f32x4 ga0 = *(const f32x4*)g, ga1 = *(const f32x4*)(g + 4), gn0 = *(const f32x4*)(g + 1024), gn1 = *(const f32x4*)(g + 1028);
            const float gaa[8] = {ga0.x, ga0.y, ga0.z, ga0.w, ga1.x, ga1.y, ga1.z, ga1.w}, gnn[8] = {gn0.x, gn0.y, gn0.z, gn0.w, gn1.x, gn1.y, gn1.z, gn1.w};
#pragma unroll
            for (int ai = 0; ai < 2; ++ai)
#pragma unroll
                for (int m = 0; m < 4; ++m) { const int lr = ai * HALF + wr * 64 + m * 16 + fr;
                    const char* gp = U + ((size_t)(u.r0 + lr) * NU + UC_GATE + which * 1024 + u.c0 + wc * 32 + 8 * fq) * 2 + bj * 256;
                    const u32x4 wa = *(const u32x4*)gp, wn = *(const u32x4*)(gp + 2048);
                    const float xa[8] = {bflo(wa.x), bfhi(wa.x), bflo(wa.y), bfhi(wa.y), bflo(wa.z), bfhi(wa.z), bflo(wa.w), bfhi(wa.w)};
                    const float xn[8] = {bflo(wn.x), bfhi(wn.x), bflo(wn.y), bfhi(wn.y), bflo(wn.z), bfhi(wn.z), bflo(wn.w), bfhi(wn.w)};
#pragma unroll
                    for (int i = 0; i < 8; ++i) { const float ea = __builtin_amdgcn_exp2f(-L2E * __builtin_amdgcn_fmed3f(xa[i] + gaa[i], -30.f, 30.f)), en = __builtin_amdgcn_exp2f(-L2E * __builtin_amdgcn_fmed3f(xn[i] + gnn[i], -30.f, 30.f));
                        acc[ai][bj][m][i >> 2][i & 3] *= (1.f + en) * __builtin_amdgcn_rcpf(1.f + ea); }
                    if (m & 1) asm volatile("" ::: "memory"); }
        }
    }
    DI void operator()(const f32x4 (&acc)[2][2][4][2], const Unit& u, int wr, int wc, int fr, int fq) const {
        f32x4 gb[2][2];
#pragma unroll
        for (int bj = 0; bj < 2; ++bj) { const float* g = gate_b + 2048 + u.c0 + bj * HALF + wc * 32 + 8 * fq; gb[bj][0] = *(const f32x4*)g; gb[bj][1] = *(const f32x4*)(g + 4); }
#pragma unroll
        for (int ai = 0; ai < 2; ++ai)
#pragma unroll
            for (int m = 0; m < 4; ++m) { const int lr = ai * HALF + wr * 64 + m * 16 + fr; char* rowp = u.c + ((size_t)lr * u.ldc + wc * 32 + 8 * fq) * 2;
                const char* gp = U + ((size_t)(u.r0 + lr) * NU + UC_GATE + 2048 + u.c0 + wc * 32 + 8 * fq) * 2;
#pragma unroll
                for (int bj = 0; bj < 2; ++bj) { const u32x4 gw = *(const u32x4*)(gp + bj * 256);
                    f32x4 v0 = acc[ai][bj][m][0], v1 = acc[ai][bj][m][1];
                    v0[0] *= sigmoidf_(bflo(gw.x) + gb[bj][0][0]); v0[1] *= sigmoidf_(bfhi(gw.x) + gb[bj][0][1]); v0[2] *= sigmoidf_(bflo(gw.y) + gb[bj][0][2]); v0[3] *= sigmoidf_(bfhi(gw.y) + gb[bj][0][3]);
                    v1[0] *= sigmoidf_(bflo(gw.z) + gb[bj][1][0]); v1[1] *= sigmoidf_(bfhi(gw.z) + gb[bj][1][1]); v1[2] *= sigmoidf_(bflo(gw.w) + gb[bj][1][2]); v1[3] *= sigmoidf_(bfhi(gw.w) + gb[bj][1][3]);
                    *(u32x4*)(rowp + bj * 256) = pack8(v0, v1); }
                asm volatile("" ::: "memory"); }
    }
};
struct EpiWo {
    const char* X;
    DI void operator()(const f32x4 (&acc)[2][2][4][2], const Unit& u, int wr, int wc, int fr, int fq) const {
#pragma unroll
        for (int ai = 0; ai < 2; ++ai)
#pragma unroll
            for (int m = 0; m < 4; ++m) { const int lr = ai * HALF + wr * 64 + m * 16 + fr; char* rowp = u.c + ((size_t)lr * u.ldc + wc * 32 + 8 * fq) * 2;
                const char* xp = X + ((size_t)(u.r0 + lr) * D + u.c0 + wc * 32 + 8 * fq) * 2;
#pragma unroll
                for (int bj = 0; bj < 2; ++bj) { const u32x4 xw = *(const u32x4*)(xp + bj * 256);
                    f32x4 v0 = acc[ai][bj][m][0], v1 = acc[ai][bj][m][1];
                    v0[0] += DN_ALPHA * bflo(xw.x); v0[1] += DN_ALPHA * bfhi(xw.x); v0[2] += DN_ALPHA * bflo(xw.y); v0[3] += DN_ALPHA * bfhi(xw.y);
                    v1[0] += DN_ALPHA * bflo(xw.z); v1[1] += DN_ALPHA * bfhi(xw.z); v1[2] += DN_ALPHA * bflo(xw.w); v1[3] += DN_ALPHA * bfhi(xw.w);
                    *(u32x4*)(rowp + bj * 256) = pack8(v0, v1); }
                asm volatile("" ::: "memory"); }
    }
};
DI float swiglu1(float a, float b) { const float g = fminf(a, 7.f), l = fminf(fmaxf(b, -7.f), 7.f); return g * sigmoidf_(1.702f * g) * (l + 1.f); }
struct EpiMoe1 {
    const float* bgu;
    DI void operator()(const f32x4 (&acc)[2][2][4][2], const Unit& u, int wr, int wc, int fr, int fq) const {
        f32x4 bv[2][2];
#pragma unroll
        for (int bj = 0; bj < 2; ++bj) { const float* b = bgu + u.e * 2048 + u.c0 + bj * HALF + wc * 32 + 8 * fq; bv[bj][0] = *(const f32x4*)b; bv[bj][1] = *(const f32x4*)(b + 4); }
#pragma unroll
        for (int ai = 0; ai < 2; ++ai)
#pragma unroll
            for (int m = 0; m < 4; ++m) { const int lr = ai * HALF + wr * 64 + m * 16 + fr; char* rowp = u.c + ((size_t)lr * u.ldc + wc * 16 + 4 * fq);
#pragma unroll
                for (int bj = 0; bj < 2; ++bj) { const f32x4 v0 = acc[ai][bj][m][0] * F8_INV1 + bv[bj][0], v1 = acc[ai][bj][m][1] * F8_INV1 + bv[bj][1];
                    *(unsigned*)(rowp + bj * 64) = pk4_f8(swiglu1(v0[0], v0[1]) * F8_SH, swiglu1(v0[2], v0[3]) * F8_SH, swiglu1(v1[0], v1[1]) * F8_SH, swiglu1(v1[2], v1[3]) * F8_SH); } }
    }
};
struct EpiMoe2 {
    const float* bdn;
    DI void operator()(const f32x4 (&acc)[2][2][4][2], const Unit& u, int wr, int wc, int fr, int fq) const {
        f32x4 bv[2][2];
#pragma unroll
        for (int bj = 0; bj < 2; ++bj) { const float* b = bdn + u.e * 1024 + u.c0 + bj * HALF + wc * 32 + 8 * fq; bv[bj][0] = *(const f32x4*)b; bv[bj][1] = *(const f32x4*)(b + 4); }
#pragma unroll
        for (int ai = 0; ai < 2; ++ai)
#pragma unroll
            for (int m = 0; m < 4; ++m) { char* rowp = u.c + ((size_t)(ai * HALF + wr * 64 + m * 16 + fr) * u.ldc + wc * 32 + 8 * fq) * 2;
#pragma unroll
                for (int bj = 0; bj < 2; ++bj) *(u32x4*)(rowp + bj * 256) = pack8(acc[ai][bj][m][0] * F8_INV2 + bv[bj][0], acc[ai][bj][m][1] * F8_INV2 + bv[bj][1]); }
    }
};

typedef int i32x8 __attribute__((ext_vector_type(8)));
typedef int i32x4 __attribute__((ext_vector_type(4)));
template <bool F8, bool MIDK = false, class Epi, class Sched>
DI void gemm_phase(LAS unsigned char* lds, const int KB  , const int ldaB, const int ldbB, const Sched& S, const Epi& E, const int wave_) {
    unsigned z_ = 0u; asm volatile("" : "+v"(z_)); const int tid = wave_ * 64 + (int)__builtin_amdgcn_mbcnt_hi(~0u, __builtin_amdgcn_mbcnt_lo(~0u, z_));
    const int wid = __builtin_amdgcn_readfirstlane(tid >> 6), lane = tid & 63, wr = wid >> 2, wc = wid & 3, fr = lane & 15, fq = lane >> 4;
    const int nt = KB / (BK * 2);
    unsigned voffA[2], voffB[2];
#pragma unroll
    for (int i = 0; i < 2; ++i) { int R, C; stage_rc(tid * 16 + i * 8192, R, C); const int Rb = (R & ~31) + perm32(R & 31);
        voffA[i] = (unsigned)(R * ldaB + C * 2); voffB[i] = (unsigned)(Rb * ldbB + C * 2); }
    asm volatile("" : "+v"(voffA[0]), "+v"(voffA[1]), "+v"(voffB[0]), "+v"(voffB[1]));
    const size_t kstep = (size_t)(BK * 2);
    const size_t hstepA = (size_t)HALF * ldaB, hstepB = (size_t)HALF * ldbB;
    const unsigned ldsw = (unsigned)wid * 1024u;
    const int aoff = lds_byte(wr * 64 + fr, fq * 8), boff = lds_byte(wc * 32 + fr, fq * 8);
#define PG8_SA(b, h) (((b) * 2 + (h)) * HTB)
#define PG8_SB(b, h) ((4 + (b) * 2 + (h)) * HTB)
#define PG8_STAGE(bufoff, gbase, voff) do { _Pragma("unroll") for (int _i = 0; _i < 2; ++_i) \
        __builtin_amdgcn_global_load_lds((const unsigned*)((const char*)(gbase) + (voff)[_i]), (LAS unsigned*)(lds + (bufoff) + ldsw + _i * 8192), 16, 0, 0); } while (0)
#define PG8_LD8(p) __builtin_shufflevector(*(const LAS i32x4*)(p), *(const LAS i32x4*)((p) + 1024), 0, 1, 2, 3, 4, 5, 6, 7)
#define PG8_LDA8(dst, b, h) do { _Pragma("unroll") for (int m = 0; m < 4; ++m) dst[m] = PG8_LD8(lds + PG8_SA(b, h) + aoff + m * 2048); } while (0)
#define PG8_LDB8(dst, b, h) do { _Pragma("unroll") for (int n = 0; n < 2; ++n) dst[n] = PG8_LD8(lds + PG8_SB(b, h) + boff + n * 2048); } while (0)
#define PG8_MMA8(ai, bj, A8, B8) do { __builtin_amdgcn_s_setprio(1); _Pragma("unroll") for (int m = 0; m < 4; ++m) _Pragma("unroll") for (int n = 0; n < 2; ++n) \
        asm volatile("v_mfma_f32_16x16x128_f8f6f4 %0, %1, %2, %0" : "+v"(acc[ai][bj][m][n]) : "v"(B8[n]), "v"(A8[m])); __builtin_amdgcn_s_setprio(0); } while (0)
#define PG8_LDA(dst, b, h) do { _Pragma("unroll") for (int m = 0; m < 4; ++m) _Pragma("unroll") for (int k = 0; k < 2; ++k) dst[m][k] = *(const LAS bf16x8*)(lds + PG8_SA(b, h) + aoff + m * 2048 + k * 1024); } while (0)
#define PG8_LDB(dst, b, h) do { _Pragma("unroll") for (int n = 0; n < 2; ++n) _Pragma("unroll") for (int k = 0; k < 2; ++k) dst[n][k] = *(const LAS bf16x8*)(lds + PG8_SB(b, h) + boff + n * 2048 + k * 1024); } while (0)
#define PG8_CAT(x) __builtin_shufflevector(__builtin_bit_cast(i32x4, (x)[0]), __builtin_bit_cast(i32x4, (x)[1]), 0, 1, 2, 3, 4, 5, 6, 7)
#define PG8_MMA(ai, bj, At, Bt) do { __builtin_amdgcn_s_setprio(1); _Pragma("unroll") for (int m = 0; m < 4; ++m) _Pragma("unroll") for (int n = 0; n < 2; ++n) _Pragma("unroll") for (int k = 0; k < 2; ++k) \
        acc[ai][bj][m][n] = __builtin_amdgcn_mfma_f32_16x16x32_bf16(Bt[n][k], At[m][k], acc[ai][bj][m][n], 0, 0, 0); __builtin_amdgcn_s_setprio(0); } while (0)
#define PG8_WAIT_V(n) asm volatile("s_waitcnt vmcnt(" #n ")" ::: "memory")
#define PG8_WAIT_L(n) asm volatile("s_waitcnt lgkmcnt(" #n ")" ::: "memory")
#define PG8_BAR __builtin_amdgcn_s_barrier()
#define PG8_SCHED __builtin_amdgcn_sched_barrier(0)
    Unit cur, nxt; int ui = 0;
    if (!S.next(0, cur)) return;
    f32x4 acc[2][2][4][2];
#pragma unroll
    for (int a = 0; a < 2; ++a)
#pragma unroll
        for (int b = 0; b < 2; ++b)
#pragma unroll
            for (int m = 0; m < 4; ++m)
#pragma unroll
                for (int n = 0; n < 2; ++n) acc[a][b][m][n] = (f32x4){0.f, 0.f, 0.f, 0.f};
    bf16x8 At[4][2], B0[2][2], B1[2][2]; i32x8 A8[4], B80[2], B81[2];
    const char* cA = cur.a; const char* cB = cur.b;
    PG8_STAGE(PG8_SB(0, 0), cB, voffB); PG8_STAGE(PG8_SB(0, 1), cB + hstepB, voffB); PG8_STAGE(PG8_SA(0, 0), cA, voffA); PG8_STAGE(PG8_SA(0, 1), cA + hstepA, voffA);
    if (wr == 1) PG8_BAR;
    PG8_WAIT_V(2); PG8_BAR;
    PG8_STAGE(PG8_SB(1, 0), cB + kstep, voffB); PG8_STAGE(PG8_SA(1, 0), cA + kstep, voffA); PG8_STAGE(PG8_SB(1, 1), cB + hstepB + kstep, voffB);
    PG8_WAIT_V(6); PG8_BAR;
    for (;;) {
        const bool has_next = S.next(ui + 1, nxt);
        const char* nA = has_next ? nxt.a : cA; const char* nB = has_next ? nxt.b : cB;
#pragma unroll 1
        for (int t = 0; t < nt; t += 2) {
            if constexpr (MIDK) { if (t == 8 || t == 16) { int fr_ = fr, fq_ = fq; asm volatile("" : "+v"(fr_), "+v"(fq_)); E.mid(acc, cur, t >> 4, wr, wc, fr_, fq_); } }
            const bool last = (t == nt - 2);
            const char* a1 = cA + (size_t)(t + 1) * kstep;
            const char* a2 = last ? nA : cA + (size_t)(t + 2) * kstep; const char* b2 = last ? nB : cB + (size_t)(t + 2) * kstep;
            const char* a3 = a2 + kstep; const char* b3 = b2 + kstep;
            if constexpr (F8) {
            PG8_LDB8(B80, 0, 0); PG8_LDB8(B81, 0, 1); PG8_SCHED; PG8_LDA8(A8, 0, 0); PG8_STAGE(PG8_SA(1, 1), a1 + hstepA, voffA);
            PG8_WAIT_V(8); PG8_WAIT_L(0); PG8_BAR; PG8_MMA8(0, 0, A8, B80); PG8_MMA8(0, 1, A8, B81); PG8_BAR; PG8_SCHED;
            PG8_LDA8(A8, 0, 1); PG8_STAGE(PG8_SB(0, 0), b2, voffB); PG8_STAGE(PG8_SB(0, 1), b2 + hstepB, voffB); PG8_STAGE(PG8_SA(0, 0), a2, voffA);
            PG8_WAIT_V(8); PG8_WAIT_L(0); PG8_BAR; PG8_MMA8(1, 0, A8, B80); PG8_MMA8(1, 1, A8, B81); PG8_BAR; PG8_SCHED;
            PG8_LDB8(B80, 1, 0); PG8_LDB8(B81, 1, 1); PG8_SCHED; PG8_LDA8(A8, 1, 0); PG8_STAGE(PG8_SA(0, 1), a2 + hstepA, voffA);
            PG8_WAIT_V(8); PG8_WAIT_L(0); PG8_BAR; PG8_MMA8(0, 0, A8, B80); PG8_MMA8(0, 1, A8, B81); PG8_BAR; PG8_SCHED;
            PG8_LDA8(A8, 1, 1); PG8_STAGE(PG8_SB(1, 0), b3, voffB); PG8_STAGE(PG8_SB(1, 1), b3 + hstepB, voffB); PG8_STAGE(PG8_SA(1, 0), a3, voffA);
            PG8_WAIT_V(8); PG8_WAIT_L(0); PG8_BAR; PG8_MMA8(1, 0, A8, B80); PG8_MMA8(1, 1, A8, B81); PG8_BAR; PG8_SCHED;
            } else {
            PG8_LDB(B0, 0, 0); PG8_LDB(B1, 0, 1); PG8_SCHED; PG8_LDA(At, 0, 0); PG8_STAGE(PG8_SA(1, 1), a1 + hstepA, voffA);
            PG8_WAIT_V(8); PG8_WAIT_L(0); PG8_BAR; PG8_MMA(0, 0, At, B0); PG8_MMA(0, 1, At, B1); PG8_BAR; PG8_SCHED;
            PG8_LDA(At, 0, 1); PG8_STAGE(PG8_SB(0, 0), b2, voffB); PG8_STAGE(PG8_SB(0, 1), b2 + hstepB, voffB); PG8_STAGE(PG8_SA(0, 0), a2, voffA);
            PG8_WAIT_V(8); PG8_WAIT_L(0); PG8_BAR; PG8_MMA(1, 0, At, B0); PG8_MMA(1, 1, At, B1); PG8_BAR; PG8_SCHED;
            PG8_LDB(B0, 1, 0); PG8_LDB(B1, 1, 1); PG8_SCHED; PG8_LDA(At, 1, 0); PG8_STAGE(PG8_SA(0, 1), a2 + hstepA, voffA);
            PG8_WAIT_V(8); PG8_WAIT_L(0); PG8_BAR; PG8_MMA(0, 0, At, B0); PG8_MMA(0, 1, At, B1); PG8_BAR; PG8_SCHED;
            PG8_LDA(At, 1, 1); PG8_STAGE(PG8_SB(1, 0), b3, voffB); PG8_STAGE(PG8_SB(1, 1), b3 + hstepB, voffB); PG8_STAGE(PG8_SA(1, 0), a3, voffA);
            PG8_WAIT_V(8); PG8_WAIT_L(0); PG8_BAR; PG8_MMA(1, 0, At, B0); PG8_MMA(1, 1, At, B1); PG8_BAR; PG8_SCHED;
            }
        }
        if (wr == 0) PG8_BAR;
        if constexpr (F8) asm volatile("s_nop 15\n\ts_nop 15" ::: "memory");
        { int fr_ = fr, fq_ = fq; asm volatile("" : "+v"(fr_), "+v"(fq_));
          E(acc, cur, wr, wc, fr_, fq_); }
        if (!has_next) break;
#pragma unroll
        for (int a = 0; a < 2; ++a)
#pragma unroll
            for (int b = 0; b < 2; ++b)
#pragma unroll
                for (int m = 0; m < 4; ++m)
#pragma unroll
                    for (int n = 0; n < 2; ++n) acc[a][b][m][n] = (f32x4){0.f, 0.f, 0.f, 0.f};
        cur = nxt; cA = nA; cB = nB; ++ui;
        if (wr == 1) PG8_BAR;
    }
    PG8_WAIT_V(0);
    PG8_BAR;
#undef PG8_SA
#undef PG8_SB
#undef PG8_STAGE
#undef PG8_LDA
#undef PG8_LDB
#undef PG8_MMA
#undef PG8_CAT
#undef PG8_LD8
#undef PG8_LDA8
#undef PG8_LDB8
#undef PG8_MMA8
#undef PG8_WAIT_V
#undef PG8_WAIT_L
#undef PG8_BAR
#undef PG8_SCHED
}
}

#define XB_TMO      128
#define XB_XCNT(j)  (256  + 64 * (j))
#define XB_XSUB(j)  (1280 + 64 * (j))
#define XB_XGEN(j)  (2304 + 64 * (j))
#define XB_TOP      3328
#define XB_TOPGEN   3392
#define XCD_BAR_WORDS 3456
#define XB_SPIN_CAP (1u << 22)
DI unsigned xb_ld(unsigned* p)              { return __hip_atomic_load(p, __ATOMIC_RELAXED, __HIP_MEMORY_SCOPE_AGENT); }
DI unsigned xb_add(unsigned* p, unsigned v) { return __hip_atomic_fetch_add(p, v, __ATOMIC_RELAXED, __HIP_MEMORY_SCOPE_AGENT); }
DI unsigned xb_xcc_id() { return (unsigned)__builtin_amdgcn_s_getreg((3 << 11) | 20) & 0xFu; }
#define XB_SPIN(cond, bar) do { unsigned _sp = 0; while (cond) { __builtin_amdgcn_s_sleep(1); \
    if ((++_sp & 255u) == 0u) { if (xb_ld(&(bar)[XB_TMO])) break; if (_sp > XB_SPIN_CAP) { atomicAdd(&(bar)[XB_TMO], 1u); break; } } } } while (0)
struct XcdBarrier { unsigned* bar; unsigned x; volatile LAS unsigned* st; };
DI XcdBarrier xcd_barrier_post(unsigned* bar, volatile LAS unsigned* st) {
    XcdBarrier b; b.bar = bar; b.x = xb_xcc_id(); b.st = st;
    if (threadIdx.x == 0) (void)xb_add(&bar[XB_XCNT(b.x)], 1u);
    return b;
}
DI void xcd_barrier_complete(unsigned* bar, unsigned x, unsigned& nloc, unsigned& nx) {
    const unsigned G = gridDim.x * gridDim.y * gridDim.z;
    unsigned sum, cnt, mine, sp = 0u;
    for (;;) {
        sum = 0u; cnt = 0u; mine = 0u;
#pragma unroll
        for (unsigned j = 0; j < 16; ++j) { const unsigned c = xb_ld(&bar[XB_XCNT(j)]); sum += c; cnt += (c > 0u) ? 1u : 0u; mine = (j == x) ? c : mine; }
        if (sum == G) break;
        __builtin_amdgcn_s_sleep(1);
        if ((++sp & 255u) == 0u) { if (xb_ld(&bar[XB_TMO])) break; if (sp > XB_SPIN_CAP) { atomicAdd(&bar[XB_TMO], 1u); break; } }
    }
    nloc = mine > 0u ? mine : 1u; nx = cnt > 0u ? cnt : 1u;
}
DI void xcd_barrier(const XcdBarrier& b) {
    asm volatile("s_waitcnt vmcnt(0)" ::: "memory");
    __syncthreads();
    if (threadIdx.x == 0) {
        unsigned* bar = b.bar;
        __builtin_amdgcn_s_waitcnt(0);
        unsigned nloc = b.st[0], nx = b.st[1];
        if (nloc == 0u) { xcd_barrier_complete(bar, b.x, nloc, nx); b.st[0] = nloc; b.st[1] = nx; }
        const unsigned old = xb_add(&bar[XB_XSUB(b.x)], 1u);
        const unsigned gen = old / nloc;
        if (old + 1u == (gen + 1u) * nloc) {
            __builtin_amdgcn_fence(__ATOMIC_RELEASE, "agent");
            asm volatile("s_waitcnt vmcnt(0)" ::: "memory");
            const unsigned og = xb_add(&bar[XB_TOP], 1u);
            const unsigned tg = og / nx;
            if (og + 1u == (tg + 1u) * nx) xb_add(&bar[XB_TOPGEN], 1u);
            else XB_SPIN(xb_ld(&bar[XB_TOPGEN]) == tg, bar);
            __builtin_amdgcn_fence(__ATOMIC_ACQUIRE, "agent");
            xb_add(&bar[XB_XGEN(b.x)], 1u);
            asm volatile("s_waitcnt vmcnt(0)" ::: "memory");
        } else {
            XB_SPIN(xb_ld(&bar[XB_XGEN(b.x)]) == gen, bar);
            __builtin_amdgcn_fence(__ATOMIC_ACQUIRE, "agent");
            asm volatile("s_waitcnt vmcnt(0)" ::: "memory");
        }
    }
    __syncthreads();
}

DI void transpose_item(const float* W, int ldw, bf16* WT, int ldt, LAS float* scr, int lane) {
#pragma unroll 8
    for (int i = 0; i < 32; ++i) { const int kk = 2 * i + (lane >> 5); scr[kk * 33 + (lane & 31)] = W[(size_t)kk * ldw + (lane & 31)]; }
    LDS_WAIT(); asm volatile("" ::: "memory");
    const int c = lane & 7;
#pragma unroll
    for (int j = 0; j < 4; ++j) { const int n = (lane >> 3) + 8 * j; const LAS float* s = scr + (8 * c) * 33 + n;
        u32x4 o; o.x = pk2(s[0 * 33], s[1 * 33]); o.y = pk2(s[2 * 33], s[3 * 33]); o.z = pk2(s[4 * 33], s[5 * 33]); o.w = pk2(s[6 * 33], s[7 * 33]);
        *(u32x4*)(WT + (size_t)n * ldt + 8 * c) = o; }
    LDS_WAIT(); asm volatile("" ::: "memory");
}
DI void transpose_item_f8(const float* W, int ldw, unsigned char* WT, int ldt, float scale, LAS float* scr, int lane) {
#pragma unroll 8
    for (int i = 0; i < 32; ++i) { const int kk = 2 * i + (lane >> 5); scr[kk * 33 + (lane & 31)] = W[(size_t)kk * ldw + (lane & 31)]; }
    LDS_WAIT(); asm volatile("" ::: "memory");
    const int c = lane & 3;
#pragma unroll
    for (int j = 0; j < 2; ++j) { const int n = (lane >> 2) + 16 * j; const LAS float* s = scr + (16 * c) * 33 + n;
        u32x4 o; o.x = pk4_f8(s[0 * 33] * scale, s[1 * 33] * scale, s[2 * 33] * scale, s[3 * 33] * scale); o.y = pk4_f8(s[4 * 33] * scale, s[5 * 33] * scale, s[6 * 33] * scale, s[7 * 33] * scale);
        o.z = pk4_f8(s[8 * 33] * scale, s[9 * 33] * scale, s[10 * 33] * scale, s[11 * 33] * scale); o.w = pk4_f8(s[12 * 33] * scale, s[13 * 33] * scale, s[14 * 33] * scale, s[15 * 33] * scale);
        *(u32x4*)(WT + (size_t)n * ldt + 16 * c) = o; }
    LDS_WAIT(); asm volatile("" ::: "memory");
}
DI void ln16(f32x4 (&v)[4], const f32x4 (&g)[4], const f32x4 (&b)[4]) {
    float s = 0.f;
#pragma unroll
    for (int j = 0; j < 4; ++j) s += (v[j].x + v[j].y) + (v[j].z + v[j].w);
    const float mean = wave_sum(s) * (1.f / D); float s2 = 0.f;
#pragma unroll
    for (int j = 0; j < 4; ++j) { v[j] = v[j] - mean; s2 += (v[j].x * v[j].x + v[j].y * v[j].y) + (v[j].z * v[j].z + v[j].w * v[j].w); }
    const float rstd = 1.f / sqrtf(wave_sum(s2) * (1.f / D) + LN_EPS);
#pragma unroll
    for (int j = 0; j < 4; ++j) v[j] = v[j] * rstd * g[j] + b[j];
}
DI void gates8(const f32x4 (&y)[4], const LAS float* wgt, float* gif_row, int lane) {
    float p[8];
#pragma unroll
    for (int j = 0; j < 8; ++j) { float s = 0.f;
#pragma unroll
        for (int jj = 0; jj < 4; ++jj) { const f32x4 w = *(const LAS f32x4*)(wgt + j * 1024 + 256 * jj + 4 * lane); s += (y[jj].x * w.x + y[jj].y * w.y) + (y[jj].z * w.z + y[jj].w * w.w); }
        p[j] = wave_sum(s); }
    if (lane == 0) { *(f32x4*)gif_row = (f32x4){p[0], p[1], p[2], p[3]}; *(f32x4*)(gif_row + 4) = (f32x4){p[4], p[5], p[6], p[7]}; }
}
DI void gates8b(const f32x4 (&y)[4], const LAS float* wgt, float* gif_row, int lane) {
    float p[8];
#pragma unroll
    for (int j = 0; j < 8; ++j) { float s = 0.f;
#pragma unroll
        for (int jj = 0; jj < 4; ++jj) { const f32x4 w = *(const LAS f32x4*)(wgt + j * 1024 + (jj >> 1) * 512 + 8 * lane + (jj & 1) * 4); s += (y[jj].x * w.x + y[jj].y * w.y) + (y[jj].z * w.z + y[jj].w * w.w); }
        p[j] = wave_sum(s); }
    if (lane == 0) { *(f32x4*)gif_row = (f32x4){p[0], p[1], p[2], p[3]}; *(f32x4*)(gif_row + 4) = (f32x4){p[4], p[5], p[6], p[7]}; }
}
DI void load_gate_table(LAS float* wgt, const float* win_l, int tid) {
    for (int i = tid; i < 8192; i += NTHR) { const int k = i >> 3, j = i & 7; wgt[j * 1024 + k] = win_l[(size_t)k * DIN + 1536 + j]; }
}
DI f32x4 ld4bf(const char* p) { const u32x2 w = *(const u32x2*)p; return (f32x4){bflo(w.x), bfhi(w.x), bflo(w.y), bfhi(w.y)}; }
DI void st4bf(char* p, const f32x4& v) { u32x2 w; w.x = pk2(v.x, v.y); w.y = pk2(v.z, v.w); *(u32x2*)p = w; }

struct Args { const float* in[N_IN]; float* out; unsigned char* ws; int ph_lo, ph_hi; };
constexpr int NP_LAYER = 12, NPH = 1 + DEPTH * NP_LAYER;

struct SchedInproj {
    pg8::TileOrder T; int G, c; const char *X, *W; char* U; bool kv; const char *MEMN, *WKV; char* KV;
    DI bool next(int i, pg8::Unit& u) const {
        const long L = (long)i * G + c; int pm, pn;
        if (T.tile(L, pm, pn)) { u.a = X + (size_t)pm * 256 * D * 2; u.b = W + (size_t)pn * 256 * D * 2; u.r0 = pm * 256; u.c0 = pn * 256; u.c = U + ((size_t)u.r0 * NU + u.c0) * 2; u.ldc = NU; u.e = 0; u.sub = 0; return true; }
        if (!kv) return false;
        const long L2 = L - T.nwg; if (L2 < 0 || L2 >= 128) return false;
        const int l = (int)L2 >> 6, t = (int)L2 & 63; pm = t >> 2; pn = t & 3;
        u.a = MEMN + (size_t)pm * 256 * D * 2; u.b = WKV + ((size_t)l * 1024 + pn * 256) * D * 2; u.r0 = pm * 256; u.c0 = pn * 256; u.c = KV + (((size_t)l * MROWS + u.r0) * D + u.c0) * 2; u.ldc = D; u.e = 0; u.sub = 0; return true;
    }
};
struct SchedPlain {
    pg8::TileOrder T; int G, c; const char *A, *B; char* C; int lda, ldb, ldc;
    DI bool next(int i, pg8::Unit& u) const {
        const long L = (long)i * G + c; int pm, pn; if (!T.tile(L, pm, pn)) return false;
        u.a = A + (size_t)pm * 256 * lda * 2; u.b = B + (size_t)pn * 256 * ldb * 2; u.r0 = pm * 256; u.c0 = pn * 256; u.c = C + ((size_t)u.r0 * ldc + u.c0) * 2; u.ldc = ldc; u.e = 0; u.sub = 0; return true;
    }
};
struct SchedMerge {
    pg8::TileOrder T; int G, c; const char *H, *W; char* Y;
    DI bool next(int i, pg8::Unit& u) const {
        const int ti = i / 3, br = i - 3 * ti; const long L = (long)ti * G + c; int pm, pn; if (!T.tile(L, pm, pn)) return false;
        u.a = H + ((size_t)pm * 256 * 1536 + br * 512) * 2; u.b = W + ((size_t)br * 1024 + pn * 256) * 512 * 2; u.r0 = pm * 256; u.c0 = pn * 256; u.c = Y + ((size_t)u.r0 * D + u.c0) * 2; u.ldc = D; u.e = 0; u.sub = br; return true;
    }
};
struct SchedMoe {
    pg8::TileOrder T; int G, c; const char *A, *W; char* C; const LAS int* PB; int wrows  , ldc, cdiv, osz;
    DI bool next(int i, pg8::Unit& u) const {
        const long L = (long)i * G + c; int pm, pn; if (!T.tile(L, pm, pn)) return false;
        int e = 0;
#pragma unroll 1
        for (int j = 1; j < NEXP; ++j) e += (PB[j] <= pm) ? 1 : 0;
        u.a = A + (size_t)pm * 256 * 1024; u.b = W + ((size_t)e * wrows + pn * 256) * 1024; u.r0 = pm * 256; u.c0 = pn * 256; u.c = C + ((size_t)u.r0 * ldc + u.c0 / cdiv) * osz; u.ldc = ldc; u.e = e; u.sub = 0; return true;
    }
};

__global__ void __launch_bounds__(NTHR, 2) fwd_kernel(Args args) {
    extern __shared__ __attribute__((aligned(16))) unsigned char lds_raw[];
#define INP(i) ([&]() -> const float* { int ii_ = (i); asm volatile("" : "+s"(ii_)); return args.in[ii_]; }())
    LAS unsigned char* lds = (LAS unsigned char*)lds_raw;
    volatile LAS unsigned* LCTL = (volatile LAS unsigned*)(lds + LDSCTL_OFF);
    const int tid0 = threadIdx.x, wave = __builtin_amdgcn_readfirstlane(tid0 >> 6);
#define PHASE_TID unsigned z_ = 0u; asm volatile("" : "+v"(z_)); int tid = wave * 64 + (int)__builtin_amdgcn_mbcnt_hi(~0u, __builtin_amdgcn_mbcnt_lo(~0u, z_)); const int lane = tid & 63; (void)lane;
    const int G = gridDim.x, bx = blockIdx.x;
    const int gw = bx * NWAVES + wave, NGW = G * NWAVES;
    unsigned char* ws = args.ws;
    gu32* ctl = (gu32*)(ws + WS_CTL);
    for (int u = tid0; u < (LDS_BYTES - LDSCTL_OFF) / 4; u += NTHR) ((LAS unsigned*)(lds + LDSCTL_OFF))[u] = 0u;
    __syncthreads();
    XcdBarrier bar; bar.bar = (unsigned*)ctl + CW_BAR; bar.x = 0; bar.st = nullptr;
    if (MK_ONE_LAUNCH) bar = xcd_barrier_post((unsigned*)ctl + CW_BAR, LCTL);
    const int lo = args.ph_lo, hi = args.ph_hi;
#ifndef SUBMASK
#define SUBMASK 7
#endif
#ifndef LN2PROBE
#define LN2PROBE 0
#endif
#ifndef SUBDUP
#define SUBDUP 0
#endif
#define NSUB(k) ((((SUBDUP) >> (k)) & 1) ? 2 : 1)
#ifndef DUPMASK
#define DUPMASK 0
#endif
#define NREP(k) ((((DUPMASK) >> (k)) & 1) ? 2 : 1)
#ifndef PHMASK
#define PHMASK 0xFFFF
#endif
#define IN(k) (lo <= (k) && (k) < hi)
#define SEAM(k) do { if (IN(k) && IN((k) + 1)) xcd_barrier(bar); } while (0)

    char* const Xb = (char*)(ws + WS_X);
    char* const Ub = (char*)(ws + WS_R1);
    float* const GIF = (float*)(ws + WS_GIF);
    LAS int* const PB = (LAS int*)(lds + LDSCTL_OFF + 64);
    LAS int* const CNT = (LAS int*)(lds + LDSCTL_OFF + 256);

    _Pragma("unroll 1") for (int rep_ = 0; rep_ < NREP(12); ++rep_) if (((PHMASK>>12)&1) && IN(0)) { PHASE_TID
        LAS float* scr = (LAS float*)(lds + wave * 8448);
        LAS float* wgt = (LAS float*)(lds + 73728);
        load_gate_table(wgt, INP(I_WIN), tid);
        constexpr int IT_IN = 16 * 216, IT_KV = 16 * 32, IT_BR = 8 * 32, IT_O = 16 * 32, IT_L = IT_IN + IT_KV + 3 * IT_BR + IT_O;
        for (int it = gw; it < DEPTH * IT_L; it += NGW) {
            const int l = it / IT_L; int r = it - l * IT_L;
            if (r < IT_IN) { const int kb = r / 216, nb = r % 216, n0 = 32 * nb, sc = n0 + (n0 >= 1536 ? 8 : 0);
                transpose_item(INP(I_WIN) + ((size_t)l * D + 64 * kb) * DIN + sc, DIN, (bf16*)(ws + WS_WIN) + ((size_t)l * NU + n0) * D + 64 * kb, D, scr, lane); continue; }
            r -= IT_IN;
            if (r < IT_KV) { const int kb = r / 32, nb = r % 32;
                transpose_item(INP(I_CAWKV) + ((size_t)l * D + 64 * kb) * 1024 + 32 * nb, 1024, (bf16*)(ws + WS_WKV) + ((size_t)l * 1024 + 32 * nb) * D + 64 * kb, D, scr, lane); continue; }
            r -= IT_KV;
            if (r < 3 * IT_BR) { const int br = r / IT_BR, q = r % IT_BR, kb = q / 32, nb = q % 32;
                const float* src = INP(br == 0 ? I_WBRML : (br == 1 ? I_WBRRW : I_WBRCA));
                transpose_item(src + ((size_t)l * 512 + 64 * kb) * 1024 + 32 * nb, 1024, (bf16*)(ws + WS_WBR) + ((size_t)l * 1024 + 32 * nb) * 1536 + br * 512 + 64 * kb, 1536, scr, lane); continue; }
            r -= 3 * IT_BR;
            { const int kb = r / 32, nb = r % 32;
                transpose_item(INP(I_WO) + ((size_t)l * D + 64 * kb) * 1024 + 32 * nb, 1024, (bf16*)(ws + WS_WO) + ((size_t)l * 1024 + 32 * nb) * D + 64 * kb, D, scr, lane); }
        }
        for (int i = bx * NTHR + tid; i < DEPTH * 1536 * 256; i += G * NTHR) {
            const int l = i / (1536 * 256), r = i % (1536 * 256), n = r >> 8, k = r & 255; float v = 0.f;
            if (n < 512) { if (k < 64) v = INP(I_RWWUP)[((size_t)l * 64 + k) * 512 + n]; }
            else if (n < 1024) { if (k >= 64 && k < 128) v = INP(I_RWAUP)[((size_t)l * 64 + (k - 64)) * 512 + (n - 512)]; }
            else { if (k >= 128) v = INP(I_RWGUP)[((size_t)l * 128 + (k - 128)) * 512 + (n - 1024)]; }
            ((bf16*)(ws + WS_WLORA))[i] = (bf16)f2bf(v);
        }
        __syncthreads();
        {
            f32x4 g[4], b[4];
#pragma unroll
            for (int j = 0; j < 4; ++j) { g[j] = *(const f32x4*)(INP(I_LNIN_G) + 256 * j + 4 * lane); b[j] = *(const f32x4*)(INP(I_LNIN_B) + 256 * j + 4 * lane); }
            for (int m = gw; m < M; m += NGW) {
                f32x4 v[4]; const float* xr = INP(I_X) + (size_t)m * D;
#pragma unroll
                for (int j = 0; j < 4; ++j) v[j] = *(const f32x4*)(xr + 256 * j + 4 * lane);
                ln16(v, g, b);
#pragma unroll
                for (int j = 0; j < 4; ++j) st4bf(Xb + ((size_t)m * D + 256 * j + 4 * lane) * 2, v[j]);
                gates8(v, wgt, GIF + (size_t)m * 8, lane);
            }
#pragma unroll
            for (int j = 0; j < 4; ++j) { g[j] = *(const f32x4*)(INP(I_MEMLN_G) + 256 * j + 4 * lane); b[j] = *(const f32x4*)(INP(I_MEMLN_B) + 256 * j + 4 * lane); }
            for (int m = gw; m < MROWS; m += NGW) {
                f32x4 v[4]; const float* xr = INP(I_MEM) + (size_t)m * D;
#pragma unroll
                for (int j = 0; j < 4; ++j) v[j] = *(const f32x4*)(xr + 256 * j + 4 * lane);
                ln16(v, g, b);
#pragma unroll
                for (int j = 0; j < 4; ++j) st4bf((char*)(ws + WS_MEMN) + ((size_t)m * D + 256 * j + 4 * lane) * 2, v[j]);
            }
        }
        __syncthreads();
    }
    SEAM(0);

#pragma unroll 1
    for (int l = 0; l < DEPTH; ++l) {
        const int pb = 1 + l * NP_LAYER;
        _Pragma("unroll 1") for (int rep_ = 0; rep_ < NREP(0); ++rep_) if (((PHMASK>>0)&1) && IN(pb + 0)) {
            SchedInproj S; S.T.init(M / 256, NU / 256); S.G = G; S.c = bx; S.X = Xb; S.W = (const char*)(ws + WS_WIN) + (size_t)l * NU * D * 2; S.U = Ub;
            S.kv = (l == 0); S.MEMN = (const char*)(ws + WS_MEMN); S.WKV = (const char*)(ws + WS_WKV); S.KV = (char*)(ws + WS_KV);
            pg8::EpiStore E;
            pg8::gemm_phase<false>(lds, D * 2, D * 2, D * 2, S, E, wave);
        }
        SEAM(pb + 0);
        _Pragma("unroll 1") for (int rep_ = 0; rep_ < NREP(1); ++rep_) if (((PHMASK>>1)&1) && IN(pb + 1)) { PHASE_TID
            const float* mu = INP(I_RWMU) + (size_t)l * 1792 + 1536;
            char* LIN = (char*)(ws + WS_R2 + R2_LORA_IN);
            for (int it = bx * NTHR + tid; it < M * 32; it += G * NTHR) {
                const int row = it >> 5, c = (it & 31) * 8;
                const u32x4 cw = *(const u32x4*)(Ub + ((size_t)row * NU + UC_RW + 1536 + c) * 2);
                u32x4 pw = (u32x4){0u, 0u, 0u, 0u};
                if ((row & (SEQ - 1)) != 0) pw = *(const u32x4*)(Ub + ((size_t)(row - 1) * NU + UC_RW + 1536 + c) * 2);
                const f32x4 m0 = *(const f32x4*)(mu + c), m1 = *(const f32x4*)(mu + c + 4);
                float x[8] = {bflo(cw.x), bfhi(cw.x), bflo(cw.y), bfhi(cw.y), bflo(cw.z), bfhi(cw.z), bflo(cw.w), bfhi(cw.w)};
                const float p[8] = {bflo(pw.x), bfhi(pw.x), bflo(pw.y), bfhi(pw.y), bflo(pw.z), bfhi(pw.z), bflo(pw.w), bfhi(pw.w)};
                const float mm[8] = {m0.x, m0.y, m0.z, m0.w, m1.x, m1.y, m1.z, m1.w};
#pragma unroll
                for (int i = 0; i < 8; ++i) { float xs = x[i] + (p[i] - x[i]) * mm[i];
                    if (c < 64) xs = 1.f - 2.f * __builtin_amdgcn_rcpf(1.f + __builtin_amdgcn_exp2f(2.8853900817779268f * xs));
                    else if (c >= 128) xs = sigmoidf_(xs);
                    x[i] = xs; }
                u32x4 o; o.x = pk2(x[0], x[1]); o.y = pk2(x[2], x[3]); o.z = pk2(x[4], x[5]); o.w = pk2(x[6], x[7]);
                *(u32x4*)(LIN + ((size_t)row * 256 + c) * 2) = o;
            }
        }
        SEAM(pb + 1);
        _Pragma("unroll 1") for (int rep_ = 0; rep_ < NREP(2); ++rep_) if (((PHMASK>>2)&1) && IN(pb + 2)) {
            SchedPlain S; S.T.init(M / 256, 6); S.G = G; S.c = bx; S.A = (const char*)(ws + WS_R2 + R2_LORA_IN); S.B = (const char*)(ws + WS_WLORA) + (size_t)l * 1536 * 256 * 2; S.C = (char*)(ws + WS_R2 + R2_LORA_OUT);
            S.lda = 256; S.ldb = 256; S.ldc = 1536;
            pg8::EpiStore E;
            pg8::gemm_phase<false>(lds, 512, 512, 512, S, E, wave);
        }
        SEAM(pb + 2);
        _Pragma("unroll 1") for (int rep_ = 0; rep_ < NREP(3); ++rep_) if (((PHMASK>>3)&1) && IN(pb + 3)) { PHASE_TID
            const char* LO = (const char*)(ws + WS_R2 + R2_LORA_OUT);
            char* HC = (char*)(ws + WS_R2 + R2_HCAT);
            const int tid_ph = tid;
#define SUB_TID unsigned zs_ = 0u; asm volatile("" : "+v"(zs_)); int tid = wave * 64 + (int)__builtin_amdgcn_mbcnt_hi(~0u, __builtin_amdgcn_mbcnt_lo(~0u, zs_)); const int lane = tid & 63; (void)lane;
#pragma unroll 1
            for (int job = bx; job < 256; job += G) {
                if (job < 128) { _Pragma("unroll 1") for (int sr_ = 0; sr_ < NSUB(0); ++sr_) if ((SUBMASK>>0)&1) {
                    SUB_TID
                    const int b = job >> 3, h = job & 7;
                    constexpr int TC = 64;
                    LAS float* OPS = (LAS float*)lds;
                    LAS float* OUTB = OPS + TC * 384;
                    LAS float* BON = OUTB + TC * 64;
                    LAS float* C12 = BON + TC;
                    LAS float* PREV = C12 + 2 * TC;
                    const int pt = tid >> 4, cs = tid & 15, pc = cs * 4, hc = h * 64 + pc;
                    if (tid < 192) PREV[tid] = 0.f;
                    f32x4 S0 = (f32x4){0.f, 0.f, 0.f, 0.f}, S1 = S0, So0 = S0, So1 = S0; float sap0 = 0.f, sap1 = 0.f; f32x2 vprev = (f32x2){0.f, 0.f};
                    u32x2 pu[2][9];
                    auto LOADC = [&](int t0) {
#pragma unroll
                        for (int tt = 0; tt < 2; ++tt) { const int t = t0 + pt + 32 * tt; const size_t row = (size_t)b * SEQ + t; const char* up = Ub + (row * NU + UC_RW + hc) * 2;
                            pu[tt][0] = *(const u32x2*)up; pu[tt][1] = *(const u32x2*)(up + 1024); pu[tt][2] = *(const u32x2*)(up + 2048);
                            if (t > 0) { const char* pp = up - (size_t)NU * 2; pu[tt][3] = *(const u32x2*)pp; pu[tt][4] = *(const u32x2*)(pp + 1024); pu[tt][5] = *(const u32x2*)(pp + 2048); }
                            else { pu[tt][3] = (u32x2){0u, 0u}; pu[tt][4] = pu[tt][3]; pu[tt][5] = pu[tt][3]; }
                            const char* lp = LO + (row * 1536 + hc) * 2; pu[tt][6] = *(const u32x2*)lp; pu[tt][7] = *(const u32x2*)(lp + 1024); pu[tt][8] = *(const u32x2*)(lp + 2048); }
                    };
#define UNP4(w) ((f32x4){bflo((w).x), bfhi((w).x), bflo((w).y), bfhi((w).y)})
#define DOT4(a, b) (((a).x * (b).x + (a).y * (b).y) + ((a).z * (b).z + (a).w * (b).w))
                    LOADC(0);
#pragma unroll 1
                    for (int t0 = 0; t0 < SEQ; t0 += TC) {
                        f32x4 gk[2];
                        int hcv = hc; asm volatile("" : "+v"(hcv));
                        const f32x4 mu_r = *(const f32x4*)(INP(I_RWMU) + (size_t)l * 1792 + hcv), mu_k = *(const f32x4*)(INP(I_RWMU) + (size_t)l * 1792 + 512 + hcv), mu_v = *(const f32x4*)(INP(I_RWMU) + (size_t)l * 1792 + 1024 + hcv);
                        const f32x4 w0 = *(const f32x4*)(INP(I_RWW0) + l * 512 + hcv), a0 = *(const f32x4*)(INP(I_RWA0) + l * 512 + hcv), kkw = *(const f32x4*)(INP(I_RWKK) + l * 512 + hcv);
                        const f32x4 kaw = *(const f32x4*)(INP(I_RWKA) + l * 512 + hcv), rkw = *(const f32x4*)(INP(I_RWRK) + l * 512 + hcv);
#pragma unroll
                        for (int tt = 0; tt < 2; ++tt) { const int tok = pt + 32 * tt;
                            const f32x4 ur = UNP4(pu[tt][0]), uk = UNP4(pu[tt][1]), uv = UNP4(pu[tt][2]), urp = UNP4(pu[tt][3]), ukp = UNP4(pu[tt][4]), uvp = UNP4(pu[tt][5]), lw = UNP4(pu[tt][6]), la = UNP4(pu[tt][7]);
                            gk[tt] = UNP4(pu[tt][8]);
                            const f32x4 xr = ur + (urp - ur) * mu_r, xk = uk + (ukp - uk) * mu_k, xv = uv + (uvp - uv) * mu_v;
                            f32x4 dec, av, kkv, kp; float ss = 0.f, bsum = 0.f;
#pragma unroll
                            for (int i = 0; i < 4; ++i) {
                                const float y = -(w0[i] + lw[i]);
                                const float sp = fmaxf(y, 0.f) + __logf(1.f + __expf(-fabsf(y)));
                                dec[i] = __expf(-__expf(-sp - 0.5f));
                                av[i] = sigmoidf_(a0[i] + la[i]);
                                kkv[i] = xk[i] * kkw[i]; ss += kkv[i] * kkv[i];
                                kp[i] = xk[i] * (1.f + (av[i] - 1.f) * kaw[i]);
                                bsum += xr[i] * kp[i] * rkw[i];
                            }
                            ss = red16(ss); bsum = red16(bsum);
                            const float inv = __builtin_amdgcn_rsqf(fmaxf(ss, 1e-24f));
                            const f32x4 kk = kkv * inv, kka = kk * av;
                            LAS float* o = OPS + tok * 384 + pc;
                            *(LAS f32x4*)(o) = dec; *(LAS f32x4*)(o + 64) = kk; *(LAS f32x4*)(o + 128) = kka; *(LAS f32x4*)(o + 192) = kp; *(LAS f32x4*)(o + 256) = xr; *(LAS f32x4*)(o + 320) = xv;
                            if (cs == 0) BON[tok] = bsum;
                        }
                        if (t0 + TC < SEQ) LOADC(t0 + TC);
                        __syncthreads();
#pragma unroll
                        for (int tt = 0; tt < 2; ++tt) { const int tok = pt + 32 * tt;
                            const LAS float* pr = OPS + (tok - 1) * 384 + pc;
                            f32x4 pw, pkp, pka;
                            if (tok > 0) { pw = *(const LAS f32x4*)pr; pkp = *(const LAS f32x4*)(pr + 192); pka = *(const LAS f32x4*)(pr + 128); }
                            else { pw = *(const LAS f32x4*)(PREV + pc); pkp = *(const LAS f32x4*)(PREV + 64 + pc); pka = *(const LAS f32x4*)(PREV + 128 + pc); }
                            LAS float* zp = OPS + tok * 384 + 64 + pc;
                            const f32x4 z = *(const LAS f32x4*)zp;
                            const float c1 = red16(DOT4(pkp, z)), c2 = red16(DOT4(pka, z));
                            *(LAS f32x4*)zp = pw * z;
                            if (cs == 0) *(LAS f32x2*)(C12 + 2 * tok) = (f32x2){c1, c2};
                        }
                        __syncthreads();
                        {
                            const LAS float* qb = OPS + pc; const LAS float* vb = OPS + 320 + 2 * pt;
                            float dc0, dc1;
                            { const f32x4 y0 = *(const LAS f32x4*)(qb + 64); dc0 = red16(DOT4(So0, y0)); dc1 = red16(DOT4(So1, y0)); }
                            f32x4 w4 = *(const LAS f32x4*)(qb), ka4 = *(const LAS f32x4*)(qb + 128), kp4 = *(const LAS f32x4*)(qb + 192), r4 = *(const LAS f32x4*)(qb + 256), yn = *(const LAS f32x4*)(qb + 384 + 64);
                            f32x2 v2 = *(const LAS f32x2*)vb, c12 = *(const LAS f32x2*)C12;
#define RW_STEP(s, LASTSTEP) do { \
                                const int s1 = (s) + 1 < TC ? (s) + 1 : TC - 1, s2 = (s) + 2 < TC ? (s) + 2 : TC - 1; \
                                const f32x4 nw4 = *(const LAS f32x4*)(qb + s1 * 384), nka4 = *(const LAS f32x4*)(qb + s1 * 384 + 128), nkp4 = *(const LAS f32x4*)(qb + s1 * 384 + 192), nr4 = *(const LAS f32x4*)(qb + s1 * 384 + 256), nyn = *(const LAS f32x4*)(qb + s2 * 384 + 64); \
                                const f32x2 nv2 = *(const LAS f32x2*)(vb + s1 * 384), nc12 = *(const LAS f32x2*)(C12 + 2 * s1); \
                                const float sa0 = dc0 + (vprev.x * c12.x - sap0 * c12.y), sa1 = dc1 + (vprev.y * c12.x - sap1 * c12.y); \
                                float dn0 = 0.f, dn1 = 0.f; \
                                if (LASTSTEP) { So0 = S0; So1 = S1; } else { dn0 = red16(DOT4(S0, yn)); dn1 = red16(DOT4(S1, yn)); } \
                                S0 = S0 * w4 + (kp4 * v2.x - ka4 * sa0); S1 = S1 * w4 + (kp4 * v2.y - ka4 * sa1); \
                                float o0 = red16(DOT4(S0, r4)), o1 = red16(DOT4(S1, r4)); \
                                if (cs == 0) *(LAS f32x2*)(OUTB + (s) * 64 + 2 * pt) = (f32x2){o0, o1}; \
                                sap0 = sa0; sap1 = sa1; vprev = v2; dc0 = dn0; dc1 = dn1; \
                                w4 = nw4; ka4 = nka4; kp4 = nkp4; r4 = nr4; yn = nyn; v2 = nv2; c12 = nc12; __builtin_amdgcn_sched_barrier(0); } while (0)
#pragma unroll 1
                            for (int s = 0; s < TC - 2; s += 2) { RW_STEP(s, false); RW_STEP(s + 1, false); }
                            RW_STEP(TC - 2, false);
                            RW_STEP(TC - 1, true);
#undef RW_STEP
                        }
                        __syncthreads();
                        int hcw = hc; asm volatile("" : "+v"(hcw));
                        const f32x4 lng = *(const f32x4*)(INP(I_RWLNG) + l * 512 + hcw), lnb = *(const f32x4*)(INP(I_RWLNB) + l * 512 + hcw);
#pragma unroll
                        for (int tt = 0; tt < 2; ++tt) { const int tok = pt + 32 * tt;
                            const f32x4 o4 = *(const LAS f32x4*)(OUTB + tok * 64 + pc), v4 = *(const LAS f32x4*)(OPS + tok * 384 + 320 + pc);
                            const float mean = red16((o4.x + o4.y) + (o4.z + o4.w)) * (1.f / 64.f);
                            const f32x4 dv = o4 - mean;
                            const float var = red16(DOT4(dv, dv)) * (1.f / 64.f);
                            const float rstd = __builtin_amdgcn_rsqf(var + RW_GN_EPS), bo = BON[tok];
                            const f32x4 y = (dv * rstd * lng + lnb + v4 * bo) * gk[tt];
                            st4bf(HC + (((size_t)b * SEQ + t0 + tok) * 1536 + 512 + hc) * 2, y);
                        }
                        if (tid < 192) { const int j = tid >> 6, c = tid & 63; PREV[tid] = OPS[(TC - 1) * 384 + (j == 0 ? 0 : (j == 1 ? 192 : 128)) + c]; }
                        __syncthreads();
                    }
                } } else {
                    const int idx = job - 128, bh = idx >> 1, half = idx & 1, b = bh >> 2, h = bh & 3;
                    _Pragma("unroll 1") for (int sr_ = 0; sr_ < NSUB(1); ++sr_) if ((SUBMASK>>1)&1) {
                        SUB_TID
                        constexpr int TC = 64;
                        LAS float* QK = (LAS float*)lds;
                        LAS float* VV = QK + TC * 128;
                        LAS float* FI = VV + TC * 64;
                        LAS float* NUM = FI + TC * 4;
                        LAS float* DENP = NUM + TC * 64;
                        const int pt = tid >> 4, cg = tid & 15;
                        const int ccol = (cg < 8) ? (h * 64 + 8 * cg) : (256 + h * 64 + 8 * (cg - 8));
                        float cw[4][8], cb[8];
#pragma unroll
                        for (int j = 0; j < 4; ++j) { const f32x4 a = *(const f32x4*)(INP(I_CONVW) + ((size_t)l * 4 + j) * 512 + ccol), c2 = *(const f32x4*)(INP(I_CONVW) + ((size_t)l * 4 + j) * 512 + ccol + 4);
                            cw[j][0] = a.x; cw[j][1] = a.y; cw[j][2] = a.z; cw[j][3] = a.w; cw[j][4] = c2.x; cw[j][5] = c2.y; cw[j][6] = c2.z; cw[j][7] = c2.w; }
                        { const f32x4 a = *(const f32x4*)(INP(I_CONVB) + l * 512 + ccol), c2 = *(const f32x4*)(INP(I_CONVB) + l * 512 + ccol + 4);
                            cb[0] = a.x; cb[1] = a.y; cb[2] = a.z; cb[3] = a.w; cb[4] = c2.x; cb[5] = c2.y; cb[6] = c2.z; cb[7] = c2.w; }
                        const float qsc = (cg < 8) ? 0.125f : 1.f;
                        const float igb = INP(I_IGB)[l * 4 + h], fgb = INP(I_FGB)[l * 4 + h];
                        const int r = tid >> 3, cs8 = (tid & 7) * 8;
                        const int ne = 8 * wave + (lane & 7);
                        float C[8] = {0.f, 0.f, 0.f, 0.f, 0.f, 0.f, 0.f, 0.f}; float nreg = 0.f, mprev = 0.f;
                        u32x4 cu[2][4]; u32x2 vu[2]; float gi = 0.f, gf = 0.f;
                        auto LOADM = [&](int t0) {
#pragma unroll
                            for (int tt = 0; tt < 2; ++tt) { const int t = t0 + pt + 32 * tt; const size_t row = (size_t)b * SEQ + t;
#pragma unroll
                                for (int j = 0; j < 4; ++j) { if (t - 3 + j >= 0) cu[tt][j] = *(const u32x4*)(Ub + ((row - 3 + j) * NU + UC_QK + ccol) * 2); else cu[tt][j] = (u32x4){0u, 0u, 0u, 0u}; }
                                vu[tt] = *(const u32x2*)(Ub + (row * NU + UC_V + h * 128 + half * 64 + 4 * cg) * 2); }
                            if (wave == 0) { const size_t rg = (size_t)b * SEQ + t0 + lane; gi = GIF[rg * 8 + h]; gf = GIF[rg * 8 + 4 + h]; }
                        };
                        LOADM(0);
#pragma unroll 1
                        for (int t0 = 0; t0 < SEQ; t0 += TC) {
#pragma unroll
                            for (int tt = 0; tt < 2; ++tt) { const int tok = pt + 32 * tt; float y[8];
#pragma unroll
                                for (int i = 0; i < 8; ++i) y[i] = cb[i];
#pragma unroll
                                for (int j = 0; j < 4; ++j) { const u32x4 w = cu[tt][j]; const float x[8] = {bflo(w.x), bfhi(w.x), bflo(w.y), bfhi(w.y), bflo(w.z), bfhi(w.z), bflo(w.w), bfhi(w.w)};
#pragma unroll
                                    for (int i = 0; i < 8; ++i) y[i] += cw[j][i] * x[i]; }
#pragma unroll
                                for (int i = 0; i < 8; ++i) y[i] = y[i] * sigmoidf_(y[i]) * qsc;
                                LAS float* o = QK + tok * 128 + 8 * cg;
                                *(LAS f32x4*)o = (f32x4){y[0], y[1], y[2], y[3]}; *(LAS f32x4*)(o + 4) = (f32x4){y[4], y[5], y[6], y[7]};
                                *(LAS f32x4*)(VV + tok * 64 + 4 * cg) = (f32x4){bflo(vu[tt].x), bfhi(vu[tt].x), bflo(vu[tt].y), bfhi(vu[tt].y)};
                            }
                            if (wave == 0) {
                                const float ig = gi + igb, fp = gf + fgb;
                                const float lf = -(fmaxf(-fp, 0.f) + __logf(1.f + __expf(-fabsf(fp))));
                                float bc = lf;
#pragma unroll
                                for (int o = 1; o < 64; o <<= 1) { const float t = __shfl_up(bc, o); if (lane >= o) bc += t; }
                                float pm = ig - bc;
#pragma unroll
                                for (int o = 1; o < 64; o <<= 1) { const float t = __shfl_up(pm, o); if (lane >= o) pm = fmaxf(pm, t); }
                                const float mt = bc + fmaxf(mprev, pm);
                                float mp1 = __shfl_up(mt, 1); if (lane == 0) mp1 = mprev;
                                const float fpr = __expf(lf + mp1 - mt), ipr = __expf(ig - mt), em = __expf(-mt);
                                *(LAS f32x4*)(FI + lane * 4) = (f32x4){fpr, ipr, em, 0.f};
                                mprev = __shfl(mt, 63);
                            }
                            if (t0 + TC < SEQ) LOADM(t0 + TC);
                            __syncthreads();
                            {
                                const LAS float* qp0 = QK + cs8;
                                f32x4 q0 = *(const LAS f32x4*)qp0, q1 = *(const LAS f32x4*)(qp0 + 4), k0 = *(const LAS f32x4*)(qp0 + 64), k1 = *(const LAS f32x4*)(qp0 + 68), fi = *(const LAS f32x4*)FI;
                                float vv = VV[r], nk = QK[64 + ne], nq = QK[ne];
#pragma unroll 1
                                for (int s = 0; s < TC; ++s) {
                                    const int s1 = s + 1 < TC ? s + 1 : TC - 1; const LAS float* qp = qp0 + s1 * 128;
                                    const f32x4 nq0 = *(const LAS f32x4*)qp, nq1 = *(const LAS f32x4*)(qp + 4), nk0 = *(const LAS f32x4*)(qp + 64), nk1 = *(const LAS f32x4*)(qp + 68), nfi = *(const LAS f32x4*)(FI + s1 * 4);
                                    const float nvv = VV[s1 * 64 + r], nnk = QK[s1 * 128 + 64 + ne], nnq = QK[s1 * 128 + ne];
                                    const float tv = fi.y * vv;
                                    C[0] = fi.x * C[0] + tv * k0.x; C[1] = fi.x * C[1] + tv * k0.y; C[2] = fi.x * C[2] + tv * k0.z; C[3] = fi.x * C[3] + tv * k0.w;
                                    C[4] = fi.x * C[4] + tv * k1.x; C[5] = fi.x * C[5] + tv * k1.y; C[6] = fi.x * C[6] + tv * k1.z; C[7] = fi.x * C[7] + tv * k1.w;
                                    float p = ((C[0] * q0.x + C[1] * q0.y) + (C[2] * q0.z + C[3] * q0.w)) + ((C[4] * q1.x + C[5] * q1.y) + (C[6] * q1.z + C[7] * q1.w));
                                    p = red8(p);
                                    nreg = fi.x * nreg + fi.y * nk;
                                    const float dp = red8(nreg * nq);
                                    if ((tid & 7) == 0) NUM[s * 64 + r] = p;
                                    if (lane == 0) DENP[s * 8 + wave] = dp;
                                    q0 = nq0; q1 = nq1; k0 = nk0; k1 = nk1; fi = nfi; vv = nvv; nk = nnk; nq = nnq;
                                }
                            }
                            __syncthreads();
#pragma unroll
                            for (int tt = 0; tt < 2; ++tt) { const int tok = pt + 32 * tt;
                                const f32x4 d0 = *(const LAS f32x4*)(DENP + tok * 8), d1 = *(const LAS f32x4*)(DENP + tok * 8 + 4);
                                const float den = ((d0.x + d0.y) + (d0.z + d0.w)) + ((d1.x + d1.y) + (d1.z + d1.w)), em = FI[tok * 4 + 2];
                                const float rdn = 1.f / fmaxf(fabsf(den), em);
                                const f32x4 nv = *(const LAS f32x4*)(NUM + tok * 64 + 4 * cg);
                                st4bf((char*)(ws + WS_HML) + (((size_t)b * SEQ + t0 + tok) * 512 + h * 128 + half * 64 + 4 * cg) * 2, nv * rdn);
                            }
                            __syncthreads();
                        }
                    }
                    _Pragma("unroll 1") for (int sr_ = 0; sr_ < NSUB(2); ++sr_) if ((SUBMASK>>2)&1) {
                        SUB_TID
                        constexpr int KST = 272, VST = 520;
                        LAS unsigned char* KI = lds; LAS unsigned char* VI = lds + 256 * KST;
                        const char* kvb = (const char*)(ws + WS_KV) + (((size_t)l * MROWS + (size_t)b * MEML) * D) * 2;
                        for (int p = tid; p < 4096; p += NTHR) { const int key = p >> 4, c16 = p & 15;
                            *(LAS u32x4*)(KI + key * KST + c16 * 16) = *(const u32x4*)(kvb + ((size_t)key * D + h * 128 + c16 * 8) * 2); }
                        for (int p = tid; p < 4096; p += NTHR) { const int key = p & 255, d8 = p >> 8;
                            const u32x4 w = *(const u32x4*)(kvb + ((size_t)key * D + 512 + h * 128 + d8 * 8) * 2);
                            LAS unsigned char* o = VI + (d8 * 8) * VST + key * 2;
                            *(LAS bf16*)(o) = (bf16)(w.x & 0xffff); *(LAS bf16*)(o + VST) = (bf16)(w.x >> 16); *(LAS bf16*)(o + 2 * VST) = (bf16)(w.y & 0xffff); *(LAS bf16*)(o + 3 * VST) = (bf16)(w.y >> 16);
                            *(LAS bf16*)(o + 4 * VST) = (bf16)(w.z & 0xffff); *(LAS bf16*)(o + 5 * VST) = (bf16)(w.z >> 16); *(LAS bf16*)(o + 6 * VST) = (bf16)(w.w & 0xffff); *(LAS bf16*)(o + 7 * VST) = (bf16)(w.w >> 16); }
                        __syncthreads();
                        const int r31 = lane & 31, h2 = lane >> 5;
                        constexpr float SC = 0.08838834764831845f * 1.4426950408889634f;
#pragma unroll 1
                        for (int rd = 0; rd < 8; ++rd) {
                            const size_t qrow = (size_t)b * SEQ + half * 2048 + rd * 256 + wave * 32 + r31;
                            bf16x8 qf[8];
#pragma unroll
                            for (int ks = 0; ks < 8; ++ks) qf[ks] = *(const bf16x8*)(Ub + (qrow * NU + UC_CAQ + h * 128 + 16 * ks + 8 * h2) * 2);
                            f32x16 O[4];
#pragma unroll
                            for (int db = 0; db < 4; ++db)
#pragma unroll
                                for (int i = 0; i < 16; ++i) O[db][i] = 0.f;
                            float mrun = -1e30f, lrun = 0.f;
#pragma unroll 1
                            for (int hf = 0; hf < 2; ++hf) {
                                f32x16 X[4];
#pragma unroll
                                for (int kb = 0; kb < 4; ++kb) {
                                    bf16x8 kf[8];
#pragma unroll
                                    for (int ks = 0; ks < 8; ++ks) kf[ks] = *(const LAS bf16x8*)(KI + (hf * 128 + kb * 32 + r31) * KST + (16 * ks + 8 * h2) * 2);
                                    __builtin_amdgcn_sched_barrier(0);
#pragma unroll
                                    for (int i = 0; i < 16; ++i) X[kb][i] = 0.f;
#pragma unroll
                                    for (int ks = 0; ks < 8; ++ks) X[kb] = __builtin_amdgcn_mfma_f32_32x32x16_bf16(kf[ks], qf[ks], X[kb], 0, 0, 0);
                                    __builtin_amdgcn_sched_barrier(0);
                                }
                                float mx = -1e30f;
#pragma unroll
                                for (int kb = 0; kb < 4; ++kb)
#pragma unroll
                                    for (int i = 0; i < 16; ++i) mx = fmaxf(mx, X[kb][i]);
                                mx = fmaxf(mx, __shfl_xor(mx, 32));
                                const float mnew = fmaxf(mrun, mx), alpha = __builtin_amdgcn_exp2f((mrun - mnew) * SC);
                                float ls = 0.f;
#pragma unroll
                                for (int kb = 0; kb < 4; ++kb)
#pragma unroll
                                    for (int i = 0; i < 16; ++i) { const float p = __builtin_amdgcn_exp2f((X[kb][i] - mnew) * SC); X[kb][i] = p; ls += p; }
                                ls += __shfl_xor(ls, 32);
                                lrun = lrun * alpha + ls; mrun = mnew;
#pragma unroll
                                for (int db = 0; db < 4; ++db)
#pragma unroll
                                    for (int i = 0; i < 16; ++i) O[db][i] *= alpha;
#pragma unroll
                                for (int kb = 0; kb < 4; ++kb) {
                                    bf16x8 vf[2][4], pf[2];
#pragma unroll
                                    for (int s = 0; s < 2; ++s) {
                                        u32x4 pw; pw.x = pk2(X[kb][8 * s], X[kb][8 * s + 1]); pw.y = pk2(X[kb][8 * s + 2], X[kb][8 * s + 3]); pw.z = pk2(X[kb][8 * s + 4], X[kb][8 * s + 5]); pw.w = pk2(X[kb][8 * s + 6], X[kb][8 * s + 7]);
                                        pf[s] = __builtin_bit_cast(bf16x8, pw);
#pragma unroll
                                        for (int db = 0; db < 4; ++db) {
                                            const LAS unsigned char* vp = VI + (db * 32 + r31) * VST + (hf * 128 + kb * 32 + 16 * s + 4 * h2) * 2;
                                            const u32x2 lo = *(const LAS u32x2*)vp, hi = *(const LAS u32x2*)(vp + 16);
                                            vf[s][db] = __builtin_bit_cast(bf16x8, (u32x4){lo.x, lo.y, hi.x, hi.y});
                                        }
                                    }
                                    __builtin_amdgcn_sched_barrier(0);
#pragma unroll
                                    for (int s = 0; s < 2; ++s)
#pragma unroll
                                        for (int db = 0; db < 4; ++db) O[db] = __builtin_amdgcn_mfma_f32_32x32x16_bf16(vf[s][db], pf[s], O[db], 0, 0, 0);
                                    __builtin_amdgcn_sched_barrier(0);
                                }
                            }
                            const float rl = 1.f / lrun;
                            char* op = HC + (qrow * 1536 + 1024 + h * 128) * 2;
#pragma unroll
                            for (int db = 0; db < 4; ++db)
#pragma unroll
                                for (int g4 = 0; g4 < 4; ++g4) { u32x2 w; w.x = pk2(O[db][4 * g4] * rl, O[db][4 * g4 + 1] * rl); w.y = pk2(O[db][4 * g4 + 2] * rl, O[db][4 * g4 + 3] * rl);
                                    *(u32x2*)(op + (db * 32 + 8 * g4 + 4 * h2) * 2) = w; }
                        }
                        __syncthreads();
                    }
                }
            }
#undef UNP4
#undef DOT4
#undef SUB_TID
        }
        SEAM(pb + 3);
        _Pragma("unroll 1") for (int rep_ = 0; rep_ < NREP(4); ++rep_) if (((PHMASK>>4)&1) && IN(pb + 4)) { PHASE_TID
            char* HC = (char*)(ws + WS_R2 + R2_HCAT);
            const int hd = lane >> 4, sb = (lane & 15) * 8;
            const f32x4 g0 = *(const f32x4*)(INP(I_MLNORMG) + l * 512 + hd * 128 + sb), g1 = *(const f32x4*)(INP(I_MLNORMG) + l * 512 + hd * 128 + sb + 4);
            for (int m = gw; m < M; m += NGW) {
                const u32x4 hw = *(const u32x4*)((const char*)(ws + WS_HML) + ((size_t)m * 512 + hd * 128 + sb) * 2);
                const u32x4 ow = *(const u32x4*)(Ub + ((size_t)m * NU + UC_OG + hd * 128 + sb) * 2);
                float v[8] = {bflo(hw.x), bfhi(hw.x), bflo(hw.y), bfhi(hw.y), bflo(hw.z), bfhi(hw.z), bflo(hw.w), bfhi(hw.w)};
                const float og[8] = {bflo(ow.x), bfhi(ow.x), bflo(ow.y), bfhi(ow.y), bflo(ow.z), bfhi(ow.z), bflo(ow.w), bfhi(ow.w)};
                const float gg[8] = {g0.x, g0.y, g0.z, g0.w, g1.x, g1.y, g1.z, g1.w};
                float s = 0.f;
#pragma unroll
                for (int i = 0; i < 8; ++i) s += v[i];
                const float mean = red16(s) * (1.f / 128.f); float s2 = 0.f;
#pragma unroll
                for (int i = 0; i < 8; ++i) { v[i] -= mean; s2 += v[i] * v[i]; }
                const float rstd = 1.f / sqrtf(red16(s2) * (1.f / 128.f) + LN_EPS);
#pragma unroll
                for (int i = 0; i < 8; ++i) v[i] = sigmoidf_(og[i]) * (v[i] * rstd * gg[i]);
                u32x4 o; o.x = pk2(v[0], v[1]); o.y = pk2(v[2], v[3]); o.z = pk2(v[4], v[5]); o.w = pk2(v[6], v[7]);
                *(u32x4*)(HC + ((size_t)m * 1536 + hd * 128 + sb) * 2) = o;
            }
        }
        SEAM(pb + 4);
        _Pragma("unroll 1") for (int rep_ = 0; rep_ < NREP(5); ++rep_) if (((PHMASK>>5)&1) && IN(pb + 5)) {
            SchedPlain S; S.T.init(M / 256, 4); S.G = G; S.c = bx; S.A = (const char*)(ws + WS_R2 + R2_HCAT); S.B = (const char*)(ws + WS_WBR) + (size_t)l * 1024 * 1536 * 2; S.C = (char*)(ws + WS_R2 + R2_YPRE);
            S.lda = 1536; S.ldb = 1536; S.ldc = D;
            pg8::EpiMerge E; E.U = Ub; E.gate_b = INP(I_GATEB) + (size_t)l * 3072;
            pg8::gemm_phase<false, true>(lds, 1536 * 2, 1536 * 2, 1536 * 2, S, E, wave);
        }
        SEAM(pb + 5);
        _Pragma("unroll 1") for (int rep_ = 0; rep_ < NREP(6); ++rep_) if (((PHMASK>>6)&1) && IN(pb + 6)) {
            SchedPlain S; S.T.init(M / 256, 4); S.G = G; S.c = bx; S.A = (const char*)(ws + WS_R2 + R2_YPRE); S.B = (const char*)(ws + WS_WO) + (size_t)l * D * D * 2; S.C = (char*)(ws + WS_R2 + R2_Z);
            S.lda = D; S.ldb = D; S.ldc = D;
            pg8::EpiStore E;
            pg8::gemm_phase<false>(lds, D * 2, D * 2, D * 2, S, E, wave);
        }
        SEAM(pb + 6);
        _Pragma("unroll 1") for (int rep_ = 0; rep_ < NREP(7); ++rep_) if (((PHMASK>>7)&1) && IN(pb + 7)) { PHASE_TID
            LAS float* WR = (LAS float*)lds;
            for (int i = tid; i < 32768; i += NTHR) { const int k = i >> 5, e = i & 31; WR[e * 1024 + k] = INP(I_RTW)[((size_t)l * D + k) * 32 + e]; }
            __syncthreads();
            f32x4 g[4], bb[4];
#pragma unroll
            for (int j = 0; j < 4; ++j) { g[j] = *(const f32x4*)(INP(I_LN1G) + l * D + 256 * j + 4 * lane); bb[j] = *(const f32x4*)(INP(I_LN1B) + l * D + 256 * j + 4 * lane); }
            const float rbias = INP(I_RTB)[l * 32 + (lane & 31)];
            const char* Zb = (const char*)(ws + WS_R2 + R2_Z);
            int* TKE = (int*)(ws + WS_TKE); float* TKG = (float*)(ws + WS_TKG); int* TKP = (int*)(ws + WS_TKP); int* ROWTOK = (int*)(ws + WS_ROWTOK);
            LAS unsigned* LCNT = (LAS unsigned*)(lds + 131072);
            LAS unsigned* GBASE = LCNT + 32; LAS unsigned* LLEN = LCNT + 64; LAS unsigned* LIST = LCNT + 128;
            if (tid < 65) LCNT[tid] = 0u;
            __syncthreads();
#pragma unroll 1
            for (int pp = gw; pp < M / 2; pp += NGW) {
                f32x4 y0[4], y1[4];
#pragma unroll
                for (int j = 0; j < 4; ++j) { y0[j] = ld4bf(Zb + ((size_t)(2 * pp) * D + 256 * j + 4 * lane) * 2) + ld4bf(Xb + ((size_t)(2 * pp) * D + 256 * j + 4 * lane) * 2) * DN_ALPHA;
                    y1[j] = ld4bf(Zb + ((size_t)(2 * pp + 1) * D + 256 * j + 4 * lane) * 2) + ld4bf(Xb + ((size_t)(2 * pp + 1) * D + 256 * j + 4 * lane) * 2) * DN_ALPHA; }
                ln16(y0, g, bb); ln16(y1, g, bb);
#pragma unroll
                for (int j = 0; j < 4; ++j) { st4bf(Xb + ((size_t)(2 * pp) * D + 256 * j + 4 * lane) * 2, y0[j]); st4bf(Xb + ((size_t)(2 * pp + 1) * D + 256 * j + 4 * lane) * 2, y1[j]); }
                float v[64];
#pragma unroll
                for (int e = 0; e < 32; ++e) { float s0 = 0.f, s1 = 0.f;
#pragma unroll
                    for (int j = 0; j < 4; ++j) { const f32x4 w = *(const LAS f32x4*)(WR + e * 1024 + 256 * j + 4 * lane);
                        s0 += (y0[j].x * w.x + y0[j].y * w.y) + (y0[j].z * w.z + y0[j].w * w.w); s1 += (y1[j].x * w.x + y1[j].y * w.y) + (y1[j].z * w.z + y1[j].w * w.w); }
                    v[e] = s0; v[32 + e] = s1; if ((e & 3) == 3) __builtin_amdgcn_sched_barrier(0); }
#pragma unroll
                for (int bsh = 5; bsh >= 0; --bsh) { const int n2 = 1 << bsh; const bool up = (lane >> bsh) & 1;
#pragma unroll
                    for (int i = 0; i < n2; ++i) { const float send = up ? v[i] : v[i + n2], keep = up ? v[i + n2] : v[i]; v[i] = keep + __shfl_xor(send, n2); } }
                float cur = v[0] + rbias;
                const int half = lane >> 5, el = lane & 31;
                float tv[4]; int te[4];
#pragma unroll
                for (int k = 0; k < 4; ++k) { float mx = cur;
#pragma unroll
                    for (int o = 1; o < 32; o <<= 1) mx = fmaxf(mx, __shfl_xor(mx, o));
                    const unsigned long long bal = __ballot(cur == mx); const unsigned hm = (unsigned)(bal >> (32 * half));
                    const int win = __builtin_ctz(hm); tv[k] = mx; te[k] = win; if (el == win) cur = -3.0e38f; }
                const float e1 = __expf(tv[1] - tv[0]), e2 = __expf(tv[2] - tv[0]), e3 = __expf(tv[3] - tv[0]), rs = 1.f / (1.f + e1 + e2 + e3);
                const float gt[4] = {rs, e1 * rs, e2 * rs, e3 * rs};
                const int token = 2 * pp + half;
#pragma unroll
                for (int k = 0; k < 4; ++k) if (el == te[k] && rep_ == 0) {
                    const unsigned lpos = __hip_atomic_fetch_add(LCNT + el, 1u, __ATOMIC_RELAXED, __HIP_MEMORY_SCOPE_WORKGROUP);
                    const unsigned li = __hip_atomic_fetch_add(LLEN, 1u, __ATOMIC_RELAXED, __HIP_MEMORY_SCOPE_WORKGROUP);
                    LIST[2 * li] = (unsigned)(token * 4 + k); LIST[2 * li + 1] = (unsigned)el | (lpos << 8);
                    TKE[token * 4 + k] = el; TKG[token * 4 + k] = gt[k]; }
            }
            __syncthreads();
            if (tid < 32 && rep_ == 0) GBASE[tid] = __hip_atomic_fetch_add((unsigned*)ctl + CW_CNT + (l * 32 + tid) * 64, LCNT[tid], RLX_AGENT);
            __syncthreads();
            if (rep_ == 0) { const unsigned n = LLEN[0];
                for (unsigned i = tid; i < n; i += NTHR) { const unsigned tk = LIST[2 * i], ev = LIST[2 * i + 1], e = ev & 255u, pos = GBASE[e] + (ev >> 8);
                    TKP[tk] = (int)pos; ROWTOK[(size_t)e * M + pos] = (int)(tk >> 2); } }
            __syncthreads();
        }
        SEAM(pb + 7);
        _Pragma("unroll 1") for (int rep_ = 0; rep_ < NREP(8); ++rep_) if (((PHMASK>>8)&1) && IN(pb + 8)) { PHASE_TID
            if (tid < 32) CNT[tid] = (int)__hip_atomic_load((unsigned*)ctl + CW_CNT + (l * 32 + tid) * 64, RLX_AGENT);
            __syncthreads();
            if (tid == 0) { int a = 0; for (int e = 0; e < 32; ++e) { PB[e] = a; a += (CNT[e] + 255) >> 8; } PB[32] = a; }
            __syncthreads();
            const int P = PB[32];
            const int* ROWTOK = (const int*)(ws + WS_ROWTOK);
            char* XD = (char*)(ws + WS_R1);
            for (int sb = gw * 64; sb < P * 256; sb += NGW * 64) {
                const int pm = sb >> 8; int e = 0;
#pragma unroll 1
                for (int j = 1; j < NEXP; ++j) e += (PB[j] <= pm) ? 1 : 0;
                const int pos0 = sb - PB[e] * 256, cnt = CNT[e];
                int nvalid = cnt - pos0; nvalid = nvalid > 64 ? 64 : nvalid;
                int tokv = -1; if (pos0 + lane < cnt) tokv = ROWTOK[(size_t)e * M + pos0 + lane];
#pragma unroll 1
                for (int j = 0; j < nvalid; j += 2) {
                    int t[2]; u32x4 a[2], b2[2];
#pragma unroll
                    for (int i = 0; i < 2; ++i) { t[i] = __builtin_amdgcn_readlane(tokv, j + i);
                        if (t[i] >= 0) { a[i] = *(const u32x4*)(Xb + (size_t)t[i] * 2048 + lane * 32); b2[i] = *(const u32x4*)(Xb + (size_t)t[i] * 2048 + lane * 32 + 16); } }
#pragma unroll
                    for (int i = 0; i < 2; ++i) if (t[i] >= 0) {
                        u32x4 o; o.x = pk4_f8(bflo(a[i].x) * F8_SX, bfhi(a[i].x) * F8_SX, bflo(a[i].y) * F8_SX, bfhi(a[i].y) * F8_SX); o.y = pk4_f8(bflo(a[i].z) * F8_SX, bfhi(a[i].z) * F8_SX, bflo(a[i].w) * F8_SX, bfhi(a[i].w) * F8_SX);
                        o.z = pk4_f8(bflo(b2[i].x) * F8_SX, bfhi(b2[i].x) * F8_SX, bflo(b2[i].y) * F8_SX, bfhi(b2[i].y) * F8_SX); o.w = pk4_f8(bflo(b2[i].z) * F8_SX, bfhi(b2[i].z) * F8_SX, bflo(b2[i].w) * F8_SX, bfhi(b2[i].w) * F8_SX);
                        *(u32x4*)(XD + (size_t)(sb + j + i) * 1024 + lane * 16) = o; }
                }
            }
            LAS float* scr = (LAS float*)(lds + wave * 8448);
            constexpr int IT_GU = 32 * 16 * 64, IT_DN = 32 * 16 * 32;
            for (int it = gw; it < IT_GU + IT_DN; it += NGW) {
                if (it < IT_GU) { const int e = it >> 10, q = it & 1023, kb = q >> 6, nb = q & 63;
                    transpose_item_f8(INP(I_WGU) + (((size_t)l * 32 + e) * D + 64 * kb) * 2048 + 32 * nb, 2048, (unsigned char*)(ws + WS_WGU) + ((size_t)e * 2048 + 32 * nb) * D + 64 * kb, D, F8_SWGU, scr, lane); }
                else { const int r = it - IT_GU, e = r >> 9, q = r & 511, kb = q >> 5, nb = q & 31;
                    transpose_item_f8(INP(I_WDN) + (((size_t)l * 32 + e) * D + 64 * kb) * 1024 + 32 * nb, 1024, (unsigned char*)(ws + WS_WDN) + ((size_t)e * 1024 + 32 * nb) * D + 64 * kb, D, F8_SWDN, scr, lane); }
            }
            __syncthreads();
        }
        SEAM(pb + 8);
        if (IN(pb + 9) || IN(pb + 10)) { PHASE_TID
            if (tid < 32) CNT[tid] = (int)__hip_atomic_load((unsigned*)ctl + CW_CNT + (l * 32 + tid) * 64, RLX_AGENT);
            __syncthreads();
            if (tid == 0) { int a = 0; for (int e = 0; e < 32; ++e) { PB[e] = a; a += (CNT[e] + 255) >> 8; } PB[32] = a; }
            __syncthreads();
        }
        _Pragma("unroll 1") for (int rep_ = 0; rep_ < NREP(9); ++rep_) if (((PHMASK>>9)&1) && IN(pb + 9)) {
            SchedMoe S; S.T.init(PB[32], 8); S.G = G; S.c = bx; S.A = (const char*)(ws + WS_R1); S.W = (const char*)(ws + WS_WGU); S.C = (char*)(ws + WS_R2 + R2_HMID); S.PB = PB; S.wrows = 2048; S.ldc = 1024; S.cdiv = 2; S.osz = 1;
            pg8::EpiMoe1 E; E.bgu = INP(I_BGU) + (size_t)l * 32 * 2048;
            pg8::gemm_phase<true>(lds, D, D, D, S, E, wave);
        }
        SEAM(pb + 9);
        _Pragma("unroll 1") for (int rep_ = 0; rep_ < NREP(10); ++rep_) if (((PHMASK>>10)&1) && IN(pb + 10)) {
            SchedMoe S; S.T.init(PB[32], 4); S.G = G; S.c = bx; S.A = (const char*)(ws + WS_R2 + R2_HMID); S.W = (const char*)(ws + WS_WDN); S.C = (char*)(ws + WS_R1); S.PB = PB; S.wrows = 1024; S.ldc = 1024; S.cdiv = 1; S.osz = 2;
            pg8::EpiMoe2 E; E.bdn = INP(I_BDN) + (size_t)l * 32 * 1024;
            pg8::gemm_phase<true>(lds, D, D, D, S, E, wave);
        }
        SEAM(pb + 10);
        _Pragma("unroll 1") for (int rep_ = 0; rep_ < NREP(11); ++rep_) if (((PHMASK>>11)&1) && IN(pb + 11)) { PHASE_TID
            if (tid < 32) CNT[tid] = (int)__hip_atomic_load((unsigned*)ctl + CW_CNT + (l * 32 + tid) * 64, RLX_AGENT);
            LAS float* wgt = (LAS float*)(lds + 73728);
            const bool lastl = (l == DEPTH - 1);
            if (!lastl) load_gate_table(wgt, INP(I_WIN) + (size_t)(l + 1) * D * DIN, tid);
            __syncthreads();
            if (tid == 0) { int a = 0; for (int e = 0; e < 32; ++e) { PB[e] = a; a += (CNT[e] + 255) >> 8; } PB[32] = a; }
            __syncthreads();
            const int e0 = 8 * lane;
            f32x4 g[4], bb[4];
#pragma unroll
            for (int j = 0; j < 4; ++j) { const int o = (j >> 1) * 512 + e0 + (j & 1) * 4; g[j] = *(const f32x4*)(INP(I_LN2G) + l * D + o); bb[j] = *(const f32x4*)(INP(I_LN2B) + l * D + o); }
            const char* YA = (const char*)(ws + WS_R1);
            const bool dummy_ = (rep_ + 1 < NREP(11)); char* const Xo = dummy_ ? (char*)(ws + WS_R2) : Xb; float* const Fo = dummy_ ? (float*)(ws + WS_R2 + 256 * MiB) : args.out; float* const Go = dummy_ ? (float*)(ws + WS_R2 + 200 * MiB) : GIF;
            const int* TKE = (const int*)(ws + WS_TKE); const float* TKG = (const float*)(ws + WS_TKG); const int* TKP = (const int*)(ws + WS_TKP);
#pragma unroll 1
            for (int mb = gw * 16; mb < M; mb += NGW * 16) {
                const int ev = TKE[mb * 4 + lane], pv = TKP[mb * 4 + lane]; const float gv = TKG[mb * 4 + lane];
                const int rowv = PB[ev] * 256 + pv;
#pragma unroll 1
                for (int ti = 0; ti < 16; ti += 2) {
                    u32x4 xw[2][2], yw[2][4][2]; float gk[2][4];
#pragma unroll
                    for (int q = 0; q < 2; ++q) { const size_t m = (size_t)mb + ti + q;
                        xw[q][0] = *(const u32x4*)(Xb + (m * D + e0) * 2); xw[q][1] = *(const u32x4*)(Xb + (m * D + 512 + e0) * 2);
#pragma unroll
                        for (int k = 0; k < 4; ++k) { const size_t row = (size_t)__builtin_amdgcn_readlane(rowv, 4 * (ti + q) + k);
                            gk[q][k] = __builtin_bit_cast(float, __builtin_amdgcn_readlane(__builtin_bit_cast(int, gv), 4 * (ti + q) + k));
                            yw[q][k][0] = *(const u32x4*)(YA + (row * D + e0) * 2); yw[q][k][1] = *(const u32x4*)(YA + (row * D + 512 + e0) * 2); } }
#pragma unroll
                    for (int q = 0; q < 2; ++q) { const size_t m = (size_t)mb + ti + q;
                        f32x4 v[4];
#pragma unroll
                        for (int hh = 0; hh < 2; ++hh) { const u32x4 w = xw[q][hh];
                            v[2 * hh] = (f32x4){bflo(w.x), bfhi(w.x), bflo(w.y), bfhi(w.y)} * DN_ALPHA; v[2 * hh + 1] = (f32x4){bflo(w.z), bfhi(w.z), bflo(w.w), bfhi(w.w)} * DN_ALPHA; }
#pragma unroll
                        for (int k = 0; k < 4; ++k)
#pragma unroll
                            for (int hh = 0; hh < 2; ++hh) { const u32x4 w = yw[q][k][hh];
                                v[2 * hh] = v[2 * hh] + (f32x4){bflo(w.x), bfhi(w.x), bflo(w.y), bfhi(w.y)} * gk[q][k]; v[2 * hh + 1] = v[2 * hh + 1] + (f32x4){bflo(w.z), bfhi(w.z), bflo(w.w), bfhi(w.w)} * gk[q][k]; }
                        ln16(v, g, bb);
                        if (lastl) {
#pragma unroll
                            for (int j = 0; j < 4; ++j) *(f32x4*)(Fo + m * D + (j >> 1) * 512 + e0 + (j & 1) * 4) = v[j];
                        } else {
#pragma unroll
                            for (int hh = 0; hh < 2; ++hh) *(u32x4*)(Xo + (m * D + hh * 512 + e0) * 2) = pg8::pack8(v[2 * hh], v[2 * hh + 1]);
                            gates8b(v, wgt, Go + m * 8, lane);
                        }
                    }
                }
            }
            __syncthreads();
        }
        SEAM(pb + 11);
    }
#undef IN
#undef SEAM
}

extern "C" void kernel_launch(void* const* d_in, const int* in_sizes, int n_in, void* d_out, int out_size, void* d_ws, size_t ws_size, hipStream_t stream) {
    static int grid = 0;
    if (grid == 0) {
        if (n_in != N_IN || out_size != M * D || ws_size < WS_END) { fprintf(stderr, "kernel_launch: unexpected shapes (n_in %d, out %d, ws %zu)\n", n_in, out_size, ws_size); grid = -1; return; }
        int dev = 0, cus = 0, per_cu = 0;
        if (hipGetDevice(&dev) != hipSuccess || hipDeviceGetAttribute(&cus, hipDeviceAttributeMultiprocessorCount, dev) != hipSuccess) { grid = -1; return; }
        if (hipFuncSetAttribute((const void*)fwd_kernel, hipFuncAttributeMaxDynamicSharedMemorySize, LDS_BYTES) != hipSuccess) { fprintf(stderr, "kernel_launch: hipFuncSetAttribute failed\n"); grid = -1; return; }
        if (hipOccupancyMaxActiveBlocksPerMultiprocessor(&per_cu, (const void*)fwd_kernel, NTHR, LDS_BYTES) != hipSuccess || per_cu < 1) fprintf(stderr, "kernel_launch: occupancy query reports %d\n", per_cu);
        (void)hipGetLastError();
        grid = cus;
    }
    if (grid < 0) return;
    (void)hipMemsetAsync((char*)d_ws + WS_CTL, 0, CTL_ZERO_BYTES, stream);
    Args a{};
    for (int i = 0; i < N_IN; ++i) a.in[i] = (const float*)d_in[i];
    a.out = (float*)d_out; a.ws = (unsigned char*)d_ws;
#if MK_ONE_LAUNCH
    a.ph_lo = 0; a.ph_hi = NPH;
    hipLaunchKernelGGL(fwd_kernel, dim3(grid), dim3(NTHR), LDS_BYTES, stream, a);
#else
    for (int p = 0; p < NPH; ++p) { a.ph_lo = p; a.ph_hi = p + 1; hipLaunchKernelGGL(fwd_kernel, dim3(grid), dim3(NTHR), LDS_BYTES, stream, a); }
#endif
    const hipError_t le = hipPeekAtLastError();
    if (le != hipSuccess) fprintf(stderr, "kernel_launch: launch failed: %s\n", hipGetErrorName(le));
}
```

```cpp
#include <hip/hip_runtime.h>
#include <cstdio>
#include <cstdint>

#ifndef MK_ONE_LAUNCH
#define MK_ONE_LAUNCH 1
#endif

#define LAS __attribute__((address_space(3)))
#define GAS __attribute__((address_space(1)))
typedef unsigned short bf16;
typedef short bf16x8 __attribute__((ext_vector_type(8)));
typedef float f32x4 __attribute__((ext_vector_type(4)));
typedef float f32x2 __attribute__((ext_vector_type(2)));
typedef float f32x16 __attribute__((ext_vector_type(16)));
typedef unsigned u32x4 __attribute__((ext_vector_type(4)));
typedef unsigned u32x2 __attribute__((ext_vector_type(2)));
typedef __bf16 bf16x2_t __attribute__((ext_vector_type(2)));
typedef GAS unsigned gu32;
#define RLX_AGENT __ATOMIC_RELAXED, __HIP_MEMORY_SCOPE_AGENT
#define DI __device__ __forceinline__

constexpr int NWAVES = 8, NTHR = 512;
constexpr int D = 1024, BATCH = 16, SEQ = 4096, M = BATCH * SEQ, DEPTH = 2, MEML = 256, MROWS = BATCH * MEML;
constexpr int DIN = 6920, NU = 6912;
constexpr int UC_QK = 0, UC_V = 512, UC_OG = 1024, UC_RW = 1536, UC_CAQ = 3328, UC_GATE = 3840;
constexpr int NEXP = 32, TOPK = 4;
constexpr int PMAX = M * TOPK / 256 + NEXP;
constexpr float LN_EPS = 1e-5f, RW_GN_EPS = 64e-5f, DN_ALPHA = 1.41421356237f;

enum { I_X = 0, I_MEM, I_LNIN_G, I_LNIN_B, I_MEMLN_G, I_MEMLN_B, I_WIN, I_CONVW, I_CONVB, I_IGB, I_FGB, I_MLNORMG, I_RWMU, I_RWW0, I_RWWUP, I_RWA0, I_RWAUP, I_RWGUP,
       I_RWKK, I_RWKA, I_RWRK, I_RWLNG, I_RWLNB, I_CAWKV, I_GATEB, I_WBRML, I_WBRRW, I_WBRCA, I_WO, I_LN1G, I_LN1B, I_RTW, I_RTB, I_WGU, I_BGU, I_WDN, I_BDN, I_LN2G, I_LN2B, N_IN };

constexpr size_t MiB = 1u << 20;
constexpr size_t WS_CTL = 0, CTL_ZERO_BYTES = 1 * MiB;
constexpr size_t WS_WIN = 1 * MiB;
constexpr size_t WS_WKV = 28 * MiB;
constexpr size_t WS_WBR = 32 * MiB;
constexpr size_t WS_WO = 38 * MiB;
constexpr size_t WS_WLORA = 42 * MiB;
constexpr size_t WS_WGU = 45 * MiB;
constexpr size_t WS_WDN = 173 * MiB;
constexpr size_t WS_X = 237 * MiB;
constexpr size_t WS_MEMN = 365 * MiB;
constexpr size_t WS_KV = 373 * MiB;
constexpr size_t WS_GIF = 389 * MiB;
constexpr size_t WS_TKE = 391 * MiB, WS_TKG = 392 * MiB, WS_TKP = 393 * MiB;
constexpr size_t WS_ROWTOK = 394 * MiB;
constexpr size_t WS_HML = 402 * MiB;
constexpr size_t WS_R1 = 466 * MiB;
constexpr size_t WS_R2 = 1330 * MiB;
constexpr size_t WS_END = 1858 * MiB;
constexpr size_t R2_LORA_OUT = 0, R2_HCAT = 192 * MiB, R2_LORA_IN = 384 * MiB, R2_YPRE = 0, R2_Z = 192 * MiB, R2_HMID = 0;
constexpr int CW_TMO = 0, CW_BAR = 4096, CW_CNT = 16384;

constexpr int LDS_BYTES = 155648;
constexpr int LDSCTL_OFF = 153600;

DI unsigned f2bf(float f) { unsigned u = __builtin_bit_cast(unsigned, f); return (u + 0x7fffu + ((u >> 16) & 1u)) >> 16; }
DI unsigned pk2(float lo, float hi) { bf16x2_t b = __builtin_convertvector((f32x2){lo, hi}, bf16x2_t); return __builtin_bit_cast(unsigned, b); }
DI float bflo(unsigned u) { return __builtin_bit_cast(float, u << 16); }
DI float bfhi(unsigned u) { return __builtin_bit_cast(float, u & 0xffff0000u); }
DI unsigned pk4_f8(float a, float b, float c, float d) {
    a = __builtin_amdgcn_fmed3f(a, -448.f, 448.f); b = __builtin_amdgcn_fmed3f(b, -448.f, 448.f); c = __builtin_amdgcn_fmed3f(c, -448.f, 448.f); d = __builtin_amdgcn_fmed3f(d, -448.f, 448.f);
    int w = 0; w = __builtin_amdgcn_cvt_pk_fp8_f32(a, b, w, false); w = __builtin_amdgcn_cvt_pk_fp8_f32(c, d, w, true); return (unsigned)w; }
DI float sigmoidf_(float x) { return __builtin_amdgcn_rcpf(1.f + __builtin_amdgcn_exp2f(-1.4426950408889634f * x)); }
template <int CTRL> DI float dppf(float x) { return __builtin_bit_cast(float, __builtin_amdgcn_update_dpp(0, __builtin_bit_cast(int, x), CTRL, 0xF, 0xF, true)); }
DI float red4(float x) { x += dppf<0xB1>(x); x += dppf<0x4E>(x); return x; }
DI float red8(float x) { x = red4(x); x += dppf<0x141>(x); return x; }
DI float red16(float x) { x = red8(x); x += dppf<0x140>(x); return x; }
DI float red8o(float x) { x += dppf<0xB1>(x); asm("" : "+v"(x)); x += dppf<0x4E>(x); asm("" : "+v"(x)); x += dppf<0x141>(x); asm("" : "+v"(x)); return x; }
DI float red16o(float x) { x = red8o(x); x += dppf<0x140>(x); asm("" : "+v"(x)); return x; }
DI float wave_sum(float v) {
    v = red16(v);
    const int vi = __builtin_bit_cast(int, v);
    const float a = __builtin_bit_cast(float, __builtin_amdgcn_readlane(vi, 0)), b = __builtin_bit_cast(float, __builtin_amdgcn_readlane(vi, 16));
    const float c = __builtin_bit_cast(float, __builtin_amdgcn_readlane(vi, 32)), d = __builtin_bit_cast(float, __builtin_amdgcn_readlane(vi, 48));
    return (a + b) + (c + d);
}
#define LDS_WAIT() asm volatile("s_waitcnt lgkmcnt(0)" ::: "memory")

constexpr float F8_SX = 8.f, F8_SWGU = 512.f, F8_SH = 4.f, F8_SWDN = 1024.f, F8_INV1 = 1.f / (F8_SX * F8_SWGU), F8_INV2 = 1.f / (F8_SH * F8_SWDN);
namespace pg8 {
constexpr int BM = 256, BK = 64, HALF = 128, HTB = HALF * BK * 2, STAGE_BYTES = 8 * HTB, NXCD = 8, WGM = 8;
__host__ __device__ __forceinline__ int lds_byte(int r, int c) { const int st = (r >> 4) * 2 + (c >> 5), rr = r & 15, cc = c & 31, ob = rr * 64 + cc * 2; return st * 1024 + (ob ^ (((ob >> 9) & 1) << 5)); }
__host__ __device__ __forceinline__ void stage_rc(int b, int& R, int& C) { const int st = b / 1024, sb = b % 1024, swz = sb ^ (((sb >> 9) & 1) << 5); R = (st >> 1) * 16 + swz / 64; C = (st & 1) * 32 + (swz % 64) / 2; }
__host__ __device__ __forceinline__ int perm32(int rho) { const int n = rho >> 4, i = rho & 15; return 8 * (i >> 2) + 4 * n + (i & 3); }

struct Unit { const char* a; const char* b; char* c; int ldc; int r0, c0, e, sub; };

struct TileOrder {
    int nM, nN, nwg;
    DI void init(int nM_, int nN_) { nM = nM_; nN = nN_; nwg = nM * nN; }
    DI bool tile(long L, int& pm, int& pn) const {
        if (L >= nwg) return false;
        int wgid = (int)L; { const int q = nwg / NXCD, r = nwg % NXCD, xcd = wgid % NXCD, off = wgid / NXCD; wgid = (xcd < r ? xcd * (q + 1) : r * (q + 1) + (xcd - r) * q) + off; }
        const int nig = WGM * nN, gid = wgid / nig, fm = gid * WGM, gsz = (nM - fm) < WGM ? (nM - fm) : WGM;
        pm = fm + ((wgid % nig) % gsz); pn = (wgid % nig) / gsz; return true;
    }
};

DI u32x4 pack8(const f32x4& v0, const f32x4& v1) { u32x4 w; w.x = pk2(v0[0], v0[1]); w.y = pk2(v0[2], v0[3]); w.z = pk2(v1[0], v1[1]); w.w = pk2(v1[2], v1[3]); return w; }

struct EpiStore {
    DI void operator()(const f32x4 (&acc)[2][2][4][2], const Unit& u, int wr, int wc, int fr, int fq) const {
#pragma unroll
        for (int ai = 0; ai < 2; ++ai)
#pragma unroll
            for (int m = 0; m < 4; ++m) { char* rowp = u.c + ((size_t)(ai * HALF + wr * 64 + m * 16 + fr) * u.ldc + wc * 32 + 8 * fq) * 2;
#pragma unroll
                for (int bj = 0; bj < 2; ++bj) *(u32x4*)(rowp + bj * 256) = pack8(acc[ai][bj][m][0], acc[ai][bj][m][1]); }
    }
};
struct EpiMerge {
    static constexpr bool MIDK = true;
    const char* U; const float* gate_b;
    DI void mid(f32x4 (&acc)[2][2][4][2], const Unit& u, int which, int wr, int wc, int fr, int fq) const {
        const float L2E = 1.4426950408889634f;
#pragma unroll
        for (int bj = 0; bj < 2; ++bj) {
            const float* g = gate_b + which * 1024 + u.c0 + bj * HALF + wc * 32 + 8 * fq;
            const f32x4 ga0 = *(const f32x4*)g, ga1 = *(const f32x4*)(g + 4), gn0 = *(const f32x4*)(g + 1024), gn1 = *(const f32x4*)(g + 1028);
            const float gaa[8] = {ga0.x, ga0.y, ga0.z, ga0.w, ga1.x, ga1.y, ga1.z, ga1.w}, gnn[8] = {gn0.x, gn0.y, gn0.z, gn0.w, gn1.x, gn1.y, gn1.z, gn1.w};
#pragma unroll
            for (int ai = 0; ai < 2; ++ai)
#pragma unroll
                for (int m = 0; m < 4; ++m) { const int lr = ai * HALF + wr * 64 + m * 16 + fr;
                    const char* gp = U + ((size_t)(u.r0 + lr) * NU + UC_GATE + which * 1024 + u.c0 + wc * 32 + 8 * fq) * 2 + bj * 256;
                    const u32x4 wa = *(const u32x4*)gp, wn = *(const u32x4*)(gp + 2048);
                    const float xa[8] = {bflo(wa.x), bfhi(wa.x), bflo(wa.y), bfhi(wa.y), bflo(wa.z), bfhi(wa.z), bflo(wa.w), bfhi(wa.w)};
                    const float xn[8] = {bflo(wn.x), bfhi(wn.x), bflo(wn.y), bfhi(wn.y), bflo(wn.z), bfhi(wn.z), bflo(wn.w), bfhi(wn.w)};
#pragma unroll
                    for (int i = 0; i < 8; ++i) { const float ea = __builtin_amdgcn_exp2f(-L2E * __builtin_amdgcn_fmed3f(xa[i] + gaa[i], -30.f, 30.f)), en = __builtin_amdgcn_exp2f(-L2E * __builtin_amdgcn_fmed3f(xn[i] + gnn[i], -30.f, 30.f));
                        acc[ai][bj][m][i >> 2][i & 3] *= (1.f + en) * __builtin_amdgcn_rcpf(1.f + ea); }
                    if (m & 1) asm volatile("" ::: "memory"); }
        }
    }
    DI void operator()(const f32x4 (&acc)[2][2][4][2], const Unit& u, int wr, int wc, int fr, int fq) const {
        f32x4 gb[2][2];
#pragma unroll
        for (int bj = 0; bj < 2; ++bj) { const float* g = gate_b + 2048 + u.c0 + bj * HALF + wc * 32 + 8 * fq; gb[bj][0] = *(const f32x4*)g; gb[bj][1] = *(const f32x4*)(g + 4); }
#pragma unroll
        for (int ai = 0; ai < 2; ++ai)
#pragma unroll
            for (int m = 0; m < 4; ++m) { const int lr = ai * HALF + wr * 64 + m * 16 + fr; char* rowp = u.c + ((size_t)lr * u.ldc + wc * 32 + 8 * fq) * 2;
                const char* gp = U + ((size_t)(u.r0 + lr) * NU + UC_GATE + 2048 + u.c0 + wc * 32 + 8 * fq) * 2;
#pragma unroll
                for (int bj = 0; bj < 2; ++bj) { const u32x4 gw = *(const u32x4*)(gp + bj * 256);
                    f32x4 v0 = acc[ai][bj][m][0], v1 = acc[ai][bj][m][1];
                    v0[0] *= sigmoidf_(bflo(gw.x) + gb[bj][0][0]); v0[1] *= sigmoidf_(bfhi(gw.x) + gb[bj][0][1]); v0[2] *= sigmoidf_(bflo(gw.y) + gb[bj][0][2]); v0[3] *= sigmoidf_(bfhi(gw.y) + gb[bj][0][3]);
                    v1[0] *= sigmoidf_(bflo(gw.z) + gb[bj][1][0]); v1[1] *= sigmoidf_(bfhi(gw.z) + gb[bj][1][1]); v1[2] *= sigmoidf_(bflo(gw.w) + gb[bj][1][2]); v1[3] *= sigmoidf_(bfhi(gw.w) + gb[bj][1][3]);
                    *(u32x4*)(rowp + bj * 256) = pack8(v0, v1); }
                asm volatile("" ::: "memory"); }
    }
};
struct EpiWo {
    const char* X;
    DI void operator()(const f32x4 (&acc)[2][2][4][2], const Unit& u, int wr, int wc, int fr, int fq) const {
#pragma unroll
        for (int ai = 0; ai < 2; ++ai)
#pragma unroll
            for (int m = 0; m < 4; ++m) { const int lr = ai * HALF + wr * 64 + m * 16 + fr; char* rowp = u.c + ((size_t)lr * u.ldc + wc * 32 + 8 * fq) * 2;
                const char* xp = X + ((size_t)(u.r0 + lr) * D + u.c0 + wc * 32 + 8 * fq) * 2;
#pragma unroll
                for (int bj = 0; bj < 2; ++bj) { const u32x4 xw = *(const u32x4*)(xp + bj * 256);
                    f32x4 v0 = acc[ai][bj][m][0], v1 = acc[ai][bj][m][1];
                    v0[0] += DN_ALPHA * bflo(xw.x); v0[1] += DN_ALPHA * bfhi(xw.x); v0[2] += DN_ALPHA * bflo(xw.y); v0[3] += DN_ALPHA * bfhi(xw.y);
                    v1[0] += DN_ALPHA * bflo(xw.z); v1[1] += DN_ALPHA * bfhi(xw.z); v1[2] += DN_ALPHA * bflo(xw.w); v1[3] += DN_ALPHA * bfhi(xw.w);
                    *(u32x4*)(rowp + bj * 256) = pack8(v0, v1); }
                asm volatile("" ::: "memory"); }
    }
};
DI float swiglu1(float a, float b) { const float g = fminf(a, 7.f), l = fminf(fmaxf(b, -7.f), 7.f); return g * sigmoidf_(1.702f * g) * (l + 1.f); }
struct EpiMoe1 {
    const float* bgu;
    DI void operator()(const f32x4 (&acc)[2][2][4][2], const Unit& u, int wr, int wc, int fr, int fq) const {
        f32x4 bv[2][2];
#pragma unroll
        for (int bj = 0; bj < 2; ++bj) { const float* b = bgu + u.e * 2048 + u.c0 + bj * HALF + wc * 32 + 8 * fq; bv[bj][0] = *(const f32x4*)b; bv[bj][1] = *(const f32x4*)(b + 4); }
#pragma unroll
        for (int ai = 0; ai < 2; ++ai)
#pragma unroll
            for (int m = 0; m < 4; ++m) { const int lr = ai * HALF + wr * 64 + m * 16 + fr; char* rowp = u.c + ((size_t)lr * u.ldc + wc * 16 + 4 * fq);
#pragma unroll
                for (int bj = 0; bj < 2; ++bj) { const f32x4 v0 = acc[ai][bj][m][0] * F8_INV1 + bv[bj][0], v1 = acc[ai][bj][m][1] * F8_INV1 + bv[bj][1];
                    *(unsigned*)(rowp + bj * 64) = pk4_f8(swiglu1(v0[0], v0[1]) * F8_SH, swiglu1(v0[2], v0[3]) * F8_SH, swiglu1(v1[0], v1[1]) * F8_SH, swiglu1(v1[2], v1[3]) * F8_SH); } }
    }
};
struct EpiMoe2 {
    const float* bdn;
    DI void operator()(const f32x4 (&acc)[2][2][4][2], const Unit& u, int wr, int wc, int fr, int fq) const {
        f32x4 bv[2][2];
#pragma unroll
        for (int bj = 0; bj < 2; ++bj) { const float* b = bdn + u.e * 1024 + u.c0 + bj * HALF + wc * 32 + 8 * fq; bv[bj][0] = *(const f32x4*)b; bv[bj][1] = *(const f32x4*)(b + 4); }
#pragma unroll
        for (int ai = 0; ai < 2; ++ai)
#pragma unroll
            for (int m = 0; m < 4; ++m) { char* rowp = u.c + ((size_t)(ai * HALF + wr * 64 + m * 16 + fr) * u.ldc + wc * 32 + 8 * fq) * 2;
#pragma unroll
                for (int bj = 0; bj < 2; ++bj) *(u32x4*)(rowp + bj * 256) = pack8(acc[ai][bj][m][0] * F8_INV2 + bv[bj][0], acc[ai][bj][m][1] * F8_INV2 + bv[bj][1]); }
    }
};

typedef int i32x8 __attribute__((ext_vector_type(8)));
typedef int i32x4 __attribute__((ext_vector_type(4)));
template <bool F8, bool MIDK = false, class Epi, class Sched>
DI void gemm_phase(LAS unsigned char* lds, const int KB  , const int ldaB, const int ldbB, const Sched& S, const Epi& E, const int wave_) {
    unsigned z_ = 0u; asm volatile("" : "+v"(z_)); const int tid = wave_ * 64 + (int)__builtin_amdgcn_mbcnt_hi(~0u, __builtin_amdgcn_mbcnt_lo(~0u, z_));
    const int wid = __builtin_amdgcn_readfirstlane(tid >> 6), lane = tid & 63, wr = wid >> 2, wc = wid & 3, fr = lane & 15, fq = lane >> 4;
    const int nt = KB / (BK * 2);
    unsigned voffA[2], voffB[2];
#pragma unroll
    for (int i = 0; i < 2; ++i) { int R, C; stage_rc(tid * 16 + i * 8192, R, C); const int Rb = (R & ~31) + perm32(R & 31);
        voffA[i] = (unsigned)(R * ldaB + C * 2); voffB[i] = (unsigned)(Rb * ldbB + C * 2); }
    asm volatile("" : "+v"(voffA[0]), "+v"(voffA[1]), "+v"(voffB[0]), "+v"(voffB[1]));
    const size_t kstep = (size_t)(BK * 2);
    const size_t hstepA = (size_t)HALF * ldaB, hstepB = (size_t)HALF * ldbB;
    const unsigned ldsw = (unsigned)wid * 1024u;
    const int aoff = lds_byte(wr * 64 + fr, fq * 8), boff = lds_byte(wc * 32 + fr, fq * 8);
#define PG8_SA(b, h) (((b) * 2 + (h)) * HTB)
#define PG8_SB(b, h) ((4 + (b) * 2 + (h)) * HTB)
#define PG8_STAGE(bufoff, gbase, voff) do { _Pragma("unroll") for (int _i = 0; _i < 2; ++_i) \
        __builtin_amdgcn_global_load_lds((const unsigned*)((const char*)(gbase) + (voff)[_i]), (LAS unsigned*)(lds + (bufoff) + ldsw + _i * 8192), 16, 0, 0); } while (0)
#define PG8_LD8(p) __builtin_shufflevector(*(const LAS i32x4*)(p), *(const LAS i32x4*)((p) + 1024), 0, 1, 2, 3, 4, 5, 6, 7)
#define PG8_LDA8(dst, b, h) do { _Pragma("unroll") for (int m = 0; m < 4; ++m) dst[m] = PG8_LD8(lds + PG8_SA(b, h) + aoff + m * 2048); } while (0)
#define PG8_LDB8(dst, b, h) do { _Pragma("unroll") for (int n = 0; n < 2; ++n) dst[n] = PG8_LD8(lds + PG8_SB(b, h) + boff + n * 2048); } while (0)
#define PG8_MMA8(ai, bj, A8, B8) do { __builtin_amdgcn_s_setprio(1); _Pragma("unroll") for (int m = 0; m < 4; ++m) _Pragma("unroll") for (int n = 0; n < 2; ++n) \
        asm volatile("v_mfma_f32_16x16x128_f8f6f4 %0, %1, %2, %0" : "+v"(acc[ai][bj][m][n]) : "v"(B8[n]), "v"(A8[m])); __builtin_amdgcn_s_setprio(0); } while (0)
#define PG8_LDA(dst, b, h) do { _Pragma("unroll") for (int m = 0; m < 4; ++m) _Pragma("unroll") for (int k = 0; k < 2; ++k) dst[m][k] = *(const LAS bf16x8*)(lds + PG8_SA(b, h) + aoff + m * 2048 + k * 1024); } while (0)
#define PG8_LDB(dst, b, h) do { _Pragma("unroll") for (int n = 0; n < 2; ++n) _Pragma("unroll") for (int k = 0; k < 2; ++k) dst[n][k] = *(const LAS bf16x8*)(lds + PG8_SB(b, h) + boff + n * 2048 + k * 1024); } while (0)
#define PG8_CAT(x) __builtin_shufflevector(__builtin_bit_cast(i32x4, (x)[0]), __builtin_bit_cast(i32x4, (x)[1]), 0, 1, 2, 3, 4, 5, 6, 7)
#define PG8_MMA(ai, bj, At, Bt) do { __builtin_amdgcn_s_setprio(1); _Pragma("unroll") for (int m = 0; m < 4; ++m) _Pragma("unroll") for (int n = 0; n < 2; ++n) _Pragma("unroll") for (int k = 0; k < 2; ++k) \
        acc[ai][bj][m][n] = __builtin_amdgcn_mfma_f32_16x16x32_bf16(Bt[n][k], At[m][k], acc[ai][bj][m][n], 0, 0, 0); __builtin_amdgcn_s_setprio(0); } while (0)
#define PG8_WAIT_V(n) asm volatile("s_waitcnt vmcnt(" #n ")" ::: "memory")
#define PG8_WAIT_L(n) asm volatile("s_waitcnt lgkmcnt(" #n ")" ::: "memory")
#define PG8_BAR __builtin_amdgcn_s_barrier()
#define PG8_SCHED __builtin_amdgcn_sched_barrier(0)
    Unit cur, nxt; int ui = 0;
    if (!S.next(0, cur)) return;
    f32x4 acc[2][2][4][2];
#pragma unroll
    for (int a = 0; a < 2; ++a)
#pragma unroll
        for (int b = 0; b < 2; ++b)
#pragma unroll
            for (int m = 0; m < 4; ++m)
#pragma unroll
                for (int n = 0; n < 2; ++n) acc[a][b][m][n] = (f32x4){0.f, 0.f, 0.f, 0.f};
    bf16x8 At[4][2], B0[2][2], B1[2][2]; i32x8 A8[4], B80[2], B81[2];
    const char* cA = cur.a; const char* cB = cur.b;
    PG8_STAGE(PG8_SB(0, 0), cB, voffB); PG8_STAGE(PG8_SB(0, 1), cB + hstepB, voffB); PG8_STAGE(PG8_SA(0, 0), cA, voffA); PG8_STAGE(PG8_SA(0, 1), cA + hstepA, voffA);
    if (wr == 1) PG8_BAR;
    PG8_WAIT_V(2); PG8_BAR;
    PG8_STAGE(PG8_SB(1, 0), cB + kstep, voffB); PG8_STAGE(PG8_SA(1, 0), cA + kstep, voffA); PG8_STAGE(PG8_SB(1, 1), cB + hstepB + kstep, voffB);
    PG8_WAIT_V(6); PG8_BAR;
    for (;;) {
        const bool has_next = S.next(ui + 1, nxt);
        const char* nA = has_next ? nxt.a : cA; const char* nB = has_next ? nxt.b : cB;
#pragma unroll 1
        for (int t = 0; t < nt; t += 2) {
            if constexpr (MIDK) { if (t == 8 || t == 16) { int fr_ = fr, fq_ = fq; asm volatile("" : "+v"(fr_), "+v"(fq_)); E.mid(acc, cur, t >> 4, wr, wc, fr_, fq_); } }
            const bool last = (t == nt - 2);
            const char* a1 = cA + (size_t)(t + 1) * kstep;
            const char* a2 = last ? nA : cA + (size_t)(t + 2) * kstep; const char* b2 = last ? nB : cB + (size_t)(t + 2) * kstep;
            const char* a3 = a2 + kstep; const char* b3 = b2 + kstep;
            if constexpr (F8) {
            PG8_LDB8(B80, 0, 0); PG8_LDB8(B81, 0, 1); PG8_SCHED; PG8_LDA8(A8, 0, 0); PG8_STAGE(PG8_SA(1, 1), a1 + hstepA, voffA);
            PG8_WAIT_V(8); PG8_WAIT_L(0); PG8_BAR; PG8_MMA8(0, 0, A8, B80); PG8_MMA8(0, 1, A8, B81); PG8_BAR; PG8_SCHED;
            PG8_LDA8(A8, 0, 1); PG8_STAGE(PG8_SB(0, 0), b2, voffB); PG8_STAGE(PG8_SB(0, 1), b2 + hstepB, voffB); PG8_STAGE(PG8_SA(0, 0), a2, voffA);
            PG8_WAIT_V(8); PG8_WAIT_L(0); PG8_BAR; PG8_MMA8(1, 0, A8, B80); PG8_MMA8(1, 1, A8, B81); PG8_BAR; PG8_SCHED;
            PG8_LDB8(B80, 1, 0); PG8_LDB8(B81, 1, 1); PG8_SCHED; PG8_LDA8(A8, 1, 0); PG8_STAGE(PG8_SA(0, 1), a2 + hstepA, voffA);
            PG8_WAIT_V(8); PG8_WAIT_L(0); PG8_BAR; PG8_MMA8(0, 0, A8, B80); PG8_MMA8(0, 1, A8, B81); PG8_BAR; PG8_SCHED;
            PG8_LDA8(A8, 1, 1); PG8_STAGE(PG8_SB(1, 0), b3, voffB); PG8_STAGE(PG8_SB(1, 1), b3 + hstepB, voffB); PG8_STAGE(PG8_SA(1, 0), a3, voffA);
            PG8_WAIT_V(8); PG8_WAIT_L(0); PG8_BAR; PG8_MMA8(1, 0, A8, B80); PG8_MMA8(1, 1, A8, B81); PG8_BAR; PG8_SCHED;
            } else {
            PG8_LDB(B0, 0, 0); PG8_LDB(B1, 0, 1); PG8_SCHED; PG8_LDA(At, 0, 0); PG8_STAGE(PG8_SA(1, 1), a1 + hstepA, voffA);
            PG8_WAIT_V(8); PG8_WAIT_L(0); PG8_BAR; PG8_MMA(0, 0, At, B0); PG8_MMA(0, 1, At, B1); PG8_BAR; PG8_SCHED;
            PG8_LDA(At, 0, 1); PG8_STAGE(PG8_SB(0, 0), b2, voffB); PG8_STAGE(PG8_SB(0, 1), b2 + hstepB, voffB); PG8_STAGE(PG8_SA(0, 0), a2, voffA);
            PG8_WAIT_V(8); PG8_WAIT_L(0); PG8_BAR; PG8_MMA(1, 0, At, B0); PG8_MMA(1, 1, At, B1); PG8_BAR; PG8_SCHED;
            PG8_LDB(B0, 1, 0); PG8_LDB(B1, 1, 1); PG8_SCHED; PG8_LDA(At, 1, 0); PG8_STAGE(PG8_SA(0, 1), a2 + hstepA, voffA);
            PG8_WAIT_V(8); PG8_WAIT_L(0); PG8_BAR; PG8_MMA(0, 0, At, B0); PG8_MMA(0, 1, At, B1); PG8_BAR; PG8_SCHED;
            PG8_LDA(At, 1, 1); PG8_STAGE(PG8_SB(1, 0), b3, voffB); PG8_STAGE(PG8_SB(1, 1), b3 + hstepB, voffB); PG8_STAGE(PG8_SA(1, 0), a3, voffA);
            PG8_WAIT_V(8); PG8_WAIT_L(0); PG8_BAR; PG8_MMA(1, 0, At, B0); PG8_MMA(1, 1, At, B1); PG8_BAR; PG8_SCHED;
            }
        }
        if (wr == 0) PG8_BAR;
        if constexpr (F8) asm volatile("s_nop 15\n\ts_nop 15" ::: "memory");
        { int fr_ = fr, fq_ = fq; asm volatile("" : "+v"(fr_), "+v"(fq_));
          E(acc, cur, wr, wc, fr_, fq_); }
        if (!has_next) break;
#pragma unroll
        for (int a = 0; a < 2; ++a)
#pragma unroll
            for (int b = 0; b < 2; ++b)
#pragma unroll
                for (int m = 0; m < 4; ++m)
#pragma unroll
                    for (int n = 0; n < 2; ++n) acc[a][b][m][n] = (f32x4){0.f, 0.f, 0.f, 0.f};
        cur = nxt; cA = nA; cB = nB; ++ui;
        if (wr == 1) PG8_BAR;
    }
    PG8_WAIT_V(0);
    PG8_BAR;
#undef PG8_SA
#undef PG8_SB
#undef PG8_STAGE
#undef PG8_LDA
#undef PG8_LDB
#undef PG8_MMA
#undef PG8_CAT
#undef PG8_LD8
#undef PG8_LDA8
#undef PG8_LDB8
#undef PG8_MMA8
#undef PG8_WAIT_V
#undef PG8_WAIT_L
#undef PG8_BAR
#undef PG8_SCHED
}
}

#define XB_TMO      128
#define XB_XCNT(j)  (256  + 64 * (j))
#define XB_XSUB(j)  (1280 + 64 * (j))
#define XB_XGEN(j)  (2304 + 64 * (j))
#define XB_TOP      3328
#define XB_TOPGEN   3392
#define XCD_BAR_WORDS 3456
#define XB_SPIN_CAP (1u << 22)
DI unsigned xb_ld(unsigned* p)              { return __hip_atomic_load(p, __ATOMIC_RELAXED, __HIP_MEMORY_SCOPE_AGENT); }
DI unsigned xb_add(unsigned* p, unsigned v) { return __hip_atomic_fetch_add(p, v, __ATOMIC_RELAXED, __HIP_MEMORY_SCOPE_AGENT); }
DI unsigned xb_xcc_id() { return (unsigned)__builtin_amdgcn_s_getreg((3 << 11) | 20) & 0xFu; }
#define XB_SPIN(cond, bar) do { unsigned _sp = 0; while (cond) { __builtin_amdgcn_s_sleep(1); \
    if ((++_sp & 255u) == 0u) { if (xb_ld(&(bar)[XB_TMO])) break; if (_sp > XB_SPIN_CAP) { atomicAdd(&(bar)[XB_TMO], 1u); break; } } } } while (0)
struct XcdBarrier { unsigned* bar; unsigned x; volatile LAS unsigned* st; };
DI XcdBarrier xcd_barrier_post(unsigned* bar, volatile LAS unsigned* st) {
    XcdBarrier b; b.bar = bar; b.x = xb_xcc_id(); b.st = st;
    if (threadIdx.x == 0) (void)xb_add(&bar[XB_XCNT(b.x)], 1u);
    return b;
}
DI void xcd_barrier_complete(unsigned* bar, unsigned x, unsigned& nloc, unsigned& nx) {
    const unsigned G = gridDim.x * gridDim.y * gridDim.z;
    unsigned sum, cnt, mine, sp = 0u;
    for (;;) {
        sum = 0u; cnt = 0u; mine = 0u;
#pragma unroll
        for (unsigned j = 0; j < 16; ++j) { const unsigned c = xb_ld(&bar[XB_XCNT(j)]); sum += c; cnt += (c > 0u) ? 1u : 0u; mine = (j == x) ? c : mine; }
        if (sum == G) break;
        __builtin_amdgcn_s_sleep(1);
        if ((++sp & 255u) == 0u) { if (xb_ld(&bar[XB_TMO])) break; if (sp > XB_SPIN_CAP) { atomicAdd(&bar[XB_TMO], 1u); break; } }
    }
    nloc = mine > 0u ? mine : 1u; nx = cnt > 0u ? cnt : 1u;
}
DI void xcd_barrier(const XcdBarrier& b) {
    asm volatile("s_waitcnt vmcnt(0)" ::: "memory");
    __syncthreads();
    if (threadIdx.x == 0) {
        unsigned* bar = b.bar;
        __builtin_amdgcn_s_waitcnt(0);
        unsigned nloc = b.st[0], nx = b.st[1];
        if (nloc == 0u) { xcd_barrier_complete(bar, b.x, nloc, nx); b.st[0] = nloc; b.st[1] = nx; }
        const unsigned old = xb_add(&bar[XB_XSUB(b.x)], 1u);
        const unsigned gen = old / nloc;
        if (old + 1u == (gen + 1u) * nloc) {
            __builtin_amdgcn_fence(__ATOMIC_RELEASE, "agent");
            asm volatile("s_waitcnt vmcnt(0)" ::: "memory");
            const unsigned og = xb_add(&bar[XB_TOP], 1u);
            const unsigned tg = og / nx;
            if (og + 1u == (tg + 1u) * nx) xb_add(&bar[XB_TOPGEN], 1u);
            else XB_SPIN(xb_ld(&bar[XB_TOPGEN]) == tg, bar);
            __builtin_amdgcn_fence(__ATOMIC_ACQUIRE, "agent");
            xb_add(&bar[XB_XGEN(b.x)], 1u);
            asm volatile("s_waitcnt vmcnt(0)" ::: "memory");
        } else {
            XB_SPIN(xb_ld(&bar[XB_XGEN(b.x)]) == gen, bar);
            __builtin_amdgcn_fence(__ATOMIC_ACQUIRE, "agent");
            asm volatile("s_waitcnt vmcnt(0)" ::: "memory");
        }
    }
    __syncthreads();
}

DI void transpose_item(const float* W, int ldw, bf16* WT, int ldt, LAS float* scr, int lane) {
#pragma unroll 8
    for (int i = 0; i < 32; ++i) { const int kk = 2 * i + (lane >> 5); scr[kk * 33 + (lane & 31)] = W[(size_t)kk * ldw + (lane & 31)]; }
    LDS_WAIT(); asm volatile("" ::: "memory");
    const int c = lane & 7;
#pragma unroll
    for (int j = 0; j < 4; ++j) { const int n = (lane >> 3) + 8 * j; const LAS float* s = scr + (8 * c) * 33 + n;
        u32x4 o; o.x = pk2(s[0 * 33], s[1 * 33]); o.y = pk2(s[2 * 33], s[3 * 33]); o.z = pk2(s[4 * 33], s[5 * 33]); o.w = pk2(s[6 * 33], s[7 * 33]);
        *(u32x4*)(WT + (size_t)n * ldt + 8 * c) = o; }
    LDS_WAIT(); asm volatile("" ::: "memory");
}
DI void transpose_item_f8(const float* W, int ldw, unsigned char* WT, int ldt, float scale, LAS float* scr, int lane) {
#pragma unroll 8
    for (int i = 0; i < 32; ++i) { const int kk = 2 * i + (lane >> 5); scr[kk * 33 + (lane & 31)] = W[(size_t)kk * ldw + (lane & 31)]; }
    LDS_WAIT(); asm volatile("" ::: "memory");
    const int c = lane & 3;
#pragma unroll
    for (int j = 0; j < 2; ++j) { const int n = (lane >> 2) + 16 * j; const LAS float* s = scr + (16 * c) * 33 + n;
        u32x4 o; o.x = pk4_f8(s[0 * 33] * scale, s[1 * 33] * scale, s[2 * 33] * scale, s[3 * 33] * scale); o.y = pk4_f8(s[4 * 33] * scale, s[5 * 33] * scale, s[6 * 33] * scale, s[7 * 33] * scale);
        o.z = pk4_f8(s[8 * 33] * scale, s[9 * 33] * scale, s[10 * 33] * scale, s[11 * 33] * scale); o.w = pk4_f8(s[12 * 33] * scale, s[13 * 33] * scale, s[14 * 33] * scale, s[15 * 33] * scale);
        *(u32x4*)(WT + (size_t)n * ldt + 16 * c) = o; }
    LDS_WAIT(); asm volatile("" ::: "memory");
}
DI void ln16(f32x4 (&v)[4], const f32x4 (&g)[4], const f32x4 (&b)[4]) {
    float s = 0.f;
#pragma unroll
    for (int j = 0; j < 4; ++j) s += (v[j].x + v[j].y) + (v[j].z + v[j].w);
    const float mean = wave_sum(s) * (1.f / D); float s2 = 0.f;
#pragma unroll
    for (int j = 0; j < 4; ++j) { v[j] = v[j] - mean; s2 += (v[j].x * v[j].x + v[j].y * v[j].y) + (v[j].z * v[j].z + v[j].w * v[j].w); }
    const float rstd = 1.f / sqrtf(wave_sum(s2) * (1.f / D) + LN_EPS);
#pragma unroll
    for (int j = 0; j < 4; ++j) v[j] = v[j] * rstd * g[j] + b[j];
}
DI void gates8(const f32x4 (&y)[4], const LAS float* wgt, float* gif_row, int lane) {
    float p[8];
#pragma unroll
    for (int j = 0; j < 8; ++j) { float s = 0.f;
#pragma unroll
        for (int jj = 0; jj < 4; ++jj) { const f32x4 w = *(const LAS f32x4*)(wgt + j * 1024 + 256 * jj + 4 * lane); s += (y[jj].x * w.x + y[jj].y * w.y) + (y[jj].z * w.z + y[jj].w * w.w); }
        p[j] = wave_sum(s); }
    if (lane == 0) { *(f32x4*)gif_row = (f32x4){p[0], p[1], p[2], p[3]}; *(f32x4*)(gif_row + 4) = (f32x4){p[4], p[5], p[6], p[7]}; }
}
DI void gates8b(const f32x4 (&y)[4], const LAS float* wgt, float* gif_row, int lane) {
    float p[8];
#pragma unroll
    for (int j = 0; j < 8; ++j) { float s = 0.f;
#pragma unroll
        for (int jj = 0; jj < 4; ++jj) { const f32x4 w = *(const LAS f32x4*)(wgt + j * 1024 + (jj >> 1) * 512 + 8 * lane + (jj & 1) * 4); s += (y[jj].x * w.x + y[jj].y * w.y) + (y[jj].z * w.z + y[jj].w * w.w); }
        p[j] = wave_sum(s); }
    if (lane == 0) { *(f32x4*)gif_row = (f32x4){p[0], p[1], p[2], p[3]}; *(f32x4*)(gif_row + 4) = (f32x4){p[4], p[5], p[6], p[7]}; }
}
DI void load_gate_table(LAS float* wgt, const float* win_l, int tid) {
    for (int i = tid; i < 8192; i += NTHR) { const int k = i >> 3, j = i & 7; wgt[j * 1024 + k] = win_l[(size_t)k * DIN + 1536 + j]; }
}
DI f32x4 ld4bf(const char* p) { const u32x2 w = *(const u32x2*)p; return (f32x4){bflo(w.x), bfhi(w.x), bflo(w.y), bfhi(w.y)}; }
DI void st4bf(char* p, const f32x4& v) { u32x2 w; w.x = pk2(v.x, v.y); w.y = pk2(v.z, v.w); *(u32x2*)p = w; }

struct Args { const float* in[N_IN]; float* out; unsigned char* ws; int ph_lo, ph_hi; };
constexpr int NP_LAYER = 12, NPH = 1 + DEPTH * NP_LAYER;
constexpr int XW_SPLIT = 33792;

struct SchedInproj {
    pg8::TileOrder T; int G, c; const char *X, *W; char* U; bool kv; const char *MEMN, *WKV; char* KV;
    DI bool next(int i, pg8::Unit& u) const {
        const long L = (long)i * G + c; int pm, pn;
        if (T.tile(L, pm, pn)) { u.a = X + (size_t)pm * 256 * D * 2; u.b = W + (size_t)pn * 256 * D * 2; u.r0 = pm * 256; u.c0 = pn * 256; u.c = U + ((size_t)u.r0 * NU + u.c0) * 2; u.ldc = NU; u.e = 0; u.sub = 0; return true; }
        if (!kv) return false;
        const long L2 = L - T.nwg; if (L2 < 0 || L2 >= 128) return false;
        const int l = (int)L2 >> 6, t = (int)L2 & 63; pm = t >> 2; pn = t & 3;
        u.a = MEMN + (size_t)pm * 256 * D * 2; u.b = WKV + ((size_t)l * 1024 + pn * 256) * D * 2; u.r0 = pm * 256; u.c0 = pn * 256; u.c = KV + (((size_t)l * MROWS + u.r0) * D + u.c0) * 2; u.ldc = D; u.e = 0; u.sub = 0; return true;
    }
};
struct SchedPlain {
    pg8::TileOrder T; int G, c; const char *A, *B; char* C; int lda, ldb, ldc;
    DI bool next(int i, pg8::Unit& u) const {
        const long L = (long)i * G + c; int pm, pn; if (!T.tile(L, pm, pn)) return false;
        u.a = A + (size_t)pm * 256 * lda * 2; u.b = B + (size_t)pn * 256 * ldb * 2; u.r0 = pm * 256; u.c0 = pn * 256; u.c = C + ((size_t)u.r0 * ldc + u.c0) * 2; u.ldc = ldc; u.e = 0; u.sub = 0; return true;
    }
};
struct SchedMerge {
    pg8::TileOrder T; int G, c; const char *H, *W; char* Y;
    DI bool next(int i, pg8::Unit& u) const {
        const int ti = i / 3, br = i - 3 * ti; const long L = (long)ti * G + c; int pm, pn; if (!T.tile(L, pm, pn)) return false;
        u.a = H + ((size_t)pm * 256 * 1536 + br * 512) * 2; u.b = W + ((size_t)br * 1024 + pn * 256) * 512 * 2; u.r0 = pm * 256; u.c0 = pn * 256; u.c = Y + ((size_t)u.r0 * D + u.c0) * 2; u.ldc = D; u.e = 0; u.sub = br; return true;
    }
};
struct SchedMoe {
    pg8::TileOrder T; int G, c; const char *A, *W; char* C; const LAS int* PB; int wrows  , ldc, cdiv, osz;
    DI bool next(int i, pg8::Unit& u) const {
        const long L = (long)i * G + c; int pm, pn; if (!T.tile(L, pm, pn)) return false;
        int e = 0;
#pragma unroll 1
        for (int j = 1; j < NEXP; ++j) e += (PB[j] <= pm) ? 1 : 0;
        u.a = A + (size_t)pm * 256 * 1024; u.b = W + ((size_t)e * wrows + pn * 256) * 1024; u.r0 = pm * 256; u.c0 = pn * 256; u.c = C + ((size_t)u.r0 * ldc + u.c0 / cdiv) * osz; u.ldc = ldc; u.e = e; u.sub = 0; return true;
    }
};

__global__ void __launch_bounds__(NTHR, 2) fwd_kernel(Args args) {
    extern __shared__ __attribute__((aligned(16))) unsigned char lds_raw[];
#define INP(i) ([&]() -> const float* { int ii_ = (i); asm volatile("" : "+s"(ii_)); return args.in[ii_]; }())
    LAS unsigned char* lds = (LAS unsigned char*)lds_raw;
    volatile LAS unsigned* LCTL = (volatile LAS unsigned*)(lds + LDSCTL_OFF);
    const int tid0 = threadIdx.x, wave = __builtin_amdgcn_readfirstlane(tid0 >> 6);
#define PHASE_TID unsigned z_ = 0u; asm volatile("" : "+v"(z_)); int tid = wave * 64 + (int)__builtin_amdgcn_mbcnt_hi(~0u, __builtin_amdgcn_mbcnt_lo(~0u, z_)); const int lane = tid & 63; (void)lane;
    const int G = gridDim.x, bx = blockIdx.x;
    const int gw = bx * NWAVES + wave, NGW = G * NWAVES;
    unsigned char* ws = args.ws;
    gu32* ctl = (gu32*)(ws + WS_CTL);
    for (int u = tid0; u < (LDS_BYTES - LDSCTL_OFF) / 4; u += NTHR) ((LAS unsigned*)(lds + LDSCTL_OFF))[u] = 0u;
    __syncthreads();
    XcdBarrier bar; bar.bar = (unsigned*)ctl + CW_BAR; bar.x = 0; bar.st = nullptr;
    if (MK_ONE_LAUNCH) bar = xcd_barrier_post((unsigned*)ctl + CW_BAR, LCTL);
    const int lo = args.ph_lo, hi = args.ph_hi;
#ifndef SUBMASK
#define SUBMASK 7
#endif
#ifndef LN2PROBE
#define LN2PROBE 0
#endif
#ifndef SUBDUP
#define SUBDUP 0
#endif
#define NSUB(k) ((((SUBDUP) >> (k)) & 1) ? 2 : 1)
#ifndef DUPMASK
#define DUPMASK 0
#endif
#define NREP(k) ((((DUPMASK) >> (k)) & 1) ? 2 : 1)
#ifndef PHMASK
#define PHMASK 0xFFFF
#endif
#define IN(k) (lo <= (k) && (k) < hi)
#define SEAM(k) do { if (IN(k) && IN((k) + 1)) xcd_barrier(bar); } while (0)

    char* const Xb = (char*)(ws + WS_X);
    char* const Ub = (char*)(ws + WS_R1);
    float* const GIF = (float*)(ws + WS_GIF);
    LAS int* const PB = (LAS int*)(lds + LDSCTL_OFF + 64);
    LAS int* const CNT = (LAS int*)(lds + LDSCTL_OFF + 256);

    _Pragma("unroll 1") for (int rep_ = 0; rep_ < NREP(12); ++rep_) if (((PHMASK>>12)&1) && IN(0)) { PHASE_TID
        LAS float* scr = (LAS float*)(lds + wave * 8448);
        LAS float* wgt = (LAS float*)(lds + 73728);
        load_gate_table(wgt, INP(I_WIN), tid);
        constexpr int IT_IN = 16 * 216, IT_KV = 16 * 32, IT_BR = 8 * 32, IT_O = 16 * 32, IT_L = IT_IN + IT_KV + 3 * IT_BR + IT_O;
        for (int it = gw; it < DEPTH * IT_L; it += NGW) {
            const int l = it / IT_L; int r = it - l * IT_L;
            if (r < IT_IN) { const int kb = r / 216, nb = r % 216, n0 = 32 * nb, sc = n0 + (n0 >= 1536 ? 8 : 0);
                transpose_item(INP(I_WIN) + ((size_t)l * D + 64 * kb) * DIN + sc, DIN, (bf16*)(ws + WS_WIN) + ((size_t)l * NU + n0) * D + 64 * kb, D, scr, lane); continue; }
            r -= IT_IN;
            if (r < IT_KV) { const int kb = r / 32, nb = r % 32;
                transpose_item(INP(I_CAWKV) + ((size_t)l * D + 64 * kb) * 1024 + 32 * nb, 1024, (bf16*)(ws + WS_WKV) + ((size_t)l * 1024 + 32 * nb) * D + 64 * kb, D, scr, lane); continue; }
            r -= IT_KV;
            if (r < 3 * IT_BR) { const int br = r / IT_BR, q = r % IT_BR, kb = q / 32, nb = q % 32;
                const float* src = INP(br == 0 ? I_WBRML : (br == 1 ? I_WBRRW : I_WBRCA));
                transpose_item(src + ((size_t)l * 512 + 64 * kb) * 1024 + 32 * nb, 1024, (bf16*)(ws + WS_WBR) + ((size_t)l * 1024 + 32 * nb) * 1536 + br * 512 + 64 * kb, 1536, scr, lane); continue; }
            r -= 3 * IT_BR;
            { const int kb = r / 32, nb = r % 32;
                transpose_item(INP(I_WO) + ((size_t)l * D + 64 * kb) * 1024 + 32 * nb, 1024, (bf16*)(ws + WS_WO) + ((size_t)l * 1024 + 32 * nb) * D + 64 * kb, D, scr, lane); }
        }
        for (int i = bx * NTHR + tid; i < DEPTH * 1536 * 256; i += G * NTHR) {
            const int l = i / (1536 * 256), r = i % (1536 * 256), n = r >> 8, k = r & 255; float v = 0.f;
            if (n < 512) { if (k < 64) v = INP(I_RWWUP)[((size_t)l * 64 + k) * 512 + n]; }
            else if (n < 1024) { if (k >= 64 && k < 128) v = INP(I_RWAUP)[((size_t)l * 64 + (k - 64)) * 512 + (n - 512)]; }
            else { if (k >= 128) v = INP(I_RWGUP)[((size_t)l * 128 + (k - 128)) * 512 + (n - 1024)]; }
            ((bf16*)(ws + WS_WLORA))[i] = (bf16)f2bf(v);
        }
        __syncthreads();
        {
            f32x4 g[4], b[4];
#pragma unroll
            for (int j = 0; j < 4; ++j) { g[j] = *(const f32x4*)(INP(I_LNIN_G) + 256 * j + 4 * lane); b[j] = *(const f32x4*)(INP(I_LNIN_B) + 256 * j + 4 * lane); }
            for (int m = gw; m < M; m += NGW) {
                f32x4 v[4]; const float* xr = INP(I_X) + (size_t)m * D;
#pragma unroll
                for (int j = 0; j < 4; ++j) v[j] = *(const f32x4*)(xr + 256 * j + 4 * lane);
                ln16(v, g, b);
#pragma unroll
                for (int j = 0; j < 4; ++j) st4bf(Xb + ((size_t)m * D + 256 * j + 4 * lane) * 2, v[j]);
                gates8(v, wgt, GIF + (size_t)m * 8, lane);
            }
#pragma unroll
            for (int j = 0; j < 4; ++j) { g[j] = *(const f32x4*)(INP(I_MEMLN_G) + 256 * j + 4 * lane); b[j] = *(const f32x4*)(INP(I_MEMLN_B) + 256 * j + 4 * lane); }
            for (int m = gw; m < MROWS; m += NGW) {
                f32x4 v[4]; const float* xr = INP(I_MEM) + (size_t)m * D;
#pragma unroll
                for (int j = 0; j < 4; ++j) v[j] = *(const f32x4*)(xr + 256 * j + 4 * lane);
                ln16(v, g, b);
#pragma unroll
                for (int j = 0; j < 4; ++j) st4bf((char*)(ws + WS_MEMN) + ((size_t)m * D + 256 * j + 4 * lane) * 2, v[j]);
            }
        }
        __syncthreads();
    }
    SEAM(0);

#pragma unroll 1
    for (int l = 0; l < DEPTH; ++l) {
        const int pb = 1 + l * NP_LAYER;
        _Pragma("unroll 1") for (int rep_ = 0; rep_ < NREP(0); ++rep_) if (((PHMASK>>0)&1) && IN(pb + 0)) {
            SchedInproj S; S.T.init(M / 256, NU / 256); S.G = G; S.c = bx; S.X = Xb; S.W = (const char*)(ws + WS_WIN) + (size_t)l * NU * D * 2; S.U = Ub;
            S.kv = (l == 0); S.MEMN = (const char*)(ws + WS_MEMN); S.WKV = (const char*)(ws + WS_WKV); S.KV = (char*)(ws + WS_KV);
            pg8::EpiStore E;
            pg8::gemm_phase<false>(lds, D * 2, D * 2, D * 2, S, E, wave);
        }
        SEAM(pb + 0);
        _Pragma("unroll 1") for (int rep_ = 0; rep_ < NREP(1); ++rep_) if (((PHMASK>>1)&1) && IN(pb + 1)) { PHASE_TID
            const float* mu = INP(I_RWMU) + (size_t)l * 1792 + 1536;
            char* LIN = (char*)(ws + WS_R2 + R2_LORA_IN);
            for (int it = bx * NTHR + tid; it < M * 32; it += G * NTHR) {
                const int row = it >> 5, c = (it & 31) * 8;
                const u32x4 cw = *(const u32x4*)(Ub + ((size_t)row * NU + UC_RW + 1536 + c) * 2);
                u32x4 pw = (u32x4){0u, 0u, 0u, 0u};
                if ((row & (SEQ - 1)) != 0) pw = *(const u32x4*)(Ub + ((size_t)(row - 1) * NU + UC_RW + 1536 + c) * 2);
                const f32x4 m0 = *(const f32x4*)(mu + c), m1 = *(const f32x4*)(mu + c + 4);
                float x[8] = {bflo(cw.x), bfhi(cw.x), bflo(cw.y), bfhi(cw.y), bflo(cw.z), bfhi(cw.z), bflo(cw.w), bfhi(cw.w)};
                const float p[8] = {bflo(pw.x), bfhi(pw.x), bflo(pw.y), bfhi(pw.y), bflo(pw.z), bfhi(pw.z), bflo(pw.w), bfhi(pw.w)};
                const float mm[8] = {m0.x, m0.y, m0.z, m0.w, m1.x, m1.y, m1.z, m1.w};
#pragma unroll
                for (int i = 0; i < 8; ++i) { float xs = x[i] + (p[i] - x[i]) * mm[i];
                    if (c < 64) xs = 1.f - 2.f * __builtin_amdgcn_rcpf(1.f + __builtin_amdgcn_exp2f(2.8853900817779268f * xs));
                    else if (c >= 128) xs = sigmoidf_(xs);
                    x[i] = xs; }
                u32x4 o; o.x = pk2(x[0], x[1]); o.y = pk2(x[2], x[3]); o.z = pk2(x[4], x[5]); o.w = pk2(x[6], x[7]);
                *(u32x4*)(LIN + ((size_t)row * 256 + c) * 2) = o;
            }
        }
        SEAM(pb + 1);
        _Pragma("unroll 1") for (int rep_ = 0; rep_ < NREP(2); ++rep_) if (((PHMASK>>2)&1) && IN(pb + 2)) {
            SchedPlain S; S.T.init(M / 256, 6); S.G = G; S.c = bx; S.A = (const char*)(ws + WS_R2 + R2_LORA_IN); S.B = (const char*)(ws + WS_WLORA) + (size_t)l * 1536 * 256 * 2; S.C = (char*)(ws + WS_R2 + R2_LORA_OUT);
            S.lda = 256; S.ldb = 256; S.ldc = 1536;
            pg8::EpiStore E;
            pg8::gemm_phase<false>(lds, 512, 512, 512, S, E, wave);
        }
        SEAM(pb + 2);
        _Pragma("unroll 1") for (int rep_ = 0; rep_ < NREP(3); ++rep_) if (((PHMASK>>3)&1) && IN(pb + 3)) { PHASE_TID
            const char* LO = (const char*)(ws + WS_R2 + R2_LORA_OUT);
            char* HC = (char*)(ws + WS_R2 + R2_HCAT);
            const int tid_ph = tid;
#define SUB_TID unsigned zs_ = 0u; asm volatile("" : "+v"(zs_)); int tid = wave * 64 + (int)__builtin_amdgcn_mbcnt_hi(~0u, __builtin_amdgcn_mbcnt_lo(~0u, zs_)); const int lane = tid & 63; (void)lane;
#pragma unroll 1
            for (int job = bx; job < 256; job += G) {
                if (job < 128) { _Pragma("unroll 1") for (int sr_ = 0; sr_ < NSUB(0); ++sr_) if ((SUBMASK>>0)&1) {
                    SUB_TID
                    const int b = job >> 3, h = job & 7;
                    constexpr int TC = 64;
                    LAS float* OPS = (LAS float*)lds;
                    LAS float* OUTB = OPS + TC * 384;
                    LAS float* BON = OUTB + TC * 64;
                    LAS float* C12 = BON + TC;
                    LAS float* PREV = C12 + 2 * TC;
                    const int pt = tid >> 4, cs = tid & 15, pc = cs * 4, hc = h * 64 + pc;
                    if (tid < 192) PREV[tid] = 0.f;
                    f32x4 S0 = (f32x4){0.f, 0.f, 0.f, 0.f}, S1 = S0, So0 = S0, So1 = S0; float sap0 = 0.f, sap1 = 0.f; f32x2 vprev = (f32x2){0.f, 0.f};
                    u32x2 pu[2][9];
                    auto LOADC = [&](int t0) {
#pragma unroll
                        for (int tt = 0; tt < 2; ++tt) { const int t = t0 + pt + 32 * tt; const size_t row = (size_t)b * SEQ + t; const char* up = Ub + (row * NU + UC_RW + hc) * 2;
                            pu[tt][0] = *(const u32x2*)up; pu[tt][1] = *(const u32x2*)(up + 1024); pu[tt][2] = *(const u32x2*)(up + 2048);
                            if (t > 0) { const char* pp = up - (size_t)NU * 2; pu[tt][3] = *(const u32x2*)pp; pu[tt][4] = *(const u32x2*)(pp + 1024); pu[tt][5] = *(const u32x2*)(pp + 2048); }
                            else { pu[tt][3] = (u32x2){0u, 0u}; pu[tt][4] = pu[tt][3]; pu[tt][5] = pu[tt][3]; }
                            const char* lp = LO + (row * 1536 + hc) * 2; pu[tt][6] = *(const u32x2*)lp; pu[tt][7] = *(const u32x2*)(lp + 1024); pu[tt][8] = *(const u32x2*)(lp + 2048); }
                    };
#define UNP4(w) ((f32x4){bflo((w).x), bfhi((w).x), bflo((w).y), bfhi((w).y)})
#define DOT4(a, b) (((a).x * (b).x + (a).y * (b).y) + ((a).z * (b).z + (a).w * (b).w))
                    LOADC(0);
#pragma unroll 1
                    for (int t0 = 0; t0 < SEQ; t0 += TC) {
                        f32x4 gk[2];
                        int hcv = hc; asm volatile("" : "+v"(hcv));
                        const f32x4 mu_r = *(const f32x4*)(INP(I_RWMU) + (size_t)l * 1792 + hcv), mu_k = *(const f32x4*)(INP(I_RWMU) + (size_t)l * 1792 + 512 + hcv), mu_v = *(const f32x4*)(INP(I_RWMU) + (size_t)l * 1792 + 1024 + hcv);
                        const f32x4 w0 = *(const f32x4*)(INP(I_RWW0) + l * 512 + hcv), a0 = *(const f32x4*)(INP(I_RWA0) + l * 512 + hcv), kkw = *(const f32x4*)(INP(I_RWKK) + l * 512 + hcv);
                        const f32x4 kaw = *(const f32x4*)(INP(I_RWKA) + l * 512 + hcv), rkw = *(const f32x4*)(INP(I_RWRK) + l * 512 + hcv);
#pragma unroll
                        for (int tt = 0; tt < 2; ++tt) { const int tok = pt + 32 * tt;
                            const f32x4 ur = UNP4(pu[tt][0]), uk = UNP4(pu[tt][1]), uv = UNP4(pu[tt][2]), urp = UNP4(pu[tt][3]), ukp = UNP4(pu[tt][4]), uvp = UNP4(pu[tt][5]), lw = UNP4(pu[tt][6]), la = UNP4(pu[tt][7]);
                            gk[tt] = UNP4(pu[tt][8]);
                            const f32x4 xr = ur + (urp - ur) * mu_r, xk = uk + (ukp - uk) * mu_k, xv = uv + (uvp - uv) * mu_v;
                            f32x4 dec, av, kkv, kp; float ss = 0.f, bsum = 0.f;
#pragma unroll
                            for (int i = 0; i < 4; ++i) {
                                const float y = -(w0[i] + lw[i]);
                                const float sp = fmaxf(y, 0.f) + __logf(1.f + __expf(-fabsf(y)));
                                dec[i] = __expf(-__expf(-sp - 0.5f));
                                av[i] = sigmoidf_(a0[i] + la[i]);
                                kkv[i] = xk[i] * kkw[i]; ss += kkv[i] * kkv[i];
                                kp[i] = xk[i] * (1.f + (av[i] - 1.f) * kaw[i]);
                                bsum += xr[i] * kp[i] * rkw[i];
                            }
                            ss = red16(ss); bsum = red16(bsum);
                            const float inv = __builtin_amdgcn_rsqf(fmaxf(ss, 1e-24f));
                            const f32x4 kk = kkv * inv, kka = kk * av;
                            LAS float* o = OPS + tok * 384 + pc;
                            *(LAS f32x4*)(o) = dec; *(LAS f32x4*)(o + 64) = kk; *(LAS f32x4*)(o + 128) = kka; *(LAS f32x4*)(o + 192) = kp; *(LAS f32x4*)(o + 256) = xr; *(LAS f32x4*)(o + 320) = xv;
                            if (cs == 0) BON[tok] = bsum;
                        }
                        if (t0 + TC < SEQ) LOADC(t0 + TC);
                        __syncthreads();
#pragma unroll
                        for (int tt = 0; tt < 2; ++tt) { const int tok = pt + 32 * tt;
                            const LAS float* pr = OPS + (tok - 1) * 384 + pc;
                            f32x4 pw, pkp, pka;
                            if (tok > 0) { pw = *(const LAS f32x4*)pr; pkp = *(const LAS f32x4*)(pr + 192); pka = *(const LAS f32x4*)(pr + 128); }
                            else { pw = *(const LAS f32x4*)(PREV + pc); pkp = *(const LAS f32x4*)(PREV + 64 + pc); pka = *(const LAS f32x4*)(PREV + 128 + pc); }
                            LAS float* zp = OPS + tok * 384 + 64 + pc;
                            const f32x4 z = *(const LAS f32x4*)zp;
                            const float c1 = red16(DOT4(pkp, z)), c2 = red16(DOT4(pka, z));
                            *(LAS f32x4*)zp = pw * z;
                            if (cs == 0) *(LAS f32x2*)(C12 + 2 * tok) = (f32x2){c1, c2};
                        }
                        __syncthreads();
                        {
                            const LAS float* qb = OPS + pc; const LAS float* vb = OPS + 320 + 2 * pt;
                            float dc0, dc1;
                            { const f32x4 y0 = *(const LAS f32x4*)(qb + 64); dc0 = red16(DOT4(So0, y0)); dc1 = red16(DOT4(So1, y0)); }
                            f32x4 w4 = *(const LAS f32x4*)(qb), ka4 = *(const LAS f32x4*)(qb + 128), kp4 = *(const LAS f32x4*)(qb + 192), r4 = *(const LAS f32x4*)(qb + 256), yn = *(const LAS f32x4*)(qb + 384 + 64);
                            f32x2 v2 = *(const LAS f32x2*)vb, c12 = *(const LAS f32x2*)C12;
#define OPQ(x) asm("" : "+v"(x))
#define DOT4S(d, a, b) do { float t0_ = (a).x * (b).x, t1_ = (a).z * (b).z; OPQ(t0_); OPQ(t1_); t0_ = __builtin_fmaf((a).y, (b).y, t0_); t1_ = __builtin_fmaf((a).w, (b).w, t1_); OPQ(t0_); OPQ(t1_); d = t0_ + t1_; OPQ(d); } while (0)
#define UPD1(Sc, wc, kpc, kac, vs, sas) do { float t_ = (kpc) * (vs); OPQ(t_); t_ = __builtin_fmaf(-(kac), (sas), t_); OPQ(t_); Sc = __builtin_fmaf(Sc, (wc), t_); OPQ(Sc); } while (0)
#define RW_STEP(s, LASTSTEP) do { \
                                const int s1 = (s) + 1 < TC ? (s) + 1 : TC - 1, s2 = (s) + 2 < TC ? (s) + 2 : TC - 1; \
                                const f32x4 nw4 = *(const LAS f32x4*)(qb + s1 * 384), nka4 = *(const LAS f32x4*)(qb + s1 * 384 + 128), nkp4 = *(const LAS f32x4*)(qb + s1 * 384 + 192), nr4 = *(const LAS f32x4*)(qb + s1 * 384 + 256), nyn = *(const LAS f32x4*)(qb + s2 * 384 + 64); \
                                const f32x2 nv2 = *(const LAS f32x2*)(vb + s1 * 384), nc12 = *(const LAS f32x2*)(C12 + 2 * s1); \
                                float sa0 = vprev.x * c12.x, sa1 = vprev.y * c12.x; OPQ(sa0); OPQ(sa1); sa0 = __builtin_fmaf(-sap0, c12.y, sa0); sa1 = __builtin_fmaf(-sap1, c12.y, sa1); OPQ(sa0); OPQ(sa1); sa0 += dc0; sa1 += dc1; OPQ(sa0); OPQ(sa1); \
                                float dn0 = 0.f, dn1 = 0.f; \
                                if (LASTSTEP) { So0 = S0; So1 = S1; } else { DOT4S(dn0, S0, yn); DOT4S(dn1, S1, yn); dn0 = red16o(dn0); dn1 = red16o(dn1); } \
                                UPD1(S0.x, w4.x, kp4.x, ka4.x, v2.x, sa0); UPD1(S0.y, w4.y, kp4.y, ka4.y, v2.x, sa0); UPD1(S0.z, w4.z, kp4.z, ka4.z, v2.x, sa0); UPD1(S0.w, w4.w, kp4.w, ka4.w, v2.x, sa0); \
                                UPD1(S1.x, w4.x, kp4.x, ka4.x, v2.y, sa1); UPD1(S1.y, w4.y, kp4.y, ka4.y, v2.y, sa1); UPD1(S1.z, w4.z, kp4.z, ka4.z, v2.y, sa1); UPD1(S1.w, w4.w, kp4.w, ka4.w, v2.y, sa1); \
                                float o0, o1; DOT4S(o0, S0, r4); DOT4S(o1, S1, r4); o0 = red16o(o0); o1 = red16o(o1); \
                                if (cs == 0) *(LAS f32x2*)(OUTB + (s) * 64 + 2 * pt) = (f32x2){o0, o1}; \
                                sap0 = sa0; sap1 = sa1; vprev = v2; dc0 = dn0; dc1 = dn1; \
                                w4 = nw4; ka4 = nka4; kp4 = nkp4; r4 = nr4; yn = nyn; v2 = nv2; c12 = nc12; __builtin_amdgcn_sched_barrier(0); } while (0)
#pragma unroll 1
                            for (int s = 0; s < TC - 2; s += 2) { RW_STEP(s, false); RW_STEP(s + 1, false); }
                            RW_STEP(TC - 2, false);
                            RW_STEP(TC - 1, true);
#undef RW_STEP
#undef OPQ
#undef DOT4S
#undef UPD1
                        }
                        __syncthreads();
                        int hcw = hc; asm volatile("" : "+v"(hcw));
                        const f32x4 lng = *(const f32x4*)(INP(I_RWLNG) + l * 512 + hcw), lnb = *(const f32x4*)(INP(I_RWLNB) + l * 512 + hcw);
#pragma unroll
                        for (int tt = 0; tt < 2; ++tt) { const int tok = pt + 32 * tt;
                            const f32x4 o4 = *(const LAS f32x4*)(OUTB + tok * 64 + pc), v4 = *(const LAS f32x4*)(OPS + tok * 384 + 320 + pc);
                            const float mean = red16((o4.x + o4.y) + (o4.z + o4.w)) * (1.f / 64.f);
                            const f32x4 dv = o4 - mean;
                            const float var = red16(DOT4(dv, dv)) * (1.f / 64.f);
                            const float rstd = __builtin_amdgcn_rsqf(var + RW_GN_EPS), bo = BON[tok];
                            const f32x4 y = (dv * rstd * lng + lnb + v4 * bo) * gk[tt];
                            st4bf(HC + (((size_t)b * SEQ + t0 + tok) * 1536 + 512 + hc) * 2, y);
                        }
                        if (tid < 192) { const int j = tid >> 6, c = tid & 63; PREV[tid] = OPS[(TC - 1) * 384 + (j == 0 ? 0 : (j == 1 ? 192 : 128)) + c]; }
                        __syncthreads();
                    }
                } } else {
                    const int idx = job - 128, bh = idx >> 1, half = idx & 1, b = bh >> 2, h = bh & 3;
                    unsigned zl_ = 0u; asm volatile("" : "+v"(zl_)); const int lane_ml = (int)__builtin_amdgcn_mbcnt_hi(~0u, __builtin_amdgcn_mbcnt_lo(~0u, zl_));
                    _Pragma("unroll 1") for (int sr_ = 0; sr_ < NSUB(1); ++sr_) if ((SUBMASK>>1)&1) {
                        SUB_TID
                        constexpr int TC = 64;
                        LAS float* QK = (LAS float*)lds;
                        LAS float* VV = QK + TC * 128;
                        LAS float* FI = VV + TC * 64;
                        LAS float* NUM = FI + TC * 4;
                        LAS float* DENP = NUM + TC * 64;
                        const int pt = tid >> 4, cg = tid & 15;
                        const int ccol = (cg < 8) ? (h * 64 + 8 * cg) : (256 + h * 64 + 8 * (cg - 8));
                        float cw[4][8], cb[8];
#pragma unroll
                        for (int j = 0; j < 4; ++j) { const f32x4 a = *(const f32x4*)(INP(I_CONVW) + ((size_t)l * 4 + j) * 512 + ccol), c2 = *(const f32x4*)(INP(I_CONVW) + ((size_t)l * 4 + j) * 512 + ccol + 4);
                            cw[j][0] = a.x; cw[j][1] = a.y; cw[j][2] = a.z; cw[j][3] = a.w; cw[j][4] = c2.x; cw[j][5] = c2.y; cw[j][6] = c2.z; cw[j][7] = c2.w; }
                        { const f32x4 a = *(const f32x4*)(INP(I_CONVB) + l * 512 + ccol), c2 = *(const f32x4*)(INP(I_CONVB) + l * 512 + ccol + 4);
                            cb[0] = a.x; cb[1] = a.y; cb[2] = a.z; cb[3] = a.w; cb[4] = c2.x; cb[5] = c2.y; cb[6] = c2.z; cb[7] = c2.w; }
                        const float qsc = (cg < 8) ? 0.125f : 1.f;
                        const float igb = INP(I_IGB)[l * 4 + h], fgb = INP(I_FGB)[l * 4 + h];
                        const int r = tid >> 3, cs8 = (tid & 7) * 8;
                        const int ne = 8 * wave + (lane & 7);
                        float C[8] = {0.f, 0.f, 0.f, 0.f, 0.f, 0.f, 0.f, 0.f}; float nreg = 0.f, mprev = 0.f;
                        u32x4 cu[2][4]; u32x2 vu[2]; float gi = 0.f, gf = 0.f;
                        auto LOADM = [&](int t0) {
#pragma unroll
                            for (int tt = 0; tt < 2; ++tt) { const int t = t0 + pt + 32 * tt; const size_t row = (size_t)b * SEQ + t;
#pragma unroll
                                for (int j = 0; j < 4; ++j) { if (t - 3 + j >= 0) cu[tt][j] = *(const u32x4*)(Ub + ((row - 3 + j) * NU + UC_QK + ccol) * 2); else cu[tt][j] = (u32x4){0u, 0u, 0u, 0u}; }
                                vu[tt] = *(const u32x2*)(Ub + (row * NU + UC_V + h * 128 + half * 64 + 4 * cg) * 2); }
                            if (wave == 0) { const size_t rg = (size_t)b * SEQ + t0 + lane; gi = GIF[rg * 8 + h]; gf = GIF[rg * 8 + 4 + h]; }
                        };
                        LOADM(0);
#pragma unroll 1
                        for (int t0 = 0; t0 < SEQ; t0 += TC) {
#pragma unroll
                            for (int tt = 0; tt < 2; ++tt) { const int tok = pt + 32 * tt; float y[8];
#pragma unroll
                                for (int i = 0; i < 8; ++i) y[i] = cb[i];
#pragma unroll
                                for (int j = 0; j < 4; ++j) { const u32x4 w = cu[tt][j]; const float x[8] = {bflo(w.x), bfhi(w.x), bflo(w.y), bfhi(w.y), bflo(w.z), bfhi(w.z), bflo(w.w), bfhi(w.w)};
#pragma unroll
                                    for (int i = 0; i < 8; ++i) y[i] += cw[j][i] * x[i]; }
#pragma unroll
                                for (int i = 0; i < 8; ++i) y[i] = y[i] * sigmoidf_(y[i]) * qsc;
                                LAS float* o = QK + tok * 128 + 8 * cg;
                                *(LAS f32x4*)o = (f32x4){y[0], y[1], y[2], y[3]}; *(LAS f32x4*)(o + 4) = (f32x4){y[4], y[5], y[6], y[7]};
                                *(LAS f32x4*)(VV + tok * 64 + 4 * cg) = (f32x4){bflo(vu[tt].x), bfhi(vu[tt].x), bflo(vu[tt].y), bfhi(vu[tt].y)};
                            }
                            if (wave == 0) {
                                const float ig = gi + igb, fp = gf + fgb;
                                const float lf = -(fmaxf(-fp, 0.f) + __logf(1.f + __expf(-fabsf(fp))));
                                float bc = lf;
#pragma unroll
                                for (int o = 1; o < 64; o <<= 1) { const float t = __shfl_up(bc, o); if (lane >= o) bc += t; }
                                float pm = ig - bc;
#pragma unroll
                                for (int o = 1; o < 64; o <<= 1) { const float t = __shfl_up(pm, o); if (lane >= o) pm = fmaxf(pm, t); }
                                const float mt = bc + fmaxf(mprev, pm);
                                float mp1 = __shfl_up(mt, 1); if (lane == 0) mp1 = mprev;
                                const float fpr = __expf(lf + mp1 - mt), ipr = __expf(ig - mt), em = __expf(-mt);
                                *(LAS f32x4*)(FI + lane * 4) = (f32x4){fpr, ipr, em, 0.f};
                                mprev = __shfl(mt, 63);
                            }
                            if (t0 + TC < SEQ) LOADM(t0 + TC);
                            __syncthreads();
                            {
                                const LAS float* qp0 = QK + cs8;
                                f32x4 q0 = *(const LAS f32x4*)qp0, q1 = *(const LAS f32x4*)(qp0 + 4), k0 = *(const LAS f32x4*)(qp0 + 64), k1 = *(const LAS f32x4*)(qp0 + 68), fi = *(const LAS f32x4*)FI;
                                float vv = VV[r], nk = QK[64 + ne], nq = QK[ne];
#define OPQ(x) asm("" : "+v"(x))
#define ML_UPD(Cj, kj) do { float t_ = fi.x * Cj; OPQ(t_); Cj = __builtin_fmaf(tv, (kj), t_); OPQ(Cj); } while (0)
#define ML_STEP(s) do { \
                                    const int s1 = (s) + 1 < TC ? (s) + 1 : TC - 1; const LAS float* qp = qp0 + s1 * 128; \
                                    const f32x4 nq0 = *(const LAS f32x4*)qp, nq1 = *(const LAS f32x4*)(qp + 4), nk0 = *(const LAS f32x4*)(qp + 64), nk1 = *(const LAS f32x4*)(qp + 68), nfi = *(const LAS f32x4*)(FI + s1 * 4); \
                                    const float nvv = VV[s1 * 64 + r], nnk = QK[s1 * 128 + 64 + ne], nnq = QK[s1 * 128 + ne]; \
                                    float tv = fi.y * vv; OPQ(tv); \
                                    ML_UPD(C[0], k0.x); ML_UPD(C[1], k0.y); ML_UPD(C[2], k0.z); ML_UPD(C[3], k0.w); ML_UPD(C[4], k1.x); ML_UPD(C[5], k1.y); ML_UPD(C[6], k1.z); ML_UPD(C[7], k1.w); \
                                    float pa = C[0] * q0.x, pb = C[4] * q1.x; OPQ(pa); OPQ(pb); pa = __builtin_fmaf(C[1], q0.y, pa); pb = __builtin_fmaf(C[5], q1.y, pb); OPQ(pa); OPQ(pb); \
                                    pa = __builtin_fmaf(C[2], q0.z, pa); pb = __builtin_fmaf(C[6], q1.z, pb); OPQ(pa); OPQ(pb); pa = __builtin_fmaf(C[3], q0.w, pa); pb = __builtin_fmaf(C[7], q1.w, pb); OPQ(pa); OPQ(pb); \
                                    float p = pa + pb; OPQ(p); p = red8o(p); \
                                    float nt_ = fi.x * nreg; OPQ(nt_); nreg = __builtin_fmaf(fi.y, nk, nt_); OPQ(nreg); \
                                    float dp = nreg * nq; OPQ(dp); dp = red8o(dp); \
                                    NUM[(s) * 64 + r] = p;                   \
                                    DENP[(s) * 8 + wave] = dp; \
                                    q0 = nq0; q1 = nq1; k0 = nk0; k1 = nk1; fi = nfi; vv = nvv; nk = nnk; nq = nnq; __builtin_amdgcn_sched_barrier(0); } while (0)
#pragma unroll 1
                                for (int s = 0; s < TC; s += 2) { ML_STEP(s); ML_STEP(s + 1); }
#undef ML_STEP
#undef ML_UPD
#undef OPQ
                            }
                            __syncthreads();
#pragma unroll
                            for (int tt = 0; tt < 2; ++tt) { const int tok = pt + 32 * tt;
                                const f32x4 d0 = *(const LAS f32x4*)(DENP + tok * 8), d1 = *(const LAS f32x4*)(DENP + tok * 8 + 4);
                                const float den = ((d0.x + d0.y) + (d0.z + d0.w)) + ((d1.x + d1.y) + (d1.z + d1.w)), em = FI[tok * 4 + 2];
                                const float rdn = 1.f / fmaxf(fabsf(den), em);
                                const f32x4 nv = *(const LAS f32x4*)(NUM + tok * 64 + 4 * cg);
                                st4bf((char*)(ws + WS_HML) + (((size_t)b * SEQ + t0 + tok) * 512 + h * 128 + half * 64 + 4 * cg) * 2, nv * rdn);
                            }
                            __syncthreads();
                        }
                    }
                    _Pragma("unroll 1") for (int sr_ = 0; sr_ < NSUB(2); ++sr_) if ((SUBMASK>>2)&1) {
                        SUB_TID
                        constexpr int KST = 272, VST = 520;
                        LAS unsigned char* KI = lds; LAS unsigned char* VI = lds + 256 * KST;
                        const char* kvb = (const char*)(ws + WS_KV) + (((size_t)l * MROWS + (size_t)b * MEML) * D) * 2;
                        for (int p = tid; p < 4096; p += NTHR) { const int key = p >> 4, c16 = p & 15;
                            *(LAS u32x4*)(KI + key * KST + c16 * 16) = *(const u32x4*)(kvb + ((size_t)key * D + h * 128 + c16 * 8) * 2); }
                        for (int p = tid; p < 4096; p += NTHR) { const int key = p & 255, d8 = p >> 8;
                            const u32x4 w = *(const u32x4*)(kvb + ((size_t)key * D + 512 + h * 128 + d8 * 8) * 2);
                            LAS unsigned char* o = VI + (d8 * 8) * VST + key * 2;
                            *(LAS bf16*)(o) = (bf16)(w.x & 0xffff); *(LAS bf16*)(o + VST) = (bf16)(w.x >> 16); *(LAS bf16*)(o + 2 * VST) = (bf16)(w.y & 0xffff); *(LAS bf16*)(o + 3 * VST) = (bf16)(w.y >> 16);
                            *(LAS bf16*)(o + 4 * VST) = (bf16)(w.z & 0xffff); *(LAS bf16*)(o + 5 * VST) = (bf16)(w.z >> 16); *(LAS bf16*)(o + 6 * VST) = (bf16)(w.w & 0xffff); *(LAS bf16*)(o + 7 * VST) = (bf16)(w.w >> 16); }
                        __syncthreads();
                        const int r31 = lane & 31, h2 = lane >> 5;
                        constexpr float SC = 0.08838834764831845f * 1.4426950408889634f;
#pragma unroll 1
                        for (int rd = 0; rd < 8; ++rd) {
                            const size_t qrow = (size_t)b * SEQ + half * 2048 + rd * 256 + wave * 32 + r31;
                            bf16x8 qf[8];
#pragma unroll
                            for (int ks = 0; ks < 8; ++ks) qf[ks] = *(const bf16x8*)(Ub + (qrow * NU + UC_CAQ + h * 128 + 16 * ks + 8 * h2) * 2);
                            f32x16 O[4];
#pragma unroll
                            for (int db = 0; db < 4; ++db)
#pragma unroll
                                for (int i = 0; i < 16; ++i) O[db][i] = 0.f;
                            float mrun = -1e30f, lrun = 0.f;
#pragma unroll 1
                            for (int hf = 0; hf < 2; ++hf) {
                                f32x16 X[4];
#pragma unroll
                                for (int kb = 0; kb < 4; ++kb) {
                                    bf16x8 kf[8];
#pragma unroll
                                    for (int ks = 0; ks < 8; ++ks) kf[ks] = *(const LAS bf16x8*)(KI + (hf * 128 + kb * 32 + r31) * KST + (16 * ks + 8 * h2) * 2);
                                    __builtin_amdgcn_sched_barrier(0);
#pragma unroll
                                    for (int i = 0; i < 16; ++i) X[kb][i] = 0.f;
#pragma unroll
                                    for (int ks = 0; ks < 8; ++ks) X[kb] = __builtin_amdgcn_mfma_f32_32x32x16_bf16(kf[ks], qf[ks], X[kb], 0, 0, 0);
                                    __builtin_amdgcn_sched_barrier(0);
                                }
                                float mx = -1e30f;
#pragma unroll
                                for (int kb = 0; kb < 4; ++kb)
#pragma unroll
                                    for (int i = 0; i < 16; ++i) mx = fmaxf(mx, X[kb][i]);
                                mx = fmaxf(mx, __shfl_xor(mx, 32));
                                const float mnew = fmaxf(mrun, mx), alpha = __builtin_amdgcn_exp2f((mrun - mnew) * SC);
                                float ls = 0.f;
#pragma unroll
                                for (int kb = 0; kb < 4; ++kb)
#pragma unroll
                                    for (int i = 0; i < 16; ++i) { const float p = __builtin_amdgcn_exp2f((X[kb][i] - mnew) * SC); X[kb][i] = p; ls += p; }
                                ls += __shfl_xor(ls, 32);
                                lrun = lrun * alpha + ls; mrun = mnew;
#pragma unroll
                                for (int db = 0; db < 4; ++db)
#pragma unroll
                                    for (int i = 0; i < 16; ++i) O[db][i] *= alpha;
#pragma unroll
                                for (int kb = 0; kb < 4; ++kb) {
                                    bf16x8 vf[2][4], pf[2];
#pragma unroll
                                    for (int s = 0; s < 2; ++s) {
                                        u32x4 pw; pw.x = pk2(X[kb][8 * s], X[kb][8 * s + 1]); pw.y = pk2(X[kb][8 * s + 2], X[kb][8 * s + 3]); pw.z = pk2(X[kb][8 * s + 4], X[kb][8 * s + 5]); pw.w = pk2(X[kb][8 * s + 6], X[kb][8 * s + 7]);
                                        pf[s] = __builtin_bit_cast(bf16x8, pw);
#pragma unroll
                                        for (int db = 0; db < 4; ++db) {
                                            const LAS unsigned char* vp = VI + (db * 32 + r31) * VST + (hf * 128 + kb * 32 + 16 * s + 4 * h2) * 2;
                                            const u32x2 lo = *(const LAS u32x2*)vp, hi = *(const LAS u32x2*)(vp + 16);
                                            vf[s][db] = __builtin_bit_cast(bf16x8, (u32x4){lo.x, lo.y, hi.x, hi.y});
                                        }
                                    }
                                    __builtin_amdgcn_sched_barrier(0);
#pragma unroll
                                    for (int s = 0; s < 2; ++s)
#pragma unroll
                                        for (int db = 0; db < 4; ++db) O[db] = __builtin_amdgcn_mfma_f32_32x32x16_bf16(vf[s][db], pf[s], O[db], 0, 0, 0);
                                    __builtin_amdgcn_sched_barrier(0);
                                }
                            }
                            const float rl = 1.f / lrun;
                            char* op = HC + (qrow * 1536 + 1024 + h * 128) * 2;
#pragma unroll
                            for (int db = 0; db < 4; ++db)
#pragma unroll
                                for (int g4 = 0; g4 < 4; ++g4) { u32x2 w; w.x = pk2(O[db][4 * g4] * rl, O[db][4 * g4 + 1] * rl); w.y = pk2(O[db][4 * g4 + 2] * rl, O[db][4 * g4 + 3] * rl);
                                    *(u32x2*)(op + (db * 32 + 8 * g4 + 4 * h2) * 2) = w; }
                        }
                        __syncthreads();
                    }
                    if (rep_ == 0) {
                        LAS float* scr = (LAS float*)(lds + wave * 8448);
                        constexpr int IT_GU = 32 * 16 * 64;
                        for (int it = idx * NWAVES + wave; it < XW_SPLIT; it += 128 * NWAVES) {
                            if (it < IT_GU) { const int e = it >> 10, q = it & 1023, kb = q >> 6, nb = q & 63;
                                transpose_item_f8(INP(I_WGU) + (((size_t)l * 32 + e) * D + 64 * kb) * 2048 + 32 * nb, 2048, (unsigned char*)(ws + WS_WGU) + ((size_t)e * 2048 + 32 * nb) * D + 64 * kb, D, F8_SWGU, scr, lane_ml); }
                            else { const int r2 = it - IT_GU, e = r2 >> 9, q = r2 & 511, kb = q >> 5, nb = q & 31;
                                transpose_item_f8(INP(I_WDN) + (((size_t)l * 32 + e) * D + 64 * kb) * 1024 + 32 * nb, 1024, (unsigned char*)(ws + WS_WDN) + ((size_t)e * 1024 + 32 * nb) * D + 64 * kb, D, F8_SWDN, scr, lane_ml); }
                        }
                        __syncthreads();
                    }
                }
            }
#undef UNP4
#undef DOT4
#undef SUB_TID
        }
        SEAM(pb + 3);
        _Pragma("unroll 1") for (int rep_ = 0; rep_ < NREP(4); ++rep_) if (((PHMASK>>4)&1) && IN(pb + 4)) { PHASE_TID
            char* HC = (char*)(ws + WS_R2 + R2_HCAT);
            const int hd = lane >> 4, sb = (lane & 15) * 8;
            const f32x4 g0 = *(const f32x4*)(INP(I_MLNORMG) + l * 512 + hd * 128 + sb), g1 = *(const f32x4*)(INP(I_MLNORMG) + l * 512 + hd * 128 + sb + 4);
            for (int m = gw; m < M; m += NGW) {
                const u32x4 hw = *(const u32x4*)((const char*)(ws + WS_HML) + ((size_t)m * 512 + hd * 128 + sb) * 2);
                const u32x4 ow = *(const u32x4*)(Ub + ((size_t)m * NU + UC_OG + hd * 128 + sb) * 2);
                float v[8] = {bflo(hw.x), bfhi(hw.x), bflo(hw.y), bfhi(hw.y), bflo(hw.z), bfhi(hw.z), bflo(hw.w), bfhi(hw.w)};
                const float og[8] = {bflo(ow.x), bfhi(ow.x), bflo(ow.y), bfhi(ow.y), bflo(ow.z), bfhi(ow.z), bflo(ow.w), bfhi(ow.w)};
                const float gg[8] = {g0.x, g0.y, g0.z, g0.w, g1.x, g1.y, g1.z, g1.w};
                float s = 0.f;
#pragma unroll
                for (int i = 0; i < 8; ++i) s += v[i];
                const float mean = red16(s) * (1.f / 128.f); float s2 = 0.f;
#pragma unroll
                for (int i = 0; i < 8; ++i) { v[i] -= mean; s2 += v[i] * v[i]; }
                const float rstd = 1.f / sqrtf(red16(s2) * (1.f / 128.f) + LN_EPS);
#pragma unroll
                for (int i = 0; i < 8; ++i) v[i] = sigmoidf_(og[i]) * (v[i] * rstd * gg[i]);
                u32x4 o; o.x = pk2(v[0], v[1]); o.y = pk2(v[2], v[3]); o.z = pk2(v[4], v[5]); o.w = pk2(v[6], v[7]);
                *(u32x4*)(HC + ((size_t)m * 1536 + hd * 128 + sb) * 2) = o;
            }
        }
        SEAM(pb + 4);
        _Pragma("unroll 1") for (int rep_ = 0; rep_ < NREP(5); ++rep_) if (((PHMASK>>5)&1) && IN(pb + 5)) {
            SchedPlain S; S.T.init(M / 256, 4); S.G = G; S.c = bx; S.A = (const char*)(ws + WS_R2 + R2_HCAT); S.B = (const char*)(ws + WS_WBR) + (size_t)l * 1024 * 1536 * 2; S.C = (char*)(ws + WS_R2 + R2_YPRE);
            S.lda = 1536; S.ldb = 1536; S.ldc = D;
            pg8::EpiMerge E; E.U = Ub; E.gate_b = INP(I_GATEB) + (size_t)l * 3072;
            pg8::gemm_phase<false, true>(lds, 1536 * 2, 1536 * 2, 1536 * 2, S, E, wave);
        }
        SEAM(pb + 5);
        _Pragma("unroll 1") for (int rep_ = 0; rep_ < NREP(6); ++rep_) if (((PHMASK>>6)&1) && IN(pb + 6)) {
            SchedPlain S; S.T.init(M / 256, 4); S.G = G; S.c = bx; S.A = (const char*)(ws + WS_R2 + R2_YPRE); S.B = (const char*)(ws + WS_WO) + (size_t)l * D * D * 2; S.C = (char*)(ws + WS_R2 + R2_Z);
            S.lda = D; S.ldb = D; S.ldc = D;
            pg8::EpiStore E;
            pg8::gemm_phase<false>(lds, D * 2, D * 2, D * 2, S, E, wave);
        }
        SEAM(pb + 6);
        _Pragma("unroll 1") for (int rep_ = 0; rep_ < NREP(7); ++rep_) if (((PHMASK>>7)&1) && IN(pb + 7)) { PHASE_TID
            LAS float* WR = (LAS float*)lds;
            for (int i = tid; i < 32768; i += NTHR) { const int k = i >> 5, e = i & 31; WR[e * 1024 + k] = INP(I_RTW)[((size_t)l * D + k) * 32 + e]; }
            __syncthreads();
            f32x4 g[4], bb[4];
#pragma unroll
            for (int j = 0; j < 4; ++j) { g[j] = *(const f32x4*)(INP(I_LN1G) + l * D + 256 * j + 4 * lane); bb[j] = *(const f32x4*)(INP(I_LN1B) + l * D + 256 * j + 4 * lane); }
            const float rbias = INP(I_RTB)[l * 32 + (lane & 31)];
            const char* Zb = (const char*)(ws + WS_R2 + R2_Z);
            int* TKE = (int*)(ws + WS_TKE); float* TKG = (float*)(ws + WS_TKG); int* TKP = (int*)(ws + WS_TKP); int* ROWTOK = (int*)(ws + WS_ROWTOK);
            LAS unsigned* LCNT = (LAS unsigned*)(lds + 131072);
            LAS unsigned* GBASE = LCNT + 32; LAS unsigned* LLEN = LCNT + 64; LAS unsigned* LIST = LCNT + 128;
            if (tid < 65) LCNT[tid] = 0u;
            __syncthreads();
#pragma unroll 1
            for (int pp = gw; pp < M / 2; pp += NGW) {
                f32x4 y0[4], y1[4];
#pragma unroll
                for (int j = 0; j < 4; ++j) { y0[j] = ld4bf(Zb + ((size_t)(2 * pp) * D + 256 * j + 4 * lane) * 2) + ld4bf(Xb + ((size_t)(2 * pp) * D + 256 * j + 4 * lane) * 2) * DN_ALPHA;
                    y1[j] = ld4bf(Zb + ((size_t)(2 * pp + 1) * D + 256 * j + 4 * lane) * 2) + ld4bf(Xb + ((size_t)(2 * pp + 1) * D + 256 * j + 4 * lane) * 2) * DN_ALPHA; }
                ln16(y0, g, bb); ln16(y1, g, bb);
#pragma unroll
                for (int j = 0; j < 4; ++j) { st4bf(Xb + ((size_t)(2 * pp) * D + 256 * j + 4 * lane) * 2, y0[j]); st4bf(Xb + ((size_t)(2 * pp + 1) * D + 256 * j + 4 * lane) * 2, y1[j]); }
                float v[64];
#pragma unroll
                for (int e = 0; e < 32; ++e) { float s0 = 0.f, s1 = 0.f;
#pragma unroll
                    for (int j = 0; j < 4; ++j) { const f32x4 w = *(const LAS f32x4*)(WR + e * 1024 + 256 * j + 4 * lane);
                        s0 += (y0[j].x * w.x + y0[j].y * w.y) + (y0[j].z * w.z + y0[j].w * w.w); s1 += (y1[j].x * w.x + y1[j].y * w.y) + (y1[j].z * w.z + y1[j].w * w.w); }
                    v[e] = s0; v[32 + e] = s1; if ((e & 3) == 3) __builtin_amdgcn_sched_barrier(0); }
#pragma unroll
                for (int bsh = 5; bsh >= 0; --bsh) { const int n2 = 1 << bsh; const bool up = (lane >> bsh) & 1;
#pragma unroll
                    for (int i = 0; i < n2; ++i) { const float send = up ? v[i] : v[i + n2], keep = up ? v[i + n2] : v[i]; v[i] = keep + __shfl_xor(send, n2); } }
                float cur = v[0] + rbias;
                const int half = lane >> 5, el = lane & 31;
                float tv[4]; int te[4];
#pragma unroll
                for (int k = 0; k < 4; ++k) { float mx = cur;
#pragma unroll
                    for (int o = 1; o < 32; o <<= 1) mx = fmaxf(mx, __shfl_xor(mx, o));
                    const unsigned long long bal = __ballot(cur == mx); const unsigned hm = (unsigned)(bal >> (32 * half));
                    const int win = __builtin_ctz(hm); tv[k] = mx; te[k] = win; if (el == win) cur = -3.0e38f; }
                const float e1 = __expf(tv[1] - tv[0]), e2 = __expf(tv[2] - tv[0]), e3 = __expf(tv[3] - tv[0]), rs = 1.f / (1.f + e1 + e2 + e3);
                const float gt[4] = {rs, e1 * rs, e2 * rs, e3 * rs};
                const int token = 2 * pp + half;
#pragma unroll
                for (int k = 0; k < 4; ++k) if (el == te[k] && rep_ == 0) {
                    const unsigned lpos = __hip_atomic_fetch_add(LCNT + el, 1u, __ATOMIC_RELAXED, __HIP_MEMORY_SCOPE_WORKGROUP);
                    const unsigned li = __hip_atomic_fetch_add(LLEN, 1u, __ATOMIC_RELAXED, __HIP_MEMORY_SCOPE_WORKGROUP);
                    LIST[2 * li] = (unsigned)(token * 4 + k); LIST[2 * li + 1] = (unsigned)el | (lpos << 8);
                    TKE[token * 4 + k] = el; TKG[token * 4 + k] = gt[k]; }
            }
            __syncthreads();
            if (tid < 32 && rep_ == 0) GBASE[tid] = __hip_atomic_fetch_add((unsigned*)ctl + CW_CNT + (l * 32 + tid) * 64, LCNT[tid], RLX_AGENT);
            __syncthreads();
            if (rep_ == 0) { const unsigned n = LLEN[0];
                for (unsigned i = tid; i < n; i += NTHR) { const unsigned tk = LIST[2 * i], ev = LIST[2 * i + 1], e = ev & 255u, pos = GBASE[e] + (ev >> 8);
                    TKP[tk] = (int)pos; ROWTOK[(size_t)e * M + pos] = (int)(tk >> 2); } }
            __syncthreads();
        }
        SEAM(pb + 7);
        _Pragma("unroll 1") for (int rep_ = 0; rep_ < NREP(8); ++rep_) if (((PHMASK>>8)&1) && IN(pb + 8)) { PHASE_TID
            if (tid < 32) CNT[tid] = (int)__hip_atomic_load((unsigned*)ctl + CW_CNT + (l * 32 + tid) * 64, RLX_AGENT);
            __syncthreads();
            if (tid == 0) { int a = 0; for (int e = 0; e < 32; ++e) { PB[e] = a; a += (CNT[e] + 255) >> 8; } PB[32] = a; }
            __syncthreads();
            const int P = PB[32];
            const int* ROWTOK = (const int*)(ws + WS_ROWTOK);
            char* XD = (char*)(ws + WS_R1);
            for (int sb = gw * 64; sb < P * 256; sb += NGW * 64) {
                const int pm = sb >> 8; int e = 0;
#pragma unroll 1
                for (int j = 1; j < NEXP; ++j) e += (PB[j] <= pm) ? 1 : 0;
                const int pos0 = sb - PB[e] * 256, cnt = CNT[e];
                int nvalid = cnt - pos0; nvalid = nvalid > 64 ? 64 : nvalid;
                int tokv = -1; if (pos0 + lane < cnt) tokv = ROWTOK[(size_t)e * M + pos0 + lane];
#pragma unroll 1
                for (int j = 0; j < nvalid; j += 2) {
                    int t[2]; u32x4 a[2], b2[2];
#pragma unroll
                    for (int i = 0; i < 2; ++i) { t[i] = __builtin_amdgcn_readlane(tokv, j + i);
                        if (t[i] >= 0) { a[i] = *(const u32x4*)(Xb + (size_t)t[i] * 2048 + lane * 32); b2[i] = *(const u32x4*)(Xb + (size_t)t[i] * 2048 + lane * 32 + 16); } }
#pragma unroll
                    for (int i = 0; i < 2; ++i) if (t[i] >= 0) {
                        u32x4 o; o.x = pk4_f8(bflo(a[i].x) * F8_SX, bfhi(a[i].x) * F8_SX, bflo(a[i].y) * F8_SX, bfhi(a[i].y) * F8_SX); o.y = pk4_f8(bflo(a[i].z) * F8_SX, bfhi(a[i].z) * F8_SX, bflo(a[i].w) * F8_SX, bfhi(a[i].w) * F8_SX);
                        o.z = pk4_f8(bflo(b2[i].x) * F8_SX, bfhi(b2[i].x) * F8_SX, bflo(b2[i].y) * F8_SX, bfhi(b2[i].y) * F8_SX); o.w = pk4_f8(bflo(b2[i].z) * F8_SX, bfhi(b2[i].z) * F8_SX, bflo(b2[i].w) * F8_SX, bfhi(b2[i].w) * F8_SX);
                        *(u32x4*)(XD + (size_t)(sb + j + i) * 1024 + lane * 16) = o; }
                }
            }
            LAS float* scr = (LAS float*)(lds + wave * 8448);
            constexpr int IT_GU = 32 * 16 * 64, IT_DN = 32 * 16 * 32;
            for (int it = XW_SPLIT + gw; it < IT_GU + IT_DN; it += NGW) {
                if (it < IT_GU) { const int e = it >> 10, q = it & 1023, kb = q >> 6, nb = q & 63;
                    transpose_item_f8(INP(I_WGU) + (((size_t)l * 32 + e) * D + 64 * kb) * 2048 + 32 * nb, 2048, (unsigned char*)(ws + WS_WGU) + ((size_t)e * 2048 + 32 * nb) * D + 64 * kb, D, F8_SWGU, scr, lane); }
                else { const int r = it - IT_GU, e = r >> 9, q = r & 511, kb = q >> 5, nb = q & 31;
                    transpose_item_f8(INP(I_WDN) + (((size_t)l * 32 + e) * D + 64 * kb) * 1024 + 32 * nb, 1024, (unsigned char*)(ws + WS_WDN) + ((size_t)e * 1024 + 32 * nb) * D + 64 * kb, D, F8_SWDN, scr, lane); }
            }
            __syncthreads();
        }
        SEAM(pb + 8);
        if (IN(pb + 9) || IN(pb + 10)) { PHASE_TID
            if (tid < 32) CNT[tid] = (int)__hip_atomic_load((unsigned*)ctl + CW_CNT + (l * 32 + tid) * 64, RLX_AGENT);
            __syncthreads();
            if (tid == 0) { int a = 0; for (int e = 0; e < 32; ++e) { PB[e] = a; a += (CNT[e] + 255) >> 8; } PB[32] = a; }
            __syncthreads();
        }
        _Pragma("unroll 1") for (int rep_ = 0; rep_ < NREP(9); ++rep_) if (((PHMASK>>9)&1) && IN(pb + 9)) {
            SchedMoe S; S.T.init(PB[32], 8); S.G = G; S.c = bx; S.A = (const char*)(ws + WS_R1); S.W = (const char*)(ws + WS_WGU); S.C = (char*)(ws + WS_R2 + R2_HMID); S.PB = PB; S.wrows = 2048; S.ldc = 1024; S.cdiv = 2; S.osz = 1;
            pg8::EpiMoe1 E; E.bgu = INP(I_BGU) + (size_t)l * 32 * 2048;
            pg8::gemm_phase<true>(lds, D, D, D, S, E, wave);
        }
        SEAM(pb + 9);
        _Pragma("unroll 1") for (int rep_ = 0; rep_ < NREP(10); ++rep_) if (((PHMASK>>10)&1) && IN(pb + 10)) {
            SchedMoe S; S.T.init(PB[32], 4); S.G = G; S.c = bx; S.A = (const char*)(ws + WS_R2 + R2_HMID); S.W = (const char*)(ws + WS_WDN); S.C = (char*)(ws + WS_R1); S.PB = PB; S.wrows = 1024; S.ldc = 1024; S.cdiv = 1; S.osz = 2;
            pg8::EpiMoe2 E; E.bdn = INP(I_BDN) + (size_t)l * 32 * 1024;
            pg8::gemm_phase<true>(lds, D, D, D, S, E, wave);
        }
        SEAM(pb + 10);
        _Pragma("unroll 1") for (int rep_ = 0; rep_ < NREP(11); ++rep_) if (((PHMASK>>11)&1) && IN(pb + 11)) { PHASE_TID
            if (tid < 32) CNT[tid] = (int)__hip_atomic_load((unsigned*)ctl + CW_CNT + (l * 32 + tid) * 64, RLX_AGENT);
            LAS float* wgt = (LAS float*)(lds + 73728);
            const bool lastl = (l == DEPTH - 1);
            if (!lastl) load_gate_table(wgt, INP(I_WIN) + (size_t)(l + 1) * D * DIN, tid);
            __syncthreads();
            if (tid == 0) { int a = 0; for (int e = 0; e < 32; ++e) { PB[e] = a; a += (CNT[e] + 255) >> 8; } PB[32] = a; }
            __syncthreads();
            const int e0 = 8 * lane;
            f32x4 g[4], bb[4];
#pragma unroll
            for (int j = 0; j < 4; ++j) { const int o = (j >> 1) * 512 + e0 + (j & 1) * 4; g[j] = *(const f32x4*)(INP(I_LN2G) + l * D + o); bb[j] = *(const f32x4*)(INP(I_LN2B) + l * D + o); }
            const char* YA = (const char*)(ws + WS_R1);
            const bool dummy_ = (rep_ + 1 < NREP(11)); char* const Xo = dummy_ ? (char*)(ws + WS_R2) : Xb; float* const Fo = dummy_ ? (float*)(ws + WS_R2 + 256 * MiB) : args.out; float* const Go = dummy_ ? (float*)(ws + WS_R2 + 200 * MiB) : GIF;
            const int* TKE = (const int*)(ws + WS_TKE); const float* TKG = (const float*)(ws + WS_TKG); const int* TKP = (const int*)(ws + WS_TKP);
#pragma unroll 1
            for (int mb = gw * 16; mb < M; mb += NGW * 16) {
                const int ev = TKE[mb * 4 + lane], pv = TKP[mb * 4 + lane]; const float gv = TKG[mb * 4 + lane];
                const int rowv = PB[ev] * 256 + pv;
#pragma unroll 1
                for (int ti = 0; ti < 16; ti += 2) {
                    u32x4 xw[2][2], yw[2][4][2]; float gk[2][4];
#pragma unroll
                    for (int q = 0; q < 2; ++q) { const size_t m = (size_t)mb + ti + q;
                        xw[q][0] = *(const u32x4*)(Xb + (m * D + e0) * 2); xw[q][1] = *(const u32x4*)(Xb + (m * D + 512 + e0) * 2);
#pragma unroll
                        for (int k = 0; k < 4; ++k) { const size_t row = (size_t)__builtin_amdgcn_readlane(rowv, 4 * (ti + q) + k);
                            gk[q][k] = __builtin_bit_cast(float, __builtin_amdgcn_readlane(__builtin_bit_cast(int, gv), 4 * (ti + q) + k));
                            yw[q][k][0] = *(const u32x4*)(YA + (row * D + e0) * 2); yw[q][k][1] = *(const u32x4*)(YA + (row * D + 512 + e0) * 2); } }
#pragma unroll
                    for (int q = 0; q < 2; ++q) { const size_t m = (size_t)mb + ti + q;
                        f32x4 v[4];
#pragma unroll
                        for (int hh = 0; hh < 2; ++hh) { const u32x4 w = xw[q][hh];
                            v[2 * hh] = (f32x4){bflo(w.x), bfhi(w.x), bflo(w.y), bfhi(w.y)} * DN_ALPHA; v[2 * hh + 1] = (f32x4){bflo(w.z), bfhi(w.z), bflo(w.w), bfhi(w.w)} * DN_ALPHA; }
#pragma unroll
                        for (int k = 0; k < 4; ++k)
#pragma unroll
                            for (int hh = 0; hh < 2; ++hh) { const u32x4 w = yw[q][k][hh];
                                v[2 * hh] = v[2 * hh] + (f32x4){bflo(w.x), bfhi(w.x), bflo(w.y), bfhi(w.y)} * gk[q][k]; v[2 * hh + 1] = v[2 * hh + 1] + (f32x4){bflo(w.z), bfhi(w.z), bflo(w.w), bfhi(w.w)} * gk[q][k]; }
                        ln16(v, g, bb);
                        if (lastl) {
#pragma unroll
                            for (int j = 0; j < 4; ++j) *(f32x4*)(Fo + m * D + (j >> 1) * 512 + e0 + (j & 1) * 4) = v[j];
                        } else {
#pragma unroll
                            for (int hh = 0; hh < 2; ++hh) *(u32x4*)(Xo + (m * D + hh * 512 + e0) * 2) = pg8::pack8(v[2 * hh], v[2 * hh + 1]);
                            gates8b(v, wgt, Go + m * 8, lane);
                        }
                    }
                }
            }
            __syncthreads();
        }
        SEAM(pb + 11);
    }
#undef IN
#undef SEAM
}

extern "C" void kernel_launch(void* const* d_in, const int* in_sizes, int n_in, void* d_out, int out_size, void* d_ws, size_t ws_size, hipStream_t stream) {
    static int grid = 0;
    if (grid == 0) {
        if (n_in != N_IN || out_size != M * D || ws_size < WS_END) { fprintf(stderr, "kernel_launch: unexpected shapes (n_in %d, out %d, ws %zu)\n", n_in, out_size, ws_size); grid = -1; return; }
        int dev = 0, cus = 0, per_cu = 0;
        if (hipGetDevice(&dev) != hipSuccess || hipDeviceGetAttribute(&cus, hipDeviceAttributeMultiprocessorCount, dev) != hipSuccess) { grid = -1; return; }
        if (hipFuncSetAttribute((const void*)fwd_kernel, hipFuncAttributeMaxDynamicSharedMemorySize, LDS_BYTES) != hipSuccess) { fprintf(stderr, "kernel_launch: hipFuncSetAttribute failed\n"); grid = -1; return; }
        if (hipOccupancyMaxActiveBlocksPerMultiprocessor(&per_cu, (const void*)fwd_kernel, NTHR, LDS_BYTES) != hipSuccess || per_cu < 1) fprintf(stderr, "kernel_launch: occupancy query reports %d\n", per_cu);
        (void)hipGetLastError();
        grid = cus;
    }
    if (grid < 0) return;
    (void)hipMemsetAsync((char*)d_ws + WS_CTL, 0, CTL_ZERO_BYTES, stream);
    Args a{};
    for (int i = 0; i < N_IN; ++i) a.in[i] = (const float*)d_in[i];
    a.out = (float*)d_out; a.ws = (unsigned char*)d_ws;
#if MK_ONE_LAUNCH
    a.ph_lo = 0; a.ph_hi = NPH;
    hipLaunchKernelGGL(fwd_kernel, dim3(grid), dim3(NTHR), LDS_BYTES, stream, a);
#else
    for (int p = 0; p < NPH; ++p) { a.ph_lo = p; a.ph_hi = p + 1; hipLaunchKernelGGL(fwd_kernel, dim3(grid), dim3(NTHR), LDS_BYTES, stream, a); }
#endif
    const hipError_t le = hipPeekAtLastError();
    if (le != hipSuccess) fprintf(stderr, "kernel_launch: launch failed: %s\n", hipGetErrorName(le));
}
```

```cpp
#include <hip/hip_runtime.h>
#include <cstdio>
#include <cstdint>

#ifndef MK_ONE_LAUNCH
#define MK_ONE_LAUNCH 1
#endif

#define LAS __attribute__((address_space(3)))
#define GAS __attribute__((address_space(1)))
typedef unsigned short bf16;
typedef short bf16x8 __attribute__((ext_vector_type(8)));
typedef float f32x4 __attribute__((ext_vector_type(4)));
typedef float f32x2 __attribute__((ext_vector_type(2)));
typedef float f32x16 __attribute__((ext_vector_type(16)));
typedef unsigned u32x4 __attribute__((ext_vector_type(4)));
typedef unsigned u32x2 __attribute__((ext_vector_type(2)));
typedef __bf16 bf16x2_t __attribute__((ext_vector_type(2)));
typedef GAS unsigned gu32;
#define RLX_AGENT __ATOMIC_RELAXED, __HIP_MEMORY_SCOPE_AGENT
#define DI __device__ __forceinline__

constexpr int NWAVES = 8, NTHR = 512;
constexpr int D = 1024, BATCH = 16, SEQ = 4096, M = BATCH * SEQ, DEPTH = 2, MEML = 256, MROWS = BATCH * MEML;
constexpr int DIN = 6920, NU = 6912;
constexpr int UC_QK = 0, UC_V = 512, UC_OG = 1024, UC_RW = 1536, UC_CAQ = 3328, UC_GATE = 3840;
constexpr int NEXP = 32, TOPK = 4;
constexpr int PMAX = M * TOPK / 256 + NEXP;
constexpr float LN_EPS = 1e-5f, RW_GN_EPS = 64e-5f, DN_ALPHA = 1.41421356237f;

enum { I_X = 0, I_MEM, I_LNIN_G, I_LNIN_B, I_MEMLN_G, I_MEMLN_B, I_WIN, I_CONVW, I_CONVB, I_IGB, I_FGB, I_MLNORMG, I_RWMU, I_RWW0, I_RWWUP, I_RWA0, I_RWAUP, I_RWGUP,
       I_RWKK, I_RWKA, I_RWRK, I_RWLNG, I_RWLNB, I_CAWKV, I_GATEB, I_WBRML, I_WBRRW, I_WBRCA, I_WO, I_LN1G, I_LN1B, I_RTW, I_RTB, I_WGU, I_BGU, I_WDN, I_BDN, I_LN2G, I_LN2B, N_IN };

constexpr size_t MiB = 1u << 20;
constexpr size_t WS_CTL = 0, CTL_ZERO_BYTES = 1 * MiB;
constexpr size_t WS_WIN = 1 * MiB;
constexpr size_t WS_WKV = 28 * MiB;
constexpr size_t WS_WBR = 32 * MiB;
constexpr size_t WS_WO = 38 * MiB;
constexpr size_t WS_WLORA = 42 * MiB;
constexpr size_t WS_WGU = 45 * MiB;
constexpr size_t WS_WDN = 173 * MiB;
constexpr size_t WS_X = 237 * MiB;
constexpr size_t WS_MEMN = 365 * MiB;
constexpr size_t WS_KV = 373 * MiB;
constexpr size_t WS_GIF = 389 * MiB;
constexpr size_t WS_TKE = 391 * MiB, WS_TKG = 392 * MiB, WS_TKP = 393 * MiB;
constexpr size_t WS_ROWTOK = 394 * MiB;
constexpr size_t WS_HML = 402 * MiB;
constexpr size_t WS_R1 = 466 * MiB;
constexpr size_t WS_R2 = 1330 * MiB;
constexpr size_t WS_XF8 = 1858 * MiB;
constexpr size_t WS_WING8 = 1922 * MiB;
constexpr size_t WS_END = 1930 * MiB;
constexpr size_t R2_LORA_OUT = 0, R2_HCAT = 192 * MiB, R2_LORA_IN = 384 * MiB, R2_YPRE = 0, R2_Z = 192 * MiB, R2_HMID = 0;
constexpr int CW_TMO = 0, CW_BAR = 4096, CW_CNT = 16384;

constexpr int LDS_BYTES = 155648;
constexpr int LDSCTL_OFF = 153600;

DI unsigned f2bf(float f) { unsigned u = __builtin_bit_cast(unsigned, f); return (u + 0x7fffu + ((u >> 16) & 1u)) >> 16; }
DI unsigned pk2(float lo, float hi) { bf16x2_t b = __builtin_convertvector((f32x2){lo, hi}, bf16x2_t); return __builtin_bit_cast(unsigned, b); }
DI float bflo(unsigned u) { return __builtin_bit_cast(float, u << 16); }
DI float bfhi(unsigned u) { return __builtin_bit_cast(float, u & 0xffff0000u); }
DI unsigned pk4_f8(float a, float b, float c, float d) {
    a = __builtin_amdgcn_fmed3f(a, -448.f, 448.f); b = __builtin_amdgcn_fmed3f(b, -448.f, 448.f); c = __builtin_amdgcn_fmed3f(c, -448.f, 448.f); d = __builtin_amdgcn_fmed3f(d, -448.f, 448.f);
    int w = 0; w = __builtin_amdgcn_cvt_pk_fp8_f32(a, b, w, false); w = __builtin_amdgcn_cvt_pk_fp8_f32(c, d, w, true); return (unsigned)w; }
DI float sigmoidf_(float x) { return __builtin_amdgcn_rcpf(1.f + __builtin_amdgcn_exp2f(-1.4426950408889634f * x)); }
template <int CTRL> DI float dppf(float x) { return __builtin_bit_cast(float, __builtin_amdgcn_update_dpp(0, __builtin_bit_cast(int, x), CTRL, 0xF, 0xF, true)); }
DI float red4(float x) { x += dppf<0xB1>(x); x += dppf<0x4E>(x); return x; }
DI float red8(float x) { x = red4(x); x += dppf<0x141>(x); return x; }
DI float red16(float x) { x = red8(x); x += dppf<0x140>(x); return x; }
DI float red8o(float x) { x += dppf<0xB1>(x); asm("" : "+v"(x)); x += dppf<0x4E>(x); asm("" : "+v"(x)); x += dppf<0x141>(x); asm("" : "+v"(x)); return x; }
DI float red16o(float x) { x = red8o(x); x += dppf<0x140>(x); asm("" : "+v"(x)); return x; }
DI float wave_sum(float v) {
    v = red16(v);
    const int vi = __builtin_bit_cast(int, v);
    const float a = __builtin_bit_cast(float, __builtin_amdgcn_readlane(vi, 0)), b = __builtin_bit_cast(float, __builtin_amdgcn_readlane(vi, 16));
    const float c = __builtin_bit_cast(float, __builtin_amdgcn_readlane(vi, 32)), d = __builtin_bit_cast(float, __builtin_amdgcn_readlane(vi, 48));
    return (a + b) + (c + d);
}
#define LDS_WAIT() asm volatile("s_waitcnt lgkmcnt(0)" ::: "memory")

constexpr float F8_SX = 8.f, F8_SWGU = 512.f, F8_SH = 4.f, F8_SWDN = 1024.f, F8_INV1 = 1.f / (F8_SX * F8_SWGU), F8_INV2 = 1.f / (F8_SH * F8_SWDN);
namespace pg8 {
constexpr int BM = 256, BK = 64, HALF = 128, HTB = HALF * BK * 2, STAGE_BYTES = 8 * HTB, NXCD = 8, WGM = 8;
__host__ __device__ __forceinline__ int lds_byte(int r, int c) { const int st = (r >> 4) * 2 + (c >> 5), rr = r & 15, cc = c & 31, ob = rr * 64 + cc * 2; return st * 1024 + (ob ^ (((ob >> 9) & 1) << 5)); }
__host__ __device__ __forceinline__ void stage_rc(int b, int& R, int& C) { const int st = b / 1024, sb = b % 1024, swz = sb ^ (((sb >> 9) & 1) << 5); R = (st >> 1) * 16 + swz / 64; C = (st & 1) * 32 + (swz % 64) / 2; }
__host__ __device__ __forceinline__ int perm32(int rho) { const int n = rho >> 4, i = rho & 15; return 8 * (i >> 2) + 4 * n + (i & 3); }

struct Unit { const char* a; const char* b; char* c; int ldc; int r0, c0, e, sub; };

struct TileOrder {
    int nM, nN, nwg;
    DI void init(int nM_, int nN_) { nM = nM_; nN = nN_; nwg = nM * nN; }
    DI bool tile(long L, int& pm, int& pn) const {
        if (L >= nwg) return false;
        int wgid = (int)L; { const int q = nwg / NXCD, r = nwg % NXCD, xcd = wgid % NXCD, off = wgid / NXCD; wgid = (xcd < r ? xcd * (q + 1) : r * (q + 1) + (xcd - r) * q) + off; }
        const int nig = WGM * nN, gid = wgid / nig, fm = gid * WGM, gsz = (nM - fm) < WGM ? (nM - fm) : WGM;
        pm = fm + ((wgid % nig) % gsz); pn = (wgid % nig) / gsz; return true;
    }
};

DI u32x4 pack8(const f32x4& v0, const f32x4& v1) { u32x4 w; w.x = pk2(v0[0], v0[1]); w.y = pk2(v0[2], v0[3]); w.z = pk2(v1[0], v1[1]); w.w = pk2(v1[2], v1[3]); return w; }

struct EpiStore {
    DI void operator()(const f32x4 (&acc)[2][2][4][2], const Unit& u, int wr, int wc, int fr, int fq) const {
#pragma unroll
        for (int ai = 0; ai < 2; ++ai)
#pragma unroll
            for (int m = 0; m < 4; ++m) { char* rowp = u.c + ((size_t)(ai * HALF + wr * 64 + m * 16 + fr) * u.ldc + wc * 32 + 8 * fq) * 2;
#pragma unroll
                for (int bj = 0; bj < 2; ++bj) *(u32x4*)(rowp + bj * 256) = pack8(acc[ai][bj][m][0], acc[ai][bj][m][1]); }
    }
};
struct EpiStoreS {
    float s;
    DI void operator()(const f32x4 (&acc)[2][2][4][2], const Unit& u, int wr, int wc, int fr, int fq) const {
#pragma unroll
        for (int ai = 0; ai < 2; ++ai)
#pragma unroll
            for (int m = 0; m < 4; ++m) { char* rowp = u.c + ((size_t)(ai * HALF + wr * 64 + m * 16 + fr) * u.ldc + wc * 32 + 8 * fq) * 2;
#pragma unroll
                for (int bj = 0; bj < 2; ++bj) *(u32x4*)(rowp + bj * 256) = pack8(acc[ai][bj][m][0] * s, acc[ai][bj][m][1] * s); }
    }
};
struct EpiMerge {
    static constexpr bool MIDK = true;
    const char* U; const float* gate_b;
    DI void mid(f32x4 (&acc)[2][2][4][2], const Unit& u, int which, int wr, int wc, int fr, int fq) const {
        const float L2E = 1.4426950408889634f;
#pragma unroll
        for (int bj = 0; bj < 2; ++bj) {
            const float* g = gate_b + which * 1024 + u.c0 + bj * HALF + wc * 32 + 8 * fq;
            const f32x4 ga0 = *(const f32x4*)g, ga1 = *(const f32x4*)(g + 4), gn0 = *(const f32x4*)(g + 1024), gn1 = *(const f32x4*)(g + 1028);
            const float gaa[8] = {ga0.x, ga0.y, ga0.z, ga0.w, ga1.x, ga1.y, ga1.z, ga1.w}, gnn[8] = {gn0.x, gn0.y, gn0.z, gn0.w, gn1.x, gn1.y, gn1.z, gn1.w};
#pragma unroll
            for (int ai = 0; ai < 2; ++ai)
#pragma unroll
                for (int m = 0; m < 4; ++m) { const int lr = ai * HALF + wr * 64 + m * 16 + fr;
                    const char* gp = U + ((size_t)(u.r0 + lr) * NU + UC_GATE + which * 1024 + u.c0 + wc * 32 + 8 * fq) * 2 + bj * 256;
                    const u32x4 wa = *(const u32x4*)gp, wn = *(const u32x4*)(gp + 2048);
                    const float xa[8] = {bflo(wa.x), bfhi(wa.x), bflo(wa.y), bfhi(wa.y), bflo(wa.z), bfhi(wa.z), bflo(wa.w), bfhi(wa.w)};
                    const float xn[8] = {bflo(wn.x), bfhi(wn.x), bflo(wn.y), bfhi(wn.y), bflo(wn.z), bfhi(wn.z), bflo(wn.w), bfhi(wn.w)};
#pragma unroll
                    for (int i = 0; i < 8; ++i) { const float ea = __builtin_amdgcn_exp2f(-L2E * __builtin_amdgcn_fmed3f(xa[i] + gaa[i], -30.f, 30.f)), en = __builtin_amdgcn_exp2f(-L2E * __builtin_amdgcn_fmed3f(xn[i] + gnn[i], -30.f, 30.f));
                        acc[ai][bj][m][i >> 2][i & 3] *= (1.f + en) * __builtin_amdgcn_rcpf(1.f + ea); }
                    if (m & 1) asm volatile("" ::: "memory"); }
        }
    }
    DI void operator()(const f32x4 (&acc)[2][2][4][2], const Unit& u, int wr, int wc, int fr, int fq) const {
        f32x4 gb[2][2];
#pragma unroll
        for (int bj = 0; bj < 2; ++bj) { const float* g = gate_b + 2048 + u.c0 + bj * HALF + wc * 32 + 8 * fq; gb[bj][0] = *(const f32x4*)g; gb[bj][1] = *(const f32x4*)(g + 4); }
#pragma unroll
        for (int ai = 0; ai < 2; ++ai)
#pragma unroll
            for (int m = 0; m < 4; ++m) { const int lr = ai * HALF + wr * 64 + m * 16 + fr; char* rowp = u.c + ((size_t)lr * u.ldc + wc * 32 + 8 * fq) * 2;
                const char* gp = U + ((size_t)(u.r0 + lr) * NU + UC_GATE + 2048 + u.c0 + wc * 32 + 8 * fq) * 2;
#pragma unroll
                for (int bj = 0; bj < 2; ++bj) { const u32x4 gw = *(const u32x4*)(gp + bj * 256);
                    f32x4 v0 = acc[ai][bj][m][0], v1 = acc[ai][bj][m][1];
                    v0[0] *= sigmoidf_(bflo(gw.x) + gb[bj][0][0]); v0[1] *= sigmoidf_(bfhi(gw.x) + gb[bj][0][1]); v0[2] *= sigmoidf_(bflo(gw.y) + gb[bj][0][2]); v0[3] *= sigmoidf_(bfhi(gw.y) + gb[bj][0][3]);
                    v1[0] *= sigmoidf_(bflo(gw.z) + gb[bj][1][0]); v1[1] *= sigmoidf_(bfhi(gw.z) + gb[bj][1][1]); v1[2] *= sigmoidf_(bflo(gw.w) + gb[bj][1][2]); v1[3] *= sigmoidf_(bfhi(gw.w) + gb[bj][1][3]);
                    *(u32x4*)(rowp + bj * 256) = pack8(v0, v1); }
                asm volatile("" ::: "memory"); }
    }
};
struct EpiWo {
    const char* X;
    DI void operator()(const f32x4 (&acc)[2][2][4][2], const Unit& u, int wr, int wc, int fr, int fq) const {
#pragma unroll
        for (int ai = 0; ai < 2; ++ai)
#pragma unroll
            for (int m = 0; m < 4; ++m) { const int lr = ai * HALF + wr * 64 + m * 16 + fr; char* rowp = u.c + ((size_t)lr * u.ldc + wc * 32 + 8 * fq) * 2;
                const char* xp = X + ((size_t)(u.r0 + lr) * D + u.c0 + wc * 32 + 8 * fq) * 2;
#pragma unroll
                for (int bj = 0; bj < 2; ++bj) { const u32x4 xw = *(const u32x4*)(xp + bj * 256);
                    f32x4 v0 = acc[ai][bj][m][0], v1 = acc[ai][bj][m][1];
                    v0[0] += DN_ALPHA * bflo(xw.x); v0[1] += DN_ALPHA * bfhi(xw.x); v0[2] += DN_ALPHA * bflo(xw.y); v0[3] += DN_ALPHA * bfhi(xw.y);
                    v1[0] += DN_ALPHA * bflo(xw.z); v1[1] += DN_ALPHA * bfhi(xw.z); v1[2] += DN_ALPHA * bflo(xw.w); v1[3] += DN_ALPHA * bfhi(xw.w);
                    *(u32x4*)(rowp + bj * 256) = pack8(v0, v1); }
                asm volatile("" ::: "memory"); }
    }
};
DI float swiglu1(float a, float b) { const float g = fminf(a, 7.f), l = fminf(fmaxf(b, -7.f), 7.f); return g * sigmoidf_(1.702f * g) * (l + 1.f); }
struct EpiMoe1 {
    const float* bgu;
    DI void operator()(const f32x4 (&acc)[2][2][4][2], const Unit& u, int wr, int wc, int fr, int fq) const {
        f32x4 bv[2][2];
#pragma unroll
        for (int bj = 0; bj < 2; ++bj) { const float* b = bgu + u.e * 2048 + u.c0 + bj * HALF + wc * 32 + 8 * fq; bv[bj][0] = *(const f32x4*)b; bv[bj][1] = *(const f32x4*)(b + 4); }
#pragma unroll
        for (int ai = 0; ai < 2; ++ai)
#pragma unroll
            for (int m = 0; m < 4; ++m) { const int lr = ai * HALF + wr * 64 + m * 16 + fr; char* rowp = u.c + ((size_t)lr * u.ldc + wc * 16 + 4 * fq);
#pragma unroll
                for (int bj = 0; bj < 2; ++bj) { const f32x4 v0 = acc[ai][bj][m][0] * F8_INV1 + bv[bj][0], v1 = acc[ai][bj][m][1] * F8_INV1 + bv[bj][1];
                    *(unsigned*)(rowp + bj * 64) = pk4_f8(swiglu1(v0[0], v0[1]) * F8_SH, swiglu1(v0[2], v0[3]) * F8_SH, swiglu1(v1[0], v1[1]) * F8_SH, swiglu1(v1[2], v1[3]) * F8_SH); } }
    }
};
struct EpiMoe2 {
    const float* bdn;
    DI void operator()(const f32x4 (&acc)[2][2][4][2], const Unit& u, int wr, int wc, int fr, int fq) const {
        f32x4 bv[2][2];
#pragma unroll
        for (int bj = 0; bj < 2; ++bj) { const float* b = bdn + u.e * 1024 + u.c0 + bj * HALF + wc * 32 + 8 * fq; bv[bj][0] = *(const f32x4*)b; bv[bj][1] = *(const f32x4*)(b + 4); }
#pragma unroll
        for (int ai = 0; ai < 2; ++ai)
#pragma unroll
            for (int m = 0; m < 4; ++m) { char* rowp = u.c + ((size_t)(ai * HALF + wr * 64 + m * 16 + fr) * u.ldc + wc * 32 + 8 * fq) * 2;
#pragma unroll
                for (int bj = 0; bj < 2; ++bj) *(u32x4*)(rowp + bj * 256) = pack8(acc[ai][bj][m][0] * F8_INV2 + bv[bj][0], acc[ai][bj][m][1] * F8_INV2 + bv[bj][1]); }
    }
};

typedef int i32x8 __attribute__((ext_vector_type(8)));
typedef int i32x4 __attribute__((ext_vector_type(4)));
template <bool F8, bool MIDK = false, class Epi, class Sched>
DI void gemm_phase(LAS unsigned char* lds, const int KB  , const int ldaB, const int ldbB, const Sched& S, const Epi& E, const int wave_) {
    unsigned z_ = 0u; asm volatile("" : "+v"(z_)); const int tid = wave_ * 64 + (int)__builtin_amdgcn_mbcnt_hi(~0u, __builtin_amdgcn_mbcnt_lo(~0u, z_));
    const int wid = __builtin_amdgcn_readfirstlane(tid >> 6), lane = tid & 63, wr = wid >> 2, wc = wid & 3, fr = lane & 15, fq = lane >> 4;
    const int nt = KB / (BK * 2);
    unsigned voffA[2], voffB[2];
#pragma unroll
    for (int i = 0; i < 2; ++i) { int R, C; stage_rc(tid * 16 + i * 8192, R, C); const int Rb = (R & ~31) + perm32(R & 31);
        voffA[i] = (unsigned)(R * ldaB + C * 2); voffB[i] = (unsigned)(Rb * ldbB + C * 2); }
    asm volatile("" : "+v"(voffA[0]), "+v"(voffA[1]), "+v"(voffB[0]), "+v"(voffB[1]));
    const size_t kstep = (size_t)(BK * 2);
    const size_t hstepA = (size_t)HALF * ldaB, hstepB = (size_t)HALF * ldbB;
    const unsigned ldsw = (unsigned)wid * 1024u;
    const int aoff = lds_byte(wr * 64 + fr, fq * 8), boff = lds_byte(wc * 32 + fr, fq * 8);
#define PG8_SA(b, h) (((b) * 2 + (h)) * HTB)
#define PG8_SB(b, h) ((4 + (b) * 2 + (h)) * HTB)
#define PG8_STAGE(bufoff, gbase, voff) do { _Pragma("unroll") for (int _i = 0; _i < 2; ++_i) \
        __builtin_amdgcn_global_load_lds((const unsigned*)((const char*)(gbase) + (voff)[_i]), (LAS unsigned*)(lds + (bufoff) + ldsw + _i * 8192), 16, 0, 0); } while (0)
#define PG8_LD8(p) __builtin_shufflevector(*(const LAS i32x4*)(p), *(const LAS i32x4*)((p) + 1024), 0, 1, 2, 3, 4, 5, 6, 7)
#define PG8_LDA8(dst, b, h) do { _Pragma("unroll") for (int m = 0; m < 4; ++m) dst[m] = PG8_LD8(lds + PG8_SA(b, h) + aoff + m * 2048); } while (0)
#define PG8_LDB8(dst, b, h) do { _Pragma("unroll") for (int n = 0; n < 2; ++n) dst[n] = PG8_LD8(lds + PG8_SB(b, h) + boff + n * 2048); } while (0)
#define PG8_MMA8(ai, bj, A8, B8) do { __builtin_amdgcn_s_setprio(1); _Pragma("unroll") for (int m = 0; m < 4; ++m) _Pragma("unroll") for (int n = 0; n < 2; ++n) \
        asm volatile("v_mfma_f32_16x16x128_f8f6f4 %0, %1, %2, %0" : "+v"(acc[ai][bj][m][n]) : "v"(B8[n]), "v"(A8[m])); __builtin_amdgcn_s_setprio(0); } while (0)
#define PG8_LDA(dst, b, h) do { _Pragma("unroll") for (int m = 0; m < 4; ++m) _Pragma("unroll") for (int k = 0; k < 2; ++k) dst[m][k] = *(const LAS bf16x8*)(lds + PG8_SA(b, h) + aoff + m * 2048 + k * 1024); } while (0)
#define PG8_LDB(dst, b, h) do { _Pragma("unroll") for (int n = 0; n < 2; ++n) _Pragma("unroll") for (int k = 0; k < 2; ++k) dst[n][k] = *(const LAS bf16x8*)(lds + PG8_SB(b, h) + boff + n * 2048 + k * 1024); } while (0)
#define PG8_CAT(x) __builtin_shufflevector(__builtin_bit_cast(i32x4, (x)[0]), __builtin_bit_cast(i32x4, (x)[1]), 0, 1, 2, 3, 4, 5, 6, 7)
#define PG8_MMA(ai, bj, At, Bt) do { __builtin_amdgcn_s_setprio(1); _Pragma("unroll") for (int m = 0; m < 4; ++m) _Pragma("unroll") for (int n = 0; n < 2; ++n) _Pragma("unroll") for (int k = 0; k < 2; ++k) \
        acc[ai][bj][m][n] = __builtin_amdgcn_mfma_f32_16x16x32_bf16(Bt[n][k], At[m][k], acc[ai][bj][m][n], 0, 0, 0); __builtin_amdgcn_s_setprio(0); } while (0)
#define PG8_WAIT_V(n) asm volatile("s_waitcnt vmcnt(" #n ")" ::: "memory")
#define PG8_WAIT_L(n) asm volatile("s_waitcnt lgkmcnt(" #n ")" ::: "memory")
#define PG8_BAR __builtin_amdgcn_s_barrier()
#define PG8_SCHED __builtin_amdgcn_sched_barrier(0)
    Unit cur, nxt; int ui = 0;
    if (!S.next(0, cur)) return;
    f32x4 acc[2][2][4][2];
#pragma unroll
    for (int a = 0; a < 2; ++a)
#pragma unroll
        for (int b = 0; b < 2; ++b)
#pragma unroll
            for (int m = 0; m < 4; ++m)
#pragma unroll
                for (int n = 0; n < 2; ++n) acc[a][b][m][n] = (f32x4){0.f, 0.f, 0.f, 0.f};
    bf16x8 At[4][2], B0[2][2], B1[2][2]; i32x8 A8[4], B80[2], B81[2];
    const char* cA = cur.a; const char* cB = cur.b;
    PG8_STAGE(PG8_SB(0, 0), cB, voffB); PG8_STAGE(PG8_SB(0, 1), cB + hstepB, voffB); PG8_STAGE(PG8_SA(0, 0), cA, voffA); PG8_STAGE(PG8_SA(0, 1), cA + hstepA, voffA);
    if (wr == 1) PG8_BAR;
    PG8_WAIT_V(2); PG8_BAR;
    PG8_STAGE(PG8_SB(1, 0), cB + kstep, voffB); PG8_STAGE(PG8_SA(1, 0), cA + kstep, voffA); PG8_STAGE(PG8_SB(1, 1), cB + hstepB + kstep, voffB);
    PG8_WAIT_V(6); PG8_BAR;
    for (;;) {
        const bool has_next = S.next(ui + 1, nxt);
        const char* nA = has_next ? nxt.a : cA; const char* nB = has_next ? nxt.b : cB;
#pragma unroll 1
        for (int t = 0; t < nt; t += 2) {
            if constexpr (MIDK) { if (t == 8 || t == 16) { int fr_ = fr, fq_ = fq; asm volatile("" : "+v"(fr_), "+v"(fq_)); E.mid(acc, cur, t >> 4, wr, wc, fr_, fq_); } }
            const bool last = (t == nt - 2);
            const char* a1 = cA + (size_t)(t + 1) * kstep;
            const char* a2 = last ? nA : cA + (size_t)(t + 2) * kstep; const char* b2 = last ? nB : cB + (size_t)(t + 2) * kstep;
            const char* a3 = a2 + kstep; const char* b3 = b2 + kstep;
            if constexpr (F8) {
            PG8_LDB8(B80, 0, 0); PG8_LDB8(B81, 0, 1); PG8_SCHED; PG8_LDA8(A8, 0, 0); PG8_STAGE(PG8_SA(1, 1), a1 + hstepA, voffA);
            PG8_WAIT_V(8); PG8_WAIT_L(0); PG8_BAR; PG8_MMA8(0, 0, A8, B80); PG8_MMA8(0, 1, A8, B81); PG8_BAR; PG8_SCHED;
            PG8_LDA8(A8, 0, 1); PG8_STAGE(PG8_SB(0, 0), b2, voffB); PG8_STAGE(PG8_SB(0, 1), b2 + hstepB, voffB); PG8_STAGE(PG8_SA(0, 0), a2, voffA);
            PG8_WAIT_V(8); PG8_WAIT_L(0); PG8_BAR; PG8_MMA8(1, 0, A8, B80); PG8_MMA8(1, 1, A8, B81); PG8_BAR; PG8_SCHED;
            PG8_LDB8(B80, 1, 0); PG8_LDB8(B81, 1, 1); PG8_SCHED; PG8_LDA8(A8, 1, 0); PG8_STAGE(PG8_SA(0, 1), a2 + hstepA, voffA);
            PG8_WAIT_V(8); PG8_WAIT_L(0); PG8_BAR; PG8_MMA8(0, 0, A8, B80); PG8_MMA8(0, 1, A8, B81); PG8_BAR; PG8_SCHED;
            PG8_LDA8(A8, 1, 1); PG8_STAGE(PG8_SB(1, 0), b3, voffB); PG8_STAGE(PG8_SB(1, 1), b3 + hstepB, voffB); PG8_STAGE(PG8_SA(1, 0), a3, voffA);
            PG8_WAIT_V(8); PG8_WAIT_L(0); PG8_BAR; PG8_MMA8(1, 0, A8, B80); PG8_MMA8(1, 1, A8, B81); PG8_BAR; PG8_SCHED;
            } else {
            PG8_LDB(B0, 0, 0); PG8_LDB(B1, 0, 1); PG8_SCHED; PG8_LDA(At, 0, 0); PG8_STAGE(PG8_SA(1, 1), a1 + hstepA, voffA);
            PG8_WAIT_V(8); PG8_WAIT_L(0); PG8_BAR; PG8_MMA(0, 0, At, B0); PG8_MMA(0, 1, At, B1); PG8_BAR; PG8_SCHED;
            PG8_LDA(At, 0, 1); PG8_STAGE(PG8_SB(0, 0), b2, voffB); PG8_STAGE(PG8_SB(0, 1), b2 + hstepB, voffB); PG8_STAGE(PG8_SA(0, 0), a2, voffA);
            PG8_WAIT_V(8); PG8_WAIT_L(0); PG8_BAR; PG8_MMA(1, 0, At, B0); PG8_MMA(1, 1, At, B1); PG8_BAR; PG8_SCHED;
            PG8_LDB(B0, 1, 0); PG8_LDB(B1, 1, 1); PG8_SCHED; PG8_LDA(At, 1, 0); PG8_STAGE(PG8_SA(0, 1), a2 + hstepA, voffA);
            PG8_WAIT_V(8); PG8_WAIT_L(0); PG8_BAR; PG8_MMA(0, 0, At, B0); PG8_MMA(0, 1, At, B1); PG8_BAR; PG8_SCHED;
            PG8_LDA(At, 1, 1); PG8_STAGE(PG8_SB(1, 0), b3, voffB); PG8_STAGE(PG8_SB(1, 1), b3 + hstepB, voffB); PG8_STAGE(PG8_SA(1, 0), a3, voffA);
            PG8_WAIT_V(8); PG8_WAIT_L(0); PG8_BAR; PG8_MMA(1, 0, At, B0); PG8_MMA(1, 1, At, B1); PG8_BAR; PG8_SCHED;
            }
        }
        if (wr == 0) PG8_BAR;
        if constexpr (F8) asm volatile("s_nop 15\n\ts_nop 15" ::: "memory");
        { int fr_ = fr, fq_ = fq; asm volatile("" : "+v"(fr_), "+v"(fq_));
          E(acc, cur, wr, wc, fr_, fq_); }
        if (!has_next) break;
#pragma unroll
        for (int a = 0; a < 2; ++a)
#pragma unroll
            for (int b = 0; b < 2; ++b)
#pragma unroll
                for (int m = 0; m < 4; ++m)
#pragma unroll
                    for (int n = 0; n < 2; ++n) acc[a][b][m][n] = (f32x4){0.f, 0.f, 0.f, 0.f};
        cur = nxt; cA = nA; cB = nB; ++ui;
        if (wr == 1) PG8_BAR;
    }
    PG8_WAIT_V(0);
    PG8_BAR;
#undef PG8_SA
#undef PG8_SB
#undef PG8_STAGE
#undef PG8_LDA
#undef PG8_LDB
#undef PG8_MMA
#undef PG8_CAT
#undef PG8_LD8
#undef PG8_LDA8
#undef PG8_LDB8
#undef PG8_MMA8
#undef PG8_WAIT_V
#undef PG8_WAIT_L
#undef PG8_BAR
#undef PG8_SCHED
}
}

#define XB_TMO      128
#define XB_XCNT(j)  (256  + 64 * (j))
#define XB_XSUB(j)  (1280 + 64 * (j))
#define XB_XGEN(j)  (2304 + 64 * (j))
#define XB_TOP      3328
#define XB_TOPGEN   3392
#define XCD_BAR_WORDS 3456
#define XB_SPIN_CAP (1u << 22)
DI unsigned xb_ld(unsigned* p)              { return __hip_atomic_load(p, __ATOMIC_RELAXED, __HIP_MEMORY_SCOPE_AGENT); }
DI unsigned xb_add(unsigned* p, unsigned v) { return __hip_atomic_fetch_add(p, v, __ATOMIC_RELAXED, __HIP_MEMORY_SCOPE_AGENT); }
DI unsigned xb_xcc_id() { return (unsigned)__builtin_amdgcn_s_getreg((3 << 11) | 20) & 0xFu; }
#define XB_SPIN(cond, bar) do { unsigned _sp = 0; while (cond) { __builtin_amdgcn_s_sleep(1); \
    if ((++_sp & 255u) == 0u) { if (xb_ld(&(bar)[XB_TMO])) break; if (_sp > XB_SPIN_CAP) { atomicAdd(&(bar)[XB_TMO], 1u); break; } } } } while (0)
struct XcdBarrier { unsigned* bar; unsigned x; volatile LAS unsigned* st; };
DI XcdBarrier xcd_barrier_post(unsigned* bar, volatile LAS unsigned* st) {
    XcdBarrier b; b.bar = bar; b.x = xb_xcc_id(); b.st = st;
    if (threadIdx.x == 0) (void)xb_add(&bar[XB_XCNT(b.x)], 1u);
    return b;
}
DI void xcd_barrier_complete(unsigned* bar, unsigned x, unsigned& nloc, unsigned& nx) {
    const unsigned G = gridDim.x * gridDim.y * gridDim.z;
    unsigned sum, cnt, mine, sp = 0u;
    for (;;) {
        sum = 0u; cnt = 0u; mine = 0u;
#pragma unroll
        for (unsigned j = 0; j < 16; ++j) { const unsigned c = xb_ld(&bar[XB_XCNT(j)]); sum += c; cnt += (c > 0u) ? 1u : 0u; mine = (j == x) ? c : mine; }
        if (sum == G) break;
        __builtin_amdgcn_s_sleep(1);
        if ((++sp & 255u) == 0u) { if (xb_ld(&bar[XB_TMO])) break; if (sp > XB_SPIN_CAP) { atomicAdd(&bar[XB_TMO], 1u); break; } }
    }
    nloc = mine > 0u ? mine : 1u; nx = cnt > 0u ? cnt : 1u;
}
DI void xcd_barrier(const XcdBarrier& b) {
    asm volatile("s_waitcnt vmcnt(0)" ::: "memory");
    __syncthreads();
    if (threadIdx.x == 0) {
        unsigned* bar = b.bar;
        __builtin_amdgcn_s_waitcnt(0);
        unsigned nloc = b.st[0], nx = b.st[1];
        if (nloc == 0u) { xcd_barrier_complete(bar, b.x, nloc, nx); b.st[0] = nloc; b.st[1] = nx; }
        const unsigned old = xb_add(&bar[XB_XSUB(b.x)], 1u);
        const unsigned gen = old / nloc;
        if (old + 1u == (gen + 1u) * nloc) {
            __builtin_amdgcn_fence(__ATOMIC_RELEASE, "agent");
            asm volatile("s_waitcnt vmcnt(0)" ::: "memory");
            const unsigned og = xb_add(&bar[XB_TOP], 1u);
            const unsigned tg = og / nx;
            if (og + 1u == (tg + 1u) * nx) xb_add(&bar[XB_TOPGEN], 1u);
            else XB_SPIN(xb_ld(&bar[XB_TOPGEN]) == tg, bar);
            __builtin_amdgcn_fence(__ATOMIC_ACQUIRE, "agent");
            xb_add(&bar[XB_XGEN(b.x)], 1u);
            asm volatile("s_waitcnt vmcnt(0)" ::: "memory");
        } else {
            XB_SPIN(xb_ld(&bar[XB_XGEN(b.x)]) == gen, bar);
            __builtin_amdgcn_fence(__ATOMIC_ACQUIRE, "agent");
            asm volatile("s_waitcnt vmcnt(0)" ::: "memory");
        }
    }
    __syncthreads();
}

DI void transpose_item(const float* W, int ldw, bf16* WT, int ldt, LAS float* scr, int lane) {
#pragma unroll 8
    for (int i = 0; i < 32; ++i) { const int kk = 2 * i + (lane >> 5); scr[kk * 33 + (lane & 31)] = W[(size_t)kk * ldw + (lane & 31)]; }
    LDS_WAIT(); asm volatile("" ::: "memory");
    const int c = lane & 7;
#pragma unroll
    for (int j = 0; j < 4; ++j) { const int n = (lane >> 3) + 8 * j; const LAS float* s = scr + (8 * c) * 33 + n;
        u32x4 o; o.x = pk2(s[0 * 33], s[1 * 33]); o.y = pk2(s[2 * 33], s[3 * 33]); o.z = pk2(s[4 * 33], s[5 * 33]); o.w = pk2(s[6 * 33], s[7 * 33]);
        *(u32x4*)(WT + (size_t)n * ldt + 8 * c) = o; }
    LDS_WAIT(); asm volatile("" ::: "memory");
}
DI void transpose_item_f8(const float* W, int ldw, unsigned char* WT, int ldt, float scale, LAS float* scr, int lane) {
#pragma unroll 8
    for (int i = 0; i < 32; ++i) { const int kk = 2 * i + (lane >> 5); scr[kk * 33 + (lane & 31)] = W[(size_t)kk * ldw + (lane & 31)]; }
    LDS_WAIT(); asm volatile("" ::: "memory");
    const int c = lane & 3;
#pragma unroll
    for (int j = 0; j < 2; ++j) { const int n = (lane >> 2) + 16 * j; const LAS float* s = scr + (16 * c) * 33 + n;
        u32x4 o; o.x = pk4_f8(s[0 * 33] * scale, s[1 * 33] * scale, s[2 * 33] * scale, s[3 * 33] * scale); o.y = pk4_f8(s[4 * 33] * scale, s[5 * 33] * scale, s[6 * 33] * scale, s[7 * 33] * scale);
        o.z = pk4_f8(s[8 * 33] * scale, s[9 * 33] * scale, s[10 * 33] * scale, s[11 * 33] * scale); o.w = pk4_f8(s[12 * 33] * scale, s[13 * 33] * scale, s[14 * 33] * scale, s[15 * 33] * scale);
        *(u32x4*)(WT + (size_t)n * ldt + 16 * c) = o; }
    LDS_WAIT(); asm volatile("" ::: "memory");
}
DI void ln16(f32x4 (&v)[4], const f32x4 (&g)[4], const f32x4 (&b)[4]) {
    float s = 0.f;
#pragma unroll
    for (int j = 0; j < 4; ++j) s += (v[j].x + v[j].y) + (v[j].z + v[j].w);
    const float mean = wave_sum(s) * (1.f / D); float s2 = 0.f;
#pragma unroll
    for (int j = 0; j < 4; ++j) { v[j] = v[j] - mean; s2 += (v[j].x * v[j].x + v[j].y * v[j].y) + (v[j].z * v[j].z + v[j].w * v[j].w); }
    const float rstd = 1.f / sqrtf(wave_sum(s2) * (1.f / D) + LN_EPS);
#pragma unroll
    for (int j = 0; j < 4; ++j) v[j] = v[j] * rstd * g[j] + b[j];
}
DI void gates8(const f32x4 (&y)[4], const LAS float* wgt, float* gif_row, int lane) {
    float p[8];
#pragma unroll
    for (int j = 0; j < 8; ++j) { float s = 0.f;
#pragma unroll
        for (int jj = 0; jj < 4; ++jj) { const f32x4 w = *(const LAS f32x4*)(wgt + j * 1024 + 256 * jj + 4 * lane); s += (y[jj].x * w.x + y[jj].y * w.y) + (y[jj].z * w.z + y[jj].w * w.w); }
        p[j] = wave_sum(s); }
    if (lane == 0) { *(f32x4*)gif_row = (f32x4){p[0], p[1], p[2], p[3]}; *(f32x4*)(gif_row + 4) = (f32x4){p[4], p[5], p[6], p[7]}; }
}
DI void gates8b(const f32x4 (&y)[4], const LAS float* wgt, float* gif_row, int lane) {
    float p[8];
#pragma unroll
    for (int j = 0; j < 8; ++j) { float s = 0.f;
#pragma unroll
        for (int jj = 0; jj < 4; ++jj) { const f32x4 w = *(const LAS f32x4*)(wgt + j * 1024 + (jj >> 1) * 512 + 8 * lane + (jj & 1) * 4); s += (y[jj].x * w.x + y[jj].y * w.y) + (y[jj].z * w.z + y[jj].w * w.w); }
        p[j] = wave_sum(s); }
    if (lane == 0) { *(f32x4*)gif_row = (f32x4){p[0], p[1], p[2], p[3]}; *(f32x4*)(gif_row + 4) = (f32x4){p[4], p[5], p[6], p[7]}; }
}
DI void load_gate_table(LAS float* wgt, const float* win_l, int tid) {
    for (int i = tid; i < 8192; i += NTHR) { const int k = i >> 3, j = i & 7; wgt[j * 1024 + k] = win_l[(size_t)k * DIN + 1536 + j]; }
}
DI f32x4 ld4bf(const char* p) { const u32x2 w = *(const u32x2*)p; return (f32x4){bflo(w.x), bfhi(w.x), bflo(w.y), bfhi(w.y)}; }
DI void st4bf(char* p, const f32x4& v) { u32x2 w; w.x = pk2(v.x, v.y); w.y = pk2(v.z, v.w); *(u32x2*)p = w; }

struct Args { const float* in[N_IN]; float* out; unsigned char* ws; int ph_lo, ph_hi; };
constexpr int NP_LAYER = 12, NPH = 1 + DEPTH * NP_LAYER;
constexpr int XW_SPLIT = 33792;

struct SchedInproj {
    pg8::TileOrder T; int G, c; const char *X, *W; char* U; bool kv; const char *MEMN, *WKV; char* KV;
    DI bool next(int i, pg8::Unit& u) const {
        const long L = (long)i * G + c; int pm, pn;
        if (T.tile(L, pm, pn)) { u.a = X + (size_t)pm * 256 * D * 2; u.b = W + (size_t)pn * 256 * D * 2; u.r0 = pm * 256; u.c0 = pn * 256; u.c = U + ((size_t)u.r0 * NU + u.c0) * 2; u.ldc = NU; u.e = 0; u.sub = 0; return true; }
        if (!kv) return false;
        const long L2 = L - T.nwg; if (L2 < 0 || L2 >= 128) return false;
        const int l = (int)L2 >> 6, t = (int)L2 & 63; pm = t >> 2; pn = t & 3;
        u.a = MEMN + (size_t)pm * 256 * D * 2; u.b = WKV + ((size_t)l * 1024 + pn * 256) * D * 2; u.r0 = pm * 256; u.c0 = pn * 256; u.c = KV + (((size_t)l * MROWS + u.r0) * D + u.c0) * 2; u.ldc = D; u.e = 0; u.sub = 0; return true;
    }
};
struct SchedPlain {
    pg8::TileOrder T; int G, c; const char *A, *B; char* C; int lda, ldb, ldc;
    DI bool next(int i, pg8::Unit& u) const {
        const long L = (long)i * G + c; int pm, pn; if (!T.tile(L, pm, pn)) return false;
        u.a = A + (size_t)pm * 256 * lda * 2; u.b = B + (size_t)pn * 256 * ldb * 2; u.r0 = pm * 256; u.c0 = pn * 256; u.c = C + ((size_t)u.r0 * ldc + u.c0) * 2; u.ldc = ldc; u.e = 0; u.sub = 0; return true;
    }
};
struct SchedMerge {
    pg8::TileOrder T; int G, c; const char *H, *W; char* Y;
    DI bool next(int i, pg8::Unit& u) const {
        const int ti = i / 3, br = i - 3 * ti; const long L = (long)ti * G + c; int pm, pn; if (!T.tile(L, pm, pn)) return false;
        u.a = H + ((size_t)pm * 256 * 1536 + br * 512) * 2; u.b = W + ((size_t)br * 1024 + pn * 256) * 512 * 2; u.r0 = pm * 256; u.c0 = pn * 256; u.c = Y + ((size_t)u.r0 * D + u.c0) * 2; u.ldc = D; u.e = 0; u.sub = br; return true;
    }
};
struct SchedMoe {
    pg8::TileOrder T; int G, c; const char *A, *W; char* C; const LAS int* PB; int wrows  , ldc, cdiv, osz;
    DI bool next(int i, pg8::Unit& u) const {
        const long L = (long)i * G + c; int pm, pn; if (!T.tile(L, pm, pn)) return false;
        int e = 0;
#pragma unroll 1
        for (int j = 1; j < NEXP; ++j) e += (PB[j] <= pm) ? 1 : 0;
        u.a = A + (size_t)pm * 256 * 1024; u.b = W + ((size_t)e * wrows + pn * 256) * 1024; u.r0 = pm * 256; u.c0 = pn * 256; u.c = C + ((size_t)u.r0 * ldc + u.c0 / cdiv) * osz; u.ldc = ldc; u.e = e; u.sub = 0; return true;
    }
};

__global__ void __launch_bounds__(NTHR, 2) fwd_kernel(Args args) {
    extern __shared__ __attribute__((aligned(16))) unsigned char lds_raw[];
#define INP(i) ([&]() -> const float* { int ii_ = (i); asm volatile("" : "+s"(ii_)); return args.in[ii_]; }())
    LAS unsigned char* lds = (LAS unsigned char*)lds_raw;
    volatile LAS unsigned* LCTL = (volatile LAS unsigned*)(lds + LDSCTL_OFF);
    const int tid0 = threadIdx.x, wave = __builtin_amdgcn_readfirstlane(tid0 >> 6);
#define PHASE_TID unsigned z_ = 0u; asm volatile("" : "+v"(z_)); int tid = wave * 64 + (int)__builtin_amdgcn_mbcnt_hi(~0u, __builtin_amdgcn_mbcnt_lo(~0u, z_)); const int lane = tid & 63; (void)lane;
    const int G = gridDim.x, bx = blockIdx.x;
    const int gw = bx * NWAVES + wave, NGW = G * NWAVES;
    unsigned char* ws = args.ws;
    gu32* ctl = (gu32*)(ws + WS_CTL);
    for (int u = tid0; u < (LDS_BYTES - LDSCTL_OFF) / 4; u += NTHR) ((LAS unsigned*)(lds + LDSCTL_OFF))[u] = 0u;
    __syncthreads();
    XcdBarrier bar; bar.bar = (unsigned*)ctl + CW_BAR; bar.x = 0; bar.st = nullptr;
    if (MK_ONE_LAUNCH) bar = xcd_barrier_post((unsigned*)ctl + CW_BAR, LCTL);
    const int lo = args.ph_lo, hi = args.ph_hi;
#ifndef SUBMASK
#define SUBMASK 7
#endif
#ifndef LN2PROBE
#define LN2PROBE 0
#endif
#ifndef SUBDUP
#define SUBDUP 0
#endif
#define NSUB(k) ((((SUBDUP) >> (k)) & 1) ? 2 : 1)
#ifndef DUPMASK
#define DUPMASK 0
#endif
#define NREP(k) ((((DUPMASK) >> (k)) & 1) ? 2 : 1)
#ifndef PHMASK
#define PHMASK 0xFFFF
#endif
#define IN(k) (lo <= (k) && (k) < hi)
#define SEAM(k) do { if (IN(k) && IN((k) + 1)) xcd_barrier(bar); } while (0)

    char* const Xb = (char*)(ws + WS_X);
    char* const Ub = (char*)(ws + WS_R1);
    float* const GIF = (float*)(ws + WS_GIF);
    LAS int* const PB = (LAS int*)(lds + LDSCTL_OFF + 64);
    LAS int* const CNT = (LAS int*)(lds + LDSCTL_OFF + 256);

    _Pragma("unroll 1") for (int rep_ = 0; rep_ < NREP(12); ++rep_) if (((PHMASK>>12)&1) && IN(0)) { PHASE_TID
        LAS float* scr = (LAS float*)(lds + wave * 8448);
        LAS float* wgt = (LAS float*)(lds + 73728);
        load_gate_table(wgt, INP(I_WIN), tid);
        constexpr int IT_IN = 16 * 216, IT_KV = 16 * 32, IT_BR = 8 * 32, IT_O = 16 * 32, IT_L = IT_IN + IT_KV + 3 * IT_BR + IT_O;
        for (int it = gw; it < DEPTH * IT_L; it += NGW) {
            const int l = it / IT_L; int r = it - l * IT_L;
            if (r < IT_IN) { const int kb = r / 216, nb = r % 216, n0 = 32 * nb, sc = n0 + (n0 >= 1536 ? 8 : 0);
                if (n0 < UC_GATE) transpose_item(INP(I_WIN) + ((size_t)l * D + 64 * kb) * DIN + sc, DIN, (bf16*)(ws + WS_WIN) + ((size_t)l * NU + n0) * D + 64 * kb, D, scr, lane);
                else transpose_item_f8(INP(I_WIN) + ((size_t)l * D + 64 * kb) * DIN + sc, DIN, (unsigned char*)(ws + WS_WING8) + ((size_t)l * 3072 + (n0 - UC_GATE)) * D + 64 * kb, D, F8_SWGU, scr, lane);
                continue; }
            r -= IT_IN;
            if (r < IT_KV) { const int kb = r / 32, nb = r % 32;
                transpose_item(INP(I_CAWKV) + ((size_t)l * D + 64 * kb) * 1024 + 32 * nb, 1024, (bf16*)(ws + WS_WKV) + ((size_t)l * 1024 + 32 * nb) * D + 64 * kb, D, scr, lane); continue; }
            r -= IT_KV;
            if (r < 3 * IT_BR) { const int br = r / IT_BR, q = r % IT_BR, kb = q / 32, nb = q % 32;
                const float* src = INP(br == 0 ? I_WBRML : (br == 1 ? I_WBRRW : I_WBRCA));
                transpose_item(src + ((size_t)l * 512 + 64 * kb) * 1024 + 32 * nb, 1024, (bf16*)(ws + WS_WBR) + ((size_t)l * 1024 + 32 * nb) * 1536 + br * 512 + 64 * kb, 1536, scr, lane); continue; }
            r -= 3 * IT_BR;
            { const int kb = r / 32, nb = r % 32;
                transpose_item(INP(I_WO) + ((size_t)l * D + 64 * kb) * 1024 + 32 * nb, 1024, (bf16*)(ws + WS_WO) + ((size_t)l * 1024 + 32 * nb) * D + 64 * kb, D, scr, lane); }
        }
        for (int i = bx * NTHR + tid; i < DEPTH * 1536 * 256; i += G * NTHR) {
            const int l = i / (1536 * 256), r = i % (1536 * 256), n = r >> 8, k = r & 255; float v = 0.f;
            if (n < 512) { if (k < 64) v = INP(I_RWWUP)[((size_t)l * 64 + k) * 512 + n]; }
            else if (n < 1024) { if (k >= 64 && k < 128) v = INP(I_RWAUP)[((size_t)l * 64 + (k - 64)) * 512 + (n - 512)]; }
            else { if (k >= 128) v = INP(I_RWGUP)[((size_t)l * 128 + (k - 128)) * 512 + (n - 1024)]; }
            ((bf16*)(ws + WS_WLORA))[i] = (bf16)f2bf(v);
        }
        __syncthreads();
        {
            f32x4 g[4], b[4];
#pragma unroll
            for (int j = 0; j < 4; ++j) { g[j] = *(const f32x4*)(INP(I_LNIN_G) + 256 * j + 4 * lane); b[j] = *(const f32x4*)(INP(I_LNIN_B) + 256 * j + 4 * lane); }
            for (int m = gw; m < M; m += NGW) {
                f32x4 v[4]; const float* xr = INP(I_X) + (size_t)m * D;
#pragma unroll
                for (int j = 0; j < 4; ++j) v[j] = *(const f32x4*)(xr + 256 * j + 4 * lane);
                ln16(v, g, b);
#pragma unroll
                for (int j = 0; j < 4; ++j) { st4bf(Xb + ((size_t)m * D + 256 * j + 4 * lane) * 2, v[j]); *(unsigned*)((char*)(ws + WS_XF8) + (size_t)m * D + 256 * j + 4 * lane) = pk4_f8(v[j].x * F8_SX, v[j].y * F8_SX, v[j].z * F8_SX, v[j].w * F8_SX); }
                gates8(v, wgt, GIF + (size_t)m * 8, lane);
            }
#pragma unroll
            for (int j = 0; j < 4; ++j) { g[j] = *(const f32x4*)(INP(I_MEMLN_G) + 256 * j + 4 * lane); b[j] = *(const f32x4*)(INP(I_MEMLN_B) + 256 * j + 4 * lane); }
            for (int m = gw; m < MROWS; m += NGW) {
                f32x4 v[4]; const float* xr = INP(I_MEM) + (size_t)m * D;
#pragma unroll
                for (int j = 0; j < 4; ++j) v[j] = *(const f32x4*)(xr + 256 * j + 4 * lane);
                ln16(v, g, b);
#pragma unroll
                for (int j = 0; j < 4; ++j) st4bf((char*)(ws + WS_MEMN) + ((size_t)m * D + 256 * j + 4 * lane) * 2, v[j]);
            }
        }
        __syncthreads();
    }
    SEAM(0);

#pragma unroll 1
    for (int l = 0; l < DEPTH; ++l) {
        const int pb = 1 + l * NP_LAYER;
        _Pragma("unroll 1") for (int rep_ = 0; rep_ < NREP(0); ++rep_) if (((PHMASK>>0)&1) && IN(pb + 0)) {
            SchedInproj S; S.T.init(M / 256, UC_GATE / 256); S.G = G; S.c = bx; S.X = Xb; S.W = (const char*)(ws + WS_WIN) + (size_t)l * NU * D * 2; S.U = Ub;
            S.kv = (l == 0); S.MEMN = (const char*)(ws + WS_MEMN); S.WKV = (const char*)(ws + WS_WKV); S.KV = (char*)(ws + WS_KV);
            pg8::EpiStore E;
            pg8::gemm_phase<false>(lds, D * 2, D * 2, D * 2, S, E, wave);
            SchedPlain S8; S8.T.init(M / 256, 12); S8.G = G; S8.c = bx; S8.A = (const char*)(ws + WS_XF8); S8.B = (const char*)(ws + WS_WING8) + (size_t)l * 3072 * D; S8.C = Ub + UC_GATE * 2;
            S8.lda = 512; S8.ldb = 512; S8.ldc = NU;
            pg8::EpiStoreS E8; E8.s = F8_INV1;
            pg8::gemm_phase<true>(lds, D, D, D, S8, E8, wave);
        }
        SEAM(pb + 0);
        _Pragma("unroll 1") for (int rep_ = 0; rep_ < NREP(1); ++rep_) if (((PHMASK>>1)&1) && IN(pb + 1)) { PHASE_TID
            const float* mu = INP(I_RWMU) + (size_t)l * 1792 + 1536;
            char* LIN = (char*)(ws + WS_R2 + R2_LORA_IN);
            for (int it = bx * NTHR + tid; it < M * 32; it += G * NTHR) {
                const int row = it >> 5, c = (it & 31) * 8;
                const u32x4 cw = *(const u32x4*)(Ub + ((size_t)row * NU + UC_RW + 1536 + c) * 2);
                u32x4 pw = (u32x4){0u, 0u, 0u, 0u};
                if ((row & (SEQ - 1)) != 0) pw = *(const u32x4*)(Ub + ((size_t)(row - 1) * NU + UC_RW + 1536 + c) * 2);
                const f32x4 m0 = *(const f32x4*)(mu + c), m1 = *(const f32x4*)(mu + c + 4);
                float x[8] = {bflo(cw.x), bfhi(cw.x), bflo(cw.y), bfhi(cw.y), bflo(cw.z), bfhi(cw.z), bflo(cw.w), bfhi(cw.w)};
                const float p[8] = {bflo(pw.x), bfhi(pw.x), bflo(pw.y), bfhi(pw.y), bflo(pw.z), bfhi(pw.z), bflo(pw.w), bfhi(pw.w)};
                const float mm[8] = {m0.x, m0.y, m0.z, m0.w, m1.x, m1.y, m1.z, m1.w};
#pragma unroll
                for (int i = 0; i < 8; ++i) { float xs = x[i] + (p[i] - x[i]) * mm[i];
                    if (c < 64) xs = 1.f - 2.f * __builtin_amdgcn_rcpf(1.f + __builtin_amdgcn_exp2f(2.8853900817779268f * xs));
                    else if (c >= 128) xs = sigmoidf_(xs);
                    x[i] = xs; }
                u32x4 o; o.x = pk2(x[0], x[1]); o.y = pk2(x[2], x[3]); o.z = pk2(x[4], x[5]); o.w = pk2(x[6], x[7]);
                *(u32x4*)(LIN + ((size_t)row * 256 + c) * 2) = o;
            }
        }
        SEAM(pb + 1);
        _Pragma("unroll 1") for (int rep_ = 0; rep_ < NREP(2); ++rep_) if (((PHMASK>>2)&1) && IN(pb + 2)) {
            SchedPlain S; S.T.init(M / 256, 6); S.G = G; S.c = bx; S.A = (const char*)(ws + WS_R2 + R2_LORA_IN); S.B = (const char*)(ws + WS_WLORA) + (size_t)l * 1536 * 256 * 2; S.C = (char*)(ws + WS_R2 + R2_LORA_OUT);
            S.lda = 256; S.ldb = 256; S.ldc = 1536;
            pg8::EpiStore E;
            pg8::gemm_phase<false>(lds, 512, 512, 512, S, E, wave);
        }
        SEAM(pb + 2);
        _Pragma("unroll 1") for (int rep_ = 0; rep_ < NREP(3); ++rep_) if (((PHMASK>>3)&1) && IN(pb + 3)) { PHASE_TID
            const char* LO = (const char*)(ws + WS_R2 + R2_LORA_OUT);
            char* HC = (char*)(ws + WS_R2 + R2_HCAT);
            const int tid_ph = tid;
#define SUB_TID unsigned zs_ = 0u; asm volatile("" : "+v"(zs_)); int tid = wave * 64 + (int)__builtin_amdgcn_mbcnt_hi(~0u, __builtin_amdgcn_mbcnt_lo(~0u, zs_)); const int lane = tid & 63; (void)lane;
#pragma unroll 1
            for (int job = bx; job < 256; job += G) {
                if (job < 128) { _Pragma("unroll 1") for (int sr_ = 0; sr_ < NSUB(0); ++sr_) if ((SUBMASK>>0)&1) {
                    SUB_TID
                    const int b = job >> 3, h = job & 7;
                    constexpr int TC = 64;
                    LAS float* OPS = (LAS float*)lds;
                    LAS float* OUTB = OPS + TC * 384;
                    LAS float* BON = OUTB + TC * 64;
                    LAS float* C12 = BON + TC;
                    LAS float* PREV = C12 + 2 * TC;
                    const int pt = tid >> 4, cs = tid & 15, pc = cs * 4, hc = h * 64 + pc;
                    if (tid < 192) PREV[tid] = 0.f;
                    f32x4 S0 = (f32x4){0.f, 0.f, 0.f, 0.f}, S1 = S0, So0 = S0, So1 = S0; float sap0 = 0.f, sap1 = 0.f; f32x2 vprev = (f32x2){0.f, 0.f};
                    u32x2 pu[2][9];
                    auto LOADC = [&](int t0) {
#pragma unroll
                        for (int tt = 0; tt < 2; ++tt) { const int t = t0 + pt + 32 * tt; const size_t row = (size_t)b * SEQ + t; const char* up = Ub + (row * NU + UC_RW + hc) * 2;
                            pu[tt][0] = *(const u32x2*)up; pu[tt][1] = *(const u32x2*)(up + 1024); pu[tt][2] = *(const u32x2*)(up + 2048);
                            if (t > 0) { const char* pp = up - (size_t)NU * 2; pu[tt][3] = *(const u32x2*)pp; pu[tt][4] = *(const u32x2*)(pp + 1024); pu[tt][5] = *(const u32x2*)(pp + 2048); }
                            else { pu[tt][3] = (u32x2){0u, 0u}; pu[tt][4] = pu[tt][3]; pu[tt][5] = pu[tt][3]; }
                            const char* lp = LO + (row * 1536 + hc) * 2; pu[tt][6] = *(const u32x2*)lp; pu[tt][7] = *(const u32x2*)(lp + 1024); pu[tt][8] = *(const u32x2*)(lp + 2048); }
                    };
#define UNP4(w) ((f32x4){bflo((w).x), bfhi((w).x), bflo((w).y), bfhi((w).y)})
#define DOT4(a, b) (((a).x * (b).x + (a).y * (b).y) + ((a).z * (b).z + (a).w * (b).w))
                    LOADC(0);
#pragma unroll 1
                    for (int t0 = 0; t0 < SEQ; t0 += TC) {
                        f32x4 gk[2];
                        int hcv = hc; asm volatile("" : "+v"(hcv));
                        const f32x4 mu_r = *(const f32x4*)(INP(I_RWMU) + (size_t)l * 1792 + hcv), mu_k = *(const f32x4*)(INP(I_RWMU) + (size_t)l * 1792 + 512 + hcv), mu_v = *(const f32x4*)(INP(I_RWMU) + (size_t)l * 1792 + 1024 + hcv);
                        const f32x4 w0 = *(const f32x4*)(INP(I_RWW0) + l * 512 + hcv), a0 = *(const f32x4*)(INP(I_RWA0) + l * 512 + hcv), kkw = *(const f32x4*)(INP(I_RWKK) + l * 512 + hcv);
                        const f32x4 kaw = *(const f32x4*)(INP(I_RWKA) + l * 512 + hcv), rkw = *(const f32x4*)(INP(I_RWRK) + l * 512 + hcv);
#pragma unroll
                        for (int tt = 0; tt < 2; ++tt) { const int tok = pt + 32 * tt;
                            const f32x4 ur = UNP4(pu[tt][0]), uk = UNP4(pu[tt][1]), uv = UNP4(pu[tt][2]), urp = UNP4(pu[tt][3]), ukp = UNP4(pu[tt][4]), uvp = UNP4(pu[tt][5]), lw = UNP4(pu[tt][6]), la = UNP4(pu[tt][7]);
                            gk[tt] = UNP4(pu[tt][8]);
                            const f32x4 xr = ur + (urp - ur) * mu_r, xk = uk + (ukp - uk) * mu_k, xv = uv + (uvp - uv) * mu_v;
                            f32x4 dec, av, kkv, kp; float ss = 0.f, bsum = 0.f;
#pragma unroll
                            for (int i = 0; i < 4; ++i) {
                                const float y = -(w0[i] + lw[i]);
                                const float sp = fmaxf(y, 0.f) + __logf(1.f + __expf(-fabsf(y)));
                                dec[i] = __expf(-__expf(-sp - 0.5f));
                                av[i] = sigmoidf_(a0[i] + la[i]);
                                kkv[i] = xk[i] * kkw[i]; ss += kkv[i] * kkv[i];
                                kp[i] = xk[i] * (1.f + (av[i] - 1.f) * kaw[i]);
                                bsum += xr[i] * kp[i] * rkw[i];
                            }
                            ss = red16(ss); bsum = red16(bsum);
                            const float inv = __builtin_amdgcn_rsqf(fmaxf(ss, 1e-24f));
                            const f32x4 kk = kkv * inv, kka = kk * av;
                            LAS float* o = OPS + tok * 384 + pc;
                            *(LAS f32x4*)(o) = dec; *(LAS f32x4*)(o + 64) = kk; *(LAS f32x4*)(o + 128) = kka; *(LAS f32x4*)(o + 192) = kp; *(LAS f32x4*)(o + 256) = xr; *(LAS f32x4*)(o + 320) = xv;
                            if (cs == 0) BON[tok] = bsum;
                        }
                        if (t0 + TC < SEQ) LOADC(t0 + TC);
                        __syncthreads();
#pragma unroll
                        for (int tt = 0; tt < 2; ++tt) { const int tok = pt + 32 * tt;
                            const LAS float* pr = OPS + (tok - 1) * 384 + pc;
                            f32x4 pw, pkp, pka;
                            if (tok > 0) { pw = *(const LAS f32x4*)pr; pkp = *(const LAS f32x4*)(pr + 192); pka = *(const LAS f32x4*)(pr + 128); }
                            else { pw = *(const LAS f32x4*)(PREV + pc); pkp = *(const LAS f32x4*)(PREV + 64 + pc); pka = *(const LAS f32x4*)(PREV + 128 + pc); }
                            LAS float* zp = OPS + tok * 384 + 64 + pc;
                            const f32x4 z = *(const LAS f32x4*)zp;
                            const float c1 = red16(DOT4(pkp, z)), c2 = red16(DOT4(pka, z));
                            *(LAS f32x4*)zp = pw * z;
                            if (cs == 0) *(LAS f32x2*)(C12 + 2 * tok) = (f32x2){c1, c2};
                        }
                        __syncthreads();
                        {
                            const LAS float* qb = OPS + pc; const LAS float* vb = OPS + 320 + 2 * pt;
                            float dc0, dc1;
                            { const f32x4 y0 = *(const LAS f32x4*)(qb + 64); dc0 = red16(DOT4(So0, y0)); dc1 = red16(DOT4(So1, y0)); }
                            f32x4 w4 = *(const LAS f32x4*)(qb), ka4 = *(const LAS f32x4*)(qb + 128), kp4 = *(const LAS f32x4*)(qb + 192), r4 = *(const LAS f32x4*)(qb + 256), yn = *(const LAS f32x4*)(qb + 384 + 64);
                            f32x2 v2 = *(const LAS f32x2*)vb, c12 = *(const LAS f32x2*)C12;
#define OPQ(x) asm("" : "+v"(x))
#define DOT4S(d, a, b) do { float t0_ = (a).x * (b).x, t1_ = (a).z * (b).z; OPQ(t0_); OPQ(t1_); t0_ = __builtin_fmaf((a).y, (b).y, t0_); t1_ = __builtin_fmaf((a).w, (b).w, t1_); OPQ(t0_); OPQ(t1_); d = t0_ + t1_; OPQ(d); } while (0)
#define UPD1(Sc, wc, kpc, kac, vs, sas) do { float t_ = (kpc) * (vs); OPQ(t_); t_ = __builtin_fmaf(-(kac), (sas), t_); OPQ(t_); Sc = __builtin_fmaf(Sc, (wc), t_); OPQ(Sc); } while (0)
#define RW_STEP(s, LASTSTEP) do { \
                                const int s1 = (s) + 1 < TC ? (s) + 1 : TC - 1, s2 = (s) + 2 < TC ? (s) + 2 : TC - 1; \
                                const f32x4 nw4 = *(const LAS f32x4*)(qb + s1 * 384), nka4 = *(const LAS f32x4*)(qb + s1 * 384 + 128), nkp4 = *(const LAS f32x4*)(qb + s1 * 384 + 192), nr4 = *(const LAS f32x4*)(qb + s1 * 384 + 256), nyn = *(const LAS f32x4*)(qb + s2 * 384 + 64); \
                                const f32x2 nv2 = *(const LAS f32x2*)(vb + s1 * 384), nc12 = *(const LAS f32x2*)(C12 + 2 * s1); \
                                float sa0 = vprev.x * c12.x, sa1 = vprev.y * c12.x; OPQ(sa0); OPQ(sa1); sa0 = __builtin_fmaf(-sap0, c12.y, sa0); sa1 = __builtin_fmaf(-sap1, c12.y, sa1); OPQ(sa0); OPQ(sa1); sa0 += dc0; sa1 += dc1; OPQ(sa0); OPQ(sa1); \
                                float dn0 = 0.f, dn1 = 0.f; \
                                if (LASTSTEP) { So0 = S0; So1 = S1; } else { DOT4S(dn0, S0, yn); DOT4S(dn1, S1, yn); dn0 = red16o(dn0); dn1 = red16o(dn1); } \
                                UPD1(S0.x, w4.x, kp4.x, ka4.x, v2.x, sa0); UPD1(S0.y, w4.y, kp4.y, ka4.y, v2.x, sa0); UPD1(S0.z, w4.z, kp4.z, ka4.z, v2.x, sa0); UPD1(S0.w, w4.w, kp4.w, ka4.w, v2.x, sa0); \
                                UPD1(S1.x, w4.x, kp4.x, ka4.x, v2.y, sa1); UPD1(S1.y, w4.y, kp4.y, ka4.y, v2.y, sa1); UPD1(S1.z, w4.z, kp4.z, ka4.z, v2.y, sa1); UPD1(S1.w, w4.w, kp4.w, ka4.w, v2.y, sa1); \
                                float o0, o1; DOT4S(o0, S0, r4); DOT4S(o1, S1, r4); o0 = red16o(o0); o1 = red16o(o1); \
                                if (cs == 0) *(LAS f32x2*)(OUTB + (s) * 64 + 2 * pt) = (f32x2){o0, o1}; \
                                sap0 = sa0; sap1 = sa1; vprev = v2; dc0 = dn0; dc1 = dn1; \
                                w4 = nw4; ka4 = nka4; kp4 = nkp4; r4 = nr4; yn = nyn; v2 = nv2; c12 = nc12; __builtin_amdgcn_sched_barrier(0); } while (0)
#pragma unroll 1
                            for (int s = 0; s < TC - 2; s += 2) { RW_STEP(s, false); RW_STEP(s + 1, false); }
                            RW_STEP(TC - 2, false);
                            RW_STEP(TC - 1, true);
#undef RW_STEP
#undef OPQ
#undef DOT4S
#undef UPD1
                        }
                        __syncthreads();
                        int hcw = hc; asm volatile("" : "+v"(hcw));
                        const f32x4 lng = *(const f32x4*)(INP(I_RWLNG) + l * 512 + hcw), lnb = *(const f32x4*)(INP(I_RWLNB) + l * 512 + hcw);
#pragma unroll
                        for (int tt = 0; tt < 2; ++tt) { const int tok = pt + 32 * tt;
                            const f32x4 o4 = *(const LAS f32x4*)(OUTB + tok * 64 + pc), v4 = *(const LAS f32x4*)(OPS + tok * 384 + 320 + pc);
                            const float mean = red16((o4.x + o4.y) + (o4.z + o4.w)) * (1.f / 64.f);
                            const f32x4 dv = o4 - mean;
                            const float var = red16(DOT4(dv, dv)) * (1.f / 64.f);
                            const float rstd = __builtin_amdgcn_rsqf(var + RW_GN_EPS), bo = BON[tok];
                            const f32x4 y = (dv * rstd * lng + lnb + v4 * bo) * gk[tt];
                            st4bf(HC + (((size_t)b * SEQ + t0 + tok) * 1536 + 512 + hc) * 2, y);
                        }
                        if (tid < 192) { const int j = tid >> 6, c = tid & 63; PREV[tid] = OPS[(TC - 1) * 384 + (j == 0 ? 0 : (j == 1 ? 192 : 128)) + c]; }
                        __syncthreads();
                    }
                } } else {
                    const int idx = job - 128, bh = idx >> 1, half = idx & 1, b = bh >> 2, h = bh & 3;
                    unsigned zl_ = 0u; asm volatile("" : "+v"(zl_)); const int lane_ml = (int)__builtin_amdgcn_mbcnt_hi(~0u, __builtin_amdgcn_mbcnt_lo(~0u, zl_));
                    _Pragma("unroll 1") for (int sr_ = 0; sr_ < NSUB(1); ++sr_) if ((SUBMASK>>1)&1) {
                        SUB_TID
                        constexpr int TC = 64;
                        LAS float* QK = (LAS float*)lds;
                        LAS float* VV = QK + TC * 128;
                        LAS float* FI = VV + TC * 64;
                        LAS float* NUM = FI + TC * 4;
                        LAS float* DENP = NUM + TC * 64;
                        const int pt = tid >> 4, cg = tid & 15;
                        const int ccol = (cg < 8) ? (h * 64 + 8 * cg) : (256 + h * 64 + 8 * (cg - 8));
                        float cw[4][8], cb[8];
#pragma unroll
                        for (int j = 0; j < 4; ++j) { const f32x4 a = *(const f32x4*)(INP(I_CONVW) + ((size_t)l * 4 + j) * 512 + ccol), c2 = *(const f32x4*)(INP(I_CONVW) + ((size_t)l * 4 + j) * 512 + ccol + 4);
                            cw[j][0] = a.x; cw[j][1] = a.y; cw[j][2] = a.z; cw[j][3] = a.w; cw[j][4] = c2.x; cw[j][5] = c2.y; cw[j][6] = c2.z; cw[j][7] = c2.w; }
                        { const f32x4 a = *(const f32x4*)(INP(I_CONVB) + l * 512 + ccol), c2 = *(const f32x4*)(INP(I_CONVB) + l * 512 + ccol + 4);
                            cb[0] = a.x; cb[1] = a.y; cb[2] = a.z; cb[3] = a.w; cb[4] = c2.x; cb[5] = c2.y; cb[6] = c2.z; cb[7] = c2.w; }
                        const float qsc = (cg < 8) ? 0.125f : 1.f;
                        const float igb = INP(I_IGB)[l * 4 + h], fgb = INP(I_FGB)[l * 4 + h];
                        const int r = tid >> 3, cs8 = (tid & 7) * 8;
                        const int ne = 8 * wave + (lane & 7);
                        float C[8] = {0.f, 0.f, 0.f, 0.f, 0.f, 0.f, 0.f, 0.f}; float nreg = 0.f, mprev = 0.f;
                        u32x4 cu[2][4]; u32x2 vu[2]; float gi = 0.f, gf = 0.f;
                        auto LOADM = [&](int t0) {
#pragma unroll
                            for (int tt = 0; tt < 2; ++tt) { const int t = t0 + pt + 32 * tt; const size_t row = (size_t)b * SEQ + t;
#pragma unroll
                                for (int j = 0; j < 4; ++j) { if (t - 3 + j >= 0) cu[tt][j] = *(const u32x4*)(Ub + ((row - 3 + j) * NU + UC_QK + ccol) * 2); else cu[tt][j] = (u32x4){0u, 0u, 0u, 0u}; }
                                vu[tt] = *(const u32x2*)(Ub + (row * NU + UC_V + h * 128 + half * 64 + 4 * cg) * 2); }
                            if (wave == 0) { const size_t rg = (size_t)b * SEQ + t0 + lane; gi = GIF[rg * 8 + h]; gf = GIF[rg * 8 + 4 + h]; }
                        };
                        LOADM(0);
#pragma unroll 1
                        for (int t0 = 0; t0 < SEQ; t0 += TC) {
#pragma unroll
                            for (int tt = 0; tt < 2; ++tt) { const int tok = pt + 32 * tt; float y[8];
#pragma unroll
                                for (int i = 0; i < 8; ++i) y[i] = cb[i];
#pragma unroll
                                for (int j = 0; j < 4; ++j) { const u32x4 w = cu[tt][j]; const float x[8] = {bflo(w.x), bfhi(w.x), bflo(w.y), bfhi(w.y), bflo(w.z), bfhi(w.z), bflo(w.w), bfhi(w.w)};
#pragma unroll
                                    for (int i = 0; i < 8; ++i) y[i] += cw[j][i] * x[i]; }
#pragma unroll
                                for (int i = 0; i < 8; ++i) y[i] = y[i] * sigmoidf_(y[i]) * qsc;
                                LAS float* o = QK + tok * 128 + 8 * cg;
                                *(LAS f32x4*)o = (f32x4){y[0], y[1], y[2], y[3]}; *(LAS f32x4*)(o + 4) = (f32x4){y[4], y[5], y[6], y[7]};
                                *(LAS f32x4*)(VV + tok * 64 + 4 * cg) = (f32x4){bflo(vu[tt].x), bfhi(vu[tt].x), bflo(vu[tt].y), bfhi(vu[tt].y)};
                            }
                            if (wave == 0) {
                                const float ig = gi + igb, fp = gf + fgb;
                                const float lf = -(fmaxf(-fp, 0.f) + __logf(1.f + __expf(-fabsf(fp))));
                                float bc = lf;
#pragma unroll
                                for (int o = 1; o < 64; o <<= 1) { const float t = __shfl_up(bc, o); if (lane >= o) bc += t; }
                                float pm = ig - bc;
#pragma unroll
                                for (int o = 1; o < 64; o <<= 1) { const float t = __shfl_up(pm, o); if (lane >= o) pm = fmaxf(pm, t); }
                                const float mt = bc + fmaxf(mprev, pm);
                                float mp1 = __shfl_up(mt, 1); if (lane == 0) mp1 = mprev;
                                const float fpr = __expf(lf + mp1 - mt), ipr = __expf(ig - mt), em = __expf(-mt);
                                *(LAS f32x4*)(FI + lane * 4) = (f32x4){fpr, ipr, em, 0.f};
                                mprev = __shfl(mt, 63);
                            }
                            if (t0 + TC < SEQ) LOADM(t0 + TC);
                            __syncthreads();
                            {
                                const LAS float* qp0 = QK + cs8;
                                f32x4 q0 = *(const LAS f32x4*)qp0, q1 = *(const LAS f32x4*)(qp0 + 4), k0 = *(const LAS f32x4*)(qp0 + 64), k1 = *(const LAS f32x4*)(qp0 + 68), fi = *(const LAS f32x4*)FI;
                                float vv = VV[r], nk = QK[64 + ne], nq = QK[ne];
#define OPQ(x) asm("" : "+v"(x))
#define ML_UPD(Cj, kj) do { float t_ = fi.x * Cj; OPQ(t_); Cj = __builtin_fmaf(tv, (kj), t_); OPQ(Cj); } while (0)
#define ML_STEP(s) do { \
                                    const int s1 = (s) + 1 < TC ? (s) + 1 : TC - 1; const LAS float* qp = qp0 + s1 * 128; \
                                    const f32x4 nq0 = *(const LAS f32x4*)qp, nq1 = *(const LAS f32x4*)(qp + 4), nk0 = *(const LAS f32x4*)(qp + 64), nk1 = *(const LAS f32x4*)(qp + 68), nfi = *(const LAS f32x4*)(FI + s1 * 4); \
                                    const float nvv = VV[s1 * 64 + r], nnk = QK[s1 * 128 + 64 + ne], nnq = QK[s1 * 128 + ne]; \
                                    float tv = fi.y * vv; OPQ(tv); \
                                    ML_UPD(C[0], k0.x); ML_UPD(C[1], k0.y); ML_UPD(C[2], k0.z); ML_UPD(C[3], k0.w); ML_UPD(C[4], k1.x); ML_UPD(C[5], k1.y); ML_UPD(C[6], k1.z); ML_UPD(C[7], k1.w); \
                                    float pa = C[0] * q0.x, pb = C[4] * q1.x; OPQ(pa); OPQ(pb); pa = __builtin_fmaf(C[1], q0.y, pa); pb = __builtin_fmaf(C[5], q1.y, pb); OPQ(pa); OPQ(pb); \
                                    pa = __builtin_fmaf(C[2], q0.z, pa); pb = __builtin_fmaf(C[6], q1.z, pb); OPQ(pa); OPQ(pb); pa = __builtin_fmaf(C[3], q0.w, pa); pb = __builtin_fmaf(C[7], q1.w, pb); OPQ(pa); OPQ(pb); \
                                    float p = pa + pb; OPQ(p); p = red8o(p); \
                                    float nt_ = fi.x * nreg; OPQ(nt_); nreg = __builtin_fmaf(fi.y, nk, nt_); OPQ(nreg); \
                                    float dp = nreg * nq; OPQ(dp); dp = red8o(dp); \
                                    NUM[(s) * 64 + r] = p;                   \
                                    DENP[(s) * 8 + wave] = dp; \
                                    q0 = nq0; q1 = nq1; k0 = nk0; k1 = nk1; fi = nfi; vv = nvv; nk = nnk; nq = nnq; __builtin_amdgcn_sched_barrier(0); } while (0)
#pragma unroll 1
                                for (int s = 0; s < TC; s += 2) { ML_STEP(s); ML_STEP(s + 1); }
#undef ML_STEP
#undef ML_UPD
#undef OPQ
                            }
                            __syncthreads();
#pragma unroll
                            for (int tt = 0; tt < 2; ++tt) { const int tok = pt + 32 * tt;
                                const f32x4 d0 = *(const LAS f32x4*)(DENP + tok * 8), d1 = *(const LAS f32x4*)(DENP + tok * 8 + 4);
                                const float den = ((d0.x + d0.y) + (d0.z + d0.w)) + ((d1.x + d1.y) + (d1.z + d1.w)), em = FI[tok * 4 + 2];
                                const float rdn = 1.f / fmaxf(fabsf(den), em);
                                const f32x4 nv = *(const LAS f32x4*)(NUM + tok * 64 + 4 * cg);
                                st4bf((char*)(ws + WS_HML) + (((size_t)b * SEQ + t0 + tok) * 512 + h * 128 + half * 64 + 4 * cg) * 2, nv * rdn);
                            }
                            __syncthreads();
                        }
                    }
                    _Pragma("unroll 1") for (int sr_ = 0; sr_ < NSUB(2); ++sr_) if ((SUBMASK>>2)&1) {
                        SUB_TID
                        constexpr int KST = 272, VST = 520;
                        LAS unsigned char* KI = lds; LAS unsigned char* VI = lds + 256 * KST;
                        const char* kvb = (const char*)(ws + WS_KV) + (((size_t)l * MROWS + (size_t)b * MEML) * D) * 2;
                        for (int p = tid; p < 4096; p += NTHR) { const int key = p >> 4, c16 = p & 15;
                            *(LAS u32x4*)(KI + key * KST + c16 * 16) = *(const u32x4*)(kvb + ((size_t)key * D + h * 128 + c16 * 8) * 2); }
                        for (int p = tid; p < 4096; p += NTHR) { const int key = p & 255, d8 = p >> 8;
                            const u32x4 w = *(const u32x4*)(kvb + ((size_t)key * D + 512 + h * 128 + d8 * 8) * 2);
                            LAS unsigned char* o = VI + (d8 * 8) * VST + key * 2;
                            *(LAS bf16*)(o) = (bf16)(w.x & 0xffff); *(LAS bf16*)(o + VST) = (bf16)(w.x >> 16); *(LAS bf16*)(o + 2 * VST) = (bf16)(w.y & 0xffff); *(LAS bf16*)(o + 3 * VST) = (bf16)(w.y >> 16);
                            *(LAS bf16*)(o + 4 * VST) = (bf16)(w.z & 0xffff); *(LAS bf16*)(o + 5 * VST) = (bf16)(w.z >> 16); *(LAS bf16*)(o + 6 * VST) = (bf16)(w.w & 0xffff); *(LAS bf16*)(o + 7 * VST) = (bf16)(w.w >> 16); }
                        __syncthreads();
                        const int r31 = lane & 31, h2 = lane >> 5;
                        constexpr float SC = 0.08838834764831845f * 1.4426950408889634f;
#pragma unroll 1
                        for (int rd = 0; rd < 8; ++rd) {
                            const size_t qrow = (size_t)b * SEQ + half * 2048 + rd * 256 + wave * 32 + r31;
                            bf16x8 qf[8];
#pragma unroll
                            for (int ks = 0; ks < 8; ++ks) qf[ks] = *(const bf16x8*)(Ub + (qrow * NU + UC_CAQ + h * 128 + 16 * ks + 8 * h2) * 2);
                            f32x16 O[4];
#pragma unroll
                            for (int db = 0; db < 4; ++db)
#pragma unroll
                                for (int i = 0; i < 16; ++i) O[db][i] = 0.f;
                            float mrun = -1e30f, lrun = 0.f;
#pragma unroll 1
                            for (int hf = 0; hf < 2; ++hf) {
                                f32x16 X[4];
#pragma unroll
                                for (int kb = 0; kb < 4; ++kb) {
                                    bf16x8 kf[8];
#pragma unroll
                                    for (int ks = 0; ks < 8; ++ks) kf[ks] = *(const LAS bf16x8*)(KI + (hf * 128 + kb * 32 + r31) * KST + (16 * ks + 8 * h2) * 2);
                                    __builtin_amdgcn_sched_barrier(0);
#pragma unroll
                                    for (int i = 0; i < 16; ++i) X[kb][i] = 0.f;
#pragma unroll
                                    for (int ks = 0; ks < 8; ++ks) X[kb] = __builtin_amdgcn_mfma_f32_32x32x16_bf16(kf[ks], qf[ks], X[kb], 0, 0, 0);
                                    __builtin_amdgcn_sched_barrier(0);
                                }
                                float mx = -1e30f;
#pragma unroll
                                for (int kb = 0; kb < 4; ++kb)
#pragma unroll
                                    for (int i = 0; i < 16; ++i) mx = fmaxf(mx, X[kb][i]);
                                mx = fmaxf(mx, __shfl_xor(mx, 32));
                                const float mnew = fmaxf(mrun, mx), alpha = __builtin_amdgcn_exp2f((mrun - mnew) * SC);
                                float ls = 0.f;
#pragma unroll
                                for (int kb = 0; kb < 4; ++kb)
#pragma unroll
                                    for (int i = 0; i < 16; ++i) { const float p = __builtin_amdgcn_exp2f((X[kb][i] - mnew) * SC); X[kb][i] = p; ls += p; }
                                ls += __shfl_xor(ls, 32);
                                lrun = lrun * alpha + ls; mrun = mnew;
#pragma unroll
                                for (int db = 0; db < 4; ++db)
#pragma unroll
                                    for (int i = 0; i < 16; ++i) O[db][i] *= alpha;
#pragma unroll
                                for (int kb = 0; kb < 4; ++kb) {
                                    bf16x8 vf[2][4], pf[2];
#pragma unroll
                                    for (int s = 0; s < 2; ++s) {
                                        u32x4 pw; pw.x = pk2(X[kb][8 * s], X[kb][8 * s + 1]); pw.y = pk2(X[kb][8 * s + 2], X[kb][8 * s + 3]); pw.z = pk2(X[kb][8 * s + 4], X[kb][8 * s + 5]); pw.w = pk2(X[kb][8 * s + 6], X[kb][8 * s + 7]);
                                        pf[s] = __builtin_bit_cast(bf16x8, pw);
#pragma unroll
                                        for (int db = 0; db < 4; ++db) {
                                            const LAS unsigned char* vp = VI + (db * 32 + r31) * VST + (hf * 128 + kb * 32 + 16 * s + 4 * h2) * 2;
                                            const u32x2 lo = *(const LAS u32x2*)vp, hi = *(const LAS u32x2*)(vp + 16);
                                            vf[s][db] = __builtin_bit_cast(bf16x8, (u32x4){lo.x, lo.y, hi.x, hi.y});
                                        }
                                    }
                                    __builtin_amdgcn_sched_barrier(0);
#pragma unroll
                                    for (int s = 0; s < 2; ++s)
#pragma unroll
                                        for (int db = 0; db < 4; ++db) O[db] = __builtin_amdgcn_mfma_f32_32x32x16_bf16(vf[s][db], pf[s], O[db], 0, 0, 0);
                                    __builtin_amdgcn_sched_barrier(0);
                                }
                            }
                            const float rl = 1.f / lrun;
                            char* op = HC + (qrow * 1536 + 1024 + h * 128) * 2;
#pragma unroll
                            for (int db = 0; db < 4; ++db)
#pragma unroll
                                for (int g4 = 0; g4 < 4; ++g4) { u32x2 w; w.x = pk2(O[db][4 * g4] * rl, O[db][4 * g4 + 1] * rl); w.y = pk2(O[db][4 * g4 + 2] * rl, O[db][4 * g4 + 3] * rl);
                                    *(u32x2*)(op + (db * 32 + 8 * g4 + 4 * h2) * 2) = w; }
                        }
                        __syncthreads();
                    }
                    if (rep_ == 0) {
                        LAS float* scr = (LAS float*)(lds + wave * 8448);
                        constexpr int IT_GU = 32 * 16 * 64;
                        for (int it = idx * NWAVES + wave; it < XW_SPLIT; it += 128 * NWAVES) {
                            if (it < IT_GU) { const int e = it >> 10, q = it & 1023, kb = q >> 6, nb = q & 63;
                                transpose_item_f8(INP(I_WGU) + (((size_t)l * 32 + e) * D + 64 * kb) * 2048 + 32 * nb, 2048, (unsigned char*)(ws + WS_WGU) + ((size_t)e * 2048 + 32 * nb) * D + 64 * kb, D, F8_SWGU, scr, lane_ml); }
                            else { const int r2 = it - IT_GU, e = r2 >> 9, q = r2 & 511, kb = q >> 5, nb = q & 31;
                                transpose_item_f8(INP(I_WDN) + (((size_t)l * 32 + e) * D + 64 * kb) * 1024 + 32 * nb, 1024, (unsigned char*)(ws + WS_WDN) + ((size_t)e * 1024 + 32 * nb) * D + 64 * kb, D, F8_SWDN, scr, lane_ml); }
                        }
                        __syncthreads();
                    }
                }
            }
#undef UNP4
#undef DOT4
#undef SUB_TID
        }
        SEAM(pb + 3);
        _Pragma("unroll 1") for (int rep_ = 0; rep_ < NREP(4); ++rep_) if (((PHMASK>>4)&1) && IN(pb + 4)) { PHASE_TID
            char* HC = (char*)(ws + WS_R2 + R2_HCAT);
            const int hd = lane >> 4, sb = (lane & 15) * 8;
            const f32x4 g0 = *(const f32x4*)(INP(I_MLNORMG) + l * 512 + hd * 128 + sb), g1 = *(const f32x4*)(INP(I_MLNORMG) + l * 512 + hd * 128 + sb + 4);
            for (int m = gw; m < M; m += NGW) {
                const u32x4 hw = *(const u32x4*)((const char*)(ws + WS_HML) + ((size_t)m * 512 + hd * 128 + sb) * 2);
                const u32x4 ow = *(const u32x4*)(Ub + ((size_t)m * NU + UC_OG + hd * 128 + sb) * 2);
                float v[8] = {bflo(hw.x), bfhi(hw.x), bflo(hw.y), bfhi(hw.y), bflo(hw.z), bfhi(hw.z), bflo(hw.w), bfhi(hw.w)};
                const float og[8] = {bflo(ow.x), bfhi(ow.x), bflo(ow.y), bfhi(ow.y), bflo(ow.z), bfhi(ow.z), bflo(ow.w), bfhi(ow.w)};
                const float gg[8] = {g0.x, g0.y, g0.z, g0.w, g1.x, g1.y, g1.z, g1.w};
                float s = 0.f;
#pragma unroll
                for (int i = 0; i < 8; ++i) s += v[i];
                const float mean = red16(s) * (1.f / 128.f); float s2 = 0.f;
#pragma unroll
                for (int i = 0; i < 8; ++i) { v[i] -= mean; s2 += v[i] * v[i]; }
                const float rstd = 1.f / sqrtf(red16(s2) * (1.f / 128.f) + LN_EPS);
#pragma unroll
                for (int i = 0; i < 8; ++i) v[i] = sigmoidf_(og[i]) * (v[i] * rstd * gg[i]);
                u32x4 o; o.x = pk2(v[0], v[1]); o.y = pk2(v[2], v[3]); o.z = pk2(v[4], v[5]); o.w = pk2(v[6], v[7]);
                *(u32x4*)(HC + ((size_t)m * 1536 + hd * 128 + sb) * 2) = o;
            }
        }
        SEAM(pb + 4);
        _Pragma("unroll 1") for (int rep_ = 0; rep_ < NREP(5); ++rep_) if (((PHMASK>>5)&1) && IN(pb + 5)) {
            SchedPlain S; S.T.init(M / 256, 4); S.G = G; S.c = bx; S.A = (const char*)(ws + WS_R2 + R2_HCAT); S.B = (const char*)(ws + WS_WBR) + (size_t)l * 1024 * 1536 * 2; S.C = (char*)(ws + WS_R2 + R2_YPRE);
            S.lda = 1536; S.ldb = 1536; S.ldc = D;
            pg8::EpiMerge E; E.U = Ub; E.gate_b = INP(I_GATEB) + (size_t)l * 3072;
            pg8::gemm_phase<false, true>(lds, 1536 * 2, 1536 * 2, 1536 * 2, S, E, wave);
        }
        SEAM(pb + 5);
        _Pragma("unroll 1") for (int rep_ = 0; rep_ < NREP(6); ++rep_) if (((PHMASK>>6)&1) && IN(pb + 6)) {
            SchedPlain S; S.T.init(M / 256, 4); S.G = G; S.c = bx; S.A = (const char*)(ws + WS_R2 + R2_YPRE); S.B = (const char*)(ws + WS_WO) + (size_t)l * D * D * 2; S.C = (char*)(ws + WS_R2 + R2_Z);
            S.lda = D; S.ldb = D; S.ldc = D;
            pg8::EpiStore E;
            pg8::gemm_phase<false>(lds, D * 2, D * 2, D * 2, S, E, wave);
        }
        SEAM(pb + 6);
        _Pragma("unroll 1") for (int rep_ = 0; rep_ < NREP(7); ++rep_) if (((PHMASK>>7)&1) && IN(pb + 7)) { PHASE_TID
            LAS float* WR = (LAS float*)lds;
            for (int i = tid; i < 32768; i += NTHR) { const int k = i >> 5, e = i & 31; WR[e * 1024 + k] = INP(I_RTW)[((size_t)l * D + k) * 32 + e]; }
            __syncthreads();
            f32x4 g[4], bb[4];
#pragma unroll
            for (int j = 0; j < 4; ++j) { g[j] = *(const f32x4*)(INP(I_LN1G) + l * D + 256 * j + 4 * lane); bb[j] = *(const f32x4*)(INP(I_LN1B) + l * D + 256 * j + 4 * lane); }
            const float rbias = INP(I_RTB)[l * 32 + (lane & 31)];
            const char* Zb = (const char*)(ws + WS_R2 + R2_Z);
            int* TKE = (int*)(ws + WS_TKE); float* TKG = (float*)(ws + WS_TKG); int* TKP = (int*)(ws + WS_TKP); int* ROWTOK = (int*)(ws + WS_ROWTOK);
            LAS unsigned* LCNT = (LAS unsigned*)(lds + 131072);
            LAS unsigned* GBASE = LCNT + 32; LAS unsigned* LLEN = LCNT + 64; LAS unsigned* LIST = LCNT + 128;
            if (tid < 65) LCNT[tid] = 0u;
            __syncthreads();
#pragma unroll 1
            for (int pp = gw; pp < M / 2; pp += NGW) {
                f32x4 y0[4], y1[4];
#pragma unroll
                for (int j = 0; j < 4; ++j) { y0[j] = ld4bf(Zb + ((size_t)(2 * pp) * D + 256 * j + 4 * lane) * 2) + ld4bf(Xb + ((size_t)(2 * pp) * D + 256 * j + 4 * lane) * 2) * DN_ALPHA;
                    y1[j] = ld4bf(Zb + ((size_t)(2 * pp + 1) * D + 256 * j + 4 * lane) * 2) + ld4bf(Xb + ((size_t)(2 * pp + 1) * D + 256 * j + 4 * lane) * 2) * DN_ALPHA; }
                ln16(y0, g, bb); ln16(y1, g, bb);
#pragma unroll
                for (int j = 0; j < 4; ++j) { st4bf(Xb + ((size_t)(2 * pp) * D + 256 * j + 4 * lane) * 2, y0[j]); st4bf(Xb + ((size_t)(2 * pp + 1) * D + 256 * j + 4 * lane) * 2, y1[j]); }
                float v[64];
#pragma unroll
                for (int e = 0; e < 32; ++e) { float s0 = 0.f, s1 = 0.f;
#pragma unroll
                    for (int j = 0; j < 4; ++j) { const f32x4 w = *(const LAS f32x4*)(WR + e * 1024 + 256 * j + 4 * lane);
                        s0 += (y0[j].x * w.x + y0[j].y * w.y) + (y0[j].z * w.z + y0[j].w * w.w); s1 += (y1[j].x * w.x + y1[j].y * w.y) + (y1[j].z * w.z + y1[j].w * w.w); }
                    v[e] = s0; v[32 + e] = s1; if ((e & 3) == 3) __builtin_amdgcn_sched_barrier(0); }
#pragma unroll
                for (int bsh = 5; bsh >= 0; --bsh) { const int n2 = 1 << bsh; const bool up = (lane >> bsh) & 1;
#pragma unroll
                    for (int i = 0; i < n2; ++i) { const float send = up ? v[i] : v[i + n2], keep = up ? v[i + n2] : v[i]; v[i] = keep + __shfl_xor(send, n2); } }
                float cur = v[0] + rbias;
                const int half = lane >> 5, el = lane & 31;
                float tv[4]; int te[4];
#pragma unroll
                for (int k = 0; k < 4; ++k) { float mx = cur;
#pragma unroll
                    for (int o = 1; o < 32; o <<= 1) mx = fmaxf(mx, __shfl_xor(mx, o));
                    const unsigned long long bal = __ballot(cur == mx); const unsigned hm = (unsigned)(bal >> (32 * half));
                    const int win = __builtin_ctz(hm); tv[k] = mx; te[k] = win; if (el == win) cur = -3.0e38f; }
                const float e1 = __expf(tv[1] - tv[0]), e2 = __expf(tv[2] - tv[0]), e3 = __expf(tv[3] - tv[0]), rs = 1.f / (1.f + e1 + e2 + e3);
                const float gt[4] = {rs, e1 * rs, e2 * rs, e3 * rs};
                const int token = 2 * pp + half;
#pragma unroll
                for (int k = 0; k < 4; ++k) if (el == te[k] && rep_ == 0) {
                    const unsigned lpos = __hip_atomic_fetch_add(LCNT + el, 1u, __ATOMIC_RELAXED, __HIP_MEMORY_SCOPE_WORKGROUP);
                    const unsigned li = __hip_atomic_fetch_add(LLEN, 1u, __ATOMIC_RELAXED, __HIP_MEMORY_SCOPE_WORKGROUP);
                    LIST[2 * li] = (unsigned)(token * 4 + k); LIST[2 * li + 1] = (unsigned)el | (lpos << 8);
                    TKE[token * 4 + k] = el; TKG[token * 4 + k] = gt[k]; }
            }
            __syncthreads();
            if (tid < 32 && rep_ == 0) GBASE[tid] = __hip_atomic_fetch_add((unsigned*)ctl + CW_CNT + (l * 32 + tid) * 64, LCNT[tid], RLX_AGENT);
            __syncthreads();
            if (rep_ == 0) { const unsigned n = LLEN[0];
                for (unsigned i = tid; i < n; i += NTHR) { const unsigned tk = LIST[2 * i], ev = LIST[2 * i + 1], e = ev & 255u, pos = GBASE[e] + (ev >> 8);
                    TKP[tk] = (int)pos; ROWTOK[(size_t)e * M + pos] = (int)(tk >> 2); } }
            __syncthreads();
        }
        SEAM(pb + 7);
        _Pragma("unroll 1") for (int rep_ = 0; rep_ < NREP(8); ++rep_) if (((PHMASK>>8)&1) && IN(pb + 8)) { PHASE_TID
            if (tid < 32) CNT[tid] = (int)__hip_atomic_load((unsigned*)ctl + CW_CNT + (l * 32 + tid) * 64, RLX_AGENT);
            __syncthreads();
            if (tid == 0) { int a = 0; for (int e = 0; e < 32; ++e) { PB[e] = a; a += (CNT[e] + 255) >> 8; } PB[32] = a; }
            __syncthreads();
            const int P = PB[32];
            const int* ROWTOK = (const int*)(ws + WS_ROWTOK);
            char* XD = (char*)(ws + WS_R1);
            for (int sb = gw * 64; sb < P * 256; sb += NGW * 64) {
                const int pm = sb >> 8; int e = 0;
#pragma unroll 1
                for (int j = 1; j < NEXP; ++j) e += (PB[j] <= pm) ? 1 : 0;
                const int pos0 = sb - PB[e] * 256, cnt = CNT[e];
                int nvalid = cnt - pos0; nvalid = nvalid > 64 ? 64 : nvalid;
                int tokv = -1; if (pos0 + lane < cnt) tokv = ROWTOK[(size_t)e * M + pos0 + lane];
#pragma unroll 1
                for (int j = 0; j < nvalid; j += 2) {
                    int t[2]; u32x4 a[2], b2[2];
#pragma unroll
                    for (int i = 0; i < 2; ++i) { t[i] = __builtin_amdgcn_readlane(tokv, j + i);
                        if (t[i] >= 0) { a[i] = *(const u32x4*)(Xb + (size_t)t[i] * 2048 + lane * 32); b2[i] = *(const u32x4*)(Xb + (size_t)t[i] * 2048 + lane * 32 + 16); } }
#pragma unroll
                    for (int i = 0; i < 2; ++i) if (t[i] >= 0) {
                        u32x4 o; o.x = pk4_f8(bflo(a[i].x) * F8_SX, bfhi(a[i].x) * F8_SX, bflo(a[i].y) * F8_SX, bfhi(a[i].y) * F8_SX); o.y = pk4_f8(bflo(a[i].z) * F8_SX, bfhi(a[i].z) * F8_SX, bflo(a[i].w) * F8_SX, bfhi(a[i].w) * F8_SX);
                        o.z = pk4_f8(bflo(b2[i].x) * F8_SX, bfhi(b2[i].x) * F8_SX, bflo(b2[i].y) * F8_SX, bfhi(b2[i].y) * F8_SX); o.w = pk4_f8(bflo(b2[i].z) * F8_SX, bfhi(b2[i].z) * F8_SX, bflo(b2[i].w) * F8_SX, bfhi(b2[i].w) * F8_SX);
                        *(u32x4*)(XD + (size_t)(sb + j + i) * 1024 + lane * 16) = o; }
                }
            }
            LAS float* scr = (LAS float*)(lds + wave * 8448);
            constexpr int IT_GU = 32 * 16 * 64, IT_DN = 32 * 16 * 32;
            for (int it = XW_SPLIT + gw; it < IT_GU + IT_DN; it += NGW) {
                if (it < IT_GU) { const int e = it >> 10, q = it & 1023, kb = q >> 6, nb = q & 63;
                    transpose_item_f8(INP(I_WGU) + (((size_t)l * 32 + e) * D + 64 * kb) * 2048 + 32 * nb, 2048, (unsigned char*)(ws + WS_WGU) + ((size_t)e * 2048 + 32 * nb) * D + 64 * kb, D, F8_SWGU, scr, lane); }
                else { const int r = it - IT_GU, e = r >> 9, q = r & 511, kb = q >> 5, nb = q & 31;
                    transpose_item_f8(INP(I_WDN) + (((size_t)l * 32 + e) * D + 64 * kb) * 1024 + 32 * nb, 1024, (unsigned char*)(ws + WS_WDN) + ((size_t)e * 1024 + 32 * nb) * D + 64 * kb, D, F8_SWDN, scr, lane); }
            }
            __syncthreads();
        }
        SEAM(pb + 8);
        if (IN(pb + 9) || IN(pb + 10)) { PHASE_TID
            if (tid < 32) CNT[tid] = (int)__hip_atomic_load((unsigned*)ctl + CW_CNT + (l * 32 + tid) * 64, RLX_AGENT);
            __syncthreads();
            if (tid == 0) { int a = 0; for (int e = 0; e < 32; ++e) { PB[e] = a; a += (CNT[e] + 255) >> 8; } PB[32] = a; }
            __syncthreads();
        }
        _Pragma("unroll 1") for (int rep_ = 0; rep_ < NREP(9); ++rep_) if (((PHMASK>>9)&1) && IN(pb + 9)) {
            SchedMoe S; S.T.init(PB[32], 8); S.G = G; S.c = bx; S.A = (const char*)(ws + WS_R1); S.W = (const char*)(ws + WS_WGU); S.C = (char*)(ws + WS_R2 + R2_HMID); S.PB = PB; S.wrows = 2048; S.ldc = 1024; S.cdiv = 2; S.osz = 1;
            pg8::EpiMoe1 E; E.bgu = INP(I_BGU) + (size_t)l * 32 * 2048;
            pg8::gemm_phase<true>(lds, D, D, D, S, E, wave);
        }
        SEAM(pb + 9);
        _Pragma("unroll 1") for (int rep_ = 0; rep_ < NREP(10); ++rep_) if (((PHMASK>>10)&1) && IN(pb + 10)) {
            SchedMoe S; S.T.init(PB[32], 4); S.G = G; S.c = bx; S.A = (const char*)(ws + WS_R2 + R2_HMID); S.W = (const char*)(ws + WS_WDN); S.C = (char*)(ws + WS_R1); S.PB = PB; S.wrows = 1024; S.ldc = 1024; S.cdiv = 1; S.osz = 2;
            pg8::EpiMoe2 E; E.bdn = INP(I_BDN) + (size_t)l * 32 * 1024;
            pg8::gemm_phase<true>(lds, D, D, D, S, E, wave);
        }
        SEAM(pb + 10);
        _Pragma("unroll 1") for (int rep_ = 0; rep_ < NREP(11); ++rep_) if (((PHMASK>>11)&1) && IN(pb + 11)) { PHASE_TID
            if (tid < 32) CNT[tid] = (int)__hip_atomic_load((unsigned*)ctl + CW_CNT + (l * 32 + tid) * 64, RLX_AGENT);
            LAS float* wgt = (LAS float*)(lds + 73728);
            const bool lastl = (l == DEPTH - 1);
            if (!lastl) load_gate_table(wgt, INP(I_WIN) + (size_t)(l + 1) * D * DIN, tid);
            __syncthreads();
            if (tid == 0) { int a = 0; for (int e = 0; e < 32; ++e) { PB[e] = a; a += (CNT[e] + 255) >> 8; } PB[32] = a; }
            __syncthreads();
            const int e0 = 8 * lane;
            f32x4 g[4], bb[4];
#pragma unroll
            for (int j = 0; j < 4; ++j) { const int o = (j >> 1) * 512 + e0 + (j & 1) * 4; g[j] = *(const f32x4*)(INP(I_LN2G) + l * D + o); bb[j] = *(const f32x4*)(INP(I_LN2B) + l * D + o); }
            const char* YA = (const char*)(ws + WS_R1);
            const bool dummy_ = (rep_ + 1 < NREP(11)); char* const Xo = dummy_ ? (char*)(ws + WS_R2) : Xb; float* const Fo = dummy_ ? (float*)(ws + WS_R2 + 256 * MiB) : args.out; float* const Go = dummy_ ? (float*)(ws + WS_R2 + 200 * MiB) : GIF;
            const int* TKE = (const int*)(ws + WS_TKE); const float* TKG = (const float*)(ws + WS_TKG); const int* TKP = (const int*)(ws + WS_TKP);
#pragma unroll 1
            for (int mb = gw * 16; mb < M; mb += NGW * 16) {
                const int ev = TKE[mb * 4 + lane], pv = TKP[mb * 4 + lane]; const float gv = TKG[mb * 4 + lane];
                const int rowv = PB[ev] * 256 + pv;
#pragma unroll 1
                for (int ti = 0; ti < 16; ti += 2) {
                    u32x4 xw[2][2], yw[2][4][2]; float gk[2][4];
#pragma unroll
                    for (int q = 0; q < 2; ++q) { const size_t m = (size_t)mb + ti + q;
                        xw[q][0] = *(const u32x4*)(Xb + (m * D + e0) * 2); xw[q][1] = *(const u32x4*)(Xb + (m * D + 512 + e0) * 2);
#pragma unroll
                        for (int k = 0; k < 4; ++k) { const size_t row = (size_t)__builtin_amdgcn_readlane(rowv, 4 * (ti + q) + k);
                            gk[q][k] = __builtin_bit_cast(float, __builtin_amdgcn_readlane(__builtin_bit_cast(int, gv), 4 * (ti + q) + k));
                            yw[q][k][0] = *(const u32x4*)(YA + (row * D + e0) * 2); yw[q][k][1] = *(const u32x4*)(YA + (row * D + 512 + e0) * 2); } }
#pragma unroll
                    for (int q = 0; q < 2; ++q) { const size_t m = (size_t)mb + ti + q;
                        f32x4 v[4];
#pragma unroll
                        for (int hh = 0; hh < 2; ++hh) { const u32x4 w = xw[q][hh];
                            v[2 * hh] = (f32x4){bflo(w.x), bfhi(w.x), bflo(w.y), bfhi(w.y)} * DN_ALPHA; v[2 * hh + 1] = (f32x4){bflo(w.z), bfhi(w.z), bflo(w.w), bfhi(w.w)} * DN_ALPHA; }
#pragma unroll
                        for (int k = 0; k < 4; ++k)
#pragma unroll
                            for (int hh = 0; hh < 2; ++hh) { const u32x4 w = yw[q][k][hh];
                                v[2 * hh] = v[2 * hh] + (f32x4){bflo(w.x), bfhi(w.x), bflo(w.y), bfhi(w.y)} * gk[q][k]; v[2 * hh + 1] = v[2 * hh + 1] + (f32x4){bflo(w.z), bfhi(w.z), bflo(w.w), bfhi(w.w)} * gk[q][k]; }
                        ln16(v, g, bb);
                        if (lastl) {
#pragma unroll
                            for (int j = 0; j < 4; ++j) *(f32x4*)(Fo + m * D + (j >> 1) * 512 + e0 + (j & 1) * 4) = v[j];
                        } else {
#pragma unroll
                            for (int hh = 0; hh < 2; ++hh) { *(u32x4*)(Xo + (m * D + hh * 512 + e0) * 2) = pg8::pack8(v[2 * hh], v[2 * hh + 1]);
                                u32x2 f8w; f8w.x = pk4_f8(v[2 * hh].x * F8_SX, v[2 * hh].y * F8_SX, v[2 * hh].z * F8_SX, v[2 * hh].w * F8_SX); f8w.y = pk4_f8(v[2 * hh + 1].x * F8_SX, v[2 * hh + 1].y * F8_SX, v[2 * hh + 1].z * F8_SX, v[2 * hh + 1].w * F8_SX);
                                if (!dummy_) *(u32x2*)((char*)(ws + WS_XF8) + m * D + hh * 512 + e0) = f8w; }
                            gates8b(v, wgt, Go + m * 8, lane);
                        }
                    }
                }
            }
            __syncthreads();
        }
        SEAM(pb + 11);
    }
#undef IN
#undef SEAM
}

extern "C" void kernel_launch(void* const* d_in, const int* in_sizes, int n_in, void* d_out, int out_size, void* d_ws, size_t ws_size, hipStream_t stream) {
    static int grid = 0;
    if (grid == 0) {
        if (n_in != N_IN || out_size != M * D || ws_size < WS_END) { fprintf(stderr, "kernel_launch: unexpected shapes (n_in %d, out %d, ws %zu)\n", n_in, out_size, ws_size); grid = -1; return; }
        int dev = 0, cus = 0, per_cu = 0;
        if (hipGetDevice(&dev) != hipSuccess || hipDeviceGetAttribute(&cus, hipDeviceAttributeMultiprocessorCount, dev) != hipSuccess) { grid = -1; return; }
        if (hipFuncSetAttribute((const void*)fwd_kernel, hipFuncAttributeMaxDynamicSharedMemorySize, LDS_BYTES) != hipSuccess) { fprintf(stderr, "kernel_launch: hipFuncSetAttribute failed\n"); grid = -1; return; }
        if (hipOccupancyMaxActiveBlocksPerMultiprocessor(&per_cu, (const void*)fwd_kernel, NTHR, LDS_BYTES) != hipSuccess || per_cu < 1) fprintf(stderr, "kernel_launch: occupancy query reports %d\n", per_cu);
        (void)hipGetLastError();
        grid = cus;
    }
    if (grid < 0) return;
    (void)hipMemsetAsync((char*)d_ws + WS_CTL, 0, CTL_ZERO_BYTES, stream);
    Args a{};
    for (int i = 0; i < N_IN; ++i) a.in[i] = (const float*)d_in[i];
    a.out = (float*)d_out; a.ws = (unsigned char*)d_ws;
#if MK_ONE_LAUNCH
    a.ph_lo = 0; a.ph_hi = NPH;
    hipLaunchKernelGGL(fwd_kernel, dim3(grid), dim3(NTHR), LDS_BYTES, stream, a);
#else
    for (int p = 0; p < NPH; ++p) { a.ph_lo = p; a.ph_hi = p + 1; hipLaunchKernelGGL(fwd_kernel, dim3(grid), dim3(NTHR), LDS_BYTES, stream, a); }
#endif
    const hipError_t le = hipPeekAtLastError();
    if (le != hipSuccess) fprintf(stderr, "kernel_launch: launch failed: %s\n", hipGetErrorName(le));
}
```

```cpp
#include <hip/hip_runtime.h>
#include <cstdio>
#include <cstdint>

#ifndef MK_ONE_LAUNCH
#define MK_ONE_LAUNCH 1
#endif

#define LAS __attribute__((address_space(3)))
#define GAS __attribute__((address_space(1)))
typedef unsigned short bf16;
typedef short bf16x8 __attribute__((ext_vector_type(8)));
typedef float f32x4 __attribute__((ext_vector_type(4)));
typedef float f32x2 __attribute__((ext_vector_type(2)));
typedef float f32x16 __attribute__((ext_vector_type(16)));
typedef unsigned u32x4 __attribute__((ext_vector_type(4)));
typedef unsigned u32x2 __attribute__((ext_vector_type(2)));
typedef __bf16 bf16x2_t __attribute__((ext_vector_type(2)));
typedef GAS unsigned gu32;
#define RLX_AGENT __ATOMIC_RELAXED, __HIP_MEMORY_SCOPE_AGENT
#define DI __device__ __forceinline__

constexpr int NWAVES = 8, NTHR = 512;
constexpr int D = 1024, BATCH = 16, SEQ = 4096, M = BATCH * SEQ, DEPTH = 2, MEML = 256, MROWS = BATCH * MEML;
constexpr int DIN = 6920, NU = 6912;
constexpr int UC_QK = 0, UC_V = 512, UC_OG = 1024, UC_RW = 1536, UC_CAQ = 3328, UC_GATE = 3840;
constexpr int NEXP = 32, TOPK = 4;
constexpr int PMAX = M * TOPK / 256 + NEXP;
constexpr float LN_EPS = 1e-5f, RW_GN_EPS = 64e-5f, DN_ALPHA = 1.41421356237f;

enum { I_X = 0, I_MEM, I_LNIN_G, I_LNIN_B, I_MEMLN_G, I_MEMLN_B, I_WIN, I_CONVW, I_CONVB, I_IGB, I_FGB, I_MLNORMG, I_RWMU, I_RWW0, I_RWWUP, I_RWA0, I_RWAUP, I_RWGUP,
       I_RWKK, I_RWKA, I_RWRK, I_RWLNG, I_RWLNB, I_CAWKV, I_GATEB, I_WBRML, I_WBRRW, I_WBRCA, I_WO, I_LN1G, I_LN1B, I_RTW, I_RTB, I_WGU, I_BGU, I_WDN, I_BDN, I_LN2G, I_LN2B, N_IN };

constexpr size_t MiB = 1u << 20;
constexpr size_t WS_CTL = 0, CTL_ZERO_BYTES = 1 * MiB;
constexpr size_t WS_WIN = 1 * MiB;
constexpr size_t WS_WKV = 28 * MiB;
constexpr size_t WS_WBR = 32 * MiB;
constexpr size_t WS_WO = 38 * MiB;
constexpr size_t WS_WLORA = 42 * MiB;
constexpr size_t WS_WGU = 45 * MiB;
constexpr size_t WS_WDN = 173 * MiB;
constexpr size_t WS_X = 237 * MiB;
constexpr size_t WS_MEMN = 365 * MiB;
constexpr size_t WS_KV = 373 * MiB;
constexpr size_t WS_GIF = 389 * MiB;
constexpr size_t WS_TKE = 391 * MiB, WS_TKG = 392 * MiB, WS_TKP = 393 * MiB;
constexpr size_t WS_ROWTOK = 394 * MiB;
constexpr size_t WS_HML = 402 * MiB;
constexpr size_t WS_R1 = 466 * MiB;
constexpr size_t WS_R2 = 1330 * MiB;
constexpr size_t WS_XF8 = 1858 * MiB;
constexpr size_t WS_WING8 = 1922 * MiB;
constexpr size_t WS_END = 1930 * MiB;
constexpr size_t R2_LORA_OUT = 0, R2_HCAT = 192 * MiB, R2_LORA_IN = 384 * MiB, R2_YPRE = 0, R2_Z = 192 * MiB, R2_HMID = 0;
constexpr int CW_TMO = 0, CW_BAR = 4096, CW_CNT = 16384;

constexpr int LDS_BYTES = 155648;
constexpr int LDSCTL_OFF = 153600;

DI unsigned f2bf(float f) { unsigned u = __builtin_bit_cast(unsigned, f); return (u + 0x7fffu + ((u >> 16) & 1u)) >> 16; }
DI unsigned pk2(float lo, float hi) { bf16x2_t b = __builtin_convertvector((f32x2){lo, hi}, bf16x2_t); return __builtin_bit_cast(unsigned, b); }
DI float bflo(unsigned u) { return __builtin_bit_cast(float, u << 16); }
DI float bfhi(unsigned u) { return __builtin_bit_cast(float, u & 0xffff0000u); }
DI unsigned pk4_f8(float a, float b, float c, float d) {
    a = __builtin_amdgcn_fmed3f(a, -448.f, 448.f); b = __builtin_amdgcn_fmed3f(b, -448.f, 448.f); c = __builtin_amdgcn_fmed3f(c, -448.f, 448.f); d = __builtin_amdgcn_fmed3f(d, -448.f, 448.f);
    int w = 0; w = __builtin_amdgcn_cvt_pk_fp8_f32(a, b, w, false); w = __builtin_amdgcn_cvt_pk_fp8_f32(c, d, w, true); return (unsigned)w; }
DI float sigmoidf_(float x) { return __builtin_amdgcn_rcpf(1.f + __builtin_amdgcn_exp2f(-1.4426950408889634f * x)); }
template <int CTRL> DI float dppf(float x) { return __builtin_bit_cast(float, __builtin_amdgcn_update_dpp(0, __builtin_bit_cast(int, x), CTRL, 0xF, 0xF, true)); }
DI float red4(float x) { x += dppf<0xB1>(x); x += dppf<0x4E>(x); return x; }
DI float red8(float x) { x = red4(x); x += dppf<0x141>(x); return x; }
DI float red16(float x) { x = red8(x); x += dppf<0x140>(x); return x; }
DI float red8o(float x) { x += dppf<0xB1>(x); asm("" : "+v"(x)); x += dppf<0x4E>(x); asm("" : "+v"(x)); x += dppf<0x141>(x); asm("" : "+v"(x)); return x; }
DI float red16o(float x) { x = red8o(x); x += dppf<0x140>(x); asm("" : "+v"(x)); return x; }
DI float wave_sum(float v) {
    v = red16(v);
    const int vi = __builtin_bit_cast(int, v);
    const float a = __builtin_bit_cast(float, __builtin_amdgcn_readlane(vi, 0)), b = __builtin_bit_cast(float, __builtin_amdgcn_readlane(vi, 16));
    const float c = __builtin_bit_cast(float, __builtin_amdgcn_readlane(vi, 32)), d = __builtin_bit_cast(float, __builtin_amdgcn_readlane(vi, 48));
    return (a + b) + (c + d);
}
#define LDS_WAIT() asm volatile("s_waitcnt lgkmcnt(0)" ::: "memory")

constexpr float F8_SX = 8.f, F8_SWGU = 512.f, F8_SH = 4.f, F8_SWDN = 1024.f, F8_INV1 = 1.f / (F8_SX * F8_SWGU), F8_INV2 = 1.f / (F8_SH * F8_SWDN);
namespace pg8 {
constexpr int BM = 256, BK = 64, HALF = 128, HTB = HALF * BK * 2, STAGE_BYTES = 8 * HTB, NXCD = 8, WGM = 8;
__host__ __device__ __forceinline__ int lds_byte(int r, int c) { const int st = (r >> 4) * 2 + (c >> 5), rr = r & 15, cc = c & 31, ob = rr * 64 + cc * 2; return st * 1024 + (ob ^ (((ob >> 9) & 1) << 5)); }
__host__ __device__ __forceinline__ void stage_rc(int b, int& R, int& C) { const int st = b / 1024, sb = b % 1024, swz = sb ^ (((sb >> 9) & 1) << 5); R = (st >> 1) * 16 + swz / 64; C = (st & 1) * 32 + (swz % 64) / 2; }
__host__ __device__ __forceinline__ int perm32(int rho) { const int n = rho >> 4, i = rho & 15; return 8 * (i >> 2) + 4 * n + (i & 3); }

struct Unit { const char* a; const char* b; char* c; int ldc; int r0, c0, e, sub; };

struct TileOrder {
    int nM, nN, nwg;
    DI void init(int nM_, int nN_) { nM = nM_; nN = nN_; nwg = nM * nN; }
    DI bool tile(long L, int& pm, int& pn) const {
        if (L >= nwg) return false;
        int wgid = (int)L; { const int q = nwg / NXCD, r = nwg % NXCD, xcd = wgid % NXCD, off = wgid / NXCD; wgid = (xcd < r ? xcd * (q + 1) : r * (q + 1) + (xcd - r) * q) + off; }
        const int nig = WGM * nN, gid = wgid / nig, fm = gid * WGM, gsz = (nM - fm) < WGM ? (nM - fm) : WGM;
        pm = fm + ((wgid % nig) % gsz); pn = (wgid % nig) / gsz; return true;
    }
};

DI u32x4 pack8(const f32x4& v0, const f32x4& v1) { u32x4 w; w.x = pk2(v0[0], v0[1]); w.y = pk2(v0[2], v0[3]); w.z = pk2(v1[0], v1[1]); w.w = pk2(v1[2], v1[3]); return w; }

struct EpiStore {
    DI void operator()(const f32x4 (&acc)[2][2][4][2], const Unit& u, int wr, int wc, int fr, int fq) const {
#pragma unroll
        for (int ai = 0; ai < 2; ++ai)
#pragma unroll
            for (int m = 0; m < 4; ++m) { char* rowp = u.c + ((size_t)(ai * HALF + wr * 64 + m * 16 + fr) * u.ldc + wc * 32 + 8 * fq) * 2;
#pragma unroll
                for (int bj = 0; bj < 2; ++bj) *(u32x4*)(rowp + bj * 256) = pack8(acc[ai][bj][m][0], acc[ai][bj][m][1]); }
    }
};
struct EpiStoreS {
    float s;
    DI void operator()(const f32x4 (&acc)[2][2][4][2], const Unit& u, int wr, int wc, int fr, int fq) const {
#pragma unroll
        for (int ai = 0; ai < 2; ++ai)
#pragma unroll
            for (int m = 0; m < 4; ++m) { char* rowp = u.c + ((size_t)(ai * HALF + wr * 64 + m * 16 + fr) * u.ldc + wc * 32 + 8 * fq) * 2;
#pragma unroll
                for (int bj = 0; bj < 2; ++bj) *(u32x4*)(rowp + bj * 256) = pack8(acc[ai][bj][m][0] * s, acc[ai][bj][m][1] * s); }
    }
};
struct EpiMerge {
    static constexpr bool MIDK = true;
    const char* U; const float* gate_b;
    DI void mid(f32x4 (&acc)[2][2][4][2], const Unit& u, int which, int wr, int wc, int fr, int fq) const {
        const float L2E = 1.4426950408889634f;
#pragma unroll
        for (int bj = 0; bj < 2; ++bj) {
            const float* g = gate_b + which * 1024 + u.c0 + bj * HALF + wc * 32 + 8 * fq;
            const f32x4 ga0 = *(const f32x4*)g, ga1 = *(const f32x4*)(g + 4), gn0 = *(const f32x4*)(g + 1024), gn1 = *(const f32x4*)(g + 1028);
            const float gaa[8] = {ga0.x, ga0.y, ga0.z, ga0.w, ga1.x, ga1.y, ga1.z, ga1.w}, gnn[8] = {gn0.x, gn0.y, gn0.z, gn0.w, gn1.x, gn1.y, gn1.z, gn1.w};
#pragma unroll
            for (int ai = 0; ai < 2; ++ai)
#pragma unroll
                for (int m = 0; m < 4; ++m) { const int lr = ai * HALF + wr * 64 + m * 16 + fr;
                    const char* gp = U + ((size_t)(u.r0 + lr) * NU + UC_GATE + which * 1024 + u.c0 + wc * 32 + 8 * fq) * 2 + bj * 256;
                    const u32x4 wa = *(const u32x4*)gp, wn = *(const u32x4*)(gp + 2048);
                    const float xa[8] = {bflo(wa.x), bfhi(wa.x), bflo(wa.y), bfhi(wa.y), bflo(wa.z), bfhi(wa.z), bflo(wa.w), bfhi(wa.w)};
                    const float xn[8] = {bflo(wn.x), bfhi(wn.x), bflo(wn.y), bfhi(wn.y), bflo(wn.z), bfhi(wn.z), bflo(wn.w), bfhi(wn.w)};
#pragma unroll
                    for (int i = 0; i < 8; ++i) { const float ea = __builtin_amdgcn_exp2f(-L2E * __builtin_amdgcn_fmed3f(xa[i] + gaa[i], -30.f, 30.f)), en = __builtin_amdgcn_exp2f(-L2E * __builtin_amdgcn_fmed3f(xn[i] + gnn[i], -30.f, 30.f));
                        acc[ai][bj][m][i >> 2][i & 3] *= (1.f + en) * __builtin_amdgcn_rcpf(1.f + ea); }
                    if (m & 1) asm volatile("" ::: "memory"); }
        }
    }
    DI void operator()(const f32x4 (&acc)[2][2][4][2], const Unit& u, int wr, int wc, int fr, int fq) const {
        f32x4 gb[2][2];
#pragma unroll
        for (int bj = 0; bj < 2; ++bj) { const float* g = gate_b + 2048 + u.c0 + bj * HALF + wc * 32 + 8 * fq; gb[bj][0] = *(const f32x4*)g; gb[bj][1] = *(const f32x4*)(g + 4); }
#pragma unroll
        for (int ai = 0; ai < 2; ++ai)
#pragma unroll
            for (int m = 0; m < 4; ++m) { const int lr = ai * HALF + wr * 64 + m * 16 + fr; char* rowp = u.c + ((size_t)lr * u.ldc + wc * 32 + 8 * fq) * 2;
                const char* gp = U + ((size_t)(u.r0 + lr) * NU + UC_GATE + 2048 + u.c0 + wc * 32 + 8 * fq) * 2;
#pragma unroll
                for (int bj = 0; bj < 2; ++bj) { const u32x4 gw = *(const u32x4*)(gp + bj * 256);
                    f32x4 v0 = acc[ai][bj][m][0], v1 = acc[ai][bj][m][1];
                    v0[0] *= sigmoidf_(bflo(gw.x) + gb[bj][0][0]); v0[1] *= sigmoidf_(bfhi(gw.x) + gb[bj][0][1]); v0[2] *= sigmoidf_(bflo(gw.y) + gb[bj][0][2]); v0[3] *= sigmoidf_(bfhi(gw.y) + gb[bj][0][3]);
                    v1[0] *= sigmoidf_(bflo(gw.z) + gb[bj][1][0]); v1[1] *= sigmoidf_(bfhi(gw.z) + gb[bj][1][1]); v1[2] *= sigmoidf_(bflo(gw.w) + gb[bj][1][2]); v1[3] *= sigmoidf_(bfhi(gw.w) + gb[bj][1][3]);
                    *(u32x4*)(rowp + bj * 256) = pack8(v0, v1); }
                asm volatile("" ::: "memory"); }
    }
};
struct EpiWo {
    const char* X;
    DI void operator()(const f32x4 (&acc)[2][2][4][2], const Unit& u, int wr, int wc, int fr, int fq) const {
#pragma unroll
        for (int ai = 0; ai < 2; ++ai)
#pragma unroll
            for (int m = 0; m < 4; ++m) { const int lr = ai * HALF + wr * 64 + m * 16 + fr; char* rowp = u.c + ((size_t)lr * u.ldc + wc * 32 + 8 * fq) * 2;
                const char* xp = X + ((size_t)(u.r0 + lr) * D + u.c0 + wc * 32 + 8 * fq) * 2;
#pragma unroll
                for (int bj = 0; bj < 2; ++bj) { const u32x4 xw = *(const u32x4*)(xp + bj * 256);
                    f32x4 v0 = acc[ai][bj][m][0], v1 = acc[ai][bj][m][1];
                    v0[0] += DN_ALPHA * bflo(xw.x); v0[1] += DN_ALPHA * bfhi(xw.x); v0[2] += DN_ALPHA * bflo(xw.y); v0[3] += DN_ALPHA * bfhi(xw.y);
                    v1[0] += DN_ALPHA * bflo(xw.z); v1[1] += DN_ALPHA * bfhi(xw.z); v1[2] += DN_ALPHA * bflo(xw.w); v1[3] += DN_ALPHA * bfhi(xw.w);
                    *(u32x4*)(rowp + bj * 256) = pack8(v0, v1); }
                asm volatile("" ::: "memory"); }
    }
};
DI float swiglu1(float a, float b) { const float g = fminf(a, 7.f), l = fminf(fmaxf(b, -7.f), 7.f); return g * sigmoidf_(1.702f * g) * (l + 1.f); }
struct EpiMoe1 {
    const float* bgu;
    DI void operator()(const f32x4 (&acc)[2][2][4][2], const Unit& u, int wr, int wc, int fr, int fq) const {
        f32x4 bv[2][2];
#pragma unroll
        for (int bj = 0; bj < 2; ++bj) { const float* b = bgu + u.e * 2048 + u.c0 + bj * HALF + wc * 32 + 8 * fq; bv[bj][0] = *(const f32x4*)b; bv[bj][1] = *(const f32x4*)(b + 4); }
#pragma unroll
        for (int ai = 0; ai < 2; ++ai)
#pragma unroll
            for (int m = 0; m < 4; ++m) { const int lr = ai * HALF + wr * 64 + m * 16 + fr; char* rowp = u.c + ((size_t)lr * u.ldc + wc * 16 + 4 * fq);
#pragma unroll
                for (int bj = 0; bj < 2; ++bj) { const f32x4 v0 = acc[ai][bj][m][0] * F8_INV1 + bv[bj][0], v1 = acc[ai][bj][m][1] * F8_INV1 + bv[bj][1];
                    *(unsigned*)(rowp + bj * 64) = pk4_f8(swiglu1(v0[0], v0[1]) * F8_SH, swiglu1(v0[2], v0[3]) * F8_SH, swiglu1(v1[0], v1[1]) * F8_SH, swiglu1(v1[2], v1[3]) * F8_SH); } }
    }
};
struct EpiMoe2 {
    const float* bdn;
    DI void operator()(const f32x4 (&acc)[2][2][4][2], const Unit& u, int wr, int wc, int fr, int fq) const {
        f32x4 bv[2][2];
#pragma unroll
        for (int bj = 0; bj < 2; ++bj) { const float* b = bdn + u.e * 1024 + u.c0 + bj * HALF + wc * 32 + 8 * fq; bv[bj][0] = *(const f32x4*)b; bv[bj][1] = *(const f32x4*)(b + 4); }
#pragma unroll
        for (int ai = 0; ai < 2; ++ai)
#pragma unroll
            for (int m = 0; m < 4; ++m) { char* rowp = u.c + ((size_t)(ai * HALF + wr * 64 + m * 16 + fr) * u.ldc + wc * 32 + 8 * fq) * 2;
#pragma unroll
                for (int bj = 0; bj < 2; ++bj) *(u32x4*)(rowp + bj * 256) = pack8(acc[ai][bj][m][0] * F8_INV2 + bv[bj][0], acc[ai][bj][m][1] * F8_INV2 + bv[bj][1]); }
    }
};

typedef int i32x8 __attribute__((ext_vector_type(8)));
typedef int i32x4 __attribute__((ext_vector_type(4)));
template <bool F8, bool MIDK = false, class Epi, class Sched>
DI void gemm_phase(LAS unsigned char* lds, const int KB  , const int ldaB, const int ldbB, const Sched& S, const Epi& E, const int wave_) {
    unsigned z_ = 0u; asm volatile("" : "+v"(z_)); const int tid = wave_ * 64 + (int)__builtin_amdgcn_mbcnt_hi(~0u, __builtin_amdgcn_mbcnt_lo(~0u, z_));
    const int wid = __builtin_amdgcn_readfirstlane(tid >> 6), lane = tid & 63, wr = wid >> 2, wc = wid & 3, fr = lane & 15, fq = lane >> 4;
    const int nt = KB / (BK * 2);
    unsigned voffA[2], voffB[2];
#pragma unroll
    for (int i = 0; i < 2; ++i) { int R, C; stage_rc(tid * 16 + i * 8192, R, C); const int Rb = (R & ~31) + perm32(R & 31);
        voffA[i] = (unsigned)(R * ldaB + C * 2); voffB[i] = (unsigned)(Rb * ldbB + C * 2); }
    asm volatile("" : "+v"(voffA[0]), "+v"(voffA[1]), "+v"(voffB[0]), "+v"(voffB[1]));
    const size_t kstep = (size_t)(BK * 2);
    const size_t hstepA = (size_t)HALF * ldaB, hstepB = (size_t)HALF * ldbB;
    const unsigned ldsw = (unsigned)wid * 1024u;
    const int aoff = lds_byte(wr * 64 + fr, fq * 8), boff = lds_byte(wc * 32 + fr, fq * 8);
#define PG8_SA(b, h) (((b) * 2 + (h)) * HTB)
#define PG8_SB(b, h) ((4 + (b) * 2 + (h)) * HTB)
#define PG8_STAGE(bufoff, gbase, voff) do { _Pragma("unroll") for (int _i = 0; _i < 2; ++_i) \
        __builtin_amdgcn_global_load_lds((const unsigned*)((const char*)(gbase) + (voff)[_i]), (LAS unsigned*)(lds + (bufoff) + ldsw + _i * 8192), 16, 0, 0); } while (0)
#define PG8_LD8(p) __builtin_shufflevector(*(const LAS i32x4*)(p), *(const LAS i32x4*)((p) + 1024), 0, 1, 2, 3, 4, 5, 6, 7)
#define PG8_LDA8(dst, b, h) do { _Pragma("unroll") for (int m = 0; m < 4; ++m) dst[m] = PG8_LD8(lds + PG8_SA(b, h) + aoff + m * 2048); } while (0)
#define PG8_LDB8(dst, b, h) do { _Pragma("unroll") for (int n = 0; n < 2; ++n) dst[n] = PG8_LD8(lds + PG8_SB(b, h) + boff + n * 2048); } while (0)
#define PG8_MMA8(ai, bj, A8, B8) do { __builtin_amdgcn_s_setprio(1); _Pragma("unroll") for (int m = 0; m < 4; ++m) _Pragma("unroll") for (int n = 0; n < 2; ++n) \
        asm volatile("v_mfma_f32_16x16x128_f8f6f4 %0, %1, %2, %0" : "+v"(acc[ai][bj][m][n]) : "v"(B8[n]), "v"(A8[m])); __builtin_amdgcn_s_setprio(0); } while (0)
#define PG8_LDA(dst, b, h) do { _Pragma("unroll") for (int m = 0; m < 4; ++m) _Pragma("unroll") for (int k = 0; k < 2; ++k) dst[m][k] = *(const LAS bf16x8*)(lds + PG8_SA(b, h) + aoff + m * 2048 + k * 1024); } while (0)
#define PG8_LDB(dst, b, h) do { _Pragma("unroll") for (int n = 0; n < 2; ++n) _Pragma("unroll") for (int k = 0; k < 2; ++k) dst[n][k] = *(const LAS bf16x8*)(lds + PG8_SB(b, h) + boff + n * 2048 + k * 1024); } while (0)
#define PG8_CAT(x) __builtin_shufflevector(__builtin_bit_cast(i32x4, (x)[0]), __builtin_bit_cast(i32x4, (x)[1]), 0, 1, 2, 3, 4, 5, 6, 7)
#define PG8_MMA(ai, bj, At, Bt) do { __builtin_amdgcn_s_setprio(1); _Pragma("unroll") for (int m = 0; m < 4; ++m) _Pragma("unroll") for (int n = 0; n < 2; ++n) _Pragma("unroll") for (int k = 0; k < 2; ++k) \
        acc[ai][bj][m][n] = __builtin_amdgcn_mfma_f32_16x16x32_bf16(Bt[n][k], At[m][k], acc[ai][bj][m][n], 0, 0, 0); __builtin_amdgcn_s_setprio(0); } while (0)
#define PG8_WAIT_V(n) asm volatile("s_waitcnt vmcnt(" #n ")" ::: "memory")
#define PG8_WAIT_L(n) asm volatile("s_waitcnt lgkmcnt(" #n ")" ::: "memory")
#define PG8_BAR __builtin_amdgcn_s_barrier()
#define PG8_SCHED __builtin_amdgcn_sched_barrier(0)
    Unit cur, nxt; int ui = 0;
    if (!S.next(0, cur)) return;
    f32x4 acc[2][2][4][2];
#pragma unroll
    for (int a = 0; a < 2; ++a)
#pragma unroll
        for (int b = 0; b < 2; ++b)
#pragma unroll
            for (int m = 0; m < 4; ++m)
#pragma unroll
                for (int n = 0; n < 2; ++n) acc[a][b][m][n] = (f32x4){0.f, 0.f, 0.f, 0.f};
    bf16x8 At[4][2], B0[2][2], B1[2][2]; i32x8 A8[4], B80[2], B81[2];
    const char* cA = cur.a; const char* cB = cur.b;
    PG8_STAGE(PG8_SB(0, 0), cB, voffB); PG8_STAGE(PG8_SB(0, 1), cB + hstepB, voffB); PG8_STAGE(PG8_SA(0, 0), cA, voffA); PG8_STAGE(PG8_SA(0, 1), cA + hstepA, voffA);
    if (wr == 1) PG8_BAR;
    PG8_WAIT_V(2); PG8_BAR;
    PG8_STAGE(PG8_SB(1, 0), cB + kstep, voffB); PG8_STAGE(PG8_SA(1, 0), cA + kstep, voffA); PG8_STAGE(PG8_SB(1, 1), cB + hstepB + kstep, voffB);
    PG8_WAIT_V(6); PG8_BAR;
    for (;;) {
        const bool has_next = S.next(ui + 1, nxt);
        const char* nA = has_next ? nxt.a : cA; const char* nB = has_next ? nxt.b : cB;
#pragma unroll 1
        for (int t = 0; t < nt; t += 2) {
            if constexpr (MIDK) { if (t == 8 || t == 16) { int fr_ = fr, fq_ = fq; asm volatile("" : "+v"(fr_), "+v"(fq_)); E.mid(acc, cur, t >> 4, wr, wc, fr_, fq_); } }
            const bool last = (t == nt - 2);
            const char* a1 = cA + (size_t)(t + 1) * kstep;
            const char* a2 = last ? nA : cA + (size_t)(t + 2) * kstep; const char* b2 = last ? nB : cB + (size_t)(t + 2) * kstep;
            const char* a3 = a2 + kstep; const char* b3 = b2 + kstep;
            if constexpr (F8) {
            PG8_LDB8(B80, 0, 0); PG8_LDB8(B81, 0, 1); PG8_SCHED; PG8_LDA8(A8, 0, 0); PG8_STAGE(PG8_SA(1, 1), a1 + hstepA, voffA);
            PG8_WAIT_V(8); PG8_WAIT_L(0); PG8_BAR; PG8_MMA8(0, 0, A8, B80); PG8_MMA8(0, 1, A8, B81); PG8_BAR; PG8_SCHED;
            PG8_LDA8(A8, 0, 1); PG8_STAGE(PG8_SB(0, 0), b2, voffB); PG8_STAGE(PG8_SB(0, 1), b2 + hstepB, voffB); PG8_STAGE(PG8_SA(0, 0), a2, voffA);
            PG8_WAIT_V(8); PG8_WAIT_L(0); PG8_BAR; PG8_MMA8(1, 0, A8, B80); PG8_MMA8(1, 1, A8, B81); PG8_BAR; PG8_SCHED;
            PG8_LDB8(B80, 1, 0); PG8_LDB8(B81, 1, 1); PG8_SCHED; PG8_LDA8(A8, 1, 0); PG8_STAGE(PG8_SA(0, 1), a2 + hstepA, voffA);
            PG8_WAIT_V(8); PG8_WAIT_L(0); PG8_BAR; PG8_MMA8(0, 0, A8, B80); PG8_MMA8(0, 1, A8, B81); PG8_BAR; PG8_SCHED;
            PG8_LDA8(A8, 1, 1); PG8_STAGE(PG8_SB(1, 0), b3, voffB); PG8_STAGE(PG8_SB(1, 1), b3 + hstepB, voffB); PG8_STAGE(PG8_SA(1, 0), a3, voffA);
            PG8_WAIT_V(8); PG8_WAIT_L(0); PG8_BAR; PG8_MMA8(1, 0, A8, B80); PG8_MMA8(1, 1, A8, B81); PG8_BAR; PG8_SCHED;
            } else {
            PG8_LDB(B0, 0, 0); PG8_LDB(B1, 0, 1); PG8_SCHED; PG8_LDA(At, 0, 0); PG8_STAGE(PG8_SA(1, 1), a1 + hstepA, voffA);
            PG8_WAIT_V(8); PG8_WAIT_L(0); PG8_BAR; PG8_MMA(0, 0, At, B0); PG8_MMA(0, 1, At, B1); PG8_BAR; PG8_SCHED;
            PG8_LDA(At, 0, 1); PG8_STAGE(PG8_SB(0, 0), b2, voffB); PG8_STAGE(PG8_SB(0, 1), b2 + hstepB, voffB); PG8_STAGE(PG8_SA(0, 0), a2, voffA);
            PG8_WAIT_V(8); PG8_WAIT_L(0); PG8_BAR; PG8_MMA(1, 0, At, B0); PG8_MMA(1, 1, At, B1); PG8_BAR; PG8_SCHED;
            PG8_LDB(B0, 1, 0); PG8_LDB(B1, 1, 1); PG8_SCHED; PG8_LDA(At, 1, 0); PG8_STAGE(PG8_SA(0, 1), a2 + hstepA, voffA);
            PG8_WAIT_V(8); PG8_WAIT_L(0); PG8_BAR; PG8_MMA(0, 0, At, B0); PG8_MMA(0, 1, At, B1); PG8_BAR; PG8_SCHED;
            PG8_LDA(At, 1, 1); PG8_STAGE(PG8_SB(1, 0), b3, voffB); PG8_STAGE(PG8_SB(1, 1), b3 + hstepB, voffB); PG8_STAGE(PG8_SA(1, 0), a3, voffA);
            PG8_WAIT_V(8); PG8_WAIT_L(0); PG8_BAR; PG8_MMA(1, 0, At, B0); PG8_MMA(1, 1, At, B1); PG8_BAR; PG8_SCHED;
            }
        }
        if (wr == 0) PG8_BAR;
        if constexpr (F8) asm volatile("s_nop 15\n\ts_nop 15" ::: "memory");
        { int fr_ = fr, fq_ = fq; asm volatile("" : "+v"(fr_), "+v"(fq_));
          E(acc, cur, wr, wc, fr_, fq_); }
        if (!has_next) break;
#pragma unroll
        for (int a = 0; a < 2; ++a)
#pragma unroll
            for (int b = 0; b < 2; ++b)
#pragma unroll
                for (int m = 0; m < 4; ++m)
#pragma unroll
                    for (int n = 0; n < 2; ++n) acc[a][b][m][n] = (f32x4){0.f, 0.f, 0.f, 0.f};
        cur = nxt; cA = nA; cB = nB; ++ui;
        if (wr == 1) PG8_BAR;
    }
    PG8_WAIT_V(0);
    PG8_BAR;
#undef PG8_SA
#undef PG8_SB
#undef PG8_STAGE
#undef PG8_LDA
#undef PG8_LDB
#undef PG8_MMA
#undef PG8_CAT
#undef PG8_LD8
#undef PG8_LDA8
#undef PG8_LDB8
#undef PG8_MMA8
#undef PG8_WAIT_V
#undef PG8_WAIT_L
#undef PG8_BAR
#undef PG8_SCHED
}
}

#define XB_TMO      128
#define XB_XCNT(j)  (256  + 64 * (j))
#define XB_XSUB(j)  (1280 + 64 * (j))
#define XB_XGEN(j)  (2304 + 64 * (j))
#define XB_TOP      3328
#define XB_TOPGEN   3392
#define XCD_BAR_WORDS 3456
#define XB_SPIN_CAP (1u << 22)
DI unsigned xb_ld(unsigned* p)              { return __hip_atomic_load(p, __ATOMIC_RELAXED, __HIP_MEMORY_SCOPE_AGENT); }
DI unsigned xb_add(unsigned* p, unsigned v) { return __hip_atomic_fetch_add(p, v, __ATOMIC_RELAXED, __HIP_MEMORY_SCOPE_AGENT); }
DI unsigned xb_xcc_id() { return (unsigned)__builtin_amdgcn_s_getreg((3 << 11) | 20) & 0xFu; }
#define XB_SPIN(cond, bar) do { unsigned _sp = 0; while (cond) { __builtin_amdgcn_s_sleep(1); \
    if ((++_sp & 255u) == 0u) { if (xb_ld(&(bar)[XB_TMO])) break; if (_sp > XB_SPIN_CAP) { atomicAdd(&(bar)[XB_TMO], 1u); break; } } } } while (0)
struct XcdBarrier { unsigned* bar; unsigned x; volatile LAS unsigned* st; };
DI XcdBarrier xcd_barrier_post(unsigned* bar, volatile LAS unsigned* st) {
    XcdBarrier b; b.bar = bar; b.x = xb_xcc_id(); b.st = st;
    if (threadIdx.x == 0) (void)xb_add(&bar[XB_XCNT(b.x)], 1u);
    return b;
}
DI void xcd_barrier_complete(unsigned* bar, unsigned x, unsigned& nloc, unsigned& nx) {
    const unsigned G = gridDim.x * gridDim.y * gridDim.z;
    unsigned sum, cnt, mine, sp = 0u;
    for (;;) {
        sum = 0u; cnt = 0u; mine = 0u;
#pragma unroll
        for (unsigned j = 0; j < 16; ++j) { const unsigned c = xb_ld(&bar[XB_XCNT(j)]); sum += c; cnt += (c > 0u) ? 1u : 0u; mine = (j == x) ? c : mine; }
        if (sum == G) break;
        __builtin_amdgcn_s_sleep(1);
        if ((++sp & 255u) == 0u) { if (xb_ld(&bar[XB_TMO])) break; if (sp > XB_SPIN_CAP) { atomicAdd(&bar[XB_TMO], 1u); break; } }
    }
    nloc = mine > 0u ? mine : 1u; nx = cnt > 0u ? cnt : 1u;
}
DI void xcd_barrier(const XcdBarrier& b) {
    asm volatile("s_waitcnt vmcnt(0)" ::: "memory");
    __syncthreads();
    if (threadIdx.x == 0) {
        unsigned* bar = b.bar;
        __builtin_amdgcn_s_waitcnt(0);
        unsigned nloc = b.st[0], nx = b.st[1];
        if (nloc == 0u) { xcd_barrier_complete(bar, b.x, nloc, nx); b.st[0] = nloc; b.st[1] = nx; }
        const unsigned old = xb_add(&bar[XB_XSUB(b.x)], 1u);
        const unsigned gen = old / nloc;
        if (old + 1u == (gen + 1u) * nloc) {
            __builtin_amdgcn_fence(__ATOMIC_RELEASE, "agent");
            asm volatile("s_waitcnt vmcnt(0)" ::: "memory");
            const unsigned og = xb_add(&bar[XB_TOP], 1u);
            const unsigned tg = og / nx;
            if (og + 1u == (tg + 1u) * nx) xb_add(&bar[XB_TOPGEN], 1u);
            else XB_SPIN(xb_ld(&bar[XB_TOPGEN]) == tg, bar);
            __builtin_amdgcn_fence(__ATOMIC_ACQUIRE, "agent");
            xb_add(&bar[XB_XGEN(b.x)], 1u);
            asm volatile("s_waitcnt vmcnt(0)" ::: "memory");
        } else {
            XB_SPIN(xb_ld(&bar[XB_XGEN(b.x)]) == gen, bar);
            __builtin_amdgcn_fence(__ATOMIC_ACQUIRE, "agent");
            asm volatile("s_waitcnt vmcnt(0)" ::: "memory");
        }
    }
    __syncthreads();
}

DI void transpose_item(const float* W, int ldw, bf16* WT, int ldt, LAS float* scr, int lane) {
#pragma unroll 8
    for (int i = 0; i < 32; ++i) { const int kk = 2 * i + (lane >> 5); scr[kk * 33 + (lane & 31)] = W[(size_t)kk * ldw + (lane & 31)]; }
    LDS_WAIT(); asm volatile("" ::: "memory");
    const int c = lane & 7;
#pragma unroll
    for (int j = 0; j < 4; ++j) { const int n = (lane >> 3) + 8 * j; const LAS float* s = scr + (8 * c) * 33 + n;
        u32x4 o; o.x = pk2(s[0 * 33], s[1 * 33]); o.y = pk2(s[2 * 33], s[3 * 33]); o.z = pk2(s[4 * 33], s[5 * 33]); o.w = pk2(s[6 * 33], s[7 * 33]);
        *(u32x4*)(WT + (size_t)n * ldt + 8 * c) = o; }
    LDS_WAIT(); asm volatile("" ::: "memory");
}
DI void transpose_item_f8(const float* W, int ldw, unsigned char* WT, int ldt, float scale, LAS float* scr, int lane) {
#pragma unroll 8
    for (int i = 0; i < 32; ++i) { const int kk = 2 * i + (lane >> 5); scr[kk * 33 + (lane & 31)] = W[(size_t)kk * ldw + (lane & 31)]; }
    LDS_WAIT(); asm volatile("" ::: "memory");
    const int c = lane & 3;
#pragma unroll
    for (int j = 0; j < 2; ++j) { const int n = (lane >> 2) + 16 * j; const LAS float* s = scr + (16 * c) * 33 + n;
        u32x4 o; o.x = pk4_f8(s[0 * 33] * scale, s[1 * 33] * scale, s[2 * 33] * scale, s[3 * 33] * scale); o.y = pk4_f8(s[4 * 33] * scale, s[5 * 33] * scale, s[6 * 33] * scale, s[7 * 33] * scale);
        o.z = pk4_f8(s[8 * 33] * scale, s[9 * 33] * scale, s[10 * 33] * scale, s[11 * 33] * scale); o.w = pk4_f8(s[12 * 33] * scale, s[13 * 33] * scale, s[14 * 33] * scale, s[15 * 33] * scale);
        *(u32x4*)(WT + (size_t)n * ldt + 16 * c) = o; }
    LDS_WAIT(); asm volatile("" ::: "memory");
}
DI void ln16(f32x4 (&v)[4], const f32x4 (&g)[4], const f32x4 (&b)[4]) {
    float s = 0.f;
#pragma unroll
    for (int j = 0; j < 4; ++j) s += (v[j].x + v[j].y) + (v[j].z + v[j].w);
    const float mean = wave_sum(s) * (1.f / D); float s2 = 0.f;
#pragma unroll
    for (int j = 0; j < 4; ++j) { v[j] = v[j] - mean; s2 += (v[j].x * v[j].x + v[j].y * v[j].y) + (v[j].z * v[j].z + v[j].w * v[j].w); }
    const float rstd = 1.f / sqrtf(wave_sum(s2) * (1.f / D) + LN_EPS);
#pragma unroll
    for (int j = 0; j < 4; ++j) v[j] = v[j] * rstd * g[j] + b[j];
}
DI void gates8(const f32x4 (&y)[4], const LAS float* wgt, float* gif_row, int lane) {
    float p[8];
#pragma unroll
    for (int j = 0; j < 8; ++j) { float s = 0.f;
#pragma unroll
        for (int jj = 0; jj < 4; ++jj) { const f32x4 w = *(const LAS f32x4*)(wgt + j * 1024 + 256 * jj + 4 * lane); s += (y[jj].x * w.x + y[jj].y * w.y) + (y[jj].z * w.z + y[jj].w * w.w); }
        p[j] = wave_sum(s); }
    if (lane == 0) { *(f32x4*)gif_row = (f32x4){p[0], p[1], p[2], p[3]}; *(f32x4*)(gif_row + 4) = (f32x4){p[4], p[5], p[6], p[7]}; }
}
DI void gates8b(const f32x4 (&y)[4], const LAS float* wgt, float* gif_row, int lane) {
    float p[8];
#pragma unroll
    for (int j = 0; j < 8; ++j) { float s = 0.f;
#pragma unroll
        for (int jj = 0; jj < 4; ++jj) { const f32x4 w = *(const LAS f32x4*)(wgt + j * 1024 + (jj >> 1) * 512 + 8 * lane + (jj & 1) * 4); s += (y[jj].x * w.x + y[jj].y * w.y) + (y[jj].z * w.z + y[jj].w * w.w); }
        p[j] = wave_sum(s); }
    if (lane == 0) { *(f32x4*)gif_row = (f32x4){p[0], p[1], p[2], p[3]}; *(f32x4*)(gif_row + 4) = (f32x4){p[4], p[5], p[6], p[7]}; }
}
DI void load_gate_table(LAS float* wgt, const float* win_l, int tid) {
    for (int i = tid; i < 8192; i += NTHR) { const int k = i >> 3, j = i & 7; wgt[j * 1024 + k] = win_l[(size_t)k * DIN + 1536 + j]; }
}
DI f32x4 ld4bf(const char* p) { const u32x2 w = *(const u32x2*)p; return (f32x4){bflo(w.x), bfhi(w.x), bflo(w.y), bfhi(w.y)}; }
DI void st4bf(char* p, const f32x4& v) { u32x2 w; w.x = pk2(v.x, v.y); w.y = pk2(v.z, v.w); *(u32x2*)p = w; }

struct Args { const float* in[N_IN]; float* out; unsigned char* ws; int ph_lo, ph_hi; };
constexpr int NP_LAYER = 12, NPH = 1 + DEPTH * NP_LAYER;
constexpr int XW_SPLIT = 33792;

struct SchedInproj {
    pg8::TileOrder T; int G, c; const char *X, *W; char* U; bool kv; const char *MEMN, *WKV; char* KV;
    DI bool next(int i, pg8::Unit& u) const {
        const long L = (long)i * G + c; int pm, pn;
        if (T.tile(L, pm, pn)) { u.a = X + (size_t)pm * 256 * D * 2; u.b = W + (size_t)pn * 256 * D * 2; u.r0 = pm * 256; u.c0 = pn * 256; u.c = U + ((size_t)u.r0 * NU + u.c0) * 2; u.ldc = NU; u.e = 0; u.sub = 0; return true; }
        if (!kv) return false;
        const long L2 = L - T.nwg; if (L2 < 0 || L2 >= 128) return false;
        const int l = (int)L2 >> 6, t = (int)L2 & 63; pm = t >> 2; pn = t & 3;
        u.a = MEMN + (size_t)pm * 256 * D * 2; u.b = WKV + ((size_t)l * 1024 + pn * 256) * D * 2; u.r0 = pm * 256; u.c0 = pn * 256; u.c = KV + (((size_t)l * MROWS + u.r0) * D + u.c0) * 2; u.ldc = D; u.e = 0; u.sub = 0; return true;
    }
};
struct SchedPlain {
    pg8::TileOrder T; int G, c; const char *A, *B; char* C; int lda, ldb, ldc;
    DI bool next(int i, pg8::Unit& u) const {
        const long L = (long)i * G + c; int pm, pn; if (!T.tile(L, pm, pn)) return false;
        u.a = A + (size_t)pm * 256 * lda * 2; u.b = B + (size_t)pn * 256 * ldb * 2; u.r0 = pm * 256; u.c0 = pn * 256; u.c = C + ((size_t)u.r0 * ldc + u.c0) * 2; u.ldc = ldc; u.e = 0; u.sub = 0; return true;
    }
};
struct SchedMerge {
    pg8::TileOrder T; int G, c; const char *H, *W; char* Y;
    DI bool next(int i, pg8::Unit& u) const {
        const int ti = i / 3, br = i - 3 * ti; const long L = (long)ti * G + c; int pm, pn; if (!T.tile(L, pm, pn)) return false;
        u.a = H + ((size_t)pm * 256 * 1536 + br * 512) * 2; u.b = W + ((size_t)br * 1024 + pn * 256) * 512 * 2; u.r0 = pm * 256; u.c0 = pn * 256; u.c = Y + ((size_t)u.r0 * D + u.c0) * 2; u.ldc = D; u.e = 0; u.sub = br; return true;
    }
};
struct SchedMoe {
    pg8::TileOrder T; int G, c; const char *A, *W; char* C; const LAS int* PB; int wrows  , ldc, cdiv, osz;
    DI bool next(int i, pg8::Unit& u) const {
        const long L = (long)i * G + c; int pm, pn; if (!T.tile(L, pm, pn)) return false;
        int e = 0;
#pragma unroll 1
        for (int j = 1; j < NEXP; ++j) e += (PB[j] <= pm) ? 1 : 0;
        u.a = A + (size_t)pm * 256 * 1024; u.b = W + ((size_t)e * wrows + pn * 256) * 1024; u.r0 = pm * 256; u.c0 = pn * 256; u.c = C + ((size_t)u.r0 * ldc + u.c0 / cdiv) * osz; u.ldc = ldc; u.e = e; u.sub = 0; return true;
    }
};

__global__ void __launch_bounds__(NTHR, 2) fwd_kernel(Args args) {
    extern __shared__ __attribute__((aligned(16))) unsigned char lds_raw[];
#define INP(i) ([&]() -> const float* { int ii_ = (i); asm volatile("" : "+s"(ii_)); return args.in[ii_]; }())
    LAS unsigned char* lds = (LAS unsigned char*)lds_raw;
    volatile LAS unsigned* LCTL = (volatile LAS unsigned*)(lds + LDSCTL_OFF);
    const int tid0 = threadIdx.x, wave = __builtin_amdgcn_readfirstlane(tid0 >> 6);
#define PHASE_TID unsigned z_ = 0u; asm volatile("" : "+v"(z_)); int tid = wave * 64 + (int)__builtin_amdgcn_mbcnt_hi(~0u, __builtin_amdgcn_mbcnt_lo(~0u, z_)); const int lane = tid & 63; (void)lane;
    const int G = gridDim.x, bx = blockIdx.x;
    const int gw = bx * NWAVES + wave, NGW = G * NWAVES;
    unsigned char* ws = args.ws;
    gu32* ctl = (gu32*)(ws + WS_CTL);
    for (int u = tid0; u < (LDS_BYTES - LDSCTL_OFF) / 4; u += NTHR) ((LAS unsigned*)(lds + LDSCTL_OFF))[u] = 0u;
    __syncthreads();
    XcdBarrier bar; bar.bar = (unsigned*)ctl + CW_BAR; bar.x = 0; bar.st = nullptr;
    if (MK_ONE_LAUNCH) bar = xcd_barrier_post((unsigned*)ctl + CW_BAR, LCTL);
    const int lo = args.ph_lo, hi = args.ph_hi;
#ifndef SUBMASK
#define SUBMASK 7
#endif
#ifndef LN2PROBE
#define LN2PROBE 0
#endif
#ifndef SUBDUP
#define SUBDUP 0
#endif
#define NSUB(k) ((((SUBDUP) >> (k)) & 1) ? 2 : 1)
#ifndef DUPMASK
#define DUPMASK 0
#endif
#define NREP(k) ((((DUPMASK) >> (k)) & 1) ? 2 : 1)
#ifndef PHMASK
#define PHMASK 0xFFFF
#endif
#define IN(k) (lo <= (k) && (k) < hi)
#define SEAM(k) do { if (IN(k) && IN((k) + 1)) xcd_barrier(bar); } while (0)

    char* const Xb = (char*)(ws + WS_X);
    char* const Ub = (char*)(ws + WS_R1);
    float* const GIF = (float*)(ws + WS_GIF);
    LAS int* const PB = (LAS int*)(lds + LDSCTL_OFF + 64);
    LAS int* const CNT = (LAS int*)(lds + LDSCTL_OFF + 256);

    _Pragma("unroll 1") for (int rep_ = 0; rep_ < NREP(12); ++rep_) if (((PHMASK>>12)&1) && IN(0)) { PHASE_TID
        LAS float* scr = (LAS float*)(lds + wave * 8448);
        LAS float* wgt = (LAS float*)(lds + 73728);
        load_gate_table(wgt, INP(I_WIN), tid);
        constexpr int IT_IN = 16 * 216, IT_KV = 16 * 32, IT_BR = 8 * 32, IT_O = 16 * 32, IT_L = IT_IN + IT_KV + 3 * IT_BR + IT_O;
        for (int it = gw; it < DEPTH * IT_L; it += NGW) {
            const int l = it / IT_L; int r = it - l * IT_L;
            if (r < IT_IN) { const int kb = r / 216, nb = r % 216, n0 = 32 * nb, sc = n0 + (n0 >= 1536 ? 8 : 0);
                if (n0 < UC_GATE) transpose_item(INP(I_WIN) + ((size_t)l * D + 64 * kb) * DIN + sc, DIN, (bf16*)(ws + WS_WIN) + ((size_t)l * NU + n0) * D + 64 * kb, D, scr, lane);
                else transpose_item_f8(INP(I_WIN) + ((size_t)l * D + 64 * kb) * DIN + sc, DIN, (unsigned char*)(ws + WS_WING8) + ((size_t)l * 3072 + (n0 - UC_GATE)) * D + 64 * kb, D, F8_SWGU, scr, lane);
                continue; }
            r -= IT_IN;
            if (r < IT_KV) { const int kb = r / 32, nb = r % 32;
                transpose_item(INP(I_CAWKV) + ((size_t)l * D + 64 * kb) * 1024 + 32 * nb, 1024, (bf16*)(ws + WS_WKV) + ((size_t)l * 1024 + 32 * nb) * D + 64 * kb, D, scr, lane); continue; }
            r -= IT_KV;
            if (r < 3 * IT_BR) { const int br = r / IT_BR, q = r % IT_BR, kb = q / 32, nb = q % 32;
                const float* src = INP(br == 0 ? I_WBRML : (br == 1 ? I_WBRRW : I_WBRCA));
                transpose_item(src + ((size_t)l * 512 + 64 * kb) * 1024 + 32 * nb, 1024, (bf16*)(ws + WS_WBR) + ((size_t)l * 1024 + 32 * nb) * 1536 + br * 512 + 64 * kb, 1536, scr, lane); continue; }
            r -= 3 * IT_BR;
            { const int kb = r / 32, nb = r % 32;
                transpose_item(INP(I_WO) + ((size_t)l * D + 64 * kb) * 1024 + 32 * nb, 1024, (bf16*)(ws + WS_WO) + ((size_t)l * 1024 + 32 * nb) * D + 64 * kb, D, scr, lane); }
        }
        for (int i = bx * NTHR + tid; i < DEPTH * 1536 * 256; i += G * NTHR) {
            const int l = i / (1536 * 256), r = i % (1536 * 256), n = r >> 8, k = r & 255; float v = 0.f;
            if (n < 512) { if (k < 64) v = INP(I_RWWUP)[((size_t)l * 64 + k) * 512 + n]; }
            else if (n < 1024) { if (k >= 64 && k < 128) v = INP(I_RWAUP)[((size_t)l * 64 + (k - 64)) * 512 + (n - 512)]; }
            else { if (k >= 128) v = INP(I_RWGUP)[((size_t)l * 128 + (k - 128)) * 512 + (n - 1024)]; }
            ((bf16*)(ws + WS_WLORA))[i] = (bf16)f2bf(v);
        }
        __syncthreads();
        {
            f32x4 g[4], b[4];
#pragma unroll
            for (int j = 0; j < 4; ++j) { g[j] = *(const f32x4*)(INP(I_LNIN_G) + 256 * j + 4 * lane); b[j] = *(const f32x4*)(INP(I_LNIN_B) + 256 * j + 4 * lane); }
            for (int m = gw; m < M; m += NGW) {
                f32x4 v[4]; const float* xr = INP(I_X) + (size_t)m * D;
#pragma unroll
                for (int j = 0; j < 4; ++j) v[j] = *(const f32x4*)(xr + 256 * j + 4 * lane);
                ln16(v, g, b);
#pragma unroll
                for (int j = 0; j < 4; ++j) { st4bf(Xb + ((size_t)m * D + 256 * j + 4 * lane) * 2, v[j]); *(unsigned*)((char*)(ws + WS_XF8) + (size_t)m * D + 256 * j + 4 * lane) = pk4_f8(v[j].x * F8_SX, v[j].y * F8_SX, v[j].z * F8_SX, v[j].w * F8_SX); }
                gates8(v, wgt, GIF + (size_t)m * 8, lane);
            }
#pragma unroll
            for (int j = 0; j < 4; ++j) { g[j] = *(const f32x4*)(INP(I_MEMLN_G) + 256 * j + 4 * lane); b[j] = *(const f32x4*)(INP(I_MEMLN_B) + 256 * j + 4 * lane); }
            for (int m = gw; m < MROWS; m += NGW) {
                f32x4 v[4]; const float* xr = INP(I_MEM) + (size_t)m * D;
#pragma unroll
                for (int j = 0; j < 4; ++j) v[j] = *(const f32x4*)(xr + 256 * j + 4 * lane);
                ln16(v, g, b);
#pragma unroll
                for (int j = 0; j < 4; ++j) st4bf((char*)(ws + WS_MEMN) + ((size_t)m * D + 256 * j + 4 * lane) * 2, v[j]);
            }
        }
        __syncthreads();
    }
    SEAM(0);

#pragma unroll 1
    for (int l = 0; l < DEPTH; ++l) {
        const int pb = 1 + l * NP_LAYER;
        _Pragma("unroll 1") for (int rep_ = 0; rep_ < NREP(0); ++rep_) if (((PHMASK>>0)&1) && IN(pb + 0)) {
            SchedInproj S; S.T.init(M / 256, UC_GATE / 256); S.G = G; S.c = bx; S.X = Xb; S.W = (const char*)(ws + WS_WIN) + (size_t)l * NU * D * 2; S.U = Ub;
            S.kv = (l == 0); S.MEMN = (const char*)(ws + WS_MEMN); S.WKV = (const char*)(ws + WS_WKV); S.KV = (char*)(ws + WS_KV);
            pg8::EpiStore E;
            pg8::gemm_phase<false>(lds, D * 2, D * 2, D * 2, S, E, wave);
            SchedPlain S8; S8.T.init(M / 256, 12); S8.G = G; S8.c = bx; S8.A = (const char*)(ws + WS_XF8); S8.B = (const char*)(ws + WS_WING8) + (size_t)l * 3072 * D; S8.C = Ub + UC_GATE * 2;
            S8.lda = 512; S8.ldb = 512; S8.ldc = NU;
            pg8::EpiStoreS E8; E8.s = F8_INV1;
            pg8::gemm_phase<true>(lds, D, D, D, S8, E8, wave);
        }
        SEAM(pb + 0);
        _Pragma("unroll 1") for (int rep_ = 0; rep_ < NREP(1); ++rep_) if (((PHMASK>>1)&1) && IN(pb + 1)) { PHASE_TID
            const float* mu = INP(I_RWMU) + (size_t)l * 1792 + 1536;
            char* LIN = (char*)(ws + WS_R2 + R2_LORA_IN);
            for (int it = bx * NTHR + tid; it < M * 32; it += G * NTHR) {
                const int row = it >> 5, c = (it & 31) * 8;
                const u32x4 cw = *(const u32x4*)(Ub + ((size_t)row * NU + UC_RW + 1536 + c) * 2);
                u32x4 pw = (u32x4){0u, 0u, 0u, 0u};
                if ((row & (SEQ - 1)) != 0) pw = *(const u32x4*)(Ub + ((size_t)(row - 1) * NU + UC_RW + 1536 + c) * 2);
                const f32x4 m0 = *(const f32x4*)(mu + c), m1 = *(const f32x4*)(mu + c + 4);
                float x[8] = {bflo(cw.x), bfhi(cw.x), bflo(cw.y), bfhi(cw.y), bflo(cw.z), bfhi(cw.z), bflo(cw.w), bfhi(cw.w)};
                const float p[8] = {bflo(pw.x), bfhi(pw.x), bflo(pw.y), bfhi(pw.y), bflo(pw.z), bfhi(pw.z), bflo(pw.w), bfhi(pw.w)};
                const float mm[8] = {m0.x, m0.y, m0.z, m0.w, m1.x, m1.y, m1.z, m1.w};
#pragma unroll
                for (int i = 0; i < 8; ++i) { float xs = x[i] + (p[i] - x[i]) * mm[i];
                    if (c < 64) xs = 1.f - 2.f * __builtin_amdgcn_rcpf(1.f + __builtin_amdgcn_exp2f(2.8853900817779268f * xs));
                    else if (c >= 128) xs = sigmoidf_(xs);
                    x[i] = xs; }
                u32x4 o; o.x = pk2(x[0], x[1]); o.y = pk2(x[2], x[3]); o.z = pk2(x[4], x[5]); o.w = pk2(x[6], x[7]);
                *(u32x4*)(LIN + ((size_t)row * 256 + c) * 2) = o;
            }
        }
        SEAM(pb + 1);
        _Pragma("unroll 1") for (int rep_ = 0; rep_ < NREP(2); ++rep_) if (((PHMASK>>2)&1) && IN(pb + 2)) {
            SchedPlain S; S.T.init(M / 256, 6); S.G = G; S.c = bx; S.A = (const char*)(ws + WS_R2 + R2_LORA_IN); S.B = (const char*)(ws + WS_WLORA) + (size_t)l * 1536 * 256 * 2; S.C = (char*)(ws + WS_R2 + R2_LORA_OUT);
            S.lda = 256; S.ldb = 256; S.ldc = 1536;
            pg8::EpiStore E;
            pg8::gemm_phase<false>(lds, 512, 512, 512, S, E, wave);
        }
        SEAM(pb + 2);
        _Pragma("unroll 1") for (int rep_ = 0; rep_ < NREP(3); ++rep_) if (((PHMASK>>3)&1) && IN(pb + 3)) { PHASE_TID
            const char* LO = (const char*)(ws + WS_R2 + R2_LORA_OUT);
            char* HC = (char*)(ws + WS_R2 + R2_HCAT);
            const int tid_ph = tid;
#define SUB_TID unsigned zs_ = 0u; asm volatile("" : "+v"(zs_)); int tid = wave * 64 + (int)__builtin_amdgcn_mbcnt_hi(~0u, __builtin_amdgcn_mbcnt_lo(~0u, zs_)); const int lane = tid & 63; (void)lane;
#pragma unroll 1
            for (int job = bx; job < 256; job += G) {
                if (job < 128) { _Pragma("unroll 1") for (int sr_ = 0; sr_ < NSUB(0); ++sr_) if ((SUBMASK>>0)&1) {
                    SUB_TID
                    const int b = job >> 3, h = job & 7;
                    constexpr int TC = 64;
                    LAS float* OPS = (LAS float*)lds;
                    LAS float* OUTB = OPS + TC * 384;
                    LAS float* BON = OUTB + TC * 64;
                    LAS float* C12 = BON + TC;
                    LAS float* PREV = C12 + 2 * TC;
                    const int pt = tid >> 4, cs = tid & 15, pc = cs * 4, hc = h * 64 + pc;
                    if (tid < 192) PREV[tid] = 0.f;
                    f32x4 S0 = (f32x4){0.f, 0.f, 0.f, 0.f}, S1 = S0, So0 = S0, So1 = S0; float sap0 = 0.f, sap1 = 0.f; f32x2 vprev = (f32x2){0.f, 0.f};
                    u32x2 pu[2][9];
                    auto LOADC = [&](int t0) {
#pragma unroll
                        for (int tt = 0; tt < 2; ++tt) { const int t = t0 + pt + 32 * tt; const size_t row = (size_t)b * SEQ + t; const char* up = Ub + (row * NU + UC_RW + hc) * 2;
                            pu[tt][0] = *(const u32x2*)up; pu[tt][1] = *(const u32x2*)(up + 1024); pu[tt][2] = *(const u32x2*)(up + 2048);
                            if (t > 0) { const char* pp = up - (size_t)NU * 2; pu[tt][3] = *(const u32x2*)pp; pu[tt][4] = *(const u32x2*)(pp + 1024); pu[tt][5] = *(const u32x2*)(pp + 2048); }
                            else { pu[tt][3] = (u32x2){0u, 0u}; pu[tt][4] = pu[tt][3]; pu[tt][5] = pu[tt][3]; }
                            const char* lp = LO + (row * 1536 + hc) * 2; pu[tt][6] = *(const u32x2*)lp; pu[tt][7] = *(const u32x2*)(lp + 1024); pu[tt][8] = *(const u32x2*)(lp + 2048); }
                    };
#define UNP4(w) ((f32x4){bflo((w).x), bfhi((w).x), bflo((w).y), bfhi((w).y)})
#define DOT4(a, b) (((a).x * (b).x + (a).y * (b).y) + ((a).z * (b).z + (a).w * (b).w))
                    LOADC(0);
#pragma unroll 1
                    for (int t0 = 0; t0 < SEQ; t0 += TC) {
                        f32x4 gk[2];
                        int hcv = hc; asm volatile("" : "+v"(hcv));
                        const f32x4 mu_r = *(const f32x4*)(INP(I_RWMU) + (size_t)l * 1792 + hcv), mu_k = *(const f32x4*)(INP(I_RWMU) + (size_t)l * 1792 + 512 + hcv), mu_v = *(const f32x4*)(INP(I_RWMU) + (size_t)l * 1792 + 1024 + hcv);
                        const f32x4 w0 = *(const f32x4*)(INP(I_RWW0) + l * 512 + hcv), a0 = *(const f32x4*)(INP(I_RWA0) + l * 512 + hcv), kkw = *(const f32x4*)(INP(I_RWKK) + l * 512 + hcv);
                        const f32x4 kaw = *(const f32x4*)(INP(I_RWKA) + l * 512 + hcv), rkw = *(const f32x4*)(INP(I_RWRK) + l * 512 + hcv);
#pragma unroll
                        for (int tt = 0; tt < 2; ++tt) { const int tok = pt + 32 * tt;
                            const f32x4 ur = UNP4(pu[tt][0]), uk = UNP4(pu[tt][1]), uv = UNP4(pu[tt][2]), urp = UNP4(pu[tt][3]), ukp = UNP4(pu[tt][4]), uvp = UNP4(pu[tt][5]), lw = UNP4(pu[tt][6]), la = UNP4(pu[tt][7]);
                            gk[tt] = UNP4(pu[tt][8]);
                            const f32x4 xr = ur + (urp - ur) * mu_r, xk = uk + (ukp - uk) * mu_k, xv = uv + (uvp - uv) * mu_v;
                            f32x4 dec, av, kkv, kp; float ss = 0.f, bsum = 0.f;
#pragma unroll
                            for (int i = 0; i < 4; ++i) {
                                const float y = -(w0[i] + lw[i]);
                                const float sp = fmaxf(y, 0.f) + __logf(1.f + __expf(-fabsf(y)));
                                dec[i] = __expf(-__expf(-sp - 0.5f));
                                av[i] = sigmoidf_(a0[i] + la[i]);
                                kkv[i] = xk[i] * kkw[i]; ss += kkv[i] * kkv[i];
                                kp[i] = xk[i] * (1.f + (av[i] - 1.f) * kaw[i]);
                                bsum += xr[i] * kp[i] * rkw[i];
                            }
                            ss = red16(ss); bsum = red16(bsum);
                            const float inv = __builtin_amdgcn_rsqf(fmaxf(ss, 1e-24f));
                            const f32x4 kk = kkv * inv, kka = kk * av;
                            LAS float* o = OPS + tok * 384 + pc;
                            *(LAS f32x4*)(o) = dec; *(LAS f32x4*)(o + 64) = kk; *(LAS f32x4*)(o + 128) = kka; *(LAS f32x4*)(o + 192) = kp; *(LAS f32x4*)(o + 256) = xr; *(LAS f32x4*)(o + 320) = xv;
                            if (cs == 0) BON[tok] = bsum;
                        }
                        if (t0 + TC < SEQ) LOADC(t0 + TC);
                        __syncthreads();
#pragma unroll
                        for (int tt = 0; tt < 2; ++tt) { const int tok = pt + 32 * tt;
                            const LAS float* pr = OPS + (tok - 1) * 384 + pc;
                            f32x4 pw, pkp, pka;
                            if (tok > 0) { pw = *(const LAS f32x4*)pr; pkp = *(const LAS f32x4*)(pr + 192); pka = *(const LAS f32x4*)(pr + 128); }
                            else { pw = *(const LAS f32x4*)(PREV + pc); pkp = *(const LAS f32x4*)(PREV + 64 + pc); pka = *(const LAS f32x4*)(PREV + 128 + pc); }
                            LAS float* zp = OPS + tok * 384 + 64 + pc;
                            const f32x4 z = *(const LAS f32x4*)zp;
                            const float c1 = red16(DOT4(pkp, z)), c2 = red16(DOT4(pka, z));
                            *(LAS f32x4*)zp = pw * z;
                            if (cs == 0) *(LAS f32x2*)(C12 + 2 * tok) = (f32x2){c1, c2};
                        }
                        __syncthreads();
                        {
                            const LAS float* qb = OPS + pc; const LAS float* vb = OPS + 320 + 2 * pt;
                            float dc0, dc1;
                            { const f32x4 y0 = *(const LAS f32x4*)(qb + 64); dc0 = red16(DOT4(So0, y0)); dc1 = red16(DOT4(So1, y0)); }
                            f32x4 w4 = *(const LAS f32x4*)(qb), ka4 = *(const LAS f32x4*)(qb + 128), kp4 = *(const LAS f32x4*)(qb + 192), r4 = *(const LAS f32x4*)(qb + 256), yn = *(const LAS f32x4*)(qb + 384 + 64);
                            f32x2 v2 = *(const LAS f32x2*)vb, c12 = *(const LAS f32x2*)C12;
#define OPQ(x) asm("" : "+v"(x))
#define DOT4S(d, a, b) do { float t0_ = (a).x * (b).x, t1_ = (a).z * (b).z; OPQ(t0_); OPQ(t1_); t0_ = __builtin_fmaf((a).y, (b).y, t0_); t1_ = __builtin_fmaf((a).w, (b).w, t1_); OPQ(t0_); OPQ(t1_); d = t0_ + t1_; OPQ(d); } while (0)
#define UPD1(Sc, wc, kpc, kac, vs, sas) do { float t_ = (kpc) * (vs); OPQ(t_); t_ = __builtin_fmaf(-(kac), (sas), t_); OPQ(t_); Sc = __builtin_fmaf(Sc, (wc), t_); OPQ(Sc); } while (0)
#define RW_STEP(s, LASTSTEP) do { \
                                const int s1 = (s) + 1 < TC ? (s) + 1 : TC - 1, s2 = (s) + 2 < TC ? (s) + 2 : TC - 1; \
                                const f32x4 nw4 = *(const LAS f32x4*)(qb + s1 * 384), nka4 = *(const LAS f32x4*)(qb + s1 * 384 + 128), nkp4 = *(const LAS f32x4*)(qb + s1 * 384 + 192), nr4 = *(const LAS f32x4*)(qb + s1 * 384 + 256), nyn = *(const LAS f32x4*)(qb + s2 * 384 + 64); \
                                const f32x2 nv2 = *(const LAS f32x2*)(vb + s1 * 384), nc12 = *(const LAS f32x2*)(C12 + 2 * s1); \
                                float sa0 = vprev.x * c12.x, sa1 = vprev.y * c12.x; OPQ(sa0); OPQ(sa1); sa0 = __builtin_fmaf(-sap0, c12.y, sa0); sa1 = __builtin_fmaf(-sap1, c12.y, sa1); OPQ(sa0); OPQ(sa1); sa0 += dc0; sa1 += dc1; OPQ(sa0); OPQ(sa1); \
                                float dn0 = 0.f, dn1 = 0.f; \
                                if (LASTSTEP) { So0 = S0; So1 = S1; } else { DOT4S(dn0, S0, yn); DOT4S(dn1, S1, yn); dn0 = red16o(dn0); dn1 = red16o(dn1); } \
                                UPD1(S0.x, w4.x, kp4.x, ka4.x, v2.x, sa0); UPD1(S0.y, w4.y, kp4.y, ka4.y, v2.x, sa0); UPD1(S0.z, w4.z, kp4.z, ka4.z, v2.x, sa0); UPD1(S0.w, w4.w, kp4.w, ka4.w, v2.x, sa0); \
                                UPD1(S1.x, w4.x, kp4.x, ka4.x, v2.y, sa1); UPD1(S1.y, w4.y, kp4.y, ka4.y, v2.y, sa1); UPD1(S1.z, w4.z, kp4.z, ka4.z, v2.y, sa1); UPD1(S1.w, w4.w, kp4.w, ka4.w, v2.y, sa1); \
                                float o0, o1; DOT4S(o0, S0, r4); DOT4S(o1, S1, r4); o0 = red16o(o0); o1 = red16o(o1); \
                                if (cs == 0) *(LAS f32x2*)(OUTB + (s) * 64 + 2 * pt) = (f32x2){o0, o1}; \
                                sap0 = sa0; sap1 = sa1; vprev = v2; dc0 = dn0; dc1 = dn1; \
                                w4 = nw4; ka4 = nka4; kp4 = nkp4; r4 = nr4; yn = nyn; v2 = nv2; c12 = nc12; __builtin_amdgcn_sched_barrier(0); } while (0)
#pragma unroll 1
                            for (int s = 0; s < TC - 2; s += 2) { RW_STEP(s, false); RW_STEP(s + 1, false); }
                            RW_STEP(TC - 2, false);
                            RW_STEP(TC - 1, true);
#undef RW_STEP
#undef OPQ
#undef DOT4S
#undef UPD1
                        }
                        __syncthreads();
                        int hcw = hc; asm volatile("" : "+v"(hcw));
                        const f32x4 lng = *(const f32x4*)(INP(I_RWLNG) + l * 512 + hcw), lnb = *(const f32x4*)(INP(I_RWLNB) + l * 512 + hcw);
#pragma unroll
                        for (int tt = 0; tt < 2; ++tt) { const int tok = pt + 32 * tt;
                            const f32x4 o4 = *(const LAS f32x4*)(OUTB + tok * 64 + pc), v4 = *(const LAS f32x4*)(OPS + tok * 384 + 320 + pc);
                            const float mean = red16((o4.x + o4.y) + (o4.z + o4.w)) * (1.f / 64.f);
                            const f32x4 dv = o4 - mean;
                            const float var = red16(DOT4(dv, dv)) * (1.f / 64.f);
                            const float rstd = __builtin_amdgcn_rsqf(var + RW_GN_EPS), bo = BON[tok];
                            const f32x4 y = (dv * rstd * lng + lnb + v4 * bo) * gk[tt];
                            st4bf(HC + (((size_t)b * SEQ + t0 + tok) * 1536 + 512 + hc) * 2, y);
                        }
                        if (tid < 192) { const int j = tid >> 6, c = tid & 63; PREV[tid] = OPS[(TC - 1) * 384 + (j == 0 ? 0 : (j == 1 ? 192 : 128)) + c]; }
                        __syncthreads();
                    }
                } } else {
                    const int idx = job - 128, bh = idx >> 1, half = idx & 1, b = bh >> 2, h = bh & 3;
                    unsigned zl_ = 0u; asm volatile("" : "+v"(zl_)); const int lane_ml = (int)__builtin_amdgcn_mbcnt_hi(~0u, __builtin_amdgcn_mbcnt_lo(~0u, zl_));
                    _Pragma("unroll 1") for (int sr_ = 0; sr_ < NSUB(1); ++sr_) if (((SUBMASK>>1)&1) && idx < 64) {
                        SUB_TID
                        const int bm = idx >> 2, hm = idx & 3;
                        constexpr int PT = 144;
                        LAS unsigned char* QI = lds;
                        LAS unsigned char* KI = QI + 64 * PT;
                        LAS unsigned char* KW = KI + 64 * PT;
                        LAS unsigned char* VT = KW + 64 * PT;
                        LAS unsigned char* CI = VT + 128 * PT;
                        LAS float* AS = (LAS float*)(CI + 128 * PT);
                        LAS float* MX = AS + 64; LAS float* SI = AS + 128; LAS float* EM = AS + 192; LAS float* WG = AS + 256; LAS float* NN = AS + 320; LAS float* CR = AS + 384;
                        for (int i = tid; i < 128 * PT / 4; i += NTHR) ((LAS unsigned*)CI)[i] = 0u;
                        if (tid < 64) NN[tid] = 0.f;
                        const int pt = tid >> 4, cg = tid & 15;
                        const int ccol = (cg < 8) ? (hm * 64 + 8 * cg) : (256 + hm * 64 + 8 * (cg - 8));
                        const float qsc = (cg < 8) ? 0.125f : 1.f;
                        const float igb = INP(I_IGB)[l * 4 + hm], fgb = INP(I_FGB)[l * 4 + hm];
                        const int r31 = lane & 31, h2 = lane >> 5, vb = wave >> 1, tb = wave & 1;
                        f32x16 accC;
#pragma unroll
                        for (int i = 0; i < 16; ++i) accC[i] = 0.f;
                        float nreg = 0.f, mprev = 0.f;
                        u32x4 cu[2][4], vu[2]; float gi = 0.f, gf = 0.f;
                        auto LOADM = [&](int t0) {
#pragma unroll
                            for (int tt = 0; tt < 2; ++tt) { const int t = t0 + pt + 32 * tt; const size_t row = (size_t)bm * SEQ + t;
#pragma unroll
                                for (int j = 0; j < 4; ++j) { if (t - 3 + j >= 0) cu[tt][j] = *(const u32x4*)(Ub + ((row - 3 + j) * NU + UC_QK + ccol) * 2); else cu[tt][j] = (u32x4){0u, 0u, 0u, 0u}; }
                                const int p = tid + 512 * tt; vu[tt] = *(const u32x4*)(Ub + (((size_t)bm * SEQ + t0 + (p >> 4)) * NU + UC_V + hm * 128 + 8 * (p & 15)) * 2); }
                            if (wave == 0) { const size_t rg = (size_t)bm * SEQ + t0 + lane; gi = GIF[rg * 8 + hm]; gf = GIF[rg * 8 + 4 + hm]; }
                        };
                        LOADM(0);
                        __syncthreads();
#pragma unroll 1
                        for (int t0 = 0; t0 < SEQ; t0 += 64) {
                            int ccv = ccol; asm volatile("" : "+v"(ccv));
                            float cw[4][8], cb[8];
#pragma unroll
                        for (int j = 0; j < 4; ++j) { const f32x4 a = *(const f32x4*)(INP(I_CONVW) + ((size_t)l * 4 + j) * 512 + ccv), c2 = *(const f32x4*)(INP(I_CONVW) + ((size_t)l * 4 + j) * 512 + ccv + 4);
                            cw[j][0] = a.x; cw[j][1] = a.y; cw[j][2] = a.z; cw[j][3] = a.w; cw[j][4] = c2.x; cw[j][5] = c2.y; cw[j][6] = c2.z; cw[j][7] = c2.w; }
                        { const f32x4 a = *(const f32x4*)(INP(I_CONVB) + l * 512 + ccv), c2 = *(const f32x4*)(INP(I_CONVB) + l * 512 + ccv + 4);
                            cb[0] = a.x; cb[1] = a.y; cb[2] = a.z; cb[3] = a.w; cb[4] = c2.x; cb[5] = c2.y; cb[6] = c2.z; cb[7] = c2.w; }
                            float yq[2][8];
#pragma unroll
                            for (int tt = 0; tt < 2; ++tt) {
#pragma unroll
                                for (int i = 0; i < 8; ++i) yq[tt][i] = cb[i];
#pragma unroll
                                for (int j = 0; j < 4; ++j) { const u32x4 w = cu[tt][j]; const float x[8] = {bflo(w.x), bfhi(w.x), bflo(w.y), bfhi(w.y), bflo(w.z), bfhi(w.z), bflo(w.w), bfhi(w.w)};
#pragma unroll
                                    for (int i = 0; i < 8; ++i) yq[tt][i] += cw[j][i] * x[i]; }
#pragma unroll
                                for (int i = 0; i < 8; ++i) yq[tt][i] = yq[tt][i] * sigmoidf_(yq[tt][i]) * qsc;
                            }
                            const u32x4 vreg0 = vu[0], vreg1 = vu[1];
                            if (wave == 0) {
                                const float ig = gi + igb, fp = gf + fgb;
                                const float lf = -(fmaxf(-fp, 0.f) + __logf(1.f + __expf(-fabsf(fp))));
                                float bc = lf;
#pragma unroll
                                for (int o = 1; o < 64; o <<= 1) { const float t = __shfl_up(bc, o); if (lane >= o) bc += t; }
                                const float as = ig - bc; float pm = as;
#pragma unroll
                                for (int o = 1; o < 64; o <<= 1) { const float t = __shfl_up(pm, o); if (lane >= o) pm = fmaxf(pm, t); }
                                const float mxv = fmaxf(mprev, pm), mx63 = __shfl(mxv, 63), bl = __shfl(bc, 63);
                                AS[lane] = as; MX[lane] = mxv; SI[lane] = __expf(mprev - mxv); EM[lane] = __expf(-(bc + mxv)); WG[lane] = __expf(as - mx63);
                                if (lane == 0) CR[0] = __expf(mprev - mx63);
                                mprev = bl + mx63;
                            }
                            if (t0 + 64 < SEQ) LOADM(t0 + 64);
                            __syncthreads();
#pragma unroll
                            for (int tt = 0; tt < 2; ++tt) { const int tok = pt + 32 * tt;
                                u32x4 pw; pw.x = pk2(yq[tt][0], yq[tt][1]); pw.y = pk2(yq[tt][2], yq[tt][3]); pw.z = pk2(yq[tt][4], yq[tt][5]); pw.w = pk2(yq[tt][6], yq[tt][7]);
                                if (cg < 8) *(LAS u32x4*)(QI + tok * PT + cg * 16) = pw;
                                else { *(LAS u32x4*)(KI + tok * PT + (cg - 8) * 16) = pw; const float wgs = WG[tok];
#pragma unroll
                                    for (int i = 0; i < 8; ++i) *(LAS bf16*)(KW + (8 * (cg - 8) + i) * PT + tok * 2) = (bf16)f2bf(yq[tt][i] * wgs); }
                                const u32x4 vw = tt ? vreg1 : vreg0; const int p = tid + 512 * tt, vtok = p >> 4, v8 = p & 15;
                                LAS unsigned char* o = VT + (8 * v8) * PT + vtok * 2;
                                *(LAS bf16*)(o) = (bf16)(vw.x & 0xffff); *(LAS bf16*)(o + PT) = (bf16)(vw.x >> 16); *(LAS bf16*)(o + 2 * PT) = (bf16)(vw.y & 0xffff); *(LAS bf16*)(o + 3 * PT) = (bf16)(vw.y >> 16);
                                *(LAS bf16*)(o + 4 * PT) = (bf16)(vw.z & 0xffff); *(LAS bf16*)(o + 5 * PT) = (bf16)(vw.z >> 16); *(LAS bf16*)(o + 6 * PT) = (bf16)(vw.w & 0xffff); *(LAS bf16*)(o + 7 * PT) = (bf16)(vw.w >> 16);
                            }
                            __syncthreads();
                            {
                                constexpr float L2E = 1.4426950408889634f;
                                const int t = 32 * tb + r31;
                                bf16x8 qf[4];
#pragma unroll
                                for (int ks = 0; ks < 4; ++ks) qf[ks] = *(const LAS bf16x8*)(QI + t * PT + (16 * ks + 8 * h2) * 2);
                                const float mx = MX[t], si = SI[t], em = EM[t];
                                f32x16 O, I; float denI = 0.f;
#pragma unroll
                                for (int i = 0; i < 16; ++i) { O[i] = 0.f; I[i] = 0.f; }
#pragma unroll
                                for (int sb = 0; sb < 2; ++sb) if (sb <= tb) {
                                    f32x16 X;
#pragma unroll
                                    for (int i = 0; i < 16; ++i) X[i] = 0.f;
#pragma unroll
                                    for (int ks = 0; ks < 4; ++ks) { const bf16x8 kf = *(const LAS bf16x8*)(KI + (32 * sb + r31) * PT + (16 * ks + 8 * h2) * 2); X = __builtin_amdgcn_mfma_f32_32x32x16_bf16(kf, qf[ks], X, 0, 0, 0); }
#pragma unroll
                                    for (int g4 = 0; g4 < 4; ++g4) { const f32x4 a4 = *(const LAS f32x4*)(AS + 32 * sb + 8 * g4 + 4 * h2);
#pragma unroll
                                        for (int j = 0; j < 4; ++j) { const int s = 32 * sb + 8 * g4 + 4 * h2 + j; const float w = (s <= t) ? __builtin_amdgcn_exp2f((a4[j] - mx) * L2E) * X[4 * g4 + j] : 0.f; X[4 * g4 + j] = w; denI += w; } }
#pragma unroll
                                    for (int st = 0; st < 2; ++st) {
                                        u32x4 pw; pw.x = pk2(X[8 * st], X[8 * st + 1]); pw.y = pk2(X[8 * st + 2], X[8 * st + 3]); pw.z = pk2(X[8 * st + 4], X[8 * st + 5]); pw.w = pk2(X[8 * st + 6], X[8 * st + 7]);
                                        const LAS unsigned char* vp = VT + (32 * vb + r31) * PT + (32 * sb + 16 * st + 4 * h2) * 2;
                                        const u32x2 lo = *(const LAS u32x2*)vp, hi = *(const LAS u32x2*)(vp + 16);
                                        O = __builtin_amdgcn_mfma_f32_32x32x16_bf16(__builtin_bit_cast(bf16x8, (u32x4){lo.x, lo.y, hi.x, hi.y}), __builtin_bit_cast(bf16x8, pw), O, 0, 0, 0);
                                    }
                                }
                                float nq = 0.f;
#pragma unroll
                                for (int ks = 0; ks < 4; ++ks) { const bf16x8 cf = *(const LAS bf16x8*)(CI + (32 * vb + r31) * PT + (16 * ks + 8 * h2) * 2); I = __builtin_amdgcn_mfma_f32_32x32x16_bf16(cf, qf[ks], I, 0, 0, 0);
                                    const f32x4 n0 = *(const LAS f32x4*)(NN + 16 * ks + 8 * h2), n1 = *(const LAS f32x4*)(NN + 16 * ks + 8 * h2 + 4); const u32x4 qw = __builtin_bit_cast(u32x4, qf[ks]);
                                    nq += (bflo(qw.x) * n0.x + bfhi(qw.x) * n0.y) + (bflo(qw.y) * n0.z + bfhi(qw.y) * n0.w) + (bflo(qw.z) * n1.x + bfhi(qw.z) * n1.y) + (bflo(qw.w) * n1.z + bfhi(qw.w) * n1.w); }
                                nq += __shfl_xor(nq, 32); denI += __shfl_xor(denI, 32);
                                const float den = si * nq + denI, rdn = 1.f / fmaxf(fabsf(den), em);
                                char* op = (char*)(ws + WS_HML) + (((size_t)bm * SEQ + t0 + t) * 512 + hm * 128 + 32 * vb) * 2;
#pragma unroll
                                for (int g4 = 0; g4 < 4; ++g4) { u32x2 w; w.x = pk2((O[4 * g4] + si * I[4 * g4]) * rdn, (O[4 * g4 + 1] + si * I[4 * g4 + 1]) * rdn); w.y = pk2((O[4 * g4 + 2] + si * I[4 * g4 + 2]) * rdn, (O[4 * g4 + 3] + si * I[4 * g4 + 3]) * rdn);
                                    *(u32x2*)(op + (8 * g4 + 4 * h2) * 2) = w; }
                                const float carry = CR[0];
#pragma unroll
                                for (int i = 0; i < 16; ++i) accC[i] *= carry;
#pragma unroll
                                for (int st = 0; st < 4; ++st) { const bf16x8 va = *(const LAS bf16x8*)(VT + (32 * vb + r31) * PT + (16 * st + 8 * h2) * 2), kw = *(const LAS bf16x8*)(KW + (32 * tb + r31) * PT + (16 * st + 8 * h2) * 2);
                                    accC = __builtin_amdgcn_mfma_f32_32x32x16_bf16(va, kw, accC, 0, 0, 0); }
                            }
                            __syncthreads();
#pragma unroll
                            for (int i = 0; i < 16; ++i) { const int v = 32 * vb + (i & 3) + 8 * (i >> 2) + 4 * h2; *(LAS bf16*)(CI + v * PT + (32 * tb + r31) * 2) = (bf16)f2bf(accC[i]); }
                            if (tid < 64) { float s = 0.f;
#pragma unroll
                                for (int q8 = 0; q8 < 8; ++q8) { const u32x4 w = *(const LAS u32x4*)(KW + tid * PT + q8 * 16); s += (bflo(w.x) + bfhi(w.x)) + (bflo(w.y) + bfhi(w.y)) + (bflo(w.z) + bfhi(w.z)) + (bflo(w.w) + bfhi(w.w)); }
                                nreg = CR[0] * nreg + s; NN[tid] = nreg; }
                            __syncthreads();
                        }
                    }
                    _Pragma("unroll 1") for (int sr_ = 0; sr_ < NSUB(2); ++sr_) if ((SUBMASK>>2)&1) {
                        SUB_TID
                        constexpr int KST = 272, VST = 520;
                        LAS unsigned char* KI = lds; LAS unsigned char* VI = lds + 256 * KST;
                        const char* kvb = (const char*)(ws + WS_KV) + (((size_t)l * MROWS + (size_t)b * MEML) * D) * 2;
                        for (int p = tid; p < 4096; p += NTHR) { const int key = p >> 4, c16 = p & 15;
                            *(LAS u32x4*)(KI + key * KST + c16 * 16) = *(const u32x4*)(kvb + ((size_t)key * D + h * 128 + c16 * 8) * 2); }
                        for (int p = tid; p < 4096; p += NTHR) { const int key = p & 255, d8 = p >> 8;
                            const u32x4 w = *(const u32x4*)(kvb + ((size_t)key * D + 512 + h * 128 + d8 * 8) * 2);
                            LAS unsigned char* o = VI + (d8 * 8) * VST + key * 2;
                            *(LAS bf16*)(o) = (bf16)(w.x & 0xffff); *(LAS bf16*)(o + VST) = (bf16)(w.x >> 16); *(LAS bf16*)(o + 2 * VST) = (bf16)(w.y & 0xffff); *(LAS bf16*)(o + 3 * VST) = (bf16)(w.y >> 16);
                            *(LAS bf16*)(o + 4 * VST) = (bf16)(w.z & 0xffff); *(LAS bf16*)(o + 5 * VST) = (bf16)(w.z >> 16); *(LAS bf16*)(o + 6 * VST) = (bf16)(w.w & 0xffff); *(LAS bf16*)(o + 7 * VST) = (bf16)(w.w >> 16); }
                        __syncthreads();
                        const int r31 = lane & 31, h2 = lane >> 5;
                        constexpr float SC = 0.08838834764831845f * 1.4426950408889634f;
#pragma unroll 1
                        for (int rd = 0; rd < 8; ++rd) {
                            const size_t qrow = (size_t)b * SEQ + half * 2048 + rd * 256 + wave * 32 + r31;
                            bf16x8 qf[8];
#pragma unroll
                            for (int ks = 0; ks < 8; ++ks) qf[ks] = *(const bf16x8*)(Ub + (qrow * NU + UC_CAQ + h * 128 + 16 * ks + 8 * h2) * 2);
                            f32x16 O[4];
#pragma unroll
                            for (int db = 0; db < 4; ++db)
#pragma unroll
                                for (int i = 0; i < 16; ++i) O[db][i] = 0.f;
                            float mrun = -1e30f, lrun = 0.f;
#pragma unroll 1
                            for (int hf = 0; hf < 2; ++hf) {
                                f32x16 X[4];
#pragma unroll
                                for (int kb = 0; kb < 4; ++kb) {
                                    bf16x8 kf[8];
#pragma unroll
                                    for (int ks = 0; ks < 8; ++ks) kf[ks] = *(const LAS bf16x8*)(KI + (hf * 128 + kb * 32 + r31) * KST + (16 * ks + 8 * h2) * 2);
                                    __builtin_amdgcn_sched_barrier(0);
#pragma unroll
                                    for (int i = 0; i < 16; ++i) X[kb][i] = 0.f;
#pragma unroll
                                    for (int ks = 0; ks < 8; ++ks) X[kb] = __builtin_amdgcn_mfma_f32_32x32x16_bf16(kf[ks], qf[ks], X[kb], 0, 0, 0);
                                    __builtin_amdgcn_sched_barrier(0);
                                }
                                float mx = -1e30f;
#pragma unroll
                                for (int kb = 0; kb < 4; ++kb)
#pragma unroll
                                    for (int i = 0; i < 16; ++i) mx = fmaxf(mx, X[kb][i]);
                                mx = fmaxf(mx, __shfl_xor(mx, 32));
                                const float mnew = fmaxf(mrun, mx), alpha = __builtin_amdgcn_exp2f((mrun - mnew) * SC);
                                float ls = 0.f;
#pragma unroll
                                for (int kb = 0; kb < 4; ++kb)
#pragma unroll
                                    for (int i = 0; i < 16; ++i) { const float p = __builtin_amdgcn_exp2f((X[kb][i] - mnew) * SC); X[kb][i] = p; ls += p; }
                                ls += __shfl_xor(ls, 32);
                                lrun = lrun * alpha + ls; mrun = mnew;
#pragma unroll
                                for (int db = 0; db < 4; ++db)
#pragma unroll
                                    for (int i = 0; i < 16; ++i) O[db][i] *= alpha;
#pragma unroll
                                for (int kb = 0; kb < 4; ++kb) {
                                    bf16x8 vf[2][4], pf[2];
#pragma unroll
                                    for (int s = 0; s < 2; ++s) {
                                        u32x4 pw; pw.x = pk2(X[kb][8 * s], X[kb][8 * s + 1]); pw.y = pk2(X[kb][8 * s + 2], X[kb][8 * s + 3]); pw.z = pk2(X[kb][8 * s + 4], X[kb][8 * s + 5]); pw.w = pk2(X[kb][8 * s + 6], X[kb][8 * s + 7]);
                                        pf[s] = __builtin_bit_cast(bf16x8, pw);
#pragma unroll
                                        for (int db = 0; db < 4; ++db) {
                                            const LAS unsigned char* vp = VI + (db * 32 + r31) * VST + (hf * 128 + kb * 32 + 16 * s + 4 * h2) * 2;
                                            const u32x2 lo = *(const LAS u32x2*)vp, hi = *(const LAS u32x2*)(vp + 16);
                                            vf[s][db] = __builtin_bit_cast(bf16x8, (u32x4){lo.x, lo.y, hi.x, hi.y});
                                        }
                                    }
                                    __builtin_amdgcn_sched_barrier(0);
#pragma unroll
                                    for (int s = 0; s < 2; ++s)
#pragma unroll
                                        for (int db = 0; db < 4; ++db) O[db] = __builtin_amdgcn_mfma_f32_32x32x16_bf16(vf[s][db], pf[s], O[db], 0, 0, 0);
                                    __builtin_amdgcn_sched_barrier(0);
                                }
                            }
                            const float rl = 1.f / lrun;
                            char* op = HC + (qrow * 1536 + 1024 + h * 128) * 2;
#pragma unroll
                            for (int db = 0; db < 4; ++db)
#pragma unroll
                                for (int g4 = 0; g4 < 4; ++g4) { u32x2 w; w.x = pk2(O[db][4 * g4] * rl, O[db][4 * g4 + 1] * rl); w.y = pk2(O[db][4 * g4 + 2] * rl, O[db][4 * g4 + 3] * rl);
                                    *(u32x2*)(op + (db * 32 + 8 * g4 + 4 * h2) * 2) = w; }
                        }
                        __syncthreads();
                    }
                    if (rep_ == 0) {
                        LAS float* scr = (LAS float*)(lds + wave * 8448);
                        constexpr int IT_GU = 32 * 16 * 64;
                        for (int it = idx * NWAVES + wave; it < XW_SPLIT; it += 128 * NWAVES) {
                            if (it < IT_GU) { const int e = it >> 10, q = it & 1023, kb = q >> 6, nb = q & 63;
                                transpose_item_f8(INP(I_WGU) + (((size_t)l * 32 + e) * D + 64 * kb) * 2048 + 32 * nb, 2048, (unsigned char*)(ws + WS_WGU) + ((size_t)e * 2048 + 32 * nb) * D + 64 * kb, D, F8_SWGU, scr, lane_ml); }
                            else { const int r2 = it - IT_GU, e = r2 >> 9, q = r2 & 511, kb = q >> 5, nb = q & 31;
                                transpose_item_f8(INP(I_WDN) + (((size_t)l * 32 + e) * D + 64 * kb) * 1024 + 32 * nb, 1024, (unsigned char*)(ws + WS_WDN) + ((size_t)e * 1024 + 32 * nb) * D + 64 * kb, D, F8_SWDN, scr, lane_ml); }
                        }
                        __syncthreads();
                    }
                }
            }
#undef UNP4
#undef DOT4
#undef SUB_TID
        }
        SEAM(pb + 3);
        _Pragma("unroll 1") for (int rep_ = 0; rep_ < NREP(4); ++rep_) if (((PHMASK>>4)&1) && IN(pb + 4)) { PHASE_TID
            char* HC = (char*)(ws + WS_R2 + R2_HCAT);
            const int hd = lane >> 4, sb = (lane & 15) * 8;
            const f32x4 g0 = *(const f32x4*)(INP(I_MLNORMG) + l * 512 + hd * 128 + sb), g1 = *(const f32x4*)(INP(I_MLNORMG) + l * 512 + hd * 128 + sb + 4);
            for (int m = gw; m < M; m += NGW) {
                const u32x4 hw = *(const u32x4*)((const char*)(ws + WS_HML) + ((size_t)m * 512 + hd * 128 + sb) * 2);
                const u32x4 ow = *(const u32x4*)(Ub + ((size_t)m * NU + UC_OG + hd * 128 + sb) * 2);
                float v[8] = {bflo(hw.x), bfhi(hw.x), bflo(hw.y), bfhi(hw.y), bflo(hw.z), bfhi(hw.z), bflo(hw.w), bfhi(hw.w)};
                const float og[8] = {bflo(ow.x), bfhi(ow.x), bflo(ow.y), bfhi(ow.y), bflo(ow.z), bfhi(ow.z), bflo(ow.w), bfhi(ow.w)};
                const float gg[8] = {g0.x, g0.y, g0.z, g0.w, g1.x, g1.y, g1.z, g1.w};
                float s = 0.f;
#pragma unroll
                for (int i = 0; i < 8; ++i) s += v[i];
                const float mean = red16(s) * (1.f / 128.f); float s2 = 0.f;
#pragma unroll
                for (int i = 0; i < 8; ++i) { v[i] -= mean; s2 += v[i] * v[i]; }
                const float rstd = 1.f / sqrtf(red16(s2) * (1.f / 128.f) + LN_EPS);
#pragma unroll
                for (int i = 0; i < 8; ++i) v[i] = sigmoidf_(og[i]) * (v[i] * rstd * gg[i]);
                u32x4 o; o.x = pk2(v[0], v[1]); o.y = pk2(v[2], v[3]); o.z = pk2(v[4], v[5]); o.w = pk2(v[6], v[7]);
                *(u32x4*)(HC + ((size_t)m * 1536 + hd * 128 + sb) * 2) = o;
            }
        }
        SEAM(pb + 4);
        _Pragma("unroll 1") for (int rep_ = 0; rep_ < NREP(5); ++rep_) if (((PHMASK>>5)&1) && IN(pb + 5)) {
            SchedPlain S; S.T.init(M / 256, 4); S.G = G; S.c = bx; S.A = (const char*)(ws + WS_R2 + R2_HCAT); S.B = (const char*)(ws + WS_WBR) + (size_t)l * 1024 * 1536 * 2; S.C = (char*)(ws + WS_R2 + R2_YPRE);
            S.lda = 1536; S.ldb = 1536; S.ldc = D;
            pg8::EpiMerge E; E.U = Ub; E.gate_b = INP(I_GATEB) + (size_t)l * 3072;
            pg8::gemm_phase<false, true>(lds, 1536 * 2, 1536 * 2, 1536 * 2, S, E, wave);
        }
        SEAM(pb + 5);
        _Pragma("unroll 1") for (int rep_ = 0; rep_ < NREP(6); ++rep_) if (((PHMASK>>6)&1) && IN(pb + 6)) {
            SchedPlain S; S.T.init(M / 256, 4); S.G = G; S.c = bx; S.A = (const char*)(ws + WS_R2 + R2_YPRE); S.B = (const char*)(ws + WS_WO) + (size_t)l * D * D * 2; S.C = (char*)(ws + WS_R2 + R2_Z);
            S.lda = D; S.ldb = D; S.ldc = D;
            pg8::EpiStore E;
            pg8::gemm_phase<false>(lds, D * 2, D * 2, D * 2, S, E, wave);
        }
        SEAM(pb + 6);
        _Pragma("unroll 1") for (int rep_ = 0; rep_ < NREP(7); ++rep_) if (((PHMASK>>7)&1) && IN(pb + 7)) { PHASE_TID
            LAS float* WR = (LAS float*)lds;
            for (int i = tid; i < 32768; i += NTHR) { const int k = i >> 5, e = i & 31; WR[e * 1024 + k] = INP(I_RTW)[((size_t)l * D + k) * 32 + e]; }
            __syncthreads();
            f32x4 g[4], bb[4];
#pragma unroll
            for (int j = 0; j < 4; ++j) { g[j] = *(const f32x4*)(INP(I_LN1G) + l * D + 256 * j + 4 * lane); bb[j] = *(const f32x4*)(INP(I_LN1B) + l * D + 256 * j + 4 * lane); }
            const float rbias = INP(I_RTB)[l * 32 + (lane & 31)];
            const char* Zb = (const char*)(ws + WS_R2 + R2_Z);
            int* TKE = (int*)(ws + WS_TKE); float* TKG = (float*)(ws + WS_TKG); int* TKP = (int*)(ws + WS_TKP); int* ROWTOK = (int*)(ws + WS_ROWTOK);
            LAS unsigned* LCNT = (LAS unsigned*)(lds + 131072);
            LAS unsigned* GBASE = LCNT + 32; LAS unsigned* LLEN = LCNT + 64; LAS unsigned* LIST = LCNT + 128;
            if (tid < 65) LCNT[tid] = 0u;
            __syncthreads();
#pragma unroll 1
            for (int pp = gw; pp < M / 2; pp += NGW) {
                f32x4 y0[4], y1[4];
#pragma unroll
                for (int j = 0; j < 4; ++j) { y0[j] = ld4bf(Zb + ((size_t)(2 * pp) * D + 256 * j + 4 * lane) * 2) + ld4bf(Xb + ((size_t)(2 * pp) * D + 256 * j + 4 * lane) * 2) * DN_ALPHA;
                    y1[j] = ld4bf(Zb + ((size_t)(2 * pp + 1) * D + 256 * j + 4 * lane) * 2) + ld4bf(Xb + ((size_t)(2 * pp + 1) * D + 256 * j + 4 * lane) * 2) * DN_ALPHA; }
                ln16(y0, g, bb); ln16(y1, g, bb);
#pragma unroll
                for (int j = 0; j < 4; ++j) { st4bf(Xb + ((size_t)(2 * pp) * D + 256 * j + 4 * lane) * 2, y0[j]); st4bf(Xb + ((size_t)(2 * pp + 1) * D + 256 * j + 4 * lane) * 2, y1[j]); }
                float v[64];
#pragma unroll
                for (int e = 0; e < 32; ++e) { float s0 = 0.f, s1 = 0.f;
#pragma unroll
                    for (int j = 0; j < 4; ++j) { const f32x4 w = *(const LAS f32x4*)(WR + e * 1024 + 256 * j + 4 * lane);
                        s0 += (y0[j].x * w.x + y0[j].y * w.y) + (y0[j].z * w.z + y0[j].w * w.w); s1 += (y1[j].x * w.x + y1[j].y * w.y) + (y1[j].z * w.z + y1[j].w * w.w); }
                    v[e] = s0; v[32 + e] = s1; if ((e & 3) == 3) __builtin_amdgcn_sched_barrier(0); }
#pragma unroll
                for (int bsh = 5; bsh >= 0; --bsh) { const int n2 = 1 << bsh; const bool up = (lane >> bsh) & 1;
#pragma unroll
                    for (int i = 0; i < n2; ++i) { const float send = up ? v[i] : v[i + n2], keep = up ? v[i + n2] : v[i]; v[i] = keep + __shfl_xor(send, n2); } }
                float cur = v[0] + rbias;
                const int half = lane >> 5, el = lane & 31;
                float tv[4]; int te[4];
#pragma unroll
                for (int k = 0; k < 4; ++k) { float mx = cur;
#pragma unroll
                    for (int o = 1; o < 32; o <<= 1) mx = fmaxf(mx, __shfl_xor(mx, o));
                    const unsigned long long bal = __ballot(cur == mx); const unsigned hm = (unsigned)(bal >> (32 * half));
                    const int win = __builtin_ctz(hm); tv[k] = mx; te[k] = win; if (el == win) cur = -3.0e38f; }
                const float e1 = __expf(tv[1] - tv[0]), e2 = __expf(tv[2] - tv[0]), e3 = __expf(tv[3] - tv[0]), rs = 1.f / (1.f + e1 + e2 + e3);
                const float gt[4] = {rs, e1 * rs, e2 * rs, e3 * rs};
                const int token = 2 * pp + half;
#pragma unroll
                for (int k = 0; k < 4; ++k) if (el == te[k] && rep_ == 0) {
                    const unsigned lpos = __hip_atomic_fetch_add(LCNT + el, 1u, __ATOMIC_RELAXED, __HIP_MEMORY_SCOPE_WORKGROUP);
                    const unsigned li = __hip_atomic_fetch_add(LLEN, 1u, __ATOMIC_RELAXED, __HIP_MEMORY_SCOPE_WORKGROUP);
                    LIST[2 * li] = (unsigned)(token * 4 + k); LIST[2 * li + 1] = (unsigned)el | (lpos << 8);
                    TKE[token * 4 + k] = el; TKG[token * 4 + k] = gt[k]; }
            }
            __syncthreads();
            if (tid < 32 && rep_ == 0) GBASE[tid] = __hip_atomic_fetch_add((unsigned*)ctl + CW_CNT + (l * 32 + tid) * 64, LCNT[tid], RLX_AGENT);
            __syncthreads();
            if (rep_ == 0) { const unsigned n = LLEN[0];
                for (unsigned i = tid; i < n; i += NTHR) { const unsigned tk = LIST[2 * i], ev = LIST[2 * i + 1], e = ev & 255u, pos = GBASE[e] + (ev >> 8);
                    TKP[tk] = (int)pos; ROWTOK[(size_t)e * M + pos] = (int)(tk >> 2); } }
            __syncthreads();
        }
        SEAM(pb + 7);
        _Pragma("unroll 1") for (int rep_ = 0; rep_ < NREP(8); ++rep_) if (((PHMASK>>8)&1) && IN(pb + 8)) { PHASE_TID
            if (tid < 32) CNT[tid] = (int)__hip_atomic_load((unsigned*)ctl + CW_CNT + (l * 32 + tid) * 64, RLX_AGENT);
            __syncthreads();
            if (tid == 0) { int a = 0; for (int e = 0; e < 32; ++e) { PB[e] = a; a += (CNT[e] + 255) >> 8; } PB[32] = a; }
            __syncthreads();
            const int P = PB[32];
            const int* ROWTOK = (const int*)(ws + WS_ROWTOK);
            char* XD = (char*)(ws + WS_R1);
            for (int sb = gw * 64; sb < P * 256; sb += NGW * 64) {
                const int pm = sb >> 8; int e = 0;
#pragma unroll 1
                for (int j = 1; j < NEXP; ++j) e += (PB[j] <= pm) ? 1 : 0;
                const int pos0 = sb - PB[e] * 256, cnt = CNT[e];
                int nvalid = cnt - pos0; nvalid = nvalid > 64 ? 64 : nvalid;
                int tokv = -1; if (pos0 + lane < cnt) tokv = ROWTOK[(size_t)e * M + pos0 + lane];
#pragma unroll 1
                for (int j = 0; j < nvalid; j += 2) {
                    int t[2]; u32x4 a[2], b2[2];
#pragma unroll
                    for (int i = 0; i < 2; ++i) { t[i] = __builtin_amdgcn_readlane(tokv, j + i);
                        if (t[i] >= 0) { a[i] = *(const u32x4*)(Xb + (size_t)t[i] * 2048 + lane * 32); b2[i] = *(const u32x4*)(Xb + (size_t)t[i] * 2048 + lane * 32 + 16); } }
#pragma unroll
                    for (int i = 0; i < 2; ++i) if (t[i] >= 0) {
                        u32x4 o; o.x = pk4_f8(bflo(a[i].x) * F8_SX, bfhi(a[i].x) * F8_SX, bflo(a[i].y) * F8_SX, bfhi(a[i].y) * F8_SX); o.y = pk4_f8(bflo(a[i].z) * F8_SX, bfhi(a[i].z) * F8_SX, bflo(a[i].w) * F8_SX, bfhi(a[i].w) * F8_SX);
                        o.z = pk4_f8(bflo(b2[i].x) * F8_SX, bfhi(b2[i].x) * F8_SX, bflo(b2[i].y) * F8_SX, bfhi(b2[i].y) * F8_SX); o.w = pk4_f8(bflo(b2[i].z) * F8_SX, bfhi(b2[i].z) * F8_SX, bflo(b2[i].w) * F8_SX, bfhi(b2[i].w) * F8_SX);
                        *(u32x4*)(XD + (size_t)(sb + j + i) * 1024 + lane * 16) = o; }
                }
            }
            LAS float* scr = (LAS float*)(lds + wave * 8448);
            constexpr int IT_GU = 32 * 16 * 64, IT_DN = 32 * 16 * 32;
            for (int it = XW_SPLIT + gw; it < IT_GU + IT_DN; it += NGW) {
                if (it < IT_GU) { const int e = it >> 10, q = it & 1023, kb = q >> 6, nb = q & 63;
                    transpose_item_f8(INP(I_WGU) + (((size_t)l * 32 + e) * D + 64 * kb) * 2048 + 32 * nb, 2048, (unsigned char*)(ws + WS_WGU) + ((size_t)e * 2048 + 32 * nb) * D + 64 * kb, D, F8_SWGU, scr, lane); }
                else { const int r = it - IT_GU, e = r >> 9, q = r & 511, kb = q >> 5, nb = q & 31;
                    transpose_item_f8(INP(I_WDN) + (((size_t)l * 32 + e) * D + 64 * kb) * 1024 + 32 * nb, 1024, (unsigned char*)(ws + WS_WDN) + ((size_t)e * 1024 + 32 * nb) * D + 64 * kb, D, F8_SWDN, scr, lane); }
            }
            __syncthreads();
        }
        SEAM(pb + 8);
        if (IN(pb + 9) || IN(pb + 10)) { PHASE_TID
            if (tid < 32) CNT[tid] = (int)__hip_atomic_load((unsigned*)ctl + CW_CNT + (l * 32 + tid) * 64, RLX_AGENT);
            __syncthreads();
            if (tid == 0) { int a = 0; for (int e = 0; e < 32; ++e) { PB[e] = a; a += (CNT[e] + 255) >> 8; } PB[32] = a; }
            __syncthreads();
        }
        _Pragma("unroll 1") for (int rep_ = 0; rep_ < NREP(9); ++rep_) if (((PHMASK>>9)&1) && IN(pb + 9)) {
            SchedMoe S; S.T.init(PB[32], 8); S.G = G; S.c = bx; S.A = (const char*)(ws + WS_R1); S.W = (const char*)(ws + WS_WGU); S.C = (char*)(ws + WS_R2 + R2_HMID); S.PB = PB; S.wrows = 2048; S.ldc = 1024; S.cdiv = 2; S.osz = 1;
            pg8::EpiMoe1 E; E.bgu = INP(I_BGU) + (size_t)l * 32 * 2048;
            pg8::gemm_phase<true>(lds, D, D, D, S, E, wave);
        }
        SEAM(pb + 9);
        _Pragma("unroll 1") for (int rep_ = 0; rep_ < NREP(10); ++rep_) if (((PHMASK>>10)&1) && IN(pb + 10)) {
            SchedMoe S; S.T.init(PB[32], 4); S.G = G; S.c = bx; S.A = (const char*)(ws + WS_R2 + R2_HMID); S.W = (const char*)(ws + WS_WDN); S.C = (char*)(ws + WS_R1); S.PB = PB; S.wrows = 1024; S.ldc = 1024; S.cdiv = 1; S.osz = 2;
            pg8::EpiMoe2 E; E.bdn = INP(I_BDN) + (size_t)l * 32 * 1024;
            pg8::gemm_phase<true>(lds, D, D, D, S, E, wave);
        }
        SEAM(pb + 10);
        _Pragma("unroll 1") for (int rep_ = 0; rep_ < NREP(11); ++rep_) if (((PHMASK>>11)&1) && IN(pb + 11)) { PHASE_TID
            if (tid < 32) CNT[tid] = (int)__hip_atomic_load((unsigned*)ctl + CW_CNT + (l * 32 + tid) * 64, RLX_AGENT);
            LAS float* wgt = (LAS float*)(lds + 73728);
            const bool lastl = (l == DEPTH - 1);
            if (!lastl) load_gate_table(wgt, INP(I_WIN) + (size_t)(l + 1) * D * DIN, tid);
            __syncthreads();
            if (tid == 0) { int a = 0; for (int e = 0; e < 32; ++e) { PB[e] = a; a += (CNT[e] + 255) >> 8; } PB[32] = a; }
            __syncthreads();
            const int e0 = 8 * lane;
            f32x4 g[4], bb[4];
#pragma unroll
            for (int j = 0; j < 4; ++j) { const int o = (j >> 1) * 512 + e0 + (j & 1) * 4; g[j] = *(const f32x4*)(INP(I_LN2G) + l * D + o); bb[j] = *(const f32x4*)(INP(I_LN2B) + l * D + o); }
            const char* YA = (const char*)(ws + WS_R1);
            const bool dummy_ = (rep_ + 1 < NREP(11)); char* const Xo = dummy_ ? (char*)(ws + WS_R2) : Xb; float* const Fo = dummy_ ? (float*)(ws + WS_R2 + 256 * MiB) : args.out; float* const Go = dummy_ ? (float*)(ws + WS_R2 + 200 * MiB) : GIF;
            const int* TKE = (const int*)(ws + WS_TKE); const float* TKG = (const float*)(ws + WS_TKG); const int* TKP = (const int*)(ws + WS_TKP);
#pragma unroll 1
            for (int mb = gw * 16; mb < M; mb += NGW * 16) {
                const int ev = TKE[mb * 4 + lane], pv = TKP[mb * 4 + lane]; const float gv = TKG[mb * 4 + lane];
                const int rowv = PB[ev] * 256 + pv;
#pragma unroll 1
                for (int ti = 0; ti < 16; ti += 2) {
                    u32x4 xw[2][2], yw[2][4][2]; float gk[2][4];
#pragma unroll
                    for (int q = 0; q < 2; ++q) { const size_t m = (size_t)mb + ti + q;
                        xw[q][0] = *(const u32x4*)(Xb + (m * D + e0) * 2); xw[q][1] = *(const u32x4*)(Xb + (m * D + 512 + e0) * 2);
#pragma unroll
                        for (int k = 0; k < 4; ++k) { const size_t row = (size_t)__builtin_amdgcn_readlane(rowv, 4 * (ti + q) + k);
                            gk[q][k] = __builtin_bit_cast(float, __builtin_amdgcn_readlane(__builtin_bit_cast(int, gv), 4 * (ti + q) + k));
                            yw[q][k][0] = *(const u32x4*)(YA + (row * D + e0) * 2); yw[q][k][1] = *(const u32x4*)(YA + (row * D + 512 + e0) * 2); } }
#pragma unroll
                    for (int q = 0; q < 2; ++q) { const size_t m = (size_t)mb + ti + q;
                        f32x4 v[4];
#pragma unroll
                        for (int hh = 0; hh < 2; ++hh) { const u32x4 w = xw[q][hh];
                            v[2 * hh] = (f32x4){bflo(w.x), bfhi(w.x), bflo(w.y), bfhi(w.y)} * DN_ALPHA; v[2 * hh + 1] = (f32x4){bflo(w.z), bfhi(w.z), bflo(w.w), bfhi(w.w)} * DN_ALPHA; }
#pragma unroll
                        for (int k = 0; k < 4; ++k)
#pragma unroll
                            for (int hh = 0; hh < 2; ++hh) { const u32x4 w = yw[q][k][hh];
                                v[2 * hh] = v[2 * hh] + (f32x4){bflo(w.x), bfhi(w.x), bflo(w.y), bfhi(w.y)} * gk[q][k]; v[2 * hh + 1] = v[2 * hh + 1] + (f32x4){bflo(w.z), bfhi(w.z), bflo(w.w), bfhi(w.w)} * gk[q][k]; }
                        ln16(v, g, bb);
                        if (lastl) {
#pragma unroll
                            for (int j = 0; j < 4; ++j) *(f32x4*)(Fo + m * D + (j >> 1) * 512 + e0 + (j & 1) * 4) = v[j];
                        } else {
#pragma unroll
                            for (int hh = 0; hh < 2; ++hh) { *(u32x4*)(Xo + (m * D + hh * 512 + e0) * 2) = pg8::pack8(v[2 * hh], v[2 * hh + 1]);
                                u32x2 f8w; f8w.x = pk4_f8(v[2 * hh].x * F8_SX, v[2 * hh].y * F8_SX, v[2 * hh].z * F8_SX, v[2 * hh].w * F8_SX); f8w.y = pk4_f8(v[2 * hh + 1].x * F8_SX, v[2 * hh + 1].y * F8_SX, v[2 * hh + 1].z * F8_SX, v[2 * hh + 1].w * F8_SX);
                                if (!dummy_) *(u32x2*)((char*)(ws + WS_XF8) + m * D + hh * 512 + e0) = f8w; }
                            gates8b(v, wgt, Go + m * 8, lane);
                        }
                    }
                }
            }
            __syncthreads();
        }
        SEAM(pb + 11);
    }
#undef IN
#undef SEAM
}

extern "C" void kernel_launch(void* const* d_in, const int* in_sizes, int n_in, void* d_out, int out_size, void* d_ws, size_t ws_size, hipStream_t stream) {
    static int grid = 0;
    if (grid == 0) {
        if (n_in != N_IN || out_size != M * D || ws_size < WS_END) { fprintf(stderr, "kernel_launch: unexpected shapes (n_in %d, out %d, ws %zu)\n", n_in, out_size, ws_size); grid = -1; return; }
        int dev = 0, cus = 0, per_cu = 0;
        if (hipGetDevice(&dev) != hipSuccess || hipDeviceGetAttribute(&cus, hipDeviceAttributeMultiprocessorCount, dev) != hipSuccess) { grid = -1; return; }
        if (hipFuncSetAttribute((const void*)fwd_kernel, hipFuncAttributeMaxDynamicSharedMemorySize, LDS_BYTES) != hipSuccess) { fprintf(stderr, "kernel_launch: hipFuncSetAttribute failed\n"); grid = -1; return; }
        if (hipOccupancyMaxActiveBlocksPerMultiprocessor(&per_cu, (const void*)fwd_kernel, NTHR, LDS_BYTES) != hipSuccess || per_cu < 1) fprintf(stderr, "kernel_launch: occupancy query reports %d\n", per_cu);
        (void)hipGetLastError();
        grid = cus;
    }
    if (grid < 0) return;
    (void)hipMemsetAsync((char*)d_ws + WS_CTL, 0, CTL_ZERO_BYTES, stream);
    Args a{};
    for (int i = 0; i < N_IN; ++i) a.in[i] = (const float*)d_in[i];
    a.out = (float*)d_out; a.ws = (unsigned char*)d_ws;
#if MK_ONE_LAUNCH
    a.ph_lo = 0; a.ph_hi = NPH;
    hipLaunchKernelGGL(fwd_kernel, dim3(grid), dim3(NTHR), LDS_BYTES, stream, a);
#else
    for (int p = 0; p < NPH; ++p) { a.ph_lo = p; a.ph_hi = p + 1; hipLaunchKernelGGL(fwd_kernel, dim3(grid), dim3(NTHR), LDS_BYTES, stream, a); }
#endif
    const hipError_t le = hipPeekAtLastError();
    if (le != hipSuccess) fprintf(stderr, "kernel_launch: launch failed: %s\n", hipGetErrorName(le));
}
```

```cpp
#include <hip/hip_runtime.h>
#include <cstdio>
#include <cstdint>

#ifndef MK_ONE_LAUNCH
#define MK_ONE_LAUNCH 1
#endif

#define LAS __attribute__((address_space(3)))
#define GAS __attribute__((address_space(1)))
typedef unsigned short bf16;
typedef short bf16x8 __attribute__((ext_vector_type(8)));
typedef float f32x4 __attribute__((ext_vector_type(4)));
typedef float f32x2 __attribute__((ext_vector_type(2)));
typedef float f32x16 __attribute__((ext_vector_type(16)));
typedef unsigned u32x4 __attribute__((ext_vector_type(4)));
typedef unsigned u32x2 __attribute__((ext_vector_type(2)));
typedef __bf16 bf16x2_t __attribute__((ext_vector_type(2)));
typedef GAS unsigned gu32;
#define RLX_AGENT __ATOMIC_RELAXED, __HIP_MEMORY_SCOPE_AGENT
#define DI __device__ __forceinline__

constexpr int NWAVES = 8, NTHR = 512;
constexpr int D = 1024, BATCH = 16, SEQ = 4096, M = BATCH * SEQ, DEPTH = 2, MEML = 256, MROWS = BATCH * MEML;
constexpr int DIN = 6920, NU = 6912;
constexpr int UC_QK = 0, UC_V = 512, UC_OG = 1024, UC_RW = 1536, UC_CAQ = 3328, UC_GATE = 3840;
constexpr int NEXP = 32, TOPK = 4;
constexpr int PMAX = M * TOPK / 256 + NEXP;
constexpr float LN_EPS = 1e-5f, RW_GN_EPS = 64e-5f, DN_ALPHA = 1.41421356237f;

enum { I_X = 0, I_MEM, I_LNIN_G, I_LNIN_B, I_MEMLN_G, I_MEMLN_B, I_WIN, I_CONVW, I_CONVB, I_IGB, I_FGB, I_MLNORMG, I_RWMU, I_RWW0, I_RWWUP, I_RWA0, I_RWAUP, I_RWGUP,
       I_RWKK, I_RWKA, I_RWRK, I_RWLNG, I_RWLNB, I_CAWKV, I_GATEB, I_WBRML, I_WBRRW, I_WBRCA, I_WO, I_LN1G, I_LN1B, I_RTW, I_RTB, I_WGU, I_BGU, I_WDN, I_BDN, I_LN2G, I_LN2B, N_IN };

constexpr size_t MiB = 1u << 20;
constexpr size_t WS_CTL = 0, CTL_ZERO_BYTES = 1 * MiB;
constexpr size_t WS_WIN = 1 * MiB;
constexpr size_t WS_WKV = 28 * MiB;
constexpr size_t WS_WBR = 32 * MiB;
constexpr size_t WS_WO = 38 * MiB;
constexpr size_t WS_WLORA = 42 * MiB;
constexpr size_t WS_WGU = 45 * MiB;
constexpr size_t WS_WDN = 173 * MiB;
constexpr size_t WS_X = 237 * MiB;
constexpr size_t WS_MEMN = 365 * MiB;
constexpr size_t WS_KV = 373 * MiB;
constexpr size_t WS_GIF = 389 * MiB;
constexpr size_t WS_TKE = 391 * MiB, WS_TKG = 392 * MiB, WS_TKP = 393 * MiB;
constexpr size_t WS_ROWTOK = 394 * MiB;
constexpr size_t WS_HML = 402 * MiB;
constexpr size_t WS_R1 = 466 * MiB;
constexpr size_t WS_R2 = 1330 * MiB;
constexpr size_t WS_XF8 = 1858 * MiB;
constexpr size_t WS_WING8 = 1922 * MiB;
constexpr size_t WS_END = 1930 * MiB;
constexpr size_t R2_LORA_OUT = 0, R2_HCAT = 192 * MiB, R2_LORA_IN = 384 * MiB, R2_YPRE = 0, R2_Z = 192 * MiB, R2_HMID = 0;
constexpr int CW_TMO = 0, CW_BAR = 4096, CW_CNT = 16384;

constexpr int LDS_BYTES = 155648;
constexpr int LDSCTL_OFF = 153600;

DI unsigned f2bf(float f) { unsigned u = __builtin_bit_cast(unsigned, f); return (u + 0x7fffu + ((u >> 16) & 1u)) >> 16; }
DI unsigned pk2(float lo, float hi) { bf16x2_t b = __builtin_convertvector((f32x2){lo, hi}, bf16x2_t); return __builtin_bit_cast(unsigned, b); }
DI float bflo(unsigned u) { return __builtin_bit_cast(float, u << 16); }
DI float bfhi(unsigned u) { return __builtin_bit_cast(float, u & 0xffff0000u); }
DI unsigned pk4_f8(float a, float b, float c, float d) {
    a = __builtin_amdgcn_fmed3f(a, -448.f, 448.f); b = __builtin_amdgcn_fmed3f(b, -448.f, 448.f); c = __builtin_amdgcn_fmed3f(c, -448.f, 448.f); d = __builtin_amdgcn_fmed3f(d, -448.f, 448.f);
    int w = 0; w = __builtin_amdgcn_cvt_pk_fp8_f32(a, b, w, false); w = __builtin_amdgcn_cvt_pk_fp8_f32(c, d, w, true); return (unsigned)w; }
DI float sigmoidf_(float x) { return __builtin_amdgcn_rcpf(1.f + __builtin_amdgcn_exp2f(-1.4426950408889634f * x)); }
template <int CTRL> DI float dppf(float x) { return __builtin_bit_cast(float, __builtin_amdgcn_update_dpp(0, __builtin_bit_cast(int, x), CTRL, 0xF, 0xF, true)); }
DI float red4(float x) { x += dppf<0xB1>(x); x += dppf<0x4E>(x); return x; }
DI float red8(float x) { x = red4(x); x += dppf<0x141>(x); return x; }
DI float red16(float x) { x = red8(x); x += dppf<0x140>(x); return x; }
DI float red8o(float x) { x += dppf<0xB1>(x); asm("" : "+v"(x)); x += dppf<0x4E>(x); asm("" : "+v"(x)); x += dppf<0x141>(x); asm("" : "+v"(x)); return x; }
DI float red16o(float x) { x = red8o(x); x += dppf<0x140>(x); asm("" : "+v"(x)); return x; }
DI float wave_sum(float v) {
    v = red16(v);
    const int vi = __builtin_bit_cast(int, v);
    const float a = __builtin_bit_cast(float, __builtin_amdgcn_readlane(vi, 0)), b = __builtin_bit_cast(float, __builtin_amdgcn_readlane(vi, 16));
    const float c = __builtin_bit_cast(float, __builtin_amdgcn_readlane(vi, 32)), d = __builtin_bit_cast(float, __builtin_amdgcn_readlane(vi, 48));
    return (a + b) + (c + d);
}
#define LDS_WAIT() asm volatile("s_waitcnt lgkmcnt(0)" ::: "memory")

constexpr float F8_SX = 8.f, F8_SWGU = 512.f, F8_SH = 4.f, F8_SWDN = 1024.f, F8_INV1 = 1.f / (F8_SX * F8_SWGU), F8_INV2 = 1.f / (F8_SH * F8_SWDN);
namespace pg8 {
constexpr int BM = 256, BK = 64, HALF = 128, HTB = HALF * BK * 2, STAGE_BYTES = 8 * HTB, NXCD = 8, WGM = 8;
__host__ __device__ __forceinline__ int lds_byte(int r, int c) { const int st = (r >> 4) * 2 + (c >> 5), rr = r & 15, cc = c & 31, ob = rr * 64 + cc * 2; return st * 1024 + (ob ^ (((ob >> 9) & 1) << 5)); }
__host__ __device__ __forceinline__ void stage_rc(int b, int& R, int& C) { const int st = b / 1024, sb = b % 1024, swz = sb ^ (((sb >> 9) & 1) << 5); R = (st >> 1) * 16 + swz / 64; C = (st & 1) * 32 + (swz % 64) / 2; }
__host__ __device__ __forceinline__ int perm32(int rho) { const int n = rho >> 4, i = rho & 15; return 8 * (i >> 2) + 4 * n + (i & 3); }

struct Unit { const char* a; const char* b; char* c; int ldc; int r0, c0, e, sub; };

struct TileOrder {
    int nM, nN, nwg;
    DI void init(int nM_, int nN_) { nM = nM_; nN = nN_; nwg = nM * nN; }
    DI bool tile(long L, int& pm, int& pn) const {
        if (L >= nwg) return false;
        int wgid = (int)L; { const int q = nwg / NXCD, r = nwg % NXCD, xcd = wgid % NXCD, off = wgid / NXCD; wgid = (xcd < r ? xcd * (q + 1) : r * (q + 1) + (xcd - r) * q) + off; }
        const int nig = WGM * nN, gid = wgid / nig, fm = gid * WGM, gsz = (nM - fm) < WGM ? (nM - fm) : WGM;
        pm = fm + ((wgid % nig) % gsz); pn = (wgid % nig) / gsz; return true;
    }
};

DI u32x4 pack8(const f32x4& v0, const f32x4& v1) { u32x4 w; w.x = pk2(v0[0], v0[1]); w.y = pk2(v0[2], v0[3]); w.z = pk2(v1[0], v1[1]); w.w = pk2(v1[2], v1[3]); return w; }

struct EpiStore {
    DI void operator()(const f32x4 (&acc)[2][2][4][2], const Unit& u, int wr, int wc, int fr, int fq) const {
#pragma unroll
        for (int ai = 0; ai < 2; ++ai)
#pragma unroll
            for (int m = 0; m < 4; ++m) { char* rowp = u.c + ((size_t)(ai * HALF + wr * 64 + m * 16 + fr) * u.ldc + wc * 32 + 8 * fq) * 2;
#pragma unroll
                for (int bj = 0; bj < 2; ++bj) *(u32x4*)(rowp + bj * 256) = pack8(acc[ai][bj][m][0], acc[ai][bj][m][1]); }
    }
};
struct EpiStoreS {
    float s;
    DI void operator()(const f32x4 (&acc)[2][2][4][2], const Unit& u, int wr, int wc, int fr, int fq) const {
#pragma unroll
        for (int ai = 0; ai < 2; ++ai)
#pragma unroll
            for (int m = 0; m < 4; ++m) { char* rowp = u.c + ((size_t)(ai * HALF + wr * 64 + m * 16 + fr) * u.ldc + wc * 32 + 8 * fq) * 2;
#pragma unroll
                for (int bj = 0; bj < 2; ++bj) *(u32x4*)(rowp + bj * 256) = pack8(acc[ai][bj][m][0] * s, acc[ai][bj][m][1] * s); }
    }
};
struct EpiMerge {
    static constexpr bool MIDK = true;
    const char* U; const float* gate_b;
    DI void mid(f32x4 (&acc)[2][2][4][2], const Unit& u, int which, int wr, int wc, int fr, int fq) const {
        const float L2E = 1.4426950408889634f;
#pragma unroll
        for (int bj = 0; bj < 2; ++bj) {
            const float* g = gate_b + which * 1024 + u.c0 + bj * HALF + wc * 32 + 8 * fq;
            const f32x4 ga0 = *(const f32x4*)g, ga1 = *(const f32x4*)(g + 4), gn0 = *(const f32x4*)(g + 1024), gn1 = *(const f32x4*)(g + 1028);
            const float gaa[8] = {ga0.x, ga0.y, ga0.z, ga0.w, ga1.x, ga1.y, ga1.z, ga1.w}, gnn[8] = {gn0.x, gn0.y, gn0.z, gn0.w, gn1.x, gn1.y, gn1.z, gn1.w};
#pragma unroll
            for (int ai = 0; ai < 2; ++ai)
#pragma unroll
                for (int m = 0; m < 4; ++m) { const int lr = ai * HALF + wr * 64 + m * 16 + fr;
                    const char* gp = U + ((size_t)(u.r0 + lr) * NU + UC_GATE + which * 1024 + u.c0 + wc * 32 + 8 * fq) * 2 + bj * 256;
                    const u32x4 wa = *(const u32x4*)gp, wn = *(const u32x4*)(gp + 2048);
                    const float xa[8] = {bflo(wa.x), bfhi(wa.x), bflo(wa.y), bfhi(wa.y), bflo(wa.z), bfhi(wa.z), bflo(wa.w), bfhi(wa.w)};
                    const float xn[8] = {bflo(wn.x), bfhi(wn.x), bflo(wn.y), bfhi(wn.y), bflo(wn.z), bfhi(wn.z), bflo(wn.w), bfhi(wn.w)};
#pragma unroll
                    for (int i = 0; i < 8; ++i) { const float ea = __builtin_amdgcn_exp2f(-L2E * __builtin_amdgcn_fmed3f(xa[i] + gaa[i], -30.f, 30.f)), en = __builtin_amdgcn_exp2f(-L2E * __builtin_amdgcn_fmed3f(xn[i] + gnn[i], -30.f, 30.f));
                        acc[ai][bj][m][i >> 2][i & 3] *= (1.f + en) * __builtin_amdgcn_rcpf(1.f + ea); }
                    if (m & 1) asm volatile("" ::: "memory"); }
        }
    }
    DI void operator()(const f32x4 (&acc)[2][2][4][2], const Unit& u, int wr, int wc, int fr, int fq) const {
        f32x4 gb[2][2];
#pragma unroll
        for (int bj = 0; bj < 2; ++bj) { const float* g = gate_b + 2048 + u.c0 + bj * HALF + wc * 32 + 8 * fq; gb[bj][0] = *(const f32x4*)g; gb[bj][1] = *(const f32x4*)(g + 4); }
#pragma unroll
        for (int ai = 0; ai < 2; ++ai)
#pragma unroll
            for (int m = 0; m < 4; ++m) { const int lr = ai * HALF + wr * 64 + m * 16 + fr; char* rowp = u.c + ((size_t)lr * u.ldc + wc * 32 + 8 * fq) * 2;
                const char* gp = U + ((size_t)(u.r0 + lr) * NU + UC_GATE + 2048 + u.c0 + wc * 32 + 8 * fq) * 2;
#pragma unroll
                for (int bj = 0; bj < 2; ++bj) { const u32x4 gw = *(const u32x4*)(gp + bj * 256);
                    f32x4 v0 = acc[ai][bj][m][0], v1 = acc[ai][bj][m][1];
                    v0[0] *= sigmoidf_(bflo(gw.x) + gb[bj][0][0]); v0[1] *= sigmoidf_(bfhi(gw.x) + gb[bj][0][1]); v0[2] *= sigmoidf_(bflo(gw.y) + gb[bj][0][2]); v0[3] *= sigmoidf_(bfhi(gw.y) + gb[bj][0][3]);
                    v1[0] *= sigmoidf_(bflo(gw.z) + gb[bj][1][0]); v1[1] *= sigmoidf_(bfhi(gw.z) + gb[bj][1][1]); v1[2] *= sigmoidf_(bflo(gw.w) + gb[bj][1][2]); v1[3] *= sigmoidf_(bfhi(gw.w) + gb[bj][1][3]);
                    *(u32x4*)(rowp + bj * 256) = pack8(v0, v1); }
                asm volatile("" ::: "memory"); }
    }
};
struct EpiWo {
    const char* X;
    DI void operator()(const f32x4 (&acc)[2][2][4][2], const Unit& u, int wr, int wc, int fr, int fq) const {
#pragma unroll
        for (int ai = 0; ai < 2; ++ai)
#pragma unroll
            for (int m = 0; m < 4; ++m) { const int lr = ai * HALF + wr * 64 + m * 16 + fr; char* rowp = u.c + ((size_t)lr * u.ldc + wc * 32 + 8 * fq) * 2;
                const char* xp = X + ((size_t)(u.r0 + lr) * D + u.c0 + wc * 32 + 8 * fq) * 2;
#pragma unroll
                for (int bj = 0; bj < 2; ++bj) { const u32x4 xw = *(const u32x4*)(xp + bj * 256);
                    f32x4 v0 = acc[ai][bj][m][0], v1 = acc[ai][bj][m][1];
                    v0[0] += DN_ALPHA * bflo(xw.x); v0[1] += DN_ALPHA * bfhi(xw.x); v0[2] += DN_ALPHA * bflo(xw.y); v0[3] += DN_ALPHA * bfhi(xw.y);
                    v1[0] += DN_ALPHA * bflo(xw.z); v1[1] += DN_ALPHA * bfhi(xw.z); v1[2] += DN_ALPHA * bflo(xw.w); v1[3] += DN_ALPHA * bfhi(xw.w);
                    *(u32x4*)(rowp + bj * 256) = pack8(v0, v1); }
                asm volatile("" ::: "memory"); }
    }
};
DI float swiglu1(float a, float b) { const float g = fminf(a, 7.f), l = fminf(fmaxf(b, -7.f), 7.f); return g * sigmoidf_(1.702f * g) * (l + 1.f); }
struct EpiMoe1 {
    const float* bgu;
    DI void operator()(const f32x4 (&acc)[2][2][4][2], const Unit& u, int wr, int wc, int fr, int fq) const {
        f32x4 bv[2][2];
#pragma unroll
        for (int bj = 0; bj < 2; ++bj) { const float* b = bgu + u.e * 2048 + u.c0 + bj * HALF + wc * 32 + 8 * fq; bv[bj][0] = *(const f32x4*)b; bv[bj][1] = *(const f32x4*)(b + 4); }
#pragma unroll
        for (int ai = 0; ai < 2; ++ai)
#pragma unroll
            for (int m = 0; m < 4; ++m) { const int lr = ai * HALF + wr * 64 + m * 16 + fr; char* rowp = u.c + ((size_t)lr * u.ldc + wc * 16 + 4 * fq);
#pragma unroll
                for (int bj = 0; bj < 2; ++bj) { const f32x4 v0 = acc[ai][bj][m][0] * F8_INV1 + bv[bj][0], v1 = acc[ai][bj][m][1] * F8_INV1 + bv[bj][1];
                    *(unsigned*)(rowp + bj * 64) = pk4_f8(swiglu1(v0[0], v0[1]) * F8_SH, swiglu1(v0[2], v0[3]) * F8_SH, swiglu1(v1[0], v1[1]) * F8_SH, swiglu1(v1[2], v1[3]) * F8_SH); } }
    }
};
struct EpiMoe2 {
    const float* bdn;
    DI void operator()(const f32x4 (&acc)[2][2][4][2], const Unit& u, int wr, int wc, int fr, int fq) const {
        f32x4 bv[2][2];
#pragma unroll
        for (int bj = 0; bj < 2; ++bj) { const float* b = bdn + u.e * 1024 + u.c0 + bj * HALF + wc * 32 + 8 * fq; bv[bj][0] = *(const f32x4*)b; bv[bj][1] = *(const f32x4*)(b + 4); }
#pragma unroll
        for (int ai = 0; ai < 2; ++ai)
#pragma unroll
            for (int m = 0; m < 4; ++m) { char* rowp = u.c + ((size_t)(ai * HALF + wr * 64 + m * 16 + fr) * u.ldc + wc * 32 + 8 * fq) * 2;
#pragma unroll
                for (int bj = 0; bj < 2; ++bj) *(u32x4*)(rowp + bj * 256) = pack8(acc[ai][bj][m][0] * F8_INV2 + bv[bj][0], acc[ai][bj][m][1] * F8_INV2 + bv[bj][1]); }
    }
};

typedef int i32x8 __attribute__((ext_vector_type(8)));
typedef int i32x4 __attribute__((ext_vector_type(4)));
template <bool F8, bool MIDK = false, class Epi, class Sched>
DI void gemm_phase(LAS unsigned char* lds, const int KB  , const int ldaB, const int ldbB, const Sched& S, const Epi& E, const int wave_) {
    unsigned z_ = 0u; asm volatile("" : "+v"(z_)); const int tid = wave_ * 64 + (int)__builtin_amdgcn_mbcnt_hi(~0u, __builtin_amdgcn_mbcnt_lo(~0u, z_));
    const int wid = __builtin_amdgcn_readfirstlane(tid >> 6), lane = tid & 63, wr = wid >> 2, wc = wid & 3, fr = lane & 15, fq = lane >> 4;
    const int nt = KB / (BK * 2);
    unsigned voffA[2], voffB[2];
#pragma unroll
    for (int i = 0; i < 2; ++i) { int R, C; stage_rc(tid * 16 + i * 8192, R, C); const int Rb = (R & ~31) + perm32(R & 31);
        voffA[i] = (unsigned)(R * ldaB + C * 2); voffB[i] = (unsigned)(Rb * ldbB + C * 2); }
    asm volatile("" : "+v"(voffA[0]), "+v"(voffA[1]), "+v"(voffB[0]), "+v"(voffB[1]));
    const size_t kstep = (size_t)(BK * 2);
    const size_t hstepA = (size_t)HALF * ldaB, hstepB = (size_t)HALF * ldbB;
    const unsigned ldsw = (unsigned)wid * 1024u;
    const int aoff = lds_byte(wr * 64 + fr, fq * 8), boff = lds_byte(wc * 32 + fr, fq * 8);
#define PG8_SA(b, h) (((b) * 2 + (h)) * HTB)
#define PG8_SB(b, h) ((4 + (b) * 2 + (h)) * HTB)
#define PG8_STAGE(bufoff, gbase, voff) do { _Pragma("unroll") for (int _i = 0; _i < 2; ++_i) \
        __builtin_amdgcn_global_load_lds((const unsigned*)((const char*)(gbase) + (voff)[_i]), (LAS unsigned*)(lds + (bufoff) + ldsw + _i * 8192), 16, 0, 0); } while (0)
#define PG8_LD8(p) __builtin_shufflevector(*(const LAS i32x4*)(p), *(const LAS i32x4*)((p) + 1024), 0, 1, 2, 3, 4, 5, 6, 7)
#define PG8_LDA8(dst, b, h) do { _Pragma("unroll") for (int m = 0; m < 4; ++m) dst[m] = PG8_LD8(lds + PG8_SA(b, h) + aoff + m * 2048); } while (0)
#define PG8_LDB8(dst, b, h) do { _Pragma("unroll") for (int n = 0; n < 2; ++n) dst[n] = PG8_LD8(lds + PG8_SB(b, h) + boff + n * 2048); } while (0)
#define PG8_MMA8(ai, bj, A8, B8) do { __builtin_amdgcn_s_setprio(1); _Pragma("unroll") for (int m = 0; m < 4; ++m) _Pragma("unroll") for (int n = 0; n < 2; ++n) \
        asm volatile("v_mfma_f32_16x16x128_f8f6f4 %0, %1, %2, %0" : "+v"(acc[ai][bj][m][n]) : "v"(B8[n]), "v"(A8[m])); __builtin_amdgcn_s_setprio(0); } while (0)
#define PG8_LDA(dst, b, h) do { _Pragma("unroll") for (int m = 0; m < 4; ++m) _Pragma("unroll") for (int k = 0; k < 2; ++k) dst[m][k] = *(const LAS bf16x8*)(lds + PG8_SA(b, h) + aoff + m * 2048 + k * 1024); } while (0)
#define PG8_LDB(dst, b, h) do { _Pragma("unroll") for (int n = 0; n < 2; ++n) _Pragma("unroll") for (int k = 0; k < 2; ++k) dst[n][k] = *(const LAS bf16x8*)(lds + PG8_SB(b, h) + boff + n * 2048 + k * 1024); } while (0)
#define PG8_CAT(x) __builtin_shufflevector(__builtin_bit_cast(i32x4, (x)[0]), __builtin_bit_cast(i32x4, (x)[1]), 0, 1, 2, 3, 4, 5, 6, 7)
#define PG8_MMA(ai, bj, At, Bt) do { __builtin_amdgcn_s_setprio(1); _Pragma("unroll") for (int m = 0; m < 4; ++m) _Pragma("unroll") for (int n = 0; n < 2; ++n) _Pragma("unroll") for (int k = 0; k < 2; ++k) \
        acc[ai][bj][m][n] = __builtin_amdgcn_mfma_f32_16x16x32_bf16(Bt[n][k], At[m][k], acc[ai][bj][m][n], 0, 0, 0); __builtin_amdgcn_s_setprio(0); } while (0)
#define PG8_WAIT_V(n) asm volatile("s_waitcnt vmcnt(" #n ")" ::: "memory")
#define PG8_WAIT_L(n) asm volatile("s_waitcnt lgkmcnt(" #n ")" ::: "memory")
#define PG8_BAR __builtin_amdgcn_s_barrier()
#define PG8_SCHED __builtin_amdgcn_sched_barrier(0)
    Unit cur, nxt; int ui = 0;
    if (!S.next(0, cur)) return;
    f32x4 acc[2][2][4][2];
#pragma unroll
    for (int a = 0; a < 2; ++a)
#pragma unroll
        for (int b = 0; b < 2; ++b)
#pragma unroll
            for (int m = 0; m < 4; ++m)
#pragma unroll
                for (int n = 0; n < 2; ++n) acc[a][b][m][n] = (f32x4){0.f, 0.f, 0.f, 0.f};
    bf16x8 At[4][2], B0[2][2], B1[2][2]; i32x8 A8[4], B80[2], B81[2];
    const char* cA = cur.a; const char* cB = cur.b;
    PG8_STAGE(PG8_SB(0, 0), cB, voffB); PG8_STAGE(PG8_SB(0, 1), cB + hstepB, voffB); PG8_STAGE(PG8_SA(0, 0), cA, voffA); PG8_STAGE(PG8_SA(0, 1), cA + hstepA, voffA);
    if (wr == 1) PG8_BAR;
    PG8_WAIT_V(2); PG8_BAR;
    PG8_STAGE(PG8_SB(1, 0), cB + kstep, voffB); PG8_STAGE(PG8_SA(1, 0), cA + kstep, voffA); PG8_STAGE(PG8_SB(1, 1), cB + hstepB + kstep, voffB);
    PG8_WAIT_V(6); PG8_BAR;
    for (;;) {
        const bool has_next = S.next(ui + 1, nxt);
        const char* nA = has_next ? nxt.a : cA; const char* nB = has_next ? nxt.b : cB;
#pragma unroll 1
        for (int t = 0; t < nt; t += 2) {
            if constexpr (MIDK) { if (t == 8 || t == 16) { int fr_ = fr, fq_ = fq; asm volatile("" : "+v"(fr_), "+v"(fq_)); E.mid(acc, cur, t >> 4, wr, wc, fr_, fq_); } }
            const bool last = (t == nt - 2);
            const char* a1 = cA + (size_t)(t + 1) * kstep;
            const char* a2 = last ? nA : cA + (size_t)(t + 2) * kstep; const char* b2 = last ? nB : cB + (size_t)(t + 2) * kstep;
            const char* a3 = a2 + kstep; const char* b3 = b2 + kstep;
            if constexpr (F8) {
            PG8_LDB8(B80, 0, 0); PG8_LDB8(B81, 0, 1); PG8_SCHED; PG8_LDA8(A8, 0, 0); PG8_STAGE(PG8_SA(1, 1), a1 + hstepA, voffA);
            PG8_WAIT_V(8); PG8_WAIT_L(0); PG8_BAR; PG8_MMA8(0, 0, A8, B80); PG8_MMA8(0, 1, A8, B81); PG8_BAR; PG8_SCHED;
            PG8_LDA8(A8, 0, 1); PG8_STAGE(PG8_SB(0, 0), b2, voffB); PG8_STAGE(PG8_SB(0, 1), b2 + hstepB, voffB); PG8_STAGE(PG8_SA(0, 0), a2, voffA);
            PG8_WAIT_V(8); PG8_WAIT_L(0); PG8_BAR; PG8_MMA8(1, 0, A8, B80); PG8_MMA8(1, 1, A8, B81); PG8_BAR; PG8_SCHED;
            PG8_LDB8(B80, 1, 0); PG8_LDB8(B81, 1, 1); PG8_SCHED; PG8_LDA8(A8, 1, 0); PG8_STAGE(PG8_SA(0, 1), a2 + hstepA, voffA);
            PG8_WAIT_V(8); PG8_WAIT_L(0); PG8_BAR; PG8_MMA8(0, 0, A8, B80); PG8_MMA8(0, 1, A8, B81); PG8_BAR; PG8_SCHED;
            PG8_LDA8(A8, 1, 1); PG8_STAGE(PG8_SB(1, 0), b3, voffB); PG8_STAGE(PG8_SB(1, 1), b3 + hstepB, voffB); PG8_STAGE(PG8_SA(1, 0), a3, voffA);
            PG8_WAIT_V(8); PG8_WAIT_L(0); PG8_BAR; PG8_MMA8(1, 0, A8, B80); PG8_MMA8(1, 1, A8, B81); PG8_BAR; PG8_SCHED;
            } else {
            PG8_LDB(B0, 0, 0); PG8_LDB(B1, 0, 1); PG8_SCHED; PG8_LDA(At, 0, 0); PG8_STAGE(PG8_SA(1, 1), a1 + hstepA, voffA);
            PG8_WAIT_V(8); PG8_WAIT_L(0); PG8_BAR; PG8_MMA(0, 0, At, B0); PG8_MMA(0, 1, At, B1); PG8_BAR; PG8_SCHED;
            PG8_LDA(At, 0, 1); PG8_STAGE(PG8_SB(0, 0), b2, voffB); PG8_STAGE(PG8_SB(0, 1), b2 + hstepB, voffB); PG8_STAGE(PG8_SA(0, 0), a2, voffA);
            PG8_WAIT_V(8); PG8_WAIT_L(0); PG8_BAR; PG8_MMA(1, 0, At, B0); PG8_MMA(1, 1, At, B1); PG8_BAR; PG8_SCHED;
            PG8_LDB(B0, 1, 0); PG8_LDB(B1, 1, 1); PG8_SCHED; PG8_LDA(At, 1, 0); PG8_STAGE(PG8_SA(0, 1), a2 + hstepA, voffA);
            PG8_WAIT_V(8); PG8_WAIT_L(0); PG8_BAR; PG8_MMA(0, 0, At, B0); PG8_MMA(0, 1, At, B1); PG8_BAR; PG8_SCHED;
            PG8_LDA(At, 1, 1); PG8_STAGE(PG8_SB(1, 0), b3, voffB); PG8_STAGE(PG8_SB(1, 1), b3 + hstepB, voffB); PG8_STAGE(PG8_SA(1, 0), a3, voffA);
            PG8_WAIT_V(8); PG8_WAIT_L(0); PG8_BAR; PG8_MMA(1, 0, At, B0); PG8_MMA(1, 1, At, B1); PG8_BAR; PG8_SCHED;
            }
        }
        if (wr == 0) PG8_BAR;
        if constexpr (F8) asm volatile("s_nop 15\n\ts_nop 15" ::: "memory");
        { int fr_ = fr, fq_ = fq; asm volatile("" : "+v"(fr_), "+v"(fq_));
          E(acc, cur, wr, wc, fr_, fq_); }
        if (!has_next) break;
#pragma unroll
        for (int a = 0; a < 2; ++a)
#pragma unroll
            for (int b = 0; b < 2; ++b)
#pragma unroll
                for (int m = 0; m < 4; ++m)
#pragma unroll
                    for (int n = 0; n < 2; ++n) acc[a][b][m][n] = (f32x4){0.f, 0.f, 0.f, 0.f};
        cur = nxt; cA = nA; cB = nB; ++ui;
        if (wr == 1) PG8_BAR;
    }
    PG8_WAIT_V(0);
    PG8_BAR;
#undef PG8_SA
#undef PG8_SB
#undef PG8_STAGE
#undef PG8_LDA
#undef PG8_LDB
#undef PG8_MMA
#undef PG8_CAT
#undef PG8_LD8
#undef PG8_LDA8
#undef PG8_LDB8
#undef PG8_MMA8
#undef PG8_WAIT_V
#undef PG8_WAIT_L
#undef PG8_BAR
#undef PG8_SCHED
}
}

#define XB_TMO      128
#define XB_XCNT(j)  (256  + 64 * (j))
#define XB_XSUB(j)  (1280 + 64 * (j))
#define XB_XGEN(j)  (2304 + 64 * (j))
#define XB_TOP      3328
#define XB_TOPGEN   3392
#define XCD_BAR_WORDS 3456
#define XB_SPIN_CAP (1u << 22)
DI unsigned xb_ld(unsigned* p)              { return __hip_atomic_load(p, __ATOMIC_RELAXED, __HIP_MEMORY_SCOPE_AGENT); }
DI unsigned xb_add(unsigned* p, unsigned v) { return __hip_atomic_fetch_add(p, v, __ATOMIC_RELAXED, __HIP_MEMORY_SCOPE_AGENT); }
DI unsigned xb_xcc_id() { return (unsigned)__builtin_amdgcn_s_getreg((3 << 11) | 20) & 0xFu; }
#define XB_SPIN(cond, bar) do { unsigned _sp = 0; while (cond) { __builtin_amdgcn_s_sleep(1); \
    if ((++_sp & 255u) == 0u) { if (xb_ld(&(bar)[XB_TMO])) break; if (_sp > XB_SPIN_CAP) { atomicAdd(&(bar)[XB_TMO], 1u); break; } } } } while (0)
struct XcdBarrier { unsigned* bar; unsigned x; volatile LAS unsigned* st; };
DI XcdBarrier xcd_barrier_post(unsigned* bar, volatile LAS unsigned* st) {
    XcdBarrier b; b.bar = bar; b.x = xb_xcc_id(); b.st = st;
    if (threadIdx.x == 0) (void)xb_add(&bar[XB_XCNT(b.x)], 1u);
    return b;
}
DI void xcd_barrier_complete(unsigned* bar, unsigned x, unsigned& nloc, unsigned& nx) {
    const unsigned G = gridDim.x * gridDim.y * gridDim.z;
    unsigned sum, cnt, mine, sp = 0u;
    for (;;) {
        sum = 0u; cnt = 0u; mine = 0u;
#pragma unroll
        for (unsigned j = 0; j < 16; ++j) { const unsigned c = xb_ld(&bar[XB_XCNT(j)]); sum += c; cnt += (c > 0u) ? 1u : 0u; mine = (j == x) ? c : mine; }
        if (sum == G) break;
        __builtin_amdgcn_s_sleep(1);
        if ((++sp & 255u) == 0u) { if (xb_ld(&bar[XB_TMO])) break; if (sp > XB_SPIN_CAP) { atomicAdd(&bar[XB_TMO], 1u); break; } }
    }
    nloc = mine > 0u ? mine : 1u; nx = cnt > 0u ? cnt : 1u;
}
DI void xcd_barrier(const XcdBarrier& b) {
    asm volatile("s_waitcnt vmcnt(0)" ::: "memory");
    __syncthreads();
    if (threadIdx.x == 0) {
        unsigned* bar = b.bar;
        __builtin_amdgcn_s_waitcnt(0);
        unsigned nloc = b.st[0], nx = b.st[1];
        if (nloc == 0u) { xcd_barrier_complete(bar, b.x, nloc, nx); b.st[0] = nloc; b.st[1] = nx; }
        const unsigned old = xb_add(&bar[XB_XSUB(b.x)], 1u);
        const unsigned gen = old / nloc;
        if (old + 1u == (gen + 1u) * nloc) {
            __builtin_amdgcn_fence(__ATOMIC_RELEASE, "agent");
            asm volatile("s_waitcnt vmcnt(0)" ::: "memory");
            const unsigned og = xb_add(&bar[XB_TOP], 1u);
            const unsigned tg = og / nx;
            if (og + 1u == (tg + 1u) * nx) xb_add(&bar[XB_TOPGEN], 1u);
            else XB_SPIN(xb_ld(&bar[XB_TOPGEN]) == tg, bar);
            __builtin_amdgcn_fence(__ATOMIC_ACQUIRE, "agent");
            xb_add(&bar[XB_XGEN(b.x)], 1u);
            asm volatile("s_waitcnt vmcnt(0)" ::: "memory");
        } else {
            XB_SPIN(xb_ld(&bar[XB_XGEN(b.x)]) == gen, bar);
            __builtin_amdgcn_fence(__ATOMIC_ACQUIRE, "agent");
            asm volatile("s_waitcnt vmcnt(0)" ::: "memory");
        }
    }
    __syncthreads();
}

DI void transpose_item(const float* W, int ldw, bf16* WT, int ldt, LAS float* scr, int lane) {
#pragma unroll 8
    for (int i = 0; i < 32; ++i) { const int kk = 2 * i + (lane >> 5); scr[kk * 33 + (lane & 31)] = W[(size_t)kk * ldw + (lane & 31)]; }
    LDS_WAIT(); asm volatile("" ::: "memory");
    const int c = lane & 7;
#pragma unroll
    for (int j = 0; j < 4; ++j) { const int n = (lane >> 3) + 8 * j; const LAS float* s = scr + (8 * c) * 33 + n;
        u32x4 o; o.x = pk2(s[0 * 33], s[1 * 33]); o.y = pk2(s[2 * 33], s[3 * 33]); o.z = pk2(s[4 * 33], s[5 * 33]); o.w = pk2(s[6 * 33], s[7 * 33]);
        *(u32x4*)(WT + (size_t)n * ldt + 8 * c) = o; }
    LDS_WAIT(); asm volatile("" ::: "memory");
}
DI void transpose_item_f8(const float* W, int ldw, unsigned char* WT, int ldt, float scale, LAS float* scr, int lane) {
#pragma unroll 8
    for (int i = 0; i < 32; ++i) { const int kk = 2 * i + (lane >> 5); scr[kk * 33 + (lane & 31)] = W[(size_t)kk * ldw + (lane & 31)]; }
    LDS_WAIT(); asm volatile("" ::: "memory");
    const int c = lane & 3;
#pragma unroll
    for (int j = 0; j < 2; ++j) { const int n = (lane >> 2) + 16 * j; const LAS float* s = scr + (16 * c) * 33 + n;
        u32x4 o; o.x = pk4_f8(s[0 * 33] * scale, s[1 * 33] * scale, s[2 * 33] * scale, s[3 * 33] * scale); o.y = pk4_f8(s[4 * 33] * scale, s[5 * 33] * scale, s[6 * 33] * scale, s[7 * 33] * scale);
        o.z = pk4_f8(s[8 * 33] * scale, s[9 * 33] * scale, s[10 * 33] * scale, s[11 * 33] * scale); o.w = pk4_f8(s[12 * 33] * scale, s[13 * 33] * scale, s[14 * 33] * scale, s[15 * 33] * scale);
        *(u32x4*)(WT + (size_t)n * ldt + 16 * c) = o; }
    LDS_WAIT(); asm volatile("" ::: "memory");
}
DI void ln16(f32x4 (&v)[4], const f32x4 (&g)[4], const f32x4 (&b)[4]) {
    float s = 0.f;
#pragma unroll
    for (int j = 0; j < 4; ++j) s += (v[j].x + v[j].y) + (v[j].z + v[j].w);
    const float mean = wave_sum(s) * (1.f / D); float s2 = 0.f;
#pragma unroll
    for (int j = 0; j < 4; ++j) { v[j] = v[j] - mean; s2 += (v[j].x * v[j].x + v[j].y * v[j].y) + (v[j].z * v[j].z + v[j].w * v[j].w); }
    const float rstd = 1.f / sqrtf(wave_sum(s2) * (1.f / D) + LN_EPS);
#pragma unroll
    for (int j = 0; j < 4; ++j) v[j] = v[j] * rstd * g[j] + b[j];
}
DI void gates8(const f32x4 (&y)[4], const LAS float* wgt, float* gif_row, int lane) {
    float p[8];
#pragma unroll
    for (int j = 0; j < 8; ++j) { float s = 0.f;
#pragma unroll
        for (int jj = 0; jj < 4; ++jj) { const f32x4 w = *(const LAS f32x4*)(wgt + j * 1024 + 256 * jj + 4 * lane); s += (y[jj].x * w.x + y[jj].y * w.y) + (y[jj].z * w.z + y[jj].w * w.w); }
        p[j] = wave_sum(s); }
    if (lane == 0) { *(f32x4*)gif_row = (f32x4){p[0], p[1], p[2], p[3]}; *(f32x4*)(gif_row + 4) = (f32x4){p[4], p[5], p[6], p[7]}; }
}
DI void gates8b(const f32x4 (&y)[4], const LAS float* wgt, float* gif_row, int lane) {
    float p[8];
#pragma unroll
    for (int j = 0; j < 8; ++j) { float s = 0.f;
#pragma unroll
        for (int jj = 0; jj < 4; ++jj) { const f32x4 w = *(const LAS f32x4*)(wgt + j * 1024 + (jj >> 1) * 512 + 8 * lane + (jj & 1) * 4); s += (y[jj].x * w.x + y[jj].y * w.y) + (y[jj].z * w.z + y[jj].w * w.w); }
        p[j] = wave_sum(s); }
    if (lane == 0) { *(f32x4*)gif_row = (f32x4){p[0], p[1], p[2], p[3]}; *(f32x4*)(gif_row + 4) = (f32x4){p[4], p[5], p[6], p[7]}; }
}
DI void load_gate_table(LAS float* wgt, const float* win_l, int tid) {
    for (int i = tid; i < 8192; i += NTHR) { const int k = i >> 3, j = i & 7; wgt[j * 1024 + k] = win_l[(size_t)k * DIN + 1536 + j]; }
}
DI f32x4 ld4bf(const char* p) { const u32x2 w = *(const u32x2*)p; return (f32x4){bflo(w.x), bfhi(w.x), bflo(w.y), bfhi(w.y)}; }
DI void st4bf(char* p, const f32x4& v) { u32x2 w; w.x = pk2(v.x, v.y); w.y = pk2(v.z, v.w); *(u32x2*)p = w; }

struct Args { const float* in[N_IN]; float* out; unsigned char* ws; int ph_lo, ph_hi; };
constexpr int NP_LAYER = 12, NPH = 1 + DEPTH * NP_LAYER;
constexpr int XW_SPLIT = 33792;

struct SchedInproj {
    pg8::TileOrder T; int G, c; const char *X, *W; char* U; bool kv; const char *MEMN, *WKV; char* KV;
    DI bool next(int i, pg8::Unit& u) const {
        const long L = (long)i * G + c; int pm, pn;
        if (T.tile(L, pm, pn)) { u.a = X + (size_t)pm * 256 * D * 2; u.b = W + (size_t)pn * 256 * D * 2; u.r0 = pm * 256; u.c0 = pn * 256; u.c = U + ((size_t)u.r0 * NU + u.c0) * 2; u.ldc = NU; u.e = 0; u.sub = 0; return true; }
        if (!kv) return false;
        const long L2 = L - T.nwg; if (L2 < 0 || L2 >= 128) return false;
        const int l = (int)L2 >> 6, t = (int)L2 & 63; pm = t >> 2; pn = t & 3;
        u.a = MEMN + (size_t)pm * 256 * D * 2; u.b = WKV + ((size_t)l * 1024 + pn * 256) * D * 2; u.r0 = pm * 256; u.c0 = pn * 256; u.c = KV + (((size_t)l * MROWS + u.r0) * D + u.c0) * 2; u.ldc = D; u.e = 0; u.sub = 0; return true;
    }
};
struct SchedPlain {
    pg8::TileOrder T; int G, c; const char *A, *B; char* C; int lda, ldb, ldc;
    DI bool next(int i, pg8::Unit& u) const {
        const long L = (long)i * G + c; int pm, pn; if (!T.tile(L, pm, pn)) return false;
        u.a = A + (size_t)pm * 256 * lda * 2; u.b = B + (size_t)pn * 256 * ldb * 2; u.r0 = pm * 256; u.c0 = pn * 256; u.c = C + ((size_t)u.r0 * ldc + u.c0) * 2; u.ldc = ldc; u.e = 0; u.sub = 0; return true;
    }
};
struct SchedMerge {
    pg8::TileOrder T; int G, c; const char *H, *W; char* Y;
    DI bool next(int i, pg8::Unit& u) const {
        const int ti = i / 3, br = i - 3 * ti; const long L = (long)ti * G + c; int pm, pn; if (!T.tile(L, pm, pn)) return false;
        u.a = H + ((size_t)pm * 256 * 1536 + br * 512) * 2; u.b = W + ((size_t)br * 1024 + pn * 256) * 512 * 2; u.r0 = pm * 256; u.c0 = pn * 256; u.c = Y + ((size_t)u.r0 * D + u.c0) * 2; u.ldc = D; u.e = 0; u.sub = br; return true;
    }
};
struct SchedMoe {
    pg8::TileOrder T; int G, c; const char *A, *W; char* C; const LAS int* PB; int wrows  , ldc, cdiv, osz;
    DI bool next(int i, pg8::Unit& u) const {
        const long L = (long)i * G + c; int pm, pn; if (!T.tile(L, pm, pn)) return false;
        int e = 0;
#pragma unroll 1
        for (int j = 1; j < NEXP; ++j) e += (PB[j] <= pm) ? 1 : 0;
        u.a = A + (size_t)pm * 256 * 1024; u.b = W + ((size_t)e * wrows + pn * 256) * 1024; u.r0 = pm * 256; u.c0 = pn * 256; u.c = C + ((size_t)u.r0 * ldc + u.c0 / cdiv) * osz; u.ldc = ldc; u.e = e; u.sub = 0; return true;
    }
};

__global__ void __launch_bounds__(NTHR, 2) fwd_kernel(Args args) {
    extern __shared__ __attribute__((aligned(16))) unsigned char lds_raw[];
#define INP(i) ([&]() -> const float* { int ii_ = (i); asm volatile("" : "+s"(ii_)); return args.in[ii_]; }())
    LAS unsigned char* lds = (LAS unsigned char*)lds_raw;
    volatile LAS unsigned* LCTL = (volatile LAS unsigned*)(lds + LDSCTL_OFF);
    const int tid0 = threadIdx.x, wave = __builtin_amdgcn_readfirstlane(tid0 >> 6);
#define PHASE_TID unsigned z_ = 0u; asm volatile("" : "+v"(z_)); int tid = wave * 64 + (int)__builtin_amdgcn_mbcnt_hi(~0u, __builtin_amdgcn_mbcnt_lo(~0u, z_)); const int lane = tid & 63; (void)lane;
    const int G = gridDim.x, bx = blockIdx.x;
    const int gw = bx * NWAVES + wave, NGW = G * NWAVES;
    unsigned char* ws = args.ws;
    gu32* ctl = (gu32*)(ws + WS_CTL);
    for (int u = tid0; u < (LDS_BYTES - LDSCTL_OFF) / 4; u += NTHR) ((LAS unsigned*)(lds + LDSCTL_OFF))[u] = 0u;
    __syncthreads();
    XcdBarrier bar; bar.bar = (unsigned*)ctl + CW_BAR; bar.x = 0; bar.st = nullptr;
    if (MK_ONE_LAUNCH) bar = xcd_barrier_post((unsigned*)ctl + CW_BAR, LCTL);
    const int lo = args.ph_lo, hi = args.ph_hi;
#ifndef SUBMASK
#define SUBMASK 7
#endif
#ifndef LN2PROBE
#define LN2PROBE 0
#endif
#ifndef SUBDUP
#define SUBDUP 0
#endif
#define NSUB(k) ((((SUBDUP) >> (k)) & 1) ? 2 : 1)
#ifndef DUPMASK
#define DUPMASK 0
#endif
#define NREP(k) ((((DUPMASK) >> (k)) & 1) ? 2 : 1)
#ifndef PHMASK
#define PHMASK 0xFFFF
#endif
#define IN(k) (lo <= (k) && (k) < hi)
#define SEAM(k) do { if (IN(k) && IN((k) + 1)) xcd_barrier(bar); } while (0)

    char* const Xb = (char*)(ws + WS_X);
    char* const Ub = (char*)(ws + WS_R1);
    float* const GIF = (float*)(ws + WS_GIF);
    LAS int* const PB = (LAS int*)(lds + LDSCTL_OFF + 64);
    LAS int* const CNT = (LAS int*)(lds + LDSCTL_OFF + 256);

    _Pragma("unroll 1") for (int rep_ = 0; rep_ < NREP(12); ++rep_) if (((PHMASK>>12)&1) && IN(0)) { PHASE_TID
        LAS float* scr = (LAS float*)(lds + wave * 8448);
        LAS float* wgt = (LAS float*)(lds + 73728);
        load_gate_table(wgt, INP(I_WIN), tid);
        constexpr int IT_IN = 16 * 216, IT_KV = 16 * 32, IT_BR = 8 * 32, IT_O = 16 * 32, IT_L = IT_IN + IT_KV + 3 * IT_BR + IT_O;
        for (int it = gw; it < DEPTH * IT_L; it += NGW) {
            const int l = it / IT_L; int r = it - l * IT_L;
            if (r < IT_IN) { const int kb = r / 216, nb = r % 216, n0 = 32 * nb, sc = n0 + (n0 >= 1536 ? 8 : 0);
                if (n0 < UC_GATE) transpose_item(INP(I_WIN) + ((size_t)l * D + 64 * kb) * DIN + sc, DIN, (bf16*)(ws + WS_WIN) + ((size_t)l * NU + n0) * D + 64 * kb, D, scr, lane);
                else transpose_item_f8(INP(I_WIN) + ((size_t)l * D + 64 * kb) * DIN + sc, DIN, (unsigned char*)(ws + WS_WING8) + ((size_t)l * 3072 + (n0 - UC_GATE)) * D + 64 * kb, D, F8_SWGU, scr, lane);
                continue; }
            r -= IT_IN;
            if (r < IT_KV) { const int kb = r / 32, nb = r % 32;
                transpose_item(INP(I_CAWKV) + ((size_t)l * D + 64 * kb) * 1024 + 32 * nb, 1024, (bf16*)(ws + WS_WKV) + ((size_t)l * 1024 + 32 * nb) * D + 64 * kb, D, scr, lane); continue; }
            r -= IT_KV;
            if (r < 3 * IT_BR) { const int br = r / IT_BR, q = r % IT_BR, kb = q / 32, nb = q % 32;
                const float* src = INP(br == 0 ? I_WBRML : (br == 1 ? I_WBRRW : I_WBRCA));
                transpose_item(src + ((size_t)l * 512 + 64 * kb) * 1024 + 32 * nb, 1024, (bf16*)(ws + WS_WBR) + ((size_t)l * 1024 + 32 * nb) * 1536 + br * 512 + 64 * kb, 1536, scr, lane); continue; }
            r -= 3 * IT_BR;
            { const int kb = r / 32, nb = r % 32;
                transpose_item(INP(I_WO) + ((size_t)l * D + 64 * kb) * 1024 + 32 * nb, 1024, (bf16*)(ws + WS_WO) + ((size_t)l * 1024 + 32 * nb) * D + 64 * kb, D, scr, lane); }
        }
        for (int i = bx * NTHR + tid; i < DEPTH * 1536 * 256; i += G * NTHR) {
            const int l = i / (1536 * 256), r = i % (1536 * 256), n = r >> 8, k = r & 255; float v = 0.f;
            if (n < 512) { if (k < 64) v = INP(I_RWWUP)[((size_t)l * 64 + k) * 512 + n]; }
            else if (n < 1024) { if (k >= 64 && k < 128) v = INP(I_RWAUP)[((size_t)l * 64 + (k - 64)) * 512 + (n - 512)]; }
            else { if (k >= 128) v = INP(I_RWGUP)[((size_t)l * 128 + (k - 128)) * 512 + (n - 1024)]; }
            ((bf16*)(ws + WS_WLORA))[i] = (bf16)f2bf(v);
        }
        __syncthreads();
        {
            f32x4 g[4], b[4];
#pragma unroll
            for (int j = 0; j < 4; ++j) { g[j] = *(const f32x4*)(INP(I_LNIN_G) + 256 * j + 4 * lane); b[j] = *(const f32x4*)(INP(I_LNIN_B) + 256 * j + 4 * lane); }
            for (int m = gw; m < M; m += NGW) {
                f32x4 v[4]; const float* xr = INP(I_X) + (size_t)m * D;
#pragma unroll
                for (int j = 0; j < 4; ++j) v[j] = *(const f32x4*)(xr + 256 * j + 4 * lane);
                ln16(v, g, b);
#pragma unroll
                for (int j = 0; j < 4; ++j) { st4bf(Xb + ((size_t)m * D + 256 * j + 4 * lane) * 2, v[j]); *(unsigned*)((char*)(ws + WS_XF8) + (size_t)m * D + 256 * j + 4 * lane) = pk4_f8(v[j].x * F8_SX, v[j].y * F8_SX, v[j].z * F8_SX, v[j].w * F8_SX); }
                gates8(v, wgt, GIF + (size_t)m * 8, lane);
            }
#pragma unroll
            for (int j = 0; j < 4; ++j) { g[j] = *(const f32x4*)(INP(I_MEMLN_G) + 256 * j + 4 * lane); b[j] = *(const f32x4*)(INP(I_MEMLN_B) + 256 * j + 4 * lane); }
            for (int m = gw; m < MROWS; m += NGW) {
                f32x4 v[4]; const float* xr = INP(I_MEM) + (size_t)m * D;
#pragma unroll
                for (int j = 0; j < 4; ++j) v[j] = *(const f32x4*)(xr + 256 * j + 4 * lane);
                ln16(v, g, b);
#pragma unroll
                for (int j = 0; j < 4; ++j) st4bf((char*)(ws + WS_MEMN) + ((size_t)m * D + 256 * j + 4 * lane) * 2, v[j]);
            }
        }
        __syncthreads();
    }
    SEAM(0);

#pragma unroll 1
    for (int l = 0; l < DEPTH; ++l) {
        const int pb = 1 + l * NP_LAYER;
        _Pragma("unroll 1") for (int rep_ = 0; rep_ < NREP(0); ++rep_) if (((PHMASK>>0)&1) && IN(pb + 0)) {
            SchedInproj S; S.T.init(M / 256, UC_GATE / 256); S.G = G; S.c = bx; S.X = Xb; S.W = (const char*)(ws + WS_WIN) + (size_t)l * NU * D * 2; S.U = Ub;
            S.kv = (l == 0); S.MEMN = (const char*)(ws + WS_MEMN); S.WKV = (const char*)(ws + WS_WKV); S.KV = (char*)(ws + WS_KV);
            pg8::EpiStore E;
            pg8::gemm_phase<false>(lds, D * 2, D * 2, D * 2, S, E, wave);
            SchedPlain S8; S8.T.init(M / 256, 12); S8.G = G; S8.c = bx; S8.A = (const char*)(ws + WS_XF8); S8.B = (const char*)(ws + WS_WING8) + (size_t)l * 3072 * D; S8.C = Ub + UC_GATE * 2;
            S8.lda = 512; S8.ldb = 512; S8.ldc = NU;
            pg8::EpiStoreS E8; E8.s = F8_INV1;
            pg8::gemm_phase<true>(lds, D, D, D, S8, E8, wave);
        }
        SEAM(pb + 0);
        _Pragma("unroll 1") for (int rep_ = 0; rep_ < NREP(1); ++rep_) if (((PHMASK>>1)&1) && IN(pb + 1)) { PHASE_TID
            const float* mu = INP(I_RWMU) + (size_t)l * 1792 + 1536;
            char* LIN = (char*)(ws + WS_R2 + R2_LORA_IN);
            for (int it = bx * NTHR + tid; it < M * 32; it += G * NTHR) {
                const int row = it >> 5, c = (it & 31) * 8;
                const u32x4 cw = *(const u32x4*)(Ub + ((size_t)row * NU + UC_RW + 1536 + c) * 2);
                u32x4 pw = (u32x4){0u, 0u, 0u, 0u};
                if ((row & (SEQ - 1)) != 0) pw = *(const u32x4*)(Ub + ((size_t)(row - 1) * NU + UC_RW + 1536 + c) * 2);
                const f32x4 m0 = *(const f32x4*)(mu + c), m1 = *(const f32x4*)(mu + c + 4);
                float x[8] = {bflo(cw.x), bfhi(cw.x), bflo(cw.y), bfhi(cw.y), bflo(cw.z), bfhi(cw.z), bflo(cw.w), bfhi(cw.w)};
                const float p[8] = {bflo(pw.x), bfhi(pw.x), bflo(pw.y), bfhi(pw.y), bflo(pw.z), bfhi(pw.z), bflo(pw.w), bfhi(pw.w)};
                const float mm[8] = {m0.x, m0.y, m0.z, m0.w, m1.x, m1.y, m1.z, m1.w};
#pragma unroll
                for (int i = 0; i < 8; ++i) { float xs = x[i] + (p[i] - x[i]) * mm[i];
                    if (c < 64) xs = 1.f - 2.f * __builtin_amdgcn_rcpf(1.f + __builtin_amdgcn_exp2f(2.8853900817779268f * xs));
                    else if (c >= 128) xs = sigmoidf_(xs);
                    x[i] = xs; }
                u32x4 o; o.x = pk2(x[0], x[1]); o.y = pk2(x[2], x[3]); o.z = pk2(x[4], x[5]); o.w = pk2(x[6], x[7]);
                *(u32x4*)(LIN + ((size_t)row * 256 + c) * 2) = o;
            }
        }
        SEAM(pb + 1);
        _Pragma("unroll 1") for (int rep_ = 0; rep_ < NREP(2); ++rep_) if (((PHMASK>>2)&1) && IN(pb + 2)) {
            SchedPlain S; S.T.init(M / 256, 6); S.G = G; S.c = bx; S.A = (const char*)(ws + WS_R2 + R2_LORA_IN); S.B = (const char*)(ws + WS_WLORA) + (size_t)l * 1536 * 256 * 2; S.C = (char*)(ws + WS_R2 + R2_LORA_OUT);
            S.lda = 256; S.ldb = 256; S.ldc = 1536;
            pg8::EpiStore E;
            pg8::gemm_phase<false>(lds, 512, 512, 512, S, E, wave);
        }
        SEAM(pb + 2);
        _Pragma("unroll 1") for (int rep_ = 0; rep_ < NREP(3); ++rep_) if (((PHMASK>>3)&1) && IN(pb + 3)) { PHASE_TID
            const char* LO = (const char*)(ws + WS_R2 + R2_LORA_OUT);
            char* HC = (char*)(ws + WS_R2 + R2_HCAT);
            const int tid_ph = tid;
#define SUB_TID unsigned zs_ = 0u; asm volatile("" : "+v"(zs_)); int tid = wave * 64 + (int)__builtin_amdgcn_mbcnt_hi(~0u, __builtin_amdgcn_mbcnt_lo(~0u, zs_)); const int lane = tid & 63; (void)lane;
#pragma unroll 1
            for (int job = bx; job < 256; job += G) {
                if (job < 128) { _Pragma("unroll 1") for (int sr_ = 0; sr_ < NSUB(0); ++sr_) if ((SUBMASK>>0)&1) {
                    SUB_TID
                    const int b = job >> 3, h = job & 7;
                    constexpr int TC = 32, PT = 144, P16 = 48, IMG = 25856;
                    LAS float* OPS = (LAS float*)lds;
                    LAS float* OUTB = OPS + TC * 384;
                    LAS float* BON = OUTB + TC * 64;
                    LAS unsigned char* IM0 = lds + 57600;
                    const int pt = tid >> 4, cs = tid & 15, pc = cs * 4, hc = h * 64 + pc;
                    const int r31 = lane & 31, h2 = lane >> 5;
                    f32x16 Sreg[2];
#pragma unroll
                    for (int i = 0; i < 16; ++i) { Sreg[0][i] = 0.f; Sreg[1][i] = 0.f; }
                    u32x2 pu[9];
                    auto LOADC = [&](int t0) {
                        const int t = t0 + pt; const size_t row = (size_t)b * SEQ + t; const char* up = Ub + (row * NU + UC_RW + hc) * 2;
                        pu[0] = *(const u32x2*)up; pu[1] = *(const u32x2*)(up + 1024); pu[2] = *(const u32x2*)(up + 2048);
                        if (t > 0) { const char* pp = up - (size_t)NU * 2; pu[3] = *(const u32x2*)pp; pu[4] = *(const u32x2*)(pp + 1024); pu[5] = *(const u32x2*)(pp + 2048); }
                        else { pu[3] = (u32x2){0u, 0u}; pu[4] = pu[3]; pu[5] = pu[3]; }
                        const char* lp = LO + (row * 1536 + hc) * 2; pu[6] = *(const u32x2*)lp; pu[7] = *(const u32x2*)(lp + 1024); pu[8] = *(const u32x2*)(lp + 2048);
                    };
#define UNP4(w) ((f32x4){bflo((w).x), bfhi((w).x), bflo((w).y), bfhi((w).y)})
#define DOT4(a, b) (((a).x * (b).x + (a).y * (b).y) + ((a).z * (b).z + (a).w * (b).w))
#define PACK8(x, s) __builtin_bit_cast(bf16x8, (u32x4){pk2((x)[8 * (s)], (x)[8 * (s) + 1]), pk2((x)[8 * (s) + 2], (x)[8 * (s) + 3]), pk2((x)[8 * (s) + 4], (x)[8 * (s) + 5]), pk2((x)[8 * (s) + 6], (x)[8 * (s) + 7])})
#define LD2x64(p) __builtin_bit_cast(bf16x8, (u32x4){(*(const LAS u32x2*)(p)).x, (*(const LAS u32x2*)(p)).y, (*(const LAS u32x2*)((p) + 16)).x, (*(const LAS u32x2*)((p) + 16)).y})
                    LOADC(0);
#pragma unroll 1
                    for (int t0 = 0; t0 < SEQ; t0 += TC) {
                        f32x4 gk;
                        {
                            int hcv = hc; asm volatile("" : "+v"(hcv));
                            const f32x4 mu_r = *(const f32x4*)(INP(I_RWMU) + (size_t)l * 1792 + hcv), mu_k = *(const f32x4*)(INP(I_RWMU) + (size_t)l * 1792 + 512 + hcv), mu_v = *(const f32x4*)(INP(I_RWMU) + (size_t)l * 1792 + 1024 + hcv);
                            const f32x4 w0 = *(const f32x4*)(INP(I_RWW0) + l * 512 + hcv), a0 = *(const f32x4*)(INP(I_RWA0) + l * 512 + hcv), kkw = *(const f32x4*)(INP(I_RWKK) + l * 512 + hcv);
                            const f32x4 kaw = *(const f32x4*)(INP(I_RWKA) + l * 512 + hcv), rkw = *(const f32x4*)(INP(I_RWRK) + l * 512 + hcv);
                            const f32x4 ur = UNP4(pu[0]), uk = UNP4(pu[1]), uv = UNP4(pu[2]), urp = UNP4(pu[3]), ukp = UNP4(pu[4]), uvp = UNP4(pu[5]), lw = UNP4(pu[6]), la = UNP4(pu[7]);
                            gk = UNP4(pu[8]);
                            const f32x4 xr = ur + (urp - ur) * mu_r, xk = uk + (ukp - uk) * mu_k, xv = uv + (uvp - uv) * mu_v;
                            f32x4 dec, av, kkv, kp; float ss = 0.f, bsum = 0.f;
#pragma unroll
                            for (int i = 0; i < 4; ++i) {
                                const float y = -(w0[i] + lw[i]);
                                const float sp = fmaxf(y, 0.f) + __logf(1.f + __expf(-fabsf(y)));
                                dec[i] = __expf(-__expf(-sp - 0.5f));
                                av[i] = sigmoidf_(a0[i] + la[i]);
                                kkv[i] = xk[i] * kkw[i]; ss += kkv[i] * kkv[i];
                                kp[i] = xk[i] * (1.f + (av[i] - 1.f) * kaw[i]);
                                bsum += xr[i] * kp[i] * rkw[i];
                            }
                            ss = red16(ss); bsum = red16(bsum);
                            const float inv = __builtin_amdgcn_rsqf(fmaxf(ss, 1e-24f));
                            const f32x4 kk = kkv * inv, kka = kk * av;
                            LAS float* o = OPS + pt * 384 + pc;
                            *(LAS f32x4*)(o) = dec; *(LAS f32x4*)(o + 64) = kk; *(LAS f32x4*)(o + 128) = kka; *(LAS f32x4*)(o + 192) = kp; *(LAS f32x4*)(o + 256) = xr; *(LAS f32x4*)(o + 320) = xv;
                            if (cs == 0) BON[pt] = bsum;
                        }
                        if (t0 + TC < SEQ) LOADC(t0 + TC);
                        __syncthreads();
                        if (wave < 2) {
                            LAS unsigned char* im = IM0 + wave * IMG;
                            LAS unsigned char* KR = im; LAS unsigned char* BGr = im + 4608; LAS unsigned char* BT = im + 9216; LAS unsigned char* GT = im + 12288; LAS unsigned char* VT = im + 15360;
                            LAS unsigned char* TT = im + 18432; LAS unsigned char* BB = im + 19968; LAS float* ZF = (LAS float*)(im + 21504); LAS float* PL = (LAS float*)(im + 25600);
                            {
                                float P = 1.f;
#pragma unroll 2
                                for (int t = 0; t < 16; ++t) { const LAS float* o = OPS + (16 * wave + t) * 384 + lane;
                                    const float w = o[0], z = o[64], bb = o[128], kp = o[192], rr = o[256], vv = o[320];
                                    const float kap = z * P; P *= w; const float rho = rr * P, ip = __builtin_amdgcn_rcpf(P), bet = bb * ip, gam = kp * ip;
                                    *(LAS bf16*)(KR + t * PT + lane * 2) = (bf16)f2bf(kap); *(LAS bf16*)(KR + (16 + t) * PT + lane * 2) = (bf16)f2bf(rho);
                                    *(LAS bf16*)(BGr + t * PT + lane * 2) = (bf16)f2bf(bet); *(LAS bf16*)(BGr + (16 + t) * PT + lane * 2) = (bf16)f2bf(gam);
                                    *(LAS bf16*)(BT + lane * P16 + t * 2) = (bf16)f2bf(bet); *(LAS bf16*)(GT + lane * P16 + t * 2) = (bf16)f2bf(gam); *(LAS bf16*)(VT + lane * P16 + t * 2) = (bf16)f2bf(vv); }
                                PL[lane] = P;
                            }
                            LDS_WAIT(); asm volatile("" ::: "memory");
                            {
                                f32x16 Z;
#pragma unroll
                                for (int i = 0; i < 16; ++i) Z[i] = 0.f;
#pragma unroll
                                for (int ks = 0; ks < 4; ++ks) Z = __builtin_amdgcn_mfma_f32_32x32x16_bf16(*(const LAS bf16x8*)(KR + r31 * PT + (16 * ks + 8 * h2) * 2), *(const LAS bf16x8*)(BGr + r31 * PT + (16 * ks + 8 * h2) * 2), Z, 0, 0, 0);
#pragma unroll
                                for (int i = 0; i < 16; ++i) ZF[((i & 3) + 8 * (i >> 2) + 4 * h2) * 32 + r31] = Z[i];
                            }
                            LDS_WAIT(); asm volatile("" ::: "memory");
                            {
                                const int c = lane & 15, part = lane >> 4; float Tc[16];
#pragma unroll
                                for (int t = 0; t < 16; ++t) {
                                    f32x4 ar[4];
#pragma unroll
                                    for (int q = 0; q < 4; ++q) if (4 * q < t) ar[q] = *(const LAS f32x4*)(ZF + t * 32 + 4 * q);
                                    float s0 = (t == c) ? 1.f : 0.f, s1 = 0.f;
#pragma unroll
                                    for (int j = 0; j < t; ++j) { if (j & 1) s1 -= ar[j >> 2][j & 3] * Tc[j]; else s0 -= ar[j >> 2][j & 3] * Tc[j]; }
                                    Tc[t] = s0 + s1; __builtin_amdgcn_sched_barrier(0); }
#pragma unroll
                                for (int q = 0; q < 4; ++q) { const int t = 4 * part + q; float s0 = 0.f, s1 = 0.f, tv = 0.f;
                                    const LAS float* zr = ZF + (16 + t) * 32;
                                    const f32x4 a0 = *(const LAS f32x4*)zr, a1 = *(const LAS f32x4*)(zr + 4), a2 = *(const LAS f32x4*)(zr + 8), a3 = *(const LAS f32x4*)(zr + 12);
                                    const float av[16] = {a0.x, a0.y, a0.z, a0.w, a1.x, a1.y, a1.z, a1.w, a2.x, a2.y, a2.z, a2.w, a3.x, a3.y, a3.z, a3.w};
#pragma unroll
                                    for (int j = 0; j < 16; ++j) { const float a = (j <= t) ? av[j] : 0.f; if (j & 1) s1 += a * Tc[j]; else s0 += a * Tc[j]; tv = (j == t) ? Tc[j] : tv; }
                                    *(LAS bf16*)(TT + t * P16 + c * 2) = (bf16)f2bf(-tv); *(LAS bf16*)(TT + (16 + t) * P16 + c * 2) = (bf16)f2bf(-(s0 + s1)); __builtin_amdgcn_sched_barrier(0); }
                                const int row = lane >> 1, c0 = 8 * (lane & 1), tt = row & 15; const bool rho_row = row >= 16; float bv[8];
#pragma unroll
                                for (int j = 0; j < 8; ++j) { const int jj = c0 + j; const float zv = ZF[row * 32 + 16 + jj]; bv[j] = (rho_row ? (jj <= tt) : (jj < tt)) ? zv : 0.f; }
                                *(LAS u32x4*)(BB + row * P16 + c0 * 2) = (u32x4){pk2(bv[0], bv[1]), pk2(bv[2], bv[3]), pk2(bv[4], bv[5]), pk2(bv[6], bv[7])};
                            }
                        }
                        __syncthreads();
                        if (wave < 2) {
#pragma unroll 1
                            for (int sc = 0; sc < 2; ++sc) {
                                const LAS unsigned char* im = IM0 + sc * IMG;
                                const LAS unsigned char* KR = im; const LAS unsigned char* BT = im + 9216; const LAS unsigned char* GT = im + 12288; const LAS unsigned char* VT = im + 15360;
                                const LAS unsigned char* TT = im + 18432; const LAS unsigned char* BB = im + 19968; const LAS float* PL = (const LAS float*)(im + 25600);
                                const bf16x8 vfr = *(const LAS bf16x8*)(VT + (32 * wave + r31) * P16 + 8 * h2 * 2);
                                f32x16 t1;
#pragma unroll
                                for (int i = 0; i < 16; ++i) t1[i] = 0.f;
                                t1 = __builtin_amdgcn_mfma_f32_32x32x16_bf16(*(const LAS bf16x8*)(BB + r31 * P16 + 8 * h2 * 2), vfr, t1, 0, 0, 0);
#pragma unroll
                                for (int kb = 0; kb < 2; ++kb)
#pragma unroll
                                    for (int s = 0; s < 2; ++s) t1 = __builtin_amdgcn_mfma_f32_32x32x16_bf16(LD2x64(KR + r31 * PT + (32 * kb + 16 * s + 4 * h2) * 2), PACK8(Sreg[kb], s), t1, 0, 0, 0);
                                f32x16 t2;
#pragma unroll
                                for (int i = 0; i < 16; ++i) t2[i] = 0.f;
                                t2 = __builtin_amdgcn_mfma_f32_32x32x16_bf16(LD2x64(TT + r31 * P16 + (4 * h2) * 2), PACK8(t1, 0), t2, 0, 0, 0);
#pragma unroll
                                for (int i = 8; i < 16; ++i) OUTB[(16 * sc + (i & 3) + 8 * ((i >> 2) - 2) + 4 * h2) * 64 + 32 * wave + r31] = t2[i] + t1[i];
                                const bf16x8 uq = PACK8(t2, 0);
#pragma unroll
                                for (int kb = 0; kb < 2; ++kb) {
                                    f32x16 a = Sreg[kb];
                                    a = __builtin_amdgcn_mfma_f32_32x32x16_bf16(LD2x64(BT + (32 * kb + r31) * P16 + (4 * h2) * 2), uq, a, 0, 0, 0);
                                    a = __builtin_amdgcn_mfma_f32_32x32x16_bf16(*(const LAS bf16x8*)(GT + (32 * kb + r31) * P16 + 8 * h2 * 2), vfr, a, 0, 0, 0);
#pragma unroll
                                    for (int g4 = 0; g4 < 4; ++g4) { const f32x4 p4 = *(const LAS f32x4*)(PL + 32 * kb + 8 * g4 + 4 * h2);
                                        a[4 * g4] *= p4.x; a[4 * g4 + 1] *= p4.y; a[4 * g4 + 2] *= p4.z; a[4 * g4 + 3] *= p4.w; }
                                    Sreg[kb] = a;
                                }
                            }
                        }
                        __syncthreads();
                        {
                            int hcw = hc; asm volatile("" : "+v"(hcw));
                            const f32x4 lng = *(const f32x4*)(INP(I_RWLNG) + l * 512 + hcw), lnb = *(const f32x4*)(INP(I_RWLNB) + l * 512 + hcw);
                            const f32x4 o4 = *(const LAS f32x4*)(OUTB + pt * 64 + pc), v4 = *(const LAS f32x4*)(OPS + pt * 384 + 320 + pc);
                            const float mean = red16((o4.x + o4.y) + (o4.z + o4.w)) * (1.f / 64.f);
                            const f32x4 dv = o4 - mean;
                            const float var = red16(DOT4(dv, dv)) * (1.f / 64.f);
                            const float rstd = __builtin_amdgcn_rsqf(var + RW_GN_EPS), bo = BON[pt];
                            const f32x4 y = (dv * rstd * lng + lnb + v4 * bo) * gk;
                            st4bf(HC + (((size_t)b * SEQ + t0 + pt) * 1536 + 512 + hc) * 2, y);
                        }
                        __syncthreads();
                    }
#undef PACK8
#undef LD2x64
                } } else {
                    const int idx = job - 128, bh = idx >> 1, half = idx & 1, b = bh >> 2, h = bh & 3;
                    unsigned zl_ = 0u; asm volatile("" : "+v"(zl_)); const int lane_ml = (int)__builtin_amdgcn_mbcnt_hi(~0u, __builtin_amdgcn_mbcnt_lo(~0u, zl_));
                    _Pragma("unroll 1") for (int sr_ = 0; sr_ < NSUB(1); ++sr_) if (((SUBMASK>>1)&1) && idx < 64) {
                        SUB_TID
                        const int bm = idx >> 2, hm = idx & 3;
                        constexpr int PT = 144;
                        LAS unsigned char* QI = lds;
                        LAS unsigned char* KI = QI + 64 * PT;
                        LAS unsigned char* KW = KI + 64 * PT;
                        LAS unsigned char* VT = KW + 64 * PT;
                        LAS unsigned char* CI = VT + 128 * PT;
                        LAS float* AS = (LAS float*)(CI + 128 * PT);
                        LAS float* MX = AS + 64; LAS float* SI = AS + 128; LAS float* EM = AS + 192; LAS float* WG = AS + 256; LAS float* NN = AS + 320; LAS float* CR = AS + 384;
                        for (int i = tid; i < 128 * PT / 4; i += NTHR) ((LAS unsigned*)CI)[i] = 0u;
                        if (tid < 64) NN[tid] = 0.f;
                        const int pt = tid >> 4, cg = tid & 15;
                        const int ccol = (cg < 8) ? (hm * 64 + 8 * cg) : (256 + hm * 64 + 8 * (cg - 8));
                        const float qsc = (cg < 8) ? 0.125f : 1.f;
                        const float igb = INP(I_IGB)[l * 4 + hm], fgb = INP(I_FGB)[l * 4 + hm];
                        const int r31 = lane & 31, h2 = lane >> 5, vb = wave >> 1, tb = wave & 1;
                        f32x16 accC;
#pragma unroll
                        for (int i = 0; i < 16; ++i) accC[i] = 0.f;
                        float nreg = 0.f, mprev = 0.f;
                        u32x4 cu[2][4], vu[2]; float gi = 0.f, gf = 0.f;
                        auto LOADM = [&](int t0) {
#pragma unroll
                            for (int tt = 0; tt < 2; ++tt) { const int t = t0 + pt + 32 * tt; const size_t row = (size_t)bm * SEQ + t;
#pragma unroll
                                for (int j = 0; j < 4; ++j) { if (t - 3 + j >= 0) cu[tt][j] = *(const u32x4*)(Ub + ((row - 3 + j) * NU + UC_QK + ccol) * 2); else cu[tt][j] = (u32x4){0u, 0u, 0u, 0u}; }
                                const int p = tid + 512 * tt; vu[tt] = *(const u32x4*)(Ub + (((size_t)bm * SEQ + t0 + (p >> 4)) * NU + UC_V + hm * 128 + 8 * (p & 15)) * 2); }
                            if (wave == 0) { const size_t rg = (size_t)bm * SEQ + t0 + lane; gi = GIF[rg * 8 + hm]; gf = GIF[rg * 8 + 4 + hm]; }
                        };
                        LOADM(0);
                        __syncthreads();
#pragma unroll 1
                        for (int t0 = 0; t0 < SEQ; t0 += 64) {
                            int ccv = ccol; asm volatile("" : "+v"(ccv));
                            float cw[4][8], cb[8];
#pragma unroll
                        for (int j = 0; j < 4; ++j) { const f32x4 a = *(const f32x4*)(INP(I_CONVW) + ((size_t)l * 4 + j) * 512 + ccv), c2 = *(const f32x4*)(INP(I_CONVW) + ((size_t)l * 4 + j) * 512 + ccv + 4);
                            cw[j][0] = a.x; cw[j][1] = a.y; cw[j][2] = a.z; cw[j][3] = a.w; cw[j][4] = c2.x; cw[j][5] = c2.y; cw[j][6] = c2.z; cw[j][7] = c2.w; }
                        { const f32x4 a = *(const f32x4*)(INP(I_CONVB) + l * 512 + ccv), c2 = *(const f32x4*)(INP(I_CONVB) + l * 512 + ccv + 4);
                            cb[0] = a.x; cb[1] = a.y; cb[2] = a.z; cb[3] = a.w; cb[4] = c2.x; cb[5] = c2.y; cb[6] = c2.z; cb[7] = c2.w; }
                            float yq[2][8];
#pragma unroll
                            for (int tt = 0; tt < 2; ++tt) {
#pragma unroll
                                for (int i = 0; i < 8; ++i) yq[tt][i] = cb[i];
#pragma unroll
                                for (int j = 0; j < 4; ++j) { const u32x4 w = cu[tt][j]; const float x[8] = {bflo(w.x), bfhi(w.x), bflo(w.y), bfhi(w.y), bflo(w.z), bfhi(w.z), bflo(w.w), bfhi(w.w)};
#pragma unroll
                                    for (int i = 0; i < 8; ++i) yq[tt][i] += cw[j][i] * x[i]; }
#pragma unroll
                                for (int i = 0; i < 8; ++i) yq[tt][i] = yq[tt][i] * sigmoidf_(yq[tt][i]) * qsc;
                            }
                            const u32x4 vreg0 = vu[0], vreg1 = vu[1];
                            if (wave == 0) {
                                const float ig = gi + igb, fp = gf + fgb;
                                const float lf = -(fmaxf(-fp, 0.f) + __logf(1.f + __expf(-fabsf(fp))));
                                float bc = lf;
#pragma unroll
                                for (int o = 1; o < 64; o <<= 1) { const float t = __shfl_up(bc, o); if (lane >= o) bc += t; }
                                const float as = ig - bc; float pm = as;
#pragma unroll
                                for (int o = 1; o < 64; o <<= 1) { const float t = __shfl_up(pm, o); if (lane >= o) pm = fmaxf(pm, t); }
                                const float mxv = fmaxf(mprev, pm), mx63 = __shfl(mxv, 63), bl = __shfl(bc, 63);
                                AS[lane] = as; MX[lane] = mxv; SI[lane] = __expf(mprev - mxv); EM[lane] = __expf(-(bc + mxv)); WG[lane] = __expf(as - mx63);
                                if (lane == 0) CR[0] = __expf(mprev - mx63);
                                mprev = bl + mx63;
                            }
                            if (t0 + 64 < SEQ) LOADM(t0 + 64);
                            __syncthreads();
#pragma unroll
                            for (int tt = 0; tt < 2; ++tt) { const int tok = pt + 32 * tt;
                                u32x4 pw; pw.x = pk2(yq[tt][0], yq[tt][1]); pw.y = pk2(yq[tt][2], yq[tt][3]); pw.z = pk2(yq[tt][4], yq[tt][5]); pw.w = pk2(yq[tt][6], yq[tt][7]);
                                if (cg < 8) *(LAS u32x4*)(QI + tok * PT + cg * 16) = pw;
                                else { *(LAS u32x4*)(KI + tok * PT + (cg - 8) * 16) = pw; const float wgs = WG[tok];
#pragma unroll
                                    for (int i = 0; i < 8; ++i) *(LAS bf16*)(KW + (8 * (cg - 8) + i) * PT + tok * 2) = (bf16)f2bf(yq[tt][i] * wgs); }
                                const u32x4 vw = tt ? vreg1 : vreg0; const int p = tid + 512 * tt, vtok = p >> 4, v8 = p & 15;
                                LAS unsigned char* o = VT + (8 * v8) * PT + vtok * 2;
                                *(LAS bf16*)(o) = (bf16)(vw.x & 0xffff); *(LAS bf16*)(o + PT) = (bf16)(vw.x >> 16); *(LAS bf16*)(o + 2 * PT) = (bf16)(vw.y & 0xffff); *(LAS bf16*)(o + 3 * PT) = (bf16)(vw.y >> 16);
                                *(LAS bf16*)(o + 4 * PT) = (bf16)(vw.z & 0xffff); *(LAS bf16*)(o + 5 * PT) = (bf16)(vw.z >> 16); *(LAS bf16*)(o + 6 * PT) = (bf16)(vw.w & 0xffff); *(LAS bf16*)(o + 7 * PT) = (bf16)(vw.w >> 16);
                            }
                            __syncthreads();
                            {
                                constexpr float L2E = 1.4426950408889634f;
                                const int t = 32 * tb + r31;
                                bf16x8 qf[4];
#pragma unroll
                                for (int ks = 0; ks < 4; ++ks) qf[ks] = *(const LAS bf16x8*)(QI + t * PT + (16 * ks + 8 * h2) * 2);
                                const float mx = MX[t], si = SI[t], em = EM[t];
                                f32x16 O, I; float denI = 0.f;
#pragma unroll
                                for (int i = 0; i < 16; ++i) { O[i] = 0.f; I[i] = 0.f; }
#pragma unroll
                                for (int sb = 0; sb < 2; ++sb) if (sb <= tb) {
                                    f32x16 X;
#pragma unroll
                                    for (int i = 0; i < 16; ++i) X[i] = 0.f;
#pragma unroll
                                    for (int ks = 0; ks < 4; ++ks) { const bf16x8 kf = *(const LAS bf16x8*)(KI + (32 * sb + r31) * PT + (16 * ks + 8 * h2) * 2); X = __builtin_amdgcn_mfma_f32_32x32x16_bf16(kf, qf[ks], X, 0, 0, 0); }
#pragma unroll
                                    for (int g4 = 0; g4 < 4; ++g4) { const f32x4 a4 = *(const LAS f32x4*)(AS + 32 * sb + 8 * g4 + 4 * h2);
#pragma unroll
                                        for (int j = 0; j < 4; ++j) { const int s = 32 * sb + 8 * g4 + 4 * h2 + j; const float w = (s <= t) ? __builtin_amdgcn_exp2f((a4[j] - mx) * L2E) * X[4 * g4 + j] : 0.f; X[4 * g4 + j] = w; denI += w; } }
#pragma unroll
                                    for (int st = 0; st < 2; ++st) {
                                        u32x4 pw; pw.x = pk2(X[8 * st], X[8 * st + 1]); pw.y = pk2(X[8 * st + 2], X[8 * st + 3]); pw.z = pk2(X[8 * st + 4], X[8 * st + 5]); pw.w = pk2(X[8 * st + 6], X[8 * st + 7]);
                                        const LAS unsigned char* vp = VT + (32 * vb + r31) * PT + (32 * sb + 16 * st + 4 * h2) * 2;
                                        const u32x2 lo = *(const LAS u32x2*)vp, hi = *(const LAS u32x2*)(vp + 16);
                                        O = __builtin_amdgcn_mfma_f32_32x32x16_bf16(__builtin_bit_cast(bf16x8, (u32x4){lo.x, lo.y, hi.x, hi.y}), __builtin_bit_cast(bf16x8, pw), O, 0, 0, 0);
                                    }
                                }
                                float nq = 0.f;
#pragma unroll
                                for (int ks = 0; ks < 4; ++ks) { const bf16x8 cf = *(const LAS bf16x8*)(CI + (32 * vb + r31) * PT + (16 * ks + 8 * h2) * 2); I = __builtin_amdgcn_mfma_f32_32x32x16_bf16(cf, qf[ks], I, 0, 0, 0);
                                    const f32x4 n0 = *(const LAS f32x4*)(NN + 16 * ks + 8 * h2), n1 = *(const LAS f32x4*)(NN + 16 * ks + 8 * h2 + 4); const u32x4 qw = __builtin_bit_cast(u32x4, qf[ks]);
                                    nq += (bflo(qw.x) * n0.x + bfhi(qw.x) * n0.y) + (bflo(qw.y) * n0.z + bfhi(qw.y) * n0.w) + (bflo(qw.z) * n1.x + bfhi(qw.z) * n1.y) + (bflo(qw.w) * n1.z + bfhi(qw.w) * n1.w); }
                                nq += __shfl_xor(nq, 32); denI += __shfl_xor(denI, 32);
                                const float den = si * nq + denI, rdn = 1.f / fmaxf(fabsf(den), em);
                                char* op = (char*)(ws + WS_HML) + (((size_t)bm * SEQ + t0 + t) * 512 + hm * 128 + 32 * vb) * 2;
#pragma unroll
                                for (int g4 = 0; g4 < 4; ++g4) { u32x2 w; w.x = pk2((O[4 * g4] + si * I[4 * g4]) * rdn, (O[4 * g4 + 1] + si * I[4 * g4 + 1]) * rdn); w.y = pk2((O[4 * g4 + 2] + si * I[4 * g4 + 2]) * rdn, (O[4 * g4 + 3] + si * I[4 * g4 + 3]) * rdn);
                                    *(u32x2*)(op + (8 * g4 + 4 * h2) * 2) = w; }
                                const float carry = CR[0];
#pragma unroll
                                for (int i = 0; i < 16; ++i) accC[i] *= carry;
#pragma unroll
                                for (int st = 0; st < 4; ++st) { const bf16x8 va = *(const LAS bf16x8*)(VT + (32 * vb + r31) * PT + (16 * st + 8 * h2) * 2), kw = *(const LAS bf16x8*)(KW + (32 * tb + r31) * PT + (16 * st + 8 * h2) * 2);
                                    accC = __builtin_amdgcn_mfma_f32_32x32x16_bf16(va, kw, accC, 0, 0, 0); }
                            }
                            __syncthreads();
#pragma unroll
                            for (int i = 0; i < 16; ++i) { const int v = 32 * vb + (i & 3) + 8 * (i >> 2) + 4 * h2; *(LAS bf16*)(CI + v * PT + (32 * tb + r31) * 2) = (bf16)f2bf(accC[i]); }
                            if (tid < 64) { float s = 0.f;
#pragma unroll
                                for (int q8 = 0; q8 < 8; ++q8) { const u32x4 w = *(const LAS u32x4*)(KW + tid * PT + q8 * 16); s += (bflo(w.x) + bfhi(w.x)) + (bflo(w.y) + bfhi(w.y)) + (bflo(w.z) + bfhi(w.z)) + (bflo(w.w) + bfhi(w.w)); }
                                nreg = CR[0] * nreg + s; NN[tid] = nreg; }
                            __syncthreads();
                        }
                    }
                    _Pragma("unroll 1") for (int sr_ = 0; sr_ < NSUB(2); ++sr_) if ((SUBMASK>>2)&1) {
                        SUB_TID
                        constexpr int KST = 272, VST = 520;
                        LAS unsigned char* KI = lds; LAS unsigned char* VI = lds + 256 * KST;
                        const char* kvb = (const char*)(ws + WS_KV) + (((size_t)l * MROWS + (size_t)b * MEML) * D) * 2;
                        for (int p = tid; p < 4096; p += NTHR) { const int key = p >> 4, c16 = p & 15;
                            *(LAS u32x4*)(KI + key * KST + c16 * 16) = *(const u32x4*)(kvb + ((size_t)key * D + h * 128 + c16 * 8) * 2); }
                        for (int p = tid; p < 4096; p += NTHR) { const int key = p & 255, d8 = p >> 8;
                            const u32x4 w = *(const u32x4*)(kvb + ((size_t)key * D + 512 + h * 128 + d8 * 8) * 2);
                            LAS unsigned char* o = VI + (d8 * 8) * VST + key * 2;
                            *(LAS bf16*)(o) = (bf16)(w.x & 0xffff); *(LAS bf16*)(o + VST) = (bf16)(w.x >> 16); *(LAS bf16*)(o + 2 * VST) = (bf16)(w.y & 0xffff); *(LAS bf16*)(o + 3 * VST) = (bf16)(w.y >> 16);
                            *(LAS bf16*)(o + 4 * VST) = (bf16)(w.z & 0xffff); *(LAS bf16*)(o + 5 * VST) = (bf16)(w.z >> 16); *(LAS bf16*)(o + 6 * VST) = (bf16)(w.w & 0xffff); *(LAS bf16*)(o + 7 * VST) = (bf16)(w.w >> 16); }
                        __syncthreads();
                        const int r31 = lane & 31, h2 = lane >> 5;
                        constexpr float SC = 0.08838834764831845f * 1.4426950408889634f;
#pragma unroll 1
                        for (int rd = 0; rd < 8; ++rd) {
                            const size_t qrow = (size_t)b * SEQ + half * 2048 + rd * 256 + wave * 32 + r31;
                            bf16x8 qf[8];
#pragma unroll
                            for (int ks = 0; ks < 8; ++ks) qf[ks] = *(const bf16x8*)(Ub + (qrow * NU + UC_CAQ + h * 128 + 16 * ks + 8 * h2) * 2);
                            f32x16 O[4];
#pragma unroll
                            for (int db = 0; db < 4; ++db)
#pragma unroll
                                for (int i = 0; i < 16; ++i) O[db][i] = 0.f;
                            float mrun = -1e30f, lrun = 0.f;
#pragma unroll 1
                            for (int hf = 0; hf < 2; ++hf) {
                                f32x16 X[4];
#pragma unroll
                                for (int kb = 0; kb < 4; ++kb) {
                                    bf16x8 kf[8];
#pragma unroll
                                    for (int ks = 0; ks < 8; ++ks) kf[ks] = *(const LAS bf16x8*)(KI + (hf * 128 + kb * 32 + r31) * KST + (16 * ks + 8 * h2) * 2);
                                    __builtin_amdgcn_sched_barrier(0);
#pragma unroll
                                    for (int i = 0; i < 16; ++i) X[kb][i] = 0.f;
#pragma unroll
                                    for (int ks = 0; ks < 8; ++ks) X[kb] = __builtin_amdgcn_mfma_f32_32x32x16_bf16(kf[ks], qf[ks], X[kb], 0, 0, 0);
                                    __builtin_amdgcn_sched_barrier(0);
                                }
                                float mx = -1e30f;
#pragma unroll
                                for (int kb = 0; kb < 4; ++kb)
#pragma unroll
                                    for (int i = 0; i < 16; ++i) mx = fmaxf(mx, X[kb][i]);
                                mx = fmaxf(mx, __shfl_xor(mx, 32));
                                const float mnew = fmaxf(mrun, mx), alpha = __builtin_amdgcn_exp2f((mrun - mnew) * SC);
                                float ls = 0.f;
#pragma unroll
                                for (int kb = 0; kb < 4; ++kb)
#pragma unroll
                                    for (int i = 0; i < 16; ++i) { const float p = __builtin_amdgcn_exp2f((X[kb][i] - mnew) * SC); X[kb][i] = p; ls += p; }
                                ls += __shfl_xor(ls, 32);
                                lrun = lrun * alpha + ls; mrun = mnew;
#pragma unroll
                                for (int db = 0; db < 4; ++db)
#pragma unroll
                                    for (int i = 0; i < 16; ++i) O[db][i] *= alpha;
#pragma unroll
                                for (int kb = 0; kb < 4; ++kb) {
                                    bf16x8 vf[2][4], pf[2];
#pragma unroll
                                    for (int s = 0; s < 2; ++s) {
                                        u32x4 pw; pw.x = pk2(X[kb][8 * s], X[kb][8 * s + 1]); pw.y = pk2(X[kb][8 * s + 2], X[kb][8 * s + 3]); pw.z = pk2(X[kb][8 * s + 4], X[kb][8 * s + 5]); pw.w = pk2(X[kb][8 * s + 6], X[kb][8 * s + 7]);
                                        pf[s] = __builtin_bit_cast(bf16x8, pw);
#pragma unroll
                                        for (int db = 0; db < 4; ++db) {
                                            const LAS unsigned char* vp = VI + (db * 32 + r31) * VST + (hf * 128 + kb * 32 + 16 * s + 4 * h2) * 2;
                                            const u32x2 lo = *(const LAS u32x2*)vp, hi = *(const LAS u32x2*)(vp + 16);
                                            vf[s][db] = __builtin_bit_cast(bf16x8, (u32x4){lo.x, lo.y, hi.x, hi.y});
                                        }
                                    }
                                    __builtin_amdgcn_sched_barrier(0);
#pragma unroll
                                    for (int s = 0; s < 2; ++s)
#pragma unroll
                                        for (int db = 0; db < 4; ++db) O[db] = __builtin_amdgcn_mfma_f32_32x32x16_bf16(vf[s][db], pf[s], O[db], 0, 0, 0);
                                    __builtin_amdgcn_sched_barrier(0);
                                }
                            }
                            const float rl = 1.f / lrun;
                            char* op = HC + (qrow * 1536 + 1024 + h * 128) * 2;
#pragma unroll
                            for (int db = 0; db < 4; ++db)
#pragma unroll
                                for (int g4 = 0; g4 < 4; ++g4) { u32x2 w; w.x = pk2(O[db][4 * g4] * rl, O[db][4 * g4 + 1] * rl); w.y = pk2(O[db][4 * g4 + 2] * rl, O[db][4 * g4 + 3] * rl);
                                    *(u32x2*)(op + (db * 32 + 8 * g4 + 4 * h2) * 2) = w; }
                        }
                        __syncthreads();
                    }
                    if (rep_ == 0) {
                        LAS float* scr = (LAS float*)(lds + wave * 8448);
                        constexpr int IT_GU = 32 * 16 * 64;
                        for (int it = idx * NWAVES + wave; it < XW_SPLIT; it += 128 * NWAVES) {
                            if (it < IT_GU) { const int e = it >> 10, q = it & 1023, kb = q >> 6, nb = q & 63;
                                transpose_item_f8(INP(I_WGU) + (((size_t)l * 32 + e) * D + 64 * kb) * 2048 + 32 * nb, 2048, (unsigned char*)(ws + WS_WGU) + ((size_t)e * 2048 + 32 * nb) * D + 64 * kb, D, F8_SWGU, scr, lane_ml); }
                            else { const int r2 = it - IT_GU, e = r2 >> 9, q = r2 & 511, kb = q >> 5, nb = q & 31;
                                transpose_item_f8(INP(I_WDN) + (((size_t)l * 32 + e) * D + 64 * kb) * 1024 + 32 * nb, 1024, (unsigned char*)(ws + WS_WDN) + ((size_t)e * 1024 + 32 * nb) * D + 64 * kb, D, F8_SWDN, scr, lane_ml); }
                        }
                        __syncthreads();
                    }
                }
            }
#undef UNP4
#undef DOT4
#undef SUB_TID
        }
        SEAM(pb + 3);
        _Pragma("unroll 1") for (int rep_ = 0; rep_ < NREP(4); ++rep_) if (((PHMASK>>4)&1) && IN(pb + 4)) { PHASE_TID
            char* HC = (char*)(ws + WS_R2 + R2_HCAT);
            const int hd = lane >> 4, sb = (lane & 15) * 8;
            const f32x4 g0 = *(const f32x4*)(INP(I_MLNORMG) + l * 512 + hd * 128 + sb), g1 = *(const f32x4*)(INP(I_MLNORMG) + l * 512 + hd * 128 + sb + 4);
            for (int m = gw; m < M; m += NGW) {
                const u32x4 hw = *(const u32x4*)((const char*)(ws + WS_HML) + ((size_t)m * 512 + hd * 128 + sb) * 2);
                const u32x4 ow = *(const u32x4*)(Ub + ((size_t)m * NU + UC_OG + hd * 128 + sb) * 2);
                float v[8] = {bflo(hw.x), bfhi(hw.x), bflo(hw.y), bfhi(hw.y), bflo(hw.z), bfhi(hw.z), bflo(hw.w), bfhi(hw.w)};
                const float og[8] = {bflo(ow.x), bfhi(ow.x), bflo(ow.y), bfhi(ow.y), bflo(ow.z), bfhi(ow.z), bflo(ow.w), bfhi(ow.w)};
                const float gg[8] = {g0.x, g0.y, g0.z, g0.w, g1.x, g1.y, g1.z, g1.w};
                float s = 0.f;
#pragma unroll
                for (int i = 0; i < 8; ++i) s += v[i];
                const float mean = red16(s) * (1.f / 128.f); float s2 = 0.f;
#pragma unroll
                for (int i = 0; i < 8; ++i) { v[i] -= mean; s2 += v[i] * v[i]; }
                const float rstd = 1.f / sqrtf(red16(s2) * (1.f / 128.f) + LN_EPS);
#pragma unroll
                for (int i = 0; i < 8; ++i) v[i] = sigmoidf_(og[i]) * (v[i] * rstd * gg[i]);
                u32x4 o; o.x = pk2(v[0], v[1]); o.y = pk2(v[2], v[3]); o.z = pk2(v[4], v[5]); o.w = pk2(v[6], v[7]);
                *(u32x4*)(HC + ((size_t)m * 1536 + hd * 128 + sb) * 2) = o;
            }
        }
        SEAM(pb + 4);
        _Pragma("unroll 1") for (int rep_ = 0; rep_ < NREP(5); ++rep_) if (((PHMASK>>5)&1) && IN(pb + 5)) {
            SchedPlain S; S.T.init(M / 256, 4); S.G = G; S.c = bx; S.A = (const char*)(ws + WS_R2 + R2_HCAT); S.B = (const char*)(ws + WS_WBR) + (size_t)l * 1024 * 1536 * 2; S.C = (char*)(ws + WS_R2 + R2_YPRE);
            S.lda = 1536; S.ldb = 1536; S.ldc = D;
            pg8::EpiMerge E; E.U = Ub; E.gate_b = INP(I_GATEB) + (size_t)l * 3072;
            pg8::gemm_phase<false, true>(lds, 1536 * 2, 1536 * 2, 1536 * 2, S, E, wave);
        }
        SEAM(pb + 5);
        _Pragma("unroll 1") for (int rep_ = 0; rep_ < NREP(6); ++rep_) if (((PHMASK>>6)&1) && IN(pb + 6)) {
            SchedPlain S; S.T.init(M / 256, 4); S.G = G; S.c = bx; S.A = (const char*)(ws + WS_R2 + R2_YPRE); S.B = (const char*)(ws + WS_WO) + (size_t)l * D * D * 2; S.C = (char*)(ws + WS_R2 + R2_Z);
            S.lda = D; S.ldb = D; S.ldc = D;
            pg8::EpiStore E;
            pg8::gemm_phase<false>(lds, D * 2, D * 2, D * 2, S, E, wave);
        }
        SEAM(pb + 6);
        _Pragma("unroll 1") for (int rep_ = 0; rep_ < NREP(7); ++rep_) if (((PHMASK>>7)&1) && IN(pb + 7)) { PHASE_TID
            LAS float* WR = (LAS float*)lds;
            for (int i = tid; i < 32768; i += NTHR) { const int k = i >> 5, e = i & 31; WR[e * 1024 + k] = INP(I_RTW)[((size_t)l * D + k) * 32 + e]; }
            __syncthreads();
            f32x4 g[4], bb[4];
#pragma unroll
            for (int j = 0; j < 4; ++j) { g[j] = *(const f32x4*)(INP(I_LN1G) + l * D + 256 * j + 4 * lane); bb[j] = *(const f32x4*)(INP(I_LN1B) + l * D + 256 * j + 4 * lane); }
            const float rbias = INP(I_RTB)[l * 32 + (lane & 31)];
            const char* Zb = (const char*)(ws + WS_R2 + R2_Z);
            int* TKE = (int*)(ws + WS_TKE); float* TKG = (float*)(ws + WS_TKG); int* TKP = (int*)(ws + WS_TKP); int* ROWTOK = (int*)(ws + WS_ROWTOK);
            LAS unsigned* LCNT = (LAS unsigned*)(lds + 131072);
            LAS unsigned* GBASE = LCNT + 32; LAS unsigned* LLEN = LCNT + 64; LAS unsigned* LIST = LCNT + 128;
            if (tid < 65) LCNT[tid] = 0u;
            __syncthreads();
#pragma unroll 1
            for (int pp = gw; pp < M / 2; pp += NGW) {
                f32x4 y0[4], y1[4];
#pragma unroll
                for (int j = 0; j < 4; ++j) { y0[j] = ld4bf(Zb + ((size_t)(2 * pp) * D + 256 * j + 4 * lane) * 2) + ld4bf(Xb + ((size_t)(2 * pp) * D + 256 * j + 4 * lane) * 2) * DN_ALPHA;
                    y1[j] = ld4bf(Zb + ((size_t)(2 * pp + 1) * D + 256 * j + 4 * lane) * 2) + ld4bf(Xb + ((size_t)(2 * pp + 1) * D + 256 * j + 4 * lane) * 2) * DN_ALPHA; }
                ln16(y0, g, bb); ln16(y1, g, bb);
#pragma unroll
                for (int j = 0; j < 4; ++j) { st4bf(Xb + ((size_t)(2 * pp) * D + 256 * j + 4 * lane) * 2, y0[j]); st4bf(Xb + ((size_t)(2 * pp + 1) * D + 256 * j + 4 * lane) * 2, y1[j]); }
                float v[64];
#pragma unroll
                for (int e = 0; e < 32; ++e) { float s0 = 0.f, s1 = 0.f;
#pragma unroll
                    for (int j = 0; j < 4; ++j) { const f32x4 w = *(const LAS f32x4*)(WR + e * 1024 + 256 * j + 4 * lane);
                        s0 += (y0[j].x * w.x + y0[j].y * w.y) + (y0[j].z * w.z + y0[j].w * w.w); s1 += (y1[j].x * w.x + y1[j].y * w.y) + (y1[j].z * w.z + y1[j].w * w.w); }
                    v[e] = s0; v[32 + e] = s1; if ((e & 3) == 3) __builtin_amdgcn_sched_barrier(0); }
#pragma unroll
                for (int bsh = 5; bsh >= 0; --bsh) { const int n2 = 1 << bsh; const bool up = (lane >> bsh) & 1;
#pragma unroll
                    for (int i = 0; i < n2; ++i) { const float send = up ? v[i] : v[i + n2], keep = up ? v[i + n2] : v[i]; v[i] = keep + __shfl_xor(send, n2); } }
                float cur = v[0] + rbias;
                const int half = lane >> 5, el = lane & 31;
                float tv[4]; int te[4];
#pragma unroll
                for (int k = 0; k < 4; ++k) { float mx = cur;
#pragma unroll
                    for (int o = 1; o < 32; o <<= 1) mx = fmaxf(mx, __shfl_xor(mx, o));
                    const unsigned long long bal = __ballot(cur == mx); const unsigned hm = (unsigned)(bal >> (32 * half));
                    const int win = __builtin_ctz(hm); tv[k] = mx; te[k] = win; if (el == win) cur = -3.0e38f; }
                const float e1 = __expf(tv[1] - tv[0]), e2 = __expf(tv[2] - tv[0]), e3 = __expf(tv[3] - tv[0]), rs = 1.f / (1.f + e1 + e2 + e3);
                const float gt[4] = {rs, e1 * rs, e2 * rs, e3 * rs};
                const int token = 2 * pp + half;
#pragma unroll
                for (int k = 0; k < 4; ++k) if (el == te[k] && rep_ == 0) {
                    const unsigned lpos = __hip_atomic_fetch_add(LCNT + el, 1u, __ATOMIC_RELAXED, __HIP_MEMORY_SCOPE_WORKGROUP);
                    const unsigned li = __hip_atomic_fetch_add(LLEN, 1u, __ATOMIC_RELAXED, __HIP_MEMORY_SCOPE_WORKGROUP);
                    LIST[2 * li] = (unsigned)(token * 4 + k); LIST[2 * li + 1] = (unsigned)el | (lpos << 8);
                    TKE[token * 4 + k] = el; TKG[token * 4 + k] = gt[k]; }
            }
            __syncthreads();
            if (tid < 32 && rep_ == 0) GBASE[tid] = __hip_atomic_fetch_add((unsigned*)ctl + CW_CNT + (l * 32 + tid) * 64, LCNT[tid], RLX_AGENT);
            __syncthreads();
            if (rep_ == 0) { const unsigned n = LLEN[0];
                for (unsigned i = tid; i < n; i += NTHR) { const unsigned tk = LIST[2 * i], ev = LIST[2 * i + 1], e = ev & 255u, pos = GBASE[e] + (ev >> 8);
                    TKP[tk] = (int)pos; ROWTOK[(size_t)e * M + pos] = (int)(tk >> 2); } }
            __syncthreads();
        }
        SEAM(pb + 7);
        _Pragma("unroll 1") for (int rep_ = 0; rep_ < NREP(8); ++rep_) if (((PHMASK>>8)&1) && IN(pb + 8)) { PHASE_TID
            if (tid < 32) CNT[tid] = (int)__hip_atomic_load((unsigned*)ctl + CW_CNT + (l * 32 + tid) * 64, RLX_AGENT);
            __syncthreads();
            if (tid == 0) { int a = 0; for (int e = 0; e < 32; ++e) { PB[e] = a; a += (CNT[e] + 255) >> 8; } PB[32] = a; }
            __syncthreads();
            const int P = PB[32];
            const int* ROWTOK = (const int*)(ws + WS_ROWTOK);
            char* XD = (char*)(ws + WS_R1);
            for (int sb = gw * 64; sb < P * 256; sb += NGW * 64) {
                const int pm = sb >> 8; int e = 0;
#pragma unroll 1
                for (int j = 1; j < NEXP; ++j) e += (PB[j] <= pm) ? 1 : 0;
                const int pos0 = sb - PB[e] * 256, cnt = CNT[e];
                int nvalid = cnt - pos0; nvalid = nvalid > 64 ? 64 : nvalid;
                int tokv = -1; if (pos0 + lane < cnt) tokv = ROWTOK[(size_t)e * M + pos0 + lane];
#pragma unroll 1
                for (int j = 0; j < nvalid; j += 2) {
                    int t[2]; u32x4 a[2], b2[2];
#pragma unroll
                    for (int i = 0; i < 2; ++i) { t[i] = __builtin_amdgcn_readlane(tokv, j + i);
                        if (t[i] >= 0) { a[i] = *(const u32x4*)(Xb + (size_t)t[i] * 2048 + lane * 32); b2[i] = *(const u32x4*)(Xb + (size_t)t[i] * 2048 + lane * 32 + 16); } }
#pragma unroll
                    for (int i = 0; i < 2; ++i) if (t[i] >= 0) {
                        u32x4 o; o.x = pk4_f8(bflo(a[i].x) * F8_SX, bfhi(a[i].x) * F8_SX, bflo(a[i].y) * F8_SX, bfhi(a[i].y) * F8_SX); o.y = pk4_f8(bflo(a[i].z) * F8_SX, bfhi(a[i].z) * F8_SX, bflo(a[i].w) * F8_SX, bfhi(a[i].w) * F8_SX);
                        o.z = pk4_f8(bflo(b2[i].x) * F8_SX, bfhi(b2[i].x) * F8_SX, bflo(b2[i].y) * F8_SX, bfhi(b2[i].y) * F8_SX); o.w = pk4_f8(bflo(b2[i].z) * F8_SX, bfhi(b2[i].z) * F8_SX, bflo(b2[i].w) * F8_SX, bfhi(b2[i].w) * F8_SX);
                        *(u32x4*)(XD + (size_t)(sb + j + i) * 1024 + lane * 16) = o; }
                }
            }
            LAS float* scr = (LAS float*)(lds + wave * 8448);
            constexpr int IT_GU = 32 * 16 * 64, IT_DN = 32 * 16 * 32;
            for (int it = XW_SPLIT + gw; it < IT_GU + IT_DN; it += NGW) {
                if (it < IT_GU) { const int e = it >> 10, q = it & 1023, kb = q >> 6, nb = q & 63;
                    transpose_item_f8(INP(I_WGU) + (((size_t)l * 32 + e) * D + 64 * kb) * 2048 + 32 * nb, 2048, (unsigned char*)(ws + WS_WGU) + ((size_t)e * 2048 + 32 * nb) * D + 64 * kb, D, F8_SWGU, scr, lane); }
                else { const int r = it - IT_GU, e = r >> 9, q = r & 511, kb = q >> 5, nb = q & 31;
                    transpose_item_f8(INP(I_WDN) + (((size_t)l * 32 + e) * D + 64 * kb) * 1024 + 32 * nb, 1024, (unsigned char*)(ws + WS_WDN) + ((size_t)e * 1024 + 32 * nb) * D + 64 * kb, D, F8_SWDN, scr, lane); }
            }
            __syncthreads();
        }
        SEAM(pb + 8);
        if (IN(pb + 9) || IN(pb + 10)) { PHASE_TID
            if (tid < 32) CNT[tid] = (int)__hip_atomic_load((unsigned*)ctl + CW_CNT + (l * 32 + tid) * 64, RLX_AGENT);
            __syncthreads();
            if (tid == 0) { int a = 0; for (int e = 0; e < 32; ++e) { PB[e] = a; a += (CNT[e] + 255) >> 8; } PB[32] = a; }
            __syncthreads();
        }
        _Pragma("unroll 1") for (int rep_ = 0; rep_ < NREP(9); ++rep_) if (((PHMASK>>9)&1) && IN(pb + 9)) {
            SchedMoe S; S.T.init(PB[32], 8); S.G = G; S.c = bx; S.A = (const char*)(ws + WS_R1); S.W = (const char*)(ws + WS_WGU); S.C = (char*)(ws + WS_R2 + R2_HMID); S.PB = PB; S.wrows = 2048; S.ldc = 1024; S.cdiv = 2; S.osz = 1;
            pg8::EpiMoe1 E; E.bgu = INP(I_BGU) + (size_t)l * 32 * 2048;
            pg8::gemm_phase<true>(lds, D, D, D, S, E, wave);
        }
        SEAM(pb + 9);
        _Pragma("unroll 1") for (int rep_ = 0; rep_ < NREP(10); ++rep_) if (((PHMASK>>10)&1) && IN(pb + 10)) {
            SchedMoe S; S.T.init(PB[32], 4); S.G = G; S.c = bx; S.A = (const char*)(ws + WS_R2 + R2_HMID); S.W = (const char*)(ws + WS_WDN); S.C = (char*)(ws + WS_R1); S.PB = PB; S.wrows = 1024; S.ldc = 1024; S.cdiv = 1; S.osz = 2;
            pg8::EpiMoe2 E; E.bdn = INP(I_BDN) + (size_t)l * 32 * 1024;
            pg8::gemm_phase<true>(lds, D, D, D, S, E, wave);
        }
        SEAM(pb + 10);
        _Pragma("unroll 1") for (int rep_ = 0; rep_ < NREP(11); ++rep_) if (((PHMASK>>11)&1) && IN(pb + 11)) { PHASE_TID
            if (tid < 32) CNT[tid] = (int)__hip_atomic_load((unsigned*)ctl + CW_CNT + (l * 32 + tid) * 64, RLX_AGENT);
            LAS float* wgt = (LAS float*)(lds + 73728);
            const bool lastl = (l == DEPTH - 1);
            if (!lastl) load_gate_table(wgt, INP(I_WIN) + (size_t)(l + 1) * D * DIN, tid);
            __syncthreads();
            if (tid == 0) { int a = 0; for (int e = 0; e < 32; ++e) { PB[e] = a; a += (CNT[e] + 255) >> 8; } PB[32] = a; }
            __syncthreads();
            const int e0 = 8 * lane;
            f32x4 g[4], bb[4];
#pragma unroll
            for (int j = 0; j < 4; ++j) { const int o = (j >> 1) * 512 + e0 + (j & 1) * 4; g[j] = *(const f32x4*)(INP(I_LN2G) + l * D + o); bb[j] = *(const f32x4*)(INP(I_LN2B) + l * D + o); }
            const char* YA = (const char*)(ws + WS_R1);
            const bool dummy_ = (rep_ + 1 < NREP(11)); char* const Xo = dummy_ ? (char*)(ws + WS_R2) : Xb; float* const Fo = dummy_ ? (float*)(ws + WS_R2 + 256 * MiB) : args.out; float* const Go = dummy_ ? (float*)(ws + WS_R2 + 200 * MiB) : GIF;
            const int* TKE = (const int*)(ws + WS_TKE); const float* TKG = (const float*)(ws + WS_TKG); const int* TKP = (const int*)(ws + WS_TKP);
#pragma unroll 1
            for (int mb = gw * 16; mb < M; mb += NGW * 16) {
                const int ev = TKE[mb * 4 + lane], pv = TKP[mb * 4 + lane]; const float gv = TKG[mb * 4 + lane];
                const int rowv = PB[ev] * 256 + pv;
#pragma unroll 1
                for (int ti = 0; ti < 16; ti += 2) {
                    u32x4 xw[2][2], yw[2][4][2]; float gk[2][4];
#pragma unroll
                    for (int q = 0; q < 2; ++q) { const size_t m = (size_t)mb + ti + q;
                        xw[q][0] = *(const u32x4*)(Xb + (m * D + e0) * 2); xw[q][1] = *(const u32x4*)(Xb + (m * D + 512 + e0) * 2);
#pragma unroll
                        for (int k = 0; k < 4; ++k) { const size_t row = (size_t)__builtin_amdgcn_readlane(rowv, 4 * (ti + q) + k);
                            gk[q][k] = __builtin_bit_cast(float, __builtin_amdgcn_readlane(__builtin_bit_cast(int, gv), 4 * (ti + q) + k));
                            yw[q][k][0] = *(const u32x4*)(YA + (row * D + e0) * 2); yw[q][k][1] = *(const u32x4*)(YA + (row * D + 512 + e0) * 2); } }
#pragma unroll
                    for (int q = 0; q < 2; ++q) { const size_t m = (size_t)mb + ti + q;
                        f32x4 v[4];
#pragma unroll
                        for (int hh = 0; hh < 2; ++hh) { const u32x4 w = xw[q][hh];
                            v[2 * hh] = (f32x4){bflo(w.x), bfhi(w.x), bflo(w.y), bfhi(w.y)} * DN_ALPHA; v[2 * hh + 1] = (f32x4){bflo(w.z), bfhi(w.z), bflo(w.w), bfhi(w.w)} * DN_ALPHA; }
#pragma unroll
                        for (int k = 0; k < 4; ++k)
#pragma unroll
                            for (int hh = 0; hh < 2; ++hh) { const u32x4 w = yw[q][k][hh];
                                v[2 * hh] = v[2 * hh] + (f32x4){bflo(w.x), bfhi(w.x), bflo(w.y), bfhi(w.y)} * gk[q][k]; v[2 * hh + 1] = v[2 * hh + 1] + (f32x4){bflo(w.z), bfhi(w.z), bflo(w.w), bfhi(w.w)} * gk[q][k]; }
                        ln16(v, g, bb);
                        if (lastl) {
#pragma unroll
                            for (int j = 0; j < 4; ++j) *(f32x4*)(Fo + m * D + (j >> 1) * 512 + e0 + (j & 1) * 4) = v[j];
                        } else {
#pragma unroll
                            for (int hh = 0; hh < 2; ++hh) { *(u32x4*)(Xo + (m * D + hh * 512 + e0) * 2) = pg8::pack8(v[2 * hh], v[2 * hh + 1]);
                                u32x2 f8w; f8w.x = pk4_f8(v[2 * hh].x * F8_SX, v[2 * hh].y * F8_SX, v[2 * hh].z * F8_SX, v[2 * hh].w * F8_SX); f8w.y = pk4_f8(v[2 * hh + 1].x * F8_SX, v[2 * hh + 1].y * F8_SX, v[2 * hh + 1].z * F8_SX, v[2 * hh + 1].w * F8_SX);
                                if (!dummy_) *(u32x2*)((char*)(ws + WS_XF8) + m * D + hh * 512 + e0) = f8w; }
                            gates8b(v, wgt, Go + m * 8, lane);
                        }
                    }
                }
            }
            __syncthreads();
        }
        SEAM(pb + 11);
    }
#undef IN
#undef SEAM
}

extern "C" void kernel_launch(void* const* d_in, const int* in_sizes, int n_in, void* d_out, int out_size, void* d_ws, size_t ws_size, hipStream_t stream) {
    static int grid = 0;
    if (grid == 0) {
        if (n_in != N_IN || out_size != M * D || ws_size < WS_END) { fprintf(stderr, "kernel_launch: unexpected shapes (n_in %d, out %d, ws %zu)\n", n_in, out_size, ws_size); grid = -1; return; }
        int dev = 0, cus = 0, per_cu = 0;
        if (hipGetDevice(&dev) != hipSuccess || hipDeviceGetAttribute(&cus, hipDeviceAttributeMultiprocessorCount, dev) != hipSuccess) { grid = -1; return; }
        if (hipFuncSetAttribute((const void*)fwd_kernel, hipFuncAttributeMaxDynamicSharedMemorySize, LDS_BYTES) != hipSuccess) { fprintf(stderr, "kernel_launch: hipFuncSetAttribute failed\n"); grid = -1; return; }
        if (hipOccupancyMaxActiveBlocksPerMultiprocessor(&per_cu, (const void*)fwd_kernel, NTHR, LDS_BYTES) != hipSuccess || per_cu < 1) fprintf(stderr, "kernel_launch: occupancy query reports %d\n", per_cu);
        (void)hipGetLastError();
        grid = cus;
    }
    if (grid < 0) return;
    (void)hipMemsetAsync((char*)d_ws + WS_CTL, 0, CTL_ZERO_BYTES, stream);
    Args a{};
    for (int i = 0; i < N_IN; ++i) a.in[i] = (const float*)d_in[i];
    a.out = (float*)d_out; a.ws = (unsigned char*)d_ws;
#if MK_ONE_LAUNCH
    a.ph_lo = 0; a.ph_hi = NPH;
    hipLaunchKernelGGL(fwd_kernel, dim3(grid), dim3(NTHR), LDS_BYTES, stream, a);
#else
    for (int p = 0; p < NPH; ++p) { a.ph_lo = p; a.ph_hi = p + 1; hipLaunchKernelGGL(fwd_kernel, dim3(grid), dim3(NTHR), LDS_BYTES, stream, a); }
#endif
    const hipError_t le = hipPeekAtLastError();
    if (le != hipSuccess) fprintf(stderr, "kernel_launch: launch failed: %s\n", hipGetErrorName(le));
}
```

```cpp
#include <hip/hip_runtime.h>
#include <cstdio>
#include <cstdint>

#ifndef MK_ONE_LAUNCH
#define MK_ONE_LAUNCH 1
#endif

#define LAS __attribute__((address_space(3)))
#define GAS __attribute__((address_space(1)))
typedef unsigned short bf16;
typedef short bf16x8 __attribute__((ext_vector_type(8)));
typedef float f32x4 __attribute__((ext_vector_type(4)));
typedef float f32x2 __attribute__((ext_vector_type(2)));
typedef float f32x16 __attribute__((ext_vector_type(16)));
typedef unsigned u32x4 __attribute__((ext_vector_type(4)));
typedef unsigned u32x2 __attribute__((ext_vector_type(2)));
typedef __bf16 bf16x2_t __attribute__((ext_vector_type(2)));
typedef GAS unsigned gu32;
#define RLX_AGENT __ATOMIC_RELAXED, __HIP_MEMORY_SCOPE_AGENT
#define DI __device__ __forceinline__

constexpr int NWAVES = 8, NTHR = 512;
constexpr int D = 1024, BATCH = 16, SEQ = 4096, M = BATCH * SEQ, DEPTH = 2, MEML = 256, MROWS = BATCH * MEML;
constexpr int DIN = 6920, NU = 6912;
constexpr int UC_QK = 0, UC_V = 512, UC_OG = 1024, UC_RW = 1536, UC_CAQ = 3328, UC_GATE = 3840;
constexpr int NEXP = 32, TOPK = 4;
constexpr int PMAX = M * TOPK / 256 + NEXP;
constexpr float LN_EPS = 1e-5f, RW_GN_EPS = 64e-5f, DN_ALPHA = 1.41421356237f;

enum { I_X = 0, I_MEM, I_LNIN_G, I_LNIN_B, I_MEMLN_G, I_MEMLN_B, I_WIN, I_CONVW, I_CONVB, I_IGB, I_FGB, I_MLNORMG, I_RWMU, I_RWW0, I_RWWUP, I_RWA0, I_RWAUP, I_RWGUP,
       I_RWKK, I_RWKA, I_RWRK, I_RWLNG, I_RWLNB, I_CAWKV, I_GATEB, I_WBRML, I_WBRRW, I_WBRCA, I_WO, I_LN1G, I_LN1B, I_RTW, I_RTB, I_WGU, I_BGU, I_WDN, I_BDN, I_LN2G, I_LN2B, N_IN };

constexpr size_t MiB = 1u << 20;
constexpr size_t WS_CTL = 0, CTL_ZERO_BYTES = 1 * MiB;
constexpr size_t WS_WIN = 1 * MiB;
constexpr size_t WS_WKV = 28 * MiB;
constexpr size_t WS_WBR = 32 * MiB;
constexpr size_t WS_WO = 38 * MiB;
constexpr size_t WS_WLORA = 42 * MiB;
constexpr size_t WS_WGU = 45 * MiB;
constexpr size_t WS_WDN = 173 * MiB;
constexpr size_t WS_X = 237 * MiB;
constexpr size_t WS_MEMN = 365 * MiB;
constexpr size_t WS_KV = 373 * MiB;
constexpr size_t WS_GIF = 389 * MiB;
constexpr size_t WS_TKE = 391 * MiB, WS_TKG = 392 * MiB, WS_TKP = 393 * MiB;
constexpr size_t WS_ROWTOK = 394 * MiB;
constexpr size_t WS_HML = 402 * MiB;
constexpr size_t WS_R1 = 466 * MiB;
constexpr size_t WS_R2 = 1330 * MiB;
constexpr size_t WS_XF8 = 1858 * MiB;
constexpr size_t WS_WING8 = 1922 * MiB;
constexpr size_t WS_END = 1930 * MiB;
constexpr size_t R2_LORA_OUT = 0, R2_HCAT = 192 * MiB, R2_LORA_IN = 384 * MiB, R2_YPRE = 0, R2_Z = 192 * MiB, R2_HMID = 0;
constexpr int CW_TMO = 0, CW_BAR = 4096, CW_CNT = 16384;

constexpr int LDS_BYTES = 155648;
constexpr int LDSCTL_OFF = 153600;

DI unsigned pk2(float lo, float hi) { bf16x2_t b = __builtin_convertvector((f32x2){lo, hi}, bf16x2_t); return __builtin_bit_cast(unsigned, b); }
DI unsigned f2bf(float f) { return pk2(f, 0.f) & 0xffffu; }
DI float bflo(unsigned u) { return __builtin_bit_cast(float, u << 16); }
DI float bfhi(unsigned u) { return __builtin_bit_cast(float, u & 0xffff0000u); }
DI unsigned pk4_f8(float a, float b, float c, float d) {
    a = __builtin_amdgcn_fmed3f(a, -448.f, 448.f); b = __builtin_amdgcn_fmed3f(b, -448.f, 448.f); c = __builtin_amdgcn_fmed3f(c, -448.f, 448.f); d = __builtin_amdgcn_fmed3f(d, -448.f, 448.f);
    int w = 0; w = __builtin_amdgcn_cvt_pk_fp8_f32(a, b, w, false); w = __builtin_amdgcn_cvt_pk_fp8_f32(c, d, w, true); return (unsigned)w; }
DI float sigmoidf_(float x) { return __builtin_amdgcn_rcpf(1.f + __builtin_amdgcn_exp2f(-1.4426950408889634f * x)); }
template <int CTRL> DI float dppf(float x) { return __builtin_bit_cast(float, __builtin_amdgcn_update_dpp(0, __builtin_bit_cast(int, x), CTRL, 0xF, 0xF, true)); }
DI float red4(float x) { x += dppf<0xB1>(x); x += dppf<0x4E>(x); return x; }
DI float red8(float x) { x = red4(x); x += dppf<0x141>(x); return x; }
DI float red16(float x) { x = red8(x); x += dppf<0x140>(x); return x; }
DI float red8o(float x) { x += dppf<0xB1>(x); asm("" : "+v"(x)); x += dppf<0x4E>(x); asm("" : "+v"(x)); x += dppf<0x141>(x); asm("" : "+v"(x)); return x; }
DI float red16o(float x) { x = red8o(x); x += dppf<0x140>(x); asm("" : "+v"(x)); return x; }
typedef short s16x4 __attribute__((ext_vector_type(4)));
DI u32x2 trd4(const LAS unsigned char* img, int PB, int rowbase, int colbase, int lane) {
    const LAS unsigned char* p = img + (rowbase + ((lane & 15) >> 2)) * PB + (colbase + 16 * ((lane >> 4) & 1) + 4 * (lane & 3)) * 2;
    return __builtin_bit_cast(u32x2, __builtin_amdgcn_ds_read_tr16_b64_v4i16((LAS s16x4*)p)); }
DI bf16x8 trd8(const LAS unsigned char* img, int PB, int rb0, int rb1, int colbase, int lane) { const u32x2 lo = trd4(img, PB, rb0, colbase, lane), hi = trd4(img, PB, rb1, colbase, lane); return __builtin_bit_cast(bf16x8, (u32x4){lo.x, lo.y, hi.x, hi.y}); }
template <int CTRL, int RM> DI float dpp_keep(float x, float ident) { return __builtin_bit_cast(float, __builtin_amdgcn_update_dpp(__builtin_bit_cast(int, ident), __builtin_bit_cast(int, x), CTRL, RM, 0xF, false)); }
DI float scan_add64(float x) { x += dpp_keep<0x111, 0xF>(x, 0.f); x += dpp_keep<0x112, 0xF>(x, 0.f); x += dpp_keep<0x114, 0xF>(x, 0.f); x += dpp_keep<0x118, 0xF>(x, 0.f); x += dpp_keep<0x142, 0xA>(x, 0.f); x += dpp_keep<0x143, 0xC>(x, 0.f); return x; }
DI float scan_max64(float x) { const float NI = -3.0e38f; x = fmaxf(x, dpp_keep<0x111, 0xF>(x, NI)); x = fmaxf(x, dpp_keep<0x112, 0xF>(x, NI)); x = fmaxf(x, dpp_keep<0x114, 0xF>(x, NI)); x = fmaxf(x, dpp_keep<0x118, 0xF>(x, NI));
    x = fmaxf(x, dpp_keep<0x142, 0xA>(x, NI)); x = fmaxf(x, dpp_keep<0x143, 0xC>(x, NI)); return x; }
DI float wave_sum(float v) {
    v = red16(v);
    const int vi = __builtin_bit_cast(int, v);
    const float a = __builtin_bit_cast(float, __builtin_amdgcn_readlane(vi, 0)), b = __builtin_bit_cast(float, __builtin_amdgcn_readlane(vi, 16));
    const float c = __builtin_bit_cast(float, __builtin_amdgcn_readlane(vi, 32)), d = __builtin_bit_cast(float, __builtin_amdgcn_readlane(vi, 48));
    return (a + b) + (c + d);
}
#define LDS_WAIT() asm volatile("s_waitcnt lgkmcnt(0)" ::: "memory")

constexpr float F8_SX = 8.f, F8_SWGU = 512.f, F8_SH = 4.f, F8_SWDN = 1024.f, F8_INV1 = 1.f / (F8_SX * F8_SWGU), F8_INV2 = 1.f / (F8_SH * F8_SWDN);
namespace pg8 {
constexpr int BM = 256, BK = 64, HALF = 128, HTB = HALF * BK * 2, STAGE_BYTES = 8 * HTB, NXCD = 8, WGM = 8;
__host__ __device__ __forceinline__ int lds_byte(int r, int c) { const int st = (r >> 4) * 2 + (c >> 5), rr = r & 15, cc = c & 31, ob = rr * 64 + cc * 2; return st * 1024 + (ob ^ (((ob >> 9) & 1) << 5)); }
__host__ __device__ __forceinline__ void stage_rc(int b, int& R, int& C) { const int st = b / 1024, sb = b % 1024, swz = sb ^ (((sb >> 9) & 1) << 5); R = (st >> 1) * 16 + swz / 64; C = (st & 1) * 32 + (swz % 64) / 2; }
__host__ __device__ __forceinline__ int perm32(int rho) { const int n = rho >> 4, i = rho & 15; return 8 * (i >> 2) + 4 * n + (i & 3); }

struct Unit { const char* a; const char* b; char* c; int ldc; int r0, c0, e, sub; };

struct TileOrder {
    int nM, nN, nwg;
    DI void init(int nM_, int nN_) { nM = nM_; nN = nN_; nwg = nM * nN; }
    DI bool tile(long L, int& pm, int& pn) const {
        if (L >= nwg) return false;
        int wgid = (int)L; { const int q = nwg / NXCD, r = nwg % NXCD, xcd = wgid % NXCD, off = wgid / NXCD; wgid = (xcd < r ? xcd * (q + 1) : r * (q + 1) + (xcd - r) * q) + off; }
        const int nig = WGM * nN, gid = wgid / nig, fm = gid * WGM, gsz = (nM - fm) < WGM ? (nM - fm) : WGM;
        pm = fm + ((wgid % nig) % gsz); pn = (wgid % nig) / gsz; return true;
    }
};

DI u32x4 pack8(const f32x4& v0, const f32x4& v1) { u32x4 w; w.x = pk2(v0[0], v0[1]); w.y = pk2(v0[2], v0[3]); w.z = pk2(v1[0], v1[1]); w.w = pk2(v1[2], v1[3]); return w; }

struct EpiStore {
    DI void operator()(const f32x4 (&acc)[2][2][4][2], const Unit& u, int wr, int wc, int fr, int fq) const {
#pragma unroll
        for (int ai = 0; ai < 2; ++ai)
#pragma unroll
            for (int m = 0; m < 4; ++m) { char* rowp = u.c + ((size_t)(ai * HALF + wr * 64 + m * 16 + fr) * u.ldc + wc * 32 + 8 * fq) * 2;
#pragma unroll
                for (int bj = 0; bj < 2; ++bj) *(u32x4*)(rowp + bj * 256) = pack8(acc[ai][bj][m][0], acc[ai][bj][m][1]); }
    }
};
struct EpiStoreS {
    float s;
    DI void operator()(const f32x4 (&acc)[2][2][4][2], const Unit& u, int wr, int wc, int fr, int fq) const {
#pragma unroll
        for (int ai = 0; ai < 2; ++ai)
#pragma unroll
            for (int m = 0; m < 4; ++m) { char* rowp = u.c + ((size_t)(ai * HALF + wr * 64 + m * 16 + fr) * u.ldc + wc * 32 + 8 * fq) * 2;
#pragma unroll
                for (int bj = 0; bj < 2; ++bj) *(u32x4*)(rowp + bj * 256) = pack8(acc[ai][bj][m][0] * s, acc[ai][bj][m][1] * s); }
    }
};
struct EpiMerge {
    static constexpr bool MIDK = true;
    const char* U; const float* gate_b;
    DI void mid(f32x4 (&acc)[2][2][4][2], const Unit& u, int which, int wr, int wc, int fr, int fq) const {
        const float L2E = 1.4426950408889634f;
#pragma unroll
        for (int bj = 0; bj < 2; ++bj) {
            const float* g = gate_b + which * 1024 + u.c0 + bj * HALF + wc * 32 + 8 * fq;
            const f32x4 ga0 = *(const f32x4*)g, ga1 = *(const f32x4*)(g + 4), gn0 = *(const f32x4*)(g + 1024), gn1 = *(const f32x4*)(g + 1028);
            const float gaa[8] = {ga0.x, ga0.y, ga0.z, ga0.w, ga1.x, ga1.y, ga1.z, ga1.w}, gnn[8] = {gn0.x, gn0.y, gn0.z, gn0.w, gn1.x, gn1.y, gn1.z, gn1.w};
#pragma unroll
            for (int ai = 0; ai < 2; ++ai)
#pragma unroll
                for (int m = 0; m < 4; ++m) { const int lr = ai * HALF + wr * 64 + m * 16 + fr;
                    const char* gp = U + ((size_t)(u.r0 + lr) * NU + UC_GATE + which * 1024 + u.c0 + wc * 32 + 8 * fq) * 2 + bj * 256;
                    const u32x4 wa = *(const u32x4*)gp, wn = *(const u32x4*)(gp + 2048);
                    const float xa[8] = {bflo(wa.x), bfhi(wa.x), bflo(wa.y), bfhi(wa.y), bflo(wa.z), bfhi(wa.z), bflo(wa.w), bfhi(wa.w)};
                    const float xn[8] = {bflo(wn.x), bfhi(wn.x), bflo(wn.y), bfhi(wn.y), bflo(wn.z), bfhi(wn.z), bflo(wn.w), bfhi(wn.w)};
#pragma unroll
                    for (int i = 0; i < 8; ++i) { const float ea = __builtin_amdgcn_exp2f(-L2E * __builtin_amdgcn_fmed3f(xa[i] + gaa[i], -30.f, 30.f)), en = __builtin_amdgcn_exp2f(-L2E * __builtin_amdgcn_fmed3f(xn[i] + gnn[i], -30.f, 30.f));
                        acc[ai][bj][m][i >> 2][i & 3] *= (1.f + en) * __builtin_amdgcn_rcpf(1.f + ea); }
                    if (m & 1) asm volatile("" ::: "memory"); }
        }
    }
    DI void operator()(const f32x4 (&acc)[2][2][4][2], const Unit& u, int wr, int wc, int fr, int fq) const {
        f32x4 gb[2][2];
#pragma unroll
        for (int bj = 0; bj < 2; ++bj) { const float* g = gate_b + 2048 + u.c0 + bj * HALF + wc * 32 + 8 * fq; gb[bj][0] = *(const f32x4*)g; gb[bj][1] = *(const f32x4*)(g + 4); }
#pragma unroll
        for (int ai = 0; ai < 2; ++ai)
#pragma unroll
            for (int m = 0; m < 4; ++m) { const int lr = ai * HALF + wr * 64 + m * 16 + fr; char* rowp = u.c + ((size_t)lr * u.ldc + wc * 32 + 8 * fq) * 2;
                const char* gp = U + ((size_t)(u.r0 + lr) * NU + UC_GATE + 2048 + u.c0 + wc * 32 + 8 * fq) * 2;
#pragma unroll
                for (int bj = 0; bj < 2; ++bj) { const u32x4 gw = *(const u32x4*)(gp + bj * 256);
                    f32x4 v0 = acc[ai][bj][m][0], v1 = acc[ai][bj][m][1];
                    v0[0] *= sigmoidf_(bflo(gw.x) + gb[bj][0][0]); v0[1] *= sigmoidf_(bfhi(gw.x) + gb[bj][0][1]); v0[2] *= sigmoidf_(bflo(gw.y) + gb[bj][0][2]); v0[3] *= sigmoidf_(bfhi(gw.y) + gb[bj][0][3]);
                    v1[0] *= sigmoidf_(bflo(gw.z) + gb[bj][1][0]); v1[1] *= sigmoidf_(bfhi(gw.z) + gb[bj][1][1]); v1[2] *= sigmoidf_(bflo(gw.w) + gb[bj][1][2]); v1[3] *= sigmoidf_(bfhi(gw.w) + gb[bj][1][3]);
                    *(u32x4*)(rowp + bj * 256) = pack8(v0, v1); }
                asm volatile("" ::: "memory"); }
    }
};
struct EpiWo {
    const char* X;
    DI void operator()(const f32x4 (&acc)[2][2][4][2], const Unit& u, int wr, int wc, int fr, int fq) const {
#pragma unroll
        for (int ai = 0; ai < 2; ++ai)
#pragma unroll
            for (int m = 0; m < 4; ++m) { const int lr = ai * HALF + wr * 64 + m * 16 + fr; char* rowp = u.c + ((size_t)lr * u.ldc + wc * 32 + 8 * fq) * 2;
                const char* xp = X + ((size_t)(u.r0 + lr) * D + u.c0 + wc * 32 + 8 * fq) * 2;
#pragma unroll
                for (int bj = 0; bj < 2; ++bj) { const u32x4 xw = *(const u32x4*)(xp + bj * 256);
                    f32x4 v0 = acc[ai][bj][m][0], v1 = acc[ai][bj][m][1];
                    v0[0] += DN_ALPHA * bflo(xw.x); v0[1] += DN_ALPHA * bfhi(xw.x); v0[2] += DN_ALPHA * bflo(xw.y); v0[3] += DN_ALPHA * bfhi(xw.y);
                    v1[0] += DN_ALPHA * bflo(xw.z); v1[1] += DN_ALPHA * bfhi(xw.z); v1[2] += DN_ALPHA * bflo(xw.w); v1[3] += DN_ALPHA * bfhi(xw.w);
                    *(u32x4*)(rowp + bj * 256) = pack8(v0, v1); }
                asm volatile("" ::: "memory"); }
    }
};
DI float swiglu1(float a, float b) { const float g = fminf(a, 7.f), l = fminf(fmaxf(b, -7.f), 7.f); return g * sigmoidf_(1.702f * g) * (l + 1.f); }
struct EpiMoe1 {
    const float* bgu;
    DI void operator()(const f32x4 (&acc)[2][2][4][2], const Unit& u, int wr, int wc, int fr, int fq) const {
        f32x4 bv[2][2];
#pragma unroll
        for (int bj = 0; bj < 2; ++bj) { const float* b = bgu + u.e * 2048 + u.c0 + bj * HALF + wc * 32 + 8 * fq; bv[bj][0] = *(const f32x4*)b; bv[bj][1] = *(const f32x4*)(b + 4); }
#pragma unroll
        for (int ai = 0; ai < 2; ++ai)
#pragma unroll
            for (int m = 0; m < 4; ++m) { const int lr = ai * HALF + wr * 64 + m * 16 + fr; char* rowp = u.c + ((size_t)lr * u.ldc + wc * 16 + 4 * fq);
#pragma unroll
                for (int bj = 0; bj < 2; ++bj) { const f32x4 v0 = acc[ai][bj][m][0] * F8_INV1 + bv[bj][0], v1 = acc[ai][bj][m][1] * F8_INV1 + bv[bj][1];
                    *(unsigned*)(rowp + bj * 64) = pk4_f8(swiglu1(v0[0], v0[1]) * F8_SH, swiglu1(v0[2], v0[3]) * F8_SH, swiglu1(v1[0], v1[1]) * F8_SH, swiglu1(v1[2], v1[3]) * F8_SH); } }
    }
};
struct EpiMoe2 {
    const float* bdn;
    DI void operator()(const f32x4 (&acc)[2][2][4][2], const Unit& u, int wr, int wc, int fr, int fq) const {
        f32x4 bv[2][2];
#pragma unroll
        for (int bj = 0; bj < 2; ++bj) { const float* b = bdn + u.e * 1024 + u.c0 + bj * HALF + wc * 32 + 8 * fq; bv[bj][0] = *(const f32x4*)b; bv[bj][1] = *(const f32x4*)(b + 4); }
#pragma unroll
        for (int ai = 0; ai < 2; ++ai)
#pragma unroll
            for (int m = 0; m < 4; ++m) { char* rowp = u.c + ((size_t)(ai * HALF + wr * 64 + m * 16 + fr) * u.ldc + wc * 32 + 8 * fq) * 2;
#pragma unroll
                for (int bj = 0; bj < 2; ++bj) *(u32x4*)(rowp + bj * 256) = pack8(acc[ai][bj][m][0] * F8_INV2 + bv[bj][0], acc[ai][bj][m][1] * F8_INV2 + bv[bj][1]); }
    }
};

typedef int i32x8 __attribute__((ext_vector_type(8)));
typedef int i32x4 __attribute__((ext_vector_type(4)));
template <bool F8, bool MIDK = false, class Epi, class Sched>
DI void gemm_phase(LAS unsigned char* lds, const int KB  , const int ldaB, const int ldbB, const Sched& S, const Epi& E, const int wave_) {
    unsigned z_ = 0u; asm volatile("" : "+v"(z_)); const int tid = wave_ * 64 + (int)__builtin_amdgcn_mbcnt_hi(~0u, __builtin_amdgcn_mbcnt_lo(~0u, z_));
    const int wid = __builtin_amdgcn_readfirstlane(tid >> 6), lane = tid & 63, wr = wid >> 2, wc = wid & 3, fr = lane & 15, fq = lane >> 4;
    const int nt = KB / (BK * 2);
    unsigned voffA[2], voffB[2];
#pragma unroll
    for (int i = 0; i < 2; ++i) { int R, C; stage_rc(tid * 16 + i * 8192, R, C); const int Rb = (R & ~31) + perm32(R & 31);
        voffA[i] = (unsigned)(R * ldaB + C * 2); voffB[i] = (unsigned)(Rb * ldbB + C * 2); }
    asm volatile("" : "+v"(voffA[0]), "+v"(voffA[1]), "+v"(voffB[0]), "+v"(voffB[1]));
    const size_t kstep = (size_t)(BK * 2);
    const size_t hstepA = (size_t)HALF * ldaB, hstepB = (size_t)HALF * ldbB;
    const unsigned ldsw = (unsigned)wid * 1024u;
    const int aoff = lds_byte(wr * 64 + fr, fq * 8), boff = lds_byte(wc * 32 + fr, fq * 8);
#define PG8_SA(b, h) (((b) * 2 + (h)) * HTB)
#define PG8_SB(b, h) ((4 + (b) * 2 + (h)) * HTB)
#define PG8_STAGE(bufoff, gbase, voff) do { _Pragma("unroll") for (int _i = 0; _i < 2; ++_i) \
        __builtin_amdgcn_global_load_lds((const unsigned*)((const char*)(gbase) + (voff)[_i]), (LAS unsigned*)(lds + (bufoff) + ldsw + _i * 8192), 16, 0, 0); } while (0)
#define PG8_LD8(p) __builtin_shufflevector(*(const LAS i32x4*)(p), *(const LAS i32x4*)((p) + 1024), 0, 1, 2, 3, 4, 5, 6, 7)
#define PG8_LDA8(dst, b, h) do { _Pragma("unroll") for (int m = 0; m < 4; ++m) dst[m] = PG8_LD8(lds + PG8_SA(b, h) + aoff + m * 2048); } while (0)
#define PG8_LDB8(dst, b, h) do { _Pragma("unroll") for (int n = 0; n < 2; ++n) dst[n] = PG8_LD8(lds + PG8_SB(b, h) + boff + n * 2048); } while (0)
#define PG8_MMA8(ai, bj, A8, B8) do { __builtin_amdgcn_s_setprio(1); _Pragma("unroll") for (int m = 0; m < 4; ++m) _Pragma("unroll") for (int n = 0; n < 2; ++n) \
        asm volatile("v_mfma_f32_16x16x128_f8f6f4 %0, %1, %2, %0" : "+v"(acc[ai][bj][m][n]) : "v"(B8[n]), "v"(A8[m])); __builtin_amdgcn_s_setprio(0); } while (0)
#define PG8_LDA(dst, b, h) do { _Pragma("unroll") for (int m = 0; m < 4; ++m) _Pragma("unroll") for (int k = 0; k < 2; ++k) dst[m][k] = *(const LAS bf16x8*)(lds + PG8_SA(b, h) + aoff + m * 2048 + k * 1024); } while (0)
#define PG8_LDB(dst, b, h) do { _Pragma("unroll") for (int n = 0; n < 2; ++n) _Pragma("unroll") for (int k = 0; k < 2; ++k) dst[n][k] = *(const LAS bf16x8*)(lds + PG8_SB(b, h) + boff + n * 2048 + k * 1024); } while (0)
#define PG8_CAT(x) __builtin_shufflevector(__builtin_bit_cast(i32x4, (x)[0]), __builtin_bit_cast(i32x4, (x)[1]), 0, 1, 2, 3, 4, 5, 6, 7)
#define PG8_MMA(ai, bj, At, Bt) do { __builtin_amdgcn_s_setprio(1); _Pragma("unroll") for (int m = 0; m < 4; ++m) _Pragma("unroll") for (int n = 0; n < 2; ++n) _Pragma("unroll") for (int k = 0; k < 2; ++k) \
        acc[ai][bj][m][n] = __builtin_amdgcn_mfma_f32_16x16x32_bf16(Bt[n][k], At[m][k], acc[ai][bj][m][n], 0, 0, 0); __builtin_amdgcn_s_setprio(0); } while (0)
#define PG8_WAIT_V(n) asm volatile("s_waitcnt vmcnt(" #n ")" ::: "memory")
#define PG8_WAIT_L(n) asm volatile("s_waitcnt lgkmcnt(" #n ")" ::: "memory")
#define PG8_BAR __builtin_amdgcn_s_barrier()
#define PG8_SCHED __builtin_amdgcn_sched_barrier(0)
    Unit cur, nxt; int ui = 0;
    if (!S.next(0, cur)) return;
    f32x4 acc[2][2][4][2];
#pragma unroll
    for (int a = 0; a < 2; ++a)
#pragma unroll
        for (int b = 0; b < 2; ++b)
#pragma unroll
            for (int m = 0; m < 4; ++m)
#pragma unroll
                for (int n = 0; n < 2; ++n) acc[a][b][m][n] = (f32x4){0.f, 0.f, 0.f, 0.f};
    bf16x8 At[4][2], B0[2][2], B1[2][2]; i32x8 A8[4], B80[2], B81[2];
    const char* cA = cur.a; const char* cB = cur.b;
    PG8_STAGE(PG8_SB(0, 0), cB, voffB); PG8_STAGE(PG8_SB(0, 1), cB + hstepB, voffB); PG8_STAGE(PG8_SA(0, 0), cA, voffA); PG8_STAGE(PG8_SA(0, 1), cA + hstepA, voffA);
    if (wr == 1) PG8_BAR;
    PG8_WAIT_V(2); PG8_BAR;
    PG8_STAGE(PG8_SB(1, 0), cB + kstep, voffB); PG8_STAGE(PG8_SA(1, 0), cA + kstep, voffA); PG8_STAGE(PG8_SB(1, 1), cB + hstepB + kstep, voffB);
    PG8_WAIT_V(6); PG8_BAR;
    for (;;) {
        const bool has_next = S.next(ui + 1, nxt);
        const char* nA = has_next ? nxt.a : cA; const char* nB = has_next ? nxt.b : cB;
#pragma unroll 1
        for (int t = 0; t < nt; t += 2) {
            if constexpr (MIDK) { if (t == 8 || t == 16) { int fr_ = fr, fq_ = fq; asm volatile("" : "+v"(fr_), "+v"(fq_)); E.mid(acc, cur, t >> 4, wr, wc, fr_, fq_); } }
            const bool last = (t == nt - 2);
            const char* a1 = cA + (size_t)(t + 1) * kstep;
            const char* a2 = last ? nA : cA + (size_t)(t + 2) * kstep; const char* b2 = last ? nB : cB + (size_t)(t + 2) * kstep;
            const char* a3 = a2 + kstep; const char* b3 = b2 + kstep;
            if constexpr (F8) {
            PG8_LDB8(B80, 0, 0); PG8_LDB8(B81, 0, 1); PG8_SCHED; PG8_LDA8(A8, 0, 0); PG8_STAGE(PG8_SA(1, 1), a1 + hstepA, voffA);
            PG8_WAIT_V(8); PG8_WAIT_L(0); PG8_BAR; PG8_MMA8(0, 0, A8, B80); PG8_MMA8(0, 1, A8, B81); PG8_BAR; PG8_SCHED;
            PG8_LDA8(A8, 0, 1); PG8_STAGE(PG8_SB(0, 0), b2, voffB); PG8_STAGE(PG8_SB(0, 1), b2 + hstepB, voffB); PG8_STAGE(PG8_SA(0, 0), a2, voffA);
            PG8_WAIT_V(8); PG8_WAIT_L(0); PG8_BAR; PG8_MMA8(1, 0, A8, B80); PG8_MMA8(1, 1, A8, B81); PG8_BAR; PG8_SCHED;
            PG8_LDB8(B80, 1, 0); PG8_LDB8(B81, 1, 1); PG8_SCHED; PG8_LDA8(A8, 1, 0); PG8_STAGE(PG8_SA(0, 1), a2 + hstepA, voffA);
            PG8_WAIT_V(8); PG8_WAIT_L(0); PG8_BAR; PG8_MMA8(0, 0, A8, B80); PG8_MMA8(0, 1, A8, B81); PG8_BAR; PG8_SCHED;
            PG8_LDA8(A8, 1, 1); PG8_STAGE(PG8_SB(1, 0), b3, voffB); PG8_STAGE(PG8_SB(1, 1), b3 + hstepB, voffB); PG8_STAGE(PG8_SA(1, 0), a3, voffA);
            PG8_WAIT_V(8); PG8_WAIT_L(0); PG8_BAR; PG8_MMA8(1, 0, A8, B80); PG8_MMA8(1, 1, A8, B81); PG8_BAR; PG8_SCHED;
            } else {
            PG8_LDB(B0, 0, 0); PG8_LDB(B1, 0, 1); PG8_SCHED; PG8_LDA(At, 0, 0); PG8_STAGE(PG8_SA(1, 1), a1 + hstepA, voffA);
            PG8_WAIT_V(8); PG8_WAIT_L(0); PG8_BAR; PG8_MMA(0, 0, At, B0); PG8_MMA(0, 1, At, B1); PG8_BAR; PG8_SCHED;
            PG8_LDA(At, 0, 1); PG8_STAGE(PG8_SB(0, 0), b2, voffB); PG8_STAGE(PG8_SB(0, 1), b2 + hstepB, voffB); PG8_STAGE(PG8_SA(0, 0), a2, voffA);
            PG8_WAIT_V(8); PG8_WAIT_L(0); PG8_BAR; PG8_MMA(1, 0, At, B0); PG8_MMA(1, 1, At, B1); PG8_BAR; PG8_SCHED;
            PG8_LDB(B0, 1, 0); PG8_LDB(B1, 1, 1); PG8_SCHED; PG8_LDA(At, 1, 0); PG8_STAGE(PG8_SA(0, 1), a2 + hstepA, voffA);
            PG8_WAIT_V(8); PG8_WAIT_L(0); PG8_BAR; PG8_MMA(0, 0, At, B0); PG8_MMA(0, 1, At, B1); PG8_BAR; PG8_SCHED;
            PG8_LDA(At, 1, 1); PG8_STAGE(PG8_SB(1, 0), b3, voffB); PG8_STAGE(PG8_SB(1, 1), b3 + hstepB, voffB); PG8_STAGE(PG8_SA(1, 0), a3, voffA);
            PG8_WAIT_V(8); PG8_WAIT_L(0); PG8_BAR; PG8_MMA(1, 0, At, B0); PG8_MMA(1, 1, At, B1); PG8_BAR; PG8_SCHED;
            }
        }
        if (wr == 0) PG8_BAR;
        if constexpr (F8) asm volatile("s_nop 15\n\ts_nop 15" ::: "memory");
        { int fr_ = fr, fq_ = fq; asm volatile("" : "+v"(fr_), "+v"(fq_));
          E(acc, cur, wr, wc, fr_, fq_); }
        if (!has_next) break;
#pragma unroll
        for (int a = 0; a < 2; ++a)
#pragma unroll
            for (int b = 0; b < 2; ++b)
#pragma unroll
                for (int m = 0; m < 4; ++m)
#pragma unroll
                    for (int n = 0; n < 2; ++n) acc[a][b][m][n] = (f32x4){0.f, 0.f, 0.f, 0.f};
        cur = nxt; cA = nA; cB = nB; ++ui;
        if (wr == 1) PG8_BAR;
    }
    PG8_WAIT_V(0);
    PG8_BAR;
#undef PG8_SA
#undef PG8_SB
#undef PG8_STAGE
#undef PG8_LDA
#undef PG8_LDB
#undef PG8_MMA
#undef PG8_CAT
#undef PG8_LD8
#undef PG8_LDA8
#undef PG8_LDB8
#undef PG8_MMA8
#undef PG8_WAIT_V
#undef PG8_WAIT_L
#undef PG8_BAR
#undef PG8_SCHED
}
}

#define XB_TMO      128
#define XB_XCNT(j)  (256  + 64 * (j))
#define XB_XSUB(j)  (1280 + 64 * (j))
#define XB_XGEN(j)  (2304 + 64 * (j))
#define XB_TOP      3328
#define XB_TOPGEN   3392
#define XCD_BAR_WORDS 3456
#define XB_SPIN_CAP (1u << 22)
DI unsigned xb_ld(unsigned* p)              { return __hip_atomic_load(p, __ATOMIC_RELAXED, __HIP_MEMORY_SCOPE_AGENT); }
DI unsigned xb_add(unsigned* p, unsigned v) { return __hip_atomic_fetch_add(p, v, __ATOMIC_RELAXED, __HIP_MEMORY_SCOPE_AGENT); }
DI unsigned xb_xcc_id() { return (unsigned)__builtin_amdgcn_s_getreg((3 << 11) | 20) & 0xFu; }
#define XB_SPIN(cond, bar) do { unsigned _sp = 0; while (cond) { __builtin_amdgcn_s_sleep(1); \
    if ((++_sp & 255u) == 0u) { if (xb_ld(&(bar)[XB_TMO])) break; if (_sp > XB_SPIN_CAP) { atomicAdd(&(bar)[XB_TMO], 1u); break; } } } } while (0)
struct XcdBarrier { unsigned* bar; unsigned x; volatile LAS unsigned* st; };
DI XcdBarrier xcd_barrier_post(unsigned* bar, volatile LAS unsigned* st) {
    XcdBarrier b; b.bar = bar; b.x = xb_xcc_id(); b.st = st;
    if (threadIdx.x == 0) (void)xb_add(&bar[XB_XCNT(b.x)], 1u);
    return b;
}
DI void xcd_barrier_complete(unsigned* bar, unsigned x, unsigned& nloc, unsigned& nx) {
    const unsigned G = gridDim.x * gridDim.y * gridDim.z;
    unsigned sum, cnt, mine, sp = 0u;
    for (;;) {
        sum = 0u; cnt = 0u; mine = 0u;
#pragma unroll
        for (unsigned j = 0; j < 16; ++j) { const unsigned c = xb_ld(&bar[XB_XCNT(j)]); sum += c; cnt += (c > 0u) ? 1u : 0u; mine = (j == x) ? c : mine; }
        if (sum == G) break;
        __builtin_amdgcn_s_sleep(1);
        if ((++sp & 255u) == 0u) { if (xb_ld(&bar[XB_TMO])) break; if (sp > XB_SPIN_CAP) { atomicAdd(&bar[XB_TMO], 1u); break; } }
    }
    nloc = mine > 0u ? mine : 1u; nx = cnt > 0u ? cnt : 1u;
}
DI void xcd_barrier(const XcdBarrier& b) {
    asm volatile("s_waitcnt vmcnt(0)" ::: "memory");
    __syncthreads();
    if (threadIdx.x == 0) {
        unsigned* bar = b.bar;
        __builtin_amdgcn_s_waitcnt(0);
        unsigned nloc = b.st[0], nx = b.st[1];
        if (nloc == 0u) { xcd_barrier_complete(bar, b.x, nloc, nx); b.st[0] = nloc; b.st[1] = nx; }
        const unsigned old = xb_add(&bar[XB_XSUB(b.x)], 1u);
        const unsigned gen = old / nloc;
        if (old + 1u == (gen + 1u) * nloc) {
            __builtin_amdgcn_fence(__ATOMIC_RELEASE, "agent");
            asm volatile("s_waitcnt vmcnt(0)" ::: "memory");
            const unsigned og = xb_add(&bar[XB_TOP], 1u);
            const unsigned tg = og / nx;
            if (og + 1u == (tg + 1u) * nx) xb_add(&bar[XB_TOPGEN], 1u);
            else XB_SPIN(xb_ld(&bar[XB_TOPGEN]) == tg, bar);
            __builtin_amdgcn_fence(__ATOMIC_ACQUIRE, "agent");
            xb_add(&bar[XB_XGEN(b.x)], 1u);
            asm volatile("s_waitcnt vmcnt(0)" ::: "memory");
        } else {
            XB_SPIN(xb_ld(&bar[XB_XGEN(b.x)]) == gen, bar);
            __builtin_amdgcn_fence(__ATOMIC_ACQUIRE, "agent");
            asm volatile("s_waitcnt vmcnt(0)" ::: "memory");
        }
    }
    __syncthreads();
}

DI void transpose_item(const float* W, int ldw, bf16* WT, int ldt, LAS float* scr, int lane) {
    { const int kr = lane >> 3, c4 = (lane & 7) * 4; f32x4 v[8];
#pragma unroll
        for (int i = 0; i < 8; ++i) v[i] = *(const f32x4*)(W + (size_t)(8 * i + kr) * ldw + c4);
#pragma unroll
        for (int i = 0; i < 8; ++i) { LAS float* o = scr + (8 * i + kr) * 33 + c4; o[0] = v[i].x; o[1] = v[i].y; o[2] = v[i].z; o[3] = v[i].w; } }
    LDS_WAIT(); asm volatile("" ::: "memory");
    const int c = lane & 7;
#pragma unroll
    for (int j = 0; j < 4; ++j) { const int n = (lane >> 3) + 8 * j; const LAS float* s = scr + (8 * c) * 33 + n;
        u32x4 o; o.x = pk2(s[0 * 33], s[1 * 33]); o.y = pk2(s[2 * 33], s[3 * 33]); o.z = pk2(s[4 * 33], s[5 * 33]); o.w = pk2(s[6 * 33], s[7 * 33]);
        *(u32x4*)(WT + (size_t)n * ldt + 8 * c) = o; }
    LDS_WAIT(); asm volatile("" ::: "memory");
}
DI void transpose_item_f8(const float* W, int ldw, unsigned char* WT, int ldt, float scale, LAS float* scr, int lane) {
    { const int kr = lane >> 3, c4 = (lane & 7) * 4; f32x4 v[8];
#pragma unroll
        for (int i = 0; i < 8; ++i) v[i] = *(const f32x4*)(W + (size_t)(8 * i + kr) * ldw + c4);
#pragma unroll
        for (int i = 0; i < 8; ++i) { LAS float* o = scr + (8 * i + kr) * 33 + c4; o[0] = v[i].x; o[1] = v[i].y; o[2] = v[i].z; o[3] = v[i].w; } }
    LDS_WAIT(); asm volatile("" ::: "memory");
    const int c = lane & 3;
#pragma unroll
    for (int j = 0; j < 2; ++j) { const int n = (lane >> 2) + 16 * j; const LAS float* s = scr + (16 * c) * 33 + n;
        u32x4 o; o.x = pk4_f8(s[0 * 33] * scale, s[1 * 33] * scale, s[2 * 33] * scale, s[3 * 33] * scale); o.y = pk4_f8(s[4 * 33] * scale, s[5 * 33] * scale, s[6 * 33] * scale, s[7 * 33] * scale);
        o.z = pk4_f8(s[8 * 33] * scale, s[9 * 33] * scale, s[10 * 33] * scale, s[11 * 33] * scale); o.w = pk4_f8(s[12 * 33] * scale, s[13 * 33] * scale, s[14 * 33] * scale, s[15 * 33] * scale);
        *(u32x4*)(WT + (size_t)n * ldt + 16 * c) = o; }
    LDS_WAIT(); asm volatile("" ::: "memory");
}
DI void ln16(f32x4 (&v)[4], const f32x4 (&g)[4], const f32x4 (&b)[4]) {
    float s = 0.f;
#pragma unroll
    for (int j = 0; j < 4; ++j) s += (v[j].x + v[j].y) + (v[j].z + v[j].w);
    const float mean = wave_sum(s) * (1.f / D); float s2 = 0.f;
#pragma unroll
    for (int j = 0; j < 4; ++j) { v[j] = v[j] - mean; s2 += (v[j].x * v[j].x + v[j].y * v[j].y) + (v[j].z * v[j].z + v[j].w * v[j].w); }
    const float rstd = 1.f / sqrtf(wave_sum(s2) * (1.f / D) + LN_EPS);
#pragma unroll
    for (int j = 0; j < 4; ++j) v[j] = v[j] * rstd * g[j] + b[j];
}
DI void gates8(const f32x4 (&y)[4], const LAS float* wgt, float* gif_row, int lane) {
    float p[8];
#pragma unroll
    for (int j = 0; j < 8; ++j) { float s = 0.f;
#pragma unroll
        for (int jj = 0; jj < 4; ++jj) { const f32x4 w = *(const LAS f32x4*)(wgt + j * 1024 + 256 * jj + 4 * lane); s += (y[jj].x * w.x + y[jj].y * w.y) + (y[jj].z * w.z + y[jj].w * w.w); }
        p[j] = wave_sum(s); }
    if (lane == 0) { *(f32x4*)gif_row = (f32x4){p[0], p[1], p[2], p[3]}; *(f32x4*)(gif_row + 4) = (f32x4){p[4], p[5], p[6], p[7]}; }
}
DI void gates8b(const f32x4 (&y)[4], const LAS float* wgt, float* gif_row, int lane) {
    float p[8];
#pragma unroll
    for (int j = 0; j < 8; ++j) { float s = 0.f;
#pragma unroll
        for (int jj = 0; jj < 4; ++jj) { const f32x4 w = *(const LAS f32x4*)(wgt + j * 1024 + (jj >> 1) * 512 + 8 * lane + (jj & 1) * 4); s += (y[jj].x * w.x + y[jj].y * w.y) + (y[jj].z * w.z + y[jj].w * w.w); }
        p[j] = wave_sum(s); }
    if (lane == 0) { *(f32x4*)gif_row = (f32x4){p[0], p[1], p[2], p[3]}; *(f32x4*)(gif_row + 4) = (f32x4){p[4], p[5], p[6], p[7]}; }
}
DI void load_gate_table(LAS float* wgt, const float* win_l, int tid) {
    for (int i = tid; i < 8192; i += NTHR) { const int k = i >> 3, j = i & 7; wgt[j * 1024 + k] = win_l[(size_t)k * DIN + 1536 + j]; }
}
DI f32x4 ld4bf(const char* p) { const u32x2 w = *(const u32x2*)p; return (f32x4){bflo(w.x), bfhi(w.x), bflo(w.y), bfhi(w.y)}; }
DI void st4bf(char* p, const f32x4& v) { u32x2 w; w.x = pk2(v.x, v.y); w.y = pk2(v.z, v.w); *(u32x2*)p = w; }

struct Args { const float* in[N_IN]; float* out; unsigned char* ws; int ph_lo, ph_hi; };
constexpr int NP_LAYER = 12, NPH = 1 + DEPTH * NP_LAYER;
constexpr int XW_SPLIT = 49152;

struct SchedInproj {
    pg8::TileOrder T; int G, c; const char *X, *W; char* U; bool kv; const char *MEMN, *WKV; char* KV;
    DI bool next(int i, pg8::Unit& u) const {
        const long L = (long)i * G + c; int pm, pn;
        if (T.tile(L, pm, pn)) { u.a = X + (size_t)pm * 256 * D * 2; u.b = W + (size_t)pn * 256 * D * 2; u.r0 = pm * 256; u.c0 = pn * 256; u.c = U + ((size_t)u.r0 * NU + u.c0) * 2; u.ldc = NU; u.e = 0; u.sub = 0; return true; }
        if (!kv) return false;
        const long L2 = L - T.nwg; if (L2 < 0 || L2 >= 128) return false;
        const int l = (int)L2 >> 6, t = (int)L2 & 63; pm = t >> 2; pn = t & 3;
        u.a = MEMN + (size_t)pm * 256 * D * 2; u.b = WKV + ((size_t)l * 1024 + pn * 256) * D * 2; u.r0 = pm * 256; u.c0 = pn * 256; u.c = KV + (((size_t)l * MROWS + u.r0) * D + u.c0) * 2; u.ldc = D; u.e = 0; u.sub = 0; return true;
    }
};
struct SchedPlain {
    pg8::TileOrder T; int G, c; const char *A, *B; char* C; int lda, ldb, ldc;
    DI bool next(int i, pg8::Unit& u) const {
        const long L = (long)i * G + c; int pm, pn; if (!T.tile(L, pm, pn)) return false;
        u.a = A + (size_t)pm * 256 * lda * 2; u.b = B + (size_t)pn * 256 * ldb * 2; u.r0 = pm * 256; u.c0 = pn * 256; u.c = C + ((size_t)u.r0 * ldc + u.c0) * 2; u.ldc = ldc; u.e = 0; u.sub = 0; return true;
    }
};
struct SchedMerge {
    pg8::TileOrder T; int G, c; const char *H, *W; char* Y;
    DI bool next(int i, pg8::Unit& u) const {
        const int ti = i / 3, br = i - 3 * ti; const long L = (long)ti * G + c; int pm, pn; if (!T.tile(L, pm, pn)) return false;
        u.a = H + ((size_t)pm * 256 * 1536 + br * 512) * 2; u.b = W + ((size_t)br * 1024 + pn * 256) * 512 * 2; u.r0 = pm * 256; u.c0 = pn * 256; u.c = Y + ((size_t)u.r0 * D + u.c0) * 2; u.ldc = D; u.e = 0; u.sub = br; return true;
    }
};
struct SchedMoe {
    pg8::TileOrder T; int G, c; const char *A, *W; char* C; const LAS int* PB; int wrows  , ldc, cdiv, osz;
    DI bool next(int i, pg8::Unit& u) const {
        const long L = (long)i * G + c; int pm, pn; if (!T.tile(L, pm, pn)) return false;
        int e = 0;
#pragma unroll 1
        for (int j = 1; j < NEXP; ++j) e += (PB[j] <= pm) ? 1 : 0;
        u.a = A + (size_t)pm * 256 * 1024; u.b = W + ((size_t)e * wrows + pn * 256) * 1024; u.r0 = pm * 256; u.c0 = pn * 256; u.c = C + ((size_t)u.r0 * ldc + u.c0 / cdiv) * osz; u.ldc = ldc; u.e = e; u.sub = 0; return true;
    }
};

__global__ void __launch_bounds__(NTHR, 2) fwd_kernel(Args args) {
    extern __shared__ __attribute__((aligned(16))) unsigned char lds_raw[];
#define INP(i) ([&]() -> const float* { int ii_ = (i); asm volatile("" : "+s"(ii_)); return args.in[ii_]; }())
    LAS unsigned char* lds = (LAS unsigned char*)lds_raw;
    volatile LAS unsigned* LCTL = (volatile LAS unsigned*)(lds + LDSCTL_OFF);
    const int tid0 = threadIdx.x, wave = __builtin_amdgcn_readfirstlane(tid0 >> 6);
#define PHASE_TID unsigned z_ = 0u; asm volatile("" : "+v"(z_)); int tid = wave * 64 + (int)__builtin_amdgcn_mbcnt_hi(~0u, __builtin_amdgcn_mbcnt_lo(~0u, z_)); const int lane = tid & 63; (void)lane;
    const int G = gridDim.x, bx = blockIdx.x;
    const int gw = bx * NWAVES + wave, NGW = G * NWAVES;
    unsigned char* ws = args.ws;
    gu32* ctl = (gu32*)(ws + WS_CTL);
    for (int u = tid0; u < (LDS_BYTES - LDSCTL_OFF) / 4; u += NTHR) ((LAS unsigned*)(lds + LDSCTL_OFF))[u] = 0u;
    __syncthreads();
    XcdBarrier bar; bar.bar = (unsigned*)ctl + CW_BAR; bar.x = 0; bar.st = nullptr;
    if (MK_ONE_LAUNCH) bar = xcd_barrier_post((unsigned*)ctl + CW_BAR, LCTL);
    const int lo = args.ph_lo, hi = args.ph_hi;
#ifndef SUBMASK
#define SUBMASK 7
#endif
#ifndef LN2PROBE
#define LN2PROBE 0
#endif
#ifndef SUBDUP
#define SUBDUP 0
#endif
#define NSUB(k) ((((SUBDUP) >> (k)) & 1) ? 2 : 1)
#ifndef DUPMASK
#define DUPMASK 0
#endif
#define NREP(k) ((((DUPMASK) >> (k)) & 1) ? 2 : 1)
#ifndef PHMASK
#define PHMASK 0xFFFF
#endif
#define IN(k) (lo <= (k) && (k) < hi)
#define SEAM(k) do { if (IN(k) && IN((k) + 1)) xcd_barrier(bar); } while (0)

    char* const Xb = (char*)(ws + WS_X);
    char* const Ub = (char*)(ws + WS_R1);
    float* const GIF = (float*)(ws + WS_GIF);
    LAS int* const PB = (LAS int*)(lds + LDSCTL_OFF + 64);
    LAS int* const CNT = (LAS int*)(lds + LDSCTL_OFF + 256);

    _Pragma("unroll 1") for (int rep_ = 0; rep_ < NREP(12); ++rep_) if (((PHMASK>>12)&1) && IN(0)) { PHASE_TID
        LAS float* scr = (LAS float*)(lds + wave * 8448);
        LAS float* wgt = (LAS float*)(lds + 73728);
        load_gate_table(wgt, INP(I_WIN), tid);
        constexpr int IT_IN = 16 * 216, IT_KV = 16 * 32, IT_BR = 8 * 32, IT_O = 16 * 32, IT_L = IT_IN + IT_KV + 3 * IT_BR + IT_O;
        for (int it = gw; it < DEPTH * IT_L; it += NGW) {
            const int l = it / IT_L; int r = it - l * IT_L;
            if (r < IT_IN) { const int kb = r / 216, nb = r % 216, n0 = 32 * nb, sc = n0 + (n0 >= 1536 ? 8 : 0);
                if (n0 < UC_GATE) transpose_item(INP(I_WIN) + ((size_t)l * D + 64 * kb) * DIN + sc, DIN, (bf16*)(ws + WS_WIN) + ((size_t)l * NU + n0) * D + 64 * kb, D, scr, lane);
                else transpose_item_f8(INP(I_WIN) + ((size_t)l * D + 64 * kb) * DIN + sc, DIN, (unsigned char*)(ws + WS_WING8) + ((size_t)l * 3072 + (n0 - UC_GATE)) * D + 64 * kb, D, F8_SWGU, scr, lane);
                continue; }
            r -= IT_IN;
            if (r < IT_KV) { const int kb = r / 32, nb = r % 32;
                transpose_item(INP(I_CAWKV) + ((size_t)l * D + 64 * kb) * 1024 + 32 * nb, 1024, (bf16*)(ws + WS_WKV) + ((size_t)l * 1024 + 32 * nb) * D + 64 * kb, D, scr, lane); continue; }
            r -= IT_KV;
            if (r < 3 * IT_BR) { const int br = r / IT_BR, q = r % IT_BR, kb = q / 32, nb = q % 32;
                const float* src = INP(br == 0 ? I_WBRML : (br == 1 ? I_WBRRW : I_WBRCA));
                transpose_item(src + ((size_t)l * 512 + 64 * kb) * 1024 + 32 * nb, 1024, (bf16*)(ws + WS_WBR) + ((size_t)l * 1024 + 32 * nb) * 1536 + br * 512 + 64 * kb, 1536, scr, lane); continue; }
            r -= 3 * IT_BR;
            { const int kb = r / 32, nb = r % 32;
                transpose_item(INP(I_WO) + ((size_t)l * D + 64 * kb) * 1024 + 32 * nb, 1024, (bf16*)(ws + WS_WO) + ((size_t)l * 1024 + 32 * nb) * D + 64 * kb, D, scr, lane); }
        }
        for (int i = bx * NTHR + tid; i < DEPTH * 1536 * 256; i += G * NTHR) {
            const int l = i / (1536 * 256), r = i % (1536 * 256), n = r >> 8, k = r & 255; float v = 0.f;
            if (n < 512) { if (k < 64) v = INP(I_RWWUP)[((size_t)l * 64 + k) * 512 + n]; }
            else if (n < 1024) { if (k >= 64 && k < 128) v = INP(I_RWAUP)[((size_t)l * 64 + (k - 64)) * 512 + (n - 512)]; }
            else { if (k >= 128) v = INP(I_RWGUP)[((size_t)l * 128 + (k - 128)) * 512 + (n - 1024)]; }
            ((bf16*)(ws + WS_WLORA))[i] = (bf16)f2bf(v);
        }
        __syncthreads();
        {
            f32x4 g[4], b[4];
#pragma unroll
            for (int j = 0; j < 4; ++j) { g[j] = *(const f32x4*)(INP(I_LNIN_G) + 256 * j + 4 * lane); b[j] = *(const f32x4*)(INP(I_LNIN_B) + 256 * j + 4 * lane); }
            for (int m = gw; m < M; m += NGW) {
                f32x4 v[4]; const float* xr = INP(I_X) + (size_t)m * D;
#pragma unroll
                for (int j = 0; j < 4; ++j) v[j] = *(const f32x4*)(xr + 256 * j + 4 * lane);
                ln16(v, g, b);
#pragma unroll
                for (int j = 0; j < 4; ++j) { st4bf(Xb + ((size_t)m * D + 256 * j + 4 * lane) * 2, v[j]); *(unsigned*)((char*)(ws + WS_XF8) + (size_t)m * D + 256 * j + 4 * lane) = pk4_f8(v[j].x * F8_SX, v[j].y * F8_SX, v[j].z * F8_SX, v[j].w * F8_SX); }
                gates8(v, wgt, GIF + (size_t)m * 8, lane);
            }
#pragma unroll
            for (int j = 0; j < 4; ++j) { g[j] = *(const f32x4*)(INP(I_MEMLN_G) + 256 * j + 4 * lane); b[j] = *(const f32x4*)(INP(I_MEMLN_B) + 256 * j + 4 * lane); }
            for (int m = gw; m < MROWS; m += NGW) {
                f32x4 v[4]; const float* xr = INP(I_MEM) + (size_t)m * D;
#pragma unroll
                for (int j = 0; j < 4; ++j) v[j] = *(const f32x4*)(xr + 256 * j + 4 * lane);
                ln16(v, g, b);
#pragma unroll
                for (int j = 0; j < 4; ++j) st4bf((char*)(ws + WS_MEMN) + ((size_t)m * D + 256 * j + 4 * lane) * 2, v[j]);
            }
        }
        __syncthreads();
    }
    SEAM(0);

#pragma unroll 1
    for (int l = 0; l < DEPTH; ++l) {
        const int pb = 1 + l * NP_LAYER;
        _Pragma("unroll 1") for (int rep_ = 0; rep_ < NREP(0); ++rep_) if (((PHMASK>>0)&1) && IN(pb + 0)) {
            SchedInproj S; S.T.init(M / 256, UC_GATE / 256); S.G = G; S.c = bx; S.X = Xb; S.W = (const char*)(ws + WS_WIN) + (size_t)l * NU * D * 2; S.U = Ub;
            S.kv = (l == 0); S.MEMN = (const char*)(ws + WS_MEMN); S.WKV = (const char*)(ws + WS_WKV); S.KV = (char*)(ws + WS_KV);
            pg8::EpiStore E;
            pg8::gemm_phase<false>(lds, D * 2, D * 2, D * 2, S, E, wave);
            SchedPlain S8; S8.T.init(M / 256, 12); S8.G = G; S8.c = bx; S8.A = (const char*)(ws + WS_XF8); S8.B = (const char*)(ws + WS_WING8) + (size_t)l * 3072 * D; S8.C = Ub + UC_GATE * 2;
            S8.lda = 512; S8.ldb = 512; S8.ldc = NU;
            pg8::EpiStoreS E8; E8.s = F8_INV1;
            pg8::gemm_phase<true>(lds, D, D, D, S8, E8, wave);
        }
        SEAM(pb + 0);
        _Pragma("unroll 1") for (int rep_ = 0; rep_ < NREP(1); ++rep_) if (((PHMASK>>1)&1) && IN(pb + 1)) { PHASE_TID
            const float* mu = INP(I_RWMU) + (size_t)l * 1792 + 1536;
            char* LIN = (char*)(ws + WS_R2 + R2_LORA_IN);
            for (int it = bx * NTHR + tid; it < M * 32; it += G * NTHR) {
                const int row = it >> 5, c = (it & 31) * 8;
                const u32x4 cw = *(const u32x4*)(Ub + ((size_t)row * NU + UC_RW + 1536 + c) * 2);
                u32x4 pw = (u32x4){0u, 0u, 0u, 0u};
                if ((row & (SEQ - 1)) != 0) pw = *(const u32x4*)(Ub + ((size_t)(row - 1) * NU + UC_RW + 1536 + c) * 2);
                const f32x4 m0 = *(const f32x4*)(mu + c), m1 = *(const f32x4*)(mu + c + 4);
                float x[8] = {bflo(cw.x), bfhi(cw.x), bflo(cw.y), bfhi(cw.y), bflo(cw.z), bfhi(cw.z), bflo(cw.w), bfhi(cw.w)};
                const float p[8] = {bflo(pw.x), bfhi(pw.x), bflo(pw.y), bfhi(pw.y), bflo(pw.z), bfhi(pw.z), bflo(pw.w), bfhi(pw.w)};
                const float mm[8] = {m0.x, m0.y, m0.z, m0.w, m1.x, m1.y, m1.z, m1.w};
#pragma unroll
                for (int i = 0; i < 8; ++i) { float xs = x[i] + (p[i] - x[i]) * mm[i];
                    if (c < 64) xs = 1.f - 2.f * __builtin_amdgcn_rcpf(1.f + __builtin_amdgcn_exp2f(2.8853900817779268f * xs));
                    else if (c >= 128) xs = sigmoidf_(xs);
                    x[i] = xs; }
                u32x4 o; o.x = pk2(x[0], x[1]); o.y = pk2(x[2], x[3]); o.z = pk2(x[4], x[5]); o.w = pk2(x[6], x[7]);
                *(u32x4*)(LIN + ((size_t)row * 256 + c) * 2) = o;
            }
        }
        SEAM(pb + 1);
        _Pragma("unroll 1") for (int rep_ = 0; rep_ < NREP(2); ++rep_) if (((PHMASK>>2)&1) && IN(pb + 2)) {
            SchedPlain S; S.T.init(M / 256, 6); S.G = G; S.c = bx; S.A = (const char*)(ws + WS_R2 + R2_LORA_IN); S.B = (const char*)(ws + WS_WLORA) + (size_t)l * 1536 * 256 * 2; S.C = (char*)(ws + WS_R2 + R2_LORA_OUT);
            S.lda = 256; S.ldb = 256; S.ldc = 1536;
            pg8::EpiStore E;
            pg8::gemm_phase<false>(lds, 512, 512, 512, S, E, wave);
        }
        SEAM(pb + 2);
        _Pragma("unroll 1") for (int rep_ = 0; rep_ < NREP(3); ++rep_) if (((PHMASK>>3)&1) && IN(pb + 3)) { PHASE_TID
            const char* LO = (const char*)(ws + WS_R2 + R2_LORA_OUT);
            char* HC = (char*)(ws + WS_R2 + R2_HCAT);
            const int tid_ph = tid;
#define SUB_TID unsigned zs_ = 0u; asm volatile("" : "+v"(zs_)); int tid = wave * 64 + (int)__builtin_amdgcn_mbcnt_hi(~0u, __builtin_amdgcn_mbcnt_lo(~0u, zs_)); const int lane = tid & 63; (void)lane;
#pragma unroll 1
            for (int job = bx; job < 256; job += G) {
                if (job < 128) { _Pragma("unroll 1") for (int sr_ = 0; sr_ < NSUB(0); ++sr_) if ((SUBMASK>>0)&1) {
                    SUB_TID
                    const int b = job >> 3, h = job & 7;
                    constexpr int TC = 32, PT = 144, P16 = 48, IMG = 25856;
                    LAS float* OPS = (LAS float*)lds;
                    LAS float* OUTB = OPS + TC * 384;
                    LAS float* BON = OUTB + TC * 64;
                    LAS unsigned char* IM0 = lds + 57600;
                    const int pt = tid >> 4, cs = tid & 15, pc = cs * 4, hc = h * 64 + pc;
                    const int r31 = lane & 31, h2 = lane >> 5;
                    f32x16 Sreg[2];
#pragma unroll
                    for (int i = 0; i < 16; ++i) { Sreg[0][i] = 0.f; Sreg[1][i] = 0.f; }
                    u32x2 pu[9];
                    auto LOADC = [&](int t0) {
                        const int t = t0 + pt; const size_t row = (size_t)b * SEQ + t; const char* up = Ub + (row * NU + UC_RW + hc) * 2;
                        pu[0] = *(const u32x2*)up; pu[1] = *(const u32x2*)(up + 1024); pu[2] = *(const u32x2*)(up + 2048);
                        if (t > 0) { const char* pp = up - (size_t)NU * 2; pu[3] = *(const u32x2*)pp; pu[4] = *(const u32x2*)(pp + 1024); pu[5] = *(const u32x2*)(pp + 2048); }
                        else { pu[3] = (u32x2){0u, 0u}; pu[4] = pu[3]; pu[5] = pu[3]; }
                        const char* lp = LO + (row * 1536 + hc) * 2; pu[6] = *(const u32x2*)lp; pu[7] = *(const u32x2*)(lp + 1024); pu[8] = *(const u32x2*)(lp + 2048);
                    };
#define UNP4(w) ((f32x4){bflo((w).x), bfhi((w).x), bflo((w).y), bfhi((w).y)})
#define DOT4(a, b) (((a).x * (b).x + (a).y * (b).y) + ((a).z * (b).z + (a).w * (b).w))
#define PACK8(x, s) __builtin_bit_cast(bf16x8, (u32x4){pk2((x)[8 * (s)], (x)[8 * (s) + 1]), pk2((x)[8 * (s) + 2], (x)[8 * (s) + 3]), pk2((x)[8 * (s) + 4], (x)[8 * (s) + 5]), pk2((x)[8 * (s) + 6], (x)[8 * (s) + 7])})
#define LD2x64(p) __builtin_bit_cast(bf16x8, (u32x4){(*(const LAS u32x2*)(p)).x, (*(const LAS u32x2*)(p)).y, (*(const LAS u32x2*)((p) + 16)).x, (*(const LAS u32x2*)((p) + 16)).y})
                    LOADC(0);
#pragma unroll 1
                    for (int t0 = 0; t0 < SEQ; t0 += TC) {
                        f32x4 gk;
                        {
                            int hcv = hc; asm volatile("" : "+v"(hcv));
                            const f32x4 mu_r = *(const f32x4*)(INP(I_RWMU) + (size_t)l * 1792 + hcv), mu_k = *(const f32x4*)(INP(I_RWMU) + (size_t)l * 1792 + 512 + hcv), mu_v = *(const f32x4*)(INP(I_RWMU) + (size_t)l * 1792 + 1024 + hcv);
                            const f32x4 w0 = *(const f32x4*)(INP(I_RWW0) + l * 512 + hcv), a0 = *(const f32x4*)(INP(I_RWA0) + l * 512 + hcv), kkw = *(const f32x4*)(INP(I_RWKK) + l * 512 + hcv);
                            const f32x4 kaw = *(const f32x4*)(INP(I_RWKA) + l * 512 + hcv), rkw = *(const f32x4*)(INP(I_RWRK) + l * 512 + hcv);
                            const f32x4 ur = UNP4(pu[0]), uk = UNP4(pu[1]), uv = UNP4(pu[2]), urp = UNP4(pu[3]), ukp = UNP4(pu[4]), uvp = UNP4(pu[5]), lw = UNP4(pu[6]), la = UNP4(pu[7]);
                            gk = UNP4(pu[8]);
                            const f32x4 xr = ur + (urp - ur) * mu_r, xk = uk + (ukp - uk) * mu_k, xv = uv + (uvp - uv) * mu_v;
                            f32x4 dec, av, kkv, kp; float ss = 0.f, bsum = 0.f;
#pragma unroll
                            for (int i = 0; i < 4; ++i) {
                                const float y = -(w0[i] + lw[i]);
                                const float sp = fmaxf(y, 0.f) + __logf(1.f + __expf(-fabsf(y)));
                                dec[i] = __expf(-__expf(-sp - 0.5f));
                                av[i] = sigmoidf_(a0[i] + la[i]);
                                kkv[i] = xk[i] * kkw[i]; ss += kkv[i] * kkv[i];
                                kp[i] = xk[i] * (1.f + (av[i] - 1.f) * kaw[i]);
                                bsum += xr[i] * kp[i] * rkw[i];
                            }
                            ss = red16(ss); bsum = red16(bsum);
                            const float inv = __builtin_amdgcn_rsqf(fmaxf(ss, 1e-24f));
                            const f32x4 kk = kkv * inv, kka = kk * av;
                            LAS float* o = OPS + pt * 384 + pc;
                            *(LAS f32x4*)(o) = dec; *(LAS f32x4*)(o + 64) = kk; *(LAS f32x4*)(o + 128) = kka; *(LAS f32x4*)(o + 192) = kp; *(LAS f32x4*)(o + 256) = xr; *(LAS f32x4*)(o + 320) = xv;
                            if (cs == 0) BON[pt] = bsum;
                        }
                        if (t0 + TC < SEQ) LOADC(t0 + TC);
                        __syncthreads();
                        {
                            const int sc = wave >> 2, wq = wave & 3;
                            LAS unsigned char* im = IM0 + sc * IMG;
                            LAS unsigned char* KR = im; LAS unsigned char* BGr = im + 4608; LAS unsigned char* VT = im + 15360;
                            LAS unsigned char* TT = im + 18432; LAS unsigned char* BB = im + 19968; LAS float* ZF = (LAS float*)(im + 21504); LAS float* PL = (LAS float*)(im + 25600);
                            {
                                float P = 1.f;
#pragma unroll 1
                                for (int t = 0; t < 4 * wq; ++t) P *= OPS[(16 * sc + t) * 384 + lane];
#pragma unroll
                                for (int q = 0; q < 4; ++q) { const int t = 4 * wq + q; const LAS float* o = OPS + (16 * sc + t) * 384 + lane;
                                    const float w = o[0], z = o[64], bb = o[128], kp = o[192], rr = o[256], vv = o[320];
                                    const float kap = z * P; P *= w; const float rho = rr * P, ip = __builtin_amdgcn_rcpf(P), bet = bb * ip, gam = kp * ip;
                                    *(LAS bf16*)(KR + t * PT + lane * 2) = (bf16)f2bf(kap); *(LAS bf16*)(KR + (16 + t) * PT + lane * 2) = (bf16)f2bf(rho);
                                    *(LAS bf16*)(BGr + t * PT + lane * 2) = (bf16)f2bf(bet); *(LAS bf16*)(BGr + (16 + t) * PT + lane * 2) = (bf16)f2bf(gam);
                                    *(LAS bf16*)(VT + t * PT + lane * 2) = (bf16)f2bf(vv); }
                                if (wq == 3) PL[lane] = P;
                            }
                            __syncthreads();
                            if (wq == 0) {
                                f32x16 Z;
#pragma unroll
                                for (int i = 0; i < 16; ++i) Z[i] = 0.f;
#pragma unroll
                                for (int ks = 0; ks < 4; ++ks) Z = __builtin_amdgcn_mfma_f32_32x32x16_bf16(*(const LAS bf16x8*)(KR + r31 * PT + (16 * ks + 8 * h2) * 2), *(const LAS bf16x8*)(BGr + r31 * PT + (16 * ks + 8 * h2) * 2), Z, 0, 0, 0);
                                const int cp = (r31 < 16) ? (4 * (r31 & 3) + (r31 >> 2)) : r31;
#pragma unroll
                                for (int i = 0; i < 16; ++i) ZF[((i & 3) + 8 * (i >> 2) + 4 * h2) * 32 + cp] = Z[i];
                            }
                            __syncthreads();
                            if (wq == 0) {
                                const int c = lane >> 2, jq = lane & 3; float tq[4] = {0.f, 0.f, 0.f, 0.f};
                                f32x4 an = *(const LAS f32x4*)(ZF + 1 * 32 + 4 * jq);
#pragma unroll
                                for (int t = 0; t < 16; ++t) {
                                    const f32x4 ar = an; if (t >= 1 && t < 15) an = *(const LAS f32x4*)(ZF + (t + 1) * 32 + 4 * jq);
                                    float s = 0.f;
#pragma unroll
                                    for (int m = 0; m < 4; ++m) if (4 * m < t) s += ((4 * m + jq < t) ? ar[m] : 0.f) * tq[m];
                                    s = red4(s);
                                    const float val = ((t == c) ? 1.f : 0.f) - s;
                                    tq[t >> 2] = (jq == (t & 3)) ? val : tq[t >> 2];
                                }
#pragma unroll
                                for (int m = 0; m < 4; ++m) *(LAS bf16*)(TT + (4 * m + jq) * P16 + c * 2) = (bf16)f2bf(-tq[m]);
                                an = *(const LAS f32x4*)(ZF + 16 * 32 + 4 * jq);
#pragma unroll
                                for (int t = 0; t < 16; ++t) {
                                    const f32x4 ar = an; if (t < 15) an = *(const LAS f32x4*)(ZF + (17 + t) * 32 + 4 * jq);
                                    float s = 0.f;
#pragma unroll
                                    for (int m = 0; m < 4; ++m) if (4 * m <= t) s += ((4 * m + jq <= t) ? ar[m] : 0.f) * tq[m];
                                    s = red4(s);
                                    if (jq == 0) *(LAS bf16*)(TT + (16 + t) * P16 + c * 2) = (bf16)f2bf(-s);
                                }
                            } else if (wq == 1) {
                                const int row = lane >> 1, c0 = 8 * (lane & 1), tt = row & 15; const bool rho_row = row >= 16; float bv[8];
#pragma unroll
                                for (int j = 0; j < 8; ++j) { const int jj = c0 + j; const float zv = ZF[row * 32 + 16 + jj]; bv[j] = (rho_row ? (jj <= tt) : (jj < tt)) ? zv : 0.f; }
                                *(LAS u32x4*)(BB + row * P16 + c0 * 2) = (u32x4){pk2(bv[0], bv[1]), pk2(bv[2], bv[3]), pk2(bv[4], bv[5]), pk2(bv[6], bv[7])};
                            }
                        }
                        __syncthreads();
                        if (wave < 2) {
#pragma unroll 1
                            for (int sc = 0; sc < 2; ++sc) {
                                const LAS unsigned char* im = IM0 + sc * IMG;
                                const LAS unsigned char* KR = im; const LAS unsigned char* BT = im + 9216; const LAS unsigned char* GT = im + 12288; const LAS unsigned char* VT = im + 15360;
                                const LAS unsigned char* TT = im + 18432; const LAS unsigned char* BB = im + 19968; const LAS float* PL = (const LAS float*)(im + 25600);
                                const LAS unsigned char* BGr = im + 4608;
                                const bf16x8 vfr = trd8(VT, PT, 8 * h2, 8 * h2 + 4, 32 * wave, lane);
                                f32x16 t1;
#pragma unroll
                                for (int i = 0; i < 16; ++i) t1[i] = 0.f;
                                t1 = __builtin_amdgcn_mfma_f32_32x32x16_bf16(*(const LAS bf16x8*)(BB + r31 * P16 + 8 * h2 * 2), vfr, t1, 0, 0, 0);
#pragma unroll
                                for (int kb = 0; kb < 2; ++kb)
#pragma unroll
                                    for (int s = 0; s < 2; ++s) t1 = __builtin_amdgcn_mfma_f32_32x32x16_bf16(LD2x64(KR + r31 * PT + (32 * kb + 16 * s + 4 * h2) * 2), PACK8(Sreg[kb], s), t1, 0, 0, 0);
                                f32x16 t2;
#pragma unroll
                                for (int i = 0; i < 16; ++i) t2[i] = 0.f;
                                t2 = __builtin_amdgcn_mfma_f32_32x32x16_bf16(LD2x64(TT + r31 * P16 + (4 * h2) * 2), PACK8(t1, 0), t2, 0, 0, 0);
#pragma unroll
                                for (int i = 8; i < 16; ++i) OUTB[(16 * sc + (i & 3) + 8 * ((i >> 2) - 2) + 4 * h2) * 64 + 32 * wave + r31] = t2[i] + t1[i];
                                const bf16x8 uq = PACK8(t2, 0);
#pragma unroll
                                for (int kb = 0; kb < 2; ++kb) {
                                    f32x16 a = Sreg[kb];
                                    a = __builtin_amdgcn_mfma_f32_32x32x16_bf16(trd8(BGr, PT, 4 * h2, 8 + 4 * h2, 32 * kb, lane), uq, a, 0, 0, 0);
                                    a = __builtin_amdgcn_mfma_f32_32x32x16_bf16(trd8(BGr, PT, 16 + 8 * h2, 20 + 8 * h2, 32 * kb, lane), vfr, a, 0, 0, 0);
#pragma unroll
                                    for (int g4 = 0; g4 < 4; ++g4) { const f32x4 p4 = *(const LAS f32x4*)(PL + 32 * kb + 8 * g4 + 4 * h2);
                                        a[4 * g4] *= p4.x; a[4 * g4 + 1] *= p4.y; a[4 * g4 + 2] *= p4.z; a[4 * g4 + 3] *= p4.w; }
                                    Sreg[kb] = a;
                                }
                            }
                        }
                        __syncthreads();
                        {
                            int hcw = hc; asm volatile("" : "+v"(hcw));
                            const f32x4 lng = *(const f32x4*)(INP(I_RWLNG) + l * 512 + hcw), lnb = *(const f32x4*)(INP(I_RWLNB) + l * 512 + hcw);
                            const f32x4 o4 = *(const LAS f32x4*)(OUTB + pt * 64 + pc), v4 = *(const LAS f32x4*)(OPS + pt * 384 + 320 + pc);
                            const float mean = red16((o4.x + o4.y) + (o4.z + o4.w)) * (1.f / 64.f);
                            const f32x4 dv = o4 - mean;
                            const float var = red16(DOT4(dv, dv)) * (1.f / 64.f);
                            const float rstd = __builtin_amdgcn_rsqf(var + RW_GN_EPS), bo = BON[pt];
                            const f32x4 y = (dv * rstd * lng + lnb + v4 * bo) * gk;
                            st4bf(HC + (((size_t)b * SEQ + t0 + pt) * 1536 + 512 + hc) * 2, y);
                        }
                        __syncthreads();
                    }
#undef PACK8
#undef LD2x64
                } } else {
                    const int idx = job - 128, bh = idx >> 1, half = idx & 1, b = bh >> 2, h = bh & 3;
                    unsigned zl_ = 0u; asm volatile("" : "+v"(zl_)); const int lane_ml = (int)__builtin_amdgcn_mbcnt_hi(~0u, __builtin_amdgcn_mbcnt_lo(~0u, zl_));
                    _Pragma("unroll 1") for (int sr_ = 0; sr_ < NSUB(1); ++sr_) if (((SUBMASK>>1)&1) && idx < 64) {
                        SUB_TID
                        const int bm = idx >> 2, hm = idx & 3;
                        constexpr int PT = 144;
                        LAS unsigned char* QI = lds;
                        LAS unsigned char* KI = QI + 64 * PT;
                        constexpr int PV = 272;
                        LAS unsigned char* KW = KI + 64 * PT;
                        LAS unsigned char* VT = KW + 64 * PT;
                        LAS unsigned char* CI = VT + 64 * PV;
                        LAS float* AS = (LAS float*)(CI + 128 * PT);
                        LAS float* MX = AS + 64; LAS float* SI = AS + 128; LAS float* EM = AS + 192; LAS float* WG = AS + 256; LAS float* NN = AS + 320; LAS float* CR = AS + 384; LAS float* ST = AS + 448;
                        for (int i = tid; i < 128 * PT / 4; i += NTHR) ((LAS unsigned*)CI)[i] = 0u;
                        if (tid < 64) NN[tid] = 0.f;
                        const int pt = tid >> 4, cg = tid & 15;
                        const int ccol = (cg < 8) ? (hm * 64 + 8 * cg) : (256 + hm * 64 + 8 * (cg - 8));
                        const float qsc = (cg < 8) ? 0.125f : 1.f;
                        const float igb = INP(I_IGB)[l * 4 + hm], fgb = INP(I_FGB)[l * 4 + hm];
                        const int r31 = lane & 31, h2 = lane >> 5, vb = wave >> 1, tb = wave & 1;
                        f32x16 accC;
#pragma unroll
                        for (int i = 0; i < 16; ++i) accC[i] = 0.f;
                        float nreg = 0.f, mprev = 0.f;
                        u32x4 cu[2][4], vu[2]; float gi = 0.f, gf = 0.f;
                        auto LOADM = [&](int t0) {
#pragma unroll
                            for (int tt = 0; tt < 2; ++tt) { const int t = t0 + pt + 32 * tt; const size_t row = (size_t)bm * SEQ + t;
#pragma unroll
                                for (int j = 0; j < 4; ++j) { if (t - 3 + j >= 0) cu[tt][j] = *(const u32x4*)(Ub + ((row - 3 + j) * NU + UC_QK + ccol) * 2); else cu[tt][j] = (u32x4){0u, 0u, 0u, 0u}; }
                                const int p = tid + 512 * tt; vu[tt] = *(const u32x4*)(Ub + (((size_t)bm * SEQ + t0 + (p >> 4)) * NU + UC_V + hm * 128 + 8 * (p & 15)) * 2); }
                            if (wave == 0) { const size_t rg = (size_t)bm * SEQ + t0 + lane; gi = GIF[rg * 8 + hm]; gf = GIF[rg * 8 + 4 + hm]; }
                        };
                        LOADM(0);
                        __syncthreads();
#pragma unroll 1
                        for (int t0 = 0; t0 < SEQ; t0 += 64) {
                            int ccv = ccol; asm volatile("" : "+v"(ccv));
                            float cw[4][8], cb[8];
#pragma unroll
                        for (int j = 0; j < 4; ++j) { const f32x4 a = *(const f32x4*)(INP(I_CONVW) + ((size_t)l * 4 + j) * 512 + ccv), c2 = *(const f32x4*)(INP(I_CONVW) + ((size_t)l * 4 + j) * 512 + ccv + 4);
                            cw[j][0] = a.x; cw[j][1] = a.y; cw[j][2] = a.z; cw[j][3] = a.w; cw[j][4] = c2.x; cw[j][5] = c2.y; cw[j][6] = c2.z; cw[j][7] = c2.w; }
                        { const f32x4 a = *(const f32x4*)(INP(I_CONVB) + l * 512 + ccv), c2 = *(const f32x4*)(INP(I_CONVB) + l * 512 + ccv + 4);
                            cb[0] = a.x; cb[1] = a.y; cb[2] = a.z; cb[3] = a.w; cb[4] = c2.x; cb[5] = c2.y; cb[6] = c2.z; cb[7] = c2.w; }
                            float yq[2][8];
#pragma unroll
                            for (int tt = 0; tt < 2; ++tt) {
#pragma unroll
                                for (int i = 0; i < 8; ++i) yq[tt][i] = cb[i];
#pragma unroll
                                for (int j = 0; j < 4; ++j) { const u32x4 w = cu[tt][j]; const float x[8] = {bflo(w.x), bfhi(w.x), bflo(w.y), bfhi(w.y), bflo(w.z), bfhi(w.z), bflo(w.w), bfhi(w.w)};
#pragma unroll
                                    for (int i = 0; i < 8; ++i) yq[tt][i] += cw[j][i] * x[i]; }
#pragma unroll
                                for (int i = 0; i < 8; ++i) yq[tt][i] = yq[tt][i] * sigmoidf_(yq[tt][i]) * qsc;
                            }
                            const u32x4 vreg0 = vu[0], vreg1 = vu[1];
                            if (wave == 0) {
                                const float ig = gi + igb, fp = gf + fgb;
                                const float lf = -(fmaxf(-fp, 0.f) + __logf(1.f + __expf(-fabsf(fp))));
                                const float bc = scan_add64(lf);
                                const float as = ig - bc, pm = scan_max64(as);
                                const float mxv = fmaxf(mprev, pm), mx63 = __builtin_bit_cast(float, __builtin_amdgcn_readlane(__builtin_bit_cast(int, mxv), 63)), bl = __builtin_bit_cast(float, __builtin_amdgcn_readlane(__builtin_bit_cast(int, bc), 63));
                                AS[lane] = as; MX[lane] = mxv; SI[lane] = __expf(mprev - mxv); EM[lane] = __expf(-(bc + mxv)); WG[lane] = __expf(as - mx63);
                                if (lane == 0) CR[0] = __expf(mprev - mx63);
                                mprev = bl + mx63;
                            }
                            if (t0 + 64 < SEQ) LOADM(t0 + 64);
                            __syncthreads();
#pragma unroll
                            for (int tt = 0; tt < 2; ++tt) { const int tok = pt + 32 * tt;
                                u32x4 pw; pw.x = pk2(yq[tt][0], yq[tt][1]); pw.y = pk2(yq[tt][2], yq[tt][3]); pw.z = pk2(yq[tt][4], yq[tt][5]); pw.w = pk2(yq[tt][6], yq[tt][7]);
                                if (cg < 8) *(LAS u32x4*)(QI + tok * PT + cg * 16) = pw;
                                else { *(LAS u32x4*)(KI + tok * PT + (cg - 8) * 16) = pw; const float wgs = WG[tok];
                                    u32x4 kw; kw.x = pk2(yq[tt][0] * wgs, yq[tt][1] * wgs); kw.y = pk2(yq[tt][2] * wgs, yq[tt][3] * wgs); kw.z = pk2(yq[tt][4] * wgs, yq[tt][5] * wgs); kw.w = pk2(yq[tt][6] * wgs, yq[tt][7] * wgs);
                                    *(LAS u32x4*)(KW + tok * PT + (cg - 8) * 16) = kw; }
                                const u32x4 vw = tt ? vreg1 : vreg0; const int p = tid + 512 * tt, vtok = p >> 4, v8 = p & 15;
                                *(LAS u32x4*)(VT + vtok * PV + v8 * 16) = vw;
                            }
                            __syncthreads();
                            float hv[16];
                            {
                                constexpr float L2E = 1.4426950408889634f;
                                const int t = 32 * tb + r31;
                                bf16x8 qf[4];
#pragma unroll
                                for (int ks = 0; ks < 4; ++ks) qf[ks] = *(const LAS bf16x8*)(QI + t * PT + (16 * ks + 8 * h2) * 2);
                                const float mx = MX[t], si = SI[t], em = EM[t];
                                f32x16 O, I; float denI = 0.f;
#pragma unroll
                                for (int i = 0; i < 16; ++i) { O[i] = 0.f; I[i] = 0.f; }
#pragma unroll
                                for (int sb = 0; sb < 2; ++sb) if (sb <= tb) {
                                    f32x16 X;
#pragma unroll
                                    for (int i = 0; i < 16; ++i) X[i] = 0.f;
#pragma unroll
                                    for (int ks = 0; ks < 4; ++ks) { const bf16x8 kf = *(const LAS bf16x8*)(KI + (32 * sb + r31) * PT + (16 * ks + 8 * h2) * 2); X = __builtin_amdgcn_mfma_f32_32x32x16_bf16(kf, qf[ks], X, 0, 0, 0); }
#pragma unroll
                                    for (int g4 = 0; g4 < 4; ++g4) { const f32x4 a4 = *(const LAS f32x4*)(AS + 32 * sb + 8 * g4 + 4 * h2);
#pragma unroll
                                        for (int j = 0; j < 4; ++j) { const int s = 32 * sb + 8 * g4 + 4 * h2 + j; const float w = (s <= t) ? __builtin_amdgcn_exp2f((a4[j] - mx) * L2E) * X[4 * g4 + j] : 0.f; X[4 * g4 + j] = w; denI += w; } }
#pragma unroll
                                    for (int st = 0; st < 2; ++st) {
                                        u32x4 pw; pw.x = pk2(X[8 * st], X[8 * st + 1]); pw.y = pk2(X[8 * st + 2], X[8 * st + 3]); pw.z = pk2(X[8 * st + 4], X[8 * st + 5]); pw.w = pk2(X[8 * st + 6], X[8 * st + 7]);
                                        O = __builtin_amdgcn_mfma_f32_32x32x16_bf16(trd8(VT, PV, 32 * sb + 16 * st + 4 * h2, 32 * sb + 16 * st + 8 + 4 * h2, 32 * vb, lane), __builtin_bit_cast(bf16x8, pw), O, 0, 0, 0);
                                    }
                                }
                                float nq = 0.f;
#pragma unroll
                                for (int ks = 0; ks < 4; ++ks) { const bf16x8 cf = *(const LAS bf16x8*)(CI + (32 * vb + r31) * PT + (16 * ks + 8 * h2) * 2); I = __builtin_amdgcn_mfma_f32_32x32x16_bf16(cf, qf[ks], I, 0, 0, 0);
                                    const f32x4 n0 = *(const LAS f32x4*)(NN + 16 * ks + 8 * h2), n1 = *(const LAS f32x4*)(NN + 16 * ks + 8 * h2 + 4); const u32x4 qw = __builtin_bit_cast(u32x4, qf[ks]);
                                    nq += (bflo(qw.x) * n0.x + bfhi(qw.x) * n0.y) + (bflo(qw.y) * n0.z + bfhi(qw.y) * n0.w) + (bflo(qw.z) * n1.x + bfhi(qw.z) * n1.y) + (bflo(qw.w) * n1.z + bfhi(qw.w) * n1.w); }
                                nq += __shfl_xor(nq, 32); denI += __shfl_xor(denI, 32);
                                const float den = si * nq + denI, rdn = 1.f / fmaxf(fabsf(den), em);
                                float hsum = 0.f;
#pragma unroll
                                for (int i = 0; i < 16; ++i) { hv[i] = (O[i] + si * I[i]) * rdn; hsum += hv[i]; }
                                hsum += __shfl_xor(hsum, 32);
                                const float hmean = hsum * (1.f / 32.f); float hm2 = 0.f;
#pragma unroll
                                for (int i = 0; i < 16; ++i) { const float dlt = hv[i] - hmean; hm2 += dlt * dlt; }
                                hm2 += __shfl_xor(hm2, 32);
                                if (h2 == 0) *(LAS f32x2*)(ST + ((tb * 4 + vb) * 32 + r31) * 2) = (f32x2){hmean, hm2};
                                const float carry = CR[0];
#pragma unroll
                                for (int i = 0; i < 16; ++i) accC[i] *= carry;
#pragma unroll
                                for (int st = 0; st < 4; ++st) { const bf16x8 va = trd8(VT, PV, 16 * st + 8 * h2, 16 * st + 8 * h2 + 4, 32 * vb, lane), kw = trd8(KW, PT, 16 * st + 8 * h2, 16 * st + 8 * h2 + 4, 32 * tb, lane);
                                    accC = __builtin_amdgcn_mfma_f32_32x32x16_bf16(va, kw, accC, 0, 0, 0); }
                            }
                            __syncthreads();
                            {
                                const int t = 32 * tb + r31;
                                f32x2 s4[4];
#pragma unroll
                                for (int q = 0; q < 4; ++q) s4[q] = *(const LAS f32x2*)(ST + ((tb * 4 + q) * 32 + r31) * 2);
                                const float mt = (s4[0].x + s4[1].x + s4[2].x + s4[3].x) * 0.25f;
                                float m2 = 0.f;
#pragma unroll
                                for (int q = 0; q < 4; ++q) { const float dm = s4[q].x - mt; m2 += s4[q].y + 32.f * dm * dm; }
                                const float rstd = __builtin_amdgcn_rsqf(m2 * (1.f / 128.f) + LN_EPS);
                                const size_t row = (size_t)bm * SEQ + t0 + t;
                                const char* ogp = Ub + (row * NU + UC_OG + hm * 128 + 32 * vb) * 2; char* op = HC + (row * 1536 + hm * 128 + 32 * vb) * 2;
                                const float* ngp = INP(I_MLNORMG) + l * 512 + hm * 128 + 32 * vb;
#pragma unroll
                                for (int g4 = 0; g4 < 4; ++g4) { const int vo = 8 * g4 + 4 * h2; const f32x4 og = ld4bf(ogp + vo * 2), ng = *(const f32x4*)(ngp + vo);
                                    f32x4 y; y.x = sigmoidf_(og.x) * ((hv[4 * g4] - mt) * rstd * ng.x); y.y = sigmoidf_(og.y) * ((hv[4 * g4 + 1] - mt) * rstd * ng.y); y.z = sigmoidf_(og.z) * ((hv[4 * g4 + 2] - mt) * rstd * ng.z); y.w = sigmoidf_(og.w) * ((hv[4 * g4 + 3] - mt) * rstd * ng.w);
                                    st4bf(op + vo * 2, y); }
                            }
#pragma unroll
                            for (int i = 0; i < 16; ++i) { const int v = 32 * vb + (i & 3) + 8 * (i >> 2) + 4 * h2; *(LAS bf16*)(CI + v * PT + (32 * tb + r31) * 2) = (bf16)f2bf(accC[i]); }
                            if (wave < 2) { float s = 0.f;
#pragma unroll
                                for (int q8 = 0; q8 < 8; ++q8) { const u32x2 w = trd4(KW, PT, 32 * h2 + 4 * q8, 32 * wave, lane); s += (bflo(w.x) + bfhi(w.x)) + (bflo(w.y) + bfhi(w.y)); }
                                s += __shfl_xor(s, 32);
                                nreg = CR[0] * nreg + s; if (h2 == 0) NN[32 * wave + r31] = nreg; }
                            __syncthreads();
                        }
                    }
                    _Pragma("unroll 1") for (int sr_ = 0; sr_ < NSUB(2); ++sr_) if ((SUBMASK>>2)&1) {
                        SUB_TID
                        constexpr int KST = 272, VST = 520;
                        LAS unsigned char* KI = lds; LAS unsigned char* VI = lds + 256 * KST;
                        const char* kvb = (const char*)(ws + WS_KV) + (((size_t)l * MROWS + (size_t)b * MEML) * D) * 2;
                        for (int p = tid; p < 4096; p += NTHR) { const int key = p >> 4, c16 = p & 15;
                            *(LAS u32x4*)(KI + key * KST + c16 * 16) = *(const u32x4*)(kvb + ((size_t)key * D + h * 128 + c16 * 8) * 2); }
                        for (int p = tid; p < 4096; p += NTHR) { const int key = p & 255, d8 = p >> 8;
                            const u32x4 w = *(const u32x4*)(kvb + ((size_t)key * D + 512 + h * 128 + d8 * 8) * 2);
                            LAS unsigned char* o = VI + (d8 * 8) * VST + key * 2;
                            *(LAS bf16*)(o) = (bf16)(w.x & 0xffff); *(LAS bf16*)(o + VST) = (bf16)(w.x >> 16); *(LAS bf16*)(o + 2 * VST) = (bf16)(w.y & 0xffff); *(LAS bf16*)(o + 3 * VST) = (bf16)(w.y >> 16);
                            *(LAS bf16*)(o + 4 * VST) = (bf16)(w.z & 0xffff); *(LAS bf16*)(o + 5 * VST) = (bf16)(w.z >> 16); *(LAS bf16*)(o + 6 * VST) = (bf16)(w.w & 0xffff); *(LAS bf16*)(o + 7 * VST) = (bf16)(w.w >> 16); }
                        __syncthreads();
                        const int r31 = lane & 31, h2 = lane >> 5;
                        constexpr float SC = 0.08838834764831845f * 1.4426950408889634f;
#pragma unroll 1
                        for (int rd = 0; rd < 8; ++rd) {
                            const size_t qrow = (size_t)b * SEQ + half * 2048 + rd * 256 + wave * 32 + r31;
                            bf16x8 qf[8];
#pragma unroll
                            for (int ks = 0; ks < 8; ++ks) qf[ks] = *(const bf16x8*)(Ub + (qrow * NU + UC_CAQ + h * 128 + 16 * ks + 8 * h2) * 2);
                            f32x16 O[4];
#pragma unroll
                            for (int db = 0; db < 4; ++db)
#pragma unroll
                                for (int i = 0; i < 16; ++i) O[db][i] = 0.f;
                            float mrun = -1e30f, lrun = 0.f;
#pragma unroll 1
                            for (int hf = 0; hf < 2; ++hf) {
                                f32x16 X[4];
#pragma unroll
                                for (int kb = 0; kb < 4; ++kb) {
                                    bf16x8 kf[8];
#pragma unroll
                                    for (int ks = 0; ks < 8; ++ks) kf[ks] = *(const LAS bf16x8*)(KI + (hf * 128 + kb * 32 + r31) * KST + (16 * ks + 8 * h2) * 2);
                                    __builtin_amdgcn_sched_barrier(0);
#pragma unroll
                                    for (int i = 0; i < 16; ++i) X[kb][i] = 0.f;
#pragma unroll
                                    for (int ks = 0; ks < 8; ++ks) X[kb] = __builtin_amdgcn_mfma_f32_32x32x16_bf16(kf[ks], qf[ks], X[kb], 0, 0, 0);
                                    __builtin_amdgcn_sched_barrier(0);
                                }
                                float mx = -1e30f;
#pragma unroll
                                for (int kb = 0; kb < 4; ++kb)
#pragma unroll
                                    for (int i = 0; i < 16; ++i) mx = fmaxf(mx, X[kb][i]);
                                mx = fmaxf(mx, __shfl_xor(mx, 32));
                                const float mnew = fmaxf(mrun, mx), alpha = __builtin_amdgcn_exp2f((mrun - mnew) * SC);
                                float ls = 0.f;
#pragma unroll
                                for (int kb = 0; kb < 4; ++kb)
#pragma unroll
                                    for (int i = 0; i < 16; ++i) { const float p = __builtin_amdgcn_exp2f((X[kb][i] - mnew) * SC); X[kb][i] = p; ls += p; }
                                ls += __shfl_xor(ls, 32);
                                lrun = lrun * alpha + ls; mrun = mnew;
#pragma unroll
                                for (int db = 0; db < 4; ++db)
#pragma unroll
                                    for (int i = 0; i < 16; ++i) O[db][i] *= alpha;
#pragma unroll
                                for (int kb = 0; kb < 4; ++kb) {
                                    bf16x8 vf[2][4], pf[2];
#pragma unroll
                                    for (int s = 0; s < 2; ++s) {
                                        u32x4 pw; pw.x = pk2(X[kb][8 * s], X[kb][8 * s + 1]); pw.y = pk2(X[kb][8 * s + 2], X[kb][8 * s + 3]); pw.z = pk2(X[kb][8 * s + 4], X[kb][8 * s + 5]); pw.w = pk2(X[kb][8 * s + 6], X[kb][8 * s + 7]);
                                        pf[s] = __builtin_bit_cast(bf16x8, pw);
#pragma unroll
                                        for (int db = 0; db < 4; ++db) {
                                            const LAS unsigned char* vp = VI + (db * 32 + r31) * VST + (hf * 128 + kb * 32 + 16 * s + 4 * h2) * 2;
                                            const u32x2 lo = *(const LAS u32x2*)vp, hi = *(const LAS u32x2*)(vp + 16);
                                            vf[s][db] = __builtin_bit_cast(bf16x8, (u32x4){lo.x, lo.y, hi.x, hi.y});
                                        }
                                    }
                                    __builtin_amdgcn_sched_barrier(0);
#pragma unroll
                                    for (int s = 0; s < 2; ++s)
#pragma unroll
                                        for (int db = 0; db < 4; ++db) O[db] = __builtin_amdgcn_mfma_f32_32x32x16_bf16(vf[s][db], pf[s], O[db], 0, 0, 0);
                                    __builtin_amdgcn_sched_barrier(0);
                                }
                            }
                            const float rl = 1.f / lrun;
                            char* op = HC + (qrow * 1536 + 1024 + h * 128) * 2;
#pragma unroll
                            for (int db = 0; db < 4; ++db)
#pragma unroll
                                for (int g4 = 0; g4 < 4; ++g4) { u32x2 w; w.x = pk2(O[db][4 * g4] * rl, O[db][4 * g4 + 1] * rl); w.y = pk2(O[db][4 * g4 + 2] * rl, O[db][4 * g4 + 3] * rl);
                                    *(u32x2*)(op + (db * 32 + 8 * g4 + 4 * h2) * 2) = w; }
                        }
                        __syncthreads();
                    }
                    if (rep_ == 0) {
                        LAS float* scr = (LAS float*)(lds + wave * 8448);
                        constexpr int IT_GU = 32 * 16 * 64;
                        const int nper = (idx < 64) ? 4 : 92, ibase = (idx < 64) ? 0 : 2048, wk = (idx & 63) * NWAVES + wave;
                        for (int kq = 0; kq < nper; ++kq) { const int it = ibase + wk + kq * 512;
                            if (it < IT_GU) { const int e = it >> 10, q = it & 1023, kb = q >> 6, nb = q & 63;
                                transpose_item_f8(INP(I_WGU) + (((size_t)l * 32 + e) * D + 64 * kb) * 2048 + 32 * nb, 2048, (unsigned char*)(ws + WS_WGU) + ((size_t)e * 2048 + 32 * nb) * D + 64 * kb, D, F8_SWGU, scr, lane_ml); }
                            else { const int r2 = it - IT_GU, e = r2 >> 9, q = r2 & 511, kb = q >> 5, nb = q & 31;
                                transpose_item_f8(INP(I_WDN) + (((size_t)l * 32 + e) * D + 64 * kb) * 1024 + 32 * nb, 1024, (unsigned char*)(ws + WS_WDN) + ((size_t)e * 1024 + 32 * nb) * D + 64 * kb, D, F8_SWDN, scr, lane_ml); }
                        }
                        __syncthreads();
                    }
                }
            }
#undef UNP4
#undef DOT4
#undef SUB_TID
        }
        SEAM(pb + 3);
        _Pragma("unroll 1") for (int rep_ = 0; rep_ < NREP(5); ++rep_) if (((PHMASK>>5)&1) && IN(pb + 5)) {
            SchedPlain S; S.T.init(M / 256, 4); S.G = G; S.c = bx; S.A = (const char*)(ws + WS_R2 + R2_HCAT); S.B = (const char*)(ws + WS_WBR) + (size_t)l * 1024 * 1536 * 2; S.C = (char*)(ws + WS_R2 + R2_YPRE);
            S.lda = 1536; S.ldb = 1536; S.ldc = D;
            pg8::EpiMerge E; E.U = Ub; E.gate_b = INP(I_GATEB) + (size_t)l * 3072;
            pg8::gemm_phase<false, true>(lds, 1536 * 2, 1536 * 2, 1536 * 2, S, E, wave);
        }
        SEAM(pb + 5);
        _Pragma("unroll 1") for (int rep_ = 0; rep_ < NREP(6); ++rep_) if (((PHMASK>>6)&1) && IN(pb + 6)) {
            SchedPlain S; S.T.init(M / 256, 4); S.G = G; S.c = bx; S.A = (const char*)(ws + WS_R2 + R2_YPRE); S.B = (const char*)(ws + WS_WO) + (size_t)l * D * D * 2; S.C = (char*)(ws + WS_R2 + R2_Z);
            S.lda = D; S.ldb = D; S.ldc = D;
            pg8::EpiStore E;
            pg8::gemm_phase<false>(lds, D * 2, D * 2, D * 2, S, E, wave);
        }
        SEAM(pb + 6);
        _Pragma("unroll 1") for (int rep_ = 0; rep_ < NREP(7); ++rep_) if (((PHMASK>>7)&1) && IN(pb + 7)) { PHASE_TID
            constexpr int WP = 2064;
            LAS unsigned char* WRb = lds;
            LAS float* RB = (LAS float*)(lds + 66048);
            LAS unsigned char* XS = lds + 66560 + wave * 4608;
            for (int i = tid; i < 32768; i += NTHR) { const int k = i >> 5, e = i & 31; *(LAS bf16*)(WRb + e * WP + k * 2) = (bf16)f2bf(INP(I_RTW)[((size_t)l * D + k) * 32 + e]); }
            if (tid < 32) RB[tid] = INP(I_RTB)[l * 32 + tid];
            const char* Zb = (const char*)(ws + WS_R2 + R2_Z);
            int* TKE = (int*)(ws + WS_TKE); float* TKG = (float*)(ws + WS_TKG); int* TKP = (int*)(ws + WS_TKP); int* ROWTOK = (int*)(ws + WS_ROWTOK);
            LAS unsigned* LCNT = (LAS unsigned*)(lds + 131072);
            LAS unsigned* GBASE = LCNT + 32; LAS unsigned* LLEN = LCNT + 64; LAS unsigned* LIST = LCNT + 128;
            if (tid < 65) LCNT[tid] = 0u;
            {
                f32x4 g[4], bb[4];
#pragma unroll
                for (int j = 0; j < 4; ++j) { g[j] = *(const f32x4*)(INP(I_LN1G) + l * D + 256 * j + 4 * lane); bb[j] = *(const f32x4*)(INP(I_LN1B) + l * D + 256 * j + 4 * lane); }
#pragma unroll 1
                for (int pp = gw; pp < M / 2; pp += NGW) {
                    f32x4 y0[4], y1[4];
#pragma unroll
                    for (int j = 0; j < 4; ++j) { y0[j] = ld4bf(Zb + ((size_t)(2 * pp) * D + 256 * j + 4 * lane) * 2) + ld4bf(Xb + ((size_t)(2 * pp) * D + 256 * j + 4 * lane) * 2) * DN_ALPHA;
                        y1[j] = ld4bf(Zb + ((size_t)(2 * pp + 1) * D + 256 * j + 4 * lane) * 2) + ld4bf(Xb + ((size_t)(2 * pp + 1) * D + 256 * j + 4 * lane) * 2) * DN_ALPHA; }
                    ln16(y0, g, bb); ln16(y1, g, bb);
#pragma unroll
                    for (int j = 0; j < 4; ++j) { st4bf(Xb + ((size_t)(2 * pp) * D + 256 * j + 4 * lane) * 2, y0[j]); st4bf(Xb + ((size_t)(2 * pp + 1) * D + 256 * j + 4 * lane) * 2, y1[j]); }
                }
            }
            asm volatile("s_waitcnt vmcnt(0)" ::: "memory");
            __syncthreads();
            __builtin_amdgcn_fence(__ATOMIC_ACQUIRE, "agent");
            asm volatile("s_waitcnt vmcnt(0)" ::: "memory");
            if (rep_ == 0) {
                const int r31 = lane & 31, h2 = lane >> 5;
                const int mytok = 16 * (bx + (2 * wave + (r31 >> 4)) * G) + (r31 & 15);
                const char* sp[4];
#pragma unroll
                for (int q = 0; q < 4; ++q) { const int row = (lane >> 3) + 8 * q; const int tk = 16 * (bx + (2 * wave + (row >> 4)) * G) + (row & 15); sp[q] = Xb + ((size_t)tk * D + 8 * (lane & 7)) * 2; }
                f32x16 C;
#pragma unroll
                for (int i = 0; i < 16; ++i) C[i] = 0.f;
                u32x4 xr[4];
#pragma unroll
                for (int q = 0; q < 4; ++q) xr[q] = *(const u32x4*)(sp[q]);
#pragma unroll 1
                for (int sl = 0; sl < 16; ++sl) {
#pragma unroll
                    for (int q = 0; q < 4; ++q) *(LAS u32x4*)(XS + ((lane >> 3) + 8 * q) * 144 + (lane & 7) * 16) = xr[q];
                    if (sl + 1 < 16) {
#pragma unroll
                        for (int q = 0; q < 4; ++q) xr[q] = *(const u32x4*)(sp[q] + (sl + 1) * 128); }
#pragma unroll
                    for (int k2 = 0; k2 < 4; ++k2) C = __builtin_amdgcn_mfma_f32_32x32x16_bf16(*(const LAS bf16x8*)(WRb + r31 * WP + (64 * sl + 16 * k2 + 8 * h2) * 2), *(const LAS bf16x8*)(XS + r31 * 144 + (16 * k2 + 8 * h2) * 2), C, 0, 0, 0);
                }
                float v[16];
#pragma unroll
                for (int g4 = 0; g4 < 4; ++g4) { const f32x4 b4 = *(const LAS f32x4*)(RB + 8 * g4 + 4 * h2); v[4 * g4] = C[4 * g4] + b4.x; v[4 * g4 + 1] = C[4 * g4 + 1] + b4.y; v[4 * g4 + 2] = C[4 * g4 + 2] + b4.z; v[4 * g4 + 3] = C[4 * g4 + 3] + b4.w; }
                float lv[4]; int li_[4];
#pragma unroll
                for (int k = 0; k < 4; ++k) { float best = -3.0e38f; int bi = 0;
#pragma unroll
                    for (int i = 0; i < 16; ++i) { const int e = (i & 3) + 8 * (i >> 2) + 4 * h2; if (v[i] > best) { best = v[i]; bi = e; } }
#pragma unroll
                    for (int i = 0; i < 16; ++i) { const int e = (i & 3) + 8 * (i >> 2) + 4 * h2; v[i] = (e == bi) ? -3.0e38f : v[i]; }
                    lv[k] = best; li_[k] = bi; }
                float cv[8]; int ci[8];
#pragma unroll
                for (int k = 0; k < 4; ++k) { cv[k] = lv[k]; ci[k] = li_[k]; cv[4 + k] = __shfl_xor(lv[k], 32); ci[4 + k] = __shfl_xor(li_[k], 32); }
                float tv[4]; int te[4];
#pragma unroll
                for (int k = 0; k < 4; ++k) { float best = -3.0e38f; int bi = 64;
#pragma unroll
                    for (int i = 0; i < 8; ++i) { if (cv[i] > best || (cv[i] == best && ci[i] < bi)) { best = cv[i]; bi = ci[i]; } }
#pragma unroll
                    for (int i = 0; i < 8; ++i) cv[i] = (ci[i] == bi) ? -3.0e38f : cv[i];
                    tv[k] = best; te[k] = bi; }
                const float e1 = __expf(tv[1] - tv[0]), e2 = __expf(tv[2] - tv[0]), e3 = __expf(tv[3] - tv[0]), rs = 1.f / (1.f + e1 + e2 + e3);
                const float gt[4] = {rs, e1 * rs, e2 * rs, e3 * rs};
                if (h2 == 0) {
#pragma unroll
                    for (int k = 0; k < 4; ++k) {
                        const unsigned lpos = __hip_atomic_fetch_add(LCNT + te[k], 1u, __ATOMIC_RELAXED, __HIP_MEMORY_SCOPE_WORKGROUP);
                        const unsigned li = __hip_atomic_fetch_add(LLEN, 1u, __ATOMIC_RELAXED, __HIP_MEMORY_SCOPE_WORKGROUP);
                        LIST[2 * li] = (unsigned)(mytok * 4 + k); LIST[2 * li + 1] = (unsigned)te[k] | (lpos << 8);
                        TKE[mytok * 4 + k] = te[k]; TKG[mytok * 4 + k] = gt[k]; }
                }
            }
            __syncthreads();
            if (tid < 32 && rep_ == 0) GBASE[tid] = __hip_atomic_fetch_add((unsigned*)ctl + CW_CNT + (l * 32 + tid) * 64, LCNT[tid], RLX_AGENT);
            __syncthreads();
            if (rep_ == 0) { const unsigned n = LLEN[0];
                for (unsigned i = tid; i < n; i += NTHR) { const unsigned tk = LIST[2 * i], ev = LIST[2 * i + 1], e = ev & 255u, pos = GBASE[e] + (ev >> 8);
                    TKP[tk] = (int)pos; ROWTOK[(size_t)e * M + pos] = (int)(tk >> 2); } }
            __syncthreads();
        }
        SEAM(pb + 7);
        _Pragma("unroll 1") for (int rep_ = 0; rep_ < NREP(8); ++rep_) if (((PHMASK>>8)&1) && IN(pb + 8)) { PHASE_TID
            if (tid < 32) CNT[tid] = (int)__hip_atomic_load((unsigned*)ctl + CW_CNT + (l * 32 + tid) * 64, RLX_AGENT);
            __syncthreads();
            if (tid == 0) { int a = 0; for (int e = 0; e < 32; ++e) { PB[e] = a; a += (CNT[e] + 255) >> 8; } PB[32] = a; }
            __syncthreads();
            const int P = PB[32];
            const int* ROWTOK = (const int*)(ws + WS_ROWTOK);
            char* XD = (char*)(ws + WS_R1);
            for (int sb = gw * 64; sb < P * 256; sb += NGW * 64) {
                const int pm = sb >> 8; int e = 0;
#pragma unroll 1
                for (int j = 1; j < NEXP; ++j) e += (PB[j] <= pm) ? 1 : 0;
                const int pos0 = sb - PB[e] * 256, cnt = CNT[e];
                int nvalid = cnt - pos0; nvalid = nvalid > 64 ? 64 : nvalid;
                int tokv = -1; if (pos0 + lane < cnt) tokv = ROWTOK[(size_t)e * M + pos0 + lane];
#pragma unroll 1
                for (int j = 0; j < nvalid; j += 2) {
                    int t[2]; u32x4 a[2], b2[2];
#pragma unroll
                    for (int i = 0; i < 2; ++i) { t[i] = __builtin_amdgcn_readlane(tokv, j + i);
                        if (t[i] >= 0) { a[i] = *(const u32x4*)(Xb + (size_t)t[i] * 2048 + lane * 32); b2[i] = *(const u32x4*)(Xb + (size_t)t[i] * 2048 + lane * 32 + 16); } }
#pragma unroll
                    for (int i = 0; i < 2; ++i) if (t[i] >= 0) {
                        u32x4 o; o.x = pk4_f8(bflo(a[i].x) * F8_SX, bfhi(a[i].x) * F8_SX, bflo(a[i].y) * F8_SX, bfhi(a[i].y) * F8_SX); o.y = pk4_f8(bflo(a[i].z) * F8_SX, bfhi(a[i].z) * F8_SX, bflo(a[i].w) * F8_SX, bfhi(a[i].w) * F8_SX);
                        o.z = pk4_f8(bflo(b2[i].x) * F8_SX, bfhi(b2[i].x) * F8_SX, bflo(b2[i].y) * F8_SX, bfhi(b2[i].y) * F8_SX); o.w = pk4_f8(bflo(b2[i].z) * F8_SX, bfhi(b2[i].z) * F8_SX, bflo(b2[i].w) * F8_SX, bfhi(b2[i].w) * F8_SX);
                        *(u32x4*)(XD + (size_t)(sb + j + i) * 1024 + lane * 16) = o; }
                }
            }
            LAS float* scr = (LAS float*)(lds + wave * 8448);
            constexpr int IT_GU = 32 * 16 * 64, IT_DN = 32 * 16 * 32;
            for (int it = XW_SPLIT + gw; it < IT_GU + IT_DN; it += NGW) {
                if (it < IT_GU) { const int e = it >> 10, q = it & 1023, kb = q >> 6, nb = q & 63;
                    transpose_item_f8(INP(I_WGU) + (((size_t)l * 32 + e) * D + 64 * kb) * 2048 + 32 * nb, 2048, (unsigned char*)(ws + WS_WGU) + ((size_t)e * 2048 + 32 * nb) * D + 64 * kb, D, F8_SWGU, scr, lane); }
                else { const int r = it - IT_GU, e = r >> 9, q = r & 511, kb = q >> 5, nb = q & 31;
                    transpose_item_f8(INP(I_WDN) + (((size_t)l * 32 + e) * D + 64 * kb) * 1024 + 32 * nb, 1024, (unsigned char*)(ws + WS_WDN) + ((size_t)e * 1024 + 32 * nb) * D + 64 * kb, D, F8_SWDN, scr, lane); }
            }
            __syncthreads();
        }
        SEAM(pb + 8);
        if (IN(pb + 9) || IN(pb + 10)) { PHASE_TID
            if (tid < 32) CNT[tid] = (int)__hip_atomic_load((unsigned*)ctl + CW_CNT + (l * 32 + tid) * 64, RLX_AGENT);
            __syncthreads();
            if (tid == 0) { int a = 0; for (int e = 0; e < 32; ++e) { PB[e] = a; a += (CNT[e] + 255) >> 8; } PB[32] = a; }
            __syncthreads();
        }
        _Pragma("unroll 1") for (int rep_ = 0; rep_ < NREP(9); ++rep_) if (((PHMASK>>9)&1) && IN(pb + 9)) {
            SchedMoe S; S.T.init(PB[32], 8); S.G = G; S.c = bx; S.A = (const char*)(ws + WS_R1); S.W = (const char*)(ws + WS_WGU); S.C = (char*)(ws + WS_R2 + R2_HMID); S.PB = PB; S.wrows = 2048; S.ldc = 1024; S.cdiv = 2; S.osz = 1;
            pg8::EpiMoe1 E; E.bgu = INP(I_BGU) + (size_t)l * 32 * 2048;
            pg8::gemm_phase<true>(lds, D, D, D, S, E, wave);
        }
        SEAM(pb + 9);
        _Pragma("unroll 1") for (int rep_ = 0; rep_ < NREP(10); ++rep_) if (((PHMASK>>10)&1) && IN(pb + 10)) {
            SchedMoe S; S.T.init(PB[32], 4); S.G = G; S.c = bx; S.A = (const char*)(ws + WS_R2 + R2_HMID); S.W = (const char*)(ws + WS_WDN); S.C = (char*)(ws + WS_R1); S.PB = PB; S.wrows = 1024; S.ldc = 1024; S.cdiv = 1; S.osz = 2;
            pg8::EpiMoe2 E; E.bdn = INP(I_BDN) + (size_t)l * 32 * 1024;
            pg8::gemm_phase<true>(lds, D, D, D, S, E, wave);
        }
        SEAM(pb + 10);
        _Pragma("unroll 1") for (int rep_ = 0; rep_ < NREP(11); ++rep_) if (((PHMASK>>11)&1) && IN(pb + 11)) { PHASE_TID
            if (tid < 32) CNT[tid] = (int)__hip_atomic_load((unsigned*)ctl + CW_CNT + (l * 32 + tid) * 64, RLX_AGENT);
            LAS float* wgt = (LAS float*)(lds + 73728);
            const bool lastl = (l == DEPTH - 1);
            if (!lastl) load_gate_table(wgt, INP(I_WIN) + (size_t)(l + 1) * D * DIN, tid);
            __syncthreads();
            if (tid == 0) { int a = 0; for (int e = 0; e < 32; ++e) { PB[e] = a; a += (CNT[e] + 255) >> 8; } PB[32] = a; }
            __syncthreads();
            const int e0 = 8 * lane;
            f32x4 g[4], bb[4];
#pragma unroll
            for (int j = 0; j < 4; ++j) { const int o = (j >> 1) * 512 + e0 + (j & 1) * 4; g[j] = *(const f32x4*)(INP(I_LN2G) + l * D + o); bb[j] = *(const f32x4*)(INP(I_LN2B) + l * D + o); }
            const char* YA = (const char*)(ws + WS_R1);
            const bool dummy_ = (rep_ + 1 < NREP(11)); char* const Xo = dummy_ ? (char*)(ws + WS_R2) : Xb; float* const Fo = dummy_ ? (float*)(ws + WS_R2 + 256 * MiB) : args.out; float* const Go = dummy_ ? (float*)(ws + WS_R2 + 200 * MiB) : GIF;
            const int* TKE = (const int*)(ws + WS_TKE); const float* TKG = (const float*)(ws + WS_TKG); const int* TKP = (const int*)(ws + WS_TKP);
#pragma unroll 1
            for (int mb = gw * 16; mb < M; mb += NGW * 16) {
                const int ev = TKE[mb * 4 + lane], pv = TKP[mb * 4 + lane]; const float gv = TKG[mb * 4 + lane];
                const int rowv = PB[ev] * 256 + pv;
#pragma unroll 1
                for (int ti = 0; ti < 16; ti += 2) {
                    u32x4 xw[2][2], yw[2][4][2]; float gk[2][4];
#pragma unroll
                    for (int q = 0; q < 2; ++q) { const size_t m = (size_t)mb + ti + q;
                        xw[q][0] = *(const u32x4*)(Xb + (m * D + e0) * 2); xw[q][1] = *(const u32x4*)(Xb + (m * D + 512 + e0) * 2);
#pragma unroll
                        for (int k = 0; k < 4; ++k) { const size_t row = (size_t)__builtin_amdgcn_readlane(rowv, 4 * (ti + q) + k);
                            gk[q][k] = __builtin_bit_cast(float, __builtin_amdgcn_readlane(__builtin_bit_cast(int, gv), 4 * (ti + q) + k));
                            yw[q][k][0] = *(const u32x4*)(YA + (row * D + e0) * 2); yw[q][k][1] = *(const u32x4*)(YA + (row * D + 512 + e0) * 2); } }
#pragma unroll
                    for (int q = 0; q < 2; ++q) { const size_t m = (size_t)mb + ti + q;
                        f32x4 v[4];
#pragma unroll
                        for (int hh = 0; hh < 2; ++hh) { const u32x4 w = xw[q][hh];
                            v[2 * hh] = (f32x4){bflo(w.x), bfhi(w.x), bflo(w.y), bfhi(w.y)} * DN_ALPHA; v[2 * hh + 1] = (f32x4){bflo(w.z), bfhi(w.z), bflo(w.w), bfhi(w.w)} * DN_ALPHA; }
#pragma unroll
                        for (int k = 0; k < 4; ++k)
#pragma unroll
                            for (int hh = 0; hh < 2; ++hh) { const u32x4 w = yw[q][k][hh];
                                v[2 * hh] = v[2 * hh] + (f32x4){bflo(w.x), bfhi(w.x), bflo(w.y), bfhi(w.y)} * gk[q][k]; v[2 * hh + 1] = v[2 * hh + 1] + (f32x4){bflo(w.z), bfhi(w.z), bflo(w.w), bfhi(w.w)} * gk[q][k]; }
                        ln16(v, g, bb);
                        if (lastl) {
#pragma unroll
                            for (int j = 0; j < 4; ++j) *(f32x4*)(Fo + m * D + (j >> 1) * 512 + e0 + (j & 1) * 4) = v[j];
                        } else {
#pragma unroll
                            for (int hh = 0; hh < 2; ++hh) { *(u32x4*)(Xo + (m * D + hh * 512 + e0) * 2) = pg8::pack8(v[2 * hh], v[2 * hh + 1]);
                                u32x2 f8w; f8w.x = pk4_f8(v[2 * hh].x * F8_SX, v[2 * hh].y * F8_SX, v[2 * hh].z * F8_SX, v[2 * hh].w * F8_SX); f8w.y = pk4_f8(v[2 * hh + 1].x * F8_SX, v[2 * hh + 1].y * F8_SX, v[2 * hh + 1].z * F8_SX, v[2 * hh + 1].w * F8_SX);
                                if (!dummy_) *(u32x2*)((char*)(ws + WS_XF8) + m * D + hh * 512 + e0) = f8w; }
                            gates8b(v, wgt, Go + m * 8, lane);
                        }
                    }
                }
            }
            __syncthreads();
        }
        SEAM(pb + 11);
    }
#undef IN
#undef SEAM
}

extern "C" void kernel_launch(void* const* d_in, const int* in_sizes, int n_in, void* d_out, int out_size, void* d_ws, size_t ws_size, hipStream_t stream) {
    static int grid = 0;
    if (grid == 0) {
        if (n_in != N_IN || out_size != M * D || ws_size < WS_END) { fprintf(stderr, "kernel_launch: unexpected shapes (n_in %d, out %d, ws %zu)\n", n_in, out_size, ws_size); grid = -1; return; }
        int dev = 0, cus = 0, per_cu = 0;
        if (hipGetDevice(&dev) != hipSuccess || hipDeviceGetAttribute(&cus, hipDeviceAttributeMultiprocessorCount, dev) != hipSuccess) { grid = -1; return; }
        if (hipFuncSetAttribute((const void*)fwd_kernel, hipFuncAttributeMaxDynamicSharedMemorySize, LDS_BYTES) != hipSuccess) { fprintf(stderr, "kernel_launch: hipFuncSetAttribute failed\n"); grid = -1; return; }
        if (hipOccupancyMaxActiveBlocksPerMultiprocessor(&per_cu, (const void*)fwd_kernel, NTHR, LDS_BYTES) != hipSuccess || per_cu < 1) fprintf(stderr, "kernel_launch: occupancy query reports %d\n", per_cu);
        (void)hipGetLastError();
        grid = cus;
    }
    if (grid < 0) return;
    (void)hipMemsetAsync((char*)d_ws + WS_CTL, 0, CTL_ZERO_BYTES, stream);
    Args a{};
    for (int i = 0; i < N_IN; ++i) a.in[i] = (const float*)d_in[i];
    a.out = (float*)d_out; a.ws = (unsigned char*)d_ws;
#if MK_ONE_LAUNCH
    a.ph_lo = 0; a.ph_hi = NPH;
    hipLaunchKernelGGL(fwd_kernel, dim3(grid), dim3(NTHR), LDS_BYTES, stream, a);
#else
    for (int p = 0; p < NPH; ++p) { a.ph_lo = p; a.ph_hi = p + 1; hipLaunchKernelGGL(fwd_kernel, dim3(grid), dim3(NTHR), LDS_BYTES, stream, a); }
#endif
    const hipError_t le = hipPeekAtLastError();
    if (le != hipSuccess) fprintf(stderr, "kernel_launch: launch failed: %s\n", hipGetErrorName(le));
}
```

```cpp
#include <hip/hip_runtime.h>
#include <cstdio>
#include <cstdint>

#ifndef MK_ONE_LAUNCH
#define MK_ONE_LAUNCH 1
#endif

#define LAS __attribute__((address_space(3)))
#define GAS __attribute__((address_space(1)))
typedef unsigned short bf16;
typedef short bf16x8 __attribute__((ext_vector_type(8)));
typedef float f32x4 __attribute__((ext_vector_type(4)));
typedef float f32x2 __attribute__((ext_vector_type(2)));
typedef float f32x16 __attribute__((ext_vector_type(16)));
typedef unsigned u32x4 __attribute__((ext_vector_type(4)));
typedef unsigned u32x2 __attribute__((ext_vector_type(2)));
typedef __bf16 bf16x2_t __attribute__((ext_vector_type(2)));
typedef GAS unsigned gu32;
#define RLX_AGENT __ATOMIC_RELAXED, __HIP_MEMORY_SCOPE_AGENT
#define DI __device__ __forceinline__

constexpr int NWAVES = 8, NTHR = 512;
constexpr int D = 1024, BATCH = 16, SEQ = 4096, M = BATCH * SEQ, DEPTH = 2, MEML = 256, MROWS = BATCH * MEML;
constexpr int DIN = 6920, NU = 6912;
constexpr int UC_QK = 0, UC_RW = 512, UC_V = 2304, UC_OG = 2816, UC_CAQ = 3328, UC_GATE = 3840;
constexpr int UC_F8 = UC_V, NF8 = NU - UC_F8;
__host__ __device__ constexpr int ucol_src(int c) { return c < 512 ? c : (c < 2304 ? 1544 + (c - 512) : (c < 2816 ? 512 + (c - 2304) : (c < 3328 ? 1024 + (c - 2816) : (c < 3840 ? 3336 + (c - 3328) : 3848 + (c - 3840))))); }
constexpr int NEXP = 32, TOPK = 4;
constexpr int PMAX = M * TOPK / 256 + NEXP;
constexpr float LN_EPS = 1e-5f, RW_GN_EPS = 64e-5f, DN_ALPHA = 1.41421356237f;

enum { I_X = 0, I_MEM, I_LNIN_G, I_LNIN_B, I_MEMLN_G, I_MEMLN_B, I_WIN, I_CONVW, I_CONVB, I_IGB, I_FGB, I_MLNORMG, I_RWMU, I_RWW0, I_RWWUP, I_RWA0, I_RWAUP, I_RWGUP,
       I_RWKK, I_RWKA, I_RWRK, I_RWLNG, I_RWLNB, I_CAWKV, I_GATEB, I_WBRML, I_WBRRW, I_WBRCA, I_WO, I_LN1G, I_LN1B, I_RTW, I_RTB, I_WGU, I_BGU, I_WDN, I_BDN, I_LN2G, I_LN2B, N_IN };

constexpr size_t MiB = 1u << 20;
constexpr size_t WS_CTL = 0, CTL_ZERO_BYTES = 1 * MiB;
constexpr size_t WS_WIN = 1 * MiB;
constexpr size_t WS_WKV = 28 * MiB;
constexpr size_t WS_WBR = 32 * MiB;
constexpr size_t WS_WO = 38 * MiB;
constexpr size_t WS_WLORA = 42 * MiB;
constexpr size_t WS_WGU = 45 * MiB;
constexpr size_t WS_WDN = 173 * MiB;
constexpr size_t WS_X = 237 * MiB;
constexpr size_t WS_MEMN = 365 * MiB;
constexpr size_t WS_KV = 373 * MiB;
constexpr size_t WS_GIF = 389 * MiB;
constexpr size_t WS_TKE = 391 * MiB, WS_TKG = 392 * MiB, WS_TKP = 393 * MiB;
constexpr size_t WS_ROWTOK = 394 * MiB;
constexpr size_t WS_HML = 402 * MiB;
constexpr size_t WS_R1 = 466 * MiB;
constexpr size_t WS_R2 = 1330 * MiB;
constexpr size_t WS_XF8 = 1858 * MiB;
constexpr size_t WS_WING8 = 1922 * MiB;
constexpr size_t WS_END = 1932 * MiB;
constexpr size_t R2_LORA_OUT = 0, R2_HCAT = 192 * MiB, R2_LORA_IN = 384 * MiB, R2_YPRE = 0, R2_Z = 192 * MiB, R2_HMID = 0;
constexpr int CW_TMO = 0, CW_BAR = 4096, CW_CNT = 16384;

constexpr int LDS_BYTES = 155648;
constexpr int LDSCTL_OFF = 153600;

DI unsigned pk2(float lo, float hi) { bf16x2_t b = __builtin_convertvector((f32x2){lo, hi}, bf16x2_t); return __builtin_bit_cast(unsigned, b); }
DI unsigned f2bf(float f) { return pk2(f, 0.f) & 0xffffu; }
DI float bflo(unsigned u) { return __builtin_bit_cast(float, u << 16); }
DI float bfhi(unsigned u) { return __builtin_bit_cast(float, u & 0xffff0000u); }
DI unsigned pk4_f8(float a, float b, float c, float d) {
    a = __builtin_amdgcn_fmed3f(a, -448.f, 448.f); b = __builtin_amdgcn_fmed3f(b, -448.f, 448.f); c = __builtin_amdgcn_fmed3f(c, -448.f, 448.f); d = __builtin_amdgcn_fmed3f(d, -448.f, 448.f);
    int w = 0; w = __builtin_amdgcn_cvt_pk_fp8_f32(a, b, w, false); w = __builtin_amdgcn_cvt_pk_fp8_f32(c, d, w, true); return (unsigned)w; }
DI float sigmoidf_(float x) { return __builtin_amdgcn_rcpf(1.f + __builtin_amdgcn_exp2f(-1.4426950408889634f * x)); }
template <int CTRL> DI float dppf(float x) { return __builtin_bit_cast(float, __builtin_amdgcn_update_dpp(0, __builtin_bit_cast(int, x), CTRL, 0xF, 0xF, true)); }
DI float red4(float x) { x += dppf<0xB1>(x); x += dppf<0x4E>(x); return x; }
DI float red8(float x) { x = red4(x); x += dppf<0x141>(x); return x; }
DI float red16(float x) { x = red8(x); x += dppf<0x140>(x); return x; }
DI float red8o(float x) { x += dppf<0xB1>(x); asm("" : "+v"(x)); x += dppf<0x4E>(x); asm("" : "+v"(x)); x += dppf<0x141>(x); asm("" : "+v"(x)); return x; }
DI float red16o(float x) { x = red8o(x); x += dppf<0x140>(x); asm("" : "+v"(x)); return x; }
typedef short s16x4 __attribute__((ext_vector_type(4)));
DI u32x2 trd4(const LAS unsigned char* img, int PB, int rowbase, int colbase, int lane) {
    const LAS unsigned char* p = img + (rowbase + ((lane & 15) >> 2)) * PB + (colbase + 16 * ((lane >> 4) & 1) + 4 * (lane & 3)) * 2;
    return __builtin_bit_cast(u32x2, __builtin_amdgcn_ds_read_tr16_b64_v4i16((LAS s16x4*)p)); }
DI bf16x8 trd8(const LAS unsigned char* img, int PB, int rb0, int rb1, int colbase, int lane) { const u32x2 lo = trd4(img, PB, rb0, colbase, lane), hi = trd4(img, PB, rb1, colbase, lane); return __builtin_bit_cast(bf16x8, (u32x4){lo.x, lo.y, hi.x, hi.y}); }
template <int CTRL, int RM> DI float dpp_keep(float x, float ident) { return __builtin_bit_cast(float, __builtin_amdgcn_update_dpp(__builtin_bit_cast(int, ident), __builtin_bit_cast(int, x), CTRL, RM, 0xF, false)); }
DI float scan_add64(float x) { x += dpp_keep<0x111, 0xF>(x, 0.f); x += dpp_keep<0x112, 0xF>(x, 0.f); x += dpp_keep<0x114, 0xF>(x, 0.f); x += dpp_keep<0x118, 0xF>(x, 0.f); x += dpp_keep<0x142, 0xA>(x, 0.f); x += dpp_keep<0x143, 0xC>(x, 0.f); return x; }
DI float scan_max64(float x) { const float NI = -3.0e38f; x = fmaxf(x, dpp_keep<0x111, 0xF>(x, NI)); x = fmaxf(x, dpp_keep<0x112, 0xF>(x, NI)); x = fmaxf(x, dpp_keep<0x114, 0xF>(x, NI)); x = fmaxf(x, dpp_keep<0x118, 0xF>(x, NI));
    x = fmaxf(x, dpp_keep<0x142, 0xA>(x, NI)); x = fmaxf(x, dpp_keep<0x143, 0xC>(x, NI)); return x; }
DI float wave_sum(float v) {
    v = red16(v);
    const int vi = __builtin_bit_cast(int, v);
    const float a = __builtin_bit_cast(float, __builtin_amdgcn_readlane(vi, 0)), b = __builtin_bit_cast(float, __builtin_amdgcn_readlane(vi, 16));
    const float c = __builtin_bit_cast(float, __builtin_amdgcn_readlane(vi, 32)), d = __builtin_bit_cast(float, __builtin_amdgcn_readlane(vi, 48));
    return (a + b) + (c + d);
}
#define LDS_WAIT() asm volatile("s_waitcnt lgkmcnt(0)" ::: "memory")

constexpr float F8_SX = 8.f, F8_SWGU = 512.f, F8_SH = 4.f, F8_SWDN = 1024.f, F8_INV1 = 1.f / (F8_SX * F8_SWGU), F8_INV2 = 1.f / (F8_SH * F8_SWDN);
namespace pg8 {
constexpr int BM = 256, BK = 64, HALF = 128, HTB = HALF * BK * 2, STAGE_BYTES = 8 * HTB, NXCD = 8, WGM = 8;
__host__ __device__ __forceinline__ int lds_byte(int r, int c) { const int st = (r >> 4) * 2 + (c >> 5), rr = r & 15, cc = c & 31, ob = rr * 64 + cc * 2; return st * 1024 + (ob ^ (((ob >> 9) & 1) << 5)); }
__host__ __device__ __forceinline__ void stage_rc(int b, int& R, int& C) { const int st = b / 1024, sb = b % 1024, swz = sb ^ (((sb >> 9) & 1) << 5); R = (st >> 1) * 16 + swz / 64; C = (st & 1) * 32 + (swz % 64) / 2; }
__host__ __device__ __forceinline__ int perm32(int rho) { const int n = rho >> 4, i = rho & 15; return 8 * (i >> 2) + 4 * n + (i & 3); }

struct Unit { const char* a; const char* b; char* c; int ldc; int r0, c0, e, sub; };

struct TileOrder {
    int nM, nN, nwg;
    DI void init(int nM_, int nN_) { nM = nM_; nN = nN_; nwg = nM * nN; }
    DI bool tile(long L, int& pm, int& pn) const {
        if (L >= nwg) return false;
        int wgid = (int)L; { const int q = nwg / NXCD, r = nwg % NXCD, xcd = wgid % NXCD, off = wgid / NXCD; wgid = (xcd < r ? xcd * (q + 1) : r * (q + 1) + (xcd - r) * q) + off; }
        const int nig = WGM * nN, gid = wgid / nig, fm = gid * WGM, gsz = (nM - fm) < WGM ? (nM - fm) : WGM;
        pm = fm + ((wgid % nig) % gsz); pn = (wgid % nig) / gsz; return true;
    }
};

DI u32x4 pack8(const f32x4& v0, const f32x4& v1) { u32x4 w; w.x = pk2(v0[0], v0[1]); w.y = pk2(v0[2], v0[3]); w.z = pk2(v1[0], v1[1]); w.w = pk2(v1[2], v1[3]); return w; }

struct EpiStore {
    DI void operator()(const f32x4 (&acc)[2][2][4][2], const Unit& u, int wr, int wc, int fr, int fq) const {
#pragma unroll
        for (int ai = 0; ai < 2; ++ai)
#pragma unroll
            for (int m = 0; m < 4; ++m) { char* rowp = u.c + ((size_t)(ai * HALF + wr * 64 + m * 16 + fr) * u.ldc + wc * 32 + 8 * fq) * 2;
#pragma unroll
                for (int bj = 0; bj < 2; ++bj) *(u32x4*)(rowp + bj * 256) = pack8(acc[ai][bj][m][0], acc[ai][bj][m][1]); }
    }
};
struct EpiStoreS {
    float s;
    DI void operator()(const f32x4 (&acc)[2][2][4][2], const Unit& u, int wr, int wc, int fr, int fq) const {
#pragma unroll
        for (int ai = 0; ai < 2; ++ai)
#pragma unroll
            for (int m = 0; m < 4; ++m) { char* rowp = u.c + ((size_t)(ai * HALF + wr * 64 + m * 16 + fr) * u.ldc + wc * 32 + 8 * fq) * 2;
#pragma unroll
                for (int bj = 0; bj < 2; ++bj) *(u32x4*)(rowp + bj * 256) = pack8(acc[ai][bj][m][0] * s, acc[ai][bj][m][1] * s); }
    }
};
struct EpiMerge {
    static constexpr bool MIDK = true;
    const char* U; const float* gate_b;
    DI void mid(f32x4 (&acc)[2][2][4][2], const Unit& u, int which, int wr, int wc, int fr, int fq) const {
        const float L2E = 1.4426950408889634f;
#pragma unroll
        for (int bj = 0; bj < 2; ++bj) {
            const float* g = gate_b + which * 1024 + u.c0 + bj * HALF + wc * 32 + 8 * fq;
            const f32x4 ga0 = *(const f32x4*)g, ga1 = *(const f32x4*)(g + 4), gn0 = *(const f32x4*)(g + 1024), gn1 = *(const f32x4*)(g + 1028);
            const float gaa[8] = {ga0.x, ga0.y, ga0.z, ga0.w, ga1.x, ga1.y, ga1.z, ga1.w}, gnn[8] = {gn0.x, gn0.y, gn0.z, gn0.w, gn1.x, gn1.y, gn1.z, gn1.w};
#pragma unroll
            for (int ai = 0; ai < 2; ++ai)
#pragma unroll
                for (int m = 0; m < 4; ++m) { const int lr = ai * HALF + wr * 64 + m * 16 + fr;
                    const char* gp = U + ((size_t)(u.r0 + lr) * NU + UC_GATE + which * 1024 + u.c0 + wc * 32 + 8 * fq) * 2 + bj * 256;
                    const u32x4 wa = *(const u32x4*)gp, wn = *(const u32x4*)(gp + 2048);
                    const float xa[8] = {bflo(wa.x), bfhi(wa.x), bflo(wa.y), bfhi(wa.y), bflo(wa.z), bfhi(wa.z), bflo(wa.w), bfhi(wa.w)};
                    const float xn[8] = {bflo(wn.x), bfhi(wn.x), bflo(wn.y), bfhi(wn.y), bflo(wn.z), bfhi(wn.z), bflo(wn.w), bfhi(wn.w)};
#pragma unroll
                    for (int i = 0; i < 8; ++i) { const float ea = __builtin_amdgcn_exp2f(-L2E * __builtin_amdgcn_fmed3f(xa[i] + gaa[i], -30.f, 30.f)), en = __builtin_amdgcn_exp2f(-L2E * __builtin_amdgcn_fmed3f(xn[i] + gnn[i], -30.f, 30.f));
                        acc[ai][bj][m][i >> 2][i & 3] *= (1.f + en) * __builtin_amdgcn_rcpf(1.f + ea); }
                    if (m & 1) asm volatile("" ::: "memory"); }
        }
    }
    DI void operator()(const f32x4 (&acc)[2][2][4][2], const Unit& u, int wr, int wc, int fr, int fq) const {
        f32x4 gb[2][2];
#pragma unroll
        for (int bj = 0; bj < 2; ++bj) { const float* g = gate_b + 2048 + u.c0 + bj * HALF + wc * 32 + 8 * fq; gb[bj][0] = *(const f32x4*)g; gb[bj][1] = *(const f32x4*)(g + 4); }
#pragma unroll
        for (int ai = 0; ai < 2; ++ai)
#pragma unroll
            for (int m = 0; m < 4; ++m) { const int lr = ai * HALF + wr * 64 + m * 16 + fr; char* rowp = u.c + ((size_t)lr * u.ldc + wc * 32 + 8 * fq) * 2;
                const char* gp = U + ((size_t)(u.r0 + lr) * NU + UC_GATE + 2048 + u.c0 + wc * 32 + 8 * fq) * 2;
#pragma unroll
                for (int bj = 0; bj < 2; ++bj) { const u32x4 gw = *(const u32x4*)(gp + bj * 256);
                    f32x4 v0 = acc[ai][bj][m][0], v1 = acc[ai][bj][m][1];
                    v0[0] *= sigmoidf_(bflo(gw.x) + gb[bj][0][0]); v0[1] *= sigmoidf_(bfhi(gw.x) + gb[bj][0][1]); v0[2] *= sigmoidf_(bflo(gw.y) + gb[bj][0][2]); v0[3] *= sigmoidf_(bfhi(gw.y) + gb[bj][0][3]);
                    v1[0] *= sigmoidf_(bflo(gw.z) + gb[bj][1][0]); v1[1] *= sigmoidf_(bfhi(gw.z) + gb[bj][1][1]); v1[2] *= sigmoidf_(bflo(gw.w) + gb[bj][1][2]); v1[3] *= sigmoidf_(bfhi(gw.w) + gb[bj][1][3]);
                    *(u32x4*)(rowp + bj * 256) = pack8(v0, v1); }
                asm volatile("" ::: "memory"); }
    }
};
struct EpiWo {
    const char* X;
    DI void operator()(const f32x4 (&acc)[2][2][4][2], const Unit& u, int wr, int wc, int fr, int fq) const {
#pragma unroll
        for (int ai = 0; ai < 2; ++ai)
#pragma unroll
            for (int m = 0; m < 4; ++m) { const int lr = ai * HALF + wr * 64 + m * 16 + fr; char* rowp = u.c + ((size_t)lr * u.ldc + wc * 32 + 8 * fq) * 2;
                const char* xp = X + ((size_t)(u.r0 + lr) * D + u.c0 + wc * 32 + 8 * fq) * 2;
#pragma unroll
                for (int bj = 0; bj < 2; ++bj) { const u32x4 xw = *(const u32x4*)(xp + bj * 256);
                    f32x4 v0 = acc[ai][bj][m][0], v1 = acc[ai][bj][m][1];
                    v0[0] += DN_ALPHA * bflo(xw.x); v0[1] += DN_ALPHA * bfhi(xw.x); v0[2] += DN_ALPHA * bflo(xw.y); v0[3] += DN_ALPHA * bfhi(xw.y);
                    v1[0] += DN_ALPHA * bflo(xw.z); v1[1] += DN_ALPHA * bfhi(xw.z); v1[2] += DN_ALPHA * bflo(xw.w); v1[3] += DN_ALPHA * bfhi(xw.w);
                    *(u32x4*)(rowp + bj * 256) = pack8(v0, v1); }
                asm volatile("" ::: "memory"); }
    }
};
DI float swiglu1(float a, float b) { const float g = fminf(a, 7.f), l = fminf(fmaxf(b, -7.f), 7.f); return g * sigmoidf_(1.702f * g) * (l + 1.f); }
struct EpiMoe1 {
    const float* bgu;
    DI void operator()(const f32x4 (&acc)[2][2][4][2], const Unit& u, int wr, int wc, int fr, int fq) const {
        f32x4 bv[2][2];
#pragma unroll
        for (int bj = 0; bj < 2; ++bj) { const float* b = bgu + u.e * 2048 + u.c0 + bj * HALF + wc * 32 + 8 * fq; bv[bj][0] = *(const f32x4*)b; bv[bj][1] = *(const f32x4*)(b + 4); }
#pragma unroll
        for (int ai = 0; ai < 2; ++ai)
#pragma unroll
            for (int m = 0; m < 4; ++m) { const int lr = ai * HALF + wr * 64 + m * 16 + fr; char* rowp = u.c + ((size_t)lr * u.ldc + wc * 16 + 4 * fq);
#pragma unroll
                for (int bj = 0; bj < 2; ++bj) { const f32x4 v0 = acc[ai][bj][m][0] * F8_INV1 + bv[bj][0], v1 = acc[ai][bj][m][1] * F8_INV1 + bv[bj][1];
                    *(unsigned*)(rowp + bj * 64) = pk4_f8(swiglu1(v0[0], v0[1]) * F8_SH, swiglu1(v0[2], v0[3]) * F8_SH, swiglu1(v1[0], v1[1]) * F8_SH, swiglu1(v1[2], v1[3]) * F8_SH); } }
    }
};
struct EpiMoe2 {
    const float* bdn;
    DI void operator()(const f32x4 (&acc)[2][2][4][2], const Unit& u, int wr, int wc, int fr, int fq) const {
        f32x4 bv[2][2];
#pragma unroll
        for (int bj = 0; bj < 2; ++bj) { const float* b = bdn + u.e * 1024 + u.c0 + bj * HALF + wc * 32 + 8 * fq; bv[bj][0] = *(const f32x4*)b; bv[bj][1] = *(const f32x4*)(b + 4); }
#pragma unroll
        for (int ai = 0; ai < 2; ++ai)
#pragma unroll
            for (int m = 0; m < 4; ++m) { char* rowp = u.c + ((size_t)(ai * HALF + wr * 64 + m * 16 + fr) * u.ldc + wc * 32 + 8 * fq) * 2;
#pragma unroll
                for (int bj = 0; bj < 2; ++bj) *(u32x4*)(rowp + bj * 256) = pack8(acc[ai][bj][m][0] * F8_INV2 + bv[bj][0], acc[ai][bj][m][1] * F8_INV2 + bv[bj][1]); }
    }
};

typedef int i32x8 __attribute__((ext_vector_type(8)));
typedef int i32x4 __attribute__((ext_vector_type(4)));
template <bool F8, bool MIDK = false, class Epi, class Sched>
DI void gemm_phase(LAS unsigned char* lds, const int KB  , const int ldaB, const int ldbB, const Sched& S, const Epi& E, const int wave_) {
    unsigned z_ = 0u; asm volatile("" : "+v"(z_)); const int tid = wave_ * 64 + (int)__builtin_amdgcn_mbcnt_hi(~0u, __builtin_amdgcn_mbcnt_lo(~0u, z_));
    const int wid = __builtin_amdgcn_readfirstlane(tid >> 6), lane = tid & 63, wr = wid >> 2, wc = wid & 3, fr = lane & 15, fq = lane >> 4;
    const int nt = KB / (BK * 2);
    unsigned voffA[2], voffB[2];
#pragma unroll
    for (int i = 0; i < 2; ++i) { int R, C; stage_rc(tid * 16 + i * 8192, R, C); const int Rb = (R & ~31) + perm32(R & 31);
        voffA[i] = (unsigned)(R * ldaB + C * 2); voffB[i] = (unsigned)(Rb * ldbB + C * 2); }
    asm volatile("" : "+v"(voffA[0]), "+v"(voffA[1]), "+v"(voffB[0]), "+v"(voffB[1]));
    const size_t kstep = (size_t)(BK * 2);
    const size_t hstepA = (size_t)HALF * ldaB, hstepB = (size_t)HALF * ldbB;
    const unsigned ldsw = (unsigned)wid * 1024u;
    const int aoff = lds_byte(wr * 64 + fr, fq * 8), boff = lds_byte(wc * 32 + fr, fq * 8);
#define PG8_SA(b, h) (((b) * 2 + (h)) * HTB)
#define PG8_SB(b, h) ((4 + (b) * 2 + (h)) * HTB)
#define PG8_STAGE(bufoff, gbase, voff) do { _Pragma("unroll") for (int _i = 0; _i < 2; ++_i) \
        __builtin_amdgcn_global_load_lds((const unsigned*)((const char*)(gbase) + (voff)[_i]), (LAS unsigned*)(lds + (bufoff) + ldsw + _i * 8192), 16, 0, 0); } while (0)
#define PG8_LD8(p) __builtin_shufflevector(*(const LAS i32x4*)(p), *(const LAS i32x4*)((p) + 1024), 0, 1, 2, 3, 4, 5, 6, 7)
#define PG8_LDA8(dst, b, h) do { _Pragma("unroll") for (int m = 0; m < 4; ++m) dst[m] = PG8_LD8(lds + PG8_SA(b, h) + aoff + m * 2048); } while (0)
#define PG8_LDB8(dst, b, h) do { _Pragma("unroll") for (int n = 0; n < 2; ++n) dst[n] = PG8_LD8(lds + PG8_SB(b, h) + boff + n * 2048); } while (0)
#define PG8_MMA8(ai, bj, A8, B8) do { __builtin_amdgcn_s_setprio(1); _Pragma("unroll") for (int m = 0; m < 4; ++m) _Pragma("unroll") for (int n = 0; n < 2; ++n) \
        asm volatile("v_mfma_f32_16x16x128_f8f6f4 %0, %1, %2, %0" : "+v"(acc[ai][bj][m][n]) : "v"(B8[n]), "v"(A8[m])); __builtin_amdgcn_s_setprio(0); } while (0)
#define PG8_LDA(dst, b, h) do { _Pragma("unroll") for (int m = 0; m < 4; ++m) _Pragma("unroll") for (int k = 0; k < 2; ++k) dst[m][k] = *(const LAS bf16x8*)(lds + PG8_SA(b, h) + aoff + m * 2048 + k * 1024); } while (0)
#define PG8_LDB(dst, b, h) do { _Pragma("unroll") for (int n = 0; n < 2; ++n) _Pragma("unroll") for (int k = 0; k < 2; ++k) dst[n][k] = *(const LAS bf16x8*)(lds + PG8_SB(b, h) + boff + n * 2048 + k * 1024); } while (0)
#define PG8_CAT(x) __builtin_shufflevector(__builtin_bit_cast(i32x4, (x)[0]), __builtin_bit_cast(i32x4, (x)[1]), 0, 1, 2, 3, 4, 5, 6, 7)
#define PG8_MMA(ai, bj, At, Bt) do { __builtin_amdgcn_s_setprio(1); _Pragma("unroll") for (int m = 0; m < 4; ++m) _Pragma("unroll") for (int n = 0; n < 2; ++n) _Pragma("unroll") for (int k = 0; k < 2; ++k) \
        acc[ai][bj][m][n] = __builtin_amdgcn_mfma_f32_16x16x32_bf16(Bt[n][k], At[m][k], acc[ai][bj][m][n], 0, 0, 0); __builtin_amdgcn_s_setprio(0); } while (0)
#define PG8_WAIT_V(n) asm volatile("s_waitcnt vmcnt(" #n ")" ::: "memory")
#define PG8_WAIT_L(n) asm volatile("s_waitcnt lgkmcnt(" #n ")" ::: "memory")
#define PG8_BAR __builtin_amdgcn_s_barrier()
#define PG8_SCHED __builtin_amdgcn_sched_barrier(0)
    Unit cur, nxt; int ui = 0;
    if (!S.next(0, cur)) return;
    f32x4 acc[2][2][4][2];
#pragma unroll
    for (int a = 0; a < 2; ++a)
#pragma unroll
        for (int b = 0; b < 2; ++b)
#pragma unroll
            for (int m = 0; m < 4; ++m)
#pragma unroll
                for (int n = 0; n < 2; ++n) acc[a][b][m][n] = (f32x4){0.f, 0.f, 0.f, 0.f};
    bf16x8 At[4][2], B0[2][2], B1[2][2]; i32x8 A8[4], B80[2], B81[2];
    const char* cA = cur.a; const char* cB = cur.b;
    PG8_STAGE(PG8_SB(0, 0), cB, voffB); PG8_STAGE(PG8_SB(0, 1), cB + hstepB, voffB); PG8_STAGE(PG8_SA(0, 0), cA, voffA); PG8_STAGE(PG8_SA(0, 1), cA + hstepA, voffA);
    if (wr == 1) PG8_BAR;
    PG8_WAIT_V(2); PG8_BAR;
    PG8_STAGE(PG8_SB(1, 0), cB + kstep, voffB); PG8_STAGE(PG8_SA(1, 0), cA + kstep, voffA); PG8_STAGE(PG8_SB(1, 1), cB + hstepB + kstep, voffB);
    PG8_WAIT_V(6); PG8_BAR;
    for (;;) {
        const bool has_next = S.next(ui + 1, nxt);
        const char* nA = has_next ? nxt.a : cA; const char* nB = has_next ? nxt.b : cB;
#pragma unroll 1
        for (int t = 0; t < nt; t += 2) {
            if constexpr (MIDK) { if (t == 8 || t == 16) { int fr_ = fr, fq_ = fq; asm volatile("" : "+v"(fr_), "+v"(fq_)); E.mid(acc, cur, t >> 4, wr, wc, fr_, fq_); } }
            const bool last = (t == nt - 2);
            const char* a1 = cA + (size_t)(t + 1) * kstep;
            const char* a2 = last ? nA : cA + (size_t)(t + 2) * kstep; const char* b2 = last ? nB : cB + (size_t)(t + 2) * kstep;
            const char* a3 = a2 + kstep; const char* b3 = b2 + kstep;
            if constexpr (F8) {
            PG8_LDB8(B80, 0, 0); PG8_LDB8(B81, 0, 1); PG8_SCHED; PG8_LDA8(A8, 0, 0); PG8_STAGE(PG8_SA(1, 1), a1 + hstepA, voffA);
            PG8_WAIT_V(8); PG8_WAIT_L(0); PG8_BAR; PG8_MMA8(0, 0, A8, B80); PG8_MMA8(0, 1, A8, B81); PG8_BAR; PG8_SCHED;
            PG8_LDA8(A8, 0, 1); PG8_STAGE(PG8_SB(0, 0), b2, voffB); PG8_STAGE(PG8_SB(0, 1), b2 + hstepB, voffB); PG8_STAGE(PG8_SA(0, 0), a2, voffA);
            PG8_WAIT_V(8); PG8_WAIT_L(0); PG8_BAR; PG8_MMA8(1, 0, A8, B80); PG8_MMA8(1, 1, A8, B81); PG8_BAR; PG8_SCHED;
            PG8_LDB8(B80, 1, 0); PG8_LDB8(B81, 1, 1); PG8_SCHED; PG8_LDA8(A8, 1, 0); PG8_STAGE(PG8_SA(0, 1), a2 + hstepA, voffA);
            PG8_WAIT_V(8); PG8_WAIT_L(0); PG8_BAR; PG8_MMA8(0, 0, A8, B80); PG8_MMA8(0, 1, A8, B81); PG8_BAR; PG8_SCHED;
            PG8_LDA8(A8, 1, 1); PG8_STAGE(PG8_SB(1, 0), b3, voffB); PG8_STAGE(PG8_SB(1, 1), b3 + hstepB, voffB); PG8_STAGE(PG8_SA(1, 0), a3, voffA);
            PG8_WAIT_V(8); PG8_WAIT_L(0); PG8_BAR; PG8_MMA8(1, 0, A8, B80); PG8_MMA8(1, 1, A8, B81); PG8_BAR; PG8_SCHED;
            } else {
            PG8_LDB(B0, 0, 0); PG8_LDB(B1, 0, 1); PG8_SCHED; PG8_LDA(At, 0, 0); PG8_STAGE(PG8_SA(1, 1), a1 + hstepA, voffA);
            PG8_WAIT_V(8); PG8_WAIT_L(0); PG8_BAR; PG8_MMA(0, 0, At, B0); PG8_MMA(0, 1, At, B1); PG8_BAR; PG8_SCHED;
            PG8_LDA(At, 0, 1); PG8_STAGE(PG8_SB(0, 0), b2, voffB); PG8_STAGE(PG8_SB(0, 1), b2 + hstepB, voffB); PG8_STAGE(PG8_SA(0, 0), a2, voffA);
            PG8_WAIT_V(8); PG8_WAIT_L(0); PG8_BAR; PG8_MMA(1, 0, At, B0); PG8_MMA(1, 1, At, B1); PG8_BAR; PG8_SCHED;
            PG8_LDB(B0, 1, 0); PG8_LDB(B1, 1, 1); PG8_SCHED; PG8_LDA(At, 1, 0); PG8_STAGE(PG8_SA(0, 1), a2 + hstepA, voffA);
            PG8_WAIT_V(8); PG8_WAIT_L(0); PG8_BAR; PG8_MMA(0, 0, At, B0); PG8_MMA(0, 1, At, B1); PG8_BAR; PG8_SCHED;
            PG8_LDA(At, 1, 1); PG8_STAGE(PG8_SB(1, 0), b3, voffB); PG8_STAGE(PG8_SB(1, 1), b3 + hstepB, voffB); PG8_STAGE(PG8_SA(1, 0), a3, voffA);
            PG8_WAIT_V(8); PG8_WAIT_L(0); PG8_BAR; PG8_MMA(1, 0, At, B0); PG8_MMA(1, 1, At, B1); PG8_BAR; PG8_SCHED;
            }
        }
        if (wr == 0) PG8_BAR;
        if constexpr (F8) asm volatile("s_nop 15\n\ts_nop 15" ::: "memory");
        { int fr_ = fr, fq_ = fq; asm volatile("" : "+v"(fr_), "+v"(fq_));
          E(acc, cur, wr, wc, fr_, fq_); }
        if (!has_next) break;
#pragma unroll
        for (int a = 0; a < 2; ++a)
#pragma unroll
            for (int b = 0; b < 2; ++b)
#pragma unroll
                for (int m = 0; m < 4; ++m)
#pragma unroll
                    for (int n = 0; n < 2; ++n) acc[a][b][m][n] = (f32x4){0.f, 0.f, 0.f, 0.f};
        cur = nxt; cA = nA; cB = nB; ++ui;
        if (wr == 1) PG8_BAR;
    }
    PG8_WAIT_V(0);
    PG8_BAR;
#undef PG8_SA
#undef PG8_SB
#undef PG8_STAGE
#undef PG8_LDA
#undef PG8_LDB
#undef PG8_MMA
#undef PG8_CAT
#undef PG8_LD8
#undef PG8_LDA8
#undef PG8_LDB8
#undef PG8_MMA8
#undef PG8_WAIT_V
#undef PG8_WAIT_L
#undef PG8_BAR
#undef PG8_SCHED
}
}

#define XB_TMO      128
#define XB_XCNT(j)  (256  + 64 * (j))
#define XB_XSUB(j)  (1280 + 64 * (j))
#define XB_XGEN(j)  (2304 + 64 * (j))
#define XB_TOP      3328
#define XB_TOPGEN   3392
#define XCD_BAR_WORDS 3456
#define XB_SPIN_CAP (1u << 22)
DI unsigned xb_ld(unsigned* p)              { return __hip_atomic_load(p, __ATOMIC_RELAXED, __HIP_MEMORY_SCOPE_AGENT); }
DI unsigned xb_add(unsigned* p, unsigned v) { return __hip_atomic_fetch_add(p, v, __ATOMIC_RELAXED, __HIP_MEMORY_SCOPE_AGENT); }
DI unsigned xb_xcc_id() { return (unsigned)__builtin_amdgcn_s_getreg((3 << 11) | 20) & 0xFu; }
#define XB_SPIN(cond, bar) do { unsigned _sp = 0; while (cond) { __builtin_amdgcn_s_sleep(1); \
    if ((++_sp & 255u) == 0u) { if (xb_ld(&(bar)[XB_TMO])) break; if (_sp > XB_SPIN_CAP) { atomicAdd(&(bar)[XB_TMO], 1u); break; } } } } while (0)
struct XcdBarrier { unsigned* bar; unsigned x; volatile LAS unsigned* st; };
DI XcdBarrier xcd_barrier_post(unsigned* bar, volatile LAS unsigned* st) {
    XcdBarrier b; b.bar = bar; b.x = xb_xcc_id(); b.st = st;
    if (threadIdx.x == 0) (void)xb_add(&bar[XB_XCNT(b.x)], 1u);
    return b;
}
DI void xcd_barrier_complete(unsigned* bar, unsigned x, unsigned& nloc, unsigned& nx) {
    const unsigned G = gridDim.x * gridDim.y * gridDim.z;
    unsigned sum, cnt, mine, sp = 0u;
    for (;;) {
        sum = 0u; cnt = 0u; mine = 0u;
#pragma unroll
        for (unsigned j = 0; j < 16; ++j) { const unsigned c = xb_ld(&bar[XB_XCNT(j)]); sum += c; cnt += (c > 0u) ? 1u : 0u; mine = (j == x) ? c : mine; }
        if (sum == G) break;
        __builtin_amdgcn_s_sleep(1);
        if ((++sp & 255u) == 0u) { if (xb_ld(&bar[XB_TMO])) break; if (sp > XB_SPIN_CAP) { atomicAdd(&bar[XB_TMO], 1u); break; } }
    }
    nloc = mine > 0u ? mine : 1u; nx = cnt > 0u ? cnt : 1u;
}
DI void xcd_barrier(const XcdBarrier& b) {
    asm volatile("s_waitcnt vmcnt(0)" ::: "memory");
    __syncthreads();
    if (threadIdx.x == 0) {
        unsigned* bar = b.bar;
        __builtin_amdgcn_s_waitcnt(0);
        unsigned nloc = b.st[0], nx = b.st[1];
        if (nloc == 0u) { xcd_barrier_complete(bar, b.x, nloc, nx); b.st[0] = nloc; b.st[1] = nx; }
        const unsigned old = xb_add(&bar[XB_XSUB(b.x)], 1u);
        const unsigned gen = old / nloc;
        if (old + 1u == (gen + 1u) * nloc) {
            __builtin_amdgcn_fence(__ATOMIC_RELEASE, "agent");
            asm volatile("s_waitcnt vmcnt(0)" ::: "memory");
            const unsigned og = xb_add(&bar[XB_TOP], 1u);
            const unsigned tg = og / nx;
            if (og + 1u == (tg + 1u) * nx) xb_add(&bar[XB_TOPGEN], 1u);
            else XB_SPIN(xb_ld(&bar[XB_TOPGEN]) == tg, bar);
            __builtin_amdgcn_fence(__ATOMIC_ACQUIRE, "agent");
            xb_add(&bar[XB_XGEN(b.x)], 1u);
            asm volatile("s_waitcnt vmcnt(0)" ::: "memory");
        } else {
            XB_SPIN(xb_ld(&bar[XB_XGEN(b.x)]) == gen, bar);
            __builtin_amdgcn_fence(__ATOMIC_ACQUIRE, "agent");
            asm volatile("s_waitcnt vmcnt(0)" ::: "memory");
        }
    }
    __syncthreads();
}

DI void transpose_item(const float* W, int ldw, bf16* WT, int ldt, LAS float* scr, int lane) {
    { const int kr = lane >> 3, c4 = (lane & 7) * 4; f32x4 v[8];
#pragma unroll
        for (int i = 0; i < 8; ++i) v[i] = *(const f32x4*)(W + (size_t)(8 * i + kr) * ldw + c4);
#pragma unroll
        for (int i = 0; i < 8; ++i) { LAS float* o = scr + (8 * i + kr) * 33 + c4; o[0] = v[i].x; o[1] = v[i].y; o[2] = v[i].z; o[3] = v[i].w; } }
    LDS_WAIT(); asm volatile("" ::: "memory");
    const int c = lane & 7;
#pragma unroll
    for (int j = 0; j < 4; ++j) { const int n = (lane >> 3) + 8 * j; const LAS float* s = scr + (8 * c) * 33 + n;
        u32x4 o; o.x = pk2(s[0 * 33], s[1 * 33]); o.y = pk2(s[2 * 33], s[3 * 33]); o.z = pk2(s[4 * 33], s[5 * 33]); o.w = pk2(s[6 * 33], s[7 * 33]);
        *(u32x4*)(WT + (size_t)n * ldt + 8 * c) = o; }
    LDS_WAIT(); asm volatile("" ::: "memory");
}
DI void transpose_item_f8(const float* W, int ldw, unsigned char* WT, int ldt, float scale, LAS float* scr, int lane) {
    { const int kr = lane >> 3, c4 = (lane & 7) * 4; f32x4 v[8];
#pragma unroll
        for (int i = 0; i < 8; ++i) v[i] = *(const f32x4*)(W + (size_t)(8 * i + kr) * ldw + c4);
#pragma unroll
        for (int i = 0; i < 8; ++i) { LAS float* o = scr + (8 * i + kr) * 33 + c4; o[0] = v[i].x; o[1] = v[i].y; o[2] = v[i].z; o[3] = v[i].w; } }
    LDS_WAIT(); asm volatile("" ::: "memory");
    const int c = lane & 3;
#pragma unroll
    for (int j = 0; j < 2; ++j) { const int n = (lane >> 2) + 16 * j; const LAS float* s = scr + (16 * c) * 33 + n;
        u32x4 o; o.x = pk4_f8(s[0 * 33] * scale, s[1 * 33] * scale, s[2 * 33] * scale, s[3 * 33] * scale); o.y = pk4_f8(s[4 * 33] * scale, s[5 * 33] * scale, s[6 * 33] * scale, s[7 * 33] * scale);
        o.z = pk4_f8(s[8 * 33] * scale, s[9 * 33] * scale, s[10 * 33] * scale, s[11 * 33] * scale); o.w = pk4_f8(s[12 * 33] * scale, s[13 * 33] * scale, s[14 * 33] * scale, s[15 * 33] * scale);
        *(u32x4*)(WT + (size_t)n * ldt + 16 * c) = o; }
    LDS_WAIT(); asm volatile("" ::: "memory");
}
DI void ln16(f32x4 (&v)[4], const f32x4 (&g)[4], const f32x4 (&b)[4]) {
    float s = 0.f;
#pragma unroll
    for (int j = 0; j < 4; ++j) s += (v[j].x + v[j].y) + (v[j].z + v[j].w);
    const float mean = wave_sum(s) * (1.f / D); float s2 = 0.f;
#pragma unroll
    for (int j = 0; j < 4; ++j) { v[j] = v[j] - mean; s2 += (v[j].x * v[j].x + v[j].y * v[j].y) + (v[j].z * v[j].z + v[j].w * v[j].w); }
    const float rstd = 1.f / sqrtf(wave_sum(s2) * (1.f / D) + LN_EPS);
#pragma unroll
    for (int j = 0; j < 4; ++j) v[j] = v[j] * rstd * g[j] + b[j];
}
DI void gates8(const f32x4 (&y)[4], const LAS float* wgt, float* gif_row, int lane) {
    float p[8];
#pragma unroll
    for (int j = 0; j < 8; ++j) { float s = 0.f;
#pragma unroll
        for (int jj = 0; jj < 4; ++jj) { const f32x4 w = *(const LAS f32x4*)(wgt + j * 1024 + 256 * jj + 4 * lane); s += (y[jj].x * w.x + y[jj].y * w.y) + (y[jj].z * w.z + y[jj].w * w.w); }
        p[j] = wave_sum(s); }
    if (lane == 0) { *(f32x4*)gif_row = (f32x4){p[0], p[1], p[2], p[3]}; *(f32x4*)(gif_row + 4) = (f32x4){p[4], p[5], p[6], p[7]}; }
}
DI void gates8b(const f32x4 (&y)[4], const LAS float* wgt, float* gif_row, int lane) {
    float p[8];
#pragma unroll
    for (int j = 0; j < 8; ++j) { float s = 0.f;
#pragma unroll
        for (int jj = 0; jj < 4; ++jj) { const f32x4 w = *(const LAS f32x4*)(wgt + j * 1024 + (jj >> 1) * 512 + 8 * lane + (jj & 1) * 4); s += (y[jj].x * w.x + y[jj].y * w.y) + (y[jj].z * w.z + y[jj].w * w.w); }
        p[j] = wave_sum(s); }
    if (lane == 0) { *(f32x4*)gif_row = (f32x4){p[0], p[1], p[2], p[3]}; *(f32x4*)(gif_row + 4) = (f32x4){p[4], p[5], p[6], p[7]}; }
}
DI void load_gate_table(LAS float* wgt, const float* win_l, int tid) {
    for (int i = tid; i < 8192; i += NTHR) { const int k = i >> 3, j = i & 7; wgt[j * 1024 + k] = win_l[(size_t)k * DIN + 1536 + j]; }
}
DI f32x4 ld4bf(const char* p) { const u32x2 w = *(const u32x2*)p; return (f32x4){bflo(w.x), bfhi(w.x), bflo(w.y), bfhi(w.y)}; }
DI void st4bf(char* p, const f32x4& v) { u32x2 w; w.x = pk2(v.x, v.y); w.y = pk2(v.z, v.w); *(u32x2*)p = w; }

struct Args { const float* in[N_IN]; float* out; unsigned char* ws; int ph_lo, ph_hi; };
constexpr int NP_LAYER = 12, NPH = 1 + DEPTH * NP_LAYER;
constexpr int XW_SPLIT = 49152;

struct SchedInproj {
    pg8::TileOrder T; int G, c; const char *X, *W; char* U; bool kv; const char *MEMN, *WKV; char* KV;
    DI bool next(int i, pg8::Unit& u) const {
        const long L = (long)i * G + c; int pm, pn;
        if (T.tile(L, pm, pn)) { u.a = X + (size_t)pm * 256 * D * 2; u.b = W + (size_t)pn * 256 * D * 2; u.r0 = pm * 256; u.c0 = pn * 256; u.c = U + ((size_t)u.r0 * NU + u.c0) * 2; u.ldc = NU; u.e = 0; u.sub = 0; return true; }
        if (!kv) return false;
        const long L2 = L - T.nwg; if (L2 < 0 || L2 >= 128) return false;
        const int l = (int)L2 >> 6, t = (int)L2 & 63; pm = t >> 2; pn = t & 3;
        u.a = MEMN + (size_t)pm * 256 * D * 2; u.b = WKV + ((size_t)l * 1024 + pn * 256) * D * 2; u.r0 = pm * 256; u.c0 = pn * 256; u.c = KV + (((size_t)l * MROWS + u.r0) * D + u.c0) * 2; u.ldc = D; u.e = 0; u.sub = 0; return true;
    }
};
struct SchedPlain {
    pg8::TileOrder T; int G, c; const char *A, *B; char* C; int lda, ldb, ldc;
    DI bool next(int i, pg8::Unit& u) const {
        const long L = (long)i * G + c; int pm, pn; if (!T.tile(L, pm, pn)) return false;
        u.a = A + (size_t)pm * 256 * lda * 2; u.b = B + (size_t)pn * 256 * ldb * 2; u.r0 = pm * 256; u.c0 = pn * 256; u.c = C + ((size_t)u.r0 * ldc + u.c0) * 2; u.ldc = ldc; u.e = 0; u.sub = 0; return true;
    }
};
struct SchedMerge {
    pg8::TileOrder T; int G, c; const char *H, *W; char* Y;
    DI bool next(int i, pg8::Unit& u) const {
        const int ti = i / 3, br = i - 3 * ti; const long L = (long)ti * G + c; int pm, pn; if (!T.tile(L, pm, pn)) return false;
        u.a = H + ((size_t)pm * 256 * 1536 + br * 512) * 2; u.b = W + ((size_t)br * 1024 + pn * 256) * 512 * 2; u.r0 = pm * 256; u.c0 = pn * 256; u.c = Y + ((size_t)u.r0 * D + u.c0) * 2; u.ldc = D; u.e = 0; u.sub = br; return true;
    }
};
struct SchedMoe {
    pg8::TileOrder T; int G, c; const char *A, *W; char* C; const LAS int* PB; int wrows  , ldc, cdiv, osz;
    DI bool next(int i, pg8::Unit& u) const {
        const long L = (long)i * G + c; int pm, pn; if (!T.tile(L, pm, pn)) return false;
        int e = 0;
#pragma unroll 1
        for (int j = 1; j < NEXP; ++j) e += (PB[j] <= pm) ? 1 : 0;
        u.a = A + (size_t)pm * 256 * 1024; u.b = W + ((size_t)e * wrows + pn * 256) * 1024; u.r0 = pm * 256; u.c0 = pn * 256; u.c = C + ((size_t)u.r0 * ldc + u.c0 / cdiv) * osz; u.ldc = ldc; u.e = e; u.sub = 0; return true;
    }
};

__global__ void __launch_bounds__(NTHR, 2) fwd_kernel(Args args) {
    extern __shared__ __attribute__((aligned(16))) unsigned char lds_raw[];
#define INP(i) ([&]() -> const float* { int ii_ = (i); asm volatile("" : "+s"(ii_)); return args.in[ii_]; }())
    LAS unsigned char* lds = (LAS unsigned char*)lds_raw;
    volatile LAS unsigned* LCTL = (volatile LAS unsigned*)(lds + LDSCTL_OFF);
    const int tid0 = threadIdx.x, wave = __builtin_amdgcn_readfirstlane(tid0 >> 6);
#define PHASE_TID unsigned z_ = 0u; asm volatile("" : "+v"(z_)); int tid = wave * 64 + (int)__builtin_amdgcn_mbcnt_hi(~0u, __builtin_amdgcn_mbcnt_lo(~0u, z_)); const int lane = tid & 63; (void)lane;
    const int G = gridDim.x, bx = blockIdx.x;
    const int gw = bx * NWAVES + wave, NGW = G * NWAVES;
    unsigned char* ws = args.ws;
    gu32* ctl = (gu32*)(ws + WS_CTL);
    for (int u = tid0; u < (LDS_BYTES - LDSCTL_OFF) / 4; u += NTHR) ((LAS unsigned*)(lds + LDSCTL_OFF))[u] = 0u;
    __syncthreads();
    XcdBarrier bar; bar.bar = (unsigned*)ctl + CW_BAR; bar.x = 0; bar.st = nullptr;
    if (MK_ONE_LAUNCH) bar = xcd_barrier_post((unsigned*)ctl + CW_BAR, LCTL);
    const int lo = args.ph_lo, hi = args.ph_hi;
#ifndef SUBMASK
#define SUBMASK 7
#endif
#ifndef LN2PROBE
#define LN2PROBE 0
#endif
#ifndef SUBDUP
#define SUBDUP 0
#endif
#define NSUB(k) ((((SUBDUP) >> (k)) & 1) ? 2 : 1)
#ifndef DUPMASK
#define DUPMASK 0
#endif
#define NREP(k) ((((DUPMASK) >> (k)) & 1) ? 2 : 1)
#ifndef PHMASK
#define PHMASK 0xFFFF
#endif
#define IN(k) (lo <= (k) && (k) < hi)
#define SEAM(k) do { if (IN(k) && IN((k) + 1)) xcd_barrier(bar); } while (0)

    char* const Xb = (char*)(ws + WS_X);
    char* const Ub = (char*)(ws + WS_R1);
    float* const GIF = (float*)(ws + WS_GIF);
    LAS int* const PB = (LAS int*)(lds + LDSCTL_OFF + 64);
    LAS int* const CNT = (LAS int*)(lds + LDSCTL_OFF + 256);

    _Pragma("unroll 1") for (int rep_ = 0; rep_ < NREP(12); ++rep_) if (((PHMASK>>12)&1) && IN(0)) { PHASE_TID
        LAS float* scr = (LAS float*)(lds + wave * 8448);
        LAS float* wgt = (LAS float*)(lds + 73728);
        load_gate_table(wgt, INP(I_WIN), tid);
        constexpr int IT_IN = 16 * 216, IT_KV = 16 * 32, IT_BR = 8 * 32, IT_O = 16 * 32, IT_L = IT_IN + IT_KV + 3 * IT_BR + IT_O;
        for (int it = gw; it < DEPTH * IT_L; it += NGW) {
            const int l = it / IT_L; int r = it - l * IT_L;
            if (r < IT_IN) { const int kb = r / 216, nb = r % 216, n0 = 32 * nb, sc = ucol_src(n0);
                if (n0 < UC_F8) transpose_item(INP(I_WIN) + ((size_t)l * D + 64 * kb) * DIN + sc, DIN, (bf16*)(ws + WS_WIN) + ((size_t)l * NU + n0) * D + 64 * kb, D, scr, lane);
                else transpose_item_f8(INP(I_WIN) + ((size_t)l * D + 64 * kb) * DIN + sc, DIN, (unsigned char*)(ws + WS_WING8) + ((size_t)l * NF8 + (n0 - UC_F8)) * D + 64 * kb, D, F8_SWGU, scr, lane);
                continue; }
            r -= IT_IN;
            if (r < IT_KV) { const int kb = r / 32, nb = r % 32;
                transpose_item(INP(I_CAWKV) + ((size_t)l * D + 64 * kb) * 1024 + 32 * nb, 1024, (bf16*)(ws + WS_WKV) + ((size_t)l * 1024 + 32 * nb) * D + 64 * kb, D, scr, lane); continue; }
            r -= IT_KV;
            if (r < 3 * IT_BR) { const int br = r / IT_BR, q = r % IT_BR, kb = q / 32, nb = q % 32;
                const float* src = INP(br == 0 ? I_WBRML : (br == 1 ? I_WBRRW : I_WBRCA));
                transpose_item(src + ((size_t)l * 512 + 64 * kb) * 1024 + 32 * nb, 1024, (bf16*)(ws + WS_WBR) + ((size_t)l * 1024 + 32 * nb) * 1536 + br * 512 + 64 * kb, 1536, scr, lane); continue; }
            r -= 3 * IT_BR;
            { const int kb = r / 32, nb = r % 32;
                transpose_item(INP(I_WO) + ((size_t)l * D + 64 * kb) * 1024 + 32 * nb, 1024, (bf16*)(ws + WS_WO) + ((size_t)l * 1024 + 32 * nb) * D + 64 * kb, D, scr, lane); }
        }
        for (int i = bx * NTHR + tid; i < DEPTH * 1536 * 256; i += G * NTHR) {
            const int l = i / (1536 * 256), r = i % (1536 * 256), n = r >> 8, k = r & 255; float v = 0.f;
            if (n < 512) { if (k < 64) v = INP(I_RWWUP)[((size_t)l * 64 + k) * 512 + n]; }
            else if (n < 1024) { if (k >= 64 && k < 128) v = INP(I_RWAUP)[((size_t)l * 64 + (k - 64)) * 512 + (n - 512)]; }
            else { if (k >= 128) v = INP(I_RWGUP)[((size_t)l * 128 + (k - 128)) * 512 + (n - 1024)]; }
            ((bf16*)(ws + WS_WLORA))[i] = (bf16)f2bf(v);
        }
        __syncthreads();
        {
            f32x4 g[4], b[4];
#pragma unroll
            for (int j = 0; j < 4; ++j) { g[j] = *(const f32x4*)(INP(I_LNIN_G) + 256 * j + 4 * lane); b[j] = *(const f32x4*)(INP(I_LNIN_B) + 256 * j + 4 * lane); }
            for (int m = gw; m < M; m += NGW) {
                f32x4 v[4]; const float* xr = INP(I_X) + (size_t)m * D;
#pragma unroll
                for (int j = 0; j < 4; ++j) v[j] = *(const f32x4*)(xr + 256 * j + 4 * lane);
                ln16(v, g, b);
#pragma unroll
                for (int j = 0; j < 4; ++j) { st4bf(Xb + ((size_t)m * D + 256 * j + 4 * lane) * 2, v[j]); *(unsigned*)((char*)(ws + WS_XF8) + (size_t)m * D + 256 * j + 4 * lane) = pk4_f8(v[j].x * F8_SX, v[j].y * F8_SX, v[j].z * F8_SX, v[j].w * F8_SX); }
                gates8(v, wgt, GIF + (size_t)m * 8, lane);
            }
#pragma unroll
            for (int j = 0; j < 4; ++j) { g[j] = *(const f32x4*)(INP(I_MEMLN_G) + 256 * j + 4 * lane); b[j] = *(const f32x4*)(INP(I_MEMLN_B) + 256 * j + 4 * lane); }
            for (int m = gw; m < MROWS; m += NGW) {
                f32x4 v[4]; const float* xr = INP(I_MEM) + (size_t)m * D;
#pragma unroll
                for (int j = 0; j < 4; ++j) v[j] = *(const f32x4*)(xr + 256 * j + 4 * lane);
                ln16(v, g, b);
#pragma unroll
                for (int j = 0; j < 4; ++j) st4bf((char*)(ws + WS_MEMN) + ((size_t)m * D + 256 * j + 4 * lane) * 2, v[j]);
            }
        }
        __syncthreads();
    }
    SEAM(0);

#pragma unroll 1
    for (int l = 0; l < DEPTH; ++l) {
        const int pb = 1 + l * NP_LAYER;
        _Pragma("unroll 1") for (int rep_ = 0; rep_ < NREP(0); ++rep_) if (((PHMASK>>0)&1) && IN(pb + 0)) {
            SchedInproj S; S.T.init(M / 256, UC_F8 / 256); S.G = G; S.c = bx; S.X = Xb; S.W = (const char*)(ws + WS_WIN) + (size_t)l * NU * D * 2; S.U = Ub;
            S.kv = (l == 0); S.MEMN = (const char*)(ws + WS_MEMN); S.WKV = (const char*)(ws + WS_WKV); S.KV = (char*)(ws + WS_KV);
            pg8::EpiStore E;
            pg8::gemm_phase<false>(lds, D * 2, D * 2, D * 2, S, E, wave);
            SchedPlain S8; S8.T.init(M / 256, NF8 / 256); S8.G = G; S8.c = bx; S8.A = (const char*)(ws + WS_XF8); S8.B = (const char*)(ws + WS_WING8) + (size_t)l * NF8 * D; S8.C = Ub + UC_F8 * 2;
            S8.lda = 512; S8.ldb = 512; S8.ldc = NU;
            pg8::EpiStoreS E8; E8.s = F8_INV1;
            pg8::gemm_phase<true>(lds, D, D, D, S8, E8, wave);
        }
        SEAM(pb + 0);
        _Pragma("unroll 1") for (int rep_ = 0; rep_ < NREP(1); ++rep_) if (((PHMASK>>1)&1) && IN(pb + 1)) { PHASE_TID
            const float* mu = INP(I_RWMU) + (size_t)l * 1792 + 1536;
            char* LIN = (char*)(ws + WS_R2 + R2_LORA_IN);
            for (int it = bx * NTHR + tid; it < M * 32; it += G * NTHR) {
                const int row = it >> 5, c = (it & 31) * 8;
                const u32x4 cw = *(const u32x4*)(Ub + ((size_t)row * NU + UC_RW + 1536 + c) * 2);
                u32x4 pw = (u32x4){0u, 0u, 0u, 0u};
                if ((row & (SEQ - 1)) != 0) pw = *(const u32x4*)(Ub + ((size_t)(row - 1) * NU + UC_RW + 1536 + c) * 2);
                const f32x4 m0 = *(const f32x4*)(mu + c), m1 = *(const f32x4*)(mu + c + 4);
                float x[8] = {bflo(cw.x), bfhi(cw.x), bflo(cw.y), bfhi(cw.y), bflo(cw.z), bfhi(cw.z), bflo(cw.w), bfhi(cw.w)};
                const float p[8] = {bflo(pw.x), bfhi(pw.x), bflo(pw.y), bfhi(pw.y), bflo(pw.z), bfhi(pw.z), bflo(pw.w), bfhi(pw.w)};
                const float mm[8] = {m0.x, m0.y, m0.z, m0.w, m1.x, m1.y, m1.z, m1.w};
#pragma unroll
                for (int i = 0; i < 8; ++i) { float xs = x[i] + (p[i] - x[i]) * mm[i];
                    if (c < 64) xs = 1.f - 2.f * __builtin_amdgcn_rcpf(1.f + __builtin_amdgcn_exp2f(2.8853900817779268f * xs));
                    else if (c >= 128) xs = sigmoidf_(xs);
                    x[i] = xs; }
                u32x4 o; o.x = pk2(x[0], x[1]); o.y = pk2(x[2], x[3]); o.z = pk2(x[4], x[5]); o.w = pk2(x[6], x[7]);
                *(u32x4*)(LIN + ((size_t)row * 256 + c) * 2) = o;
            }
        }
        SEAM(pb + 1);
        _Pragma("unroll 1") for (int rep_ = 0; rep_ < NREP(2); ++rep_) if (((PHMASK>>2)&1) && IN(pb + 2)) {
            SchedPlain S; S.T.init(M / 256, 6); S.G = G; S.c = bx; S.A = (const char*)(ws + WS_R2 + R2_LORA_IN); S.B = (const char*)(ws + WS_WLORA) + (size_t)l * 1536 * 256 * 2; S.C = (char*)(ws + WS_R2 + R2_LORA_OUT);
            S.lda = 256; S.ldb = 256; S.ldc = 1536;
            pg8::EpiStore E;
            pg8::gemm_phase<false>(lds, 512, 512, 512, S, E, wave);
        }
        SEAM(pb + 2);
        _Pragma("unroll 1") for (int rep_ = 0; rep_ < NREP(3); ++rep_) if (((PHMASK>>3)&1) && IN(pb + 3)) { PHASE_TID
            const char* LO = (const char*)(ws + WS_R2 + R2_LORA_OUT);
            char* HC = (char*)(ws + WS_R2 + R2_HCAT);
            const int tid_ph = tid;
#define SUB_TID unsigned zs_ = 0u; asm volatile("" : "+v"(zs_)); int tid = wave * 64 + (int)__builtin_amdgcn_mbcnt_hi(~0u, __builtin_amdgcn_mbcnt_lo(~0u, zs_)); const int lane = tid & 63; (void)lane;
#pragma unroll 1
            for (int job = bx; job < 256; job += G) {
                if (job < 128) { _Pragma("unroll 1") for (int sr_ = 0; sr_ < NSUB(0); ++sr_) if ((SUBMASK>>0)&1) {
                    SUB_TID
                    const int b = job >> 3, h = job & 7;
                    constexpr int TC = 32, PT = 144, P16 = 48, IMG = 25856;
                    LAS float* OPS = (LAS float*)lds;
                    LAS float* OUTB = OPS + TC * 384;
                    LAS float* BON = OUTB + TC * 64;
                    LAS unsigned char* IM0 = lds + 57600;
                    const int pt = tid >> 4, cs = tid & 15, pc = cs * 4, hc = h * 64 + pc;
                    const int r31 = lane & 31, h2 = lane >> 5;
                    f32x16 Sreg[2];
#pragma unroll
                    for (int i = 0; i < 16; ++i) { Sreg[0][i] = 0.f; Sreg[1][i] = 0.f; }
                    u32x2 pu[9];
                    auto LOADC = [&](int t0) {
                        const int t = t0 + pt; const size_t row = (size_t)b * SEQ + t; const char* up = Ub + (row * NU + UC_RW + hc) * 2;
                        pu[0] = *(const u32x2*)up; pu[1] = *(const u32x2*)(up + 1024); pu[2] = *(const u32x2*)(up + 2048);
                        if (t > 0) { const char* pp = up - (size_t)NU * 2; pu[3] = *(const u32x2*)pp; pu[4] = *(const u32x2*)(pp + 1024); pu[5] = *(const u32x2*)(pp + 2048); }
                        else { pu[3] = (u32x2){0u, 0u}; pu[4] = pu[3]; pu[5] = pu[3]; }
                        const char* lp = LO + (row * 1536 + hc) * 2; pu[6] = *(const u32x2*)lp; pu[7] = *(const u32x2*)(lp + 1024); pu[8] = *(const u32x2*)(lp + 2048);
                    };
#define UNP4(w) ((f32x4){bflo((w).x), bfhi((w).x), bflo((w).y), bfhi((w).y)})
#define DOT4(a, b) (((a).x * (b).x + (a).y * (b).y) + ((a).z * (b).z + (a).w * (b).w))
#define PACK8(x, s) __builtin_bit_cast(bf16x8, (u32x4){pk2((x)[8 * (s)], (x)[8 * (s) + 1]), pk2((x)[8 * (s) + 2], (x)[8 * (s) + 3]), pk2((x)[8 * (s) + 4], (x)[8 * (s) + 5]), pk2((x)[8 * (s) + 6], (x)[8 * (s) + 7])})
#define LD2x64(p) __builtin_bit_cast(bf16x8, (u32x4){(*(const LAS u32x2*)(p)).x, (*(const LAS u32x2*)(p)).y, (*(const LAS u32x2*)((p) + 16)).x, (*(const LAS u32x2*)((p) + 16)).y})
                    LOADC(0);
#pragma unroll 1
                    for (int t0 = 0; t0 < SEQ; t0 += TC) {
                        f32x4 gk;
                        {
                            int hcv = hc; asm volatile("" : "+v"(hcv));
                            const f32x4 mu_r = *(const f32x4*)(INP(I_RWMU) + (size_t)l * 1792 + hcv), mu_k = *(const f32x4*)(INP(I_RWMU) + (size_t)l * 1792 + 512 + hcv), mu_v = *(const f32x4*)(INP(I_RWMU) + (size_t)l * 1792 + 1024 + hcv);
                            const f32x4 w0 = *(const f32x4*)(INP(I_RWW0) + l * 512 + hcv), a0 = *(const f32x4*)(INP(I_RWA0) + l * 512 + hcv), kkw = *(const f32x4*)(INP(I_RWKK) + l * 512 + hcv);
                            const f32x4 kaw = *(const f32x4*)(INP(I_RWKA) + l * 512 + hcv), rkw = *(const f32x4*)(INP(I_RWRK) + l * 512 + hcv);
                            const f32x4 ur = UNP4(pu[0]), uk = UNP4(pu[1]), uv = UNP4(pu[2]), urp = UNP4(pu[3]), ukp = UNP4(pu[4]), uvp = UNP4(pu[5]), lw = UNP4(pu[6]), la = UNP4(pu[7]);
                            gk = UNP4(pu[8]);
                            const f32x4 xr = ur + (urp - ur) * mu_r, xk = uk + (ukp - uk) * mu_k, xv = uv + (uvp - uv) * mu_v;
                            f32x4 dec, av, kkv, kp; float ss = 0.f, bsum = 0.f;
#pragma unroll
                            for (int i = 0; i < 4; ++i) {
                                const float y = -(w0[i] + lw[i]);
                                const float sp = fmaxf(y, 0.f) + __logf(1.f + __expf(-fabsf(y)));
                                dec[i] = __expf(-__expf(-sp - 0.5f));
                                av[i] = sigmoidf_(a0[i] + la[i]);
                                kkv[i] = xk[i] * kkw[i]; ss += kkv[i] * kkv[i];
                                kp[i] = xk[i] * (1.f + (av[i] - 1.f) * kaw[i]);
                                bsum += xr[i] * kp[i] * rkw[i];
                            }
                            ss = red16(ss); bsum = red16(bsum);
                            const float inv = __builtin_amdgcn_rsqf(fmaxf(ss, 1e-24f));
                            const f32x4 kk = kkv * inv, kka = kk * av;
                            LAS float* o = OPS + pt * 384 + pc;
                            *(LAS f32x4*)(o) = dec; *(LAS f32x4*)(o + 64) = kk; *(LAS f32x4*)(o + 128) = kka; *(LAS f32x4*)(o + 192) = kp; *(LAS f32x4*)(o + 256) = xr; *(LAS f32x4*)(o + 320) = xv;
                            if (cs == 0) BON[pt] = bsum;
                        }
                        if (t0 + TC < SEQ) LOADC(t0 + TC);
                        __syncthreads();
                        {
                            const int sc = wave >> 2, wq = wave & 3;
                            LAS unsigned char* im = IM0 + sc * IMG;
                            LAS unsigned char* KR = im; LAS unsigned char* BGr = im + 4608; LAS unsigned char* VT = im + 15360;
                            LAS unsigned char* TT = im + 18432; LAS unsigned char* BB = im + 19968; LAS float* ZF = (LAS float*)(im + 21504); LAS float* PL = (LAS float*)(im + 25600);
                            {
                                float P = 1.f;
#pragma unroll 1
                                for (int t = 0; t < 4 * wq; ++t) P *= OPS[(16 * sc + t) * 384 + lane];
#pragma unroll
                                for (int q = 0; q < 4; ++q) { const int t = 4 * wq + q; const LAS float* o = OPS + (16 * sc + t) * 384 + lane;
                                    const float w = o[0], z = o[64], bb = o[128], kp = o[192], rr = o[256], vv = o[320];
                                    const float kap = z * P; P *= w; const float rho = rr * P, ip = __builtin_amdgcn_rcpf(P), bet = bb * ip, gam = kp * ip;
                                    *(LAS bf16*)(KR + t * PT + lane * 2) = (bf16)f2bf(kap); *(LAS bf16*)(KR + (16 + t) * PT + lane * 2) = (bf16)f2bf(rho);
                                    *(LAS bf16*)(BGr + t * PT + lane * 2) = (bf16)f2bf(bet); *(LAS bf16*)(BGr + (16 + t) * PT + lane * 2) = (bf16)f2bf(gam);
                                    *(LAS bf16*)(VT + t * PT + lane * 2) = (bf16)f2bf(vv); }
                                if (wq == 3) PL[lane] = P;
                            }
                            __syncthreads();
                            if (wq == 0) {
                                f32x16 Z;
#pragma unroll
                                for (int i = 0; i < 16; ++i) Z[i] = 0.f;
#pragma unroll
                                for (int ks = 0; ks < 4; ++ks) Z = __builtin_amdgcn_mfma_f32_32x32x16_bf16(*(const LAS bf16x8*)(KR + r31 * PT + (16 * ks + 8 * h2) * 2), *(const LAS bf16x8*)(BGr + r31 * PT + (16 * ks + 8 * h2) * 2), Z, 0, 0, 0);
                                const int cp = (r31 < 16) ? (4 * (r31 & 3) + (r31 >> 2)) : r31;
#pragma unroll
                                for (int i = 0; i < 16; ++i) ZF[((i & 3) + 8 * (i >> 2) + 4 * h2) * 32 + cp] = Z[i];
                            }
                            __syncthreads();
                            if (wq == 0) {
                                const int c = lane >> 2, jq = lane & 3; float tq[4] = {0.f, 0.f, 0.f, 0.f};
                                f32x4 an = *(const LAS f32x4*)(ZF + 1 * 32 + 4 * jq);
#pragma unroll
                                for (int t = 0; t < 16; ++t) {
                                    const f32x4 ar = an; if (t >= 1 && t < 15) an = *(const LAS f32x4*)(ZF + (t + 1) * 32 + 4 * jq);
                                    float s = 0.f;
#pragma unroll
                                    for (int m = 0; m < 4; ++m) if (4 * m < t) s += ((4 * m + jq < t) ? ar[m] : 0.f) * tq[m];
                                    s = red4(s);
                                    const float val = ((t == c) ? 1.f : 0.f) - s;
                                    tq[t >> 2] = (jq == (t & 3)) ? val : tq[t >> 2];
                                }
#pragma unroll
                                for (int m = 0; m < 4; ++m) *(LAS bf16*)(TT + (4 * m + jq) * P16 + c * 2) = (bf16)f2bf(-tq[m]);
                                an = *(const LAS f32x4*)(ZF + 16 * 32 + 4 * jq);
#pragma unroll
                                for (int t = 0; t < 16; ++t) {
                                    const f32x4 ar = an; if (t < 15) an = *(const LAS f32x4*)(ZF + (17 + t) * 32 + 4 * jq);
                                    float s = 0.f;
#pragma unroll
                                    for (int m = 0; m < 4; ++m) if (4 * m <= t) s += ((4 * m + jq <= t) ? ar[m] : 0.f) * tq[m];
                                    s = red4(s);
                                    if (jq == 0) *(LAS bf16*)(TT + (16 + t) * P16 + c * 2) = (bf16)f2bf(-s);
                                }
                            } else if (wq == 1) {
                                const int row = lane >> 1, c0 = 8 * (lane & 1), tt = row & 15; const bool rho_row = row >= 16; float bv[8];
#pragma unroll
                                for (int j = 0; j < 8; ++j) { const int jj = c0 + j; const float zv = ZF[row * 32 + 16 + jj]; bv[j] = (rho_row ? (jj <= tt) : (jj < tt)) ? zv : 0.f; }
                                *(LAS u32x4*)(BB + row * P16 + c0 * 2) = (u32x4){pk2(bv[0], bv[1]), pk2(bv[2], bv[3]), pk2(bv[4], bv[5]), pk2(bv[6], bv[7])};
                            }
                        }
                        __syncthreads();
                        if (wave < 2) {
#pragma unroll 1
                            for (int sc = 0; sc < 2; ++sc) {
                                const LAS unsigned char* im = IM0 + sc * IMG;
                                const LAS unsigned char* KR = im; const LAS unsigned char* BT = im + 9216; const LAS unsigned char* GT = im + 12288; const LAS unsigned char* VT = im + 15360;
                                const LAS unsigned char* TT = im + 18432; const LAS unsigned char* BB = im + 19968; const LAS float* PL = (const LAS float*)(im + 25600);
                                const LAS unsigned char* BGr = im + 4608;
                                const bf16x8 vfr = trd8(VT, PT, 8 * h2, 8 * h2 + 4, 32 * wave, lane);
                                f32x16 t1;
#pragma unroll
                                for (int i = 0; i < 16; ++i) t1[i] = 0.f;
                                t1 = __builtin_amdgcn_mfma_f32_32x32x16_bf16(*(const LAS bf16x8*)(BB + r31 * P16 + 8 * h2 * 2), vfr, t1, 0, 0, 0);
#pragma unroll
                                for (int kb = 0; kb < 2; ++kb)
#pragma unroll
                                    for (int s = 0; s < 2; ++s) t1 = __builtin_amdgcn_mfma_f32_32x32x16_bf16(LD2x64(KR + r31 * PT + (32 * kb + 16 * s + 4 * h2) * 2), PACK8(Sreg[kb], s), t1, 0, 0, 0);
                                f32x16 t2;
#pragma unroll
                                for (int i = 0; i < 16; ++i) t2[i] = 0.f;
                                t2 = __builtin_amdgcn_mfma_f32_32x32x16_bf16(LD2x64(TT + r31 * P16 + (4 * h2) * 2), PACK8(t1, 0), t2, 0, 0, 0);
#pragma unroll
                                for (int i = 8; i < 16; ++i) OUTB[(16 * sc + (i & 3) + 8 * ((i >> 2) - 2) + 4 * h2) * 64 + 32 * wave + r31] = t2[i] + t1[i];
                                const bf16x8 uq = PACK8(t2, 0);
#pragma unroll
                                for (int kb = 0; kb < 2; ++kb) {
                                    f32x16 a = Sreg[kb];
                                    a = __builtin_amdgcn_mfma_f32_32x32x16_bf16(trd8(BGr, PT, 4 * h2, 8 + 4 * h2, 32 * kb, lane), uq, a, 0, 0, 0);
                                    a = __builtin_amdgcn_mfma_f32_32x32x16_bf16(trd8(BGr, PT, 16 + 8 * h2, 20 + 8 * h2, 32 * kb, lane), vfr, a, 0, 0, 0);
#pragma unroll
                                    for (int g4 = 0; g4 < 4; ++g4) { const f32x4 p4 = *(const LAS f32x4*)(PL + 32 * kb + 8 * g4 + 4 * h2);
                                        a[4 * g4] *= p4.x; a[4 * g4 + 1] *= p4.y; a[4 * g4 + 2] *= p4.z; a[4 * g4 + 3] *= p4.w; }
                                    Sreg[kb] = a;
                                }
                            }
                        }
                        __syncthreads();
                        {
                            int hcw = hc; asm volatile("" : "+v"(hcw));
                            const f32x4 lng = *(const f32x4*)(INP(I_RWLNG) + l * 512 + hcw), lnb = *(const f32x4*)(INP(I_RWLNB) + l * 512 + hcw);
                            const f32x4 o4 = *(const LAS f32x4*)(OUTB + pt * 64 + pc), v4 = *(const LAS f32x4*)(OPS + pt * 384 + 320 + pc);
                            const float mean = red16((o4.x + o4.y) + (o4.z + o4.w)) * (1.f / 64.f);
                            const f32x4 dv = o4 - mean;
                            const float var = red16(DOT4(dv, dv)) * (1.f / 64.f);
                            const float rstd = __builtin_amdgcn_rsqf(var + RW_GN_EPS), bo = BON[pt];
                            const f32x4 y = (dv * rstd * lng + lnb + v4 * bo) * gk;
                            st4bf(HC + (((size_t)b * SEQ + t0 + pt) * 1536 + 512 + hc) * 2, y);
                        }
                        __syncthreads();
                    }
#undef PACK8
#undef LD2x64
                } } else {
                    const int idx = job - 128, bh = idx >> 1, half = idx & 1, b = bh >> 2, h = bh & 3;
                    unsigned zl_ = 0u; asm volatile("" : "+v"(zl_)); const int lane_ml = (int)__builtin_amdgcn_mbcnt_hi(~0u, __builtin_amdgcn_mbcnt_lo(~0u, zl_));
                    _Pragma("unroll 1") for (int sr_ = 0; sr_ < NSUB(1); ++sr_) if (((SUBMASK>>1)&1) && idx < 64) {
                        SUB_TID
                        const int bm = idx >> 2, hm = idx & 3;
                        constexpr int PT = 144;
                        LAS unsigned char* QI = lds;
                        LAS unsigned char* KI = QI + 64 * PT;
                        constexpr int PV = 272;
                        LAS unsigned char* KW = KI + 64 * PT;
                        LAS unsigned char* VT = KW + 64 * PT;
                        LAS unsigned char* CI = VT + 64 * PV;
                        LAS float* AS = (LAS float*)(CI + 128 * PT);
                        LAS float* MX = AS + 64; LAS float* SI = AS + 128; LAS float* EM = AS + 192; LAS float* WG = AS + 256; LAS float* NN = AS + 320; LAS float* CR = AS + 384; LAS float* ST = AS + 448;
                        for (int i = tid; i < 128 * PT / 4; i += NTHR) ((LAS unsigned*)CI)[i] = 0u;
                        if (tid < 64) NN[tid] = 0.f;
                        const int pt = tid >> 4, cg = tid & 15;
                        const int ccol = (cg < 8) ? (hm * 64 + 8 * cg) : (256 + hm * 64 + 8 * (cg - 8));
                        const float qsc = (cg < 8) ? 0.125f : 1.f;
                        const float igb = INP(I_IGB)[l * 4 + hm], fgb = INP(I_FGB)[l * 4 + hm];
                        const int r31 = lane & 31, h2 = lane >> 5, vb = wave >> 1, tb = wave & 1;
                        f32x16 accC;
#pragma unroll
                        for (int i = 0; i < 16; ++i) accC[i] = 0.f;
                        float nreg = 0.f, mprev = 0.f;
                        u32x4 cu[2][4], vu[2]; float gi = 0.f, gf = 0.f;
                        auto LOADM = [&](int t0) {
#pragma unroll
                            for (int tt = 0; tt < 2; ++tt) { const int t = t0 + pt + 32 * tt; const size_t row = (size_t)bm * SEQ + t;
#pragma unroll
                                for (int j = 0; j < 4; ++j) { if (t - 3 + j >= 0) cu[tt][j] = *(const u32x4*)(Ub + ((row - 3 + j) * NU + UC_QK + ccol) * 2); else cu[tt][j] = (u32x4){0u, 0u, 0u, 0u}; }
                                const int p = tid + 512 * tt; vu[tt] = *(const u32x4*)(Ub + (((size_t)bm * SEQ + t0 + (p >> 4)) * NU + UC_V + hm * 128 + 8 * (p & 15)) * 2); }
                            if (wave == 0) { const size_t rg = (size_t)bm * SEQ + t0 + lane; gi = GIF[rg * 8 + hm]; gf = GIF[rg * 8 + 4 + hm]; }
                        };
                        LOADM(0);
                        __syncthreads();
#pragma unroll 1
                        for (int t0 = 0; t0 < SEQ; t0 += 64) {
                            int ccv = ccol; asm volatile("" : "+v"(ccv));
                            float cw[4][8], cb[8];
#pragma unroll
                        for (int j = 0; j < 4; ++j) { const f32x4 a = *(const f32x4*)(INP(I_CONVW) + ((size_t)l * 4 + j) * 512 + ccv), c2 = *(const f32x4*)(INP(I_CONVW) + ((size_t)l * 4 + j) * 512 + ccv + 4);
                            cw[j][0] = a.x; cw[j][1] = a.y; cw[j][2] = a.z; cw[j][3] = a.w; cw[j][4] = c2.x; cw[j][5] = c2.y; cw[j][6] = c2.z; cw[j][7] = c2.w; }
                        { const f32x4 a = *(const f32x4*)(INP(I_CONVB) + l * 512 + ccv), c2 = *(const f32x4*)(INP(I_CONVB) + l * 512 + ccv + 4);
                            cb[0] = a.x; cb[1] = a.y; cb[2] = a.z; cb[3] = a.w; cb[4] = c2.x; cb[5] = c2.y; cb[6] = c2.z; cb[7] = c2.w; }
                            float yq[2][8];
#pragma unroll
                            for (int tt = 0; tt < 2; ++tt) {
#pragma unroll
                                for (int i = 0; i < 8; ++i) yq[tt][i] = cb[i];
#pragma unroll
                                for (int j = 0; j < 4; ++j) { const u32x4 w = cu[tt][j]; const float x[8] = {bflo(w.x), bfhi(w.x), bflo(w.y), bfhi(w.y), bflo(w.z), bfhi(w.z), bflo(w.w), bfhi(w.w)};
#pragma unroll
                                    for (int i = 0; i < 8; ++i) yq[tt][i] += cw[j][i] * x[i]; }
#pragma unroll
                                for (int i = 0; i < 8; ++i) yq[tt][i] = yq[tt][i] * sigmoidf_(yq[tt][i]) * qsc;
                            }
                            const u32x4 vreg0 = vu[0], vreg1 = vu[1];
                            if (wave == 0) {
                                const float ig = gi + igb, fp = gf + fgb;
                                const float lf = -(fmaxf(-fp, 0.f) + __logf(1.f + __expf(-fabsf(fp))));
                                const float bc = scan_add64(lf);
                                const float as = ig - bc, pm = scan_max64(as);
                                const float mxv = fmaxf(mprev, pm), mx63 = __builtin_bit_cast(float, __builtin_amdgcn_readlane(__builtin_bit_cast(int, mxv), 63)), bl = __builtin_bit_cast(float, __builtin_amdgcn_readlane(__builtin_bit_cast(int, bc), 63));
                                AS[lane] = as; MX[lane] = mxv; SI[lane] = __expf(mprev - mxv); EM[lane] = __expf(-(bc + mxv)); WG[lane] = __expf(as - mx63);
                                if (lane == 0) CR[0] = __expf(mprev - mx63);
                                mprev = bl + mx63;
                            }
                            if (t0 + 64 < SEQ) LOADM(t0 + 64);
                            __syncthreads();
#pragma unroll
                            for (int tt = 0; tt < 2; ++tt) { const int tok = pt + 32 * tt;
                                u32x4 pw; pw.x = pk2(yq[tt][0], yq[tt][1]); pw.y = pk2(yq[tt][2], yq[tt][3]); pw.z = pk2(yq[tt][4], yq[tt][5]); pw.w = pk2(yq[tt][6], yq[tt][7]);
                                if (cg < 8) *(LAS u32x4*)(QI + tok * PT + cg * 16) = pw;
                                else { *(LAS u32x4*)(KI + tok * PT + (cg - 8) * 16) = pw; const float wgs = WG[tok];
                                    u32x4 kw; kw.x = pk2(yq[tt][0] * wgs, yq[tt][1] * wgs); kw.y = pk2(yq[tt][2] * wgs, yq[tt][3] * wgs); kw.z = pk2(yq[tt][4] * wgs, yq[tt][5] * wgs); kw.w = pk2(yq[tt][6] * wgs, yq[tt][7] * wgs);
                                    *(LAS u32x4*)(KW + tok * PT + (cg - 8) * 16) = kw; }
                                const u32x4 vw = tt ? vreg1 : vreg0; const int p = tid + 512 * tt, vtok = p >> 4, v8 = p & 15;
                                *(LAS u32x4*)(VT + vtok * PV + v8 * 16) = vw;
                            }
                            __syncthreads();
                            float hv[16];
                            {
                                constexpr float L2E = 1.4426950408889634f;
                                const int t = 32 * tb + r31;
                                bf16x8 qf[4];
#pragma unroll
                                for (int ks = 0; ks < 4; ++ks) qf[ks] = *(const LAS bf16x8*)(QI + t * PT + (16 * ks + 8 * h2) * 2);
                                const float mx = MX[t], si = SI[t], em = EM[t];
                                f32x16 O, I; float denI = 0.f;
#pragma unroll
                                for (int i = 0; i < 16; ++i) { O[i] = 0.f; I[i] = 0.f; }
#pragma unroll
                                for (int sb = 0; sb < 2; ++sb) if (sb <= tb) {
                                    f32x16 X;
#pragma unroll
                                    for (int i = 0; i < 16; ++i) X[i] = 0.f;
#pragma unroll
                                    for (int ks = 0; ks < 4; ++ks) { const bf16x8 kf = *(const LAS bf16x8*)(KI + (32 * sb + r31) * PT + (16 * ks + 8 * h2) * 2); X = __builtin_amdgcn_mfma_f32_32x32x16_bf16(kf, qf[ks], X, 0, 0, 0); }
#pragma unroll
                                    for (int g4 = 0; g4 < 4; ++g4) { const f32x4 a4 = *(const LAS f32x4*)(AS + 32 * sb + 8 * g4 + 4 * h2);
#pragma unroll
                                        for (int j = 0; j < 4; ++j) { const int s = 32 * sb + 8 * g4 + 4 * h2 + j; const float w = (s <= t) ? __builtin_amdgcn_exp2f((a4[j] - mx) * L2E) * X[4 * g4 + j] : 0.f; X[4 * g4 + j] = w; denI += w; } }
#pragma unroll
                                    for (int st = 0; st < 2; ++st) {
                                        u32x4 pw; pw.x = pk2(X[8 * st], X[8 * st + 1]); pw.y = pk2(X[8 * st + 2], X[8 * st + 3]); pw.z = pk2(X[8 * st + 4], X[8 * st + 5]); pw.w = pk2(X[8 * st + 6], X[8 * st + 7]);
                                        O = __builtin_amdgcn_mfma_f32_32x32x16_bf16(trd8(VT, PV, 32 * sb + 16 * st + 4 * h2, 32 * sb + 16 * st + 8 + 4 * h2, 32 * vb, lane), __builtin_bit_cast(bf16x8, pw), O, 0, 0, 0);
                                    }
                                }
                                float nq = 0.f;
#pragma unroll
                                for (int ks = 0; ks < 4; ++ks) { const bf16x8 cf = *(const LAS bf16x8*)(CI + (32 * vb + r31) * PT + (16 * ks + 8 * h2) * 2); I = __builtin_amdgcn_mfma_f32_32x32x16_bf16(cf, qf[ks], I, 0, 0, 0);
                                    const f32x4 n0 = *(const LAS f32x4*)(NN + 16 * ks + 8 * h2), n1 = *(const LAS f32x4*)(NN + 16 * ks + 8 * h2 + 4); const u32x4 qw = __builtin_bit_cast(u32x4, qf[ks]);
                                    nq += (bflo(qw.x) * n0.x + bfhi(qw.x) * n0.y) + (bflo(qw.y) * n0.z + bfhi(qw.y) * n0.w) + (bflo(qw.z) * n1.x + bfhi(qw.z) * n1.y) + (bflo(qw.w) * n1.z + bfhi(qw.w) * n1.w); }
                                nq += __shfl_xor(nq, 32); denI += __shfl_xor(denI, 32);
                                const float den = si * nq + denI, rdn = 1.f / fmaxf(fabsf(den), em);
                                float hsum = 0.f;
#pragma unroll
                                for (int i = 0; i < 16; ++i) { hv[i] = (O[i] + si * I[i]) * rdn; hsum += hv[i]; }
                                hsum += __shfl_xor(hsum, 32);
                                const float hmean = hsum * (1.f / 32.f); float hm2 = 0.f;
#pragma unroll
                                for (int i = 0; i < 16; ++i) { const float dlt = hv[i] - hmean; hm2 += dlt * dlt; }
                                hm2 += __shfl_xor(hm2, 32);
                                if (h2 == 0) *(LAS f32x2*)(ST + ((tb * 4 + vb) * 32 + r31) * 2) = (f32x2){hmean, hm2};
                                const float carry = CR[0];
#pragma unroll
                                for (int i = 0; i < 16; ++i) accC[i] *= carry;
#pragma unroll
                                for (int st = 0; st < 4; ++st) { const bf16x8 va = trd8(VT, PV, 16 * st + 8 * h2, 16 * st + 8 * h2 + 4, 32 * vb, lane), kw = trd8(KW, PT, 16 * st + 8 * h2, 16 * st + 8 * h2 + 4, 32 * tb, lane);
                                    accC = __builtin_amdgcn_mfma_f32_32x32x16_bf16(va, kw, accC, 0, 0, 0); }
                            }
                            __syncthreads();
                            {
                                const int t = 32 * tb + r31;
                                f32x2 s4[4];
#pragma unroll
                                for (int q = 0; q < 4; ++q) s4[q] = *(const LAS f32x2*)(ST + ((tb * 4 + q) * 32 + r31) * 2);
                                const float mt = (s4[0].x + s4[1].x + s4[2].x + s4[3].x) * 0.25f;
                                float m2 = 0.f;
#pragma unroll
                                for (int q = 0; q < 4; ++q) { const float dm = s4[q].x - mt; m2 += s4[q].y + 32.f * dm * dm; }
                                const float rstd = __builtin_amdgcn_rsqf(m2 * (1.f / 128.f) + LN_EPS);
                                const size_t row = (size_t)bm * SEQ + t0 + t;
                                const char* ogp = Ub + (row * NU + UC_OG + hm * 128 + 32 * vb) * 2; char* op = HC + (row * 1536 + hm * 128 + 32 * vb) * 2;
                                const float* ngp = INP(I_MLNORMG) + l * 512 + hm * 128 + 32 * vb;
#pragma unroll
                                for (int g4 = 0; g4 < 4; ++g4) { const int vo = 8 * g4 + 4 * h2; const f32x4 og = ld4bf(ogp + vo * 2), ng = *(const f32x4*)(ngp + vo);
                                    f32x4 y; y.x = sigmoidf_(og.x) * ((hv[4 * g4] - mt) * rstd * ng.x); y.y = sigmoidf_(og.y) * ((hv[4 * g4 + 1] - mt) * rstd * ng.y); y.z = sigmoidf_(og.z) * ((hv[4 * g4 + 2] - mt) * rstd * ng.z); y.w = sigmoidf_(og.w) * ((hv[4 * g4 + 3] - mt) * rstd * ng.w);
                                    st4bf(op + vo * 2, y); }
                            }
#pragma unroll
                            for (int i = 0; i < 16; ++i) { const int v = 32 * vb + (i & 3) + 8 * (i >> 2) + 4 * h2; *(LAS bf16*)(CI + v * PT + (32 * tb + r31) * 2) = (bf16)f2bf(accC[i]); }
                            if (wave < 2) { float s = 0.f;
#pragma unroll
                                for (int q8 = 0; q8 < 8; ++q8) { const u32x2 w = trd4(KW, PT, 32 * h2 + 4 * q8, 32 * wave, lane); s += (bflo(w.x) + bfhi(w.x)) + (bflo(w.y) + bfhi(w.y)); }
                                s += __shfl_xor(s, 32);
                                nreg = CR[0] * nreg + s; if (h2 == 0) NN[32 * wave + r31] = nreg; }
                            __syncthreads();
                        }
                    }
                    _Pragma("unroll 1") for (int sr_ = 0; sr_ < NSUB(2); ++sr_) if ((SUBMASK>>2)&1) {
                        SUB_TID
                        constexpr int KST = 272, VST = 520;
                        LAS unsigned char* KI = lds; LAS unsigned char* VI = lds + 256 * KST;
                        const char* kvb = (const char*)(ws + WS_KV) + (((size_t)l * MROWS + (size_t)b * MEML) * D) * 2;
                        for (int p = tid; p < 4096; p += NTHR) { const int key = p >> 4, c16 = p & 15;
                            *(LAS u32x4*)(KI + key * KST + c16 * 16) = *(const u32x4*)(kvb + ((size_t)key * D + h * 128 + c16 * 8) * 2); }
                        for (int p = tid; p < 4096; p += NTHR) { const int key = p & 255, d8 = p >> 8;
                            const u32x4 w = *(const u32x4*)(kvb + ((size_t)key * D + 512 + h * 128 + d8 * 8) * 2);
                            LAS unsigned char* o = VI + (d8 * 8) * VST + key * 2;
                            *(LAS bf16*)(o) = (bf16)(w.x & 0xffff); *(LAS bf16*)(o + VST) = (bf16)(w.x >> 16); *(LAS bf16*)(o + 2 * VST) = (bf16)(w.y & 0xffff); *(LAS bf16*)(o + 3 * VST) = (bf16)(w.y >> 16);
                            *(LAS bf16*)(o + 4 * VST) = (bf16)(w.z & 0xffff); *(LAS bf16*)(o + 5 * VST) = (bf16)(w.z >> 16); *(LAS bf16*)(o + 6 * VST) = (bf16)(w.w & 0xffff); *(LAS bf16*)(o + 7 * VST) = (bf16)(w.w >> 16); }
                        __syncthreads();
                        const int r31 = lane & 31, h2 = lane >> 5;
                        constexpr float SC = 0.08838834764831845f * 1.4426950408889634f;
#pragma unroll 1
                        for (int rd = 0; rd < 8; ++rd) {
                            const size_t qrow = (size_t)b * SEQ + half * 2048 + rd * 256 + wave * 32 + r31;
                            bf16x8 qf[8];
#pragma unroll
                            for (int ks = 0; ks < 8; ++ks) qf[ks] = *(const bf16x8*)(Ub + (qrow * NU + UC_CAQ + h * 128 + 16 * ks + 8 * h2) * 2);
                            f32x16 O[4];
#pragma unroll
                            for (int db = 0; db < 4; ++db)
#pragma unroll
                                for (int i = 0; i < 16; ++i) O[db][i] = 0.f;
                            float mrun = -1e30f, lrun = 0.f;
#pragma unroll 1
                            for (int hf = 0; hf < 2; ++hf) {
                                f32x16 X[4];
#pragma unroll
                                for (int kb = 0; kb < 4; ++kb) {
                                    bf16x8 kf[8];
#pragma unroll
                                    for (int ks = 0; ks < 8; ++ks) kf[ks] = *(const LAS bf16x8*)(KI + (hf * 128 + kb * 32 + r31) * KST + (16 * ks + 8 * h2) * 2);
                                    __builtin_amdgcn_sched_barrier(0);
#pragma unroll
                                    for (int i = 0; i < 16; ++i) X[kb][i] = 0.f;
#pragma unroll
                                    for (int ks = 0; ks < 8; ++ks) X[kb] = __builtin_amdgcn_mfma_f32_32x32x16_bf16(kf[ks], qf[ks], X[kb], 0, 0, 0);
                                    __builtin_amdgcn_sched_barrier(0);
                                }
                                float mx = -1e30f;
#pragma unroll
                                for (int kb = 0; kb < 4; ++kb)
#pragma unroll
                                    for (int i = 0; i < 16; ++i) mx = fmaxf(mx, X[kb][i]);
                                mx = fmaxf(mx, __shfl_xor(mx, 32));
                                const float mnew = fmaxf(mrun, mx), alpha = __builtin_amdgcn_exp2f((mrun - mnew) * SC);
                                float ls = 0.f;
#pragma unroll
                                for (int kb = 0; kb < 4; ++kb)
#pragma unroll
                                    for (int i = 0; i < 16; ++i) { const float p = __builtin_amdgcn_exp2f((X[kb][i] - mnew) * SC); X[kb][i] = p; ls += p; }
                                ls += __shfl_xor(ls, 32);
                                lrun = lrun * alpha + ls; mrun = mnew;
#pragma unroll
                                for (int db = 0; db < 4; ++db)
#pragma unroll
                                    for (int i = 0; i < 16; ++i) O[db][i] *= alpha;
#pragma unroll
                                for (int kb = 0; kb < 4; ++kb) {
                                    bf16x8 vf[2][4], pf[2];
#pragma unroll
                                    for (int s = 0; s < 2; ++s) {
                                        u32x4 pw; pw.x = pk2(X[kb][8 * s], X[kb][8 * s + 1]); pw.y = pk2(X[kb][8 * s + 2], X[kb][8 * s + 3]); pw.z = pk2(X[kb][8 * s + 4], X[kb][8 * s + 5]); pw.w = pk2(X[kb][8 * s + 6], X[kb][8 * s + 7]);
                                        pf[s] = __builtin_bit_cast(bf16x8, pw);
#pragma unroll
                                        for (int db = 0; db < 4; ++db) {
                                            const LAS unsigned char* vp = VI + (db * 32 + r31) * VST + (hf * 128 + kb * 32 + 16 * s + 4 * h2) * 2;
                                            const u32x2 lo = *(const LAS u32x2*)vp, hi = *(const LAS u32x2*)(vp + 16);
                                            vf[s][db] = __builtin_bit_cast(bf16x8, (u32x4){lo.x, lo.y, hi.x, hi.y});
                                        }
                                    }
                                    __builtin_amdgcn_sched_barrier(0);
#pragma unroll
                                    for (int s = 0; s < 2; ++s)
#pragma unroll
                                        for (int db = 0; db < 4; ++db) O[db] = __builtin_amdgcn_mfma_f32_32x32x16_bf16(vf[s][db], pf[s], O[db], 0, 0, 0);
                                    __builtin_amdgcn_sched_barrier(0);
                                }
                            }
                            const float rl = 1.f / lrun;
                            char* op = HC + (qrow * 1536 + 1024 + h * 128) * 2;
#pragma unroll
                            for (int db = 0; db < 4; ++db)
#pragma unroll
                                for (int g4 = 0; g4 < 4; ++g4) { u32x2 w; w.x = pk2(O[db][4 * g4] * rl, O[db][4 * g4 + 1] * rl); w.y = pk2(O[db][4 * g4 + 2] * rl, O[db][4 * g4 + 3] * rl);
                                    *(u32x2*)(op + (db * 32 + 8 * g4 + 4 * h2) * 2) = w; }
                        }
                        __syncthreads();
                    }
                    if (rep_ == 0) {
                        LAS float* scr = (LAS float*)(lds + wave * 8448);
                        constexpr int IT_GU = 32 * 16 * 64;
                        const int nper = (idx < 64) ? 4 : 92, ibase = (idx < 64) ? 0 : 2048, wk = (idx & 63) * NWAVES + wave;
                        for (int kq = 0; kq < nper; ++kq) { const int it = ibase + wk + kq * 512;
                            if (it < IT_GU) { const int e = it >> 10, q = it & 1023, kb = q >> 6, nb = q & 63;
                                transpose_item_f8(INP(I_WGU) + (((size_t)l * 32 + e) * D + 64 * kb) * 2048 + 32 * nb, 2048, (unsigned char*)(ws + WS_WGU) + ((size_t)e * 2048 + 32 * nb) * D + 64 * kb, D, F8_SWGU, scr, lane_ml); }
                            else { const int r2 = it - IT_GU, e = r2 >> 9, q = r2 & 511, kb = q >> 5, nb = q & 31;
                                transpose_item_f8(INP(I_WDN) + (((size_t)l * 32 + e) * D + 64 * kb) * 1024 + 32 * nb, 1024, (unsigned char*)(ws + WS_WDN) + ((size_t)e * 1024 + 32 * nb) * D + 64 * kb, D, F8_SWDN, scr, lane_ml); }
                        }
                        __syncthreads();
                    }
                }
            }
#undef UNP4
#undef DOT4
#undef SUB_TID
        }
        SEAM(pb + 3);
        _Pragma("unroll 1") for (int rep_ = 0; rep_ < NREP(5); ++rep_) if (((PHMASK>>5)&1) && IN(pb + 5)) {
            SchedPlain S; S.T.init(M / 256, 4); S.G = G; S.c = bx; S.A = (const char*)(ws + WS_R2 + R2_HCAT); S.B = (const char*)(ws + WS_WBR) + (size_t)l * 1024 * 1536 * 2; S.C = (char*)(ws + WS_R2 + R2_YPRE);
            S.lda = 1536; S.ldb = 1536; S.ldc = D;
            pg8::EpiMerge E; E.U = Ub; E.gate_b = INP(I_GATEB) + (size_t)l * 3072;
            pg8::gemm_phase<false, true>(lds, 1536 * 2, 1536 * 2, 1536 * 2, S, E, wave);
        }
        SEAM(pb + 5);
        _Pragma("unroll 1") for (int rep_ = 0; rep_ < NREP(6); ++rep_) if (((PHMASK>>6)&1) && IN(pb + 6)) {
            SchedPlain S; S.T.init(M / 256, 4); S.G = G; S.c = bx; S.A = (const char*)(ws + WS_R2 + R2_YPRE); S.B = (const char*)(ws + WS_WO) + (size_t)l * D * D * 2; S.C = (char*)(ws + WS_R2 + R2_Z);
            S.lda = D; S.ldb = D; S.ldc = D;
            pg8::EpiStore E;
            pg8::gemm_phase<false>(lds, D * 2, D * 2, D * 2, S, E, wave);
        }
        SEAM(pb + 6);
        _Pragma("unroll 1") for (int rep_ = 0; rep_ < NREP(7); ++rep_) if (((PHMASK>>7)&1) && IN(pb + 7)) { PHASE_TID
            constexpr int WP = 2064;
            LAS unsigned char* WRb = lds;
            LAS float* RB = (LAS float*)(lds + 66048);
            LAS unsigned char* XS = lds + 66560 + wave * 4608;
            for (int i = tid; i < 32768; i += NTHR) { const int k = i >> 5, e = i & 31; *(LAS bf16*)(WRb + e * WP + k * 2) = (bf16)f2bf(INP(I_RTW)[((size_t)l * D + k) * 32 + e]); }
            if (tid < 32) RB[tid] = INP(I_RTB)[l * 32 + tid];
            const char* Zb = (const char*)(ws + WS_R2 + R2_Z);
            int* TKE = (int*)(ws + WS_TKE); float* TKG = (float*)(ws + WS_TKG); int* TKP = (int*)(ws + WS_TKP); int* ROWTOK = (int*)(ws + WS_ROWTOK);
            LAS unsigned* LCNT = (LAS unsigned*)(lds + 131072);
            LAS unsigned* GBASE = LCNT + 32; LAS unsigned* LLEN = LCNT + 64; LAS unsigned* LIST = LCNT + 128;
            if (tid < 65) LCNT[tid] = 0u;
            {
                f32x4 g[4], bb[4];
#pragma unroll
                for (int j = 0; j < 4; ++j) { g[j] = *(const f32x4*)(INP(I_LN1G) + l * D + 256 * j + 4 * lane); bb[j] = *(const f32x4*)(INP(I_LN1B) + l * D + 256 * j + 4 * lane); }
#pragma unroll 1
                for (int pp = gw; pp < M / 2; pp += NGW) {
                    f32x4 y0[4], y1[4];
#pragma unroll
                    for (int j = 0; j < 4; ++j) { y0[j] = ld4bf(Zb + ((size_t)(2 * pp) * D + 256 * j + 4 * lane) * 2) + ld4bf(Xb + ((size_t)(2 * pp) * D + 256 * j + 4 * lane) * 2) * DN_ALPHA;
                        y1[j] = ld4bf(Zb + ((size_t)(2 * pp + 1) * D + 256 * j + 4 * lane) * 2) + ld4bf(Xb + ((size_t)(2 * pp + 1) * D + 256 * j + 4 * lane) * 2) * DN_ALPHA; }
                    ln16(y0, g, bb); ln16(y1, g, bb);
#pragma unroll
                    for (int j = 0; j < 4; ++j) { st4bf(Xb + ((size_t)(2 * pp) * D + 256 * j + 4 * lane) * 2, y0[j]); st4bf(Xb + ((size_t)(2 * pp + 1) * D + 256 * j + 4 * lane) * 2, y1[j]); }
                }
            }
            asm volatile("s_waitcnt vmcnt(0)" ::: "memory");
            __syncthreads();
            __builtin_amdgcn_fence(__ATOMIC_ACQUIRE, "agent");
            asm volatile("s_waitcnt vmcnt(0)" ::: "memory");
            if (rep_ == 0) {
                const int r31 = lane & 31, h2 = lane >> 5;
                const int mytok = 16 * (bx + (2 * wave + (r31 >> 4)) * G) + (r31 & 15);
                const char* sp[4];
#pragma unroll
                for (int q = 0; q < 4; ++q) { const int row = (lane >> 3) + 8 * q; const int tk = 16 * (bx + (2 * wave + (row >> 4)) * G) + (row & 15); sp[q] = Xb + ((size_t)tk * D + 8 * (lane & 7)) * 2; }
                f32x16 C;
#pragma unroll
                for (int i = 0; i < 16; ++i) C[i] = 0.f;
                u32x4 xr[4];
#pragma unroll
                for (int q = 0; q < 4; ++q) xr[q] = *(const u32x4*)(sp[q]);
#pragma unroll 1
                for (int sl = 0; sl < 16; ++sl) {
#pragma unroll
                    for (int q = 0; q < 4; ++q) *(LAS u32x4*)(XS + ((lane >> 3) + 8 * q) * 144 + (lane & 7) * 16) = xr[q];
                    if (sl + 1 < 16) {
#pragma unroll
                        for (int q = 0; q < 4; ++q) xr[q] = *(const u32x4*)(sp[q] + (sl + 1) * 128); }
#pragma unroll
                    for (int k2 = 0; k2 < 4; ++k2) C = __builtin_amdgcn_mfma_f32_32x32x16_bf16(*(const LAS bf16x8*)(WRb + r31 * WP + (64 * sl + 16 * k2 + 8 * h2) * 2), *(const LAS bf16x8*)(XS + r31 * 144 + (16 * k2 + 8 * h2) * 2), C, 0, 0, 0);
                }
                float v[16];
#pragma unroll
                for (int g4 = 0; g4 < 4; ++g4) { const f32x4 b4 = *(const LAS f32x4*)(RB + 8 * g4 + 4 * h2); v[4 * g4] = C[4 * g4] + b4.x; v[4 * g4 + 1] = C[4 * g4 + 1] + b4.y; v[4 * g4 + 2] = C[4 * g4 + 2] + b4.z; v[4 * g4 + 3] = C[4 * g4 + 3] + b4.w; }
                float lv[4]; int li_[4];
#pragma unroll
                for (int k = 0; k < 4; ++k) { float best = -3.0e38f; int bi = 0;
#pragma unroll
                    for (int i = 0; i < 16; ++i) { const int e = (i & 3) + 8 * (i >> 2) + 4 * h2; if (v[i] > best) { best = v[i]; bi = e; } }
#pragma unroll
                    for (int i = 0; i < 16; ++i) { const int e = (i & 3) + 8 * (i >> 2) + 4 * h2; v[i] = (e == bi) ? -3.0e38f : v[i]; }
                    lv[k] = best; li_[k] = bi; }
                float cv[8]; int ci[8];
#pragma unroll
                for (int k = 0; k < 4; ++k) { cv[k] = lv[k]; ci[k] = li_[k]; cv[4 + k] = __shfl_xor(lv[k], 32); ci[4 + k] = __shfl_xor(li_[k], 32); }
                float tv[4]; int te[4];
#pragma unroll
                for (int k = 0; k < 4; ++k) { float best = -3.0e38f; int bi = 64;
#pragma unroll
                    for (int i = 0; i < 8; ++i) { if (cv[i] > best || (cv[i] == best && ci[i] < bi)) { best = cv[i]; bi = ci[i]; } }
#pragma unroll
                    for (int i = 0; i < 8; ++i) cv[i] = (ci[i] == bi) ? -3.0e38f : cv[i];
                    tv[k] = best; te[k] = bi; }
                const float e1 = __expf(tv[1] - tv[0]), e2 = __expf(tv[2] - tv[0]), e3 = __expf(tv[3] - tv[0]), rs = 1.f / (1.f + e1 + e2 + e3);
                const float gt[4] = {rs, e1 * rs, e2 * rs, e3 * rs};
                if (h2 == 0) {
#pragma unroll
                    for (int k = 0; k < 4; ++k) {
                        const unsigned lpos = __hip_atomic_fetch_add(LCNT + te[k], 1u, __ATOMIC_RELAXED, __HIP_MEMORY_SCOPE_WORKGROUP);
                        const unsigned li = __hip_atomic_fetch_add(LLEN, 1u, __ATOMIC_RELAXED, __HIP_MEMORY_SCOPE_WORKGROUP);
                        LIST[2 * li] = (unsigned)(mytok * 4 + k); LIST[2 * li + 1] = (unsigned)te[k] | (lpos << 8);
                        TKE[mytok * 4 + k] = te[k]; TKG[mytok * 4 + k] = gt[k]; }
                }
            }
            __syncthreads();
            if (tid < 32 && rep_ == 0) GBASE[tid] = __hip_atomic_fetch_add((unsigned*)ctl + CW_CNT + (l * 32 + tid) * 64, LCNT[tid], RLX_AGENT);
            __syncthreads();
            if (rep_ == 0) { const unsigned n = LLEN[0];
                for (unsigned i = tid; i < n; i += NTHR) { const unsigned tk = LIST[2 * i], ev = LIST[2 * i + 1], e = ev & 255u, pos = GBASE[e] + (ev >> 8);
                    TKP[tk] = (int)pos; ROWTOK[(size_t)e * M + pos] = (int)(tk >> 2); } }
            __syncthreads();
        }
        SEAM(pb + 7);
        _Pragma("unroll 1") for (int rep_ = 0; rep_ < NREP(8); ++rep_) if (((PHMASK>>8)&1) && IN(pb + 8)) { PHASE_TID
            if (tid < 32) CNT[tid] = (int)__hip_atomic_load((unsigned*)ctl + CW_CNT + (l * 32 + tid) * 64, RLX_AGENT);
            __syncthreads();
            if (tid == 0) { int a = 0; for (int e = 0; e < 32; ++e) { PB[e] = a; a += (CNT[e] + 255) >> 8; } PB[32] = a; }
            __syncthreads();
            const int P = PB[32];
            const int* ROWTOK = (const int*)(ws + WS_ROWTOK);
            char* XD = (char*)(ws + WS_R1);
            for (int sb = gw * 64; sb < P * 256; sb += NGW * 64) {
                const int pm = sb >> 8; int e = 0;
#pragma unroll 1
                for (int j = 1; j < NEXP; ++j) e += (PB[j] <= pm) ? 1 : 0;
                const int pos0 = sb - PB[e] * 256, cnt = CNT[e];
                int nvalid = cnt - pos0; nvalid = nvalid > 64 ? 64 : nvalid;
                int tokv = -1; if (pos0 + lane < cnt) tokv = ROWTOK[(size_t)e * M + pos0 + lane];
#pragma unroll 1
                for (int j = 0; j < nvalid; j += 2) {
                    int t[2]; u32x4 a[2], b2[2];
#pragma unroll
                    for (int i = 0; i < 2; ++i) { t[i] = __builtin_amdgcn_readlane(tokv, j + i);
                        if (t[i] >= 0) { a[i] = *(const u32x4*)(Xb + (size_t)t[i] * 2048 + lane * 32); b2[i] = *(const u32x4*)(Xb + (size_t)t[i] * 2048 + lane * 32 + 16); } }
#pragma unroll
                    for (int i = 0; i < 2; ++i) if (t[i] >= 0) {
                        u32x4 o; o.x = pk4_f8(bflo(a[i].x) * F8_SX, bfhi(a[i].x) * F8_SX, bflo(a[i].y) * F8_SX, bfhi(a[i].y) * F8_SX); o.y = pk4_f8(bflo(a[i].z) * F8_SX, bfhi(a[i].z) * F8_SX, bflo(a[i].w) * F8_SX, bfhi(a[i].w) * F8_SX);
                        o.z = pk4_f8(bflo(b2[i].x) * F8_SX, bfhi(b2[i].x) * F8_SX, bflo(b2[i].y) * F8_SX, bfhi(b2[i].y) * F8_SX); o.w = pk4_f8(bflo(b2[i].z) * F8_SX, bfhi(b2[i].z) * F8_SX, bflo(b2[i].w) * F8_SX, bfhi(b2[i].w) * F8_SX);
                        *(u32x4*)(XD + (size_t)(sb + j + i) * 1024 + lane * 16) = o; }
                }
            }
            LAS float* scr = (LAS float*)(lds + wave * 8448);
            constexpr int IT_GU = 32 * 16 * 64, IT_DN = 32 * 16 * 32;
            for (int it = XW_SPLIT + gw; it < IT_GU + IT_DN; it += NGW) {
                if (it < IT_GU) { const int e = it >> 10, q = it & 1023, kb = q >> 6, nb = q & 63;
                    transpose_item_f8(INP(I_WGU) + (((size_t)l * 32 + e) * D + 64 * kb) * 2048 + 32 * nb, 2048, (unsigned char*)(ws + WS_WGU) + ((size_t)e * 2048 + 32 * nb) * D + 64 * kb, D, F8_SWGU, scr, lane); }
                else { const int r = it - IT_GU, e = r >> 9, q = r & 511, kb = q >> 5, nb = q & 31;
                    transpose_item_f8(INP(I_WDN) + (((size_t)l * 32 + e) * D + 64 * kb) * 1024 + 32 * nb, 1024, (unsigned char*)(ws + WS_WDN) + ((size_t)e * 1024 + 32 * nb) * D + 64 * kb, D, F8_SWDN, scr, lane); }
            }
            __syncthreads();
        }
        SEAM(pb + 8);
        if (IN(pb + 9) || IN(pb + 10)) { PHASE_TID
            if (tid < 32) CNT[tid] = (int)__hip_atomic_load((unsigned*)ctl + CW_CNT + (l * 32 + tid) * 64, RLX_AGENT);
            __syncthreads();
            if (tid == 0) { int a = 0; for (int e = 0; e < 32; ++e) { PB[e] = a; a += (CNT[e] + 255) >> 8; } PB[32] = a; }
            __syncthreads();
        }
        _Pragma("unroll 1") for (int rep_ = 0; rep_ < NREP(9); ++rep_) if (((PHMASK>>9)&1) && IN(pb + 9)) {
            SchedMoe S; S.T.init(PB[32], 8); S.G = G; S.c = bx; S.A = (const char*)(ws + WS_R1); S.W = (const char*)(ws + WS_WGU); S.C = (char*)(ws + WS_R2 + R2_HMID); S.PB = PB; S.wrows = 2048; S.ldc = 1024; S.cdiv = 2; S.osz = 1;
            pg8::EpiMoe1 E; E.bgu = INP(I_BGU) + (size_t)l * 32 * 2048;
            pg8::gemm_phase<true>(lds, D, D, D, S, E, wave);
        }
        SEAM(pb + 9);
        _Pragma("unroll 1") for (int rep_ = 0; rep_ < NREP(10); ++rep_) if (((PHMASK>>10)&1) && IN(pb + 10)) {
            SchedMoe S; S.T.init(PB[32], 4); S.G = G; S.c = bx; S.A = (const char*)(ws + WS_R2 + R2_HMID); S.W = (const char*)(ws + WS_WDN); S.C = (char*)(ws + WS_R1); S.PB = PB; S.wrows = 1024; S.ldc = 1024; S.cdiv = 1; S.osz = 2;
            pg8::EpiMoe2 E; E.bdn = INP(I_BDN) + (size_t)l * 32 * 1024;
            pg8::gemm_phase<true>(lds, D, D, D, S, E, wave);
        }
        SEAM(pb + 10);
        _Pragma("unroll 1") for (int rep_ = 0; rep_ < NREP(11); ++rep_) if (((PHMASK>>11)&1) && IN(pb + 11)) { PHASE_TID
            if (tid < 32) CNT[tid] = (int)__hip_atomic_load((unsigned*)ctl + CW_CNT + (l * 32 + tid) * 64, RLX_AGENT);
            LAS float* wgt = (LAS float*)(lds + 73728);
            const bool lastl = (l == DEPTH - 1);
            if (!lastl) load_gate_table(wgt, INP(I_WIN) + (size_t)(l + 1) * D * DIN, tid);
            __syncthreads();
            if (tid == 0) { int a = 0; for (int e = 0; e < 32; ++e) { PB[e] = a; a += (CNT[e] + 255) >> 8; } PB[32] = a; }
            __syncthreads();
            const int e0 = 8 * lane;
            f32x4 g[4], bb[4];
#pragma unroll
            for (int j = 0; j < 4; ++j) { const int o = (j >> 1) * 512 + e0 + (j & 1) * 4; g[j] = *(const f32x4*)(INP(I_LN2G) + l * D + o); bb[j] = *(const f32x4*)(INP(I_LN2B) + l * D + o); }
            const char* YA = (const char*)(ws + WS_R1);
            const bool dummy_ = (rep_ + 1 < NREP(11)); char* const Xo = dummy_ ? (char*)(ws + WS_R2) : Xb; float* const Fo = dummy_ ? (float*)(ws + WS_R2 + 256 * MiB) : args.out; float* const Go = dummy_ ? (float*)(ws + WS_R2 + 200 * MiB) : GIF;
            const int* TKE = (const int*)(ws + WS_TKE); const float* TKG = (const float*)(ws + WS_TKG); const int* TKP = (const int*)(ws + WS_TKP);
#pragma unroll 1
            for (int mb = gw * 16; mb < M; mb += NGW * 16) {
                const int ev = TKE[mb * 4 + lane], pv = TKP[mb * 4 + lane]; const float gv = TKG[mb * 4 + lane];
                const int rowv = PB[ev] * 256 + pv;
#pragma unroll 1
                for (int ti = 0; ti < 16; ti += 2) {
                    u32x4 xw[2][2], yw[2][4][2]; float gk[2][4];
#pragma unroll
                    for (int q = 0; q < 2; ++q) { const size_t m = (size_t)mb + ti + q;
                        xw[q][0] = *(const u32x4*)(Xb + (m * D + e0) * 2); xw[q][1] = *(const u32x4*)(Xb + (m * D + 512 + e0) * 2);
#pragma unroll
                        for (int k = 0; k < 4; ++k) { const size_t row = (size_t)__builtin_amdgcn_readlane(rowv, 4 * (ti + q) + k);
                            gk[q][k] = __builtin_bit_cast(float, __builtin_amdgcn_readlane(__builtin_bit_cast(int, gv), 4 * (ti + q) + k));
                            yw[q][k][0] = *(const u32x4*)(YA + (row * D + e0) * 2); yw[q][k][1] = *(const u32x4*)(YA + (row * D + 512 + e0) * 2); } }
#pragma unroll
                    for (int q = 0; q < 2; ++q) { const size_t m = (size_t)mb + ti + q;
                        f32x4 v[4];
#pragma unroll
                        for (int hh = 0; hh < 2; ++hh) { const u32x4 w = xw[q][hh];
                            v[2 * hh] = (f32x4){bflo(w.x), bfhi(w.x), bflo(w.y), bfhi(w.y)} * DN_ALPHA; v[2 * hh + 1] = (f32x4){bflo(w.z), bfhi(w.z), bflo(w.w), bfhi(w.w)} * DN_ALPHA; }
#pragma unroll
                        for (int k = 0; k < 4; ++k)
#pragma unroll
                            for (int hh = 0; hh < 2; ++hh) { const u32x4 w = yw[q][k][hh];
                                v[2 * hh] = v[2 * hh] + (f32x4){bflo(w.x), bfhi(w.x), bflo(w.y), bfhi(w.y)} * gk[q][k]; v[2 * hh + 1] = v[2 * hh + 1] + (f32x4){bflo(w.z), bfhi(w.z), bflo(w.w), bfhi(w.w)} * gk[q][k]; }
                        ln16(v, g, bb);
                        if (lastl) {
#pragma unroll
                            for (int j = 0; j < 4; ++j) *(f32x4*)(Fo + m * D + (j >> 1) * 512 + e0 + (j & 1) * 4) = v[j];
                        } else {
#pragma unroll
                            for (int hh = 0; hh < 2; ++hh) { *(u32x4*)(Xo + (m * D + hh * 512 + e0) * 2) = pg8::pack8(v[2 * hh], v[2 * hh + 1]);
                                u32x2 f8w; f8w.x = pk4_f8(v[2 * hh].x * F8_SX, v[2 * hh].y * F8_SX, v[2 * hh].z * F8_SX, v[2 * hh].w * F8_SX); f8w.y = pk4_f8(v[2 * hh + 1].x * F8_SX, v[2 * hh + 1].y * F8_SX, v[2 * hh + 1].z * F8_SX, v[2 * hh + 1].w * F8_SX);
                                if (!dummy_) *(u32x2*)((char*)(ws + WS_XF8) + m * D + hh * 512 + e0) = f8w; }
                            gates8b(v, wgt, Go + m * 8, lane);
                        }
                    }
                }
            }
            __syncthreads();
        }
        SEAM(pb + 11);
    }
#undef IN
#undef SEAM
}

extern "C" void kernel_launch(void* const* d_in, const int* in_sizes, int n_in, void* d_out, int out_size, void* d_ws, size_t ws_size, hipStream_t stream) {
    static int grid = 0;
    if (grid == 0) {
        if (n_in != N_IN || out_size != M * D || ws_size < WS_END) { fprintf(stderr, "kernel_launch: unexpected shapes (n_in %d, out %d, ws %zu)\n", n_in, out_size, ws_size); grid = -1; return; }
        int dev = 0, cus = 0, per_cu = 0;
        if (hipGetDevice(&dev) != hipSuccess || hipDeviceGetAttribute(&cus, hipDeviceAttributeMultiprocessorCount, dev) != hipSuccess) { grid = -1; return; }
        if (hipFuncSetAttribute((const void*)fwd_kernel, hipFuncAttributeMaxDynamicSharedMemorySize, LDS_BYTES) != hipSuccess) { fprintf(stderr, "kernel_launch: hipFuncSetAttribute failed\n"); grid = -1; return; }
        if (hipOccupancyMaxActiveBlocksPerMultiprocessor(&per_cu, (const void*)fwd_kernel, NTHR, LDS_BYTES) != hipSuccess || per_cu < 1) fprintf(stderr, "kernel_launch: occupancy query reports %d\n", per_cu);
        (void)hipGetLastError();
        grid = cus;
    }
    if (grid < 0) return;
    (void)hipMemsetAsync((char*)d_ws + WS_CTL, 0, CTL_ZERO_BYTES, stream);
    Args a{};
    for (int i = 0; i < N_IN; ++i) a.in[i] = (const float*)d_in[i];
    a.out = (float*)d_out; a.ws = (unsigned char*)d_ws;
#if MK_ONE_LAUNCH
    a.ph_lo = 0; a.ph_hi = NPH;
    hipLaunchKernelGGL(fwd_kernel, dim3(grid), dim3(NTHR), LDS_BYTES, stream, a);
#else
    for (int p = 0; p < NPH; ++p) { a.ph_lo = p; a.ph_hi = p + 1; hipLaunchKernelGGL(fwd_kernel, dim3(grid), dim3(NTHR), LDS_BYTES, stream, a); }
#endif
    const hipError_t le = hipPeekAtLastError();
    if (le != hipSuccess) fprintf(stderr, "kernel_launch: launch failed: %s\n", hipGetErrorName(le));
}
```

```cpp
#include <hip/hip_runtime.h>
#include <cstdio>
#include <cstdint>

#ifndef MK_ONE_LAUNCH
#define MK_ONE_LAUNCH 1
#endif

#define LAS __attribute__((address_space(3)))
#define GAS __attribute__((address_space(1)))
typedef unsigned short bf16;
typedef short bf16x8 __attribute__((ext_vector_type(8)));
typedef float f32x4 __attribute__((ext_vector_type(4)));
typedef float f32x2 __attribute__((ext_vector_type(2)));
typedef float f32x16 __attribute__((ext_vector_type(16)));
typedef unsigned u32x4 __attribute__((ext_vector_type(4)));
typedef unsigned u32x2 __attribute__((ext_vector_type(2)));
typedef __bf16 bf16x2_t __attribute__((ext_vector_type(2)));
typedef GAS unsigned gu32;
#define RLX_AGENT __ATOMIC_RELAXED, __HIP_MEMORY_SCOPE_AGENT
#define DI __device__ __forceinline__

constexpr int NWAVES = 8, NTHR = 512;
constexpr int D = 1024, BATCH = 16, SEQ = 4096, M = BATCH * SEQ, DEPTH = 2, MEML = 256, MROWS = BATCH * MEML;
constexpr int DIN = 6920, NU = 6912;
constexpr int UC_QK = 0, UC_RW = 512, UC_V = 2304, UC_OG = 2816, UC_CAQ = 3328, UC_GATE = 3840;
constexpr int UC_F8 = UC_V, NF8 = NU - UC_F8;
__host__ __device__ constexpr int ucol_src(int c) { return c < 512 ? c : (c < 2304 ? 1544 + (c - 512) : (c < 2816 ? 512 + (c - 2304) : (c < 3328 ? 1024 + (c - 2816) : (c < 3840 ? 3336 + (c - 3328) : 3848 + (c - 3840))))); }
constexpr int NEXP = 32, TOPK = 4;
constexpr int PMAX = M * TOPK / 256 + NEXP;
constexpr float LN_EPS = 1e-5f, RW_GN_EPS = 64e-5f, DN_ALPHA = 1.41421356237f;

enum { I_X = 0, I_MEM, I_LNIN_G, I_LNIN_B, I_MEMLN_G, I_MEMLN_B, I_WIN, I_CONVW, I_CONVB, I_IGB, I_FGB, I_MLNORMG, I_RWMU, I_RWW0, I_RWWUP, I_RWA0, I_RWAUP, I_RWGUP,
       I_RWKK, I_RWKA, I_RWRK, I_RWLNG, I_RWLNB, I_CAWKV, I_GATEB, I_WBRML, I_WBRRW, I_WBRCA, I_WO, I_LN1G, I_LN1B, I_RTW, I_RTB, I_WGU, I_BGU, I_WDN, I_BDN, I_LN2G, I_LN2B, N_IN };

constexpr size_t MiB = 1u << 20;
constexpr size_t WS_CTL = 0, CTL_ZERO_BYTES = 1 * MiB;
constexpr size_t WS_WIN = 1 * MiB;
constexpr size_t WS_WKV = 28 * MiB;
constexpr size_t WS_WBR = 32 * MiB;
constexpr size_t WS_WO = 38 * MiB;
constexpr size_t WS_WLORA = 42 * MiB;
constexpr size_t WS_WGU = 45 * MiB;
constexpr size_t WS_WDN = 173 * MiB;
constexpr size_t WS_X = 237 * MiB;
constexpr size_t WS_MEMN = 365 * MiB;
constexpr size_t WS_KV = 373 * MiB;
constexpr size_t WS_GIF = 389 * MiB;
constexpr size_t WS_TKE = 391 * MiB, WS_TKG = 392 * MiB, WS_TKP = 393 * MiB;
constexpr size_t WS_ROWTOK = 394 * MiB;
constexpr size_t WS_HML = 402 * MiB;
constexpr size_t WS_R1 = 466 * MiB;
constexpr size_t WS_R2 = 1330 * MiB;
constexpr size_t WS_XF8 = 1858 * MiB;
constexpr size_t WS_WING8 = 1922 * MiB;
constexpr size_t WS_END = 1932 * MiB;
constexpr size_t R2_LORA_OUT = 0, R2_HCAT = 192 * MiB, R2_LORA_IN = 384 * MiB, R2_YPRE = 0, R2_Z = 192 * MiB, R2_HMID = 0;
constexpr int CW_TMO = 0, CW_BAR = 4096, CW_CNT = 16384;

constexpr int LDS_BYTES = 155648;
constexpr int LDSCTL_OFF = 153600;

DI unsigned pk2(float lo, float hi) { bf16x2_t b = __builtin_convertvector((f32x2){lo, hi}, bf16x2_t); return __builtin_bit_cast(unsigned, b); }
DI unsigned f2bf(float f) { return pk2(f, 0.f) & 0xffffu; }
DI float bflo(unsigned u) { return __builtin_bit_cast(float, u << 16); }
DI float bfhi(unsigned u) { return __builtin_bit_cast(float, u & 0xffff0000u); }
DI unsigned pk4_f8(float a, float b, float c, float d) {
    a = __builtin_amdgcn_fmed3f(a, -448.f, 448.f); b = __builtin_amdgcn_fmed3f(b, -448.f, 448.f); c = __builtin_amdgcn_fmed3f(c, -448.f, 448.f); d = __builtin_amdgcn_fmed3f(d, -448.f, 448.f);
    int w = 0; w = __builtin_amdgcn_cvt_pk_fp8_f32(a, b, w, false); w = __builtin_amdgcn_cvt_pk_fp8_f32(c, d, w, true); return (unsigned)w; }
DI float sigmoidf_(float x) { return __builtin_amdgcn_rcpf(1.f + __builtin_amdgcn_exp2f(-1.4426950408889634f * x)); }
template <int CTRL> DI float dppf(float x) { return __builtin_bit_cast(float, __builtin_amdgcn_update_dpp(0, __builtin_bit_cast(int, x), CTRL, 0xF, 0xF, true)); }
DI float red4(float x) { x += dppf<0xB1>(x); x += dppf<0x4E>(x); return x; }
DI float red8(float x) { x = red4(x); x += dppf<0x141>(x); return x; }
DI float red16(float x) { x = red8(x); x += dppf<0x140>(x); return x; }
DI float red8o(float x) { x += dppf<0xB1>(x); asm("" : "+v"(x)); x += dppf<0x4E>(x); asm("" : "+v"(x)); x += dppf<0x141>(x); asm("" : "+v"(x)); return x; }
DI float red16o(float x) { x = red8o(x); x += dppf<0x140>(x); asm("" : "+v"(x)); return x; }
typedef short s16x4 __attribute__((ext_vector_type(4)));
DI u32x2 trd4(const LAS unsigned char* img, int PB, int rowbase, int colbase, int lane) {
    const LAS unsigned char* p = img + (rowbase + ((lane & 15) >> 2)) * PB + (colbase + 16 * ((lane >> 4) & 1) + 4 * (lane & 3)) * 2;
    return __builtin_bit_cast(u32x2, __builtin_amdgcn_ds_read_tr16_b64_v4i16((LAS s16x4*)p)); }
DI bf16x8 trd8(const LAS unsigned char* img, int PB, int rb0, int rb1, int colbase, int lane) { const u32x2 lo = trd4(img, PB, rb0, colbase, lane), hi = trd4(img, PB, rb1, colbase, lane); return __builtin_bit_cast(bf16x8, (u32x4){lo.x, lo.y, hi.x, hi.y}); }
template <int CTRL, int RM> DI float dpp_keep(float x, float ident) { return __builtin_bit_cast(float, __builtin_amdgcn_update_dpp(__builtin_bit_cast(int, ident), __builtin_bit_cast(int, x), CTRL, RM, 0xF, false)); }
DI float scan_add64(float x) { x += dpp_keep<0x111, 0xF>(x, 0.f); x += dpp_keep<0x112, 0xF>(x, 0.f); x += dpp_keep<0x114, 0xF>(x, 0.f); x += dpp_keep<0x118, 0xF>(x, 0.f); x += dpp_keep<0x142, 0xA>(x, 0.f); x += dpp_keep<0x143, 0xC>(x, 0.f); return x; }
DI float scan_max64(float x) { const float NI = -3.0e38f; x = fmaxf(x, dpp_keep<0x111, 0xF>(x, NI)); x = fmaxf(x, dpp_keep<0x112, 0xF>(x, NI)); x = fmaxf(x, dpp_keep<0x114, 0xF>(x, NI)); x = fmaxf(x, dpp_keep<0x118, 0xF>(x, NI));
    x = fmaxf(x, dpp_keep<0x142, 0xA>(x, NI)); x = fmaxf(x, dpp_keep<0x143, 0xC>(x, NI)); return x; }
DI float wave_sum(float v) {
    v = red16(v);
    const int vi = __builtin_bit_cast(int, v);
    const float a = __builtin_bit_cast(float, __builtin_amdgcn_readlane(vi, 0)), b = __builtin_bit_cast(float, __builtin_amdgcn_readlane(vi, 16));
    const float c = __builtin_bit_cast(float, __builtin_amdgcn_readlane(vi, 32)), d = __builtin_bit_cast(float, __builtin_amdgcn_readlane(vi, 48));
    return (a + b) + (c + d);
}
#define LDS_WAIT() asm volatile("s_waitcnt lgkmcnt(0)" ::: "memory")

constexpr float F8_SX = 8.f, F8_SWGU = 512.f, F8_SH = 4.f, F8_SWDN = 1024.f, F8_INV1 = 1.f / (F8_SX * F8_SWGU), F8_INV2 = 1.f / (F8_SH * F8_SWDN);
namespace pg8 {
constexpr int BM = 256, BK = 64, HALF = 128, HTB = HALF * BK * 2, STAGE_BYTES = 8 * HTB, NXCD = 8, WGM = 8;
__host__ __device__ __forceinline__ int lds_byte(int r, int c) { const int st = (r >> 4) * 2 + (c >> 5), rr = r & 15, cc = c & 31, ob = rr * 64 + cc * 2; return st * 1024 + (ob ^ (((ob >> 9) & 1) << 5)); }
__host__ __device__ __forceinline__ void stage_rc(int b, int& R, int& C) { const int st = b / 1024, sb = b % 1024, swz = sb ^ (((sb >> 9) & 1) << 5); R = (st >> 1) * 16 + swz / 64; C = (st & 1) * 32 + (swz % 64) / 2; }
__host__ __device__ __forceinline__ int perm32(int rho) { const int n = rho >> 4, i = rho & 15; return 8 * (i >> 2) + 4 * n + (i & 3); }

struct Unit { const char* a; const char* b; char* c; int ldc; int r0, c0, e, sub; };

struct TileOrder {
    int nM, nN, nwg;
    DI void init(int nM_, int nN_) { nM = nM_; nN = nN_; nwg = nM * nN; }
    DI bool tile(long L, int& pm, int& pn) const {
        if (L >= nwg) return false;
        int wgid = (int)L; { const int q = nwg / NXCD, r = nwg % NXCD, xcd = wgid % NXCD, off = wgid / NXCD; wgid = (xcd < r ? xcd * (q + 1) : r * (q + 1) + (xcd - r) * q) + off; }
        const int nig = WGM * nN, gid = wgid / nig, fm = gid * WGM, gsz = (nM - fm) < WGM ? (nM - fm) : WGM;
        pm = fm + ((wgid % nig) % gsz); pn = (wgid % nig) / gsz; return true;
    }
};

DI u32x4 pack8(const f32x4& v0, const f32x4& v1) { u32x4 w; w.x = pk2(v0[0], v0[1]); w.y = pk2(v0[2], v0[3]); w.z = pk2(v1[0], v1[1]); w.w = pk2(v1[2], v1[3]); return w; }

struct EpiStore {
    DI void operator()(const f32x4 (&acc)[2][2][4][2], const Unit& u, int wr, int wc, int fr, int fq) const {
#pragma unroll
        for (int ai = 0; ai < 2; ++ai)
#pragma unroll
            for (int m = 0; m < 4; ++m) { char* rowp = u.c + ((size_t)(ai * HALF + wr * 64 + m * 16 + fr) * u.ldc + wc * 32 + 8 * fq) * 2;
#pragma unroll
                for (int bj = 0; bj < 2; ++bj) *(u32x4*)(rowp + bj * 256) = pack8(acc[ai][bj][m][0], acc[ai][bj][m][1]); }
    }
};
struct EpiStoreS {
    float s; const float* gate_b; int gate_c0;
    DI void operator()(const f32x4 (&acc)[2][2][4][2], const Unit& u, int wr, int wc, int fr, int fq) const {
        const bool gate = u.c0 >= gate_c0;
        const float L2E = 1.4426950408889634f;
#pragma unroll
        for (int bj = 0; bj < 2; ++bj) {
            f32x4 g0 = (f32x4){0.f, 0.f, 0.f, 0.f}, g1 = g0;
            if (gate) { const float* g = gate_b + (u.c0 - gate_c0) + bj * HALF + wc * 32 + 8 * fq; g0 = *(const f32x4*)g; g1 = *(const f32x4*)(g + 4); }
#pragma unroll
            for (int ai = 0; ai < 2; ++ai)
#pragma unroll
                for (int m = 0; m < 4; ++m) { char* rowp = u.c + ((size_t)(ai * HALF + wr * 64 + m * 16 + fr) * u.ldc + wc * 32 + 8 * fq) * 2;
                    f32x4 v0 = acc[ai][bj][m][0] * s, v1 = acc[ai][bj][m][1] * s;
                    if (gate) {
#pragma unroll
                        for (int i = 0; i < 4; ++i) { v0[i] = __builtin_amdgcn_exp2f(-L2E * __builtin_amdgcn_fmed3f(v0[i] + g0[i], -30.f, 30.f)); v1[i] = __builtin_amdgcn_exp2f(-L2E * __builtin_amdgcn_fmed3f(v1[i] + g1[i], -30.f, 30.f)); } }
                    *(u32x4*)(rowp + bj * 256) = pack8(v0, v1); }
        }
    }
};
struct EpiMerge {
    static constexpr bool MIDK = true;
    const char* U; const float* gate_b;
    DI void mid(f32x4 (&acc)[2][2][4][2], const Unit& u, int which, int wr, int wc, int fr, int fq) const {
#pragma unroll
        for (int bj = 0; bj < 2; ++bj)
#pragma unroll
            for (int ai = 0; ai < 2; ++ai) {
                u32x4 wa[4], wn[4];
#pragma unroll
                for (int m = 0; m < 4; ++m) { const int lr = ai * HALF + wr * 64 + m * 16 + fr;
                    const char* gp = U + ((size_t)(u.r0 + lr) * NU + UC_GATE + which * 1024 + u.c0 + wc * 32 + 8 * fq) * 2 + bj * 256;
                    wa[m] = *(const u32x4*)gp; wn[m] = *(const u32x4*)(gp + 2048); }
#pragma unroll
                for (int m = 0; m < 4; ++m) {
                    const u32x4 a = wa[m], n = wn[m];
                    const float ea[8] = {bflo(a.x), bfhi(a.x), bflo(a.y), bfhi(a.y), bflo(a.z), bfhi(a.z), bflo(a.w), bfhi(a.w)};
                    const float en[8] = {bflo(n.x), bfhi(n.x), bflo(n.y), bfhi(n.y), bflo(n.z), bfhi(n.z), bflo(n.w), bfhi(n.w)};
#pragma unroll
                    for (int i = 0; i < 8; ++i) acc[ai][bj][m][i >> 2][i & 3] *= (1.f + en[i]) * __builtin_amdgcn_rcpf(1.f + ea[i]); }
                asm volatile("" ::: "memory"); }
    }
    DI void operator()(const f32x4 (&acc)[2][2][4][2], const Unit& u, int wr, int wc, int fr, int fq) const {
#pragma unroll
        for (int bj = 0; bj < 2; ++bj) {
            u32x4 gw[2][4];
#pragma unroll
            for (int ai = 0; ai < 2; ++ai)
#pragma unroll
                for (int m = 0; m < 4; ++m) { const int lr = ai * HALF + wr * 64 + m * 16 + fr; gw[ai][m] = *(const u32x4*)(U + ((size_t)(u.r0 + lr) * NU + UC_GATE + 2048 + u.c0 + wc * 32 + 8 * fq) * 2 + bj * 256); }
#pragma unroll
            for (int ai = 0; ai < 2; ++ai)
#pragma unroll
                for (int m = 0; m < 4; ++m) { const int lr = ai * HALF + wr * 64 + m * 16 + fr; char* rowp = u.c + ((size_t)lr * u.ldc + wc * 32 + 8 * fq) * 2; const u32x4 w = gw[ai][m];
                    f32x4 v0 = acc[ai][bj][m][0], v1 = acc[ai][bj][m][1];
                    v0[0] *= __builtin_amdgcn_rcpf(1.f + bflo(w.x)); v0[1] *= __builtin_amdgcn_rcpf(1.f + bfhi(w.x)); v0[2] *= __builtin_amdgcn_rcpf(1.f + bflo(w.y)); v0[3] *= __builtin_amdgcn_rcpf(1.f + bfhi(w.y));
                    v1[0] *= __builtin_amdgcn_rcpf(1.f + bflo(w.z)); v1[1] *= __builtin_amdgcn_rcpf(1.f + bfhi(w.z)); v1[2] *= __builtin_amdgcn_rcpf(1.f + bflo(w.w)); v1[3] *= __builtin_amdgcn_rcpf(1.f + bfhi(w.w));
                    *(u32x4*)(rowp + bj * 256) = pack8(v0, v1); }
            asm volatile("" ::: "memory");
        }
    }
};
struct EpiWo {
    const char* X;
    DI void operator()(const f32x4 (&acc)[2][2][4][2], const Unit& u, int wr, int wc, int fr, int fq) const {
#pragma unroll
        for (int ai = 0; ai < 2; ++ai)
#pragma unroll
            for (int m = 0; m < 4; ++m) { const int lr = ai * HALF + wr * 64 + m * 16 + fr; char* rowp = u.c + ((size_t)lr * u.ldc + wc * 32 + 8 * fq) * 2;
                const char* xp = X + ((size_t)(u.r0 + lr) * D + u.c0 + wc * 32 + 8 * fq) * 2;
#pragma unroll
                for (int bj = 0; bj < 2; ++bj) { const u32x4 xw = *(const u32x4*)(xp + bj * 256);
                    f32x4 v0 = acc[ai][bj][m][0], v1 = acc[ai][bj][m][1];
                    v0[0] += DN_ALPHA * bflo(xw.x); v0[1] += DN_ALPHA * bfhi(xw.x); v0[2] += DN_ALPHA * bflo(xw.y); v0[3] += DN_ALPHA * bfhi(xw.y);
                    v1[0] += DN_ALPHA * bflo(xw.z); v1[1] += DN_ALPHA * bfhi(xw.z); v1[2] += DN_ALPHA * bflo(xw.w); v1[3] += DN_ALPHA * bfhi(xw.w);
                    *(u32x4*)(rowp + bj * 256) = pack8(v0, v1); }
                asm volatile("" ::: "memory"); }
    }
};
DI float swiglu1(float a, float b) { const float g = fminf(a, 7.f), l = fminf(fmaxf(b, -7.f), 7.f); return g * sigmoidf_(1.702f * g) * (l + 1.f); }
struct EpiMoe1 {
    const float* bgu;
    DI void operator()(const f32x4 (&acc)[2][2][4][2], const Unit& u, int wr, int wc, int fr, int fq) const {
        f32x4 bv[2][2];
#pragma unroll
        for (int bj = 0; bj < 2; ++bj) { const float* b = bgu + u.e * 2048 + u.c0 + bj * HALF + wc * 32 + 8 * fq; bv[bj][0] = *(const f32x4*)b; bv[bj][1] = *(const f32x4*)(b + 4); }
#pragma unroll
        for (int ai = 0; ai < 2; ++ai)
#pragma unroll
            for (int m = 0; m < 4; ++m) { const int lr = ai * HALF + wr * 64 + m * 16 + fr; char* rowp = u.c + ((size_t)lr * u.ldc + wc * 16 + 4 * fq);
#pragma unroll
                for (int bj = 0; bj < 2; ++bj) { const f32x4 v0 = acc[ai][bj][m][0] * F8_INV1 + bv[bj][0], v1 = acc[ai][bj][m][1] * F8_INV1 + bv[bj][1];
                    *(unsigned*)(rowp + bj * 64) = pk4_f8(swiglu1(v0[0], v0[1]) * F8_SH, swiglu1(v0[2], v0[3]) * F8_SH, swiglu1(v1[0], v1[1]) * F8_SH, swiglu1(v1[2], v1[3]) * F8_SH); } }
    }
};
struct EpiMoe2 {
    const float* bdn;
    DI void operator()(const f32x4 (&acc)[2][2][4][2], const Unit& u, int wr, int wc, int fr, int fq) const {
        f32x4 bv[2][2];
#pragma unroll
        for (int bj = 0; bj < 2; ++bj) { const float* b = bdn + u.e * 1024 + u.c0 + bj * HALF + wc * 32 + 8 * fq; bv[bj][0] = *(const f32x4*)b; bv[bj][1] = *(const f32x4*)(b + 4); }
#pragma unroll
        for (int ai = 0; ai < 2; ++ai)
#pragma unroll
            for (int m = 0; m < 4; ++m) { char* rowp = u.c + ((size_t)(ai * HALF + wr * 64 + m * 16 + fr) * u.ldc + wc * 32 + 8 * fq) * 2;
#pragma unroll
                for (int bj = 0; bj < 2; ++bj) *(u32x4*)(rowp + bj * 256) = pack8(acc[ai][bj][m][0] * F8_INV2 + bv[bj][0], acc[ai][bj][m][1] * F8_INV2 + bv[bj][1]); }
    }
};

typedef int i32x8 __attribute__((ext_vector_type(8)));
typedef int i32x4 __attribute__((ext_vector_type(4)));
template <bool F8, bool MIDK = false, class Epi, class Sched>
DI void gemm_phase(LAS unsigned char* lds, const int KB  , const int ldaB, const int ldbB, const Sched& S, const Epi& E, const int wave_) {
    unsigned z_ = 0u; asm volatile("" : "+v"(z_)); const int tid = wave_ * 64 + (int)__builtin_amdgcn_mbcnt_hi(~0u, __builtin_amdgcn_mbcnt_lo(~0u, z_));
    const int wid = __builtin_amdgcn_readfirstlane(tid >> 6), lane = tid & 63, wr = wid >> 2, wc = wid & 3, fr = lane & 15, fq = lane >> 4;
    const int nt = KB / (BK * 2);
    unsigned voffA[2], voffB[2];
#pragma unroll
    for (int i = 0; i < 2; ++i) { int R, C; stage_rc(tid * 16 + i * 8192, R, C); const int Rb = (R & ~31) + perm32(R & 31);
        voffA[i] = (unsigned)(R * ldaB + C * 2); voffB[i] = (unsigned)(Rb * ldbB + C * 2); }
    asm volatile("" : "+v"(voffA[0]), "+v"(voffA[1]), "+v"(voffB[0]), "+v"(voffB[1]));
    const size_t kstep = (size_t)(BK * 2);
    const size_t hstepA = (size_t)HALF * ldaB, hstepB = (size_t)HALF * ldbB;
    const unsigned ldsw = (unsigned)wid * 1024u;
    const int aoff = lds_byte(wr * 64 + fr, fq * 8), boff = lds_byte(wc * 32 + fr, fq * 8);
#define PG8_SA(b, h) (((b) * 2 + (h)) * HTB)
#define PG8_SB(b, h) ((4 + (b) * 2 + (h)) * HTB)
#define PG8_STAGE(bufoff, gbase, voff) do { _Pragma("unroll") for (int _i = 0; _i < 2; ++_i) \
        __builtin_amdgcn_global_load_lds((const unsigned*)((const char*)(gbase) + (voff)[_i]), (LAS unsigned*)(lds + (bufoff) + ldsw + _i * 8192), 16, 0, 0); } while (0)
#define PG8_LD8(p) __builtin_shufflevector(*(const LAS i32x4*)(p), *(const LAS i32x4*)((p) + 1024), 0, 1, 2, 3, 4, 5, 6, 7)
#define PG8_LDA8(dst, b, h) do { _Pragma("unroll") for (int m = 0; m < 4; ++m) dst[m] = PG8_LD8(lds + PG8_SA(b, h) + aoff + m * 2048); } while (0)
#define PG8_LDB8(dst, b, h) do { _Pragma("unroll") for (int n = 0; n < 2; ++n) dst[n] = PG8_LD8(lds + PG8_SB(b, h) + boff + n * 2048); } while (0)
#define PG8_MMA8(ai, bj, A8, B8) do { __builtin_amdgcn_s_setprio(1); _Pragma("unroll") for (int m = 0; m < 4; ++m) _Pragma("unroll") for (int n = 0; n < 2; ++n) \
        asm volatile("v_mfma_f32_16x16x128_f8f6f4 %0, %1, %2, %0" : "+v"(acc[ai][bj][m][n]) : "v"(B8[n]), "v"(A8[m])); __builtin_amdgcn_s_setprio(0); } while (0)
#define PG8_LDA(dst, b, h) do { _Pragma("unroll") for (int m = 0; m < 4; ++m) _Pragma("unroll") for (int k = 0; k < 2; ++k) dst[m][k] = *(const LAS bf16x8*)(lds + PG8_SA(b, h) + aoff + m * 2048 + k * 1024); } while (0)
#define PG8_LDB(dst, b, h) do { _Pragma("unroll") for (int n = 0; n < 2; ++n) _Pragma("unroll") for (int k = 0; k < 2; ++k) dst[n][k] = *(const LAS bf16x8*)(lds + PG8_SB(b, h) + boff + n * 2048 + k * 1024); } while (0)
#define PG8_CAT(x) __builtin_shufflevector(__builtin_bit_cast(i32x4, (x)[0]), __builtin_bit_cast(i32x4, (x)[1]), 0, 1, 2, 3, 4, 5, 6, 7)
#define PG8_MMA(ai, bj, At, Bt) do { __builtin_amdgcn_s_setprio(1); _Pragma("unroll") for (int m = 0; m < 4; ++m) _Pragma("unroll") for (int n = 0; n < 2; ++n) _Pragma("unroll") for (int k = 0; k < 2; ++k) \
        acc[ai][bj][m][n] = __builtin_amdgcn_mfma_f32_16x16x32_bf16(Bt[n][k], At[m][k], acc[ai][bj][m][n], 0, 0, 0); __builtin_amdgcn_s_setprio(0); } while (0)
#define PG8_WAIT_V(n) asm volatile("s_waitcnt vmcnt(" #n ")" ::: "memory")
#define PG8_WAIT_L(n) asm volatile("s_waitcnt lgkmcnt(" #n ")" ::: "memory")
#define PG8_BAR __builtin_amdgcn_s_barrier()
#define PG8_SCHED __builtin_amdgcn_sched_barrier(0)
    Unit cur, nxt; int ui = 0;
    if (!S.next(0, cur)) return;
    f32x4 acc[2][2][4][2];
#pragma unroll
    for (int a = 0; a < 2; ++a)
#pragma unroll
        for (int b = 0; b < 2; ++b)
#pragma unroll
            for (int m = 0; m < 4; ++m)
#pragma unroll
                for (int n = 0; n < 2; ++n) acc[a][b][m][n] = (f32x4){0.f, 0.f, 0.f, 0.f};
    bf16x8 At[4][2], B0[2][2], B1[2][2]; i32x8 A8[4], B80[2], B81[2];
    const char* cA = cur.a; const char* cB = cur.b;
    PG8_STAGE(PG8_SB(0, 0), cB, voffB); PG8_STAGE(PG8_SB(0, 1), cB + hstepB, voffB); PG8_STAGE(PG8_SA(0, 0), cA, voffA); PG8_STAGE(PG8_SA(0, 1), cA + hstepA, voffA);
    if (wr == 1) PG8_BAR;
    PG8_WAIT_V(2); PG8_BAR;
    PG8_STAGE(PG8_SB(1, 0), cB + kstep, voffB); PG8_STAGE(PG8_SA(1, 0), cA + kstep, voffA); PG8_STAGE(PG8_SB(1, 1), cB + hstepB + kstep, voffB);
    PG8_WAIT_V(6); PG8_BAR;
    for (;;) {
        const bool has_next = S.next(ui + 1, nxt);
        const char* nA = has_next ? nxt.a : cA; const char* nB = has_next ? nxt.b : cB;
#pragma unroll 1
        for (int t = 0; t < nt; t += 2) {
            if constexpr (MIDK) { if (t == 8 || t == 16) { int fr_ = fr, fq_ = fq; asm volatile("" : "+v"(fr_), "+v"(fq_)); E.mid(acc, cur, t >> 4, wr, wc, fr_, fq_); } }
            const bool last = (t == nt - 2);
            const char* a1 = cA + (size_t)(t + 1) * kstep;
            const char* a2 = last ? nA : cA + (size_t)(t + 2) * kstep; const char* b2 = last ? nB : cB + (size_t)(t + 2) * kstep;
            const char* a3 = a2 + kstep; const char* b3 = b2 + kstep;
            if constexpr (F8) {
            PG8_LDB8(B80, 0, 0); PG8_LDB8(B81, 0, 1); PG8_SCHED; PG8_LDA8(A8, 0, 0); PG8_STAGE(PG8_SA(1, 1), a1 + hstepA, voffA);
            PG8_WAIT_V(8); PG8_WAIT_L(0); PG8_BAR; PG8_MMA8(0, 0, A8, B80); PG8_MMA8(0, 1, A8, B81); PG8_BAR; PG8_SCHED;
            PG8_LDA8(A8, 0, 1); PG8_STAGE(PG8_SB(0, 0), b2, voffB); PG8_STAGE(PG8_SB(0, 1), b2 + hstepB, voffB); PG8_STAGE(PG8_SA(0, 0), a2, voffA);
            PG8_WAIT_V(8); PG8_WAIT_L(0); PG8_BAR; PG8_MMA8(1, 0, A8, B80); PG8_MMA8(1, 1, A8, B81); PG8_BAR; PG8_SCHED;
            PG8_LDB8(B80, 1, 0); PG8_LDB8(B81, 1, 1); PG8_SCHED; PG8_LDA8(A8, 1, 0); PG8_STAGE(PG8_SA(0, 1), a2 + hstepA, voffA);
            PG8_WAIT_V(8); PG8_WAIT_L(0); PG8_BAR; PG8_MMA8(0, 0, A8, B80); PG8_MMA8(0, 1, A8, B81); PG8_BAR; PG8_SCHED;
            PG8_LDA8(A8, 1, 1); PG8_STAGE(PG8_SB(1, 0), b3, voffB); PG8_STAGE(PG8_SB(1, 1), b3 + hstepB, voffB); PG8_STAGE(PG8_SA(1, 0), a3, voffA);
            PG8_WAIT_V(8); PG8_WAIT_L(0); PG8_BAR; PG8_MMA8(1, 0, A8, B80); PG8_MMA8(1, 1, A8, B81); PG8_BAR; PG8_SCHED;
            } else {
            PG8_LDB(B0, 0, 0); PG8_LDB(B1, 0, 1); PG8_SCHED; PG8_LDA(At, 0, 0); PG8_STAGE(PG8_SA(1, 1), a1 + hstepA, voffA);
            PG8_WAIT_V(8); PG8_WAIT_L(0); PG8_BAR; PG8_MMA(0, 0, At, B0); PG8_MMA(0, 1, At, B1); PG8_BAR; PG8_SCHED;
            PG8_LDA(At, 0, 1); PG8_STAGE(PG8_SB(0, 0), b2, voffB); PG8_STAGE(PG8_SB(0, 1), b2 + hstepB, voffB); PG8_STAGE(PG8_SA(0, 0), a2, voffA);
            PG8_WAIT_V(8); PG8_WAIT_L(0); PG8_BAR; PG8_MMA(1, 0, At, B0); PG8_MMA(1, 1, At, B1); PG8_BAR; PG8_SCHED;
            PG8_LDB(B0, 1, 0); PG8_LDB(B1, 1, 1); PG8_SCHED; PG8_LDA(At, 1, 0); PG8_STAGE(PG8_SA(0, 1), a2 + hstepA, voffA);
            PG8_WAIT_V(8); PG8_WAIT_L(0); PG8_BAR; PG8_MMA(0, 0, At, B0); PG8_MMA(0, 1, At, B1); PG8_BAR; PG8_SCHED;
            PG8_LDA(At, 1, 1); PG8_STAGE(PG8_SB(1, 0), b3, voffB); PG8_STAGE(PG8_SB(1, 1), b3 + hstepB, voffB); PG8_STAGE(PG8_SA(1, 0), a3, voffA);
            PG8_WAIT_V(8); PG8_WAIT_L(0); PG8_BAR; PG8_MMA(1, 0, At, B0); PG8_MMA(1, 1, At, B1); PG8_BAR; PG8_SCHED;
            }
        }
        if (wr == 0) PG8_BAR;
        if constexpr (F8) asm volatile("s_nop 15\n\ts_nop 15" ::: "memory");
        { int fr_ = fr, fq_ = fq; asm volatile("" : "+v"(fr_), "+v"(fq_));
          E(acc, cur, wr, wc, fr_, fq_); }
        if (!has_next) break;
#pragma unroll
        for (int a = 0; a < 2; ++a)
#pragma unroll
            for (int b = 0; b < 2; ++b)
#pragma unroll
                for (int m = 0; m < 4; ++m)
#pragma unroll
                    for (int n = 0; n < 2; ++n) acc[a][b][m][n] = (f32x4){0.f, 0.f, 0.f, 0.f};
        cur = nxt; cA = nA; cB = nB; ++ui;
        if (wr == 1) PG8_BAR;
    }
    PG8_WAIT_V(0);
    PG8_BAR;
#undef PG8_SA
#undef PG8_SB
#undef PG8_STAGE
#undef PG8_LDA
#undef PG8_LDB
#undef PG8_MMA
#undef PG8_CAT
#undef PG8_LD8
#undef PG8_LDA8
#undef PG8_LDB8
#undef PG8_MMA8
#undef PG8_WAIT_V
#undef PG8_WAIT_L
#undef PG8_BAR
#undef PG8_SCHED
}
}

#define XB_TMO      128
#define XB_XCNT(j)  (256  + 64 * (j))
#define XB_XSUB(j)  (1280 + 64 * (j))
#define XB_XGEN(j)  (2304 + 64 * (j))
#define XB_TOP      3328
#define XB_TOPGEN   3392
#define XCD_BAR_WORDS 3456
#define XB_SPIN_CAP (1u << 22)
DI unsigned xb_ld(unsigned* p)              { return __hip_atomic_load(p, __ATOMIC_RELAXED, __HIP_MEMORY_SCOPE_AGENT); }
DI unsigned xb_add(unsigned* p, unsigned v) { return __hip_atomic_fetch_add(p, v, __ATOMIC_RELAXED, __HIP_MEMORY_SCOPE_AGENT); }
DI unsigned xb_xcc_id() { return (unsigned)__builtin_amdgcn_s_getreg((3 << 11) | 20) & 0xFu; }
#define XB_SPIN(cond, bar) do { unsigned _sp = 0; while (cond) { __builtin_amdgcn_s_sleep(1); \
    if ((++_sp & 255u) == 0u) { if (xb_ld(&(bar)[XB_TMO])) break; if (_sp > XB_SPIN_CAP) { atomicAdd(&(bar)[XB_TMO], 1u); break; } } } } while (0)
struct XcdBarrier { unsigned* bar; unsigned x; volatile LAS unsigned* st; };
DI XcdBarrier xcd_barrier_post(unsigned* bar, volatile LAS unsigned* st) {
    XcdBarrier b; b.bar = bar; b.x = xb_xcc_id(); b.st = st;
    if (threadIdx.x == 0) (void)xb_add(&bar[XB_XCNT(b.x)], 1u);
    return b;
}
DI void xcd_barrier_complete(unsigned* bar, unsigned x, unsigned& nloc, unsigned& nx) {
    const unsigned G = gridDim.x * gridDim.y * gridDim.z;
    unsigned sum, cnt, mine, sp = 0u;
    for (;;) {
        sum = 0u; cnt = 0u; mine = 0u;
#pragma unroll
        for (unsigned j = 0; j < 16; ++j) { const unsigned c = xb_ld(&bar[XB_XCNT(j)]); sum += c; cnt += (c > 0u) ? 1u : 0u; mine = (j == x) ? c : mine; }
        if (sum == G) break;
        __builtin_amdgcn_s_sleep(1);
        if ((++sp & 255u) == 0u) { if (xb_ld(&bar[XB_TMO])) break; if (sp > XB_SPIN_CAP) { atomicAdd(&bar[XB_TMO], 1u); break; } }
    }
    nloc = mine > 0u ? mine : 1u; nx = cnt > 0u ? cnt : 1u;
}
DI void xcd_barrier(const XcdBarrier& b) {
    asm volatile("s_waitcnt vmcnt(0)" ::: "memory");
    __syncthreads();
    if (threadIdx.x == 0) {
        unsigned* bar = b.bar;
        __builtin_amdgcn_s_waitcnt(0);
        unsigned nloc = b.st[0], nx = b.st[1];
        if (nloc == 0u) { xcd_barrier_complete(bar, b.x, nloc, nx); b.st[0] = nloc; b.st[1] = nx; }
        const unsigned old = xb_add(&bar[XB_XSUB(b.x)], 1u);
        const unsigned gen = old / nloc;
        if (old + 1u == (gen + 1u) * nloc) {
            __builtin_amdgcn_fence(__ATOMIC_RELEASE, "agent");
            asm volatile("s_waitcnt vmcnt(0)" ::: "memory");
            const unsigned og = xb_add(&bar[XB_TOP], 1u);
            const unsigned tg = og / nx;
            if (og + 1u == (tg + 1u) * nx) xb_add(&bar[XB_TOPGEN], 1u);
            else XB_SPIN(xb_ld(&bar[XB_TOPGEN]) == tg, bar);
            __builtin_amdgcn_fence(__ATOMIC_ACQUIRE, "agent");
            xb_add(&bar[XB_XGEN(b.x)], 1u);
            asm volatile("s_waitcnt vmcnt(0)" ::: "memory");
        } else {
            XB_SPIN(xb_ld(&bar[XB_XGEN(b.x)]) == gen, bar);
            __builtin_amdgcn_fence(__ATOMIC_ACQUIRE, "agent");
            asm volatile("s_waitcnt vmcnt(0)" ::: "memory");
        }
    }
    __syncthreads();
}

DI void transpose_item(const float* W, int ldw, bf16* WT, int ldt, LAS float* scr, int lane) {
    { const int kr = lane >> 3, c4 = (lane & 7) * 4; f32x4 v[8];
#pragma unroll
        for (int i = 0; i < 8; ++i) v[i] = *(const f32x4*)(W + (size_t)(8 * i + kr) * ldw + c4);
#pragma unroll
        for (int i = 0; i < 8; ++i) { LAS float* o = scr + (8 * i + kr) * 33 + c4; o[0] = v[i].x; o[1] = v[i].y; o[2] = v[i].z; o[3] = v[i].w; } }
    LDS_WAIT(); asm volatile("" ::: "memory");
    const int c = lane & 7;
#pragma unroll
    for (int j = 0; j < 4; ++j) { const int n = (lane >> 3) + 8 * j; const LAS float* s = scr + (8 * c) * 33 + n;
        u32x4 o; o.x = pk2(s[0 * 33], s[1 * 33]); o.y = pk2(s[2 * 33], s[3 * 33]); o.z = pk2(s[4 * 33], s[5 * 33]); o.w = pk2(s[6 * 33], s[7 * 33]);
        *(u32x4*)(WT + (size_t)n * ldt + 8 * c) = o; }
    LDS_WAIT(); asm volatile("" ::: "memory");
}
DI void transpose_item_f8(const float* W, int ldw, unsigned char* WT, int ldt, float scale, LAS float* scr, int lane) {
    { const int kr = lane >> 3, c4 = (lane & 7) * 4; f32x4 v[8];
#pragma unroll
        for (int i = 0; i < 8; ++i) v[i] = *(const f32x4*)(W + (size_t)(8 * i + kr) * ldw + c4);
#pragma unroll
        for (int i = 0; i < 8; ++i) { LAS float* o = scr + (8 * i + kr) * 33 + c4; o[0] = v[i].x; o[1] = v[i].y; o[2] = v[i].z; o[3] = v[i].w; } }
    LDS_WAIT(); asm volatile("" ::: "memory");
    const int c = lane & 3;
#pragma unroll
    for (int j = 0; j < 2; ++j) { const int n = (lane >> 2) + 16 * j; const LAS float* s = scr + (16 * c) * 33 + n;
        u32x4 o; o.x = pk4_f8(s[0 * 33] * scale, s[1 * 33] * scale, s[2 * 33] * scale, s[3 * 33] * scale); o.y = pk4_f8(s[4 * 33] * scale, s[5 * 33] * scale, s[6 * 33] * scale, s[7 * 33] * scale);
        o.z = pk4_f8(s[8 * 33] * scale, s[9 * 33] * scale, s[10 * 33] * scale, s[11 * 33] * scale); o.w = pk4_f8(s[12 * 33] * scale, s[13 * 33] * scale, s[14 * 33] * scale, s[15 * 33] * scale);
        *(u32x4*)(WT + (size_t)n * ldt + 16 * c) = o; }
    LDS_WAIT(); asm volatile("" ::: "memory");
}
DI void ln16(f32x4 (&v)[4], const f32x4 (&g)[4], const f32x4 (&b)[4]) {
    float s = 0.f;
#pragma unroll
    for (int j = 0; j < 4; ++j) s += (v[j].x + v[j].y) + (v[j].z + v[j].w);
    const float mean = wave_sum(s) * (1.f / D); float s2 = 0.f;
#pragma unroll
    for (int j = 0; j < 4; ++j) { v[j] = v[j] - mean; s2 += (v[j].x * v[j].x + v[j].y * v[j].y) + (v[j].z * v[j].z + v[j].w * v[j].w); }
    const float rstd = 1.f / sqrtf(wave_sum(s2) * (1.f / D) + LN_EPS);
#pragma unroll
    for (int j = 0; j < 4; ++j) v[j] = v[j] * rstd * g[j] + b[j];
}
DI void gates8(const f32x4 (&y)[4], const LAS float* wgt, float* gif_row, int lane) {
    float p[8];
#pragma unroll
    for (int j = 0; j < 8; ++j) { float s = 0.f;
#pragma unroll
        for (int jj = 0; jj < 4; ++jj) { const f32x4 w = *(const LAS f32x4*)(wgt + j * 1024 + 256 * jj + 4 * lane); s += (y[jj].x * w.x + y[jj].y * w.y) + (y[jj].z * w.z + y[jj].w * w.w); }
        p[j] = wave_sum(s); }
    if (lane == 0) { *(f32x4*)gif_row = (f32x4){p[0], p[1], p[2], p[3]}; *(f32x4*)(gif_row + 4) = (f32x4){p[4], p[5], p[6], p[7]}; }
}
DI void gates8b(const f32x4 (&y)[4], const LAS float* wgt, float* gif_row, int lane) {
    float p[8];
#pragma unroll
    for (int j = 0; j < 8; ++j) { float s = 0.f;
#pragma unroll
        for (int jj = 0; jj < 4; ++jj) { const f32x4 w = *(const LAS f32x4*)(wgt + j * 1024 + (jj >> 1) * 512 + 8 * lane + (jj & 1) * 4); s += (y[jj].x * w.x + y[jj].y * w.y) + (y[jj].z * w.z + y[jj].w * w.w); }
        p[j] = wave_sum(s); }
    if (lane == 0) { *(f32x4*)gif_row = (f32x4){p[0], p[1], p[2], p[3]}; *(f32x4*)(gif_row + 4) = (f32x4){p[4], p[5], p[6], p[7]}; }
}
DI void load_gate_table(LAS float* wgt, const float* win_l, int tid) {
    for (int i = tid; i < 8192; i += NTHR) { const int k = i >> 3, j = i & 7; wgt[j * 1024 + k] = win_l[(size_t)k * DIN + 1536 + j]; }
}
DI f32x4 ld4bf(const char* p) { const u32x2 w = *(const u32x2*)p; return (f32x4){bflo(w.x), bfhi(w.x), bflo(w.y), bfhi(w.y)}; }
DI void st4bf(char* p, const f32x4& v) { u32x2 w; w.x = pk2(v.x, v.y); w.y = pk2(v.z, v.w); *(u32x2*)p = w; }

struct Args { const float* in[N_IN]; float* out; unsigned char* ws; int ph_lo, ph_hi; };
constexpr int NP_LAYER = 12, NPH = 1 + DEPTH * NP_LAYER;
constexpr int XW_SPLIT = 49152;

struct SchedInproj {
    pg8::TileOrder T; int G, c; const char *X, *W; char* U; bool kv; const char *MEMN, *WKV; char* KV;
    DI bool next(int i, pg8::Unit& u) const {
        const long L = (long)i * G + c; int pm, pn;
        if (T.tile(L, pm, pn)) { u.a = X + (size_t)pm * 256 * D * 2; u.b = W + (size_t)pn * 256 * D * 2; u.r0 = pm * 256; u.c0 = pn * 256; u.c = U + ((size_t)u.r0 * NU + u.c0) * 2; u.ldc = NU; u.e = 0; u.sub = 0; return true; }
        if (!kv) return false;
        const long L2 = L - T.nwg; if (L2 < 0 || L2 >= 128) return false;
        const int l = (int)L2 >> 6, t = (int)L2 & 63; pm = t >> 2; pn = t & 3;
        u.a = MEMN + (size_t)pm * 256 * D * 2; u.b = WKV + ((size_t)l * 1024 + pn * 256) * D * 2; u.r0 = pm * 256; u.c0 = pn * 256; u.c = KV + (((size_t)l * MROWS + u.r0) * D + u.c0) * 2; u.ldc = D; u.e = 0; u.sub = 0; return true;
    }
};
struct SchedPlain {
    pg8::TileOrder T; int G, c; const char *A, *B; char* C; int lda, ldb, ldc;
    DI bool next(int i, pg8::Unit& u) const {
        const long L = (long)i * G + c; int pm, pn; if (!T.tile(L, pm, pn)) return false;
        u.a = A + (size_t)pm * 256 * lda * 2; u.b = B + (size_t)pn * 256 * ldb * 2; u.r0 = pm * 256; u.c0 = pn * 256; u.c = C + ((size_t)u.r0 * ldc + u.c0) * 2; u.ldc = ldc; u.e = 0; u.sub = 0; return true;
    }
};
struct SchedMerge {
    pg8::TileOrder T; int G, c; const char *H, *W; char* Y;
    DI bool next(int i, pg8::Unit& u) const {
        const int ti = i / 3, br = i - 3 * ti; const long L = (long)ti * G + c; int pm, pn; if (!T.tile(L, pm, pn)) return false;
        u.a = H + ((size_t)pm * 256 * 1536 + br * 512) * 2; u.b = W + ((size_t)br * 1024 + pn * 256) * 512 * 2; u.r0 = pm * 256; u.c0 = pn * 256; u.c = Y + ((size_t)u.r0 * D + u.c0) * 2; u.ldc = D; u.e = 0; u.sub = br; return true;
    }
};
struct SchedMoe {
    pg8::TileOrder T; int G, c; const char *A, *W; char* C; const LAS int* PB; int wrows  , ldc, cdiv, osz;
    DI bool next(int i, pg8::Unit& u) const {
        const long L = (long)i * G + c; int pm, pn; if (!T.tile(L, pm, pn)) return false;
        int e = 0;
#pragma unroll 1
        for (int j = 1; j < NEXP; ++j) e += (PB[j] <= pm) ? 1 : 0;
        u.a = A + (size_t)pm * 256 * 1024; u.b = W + ((size_t)e * wrows + pn * 256) * 1024; u.r0 = pm * 256; u.c0 = pn * 256; u.c = C + ((size_t)u.r0 * ldc + u.c0 / cdiv) * osz; u.ldc = ldc; u.e = e; u.sub = 0; return true;
    }
};

__global__ void __launch_bounds__(NTHR, 2) fwd_kernel(Args args) {
    extern __shared__ __attribute__((aligned(16))) unsigned char lds_raw[];
#define INP(i) ([&]() -> const float* { int ii_ = (i); asm volatile("" : "+s"(ii_)); return args.in[ii_]; }())
    LAS unsigned char* lds = (LAS unsigned char*)lds_raw;
    volatile LAS unsigned* LCTL = (volatile LAS unsigned*)(lds + LDSCTL_OFF);
    const int tid0 = threadIdx.x, wave = __builtin_amdgcn_readfirstlane(tid0 >> 6);
#define PHASE_TID unsigned z_ = 0u; asm volatile("" : "+v"(z_)); int tid = wave * 64 + (int)__builtin_amdgcn_mbcnt_hi(~0u, __builtin_amdgcn_mbcnt_lo(~0u, z_)); const int lane = tid & 63; (void)lane;
    const int G = gridDim.x, bx = blockIdx.x;
    const int gw = bx * NWAVES + wave, NGW = G * NWAVES;
    unsigned char* ws = args.ws;
    gu32* ctl = (gu32*)(ws + WS_CTL);
    for (int u = tid0; u < (LDS_BYTES - LDSCTL_OFF) / 4; u += NTHR) ((LAS unsigned*)(lds + LDSCTL_OFF))[u] = 0u;
    __syncthreads();
    XcdBarrier bar; bar.bar = (unsigned*)ctl + CW_BAR; bar.x = 0; bar.st = nullptr;
    if (MK_ONE_LAUNCH) bar = xcd_barrier_post((unsigned*)ctl + CW_BAR, LCTL);
    const int lo = args.ph_lo, hi = args.ph_hi;
#ifndef SUBMASK
#define SUBMASK 7
#endif
#ifndef LN2PROBE
#define LN2PROBE 0
#endif
#ifndef SUBDUP
#define SUBDUP 0
#endif
#define NSUB(k) ((((SUBDUP) >> (k)) & 1) ? 2 : 1)
#ifndef DUPMASK
#define DUPMASK 0
#endif
#define NREP(k) ((((DUPMASK) >> (k)) & 1) ? 2 : 1)
#ifndef PHMASK
#define PHMASK 0xFFFF
#endif
#define IN(k) (lo <= (k) && (k) < hi)
#define SEAM(k) do { if (IN(k) && IN((k) + 1)) xcd_barrier(bar); } while (0)

    char* const Xb = (char*)(ws + WS_X);
    char* const Ub = (char*)(ws + WS_R1);
    float* const GIF = (float*)(ws + WS_GIF);
    LAS int* const PB = (LAS int*)(lds + LDSCTL_OFF + 64);
    LAS int* const CNT = (LAS int*)(lds + LDSCTL_OFF + 256);

    _Pragma("unroll 1") for (int rep_ = 0; rep_ < NREP(12); ++rep_) if (((PHMASK>>12)&1) && IN(0)) { PHASE_TID
        LAS float* scr = (LAS float*)(lds + wave * 8448);
        LAS float* wgt = (LAS float*)(lds + 73728);
        load_gate_table(wgt, INP(I_WIN), tid);
        constexpr int IT_IN = 16 * 216, IT_KV = 16 * 32, IT_BR = 8 * 32, IT_O = 16 * 32, IT_L = IT_IN + IT_KV + 3 * IT_BR + IT_O;
        for (int it = gw; it < DEPTH * IT_L; it += NGW) {
            const int l = it / IT_L; int r = it - l * IT_L;
            if (r < IT_IN) { const int kb = r / 216, nb = r % 216, n0 = 32 * nb, sc = ucol_src(n0);
                if (n0 < UC_F8) transpose_item(INP(I_WIN) + ((size_t)l * D + 64 * kb) * DIN + sc, DIN, (bf16*)(ws + WS_WIN) + ((size_t)l * NU + n0) * D + 64 * kb, D, scr, lane);
                else transpose_item_f8(INP(I_WIN) + ((size_t)l * D + 64 * kb) * DIN + sc, DIN, (unsigned char*)(ws + WS_WING8) + ((size_t)l * NF8 + (n0 - UC_F8)) * D + 64 * kb, D, F8_SWGU, scr, lane);
                continue; }
            r -= IT_IN;
            if (r < IT_KV) { const int kb = r / 32, nb = r % 32;
                transpose_item(INP(I_CAWKV) + ((size_t)l * D + 64 * kb) * 1024 + 32 * nb, 1024, (bf16*)(ws + WS_WKV) + ((size_t)l * 1024 + 32 * nb) * D + 64 * kb, D, scr, lane); continue; }
            r -= IT_KV;
            if (r < 3 * IT_BR) { const int br = r / IT_BR, q = r % IT_BR, kb = q / 32, nb = q % 32;
                const float* src = INP(br == 0 ? I_WBRML : (br == 1 ? I_WBRRW : I_WBRCA));
                transpose_item(src + ((size_t)l * 512 + 64 * kb) * 1024 + 32 * nb, 1024, (bf16*)(ws + WS_WBR) + ((size_t)l * 1024 + 32 * nb) * 1536 + br * 512 + 64 * kb, 1536, scr, lane); continue; }
            r -= 3 * IT_BR;
            { const int kb = r / 32, nb = r % 32;
                transpose_item(INP(I_WO) + ((size_t)l * D + 64 * kb) * 1024 + 32 * nb, 1024, (bf16*)(ws + WS_WO) + ((size_t)l * 1024 + 32 * nb) * D + 64 * kb, D, scr, lane); }
        }
        for (int i = bx * NTHR + tid; i < DEPTH * 1536 * 256; i += G * NTHR) {
            const int l = i / (1536 * 256), r = i % (1536 * 256), n = r >> 8, k = r & 255; float v = 0.f;
            if (n < 512) { if (k < 64) v = INP(I_RWWUP)[((size_t)l * 64 + k) * 512 + n]; }
            else if (n < 1024) { if (k >= 64 && k < 128) v = INP(I_RWAUP)[((size_t)l * 64 + (k - 64)) * 512 + (n - 512)]; }
            else { if (k >= 128) v = INP(I_RWGUP)[((size_t)l * 128 + (k - 128)) * 512 + (n - 1024)]; }
            ((bf16*)(ws + WS_WLORA))[i] = (bf16)f2bf(v);
        }
        __syncthreads();
        {
            f32x4 g[4], b[4];
#pragma unroll
            for (int j = 0; j < 4; ++j) { g[j] = *(const f32x4*)(INP(I_LNIN_G) + 256 * j + 4 * lane); b[j] = *(const f32x4*)(INP(I_LNIN_B) + 256 * j + 4 * lane); }
            for (int m = gw; m < M; m += NGW) {
                f32x4 v[4]; const float* xr = INP(I_X) + (size_t)m * D;
#pragma unroll
                for (int j = 0; j < 4; ++j) v[j] = *(const f32x4*)(xr + 256 * j + 4 * lane);
                ln16(v, g, b);
#pragma unroll
                for (int j = 0; j < 4; ++j) { st4bf(Xb + ((size_t)m * D + 256 * j + 4 * lane) * 2, v[j]); *(unsigned*)((char*)(ws + WS_XF8) + (size_t)m * D + 256 * j + 4 * lane) = pk4_f8(v[j].x * F8_SX, v[j].y * F8_SX, v[j].z * F8_SX, v[j].w * F8_SX); }
                gates8(v, wgt, GIF + (size_t)m * 8, lane);
            }
#pragma unroll
            for (int j = 0; j < 4; ++j) { g[j] = *(const f32x4*)(INP(I_MEMLN_G) + 256 * j + 4 * lane); b[j] = *(const f32x4*)(INP(I_MEMLN_B) + 256 * j + 4 * lane); }
            for (int m = gw; m < MROWS; m += NGW) {
                f32x4 v[4]; const float* xr = INP(I_MEM) + (size_t)m * D;
#pragma unroll
                for (int j = 0; j < 4; ++j) v[j] = *(const f32x4*)(xr + 256 * j + 4 * lane);
                ln16(v, g, b);
#pragma unroll
                for (int j = 0; j < 4; ++j) st4bf((char*)(ws + WS_MEMN) + ((size_t)m * D + 256 * j + 4 * lane) * 2, v[j]);
            }
        }
        __syncthreads();
    }
    SEAM(0);

#pragma unroll 1
    for (int l = 0; l < DEPTH; ++l) {
        const int pb = 1 + l * NP_LAYER;
        _Pragma("unroll 1") for (int rep_ = 0; rep_ < NREP(0); ++rep_) if (((PHMASK>>0)&1) && IN(pb + 0)) {
            SchedInproj S; S.T.init(M / 256, UC_F8 / 256); S.G = G; S.c = bx; S.X = Xb; S.W = (const char*)(ws + WS_WIN) + (size_t)l * NU * D * 2; S.U = Ub;
            S.kv = (l == 0); S.MEMN = (const char*)(ws + WS_MEMN); S.WKV = (const char*)(ws + WS_WKV); S.KV = (char*)(ws + WS_KV);
            pg8::EpiStore E;
            pg8::gemm_phase<false>(lds, D * 2, D * 2, D * 2, S, E, wave);
            SchedPlain S8; S8.T.init(M / 256, NF8 / 256); S8.G = G; S8.c = bx; S8.A = (const char*)(ws + WS_XF8); S8.B = (const char*)(ws + WS_WING8) + (size_t)l * NF8 * D; S8.C = Ub + UC_F8 * 2;
            S8.lda = 512; S8.ldb = 512; S8.ldc = NU;
            pg8::EpiStoreS E8; E8.s = F8_INV1; E8.gate_b = INP(I_GATEB) + (size_t)l * 3072; E8.gate_c0 = UC_GATE - UC_F8;
            pg8::gemm_phase<true>(lds, D, D, D, S8, E8, wave);
        }
        SEAM(pb + 0);
        _Pragma("unroll 1") for (int rep_ = 0; rep_ < NREP(1); ++rep_) if (((PHMASK>>1)&1) && IN(pb + 1)) { PHASE_TID
            const float* mu = INP(I_RWMU) + (size_t)l * 1792 + 1536;
            char* LIN = (char*)(ws + WS_R2 + R2_LORA_IN);
            for (int it = bx * NTHR + tid; it < M * 32; it += G * NTHR) {
                const int row = it >> 5, c = (it & 31) * 8;
                const u32x4 cw = *(const u32x4*)(Ub + ((size_t)row * NU + UC_RW + 1536 + c) * 2);
                u32x4 pw = (u32x4){0u, 0u, 0u, 0u};
                if ((row & (SEQ - 1)) != 0) pw = *(const u32x4*)(Ub + ((size_t)(row - 1) * NU + UC_RW + 1536 + c) * 2);
                const f32x4 m0 = *(const f32x4*)(mu + c), m1 = *(const f32x4*)(mu + c + 4);
                float x[8] = {bflo(cw.x), bfhi(cw.x), bflo(cw.y), bfhi(cw.y), bflo(cw.z), bfhi(cw.z), bflo(cw.w), bfhi(cw.w)};
                const float p[8] = {bflo(pw.x), bfhi(pw.x), bflo(pw.y), bfhi(pw.y), bflo(pw.z), bfhi(pw.z), bflo(pw.w), bfhi(pw.w)};
                const float mm[8] = {m0.x, m0.y, m0.z, m0.w, m1.x, m1.y, m1.z, m1.w};
#pragma unroll
                for (int i = 0; i < 8; ++i) { float xs = x[i] + (p[i] - x[i]) * mm[i];
                    if (c < 64) xs = 1.f - 2.f * __builtin_amdgcn_rcpf(1.f + __builtin_amdgcn_exp2f(2.8853900817779268f * xs));
                    else if (c >= 128) xs = sigmoidf_(xs);
                    x[i] = xs; }
                u32x4 o; o.x = pk2(x[0], x[1]); o.y = pk2(x[2], x[3]); o.z = pk2(x[4], x[5]); o.w = pk2(x[6], x[7]);
                *(u32x4*)(LIN + ((size_t)row * 256 + c) * 2) = o;
            }
        }
        SEAM(pb + 1);
        _Pragma("unroll 1") for (int rep_ = 0; rep_ < NREP(2); ++rep_) if (((PHMASK>>2)&1) && IN(pb + 2)) {
            SchedPlain S; S.T.init(M / 256, 6); S.G = G; S.c = bx; S.A = (const char*)(ws + WS_R2 + R2_LORA_IN); S.B = (const char*)(ws + WS_WLORA) + (size_t)l * 1536 * 256 * 2; S.C = (char*)(ws + WS_R2 + R2_LORA_OUT);
            S.lda = 256; S.ldb = 256; S.ldc = 1536;
            pg8::EpiStore E;
            pg8::gemm_phase<false>(lds, 512, 512, 512, S, E, wave);
        }
        SEAM(pb + 2);
        _Pragma("unroll 1") for (int rep_ = 0; rep_ < NREP(3); ++rep_) if (((PHMASK>>3)&1) && IN(pb + 3)) { PHASE_TID
            const char* LO = (const char*)(ws + WS_R2 + R2_LORA_OUT);
            char* HC = (char*)(ws + WS_R2 + R2_HCAT);
            const int tid_ph = tid;
#define SUB_TID unsigned zs_ = 0u; asm volatile("" : "+v"(zs_)); int tid = wave * 64 + (int)__builtin_amdgcn_mbcnt_hi(~0u, __builtin_amdgcn_mbcnt_lo(~0u, zs_)); const int lane = tid & 63; (void)lane;
#pragma unroll 1
            for (int job = bx; job < 256; job += G) {
                if (job < 128) { _Pragma("unroll 1") for (int sr_ = 0; sr_ < NSUB(0); ++sr_) if ((SUBMASK>>0)&1) {
                    SUB_TID
                    const int b = job >> 3, h = job & 7;
                    constexpr int TC = 32, PT = 144, P16 = 48, IMG = 25856;
                    LAS float* OPS = (LAS float*)lds;
                    LAS float* OUTB = OPS + TC * 384;
                    LAS float* BON = OUTB + TC * 64;
                    LAS unsigned char* IM0 = lds + 57600;
                    const int pt = tid >> 4, cs = tid & 15, pc = cs * 4, hc = h * 64 + pc;
                    const int r31 = lane & 31, h2 = lane >> 5;
                    f32x16 Sreg[2];
#pragma unroll
                    for (int i = 0; i < 16; ++i) { Sreg[0][i] = 0.f; Sreg[1][i] = 0.f; }
                    u32x2 pu[9];
                    auto LOADC = [&](int t0) {
                        const int t = t0 + pt; const size_t row = (size_t)b * SEQ + t; const char* up = Ub + (row * NU + UC_RW + hc) * 2;
                        pu[0] = *(const u32x2*)up; pu[1] = *(const u32x2*)(up + 1024); pu[2] = *(const u32x2*)(up + 2048);
                        if (t > 0) { const char* pp = up - (size_t)NU * 2; pu[3] = *(const u32x2*)pp; pu[4] = *(const u32x2*)(pp + 1024); pu[5] = *(const u32x2*)(pp + 2048); }
                        else { pu[3] = (u32x2){0u, 0u}; pu[4] = pu[3]; pu[5] = pu[3]; }
                        const char* lp = LO + (row * 1536 + hc) * 2; pu[6] = *(const u32x2*)lp; pu[7] = *(const u32x2*)(lp + 1024); pu[8] = *(const u32x2*)(lp + 2048);
                    };
#define UNP4(w) ((f32x4){bflo((w).x), bfhi((w).x), bflo((w).y), bfhi((w).y)})
#define DOT4(a, b) (((a).x * (b).x + (a).y * (b).y) + ((a).z * (b).z + (a).w * (b).w))
#define PACK8(x, s) __builtin_bit_cast(bf16x8, (u32x4){pk2((x)[8 * (s)], (x)[8 * (s) + 1]), pk2((x)[8 * (s) + 2], (x)[8 * (s) + 3]), pk2((x)[8 * (s) + 4], (x)[8 * (s) + 5]), pk2((x)[8 * (s) + 6], (x)[8 * (s) + 7])})
#define LD2x64(p) __builtin_bit_cast(bf16x8, (u32x4){(*(const LAS u32x2*)(p)).x, (*(const LAS u32x2*)(p)).y, (*(const LAS u32x2*)((p) + 16)).x, (*(const LAS u32x2*)((p) + 16)).y})
                    LOADC(0);
#pragma unroll 1
                    for (int t0 = 0; t0 < SEQ; t0 += TC) {
                        f32x4 gk;
                        {
                            int hcv = hc; asm volatile("" : "+v"(hcv));
                            const f32x4 mu_r = *(const f32x4*)(INP(I_RWMU) + (size_t)l * 1792 + hcv), mu_k = *(const f32x4*)(INP(I_RWMU) + (size_t)l * 1792 + 512 + hcv), mu_v = *(const f32x4*)(INP(I_RWMU) + (size_t)l * 1792 + 1024 + hcv);
                            const f32x4 w0 = *(const f32x4*)(INP(I_RWW0) + l * 512 + hcv), a0 = *(const f32x4*)(INP(I_RWA0) + l * 512 + hcv), kkw = *(const f32x4*)(INP(I_RWKK) + l * 512 + hcv);
                            const f32x4 kaw = *(const f32x4*)(INP(I_RWKA) + l * 512 + hcv), rkw = *(const f32x4*)(INP(I_RWRK) + l * 512 + hcv);
                            const f32x4 ur = UNP4(pu[0]), uk = UNP4(pu[1]), uv = UNP4(pu[2]), urp = UNP4(pu[3]), ukp = UNP4(pu[4]), uvp = UNP4(pu[5]), lw = UNP4(pu[6]), la = UNP4(pu[7]);
                            gk = UNP4(pu[8]);
                            const f32x4 xr = ur + (urp - ur) * mu_r, xk = uk + (ukp - uk) * mu_k, xv = uv + (uvp - uv) * mu_v;
                            f32x4 dec, av, kkv, kp; float ss = 0.f, bsum = 0.f;
#pragma unroll
                            for (int i = 0; i < 4; ++i) {
                                const float y = -(w0[i] + lw[i]);
                                const float sp = fmaxf(y, 0.f) + __logf(1.f + __expf(-fabsf(y)));
                                dec[i] = __expf(-__expf(-sp - 0.5f));
                                av[i] = sigmoidf_(a0[i] + la[i]);
                                kkv[i] = xk[i] * kkw[i]; ss += kkv[i] * kkv[i];
                                kp[i] = xk[i] * (1.f + (av[i] - 1.f) * kaw[i]);
                                bsum += xr[i] * kp[i] * rkw[i];
                            }
                            ss = red16(ss); bsum = red16(bsum);
                            const float inv = __builtin_amdgcn_rsqf(fmaxf(ss, 1e-24f));
                            const f32x4 kk = kkv * inv, kka = kk * av;
                            LAS float* o = OPS + pt * 384 + pc;
                            *(LAS f32x4*)(o) = dec; *(LAS f32x4*)(o + 64) = kk; *(LAS f32x4*)(o + 128) = kka; *(LAS f32x4*)(o + 192) = kp; *(LAS f32x4*)(o + 256) = xr; *(LAS f32x4*)(o + 320) = xv;
                            if (cs == 0) BON[pt] = bsum;
                        }
                        if (t0 + TC < SEQ) LOADC(t0 + TC);
                        __syncthreads();
                        {
                            const int sc = wave >> 2, wq = wave & 3;
                            LAS unsigned char* im = IM0 + sc * IMG;
                            LAS unsigned char* KR = im; LAS unsigned char* BGr = im + 4608; LAS unsigned char* VT = im + 15360;
                            LAS unsigned char* TT = im + 18432; LAS unsigned char* BB = im + 19968; LAS float* ZF = (LAS float*)(im + 21504); LAS float* PL = (LAS float*)(im + 25600);
                            {
                                float P = 1.f;
#pragma unroll 1
                                for (int t = 0; t < 4 * wq; ++t) P *= OPS[(16 * sc + t) * 384 + lane];
#pragma unroll
                                for (int q = 0; q < 4; ++q) { const int t = 4 * wq + q; const LAS float* o = OPS + (16 * sc + t) * 384 + lane;
                                    const float w = o[0], z = o[64], bb = o[128], kp = o[192], rr = o[256], vv = o[320];
                                    const float kap = z * P; P *= w; const float rho = rr * P, ip = __builtin_amdgcn_rcpf(P), bet = bb * ip, gam = kp * ip;
                                    *(LAS bf16*)(KR + t * PT + lane * 2) = (bf16)f2bf(kap); *(LAS bf16*)(KR + (16 + t) * PT + lane * 2) = (bf16)f2bf(rho);
                                    *(LAS bf16*)(BGr + t * PT + lane * 2) = (bf16)f2bf(bet); *(LAS bf16*)(BGr + (16 + t) * PT + lane * 2) = (bf16)f2bf(gam);
                                    *(LAS bf16*)(VT + t * PT + lane * 2) = (bf16)f2bf(vv); }
                                if (wq == 3) PL[lane] = P;
                            }
                            __syncthreads();
                            if (wq == 0) {
                                f32x16 Z;
#pragma unroll
                                for (int i = 0; i < 16; ++i) Z[i] = 0.f;
#pragma unroll
                                for (int ks = 0; ks < 4; ++ks) Z = __builtin_amdgcn_mfma_f32_32x32x16_bf16(*(const LAS bf16x8*)(KR + r31 * PT + (16 * ks + 8 * h2) * 2), *(const LAS bf16x8*)(BGr + r31 * PT + (16 * ks + 8 * h2) * 2), Z, 0, 0, 0);
                                const int cp = (r31 < 16) ? (4 * (r31 & 3) + (r31 >> 2)) : r31;
#pragma unroll
                                for (int i = 0; i < 16; ++i) ZF[((i & 3) + 8 * (i >> 2) + 4 * h2) * 32 + cp] = Z[i];
                            }
                            __syncthreads();
                            if (wq == 0) {
                                const int c = lane >> 2, jq = lane & 3; float tq[4] = {0.f, 0.f, 0.f, 0.f};
                                f32x4 an = *(const LAS f32x4*)(ZF + 1 * 32 + 4 * jq);
#pragma unroll
                                for (int t = 0; t < 16; ++t) {
                                    const f32x4 ar = an; if (t >= 1 && t < 15) an = *(const LAS f32x4*)(ZF + (t + 1) * 32 + 4 * jq);
                                    float s = 0.f;
#pragma unroll
                                    for (int m = 0; m < 4; ++m) if (4 * m < t) s += ((4 * m + jq < t) ? ar[m] : 0.f) * tq[m];
                                    s = red4(s);
                                    const float val = ((t == c) ? 1.f : 0.f) - s;
                                    tq[t >> 2] = (jq == (t & 3)) ? val : tq[t >> 2];
                                }
#pragma unroll
                                for (int m = 0; m < 4; ++m) *(LAS bf16*)(TT + (4 * m + jq) * P16 + c * 2) = (bf16)f2bf(-tq[m]);
                                an = *(const LAS f32x4*)(ZF + 16 * 32 + 4 * jq);
#pragma unroll
                                for (int t = 0; t < 16; ++t) {
                                    const f32x4 ar = an; if (t < 15) an = *(const LAS f32x4*)(ZF + (17 + t) * 32 + 4 * jq);
                                    float s = 0.f;
#pragma unroll
                                    for (int m = 0; m < 4; ++m) if (4 * m <= t) s += ((4 * m + jq <= t) ? ar[m] : 0.f) * tq[m];
                                    s = red4(s);
                                    if (jq == 0) *(LAS bf16*)(TT + (16 + t) * P16 + c * 2) = (bf16)f2bf(-s);
                                }
                            } else if (wq == 1) {
                                const int row = lane >> 1, c0 = 8 * (lane & 1), tt = row & 15; const bool rho_row = row >= 16; float bv[8];
#pragma unroll
                                for (int j = 0; j < 8; ++j) { const int jj = c0 + j; const float zv = ZF[row * 32 + 16 + jj]; bv[j] = (rho_row ? (jj <= tt) : (jj < tt)) ? zv : 0.f; }
                                *(LAS u32x4*)(BB + row * P16 + c0 * 2) = (u32x4){pk2(bv[0], bv[1]), pk2(bv[2], bv[3]), pk2(bv[4], bv[5]), pk2(bv[6], bv[7])};
                            }
                        }
                        __syncthreads();
                        if (wave < 2) {
#pragma unroll 1
                            for (int sc = 0; sc < 2; ++sc) {
                                const LAS unsigned char* im = IM0 + sc * IMG;
                                const LAS unsigned char* KR = im; const LAS unsigned char* BT = im + 9216; const LAS unsigned char* GT = im + 12288; const LAS unsigned char* VT = im + 15360;
                                const LAS unsigned char* TT = im + 18432; const LAS unsigned char* BB = im + 19968; const LAS float* PL = (const LAS float*)(im + 25600);
                                const LAS unsigned char* BGr = im + 4608;
                                const bf16x8 vfr = trd8(VT, PT, 8 * h2, 8 * h2 + 4, 32 * wave, lane);
                                f32x16 t1;
#pragma unroll
                                for (int i = 0; i < 16; ++i) t1[i] = 0.f;
                                t1 = __builtin_amdgcn_mfma_f32_32x32x16_bf16(*(const LAS bf16x8*)(BB + r31 * P16 + 8 * h2 * 2), vfr, t1, 0, 0, 0);
#pragma unroll
                                for (int kb = 0; kb < 2; ++kb)
#pragma unroll
                                    for (int s = 0; s < 2; ++s) t1 = __builtin_amdgcn_mfma_f32_32x32x16_bf16(LD2x64(KR + r31 * PT + (32 * kb + 16 * s + 4 * h2) * 2), PACK8(Sreg[kb], s), t1, 0, 0, 0);
                                f32x16 t2;
#pragma unroll
                                for (int i = 0; i < 16; ++i) t2[i] = 0.f;
                                t2 = __builtin_amdgcn_mfma_f32_32x32x16_bf16(LD2x64(TT + r31 * P16 + (4 * h2) * 2), PACK8(t1, 0), t2, 0, 0, 0);
#pragma unroll
                                for (int i = 8; i < 16; ++i) OUTB[(16 * sc + (i & 3) + 8 * ((i >> 2) - 2) + 4 * h2) * 64 + 32 * wave + r31] = t2[i] + t1[i];
                                const bf16x8 uq = PACK8(t2, 0);
#pragma unroll
                                for (int kb = 0; kb < 2; ++kb) {
                                    f32x16 a = Sreg[kb];
                                    a = __builtin_amdgcn_mfma_f32_32x32x16_bf16(trd8(BGr, PT, 4 * h2, 8 + 4 * h2, 32 * kb, lane), uq, a, 0, 0, 0);
                                    a = __builtin_amdgcn_mfma_f32_32x32x16_bf16(trd8(BGr, PT, 16 + 8 * h2, 20 + 8 * h2, 32 * kb, lane), vfr, a, 0, 0, 0);
#pragma unroll
                                    for (int g4 = 0; g4 < 4; ++g4) { const f32x4 p4 = *(const LAS f32x4*)(PL + 32 * kb + 8 * g4 + 4 * h2);
                                        a[4 * g4] *= p4.x; a[4 * g4 + 1] *= p4.y; a[4 * g4 + 2] *= p4.z; a[4 * g4 + 3] *= p4.w; }
                                    Sreg[kb] = a;
                                }
                            }
                        }
                        __syncthreads();
                        {
                            int hcw = hc; asm volatile("" : "+v"(hcw));
                            const f32x4 lng = *(const f32x4*)(INP(I_RWLNG) + l * 512 + hcw), lnb = *(const f32x4*)(INP(I_RWLNB) + l * 512 + hcw);
                            const f32x4 o4 = *(const LAS f32x4*)(OUTB + pt * 64 + pc), v4 = *(const LAS f32x4*)(OPS + pt * 384 + 320 + pc);
                            const float mean = red16((o4.x + o4.y) + (o4.z + o4.w)) * (1.f / 64.f);
                            const f32x4 dv = o4 - mean;
                            const float var = red16(DOT4(dv, dv)) * (1.f / 64.f);
                            const float rstd = __builtin_amdgcn_rsqf(var + RW_GN_EPS), bo = BON[pt];
                            const f32x4 y = (dv * rstd * lng + lnb + v4 * bo) * gk;
                            st4bf(HC + (((size_t)b * SEQ + t0 + pt) * 1536 + 512 + hc) * 2, y);
                        }
                        __syncthreads();
                    }
#undef PACK8
#undef LD2x64
                } } else {
                    const int idx = job - 128, bh = idx >> 1, half = idx & 1, b = bh >> 2, h = bh & 3;
                    unsigned zl_ = 0u; asm volatile("" : "+v"(zl_)); const int lane_ml = (int)__builtin_amdgcn_mbcnt_hi(~0u, __builtin_amdgcn_mbcnt_lo(~0u, zl_));
                    _Pragma("unroll 1") for (int sr_ = 0; sr_ < NSUB(1); ++sr_) if (((SUBMASK>>1)&1) && idx < 64) {
                        SUB_TID
                        const int bm = idx >> 2, hm = idx & 3;
                        constexpr int PT = 144;
                        LAS unsigned char* QI = lds;
                        LAS unsigned char* KI = QI + 64 * PT;
                        constexpr int PV = 272;
                        LAS unsigned char* KW = KI + 64 * PT;
                        LAS unsigned char* VT = KW + 64 * PT;
                        LAS unsigned char* CI = VT + 64 * PV;
                        LAS float* AS = (LAS float*)(CI + 128 * PT);
                        LAS float* MX = AS + 64; LAS float* SI = AS + 128; LAS float* EM = AS + 192; LAS float* WG = AS + 256; LAS float* NN = AS + 320; LAS float* CR = AS + 384; LAS float* ST = AS + 448;
                        for (int i = tid; i < 128 * PT / 4; i += NTHR) ((LAS unsigned*)CI)[i] = 0u;
                        if (tid < 64) NN[tid] = 0.f;
                        const int pt = tid >> 4, cg = tid & 15;
                        const int ccol = (cg < 8) ? (hm * 64 + 8 * cg) : (256 + hm * 64 + 8 * (cg - 8));
                        const float qsc = (cg < 8) ? 0.125f : 1.f;
                        const float igb = INP(I_IGB)[l * 4 + hm], fgb = INP(I_FGB)[l * 4 + hm];
                        const int r31 = lane & 31, h2 = lane >> 5, vb = wave >> 1, tb = wave & 1;
                        f32x16 accC;
#pragma unroll
                        for (int i = 0; i < 16; ++i) accC[i] = 0.f;
                        float nreg = 0.f, mprev = 0.f;
                        u32x4 cu[2][4], vu[2]; float gi = 0.f, gf = 0.f;
                        auto LOADM = [&](int t0) {
#pragma unroll
                            for (int tt = 0; tt < 2; ++tt) { const int t = t0 + pt + 32 * tt; const size_t row = (size_t)bm * SEQ + t;
#pragma unroll
                                for (int j = 0; j < 4; ++j) { if (t - 3 + j >= 0) cu[tt][j] = *(const u32x4*)(Ub + ((row - 3 + j) * NU + UC_QK + ccol) * 2); else cu[tt][j] = (u32x4){0u, 0u, 0u, 0u}; }
                                const int p = tid + 512 * tt; vu[tt] = *(const u32x4*)(Ub + (((size_t)bm * SEQ + t0 + (p >> 4)) * NU + UC_V + hm * 128 + 8 * (p & 15)) * 2); }
                            if (wave == 0) { const size_t rg = (size_t)bm * SEQ + t0 + lane; gi = GIF[rg * 8 + hm]; gf = GIF[rg * 8 + 4 + hm]; }
                        };
                        LOADM(0);
                        __syncthreads();
#pragma unroll 1
                        for (int t0 = 0; t0 < SEQ; t0 += 64) {
                            int ccv = ccol; asm volatile("" : "+v"(ccv));
                            float cw[4][8], cb[8];
#pragma unroll
                        for (int j = 0; j < 4; ++j) { const f32x4 a = *(const f32x4*)(INP(I_CONVW) + ((size_t)l * 4 + j) * 512 + ccv), c2 = *(const f32x4*)(INP(I_CONVW) + ((size_t)l * 4 + j) * 512 + ccv + 4);
                            cw[j][0] = a.x; cw[j][1] = a.y; cw[j][2] = a.z; cw[j][3] = a.w; cw[j][4] = c2.x; cw[j][5] = c2.y; cw[j][6] = c2.z; cw[j][7] = c2.w; }
                        { const f32x4 a = *(const f32x4*)(INP(I_CONVB) + l * 512 + ccv), c2 = *(const f32x4*)(INP(I_CONVB) + l * 512 + ccv + 4);
                            cb[0] = a.x; cb[1] = a.y; cb[2] = a.z; cb[3] = a.w; cb[4] = c2.x; cb[5] = c2.y; cb[6] = c2.z; cb[7] = c2.w; }
                            float yq[2][8];
#pragma unroll
                            for (int tt = 0; tt < 2; ++tt) {
#pragma unroll
                                for (int i = 0; i < 8; ++i) yq[tt][i] = cb[i];
#pragma unroll
                                for (int j = 0; j < 4; ++j) { const u32x4 w = cu[tt][j]; const float x[8] = {bflo(w.x), bfhi(w.x), bflo(w.y), bfhi(w.y), bflo(w.z), bfhi(w.z), bflo(w.w), bfhi(w.w)};
#pragma unroll
                                    for (int i = 0; i < 8; ++i) yq[tt][i] += cw[j][i] * x[i]; }
#pragma unroll
                                for (int i = 0; i < 8; ++i) yq[tt][i] = yq[tt][i] * sigmoidf_(yq[tt][i]) * qsc;
                            }
                            const u32x4 vreg0 = vu[0], vreg1 = vu[1];
                            if (wave == 0) {
                                const float ig = gi + igb, fp = gf + fgb;
                                const float lf = -(fmaxf(-fp, 0.f) + __logf(1.f + __expf(-fabsf(fp))));
                                const float bc = scan_add64(lf);
                                const float as = ig - bc, pm = scan_max64(as);
                                const float mxv = fmaxf(mprev, pm), mx63 = __builtin_bit_cast(float, __builtin_amdgcn_readlane(__builtin_bit_cast(int, mxv), 63)), bl = __builtin_bit_cast(float, __builtin_amdgcn_readlane(__builtin_bit_cast(int, bc), 63));
                                AS[lane] = as; MX[lane] = mxv; SI[lane] = __expf(mprev - mxv); EM[lane] = __expf(-(bc + mxv)); WG[lane] = __expf(as - mx63);
                                if (lane == 0) CR[0] = __expf(mprev - mx63);
                                mprev = bl + mx63;
                            }
                            if (t0 + 64 < SEQ) LOADM(t0 + 64);
                            __syncthreads();
#pragma unroll
                            for (int tt = 0; tt < 2; ++tt) { const int tok = pt + 32 * tt;
                                u32x4 pw; pw.x = pk2(yq[tt][0], yq[tt][1]); pw.y = pk2(yq[tt][2], yq[tt][3]); pw.z = pk2(yq[tt][4], yq[tt][5]); pw.w = pk2(yq[tt][6], yq[tt][7]);
                                if (cg < 8) *(LAS u32x4*)(QI + tok * PT + cg * 16) = pw;
                                else { *(LAS u32x4*)(KI + tok * PT + (cg - 8) * 16) = pw; const float wgs = WG[tok];
                                    u32x4 kw; kw.x = pk2(yq[tt][0] * wgs, yq[tt][1] * wgs); kw.y = pk2(yq[tt][2] * wgs, yq[tt][3] * wgs); kw.z = pk2(yq[tt][4] * wgs, yq[tt][5] * wgs); kw.w = pk2(yq[tt][6] * wgs, yq[tt][7] * wgs);
                                    *(LAS u32x4*)(KW + tok * PT + (cg - 8) * 16) = kw; }
                                const u32x4 vw = tt ? vreg1 : vreg0; const int p = tid + 512 * tt, vtok = p >> 4, v8 = p & 15;
                                *(LAS u32x4*)(VT + vtok * PV + v8 * 16) = vw;
                            }
                            __syncthreads();
                            float hv[16];
                            {
                                constexpr float L2E = 1.4426950408889634f;
                                const int t = 32 * tb + r31;
                                bf16x8 qf[4];
#pragma unroll
                                for (int ks = 0; ks < 4; ++ks) qf[ks] = *(const LAS bf16x8*)(QI + t * PT + (16 * ks + 8 * h2) * 2);
                                const float mx = MX[t], si = SI[t], em = EM[t];
                                f32x16 O, I; float denI = 0.f;
#pragma unroll
                                for (int i = 0; i < 16; ++i) { O[i] = 0.f; I[i] = 0.f; }
#pragma unroll
                                for (int sb = 0; sb < 2; ++sb) if (sb <= tb) {
                                    f32x16 X;
#pragma unroll
                                    for (int i = 0; i < 16; ++i) X[i] = 0.f;
#pragma unroll
                                    for (int ks = 0; ks < 4; ++ks) { const bf16x8 kf = *(const LAS bf16x8*)(KI + (32 * sb + r31) * PT + (16 * ks + 8 * h2) * 2); X = __builtin_amdgcn_mfma_f32_32x32x16_bf16(kf, qf[ks], X, 0, 0, 0); }
#pragma unroll
                                    for (int g4 = 0; g4 < 4; ++g4) { const f32x4 a4 = *(const LAS f32x4*)(AS + 32 * sb + 8 * g4 + 4 * h2);
#pragma unroll
                                        for (int j = 0; j < 4; ++j) { const int s = 32 * sb + 8 * g4 + 4 * h2 + j; const float w = (s <= t) ? __builtin_amdgcn_exp2f((a4[j] - mx) * L2E) * X[4 * g4 + j] : 0.f; X[4 * g4 + j] = w; denI += w; } }
#pragma unroll
                                    for (int st = 0; st < 2; ++st) {
                                        u32x4 pw; pw.x = pk2(X[8 * st], X[8 * st + 1]); pw.y = pk2(X[8 * st + 2], X[8 * st + 3]); pw.z = pk2(X[8 * st + 4], X[8 * st + 5]); pw.w = pk2(X[8 * st + 6], X[8 * st + 7]);
                                        O = __builtin_amdgcn_mfma_f32_32x32x16_bf16(trd8(VT, PV, 32 * sb + 16 * st + 4 * h2, 32 * sb + 16 * st + 8 + 4 * h2, 32 * vb, lane), __builtin_bit_cast(bf16x8, pw), O, 0, 0, 0);
                                    }
                                }
                                float nq = 0.f;
#pragma unroll
                                for (int ks = 0; ks < 4; ++ks) { const bf16x8 cf = *(const LAS bf16x8*)(CI + (32 * vb + r31) * PT + (16 * ks + 8 * h2) * 2); I = __builtin_amdgcn_mfma_f32_32x32x16_bf16(cf, qf[ks], I, 0, 0, 0);
                                    const f32x4 n0 = *(const LAS f32x4*)(NN + 16 * ks + 8 * h2), n1 = *(const LAS f32x4*)(NN + 16 * ks + 8 * h2 + 4); const u32x4 qw = __builtin_bit_cast(u32x4, qf[ks]);
                                    nq += (bflo(qw.x) * n0.x + bfhi(qw.x) * n0.y) + (bflo(qw.y) * n0.z + bfhi(qw.y) * n0.w) + (bflo(qw.z) * n1.x + bfhi(qw.z) * n1.y) + (bflo(qw.w) * n1.z + bfhi(qw.w) * n1.w); }
                                nq += __shfl_xor(nq, 32); denI += __shfl_xor(denI, 32);
                                const float den = si * nq + denI, rdn = 1.f / fmaxf(fabsf(den), em);
                                float hsum = 0.f;
#pragma unroll
                                for (int i = 0; i < 16; ++i) { hv[i] = (O[i] + si * I[i]) * rdn; hsum += hv[i]; }
                                hsum += __shfl_xor(hsum, 32);
                                const float hmean = hsum * (1.f / 32.f); float hm2 = 0.f;
#pragma unroll
                                for (int i = 0; i < 16; ++i) { const float dlt = hv[i] - hmean; hm2 += dlt * dlt; }
                                hm2 += __shfl_xor(hm2, 32);
                                if (h2 == 0) *(LAS f32x2*)(ST + ((tb * 4 + vb) * 32 + r31) * 2) = (f32x2){hmean, hm2};
                                const float carry = CR[0];
#pragma unroll
                                for (int i = 0; i < 16; ++i) accC[i] *= carry;
#pragma unroll
                                for (int st = 0; st < 4; ++st) { const bf16x8 va = trd8(VT, PV, 16 * st + 8 * h2, 16 * st + 8 * h2 + 4, 32 * vb, lane), kw = trd8(KW, PT, 16 * st + 8 * h2, 16 * st + 8 * h2 + 4, 32 * tb, lane);
                                    accC = __builtin_amdgcn_mfma_f32_32x32x16_bf16(va, kw, accC, 0, 0, 0); }
                            }
                            __syncthreads();
                            {
                                const int t = 32 * tb + r31;
                                f32x2 s4[4];
#pragma unroll
                                for (int q = 0; q < 4; ++q) s4[q] = *(const LAS f32x2*)(ST + ((tb * 4 + q) * 32 + r31) * 2);
                                const float mt = (s4[0].x + s4[1].x + s4[2].x + s4[3].x) * 0.25f;
                                float m2 = 0.f;
#pragma unroll
                                for (int q = 0; q < 4; ++q) { const float dm = s4[q].x - mt; m2 += s4[q].y + 32.f * dm * dm; }
                                const float rstd = __builtin_amdgcn_rsqf(m2 * (1.f / 128.f) + LN_EPS);
                                const size_t row = (size_t)bm * SEQ + t0 + t;
                                const char* ogp = Ub + (row * NU + UC_OG + hm * 128 + 32 * vb) * 2; char* op = HC + (row * 1536 + hm * 128 + 32 * vb) * 2;
                                const float* ngp = INP(I_MLNORMG) + l * 512 + hm * 128 + 32 * vb;
#pragma unroll
                                for (int g4 = 0; g4 < 4; ++g4) { const int vo = 8 * g4 + 4 * h2; const f32x4 og = ld4bf(ogp + vo * 2), ng = *(const f32x4*)(ngp + vo);
                                    f32x4 y; y.x = sigmoidf_(og.x) * ((hv[4 * g4] - mt) * rstd * ng.x); y.y = sigmoidf_(og.y) * ((hv[4 * g4 + 1] - mt) * rstd * ng.y); y.z = sigmoidf_(og.z) * ((hv[4 * g4 + 2] - mt) * rstd * ng.z); y.w = sigmoidf_(og.w) * ((hv[4 * g4 + 3] - mt) * rstd * ng.w);
                                    st4bf(op + vo * 2, y); }
                            }
#pragma unroll
                            for (int i = 0; i < 16; ++i) { const int v = 32 * vb + (i & 3) + 8 * (i >> 2) + 4 * h2; *(LAS bf16*)(CI + v * PT + (32 * tb + r31) * 2) = (bf16)f2bf(accC[i]); }
                            if (wave < 2) { float s = 0.f;
#pragma unroll
                                for (int q8 = 0; q8 < 8; ++q8) { const u32x2 w = trd4(KW, PT, 32 * h2 + 4 * q8, 32 * wave, lane); s += (bflo(w.x) + bfhi(w.x)) + (bflo(w.y) + bfhi(w.y)); }
                                s += __shfl_xor(s, 32);
                                nreg = CR[0] * nreg + s; if (h2 == 0) NN[32 * wave + r31] = nreg; }
                            __syncthreads();
                        }
                    }
                    _Pragma("unroll 1") for (int sr_ = 0; sr_ < NSUB(2); ++sr_) if ((SUBMASK>>2)&1) {
                        SUB_TID
                        constexpr int KST = 272, VST = 520;
                        LAS unsigned char* KI = lds; LAS unsigned char* VI = lds + 256 * KST;
                        const char* kvb = (const char*)(ws + WS_KV) + (((size_t)l * MROWS + (size_t)b * MEML) * D) * 2;
                        for (int p = tid; p < 4096; p += NTHR) { const int key = p >> 4, c16 = p & 15;
                            *(LAS u32x4*)(KI + key * KST + c16 * 16) = *(const u32x4*)(kvb + ((size_t)key * D + h * 128 + c16 * 8) * 2); }
                        for (int p = tid; p < 4096; p += NTHR) { const int key = p & 255, d8 = p >> 8;
                            const u32x4 w = *(const u32x4*)(kvb + ((size_t)key * D + 512 + h * 128 + d8 * 8) * 2);
                            LAS unsigned char* o = VI + (d8 * 8) * VST + key * 2;
                            *(LAS bf16*)(o) = (bf16)(w.x & 0xffff); *(LAS bf16*)(o + VST) = (bf16)(w.x >> 16); *(LAS bf16*)(o + 2 * VST) = (bf16)(w.y & 0xffff); *(LAS bf16*)(o + 3 * VST) = (bf16)(w.y >> 16);
                            *(LAS bf16*)(o + 4 * VST) = (bf16)(w.z & 0xffff); *(LAS bf16*)(o + 5 * VST) = (bf16)(w.z >> 16); *(LAS bf16*)(o + 6 * VST) = (bf16)(w.w & 0xffff); *(LAS bf16*)(o + 7 * VST) = (bf16)(w.w >> 16); }
                        __syncthreads();
                        const int r31 = lane & 31, h2 = lane >> 5;
                        constexpr float SC = 0.08838834764831845f * 1.4426950408889634f;
#pragma unroll 1
                        for (int rd = 0; rd < 8; ++rd) {
                            const size_t qrow = (size_t)b * SEQ + half * 2048 + rd * 256 + wave * 32 + r31;
                            bf16x8 qf[8];
#pragma unroll
                            for (int ks = 0; ks < 8; ++ks) qf[ks] = *(const bf16x8*)(Ub + (qrow * NU + UC_CAQ + h * 128 + 16 * ks + 8 * h2) * 2);
                            f32x16 O[4];
#pragma unroll
                            for (int db = 0; db < 4; ++db)
#pragma unroll
                                for (int i = 0; i < 16; ++i) O[db][i] = 0.f;
                            float mrun = -1e30f, lrun = 0.f;
#pragma unroll 1
                            for (int hf = 0; hf < 2; ++hf) {
                                f32x16 X[4];
#pragma unroll
                                for (int kb = 0; kb < 4; ++kb) {
                                    bf16x8 kf[8];
#pragma unroll
                                    for (int ks = 0; ks < 8; ++ks) kf[ks] = *(const LAS bf16x8*)(KI + (hf * 128 + kb * 32 + r31) * KST + (16 * ks + 8 * h2) * 2);
                                    __builtin_amdgcn_sched_barrier(0);
#pragma unroll
                                    for (int i = 0; i < 16; ++i) X[kb][i] = 0.f;
#pragma unroll
                                    for (int ks = 0; ks < 8; ++ks) X[kb] = __builtin_amdgcn_mfma_f32_32x32x16_bf16(kf[ks], qf[ks], X[kb], 0, 0, 0);
                                    __builtin_amdgcn_sched_barrier(0);
                                }
                                float mx = -1e30f;
#pragma unroll
                                for (int kb = 0; kb < 4; ++kb)
#pragma unroll
                                    for (int i = 0; i < 16; ++i) mx = fmaxf(mx, X[kb][i]);
                                mx = fmaxf(mx, __shfl_xor(mx, 32));
                                const float mnew = fmaxf(mrun, mx), alpha = __builtin_amdgcn_exp2f((mrun - mnew) * SC);
                                float ls = 0.f;
#pragma unroll
                                for (int kb = 0; kb < 4; ++kb)
#pragma unroll
                                    for (int i = 0; i < 16; ++i) { const float p = __builtin_amdgcn_exp2f((X[kb][i] - mnew) * SC); X[kb][i] = p; ls += p; }
                                ls += __shfl_xor(ls, 32);
                                lrun = lrun * alpha + ls; mrun = mnew;
#pragma unroll
                                for (int db = 0; db < 4; ++db)
#pragma unroll
                                    for (int i = 0; i < 16; ++i) O[db][i] *= alpha;
#pragma unroll
                                for (int kb = 0; kb < 4; ++kb) {
                                    bf16x8 vf[2][4], pf[2];
#pragma unroll
                                    for (int s = 0; s < 2; ++s) {
                                        u32x4 pw; pw.x = pk2(X[kb][8 * s], X[kb][8 * s + 1]); pw.y = pk2(X[kb][8 * s + 2], X[kb][8 * s + 3]); pw.z = pk2(X[kb][8 * s + 4], X[kb][8 * s + 5]); pw.w = pk2(X[kb][8 * s + 6], X[kb][8 * s + 7]);
                                        pf[s] = __builtin_bit_cast(bf16x8, pw);
#pragma unroll
                                        for (int db = 0; db < 4; ++db) {
                                            const LAS unsigned char* vp = VI + (db * 32 + r31) * VST + (hf * 128 + kb * 32 + 16 * s + 4 * h2) * 2;
                                            const u32x2 lo = *(const LAS u32x2*)vp, hi = *(const LAS u32x2*)(vp + 16);
                                            vf[s][db] = __builtin_bit_cast(bf16x8, (u32x4){lo.x, lo.y, hi.x, hi.y});
                                        }
                                    }
                                    __builtin_amdgcn_sched_barrier(0);
#pragma unroll
                                    for (int s = 0; s < 2; ++s)
#pragma unroll
                                        for (int db = 0; db < 4; ++db) O[db] = __builtin_amdgcn_mfma_f32_32x32x16_bf16(vf[s][db], pf[s], O[db], 0, 0, 0);
                                    __builtin_amdgcn_sched_barrier(0);
                                }
                            }
                            const float rl = 1.f / lrun;
                            char* op = HC + (qrow * 1536 + 1024 + h * 128) * 2;
#pragma unroll
                            for (int db = 0; db < 4; ++db)
#pragma unroll
                                for (int g4 = 0; g4 < 4; ++g4) { u32x2 w; w.x = pk2(O[db][4 * g4] * rl, O[db][4 * g4 + 1] * rl); w.y = pk2(O[db][4 * g4 + 2] * rl, O[db][4 * g4 + 3] * rl);
                                    *(u32x2*)(op + (db * 32 + 8 * g4 + 4 * h2) * 2) = w; }
                        }
                        __syncthreads();
                    }
                    if (rep_ == 0) {
                        LAS float* scr = (LAS float*)(lds + wave * 8448);
                        constexpr int IT_GU = 32 * 16 * 64;
                        const int nper = (idx < 64) ? 4 : 92, ibase = (idx < 64) ? 0 : 2048, wk = (idx & 63) * NWAVES + wave;
                        for (int kq = 0; kq < nper; ++kq) { const int it = ibase + wk + kq * 512;
                            if (it < IT_GU) { const int e = it >> 10, q = it & 1023, kb = q >> 6, nb = q & 63;
                                transpose_item_f8(INP(I_WGU) + (((size_t)l * 32 + e) * D + 64 * kb) * 2048 + 32 * nb, 2048, (unsigned char*)(ws + WS_WGU) + ((size_t)e * 2048 + 32 * nb) * D + 64 * kb, D, F8_SWGU, scr, lane_ml); }
                            else { const int r2 = it - IT_GU, e = r2 >> 9, q = r2 & 511, kb = q >> 5, nb = q & 31;
                                transpose_item_f8(INP(I_WDN) + (((size_t)l * 32 + e) * D + 64 * kb) * 1024 + 32 * nb, 1024, (unsigned char*)(ws + WS_WDN) + ((size_t)e * 1024 + 32 * nb) * D + 64 * kb, D, F8_SWDN, scr, lane_ml); }
                        }
                        __syncthreads();
                    }
                }
            }
#undef UNP4
#undef DOT4
#undef SUB_TID
        }
        SEAM(pb + 3);
        _Pragma("unroll 1") for (int rep_ = 0; rep_ < NREP(5); ++rep_) if (((PHMASK>>5)&1) && IN(pb + 5)) {
            SchedPlain S; S.T.init(M / 256, 4); S.G = G; S.c = bx; S.A = (const char*)(ws + WS_R2 + R2_HCAT); S.B = (const char*)(ws + WS_WBR) + (size_t)l * 1024 * 1536 * 2; S.C = (char*)(ws + WS_R2 + R2_YPRE);
            S.lda = 1536; S.ldb = 1536; S.ldc = D;
            pg8::EpiMerge E; E.U = Ub; E.gate_b = INP(I_GATEB) + (size_t)l * 3072;
            pg8::gemm_phase<false, true>(lds, 1536 * 2, 1536 * 2, 1536 * 2, S, E, wave);
        }
        SEAM(pb + 5);
        _Pragma("unroll 1") for (int rep_ = 0; rep_ < NREP(6); ++rep_) if (((PHMASK>>6)&1) && IN(pb + 6)) {
            SchedPlain S; S.T.init(M / 256, 4); S.G = G; S.c = bx; S.A = (const char*)(ws + WS_R2 + R2_YPRE); S.B = (const char*)(ws + WS_WO) + (size_t)l * D * D * 2; S.C = (char*)(ws + WS_R2 + R2_Z);
            S.lda = D; S.ldb = D; S.ldc = D;
            pg8::EpiStore E;
            pg8::gemm_phase<false>(lds, D * 2, D * 2, D * 2, S, E, wave);
        }
        SEAM(pb + 6);
        _Pragma("unroll 1") for (int rep_ = 0; rep_ < NREP(7); ++rep_) if (((PHMASK>>7)&1) && IN(pb + 7)) { PHASE_TID
            constexpr int WP = 2064;
            LAS unsigned char* WRb = lds;
            LAS float* RB = (LAS float*)(lds + 66048);
            LAS unsigned char* XS = lds + 66560 + wave * 4608;
            for (int i = tid; i < 32768; i += NTHR) { const int k = i >> 5, e = i & 31; *(LAS bf16*)(WRb + e * WP + k * 2) = (bf16)f2bf(INP(I_RTW)[((size_t)l * D + k) * 32 + e]); }
            if (tid < 32) RB[tid] = INP(I_RTB)[l * 32 + tid];
            const char* Zb = (const char*)(ws + WS_R2 + R2_Z);
            int* TKE = (int*)(ws + WS_TKE); float* TKG = (float*)(ws + WS_TKG); int* TKP = (int*)(ws + WS_TKP); int* ROWTOK = (int*)(ws + WS_ROWTOK);
            LAS unsigned* LCNT = (LAS unsigned*)(lds + 131072);
            LAS unsigned* GBASE = LCNT + 32; LAS unsigned* LLEN = LCNT + 64; LAS unsigned* LIST = LCNT + 128;
            if (tid < 65) LCNT[tid] = 0u;
            {
                f32x4 g[4], bb[4];
#pragma unroll
                for (int j = 0; j < 4; ++j) { g[j] = *(const f32x4*)(INP(I_LN1G) + l * D + 256 * j + 4 * lane); bb[j] = *(const f32x4*)(INP(I_LN1B) + l * D + 256 * j + 4 * lane); }
#pragma unroll 1
                for (int pp = gw; pp < M / 2; pp += NGW) {
                    f32x4 y0[4], y1[4];
#pragma unroll
                    for (int j = 0; j < 4; ++j) { y0[j] = ld4bf(Zb + ((size_t)(2 * pp) * D + 256 * j + 4 * lane) * 2) + ld4bf(Xb + ((size_t)(2 * pp) * D + 256 * j + 4 * lane) * 2) * DN_ALPHA;
                        y1[j] = ld4bf(Zb + ((size_t)(2 * pp + 1) * D + 256 * j + 4 * lane) * 2) + ld4bf(Xb + ((size_t)(2 * pp + 1) * D + 256 * j + 4 * lane) * 2) * DN_ALPHA; }
                    ln16(y0, g, bb); ln16(y1, g, bb);
#pragma unroll
                    for (int j = 0; j < 4; ++j) { st4bf(Xb + ((size_t)(2 * pp) * D + 256 * j + 4 * lane) * 2, y0[j]); st4bf(Xb + ((size_t)(2 * pp + 1) * D + 256 * j + 4 * lane) * 2, y1[j]); }
                }
            }
            asm volatile("s_waitcnt vmcnt(0)" ::: "memory");
            __syncthreads();
            __builtin_amdgcn_fence(__ATOMIC_ACQUIRE, "agent");
            asm volatile("s_waitcnt vmcnt(0)" ::: "memory");
            if (rep_ == 0) {
                const int r31 = lane & 31, h2 = lane >> 5;
                const int mytok = 16 * (bx + (2 * wave + (r31 >> 4)) * G) + (r31 & 15);
                const char* sp[4];
#pragma unroll
                for (int q = 0; q < 4; ++q) { const int row = (lane >> 3) + 8 * q; const int tk = 16 * (bx + (2 * wave + (row >> 4)) * G) + (row & 15); sp[q] = Xb + ((size_t)tk * D + 8 * (lane & 7)) * 2; }
                f32x16 C;
#pragma unroll
                for (int i = 0; i < 16; ++i) C[i] = 0.f;
                u32x4 xr[4];
#pragma unroll
                for (int q = 0; q < 4; ++q) xr[q] = *(const u32x4*)(sp[q]);
#pragma unroll 1
                for (int sl = 0; sl < 16; ++sl) {
#pragma unroll
                    for (int q = 0; q < 4; ++q) *(LAS u32x4*)(XS + ((lane >> 3) + 8 * q) * 144 + (lane & 7) * 16) = xr[q];
                    if (sl + 1 < 16) {
#pragma unroll
                        for (int q = 0; q < 4; ++q) xr[q] = *(const u32x4*)(sp[q] + (sl + 1) * 128); }
#pragma unroll
                    for (int k2 = 0; k2 < 4; ++k2) C = __builtin_amdgcn_mfma_f32_32x32x16_bf16(*(const LAS bf16x8*)(WRb + r31 * WP + (64 * sl + 16 * k2 + 8 * h2) * 2), *(const LAS bf16x8*)(XS + r31 * 144 + (16 * k2 + 8 * h2) * 2), C, 0, 0, 0);
                }
                float v[16];
#pragma unroll
                for (int g4 = 0; g4 < 4; ++g4) { const f32x4 b4 = *(const LAS f32x4*)(RB + 8 * g4 + 4 * h2); v[4 * g4] = C[4 * g4] + b4.x; v[4 * g4 + 1] = C[4 * g4 + 1] + b4.y; v[4 * g4 + 2] = C[4 * g4 + 2] + b4.z; v[4 * g4 + 3] = C[4 * g4 + 3] + b4.w; }
                float lv[4]; int li_[4];
#pragma unroll
                for (int k = 0; k < 4; ++k) { float best = -3.0e38f; int bi = 0;
#pragma unroll
                    for (int i = 0; i < 16; ++i) { const int e = (i & 3) + 8 * (i >> 2) + 4 * h2; if (v[i] > best) { best = v[i]; bi = e; } }
#pragma unroll
                    for (int i = 0; i < 16; ++i) { const int e = (i & 3) + 8 * (i >> 2) + 4 * h2; v[i] = (e == bi) ? -3.0e38f : v[i]; }
                    lv[k] = best; li_[k] = bi; }
                float cv[8]; int ci[8];
#pragma unroll
                for (int k = 0; k < 4; ++k) { cv[k] = lv[k]; ci[k] = li_[k]; cv[4 + k] = __shfl_xor(lv[k], 32); ci[4 + k] = __shfl_xor(li_[k], 32); }
                float tv[4]; int te[4];
#pragma unroll
                for (int k = 0; k < 4; ++k) { float best = -3.0e38f; int bi = 64;
#pragma unroll
                    for (int i = 0; i < 8; ++i) { if (cv[i] > best || (cv[i] == best && ci[i] < bi)) { best = cv[i]; bi = ci[i]; } }
#pragma unroll
                    for (int i = 0; i < 8; ++i) cv[i] = (ci[i] == bi) ? -3.0e38f : cv[i];
                    tv[k] = best; te[k] = bi; }
                const float e1 = __expf(tv[1] - tv[0]), e2 = __expf(tv[2] - tv[0]), e3 = __expf(tv[3] - tv[0]), rs = 1.f / (1.f + e1 + e2 + e3);
                const float gt[4] = {rs, e1 * rs, e2 * rs, e3 * rs};
                if (h2 == 0) {
#pragma unroll
                    for (int k = 0; k < 4; ++k) {
                        const unsigned lpos = __hip_atomic_fetch_add(LCNT + te[k], 1u, __ATOMIC_RELAXED, __HIP_MEMORY_SCOPE_WORKGROUP);
                        const unsigned li = __hip_atomic_fetch_add(LLEN, 1u, __ATOMIC_RELAXED, __HIP_MEMORY_SCOPE_WORKGROUP);
                        LIST[2 * li] = (unsigned)(mytok * 4 + k); LIST[2 * li + 1] = (unsigned)te[k] | (lpos << 8);
                        TKE[mytok * 4 + k] = te[k]; TKG[mytok * 4 + k] = gt[k]; }
                }
            }
            __syncthreads();
            if (tid < 32 && rep_ == 0) GBASE[tid] = __hip_atomic_fetch_add((unsigned*)ctl + CW_CNT + (l * 32 + tid) * 64, LCNT[tid], RLX_AGENT);
            __syncthreads();
            if (rep_ == 0) { const unsigned n = LLEN[0];
                for (unsigned i = tid; i < n; i += NTHR) { const unsigned tk = LIST[2 * i], ev = LIST[2 * i + 1], e = ev & 255u, pos = GBASE[e] + (ev >> 8);
                    TKP[tk] = (int)pos; ROWTOK[(size_t)e * M + pos] = (int)(tk >> 2); } }
            __syncthreads();
        }
        SEAM(pb + 7);
        _Pragma("unroll 1") for (int rep_ = 0; rep_ < NREP(8); ++rep_) if (((PHMASK>>8)&1) && IN(pb + 8)) { PHASE_TID
            if (tid < 32) CNT[tid] = (int)__hip_atomic_load((unsigned*)ctl + CW_CNT + (l * 32 + tid) * 64, RLX_AGENT);
            __syncthreads();
            if (tid == 0) { int a = 0; for (int e = 0; e < 32; ++e) { PB[e] = a; a += (CNT[e] + 255) >> 8; } PB[32] = a; }
            __syncthreads();
            const int P = PB[32];
            const int* ROWTOK = (const int*)(ws + WS_ROWTOK);
            char* XD = (char*)(ws + WS_R1);
            for (int sb = gw * 64; sb < P * 256; sb += NGW * 64) {
                const int pm = sb >> 8; int e = 0;
#pragma unroll 1
                for (int j = 1; j < NEXP; ++j) e += (PB[j] <= pm) ? 1 : 0;
                const int pos0 = sb - PB[e] * 256, cnt = CNT[e];
                int nvalid = cnt - pos0; nvalid = nvalid > 64 ? 64 : nvalid;
                int tokv = -1; if (pos0 + lane < cnt) tokv = ROWTOK[(size_t)e * M + pos0 + lane];
#pragma unroll 1
                for (int j = 0; j < nvalid; j += 2) {
                    int t[2]; u32x4 a[2], b2[2];
#pragma unroll
                    for (int i = 0; i < 2; ++i) { t[i] = __builtin_amdgcn_readlane(tokv, j + i);
                        if (t[i] >= 0) { a[i] = *(const u32x4*)(Xb + (size_t)t[i] * 2048 + lane * 32); b2[i] = *(const u32x4*)(Xb + (size_t)t[i] * 2048 + lane * 32 + 16); } }
#pragma unroll
                    for (int i = 0; i < 2; ++i) if (t[i] >= 0) {
                        u32x4 o; o.x = pk4_f8(bflo(a[i].x) * F8_SX, bfhi(a[i].x) * F8_SX, bflo(a[i].y) * F8_SX, bfhi(a[i].y) * F8_SX); o.y = pk4_f8(bflo(a[i].z) * F8_SX, bfhi(a[i].z) * F8_SX, bflo(a[i].w) * F8_SX, bfhi(a[i].w) * F8_SX);
                        o.z = pk4_f8(bflo(b2[i].x) * F8_SX, bfhi(b2[i].x) * F8_SX, bflo(b2[i].y) * F8_SX, bfhi(b2[i].y) * F8_SX); o.w = pk4_f8(bflo(b2[i].z) * F8_SX, bfhi(b2[i].z) * F8_SX, bflo(b2[i].w) * F8_SX, bfhi(b2[i].w) * F8_SX);
                        *(u32x4*)(XD + (size_t)(sb + j + i) * 1024 + lane * 16) = o; }
                }
            }
            LAS float* scr = (LAS float*)(lds + wave * 8448);
            constexpr int IT_GU = 32 * 16 * 64, IT_DN = 32 * 16 * 32;
            for (int it = XW_SPLIT + gw; it < IT_GU + IT_DN; it += NGW) {
                if (it < IT_GU) { const int e = it >> 10, q = it & 1023, kb = q >> 6, nb = q & 63;
                    transpose_item_f8(INP(I_WGU) + (((size_t)l * 32 + e) * D + 64 * kb) * 2048 + 32 * nb, 2048, (unsigned char*)(ws + WS_WGU) + ((size_t)e * 2048 + 32 * nb) * D + 64 * kb, D, F8_SWGU, scr, lane); }
                else { const int r = it - IT_GU, e = r >> 9, q = r & 511, kb = q >> 5, nb = q & 31;
                    transpose_item_f8(INP(I_WDN) + (((size_t)l * 32 + e) * D + 64 * kb) * 1024 + 32 * nb, 1024, (unsigned char*)(ws + WS_WDN) + ((size_t)e * 1024 + 32 * nb) * D + 64 * kb, D, F8_SWDN, scr, lane); }
            }
            __syncthreads();
        }
        SEAM(pb + 8);
        if (IN(pb + 9) || IN(pb + 10)) { PHASE_TID
            if (tid < 32) CNT[tid] = (int)__hip_atomic_load((unsigned*)ctl + CW_CNT + (l * 32 + tid) * 64, RLX_AGENT);
            __syncthreads();
            if (tid == 0) { int a = 0; for (int e = 0; e < 32; ++e) { PB[e] = a; a += (CNT[e] + 255) >> 8; } PB[32] = a; }
            __syncthreads();
        }
        _Pragma("unroll 1") for (int rep_ = 0; rep_ < NREP(9); ++rep_) if (((PHMASK>>9)&1) && IN(pb + 9)) {
            SchedMoe S; S.T.init(PB[32], 8); S.G = G; S.c = bx; S.A = (const char*)(ws + WS_R1); S.W = (const char*)(ws + WS_WGU); S.C = (char*)(ws + WS_R2 + R2_HMID); S.PB = PB; S.wrows = 2048; S.ldc = 1024; S.cdiv = 2; S.osz = 1;
            pg8::EpiMoe1 E; E.bgu = INP(I_BGU) + (size_t)l * 32 * 2048;
            pg8::gemm_phase<true>(lds, D, D, D, S, E, wave);
        }
        SEAM(pb + 9);
        _Pragma("unroll 1") for (int rep_ = 0; rep_ < NREP(10); ++rep_) if (((PHMASK>>10)&1) && IN(pb + 10)) {
            SchedMoe S; S.T.init(PB[32], 4); S.G = G; S.c = bx; S.A = (const char*)(ws + WS_R2 + R2_HMID); S.W = (const char*)(ws + WS_WDN); S.C = (char*)(ws + WS_R1); S.PB = PB; S.wrows = 1024; S.ldc = 1024; S.cdiv = 1; S.osz = 2;
            pg8::EpiMoe2 E; E.bdn = INP(I_BDN) + (size_t)l * 32 * 1024;
            pg8::gemm_phase<true>(lds, D, D, D, S, E, wave);
        }
        SEAM(pb + 10);
        _Pragma("unroll 1") for (int rep_ = 0; rep_ < NREP(11); ++rep_) if (((PHMASK>>11)&1) && IN(pb + 11)) { PHASE_TID
            if (tid < 32) CNT[tid] = (int)__hip_atomic_load((unsigned*)ctl + CW_CNT + (l * 32 + tid) * 64, RLX_AGENT);
            LAS float* wgt = (LAS float*)(lds + 73728);
            const bool lastl = (l == DEPTH - 1);
            if (!lastl) load_gate_table(wgt, INP(I_WIN) + (size_t)(l + 1) * D * DIN, tid);
            __syncthreads();
            if (tid == 0) { int a = 0; for (int e = 0; e < 32; ++e) { PB[e] = a; a += (CNT[e] + 255) >> 8; } PB[32] = a; }
            __syncthreads();
            const int e0 = 8 * lane;
            f32x4 g[4], bb[4];
#pragma unroll
            for (int j = 0; j < 4; ++j) { const int o = (j >> 1) * 512 + e0 + (j & 1) * 4; g[j] = *(const f32x4*)(INP(I_LN2G) + l * D + o); bb[j] = *(const f32x4*)(INP(I_LN2B) + l * D + o); }
            const char* YA = (const char*)(ws + WS_R1);
            const bool dummy_ = (rep_ + 1 < NREP(11)); char* const Xo = dummy_ ? (char*)(ws + WS_R2) : Xb; float* const Fo = dummy_ ? (float*)(ws + WS_R2 + 256 * MiB) : args.out; float* const Go = dummy_ ? (float*)(ws + WS_R2 + 200 * MiB) : GIF;
            const int* TKE = (const int*)(ws + WS_TKE); const float* TKG = (const float*)(ws + WS_TKG); const int* TKP = (const int*)(ws + WS_TKP);
#pragma unroll 1
            for (int mb = gw * 16; mb < M; mb += NGW * 16) {
                const int ev = TKE[mb * 4 + lane], pv = TKP[mb * 4 + lane]; const float gv = TKG[mb * 4 + lane];
                const int rowv = PB[ev] * 256 + pv;
#pragma unroll 1
                for (int ti = 0; ti < 16; ti += 2) {
                    u32x4 xw[2][2], yw[2][4][2]; float gk[2][4];
#pragma unroll
                    for (int q = 0; q < 2; ++q) { const size_t m = (size_t)mb + ti + q;
                        xw[q][0] = *(const u32x4*)(Xb + (m * D + e0) * 2); xw[q][1] = *(const u32x4*)(Xb + (m * D + 512 + e0) * 2);
#pragma unroll
                        for (int k = 0; k < 4; ++k) { const size_t row = (size_t)__builtin_amdgcn_readlane(rowv, 4 * (ti + q) + k);
                            gk[q][k] = __builtin_bit_cast(float, __builtin_amdgcn_readlane(__builtin_bit_cast(int, gv), 4 * (ti + q) + k));
                            yw[q][k][0] = *(const u32x4*)(YA + (row * D + e0) * 2); yw[q][k][1] = *(const u32x4*)(YA + (row * D + 512 + e0) * 2); } }
#pragma unroll
                    for (int q = 0; q < 2; ++q) { const size_t m = (size_t)mb + ti + q;
                        f32x4 v[4];
#pragma unroll
                        for (int hh = 0; hh < 2; ++hh) { const u32x4 w = xw[q][hh];
                            v[2 * hh] = (f32x4){bflo(w.x), bfhi(w.x), bflo(w.y), bfhi(w.y)} * DN_ALPHA; v[2 * hh + 1] = (f32x4){bflo(w.z), bfhi(w.z), bflo(w.w), bfhi(w.w)} * DN_ALPHA; }
#pragma unroll
                        for (int k = 0; k < 4; ++k)
#pragma unroll
                            for (int hh = 0; hh < 2; ++hh) { const u32x4 w = yw[q][k][hh];
                                v[2 * hh] = v[2 * hh] + (f32x4){bflo(w.x), bfhi(w.x), bflo(w.y), bfhi(w.y)} * gk[q][k]; v[2 * hh + 1] = v[2 * hh + 1] + (f32x4){bflo(w.z), bfhi(w.z), bflo(w.w), bfhi(w.w)} * gk[q][k]; }
                        ln16(v, g, bb);
                        if (lastl) {
#pragma unroll
                            for (int j = 0; j < 4; ++j) *(f32x4*)(Fo + m * D + (j >> 1) * 512 + e0 + (j & 1) * 4) = v[j];
                        } else {
#pragma unroll
                            for (int hh = 0; hh < 2; ++hh) { *(u32x4*)(Xo + (m * D + hh * 512 + e0) * 2) = pg8::pack8(v[2 * hh], v[2 * hh + 1]);
                                u32x2 f8w; f8w.x = pk4_f8(v[2 * hh].x * F8_SX, v[2 * hh].y * F8_SX, v[2 * hh].z * F8_SX, v[2 * hh].w * F8_SX); f8w.y = pk4_f8(v[2 * hh + 1].x * F8_SX, v[2 * hh + 1].y * F8_SX, v[2 * hh + 1].z * F8_SX, v[2 * hh + 1].w * F8_SX);
                                if (!dummy_) *(u32x2*)((char*)(ws + WS_XF8) + m * D + hh * 512 + e0) = f8w; }
                            gates8b(v, wgt, Go + m * 8, lane);
                        }
                    }
                }
            }
            __syncthreads();
        }
        SEAM(pb + 11);
    }
#undef IN
#undef SEAM
}

extern "C" void kernel_launch(void* const* d_in, const int* in_sizes, int n_in, void* d_out, int out_size, void* d_ws, size_t ws_size, hipStream_t stream) {
    static int grid = 0;
    if (grid == 0) {
        if (n_in != N_IN || out_size != M * D || ws_size < WS_END) { fprintf(stderr, "kernel_launch: unexpected shapes (n_in %d, out %d, ws %zu)\n", n_in, out_size, ws_size); grid = -1; return; }
        int dev = 0, cus = 0, per_cu = 0;
        if (hipGetDevice(&dev) != hipSuccess || hipDeviceGetAttribute(&cus, hipDeviceAttributeMultiprocessorCount, dev) != hipSuccess) { grid = -1; return; }
        if (hipFuncSetAttribute((const void*)fwd_kernel, hipFuncAttributeMaxDynamicSharedMemorySize, LDS_BYTES) != hipSuccess) { fprintf(stderr, "kernel_launch: hipFuncSetAttribute failed\n"); grid = -1; return; }
        if (hipOccupancyMaxActiveBlocksPerMultiprocessor(&per_cu, (const void*)fwd_kernel, NTHR, LDS_BYTES) != hipSuccess || per_cu < 1) fprintf(stderr, "kernel_launch: occupancy query reports %d\n", per_cu);
        (void)hipGetLastError();
        grid = cus;
    }
    if (grid < 0) return;
    (void)hipMemsetAsync((char*)d_ws + WS_CTL, 0, CTL_ZERO_BYTES, stream);
    Args a{};
    for (int i = 0; i < N_IN; ++i) a.in[i] = (const float*)d_in[i];
    a.out = (float*)d_out; a.ws = (unsigned char*)d_ws;
#if MK_ONE_LAUNCH
    a.ph_lo = 0; a.ph_hi = NPH;
    hipLaunchKernelGGL(fwd_kernel, dim3(grid), dim3(NTHR), LDS_BYTES, stream, a);
#else
    for (int p = 0; p < NPH; ++p) { a.ph_lo = p; a.ph_hi = p + 1; hipLaunchKernelGGL(fwd_kernel, dim3(grid), dim3(NTHR), LDS_BYTES, stream, a); }
#endif
    const hipError_t le = hipPeekAtLastError();
    if (le != hipSuccess) fprintf(stderr, "kernel_launch: launch failed: %s\n", hipGetErrorName(le));
}
```

```cpp
#include <hip/hip_runtime.h>
#include <cstdio>
#include <cstdint>

#ifndef MK_ONE_LAUNCH
#define MK_ONE_LAUNCH 1
#endif

#define LAS __attribute__((address_space(3)))
#define GAS __attribute__((address_space(1)))
typedef unsigned short bf16;
typedef short bf16x8 __attribute__((ext_vector_type(8)));
typedef float f32x4 __attribute__((ext_vector_type(4)));
typedef float f32x2 __attribute__((ext_vector_type(2)));
typedef float f32x16 __attribute__((ext_vector_type(16)));
typedef unsigned u32x4 __attribute__((ext_vector_type(4)));
typedef unsigned u32x2 __attribute__((ext_vector_type(2)));
typedef __bf16 bf16x2_t __attribute__((ext_vector_type(2)));
typedef GAS unsigned gu32;
#define RLX_AGENT __ATOMIC_RELAXED, __HIP_MEMORY_SCOPE_AGENT
#define DI __device__ __forceinline__

constexpr int NWAVES = 8, NTHR = 512;
constexpr int D = 1024, BATCH = 16, SEQ = 4096, M = BATCH * SEQ, DEPTH = 2, MEML = 256, MROWS = BATCH * MEML;
constexpr int DIN = 6920, NU = 6912;
constexpr int UC_QK = 0, UC_RW = 512, UC_V = 2304, UC_OG = 2816, UC_CAQ = 3328, UC_GATE = 3840;
constexpr int UC_F8 = UC_V, NF8 = NU - UC_F8;
__host__ __device__ constexpr int ucol_src(int c) { return c < 512 ? c : (c < 2304 ? 1544 + (c - 512) : (c < 2816 ? 512 + (c - 2304) : (c < 3328 ? 1024 + (c - 2816) : (c < 3840 ? 3336 + (c - 3328) : 3848 + (c - 3840))))); }
constexpr int NEXP = 32, TOPK = 4;
constexpr int PMAX = M * TOPK / 256 + NEXP;
constexpr float LN_EPS = 1e-5f, RW_GN_EPS = 64e-5f, DN_ALPHA = 1.41421356237f;

enum { I_X = 0, I_MEM, I_LNIN_G, I_LNIN_B, I_MEMLN_G, I_MEMLN_B, I_WIN, I_CONVW, I_CONVB, I_IGB, I_FGB, I_MLNORMG, I_RWMU, I_RWW0, I_RWWUP, I_RWA0, I_RWAUP, I_RWGUP,
       I_RWKK, I_RWKA, I_RWRK, I_RWLNG, I_RWLNB, I_CAWKV, I_GATEB, I_WBRML, I_WBRRW, I_WBRCA, I_WO, I_LN1G, I_LN1B, I_RTW, I_RTB, I_WGU, I_BGU, I_WDN, I_BDN, I_LN2G, I_LN2B, N_IN };

constexpr size_t MiB = 1u << 20;
constexpr size_t WS_CTL = 0, CTL_ZERO_BYTES = 1 * MiB;
constexpr size_t WS_WIN = 1 * MiB;
constexpr size_t WS_WKV = 28 * MiB;
constexpr size_t WS_WBR = 32 * MiB;
constexpr size_t WS_WO = 38 * MiB;
constexpr size_t WS_WLORA = 42 * MiB;
constexpr size_t WS_WGU = 45 * MiB;
constexpr size_t WS_WDN = 173 * MiB;
constexpr size_t WS_X = 237 * MiB;
constexpr size_t WS_MEMN = 365 * MiB;
constexpr size_t WS_KV = 373 * MiB;
constexpr size_t WS_GIF = 389 * MiB;
constexpr size_t WS_TKE = 391 * MiB, WS_TKG = 392 * MiB, WS_TKP = 393 * MiB;
constexpr size_t WS_ROWTOK = 394 * MiB;
constexpr size_t WS_HML = 402 * MiB;
constexpr size_t WS_R1 = 466 * MiB;
constexpr size_t WS_R2 = 1330 * MiB;
constexpr size_t WS_XF8 = 1858 * MiB;
constexpr size_t WS_WING8 = 1922 * MiB;
constexpr size_t WS_END = 1932 * MiB;
constexpr size_t R2_LORA_OUT = 0, R2_HCAT = 192 * MiB, R2_LORA_IN = 384 * MiB, R2_YPRE = 0, R2_Z = 192 * MiB, R2_HMID = 0;
constexpr int CW_TMO = 0, CW_BAR = 4096, CW_CNT = 16384;

constexpr int LDS_BYTES = 155648;
constexpr int LDSCTL_OFF = 153600;

DI unsigned pk2(float lo, float hi) { bf16x2_t b = __builtin_convertvector((f32x2){lo, hi}, bf16x2_t); return __builtin_bit_cast(unsigned, b); }
DI unsigned f2bf(float f) { return pk2(f, 0.f) & 0xffffu; }
DI float u2f_(unsigned u) { return __builtin_bit_cast(float, u); }
DI unsigned f2u_(float f) { return __builtin_bit_cast(unsigned, f); }
DI float bflo(unsigned u) { return __builtin_bit_cast(float, u << 16); }
DI float bfhi(unsigned u) { return __builtin_bit_cast(float, u & 0xffff0000u); }
DI unsigned pk4_f8(float a, float b, float c, float d) {
    a = __builtin_amdgcn_fmed3f(a, -448.f, 448.f); b = __builtin_amdgcn_fmed3f(b, -448.f, 448.f); c = __builtin_amdgcn_fmed3f(c, -448.f, 448.f); d = __builtin_amdgcn_fmed3f(d, -448.f, 448.f);
    int w = 0; w = __builtin_amdgcn_cvt_pk_fp8_f32(a, b, w, false); w = __builtin_amdgcn_cvt_pk_fp8_f32(c, d, w, true); return (unsigned)w; }
DI float sigmoidf_(float x) { return __builtin_amdgcn_rcpf(1.f + __builtin_amdgcn_exp2f(-1.4426950408889634f * x)); }
template <int CTRL> DI float dppf(float x) { return __builtin_bit_cast(float, __builtin_amdgcn_update_dpp(0, __builtin_bit_cast(int, x), CTRL, 0xF, 0xF, true)); }
DI float red4(float x) { x += dppf<0xB1>(x); x += dppf<0x4E>(x); return x; }
DI float red8(float x) { x = red4(x); x += dppf<0x141>(x); return x; }
DI float red16(float x) { x = red8(x); x += dppf<0x140>(x); return x; }
DI float red8o(float x) { x += dppf<0xB1>(x); asm("" : "+v"(x)); x += dppf<0x4E>(x); asm("" : "+v"(x)); x += dppf<0x141>(x); asm("" : "+v"(x)); return x; }
DI float red16o(float x) { x = red8o(x); x += dppf<0x140>(x); asm("" : "+v"(x)); return x; }
typedef short s16x4 __attribute__((ext_vector_type(4)));
DI u32x2 trd4(const LAS unsigned char* img, int PB, int rowbase, int colbase, int lane) {
    const LAS unsigned char* p = img + (rowbase + ((lane & 15) >> 2)) * PB + (colbase + 16 * ((lane >> 4) & 1) + 4 * (lane & 3)) * 2;
    return __builtin_bit_cast(u32x2, __builtin_amdgcn_ds_read_tr16_b64_v4i16((LAS s16x4*)p)); }
DI bf16x8 trd8(const LAS unsigned char* img, int PB, int rb0, int rb1, int colbase, int lane) { const u32x2 lo = trd4(img, PB, rb0, colbase, lane), hi = trd4(img, PB, rb1, colbase, lane); return __builtin_bit_cast(bf16x8, (u32x4){lo.x, lo.y, hi.x, hi.y}); }
template <int CTRL, int RM> DI float dpp_keep(float x, float ident) { return __builtin_bit_cast(float, __builtin_amdgcn_update_dpp(__builtin_bit_cast(int, ident), __builtin_bit_cast(int, x), CTRL, RM, 0xF, false)); }
DI float scan_add64(float x) { x += dpp_keep<0x111, 0xF>(x, 0.f); x += dpp_keep<0x112, 0xF>(x, 0.f); x += dpp_keep<0x114, 0xF>(x, 0.f); x += dpp_keep<0x118, 0xF>(x, 0.f); x += dpp_keep<0x142, 0xA>(x, 0.f); x += dpp_keep<0x143, 0xC>(x, 0.f); return x; }
DI float scan_max64(float x) { const float NI = -3.0e38f; x = fmaxf(x, dpp_keep<0x111, 0xF>(x, NI)); x = fmaxf(x, dpp_keep<0x112, 0xF>(x, NI)); x = fmaxf(x, dpp_keep<0x114, 0xF>(x, NI)); x = fmaxf(x, dpp_keep<0x118, 0xF>(x, NI));
    x = fmaxf(x, dpp_keep<0x142, 0xA>(x, NI)); x = fmaxf(x, dpp_keep<0x143, 0xC>(x, NI)); return x; }
DI float wave_sum(float v) {
    v = red16(v);
    const int vi = __builtin_bit_cast(int, v);
    const float a = __builtin_bit_cast(float, __builtin_amdgcn_readlane(vi, 0)), b = __builtin_bit_cast(float, __builtin_amdgcn_readlane(vi, 16));
    const float c = __builtin_bit_cast(float, __builtin_amdgcn_readlane(vi, 32)), d = __builtin_bit_cast(float, __builtin_amdgcn_readlane(vi, 48));
    return (a + b) + (c + d);
}
#define LDS_WAIT() asm volatile("s_waitcnt lgkmcnt(0)" ::: "memory")

constexpr float F8_SX = 8.f, F8_SWGU = 512.f, F8_SH = 4.f, F8_SWDN = 1024.f, F8_INV1 = 1.f / (F8_SX * F8_SWGU), F8_INV2 = 1.f / (F8_SH * F8_SWDN);
namespace pg8 {
constexpr int BM = 256, BK = 64, HALF = 128, HTB = HALF * BK * 2, STAGE_BYTES = 8 * HTB, NXCD = 8, WGM = 8;
__host__ __device__ __forceinline__ int lds_byte(int r, int c) { const int st = (r >> 4) * 2 + (c >> 5), rr = r & 15, cc = c & 31, ob = rr * 64 + cc * 2; return st * 1024 + (ob ^ (((ob >> 9) & 1) << 5)); }
__host__ __device__ __forceinline__ void stage_rc(int b, int& R, int& C) { const int st = b / 1024, sb = b % 1024, swz = sb ^ (((sb >> 9) & 1) << 5); R = (st >> 1) * 16 + swz / 64; C = (st & 1) * 32 + (swz % 64) / 2; }
__host__ __device__ __forceinline__ int perm32(int rho) { const int n = rho >> 4, i = rho & 15; return 8 * (i >> 2) + 4 * n + (i & 3); }

struct Unit { const char* a; const char* b; char* c; int ldc; int r0, c0, e, sub; };

struct TileOrder {
    int nM, nN, nwg;
    DI void init(int nM_, int nN_) { nM = nM_; nN = nN_; nwg = nM * nN; }
    DI bool tile(long L, int& pm, int& pn) const {
        if (L >= nwg) return false;
        int wgid = (int)L; { const int q = nwg / NXCD, r = nwg % NXCD, xcd = wgid % NXCD, off = wgid / NXCD; wgid = (xcd < r ? xcd * (q + 1) : r * (q + 1) + (xcd - r) * q) + off; }
        const int nig = WGM * nN, gid = wgid / nig, fm = gid * WGM, gsz = (nM - fm) < WGM ? (nM - fm) : WGM;
        pm = fm + ((wgid % nig) % gsz); pn = (wgid % nig) / gsz; return true;
    }
};

DI u32x4 pack8(const f32x4& v0, const f32x4& v1) { u32x4 w; w.x = pk2(v0[0], v0[1]); w.y = pk2(v0[2], v0[3]); w.z = pk2(v1[0], v1[1]); w.w = pk2(v1[2], v1[3]); return w; }

struct EpiStore {
    DI void operator()(const f32x4 (&acc)[2][2][4][2], const Unit& u, int wr, int wc, int fr, int fq) const {
#pragma unroll
        for (int ai = 0; ai < 2; ++ai)
#pragma unroll
            for (int m = 0; m < 4; ++m) { char* rowp = u.c + ((size_t)(ai * HALF + wr * 64 + m * 16 + fr) * u.ldc + wc * 32 + 8 * fq) * 2;
#pragma unroll
                for (int bj = 0; bj < 2; ++bj) *(u32x4*)(rowp + bj * 256) = pack8(acc[ai][bj][m][0], acc[ai][bj][m][1]); }
    }
};
struct EpiStoreS {
    float s; const float* gate_b; int gate_c0;
    DI void operator()(const f32x4 (&acc)[2][2][4][2], const Unit& u, int wr, int wc, int fr, int fq) const {
        const bool gate = u.c0 >= gate_c0;
        const float L2E = 1.4426950408889634f;
#pragma unroll
        for (int bj = 0; bj < 2; ++bj) {
            f32x4 g0 = (f32x4){0.f, 0.f, 0.f, 0.f}, g1 = g0;
            if (gate) { const float* g = gate_b + (u.c0 - gate_c0) + bj * HALF + wc * 32 + 8 * fq; g0 = *(const f32x4*)g; g1 = *(const f32x4*)(g + 4); }
#pragma unroll
            for (int ai = 0; ai < 2; ++ai)
#pragma unroll
                for (int m = 0; m < 4; ++m) { char* rowp = u.c + ((size_t)(ai * HALF + wr * 64 + m * 16 + fr) * u.ldc + wc * 32 + 8 * fq) * 2;
                    f32x4 v0 = acc[ai][bj][m][0] * s, v1 = acc[ai][bj][m][1] * s;
                    if (gate) {
#pragma unroll
                        for (int i = 0; i < 4; ++i) { v0[i] = __builtin_amdgcn_exp2f(-L2E * __builtin_amdgcn_fmed3f(v0[i] + g0[i], -30.f, 30.f)); v1[i] = __builtin_amdgcn_exp2f(-L2E * __builtin_amdgcn_fmed3f(v1[i] + g1[i], -30.f, 30.f)); } }
                    *(u32x4*)(rowp + bj * 256) = pack8(v0, v1); }
        }
    }
};
struct EpiMerge {
    static constexpr bool MIDK = true;
    const char* U; const float* gate_b;
    DI void mid(f32x4 (&acc)[2][2][4][2], const Unit& u, int which, int wr, int wc, int fr, int fq) const {
#pragma unroll
        for (int bj = 0; bj < 2; ++bj)
#pragma unroll
            for (int ai = 0; ai < 2; ++ai) {
                u32x4 wa[4], wn[4];
#pragma unroll
                for (int m = 0; m < 4; ++m) { const int lr = ai * HALF + wr * 64 + m * 16 + fr;
                    const char* gp = U + ((size_t)(u.r0 + lr) * NU + UC_GATE + which * 1024 + u.c0 + wc * 32 + 8 * fq) * 2 + bj * 256;
                    wa[m] = *(const u32x4*)gp; wn[m] = *(const u32x4*)(gp + 2048); }
#pragma unroll
                for (int m = 0; m < 4; ++m) {
                    const u32x4 a = wa[m], n = wn[m];
                    const float ea[8] = {bflo(a.x), bfhi(a.x), bflo(a.y), bfhi(a.y), bflo(a.z), bfhi(a.z), bflo(a.w), bfhi(a.w)};
                    const float en[8] = {bflo(n.x), bfhi(n.x), bflo(n.y), bfhi(n.y), bflo(n.z), bfhi(n.z), bflo(n.w), bfhi(n.w)};
#pragma unroll
                    for (int i = 0; i < 8; ++i) acc[ai][bj][m][i >> 2][i & 3] *= (1.f + en[i]) * __builtin_amdgcn_rcpf(1.f + ea[i]); }
                asm volatile("" ::: "memory"); }
    }
    DI void operator()(const f32x4 (&acc)[2][2][4][2], const Unit& u, int wr, int wc, int fr, int fq) const {
#pragma unroll
        for (int bj = 0; bj < 2; ++bj) {
            u32x4 gw[2][4];
#pragma unroll
            for (int ai = 0; ai < 2; ++ai)
#pragma unroll
                for (int m = 0; m < 4; ++m) { const int lr = ai * HALF + wr * 64 + m * 16 + fr; gw[ai][m] = *(const u32x4*)(U + ((size_t)(u.r0 + lr) * NU + UC_GATE + 2048 + u.c0 + wc * 32 + 8 * fq) * 2 + bj * 256); }
#pragma unroll
            for (int ai = 0; ai < 2; ++ai)
#pragma unroll
                for (int m = 0; m < 4; ++m) { const int lr = ai * HALF + wr * 64 + m * 16 + fr; char* rowp = u.c + ((size_t)lr * u.ldc + wc * 32 + 8 * fq) * 2; const u32x4 w = gw[ai][m];
                    f32x4 v0 = acc[ai][bj][m][0], v1 = acc[ai][bj][m][1];
                    v0[0] *= __builtin_amdgcn_rcpf(1.f + bflo(w.x)); v0[1] *= __builtin_amdgcn_rcpf(1.f + bfhi(w.x)); v0[2] *= __builtin_amdgcn_rcpf(1.f + bflo(w.y)); v0[3] *= __builtin_amdgcn_rcpf(1.f + bfhi(w.y));
                    v1[0] *= __builtin_amdgcn_rcpf(1.f + bflo(w.z)); v1[1] *= __builtin_amdgcn_rcpf(1.f + bfhi(w.z)); v1[2] *= __builtin_amdgcn_rcpf(1.f + bflo(w.w)); v1[3] *= __builtin_amdgcn_rcpf(1.f + bfhi(w.w));
                    *(u32x4*)(rowp + bj * 256) = pack8(v0, v1); }
            asm volatile("" ::: "memory");
        }
    }
};
struct EpiWo {
    const char* X;
    DI void operator()(const f32x4 (&acc)[2][2][4][2], const Unit& u, int wr, int wc, int fr, int fq) const {
#pragma unroll
        for (int ai = 0; ai < 2; ++ai)
#pragma unroll
            for (int m = 0; m < 4; ++m) { const int lr = ai * HALF + wr * 64 + m * 16 + fr; char* rowp = u.c + ((size_t)lr * u.ldc + wc * 32 + 8 * fq) * 2;
                const char* xp = X + ((size_t)(u.r0 + lr) * D + u.c0 + wc * 32 + 8 * fq) * 2;
#pragma unroll
                for (int bj = 0; bj < 2; ++bj) { const u32x4 xw = *(const u32x4*)(xp + bj * 256);
                    f32x4 v0 = acc[ai][bj][m][0], v1 = acc[ai][bj][m][1];
                    v0[0] += DN_ALPHA * bflo(xw.x); v0[1] += DN_ALPHA * bfhi(xw.x); v0[2] += DN_ALPHA * bflo(xw.y); v0[3] += DN_ALPHA * bfhi(xw.y);
                    v1[0] += DN_ALPHA * bflo(xw.z); v1[1] += DN_ALPHA * bfhi(xw.z); v1[2] += DN_ALPHA * bflo(xw.w); v1[3] += DN_ALPHA * bfhi(xw.w);
                    *(u32x4*)(rowp + bj * 256) = pack8(v0, v1); }
                asm volatile("" ::: "memory"); }
    }
};
DI float swiglu1(float a, float b) { const float g = fminf(a, 7.f), l = fminf(fmaxf(b, -7.f), 7.f); return g * sigmoidf_(1.702f * g) * (l + 1.f); }
struct EpiMoe1 {
    const float* bgu;
    DI void operator()(const f32x4 (&acc)[2][2][4][2], const Unit& u, int wr, int wc, int fr, int fq) const {
        f32x4 bv[2][2];
#pragma unroll
        for (int bj = 0; bj < 2; ++bj) { const float* b = bgu + u.e * 2048 + u.c0 + bj * HALF + wc * 32 + 8 * fq; bv[bj][0] = *(const f32x4*)b; bv[bj][1] = *(const f32x4*)(b + 4); }
#pragma unroll
        for (int ai = 0; ai < 2; ++ai)
#pragma unroll
            for (int m = 0; m < 4; ++m) { const int lr = ai * HALF + wr * 64 + m * 16 + fr; char* rowp = u.c + ((size_t)lr * u.ldc + wc * 16 + 4 * fq);
#pragma unroll
                for (int bj = 0; bj < 2; ++bj) { const f32x4 v0 = acc[ai][bj][m][0] * F8_INV1 + bv[bj][0], v1 = acc[ai][bj][m][1] * F8_INV1 + bv[bj][1];
                    *(unsigned*)(rowp + bj * 64) = pk4_f8(swiglu1(v0[0], v0[1]) * F8_SH, swiglu1(v0[2], v0[3]) * F8_SH, swiglu1(v1[0], v1[1]) * F8_SH, swiglu1(v1[2], v1[3]) * F8_SH); } }
    }
};
struct EpiMoe2 {
    const float* bdn;
    DI void operator()(const f32x4 (&acc)[2][2][4][2], const Unit& u, int wr, int wc, int fr, int fq) const {
        f32x4 bv[2][2];
#pragma unroll
        for (int bj = 0; bj < 2; ++bj) { const float* b = bdn + u.e * 1024 + u.c0 + bj * HALF + wc * 32 + 8 * fq; bv[bj][0] = *(const f32x4*)b; bv[bj][1] = *(const f32x4*)(b + 4); }
#pragma unroll
        for (int ai = 0; ai < 2; ++ai)
#pragma unroll
            for (int m = 0; m < 4; ++m) { char* rowp = u.c + ((size_t)(ai * HALF + wr * 64 + m * 16 + fr) * u.ldc + wc * 32 + 8 * fq) * 2;
#pragma unroll
                for (int bj = 0; bj < 2; ++bj) *(u32x4*)(rowp + bj * 256) = pack8(acc[ai][bj][m][0] * F8_INV2 + bv[bj][0], acc[ai][bj][m][1] * F8_INV2 + bv[bj][1]); }
    }
};

typedef int i32x8 __attribute__((ext_vector_type(8)));
typedef int i32x4 __attribute__((ext_vector_type(4)));
template <bool F8, bool MIDK = false, class Epi, class Sched>
DI void gemm_phase(LAS unsigned char* lds, const int KB  , const int ldaB, const int ldbB, const Sched& S, const Epi& E, const int wave_) {
    unsigned z_ = 0u; asm volatile("" : "+v"(z_)); const int tid = wave_ * 64 + (int)__builtin_amdgcn_mbcnt_hi(~0u, __builtin_amdgcn_mbcnt_lo(~0u, z_));
    const int wid = __builtin_amdgcn_readfirstlane(tid >> 6), lane = tid & 63, wr = wid >> 2, wc = wid & 3, fr = lane & 15, fq = lane >> 4;
    const int nt = KB / (BK * 2);
    unsigned voffA[2], voffB[2];
#pragma unroll
    for (int i = 0; i < 2; ++i) { int R, C; stage_rc(tid * 16 + i * 8192, R, C); const int Rb = (R & ~31) + perm32(R & 31);
        voffA[i] = (unsigned)(R * ldaB + C * 2); voffB[i] = (unsigned)(Rb * ldbB + C * 2); }
    asm volatile("" : "+v"(voffA[0]), "+v"(voffA[1]), "+v"(voffB[0]), "+v"(voffB[1]));
    const size_t kstep = (size_t)(BK * 2);
    const size_t hstepA = (size_t)HALF * ldaB, hstepB = (size_t)HALF * ldbB;
    const unsigned ldsw = (unsigned)wid * 1024u;
    const int aoff = lds_byte(wr * 64 + fr, fq * 8), boff = lds_byte(wc * 32 + fr, fq * 8);
#define PG8_SA(b, h) (((b) * 2 + (h)) * HTB)
#define PG8_SB(b, h) ((4 + (b) * 2 + (h)) * HTB)
#define PG8_STAGE(bufoff, gbase, voff) do { _Pragma("unroll") for (int _i = 0; _i < 2; ++_i) \
        __builtin_amdgcn_global_load_lds((const unsigned*)((const char*)(gbase) + (voff)[_i]), (LAS unsigned*)(lds + (bufoff) + ldsw + _i * 8192), 16, 0, 0); } while (0)
#define PG8_LD8(p) __builtin_shufflevector(*(const LAS i32x4*)(p), *(const LAS i32x4*)((p) + 1024), 0, 1, 2, 3, 4, 5, 6, 7)
#define PG8_LDA8(dst, b, h) do { _Pragma("unroll") for (int m = 0; m < 4; ++m) dst[m] = PG8_LD8(lds + PG8_SA(b, h) + aoff + m * 2048); } while (0)
#define PG8_LDB8(dst, b, h) do { _Pragma("unroll") for (int n = 0; n < 2; ++n) dst[n] = PG8_LD8(lds + PG8_SB(b, h) + boff + n * 2048); } while (0)
#define PG8_MMA8(ai, bj, A8, B8) do { __builtin_amdgcn_s_setprio(1); _Pragma("unroll") for (int m = 0; m < 4; ++m) _Pragma("unroll") for (int n = 0; n < 2; ++n) \
        asm volatile("v_mfma_f32_16x16x128_f8f6f4 %0, %1, %2, %0" : "+v"(acc[ai][bj][m][n]) : "v"(B8[n]), "v"(A8[m])); __builtin_amdgcn_s_setprio(0); } while (0)
#define PG8_LDA(dst, b, h) do { _Pragma("unroll") for (int m = 0; m < 4; ++m) _Pragma("unroll") for (int k = 0; k < 2; ++k) dst[m][k] = *(const LAS bf16x8*)(lds + PG8_SA(b, h) + aoff + m * 2048 + k * 1024); } while (0)
#define PG8_LDB(dst, b, h) do { _Pragma("unroll") for (int n = 0; n < 2; ++n) _Pragma("unroll") for (int k = 0; k < 2; ++k) dst[n][k] = *(const LAS bf16x8*)(lds + PG8_SB(b, h) + boff + n * 2048 + k * 1024); } while (0)
#define PG8_CAT(x) __builtin_shufflevector(__builtin_bit_cast(i32x4, (x)[0]), __builtin_bit_cast(i32x4, (x)[1]), 0, 1, 2, 3, 4, 5, 6, 7)
#define PG8_MMA(ai, bj, At, Bt) do { __builtin_amdgcn_s_setprio(1); _Pragma("unroll") for (int m = 0; m < 4; ++m) _Pragma("unroll") for (int n = 0; n < 2; ++n) _Pragma("unroll") for (int k = 0; k < 2; ++k) \
        acc[ai][bj][m][n] = __builtin_amdgcn_mfma_f32_16x16x32_bf16(Bt[n][k], At[m][k], acc[ai][bj][m][n], 0, 0, 0); __builtin_amdgcn_s_setprio(0); } while (0)
#define PG8_WAIT_V(n) asm volatile("s_waitcnt vmcnt(" #n ")" ::: "memory")
#define PG8_WAIT_L(n) asm volatile("s_waitcnt lgkmcnt(" #n ")" ::: "memory")
#define PG8_BAR __builtin_amdgcn_s_barrier()
#define PG8_SCHED __builtin_amdgcn_sched_barrier(0)
    Unit cur, nxt; int ui = 0;
    if (!S.next(0, cur)) return;
    f32x4 acc[2][2][4][2];
#pragma unroll
    for (int a = 0; a < 2; ++a)
#pragma unroll
        for (int b = 0; b < 2; ++b)
#pragma unroll
            for (int m = 0; m < 4; ++m)
#pragma unroll
                for (int n = 0; n < 2; ++n) acc[a][b][m][n] = (f32x4){0.f, 0.f, 0.f, 0.f};
    bf16x8 At[4][2], B0[2][2], B1[2][2]; i32x8 A8[4], B80[2], B81[2];
    const char* cA = cur.a; const char* cB = cur.b;
    PG8_STAGE(PG8_SB(0, 0), cB, voffB); PG8_STAGE(PG8_SB(0, 1), cB + hstepB, voffB); PG8_STAGE(PG8_SA(0, 0), cA, voffA); PG8_STAGE(PG8_SA(0, 1), cA + hstepA, voffA);
    if (wr == 1) PG8_BAR;
    PG8_WAIT_V(2); PG8_BAR;
    PG8_STAGE(PG8_SB(1, 0), cB + kstep, voffB); PG8_STAGE(PG8_SA(1, 0), cA + kstep, voffA); PG8_STAGE(PG8_SB(1, 1), cB + hstepB + kstep, voffB);
    PG8_WAIT_V(6); PG8_BAR;
    for (;;) {
        const bool has_next = S.next(ui + 1, nxt);
        const char* nA = has_next ? nxt.a : cA; const char* nB = has_next ? nxt.b : cB;
#pragma unroll 1
        for (int t = 0; t < nt; t += 2) {
            if constexpr (MIDK) { if (t == 8 || t == 16) { int fr_ = fr, fq_ = fq; asm volatile("" : "+v"(fr_), "+v"(fq_)); E.mid(acc, cur, t >> 4, wr, wc, fr_, fq_); } }
            const bool last = (t == nt - 2);
            const char* a1 = cA + (size_t)(t + 1) * kstep;
            const char* a2 = last ? nA : cA + (size_t)(t + 2) * kstep; const char* b2 = last ? nB : cB + (size_t)(t + 2) * kstep;
            const char* a3 = a2 + kstep; const char* b3 = b2 + kstep;
            if constexpr (F8) {
            PG8_LDB8(B80, 0, 0); PG8_LDB8(B81, 0, 1); PG8_SCHED; PG8_LDA8(A8, 0, 0); PG8_STAGE(PG8_SA(1, 1), a1 + hstepA, voffA);
            PG8_WAIT_V(8); PG8_WAIT_L(0); PG8_BAR; PG8_MMA8(0, 0, A8, B80); PG8_MMA8(0, 1, A8, B81); PG8_BAR; PG8_SCHED;
            PG8_LDA8(A8, 0, 1); PG8_STAGE(PG8_SB(0, 0), b2, voffB); PG8_STAGE(PG8_SB(0, 1), b2 + hstepB, voffB); PG8_STAGE(PG8_SA(0, 0), a2, voffA);
            PG8_WAIT_V(8); PG8_WAIT_L(0); PG8_BAR; PG8_MMA8(1, 0, A8, B80); PG8_MMA8(1, 1, A8, B81); PG8_BAR; PG8_SCHED;
            PG8_LDB8(B80, 1, 0); PG8_LDB8(B81, 1, 1); PG8_SCHED; PG8_LDA8(A8, 1, 0); PG8_STAGE(PG8_SA(0, 1), a2 + hstepA, voffA);
            PG8_WAIT_V(8); PG8_WAIT_L(0); PG8_BAR; PG8_MMA8(0, 0, A8, B80); PG8_MMA8(0, 1, A8, B81); PG8_BAR; PG8_SCHED;
            PG8_LDA8(A8, 1, 1); PG8_STAGE(PG8_SB(1, 0), b3, voffB); PG8_STAGE(PG8_SB(1, 1), b3 + hstepB, voffB); PG8_STAGE(PG8_SA(1, 0), a3, voffA);
            PG8_WAIT_V(8); PG8_WAIT_L(0); PG8_BAR; PG8_MMA8(1, 0, A8, B80); PG8_MMA8(1, 1, A8, B81); PG8_BAR; PG8_SCHED;
            } else {
            PG8_LDB(B0, 0, 0); PG8_LDB(B1, 0, 1); PG8_SCHED; PG8_LDA(At, 0, 0); PG8_STAGE(PG8_SA(1, 1), a1 + hstepA, voffA);
            PG8_WAIT_V(8); PG8_WAIT_L(0); PG8_BAR; PG8_MMA(0, 0, At, B0); PG8_MMA(0, 1, At, B1); PG8_BAR; PG8_SCHED;
            PG8_LDA(At, 0, 1); PG8_STAGE(PG8_SB(0, 0), b2, voffB); PG8_STAGE(PG8_SB(0, 1), b2 + hstepB, voffB); PG8_STAGE(PG8_SA(0, 0), a2, voffA);
            PG8_WAIT_V(8); PG8_WAIT_L(0); PG8_BAR; PG8_MMA(1, 0, At, B0); PG8_MMA(1, 1, At, B1); PG8_BAR; PG8_SCHED;
            PG8_LDB(B0, 1, 0); PG8_LDB(B1, 1, 1); PG8_SCHED; PG8_LDA(At, 1, 0); PG8_STAGE(PG8_SA(0, 1), a2 + hstepA, voffA);
            PG8_WAIT_V(8); PG8_WAIT_L(0); PG8_BAR; PG8_MMA(0, 0, At, B0); PG8_MMA(0, 1, At, B1); PG8_BAR; PG8_SCHED;
            PG8_LDA(At, 1, 1); PG8_STAGE(PG8_SB(1, 0), b3, voffB); PG8_STAGE(PG8_SB(1, 1), b3 + hstepB, voffB); PG8_STAGE(PG8_SA(1, 0), a3, voffA);
            PG8_WAIT_V(8); PG8_WAIT_L(0); PG8_BAR; PG8_MMA(1, 0, At, B0); PG8_MMA(1, 1, At, B1); PG8_BAR; PG8_SCHED;
            }
        }
        if (wr == 0) PG8_BAR;
        if constexpr (F8) asm volatile("s_nop 15\n\ts_nop 15" ::: "memory");
        { int fr_ = fr, fq_ = fq; asm volatile("" : "+v"(fr_), "+v"(fq_));
          E(acc, cur, wr, wc, fr_, fq_); }
        if (!has_next) break;
#pragma unroll
        for (int a = 0; a < 2; ++a)
#pragma unroll
            for (int b = 0; b < 2; ++b)
#pragma unroll
                for (int m = 0; m < 4; ++m)
#pragma unroll
                    for (int n = 0; n < 2; ++n) acc[a][b][m][n] = (f32x4){0.f, 0.f, 0.f, 0.f};
        cur = nxt; cA = nA; cB = nB; ++ui;
        if (wr == 1) PG8_BAR;
    }
    PG8_WAIT_V(0);
    PG8_BAR;
#undef PG8_SA
#undef PG8_SB
#undef PG8_STAGE
#undef PG8_LDA
#undef PG8_LDB
#undef PG8_MMA
#undef PG8_CAT
#undef PG8_LD8
#undef PG8_LDA8
#undef PG8_LDB8
#undef PG8_MMA8
#undef PG8_WAIT_V
#undef PG8_WAIT_L
#undef PG8_BAR
#undef PG8_SCHED
}
}

#define XB_TMO      128
#define XB_XCNT(j)  (256  + 64 * (j))
#define XB_XSUB(j)  (1280 + 64 * (j))
#define XB_XGEN(j)  (2304 + 64 * (j))
#define XB_TOP      3328
#define XB_TOPGEN   3392
#define XCD_BAR_WORDS 3456
#define XB_SPIN_CAP (1u << 22)
DI unsigned xb_ld(unsigned* p)              { return __hip_atomic_load(p, __ATOMIC_RELAXED, __HIP_MEMORY_SCOPE_AGENT); }
DI unsigned xb_add(unsigned* p, unsigned v) { return __hip_atomic_fetch_add(p, v, __ATOMIC_RELAXED, __HIP_MEMORY_SCOPE_AGENT); }
DI unsigned xb_xcc_id() { return (unsigned)__builtin_amdgcn_s_getreg((3 << 11) | 20) & 0xFu; }
#define XB_SPIN(cond, bar) do { unsigned _sp = 0; while (cond) { __builtin_amdgcn_s_sleep(1); \
    if ((++_sp & 255u) == 0u) { if (xb_ld(&(bar)[XB_TMO])) break; if (_sp > XB_SPIN_CAP) { atomicAdd(&(bar)[XB_TMO], 1u); break; } } } } while (0)
struct XcdBarrier { unsigned* bar; unsigned x; volatile LAS unsigned* st; };
DI XcdBarrier xcd_barrier_post(unsigned* bar, volatile LAS unsigned* st) {
    XcdBarrier b; b.bar = bar; b.x = xb_xcc_id(); b.st = st;
    if (threadIdx.x == 0) (void)xb_add(&bar[XB_XCNT(b.x)], 1u);
    return b;
}
DI void xcd_barrier_complete(unsigned* bar, unsigned x, unsigned& nloc, unsigned& nx) {
    const unsigned G = gridDim.x * gridDim.y * gridDim.z;
    unsigned sum, cnt, mine, sp = 0u;
    for (;;) {
        sum = 0u; cnt = 0u; mine = 0u;
#pragma unroll
        for (unsigned j = 0; j < 16; ++j) { const unsigned c = xb_ld(&bar[XB_XCNT(j)]); sum += c; cnt += (c > 0u) ? 1u : 0u; mine = (j == x) ? c : mine; }
        if (sum == G) break;
        __builtin_amdgcn_s_sleep(1);
        if ((++sp & 255u) == 0u) { if (xb_ld(&bar[XB_TMO])) break; if (sp > XB_SPIN_CAP) { atomicAdd(&bar[XB_TMO], 1u); break; } }
    }
    nloc = mine > 0u ? mine : 1u; nx = cnt > 0u ? cnt : 1u;
}
DI void xcd_barrier(const XcdBarrier& b) {
    asm volatile("s_waitcnt vmcnt(0)" ::: "memory");
    __syncthreads();
    if (threadIdx.x == 0) {
        unsigned* bar = b.bar;
        __builtin_amdgcn_s_waitcnt(0);
        unsigned nloc = b.st[0], nx = b.st[1];
        if (nloc == 0u) { xcd_barrier_complete(bar, b.x, nloc, nx); b.st[0] = nloc; b.st[1] = nx; }
        const unsigned old = xb_add(&bar[XB_XSUB(b.x)], 1u);
        const unsigned gen = old / nloc;
        if (old + 1u == (gen + 1u) * nloc) {
            __builtin_amdgcn_fence(__ATOMIC_RELEASE, "agent");
            asm volatile("s_waitcnt vmcnt(0)" ::: "memory");
            const unsigned og = xb_add(&bar[XB_TOP], 1u);
            const unsigned tg = og / nx;
            if (og + 1u == (tg + 1u) * nx) xb_add(&bar[XB_TOPGEN], 1u);
            else XB_SPIN(xb_ld(&bar[XB_TOPGEN]) == tg, bar);
            __builtin_amdgcn_fence(__ATOMIC_ACQUIRE, "agent");
            xb_add(&bar[XB_XGEN(b.x)], 1u);
            asm volatile("s_waitcnt vmcnt(0)" ::: "memory");
        } else {
            XB_SPIN(xb_ld(&bar[XB_XGEN(b.x)]) == gen, bar);
            __builtin_amdgcn_fence(__ATOMIC_ACQUIRE, "agent");
            asm volatile("s_waitcnt vmcnt(0)" ::: "memory");
        }
    }
    __syncthreads();
}

DI void transpose_item(const float* W, int ldw, bf16* WT, int ldt, LAS float* scr, int lane) {
    { const int kr = lane >> 3, c4 = (lane & 7) * 4; f32x4 v[8];
#pragma unroll
        for (int i = 0; i < 8; ++i) v[i] = *(const f32x4*)(W + (size_t)(8 * i + kr) * ldw + c4);
#pragma unroll
        for (int i = 0; i < 8; ++i) { LAS float* o = scr + (8 * i + kr) * 33 + c4; o[0] = v[i].x; o[1] = v[i].y; o[2] = v[i].z; o[3] = v[i].w; } }
    LDS_WAIT(); asm volatile("" ::: "memory");
    const int c = lane & 7;
#pragma unroll
    for (int j = 0; j < 4; ++j) { const int n = (lane >> 3) + 8 * j; const LAS float* s = scr + (8 * c) * 33 + n;
        u32x4 o; o.x = pk2(s[0 * 33], s[1 * 33]); o.y = pk2(s[2 * 33], s[3 * 33]); o.z = pk2(s[4 * 33], s[5 * 33]); o.w = pk2(s[6 * 33], s[7 * 33]);
        *(u32x4*)(WT + (size_t)n * ldt + 8 * c) = o; }
    LDS_WAIT(); asm volatile("" ::: "memory");
}
DI void transpose_item_f8(const float* W, int ldw, unsigned char* WT, int ldt, float scale, LAS float* scr, int lane) {
    { const int kr = lane >> 3, c4 = (lane & 7) * 4; f32x4 v[8];
#pragma unroll
        for (int i = 0; i < 8; ++i) v[i] = *(const f32x4*)(W + (size_t)(8 * i + kr) * ldw + c4);
#pragma unroll
        for (int i = 0; i < 8; ++i) { LAS float* o = scr + (8 * i + kr) * 33 + c4; o[0] = v[i].x; o[1] = v[i].y; o[2] = v[i].z; o[3] = v[i].w; } }
    LDS_WAIT(); asm volatile("" ::: "memory");
    const int c = lane & 3;
#pragma unroll
    for (int j = 0; j < 2; ++j) { const int n = (lane >> 2) + 16 * j; const LAS float* s = scr + (16 * c) * 33 + n;
        u32x4 o; o.x = pk4_f8(s[0 * 33] * scale, s[1 * 33] * scale, s[2 * 33] * scale, s[3 * 33] * scale); o.y = pk4_f8(s[4 * 33] * scale, s[5 * 33] * scale, s[6 * 33] * scale, s[7 * 33] * scale);
        o.z = pk4_f8(s[8 * 33] * scale, s[9 * 33] * scale, s[10 * 33] * scale, s[11 * 33] * scale); o.w = pk4_f8(s[12 * 33] * scale, s[13 * 33] * scale, s[14 * 33] * scale, s[15 * 33] * scale);
        *(u32x4*)(WT + (size_t)n * ldt + 16 * c) = o; }
    LDS_WAIT(); asm volatile("" ::: "memory");
}
DI void ln16(f32x4 (&v)[4], const f32x4 (&g)[4], const f32x4 (&b)[4]) {
    float s = 0.f;
#pragma unroll
    for (int j = 0; j < 4; ++j) s += (v[j].x + v[j].y) + (v[j].z + v[j].w);
    const float mean = wave_sum(s) * (1.f / D); float s2 = 0.f;
#pragma unroll
    for (int j = 0; j < 4; ++j) { v[j] = v[j] - mean; s2 += (v[j].x * v[j].x + v[j].y * v[j].y) + (v[j].z * v[j].z + v[j].w * v[j].w); }
    const float rstd = 1.f / sqrtf(wave_sum(s2) * (1.f / D) + LN_EPS);
#pragma unroll
    for (int j = 0; j < 4; ++j) v[j] = v[j] * rstd * g[j] + b[j];
}
DI void gates8(const f32x4 (&y)[4], const LAS float* wgt, float* gif_row, int lane) {
    float p[8];
#pragma unroll
    for (int j = 0; j < 8; ++j) { float s = 0.f;
#pragma unroll
        for (int jj = 0; jj < 4; ++jj) { const f32x4 w = *(const LAS f32x4*)(wgt + j * 1024 + 256 * jj + 4 * lane); s += (y[jj].x * w.x + y[jj].y * w.y) + (y[jj].z * w.z + y[jj].w * w.w); }
        p[j] = wave_sum(s); }
    if (lane == 0) { *(f32x4*)gif_row = (f32x4){p[0], p[1], p[2], p[3]}; *(f32x4*)(gif_row + 4) = (f32x4){p[4], p[5], p[6], p[7]}; }
}
DI void gates8b(const f32x4 (&y)[4], const LAS float* wgt, float* gif_row, int lane) {
    float p[8];
#pragma unroll
    for (int j = 0; j < 8; ++j) { float s = 0.f;
#pragma unroll
        for (int jj = 0; jj < 4; ++jj) { const f32x4 w = *(const LAS f32x4*)(wgt + j * 1024 + (jj >> 1) * 512 + 8 * lane + (jj & 1) * 4); s += (y[jj].x * w.x + y[jj].y * w.y) + (y[jj].z * w.z + y[jj].w * w.w); }
        p[j] = wave_sum(s); }
    if (lane == 0) { *(f32x4*)gif_row = (f32x4){p[0], p[1], p[2], p[3]}; *(f32x4*)(gif_row + 4) = (f32x4){p[4], p[5], p[6], p[7]}; }
}
DI void load_gate_table(LAS float* wgt, const float* win_l, int tid) {
    for (int i = tid; i < 8192; i += NTHR) { const int k = i >> 3, j = i & 7; wgt[j * 1024 + k] = win_l[(size_t)k * DIN + 1536 + j]; }
}
DI f32x4 ld4bf(const char* p) { const u32x2 w = *(const u32x2*)p; return (f32x4){bflo(w.x), bfhi(w.x), bflo(w.y), bfhi(w.y)}; }
DI void st4bf(char* p, const f32x4& v) { u32x2 w; w.x = pk2(v.x, v.y); w.y = pk2(v.z, v.w); *(u32x2*)p = w; }

struct Args { const float* in[N_IN]; float* out; unsigned char* ws; int ph_lo, ph_hi; };
constexpr int NP_LAYER = 12, NPH = 1 + DEPTH * NP_LAYER;
constexpr int XW_SPLIT = 49152;

struct SchedInproj {
    pg8::TileOrder T; int G, c; const char *X, *W; char* U; bool kv; const char *MEMN, *WKV; char* KV;
    DI bool next(int i, pg8::Unit& u) const {
        const long L = (long)i * G + c; int pm, pn;
        if (T.tile(L, pm, pn)) { u.a = X + (size_t)pm * 256 * D * 2; u.b = W + (size_t)pn * 256 * D * 2; u.r0 = pm * 256; u.c0 = pn * 256; u.c = U + ((size_t)u.r0 * NU + u.c0) * 2; u.ldc = NU; u.e = 0; u.sub = 0; return true; }
        if (!kv) return false;
        const long L2 = L - T.nwg; if (L2 < 0 || L2 >= 128) return false;
        const int l = (int)L2 >> 6, t = (int)L2 & 63; pm = t >> 2; pn = t & 3;
        u.a = MEMN + (size_t)pm * 256 * D * 2; u.b = WKV + ((size_t)l * 1024 + pn * 256) * D * 2; u.r0 = pm * 256; u.c0 = pn * 256; u.c = KV + (((size_t)l * MROWS + u.r0) * D + u.c0) * 2; u.ldc = D; u.e = 0; u.sub = 0; return true;
    }
};
struct SchedPlain {
    pg8::TileOrder T; int G, c; const char *A, *B; char* C; int lda, ldb, ldc;
    DI bool next(int i, pg8::Unit& u) const {
        const long L = (long)i * G + c; int pm, pn; if (!T.tile(L, pm, pn)) return false;
        u.a = A + (size_t)pm * 256 * lda * 2; u.b = B + (size_t)pn * 256 * ldb * 2; u.r0 = pm * 256; u.c0 = pn * 256; u.c = C + ((size_t)u.r0 * ldc + u.c0) * 2; u.ldc = ldc; u.e = 0; u.sub = 0; return true;
    }
};
struct SchedMerge {
    pg8::TileOrder T; int G, c; const char *H, *W; char* Y;
    DI bool next(int i, pg8::Unit& u) const {
        const int ti = i / 3, br = i - 3 * ti; const long L = (long)ti * G + c; int pm, pn; if (!T.tile(L, pm, pn)) return false;
        u.a = H + ((size_t)pm * 256 * 1536 + br * 512) * 2; u.b = W + ((size_t)br * 1024 + pn * 256) * 512 * 2; u.r0 = pm * 256; u.c0 = pn * 256; u.c = Y + ((size_t)u.r0 * D + u.c0) * 2; u.ldc = D; u.e = 0; u.sub = br; return true;
    }
};
struct SchedMoe {
    pg8::TileOrder T; int G, c; const char *A, *W; char* C; const LAS int* PB; int wrows  , ldc, cdiv, osz;
    DI bool next(int i, pg8::Unit& u) const {
        const long L = (long)i * G + c; int pm, pn; if (!T.tile(L, pm, pn)) return false;
        int e = 0;
#pragma unroll 1
        for (int j = 1; j < NEXP; ++j) e += (PB[j] <= pm) ? 1 : 0;
        u.a = A + (size_t)pm * 256 * 1024; u.b = W + ((size_t)e * wrows + pn * 256) * 1024; u.r0 = pm * 256; u.c0 = pn * 256; u.c = C + ((size_t)u.r0 * ldc + u.c0 / cdiv) * osz; u.ldc = ldc; u.e = e; u.sub = 0; return true;
    }
};

__global__ void __launch_bounds__(NTHR, 2) fwd_kernel(Args args) {
    extern __shared__ __attribute__((aligned(16))) unsigned char lds_raw[];
#define INP(i) ([&]() -> const float* { int ii_ = (i); asm volatile("" : "+s"(ii_)); return args.in[ii_]; }())
    LAS unsigned char* lds = (LAS unsigned char*)lds_raw;
    volatile LAS unsigned* LCTL = (volatile LAS unsigned*)(lds + LDSCTL_OFF);
    const int tid0 = threadIdx.x, wave = __builtin_amdgcn_readfirstlane(tid0 >> 6);
#define PHASE_TID unsigned z_ = 0u; asm volatile("" : "+v"(z_)); int tid = wave * 64 + (int)__builtin_amdgcn_mbcnt_hi(~0u, __builtin_amdgcn_mbcnt_lo(~0u, z_)); const int lane = tid & 63; (void)lane;
    const int G = gridDim.x, bx = blockIdx.x;
    const int gw = bx * NWAVES + wave, NGW = G * NWAVES;
    unsigned char* ws = args.ws;
    gu32* ctl = (gu32*)(ws + WS_CTL);
    for (int u = tid0; u < (LDS_BYTES - LDSCTL_OFF) / 4; u += NTHR) ((LAS unsigned*)(lds + LDSCTL_OFF))[u] = 0u;
    __syncthreads();
    XcdBarrier bar; bar.bar = (unsigned*)ctl + CW_BAR; bar.x = 0; bar.st = nullptr;
    if (MK_ONE_LAUNCH) bar = xcd_barrier_post((unsigned*)ctl + CW_BAR, LCTL);
    const int lo = args.ph_lo, hi = args.ph_hi;
#ifndef SUBMASK
#define SUBMASK 7
#endif
#ifndef LN2PROBE
#define LN2PROBE 0
#endif
#ifndef SUBDUP
#define SUBDUP 0
#endif
#define NSUB(k) ((((SUBDUP) >> (k)) & 1) ? 2 : 1)
#ifndef DUPMASK
#define DUPMASK 0
#endif
#define NREP(k) ((((DUPMASK) >> (k)) & 1) ? 2 : 1)
#ifndef PHMASK
#define PHMASK 0xFFFF
#endif
#define IN(k) (lo <= (k) && (k) < hi)
#define SEAM(k) do { if (IN(k) && IN((k) + 1)) xcd_barrier(bar); } while (0)

    char* const Xb = (char*)(ws + WS_X);
    char* const Ub = (char*)(ws + WS_R1);
    float* const GIF = (float*)(ws + WS_GIF);
    LAS int* const PB = (LAS int*)(lds + LDSCTL_OFF + 64);
    LAS int* const CNT = (LAS int*)(lds + LDSCTL_OFF + 256);

    _Pragma("unroll 1") for (int rep_ = 0; rep_ < NREP(12); ++rep_) if (((PHMASK>>12)&1) && IN(0)) { PHASE_TID
        LAS float* scr = (LAS float*)(lds + wave * 8448);
        LAS float* wgt = (LAS float*)(lds + 73728);
        load_gate_table(wgt, INP(I_WIN), tid);
        constexpr int IT_IN = 16 * 216, IT_KV = 16 * 32, IT_BR = 8 * 32, IT_O = 16 * 32, IT_L = IT_IN + IT_KV + 3 * IT_BR + IT_O;
        for (int it = gw; it < DEPTH * IT_L; it += NGW) {
            const int l = it / IT_L; int r = it - l * IT_L;
            if (r < IT_IN) { const int kb = r / 216, nb = r % 216, n0 = 32 * nb, sc = ucol_src(n0);
                if (n0 < UC_F8) transpose_item(INP(I_WIN) + ((size_t)l * D + 64 * kb) * DIN + sc, DIN, (bf16*)(ws + WS_WIN) + ((size_t)l * NU + n0) * D + 64 * kb, D, scr, lane);
                else transpose_item_f8(INP(I_WIN) + ((size_t)l * D + 64 * kb) * DIN + sc, DIN, (unsigned char*)(ws + WS_WING8) + ((size_t)l * NF8 + (n0 - UC_F8)) * D + 64 * kb, D, F8_SWGU, scr, lane);
                continue; }
            r -= IT_IN;
            if (r < IT_KV) { const int kb = r / 32, nb = r % 32;
                transpose_item(INP(I_CAWKV) + ((size_t)l * D + 64 * kb) * 1024 + 32 * nb, 1024, (bf16*)(ws + WS_WKV) + ((size_t)l * 1024 + 32 * nb) * D + 64 * kb, D, scr, lane); continue; }
            r -= IT_KV;
            if (r < 3 * IT_BR) { const int br = r / IT_BR, q = r % IT_BR, kb = q / 32, nb = q % 32;
                const float* src = INP(br == 0 ? I_WBRML : (br == 1 ? I_WBRRW : I_WBRCA));
                transpose_item(src + ((size_t)l * 512 + 64 * kb) * 1024 + 32 * nb, 1024, (bf16*)(ws + WS_WBR) + ((size_t)l * 1024 + 32 * nb) * 1536 + br * 512 + 64 * kb, 1536, scr, lane); continue; }
            r -= 3 * IT_BR;
            { const int kb = r / 32, nb = r % 32;
                transpose_item(INP(I_WO) + ((size_t)l * D + 64 * kb) * 1024 + 32 * nb, 1024, (bf16*)(ws + WS_WO) + ((size_t)l * 1024 + 32 * nb) * D + 64 * kb, D, scr, lane); }
        }
        for (int i = bx * NTHR + tid; i < DEPTH * 1536 * 256; i += G * NTHR) {
            const int l = i / (1536 * 256), r = i % (1536 * 256), n = r >> 8, k = r & 255; float v = 0.f;
            if (n < 512) { if (k < 64) v = INP(I_RWWUP)[((size_t)l * 64 + k) * 512 + n]; }
            else if (n < 1024) { if (k >= 64 && k < 128) v = INP(I_RWAUP)[((size_t)l * 64 + (k - 64)) * 512 + (n - 512)]; }
            else { if (k >= 128) v = INP(I_RWGUP)[((size_t)l * 128 + (k - 128)) * 512 + (n - 1024)]; }
            ((bf16*)(ws + WS_WLORA))[i] = (bf16)f2bf(v);
        }
        __syncthreads();
        {
            f32x4 g[4], b[4];
#pragma unroll
            for (int j = 0; j < 4; ++j) { g[j] = *(const f32x4*)(INP(I_LNIN_G) + 256 * j + 4 * lane); b[j] = *(const f32x4*)(INP(I_LNIN_B) + 256 * j + 4 * lane); }
            for (int m = gw; m < M; m += NGW) {
                f32x4 v[4]; const float* xr = INP(I_X) + (size_t)m * D;
#pragma unroll
                for (int j = 0; j < 4; ++j) v[j] = *(const f32x4*)(xr + 256 * j + 4 * lane);
                ln16(v, g, b);
#pragma unroll
                for (int j = 0; j < 4; ++j) { st4bf(Xb + ((size_t)m * D + 256 * j + 4 * lane) * 2, v[j]); *(unsigned*)((char*)(ws + WS_XF8) + (size_t)m * D + 256 * j + 4 * lane) = pk4_f8(v[j].x * F8_SX, v[j].y * F8_SX, v[j].z * F8_SX, v[j].w * F8_SX); }
                gates8(v, wgt, GIF + (size_t)m * 8, lane);
            }
#pragma unroll
            for (int j = 0; j < 4; ++j) { g[j] = *(const f32x4*)(INP(I_MEMLN_G) + 256 * j + 4 * lane); b[j] = *(const f32x4*)(INP(I_MEMLN_B) + 256 * j + 4 * lane); }
            for (int m = gw; m < MROWS; m += NGW) {
                f32x4 v[4]; const float* xr = INP(I_MEM) + (size_t)m * D;
#pragma unroll
                for (int j = 0; j < 4; ++j) v[j] = *(const f32x4*)(xr + 256 * j + 4 * lane);
                ln16(v, g, b);
#pragma unroll
                for (int j = 0; j < 4; ++j) st4bf((char*)(ws + WS_MEMN) + ((size_t)m * D + 256 * j + 4 * lane) * 2, v[j]);
            }
        }
        __syncthreads();
    }
    SEAM(0);

#pragma unroll 1
    for (int l = 0; l < DEPTH; ++l) {
        const int pb = 1 + l * NP_LAYER;
        _Pragma("unroll 1") for (int rep_ = 0; rep_ < NREP(0); ++rep_) if (((PHMASK>>0)&1) && IN(pb + 0)) {
            SchedInproj S; S.T.init(M / 256, UC_F8 / 256); S.G = G; S.c = bx; S.X = Xb; S.W = (const char*)(ws + WS_WIN) + (size_t)l * NU * D * 2; S.U = Ub;
            S.kv = (l == 0); S.MEMN = (const char*)(ws + WS_MEMN); S.WKV = (const char*)(ws + WS_WKV); S.KV = (char*)(ws + WS_KV);
            pg8::EpiStore E;
            pg8::gemm_phase<false>(lds, D * 2, D * 2, D * 2, S, E, wave);
            SchedPlain S8; S8.T.init(M / 256, NF8 / 256); S8.G = G; S8.c = bx; S8.A = (const char*)(ws + WS_XF8); S8.B = (const char*)(ws + WS_WING8) + (size_t)l * NF8 * D; S8.C = Ub + UC_F8 * 2;
            S8.lda = 512; S8.ldb = 512; S8.ldc = NU;
            pg8::EpiStoreS E8; E8.s = F8_INV1; E8.gate_b = INP(I_GATEB) + (size_t)l * 3072; E8.gate_c0 = UC_GATE - UC_F8;
            pg8::gemm_phase<true>(lds, D, D, D, S8, E8, wave);
        }
        SEAM(pb + 0);
        _Pragma("unroll 1") for (int rep_ = 0; rep_ < NREP(1); ++rep_) if (((PHMASK>>1)&1) && IN(pb + 1)) { PHASE_TID
            const float* mu = INP(I_RWMU) + (size_t)l * 1792 + 1536;
            char* LIN = (char*)(ws + WS_R2 + R2_LORA_IN);
            for (int it = bx * NTHR + tid; it < M * 32; it += G * NTHR) {
                const int row = it >> 5, c = (it & 31) * 8;
                const u32x4 cw = *(const u32x4*)(Ub + ((size_t)row * NU + UC_RW + 1536 + c) * 2);
                u32x4 pw = (u32x4){0u, 0u, 0u, 0u};
                if ((row & (SEQ - 1)) != 0) pw = *(const u32x4*)(Ub + ((size_t)(row - 1) * NU + UC_RW + 1536 + c) * 2);
                const f32x4 m0 = *(const f32x4*)(mu + c), m1 = *(const f32x4*)(mu + c + 4);
                float x[8] = {bflo(cw.x), bfhi(cw.x), bflo(cw.y), bfhi(cw.y), bflo(cw.z), bfhi(cw.z), bflo(cw.w), bfhi(cw.w)};
                const float p[8] = {bflo(pw.x), bfhi(pw.x), bflo(pw.y), bfhi(pw.y), bflo(pw.z), bfhi(pw.z), bflo(pw.w), bfhi(pw.w)};
                const float mm[8] = {m0.x, m0.y, m0.z, m0.w, m1.x, m1.y, m1.z, m1.w};
#pragma unroll
                for (int i = 0; i < 8; ++i) { float xs = x[i] + (p[i] - x[i]) * mm[i];
                    if (c < 64) xs = 1.f - 2.f * __builtin_amdgcn_rcpf(1.f + __builtin_amdgcn_exp2f(2.8853900817779268f * xs));
                    else if (c >= 128) xs = sigmoidf_(xs);
                    x[i] = xs; }
                u32x4 o; o.x = pk2(x[0], x[1]); o.y = pk2(x[2], x[3]); o.z = pk2(x[4], x[5]); o.w = pk2(x[6], x[7]);
                *(u32x4*)(LIN + ((size_t)row * 256 + c) * 2) = o;
            }
        }
        SEAM(pb + 1);
        _Pragma("unroll 1") for (int rep_ = 0; rep_ < NREP(2); ++rep_) if (((PHMASK>>2)&1) && IN(pb + 2)) {
            SchedPlain S; S.T.init(M / 256, 6); S.G = G; S.c = bx; S.A = (const char*)(ws + WS_R2 + R2_LORA_IN); S.B = (const char*)(ws + WS_WLORA) + (size_t)l * 1536 * 256 * 2; S.C = (char*)(ws + WS_R2 + R2_LORA_OUT);
            S.lda = 256; S.ldb = 256; S.ldc = 1536;
            pg8::EpiStore E;
            pg8::gemm_phase<false>(lds, 512, 512, 512, S, E, wave);
        }
        SEAM(pb + 2);
        _Pragma("unroll 1") for (int rep_ = 0; rep_ < NREP(3); ++rep_) if (((PHMASK>>3)&1) && IN(pb + 3)) { PHASE_TID
            const char* LO = (const char*)(ws + WS_R2 + R2_LORA_OUT);
            char* HC = (char*)(ws + WS_R2 + R2_HCAT);
            const int tid_ph = tid;
#define SUB_TID unsigned zs_ = 0u; asm volatile("" : "+v"(zs_)); int tid = wave * 64 + (int)__builtin_amdgcn_mbcnt_hi(~0u, __builtin_amdgcn_mbcnt_lo(~0u, zs_)); const int lane = tid & 63; (void)lane;
#pragma unroll 1
            for (int job = bx; job < 256; job += G) {
                if (job < 128) { _Pragma("unroll 1") for (int sr_ = 0; sr_ < NSUB(0); ++sr_) if ((SUBMASK>>0)&1) {
                    SUB_TID
                    const int b = job >> 3, h = job & 7;
                    constexpr int TC = 32, PT = 144, P16 = 48, IMG = 25856;
                    LAS float* OPS = (LAS float*)lds;
                    LAS float* OUTB = OPS + TC * 384;
                    LAS float* BON = OUTB + TC * 64;
                    LAS unsigned char* IM0 = lds + 57600;
                    LAS float* VEP = (LAS float*)(lds + 109312);
                    LAS unsigned char* GKB = (LAS unsigned char*)(VEP + 2 * TC * 64);
                    LAS float* PARF = (LAS float*)(lds + 142080);
                    const int pt = tid >> 4, cs = tid & 15, pc = cs * 4, hc = h * 64 + pc;
                    const int p1t = (tid >> 3) & 31, c8 = (tid & 7) * 8, hc8 = h * 64 + c8;
                    const int r31 = lane & 31, h2 = lane >> 5;
                    f32x16 Sreg[2];
#pragma unroll
                    for (int i = 0; i < 16; ++i) { Sreg[0][i] = 0.f; Sreg[1][i] = 0.f; }
#pragma unroll 1
                    for (int a = wave; a < 10; a += 8) {
                        const int ii = (a < 3) ? I_RWMU : (a == 3) ? I_RWW0 : (a == 4) ? I_RWA0 : (a == 5) ? I_RWKK : (a == 6) ? I_RWKA : (a == 7) ? I_RWRK : (a == 8) ? I_RWLNG : I_RWLNB;
                        const size_t po = (a < 3) ? ((size_t)l * 1792 + a * 512) : (size_t)l * 512;
                        PARF[a * 64 + lane] = (INP(ii) + po)[h * 64 + lane];
                    }
#define SETPU(j, q_) do { const u32x4 q__ = (q_); Sreg[(j) >> 2][((j) & 3) * 4] = u2f_(q__.x); Sreg[(j) >> 2][((j) & 3) * 4 + 1] = u2f_(q__.y); \
                          Sreg[(j) >> 2][((j) & 3) * 4 + 2] = u2f_(q__.z); Sreg[(j) >> 2][((j) & 3) * 4 + 3] = u2f_(q__.w); } while (0)
#define PUW(j, c) f2u_(Pc[(j) >> 2][((j) & 3) * 4 + (c)])
#define PUWS(j, c) f2u_(Sreg[(j) >> 2][((j) & 3) * 4 + (c)])
#define UNPJ(j, hh) ((f32x4){bflo(PUW(j, 2 * (hh))), bfhi(PUW(j, 2 * (hh))), bflo(PUW(j, 2 * (hh) + 1)), bfhi(PUW(j, 2 * (hh) + 1))})
#define UNPH(q_, hh) ((hh) ? (f32x4){bflo((q_).z), bfhi((q_).z), bflo((q_).w), bfhi((q_).w)} : (f32x4){bflo((q_).x), bfhi((q_).x), bflo((q_).y), bfhi((q_).y)})
                    auto LOADC = [&](int t0) {
                        const int t = t0 + p1t; const size_t row = (size_t)b * SEQ + t; const char* up = Ub + (row * NU + UC_RW + hc8) * 2;
                        SETPU(0, *(const u32x4*)up); SETPU(1, *(const u32x4*)(up + 1024)); SETPU(2, *(const u32x4*)(up + 2048));
                        if (t > 0) { const char* pp = up - (size_t)NU * 2; SETPU(3, *(const u32x4*)pp); SETPU(4, *(const u32x4*)(pp + 1024)); SETPU(5, *(const u32x4*)(pp + 2048)); }
                        else { const u32x4 z4 = (u32x4){0u, 0u, 0u, 0u}; SETPU(3, z4); SETPU(4, z4); SETPU(5, z4); }
                        const char* lp = LO + (row * 1536 + hc8) * 2; SETPU(6, *(const u32x4*)lp); SETPU(7, *(const u32x4*)(lp + 1024));
                    };
                    const int gq = tid - 128, gt = (gq >> 2) & 31, gp = (gq & 3) * 16;
                    auto LOADG = [&](int t0) {
                        const char* gp_ = LO + (((size_t)b * SEQ + t0 + gt) * 1536 + 1024 + h * 64 + gp) * 2;
                        SETPU(0, *(const u32x4*)gp_); SETPU(1, *(const u32x4*)(gp_ + 16));
                    };
                    auto PASS1 = [&](int t1, int par1, bool more) {
                        int hcv = hc8; asm volatile("" : "+v"(hcv));
                        const f32x16 Pc[2] = {Sreg[0], Sreg[1]};
                        if (more) LOADC(t1 + TC);
                        const LAS float* MU = PARF + c8;
                        const LAS float* W0 = PARF + 192 + c8; const LAS float* A0 = PARF + 256 + c8; const LAS float* KKW = PARF + 320 + c8;
                        const LAS float* KAW = PARF + 384 + c8; const LAS float* RKW = PARF + 448 + c8;
                        f32x4 dec[2], av[2], kkv[2], kp[2], xr[2], xv[2]; float ss = 0.f, bsum = 0.f;
#pragma unroll
                        for (int hh = 0; hh < 2; ++hh) {
                            const f32x4 mu_r = *(const LAS f32x4*)(MU + 4 * hh), mu_k = *(const LAS f32x4*)(MU + 64 + 4 * hh), mu_v = *(const LAS f32x4*)(MU + 128 + 4 * hh);
                            const f32x4 w0 = *(const LAS f32x4*)(W0 + 4 * hh), a0 = *(const LAS f32x4*)(A0 + 4 * hh), kkw = *(const LAS f32x4*)(KKW + 4 * hh), kaw = *(const LAS f32x4*)(KAW + 4 * hh), rkw = *(const LAS f32x4*)(RKW + 4 * hh);
                            const f32x4 ur = UNPJ(0, hh), uk = UNPJ(1, hh), uv = UNPJ(2, hh), urp = UNPJ(3, hh), ukp = UNPJ(4, hh), uvp = UNPJ(5, hh), lw = UNPJ(6, hh), la = UNPJ(7, hh);
                            xr[hh] = ur + (urp - ur) * mu_r; const f32x4 xk = uk + (ukp - uk) * mu_k; xv[hh] = uv + (uvp - uv) * mu_v;
#pragma unroll
                            for (int i = 0; i < 4; ++i) {
                                const float y = -(w0[i] + lw[i]);
                                const float sp = fmaxf(y, 0.f) + __logf(1.f + __expf(-fabsf(y)));
                                dec[hh][i] = __expf(-__expf(-sp - 0.5f));
                                av[hh][i] = sigmoidf_(a0[i] + la[i]);
                                kkv[hh][i] = xk[i] * kkw[i]; ss += kkv[hh][i] * kkv[hh][i];
                                kp[hh][i] = xk[i] * (1.f + (av[hh][i] - 1.f) * kaw[i]);
                                bsum += xr[hh][i] * kp[hh][i] * rkw[i];
                            }
                            __builtin_amdgcn_sched_barrier(0);
                        }
                        ss = red8(ss); bsum = red8(bsum);
                        const float inv = __builtin_amdgcn_rsqf(fmaxf(ss, 1e-24f));
#pragma unroll
                        for (int hh = 0; hh < 2; ++hh) {
                            const f32x4 kk = kkv[hh] * inv, kka = kk * av[hh];
                            LAS float* o = OPS + p1t * 384 + c8 + 4 * hh;
                            *(LAS f32x4*)(o) = dec[hh]; *(LAS f32x4*)(o + 64) = kk; *(LAS f32x4*)(o + 128) = kka; *(LAS f32x4*)(o + 192) = kp[hh]; *(LAS f32x4*)(o + 256) = xr[hh]; *(LAS f32x4*)(o + 320) = xv[hh];
                            *(LAS f32x4*)(VEP + par1 * 2048 + p1t * 64 + c8 + 4 * hh) = xv[hh];
                        }
                        if ((tid & 7) == 0) BON[par1 * 32 + p1t] = bsum;
                    };
#define UNP4(w) ((f32x4){bflo((w).x), bfhi((w).x), bflo((w).y), bfhi((w).y)})
#define DOT4(a, b) (((a).x * (b).x + (a).y * (b).y) + ((a).z * (b).z + (a).w * (b).w))
#define PACK8(x, s) __builtin_bit_cast(bf16x8, (u32x4){pk2((x)[8 * (s)], (x)[8 * (s) + 1]), pk2((x)[8 * (s) + 2], (x)[8 * (s) + 3]), pk2((x)[8 * (s) + 4], (x)[8 * (s) + 5]), pk2((x)[8 * (s) + 6], (x)[8 * (s) + 7])})
#define LD2x64(p) __builtin_bit_cast(bf16x8, (u32x4){(*(const LAS u32x2*)(p)).x, (*(const LAS u32x2*)(p)).y, (*(const LAS u32x2*)((p) + 16)).x, (*(const LAS u32x2*)((p) + 16)).y})
                    if (wave >= 4) LOADC(0); else if (wave >= 2) LOADG(0);
#pragma unroll 1
                    for (int t0 = -TC; t0 < SEQ; t0 += TC) {
                        const int par = (t0 >> 5) & 1;
                        __syncthreads();
                        if (t0 >= 0)
                        {
                            const int sc = wave >> 2, wq = wave & 3;
                            LAS unsigned char* im = IM0 + sc * IMG;
                            LAS unsigned char* KR = im; LAS unsigned char* BGr = im + 4608; LAS unsigned char* VT = im + 15360;
                            LAS unsigned char* TT = im + 18432; LAS unsigned char* BB = im + 19968; LAS float* ZF = (LAS float*)(im + 21504); LAS float* PL = (LAS float*)(im + 25600);
                            {
                                float P = 1.f;
#pragma unroll 1
                                for (int t = 0; t < 4 * wq; ++t) P *= OPS[(16 * sc + t) * 384 + lane];
#pragma unroll
                                for (int q = 0; q < 4; ++q) { const int t = 4 * wq + q; const LAS float* o = OPS + (16 * sc + t) * 384 + lane;
                                    const float w = o[0], z = o[64], bb = o[128], kp = o[192], rr = o[256], vv = o[320];
                                    const float kap = z * P; P *= w; const float rho = rr * P, ip = __builtin_amdgcn_rcpf(P), bet = bb * ip, gam = kp * ip;
                                    *(LAS bf16*)(KR + t * PT + lane * 2) = (bf16)f2bf(kap); *(LAS bf16*)(KR + (16 + t) * PT + lane * 2) = (bf16)f2bf(rho);
                                    *(LAS bf16*)(BGr + t * PT + lane * 2) = (bf16)f2bf(bet); *(LAS bf16*)(BGr + (16 + t) * PT + lane * 2) = (bf16)f2bf(gam);
                                    *(LAS bf16*)(VT + t * PT + lane * 2) = (bf16)f2bf(vv); }
                                if (wq == 3) PL[lane] = P;
                            }
                            __syncthreads();
                            if (wq == 0) {
                                f32x16 Z;
#pragma unroll
                                for (int i = 0; i < 16; ++i) Z[i] = 0.f;
#pragma unroll
                                for (int ks = 0; ks < 4; ++ks) Z = __builtin_amdgcn_mfma_f32_32x32x16_bf16(*(const LAS bf16x8*)(KR + r31 * PT + (16 * ks + 8 * h2) * 2), *(const LAS bf16x8*)(BGr + r31 * PT + (16 * ks + 8 * h2) * 2), Z, 0, 0, 0);
                                const int cp = (r31 < 16) ? (4 * (r31 & 3) + (r31 >> 2)) : r31;
#pragma unroll
                                for (int i = 0; i < 16; ++i) ZF[((i & 3) + 8 * (i >> 2) + 4 * h2) * 32 + cp] = Z[i];
                            }
                            __syncthreads();
                            if (wq == 0) {
                                const int c = lane >> 2, jq = lane & 3; float tq[4] = {0.f, 0.f, 0.f, 0.f};
                                f32x4 an = *(const LAS f32x4*)(ZF + 1 * 32 + 4 * jq);
#pragma unroll
                                for (int t = 0; t < 16; ++t) {
                                    const f32x4 ar = an; if (t >= 1 && t < 15) an = *(const LAS f32x4*)(ZF + (t + 1) * 32 + 4 * jq);
                                    float s = 0.f;
#pragma unroll
                                    for (int m = 0; m < 4; ++m) if (4 * m < t) s += ((4 * m + jq < t) ? ar[m] : 0.f) * tq[m];
                                    s = red4(s);
                                    const float val = ((t == c) ? 1.f : 0.f) - s;
                                    tq[t >> 2] = (jq == (t & 3)) ? val : tq[t >> 2];
                                }
#pragma unroll
                                for (int m = 0; m < 4; ++m) *(LAS bf16*)(TT + (4 * m + jq) * P16 + c * 2) = (bf16)f2bf(-tq[m]);
                                an = *(const LAS f32x4*)(ZF + 16 * 32 + 4 * jq);
#pragma unroll
                                for (int t = 0; t < 16; ++t) {
                                    const f32x4 ar = an; if (t < 15) an = *(const LAS f32x4*)(ZF + (17 + t) * 32 + 4 * jq);
                                    float s = 0.f;
#pragma unroll
                                    for (int m = 0; m < 4; ++m) if (4 * m <= t) s += ((4 * m + jq <= t) ? ar[m] : 0.f) * tq[m];
                                    s = red4(s);
                                    if (jq == 0) *(LAS bf16*)(TT + (16 + t) * P16 + c * 2) = (bf16)f2bf(-s);
                                }
                            } else if (wq == 1) {
                                const int row = lane >> 1, c0 = 8 * (lane & 1), tt = row & 15; const bool rho_row = row >= 16; float bv[8];
#pragma unroll
                                for (int j = 0; j < 8; ++j) { const int jj = c0 + j; const float zv = ZF[row * 32 + 16 + jj]; bv[j] = (rho_row ? (jj <= tt) : (jj < tt)) ? zv : 0.f; }
                                *(LAS u32x4*)(BB + row * P16 + c0 * 2) = (u32x4){pk2(bv[0], bv[1]), pk2(bv[2], bv[3]), pk2(bv[4], bv[5]), pk2(bv[6], bv[7])};
                            }
                        }
                        __syncthreads();
                        if (wave >= 4) { if (t0 + TC < SEQ) PASS1(t0 + TC, par ^ 1, t0 + 2 * TC < SEQ); }
                        else if (wave >= 2) { if (t0 + TC < SEQ) {
                            LAS unsigned char* gd = GKB + (par ^ 1) * 4096 + gt * 128 + gp * 2;
                            *(LAS u32x4*)gd = (u32x4){PUWS(0, 0), PUWS(0, 1), PUWS(0, 2), PUWS(0, 3)}; *(LAS u32x4*)(gd + 16) = (u32x4){PUWS(1, 0), PUWS(1, 1), PUWS(1, 2), PUWS(1, 3)};
                            if (t0 + 2 * TC < SEQ) LOADG(t0 + 2 * TC); } }
                        else if (wave < 2 && t0 >= 0) {
#pragma unroll 1
                            for (int sc = 0; sc < 2; ++sc) {
                                const LAS unsigned char* im = IM0 + sc * IMG;
                                const LAS unsigned char* KR = im; const LAS unsigned char* BT = im + 9216; const LAS unsigned char* GT = im + 12288; const LAS unsigned char* VT = im + 15360;
                                const LAS unsigned char* TT = im + 18432; const LAS unsigned char* BB = im + 19968; const LAS float* PL = (const LAS float*)(im + 25600);
                                const LAS unsigned char* BGr = im + 4608;
                                const bf16x8 vfr = trd8(VT, PT, 8 * h2, 8 * h2 + 4, 32 * wave, lane);
                                f32x16 t1;
#pragma unroll
                                for (int i = 0; i < 16; ++i) t1[i] = 0.f;
                                t1 = __builtin_amdgcn_mfma_f32_32x32x16_bf16(*(const LAS bf16x8*)(BB + r31 * P16 + 8 * h2 * 2), vfr, t1, 0, 0, 0);
#pragma unroll
                                for (int kb = 0; kb < 2; ++kb)
#pragma unroll
                                    for (int s = 0; s < 2; ++s) t1 = __builtin_amdgcn_mfma_f32_32x32x16_bf16(LD2x64(KR + r31 * PT + (32 * kb + 16 * s + 4 * h2) * 2), PACK8(Sreg[kb], s), t1, 0, 0, 0);
                                f32x16 t2;
#pragma unroll
                                for (int i = 0; i < 16; ++i) t2[i] = 0.f;
                                t2 = __builtin_amdgcn_mfma_f32_32x32x16_bf16(LD2x64(TT + r31 * P16 + (4 * h2) * 2), PACK8(t1, 0), t2, 0, 0, 0);
#pragma unroll
                                for (int i = 8; i < 16; ++i) OUTB[(16 * sc + (i & 3) + 8 * ((i >> 2) - 2) + 4 * h2) * 64 + 32 * wave + r31] = t2[i] + t1[i];
                                const bf16x8 uq = PACK8(t2, 0);
#pragma unroll
                                for (int kb = 0; kb < 2; ++kb) {
                                    f32x16 a = Sreg[kb];
                                    a = __builtin_amdgcn_mfma_f32_32x32x16_bf16(trd8(BGr, PT, 4 * h2, 8 + 4 * h2, 32 * kb, lane), uq, a, 0, 0, 0);
                                    a = __builtin_amdgcn_mfma_f32_32x32x16_bf16(trd8(BGr, PT, 16 + 8 * h2, 20 + 8 * h2, 32 * kb, lane), vfr, a, 0, 0, 0);
#pragma unroll
                                    for (int g4 = 0; g4 < 4; ++g4) { const f32x4 p4 = *(const LAS f32x4*)(PL + 32 * kb + 8 * g4 + 4 * h2);
                                        a[4 * g4] *= p4.x; a[4 * g4 + 1] *= p4.y; a[4 * g4 + 2] *= p4.z; a[4 * g4 + 3] *= p4.w; }
                                    Sreg[kb] = a;
                                }
                            }
                        }
                        __syncthreads();
                        if (t0 >= 0) {
                            const f32x4 lng = *(const LAS f32x4*)(PARF + 512 + pc), lnb = *(const LAS f32x4*)(PARF + 576 + pc);
                            const u32x2 gkw = *(const LAS u32x2*)(GKB + par * 4096 + pt * 128 + pc * 2);
                            const f32x4 o4 = *(const LAS f32x4*)(OUTB + pt * 64 + pc), v4 = *(const LAS f32x4*)(VEP + par * 2048 + pt * 64 + pc), gk = UNP4(gkw);
                            const float mean = red16((o4.x + o4.y) + (o4.z + o4.w)) * (1.f / 64.f);
                            const f32x4 dv = o4 - mean;
                            const float var = red16(DOT4(dv, dv)) * (1.f / 64.f);
                            const float rstd = __builtin_amdgcn_rsqf(var + RW_GN_EPS), bo = BON[par * 32 + pt];
                            const f32x4 y = (dv * rstd * lng + lnb + v4 * bo) * gk;
                            st4bf(HC + (((size_t)b * SEQ + t0 + pt) * 1536 + 512 + hc) * 2, y);
                        }
                    }
                    __syncthreads();
#undef UNPH
#undef UNPJ
#undef PUW
#undef PUWS
#undef SETPU
#undef PACK8
#undef LD2x64
                } } else {
                    const int idx = job - 128, bh = idx >> 1, half = idx & 1, b = bh >> 2, h = bh & 3;
                    unsigned zl_ = 0u; asm volatile("" : "+v"(zl_)); const int lane_ml = (int)__builtin_amdgcn_mbcnt_hi(~0u, __builtin_amdgcn_mbcnt_lo(~0u, zl_));
                    _Pragma("unroll 1") for (int sr_ = 0; sr_ < NSUB(1); ++sr_) if (((SUBMASK>>1)&1) && idx < 64) {
                        SUB_TID
                        const int bm = idx >> 2, hm = idx & 3;
                        constexpr int PT = 144;
                        LAS unsigned char* QI = lds;
                        LAS unsigned char* KI = QI + 64 * PT;
                        constexpr int PV = 272;
                        LAS unsigned char* KW = KI + 64 * PT;
                        LAS unsigned char* VT = KW + 64 * PT;
                        LAS unsigned char* CI = VT + 64 * PV;
                        LAS float* AS = (LAS float*)(CI + 128 * PT);
                        LAS float* MX = AS + 64; LAS float* SI = AS + 128; LAS float* EM = AS + 192; LAS float* WG = AS + 256; LAS float* NN = AS + 320; LAS float* CR = AS + 384; LAS float* ST = AS + 448;
                        for (int i = tid; i < 128 * PT / 4; i += NTHR) ((LAS unsigned*)CI)[i] = 0u;
                        if (tid < 64) NN[tid] = 0.f;
                        const int pt = tid >> 4, cg = tid & 15;
                        const int ccol = (cg < 8) ? (hm * 64 + 8 * cg) : (256 + hm * 64 + 8 * (cg - 8));
                        const float qsc = (cg < 8) ? 0.125f : 1.f;
                        const float igb = INP(I_IGB)[l * 4 + hm], fgb = INP(I_FGB)[l * 4 + hm];
                        const int r31 = lane & 31, h2 = lane >> 5, vb = wave >> 1, tb = wave & 1;
                        f32x16 accC;
#pragma unroll
                        for (int i = 0; i < 16; ++i) accC[i] = 0.f;
                        float nreg = 0.f, mprev = 0.f;
                        u32x4 cu[2][4], vu[2]; float gi = 0.f, gf = 0.f;
                        auto LOADM = [&](int t0) {
#pragma unroll
                            for (int tt = 0; tt < 2; ++tt) { const int t = t0 + pt + 32 * tt; const size_t row = (size_t)bm * SEQ + t;
#pragma unroll
                                for (int j = 0; j < 4; ++j) { if (t - 3 + j >= 0) cu[tt][j] = *(const u32x4*)(Ub + ((row - 3 + j) * NU + UC_QK + ccol) * 2); else cu[tt][j] = (u32x4){0u, 0u, 0u, 0u}; }
                                const int p = tid + 512 * tt; vu[tt] = *(const u32x4*)(Ub + (((size_t)bm * SEQ + t0 + (p >> 4)) * NU + UC_V + hm * 128 + 8 * (p & 15)) * 2); }
                            if (wave == 0) { const size_t rg = (size_t)bm * SEQ + t0 + lane; gi = GIF[rg * 8 + hm]; gf = GIF[rg * 8 + 4 + hm]; }
                        };
                        LOADM(0);
                        __syncthreads();
#pragma unroll 1
                        for (int t0 = 0; t0 < SEQ; t0 += 64) {
                            int ccv = ccol; asm volatile("" : "+v"(ccv));
                            float cw[4][8], cb[8];
#pragma unroll
                        for (int j = 0; j < 4; ++j) { const f32x4 a = *(const f32x4*)(INP(I_CONVW) + ((size_t)l * 4 + j) * 512 + ccv), c2 = *(const f32x4*)(INP(I_CONVW) + ((size_t)l * 4 + j) * 512 + ccv + 4);
                            cw[j][0] = a.x; cw[j][1] = a.y; cw[j][2] = a.z; cw[j][3] = a.w; cw[j][4] = c2.x; cw[j][5] = c2.y; cw[j][6] = c2.z; cw[j][7] = c2.w; }
                        { const f32x4 a = *(const f32x4*)(INP(I_CONVB) + l * 512 + ccv), c2 = *(const f32x4*)(INP(I_CONVB) + l * 512 + ccv + 4);
                            cb[0] = a.x; cb[1] = a.y; cb[2] = a.z; cb[3] = a.w; cb[4] = c2.x; cb[5] = c2.y; cb[6] = c2.z; cb[7] = c2.w; }
                            float yq[2][8];
#pragma unroll
                            for (int tt = 0; tt < 2; ++tt) {
#pragma unroll
                                for (int i = 0; i < 8; ++i) yq[tt][i] = cb[i];
#pragma unroll
                                for (int j = 0; j < 4; ++j) { const u32x4 w = cu[tt][j]; const float x[8] = {bflo(w.x), bfhi(w.x), bflo(w.y), bfhi(w.y), bflo(w.z), bfhi(w.z), bflo(w.w), bfhi(w.w)};
#pragma unroll
                                    for (int i = 0; i < 8; ++i) yq[tt][i] += cw[j][i] * x[i]; }
#pragma unroll
                                for (int i = 0; i < 8; ++i) yq[tt][i] = yq[tt][i] * sigmoidf_(yq[tt][i]) * qsc;
                            }
                            const u32x4 vreg0 = vu[0], vreg1 = vu[1];
                            if (wave == 0) {
                                const float ig = gi + igb, fp = gf + fgb;
                                const float lf = -(fmaxf(-fp, 0.f) + __logf(1.f + __expf(-fabsf(fp))));
                                const float bc = scan_add64(lf);
                                const float as = ig - bc, pm = scan_max64(as);
                                const float mxv = fmaxf(mprev, pm), mx63 = __builtin_bit_cast(float, __builtin_amdgcn_readlane(__builtin_bit_cast(int, mxv), 63)), bl = __builtin_bit_cast(float, __builtin_amdgcn_readlane(__builtin_bit_cast(int, bc), 63));
                                AS[lane] = as; MX[lane] = mxv; SI[lane] = __expf(mprev - mxv); EM[lane] = __expf(-(bc + mxv)); WG[lane] = __expf(as - mx63);
                                if (lane == 0) CR[0] = __expf(mprev - mx63);
                                mprev = bl + mx63;
                            }
                            if (t0 + 64 < SEQ) LOADM(t0 + 64);
                            __syncthreads();
#pragma unroll
                            for (int tt = 0; tt < 2; ++tt) { const int tok = pt + 32 * tt;
                                u32x4 pw; pw.x = pk2(yq[tt][0], yq[tt][1]); pw.y = pk2(yq[tt][2], yq[tt][3]); pw.z = pk2(yq[tt][4], yq[tt][5]); pw.w = pk2(yq[tt][6], yq[tt][7]);
                                if (cg < 8) *(LAS u32x4*)(QI + tok * PT + cg * 16) = pw;
                                else { *(LAS u32x4*)(KI + tok * PT + (cg - 8) * 16) = pw; const float wgs = WG[tok];
                                    u32x4 kw; kw.x = pk2(yq[tt][0] * wgs, yq[tt][1] * wgs); kw.y = pk2(yq[tt][2] * wgs, yq[tt][3] * wgs); kw.z = pk2(yq[tt][4] * wgs, yq[tt][5] * wgs); kw.w = pk2(yq[tt][6] * wgs, yq[tt][7] * wgs);
                                    *(LAS u32x4*)(KW + tok * PT + (cg - 8) * 16) = kw; }
                                const u32x4 vw = tt ? vreg1 : vreg0; const int p = tid + 512 * tt, vtok = p >> 4, v8 = p & 15;
                                *(LAS u32x4*)(VT + vtok * PV + v8 * 16) = vw;
                            }
                            __syncthreads();
                            float hv[16];
                            {
                                constexpr float L2E = 1.4426950408889634f;
                                const int t = 32 * tb + r31;
                                bf16x8 qf[4];
#pragma unroll
                                for (int ks = 0; ks < 4; ++ks) qf[ks] = *(const LAS bf16x8*)(QI + t * PT + (16 * ks + 8 * h2) * 2);
                                const float mx = MX[t], si = SI[t], em = EM[t];
                                f32x16 O, I; float denI = 0.f;
#pragma unroll
                                for (int i = 0; i < 16; ++i) { O[i] = 0.f; I[i] = 0.f; }
#pragma unroll
                                for (int sb = 0; sb < 2; ++sb) if (sb <= tb) {
                                    f32x16 X;
#pragma unroll
                                    for (int i = 0; i < 16; ++i) X[i] = 0.f;
#pragma unroll
                                    for (int ks = 0; ks < 4; ++ks) { const bf16x8 kf = *(const LAS bf16x8*)(KI + (32 * sb + r31) * PT + (16 * ks + 8 * h2) * 2); X = __builtin_amdgcn_mfma_f32_32x32x16_bf16(kf, qf[ks], X, 0, 0, 0); }
#pragma unroll
                                    for (int g4 = 0; g4 < 4; ++g4) { const f32x4 a4 = *(const LAS f32x4*)(AS + 32 * sb + 8 * g4 + 4 * h2);
#pragma unroll
                                        for (int j = 0; j < 4; ++j) { const int s = 32 * sb + 8 * g4 + 4 * h2 + j; const float w = (s <= t) ? __builtin_amdgcn_exp2f((a4[j] - mx) * L2E) * X[4 * g4 + j] : 0.f; X[4 * g4 + j] = w; denI += w; } }
#pragma unroll
                                    for (int st = 0; st < 2; ++st) {
                                        u32x4 pw; pw.x = pk2(X[8 * st], X[8 * st + 1]); pw.y = pk2(X[8 * st + 2], X[8 * st + 3]); pw.z = pk2(X[8 * st + 4], X[8 * st + 5]); pw.w = pk2(X[8 * st + 6], X[8 * st + 7]);
                                        O = __builtin_amdgcn_mfma_f32_32x32x16_bf16(trd8(VT, PV, 32 * sb + 16 * st + 4 * h2, 32 * sb + 16 * st + 8 + 4 * h2, 32 * vb, lane), __builtin_bit_cast(bf16x8, pw), O, 0, 0, 0);
                                    }
                                }
                                float nq = 0.f;
#pragma unroll
                                for (int ks = 0; ks < 4; ++ks) { const bf16x8 cf = *(const LAS bf16x8*)(CI + (32 * vb + r31) * PT + (16 * ks + 8 * h2) * 2); I = __builtin_amdgcn_mfma_f32_32x32x16_bf16(cf, qf[ks], I, 0, 0, 0);
                                    const f32x4 n0 = *(const LAS f32x4*)(NN + 16 * ks + 8 * h2), n1 = *(const LAS f32x4*)(NN + 16 * ks + 8 * h2 + 4); const u32x4 qw = __builtin_bit_cast(u32x4, qf[ks]);
                                    nq += (bflo(qw.x) * n0.x + bfhi(qw.x) * n0.y) + (bflo(qw.y) * n0.z + bfhi(qw.y) * n0.w) + (bflo(qw.z) * n1.x + bfhi(qw.z) * n1.y) + (bflo(qw.w) * n1.z + bfhi(qw.w) * n1.w); }
                                nq += __shfl_xor(nq, 32); denI += __shfl_xor(denI, 32);
                                const float den = si * nq + denI, rdn = 1.f / fmaxf(fabsf(den), em);
                                float hsum = 0.f;
#pragma unroll
                                for (int i = 0; i < 16; ++i) { hv[i] = (O[i] + si * I[i]) * rdn; hsum += hv[i]; }
                                hsum += __shfl_xor(hsum, 32);
                                const float hmean = hsum * (1.f / 32.f); float hm2 = 0.f;
#pragma unroll
                                for (int i = 0; i < 16; ++i) { const float dlt = hv[i] - hmean; hm2 += dlt * dlt; }
                                hm2 += __shfl_xor(hm2, 32);
                                if (h2 == 0) *(LAS f32x2*)(ST + ((tb * 4 + vb) * 32 + r31) * 2) = (f32x2){hmean, hm2};
                                const float carry = CR[0];
#pragma unroll
                                for (int i = 0; i < 16; ++i) accC[i] *= carry;
#pragma unroll
                                for (int st = 0; st < 4; ++st) { const bf16x8 va = trd8(VT, PV, 16 * st + 8 * h2, 16 * st + 8 * h2 + 4, 32 * vb, lane), kw = trd8(KW, PT, 16 * st + 8 * h2, 16 * st + 8 * h2 + 4, 32 * tb, lane);
                                    accC = __builtin_amdgcn_mfma_f32_32x32x16_bf16(va, kw, accC, 0, 0, 0); }
                            }
                            __syncthreads();
                            {
                                const int t = 32 * tb + r31;
                                f32x2 s4[4];
#pragma unroll
                                for (int q = 0; q < 4; ++q) s4[q] = *(const LAS f32x2*)(ST + ((tb * 4 + q) * 32 + r31) * 2);
                                const float mt = (s4[0].x + s4[1].x + s4[2].x + s4[3].x) * 0.25f;
                                float m2 = 0.f;
#pragma unroll
                                for (int q = 0; q < 4; ++q) { const float dm = s4[q].x - mt; m2 += s4[q].y + 32.f * dm * dm; }
                                const float rstd = __builtin_amdgcn_rsqf(m2 * (1.f / 128.f) + LN_EPS);
                                const size_t row = (size_t)bm * SEQ + t0 + t;
                                const char* ogp = Ub + (row * NU + UC_OG + hm * 128 + 32 * vb) * 2; char* op = HC + (row * 1536 + hm * 128 + 32 * vb) * 2;
                                const float* ngp = INP(I_MLNORMG) + l * 512 + hm * 128 + 32 * vb;
#pragma unroll
                                for (int g4 = 0; g4 < 4; ++g4) { const int vo = 8 * g4 + 4 * h2; const f32x4 og = ld4bf(ogp + vo * 2), ng = *(const f32x4*)(ngp + vo);
                                    f32x4 y; y.x = sigmoidf_(og.x) * ((hv[4 * g4] - mt) * rstd * ng.x); y.y = sigmoidf_(og.y) * ((hv[4 * g4 + 1] - mt) * rstd * ng.y); y.z = sigmoidf_(og.z) * ((hv[4 * g4 + 2] - mt) * rstd * ng.z); y.w = sigmoidf_(og.w) * ((hv[4 * g4 + 3] - mt) * rstd * ng.w);
                                    st4bf(op + vo * 2, y); }
                            }
#pragma unroll
                            for (int i = 0; i < 16; ++i) { const int v = 32 * vb + (i & 3) + 8 * (i >> 2) + 4 * h2; *(LAS bf16*)(CI + v * PT + (32 * tb + r31) * 2) = (bf16)f2bf(accC[i]); }
                            if (wave < 2) { float s = 0.f;
#pragma unroll
                                for (int q8 = 0; q8 < 8; ++q8) { const u32x2 w = trd4(KW, PT, 32 * h2 + 4 * q8, 32 * wave, lane); s += (bflo(w.x) + bfhi(w.x)) + (bflo(w.y) + bfhi(w.y)); }
                                s += __shfl_xor(s, 32);
                                nreg = CR[0] * nreg + s; if (h2 == 0) NN[32 * wave + r31] = nreg; }
                            __syncthreads();
                        }
                    }
                    _Pragma("unroll 1") for (int sr_ = 0; sr_ < NSUB(2); ++sr_) if ((SUBMASK>>2)&1) {
                        SUB_TID
                        constexpr int KST = 272, VST = 520;
                        LAS unsigned char* KI = lds; LAS unsigned char* VI = lds + 256 * KST;
                        const char* kvb = (const char*)(ws + WS_KV) + (((size_t)l * MROWS + (size_t)b * MEML) * D) * 2;
                        for (int p = tid; p < 4096; p += NTHR) { const int key = p >> 4, c16 = p & 15;
                            *(LAS u32x4*)(KI + key * KST + c16 * 16) = *(const u32x4*)(kvb + ((size_t)key * D + h * 128 + c16 * 8) * 2); }
                        for (int p = tid; p < 4096; p += NTHR) { const int key = p & 255, d8 = p >> 8;
                            const u32x4 w = *(const u32x4*)(kvb + ((size_t)key * D + 512 + h * 128 + d8 * 8) * 2);
                            LAS unsigned char* o = VI + (d8 * 8) * VST + key * 2;
                            *(LAS bf16*)(o) = (bf16)(w.x & 0xffff); *(LAS bf16*)(o + VST) = (bf16)(w.x >> 16); *(LAS bf16*)(o + 2 * VST) = (bf16)(w.y & 0xffff); *(LAS bf16*)(o + 3 * VST) = (bf16)(w.y >> 16);
                            *(LAS bf16*)(o + 4 * VST) = (bf16)(w.z & 0xffff); *(LAS bf16*)(o + 5 * VST) = (bf16)(w.z >> 16); *(LAS bf16*)(o + 6 * VST) = (bf16)(w.w & 0xffff); *(LAS bf16*)(o + 7 * VST) = (bf16)(w.w >> 16); }
                        __syncthreads();
                        const int r31 = lane & 31, h2 = lane >> 5;
                        constexpr float SC = 0.08838834764831845f * 1.4426950408889634f;
#pragma unroll 1
                        for (int rd = 0; rd < 8; ++rd) {
                            const size_t qrow = (size_t)b * SEQ + half * 2048 + rd * 256 + wave * 32 + r31;
                            bf16x8 qf[8];
#pragma unroll
                            for (int ks = 0; ks < 8; ++ks) qf[ks] = *(const bf16x8*)(Ub + (qrow * NU + UC_CAQ + h * 128 + 16 * ks + 8 * h2) * 2);
                            f32x16 O[4];
#pragma unroll
                            for (int db = 0; db < 4; ++db)
#pragma unroll
                                for (int i = 0; i < 16; ++i) O[db][i] = 0.f;
                            float mrun = -1e30f, lrun = 0.f;
#pragma unroll 1
                            for (int hf = 0; hf < 2; ++hf) {
                                f32x16 X[4];
#pragma unroll
                                for (int kb = 0; kb < 4; ++kb) {
                                    bf16x8 kf[8];
#pragma unroll
                                    for (int ks = 0; ks < 8; ++ks) kf[ks] = *(const LAS bf16x8*)(KI + (hf * 128 + kb * 32 + r31) * KST + (16 * ks + 8 * h2) * 2);
                                    __builtin_amdgcn_sched_barrier(0);
#pragma unroll
                                    for (int i = 0; i < 16; ++i) X[kb][i] = 0.f;
#pragma unroll
                                    for (int ks = 0; ks < 8; ++ks) X[kb] = __builtin_amdgcn_mfma_f32_32x32x16_bf16(kf[ks], qf[ks], X[kb], 0, 0, 0);
                                    __builtin_amdgcn_sched_barrier(0);
                                }
                                float mx = -1e30f;
#pragma unroll
                                for (int kb = 0; kb < 4; ++kb)
#pragma unroll
                                    for (int i = 0; i < 16; ++i) mx = fmaxf(mx, X[kb][i]);
                                mx = fmaxf(mx, __shfl_xor(mx, 32));
                                const float mnew = fmaxf(mrun, mx), alpha = __builtin_amdgcn_exp2f((mrun - mnew) * SC);
                                float ls = 0.f;
#pragma unroll
                                for (int kb = 0; kb < 4; ++kb)
#pragma unroll
                                    for (int i = 0; i < 16; ++i) { const float p = __builtin_amdgcn_exp2f((X[kb][i] - mnew) * SC); X[kb][i] = p; ls += p; }
                                ls += __shfl_xor(ls, 32);
                                lrun = lrun * alpha + ls; mrun = mnew;
#pragma unroll
                                for (int db = 0; db < 4; ++db)
#pragma unroll
                                    for (int i = 0; i < 16; ++i) O[db][i] *= alpha;
#pragma unroll
                                for (int kb = 0; kb < 4; ++kb) {
                                    bf16x8 vf[2][4], pf[2];
#pragma unroll
                                    for (int s = 0; s < 2; ++s) {
                                        u32x4 pw; pw.x = pk2(X[kb][8 * s], X[kb][8 * s + 1]); pw.y = pk2(X[kb][8 * s + 2], X[kb][8 * s + 3]); pw.z = pk2(X[kb][8 * s + 4], X[kb][8 * s + 5]); pw.w = pk2(X[kb][8 * s + 6], X[kb][8 * s + 7]);
                                        pf[s] = __builtin_bit_cast(bf16x8, pw);
#pragma unroll
                                        for (int db = 0; db < 4; ++db) {
                                            const LAS unsigned char* vp = VI + (db * 32 + r31) * VST + (hf * 128 + kb * 32 + 16 * s + 4 * h2) * 2;
                                            const u32x2 lo = *(const LAS u32x2*)vp, hi = *(const LAS u32x2*)(vp + 16);
                                            vf[s][db] = __builtin_bit_cast(bf16x8, (u32x4){lo.x, lo.y, hi.x, hi.y});
                                        }
                                    }
                                    __builtin_amdgcn_sched_barrier(0);
#pragma unroll
                                    for (int s = 0; s < 2; ++s)
#pragma unroll
                                        for (int db = 0; db < 4; ++db) O[db] = __builtin_amdgcn_mfma_f32_32x32x16_bf16(vf[s][db], pf[s], O[db], 0, 0, 0);
                                    __builtin_amdgcn_sched_barrier(0);
                                }
                            }
                            const float rl = 1.f / lrun;
                            char* op = HC + (qrow * 1536 + 1024 + h * 128) * 2;
#pragma unroll
                            for (int db = 0; db < 4; ++db)
#pragma unroll
                                for (int g4 = 0; g4 < 4; ++g4) { u32x2 w; w.x = pk2(O[db][4 * g4] * rl, O[db][4 * g4 + 1] * rl); w.y = pk2(O[db][4 * g4 + 2] * rl, O[db][4 * g4 + 3] * rl);
                                    *(u32x2*)(op + (db * 32 + 8 * g4 + 4 * h2) * 2) = w; }
                        }
                        __syncthreads();
                    }
                    if (rep_ == 0) {
                        LAS float* scr = (LAS float*)(lds + wave * 8448);
                        constexpr int IT_GU = 32 * 16 * 64;
                        const int nper = (idx < 64) ? 4 : 92, ibase = (idx < 64) ? 0 : 2048, wk = (idx & 63) * NWAVES + wave;
                        for (int kq = 0; kq < nper; ++kq) { const int it = ibase + wk + kq * 512;
                            if (it < IT_GU) { const int e = it >> 10, q = it & 1023, kb = q >> 6, nb = q & 63;
                                transpose_item_f8(INP(I_WGU) + (((size_t)l * 32 + e) * D + 64 * kb) * 2048 + 32 * nb, 2048, (unsigned char*)(ws + WS_WGU) + ((size_t)e * 2048 + 32 * nb) * D + 64 * kb, D, F8_SWGU, scr, lane_ml); }
                            else { const int r2 = it - IT_GU, e = r2 >> 9, q = r2 & 511, kb = q >> 5, nb = q & 31;
                                transpose_item_f8(INP(I_WDN) + (((size_t)l * 32 + e) * D + 64 * kb) * 1024 + 32 * nb, 1024, (unsigned char*)(ws + WS_WDN) + ((size_t)e * 1024 + 32 * nb) * D + 64 * kb, D, F8_SWDN, scr, lane_ml); }
                        }
                        __syncthreads();
                    }
                }
            }
#undef UNP4
#undef DOT4
#undef SUB_TID
        }
        SEAM(pb + 3);
        _Pragma("unroll 1") for (int rep_ = 0; rep_ < NREP(5); ++rep_) if (((PHMASK>>5)&1) && IN(pb + 5)) {
            SchedPlain S; S.T.init(M / 256, 4); S.G = G; S.c = bx; S.A = (const char*)(ws + WS_R2 + R2_HCAT); S.B = (const char*)(ws + WS_WBR) + (size_t)l * 1024 * 1536 * 2; S.C = (char*)(ws + WS_R2 + R2_YPRE);
            S.lda = 1536; S.ldb = 1536; S.ldc = D;
            pg8::EpiMerge E; E.U = Ub; E.gate_b = INP(I_GATEB) + (size_t)l * 3072;
            pg8::gemm_phase<false, true>(lds, 1536 * 2, 1536 * 2, 1536 * 2, S, E, wave);
        }
        SEAM(pb + 5);
        _Pragma("unroll 1") for (int rep_ = 0; rep_ < NREP(6); ++rep_) if (((PHMASK>>6)&1) && IN(pb + 6)) {
            SchedPlain S; S.T.init(M / 256, 4); S.G = G; S.c = bx; S.A = (const char*)(ws + WS_R2 + R2_YPRE); S.B = (const char*)(ws + WS_WO) + (size_t)l * D * D * 2; S.C = (char*)(ws + WS_R2 + R2_Z);
            S.lda = D; S.ldb = D; S.ldc = D;
            pg8::EpiStore E;
            pg8::gemm_phase<false>(lds, D * 2, D * 2, D * 2, S, E, wave);
        }
        SEAM(pb + 6);
        _Pragma("unroll 1") for (int rep_ = 0; rep_ < NREP(7); ++rep_) if (((PHMASK>>7)&1) && IN(pb + 7)) { PHASE_TID
            constexpr int WP = 2064;
            LAS unsigned char* WRb = lds;
            LAS float* RB = (LAS float*)(lds + 66048);
            LAS unsigned char* XS = lds + 66560 + wave * 4608;
            for (int i = tid; i < 32768; i += NTHR) { const int k = i >> 5, e = i & 31; *(LAS bf16*)(WRb + e * WP + k * 2) = (bf16)f2bf(INP(I_RTW)[((size_t)l * D + k) * 32 + e]); }
            if (tid < 32) RB[tid] = INP(I_RTB)[l * 32 + tid];
            const char* Zb = (const char*)(ws + WS_R2 + R2_Z);
            int* TKE = (int*)(ws + WS_TKE); float* TKG = (float*)(ws + WS_TKG); int* TKP = (int*)(ws + WS_TKP); int* ROWTOK = (int*)(ws + WS_ROWTOK);
            LAS unsigned* LCNT = (LAS unsigned*)(lds + 131072);
            LAS unsigned* GBASE = LCNT + 32; LAS unsigned* LLEN = LCNT + 64; LAS unsigned* LIST = LCNT + 128;
            if (tid < 65) LCNT[tid] = 0u;
            {
                f32x4 g[4], bb[4];
#pragma unroll
                for (int j = 0; j < 4; ++j) { g[j] = *(const f32x4*)(INP(I_LN1G) + l * D + 256 * j + 4 * lane); bb[j] = *(const f32x4*)(INP(I_LN1B) + l * D + 256 * j + 4 * lane); }
#pragma unroll 1
                for (int pp = gw; pp < M / 2; pp += NGW) {
                    f32x4 y0[4], y1[4];
#pragma unroll
                    for (int j = 0; j < 4; ++j) { y0[j] = ld4bf(Zb + ((size_t)(2 * pp) * D + 256 * j + 4 * lane) * 2) + ld4bf(Xb + ((size_t)(2 * pp) * D + 256 * j + 4 * lane) * 2) * DN_ALPHA;
                        y1[j] = ld4bf(Zb + ((size_t)(2 * pp + 1) * D + 256 * j + 4 * lane) * 2) + ld4bf(Xb + ((size_t)(2 * pp + 1) * D + 256 * j + 4 * lane) * 2) * DN_ALPHA; }
                    ln16(y0, g, bb); ln16(y1, g, bb);
#pragma unroll
                    for (int j = 0; j < 4; ++j) { st4bf(Xb + ((size_t)(2 * pp) * D + 256 * j + 4 * lane) * 2, y0[j]); st4bf(Xb + ((size_t)(2 * pp + 1) * D + 256 * j + 4 * lane) * 2, y1[j]); }
                }
            }
            asm volatile("s_waitcnt vmcnt(0)" ::: "memory");
            __syncthreads();
            __builtin_amdgcn_fence(__ATOMIC_ACQUIRE, "agent");
            asm volatile("s_waitcnt vmcnt(0)" ::: "memory");
            if (rep_ == 0) {
                const int r31 = lane & 31, h2 = lane >> 5;
                const int mytok = 16 * (bx + (2 * wave + (r31 >> 4)) * G) + (r31 & 15);
                const char* sp[4];
#pragma unroll
                for (int q = 0; q < 4; ++q) { const int row = (lane >> 3) + 8 * q; const int tk = 16 * (bx + (2 * wave + (row >> 4)) * G) + (row & 15); sp[q] = Xb + ((size_t)tk * D + 8 * (lane & 7)) * 2; }
                f32x16 C;
#pragma unroll
                for (int i = 0; i < 16; ++i) C[i] = 0.f;
                u32x4 xr[4];
#pragma unroll
                for (int q = 0; q < 4; ++q) xr[q] = *(const u32x4*)(sp[q]);
#pragma unroll 1
                for (int sl = 0; sl < 16; ++sl) {
#pragma unroll
                    for (int q = 0; q < 4; ++q) *(LAS u32x4*)(XS + ((lane >> 3) + 8 * q) * 144 + (lane & 7) * 16) = xr[q];
                    if (sl + 1 < 16) {
#pragma unroll
                        for (int q = 0; q < 4; ++q) xr[q] = *(const u32x4*)(sp[q] + (sl + 1) * 128); }
#pragma unroll
                    for (int k2 = 0; k2 < 4; ++k2) C = __builtin_amdgcn_mfma_f32_32x32x16_bf16(*(const LAS bf16x8*)(WRb + r31 * WP + (64 * sl + 16 * k2 + 8 * h2) * 2), *(const LAS bf16x8*)(XS + r31 * 144 + (16 * k2 + 8 * h2) * 2), C, 0, 0, 0);
                }
                float v[16];
#pragma unroll
                for (int g4 = 0; g4 < 4; ++g4) { const f32x4 b4 = *(const LAS f32x4*)(RB + 8 * g4 + 4 * h2); v[4 * g4] = C[4 * g4] + b4.x; v[4 * g4 + 1] = C[4 * g4 + 1] + b4.y; v[4 * g4 + 2] = C[4 * g4 + 2] + b4.z; v[4 * g4 + 3] = C[4 * g4 + 3] + b4.w; }
                float lv[4]; int li_[4];
#pragma unroll
                for (int k = 0; k < 4; ++k) { float best = -3.0e38f; int bi = 0;
#pragma unroll
                    for (int i = 0; i < 16; ++i) { const int e = (i & 3) + 8 * (i >> 2) + 4 * h2; if (v[i] > best) { best = v[i]; bi = e; } }
#pragma unroll
                    for (int i = 0; i < 16; ++i) { const int e = (i & 3) + 8 * (i >> 2) + 4 * h2; v[i] = (e == bi) ? -3.0e38f : v[i]; }
                    lv[k] = best; li_[k] = bi; }
                float cv[8]; int ci[8];
#pragma unroll
                for (int k = 0; k < 4; ++k) { cv[k] = lv[k]; ci[k] = li_[k]; cv[4 + k] = __shfl_xor(lv[k], 32); ci[4 + k] = __shfl_xor(li_[k], 32); }
                float tv[4]; int te[4];
#pragma unroll
                for (int k = 0; k < 4; ++k) { float best = -3.0e38f; int bi = 64;
#pragma unroll
                    for (int i = 0; i < 8; ++i) { if (cv[i] > best || (cv[i] == best && ci[i] < bi)) { best = cv[i]; bi = ci[i]; } }
#pragma unroll
                    for (int i = 0; i < 8; ++i) cv[i] = (ci[i] == bi) ? -3.0e38f : cv[i];
                    tv[k] = best; te[k] = bi; }
                const float e1 = __expf(tv[1] - tv[0]), e2 = __expf(tv[2] - tv[0]), e3 = __expf(tv[3] - tv[0]), rs = 1.f / (1.f + e1 + e2 + e3);
                const float gt[4] = {rs, e1 * rs, e2 * rs, e3 * rs};
                if (h2 == 0) {
#pragma unroll
                    for (int k = 0; k < 4; ++k) {
                        const unsigned lpos = __hip_atomic_fetch_add(LCNT + te[k], 1u, __ATOMIC_RELAXED, __HIP_MEMORY_SCOPE_WORKGROUP);
                        const unsigned li = __hip_atomic_fetch_add(LLEN, 1u, __ATOMIC_RELAXED, __HIP_MEMORY_SCOPE_WORKGROUP);
                        LIST[2 * li] = (unsigned)(mytok * 4 + k); LIST[2 * li + 1] = (unsigned)te[k] | (lpos << 8);
                        TKE[mytok * 4 + k] = te[k]; TKG[mytok * 4 + k] = gt[k]; }
                }
            }
            __syncthreads();
            if (tid < 32 && rep_ == 0) GBASE[tid] = __hip_atomic_fetch_add((unsigned*)ctl + CW_CNT + (l * 32 + tid) * 64, LCNT[tid], RLX_AGENT);
            __syncthreads();
            if (rep_ == 0) { const unsigned n = LLEN[0];
                for (unsigned i = tid; i < n; i += NTHR) { const unsigned tk = LIST[2 * i], ev = LIST[2 * i + 1], e = ev & 255u, pos = GBASE[e] + (ev >> 8);
                    TKP[tk] = (int)pos; ROWTOK[(size_t)e * M + pos] = (int)(tk >> 2); } }
            __syncthreads();
        }
        SEAM(pb + 7);
        _Pragma("unroll 1") for (int rep_ = 0; rep_ < NREP(8); ++rep_) if (((PHMASK>>8)&1) && IN(pb + 8)) { PHASE_TID
            if (tid < 32) CNT[tid] = (int)__hip_atomic_load((unsigned*)ctl + CW_CNT + (l * 32 + tid) * 64, RLX_AGENT);
            __syncthreads();
            if (tid == 0) { int a = 0; for (int e = 0; e < 32; ++e) { PB[e] = a; a += (CNT[e] + 255) >> 8; } PB[32] = a; }
            __syncthreads();
            const int P = PB[32];
            const int* ROWTOK = (const int*)(ws + WS_ROWTOK);
            char* XD = (char*)(ws + WS_R1);
            for (int sb = gw * 64; sb < P * 256; sb += NGW * 64) {
                const int pm = sb >> 8; int e = 0;
#pragma unroll 1
                for (int j = 1; j < NEXP; ++j) e += (PB[j] <= pm) ? 1 : 0;
                const int pos0 = sb - PB[e] * 256, cnt = CNT[e];
                int nvalid = cnt - pos0; nvalid = nvalid > 64 ? 64 : nvalid;
                int tokv = -1; if (pos0 + lane < cnt) tokv = ROWTOK[(size_t)e * M + pos0 + lane];
#pragma unroll 1
                for (int j = 0; j < nvalid; j += 2) {
                    int t[2]; u32x4 a[2], b2[2];
#pragma unroll
                    for (int i = 0; i < 2; ++i) { t[i] = __builtin_amdgcn_readlane(tokv, j + i);
                        if (t[i] >= 0) { a[i] = *(const u32x4*)(Xb + (size_t)t[i] * 2048 + lane * 32); b2[i] = *(const u32x4*)(Xb + (size_t)t[i] * 2048 + lane * 32 + 16); } }
#pragma unroll
                    for (int i = 0; i < 2; ++i) if (t[i] >= 0) {
                        u32x4 o; o.x = pk4_f8(bflo(a[i].x) * F8_SX, bfhi(a[i].x) * F8_SX, bflo(a[i].y) * F8_SX, bfhi(a[i].y) * F8_SX); o.y = pk4_f8(bflo(a[i].z) * F8_SX, bfhi(a[i].z) * F8_SX, bflo(a[i].w) * F8_SX, bfhi(a[i].w) * F8_SX);
                        o.z = pk4_f8(bflo(b2[i].x) * F8_SX, bfhi(b2[i].x) * F8_SX, bflo(b2[i].y) * F8_SX, bfhi(b2[i].y) * F8_SX); o.w = pk4_f8(bflo(b2[i].z) * F8_SX, bfhi(b2[i].z) * F8_SX, bflo(b2[i].w) * F8_SX, bfhi(b2[i].w) * F8_SX);
                        *(u32x4*)(XD + (size_t)(sb + j + i) * 1024 + lane * 16) = o; }
                }
            }
            LAS float* scr = (LAS float*)(lds + wave * 8448);
            constexpr int IT_GU = 32 * 16 * 64, IT_DN = 32 * 16 * 32;
            for (int it = XW_SPLIT + gw; it < IT_GU + IT_DN; it += NGW) {
                if (it < IT_GU) { const int e = it >> 10, q = it & 1023, kb = q >> 6, nb = q & 63;
                    transpose_item_f8(INP(I_WGU) + (((size_t)l * 32 + e) * D + 64 * kb) * 2048 + 32 * nb, 2048, (unsigned char*)(ws + WS_WGU) + ((size_t)e * 2048 + 32 * nb) * D + 64 * kb, D, F8_SWGU, scr, lane); }
                else { const int r = it - IT_GU, e = r >> 9, q = r & 511, kb = q >> 5, nb = q & 31;
                    transpose_item_f8(INP(I_WDN) + (((size_t)l * 32 + e) * D + 64 * kb) * 1024 + 32 * nb, 1024, (unsigned char*)(ws + WS_WDN) + ((size_t)e * 1024 + 32 * nb) * D + 64 * kb, D, F8_SWDN, scr, lane); }
            }
            __syncthreads();
        }
        SEAM(pb + 8);
        if (IN(pb + 9) || IN(pb + 10)) { PHASE_TID
            if (tid < 32) CNT[tid] = (int)__hip_atomic_load((unsigned*)ctl + CW_CNT + (l * 32 + tid) * 64, RLX_AGENT);
            __syncthreads();
            if (tid == 0) { int a = 0; for (int e = 0; e < 32; ++e) { PB[e] = a; a += (CNT[e] + 255) >> 8; } PB[32] = a; }
            __syncthreads();
        }
        _Pragma("unroll 1") for (int rep_ = 0; rep_ < NREP(9); ++rep_) if (((PHMASK>>9)&1) && IN(pb + 9)) {
            SchedMoe S; S.T.init(PB[32], 8); S.G = G; S.c = bx; S.A = (const char*)(ws + WS_R1); S.W = (const char*)(ws + WS_WGU); S.C = (char*)(ws + WS_R2 + R2_HMID); S.PB = PB; S.wrows = 2048; S.ldc = 1024; S.cdiv = 2; S.osz = 1;
            pg8::EpiMoe1 E; E.bgu = INP(I_BGU) + (size_t)l * 32 * 2048;
            pg8::gemm_phase<true>(lds, D, D, D, S, E, wave);
        }
        SEAM(pb + 9);
        _Pragma("unroll 1") for (int rep_ = 0; rep_ < NREP(10); ++rep_) if (((PHMASK>>10)&1) && IN(pb + 10)) {
            SchedMoe S; S.T.init(PB[32], 4); S.G = G; S.c = bx; S.A = (const char*)(ws + WS_R2 + R2_HMID); S.W = (const char*)(ws + WS_WDN); S.C = (char*)(ws + WS_R1); S.PB = PB; S.wrows = 1024; S.ldc = 1024; S.cdiv = 1; S.osz = 2;
            pg8::EpiMoe2 E; E.bdn = INP(I_BDN) + (size_t)l * 32 * 1024;
            pg8::gemm_phase<true>(lds, D, D, D, S, E, wave);
        }
        SEAM(pb + 10);
        _Pragma("unroll 1") for (int rep_ = 0; rep_ < NREP(11); ++rep_) if (((PHMASK>>11)&1) && IN(pb + 11)) { PHASE_TID
            if (tid < 32) CNT[tid] = (int)__hip_atomic_load((unsigned*)ctl + CW_CNT + (l * 32 + tid) * 64, RLX_AGENT);
            LAS float* wgt = (LAS float*)(lds + 73728);
            const bool lastl = (l == DEPTH - 1);
            if (!lastl) load_gate_table(wgt, INP(I_WIN) + (size_t)(l + 1) * D * DIN, tid);
            __syncthreads();
            if (tid == 0) { int a = 0; for (int e = 0; e < 32; ++e) { PB[e] = a; a += (CNT[e] + 255) >> 8; } PB[32] = a; }
            __syncthreads();
            const int e0 = 8 * lane;
            f32x4 g[4], bb[4];
#pragma unroll
            for (int j = 0; j < 4; ++j) { const int o = (j >> 1) * 512 + e0 + (j & 1) * 4; g[j] = *(const f32x4*)(INP(I_LN2G) + l * D + o); bb[j] = *(const f32x4*)(INP(I_LN2B) + l * D + o); }
            const char* YA = (const char*)(ws + WS_R1);
            const bool dummy_ = (rep_ + 1 < NREP(11)); char* const Xo = dummy_ ? (char*)(ws + WS_R2) : Xb; float* const Fo = dummy_ ? (float*)(ws + WS_R2 + 256 * MiB) : args.out; float* const Go = dummy_ ? (float*)(ws + WS_R2 + 200 * MiB) : GIF;
            const int* TKE = (const int*)(ws + WS_TKE); const float* TKG = (const float*)(ws + WS_TKG); const int* TKP = (const int*)(ws + WS_TKP);
#pragma unroll 1
            for (int mb = gw * 16; mb < M; mb += NGW * 16) {
                const int ev = TKE[mb * 4 + lane], pv = TKP[mb * 4 + lane]; const float gv = TKG[mb * 4 + lane];
                const int rowv = PB[ev] * 256 + pv;
#pragma unroll 1
                for (int ti = 0; ti < 16; ti += 2) {
                    u32x4 xw[2][2], yw[2][4][2]; float gk[2][4];
#pragma unroll
                    for (int q = 0; q < 2; ++q) { const size_t m = (size_t)mb + ti + q;
                        xw[q][0] = *(const u32x4*)(Xb + (m * D + e0) * 2); xw[q][1] = *(const u32x4*)(Xb + (m * D + 512 + e0) * 2);
#pragma unroll
                        for (int k = 0; k < 4; ++k) { const size_t row = (size_t)__builtin_amdgcn_readlane(rowv, 4 * (ti + q) + k);
                            gk[q][k] = __builtin_bit_cast(float, __builtin_amdgcn_readlane(__builtin_bit_cast(int, gv), 4 * (ti + q) + k));
                            yw[q][k][0] = *(const u32x4*)(YA + (row * D + e0) * 2); yw[q][k][1] = *(const u32x4*)(YA + (row * D + 512 + e0) * 2); } }
#pragma unroll
                    for (int q = 0; q < 2; ++q) { const size_t m = (size_t)mb + ti + q;
                        f32x4 v[4];
#pragma unroll
                        for (int hh = 0; hh < 2; ++hh) { const u32x4 w = xw[q][hh];
                            v[2 * hh] = (f32x4){bflo(w.x), bfhi(w.x), bflo(w.y), bfhi(w.y)} * DN_ALPHA; v[2 * hh + 1] = (f32x4){bflo(w.z), bfhi(w.z), bflo(w.w), bfhi(w.w)} * DN_ALPHA; }
#pragma unroll
                        for (int k = 0; k < 4; ++k)
#pragma unroll
                            for (int hh = 0; hh < 2; ++hh) { const u32x4 w = yw[q][k][hh];
                                v[2 * hh] = v[2 * hh] + (f32x4){bflo(w.x), bfhi(w.x), bflo(w.y), bfhi(w.y)} * gk[q][k]; v[2 * hh + 1] = v[2 * hh + 1] + (f32x4){bflo(w.z), bfhi(w.z), bflo(w.w), bfhi(w.w)} * gk[q][k]; }
                        ln16(v, g, bb);
                        if (lastl) {
#pragma unroll
                            for (int j = 0; j < 4; ++j) *(f32x4*)(Fo + m * D + (j >> 1) * 512 + e0 + (j & 1) * 4) = v[j];
                        } else {
#pragma unroll
                            for (int hh = 0; hh < 2; ++hh) { *(u32x4*)(Xo + (m * D + hh * 512 + e0) * 2) = pg8::pack8(v[2 * hh], v[2 * hh + 1]);
                                u32x2 f8w; f8w.x = pk4_f8(v[2 * hh].x * F8_SX, v[2 * hh].y * F8_SX, v[2 * hh].z * F8_SX, v[2 * hh].w * F8_SX); f8w.y = pk4_f8(v[2 * hh + 1].x * F8_SX, v[2 * hh + 1].y * F8_SX, v[2 * hh + 1].z * F8_SX, v[2 * hh + 1].w * F8_SX);
                                if (!dummy_) *(u32x2*)((char*)(ws + WS_XF8) + m * D + hh * 512 + e0) = f8w; }
                            gates8b(v, wgt, Go + m * 8, lane);
                        }
                    }
                }
            }
            __syncthreads();
        }
        SEAM(pb + 11);
    }
#undef IN
#undef SEAM
}

extern "C" void kernel_launch(void* const* d_in, const int* in_sizes, int n_in, void* d_out, int out_size, void* d_ws, size_t ws_size, hipStream_t stream) {
    static int grid = 0;
    if (grid == 0) {
        if (n_in != N_IN || out_size != M * D || ws_size < WS_END) { fprintf(stderr, "kernel_launch: unexpected shapes (n_in %d, out %d, ws %zu)\n", n_in, out_size, ws_size); grid = -1; return; }
        int dev = 0, cus = 0, per_cu = 0;
        if (hipGetDevice(&dev) != hipSuccess || hipDeviceGetAttribute(&cus, hipDeviceAttributeMultiprocessorCount, dev) != hipSuccess) { grid = -1; return; }
        if (hipFuncSetAttribute((const void*)fwd_kernel, hipFuncAttributeMaxDynamicSharedMemorySize, LDS_BYTES) != hipSuccess) { fprintf(stderr, "kernel_launch: hipFuncSetAttribute failed\n"); grid = -1; return; }
        if (hipOccupancyMaxActiveBlocksPerMultiprocessor(&per_cu, (const void*)fwd_kernel, NTHR, LDS_BYTES) != hipSuccess || per_cu < 1) fprintf(stderr, "kernel_launch: occupancy query reports %d\n", per_cu);
        (void)hipGetLastError();
        grid = cus;
    }
    if (grid < 0) return;
    (void)hipMemsetAsync((char*)d_ws + WS_CTL, 0, CTL_ZERO_BYTES, stream);
    Args a{};
    for (int i = 0; i < N_IN; ++i) a.in[i] = (const float*)d_in[i];
    a.out = (float*)d_out; a.ws = (unsigned char*)d_ws;
#if MK_ONE_LAUNCH
    a.ph_lo = 0; a.ph_hi = NPH;
    hipLaunchKernelGGL(fwd_kernel, dim3(grid), dim3(NTHR), LDS_BYTES, stream, a);
#else
    for (int p = 0; p < NPH; ++p) { a.ph_lo = p; a.ph_hi = p + 1; hipLaunchKernelGGL(fwd_kernel, dim3(grid), dim3(NTHR), LDS_BYTES, stream, a); }
#endif
    const hipError_t le = hipPeekAtLastError();
    if (le != hipSuccess) fprintf(stderr, "kernel_launch: launch failed: %s\n", hipGetErrorName(le));
}
```

```cpp
#include <hip/hip_runtime.h>
#include <cstdio>
#include <cstdint>

#ifndef MK_ONE_LAUNCH
#define MK_ONE_LAUNCH 1
#endif

#define LAS __attribute__((address_space(3)))
#define GAS __attribute__((address_space(1)))
typedef unsigned short bf16;
typedef short bf16x8 __attribute__((ext_vector_type(8)));
typedef float f32x4 __attribute__((ext_vector_type(4)));
typedef float f32x2 __attribute__((ext_vector_type(2)));
typedef float f32x16 __attribute__((ext_vector_type(16)));
typedef unsigned u32x4 __attribute__((ext_vector_type(4)));
typedef unsigned u32x2 __attribute__((ext_vector_type(2)));
typedef __bf16 bf16x2_t __attribute__((ext_vector_type(2)));
typedef GAS unsigned gu32;
#define RLX_AGENT __ATOMIC_RELAXED, __HIP_MEMORY_SCOPE_AGENT
#define DI __device__ __forceinline__

constexpr int NWAVES = 8, NTHR = 512;
constexpr int D = 1024, BATCH = 16, SEQ = 4096, M = BATCH * SEQ, DEPTH = 2, MEML = 256, MROWS = BATCH * MEML;
constexpr int DIN = 6920, NU = 6912;
constexpr int UC_QK = 0, UC_RW = 512, UC_V = 2304, UC_OG = 2816, UC_CAQ = 3328, UC_GATE = 3840;
constexpr int UC_F8 = UC_V, NF8 = NU - UC_F8;
__host__ __device__ constexpr int ucol_src(int c) { return c < 512 ? c : (c < 2304 ? 1544 + (c - 512) : (c < 2816 ? 512 + (c - 2304) : (c < 3328 ? 1024 + (c - 2816) : (c < 3840 ? 3336 + (c - 3328) : 3848 + (c - 3840))))); }
constexpr int NEXP = 32, TOPK = 4;
constexpr int PMAX = M * TOPK / 256 + NEXP;
constexpr float LN_EPS = 1e-5f, RW_GN_EPS = 64e-5f, DN_ALPHA = 1.41421356237f;

enum { I_X = 0, I_MEM, I_LNIN_G, I_LNIN_B, I_MEMLN_G, I_MEMLN_B, I_WIN, I_CONVW, I_CONVB, I_IGB, I_FGB, I_MLNORMG, I_RWMU, I_RWW0, I_RWWUP, I_RWA0, I_RWAUP, I_RWGUP,
       I_RWKK, I_RWKA, I_RWRK, I_RWLNG, I_RWLNB, I_CAWKV, I_GATEB, I_WBRML, I_WBRRW, I_WBRCA, I_WO, I_LN1G, I_LN1B, I_RTW, I_RTB, I_WGU, I_BGU, I_WDN, I_BDN, I_LN2G, I_LN2B, N_IN };

constexpr size_t MiB = 1u << 20;
constexpr size_t WS_CTL = 0, CTL_ZERO_BYTES = 1 * MiB;
constexpr size_t WS_WIN = 1 * MiB;
constexpr size_t WS_WKV = 28 * MiB;
constexpr size_t WS_WBR = 32 * MiB;
constexpr size_t WS_WO = 38 * MiB;
constexpr size_t WS_WLORA = 42 * MiB;
constexpr size_t WS_WGU = 45 * MiB;
constexpr size_t WS_WDN = 173 * MiB;
constexpr size_t WS_X = 237 * MiB;
constexpr size_t WS_MEMN = 365 * MiB;
constexpr size_t WS_KV = 373 * MiB;
constexpr size_t WS_GIF = 389 * MiB;
constexpr size_t WS_TKE = 391 * MiB, WS_TKG = 392 * MiB, WS_TKP = 393 * MiB;
constexpr size_t WS_ROWTOK = 394 * MiB;
constexpr size_t WS_HML = 402 * MiB;
constexpr size_t WS_R1 = 466 * MiB;
constexpr size_t WS_R2 = 1330 * MiB;
constexpr size_t WS_XF8 = 1858 * MiB;
constexpr size_t WS_WING8 = 1922 * MiB;
constexpr size_t WS_END = 1932 * MiB;
constexpr size_t R2_LORA_OUT = 0, R2_HCAT = 192 * MiB, R2_LORA_IN = 384 * MiB, R2_YPRE = 0, R2_Z = 192 * MiB, R2_HMID = 0;
constexpr int CW_TMO = 0, CW_BAR = 4096, CW_CNT = 16384, CW_FILL = 32768;

constexpr int LDS_BYTES = 155648;
constexpr int LDSCTL_OFF = 153600;

DI unsigned pk2(float lo, float hi) { bf16x2_t b = __builtin_convertvector((f32x2){lo, hi}, bf16x2_t); return __builtin_bit_cast(unsigned, b); }
DI unsigned f2bf(float f) { return pk2(f, 0.f) & 0xffffu; }
DI float u2f_(unsigned u) { return __builtin_bit_cast(float, u); }
DI unsigned f2u_(float f) { return __builtin_bit_cast(unsigned, f); }
DI float bflo(unsigned u) { return __builtin_bit_cast(float, u << 16); }
DI float bfhi(unsigned u) { return __builtin_bit_cast(float, u & 0xffff0000u); }
DI unsigned pk4_f8(float a, float b, float c, float d) {
    a = __builtin_amdgcn_fmed3f(a, -448.f, 448.f); b = __builtin_amdgcn_fmed3f(b, -448.f, 448.f); c = __builtin_amdgcn_fmed3f(c, -448.f, 448.f); d = __builtin_amdgcn_fmed3f(d, -448.f, 448.f);
    int w = 0; w = __builtin_amdgcn_cvt_pk_fp8_f32(a, b, w, false); w = __builtin_amdgcn_cvt_pk_fp8_f32(c, d, w, true); return (unsigned)w; }
DI float sigmoidf_(float x) { return __builtin_amdgcn_rcpf(1.f + __builtin_amdgcn_exp2f(-1.4426950408889634f * x)); }
template <int CTRL> DI float dppf(float x) { return __builtin_bit_cast(float, __builtin_amdgcn_update_dpp(0, __builtin_bit_cast(int, x), CTRL, 0xF, 0xF, true)); }
DI float red4(float x) { x += dppf<0xB1>(x); x += dppf<0x4E>(x); return x; }
DI float red8(float x) { x = red4(x); x += dppf<0x141>(x); return x; }
DI float red16(float x) { x = red8(x); x += dppf<0x140>(x); return x; }
DI float red8o(float x) { x += dppf<0xB1>(x); asm("" : "+v"(x)); x += dppf<0x4E>(x); asm("" : "+v"(x)); x += dppf<0x141>(x); asm("" : "+v"(x)); return x; }
DI float red16o(float x) { x = red8o(x); x += dppf<0x140>(x); asm("" : "+v"(x)); return x; }
typedef short s16x4 __attribute__((ext_vector_type(4)));
DI u32x2 trd4(const LAS unsigned char* img, int PB, int rowbase, int colbase, int lane) {
    const LAS unsigned char* p = img + (rowbase + ((lane & 15) >> 2)) * PB + (colbase + 16 * ((lane >> 4) & 1) + 4 * (lane & 3)) * 2;
    return __builtin_bit_cast(u32x2, __builtin_amdgcn_ds_read_tr16_b64_v4i16((LAS s16x4*)p)); }
DI bf16x8 trd8(const LAS unsigned char* img, int PB, int rb0, int rb1, int colbase, int lane) { const u32x2 lo = trd4(img, PB, rb0, colbase, lane), hi = trd4(img, PB, rb1, colbase, lane); return __builtin_bit_cast(bf16x8, (u32x4){lo.x, lo.y, hi.x, hi.y}); }
template <int CTRL, int RM> DI float dpp_keep(float x, float ident) { return __builtin_bit_cast(float, __builtin_amdgcn_update_dpp(__builtin_bit_cast(int, ident), __builtin_bit_cast(int, x), CTRL, RM, 0xF, false)); }
DI float scan_add64(float x) { x += dpp_keep<0x111, 0xF>(x, 0.f); x += dpp_keep<0x112, 0xF>(x, 0.f); x += dpp_keep<0x114, 0xF>(x, 0.f); x += dpp_keep<0x118, 0xF>(x, 0.f); x += dpp_keep<0x142, 0xA>(x, 0.f); x += dpp_keep<0x143, 0xC>(x, 0.f); return x; }
DI float scan_max64(float x) { const float NI = -3.0e38f; x = fmaxf(x, dpp_keep<0x111, 0xF>(x, NI)); x = fmaxf(x, dpp_keep<0x112, 0xF>(x, NI)); x = fmaxf(x, dpp_keep<0x114, 0xF>(x, NI)); x = fmaxf(x, dpp_keep<0x118, 0xF>(x, NI));
    x = fmaxf(x, dpp_keep<0x142, 0xA>(x, NI)); x = fmaxf(x, dpp_keep<0x143, 0xC>(x, NI)); return x; }
DI float wave_sum(float v) {
    v = red16(v);
    const int vi = __builtin_bit_cast(int, v);
    const float a = __builtin_bit_cast(float, __builtin_amdgcn_readlane(vi, 0)), b = __builtin_bit_cast(float, __builtin_amdgcn_readlane(vi, 16));
    const float c = __builtin_bit_cast(float, __builtin_amdgcn_readlane(vi, 32)), d = __builtin_bit_cast(float, __builtin_amdgcn_readlane(vi, 48));
    return (a + b) + (c + d);
}
#define LDS_WAIT() asm volatile("s_waitcnt lgkmcnt(0)" ::: "memory")

constexpr float F8_SX = 8.f, F8_SWGU = 512.f, F8_SH = 4.f, F8_SWDN = 1024.f, F8_INV1 = 1.f / (F8_SX * F8_SWGU), F8_INV2 = 1.f / (F8_SH * F8_SWDN);
namespace pg8 {
constexpr int BM = 256, BK = 64, HALF = 128, HTB = HALF * BK * 2, STAGE_BYTES = 8 * HTB, NXCD = 8, WGM = 8;
__host__ __device__ __forceinline__ int lds_byte(int r, int c) { const int st = (r >> 4) * 2 + (c >> 5), rr = r & 15, cc = c & 31, ob = rr * 64 + cc * 2; return st * 1024 + (ob ^ (((ob >> 9) & 1) << 5)); }
__host__ __device__ __forceinline__ void stage_rc(int b, int& R, int& C) { const int st = b / 1024, sb = b % 1024, swz = sb ^ (((sb >> 9) & 1) << 5); R = (st >> 1) * 16 + swz / 64; C = (st & 1) * 32 + (swz % 64) / 2; }
__host__ __device__ __forceinline__ int perm32(int rho) { const int n = rho >> 4, i = rho & 15; return 8 * (i >> 2) + 4 * n + (i & 3); }

struct Unit { const char* a; const char* b; char* c; int ldc; int r0, c0, e, sub; };

struct TileOrder {
    int nM, nN, nwg;
    DI void init(int nM_, int nN_) { nM = nM_; nN = nN_; nwg = nM * nN; }
    DI bool tile(long L, int& pm, int& pn) const {
        if (L >= nwg) return false;
        int wgid = (int)L; { const int q = nwg / NXCD, r = nwg % NXCD, xcd = wgid % NXCD, off = wgid / NXCD; wgid = (xcd < r ? xcd * (q + 1) : r * (q + 1) + (xcd - r) * q) + off; }
        const int nig = WGM * nN, gid = wgid / nig, fm = gid * WGM, gsz = (nM - fm) < WGM ? (nM - fm) : WGM;
        pm = fm + ((wgid % nig) % gsz); pn = (wgid % nig) / gsz; return true;
    }
};

DI u32x4 pack8(const f32x4& v0, const f32x4& v1) { u32x4 w; w.x = pk2(v0[0], v0[1]); w.y = pk2(v0[2], v0[3]); w.z = pk2(v1[0], v1[1]); w.w = pk2(v1[2], v1[3]); return w; }

struct EpiStore {
    DI void operator()(const f32x4 (&acc)[2][2][4][2], const Unit& u, int wr, int wc, int fr, int fq) const {
#pragma unroll
        for (int ai = 0; ai < 2; ++ai)
#pragma unroll
            for (int m = 0; m < 4; ++m) { char* rowp = u.c + ((size_t)(ai * HALF + wr * 64 + m * 16 + fr) * u.ldc + wc * 32 + 8 * fq) * 2;
#pragma unroll
                for (int bj = 0; bj < 2; ++bj) *(u32x4*)(rowp + bj * 256) = pack8(acc[ai][bj][m][0], acc[ai][bj][m][1]); }
    }
};
struct EpiStoreS {
    float s; const float* gate_b; int gate_c0;
    DI void operator()(const f32x4 (&acc)[2][2][4][2], const Unit& u, int wr, int wc, int fr, int fq) const {
        const bool gate = u.c0 >= gate_c0;
        const float L2E = 1.4426950408889634f;
#pragma unroll
        for (int bj = 0; bj < 2; ++bj) {
            f32x4 g0 = (f32x4){0.f, 0.f, 0.f, 0.f}, g1 = g0;
            if (gate) { const float* g = gate_b + (u.c0 - gate_c0) + bj * HALF + wc * 32 + 8 * fq; g0 = *(const f32x4*)g; g1 = *(const f32x4*)(g + 4); }
#pragma unroll
            for (int ai = 0; ai < 2; ++ai)
#pragma unroll
                for (int m = 0; m < 4; ++m) { char* rowp = u.c + ((size_t)(ai * HALF + wr * 64 + m * 16 + fr) * u.ldc + wc * 32 + 8 * fq) * 2;
                    f32x4 v0 = acc[ai][bj][m][0] * s, v1 = acc[ai][bj][m][1] * s;
                    if (gate) {
#pragma unroll
                        for (int i = 0; i < 4; ++i) { v0[i] = __builtin_amdgcn_exp2f(-L2E * __builtin_amdgcn_fmed3f(v0[i] + g0[i], -30.f, 30.f)); v1[i] = __builtin_amdgcn_exp2f(-L2E * __builtin_amdgcn_fmed3f(v1[i] + g1[i], -30.f, 30.f)); } }
                    *(u32x4*)(rowp + bj * 256) = pack8(v0, v1); }
        }
    }
};
struct EpiMerge {
    static constexpr bool MIDK = true;
    const char* U; const float* gate_b;
    DI void mid(f32x4 (&acc)[2][2][4][2], const Unit& u, int which, int wr, int wc, int fr, int fq) const {
#pragma unroll
        for (int bj = 0; bj < 2; ++bj)
#pragma unroll
            for (int ai = 0; ai < 2; ++ai) {
                u32x4 wa[4], wn[4];
#pragma unroll
                for (int m = 0; m < 4; ++m) { const int lr = ai * HALF + wr * 64 + m * 16 + fr;
                    const char* gp = U + ((size_t)(u.r0 + lr) * NU + UC_GATE + which * 1024 + u.c0 + wc * 32 + 8 * fq) * 2 + bj * 256;
                    wa[m] = *(const u32x4*)gp; wn[m] = *(const u32x4*)(gp + 2048); }
#pragma unroll
                for (int m = 0; m < 4; ++m) {
                    const u32x4 a = wa[m], n = wn[m];
                    const float ea[8] = {bflo(a.x), bfhi(a.x), bflo(a.y), bfhi(a.y), bflo(a.z), bfhi(a.z), bflo(a.w), bfhi(a.w)};
                    const float en[8] = {bflo(n.x), bfhi(n.x), bflo(n.y), bfhi(n.y), bflo(n.z), bfhi(n.z), bflo(n.w), bfhi(n.w)};
#pragma unroll
                    for (int i = 0; i < 8; ++i) acc[ai][bj][m][i >> 2][i & 3] *= (1.f + en[i]) * __builtin_amdgcn_rcpf(1.f + ea[i]); }
                asm volatile("" ::: "memory"); }
    }
    DI void operator()(const f32x4 (&acc)[2][2][4][2], const Unit& u, int wr, int wc, int fr, int fq) const {
#pragma unroll
        for (int bj = 0; bj < 2; ++bj) {
            u32x4 gw[2][4];
#pragma unroll
            for (int ai = 0; ai < 2; ++ai)
#pragma unroll
                for (int m = 0; m < 4; ++m) { const int lr = ai * HALF + wr * 64 + m * 16 + fr; gw[ai][m] = *(const u32x4*)(U + ((size_t)(u.r0 + lr) * NU + UC_GATE + 2048 + u.c0 + wc * 32 + 8 * fq) * 2 + bj * 256); }
#pragma unroll
            for (int ai = 0; ai < 2; ++ai)
#pragma unroll
                for (int m = 0; m < 4; ++m) { const int lr = ai * HALF + wr * 64 + m * 16 + fr; char* rowp = u.c + ((size_t)lr * u.ldc + wc * 32 + 8 * fq) * 2; const u32x4 w = gw[ai][m];
                    f32x4 v0 = acc[ai][bj][m][0], v1 = acc[ai][bj][m][1];
                    v0[0] *= __builtin_amdgcn_rcpf(1.f + bflo(w.x)); v0[1] *= __builtin_amdgcn_rcpf(1.f + bfhi(w.x)); v0[2] *= __builtin_amdgcn_rcpf(1.f + bflo(w.y)); v0[3] *= __builtin_amdgcn_rcpf(1.f + bfhi(w.y));
                    v1[0] *= __builtin_amdgcn_rcpf(1.f + bflo(w.z)); v1[1] *= __builtin_amdgcn_rcpf(1.f + bfhi(w.z)); v1[2] *= __builtin_amdgcn_rcpf(1.f + bflo(w.w)); v1[3] *= __builtin_amdgcn_rcpf(1.f + bfhi(w.w));
                    *(u32x4*)(rowp + bj * 256) = pack8(v0, v1); }
            asm volatile("" ::: "memory");
        }
    }
};
struct EpiWo {
    const char* X;
    DI void operator()(const f32x4 (&acc)[2][2][4][2], const Unit& u, int wr, int wc, int fr, int fq) const {
#pragma unroll
        for (int ai = 0; ai < 2; ++ai)
#pragma unroll
            for (int m = 0; m < 4; ++m) { const int lr = ai * HALF + wr * 64 + m * 16 + fr; char* rowp = u.c + ((size_t)lr * u.ldc + wc * 32 + 8 * fq) * 2;
                const char* xp = X + ((size_t)(u.r0 + lr) * D + u.c0 + wc * 32 + 8 * fq) * 2;
#pragma unroll
                for (int bj = 0; bj < 2; ++bj) { const u32x4 xw = *(const u32x4*)(xp + bj * 256);
                    f32x4 v0 = acc[ai][bj][m][0], v1 = acc[ai][bj][m][1];
                    v0[0] += DN_ALPHA * bflo(xw.x); v0[1] += DN_ALPHA * bfhi(xw.x); v0[2] += DN_ALPHA * bflo(xw.y); v0[3] += DN_ALPHA * bfhi(xw.y);
                    v1[0] += DN_ALPHA * bflo(xw.z); v1[1] += DN_ALPHA * bfhi(xw.z); v1[2] += DN_ALPHA * bflo(xw.w); v1[3] += DN_ALPHA * bfhi(xw.w);
                    *(u32x4*)(rowp + bj * 256) = pack8(v0, v1); }
                asm volatile("" ::: "memory"); }
    }
};
DI float swiglu1(float a, float b) { const float g = fminf(a, 7.f), l = fminf(fmaxf(b, -7.f), 7.f); return g * sigmoidf_(1.702f * g) * (l + 1.f); }
struct EpiMoe1 {
    const float* bgu;
    DI void operator()(const f32x4 (&acc)[2][2][4][2], const Unit& u, int wr, int wc, int fr, int fq) const {
        f32x4 bv[2][2];
#pragma unroll
        for (int bj = 0; bj < 2; ++bj) { const float* b = bgu + u.e * 2048 + u.c0 + bj * HALF + wc * 32 + 8 * fq; bv[bj][0] = *(const f32x4*)b; bv[bj][1] = *(const f32x4*)(b + 4); }
#pragma unroll
        for (int ai = 0; ai < 2; ++ai)
#pragma unroll
            for (int m = 0; m < 4; ++m) { const int lr = ai * HALF + wr * 64 + m * 16 + fr; char* rowp = u.c + ((size_t)lr * u.ldc + wc * 16 + 4 * fq);
#pragma unroll
                for (int bj = 0; bj < 2; ++bj) { const f32x4 v0 = acc[ai][bj][m][0] * F8_INV1 + bv[bj][0], v1 = acc[ai][bj][m][1] * F8_INV1 + bv[bj][1];
                    *(unsigned*)(rowp + bj * 64) = pk4_f8(swiglu1(v0[0], v0[1]) * F8_SH, swiglu1(v0[2], v0[3]) * F8_SH, swiglu1(v1[0], v1[1]) * F8_SH, swiglu1(v1[2], v1[3]) * F8_SH); } }
    }
};
struct EpiMoe2 {
    const float* bdn;
    DI void operator()(const f32x4 (&acc)[2][2][4][2], const Unit& u, int wr, int wc, int fr, int fq) const {
        f32x4 bv[2][2];
#pragma unroll
        for (int bj = 0; bj < 2; ++bj) { const float* b = bdn + u.e * 1024 + u.c0 + bj * HALF + wc * 32 + 8 * fq; bv[bj][0] = *(const f32x4*)b; bv[bj][1] = *(const f32x4*)(b + 4); }
#pragma unroll
        for (int ai = 0; ai < 2; ++ai)
#pragma unroll
            for (int m = 0; m < 4; ++m) { char* rowp = u.c + ((size_t)(ai * HALF + wr * 64 + m * 16 + fr) * u.ldc + wc * 32 + 8 * fq) * 2;
#pragma unroll
                for (int bj = 0; bj < 2; ++bj) *(u32x4*)(rowp + bj * 256) = pack8(acc[ai][bj][m][0] * F8_INV2 + bv[bj][0], acc[ai][bj][m][1] * F8_INV2 + bv[bj][1]); }
    }
};

typedef int i32x8 __attribute__((ext_vector_type(8)));
typedef int i32x4 __attribute__((ext_vector_type(4)));
template <bool F8, bool MIDK = false, class Epi, class Sched>
DI void gemm_phase(LAS unsigned char* lds, const int KB  , const int ldaB, const int ldbB, const Sched& S, const Epi& E, const int wave_) {
    unsigned z_ = 0u; asm volatile("" : "+v"(z_)); const int tid = wave_ * 64 + (int)__builtin_amdgcn_mbcnt_hi(~0u, __builtin_amdgcn_mbcnt_lo(~0u, z_));
    const int wid = __builtin_amdgcn_readfirstlane(tid >> 6), lane = tid & 63, wr = wid >> 2, wc = wid & 3, fr = lane & 15, fq = lane >> 4;
    const int nt = KB / (BK * 2);
    unsigned voffA[2], voffB[2];
#pragma unroll
    for (int i = 0; i < 2; ++i) { int R, C; stage_rc(tid * 16 + i * 8192, R, C); const int Rb = (R & ~31) + perm32(R & 31);
        voffA[i] = (unsigned)(R * ldaB + C * 2); voffB[i] = (unsigned)(Rb * ldbB + C * 2); }
    asm volatile("" : "+v"(voffA[0]), "+v"(voffA[1]), "+v"(voffB[0]), "+v"(voffB[1]));
    const size_t kstep = (size_t)(BK * 2);
    const size_t hstepA = (size_t)HALF * ldaB, hstepB = (size_t)HALF * ldbB;
    const unsigned ldsw = (unsigned)wid * 1024u;
    const int aoff = lds_byte(wr * 64 + fr, fq * 8), boff = lds_byte(wc * 32 + fr, fq * 8);
#define PG8_SA(b, h) (((b) * 2 + (h)) * HTB)
#define PG8_SB(b, h) ((4 + (b) * 2 + (h)) * HTB)
#define PG8_STAGE(bufoff, gbase, voff) do { _Pragma("unroll") for (int _i = 0; _i < 2; ++_i) \
        __builtin_amdgcn_global_load_lds((const unsigned*)((const char*)(gbase) + (voff)[_i]), (LAS unsigned*)(lds + (bufoff) + ldsw + _i * 8192), 16, 0, 0); } while (0)
#define PG8_LD8(p) __builtin_shufflevector(*(const LAS i32x4*)(p), *(const LAS i32x4*)((p) + 1024), 0, 1, 2, 3, 4, 5, 6, 7)
#define PG8_LDA8(dst, b, h) do { _Pragma("unroll") for (int m = 0; m < 4; ++m) dst[m] = PG8_LD8(lds + PG8_SA(b, h) + aoff + m * 2048); } while (0)
#define PG8_LDB8(dst, b, h) do { _Pragma("unroll") for (int n = 0; n < 2; ++n) dst[n] = PG8_LD8(lds + PG8_SB(b, h) + boff + n * 2048); } while (0)
#define PG8_MMA8(ai, bj, A8, B8) do { __builtin_amdgcn_s_setprio(1); _Pragma("unroll") for (int m = 0; m < 4; ++m) _Pragma("unroll") for (int n = 0; n < 2; ++n) \
        asm volatile("v_mfma_f32_16x16x128_f8f6f4 %0, %1, %2, %0" : "+v"(acc[ai][bj][m][n]) : "v"(B8[n]), "v"(A8[m])); __builtin_amdgcn_s_setprio(0); } while (0)
#define PG8_LDA(dst, b, h) do { _Pragma("unroll") for (int m = 0; m < 4; ++m) _Pragma("unroll") for (int k = 0; k < 2; ++k) dst[m][k] = *(const LAS bf16x8*)(lds + PG8_SA(b, h) + aoff + m * 2048 + k * 1024); } while (0)
#define PG8_LDB(dst, b, h) do { _Pragma("unroll") for (int n = 0; n < 2; ++n) _Pragma("unroll") for (int k = 0; k < 2; ++k) dst[n][k] = *(const LAS bf16x8*)(lds + PG8_SB(b, h) + boff + n * 2048 + k * 1024); } while (0)
#define PG8_CAT(x) __builtin_shufflevector(__builtin_bit_cast(i32x4, (x)[0]), __builtin_bit_cast(i32x4, (x)[1]), 0, 1, 2, 3, 4, 5, 6, 7)
#define PG8_MMA(ai, bj, At, Bt) do { __builtin_amdgcn_s_setprio(1); _Pragma("unroll") for (int m = 0; m < 4; ++m) _Pragma("unroll") for (int n = 0; n < 2; ++n) _Pragma("unroll") for (int k = 0; k < 2; ++k) \
        acc[ai][bj][m][n] = __builtin_amdgcn_mfma_f32_16x16x32_bf16(Bt[n][k], At[m][k], acc[ai][bj][m][n], 0, 0, 0); __builtin_amdgcn_s_setprio(0); } while (0)
#define PG8_WAIT_V(n) asm volatile("s_waitcnt vmcnt(" #n ")" ::: "memory")
#define PG8_WAIT_L(n) asm volatile("s_waitcnt lgkmcnt(" #n ")" ::: "memory")
#define PG8_BAR __builtin_amdgcn_s_barrier()
#define PG8_SCHED __builtin_amdgcn_sched_barrier(0)
    Unit cur, nxt; int ui = 0;
    if (!S.next(0, cur)) return;
    f32x4 acc[2][2][4][2];
#pragma unroll
    for (int a = 0; a < 2; ++a)
#pragma unroll
        for (int b = 0; b < 2; ++b)
#pragma unroll
            for (int m = 0; m < 4; ++m)
#pragma unroll
                for (int n = 0; n < 2; ++n) acc[a][b][m][n] = (f32x4){0.f, 0.f, 0.f, 0.f};
    bf16x8 At[4][2], B0[2][2], B1[2][2]; i32x8 A8[4], B80[2], B81[2];
    const char* cA = cur.a; const char* cB = cur.b;
    PG8_STAGE(PG8_SB(0, 0), cB, voffB); PG8_STAGE(PG8_SB(0, 1), cB + hstepB, voffB); PG8_STAGE(PG8_SA(0, 0), cA, voffA); PG8_STAGE(PG8_SA(0, 1), cA + hstepA, voffA);
    if (wr == 1) PG8_BAR;
    PG8_WAIT_V(2); PG8_BAR;
    PG8_STAGE(PG8_SB(1, 0), cB + kstep, voffB); PG8_STAGE(PG8_SA(1, 0), cA + kstep, voffA); PG8_STAGE(PG8_SB(1, 1), cB + hstepB + kstep, voffB);
    PG8_WAIT_V(6); PG8_BAR;
    for (;;) {
        const bool has_next = S.next(ui + 1, nxt);
        const char* nA = has_next ? nxt.a : cA; const char* nB = has_next ? nxt.b : cB;
#pragma unroll 1
        for (int t = 0; t < nt; t += 2) {
            if constexpr (MIDK) { if (t == 8 || t == 16) { int fr_ = fr, fq_ = fq; asm volatile("" : "+v"(fr_), "+v"(fq_)); E.mid(acc, cur, t >> 4, wr, wc, fr_, fq_); } }
            const bool last = (t == nt - 2);
            const char* a1 = cA + (size_t)(t + 1) * kstep;
            const char* a2 = last ? nA : cA + (size_t)(t + 2) * kstep; const char* b2 = last ? nB : cB + (size_t)(t + 2) * kstep;
            const char* a3 = a2 + kstep; const char* b3 = b2 + kstep;
            if constexpr (F8) {
            PG8_LDB8(B80, 0, 0); PG8_LDB8(B81, 0, 1); PG8_SCHED; PG8_LDA8(A8, 0, 0); PG8_STAGE(PG8_SA(1, 1), a1 + hstepA, voffA);
            PG8_WAIT_V(8); PG8_WAIT_L(0); PG8_BAR; PG8_MMA8(0, 0, A8, B80); PG8_MMA8(0, 1, A8, B81); PG8_BAR; PG8_SCHED;
            PG8_LDA8(A8, 0, 1); PG8_STAGE(PG8_SB(0, 0), b2, voffB); PG8_STAGE(PG8_SB(0, 1), b2 + hstepB, voffB); PG8_STAGE(PG8_SA(0, 0), a2, voffA);
            PG8_WAIT_V(8); PG8_WAIT_L(0); PG8_BAR; PG8_MMA8(1, 0, A8, B80); PG8_MMA8(1, 1, A8, B81); PG8_BAR; PG8_SCHED;
            PG8_LDB8(B80, 1, 0); PG8_LDB8(B81, 1, 1); PG8_SCHED; PG8_LDA8(A8, 1, 0); PG8_STAGE(PG8_SA(0, 1), a2 + hstepA, voffA);
            PG8_WAIT_V(8); PG8_WAIT_L(0); PG8_BAR; PG8_MMA8(0, 0, A8, B80); PG8_MMA8(0, 1, A8, B81); PG8_BAR; PG8_SCHED;
            PG8_LDA8(A8, 1, 1); PG8_STAGE(PG8_SB(1, 0), b3, voffB); PG8_STAGE(PG8_SB(1, 1), b3 + hstepB, voffB); PG8_STAGE(PG8_SA(1, 0), a3, voffA);
            PG8_WAIT_V(8); PG8_WAIT_L(0); PG8_BAR; PG8_MMA8(1, 0, A8, B80); PG8_MMA8(1, 1, A8, B81); PG8_BAR; PG8_SCHED;
            } else {
            PG8_LDB(B0, 0, 0); PG8_LDB(B1, 0, 1); PG8_SCHED; PG8_LDA(At, 0, 0); PG8_STAGE(PG8_SA(1, 1), a1 + hstepA, voffA);
            PG8_WAIT_V(8); PG8_WAIT_L(0); PG8_BAR; PG8_MMA(0, 0, At, B0); PG8_MMA(0, 1, At, B1); PG8_BAR; PG8_SCHED;
            PG8_LDA(At, 0, 1); PG8_STAGE(PG8_SB(0, 0), b2, voffB); PG8_STAGE(PG8_SB(0, 1), b2 + hstepB, voffB); PG8_STAGE(PG8_SA(0, 0), a2, voffA);
            PG8_WAIT_V(8); PG8_WAIT_L(0); PG8_BAR; PG8_MMA(1, 0, At, B0); PG8_MMA(1, 1, At, B1); PG8_BAR; PG8_SCHED;
            PG8_LDB(B0, 1, 0); PG8_LDB(B1, 1, 1); PG8_SCHED; PG8_LDA(At, 1, 0); PG8_STAGE(PG8_SA(0, 1), a2 + hstepA, voffA);
            PG8_WAIT_V(8); PG8_WAIT_L(0); PG8_BAR; PG8_MMA(0, 0, At, B0); PG8_MMA(0, 1, At, B1); PG8_BAR; PG8_SCHED;
            PG8_LDA(At, 1, 1); PG8_STAGE(PG8_SB(1, 0), b3, voffB); PG8_STAGE(PG8_SB(1, 1), b3 + hstepB, voffB); PG8_STAGE(PG8_SA(1, 0), a3, voffA);
            PG8_WAIT_V(8); PG8_WAIT_L(0); PG8_BAR; PG8_MMA(1, 0, At, B0); PG8_MMA(1, 1, At, B1); PG8_BAR; PG8_SCHED;
            }
        }
        if (wr == 0) PG8_BAR;
        if constexpr (F8) asm volatile("s_nop 15\n\ts_nop 15" ::: "memory");
        { int fr_ = fr, fq_ = fq; asm volatile("" : "+v"(fr_), "+v"(fq_));
          E(acc, cur, wr, wc, fr_, fq_); }
        if (!has_next) break;
#pragma unroll
        for (int a = 0; a < 2; ++a)
#pragma unroll
            for (int b = 0; b < 2; ++b)
#pragma unroll
                for (int m = 0; m < 4; ++m)
#pragma unroll
                    for (int n = 0; n < 2; ++n) acc[a][b][m][n] = (f32x4){0.f, 0.f, 0.f, 0.f};
        cur = nxt; cA = nA; cB = nB; ++ui;
        if (wr == 1) PG8_BAR;
    }
    PG8_WAIT_V(0);
    PG8_BAR;
#undef PG8_SA
#undef PG8_SB
#undef PG8_STAGE
#undef PG8_LDA
#undef PG8_LDB
#undef PG8_MMA
#undef PG8_CAT
#undef PG8_LD8
#undef PG8_LDA8
#undef PG8_LDB8
#undef PG8_MMA8
#undef PG8_WAIT_V
#undef PG8_WAIT_L
#undef PG8_BAR
#undef PG8_SCHED
}
}

#define XB_TMO      128
#define XB_XCNT(j)  (256  + 64 * (j))
#define XB_XSUB(j)  (1280 + 64 * (j))
#define XB_XGEN(j)  (2304 + 64 * (j))
#define XB_TOP      3328
#define XB_TOPGEN   3392
#define XCD_BAR_WORDS 3456
#define XB_SPIN_CAP (1u << 22)
DI unsigned xb_ld(unsigned* p)              { return __hip_atomic_load(p, __ATOMIC_RELAXED, __HIP_MEMORY_SCOPE_AGENT); }
DI unsigned xb_add(unsigned* p, unsigned v) { return __hip_atomic_fetch_add(p, v, __ATOMIC_RELAXED, __HIP_MEMORY_SCOPE_AGENT); }
DI unsigned xb_xcc_id() { return (unsigned)__builtin_amdgcn_s_getreg((3 << 11) | 20) & 0xFu; }
#define XB_SPIN(cond, bar) do { unsigned _sp = 0; while (cond) { __builtin_amdgcn_s_sleep(1); \
    if ((++_sp & 255u) == 0u) { if (xb_ld(&(bar)[XB_TMO])) break; if (_sp > XB_SPIN_CAP) { atomicAdd(&(bar)[XB_TMO], 1u); break; } } } } while (0)
struct XcdBarrier { unsigned* bar; unsigned x; volatile LAS unsigned* st; };
DI XcdBarrier xcd_barrier_post(unsigned* bar, volatile LAS unsigned* st) {
    XcdBarrier b; b.bar = bar; b.x = xb_xcc_id(); b.st = st;
    if (threadIdx.x == 0) (void)xb_add(&bar[XB_XCNT(b.x)], 1u);
    return b;
}
DI void xcd_barrier_complete(unsigned* bar, unsigned x, unsigned& nloc, unsigned& nx) {
    const unsigned G = gridDim.x * gridDim.y * gridDim.z;
    unsigned sum, cnt, mine, sp = 0u;
    for (;;) {
        sum = 0u; cnt = 0u; mine = 0u;
#pragma unroll
        for (unsigned j = 0; j < 16; ++j) { const unsigned c = xb_ld(&bar[XB_XCNT(j)]); sum += c; cnt += (c > 0u) ? 1u : 0u; mine = (j == x) ? c : mine; }
        if (sum == G) break;
        __builtin_amdgcn_s_sleep(1);
        if ((++sp & 255u) == 0u) { if (xb_ld(&bar[XB_TMO])) break; if (sp > XB_SPIN_CAP) { atomicAdd(&bar[XB_TMO], 1u); break; } }
    }
    nloc = mine > 0u ? mine : 1u; nx = cnt > 0u ? cnt : 1u;
}
DI void xcd_barrier(const XcdBarrier& b) {
    asm volatile("s_waitcnt vmcnt(0)" ::: "memory");
    __syncthreads();
    if (threadIdx.x == 0) {
        unsigned* bar = b.bar;
        __builtin_amdgcn_s_waitcnt(0);
        unsigned nloc = b.st[0], nx = b.st[1];
        if (nloc == 0u) { xcd_barrier_complete(bar, b.x, nloc, nx); b.st[0] = nloc; b.st[1] = nx; }
        const unsigned old = xb_add(&bar[XB_XSUB(b.x)], 1u);
        const unsigned gen = old / nloc;
        if (old + 1u == (gen + 1u) * nloc) {
            __builtin_amdgcn_fence(__ATOMIC_RELEASE, "agent");
            asm volatile("s_waitcnt vmcnt(0)" ::: "memory");
            const unsigned og = xb_add(&bar[XB_TOP], 1u);
            const unsigned tg = og / nx;
            if (og + 1u == (tg + 1u) * nx) xb_add(&bar[XB_TOPGEN], 1u);
            else XB_SPIN(xb_ld(&bar[XB_TOPGEN]) == tg, bar);
            __builtin_amdgcn_fence(__ATOMIC_ACQUIRE, "agent");
            xb_add(&bar[XB_XGEN(b.x)], 1u);
            asm volatile("s_waitcnt vmcnt(0)" ::: "memory");
        } else {
            XB_SPIN(xb_ld(&bar[XB_XGEN(b.x)]) == gen, bar);
            __builtin_amdgcn_fence(__ATOMIC_ACQUIRE, "agent");
            asm volatile("s_waitcnt vmcnt(0)" ::: "memory");
        }
    }
    __syncthreads();
}

DI void transpose_item(const float* W, int ldw, bf16* WT, int ldt, LAS float* scr, int lane) {
    { const int kr = lane >> 3, c4 = (lane & 7) * 4; f32x4 v[8];
#pragma unroll
        for (int i = 0; i < 8; ++i) v[i] = *(const f32x4*)(W + (size_t)(8 * i + kr) * ldw + c4);
#pragma unroll
        for (int i = 0; i < 8; ++i) { LAS float* o = scr + (8 * i + kr) * 33 + c4; o[0] = v[i].x; o[1] = v[i].y; o[2] = v[i].z; o[3] = v[i].w; } }
    LDS_WAIT(); asm volatile("" ::: "memory");
    const int c = lane & 7;
#pragma unroll
    for (int j = 0; j < 4; ++j) { const int n = (lane >> 3) + 8 * j; const LAS float* s = scr + (8 * c) * 33 + n;
        u32x4 o; o.x = pk2(s[0 * 33], s[1 * 33]); o.y = pk2(s[2 * 33], s[3 * 33]); o.z = pk2(s[4 * 33], s[5 * 33]); o.w = pk2(s[6 * 33], s[7 * 33]);
        *(u32x4*)(WT + (size_t)n * ldt + 8 * c) = o; }
    LDS_WAIT(); asm volatile("" ::: "memory");
}
DI void transpose_item_f8(const float* W, int ldw, unsigned char* WT, int ldt, float scale, LAS float* scr, int lane) {
    { const int kr = lane >> 3, c4 = (lane & 7) * 4; f32x4 v[8];
#pragma unroll
        for (int i = 0; i < 8; ++i) v[i] = *(const f32x4*)(W + (size_t)(8 * i + kr) * ldw + c4);
#pragma unroll
        for (int i = 0; i < 8; ++i) { LAS float* o = scr + (8 * i + kr) * 33 + c4; o[0] = v[i].x; o[1] = v[i].y; o[2] = v[i].z; o[3] = v[i].w; } }
    LDS_WAIT(); asm volatile("" ::: "memory");
    const int c = lane & 3;
#pragma unroll
    for (int j = 0; j < 2; ++j) { const int n = (lane >> 2) + 16 * j; const LAS float* s = scr + (16 * c) * 33 + n;
        u32x4 o; o.x = pk4_f8(s[0 * 33] * scale, s[1 * 33] * scale, s[2 * 33] * scale, s[3 * 33] * scale); o.y = pk4_f8(s[4 * 33] * scale, s[5 * 33] * scale, s[6 * 33] * scale, s[7 * 33] * scale);
        o.z = pk4_f8(s[8 * 33] * scale, s[9 * 33] * scale, s[10 * 33] * scale, s[11 * 33] * scale); o.w = pk4_f8(s[12 * 33] * scale, s[13 * 33] * scale, s[14 * 33] * scale, s[15 * 33] * scale);
        *(u32x4*)(WT + (size_t)n * ldt + 16 * c) = o; }
    LDS_WAIT(); asm volatile("" ::: "memory");
}
DI void ln16(f32x4 (&v)[4], const f32x4 (&g)[4], const f32x4 (&b)[4]) {
    float s = 0.f;
#pragma unroll
    for (int j = 0; j < 4; ++j) s += (v[j].x + v[j].y) + (v[j].z + v[j].w);
    const float mean = wave_sum(s) * (1.f / D); float s2 = 0.f;
#pragma unroll
    for (int j = 0; j < 4; ++j) { v[j] = v[j] - mean; s2 += (v[j].x * v[j].x + v[j].y * v[j].y) + (v[j].z * v[j].z + v[j].w * v[j].w); }
    const float rstd = 1.f / sqrtf(wave_sum(s2) * (1.f / D) + LN_EPS);
#pragma unroll
    for (int j = 0; j < 4; ++j) v[j] = v[j] * rstd * g[j] + b[j];
}
DI void gates8(const f32x4 (&y)[4], const LAS float* wgt, float* gif_row, int lane) {
    float p[8];
#pragma unroll
    for (int j = 0; j < 8; ++j) { float s = 0.f;
#pragma unroll
        for (int jj = 0; jj < 4; ++jj) { const f32x4 w = *(const LAS f32x4*)(wgt + j * 1024 + 256 * jj + 4 * lane); s += (y[jj].x * w.x + y[jj].y * w.y) + (y[jj].z * w.z + y[jj].w * w.w); }
        p[j] = wave_sum(s); }
    if (lane == 0) { *(f32x4*)gif_row = (f32x4){p[0], p[1], p[2], p[3]}; *(f32x4*)(gif_row + 4) = (f32x4){p[4], p[5], p[6], p[7]}; }
}
DI void gates8b(const f32x4 (&y)[4], const LAS float* wgt, float* gif_row, int lane) {
    float p[8];
#pragma unroll
    for (int j = 0; j < 8; ++j) { float s = 0.f;
#pragma unroll
        for (int jj = 0; jj < 4; ++jj) { const f32x4 w = *(const LAS f32x4*)(wgt + j * 1024 + (jj >> 1) * 512 + 8 * lane + (jj & 1) * 4); s += (y[jj].x * w.x + y[jj].y * w.y) + (y[jj].z * w.z + y[jj].w * w.w); }
        p[j] = wave_sum(s); }
    if (lane == 0) { *(f32x4*)gif_row = (f32x4){p[0], p[1], p[2], p[3]}; *(f32x4*)(gif_row + 4) = (f32x4){p[4], p[5], p[6], p[7]}; }
}
DI void load_gate_table(LAS float* wgt, const float* win_l, int tid) {
    for (int i = tid; i < 8192; i += NTHR) { const int k = i >> 3, j = i & 7; wgt[j * 1024 + k] = win_l[(size_t)k * DIN + 1536 + j]; }
}
DI f32x4 ld4bf(const char* p) { const u32x2 w = *(const u32x2*)p; return (f32x4){bflo(w.x), bfhi(w.x), bflo(w.y), bfhi(w.y)}; }
DI void st4bf(char* p, const f32x4& v) { u32x2 w; w.x = pk2(v.x, v.y); w.y = pk2(v.z, v.w); *(u32x2*)p = w; }

struct Args { const float* in[N_IN]; float* out; unsigned char* ws; int ph_lo, ph_hi; };
constexpr int NP_LAYER = 12, NPH = 1 + DEPTH * NP_LAYER;
constexpr int XW_SPLIT = 49152;

struct SchedInproj {
    pg8::TileOrder T; int G, c; const char *X, *W; char* U; bool kv; const char *MEMN, *WKV; char* KV;
    DI bool next(int i, pg8::Unit& u) const {
        const long L = (long)i * G + c; int pm, pn;
        if (T.tile(L, pm, pn)) { u.a = X + (size_t)pm * 256 * D * 2; u.b = W + (size_t)pn * 256 * D * 2; u.r0 = pm * 256; u.c0 = pn * 256; u.c = U + ((size_t)u.r0 * NU + u.c0) * 2; u.ldc = NU; u.e = 0; u.sub = 0; return true; }
        if (!kv) return false;
        const long L2 = L - T.nwg; if (L2 < 0 || L2 >= 128) return false;
        const int l = (int)L2 >> 6, t = (int)L2 & 63; pm = t >> 2; pn = t & 3;
        u.a = MEMN + (size_t)pm * 256 * D * 2; u.b = WKV + ((size_t)l * 1024 + pn * 256) * D * 2; u.r0 = pm * 256; u.c0 = pn * 256; u.c = KV + (((size_t)l * MROWS + u.r0) * D + u.c0) * 2; u.ldc = D; u.e = 0; u.sub = 0; return true;
    }
};
struct SchedPlain {
    pg8::TileOrder T; int G, c; const char *A, *B; char* C; int lda, ldb, ldc;
    DI bool next(int i, pg8::Unit& u) const {
        const long L = (long)i * G + c; int pm, pn; if (!T.tile(L, pm, pn)) return false;
        u.a = A + (size_t)pm * 256 * lda * 2; u.b = B + (size_t)pn * 256 * ldb * 2; u.r0 = pm * 256; u.c0 = pn * 256; u.c = C + ((size_t)u.r0 * ldc + u.c0) * 2; u.ldc = ldc; u.e = 0; u.sub = 0; return true;
    }
};
struct SchedMerge {
    pg8::TileOrder T; int G, c; const char *H, *W; char* Y;
    DI bool next(int i, pg8::Unit& u) const {
        const int ti = i / 3, br = i - 3 * ti; const long L = (long)ti * G + c; int pm, pn; if (!T.tile(L, pm, pn)) return false;
        u.a = H + ((size_t)pm * 256 * 1536 + br * 512) * 2; u.b = W + ((size_t)br * 1024 + pn * 256) * 512 * 2; u.r0 = pm * 256; u.c0 = pn * 256; u.c = Y + ((size_t)u.r0 * D + u.c0) * 2; u.ldc = D; u.e = 0; u.sub = br; return true;
    }
};
struct SchedMoe {
    pg8::TileOrder T; int G, c; const char *A, *W; char* C; const LAS int* PB; int wrows  , ldc, cdiv, osz;
    DI bool next(int i, pg8::Unit& u) const {
        const long L = (long)i * G + c; int pm, pn; if (!T.tile(L, pm, pn)) return false;
        int e = 0;
#pragma unroll 1
        for (int j = 1; j < NEXP; ++j) e += (PB[j] <= pm) ? 1 : 0;
        u.a = A + (size_t)pm * 256 * 1024; u.b = W + ((size_t)e * wrows + pn * 256) * 1024; u.r0 = pm * 256; u.c0 = pn * 256; u.c = C + ((size_t)u.r0 * ldc + u.c0 / cdiv) * osz; u.ldc = ldc; u.e = e; u.sub = 0; return true;
    }
};

__global__ void __launch_bounds__(NTHR, 2) fwd_kernel(Args args) {
    extern __shared__ __attribute__((aligned(16))) unsigned char lds_raw[];
#define INP(i) ([&]() -> const float* { int ii_ = (i); asm volatile("" : "+s"(ii_)); return args.in[ii_]; }())
    LAS unsigned char* lds = (LAS unsigned char*)lds_raw;
    volatile LAS unsigned* LCTL = (volatile LAS unsigned*)(lds + LDSCTL_OFF);
    const int tid0 = threadIdx.x, wave = __builtin_amdgcn_readfirstlane(tid0 >> 6);
#define PHASE_TID unsigned z_ = 0u; asm volatile("" : "+v"(z_)); int tid = wave * 64 + (int)__builtin_amdgcn_mbcnt_hi(~0u, __builtin_amdgcn_mbcnt_lo(~0u, z_)); const int lane = tid & 63; (void)lane;
    const int G = gridDim.x, bx = blockIdx.x;
    const int gw = bx * NWAVES + wave, NGW = G * NWAVES;
    unsigned char* ws = args.ws;
    gu32* ctl = (gu32*)(ws + WS_CTL);
    for (int u = tid0; u < (LDS_BYTES - LDSCTL_OFF) / 4; u += NTHR) ((LAS unsigned*)(lds + LDSCTL_OFF))[u] = 0u;
    __syncthreads();
    XcdBarrier bar; bar.bar = (unsigned*)ctl + CW_BAR; bar.x = 0; bar.st = nullptr;
    if (MK_ONE_LAUNCH) bar = xcd_barrier_post((unsigned*)ctl + CW_BAR, LCTL);
    const int lo = args.ph_lo, hi = args.ph_hi;
#ifndef SUBMASK
#define SUBMASK 7
#endif
#ifndef LN2PROBE
#define LN2PROBE 0
#endif
#ifndef SUBDUP
#define SUBDUP 0
#endif
#define NSUB(k) ((((SUBDUP) >> (k)) & 1) ? 2 : 1)
#ifndef DUPMASK
#define DUPMASK 0
#endif
#define NREP(k) ((((DUPMASK) >> (k)) & 1) ? 2 : 1)
#ifndef PHMASK
#define PHMASK 0xFFFF
#endif
#define IN(k) (lo <= (k) && (k) < hi)
#define SEAM(k) do { if (IN(k) && IN((k) + 1)) xcd_barrier(bar); } while (0)

    char* const Xb = (char*)(ws + WS_X);
    char* const Ub = (char*)(ws + WS_R1);
    float* const GIF = (float*)(ws + WS_GIF);
    LAS int* const PB = (LAS int*)(lds + LDSCTL_OFF + 64);
    LAS int* const CNT = (LAS int*)(lds + LDSCTL_OFF + 256);

    _Pragma("unroll 1") for (int rep_ = 0; rep_ < NREP(12); ++rep_) if (((PHMASK>>12)&1) && IN(0)) { PHASE_TID
        LAS float* scr = (LAS float*)(lds + wave * 8448);
        LAS float* wgt = (LAS float*)(lds + 73728);
        load_gate_table(wgt, INP(I_WIN), tid);
        constexpr int IT_IN = 16 * 216, IT_KV = 16 * 32, IT_BR = 8 * 32, IT_O = 16 * 32, IT_L = IT_IN + IT_KV + 3 * IT_BR + IT_O;
        for (int it = gw; it < DEPTH * IT_L; it += NGW) {
            const int l = it / IT_L; int r = it - l * IT_L;
            if (r < IT_IN) { const int kb = r / 216, nb = r % 216, n0 = 32 * nb, sc = ucol_src(n0);
                if (n0 < UC_F8) transpose_item(INP(I_WIN) + ((size_t)l * D + 64 * kb) * DIN + sc, DIN, (bf16*)(ws + WS_WIN) + ((size_t)l * NU + n0) * D + 64 * kb, D, scr, lane);
                else transpose_item_f8(INP(I_WIN) + ((size_t)l * D + 64 * kb) * DIN + sc, DIN, (unsigned char*)(ws + WS_WING8) + ((size_t)l * NF8 + (n0 - UC_F8)) * D + 64 * kb, D, F8_SWGU, scr, lane);
                continue; }
            r -= IT_IN;
            if (r < IT_KV) { const int kb = r / 32, nb = r % 32;
                transpose_item(INP(I_CAWKV) + ((size_t)l * D + 64 * kb) * 1024 + 32 * nb, 1024, (bf16*)(ws + WS_WKV) + ((size_t)l * 1024 + 32 * nb) * D + 64 * kb, D, scr, lane); continue; }
            r -= IT_KV;
            if (r < 3 * IT_BR) { const int br = r / IT_BR, q = r % IT_BR, kb = q / 32, nb = q % 32;
                const float* src = INP(br == 0 ? I_WBRML : (br == 1 ? I_WBRRW : I_WBRCA));
                transpose_item(src + ((size_t)l * 512 + 64 * kb) * 1024 + 32 * nb, 1024, (bf16*)(ws + WS_WBR) + ((size_t)l * 1024 + 32 * nb) * 1536 + br * 512 + 64 * kb, 1536, scr, lane); continue; }
            r -= 3 * IT_BR;
            { const int kb = r / 32, nb = r % 32;
                transpose_item(INP(I_WO) + ((size_t)l * D + 64 * kb) * 1024 + 32 * nb, 1024, (bf16*)(ws + WS_WO) + ((size_t)l * 1024 + 32 * nb) * D + 64 * kb, D, scr, lane); }
        }
        for (int i = bx * NTHR + tid; i < DEPTH * 1536 * 256; i += G * NTHR) {
            const int l = i / (1536 * 256), r = i % (1536 * 256), n = r >> 8, k = r & 255; float v = 0.f;
            if (n < 512) { if (k < 64) v = INP(I_RWWUP)[((size_t)l * 64 + k) * 512 + n]; }
            else if (n < 1024) { if (k >= 64 && k < 128) v = INP(I_RWAUP)[((size_t)l * 64 + (k - 64)) * 512 + (n - 512)]; }
            else { if (k >= 128) v = INP(I_RWGUP)[((size_t)l * 128 + (k - 128)) * 512 + (n - 1024)]; }
            ((bf16*)(ws + WS_WLORA))[i] = (bf16)f2bf(v);
        }
        __syncthreads();
        {
            f32x4 g[4], b[4];
#pragma unroll
            for (int j = 0; j < 4; ++j) { g[j] = *(const f32x4*)(INP(I_LNIN_G) + 256 * j + 4 * lane); b[j] = *(const f32x4*)(INP(I_LNIN_B) + 256 * j + 4 * lane); }
            for (int m = gw; m < M; m += NGW) {
                f32x4 v[4]; const float* xr = INP(I_X) + (size_t)m * D;
#pragma unroll
                for (int j = 0; j < 4; ++j) v[j] = *(const f32x4*)(xr + 256 * j + 4 * lane);
                ln16(v, g, b);
#pragma unroll
                for (int j = 0; j < 4; ++j) { st4bf(Xb + ((size_t)m * D + 256 * j + 4 * lane) * 2, v[j]); *(unsigned*)((char*)(ws + WS_XF8) + (size_t)m * D + 256 * j + 4 * lane) = pk4_f8(v[j].x * F8_SX, v[j].y * F8_SX, v[j].z * F8_SX, v[j].w * F8_SX); }
                gates8(v, wgt, GIF + (size_t)m * 8, lane);
            }
#pragma unroll
            for (int j = 0; j < 4; ++j) { g[j] = *(const f32x4*)(INP(I_MEMLN_G) + 256 * j + 4 * lane); b[j] = *(const f32x4*)(INP(I_MEMLN_B) + 256 * j + 4 * lane); }
            for (int m = gw; m < MROWS; m += NGW) {
                f32x4 v[4]; const float* xr = INP(I_MEM) + (size_t)m * D;
#pragma unroll
                for (int j = 0; j < 4; ++j) v[j] = *(const f32x4*)(xr + 256 * j + 4 * lane);
                ln16(v, g, b);
#pragma unroll
                for (int j = 0; j < 4; ++j) st4bf((char*)(ws + WS_MEMN) + ((size_t)m * D + 256 * j + 4 * lane) * 2, v[j]);
            }
        }
        __syncthreads();
    }
    SEAM(0);

#pragma unroll 1
    for (int l = 0; l < DEPTH; ++l) {
        const int pb = 1 + l * NP_LAYER;
        _Pragma("unroll 1") for (int rep_ = 0; rep_ < NREP(0); ++rep_) if (((PHMASK>>0)&1) && IN(pb + 0)) {
            SchedInproj S; S.T.init(M / 256, UC_F8 / 256); S.G = G; S.c = bx; S.X = Xb; S.W = (const char*)(ws + WS_WIN) + (size_t)l * NU * D * 2; S.U = Ub;
            S.kv = (l == 0); S.MEMN = (const char*)(ws + WS_MEMN); S.WKV = (const char*)(ws + WS_WKV); S.KV = (char*)(ws + WS_KV);
            pg8::EpiStore E;
            pg8::gemm_phase<false>(lds, D * 2, D * 2, D * 2, S, E, wave);
            SchedPlain S8; S8.T.init(M / 256, NF8 / 256); S8.G = G; S8.c = bx; S8.A = (const char*)(ws + WS_XF8); S8.B = (const char*)(ws + WS_WING8) + (size_t)l * NF8 * D; S8.C = Ub + UC_F8 * 2;
            S8.lda = 512; S8.ldb = 512; S8.ldc = NU;
            pg8::EpiStoreS E8; E8.s = F8_INV1; E8.gate_b = INP(I_GATEB) + (size_t)l * 3072; E8.gate_c0 = UC_GATE - UC_F8;
            pg8::gemm_phase<true>(lds, D, D, D, S8, E8, wave);
        }
        SEAM(pb + 0);
        _Pragma("unroll 1") for (int rep_ = 0; rep_ < NREP(1); ++rep_) if (((PHMASK>>1)&1) && IN(pb + 1)) { PHASE_TID
            const float* mu = INP(I_RWMU) + (size_t)l * 1792 + 1536;
            char* LIN = (char*)(ws + WS_R2 + R2_LORA_IN);
            for (int it = bx * NTHR + tid; it < M * 32; it += G * NTHR) {
                const int row = it >> 5, c = (it & 31) * 8;
                const u32x4 cw = *(const u32x4*)(Ub + ((size_t)row * NU + UC_RW + 1536 + c) * 2);
                u32x4 pw = (u32x4){0u, 0u, 0u, 0u};
                if ((row & (SEQ - 1)) != 0) pw = *(const u32x4*)(Ub + ((size_t)(row - 1) * NU + UC_RW + 1536 + c) * 2);
                const f32x4 m0 = *(const f32x4*)(mu + c), m1 = *(const f32x4*)(mu + c + 4);
                float x[8] = {bflo(cw.x), bfhi(cw.x), bflo(cw.y), bfhi(cw.y), bflo(cw.z), bfhi(cw.z), bflo(cw.w), bfhi(cw.w)};
                const float p[8] = {bflo(pw.x), bfhi(pw.x), bflo(pw.y), bfhi(pw.y), bflo(pw.z), bfhi(pw.z), bflo(pw.w), bfhi(pw.w)};
                const float mm[8] = {m0.x, m0.y, m0.z, m0.w, m1.x, m1.y, m1.z, m1.w};
#pragma unroll
                for (int i = 0; i < 8; ++i) { float xs = x[i] + (p[i] - x[i]) * mm[i];
                    if (c < 64) xs = 1.f - 2.f * __builtin_amdgcn_rcpf(1.f + __builtin_amdgcn_exp2f(2.8853900817779268f * xs));
                    else if (c >= 128) xs = sigmoidf_(xs);
                    x[i] = xs; }
                u32x4 o; o.x = pk2(x[0], x[1]); o.y = pk2(x[2], x[3]); o.z = pk2(x[4], x[5]); o.w = pk2(x[6], x[7]);
                *(u32x4*)(LIN + ((size_t)row * 256 + c) * 2) = o;
            }
        }
        SEAM(pb + 1);
        _Pragma("unroll 1") for (int rep_ = 0; rep_ < NREP(2); ++rep_) if (((PHMASK>>2)&1) && IN(pb + 2)) {
            SchedPlain S; S.T.init(M / 256, 6); S.G = G; S.c = bx; S.A = (const char*)(ws + WS_R2 + R2_LORA_IN); S.B = (const char*)(ws + WS_WLORA) + (size_t)l * 1536 * 256 * 2; S.C = (char*)(ws + WS_R2 + R2_LORA_OUT);
            S.lda = 256; S.ldb = 256; S.ldc = 1536;
            pg8::EpiStore E;
            pg8::gemm_phase<false>(lds, 512, 512, 512, S, E, wave);
        }
        SEAM(pb + 2);
        _Pragma("unroll 1") for (int rep_ = 0; rep_ < NREP(3); ++rep_) if (((PHMASK>>3)&1) && IN(pb + 3)) { PHASE_TID
            const char* LO = (const char*)(ws + WS_R2 + R2_LORA_OUT);
            char* HC = (char*)(ws + WS_R2 + R2_HCAT);
            const int tid_ph = tid;
#define SUB_TID unsigned zs_ = 0u; asm volatile("" : "+v"(zs_)); int tid = wave * 64 + (int)__builtin_amdgcn_mbcnt_hi(~0u, __builtin_amdgcn_mbcnt_lo(~0u, zs_)); const int lane = tid & 63; (void)lane;
#pragma unroll 1
            for (int job = bx; job < 256; job += G) {
                if (job < 128) { _Pragma("unroll 1") for (int sr_ = 0; sr_ < NSUB(0); ++sr_) if ((SUBMASK>>0)&1) {
                    SUB_TID
                    const int b = job >> 3, h = job & 7;
                    constexpr int TC = 32, PT = 144, P16 = 48, IMG = 25856;
                    LAS float* OPS = (LAS float*)lds;
                    LAS float* OUTB = OPS + TC * 384;
                    LAS float* BON = OUTB + TC * 64;
                    LAS unsigned char* IM0 = lds + 57600;
                    LAS float* VEP = (LAS float*)(lds + 109312);
                    LAS unsigned char* GKB = (LAS unsigned char*)(VEP + 2 * TC * 64);
                    LAS float* PARF = (LAS float*)(lds + 142080);
                    const int pt = tid >> 4, cs = tid & 15, pc = cs * 4, hc = h * 64 + pc;
                    const int p1t = (tid >> 3) & 31, c8 = (tid & 7) * 8, hc8 = h * 64 + c8;
                    const int r31 = lane & 31, h2 = lane >> 5;
                    f32x16 Sreg[2];
#pragma unroll
                    for (int i = 0; i < 16; ++i) { Sreg[0][i] = 0.f; Sreg[1][i] = 0.f; }
#pragma unroll 1
                    for (int a = wave; a < 10; a += 8) {
                        const int ii = (a < 3) ? I_RWMU : (a == 3) ? I_RWW0 : (a == 4) ? I_RWA0 : (a == 5) ? I_RWKK : (a == 6) ? I_RWKA : (a == 7) ? I_RWRK : (a == 8) ? I_RWLNG : I_RWLNB;
                        const size_t po = (a < 3) ? ((size_t)l * 1792 + a * 512) : (size_t)l * 512;
                        PARF[a * 64 + lane] = (INP(ii) + po)[h * 64 + lane];
                    }
#define SETPU(j, q_) do { const u32x4 q__ = (q_); Sreg[(j) >> 2][((j) & 3) * 4] = u2f_(q__.x); Sreg[(j) >> 2][((j) & 3) * 4 + 1] = u2f_(q__.y); \
                          Sreg[(j) >> 2][((j) & 3) * 4 + 2] = u2f_(q__.z); Sreg[(j) >> 2][((j) & 3) * 4 + 3] = u2f_(q__.w); } while (0)
#define PUW(j, c) f2u_(Pc[(j) >> 2][((j) & 3) * 4 + (c)])
#define PUWS(j, c) f2u_(Sreg[(j) >> 2][((j) & 3) * 4 + (c)])
#define UNPJ(j, hh) ((f32x4){bflo(PUW(j, 2 * (hh))), bfhi(PUW(j, 2 * (hh))), bflo(PUW(j, 2 * (hh) + 1)), bfhi(PUW(j, 2 * (hh) + 1))})
#define UNPH(q_, hh) ((hh) ? (f32x4){bflo((q_).z), bfhi((q_).z), bflo((q_).w), bfhi((q_).w)} : (f32x4){bflo((q_).x), bfhi((q_).x), bflo((q_).y), bfhi((q_).y)})
                    auto LOADC = [&](int t0) {
                        const int t = t0 + p1t; const size_t row = (size_t)b * SEQ + t; const char* up = Ub + (row * NU + UC_RW + hc8) * 2;
                        SETPU(0, *(const u32x4*)up); SETPU(1, *(const u32x4*)(up + 1024)); SETPU(2, *(const u32x4*)(up + 2048));
                        if (t > 0) { const char* pp = up - (size_t)NU * 2; SETPU(3, *(const u32x4*)pp); SETPU(4, *(const u32x4*)(pp + 1024)); SETPU(5, *(const u32x4*)(pp + 2048)); }
                        else { const u32x4 z4 = (u32x4){0u, 0u, 0u, 0u}; SETPU(3, z4); SETPU(4, z4); SETPU(5, z4); }
                        const char* lp = LO + (row * 1536 + hc8) * 2; SETPU(6, *(const u32x4*)lp); SETPU(7, *(const u32x4*)(lp + 1024));
                    };
                    const int gq = tid - 128, gt = (gq >> 2) & 31, gp = (gq & 3) * 16;
                    auto LOADG = [&](int t0) {
                        const char* gp_ = LO + (((size_t)b * SEQ + t0 + gt) * 1536 + 1024 + h * 64 + gp) * 2;
                        SETPU(0, *(const u32x4*)gp_); SETPU(1, *(const u32x4*)(gp_ + 16));
                    };
                    auto PASS1 = [&](int t1, int par1, bool more) {
                        int hcv = hc8; asm volatile("" : "+v"(hcv));
                        const f32x16 Pc[2] = {Sreg[0], Sreg[1]};
                        if (more) LOADC(t1 + TC);
                        const LAS float* MU = PARF + c8;
                        const LAS float* W0 = PARF + 192 + c8; const LAS float* A0 = PARF + 256 + c8; const LAS float* KKW = PARF + 320 + c8;
                        const LAS float* KAW = PARF + 384 + c8; const LAS float* RKW = PARF + 448 + c8;
                        f32x4 dec[2], av[2], kkv[2], kp[2], xr[2], xv[2]; float ss = 0.f, bsum = 0.f;
#pragma unroll
                        for (int hh = 0; hh < 2; ++hh) {
                            const f32x4 mu_r = *(const LAS f32x4*)(MU + 4 * hh), mu_k = *(const LAS f32x4*)(MU + 64 + 4 * hh), mu_v = *(const LAS f32x4*)(MU + 128 + 4 * hh);
                            const f32x4 w0 = *(const LAS f32x4*)(W0 + 4 * hh), a0 = *(const LAS f32x4*)(A0 + 4 * hh), kkw = *(const LAS f32x4*)(KKW + 4 * hh), kaw = *(const LAS f32x4*)(KAW + 4 * hh), rkw = *(const LAS f32x4*)(RKW + 4 * hh);
                            const f32x4 ur = UNPJ(0, hh), uk = UNPJ(1, hh), uv = UNPJ(2, hh), urp = UNPJ(3, hh), ukp = UNPJ(4, hh), uvp = UNPJ(5, hh), lw = UNPJ(6, hh), la = UNPJ(7, hh);
                            xr[hh] = ur + (urp - ur) * mu_r; const f32x4 xk = uk + (ukp - uk) * mu_k; xv[hh] = uv + (uvp - uv) * mu_v;
#pragma unroll
                            for (int i = 0; i < 4; ++i) {
                                const float y = -(w0[i] + lw[i]);
                                const float sp = fmaxf(y, 0.f) + __logf(1.f + __expf(-fabsf(y)));
                                dec[hh][i] = __expf(-__expf(-sp - 0.5f));
                                av[hh][i] = sigmoidf_(a0[i] + la[i]);
                                kkv[hh][i] = xk[i] * kkw[i]; ss += kkv[hh][i] * kkv[hh][i];
                                kp[hh][i] = xk[i] * (1.f + (av[hh][i] - 1.f) * kaw[i]);
                                bsum += xr[hh][i] * kp[hh][i] * rkw[i];
                            }
                            __builtin_amdgcn_sched_barrier(0);
                        }
                        ss = red8(ss); bsum = red8(bsum);
                        const float inv = __builtin_amdgcn_rsqf(fmaxf(ss, 1e-24f));
#pragma unroll
                        for (int hh = 0; hh < 2; ++hh) {
                            const f32x4 kk = kkv[hh] * inv, kka = kk * av[hh];
                            LAS float* o = OPS + p1t * 384 + c8 + 4 * hh;
                            *(LAS f32x4*)(o) = dec[hh]; *(LAS f32x4*)(o + 64) = kk; *(LAS f32x4*)(o + 128) = kka; *(LAS f32x4*)(o + 192) = kp[hh]; *(LAS f32x4*)(o + 256) = xr[hh]; *(LAS f32x4*)(o + 320) = xv[hh];
                            *(LAS f32x4*)(VEP + par1 * 2048 + p1t * 64 + c8 + 4 * hh) = xv[hh];
                        }
                        if ((tid & 7) == 0) BON[par1 * 32 + p1t] = bsum;
                    };
#define UNP4(w) ((f32x4){bflo((w).x), bfhi((w).x), bflo((w).y), bfhi((w).y)})
#define DOT4(a, b) (((a).x * (b).x + (a).y * (b).y) + ((a).z * (b).z + (a).w * (b).w))
#define PACK8(x, s) __builtin_bit_cast(bf16x8, (u32x4){pk2((x)[8 * (s)], (x)[8 * (s) + 1]), pk2((x)[8 * (s) + 2], (x)[8 * (s) + 3]), pk2((x)[8 * (s) + 4], (x)[8 * (s) + 5]), pk2((x)[8 * (s) + 6], (x)[8 * (s) + 7])})
#define LD2x64(p) __builtin_bit_cast(bf16x8, (u32x4){(*(const LAS u32x2*)(p)).x, (*(const LAS u32x2*)(p)).y, (*(const LAS u32x2*)((p) + 16)).x, (*(const LAS u32x2*)((p) + 16)).y})
                    auto EPI = [&](int te, int pe) {
                        const int et = ((wave >> 2) * 2 + (wave & 1)) * 64 + lane, pce = (et & 15) * 4;
                        const f32x4 lng = *(const LAS f32x4*)(PARF + 512 + pce), lnb = *(const LAS f32x4*)(PARF + 576 + pce);
#pragma unroll
                        for (int it = 0; it < 2; ++it) {
                            const int pte = (et >> 4) + 16 * it;
                            const u32x2 gkw = *(const LAS u32x2*)(GKB + pe * 4096 + pte * 128 + pce * 2);
                            const f32x4 o4 = *(const LAS f32x4*)(OUTB + pte * 64 + pce), v4 = *(const LAS f32x4*)(VEP + pe * 2048 + pte * 64 + pce), gk = UNP4(gkw);
                            const float mean = red16((o4.x + o4.y) + (o4.z + o4.w)) * (1.f / 64.f);
                            const f32x4 dv = o4 - mean;
                            const float var = red16(DOT4(dv, dv)) * (1.f / 64.f);
                            const float rstd = __builtin_amdgcn_rsqf(var + RW_GN_EPS), bo = BON[pe * 32 + pte];
                            const f32x4 y = (dv * rstd * lng + lnb + v4 * bo) * gk;
                            st4bf(HC + (((size_t)b * SEQ + te + pte) * 1536 + 512 + h * 64 + pce) * 2, y);
                        }
                    };
                    if (wave >= 4) LOADC(0); else if (wave >= 2) LOADG(0);
#pragma unroll 1
                    for (int t0 = -TC; t0 < SEQ; t0 += TC) {
                        const int par = (t0 >> 5) & 1;
                        __syncthreads();
                        if (t0 >= 0)
                        {
                            const int sc = wave >> 2, wq = wave & 3;
                            LAS unsigned char* im = IM0 + sc * IMG;
                            LAS unsigned char* KR = im; LAS unsigned char* BGr = im + 4608; LAS unsigned char* VT = im + 15360;
                            LAS unsigned char* TT = im + 18432; LAS unsigned char* BB = im + 19968; LAS float* ZF = (LAS float*)(im + 21504); LAS float* PL = (LAS float*)(im + 25600);
                            {
                                float P = 1.f;
#pragma unroll 1
                                for (int t = 0; t < 4 * wq; ++t) P *= OPS[(16 * sc + t) * 384 + lane];
#pragma unroll
                                for (int q = 0; q < 4; ++q) { const int t = 4 * wq + q; const LAS float* o = OPS + (16 * sc + t) * 384 + lane;
                                    const float w = o[0], z = o[64], bb = o[128], kp = o[192], rr = o[256], vv = o[320];
                                    const float kap = z * P; P *= w; const float rho = rr * P, ip = __builtin_amdgcn_rcpf(P), bet = bb * ip, gam = kp * ip;
                                    *(LAS bf16*)(KR + t * PT + lane * 2) = (bf16)f2bf(kap); *(LAS bf16*)(KR + (16 + t) * PT + lane * 2) = (bf16)f2bf(rho);
                                    *(LAS bf16*)(BGr + t * PT + lane * 2) = (bf16)f2bf(bet); *(LAS bf16*)(BGr + (16 + t) * PT + lane * 2) = (bf16)f2bf(gam);
                                    *(LAS bf16*)(VT + t * PT + lane * 2) = (bf16)f2bf(vv); }
                                if (wq == 3) PL[lane] = P;
                            }
                            __syncthreads();
                            if (wq == 0) {
                                f32x16 Z;
#pragma unroll
                                for (int i = 0; i < 16; ++i) Z[i] = 0.f;
#pragma unroll
                                for (int ks = 0; ks < 4; ++ks) Z = __builtin_amdgcn_mfma_f32_32x32x16_bf16(*(const LAS bf16x8*)(KR + r31 * PT + (16 * ks + 8 * h2) * 2), *(const LAS bf16x8*)(BGr + r31 * PT + (16 * ks + 8 * h2) * 2), Z, 0, 0, 0);
                                const int cp = (r31 < 16) ? (4 * (r31 & 3) + (r31 >> 2)) : r31;
#pragma unroll
                                for (int i = 0; i < 16; ++i) ZF[((i & 3) + 8 * (i >> 2) + 4 * h2) * 32 + cp] = Z[i];
                            } else if (wq >= 2 && t0 >= TC) EPI(t0 - TC, par ^ 1);
                            __syncthreads();
                            if (wq == 0) {
                                const int c = lane >> 2, jq = lane & 3; float tq[4] = {0.f, 0.f, 0.f, 0.f};
                                f32x4 an = *(const LAS f32x4*)(ZF + 1 * 32 + 4 * jq);
#pragma unroll
                                for (int t = 0; t < 16; ++t) {
                                    const f32x4 ar = an; if (t >= 1 && t < 15) an = *(const LAS f32x4*)(ZF + (t + 1) * 32 + 4 * jq);
                                    float s = 0.f;
#pragma unroll
                                    for (int m = 0; m < 4; ++m) if (4 * m < t) s += ((4 * m + jq < t) ? ar[m] : 0.f) * tq[m];
                                    s = red4(s);
                                    const float val = ((t == c) ? 1.f : 0.f) - s;
                                    tq[t >> 2] = (jq == (t & 3)) ? val : tq[t >> 2];
                                }
#pragma unroll
                                for (int m = 0; m < 4; ++m) *(LAS bf16*)(TT + (4 * m + jq) * P16 + c * 2) = (bf16)f2bf(-tq[m]);
                                an = *(const LAS f32x4*)(ZF + 16 * 32 + 4 * jq);
#pragma unroll
                                for (int t = 0; t < 16; ++t) {
                                    const f32x4 ar = an; if (t < 15) an = *(const LAS f32x4*)(ZF + (17 + t) * 32 + 4 * jq);
                                    float s = 0.f;
#pragma unroll
                                    for (int m = 0; m < 4; ++m) if (4 * m <= t) s += ((4 * m + jq <= t) ? ar[m] : 0.f) * tq[m];
                                    s = red4(s);
                                    if (jq == 0) *(LAS bf16*)(TT + (16 + t) * P16 + c * 2) = (bf16)f2bf(-s);
                                }
                            } else if (wq == 1) {
                                const int row = lane >> 1, c0 = 8 * (lane & 1), tt = row & 15; const bool rho_row = row >= 16; float bv[8];
#pragma unroll
                                for (int j = 0; j < 8; ++j) { const int jj = c0 + j; const float zv = ZF[row * 32 + 16 + jj]; bv[j] = (rho_row ? (jj <= tt) : (jj < tt)) ? zv : 0.f; }
                                *(LAS u32x4*)(BB + row * P16 + c0 * 2) = (u32x4){pk2(bv[0], bv[1]), pk2(bv[2], bv[3]), pk2(bv[4], bv[5]), pk2(bv[6], bv[7])};
                            }
                        }
                        __syncthreads();
                        if (wave >= 4) { if (t0 + TC < SEQ) PASS1(t0 + TC, par ^ 1, t0 + 2 * TC < SEQ); }
                        else if (wave >= 2) { if (t0 + TC < SEQ) {
                            LAS unsigned char* gd = GKB + (par ^ 1) * 4096 + gt * 128 + gp * 2;
                            *(LAS u32x4*)gd = (u32x4){PUWS(0, 0), PUWS(0, 1), PUWS(0, 2), PUWS(0, 3)}; *(LAS u32x4*)(gd + 16) = (u32x4){PUWS(1, 0), PUWS(1, 1), PUWS(1, 2), PUWS(1, 3)};
                            if (t0 + 2 * TC < SEQ) LOADG(t0 + 2 * TC); } }
                        else if (wave < 2 && t0 >= 0) {
#pragma unroll 1
                            for (int sc = 0; sc < 2; ++sc) {
                                const LAS unsigned char* im = IM0 + sc * IMG;
                                const LAS unsigned char* KR = im; const LAS unsigned char* BT = im + 9216; const LAS unsigned char* GT = im + 12288; const LAS unsigned char* VT = im + 15360;
                                const LAS unsigned char* TT = im + 18432; const LAS unsigned char* BB = im + 19968; const LAS float* PL = (const LAS float*)(im + 25600);
                                const LAS unsigned char* BGr = im + 4608;
                                const bf16x8 vfr = trd8(VT, PT, 8 * h2, 8 * h2 + 4, 32 * wave, lane);
                                f32x16 t1;
#pragma unroll
                                for (int i = 0; i < 16; ++i) t1[i] = 0.f;
                                t1 = __builtin_amdgcn_mfma_f32_32x32x16_bf16(*(const LAS bf16x8*)(BB + r31 * P16 + 8 * h2 * 2), vfr, t1, 0, 0, 0);
#pragma unroll
                                for (int kb = 0; kb < 2; ++kb)
#pragma unroll
                                    for (int s = 0; s < 2; ++s) t1 = __builtin_amdgcn_mfma_f32_32x32x16_bf16(LD2x64(KR + r31 * PT + (32 * kb + 16 * s + 4 * h2) * 2), PACK8(Sreg[kb], s), t1, 0, 0, 0);
                                f32x16 t2;
#pragma unroll
                                for (int i = 0; i < 16; ++i) t2[i] = 0.f;
                                t2 = __builtin_amdgcn_mfma_f32_32x32x16_bf16(LD2x64(TT + r31 * P16 + (4 * h2) * 2), PACK8(t1, 0), t2, 0, 0, 0);
#pragma unroll
                                for (int i = 8; i < 16; ++i) OUTB[(16 * sc + (i & 3) + 8 * ((i >> 2) - 2) + 4 * h2) * 64 + 32 * wave + r31] = t2[i] + t1[i];
                                const bf16x8 uq = PACK8(t2, 0);
#pragma unroll
                                for (int kb = 0; kb < 2; ++kb) {
                                    f32x16 a = Sreg[kb];
                                    a = __builtin_amdgcn_mfma_f32_32x32x16_bf16(trd8(BGr, PT, 4 * h2, 8 + 4 * h2, 32 * kb, lane), uq, a, 0, 0, 0);
                                    a = __builtin_amdgcn_mfma_f32_32x32x16_bf16(trd8(BGr, PT, 16 + 8 * h2, 20 + 8 * h2, 32 * kb, lane), vfr, a, 0, 0, 0);
#pragma unroll
                                    for (int g4 = 0; g4 < 4; ++g4) { const f32x4 p4 = *(const LAS f32x4*)(PL + 32 * kb + 8 * g4 + 4 * h2);
                                        a[4 * g4] *= p4.x; a[4 * g4 + 1] *= p4.y; a[4 * g4 + 2] *= p4.z; a[4 * g4 + 3] *= p4.w; }
                                    Sreg[kb] = a;
                                }
                            }
                        }
                    }
                    __syncthreads();
                    if ((wave & 3) >= 2) EPI(SEQ - TC, ((SEQ - TC) >> 5) & 1);
                    __syncthreads();
#undef UNPH
#undef UNPJ
#undef PUW
#undef PUWS
#undef SETPU
#undef PACK8
#undef LD2x64
                } } else {
                    const int idx = job - 128, bh = idx >> 1, half = idx & 1, b = bh >> 2, h = bh & 3;
                    unsigned zl_ = 0u; asm volatile("" : "+v"(zl_)); const int lane_ml = (int)__builtin_amdgcn_mbcnt_hi(~0u, __builtin_amdgcn_mbcnt_lo(~0u, zl_));
                    _Pragma("unroll 1") for (int sr_ = 0; sr_ < NSUB(1); ++sr_) if (((SUBMASK>>1)&1) && idx < 64) {
                        SUB_TID
                        const int bm = idx >> 2, hm = idx & 3;
                        constexpr int PT = 144;
                        LAS unsigned char* QI = lds;
                        LAS unsigned char* KI = QI + 64 * PT;
                        constexpr int PV = 272;
                        LAS unsigned char* KW = KI + 64 * PT;
                        LAS unsigned char* VT = KW + 64 * PT;
                        LAS unsigned char* CI = VT + 64 * PV;
                        LAS float* AS = (LAS float*)(CI + 128 * PT);
                        LAS float* MX = AS + 64; LAS float* SI = AS + 128; LAS float* EM = AS + 192; LAS float* WG = AS + 256; LAS float* NN = AS + 320; LAS float* CR = AS + 384; LAS float* ST = AS + 448;
                        for (int i = tid; i < 128 * PT / 4; i += NTHR) ((LAS unsigned*)CI)[i] = 0u;
                        if (tid < 64) NN[tid] = 0.f;
                        const int pt = tid >> 4, cg = tid & 15;
                        const int ccol = (cg < 8) ? (hm * 64 + 8 * cg) : (256 + hm * 64 + 8 * (cg - 8));
                        const float qsc = (cg < 8) ? 0.125f : 1.f;
                        const float igb = INP(I_IGB)[l * 4 + hm], fgb = INP(I_FGB)[l * 4 + hm];
                        const int r31 = lane & 31, h2 = lane >> 5, vb = wave >> 1, tb = wave & 1;
                        f32x16 accC;
#pragma unroll
                        for (int i = 0; i < 16; ++i) accC[i] = 0.f;
                        float nreg = 0.f, mprev = 0.f;
                        u32x4 cu[2][4], vu[2]; float gi = 0.f, gf = 0.f;
                        auto LOADM = [&](int t0) {
#pragma unroll
                            for (int tt = 0; tt < 2; ++tt) { const int t = t0 + pt + 32 * tt; const size_t row = (size_t)bm * SEQ + t;
#pragma unroll
                                for (int j = 0; j < 4; ++j) { if (t - 3 + j >= 0) cu[tt][j] = *(const u32x4*)(Ub + ((row - 3 + j) * NU + UC_QK + ccol) * 2); else cu[tt][j] = (u32x4){0u, 0u, 0u, 0u}; }
                                const int p = tid + 512 * tt; vu[tt] = *(const u32x4*)(Ub + (((size_t)bm * SEQ + t0 + (p >> 4)) * NU + UC_V + hm * 128 + 8 * (p & 15)) * 2); }
                            if (wave == 0) { const size_t rg = (size_t)bm * SEQ + t0 + lane; gi = GIF[rg * 8 + hm]; gf = GIF[rg * 8 + 4 + hm]; }
                        };
                        LOADM(0);
                        __syncthreads();
#pragma unroll 1
                        for (int t0 = 0; t0 < SEQ; t0 += 64) {
                            int ccv = ccol; asm volatile("" : "+v"(ccv));
                            float cw[4][8], cb[8];
#pragma unroll
                        for (int j = 0; j < 4; ++j) { const f32x4 a = *(const f32x4*)(INP(I_CONVW) + ((size_t)l * 4 + j) * 512 + ccv), c2 = *(const f32x4*)(INP(I_CONVW) + ((size_t)l * 4 + j) * 512 + ccv + 4);
                            cw[j][0] = a.x; cw[j][1] = a.y; cw[j][2] = a.z; cw[j][3] = a.w; cw[j][4] = c2.x; cw[j][5] = c2.y; cw[j][6] = c2.z; cw[j][7] = c2.w; }
                        { const f32x4 a = *(const f32x4*)(INP(I_CONVB) + l * 512 + ccv), c2 = *(const f32x4*)(INP(I_CONVB) + l * 512 + ccv + 4);
                            cb[0] = a.x; cb[1] = a.y; cb[2] = a.z; cb[3] = a.w; cb[4] = c2.x; cb[5] = c2.y; cb[6] = c2.z; cb[7] = c2.w; }
                            float yq[2][8];
#pragma unroll
                            for (int tt = 0; tt < 2; ++tt) {
#pragma unroll
                                for (int i = 0; i < 8; ++i) yq[tt][i] = cb[i];
#pragma unroll
                                for (int j = 0; j < 4; ++j) { const u32x4 w = cu[tt][j]; const float x[8] = {bflo(w.x), bfhi(w.x), bflo(w.y), bfhi(w.y), bflo(w.z), bfhi(w.z), bflo(w.w), bfhi(w.w)};
#pragma unroll
                                    for (int i = 0; i < 8; ++i) yq[tt][i] += cw[j][i] * x[i]; }
#pragma unroll
                                for (int i = 0; i < 8; ++i) yq[tt][i] = yq[tt][i] * sigmoidf_(yq[tt][i]) * qsc;
                            }
                            const u32x4 vreg0 = vu[0], vreg1 = vu[1];
                            if (wave == 0) {
                                const float ig = gi + igb, fp = gf + fgb;
                                const float lf = -(fmaxf(-fp, 0.f) + __logf(1.f + __expf(-fabsf(fp))));
                                const float bc = scan_add64(lf);
                                const float as = ig - bc, pm = scan_max64(as);
                                const float mxv = fmaxf(mprev, pm), mx63 = __builtin_bit_cast(float, __builtin_amdgcn_readlane(__builtin_bit_cast(int, mxv), 63)), bl = __builtin_bit_cast(float, __builtin_amdgcn_readlane(__builtin_bit_cast(int, bc), 63));
                                AS[lane] = as; MX[lane] = mxv; SI[lane] = __expf(mprev - mxv); EM[lane] = __expf(-(bc + mxv)); WG[lane] = __expf(as - mx63);
                                if (lane == 0) CR[0] = __expf(mprev - mx63);
                                mprev = bl + mx63;
                            }
                            if (t0 + 64 < SEQ) LOADM(t0 + 64);
                            __syncthreads();
#pragma unroll
                            for (int tt = 0; tt < 2; ++tt) { const int tok = pt + 32 * tt;
                                u32x4 pw; pw.x = pk2(yq[tt][0], yq[tt][1]); pw.y = pk2(yq[tt][2], yq[tt][3]); pw.z = pk2(yq[tt][4], yq[tt][5]); pw.w = pk2(yq[tt][6], yq[tt][7]);
                                if (cg < 8) *(LAS u32x4*)(QI + tok * PT + cg * 16) = pw;
                                else { *(LAS u32x4*)(KI + tok * PT + (cg - 8) * 16) = pw; const float wgs = WG[tok];
                                    u32x4 kw; kw.x = pk2(yq[tt][0] * wgs, yq[tt][1] * wgs); kw.y = pk2(yq[tt][2] * wgs, yq[tt][3] * wgs); kw.z = pk2(yq[tt][4] * wgs, yq[tt][5] * wgs); kw.w = pk2(yq[tt][6] * wgs, yq[tt][7] * wgs);
                                    *(LAS u32x4*)(KW + tok * PT + (cg - 8) * 16) = kw; }
                                const u32x4 vw = tt ? vreg1 : vreg0; const int p = tid + 512 * tt, vtok = p >> 4, v8 = p & 15;
                                *(LAS u32x4*)(VT + vtok * PV + v8 * 16) = vw;
                            }
                            __syncthreads();
                            float hv[16];
                            {
                                constexpr float L2E = 1.4426950408889634f;
                                const int t = 32 * tb + r31;
                                bf16x8 qf[4];
#pragma unroll
                                for (int ks = 0; ks < 4; ++ks) qf[ks] = *(const LAS bf16x8*)(QI + t * PT + (16 * ks + 8 * h2) * 2);
                                const float mx = MX[t], si = SI[t], em = EM[t];
                                f32x16 O, I; float denI = 0.f;
#pragma unroll
                                for (int i = 0; i < 16; ++i) { O[i] = 0.f; I[i] = 0.f; }
#pragma unroll
                                for (int sb = 0; sb < 2; ++sb) if (sb <= tb) {
                                    f32x16 X;
#pragma unroll
                                    for (int i = 0; i < 16; ++i) X[i] = 0.f;
#pragma unroll
                                    for (int ks = 0; ks < 4; ++ks) { const bf16x8 kf = *(const LAS bf16x8*)(KI + (32 * sb + r31) * PT + (16 * ks + 8 * h2) * 2); X = __builtin_amdgcn_mfma_f32_32x32x16_bf16(kf, qf[ks], X, 0, 0, 0); }
#pragma unroll
                                    for (int g4 = 0; g4 < 4; ++g4) { const f32x4 a4 = *(const LAS f32x4*)(AS + 32 * sb + 8 * g4 + 4 * h2);
#pragma unroll
                                        for (int j = 0; j < 4; ++j) { const int s = 32 * sb + 8 * g4 + 4 * h2 + j; const float w = (s <= t) ? __builtin_amdgcn_exp2f((a4[j] - mx) * L2E) * X[4 * g4 + j] : 0.f; X[4 * g4 + j] = w; denI += w; } }
#pragma unroll
                                    for (int st = 0; st < 2; ++st) {
                                        u32x4 pw; pw.x = pk2(X[8 * st], X[8 * st + 1]); pw.y = pk2(X[8 * st + 2], X[8 * st + 3]); pw.z = pk2(X[8 * st + 4], X[8 * st + 5]); pw.w = pk2(X[8 * st + 6], X[8 * st + 7]);
                                        O = __builtin_amdgcn_mfma_f32_32x32x16_bf16(trd8(VT, PV, 32 * sb + 16 * st + 4 * h2, 32 * sb + 16 * st + 8 + 4 * h2, 32 * vb, lane), __builtin_bit_cast(bf16x8, pw), O, 0, 0, 0);
                                    }
                                }
                                float nq = 0.f;
#pragma unroll
                                for (int ks = 0; ks < 4; ++ks) { const bf16x8 cf = *(const LAS bf16x8*)(CI + (32 * vb + r31) * PT + (16 * ks + 8 * h2) * 2); I = __builtin_amdgcn_mfma_f32_32x32x16_bf16(cf, qf[ks], I, 0, 0, 0);
                                    const f32x4 n0 = *(const LAS f32x4*)(NN + 16 * ks + 8 * h2), n1 = *(const LAS f32x4*)(NN + 16 * ks + 8 * h2 + 4); const u32x4 qw = __builtin_bit_cast(u32x4, qf[ks]);
                                    nq += (bflo(qw.x) * n0.x + bfhi(qw.x) * n0.y) + (bflo(qw.y) * n0.z + bfhi(qw.y) * n0.w) + (bflo(qw.z) * n1.x + bfhi(qw.z) * n1.y) + (bflo(qw.w) * n1.z + bfhi(qw.w) * n1.w); }
                                nq += __shfl_xor(nq, 32); denI += __shfl_xor(denI, 32);
                                const float den = si * nq + denI, rdn = 1.f / fmaxf(fabsf(den), em);
                                float hsum = 0.f;
#pragma unroll
                                for (int i = 0; i < 16; ++i) { hv[i] = (O[i] + si * I[i]) * rdn; hsum += hv[i]; }
                                hsum += __shfl_xor(hsum, 32);
                                const float hmean = hsum * (1.f / 32.f); float hm2 = 0.f;
#pragma unroll
                                for (int i = 0; i < 16; ++i) { const float dlt = hv[i] - hmean; hm2 += dlt * dlt; }
                                hm2 += __shfl_xor(hm2, 32);
                                if (h2 == 0) *(LAS f32x2*)(ST + ((tb * 4 + vb) * 32 + r31) * 2) = (f32x2){hmean, hm2};
                                const float carry = CR[0];
#pragma unroll
                                for (int i = 0; i < 16; ++i) accC[i] *= carry;
#pragma unroll
                                for (int st = 0; st < 4; ++st) { const bf16x8 va = trd8(VT, PV, 16 * st + 8 * h2, 16 * st + 8 * h2 + 4, 32 * vb, lane), kw = trd8(KW, PT, 16 * st + 8 * h2, 16 * st + 8 * h2 + 4, 32 * tb, lane);
                                    accC = __builtin_amdgcn_mfma_f32_32x32x16_bf16(va, kw, accC, 0, 0, 0); }
                            }
                            __syncthreads();
                            {
                                const int t = 32 * tb + r31;
                                f32x2 s4[4];
#pragma unroll
                                for (int q = 0; q < 4; ++q) s4[q] = *(const LAS f32x2*)(ST + ((tb * 4 + q) * 32 + r31) * 2);
                                const float mt = (s4[0].x + s4[1].x + s4[2].x + s4[3].x) * 0.25f;
                                float m2 = 0.f;
#pragma unroll
                                for (int q = 0; q < 4; ++q) { const float dm = s4[q].x - mt; m2 += s4[q].y + 32.f * dm * dm; }
                                const float rstd = __builtin_amdgcn_rsqf(m2 * (1.f / 128.f) + LN_EPS);
                                const size_t row = (size_t)bm * SEQ + t0 + t;
                                const char* ogp = Ub + (row * NU + UC_OG + hm * 128 + 32 * vb) * 2; char* op = HC + (row * 1536 + hm * 128 + 32 * vb) * 2;
                                const float* ngp = INP(I_MLNORMG) + l * 512 + hm * 128 + 32 * vb;
#pragma unroll
                                for (int g4 = 0; g4 < 4; ++g4) { const int vo = 8 * g4 + 4 * h2; const f32x4 og = ld4bf(ogp + vo * 2), ng = *(const f32x4*)(ngp + vo);
                                    f32x4 y; y.x = sigmoidf_(og.x) * ((hv[4 * g4] - mt) * rstd * ng.x); y.y = sigmoidf_(og.y) * ((hv[4 * g4 + 1] - mt) * rstd * ng.y); y.z = sigmoidf_(og.z) * ((hv[4 * g4 + 2] - mt) * rstd * ng.z); y.w = sigmoidf_(og.w) * ((hv[4 * g4 + 3] - mt) * rstd * ng.w);
                                    st4bf(op + vo * 2, y); }
                            }
#pragma unroll
                            for (int i = 0; i < 16; ++i) { const int v = 32 * vb + (i & 3) + 8 * (i >> 2) + 4 * h2; *(LAS bf16*)(CI + v * PT + (32 * tb + r31) * 2) = (bf16)f2bf(accC[i]); }
                            if (wave < 2) { float s = 0.f;
#pragma unroll
                                for (int q8 = 0; q8 < 8; ++q8) { const u32x2 w = trd4(KW, PT, 32 * h2 + 4 * q8, 32 * wave, lane); s += (bflo(w.x) + bfhi(w.x)) + (bflo(w.y) + bfhi(w.y)); }
                                s += __shfl_xor(s, 32);
                                nreg = CR[0] * nreg + s; if (h2 == 0) NN[32 * wave + r31] = nreg; }
                            __syncthreads();
                        }
                    }
                }
            }
            if (rep_ == 0) {
                LAS unsigned* XB = (LAS unsigned*)(lds + 153088);
                unsigned* xc = (unsigned*)ctl + CW_FILL + 32 + l * 64;
                __syncthreads();
                if (tid_ph == 0) XB[0] = __hip_atomic_fetch_add(xc, 1u, RLX_AGENT);
                __syncthreads();
                int xi = __builtin_amdgcn_readfirstlane((int)XB[0]);
#pragma unroll 1
                while (xi < 128) {
                    const int idx = xi, bh = idx >> 1, half = idx & 1, b = bh >> 2, h = bh & 3;
                    _Pragma("unroll 1") for (int sr_ = 0; sr_ < NSUB(2); ++sr_) if ((SUBMASK>>2)&1) {
                        SUB_TID
                        constexpr int KST = 272, VST = 520;
                        LAS unsigned char* KI = lds; LAS unsigned char* VI = lds + 256 * KST;
                        const char* kvb = (const char*)(ws + WS_KV) + (((size_t)l * MROWS + (size_t)b * MEML) * D) * 2;
                        for (int p = tid; p < 4096; p += NTHR) { const int key = p >> 4, c16 = p & 15;
                            *(LAS u32x4*)(KI + key * KST + c16 * 16) = *(const u32x4*)(kvb + ((size_t)key * D + h * 128 + c16 * 8) * 2); }
                        for (int p = tid; p < 4096; p += NTHR) { const int key = p & 255, d8 = p >> 8;
                            const u32x4 w = *(const u32x4*)(kvb + ((size_t)key * D + 512 + h * 128 + d8 * 8) * 2);
                            LAS unsigned char* o = VI + (d8 * 8) * VST + key * 2;
                            *(LAS bf16*)(o) = (bf16)(w.x & 0xffff); *(LAS bf16*)(o + VST) = (bf16)(w.x >> 16); *(LAS bf16*)(o + 2 * VST) = (bf16)(w.y & 0xffff); *(LAS bf16*)(o + 3 * VST) = (bf16)(w.y >> 16);
                            *(LAS bf16*)(o + 4 * VST) = (bf16)(w.z & 0xffff); *(LAS bf16*)(o + 5 * VST) = (bf16)(w.z >> 16); *(LAS bf16*)(o + 6 * VST) = (bf16)(w.w & 0xffff); *(LAS bf16*)(o + 7 * VST) = (bf16)(w.w >> 16); }
                        __syncthreads();
                        const int r31 = lane & 31, h2 = lane >> 5;
                        constexpr float SC = 0.08838834764831845f * 1.4426950408889634f;
#pragma unroll 1
                        for (int rd = 0; rd < 8; ++rd) {
                            const size_t qrow = (size_t)b * SEQ + half * 2048 + rd * 256 + wave * 32 + r31;
                            bf16x8 qf[8];
#pragma unroll
                            for (int ks = 0; ks < 8; ++ks) qf[ks] = *(const bf16x8*)(Ub + (qrow * NU + UC_CAQ + h * 128 + 16 * ks + 8 * h2) * 2);
                            f32x16 O[4];
#pragma unroll
                            for (int db = 0; db < 4; ++db)
#pragma unroll
                                for (int i = 0; i < 16; ++i) O[db][i] = 0.f;
                            float mrun = -1e30f, lrun = 0.f;
#pragma unroll 1
                            for (int hf = 0; hf < 2; ++hf) {
                                f32x16 X[4];
#pragma unroll
                                for (int kb = 0; kb < 4; ++kb) {
                                    bf16x8 kf[8];
#pragma unroll
                                    for (int ks = 0; ks < 8; ++ks) kf[ks] = *(const LAS bf16x8*)(KI + (hf * 128 + kb * 32 + r31) * KST + (16 * ks + 8 * h2) * 2);
                                    __builtin_amdgcn_sched_barrier(0);
#pragma unroll
                                    for (int i = 0; i < 16; ++i) X[kb][i] = 0.f;
#pragma unroll
                                    for (int ks = 0; ks < 8; ++ks) X[kb] = __builtin_amdgcn_mfma_f32_32x32x16_bf16(kf[ks], qf[ks], X[kb], 0, 0, 0);
                                    __builtin_amdgcn_sched_barrier(0);
                                }
                                float mx = -1e30f;
#pragma unroll
                                for (int kb = 0; kb < 4; ++kb)
#pragma unroll
                                    for (int i = 0; i < 16; ++i) mx = fmaxf(mx, X[kb][i]);
                                mx = fmaxf(mx, __shfl_xor(mx, 32));
                                const float mnew = fmaxf(mrun, mx), alpha = __builtin_amdgcn_exp2f((mrun - mnew) * SC);
                                float ls = 0.f;
#pragma unroll
                                for (int kb = 0; kb < 4; ++kb)
#pragma unroll
                                    for (int i = 0; i < 16; ++i) { const float p = __builtin_amdgcn_exp2f((X[kb][i] - mnew) * SC); X[kb][i] = p; ls += p; }
                                ls += __shfl_xor(ls, 32);
                                lrun = lrun * alpha + ls; mrun = mnew;
#pragma unroll
                                for (int db = 0; db < 4; ++db)
#pragma unroll
                                    for (int i = 0; i < 16; ++i) O[db][i] *= alpha;
#pragma unroll
                                for (int kb = 0; kb < 4; ++kb) {
                                    bf16x8 vf[2][4], pf[2];
#pragma unroll
                                    for (int s = 0; s < 2; ++s) {
                                        u32x4 pw; pw.x = pk2(X[kb][8 * s], X[kb][8 * s + 1]); pw.y = pk2(X[kb][8 * s + 2], X[kb][8 * s + 3]); pw.z = pk2(X[kb][8 * s + 4], X[kb][8 * s + 5]); pw.w = pk2(X[kb][8 * s + 6], X[kb][8 * s + 7]);
                                        pf[s] = __builtin_bit_cast(bf16x8, pw);
#pragma unroll
                                        for (int db = 0; db < 4; ++db) {
                                            const LAS unsigned char* vp = VI + (db * 32 + r31) * VST + (hf * 128 + kb * 32 + 16 * s + 4 * h2) * 2;
                                            const u32x2 lo = *(const LAS u32x2*)vp, hi = *(const LAS u32x2*)(vp + 16);
                                            vf[s][db] = __builtin_bit_cast(bf16x8, (u32x4){lo.x, lo.y, hi.x, hi.y});
                                        }
                                    }
                                    __builtin_amdgcn_sched_barrier(0);
#pragma unroll
                                    for (int s = 0; s < 2; ++s)
#pragma unroll
                                        for (int db = 0; db < 4; ++db) O[db] = __builtin_amdgcn_mfma_f32_32x32x16_bf16(vf[s][db], pf[s], O[db], 0, 0, 0);
                                    __builtin_amdgcn_sched_barrier(0);
                                }
                            }
                            const float rl = 1.f / lrun;
                            char* op = HC + (qrow * 1536 + 1024 + h * 128) * 2;
#pragma unroll
                            for (int db = 0; db < 4; ++db)
#pragma unroll
                                for (int g4 = 0; g4 < 4; ++g4) { u32x2 w; w.x = pk2(O[db][4 * g4] * rl, O[db][4 * g4 + 1] * rl); w.y = pk2(O[db][4 * g4 + 2] * rl, O[db][4 * g4 + 3] * rl);
                                    *(u32x2*)(op + (db * 32 + 8 * g4 + 4 * h2) * 2) = w; }
                        }
                        __syncthreads();
                    }
                    if (tid_ph == 0) XB[0] = __hip_atomic_fetch_add(xc, 1u, RLX_AGENT);
                    __syncthreads();
                    xi = __builtin_amdgcn_readfirstlane((int)XB[0]);
                    __syncthreads();
                }
            }
            if (rep_ == 0) {
                unsigned zf_ = 0u; asm volatile("" : "+v"(zf_)); const int lane_f = (int)__builtin_amdgcn_mbcnt_hi(~0u, __builtin_amdgcn_mbcnt_lo(~0u, zf_));
                LAS float* scr = (LAS float*)(lds + wave * 8448);
                LAS unsigned* FB = (LAS unsigned*)(lds + 8 * 8448);
                unsigned* fc = (unsigned*)ctl + CW_FILL + l * 64;
                constexpr int IT_GU = 32 * 16 * 64, IT_ALL = 49152, CH = 32;
                const bool lead = (wave == 0) && (lane_f == 0);
                __syncthreads();
                if (lead) FB[0] = __hip_atomic_fetch_add(fc, (unsigned)CH, RLX_AGENT);
                __syncthreads();
                int fbase = __builtin_amdgcn_readfirstlane((int)FB[0]), slot = 1;
#pragma unroll 1
                while (fbase < IT_ALL) {
                    unsigned nb = 0u;
                    if (lead) nb = __hip_atomic_fetch_add(fc, (unsigned)CH, RLX_AGENT);
#pragma unroll 1
                    for (int kq = 0; kq < CH / NWAVES; ++kq) { const int it = fbase + wave + kq * NWAVES;
                        if (it < IT_GU) { const int e = it >> 10, q = it & 1023, kb = q >> 6, nb_ = q & 63;
                            transpose_item_f8(INP(I_WGU) + (((size_t)l * 32 + e) * D + 64 * kb) * 2048 + 32 * nb_, 2048, (unsigned char*)(ws + WS_WGU) + ((size_t)e * 2048 + 32 * nb_) * D + 64 * kb, D, F8_SWGU, scr, lane_f); }
                        else { const int r2 = it - IT_GU, e = r2 >> 9, q = r2 & 511, kb = q >> 5, nb_ = q & 31;
                            transpose_item_f8(INP(I_WDN) + (((size_t)l * 32 + e) * D + 64 * kb) * 1024 + 32 * nb_, 1024, (unsigned char*)(ws + WS_WDN) + ((size_t)e * 1024 + 32 * nb_) * D + 64 * kb, D, F8_SWDN, scr, lane_f); }
                    }
                    if (lead) FB[slot] = nb;
                    __syncthreads();
                    fbase = __builtin_amdgcn_readfirstlane((int)FB[slot]); slot ^= 1;
                }
            }
#undef UNP4
#undef DOT4
#undef SUB_TID
        }
        SEAM(pb + 3);
        _Pragma("unroll 1") for (int rep_ = 0; rep_ < NREP(5); ++rep_) if (((PHMASK>>5)&1) && IN(pb + 5)) {
            SchedPlain S; S.T.init(M / 256, 4); S.G = G; S.c = bx; S.A = (const char*)(ws + WS_R2 + R2_HCAT); S.B = (const char*)(ws + WS_WBR) + (size_t)l * 1024 * 1536 * 2; S.C = (char*)(ws + WS_R2 + R2_YPRE);
            S.lda = 1536; S.ldb = 1536; S.ldc = D;
            pg8::EpiMerge E; E.U = Ub; E.gate_b = INP(I_GATEB) + (size_t)l * 3072;
            pg8::gemm_phase<false, true>(lds, 1536 * 2, 1536 * 2, 1536 * 2, S, E, wave);
        }
        SEAM(pb + 5);
        _Pragma("unroll 1") for (int rep_ = 0; rep_ < NREP(6); ++rep_) if (((PHMASK>>6)&1) && IN(pb + 6)) {
            SchedPlain S; S.T.init(M / 256, 4); S.G = G; S.c = bx; S.A = (const char*)(ws + WS_R2 + R2_YPRE); S.B = (const char*)(ws + WS_WO) + (size_t)l * D * D * 2; S.C = (char*)(ws + WS_R2 + R2_Z);
            S.lda = D; S.ldb = D; S.ldc = D;
            pg8::EpiStore E;
            pg8::gemm_phase<false>(lds, D * 2, D * 2, D * 2, S, E, wave);
        }
        SEAM(pb + 6);
        _Pragma("unroll 1") for (int rep_ = 0; rep_ < NREP(7); ++rep_) if (((PHMASK>>7)&1) && IN(pb + 7)) { PHASE_TID
            constexpr int WP = 2064;
            LAS unsigned char* WRb = lds;
            LAS float* RB = (LAS float*)(lds + 66048);
            LAS unsigned char* XS = lds + 66560 + wave * 4608;
            for (int i = tid; i < 32768; i += NTHR) { const int k = i >> 5, e = i & 31; *(LAS bf16*)(WRb + e * WP + k * 2) = (bf16)f2bf(INP(I_RTW)[((size_t)l * D + k) * 32 + e]); }
            if (tid < 32) RB[tid] = INP(I_RTB)[l * 32 + tid];
            const char* Zb = (const char*)(ws + WS_R2 + R2_Z);
            int* TKE = (int*)(ws + WS_TKE); float* TKG = (float*)(ws + WS_TKG); int* TKP = (int*)(ws + WS_TKP); int* ROWTOK = (int*)(ws + WS_ROWTOK);
            LAS unsigned* LCNT = (LAS unsigned*)(lds + 131072);
            LAS unsigned* GBASE = LCNT + 32; LAS unsigned* LLEN = LCNT + 64; LAS unsigned* LIST = LCNT + 128;
            if (tid < 65) LCNT[tid] = 0u;
            {
                f32x4 g[4], bb[4];
#pragma unroll
                for (int j = 0; j < 4; ++j) { g[j] = *(const f32x4*)(INP(I_LN1G) + l * D + 256 * j + 4 * lane); bb[j] = *(const f32x4*)(INP(I_LN1B) + l * D + 256 * j + 4 * lane); }
#pragma unroll 1
                for (int pp = gw; pp < M / 2; pp += NGW) {
                    f32x4 y0[4], y1[4];
#pragma unroll
                    for (int j = 0; j < 4; ++j) { y0[j] = ld4bf(Zb + ((size_t)(2 * pp) * D + 256 * j + 4 * lane) * 2) + ld4bf(Xb + ((size_t)(2 * pp) * D + 256 * j + 4 * lane) * 2) * DN_ALPHA;
                        y1[j] = ld4bf(Zb + ((size_t)(2 * pp + 1) * D + 256 * j + 4 * lane) * 2) + ld4bf(Xb + ((size_t)(2 * pp + 1) * D + 256 * j + 4 * lane) * 2) * DN_ALPHA; }
                    ln16(y0, g, bb); ln16(y1, g, bb);
#pragma unroll
                    for (int j = 0; j < 4; ++j) { st4bf(Xb + ((size_t)(2 * pp) * D + 256 * j + 4 * lane) * 2, y0[j]); st4bf(Xb + ((size_t)(2 * pp + 1) * D + 256 * j + 4 * lane) * 2, y1[j]); }
                }
            }
            asm volatile("s_waitcnt vmcnt(0)" ::: "memory");
            __syncthreads();
            __builtin_amdgcn_fence(__ATOMIC_ACQUIRE, "agent");
            asm volatile("s_waitcnt vmcnt(0)" ::: "memory");
            if (rep_ == 0) {
                const int r31 = lane & 31, h2 = lane >> 5;
                const int mytok = 16 * (bx + (2 * wave + (r31 >> 4)) * G) + (r31 & 15);
                const char* sp[4];
#pragma unroll
                for (int q = 0; q < 4; ++q) { const int row = (lane >> 3) + 8 * q; const int tk = 16 * (bx + (2 * wave + (row >> 4)) * G) + (row & 15); sp[q] = Xb + ((size_t)tk * D + 8 * (lane & 7)) * 2; }
                f32x16 C;
#pragma unroll
                for (int i = 0; i < 16; ++i) C[i] = 0.f;
                u32x4 xr[4];
#pragma unroll
                for (int q = 0; q < 4; ++q) xr[q] = *(const u32x4*)(sp[q]);
#pragma unroll 1
                for (int sl = 0; sl < 16; ++sl) {
#pragma unroll
                    for (int q = 0; q < 4; ++q) *(LAS u32x4*)(XS + ((lane >> 3) + 8 * q) * 144 + (lane & 7) * 16) = xr[q];
                    if (sl + 1 < 16) {
#pragma unroll
                        for (int q = 0; q < 4; ++q) xr[q] = *(const u32x4*)(sp[q] + (sl + 1) * 128); }
#pragma unroll
                    for (int k2 = 0; k2 < 4; ++k2) C = __builtin_amdgcn_mfma_f32_32x32x16_bf16(*(const LAS bf16x8*)(WRb + r31 * WP + (64 * sl + 16 * k2 + 8 * h2) * 2), *(const LAS bf16x8*)(XS + r31 * 144 + (16 * k2 + 8 * h2) * 2), C, 0, 0, 0);
                }
                float v[16];
#pragma unroll
                for (int g4 = 0; g4 < 4; ++g4) { const f32x4 b4 = *(const LAS f32x4*)(RB + 8 * g4 + 4 * h2); v[4 * g4] = C[4 * g4] + b4.x; v[4 * g4 + 1] = C[4 * g4 + 1] + b4.y; v[4 * g4 + 2] = C[4 * g4 + 2] + b4.z; v[4 * g4 + 3] = C[4 * g4 + 3] + b4.w; }
                float lv[4]; int li_[4];
#pragma unroll
                for (int k = 0; k < 4; ++k) { float best = -3.0e38f; int bi = 0;
#pragma unroll
                    for (int i = 0; i < 16; ++i) { const int e = (i & 3) + 8 * (i >> 2) + 4 * h2; if (v[i] > best) { best = v[i]; bi = e; } }
#pragma unroll
                    for (int i = 0; i < 16; ++i) { const int e = (i & 3) + 8 * (i >> 2) + 4 * h2; v[i] = (e == bi) ? -3.0e38f : v[i]; }
                    lv[k] = best; li_[k] = bi; }
                float cv[8]; int ci[8];
#pragma unroll
                for (int k = 0; k < 4; ++k) { cv[k] = lv[k]; ci[k] = li_[k]; cv[4 + k] = __shfl_xor(lv[k], 32); ci[4 + k] = __shfl_xor(li_[k], 32); }
                float tv[4]; int te[4];
#pragma unroll
                for (int k = 0; k < 4; ++k) { float best = -3.0e38f; int bi = 64;
#pragma unroll
                    for (int i = 0; i < 8; ++i) { if (cv[i] > best || (cv[i] == best && ci[i] < bi)) { best = cv[i]; bi = ci[i]; } }
#pragma unroll
                    for (int i = 0; i < 8; ++i) cv[i] = (ci[i] == bi) ? -3.0e38f : cv[i];
                    tv[k] = best; te[k] = bi; }
                const float e1 = __expf(tv[1] - tv[0]), e2 = __expf(tv[2] - tv[0]), e3 = __expf(tv[3] - tv[0]), rs = 1.f / (1.f + e1 + e2 + e3);
                const float gt[4] = {rs, e1 * rs, e2 * rs, e3 * rs};
                if (h2 == 0) {
#pragma unroll
                    for (int k = 0; k < 4; ++k) {
                        const unsigned lpos = __hip_atomic_fetch_add(LCNT + te[k], 1u, __ATOMIC_RELAXED, __HIP_MEMORY_SCOPE_WORKGROUP);
                        const unsigned li = __hip_atomic_fetch_add(LLEN, 1u, __ATOMIC_RELAXED, __HIP_MEMORY_SCOPE_WORKGROUP);
                        LIST[2 * li] = (unsigned)(mytok * 4 + k); LIST[2 * li + 1] = (unsigned)te[k] | (lpos << 8);
                        TKE[mytok * 4 + k] = te[k]; TKG[mytok * 4 + k] = gt[k]; }
                }
            }
            __syncthreads();
            if (tid < 32 && rep_ == 0) GBASE[tid] = __hip_atomic_fetch_add((unsigned*)ctl + CW_CNT + (l * 32 + tid) * 64, LCNT[tid], RLX_AGENT);
            __syncthreads();
            if (rep_ == 0) { const unsigned n = LLEN[0];
                for (unsigned i = tid; i < n; i += NTHR) { const unsigned tk = LIST[2 * i], ev = LIST[2 * i + 1], e = ev & 255u, pos = GBASE[e] + (ev >> 8);
                    TKP[tk] = (int)pos; ROWTOK[(size_t)e * M + pos] = (int)(tk >> 2); } }
            __syncthreads();
        }
        SEAM(pb + 7);
        _Pragma("unroll 1") for (int rep_ = 0; rep_ < NREP(8); ++rep_) if (((PHMASK>>8)&1) && IN(pb + 8)) { PHASE_TID
            if (tid < 32) CNT[tid] = (int)__hip_atomic_load((unsigned*)ctl + CW_CNT + (l * 32 + tid) * 64, RLX_AGENT);
            __syncthreads();
            if (tid == 0) { int a = 0; for (int e = 0; e < 32; ++e) { PB[e] = a; a += (CNT[e] + 255) >> 8; } PB[32] = a; }
            __syncthreads();
            const int P = PB[32];
            const int* ROWTOK = (const int*)(ws + WS_ROWTOK);
            char* XD = (char*)(ws + WS_R1);
            for (int sb = gw * 64; sb < P * 256; sb += NGW * 64) {
                const int pm = sb >> 8; int e = 0;
#pragma unroll 1
                for (int j = 1; j < NEXP; ++j) e += (PB[j] <= pm) ? 1 : 0;
                const int pos0 = sb - PB[e] * 256, cnt = CNT[e];
                int nvalid = cnt - pos0; nvalid = nvalid > 64 ? 64 : nvalid;
                int tokv = -1; if (pos0 + lane < cnt) tokv = ROWTOK[(size_t)e * M + pos0 + lane];
#pragma unroll 1
                for (int j = 0; j < nvalid; j += 2) {
                    int t[2]; u32x4 a[2], b2[2];
#pragma unroll
                    for (int i = 0; i < 2; ++i) { t[i] = __builtin_amdgcn_readlane(tokv, j + i);
                        if (t[i] >= 0) { a[i] = *(const u32x4*)(Xb + (size_t)t[i] * 2048 + lane * 32); b2[i] = *(const u32x4*)(Xb + (size_t)t[i] * 2048 + lane * 32 + 16); } }
#pragma unroll
                    for (int i = 0; i < 2; ++i) if (t[i] >= 0) {
                        u32x4 o; o.x = pk4_f8(bflo(a[i].x) * F8_SX, bfhi(a[i].x) * F8_SX, bflo(a[i].y) * F8_SX, bfhi(a[i].y) * F8_SX); o.y = pk4_f8(bflo(a[i].z) * F8_SX, bfhi(a[i].z) * F8_SX, bflo(a[i].w) * F8_SX, bfhi(a[i].w) * F8_SX);
                        o.z = pk4_f8(bflo(b2[i].x) * F8_SX, bfhi(b2[i].x) * F8_SX, bflo(b2[i].y) * F8_SX, bfhi(b2[i].y) * F8_SX); o.w = pk4_f8(bflo(b2[i].z) * F8_SX, bfhi(b2[i].z) * F8_SX, bflo(b2[i].w) * F8_SX, bfhi(b2[i].w) * F8_SX);
                        *(u32x4*)(XD + (size_t)(sb + j + i) * 1024 + lane * 16) = o; }
                }
            }
            LAS float* scr = (LAS float*)(lds + wave * 8448);
            constexpr int IT_GU = 32 * 16 * 64, IT_DN = 32 * 16 * 32;
            for (int it = XW_SPLIT + gw; it < IT_GU + IT_DN; it += NGW) {
                if (it < IT_GU) { const int e = it >> 10, q = it & 1023, kb = q >> 6, nb = q & 63;
                    transpose_item_f8(INP(I_WGU) + (((size_t)l * 32 + e) * D + 64 * kb) * 2048 + 32 * nb, 2048, (unsigned char*)(ws + WS_WGU) + ((size_t)e * 2048 + 32 * nb) * D + 64 * kb, D, F8_SWGU, scr, lane); }
                else { const int r = it - IT_GU, e = r >> 9, q = r & 511, kb = q >> 5, nb = q & 31;
                    transpose_item_f8(INP(I_WDN) + (((size_t)l * 32 + e) * D + 64 * kb) * 1024 + 32 * nb, 1024, (unsigned char*)(ws + WS_WDN) + ((size_t)e * 1024 + 32 * nb) * D + 64 * kb, D, F8_SWDN, scr, lane); }
            }
            __syncthreads();
        }
        SEAM(pb + 8);
        if (IN(pb + 9) || IN(pb + 10)) { PHASE_TID
            if (tid < 32) CNT[tid] = (int)__hip_atomic_load((unsigned*)ctl + CW_CNT + (l * 32 + tid) * 64, RLX_AGENT);
            __syncthreads();
            if (tid == 0) { int a = 0; for (int e = 0; e < 32; ++e) { PB[e] = a; a += (CNT[e] + 255) >> 8; } PB[32] = a; }
            __syncthreads();
        }
        _Pragma("unroll 1") for (int rep_ = 0; rep_ < NREP(9); ++rep_) if (((PHMASK>>9)&1) && IN(pb + 9)) {
            SchedMoe S; S.T.init(PB[32], 8); S.G = G; S.c = bx; S.A = (const char*)(ws + WS_R1); S.W = (const char*)(ws + WS_WGU); S.C = (char*)(ws + WS_R2 + R2_HMID); S.PB = PB; S.wrows = 2048; S.ldc = 1024; S.cdiv = 2; S.osz = 1;
            pg8::EpiMoe1 E; E.bgu = INP(I_BGU) + (size_t)l * 32 * 2048;
            pg8::gemm_phase<true>(lds, D, D, D, S, E, wave);
        }
        SEAM(pb + 9);
        _Pragma("unroll 1") for (int rep_ = 0; rep_ < NREP(10); ++rep_) if (((PHMASK>>10)&1) && IN(pb + 10)) {
            SchedMoe S; S.T.init(PB[32], 4); S.G = G; S.c = bx; S.A = (const char*)(ws + WS_R2 + R2_HMID); S.W = (const char*)(ws + WS_WDN); S.C = (char*)(ws + WS_R1); S.PB = PB; S.wrows = 1024; S.ldc = 1024; S.cdiv = 1; S.osz = 2;
            pg8::EpiMoe2 E; E.bdn = INP(I_BDN) + (size_t)l * 32 * 1024;
            pg8::gemm_phase<true>(lds, D, D, D, S, E, wave);
        }
        SEAM(pb + 10);
        _Pragma("unroll 1") for (int rep_ = 0; rep_ < NREP(11); ++rep_) if (((PHMASK>>11)&1) && IN(pb + 11)) { PHASE_TID
            if (tid < 32) CNT[tid] = (int)__hip_atomic_load((unsigned*)ctl + CW_CNT + (l * 32 + tid) * 64, RLX_AGENT);
            LAS float* wgt = (LAS float*)(lds + 73728);
            const bool lastl = (l == DEPTH - 1);
            if (!lastl) load_gate_table(wgt, INP(I_WIN) + (size_t)(l + 1) * D * DIN, tid);
            __syncthreads();
            if (tid == 0) { int a = 0; for (int e = 0; e < 32; ++e) { PB[e] = a; a += (CNT[e] + 255) >> 8; } PB[32] = a; }
            __syncthreads();
            const int e0 = 8 * lane;
            f32x4 g[4], bb[4];
#pragma unroll
            for (int j = 0; j < 4; ++j) { const int o = (j >> 1) * 512 + e0 + (j & 1) * 4; g[j] = *(const f32x4*)(INP(I_LN2G) + l * D + o); bb[j] = *(const f32x4*)(INP(I_LN2B) + l * D + o); }
            const char* YA = (const char*)(ws + WS_R1);
            const bool dummy_ = (rep_ + 1 < NREP(11)); char* const Xo = dummy_ ? (char*)(ws + WS_R2) : Xb; float* const Fo = dummy_ ? (float*)(ws + WS_R2 + 256 * MiB) : args.out; float* const Go = dummy_ ? (float*)(ws + WS_R2 + 200 * MiB) : GIF;
            const int* TKE = (const int*)(ws + WS_TKE); const float* TKG = (const float*)(ws + WS_TKG); const int* TKP = (const int*)(ws + WS_TKP);
#pragma unroll 1
            for (int mb = gw * 16; mb < M; mb += NGW * 16) {
                const int ev = TKE[mb * 4 + lane], pv = TKP[mb * 4 + lane]; const float gv = TKG[mb * 4 + lane];
                const int rowv = PB[ev] * 256 + pv;
#pragma unroll 1
                for (int ti = 0; ti < 16; ti += 2) {
                    u32x4 xw[2][2], yw[2][4][2]; float gk[2][4];
#pragma unroll
                    for (int q = 0; q < 2; ++q) { const size_t m = (size_t)mb + ti + q;
                        xw[q][0] = *(const u32x4*)(Xb + (m * D + e0) * 2); xw[q][1] = *(const u32x4*)(Xb + (m * D + 512 + e0) * 2);
#pragma unroll
                        for (int k = 0; k < 4; ++k) { const size_t row = (size_t)__builtin_amdgcn_readlane(rowv, 4 * (ti + q) + k);
                            gk[q][k] = __builtin_bit_cast(float, __builtin_amdgcn_readlane(__builtin_bit_cast(int, gv), 4 * (ti + q) + k));
                            yw[q][k][0] = *(const u32x4*)(YA + (row * D + e0) * 2); yw[q][k][1] = *(const u32x4*)(YA + (row * D + 512 + e0) * 2); } }
#pragma unroll
                    for (int q = 0; q < 2; ++q) { const size_t m = (size_t)mb + ti + q;
                        f32x4 v[4];
#pragma unroll
                        for (int hh = 0; hh < 2; ++hh) { const u32x4 w = xw[q][hh];
                            v[2 * hh] = (f32x4){bflo(w.x), bfhi(w.x), bflo(w.y), bfhi(w.y)} * DN_ALPHA; v[2 * hh + 1] = (f32x4){bflo(w.z), bfhi(w.z), bflo(w.w), bfhi(w.w)} * DN_ALPHA; }
#pragma unroll
                        for (int k = 0; k < 4; ++k)
#pragma unroll
                            for (int hh = 0; hh < 2; ++hh) { const u32x4 w = yw[q][k][hh];
                                v[2 * hh] = v[2 * hh] + (f32x4){bflo(w.x), bfhi(w.x), bflo(w.y), bfhi(w.y)} * gk[q][k]; v[2 * hh + 1] = v[2 * hh + 1] + (f32x4){bflo(w.z), bfhi(w.z), bflo(w.w), bfhi(w.w)} * gk[q][k]; }
                        ln16(v, g, bb);
                        if (lastl) {
#pragma unroll
                            for (int j = 0; j < 4; ++j) *(f32x4*)(Fo + m * D + (j >> 1) * 512 + e0 + (j & 1) * 4) = v[j];
                        } else {
#pragma unroll
                            for (int hh = 0; hh < 2; ++hh) { *(u32x4*)(Xo + (m * D + hh * 512 + e0) * 2) = pg8::pack8(v[2 * hh], v[2 * hh + 1]);
                                u32x2 f8w; f8w.x = pk4_f8(v[2 * hh].x * F8_SX, v[2 * hh].y * F8_SX, v[2 * hh].z * F8_SX, v[2 * hh].w * F8_SX); f8w.y = pk4_f8(v[2 * hh + 1].x * F8_SX, v[2 * hh + 1].y * F8_SX, v[2 * hh + 1].z * F8_SX, v[2 * hh + 1].w * F8_SX);
                                if (!dummy_) *(u32x2*)((char*)(ws + WS_XF8) + m * D + hh * 512 + e0) = f8w; }
                            gates8b(v, wgt, Go + m * 8, lane);
                        }
                    }
                }
            }
            __syncthreads();
        }
        SEAM(pb + 11);
    }
#undef IN
#undef SEAM
}

extern "C" void kernel_launch(void* const* d_in, const int* in_sizes, int n_in, void* d_out, int out_size, void* d_ws, size_t ws_size, hipStream_t stream) {
    static int grid = 0;
    if (grid == 0) {
        if (n_in != N_IN || out_size != M * D || ws_size < WS_END) { fprintf(stderr, "kernel_launch: unexpected shapes (n_in %d, out %d, ws %zu)\n", n_in, out_size, ws_size); grid = -1; return; }
        int dev = 0, cus = 0, per_cu = 0;
        if (hipGetDevice(&dev) != hipSuccess || hipDeviceGetAttribute(&cus, hipDeviceAttributeMultiprocessorCount, dev) != hipSuccess) { grid = -1; return; }
        if (hipFuncSetAttribute((const void*)fwd_kernel, hipFuncAttributeMaxDynamicSharedMemorySize, LDS_BYTES) != hipSuccess) { fprintf(stderr, "kernel_launch: hipFuncSetAttribute failed\n"); grid = -1; return; }
        if (hipOccupancyMaxActiveBlocksPerMultiprocessor(&per_cu, (const void*)fwd_kernel, NTHR, LDS_BYTES) != hipSuccess || per_cu < 1) fprintf(stderr, "kernel_launch: occupancy query reports %d\n", per_cu);
        (void)hipGetLastError();
        grid = cus;
    }
    if (grid < 0) return;
    (void)hipMemsetAsync((char*)d_ws + WS_CTL, 0, CTL_ZERO_BYTES, stream);
    Args a{};
    for (int i = 0; i < N_IN; ++i) a.in[i] = (const float*)d_in[i];
    a.out = (float*)d_out; a.ws = (unsigned char*)d_ws;
#if MK_ONE_LAUNCH
    a.ph_lo = 0; a.ph_hi = NPH;
    hipLaunchKernelGGL(fwd_kernel, dim3(grid), dim3(NTHR), LDS_BYTES, stream, a);
#else
    for (int p = 0; p < NPH; ++p) { a.ph_lo = p; a.ph_hi = p + 1; hipLaunchKernelGGL(fwd_kernel, dim3(grid), dim3(NTHR), LDS_BYTES, stream, a); }
#endif
    const hipError_t le = hipPeekAtLastError();
    if (le != hipSuccess) fprintf(stderr, "kernel_launch: launch failed: %s\n", hipGetErrorName(le));
}
```

```cpp
#include <hip/hip_runtime.h>
#include <cstdio>
#include <cstdint>

#ifndef MK_ONE_LAUNCH
#define MK_ONE_LAUNCH 1
#endif

#define LAS __attribute__((address_space(3)))
#define GAS __attribute__((address_space(1)))
typedef unsigned short bf16;
typedef short bf16x8 __attribute__((ext_vector_type(8)));
typedef float f32x4 __attribute__((ext_vector_type(4)));
typedef float f32x2 __attribute__((ext_vector_type(2)));
typedef float f32x16 __attribute__((ext_vector_type(16)));
typedef unsigned u32x4 __attribute__((ext_vector_type(4)));
typedef unsigned u32x2 __attribute__((ext_vector_type(2)));
typedef __bf16 bf16x2_t __attribute__((ext_vector_type(2)));
typedef GAS unsigned gu32;
#define RLX_AGENT __ATOMIC_RELAXED, __HIP_MEMORY_SCOPE_AGENT
#define DI __device__ __forceinline__

constexpr int NWAVES = 8, NTHR = 512;
constexpr int D = 1024, BATCH = 16, SEQ = 4096, M = BATCH * SEQ, DEPTH = 2, MEML = 256, MROWS = BATCH * MEML;
constexpr int DIN = 6920, NU = 6912;
constexpr int UC_QK = 0, UC_RW = 512, UC_V = 2304, UC_OG = 2816, UC_CAQ = 3328, UC_GATE = 3840;
constexpr int UC_F8 = UC_V, NF8 = NU - UC_F8;
__host__ __device__ constexpr int ucol_src(int c) { return c < 512 ? c : (c < 2304 ? 1544 + (c - 512) : (c < 2816 ? 512 + (c - 2304) : (c < 3328 ? 1024 + (c - 2816) : (c < 3840 ? 3336 + (c - 3328) : 3848 + (c - 3840))))); }
constexpr int NEXP = 32, TOPK = 4;
constexpr int PMAX = M * TOPK / 256 + NEXP;
constexpr float LN_EPS = 1e-5f, RW_GN_EPS = 64e-5f, DN_ALPHA = 1.41421356237f;

enum { I_X = 0, I_MEM, I_LNIN_G, I_LNIN_B, I_MEMLN_G, I_MEMLN_B, I_WIN, I_CONVW, I_CONVB, I_IGB, I_FGB, I_MLNORMG, I_RWMU, I_RWW0, I_RWWUP, I_RWA0, I_RWAUP, I_RWGUP,
       I_RWKK, I_RWKA, I_RWRK, I_RWLNG, I_RWLNB, I_CAWKV, I_GATEB, I_WBRML, I_WBRRW, I_WBRCA, I_WO, I_LN1G, I_LN1B, I_RTW, I_RTB, I_WGU, I_BGU, I_WDN, I_BDN, I_LN2G, I_LN2B, N_IN };

constexpr size_t MiB = 1u << 20;
constexpr size_t WS_CTL = 0, CTL_ZERO_BYTES = 1 * MiB;
constexpr size_t WS_WIN = 1 * MiB;
constexpr size_t WS_WKV = 28 * MiB;
constexpr size_t WS_WBR = 32 * MiB;
constexpr size_t WS_WO = 38 * MiB;
constexpr size_t WS_WLORA = 42 * MiB;
constexpr size_t WS_WGU = 45 * MiB;
constexpr size_t WS_WDN = 173 * MiB;
constexpr size_t WS_X = 237 * MiB;
constexpr size_t WS_MEMN = 365 * MiB;
constexpr size_t WS_KV = 373 * MiB;
constexpr size_t WS_GIF = 389 * MiB;
constexpr size_t WS_TKE = 391 * MiB, WS_TKG = 392 * MiB, WS_TKP = 393 * MiB;
constexpr size_t WS_ROWTOK = 394 * MiB;
constexpr size_t WS_HML = 402 * MiB;
constexpr size_t WS_R1 = 466 * MiB;
constexpr size_t WS_R2 = 1330 * MiB;
constexpr size_t WS_XF8 = 1858 * MiB;
constexpr size_t WS_WING8 = 1922 * MiB;
constexpr size_t WS_END = 1932 * MiB;
constexpr size_t R2_LORA_OUT = 0, R2_HCAT = 192 * MiB, R2_LORA_IN = 384 * MiB, R2_YPRE = 0, R2_Z = 192 * MiB, R2_HMID = 0;
constexpr int CW_TMO = 0, CW_BAR = 4096, CW_CNT = 16384, CW_FILL = 32768;

constexpr int LDS_BYTES = 155648;
constexpr int LDSCTL_OFF = 153600;

DI unsigned pk2(float lo, float hi) { bf16x2_t b = __builtin_convertvector((f32x2){lo, hi}, bf16x2_t); return __builtin_bit_cast(unsigned, b); }
DI unsigned f2bf(float f) { return pk2(f, 0.f) & 0xffffu; }
DI float u2f_(unsigned u) { return __builtin_bit_cast(float, u); }
DI unsigned f2u_(float f) { return __builtin_bit_cast(unsigned, f); }
DI float bflo(unsigned u) { return __builtin_bit_cast(float, u << 16); }
DI float bfhi(unsigned u) { return __builtin_bit_cast(float, u & 0xffff0000u); }
DI unsigned pk4_f8(float a, float b, float c, float d) {
    a = __builtin_amdgcn_fmed3f(a, -448.f, 448.f); b = __builtin_amdgcn_fmed3f(b, -448.f, 448.f); c = __builtin_amdgcn_fmed3f(c, -448.f, 448.f); d = __builtin_amdgcn_fmed3f(d, -448.f, 448.f);
    int w = 0; w = __builtin_amdgcn_cvt_pk_fp8_f32(a, b, w, false); w = __builtin_amdgcn_cvt_pk_fp8_f32(c, d, w, true); return (unsigned)w; }
DI float sigmoidf_(float x) { return __builtin_amdgcn_rcpf(1.f + __builtin_amdgcn_exp2f(-1.4426950408889634f * x)); }
template <int CTRL> DI float dppf(float x) { return __builtin_bit_cast(float, __builtin_amdgcn_update_dpp(0, __builtin_bit_cast(int, x), CTRL, 0xF, 0xF, true)); }
DI float red4(float x) { x += dppf<0xB1>(x); x += dppf<0x4E>(x); return x; }
DI float red8(float x) { x = red4(x); x += dppf<0x141>(x); return x; }
DI float red16(float x) { x = red8(x); x += dppf<0x140>(x); return x; }
DI float red8o(float x) { x += dppf<0xB1>(x); asm("" : "+v"(x)); x += dppf<0x4E>(x); asm("" : "+v"(x)); x += dppf<0x141>(x); asm("" : "+v"(x)); return x; }
DI float red16o(float x) { x = red8o(x); x += dppf<0x140>(x); asm("" : "+v"(x)); return x; }
typedef short s16x4 __attribute__((ext_vector_type(4)));
DI u32x2 trd4(const LAS unsigned char* img, int PB, int rowbase, int colbase, int lane) {
    const LAS unsigned char* p = img + (rowbase + ((lane & 15) >> 2)) * PB + (colbase + 16 * ((lane >> 4) & 1) + 4 * (lane & 3)) * 2;
    return __builtin_bit_cast(u32x2, __builtin_amdgcn_ds_read_tr16_b64_v4i16((LAS s16x4*)p)); }
DI bf16x8 trd8(const LAS unsigned char* img, int PB, int rb0, int rb1, int colbase, int lane) { const u32x2 lo = trd4(img, PB, rb0, colbase, lane), hi = trd4(img, PB, rb1, colbase, lane); return __builtin_bit_cast(bf16x8, (u32x4){lo.x, lo.y, hi.x, hi.y}); }
template <int CTRL, int RM> DI float dpp_keep(float x, float ident) { return __builtin_bit_cast(float, __builtin_amdgcn_update_dpp(__builtin_bit_cast(int, ident), __builtin_bit_cast(int, x), CTRL, RM, 0xF, false)); }
DI float scan_add64(float x) { x += dpp_keep<0x111, 0xF>(x, 0.f); x += dpp_keep<0x112, 0xF>(x, 0.f); x += dpp_keep<0x114, 0xF>(x, 0.f); x += dpp_keep<0x118, 0xF>(x, 0.f); x += dpp_keep<0x142, 0xA>(x, 0.f); x += dpp_keep<0x143, 0xC>(x, 0.f); return x; }
DI float scan_max64(float x) { const float NI = -3.0e38f; x = fmaxf(x, dpp_keep<0x111, 0xF>(x, NI)); x = fmaxf(x, dpp_keep<0x112, 0xF>(x, NI)); x = fmaxf(x, dpp_keep<0x114, 0xF>(x, NI)); x = fmaxf(x, dpp_keep<0x118, 0xF>(x, NI));
    x = fmaxf(x, dpp_keep<0x142, 0xA>(x, NI)); x = fmaxf(x, dpp_keep<0x143, 0xC>(x, NI)); return x; }
DI float wave_sum(float v) {
    v = red16(v);
    const int vi = __builtin_bit_cast(int, v);
    const float a = __builtin_bit_cast(float, __builtin_amdgcn_readlane(vi, 0)), b = __builtin_bit_cast(float, __builtin_amdgcn_readlane(vi, 16));
    const float c = __builtin_bit_cast(float, __builtin_amdgcn_readlane(vi, 32)), d = __builtin_bit_cast(float, __builtin_amdgcn_readlane(vi, 48));
    return (a + b) + (c + d);
}
#define LDS_WAIT() asm volatile("s_waitcnt lgkmcnt(0)" ::: "memory")

constexpr float F8_SX = 8.f, F8_SWGU = 512.f, F8_SH = 4.f, F8_SWDN = 1024.f, F8_INV1 = 1.f / (F8_SX * F8_SWGU), F8_INV2 = 1.f / (F8_SH * F8_SWDN);
namespace pg8 {
constexpr int BM = 256, BK = 64, HALF = 128, HTB = HALF * BK * 2, STAGE_BYTES = 8 * HTB, NXCD = 8, WGM = 8;
__host__ __device__ __forceinline__ int lds_byte(int r, int c) { const int st = (r >> 4) * 2 + (c >> 5), rr = r & 15, cc = c & 31, ob = rr * 64 + cc * 2; return st * 1024 + (ob ^ (((ob >> 9) & 1) << 5)); }
__host__ __device__ __forceinline__ void stage_rc(int b, int& R, int& C) { const int st = b / 1024, sb = b % 1024, swz = sb ^ (((sb >> 9) & 1) << 5); R = (st >> 1) * 16 + swz / 64; C = (st & 1) * 32 + (swz % 64) / 2; }
__host__ __device__ __forceinline__ int perm32(int rho) { const int n = rho >> 4, i = rho & 15; return 8 * (i >> 2) + 4 * n + (i & 3); }

struct Unit { const char* a; const char* b; char* c; int ldc; int r0, c0, e, sub; };

struct TileOrder {
    int nM, nN, nwg;
    DI void init(int nM_, int nN_) { nM = nM_; nN = nN_; nwg = nM * nN; }
    DI bool tile(long L, int& pm, int& pn) const {
        if (L >= nwg) return false;
        int wgid = (int)L; { const int q = nwg / NXCD, r = nwg % NXCD, xcd = wgid % NXCD, off = wgid / NXCD; wgid = (xcd < r ? xcd * (q + 1) : r * (q + 1) + (xcd - r) * q) + off; }
        const int nig = WGM * nN, gid = wgid / nig, fm = gid * WGM, gsz = (nM - fm) < WGM ? (nM - fm) : WGM;
        pm = fm + ((wgid % nig) % gsz); pn = (wgid % nig) / gsz; return true;
    }
};

DI u32x4 pack8(const f32x4& v0, const f32x4& v1) { u32x4 w; w.x = pk2(v0[0], v0[1]); w.y = pk2(v0[2], v0[3]); w.z = pk2(v1[0], v1[1]); w.w = pk2(v1[2], v1[3]); return w; }

struct EpiStore {
    DI void operator()(const f32x4 (&acc)[2][2][4][2], const Unit& u, int wr, int wc, int fr, int fq) const {
#pragma unroll
        for (int ai = 0; ai < 2; ++ai)
#pragma unroll
            for (int m = 0; m < 4; ++m) { char* rowp = u.c + ((size_t)(ai * HALF + wr * 64 + m * 16 + fr) * u.ldc + wc * 32 + 8 * fq) * 2;
#pragma unroll
                for (int bj = 0; bj < 2; ++bj) *(u32x4*)(rowp + bj * 256) = pack8(acc[ai][bj][m][0], acc[ai][bj][m][1]); }
    }
};
struct EpiStoreS {
    float s; const float* gate_b; int gate_c0;
    DI void operator()(const f32x4 (&acc)[2][2][4][2], const Unit& u, int wr, int wc, int fr, int fq) const {
        const bool gate = u.c0 >= gate_c0;
        const float L2E = 1.4426950408889634f;
#pragma unroll
        for (int bj = 0; bj < 2; ++bj) {
            f32x4 g0 = (f32x4){0.f, 0.f, 0.f, 0.f}, g1 = g0;
            if (gate) { const float* g = gate_b + (u.c0 - gate_c0) + bj * HALF + wc * 32 + 8 * fq; g0 = *(const f32x4*)g; g1 = *(const f32x4*)(g + 4); }
#pragma unroll
            for (int ai = 0; ai < 2; ++ai)
#pragma unroll
                for (int m = 0; m < 4; ++m) { char* rowp = u.c + ((size_t)(ai * HALF + wr * 64 + m * 16 + fr) * u.ldc + wc * 32 + 8 * fq) * 2;
                    f32x4 v0 = acc[ai][bj][m][0] * s, v1 = acc[ai][bj][m][1] * s;
                    if (gate) {
#pragma unroll
                        for (int i = 0; i < 4; ++i) { v0[i] = __builtin_amdgcn_exp2f(-L2E * __builtin_amdgcn_fmed3f(v0[i] + g0[i], -30.f, 30.f)); v1[i] = __builtin_amdgcn_exp2f(-L2E * __builtin_amdgcn_fmed3f(v1[i] + g1[i], -30.f, 30.f)); } }
                    *(u32x4*)(rowp + bj * 256) = pack8(v0, v1); }
        }
    }
};
struct EpiMerge {
    static constexpr bool MIDK = true;
    const char* U; const float* gate_b;
    DI void mid(f32x4 (&acc)[2][2][4][2], const Unit& u, int which, int wr, int wc, int fr, int fq) const {
#pragma unroll
        for (int bj = 0; bj < 2; ++bj)
#pragma unroll
            for (int ai = 0; ai < 2; ++ai) {
                u32x4 wa[4], wn[4];
#pragma unroll
                for (int m = 0; m < 4; ++m) { const int lr = ai * HALF + wr * 64 + m * 16 + fr;
                    const char* gp = U + ((size_t)(u.r0 + lr) * NU + UC_GATE + which * 1024 + u.c0 + wc * 32 + 8 * fq) * 2 + bj * 256;
                    wa[m] = *(const u32x4*)gp; wn[m] = *(const u32x4*)(gp + 2048); }
#pragma unroll
                for (int m = 0; m < 4; ++m) {
                    const u32x4 a = wa[m], n = wn[m];
                    const float ea[8] = {bflo(a.x), bfhi(a.x), bflo(a.y), bfhi(a.y), bflo(a.z), bfhi(a.z), bflo(a.w), bfhi(a.w)};
                    const float en[8] = {bflo(n.x), bfhi(n.x), bflo(n.y), bfhi(n.y), bflo(n.z), bfhi(n.z), bflo(n.w), bfhi(n.w)};
#pragma unroll
                    for (int i = 0; i < 8; ++i) acc[ai][bj][m][i >> 2][i & 3] *= (1.f + en[i]) * __builtin_amdgcn_rcpf(1.f + ea[i]); }
                asm volatile("" ::: "memory"); }
    }
    DI void operator()(const f32x4 (&acc)[2][2][4][2], const Unit& u, int wr, int wc, int fr, int fq) const {
#pragma unroll
        for (int bj = 0; bj < 2; ++bj) {
            u32x4 gw[2][4];
#pragma unroll
            for (int ai = 0; ai < 2; ++ai)
#pragma unroll
                for (int m = 0; m < 4; ++m) { const int lr = ai * HALF + wr * 64 + m * 16 + fr; gw[ai][m] = *(const u32x4*)(U + ((size_t)(u.r0 + lr) * NU + UC_GATE + 2048 + u.c0 + wc * 32 + 8 * fq) * 2 + bj * 256); }
#pragma unroll
            for (int ai = 0; ai < 2; ++ai)
#pragma unroll
                for (int m = 0; m < 4; ++m) { const int lr = ai * HALF + wr * 64 + m * 16 + fr; char* rowp = u.c + ((size_t)lr * u.ldc + wc * 32 + 8 * fq) * 2; const u32x4 w = gw[ai][m];
                    f32x4 v0 = acc[ai][bj][m][0], v1 = acc[ai][bj][m][1];
                    v0[0] *= __builtin_amdgcn_rcpf(1.f + bflo(w.x)); v0[1] *= __builtin_amdgcn_rcpf(1.f + bfhi(w.x)); v0[2] *= __builtin_amdgcn_rcpf(1.f + bflo(w.y)); v0[3] *= __builtin_amdgcn_rcpf(1.f + bfhi(w.y));
                    v1[0] *= __builtin_amdgcn_rcpf(1.f + bflo(w.z)); v1[1] *= __builtin_amdgcn_rcpf(1.f + bfhi(w.z)); v1[2] *= __builtin_amdgcn_rcpf(1.f + bflo(w.w)); v1[3] *= __builtin_amdgcn_rcpf(1.f + bfhi(w.w));
                    *(u32x4*)(rowp + bj * 256) = pack8(v0, v1); }
            asm volatile("" ::: "memory");
        }
    }
};
struct EpiWo {
    const char* X;
    DI void operator()(const f32x4 (&acc)[2][2][4][2], const Unit& u, int wr, int wc, int fr, int fq) const {
#pragma unroll
        for (int ai = 0; ai < 2; ++ai)
#pragma unroll
            for (int m = 0; m < 4; ++m) { const int lr = ai * HALF + wr * 64 + m * 16 + fr; char* rowp = u.c + ((size_t)lr * u.ldc + wc * 32 + 8 * fq) * 2;
                const char* xp = X + ((size_t)(u.r0 + lr) * D + u.c0 + wc * 32 + 8 * fq) * 2;
#pragma unroll
                for (int bj = 0; bj < 2; ++bj) { const u32x4 xw = *(const u32x4*)(xp + bj * 256);
                    f32x4 v0 = acc[ai][bj][m][0], v1 = acc[ai][bj][m][1];
                    v0[0] += DN_ALPHA * bflo(xw.x); v0[1] += DN_ALPHA * bfhi(xw.x); v0[2] += DN_ALPHA * bflo(xw.y); v0[3] += DN_ALPHA * bfhi(xw.y);
                    v1[0] += DN_ALPHA * bflo(xw.z); v1[1] += DN_ALPHA * bfhi(xw.z); v1[2] += DN_ALPHA * bflo(xw.w); v1[3] += DN_ALPHA * bfhi(xw.w);
                    *(u32x4*)(rowp + bj * 256) = pack8(v0, v1); }
                asm volatile("" ::: "memory"); }
    }
};
DI float swiglu1(float a, float b) { const float g = fminf(a, 7.f), l = fminf(fmaxf(b, -7.f), 7.f); return g * sigmoidf_(1.702f * g) * (l + 1.f); }
struct EpiMoe1 {
    const float* bgu;
    DI void operator()(const f32x4 (&acc)[2][2][4][2], const Unit& u, int wr, int wc, int fr, int fq) const {
        f32x4 bv[2][2];
#pragma unroll
        for (int bj = 0; bj < 2; ++bj) { const float* b = bgu + u.e * 2048 + u.c0 + bj * HALF + wc * 32 + 8 * fq; bv[bj][0] = *(const f32x4*)b; bv[bj][1] = *(const f32x4*)(b + 4); }
#pragma unroll
        for (int ai = 0; ai < 2; ++ai)
#pragma unroll
            for (int m = 0; m < 4; ++m) { const int lr = ai * HALF + wr * 64 + m * 16 + fr; char* rowp = u.c + ((size_t)lr * u.ldc + wc * 16 + 4 * fq);
#pragma unroll
                for (int bj = 0; bj < 2; ++bj) { const f32x4 v0 = acc[ai][bj][m][0] * F8_INV1 + bv[bj][0], v1 = acc[ai][bj][m][1] * F8_INV1 + bv[bj][1];
                    *(unsigned*)(rowp + bj * 64) = pk4_f8(swiglu1(v0[0], v0[1]) * F8_SH, swiglu1(v0[2], v0[3]) * F8_SH, swiglu1(v1[0], v1[1]) * F8_SH, swiglu1(v1[2], v1[3]) * F8_SH); } }
    }
};
struct EpiMoe2 {
    const float* bdn;
    DI void operator()(const f32x4 (&acc)[2][2][4][2], const Unit& u, int wr, int wc, int fr, int fq) const {
        f32x4 bv[2][2];
#pragma unroll
        for (int bj = 0; bj < 2; ++bj) { const float* b = bdn + u.e * 1024 + u.c0 + bj * HALF + wc * 32 + 8 * fq; bv[bj][0] = *(const f32x4*)b; bv[bj][1] = *(const f32x4*)(b + 4); }
#pragma unroll
        for (int ai = 0; ai < 2; ++ai)
#pragma unroll
            for (int m = 0; m < 4; ++m) { char* rowp = u.c + ((size_t)(ai * HALF + wr * 64 + m * 16 + fr) * u.ldc + wc * 32 + 8 * fq) * 2;
#pragma unroll
                for (int bj = 0; bj < 2; ++bj) *(u32x4*)(rowp + bj * 256) = pack8(acc[ai][bj][m][0] * F8_INV2 + bv[bj][0], acc[ai][bj][m][1] * F8_INV2 + bv[bj][1]); }
    }
};

typedef int i32x8 __attribute__((ext_vector_type(8)));
typedef int i32x4 __attribute__((ext_vector_type(4)));
template <bool F8, bool MIDK = false, class Epi, class Sched>
DI void gemm_phase(LAS unsigned char* lds, const int KB  , const int ldaB, const int ldbB, const Sched& S, const Epi& E, const int wave_) {
    unsigned z_ = 0u; asm volatile("" : "+v"(z_)); const int tid = wave_ * 64 + (int)__builtin_amdgcn_mbcnt_hi(~0u, __builtin_amdgcn_mbcnt_lo(~0u, z_));
    const int wid = __builtin_amdgcn_readfirstlane(tid >> 6), lane = tid & 63, wr = wid >> 2, wc = wid & 3, fr = lane & 15, fq = lane >> 4;
    const int nt = KB / (BK * 2);
    unsigned voffA[2], voffB[2];
#pragma unroll
    for (int i = 0; i < 2; ++i) { int R, C; stage_rc(tid * 16 + i * 8192, R, C); const int Rb = (R & ~31) + perm32(R & 31);
        voffA[i] = (unsigned)(R * ldaB + C * 2); voffB[i] = (unsigned)(Rb * ldbB + C * 2); }
    asm volatile("" : "+v"(voffA[0]), "+v"(voffA[1]), "+v"(voffB[0]), "+v"(voffB[1]));
    const size_t kstep = (size_t)(BK * 2);
    const size_t hstepA = (size_t)HALF * ldaB, hstepB = (size_t)HALF * ldbB;
    const unsigned ldsw = (unsigned)wid * 1024u;
    const int aoff = lds_byte(wr * 64 + fr, fq * 8), boff = lds_byte(wc * 32 + fr, fq * 8);
#define PG8_SA(b, h) (((b) * 2 + (h)) * HTB)
#define PG8_SB(b, h) ((4 + (b) * 2 + (h)) * HTB)
#define PG8_STAGE(bufoff, gbase, voff) do { _Pragma("unroll") for (int _i = 0; _i < 2; ++_i) \
        __builtin_amdgcn_global_load_lds((const unsigned*)((const char*)(gbase) + (voff)[_i]), (LAS unsigned*)(lds + (bufoff) + ldsw + _i * 8192), 16, 0, 0); } while (0)
#define PG8_LD8(p) __builtin_shufflevector(*(const LAS i32x4*)(p), *(const LAS i32x4*)((p) + 1024), 0, 1, 2, 3, 4, 5, 6, 7)
#define PG8_LDA8(dst, b, h) do { _Pragma("unroll") for (int m = 0; m < 4; ++m) dst[m] = PG8_LD8(lds + PG8_SA(b, h) + aoff + m * 2048); } while (0)
#define PG8_LDB8(dst, b, h) do { _Pragma("unroll") for (int n = 0; n < 2; ++n) dst[n] = PG8_LD8(lds + PG8_SB(b, h) + boff + n * 2048); } while (0)
#define PG8_MMA8(ai, bj, A8, B8) do { __builtin_amdgcn_s_setprio(1); _Pragma("unroll") for (int m = 0; m < 4; ++m) _Pragma("unroll") for (int n = 0; n < 2; ++n) \
        asm volatile("v_mfma_f32_16x16x128_f8f6f4 %0, %1, %2, %0" : "+v"(acc[ai][bj][m][n]) : "v"(B8[n]), "v"(A8[m])); __builtin_amdgcn_s_setprio(0); } while (0)
#define PG8_LDA(dst, b, h) do { _Pragma("unroll") for (int m = 0; m < 4; ++m) _Pragma("unroll") for (int k = 0; k < 2; ++k) dst[m][k] = *(const LAS bf16x8*)(lds + PG8_SA(b, h) + aoff + m * 2048 + k * 1024); } while (0)
#define PG8_LDB(dst, b, h) do { _Pragma("unroll") for (int n = 0; n < 2; ++n) _Pragma("unroll") for (int k = 0; k < 2; ++k) dst[n][k] = *(const LAS bf16x8*)(lds + PG8_SB(b, h) + boff + n * 2048 + k * 1024); } while (0)
#define PG8_CAT(x) __builtin_shufflevector(__builtin_bit_cast(i32x4, (x)[0]), __builtin_bit_cast(i32x4, (x)[1]), 0, 1, 2, 3, 4, 5, 6, 7)
#define PG8_MMA(ai, bj, At, Bt) do { __builtin_amdgcn_s_setprio(1); _Pragma("unroll") for (int m = 0; m < 4; ++m) _Pragma("unroll") for (int n = 0; n < 2; ++n) _Pragma("unroll") for (int k = 0; k < 2; ++k) \
        acc[ai][bj][m][n] = __builtin_amdgcn_mfma_f32_16x16x32_bf16(Bt[n][k], At[m][k], acc[ai][bj][m][n], 0, 0, 0); __builtin_amdgcn_s_setprio(0); } while (0)
#define PG8_WAIT_V(n) asm volatile("s_waitcnt vmcnt(" #n ")" ::: "memory")
#define PG8_WAIT_L(n) asm volatile("s_waitcnt lgkmcnt(" #n ")" ::: "memory")
#define PG8_BAR __builtin_amdgcn_s_barrier()
#define PG8_SCHED __builtin_amdgcn_sched_barrier(0)
    Unit cur, nxt; int ui = 0;
    if (!S.next(0, cur)) return;
    f32x4 acc[2][2][4][2];
#pragma unroll
    for (int a = 0; a < 2; ++a)
#pragma unroll
        for (int b = 0; b < 2; ++b)
#pragma unroll
            for (int m = 0; m < 4; ++m)
#pragma unroll
                for (int n = 0; n < 2; ++n) acc[a][b][m][n] = (f32x4){0.f, 0.f, 0.f, 0.f};
    bf16x8 At[4][2], B0[2][2], B1[2][2]; i32x8 A8[4], B80[2], B81[2];
    const char* cA = cur.a; const char* cB = cur.b;
    PG8_STAGE(PG8_SB(0, 0), cB, voffB); PG8_STAGE(PG8_SB(0, 1), cB + hstepB, voffB); PG8_STAGE(PG8_SA(0, 0), cA, voffA); PG8_STAGE(PG8_SA(0, 1), cA + hstepA, voffA);
    if (wr == 1) PG8_BAR;
    PG8_WAIT_V(2); PG8_BAR;
    PG8_STAGE(PG8_SB(1, 0), cB + kstep, voffB); PG8_STAGE(PG8_SA(1, 0), cA + kstep, voffA); PG8_STAGE(PG8_SB(1, 1), cB + hstepB + kstep, voffB);
    PG8_WAIT_V(6); PG8_BAR;
    for (;;) {
        const bool has_next = S.next(ui + 1, nxt);
        const char* nA = has_next ? nxt.a : cA; const char* nB = has_next ? nxt.b : cB;
#pragma unroll 1
        for (int t = 0; t < nt; t += 2) {
            if constexpr (MIDK) { if (t == 8 || t == 16) { int fr_ = fr, fq_ = fq; asm volatile("" : "+v"(fr_), "+v"(fq_)); E.mid(acc, cur, t >> 4, wr, wc, fr_, fq_); } }
            const bool last = (t == nt - 2);
            const char* a1 = cA + (size_t)(t + 1) * kstep;
            const char* a2 = last ? nA : cA + (size_t)(t + 2) * kstep; const char* b2 = last ? nB : cB + (size_t)(t + 2) * kstep;
            const char* a3 = a2 + kstep; const char* b3 = b2 + kstep;
            if constexpr (F8) {
            PG8_LDB8(B80, 0, 0); PG8_LDB8(B81, 0, 1); PG8_SCHED; PG8_LDA8(A8, 0, 0); PG8_STAGE(PG8_SA(1, 1), a1 + hstepA, voffA);
            PG8_WAIT_V(8); PG8_WAIT_L(0); PG8_BAR; PG8_MMA8(0, 0, A8, B80); PG8_MMA8(0, 1, A8, B81); PG8_BAR; PG8_SCHED;
            PG8_LDA8(A8, 0, 1); PG8_STAGE(PG8_SB(0, 0), b2, voffB); PG8_STAGE(PG8_SB(0, 1), b2 + hstepB, voffB); PG8_STAGE(PG8_SA(0, 0), a2, voffA);
            PG8_WAIT_V(8); PG8_WAIT_L(0); PG8_BAR; PG8_MMA8(1, 0, A8, B80); PG8_MMA8(1, 1, A8, B81); PG8_BAR; PG8_SCHED;
            PG8_LDB8(B80, 1, 0); PG8_LDB8(B81, 1, 1); PG8_SCHED; PG8_LDA8(A8, 1, 0); PG8_STAGE(PG8_SA(0, 1), a2 + hstepA, voffA);
            PG8_WAIT_V(8); PG8_WAIT_L(0); PG8_BAR; PG8_MMA8(0, 0, A8, B80); PG8_MMA8(0, 1, A8, B81); PG8_BAR; PG8_SCHED;
            PG8_LDA8(A8, 1, 1); PG8_STAGE(PG8_SB(1, 0), b3, voffB); PG8_STAGE(PG8_SB(1, 1), b3 + hstepB, voffB); PG8_STAGE(PG8_SA(1, 0), a3, voffA);
            PG8_WAIT_V(8); PG8_WAIT_L(0); PG8_BAR; PG8_MMA8(1, 0, A8, B80); PG8_MMA8(1, 1, A8, B81); PG8_BAR; PG8_SCHED;
            } else {
            PG8_LDB(B0, 0, 0); PG8_LDB(B1, 0, 1); PG8_SCHED; PG8_LDA(At, 0, 0); PG8_STAGE(PG8_SA(1, 1), a1 + hstepA, voffA);
            PG8_WAIT_V(8); PG8_WAIT_L(0); PG8_BAR; PG8_MMA(0, 0, At, B0); PG8_MMA(0, 1, At, B1); PG8_BAR; PG8_SCHED;
            PG8_LDA(At, 0, 1); PG8_STAGE(PG8_SB(0, 0), b2, voffB); PG8_STAGE(PG8_SB(0, 1), b2 + hstepB, voffB); PG8_STAGE(PG8_SA(0, 0), a2, voffA);
            PG8_WAIT_V(8); PG8_WAIT_L(0); PG8_BAR; PG8_MMA(1, 0, At, B0); PG8_MMA(1, 1, At, B1); PG8_BAR; PG8_SCHED;
            PG8_LDB(B0, 1, 0); PG8_LDB(B1, 1, 1); PG8_SCHED; PG8_LDA(At, 1, 0); PG8_STAGE(PG8_SA(0, 1), a2 + hstepA, voffA);
            PG8_WAIT_V(8); PG8_WAIT_L(0); PG8_BAR; PG8_MMA(0, 0, At, B0); PG8_MMA(0, 1, At, B1); PG8_BAR; PG8_SCHED;
            PG8_LDA(At, 1, 1); PG8_STAGE(PG8_SB(1, 0), b3, voffB); PG8_STAGE(PG8_SB(1, 1), b3 + hstepB, voffB); PG8_STAGE(PG8_SA(1, 0), a3, voffA);
            PG8_WAIT_V(8); PG8_WAIT_L(0); PG8_BAR; PG8_MMA(1, 0, At, B0); PG8_MMA(1, 1, At, B1); PG8_BAR; PG8_SCHED;
            }
        }
        if (wr == 0) PG8_BAR;
        if constexpr (F8) asm volatile("s_nop 15\n\ts_nop 15" ::: "memory");
        { int fr_ = fr, fq_ = fq; asm volatile("" : "+v"(fr_), "+v"(fq_));
          E(acc, cur, wr, wc, fr_, fq_); }
        if (!has_next) break;
#pragma unroll
        for (int a = 0; a < 2; ++a)
#pragma unroll
            for (int b = 0; b < 2; ++b)
#pragma unroll
                for (int m = 0; m < 4; ++m)
#pragma unroll
                    for (int n = 0; n < 2; ++n) acc[a][b][m][n] = (f32x4){0.f, 0.f, 0.f, 0.f};
        cur = nxt; cA = nA; cB = nB; ++ui;
        if (wr == 1) PG8_BAR;
    }
    PG8_WAIT_V(0);
    PG8_BAR;
#undef PG8_SA
#undef PG8_SB
#undef PG8_STAGE
#undef PG8_LDA
#undef PG8_LDB
#undef PG8_MMA
#undef PG8_CAT
#undef PG8_LD8
#undef PG8_LDA8
#undef PG8_LDB8
#undef PG8_MMA8
#undef PG8_WAIT_V
#undef PG8_WAIT_L
#undef PG8_BAR
#undef PG8_SCHED
}
}

#define XB_TMO      128
#define XB_XCNT(j)  (256  + 64 * (j))
#define XB_XSUB(j)  (1280 + 64 * (j))
#define XB_XGEN(j)  (2304 + 64 * (j))
#define XB_TOP      3328
#define XB_TOPGEN   3392
#define XCD_BAR_WORDS 3456
#define XB_SPIN_CAP (1u << 22)
DI unsigned xb_ld(unsigned* p)              { return __hip_atomic_load(p, __ATOMIC_RELAXED, __HIP_MEMORY_SCOPE_AGENT); }
DI unsigned xb_add(unsigned* p, unsigned v) { return __hip_atomic_fetch_add(p, v, __ATOMIC_RELAXED, __HIP_MEMORY_SCOPE_AGENT); }
DI unsigned xb_xcc_id() { return (unsigned)__builtin_amdgcn_s_getreg((3 << 11) | 20) & 0xFu; }
#define XB_SPIN(cond, bar) do { unsigned _sp = 0; while (cond) { __builtin_amdgcn_s_sleep(1); \
    if ((++_sp & 255u) == 0u) { if (xb_ld(&(bar)[XB_TMO])) break; if (_sp > XB_SPIN_CAP) { atomicAdd(&(bar)[XB_TMO], 1u); break; } } } } while (0)
struct XcdBarrier { unsigned* bar; unsigned x; volatile LAS unsigned* st; };
DI XcdBarrier xcd_barrier_post(unsigned* bar, volatile LAS unsigned* st) {
    XcdBarrier b; b.bar = bar; b.x = xb_xcc_id(); b.st = st;
    if (threadIdx.x == 0) (void)xb_add(&bar[XB_XCNT(b.x)], 1u);
    return b;
}
DI void xcd_barrier_complete(unsigned* bar, unsigned x, unsigned& nloc, unsigned& nx) {
    const unsigned G = gridDim.x * gridDim.y * gridDim.z;
    unsigned sum, cnt, mine, sp = 0u;
    for (;;) {
        sum = 0u; cnt = 0u; mine = 0u;
#pragma unroll
        for (unsigned j = 0; j < 16; ++j) { const unsigned c = xb_ld(&bar[XB_XCNT(j)]); sum += c; cnt += (c > 0u) ? 1u : 0u; mine = (j == x) ? c : mine; }
        if (sum == G) break;
        __builtin_amdgcn_s_sleep(1);
        if ((++sp & 255u) == 0u) { if (xb_ld(&bar[XB_TMO])) break; if (sp > XB_SPIN_CAP) { atomicAdd(&bar[XB_TMO], 1u); break; } }
    }
    nloc = mine > 0u ? mine : 1u; nx = cnt > 0u ? cnt : 1u;
}
DI void xcd_barrier(const XcdBarrier& b) {
    asm volatile("s_waitcnt vmcnt(0)" ::: "memory");
    __syncthreads();
    if (threadIdx.x == 0) {
        unsigned* bar = b.bar;
        __builtin_amdgcn_s_waitcnt(0);
        unsigned nloc = b.st[0], nx = b.st[1];
        if (nloc == 0u) { xcd_barrier_complete(bar, b.x, nloc, nx); b.st[0] = nloc; b.st[1] = nx; }
        const unsigned old = xb_add(&bar[XB_XSUB(b.x)], 1u);
        const unsigned gen = old / nloc;
        if (old + 1u == (gen + 1u) * nloc) {
            __builtin_amdgcn_fence(__ATOMIC_RELEASE, "agent");
            asm volatile("s_waitcnt vmcnt(0)" ::: "memory");
            const unsigned og = xb_add(&bar[XB_TOP], 1u);
            const unsigned tg = og / nx;
            if (og + 1u == (tg + 1u) * nx) xb_add(&bar[XB_TOPGEN], 1u);
            else XB_SPIN(xb_ld(&bar[XB_TOPGEN]) == tg, bar);
            __builtin_amdgcn_fence(__ATOMIC_ACQUIRE, "agent");
            xb_add(&bar[XB_XGEN(b.x)], 1u);
            asm volatile("s_waitcnt vmcnt(0)" ::: "memory");
        } else {
            XB_SPIN(xb_ld(&bar[XB_XGEN(b.x)]) == gen, bar);
            __builtin_amdgcn_fence(__ATOMIC_ACQUIRE, "agent");
            asm volatile("s_waitcnt vmcnt(0)" ::: "memory");
        }
    }
    __syncthreads();
}

DI void transpose_item(const float* W, int ldw, bf16* WT, int ldt, LAS float* scr, int lane) {
    { const int kr = lane >> 3, c4 = (lane & 7) * 4; f32x4 v[8];
#pragma unroll
        for (int i = 0; i < 8; ++i) v[i] = *(const f32x4*)(W + (size_t)(8 * i + kr) * ldw + c4);
#pragma unroll
        for (int i = 0; i < 8; ++i) { LAS float* o = scr + (8 * i + kr) * 33 + c4; o[0] = v[i].x; o[1] = v[i].y; o[2] = v[i].z; o[3] = v[i].w; } }
    LDS_WAIT(); asm volatile("" ::: "memory");
    const int c = lane & 7;
#pragma unroll
    for (int j = 0; j < 4; ++j) { const int n = (lane >> 3) + 8 * j; const LAS float* s = scr + (8 * c) * 33 + n;
        u32x4 o; o.x = pk2(s[0 * 33], s[1 * 33]); o.y = pk2(s[2 * 33], s[3 * 33]); o.z = pk2(s[4 * 33], s[5 * 33]); o.w = pk2(s[6 * 33], s[7 * 33]);
        *(u32x4*)(WT + (size_t)n * ldt + 8 * c) = o; }
    LDS_WAIT(); asm volatile("" ::: "memory");
}
DI void transpose_item_f8(const float* W, int ldw, unsigned char* WT, int ldt, float scale, LAS float* scr, int lane) {
    { const int kr = lane >> 3, c4 = (lane & 7) * 4; f32x4 v[8];
#pragma unroll
        for (int i = 0; i < 8; ++i) v[i] = *(const f32x4*)(W + (size_t)(8 * i + kr) * ldw + c4);
#pragma unroll
        for (int i = 0; i < 8; ++i) { LAS float* o = scr + (8 * i + kr) * 33 + c4; o[0] = v[i].x; o[1] = v[i].y; o[2] = v[i].z; o[3] = v[i].w; } }
    LDS_WAIT(); asm volatile("" ::: "memory");
    const int c = lane & 3;
#pragma unroll
    for (int j = 0; j < 2; ++j) { const int n = (lane >> 2) + 16 * j; const LAS float* s = scr + (16 * c) * 33 + n;
        u32x4 o; o.x = pk4_f8(s[0 * 33] * scale, s[1 * 33] * scale, s[2 * 33] * scale, s[3 * 33] * scale); o.y = pk4_f8(s[4 * 33] * scale, s[5 * 33] * scale, s[6 * 33] * scale, s[7 * 33] * scale);
        o.z = pk4_f8(s[8 * 33] * scale, s[9 * 33] * scale, s[10 * 33] * scale, s[11 * 33] * scale); o.w = pk4_f8(s[12 * 33] * scale, s[13 * 33] * scale, s[14 * 33] * scale, s[15 * 33] * scale);
        *(u32x4*)(WT + (size_t)n * ldt + 16 * c) = o; }
    LDS_WAIT(); asm volatile("" ::: "memory");
}
DI void ln16(f32x4 (&v)[4], const f32x4 (&g)[4], const f32x4 (&b)[4]) {
    float s = 0.f;
#pragma unroll
    for (int j = 0; j < 4; ++j) s += (v[j].x + v[j].y) + (v[j].z + v[j].w);
    const float mean = wave_sum(s) * (1.f / D); float s2 = 0.f;
#pragma unroll
    for (int j = 0; j < 4; ++j) { v[j] = v[j] - mean; s2 += (v[j].x * v[j].x + v[j].y * v[j].y) + (v[j].z * v[j].z + v[j].w * v[j].w); }
    const float rstd = 1.f / sqrtf(wave_sum(s2) * (1.f / D) + LN_EPS);
#pragma unroll
    for (int j = 0; j < 4; ++j) v[j] = v[j] * rstd * g[j] + b[j];
}
DI void gates8(const f32x4 (&y)[4], const LAS float* wgt, float* gif_row, int lane) {
    float p[8];
#pragma unroll
    for (int j = 0; j < 8; ++j) { float s = 0.f;
#pragma unroll
        for (int jj = 0; jj < 4; ++jj) { const f32x4 w = *(const LAS f32x4*)(wgt + j * 1024 + 256 * jj + 4 * lane); s += (y[jj].x * w.x + y[jj].y * w.y) + (y[jj].z * w.z + y[jj].w * w.w); }
        p[j] = wave_sum(s); }
    if (lane == 0) { *(f32x4*)gif_row = (f32x4){p[0], p[1], p[2], p[3]}; *(f32x4*)(gif_row + 4) = (f32x4){p[4], p[5], p[6], p[7]}; }
}
DI void gates8b(const f32x4 (&y)[4], const LAS float* wgt, float* gif_row, int lane) {
    float p[8];
#pragma unroll
    for (int j = 0; j < 8; ++j) { float s = 0.f;
#pragma unroll
        for (int jj = 0; jj < 4; ++jj) { const f32x4 w = *(const LAS f32x4*)(wgt + j * 1024 + (jj >> 1) * 512 + 8 * lane + (jj & 1) * 4); s += (y[jj].x * w.x + y[jj].y * w.y) + (y[jj].z * w.z + y[jj].w * w.w); }
        p[j] = wave_sum(s); }
    if (lane == 0) { *(f32x4*)gif_row = (f32x4){p[0], p[1], p[2], p[3]}; *(f32x4*)(gif_row + 4) = (f32x4){p[4], p[5], p[6], p[7]}; }
}
DI void load_gate_table(LAS float* wgt, const float* win_l, int tid) {
    for (int i = tid; i < 8192; i += NTHR) { const int k = i >> 3, j = i & 7; wgt[j * 1024 + k] = win_l[(size_t)k * DIN + 1536 + j]; }
}
DI f32x4 ld4bf(const char* p) { const u32x2 w = *(const u32x2*)p; return (f32x4){bflo(w.x), bfhi(w.x), bflo(w.y), bfhi(w.y)}; }
DI void st4bf(char* p, const f32x4& v) { u32x2 w; w.x = pk2(v.x, v.y); w.y = pk2(v.z, v.w); *(u32x2*)p = w; }

struct Args { const float* in[N_IN]; float* out; unsigned char* ws; int ph_lo, ph_hi; };
constexpr int NP_LAYER = 12, NPH = 1 + DEPTH * NP_LAYER;
constexpr int XW_SPLIT = 49152;

struct SchedInproj {
    pg8::TileOrder T; int G, c; const char *X, *W; char* U; bool kv; const char *MEMN, *WKV; char* KV;
    DI bool next(int i, pg8::Unit& u) const {
        const long L = (long)i * G + c; int pm, pn;
        if (T.tile(L, pm, pn)) { u.a = X + (size_t)pm * 256 * D * 2; u.b = W + (size_t)pn * 256 * D * 2; u.r0 = pm * 256; u.c0 = pn * 256; u.c = U + ((size_t)u.r0 * NU + u.c0) * 2; u.ldc = NU; u.e = 0; u.sub = 0; return true; }
        if (!kv) return false;
        const long L2 = L - T.nwg; if (L2 < 0 || L2 >= 128) return false;
        const int l = (int)L2 >> 6, t = (int)L2 & 63; pm = t >> 2; pn = t & 3;
        u.a = MEMN + (size_t)pm * 256 * D * 2; u.b = WKV + ((size_t)l * 1024 + pn * 256) * D * 2; u.r0 = pm * 256; u.c0 = pn * 256; u.c = KV + (((size_t)l * MROWS + u.r0) * D + u.c0) * 2; u.ldc = D; u.e = 0; u.sub = 0; return true;
    }
};
struct SchedPlain {
    pg8::TileOrder T; int G, c; const char *A, *B; char* C; int lda, ldb, ldc;
    DI bool next(int i, pg8::Unit& u) const {
        const long L = (long)i * G + c; int pm, pn; if (!T.tile(L, pm, pn)) return false;
        u.a = A + (size_t)pm * 256 * lda * 2; u.b = B + (size_t)pn * 256 * ldb * 2; u.r0 = pm * 256; u.c0 = pn * 256; u.c = C + ((size_t)u.r0 * ldc + u.c0) * 2; u.ldc = ldc; u.e = 0; u.sub = 0; return true;
    }
};
struct SchedMerge {
    pg8::TileOrder T; int G, c; const char *H, *W; char* Y;
    DI bool next(int i, pg8::Unit& u) const {
        const int ti = i / 3, br = i - 3 * ti; const long L = (long)ti * G + c; int pm, pn; if (!T.tile(L, pm, pn)) return false;
        u.a = H + ((size_t)pm * 256 * 1536 + br * 512) * 2; u.b = W + ((size_t)br * 1024 + pn * 256) * 512 * 2; u.r0 = pm * 256; u.c0 = pn * 256; u.c = Y + ((size_t)u.r0 * D + u.c0) * 2; u.ldc = D; u.e = 0; u.sub = br; return true;
    }
};
struct SchedMoe {
    pg8::TileOrder T; int G, c; const char *A, *W; char* C; const LAS int* PB; int wrows  , ldc, cdiv, osz;
    DI bool next(int i, pg8::Unit& u) const {
        const long L = (long)i * G + c; int pm, pn; if (!T.tile(L, pm, pn)) return false;
        int e = 0;
#pragma unroll 1
        for (int j = 1; j < NEXP; ++j) e += (PB[j] <= pm) ? 1 : 0;
        u.a = A + (size_t)pm * 256 * 1024; u.b = W + ((size_t)e * wrows + pn * 256) * 1024; u.r0 = pm * 256; u.c0 = pn * 256; u.c = C + ((size_t)u.r0 * ldc + u.c0 / cdiv) * osz; u.ldc = ldc; u.e = e; u.sub = 0; return true;
    }
};

__global__ void __launch_bounds__(NTHR, 2) fwd_kernel(Args args) {
    extern __shared__ __attribute__((aligned(16))) unsigned char lds_raw[];
#define INP(i) ([&]() -> const float* { int ii_ = (i); asm volatile("" : "+s"(ii_)); return args.in[ii_]; }())
    LAS unsigned char* lds = (LAS unsigned char*)lds_raw;
    volatile LAS unsigned* LCTL = (volatile LAS unsigned*)(lds + LDSCTL_OFF);
    const int tid0 = threadIdx.x, wave = __builtin_amdgcn_readfirstlane(tid0 >> 6);
#define PHASE_TID unsigned z_ = 0u; asm volatile("" : "+v"(z_)); int tid = wave * 64 + (int)__builtin_amdgcn_mbcnt_hi(~0u, __builtin_amdgcn_mbcnt_lo(~0u, z_)); const int lane = tid & 63; (void)lane;
    const int G = gridDim.x, bx = blockIdx.x;
    const int gw = bx * NWAVES + wave, NGW = G * NWAVES;
    unsigned char* ws = args.ws;
    gu32* ctl = (gu32*)(ws + WS_CTL);
    for (int u = tid0; u < (LDS_BYTES - LDSCTL_OFF) / 4; u += NTHR) ((LAS unsigned*)(lds + LDSCTL_OFF))[u] = 0u;
    __syncthreads();
    XcdBarrier bar; bar.bar = (unsigned*)ctl + CW_BAR; bar.x = 0; bar.st = nullptr;
    if (MK_ONE_LAUNCH) bar = xcd_barrier_post((unsigned*)ctl + CW_BAR, LCTL);
    const int lo = args.ph_lo, hi = args.ph_hi;
#ifndef SUBMASK
#define SUBMASK 7
#endif
#ifndef LN2PROBE
#define LN2PROBE 0
#endif
#ifndef SUBDUP
#define SUBDUP 0
#endif
#define NSUB(k) ((((SUBDUP) >> (k)) & 1) ? 2 : 1)
#ifndef DUPMASK
#define DUPMASK 0
#endif
#define NREP(k) ((((DUPMASK) >> (k)) & 1) ? 2 : 1)
#ifndef PHMASK
#define PHMASK 0xFFFF
#endif
#define IN(k) (lo <= (k) && (k) < hi)
#define SEAM(k) do { if (IN(k) && IN((k) + 1)) xcd_barrier(bar); } while (0)

    char* const Xb = (char*)(ws + WS_X);
    char* const Ub = (char*)(ws + WS_R1);
    float* const GIF = (float*)(ws + WS_GIF);
    LAS int* const PB = (LAS int*)(lds + LDSCTL_OFF + 64);
    LAS int* const CNT = (LAS int*)(lds + LDSCTL_OFF + 256);

    _Pragma("unroll 1") for (int rep_ = 0; rep_ < NREP(12); ++rep_) if (((PHMASK>>12)&1) && IN(0)) { PHASE_TID
        LAS float* scr = (LAS float*)(lds + wave * 8448);
        LAS float* wgt = (LAS float*)(lds + 73728);
        load_gate_table(wgt, INP(I_WIN), tid);
        constexpr int IT_IN = 16 * 216, IT_KV = 16 * 32, IT_BR = 8 * 32, IT_O = 16 * 32, IT_L = IT_IN + IT_KV + 3 * IT_BR + IT_O;
        for (int it = gw; it < DEPTH * IT_L; it += NGW) {
            const int l = it / IT_L; int r = it - l * IT_L;
            if (r < IT_IN) { const int kb = r / 216, nb = r % 216, n0 = 32 * nb, sc = ucol_src(n0);
                if (n0 < UC_F8) transpose_item(INP(I_WIN) + ((size_t)l * D + 64 * kb) * DIN + sc, DIN, (bf16*)(ws + WS_WIN) + ((size_t)l * NU + n0) * D + 64 * kb, D, scr, lane);
                else transpose_item_f8(INP(I_WIN) + ((size_t)l * D + 64 * kb) * DIN + sc, DIN, (unsigned char*)(ws + WS_WING8) + ((size_t)l * NF8 + (n0 - UC_F8)) * D + 64 * kb, D, F8_SWGU, scr, lane);
                continue; }
            r -= IT_IN;
            if (r < IT_KV) { const int kb = r / 32, nb = r % 32;
                transpose_item(INP(I_CAWKV) + ((size_t)l * D + 64 * kb) * 1024 + 32 * nb, 1024, (bf16*)(ws + WS_WKV) + ((size_t)l * 1024 + 32 * nb) * D + 64 * kb, D, scr, lane); continue; }
            r -= IT_KV;
            if (r < 3 * IT_BR) { const int br = r / IT_BR, q = r % IT_BR, kb = q / 32, nb = q % 32;
                const float* src = INP(br == 0 ? I_WBRML : (br == 1 ? I_WBRRW : I_WBRCA));
                transpose_item(src + ((size_t)l * 512 + 64 * kb) * 1024 + 32 * nb, 1024, (bf16*)(ws + WS_WBR) + ((size_t)l * 1024 + 32 * nb) * 1536 + br * 512 + 64 * kb, 1536, scr, lane); continue; }
            r -= 3 * IT_BR;
            { const int kb = r / 32, nb = r % 32;
                transpose_item(INP(I_WO) + ((size_t)l * D + 64 * kb) * 1024 + 32 * nb, 1024, (bf16*)(ws + WS_WO) + ((size_t)l * 1024 + 32 * nb) * D + 64 * kb, D, scr, lane); }
        }
        for (int i = bx * NTHR + tid; i < DEPTH * 1536 * 256; i += G * NTHR) {
            const int l = i / (1536 * 256), r = i % (1536 * 256), n = r >> 8, k = r & 255; float v = 0.f;
            if (n < 512) { if (k < 64) v = INP(I_RWWUP)[((size_t)l * 64 + k) * 512 + n]; }
            else if (n < 1024) { if (k >= 64 && k < 128) v = INP(I_RWAUP)[((size_t)l * 64 + (k - 64)) * 512 + (n - 512)]; }
            else { if (k >= 128) v = INP(I_RWGUP)[((size_t)l * 128 + (k - 128)) * 512 + (n - 1024)]; }
            ((bf16*)(ws + WS_WLORA))[i] = (bf16)f2bf(v);
        }
        __syncthreads();
        {
            f32x4 g[4], b[4];
#pragma unroll
            for (int j = 0; j < 4; ++j) { g[j] = *(const f32x4*)(INP(I_LNIN_G) + 256 * j + 4 * lane); b[j] = *(const f32x4*)(INP(I_LNIN_B) + 256 * j + 4 * lane); }
            for (int m = gw; m < M; m += NGW) {
                f32x4 v[4]; const float* xr = INP(I_X) + (size_t)m * D;
#pragma unroll
                for (int j = 0; j < 4; ++j) v[j] = *(const f32x4*)(xr + 256 * j + 4 * lane);
                ln16(v, g, b);
#pragma unroll
                for (int j = 0; j < 4; ++j) { st4bf(Xb + ((size_t)m * D + 256 * j + 4 * lane) * 2, v[j]); *(unsigned*)((char*)(ws + WS_XF8) + (size_t)m * D + 256 * j + 4 * lane) = pk4_f8(v[j].x * F8_SX, v[j].y * F8_SX, v[j].z * F8_SX, v[j].w * F8_SX); }
                gates8(v, wgt, GIF + (size_t)m * 8, lane);
            }
#pragma unroll
            for (int j = 0; j < 4; ++j) { g[j] = *(const f32x4*)(INP(I_MEMLN_G) + 256 * j + 4 * lane); b[j] = *(const f32x4*)(INP(I_MEMLN_B) + 256 * j + 4 * lane); }
            for (int m = gw; m < MROWS; m += NGW) {
                f32x4 v[4]; const float* xr = INP(I_MEM) + (size_t)m * D;
#pragma unroll
                for (int j = 0; j < 4; ++j) v[j] = *(const f32x4*)(xr + 256 * j + 4 * lane);
                ln16(v, g, b);
#pragma unroll
                for (int j = 0; j < 4; ++j) st4bf((char*)(ws + WS_MEMN) + ((size_t)m * D + 256 * j + 4 * lane) * 2, v[j]);
            }
        }
        __syncthreads();
    }
    SEAM(0);

#pragma unroll 1
    for (int l = 0; l < DEPTH; ++l) {
        const int pb = 1 + l * NP_LAYER;
        _Pragma("unroll 1") for (int rep_ = 0; rep_ < NREP(0); ++rep_) if (((PHMASK>>0)&1) && IN(pb + 0)) {
            SchedInproj S; S.T.init(M / 256, UC_F8 / 256); S.G = G; S.c = bx; S.X = Xb; S.W = (const char*)(ws + WS_WIN) + (size_t)l * NU * D * 2; S.U = Ub;
            S.kv = (l == 0); S.MEMN = (const char*)(ws + WS_MEMN); S.WKV = (const char*)(ws + WS_WKV); S.KV = (char*)(ws + WS_KV);
            pg8::EpiStore E;
            pg8::gemm_phase<false>(lds, D * 2, D * 2, D * 2, S, E, wave);
            SchedPlain S8; S8.T.init(M / 256, NF8 / 256); S8.G = G; S8.c = bx; S8.A = (const char*)(ws + WS_XF8); S8.B = (const char*)(ws + WS_WING8) + (size_t)l * NF8 * D; S8.C = Ub + UC_F8 * 2;
            S8.lda = 512; S8.ldb = 512; S8.ldc = NU;
            pg8::EpiStoreS E8; E8.s = F8_INV1; E8.gate_b = INP(I_GATEB) + (size_t)l * 3072; E8.gate_c0 = UC_GATE - UC_F8;
            pg8::gemm_phase<true>(lds, D, D, D, S8, E8, wave);
        }
        SEAM(pb + 0);
        _Pragma("unroll 1") for (int rep_ = 0; rep_ < NREP(1); ++rep_) if (((PHMASK>>1)&1) && IN(pb + 1)) { PHASE_TID
            const float* mu = INP(I_RWMU) + (size_t)l * 1792 + 1536;
            char* LIN = (char*)(ws + WS_R2 + R2_LORA_IN);
            for (int it = bx * NTHR + tid; it < M * 32; it += G * NTHR) {
                const int row = it >> 5, c = (it & 31) * 8;
                const u32x4 cw = *(const u32x4*)(Ub + ((size_t)row * NU + UC_RW + 1536 + c) * 2);
                u32x4 pw = (u32x4){0u, 0u, 0u, 0u};
                if ((row & (SEQ - 1)) != 0) pw = *(const u32x4*)(Ub + ((size_t)(row - 1) * NU + UC_RW + 1536 + c) * 2);
                const f32x4 m0 = *(const f32x4*)(mu + c), m1 = *(const f32x4*)(mu + c + 4);
                float x[8] = {bflo(cw.x), bfhi(cw.x), bflo(cw.y), bfhi(cw.y), bflo(cw.z), bfhi(cw.z), bflo(cw.w), bfhi(cw.w)};
                const float p[8] = {bflo(pw.x), bfhi(pw.x), bflo(pw.y), bfhi(pw.y), bflo(pw.z), bfhi(pw.z), bflo(pw.w), bfhi(pw.w)};
                const float mm[8] = {m0.x, m0.y, m0.z, m0.w, m1.x, m1.y, m1.z, m1.w};
#pragma unroll
                for (int i = 0; i < 8; ++i) { float xs = x[i] + (p[i] - x[i]) * mm[i];
                    if (c < 64) xs = 1.f - 2.f * __builtin_amdgcn_rcpf(1.f + __builtin_amdgcn_exp2f(2.8853900817779268f * xs));
                    else if (c >= 128) xs = sigmoidf_(xs);
                    x[i] = xs; }
                u32x4 o; o.x = pk2(x[0], x[1]); o.y = pk2(x[2], x[3]); o.z = pk2(x[4], x[5]); o.w = pk2(x[6], x[7]);
                *(u32x4*)(LIN + ((size_t)row * 256 + c) * 2) = o;
            }
        }
        SEAM(pb + 1);
        _Pragma("unroll 1") for (int rep_ = 0; rep_ < NREP(2); ++rep_) if (((PHMASK>>2)&1) && IN(pb + 2)) {
            SchedPlain S; S.T.init(M / 256, 6); S.G = G; S.c = bx; S.A = (const char*)(ws + WS_R2 + R2_LORA_IN); S.B = (const char*)(ws + WS_WLORA) + (size_t)l * 1536 * 256 * 2; S.C = (char*)(ws + WS_R2 + R2_LORA_OUT);
            S.lda = 256; S.ldb = 256; S.ldc = 1536;
            pg8::EpiStore E;
            pg8::gemm_phase<false>(lds, 512, 512, 512, S, E, wave);
        }
        SEAM(pb + 2);
        _Pragma("unroll 1") for (int rep_ = 0; rep_ < NREP(3); ++rep_) if (((PHMASK>>3)&1) && IN(pb + 3)) { PHASE_TID
            const char* LO = (const char*)(ws + WS_R2 + R2_LORA_OUT);
            char* HC = (char*)(ws + WS_R2 + R2_HCAT);
            const int tid_ph = tid;
#define SUB_TID unsigned zs_ = 0u; asm volatile("" : "+v"(zs_)); int tid = wave * 64 + (int)__builtin_amdgcn_mbcnt_hi(~0u, __builtin_amdgcn_mbcnt_lo(~0u, zs_)); const int lane = tid & 63; (void)lane;
#pragma unroll 1
            for (int job = bx; job < 256; job += G) {
                if (job < 128) { _Pragma("unroll 1") for (int sr_ = 0; sr_ < NSUB(0); ++sr_) if ((SUBMASK>>0)&1) {
                    SUB_TID
                    const int b = job >> 3, h = job & 7;
                    constexpr int TC = 32, PT = 144, P16 = 48, IMG = 25856;
                    LAS float* OPS = (LAS float*)lds;
                    LAS float* OUTB = OPS + TC * 384;
                    LAS float* BON = OUTB + TC * 64;
                    LAS unsigned char* IM0 = lds + 57600;
                    LAS float* VEP = (LAS float*)(lds + 109312);
                    LAS unsigned char* GKB = (LAS unsigned char*)(VEP + 2 * TC * 64);
                    LAS float* PARF = (LAS float*)(lds + 142080);
                    const int pt = tid >> 4, cs = tid & 15, pc = cs * 4, hc = h * 64 + pc;
                    const int p1t = (tid >> 3) & 31, c8 = (tid & 7) * 8, hc8 = h * 64 + c8;
                    const int r31 = lane & 31, h2 = lane >> 5;
                    f32x16 Sreg[2];
#pragma unroll
                    for (int i = 0; i < 16; ++i) { Sreg[0][i] = 0.f; Sreg[1][i] = 0.f; }
#pragma unroll 1
                    for (int a = wave; a < 10; a += 8) {
                        const int ii = (a < 3) ? I_RWMU : (a == 3) ? I_RWW0 : (a == 4) ? I_RWA0 : (a == 5) ? I_RWKK : (a == 6) ? I_RWKA : (a == 7) ? I_RWRK : (a == 8) ? I_RWLNG : I_RWLNB;
                        const size_t po = (a < 3) ? ((size_t)l * 1792 + a * 512) : (size_t)l * 512;
                        PARF[a * 64 + lane] = (INP(ii) + po)[h * 64 + lane];
                    }
#define SETPU(j, q_) do { const u32x4 q__ = (q_); Sreg[(j) >> 2][((j) & 3) * 4] = u2f_(q__.x); Sreg[(j) >> 2][((j) & 3) * 4 + 1] = u2f_(q__.y); \
                          Sreg[(j) >> 2][((j) & 3) * 4 + 2] = u2f_(q__.z); Sreg[(j) >> 2][((j) & 3) * 4 + 3] = u2f_(q__.w); } while (0)
#define PUW(j, c) f2u_(Pc[(j) >> 2][((j) & 3) * 4 + (c)])
#define PUWS(j, c) f2u_(Sreg[(j) >> 2][((j) & 3) * 4 + (c)])
#define UNPJ(j, hh) ((f32x4){bflo(PUW(j, 2 * (hh))), bfhi(PUW(j, 2 * (hh))), bflo(PUW(j, 2 * (hh) + 1)), bfhi(PUW(j, 2 * (hh) + 1))})
#define UNPH(q_, hh) ((hh) ? (f32x4){bflo((q_).z), bfhi((q_).z), bflo((q_).w), bfhi((q_).w)} : (f32x4){bflo((q_).x), bfhi((q_).x), bflo((q_).y), bfhi((q_).y)})
                    auto LOADC = [&](int t0) {
                        const int t = t0 + p1t; const size_t row = (size_t)b * SEQ + t; const char* up = Ub + (row * NU + UC_RW + hc8) * 2;
                        SETPU(0, *(const u32x4*)up); SETPU(1, *(const u32x4*)(up + 1024)); SETPU(2, *(const u32x4*)(up + 2048));
                        if (t > 0) { const char* pp = up - (size_t)NU * 2; SETPU(3, *(const u32x4*)pp); SETPU(4, *(const u32x4*)(pp + 1024)); SETPU(5, *(const u32x4*)(pp + 2048)); }
                        else { const u32x4 z4 = (u32x4){0u, 0u, 0u, 0u}; SETPU(3, z4); SETPU(4, z4); SETPU(5, z4); }
                        const char* lp = LO + (row * 1536 + hc8) * 2; SETPU(6, *(const u32x4*)lp); SETPU(7, *(const u32x4*)(lp + 1024));
                    };
                    const int gq = tid - 128, gt = (gq >> 2) & 31, gp = (gq & 3) * 16;
                    auto LOADG = [&](int t0) {
                        const char* gp_ = LO + (((size_t)b * SEQ + t0 + gt) * 1536 + 1024 + h * 64 + gp) * 2;
                        SETPU(0, *(const u32x4*)gp_); SETPU(1, *(const u32x4*)(gp_ + 16));
                    };
                    auto PASS1 = [&](int t1, int par1, bool more) {
                        int hcv = hc8; asm volatile("" : "+v"(hcv));
                        const f32x16 Pc[2] = {Sreg[0], Sreg[1]};
                        if (more) LOADC(t1 + TC);
                        const LAS float* MU = PARF + c8;
                        const LAS float* W0 = PARF + 192 + c8; const LAS float* A0 = PARF + 256 + c8; const LAS float* KKW = PARF + 320 + c8;
                        const LAS float* KAW = PARF + 384 + c8; const LAS float* RKW = PARF + 448 + c8;
                        f32x4 dec[2], av[2], kkv[2], kp[2], xr[2], xv[2]; float ss = 0.f, bsum = 0.f;
#pragma unroll
                        for (int hh = 0; hh < 2; ++hh) {
                            const f32x4 mu_r = *(const LAS f32x4*)(MU + 4 * hh), mu_k = *(const LAS f32x4*)(MU + 64 + 4 * hh), mu_v = *(const LAS f32x4*)(MU + 128 + 4 * hh);
                            const f32x4 w0 = *(const LAS f32x4*)(W0 + 4 * hh), a0 = *(const LAS f32x4*)(A0 + 4 * hh), kkw = *(const LAS f32x4*)(KKW + 4 * hh), kaw = *(const LAS f32x4*)(KAW + 4 * hh), rkw = *(const LAS f32x4*)(RKW + 4 * hh);
                            const f32x4 ur = UNPJ(0, hh), uk = UNPJ(1, hh), uv = UNPJ(2, hh), urp = UNPJ(3, hh), ukp = UNPJ(4, hh), uvp = UNPJ(5, hh), lw = UNPJ(6, hh), la = UNPJ(7, hh);
                            xr[hh] = ur + (urp - ur) * mu_r; const f32x4 xk = uk + (ukp - uk) * mu_k; xv[hh] = uv + (uvp - uv) * mu_v;
#pragma unroll
                            for (int i = 0; i < 4; ++i) {
                                const float y = -(w0[i] + lw[i]);
                                const float sp = fmaxf(y, 0.f) + __logf(1.f + __expf(-fabsf(y)));
                                dec[hh][i] = __expf(-__expf(-sp - 0.5f));
                                av[hh][i] = sigmoidf_(a0[i] + la[i]);
                                kkv[hh][i] = xk[i] * kkw[i]; ss += kkv[hh][i] * kkv[hh][i];
                                kp[hh][i] = xk[i] * (1.f + (av[hh][i] - 1.f) * kaw[i]);
                                bsum += xr[hh][i] * kp[hh][i] * rkw[i];
                            }
                            __builtin_amdgcn_sched_barrier(0);
                        }
                        ss = red8(ss); bsum = red8(bsum);
                        const float inv = __builtin_amdgcn_rsqf(fmaxf(ss, 1e-24f));
#pragma unroll
                        for (int hh = 0; hh < 2; ++hh) {
                            const f32x4 kk = kkv[hh] * inv, kka = kk * av[hh];
                            LAS float* o = OPS + p1t * 384 + c8 + 4 * hh;
                            *(LAS f32x4*)(o) = dec[hh]; *(LAS f32x4*)(o + 64) = kk; *(LAS f32x4*)(o + 128) = kka; *(LAS f32x4*)(o + 192) = kp[hh]; *(LAS f32x4*)(o + 256) = xr[hh]; *(LAS f32x4*)(o + 320) = xv[hh];
                            *(LAS f32x4*)(VEP + par1 * 2048 + p1t * 64 + c8 + 4 * hh) = xv[hh];
                        }
                        if ((tid & 7) == 0) BON[par1 * 32 + p1t] = bsum;
                    };
#define UNP4(w) ((f32x4){bflo((w).x), bfhi((w).x), bflo((w).y), bfhi((w).y)})
#define DOT4(a, b) (((a).x * (b).x + (a).y * (b).y) + ((a).z * (b).z + (a).w * (b).w))
#define PACK8(x, s) __builtin_bit_cast(bf16x8, (u32x4){pk2((x)[8 * (s)], (x)[8 * (s) + 1]), pk2((x)[8 * (s) + 2], (x)[8 * (s) + 3]), pk2((x)[8 * (s) + 4], (x)[8 * (s) + 5]), pk2((x)[8 * (s) + 6], (x)[8 * (s) + 7])})
#define LD2x64(p) __builtin_bit_cast(bf16x8, (u32x4){(*(const LAS u32x2*)(p)).x, (*(const LAS u32x2*)(p)).y, (*(const LAS u32x2*)((p) + 16)).x, (*(const LAS u32x2*)((p) + 16)).y})
                    auto EPI = [&](int te, int pe) {
                        const int et = ((wave >> 2) * 2 + (wave & 1)) * 64 + lane, pce = (et & 15) * 4;
                        const f32x4 lng = *(const LAS f32x4*)(PARF + 512 + pce), lnb = *(const LAS f32x4*)(PARF + 576 + pce);
#pragma unroll
                        for (int it = 0; it < 2; ++it) {
                            const int pte = (et >> 4) + 16 * it;
                            const u32x2 gkw = *(const LAS u32x2*)(GKB + pe * 4096 + pte * 128 + pce * 2);
                            const f32x4 o4 = *(const LAS f32x4*)(OUTB + pte * 64 + pce), v4 = *(const LAS f32x4*)(VEP + pe * 2048 + pte * 64 + pce), gk = UNP4(gkw);
                            const float mean = red16((o4.x + o4.y) + (o4.z + o4.w)) * (1.f / 64.f);
                            const f32x4 dv = o4 - mean;
                            const float var = red16(DOT4(dv, dv)) * (1.f / 64.f);
                            const float rstd = __builtin_amdgcn_rsqf(var + RW_GN_EPS), bo = BON[pe * 32 + pte];
                            const f32x4 y = (dv * rstd * lng + lnb + v4 * bo) * gk;
                            st4bf(HC + (((size_t)b * SEQ + te + pte) * 1536 + 512 + h * 64 + pce) * 2, y);
                        }
                    };
                    if (wave >= 4) LOADC(0); else if (wave >= 2) LOADG(0);
#pragma unroll 1
                    for (int t0 = -TC; t0 < SEQ; t0 += TC) {
                        const int par = (t0 >> 5) & 1;
                        __syncthreads();
                        if (t0 >= 0)
                        {
                            const int sc = wave >> 2, wq = wave & 3;
                            LAS unsigned char* im = IM0 + sc * IMG;
                            LAS unsigned char* KR = im; LAS unsigned char* BGr = im + 4608; LAS unsigned char* VT = im + 15360;
                            LAS unsigned char* TT = im + 18432; LAS unsigned char* BB = im + 19968; LAS float* ZF = (LAS float*)(im + 21504); LAS float* PL = (LAS float*)(im + 25600);
                            {
                                float P = 1.f;
#pragma unroll 1
                                for (int t = 0; t < 4 * wq; ++t) P *= OPS[(16 * sc + t) * 384 + lane];
#pragma unroll
                                for (int q = 0; q < 4; ++q) { const int t = 4 * wq + q; const LAS float* o = OPS + (16 * sc + t) * 384 + lane;
                                    const float w = o[0], z = o[64], bb = o[128], kp = o[192], rr = o[256], vv = o[320];
                                    const float kap = z * P; P *= w; const float rho = rr * P, ip = __builtin_amdgcn_rcpf(P), bet = bb * ip, gam = kp * ip;
                                    *(LAS bf16*)(KR + t * PT + lane * 2) = (bf16)f2bf(kap); *(LAS bf16*)(KR + (16 + t) * PT + lane * 2) = (bf16)f2bf(rho);
                                    *(LAS bf16*)(BGr + t * PT + lane * 2) = (bf16)f2bf(bet); *(LAS bf16*)(BGr + (16 + t) * PT + lane * 2) = (bf16)f2bf(gam);
                                    *(LAS bf16*)(VT + t * PT + lane * 2) = (bf16)f2bf(vv); }
                                if (wq == 3) PL[lane] = P;
                            }
                            __syncthreads();
                            if (wq == 0) {
                                f32x16 Z;
#pragma unroll
                                for (int i = 0; i < 16; ++i) Z[i] = 0.f;
#pragma unroll
                                for (int ks = 0; ks < 4; ++ks) Z = __builtin_amdgcn_mfma_f32_32x32x16_bf16(*(const LAS bf16x8*)(KR + r31 * PT + (16 * ks + 8 * h2) * 2), *(const LAS bf16x8*)(BGr + r31 * PT + (16 * ks + 8 * h2) * 2), Z, 0, 0, 0);
                                const int cp = r31, jj = (r31 & 15) - 4 * h2;
#pragma unroll
                                for (int i = 0; i < 16; ++i) { const int tb = (i & 3) + 8 * ((i >> 2) & 1); const bool keep = (i >= 8) ? (jj <= tb) : (jj < tb);
                                    ZF[((i & 3) + 8 * (i >> 2) + 4 * h2) * 32 + cp] = keep ? Z[i] : 0.f; }
                            } else if (wq >= 2 && t0 >= TC) EPI(t0 - TC, par ^ 1);
                            __syncthreads();
                            if (wq == 0) {
                                const int c = lane & 15, g = lane >> 4; float x[16];
                                f32x4 R[16][4];
                                constexpr int TW = 5;
#pragma unroll
                                for (int t = 1; t <= TW; ++t)
#pragma unroll
                                    for (int k = 0; k < 4; ++k) if (4 * k < t) R[t][k] = *(const LAS f32x4*)(ZF + t * 32 + 4 * k);
                                __builtin_amdgcn_sched_barrier(0);
#pragma unroll
                                for (int t = 0; t < 16; ++t) {
                                    if (t >= 1 && t + TW < 16) {
#pragma unroll
                                        for (int k = 0; k < 4; ++k) if (4 * k < t + TW) R[t + TW][k] = *(const LAS f32x4*)(ZF + (t + TW) * 32 + 4 * k);
                                    }
                                    __builtin_amdgcn_sched_barrier(0);
                                    float s0 = 0.f, s1 = 0.f;
#pragma unroll
                                    for (int j = 0; j < t; ++j) { const float a = R[t][j >> 2][j & 3]; if (j & 1) s1 += a * x[j]; else s0 += a * x[j]; }
                                    x[t] = ((t == c) ? 1.f : 0.f) - (s0 + s1);
                                }
#pragma unroll
                                for (int j = 0; j < 16; ++j) *(LAS bf16*)(TT + j * P16 + c * 2) = (bf16)f2bf(-x[j]);
#pragma unroll
                                for (int qq = 0; qq < 4; qq += 2) {
                                    f32x4 a4[2][4];
#pragma unroll
                                    for (int q = 0; q < 2; ++q)
#pragma unroll
                                        for (int k = 0; k < 4; ++k) a4[q][k] = *(const LAS f32x4*)(ZF + (16 + 4 * g + qq + q) * 32 + 4 * k);
#pragma unroll
                                    for (int q = 0; q < 2; ++q) {
                                        const int tr = 4 * g + qq + q;
                                        float s0 = 0.f, s1 = 0.f;
#pragma unroll
                                        for (int j = 0; j < 16; ++j) { const float a = a4[q][j >> 2][j & 3]; if (j & 1) s1 += a * x[j]; else s0 += a * x[j]; }
                                        *(LAS bf16*)(TT + (16 + tr) * P16 + c * 2) = (bf16)f2bf(-(s0 + s1));
                                    }
                                }
                            } else if (wq == 1) {
                                const int row = lane >> 1, c0 = 8 * (lane & 1), tt = row & 15; const bool rho_row = row >= 16; float bv[8];
                                const f32x4 z0 = *(const LAS f32x4*)(ZF + row * 32 + 16 + c0), z1 = *(const LAS f32x4*)(ZF + row * 32 + 20 + c0);
#pragma unroll
                                for (int j = 0; j < 8; ++j) bv[j] = (j < 4) ? z0[j & 3] : z1[j & 3];
                                *(LAS u32x4*)(BB + row * P16 + c0 * 2) = (u32x4){pk2(bv[0], bv[1]), pk2(bv[2], bv[3]), pk2(bv[4], bv[5]), pk2(bv[6], bv[7])};
                            }
                        }
                        __syncthreads();
                        if (wave >= 4) { if (t0 + TC < SEQ) PASS1(t0 + TC, par ^ 1, t0 + 2 * TC < SEQ); }
                        else if (wave >= 2) { if (t0 + TC < SEQ) {
                            LAS unsigned char* gd = GKB + (par ^ 1) * 4096 + gt * 128 + gp * 2;
                            *(LAS u32x4*)gd = (u32x4){PUWS(0, 0), PUWS(0, 1), PUWS(0, 2), PUWS(0, 3)}; *(LAS u32x4*)(gd + 16) = (u32x4){PUWS(1, 0), PUWS(1, 1), PUWS(1, 2), PUWS(1, 3)};
                            if (t0 + 2 * TC < SEQ) LOADG(t0 + 2 * TC); } }
                        else if (wave < 2 && t0 >= 0) {
#pragma unroll 1
                            for (int sc = 0; sc < 2; ++sc) {
                                const LAS unsigned char* im = IM0 + sc * IMG;
                                const LAS unsigned char* KR = im; const LAS unsigned char* BT = im + 9216; const LAS unsigned char* GT = im + 12288; const LAS unsigned char* VT = im + 15360;
                                const LAS unsigned char* TT = im + 18432; const LAS unsigned char* BB = im + 19968; const LAS float* PL = (const LAS float*)(im + 25600);
                                const LAS unsigned char* BGr = im + 4608;
                                const bf16x8 vfr = trd8(VT, PT, 8 * h2, 8 * h2 + 4, 32 * wave, lane);
                                f32x16 t1;
#pragma unroll
                                for (int i = 0; i < 16; ++i) t1[i] = 0.f;
                                t1 = __builtin_amdgcn_mfma_f32_32x32x16_bf16(*(const LAS bf16x8*)(BB + r31 * P16 + 8 * h2 * 2), vfr, t1, 0, 0, 0);
#pragma unroll
                                for (int kb = 0; kb < 2; ++kb)
#pragma unroll
                                    for (int s = 0; s < 2; ++s) t1 = __builtin_amdgcn_mfma_f32_32x32x16_bf16(LD2x64(KR + r31 * PT + (32 * kb + 16 * s + 4 * h2) * 2), PACK8(Sreg[kb], s), t1, 0, 0, 0);
                                f32x16 t2;
#pragma unroll
                                for (int i = 0; i < 16; ++i) t2[i] = 0.f;
                                t2 = __builtin_amdgcn_mfma_f32_32x32x16_bf16(LD2x64(TT + r31 * P16 + (4 * h2) * 2), PACK8(t1, 0), t2, 0, 0, 0);
#pragma unroll
                                for (int i = 8; i < 16; ++i) OUTB[(16 * sc + (i & 3) + 8 * ((i >> 2) - 2) + 4 * h2) * 64 + 32 * wave + r31] = t2[i] + t1[i];
                                const bf16x8 uq = PACK8(t2, 0);
#pragma unroll
                                for (int kb = 0; kb < 2; ++kb) {
                                    f32x16 a = Sreg[kb];
                                    a = __builtin_amdgcn_mfma_f32_32x32x16_bf16(trd8(BGr, PT, 4 * h2, 8 + 4 * h2, 32 * kb, lane), uq, a, 0, 0, 0);
                                    a = __builtin_amdgcn_mfma_f32_32x32x16_bf16(trd8(BGr, PT, 16 + 8 * h2, 20 + 8 * h2, 32 * kb, lane), vfr, a, 0, 0, 0);
#pragma unroll
                                    for (int g4 = 0; g4 < 4; ++g4) { const f32x4 p4 = *(const LAS f32x4*)(PL + 32 * kb + 8 * g4 + 4 * h2);
                                        a[4 * g4] *= p4.x; a[4 * g4 + 1] *= p4.y; a[4 * g4 + 2] *= p4.z; a[4 * g4 + 3] *= p4.w; }
                                    Sreg[kb] = a;
                                }
                            }
                        }
                    }
                    __syncthreads();
                    if ((wave & 3) >= 2) EPI(SEQ - TC, ((SEQ - TC) >> 5) & 1);
                    __syncthreads();
#undef UNPH
#undef UNPJ
#undef PUW
#undef PUWS
#undef SETPU
#undef PACK8
#undef LD2x64
                } } else {
                    const int idx = job - 128, bh = idx >> 1, half = idx & 1, b = bh >> 2, h = bh & 3;
                    unsigned zl_ = 0u; asm volatile("" : "+v"(zl_)); const int lane_ml = (int)__builtin_amdgcn_mbcnt_hi(~0u, __builtin_amdgcn_mbcnt_lo(~0u, zl_));
                    _Pragma("unroll 1") for (int sr_ = 0; sr_ < NSUB(1); ++sr_) if (((SUBMASK>>1)&1) && idx < 64) {
                        SUB_TID
                        const int bm = idx >> 2, hm = idx & 3;
                        constexpr int PT = 144;
                        LAS unsigned char* QI = lds;
                        LAS unsigned char* KI = QI + 64 * PT;
                        constexpr int PV = 272;
                        LAS unsigned char* KW = KI + 64 * PT;
                        LAS unsigned char* VT = KW + 64 * PT;
                        LAS unsigned char* CI = VT + 64 * PV;
                        LAS float* AS = (LAS float*)(CI + 128 * PT);
                        LAS float* MX = AS + 64; LAS float* SI = AS + 128; LAS float* EM = AS + 192; LAS float* WG = AS + 256; LAS float* NN = AS + 320; LAS float* CR = AS + 384; LAS float* ST = AS + 448;
                        for (int i = tid; i < 128 * PT / 4; i += NTHR) ((LAS unsigned*)CI)[i] = 0u;
                        if (tid < 64) NN[tid] = 0.f;
                        const int pt = tid >> 4, cg = tid & 15;
                        const int ccol = (cg < 8) ? (hm * 64 + 8 * cg) : (256 + hm * 64 + 8 * (cg - 8));
                        const float qsc = (cg < 8) ? 0.125f : 1.f;
                        const float igb = INP(I_IGB)[l * 4 + hm], fgb = INP(I_FGB)[l * 4 + hm];
                        const int r31 = lane & 31, h2 = lane >> 5, vb = wave >> 1, tb = wave & 1;
                        f32x16 accC;
#pragma unroll
                        for (int i = 0; i < 16; ++i) accC[i] = 0.f;
                        float nreg = 0.f, mprev = 0.f;
                        u32x4 cu[2][4], vu[2]; float gi = 0.f, gf = 0.f;
                        auto LOADM = [&](int t0) {
#pragma unroll
                            for (int tt = 0; tt < 2; ++tt) { const int t = t0 + pt + 32 * tt; const size_t row = (size_t)bm * SEQ + t;
#pragma unroll
                                for (int j = 0; j < 4; ++j) { if (t - 3 + j >= 0) cu[tt][j] = *(const u32x4*)(Ub + ((row - 3 + j) * NU + UC_QK + ccol) * 2); else cu[tt][j] = (u32x4){0u, 0u, 0u, 0u}; }
                                const int p = tid + 512 * tt; vu[tt] = *(const u32x4*)(Ub + (((size_t)bm * SEQ + t0 + (p >> 4)) * NU + UC_V + hm * 128 + 8 * (p & 15)) * 2); }
                            if (wave == 0) { const size_t rg = (size_t)bm * SEQ + t0 + lane; gi = GIF[rg * 8 + hm]; gf = GIF[rg * 8 + 4 + hm]; }
                        };
                        LOADM(0);
                        __syncthreads();
#pragma unroll 1
                        for (int t0 = 0; t0 < SEQ; t0 += 64) {
                            int ccv = ccol; asm volatile("" : "+v"(ccv));
                            float cw[4][8], cb[8];
#pragma unroll
                        for (int j = 0; j < 4; ++j) { const f32x4 a = *(const f32x4*)(INP(I_CONVW) + ((size_t)l * 4 + j) * 512 + ccv), c2 = *(const f32x4*)(INP(I_CONVW) + ((size_t)l * 4 + j) * 512 + ccv + 4);
                            cw[j][0] = a.x; cw[j][1] = a.y; cw[j][2] = a.z; cw[j][3] = a.w; cw[j][4] = c2.x; cw[j][5] = c2.y; cw[j][6] = c2.z; cw[j][7] = c2.w; }
                        { const f32x4 a = *(const f32x4*)(INP(I_CONVB) + l * 512 + ccv), c2 = *(const f32x4*)(INP(I_CONVB) + l * 512 + ccv + 4);
                            cb[0] = a.x; cb[1] = a.y; cb[2] = a.z; cb[3] = a.w; cb[4] = c2.x; cb[5] = c2.y; cb[6] = c2.z; cb[7] = c2.w; }
                            float yq[2][8];
#pragma unroll
                            for (int tt = 0; tt < 2; ++tt) {
#pragma unroll
                                for (int i = 0; i < 8; ++i) yq[tt][i] = cb[i];
#pragma unroll
                                for (int j = 0; j < 4; ++j) { const u32x4 w = cu[tt][j]; const float x[8] = {bflo(w.x), bfhi(w.x), bflo(w.y), bfhi(w.y), bflo(w.z), bfhi(w.z), bflo(w.w), bfhi(w.w)};
#pragma unroll
                                    for (int i = 0; i < 8; ++i) yq[tt][i] += cw[j][i] * x[i]; }
#pragma unroll
                                for (int i = 0; i < 8; ++i) yq[tt][i] = yq[tt][i] * sigmoidf_(yq[tt][i]) * qsc;
                            }
                            const u32x4 vreg0 = vu[0], vreg1 = vu[1];
                            if (wave == 0) {
                                const float ig = gi + igb, fp = gf + fgb;
                                const float lf = -(fmaxf(-fp, 0.f) + __logf(1.f + __expf(-fabsf(fp))));
                                const float bc = scan_add64(lf);
                                const float as = ig - bc, pm = scan_max64(as);
                                const float mxv = fmaxf(mprev, pm), mx63 = __builtin_bit_cast(float, __builtin_amdgcn_readlane(__builtin_bit_cast(int, mxv), 63)), bl = __builtin_bit_cast(float, __builtin_amdgcn_readlane(__builtin_bit_cast(int, bc), 63));
                                AS[lane] = as; MX[lane] = mxv; SI[lane] = __expf(mprev - mxv); EM[lane] = __expf(-(bc + mxv)); WG[lane] = __expf(as - mx63);
                                if (lane == 0) CR[0] = __expf(mprev - mx63);
                                mprev = bl + mx63;
                            }
                            if (t0 + 64 < SEQ) LOADM(t0 + 64);
                            __syncthreads();
#pragma unroll
                            for (int tt = 0; tt < 2; ++tt) { const int tok = pt + 32 * tt;
                                u32x4 pw; pw.x = pk2(yq[tt][0], yq[tt][1]); pw.y = pk2(yq[tt][2], yq[tt][3]); pw.z = pk2(yq[tt][4], yq[tt][5]); pw.w = pk2(yq[tt][6], yq[tt][7]);
                                if (cg < 8) *(LAS u32x4*)(QI + tok * PT + cg * 16) = pw;
                                else { *(LAS u32x4*)(KI + tok * PT + (cg - 8) * 16) = pw; const float wgs = WG[tok];
                                    u32x4 kw; kw.x = pk2(yq[tt][0] * wgs, yq[tt][1] * wgs); kw.y = pk2(yq[tt][2] * wgs, yq[tt][3] * wgs); kw.z = pk2(yq[tt][4] * wgs, yq[tt][5] * wgs); kw.w = pk2(yq[tt][6] * wgs, yq[tt][7] * wgs);
                                    *(LAS u32x4*)(KW + tok * PT + (cg - 8) * 16) = kw; }
                                const u32x4 vw = tt ? vreg1 : vreg0; const int p = tid + 512 * tt, vtok = p >> 4, v8 = p & 15;
                                *(LAS u32x4*)(VT + vtok * PV + v8 * 16) = vw;
                            }
                            __syncthreads();
                            float hv[16];
                            {
                                constexpr float L2E = 1.4426950408889634f;
                                const int t = 32 * tb + r31;
                                bf16x8 qf[4];
#pragma unroll
                                for (int ks = 0; ks < 4; ++ks) qf[ks] = *(const LAS bf16x8*)(QI + t * PT + (16 * ks + 8 * h2) * 2);
                                const float mx = MX[t], si = SI[t], em = EM[t];
                                f32x16 O, I; float denI = 0.f;
#pragma unroll
                                for (int i = 0; i < 16; ++i) { O[i] = 0.f; I[i] = 0.f; }
#pragma unroll
                                for (int sb = 0; sb < 2; ++sb) if (sb <= tb) {
                                    f32x16 X;
#pragma unroll
                                    for (int i = 0; i < 16; ++i) X[i] = 0.f;
#pragma unroll
                                    for (int ks = 0; ks < 4; ++ks) { const bf16x8 kf = *(const LAS bf16x8*)(KI + (32 * sb + r31) * PT + (16 * ks + 8 * h2) * 2); X = __builtin_amdgcn_mfma_f32_32x32x16_bf16(kf, qf[ks], X, 0, 0, 0); }
#pragma unroll
                                    for (int g4 = 0; g4 < 4; ++g4) { const f32x4 a4 = *(const LAS f32x4*)(AS + 32 * sb + 8 * g4 + 4 * h2);
#pragma unroll
                                        for (int j = 0; j < 4; ++j) { const int s = 32 * sb + 8 * g4 + 4 * h2 + j; const float w = (s <= t) ? __builtin_amdgcn_exp2f((a4[j] - mx) * L2E) * X[4 * g4 + j] : 0.f; X[4 * g4 + j] = w; denI += w; } }
#pragma unroll
                                    for (int st = 0; st < 2; ++st) {
                                        u32x4 pw; pw.x = pk2(X[8 * st], X[8 * st + 1]); pw.y = pk2(X[8 * st + 2], X[8 * st + 3]); pw.z = pk2(X[8 * st + 4], X[8 * st + 5]); pw.w = pk2(X[8 * st + 6], X[8 * st + 7]);
                                        O = __builtin_amdgcn_mfma_f32_32x32x16_bf16(trd8(VT, PV, 32 * sb + 16 * st + 4 * h2, 32 * sb + 16 * st + 8 + 4 * h2, 32 * vb, lane), __builtin_bit_cast(bf16x8, pw), O, 0, 0, 0);
                                    }
                                }
                                float nq = 0.f;
#pragma unroll
                                for (int ks = 0; ks < 4; ++ks) { const bf16x8 cf = *(const LAS bf16x8*)(CI + (32 * vb + r31) * PT + (16 * ks + 8 * h2) * 2); I = __builtin_amdgcn_mfma_f32_32x32x16_bf16(cf, qf[ks], I, 0, 0, 0);
                                    const f32x4 n0 = *(const LAS f32x4*)(NN + 16 * ks + 8 * h2), n1 = *(const LAS f32x4*)(NN + 16 * ks + 8 * h2 + 4); const u32x4 qw = __builtin_bit_cast(u32x4, qf[ks]);
                                    nq += (bflo(qw.x) * n0.x + bfhi(qw.x) * n0.y) + (bflo(qw.y) * n0.z + bfhi(qw.y) * n0.w) + (bflo(qw.z) * n1.x + bfhi(qw.z) * n1.y) + (bflo(qw.w) * n1.z + bfhi(qw.w) * n1.w); }
                                nq += __shfl_xor(nq, 32); denI += __shfl_xor(denI, 32);
                                const float den = si * nq + denI, rdn = 1.f / fmaxf(fabsf(den), em);
                                float hsum = 0.f;
#pragma unroll
                                for (int i = 0; i < 16; ++i) { hv[i] = (O[i] + si * I[i]) * rdn; hsum += hv[i]; }
                                hsum += __shfl_xor(hsum, 32);
                                const float hmean = hsum * (1.f / 32.f); float hm2 = 0.f;
#pragma unroll
                                for (int i = 0; i < 16; ++i) { const float dlt = hv[i] - hmean; hm2 += dlt * dlt; }
                                hm2 += __shfl_xor(hm2, 32);
                                if (h2 == 0) *(LAS f32x2*)(ST + ((tb * 4 + vb) * 32 + r31) * 2) = (f32x2){hmean, hm2};
                                const float carry = CR[0];
#pragma unroll
                                for (int i = 0; i < 16; ++i) accC[i] *= carry;
#pragma unroll
                                for (int st = 0; st < 4; ++st) { const bf16x8 va = trd8(VT, PV, 16 * st + 8 * h2, 16 * st + 8 * h2 + 4, 32 * vb, lane), kw = trd8(KW, PT, 16 * st + 8 * h2, 16 * st + 8 * h2 + 4, 32 * tb, lane);
                                    accC = __builtin_amdgcn_mfma_f32_32x32x16_bf16(va, kw, accC, 0, 0, 0); }
                            }
                            __syncthreads();
                            {
                                const int t = 32 * tb + r31;
                                f32x2 s4[4];
#pragma unroll
                                for (int q = 0; q < 4; ++q) s4[q] = *(const LAS f32x2*)(ST + ((tb * 4 + q) * 32 + r31) * 2);
                                const float mt = (s4[0].x + s4[1].x + s4[2].x + s4[3].x) * 0.25f;
                                float m2 = 0.f;
#pragma unroll
                                for (int q = 0; q < 4; ++q) { const float dm = s4[q].x - mt; m2 += s4[q].y + 32.f * dm * dm; }
                                const float rstd = __builtin_amdgcn_rsqf(m2 * (1.f / 128.f) + LN_EPS);
                                const size_t row = (size_t)bm * SEQ + t0 + t;
                                const char* ogp = Ub + (row * NU + UC_OG + hm * 128 + 32 * vb) * 2; char* op = HC + (row * 1536 + hm * 128 + 32 * vb) * 2;
                                const float* ngp = INP(I_MLNORMG) + l * 512 + hm * 128 + 32 * vb;
#pragma unroll
                                for (int g4 = 0; g4 < 4; ++g4) { const int vo = 8 * g4 + 4 * h2; const f32x4 og = ld4bf(ogp + vo * 2), ng = *(const f32x4*)(ngp + vo);
                                    f32x4 y; y.x = sigmoidf_(og.x) * ((hv[4 * g4] - mt) * rstd * ng.x); y.y = sigmoidf_(og.y) * ((hv[4 * g4 + 1] - mt) * rstd * ng.y); y.z = sigmoidf_(og.z) * ((hv[4 * g4 + 2] - mt) * rstd * ng.z); y.w = sigmoidf_(og.w) * ((hv[4 * g4 + 3] - mt) * rstd * ng.w);
                                    st4bf(op + vo * 2, y); }
                            }
#pragma unroll
                            for (int i = 0; i < 16; ++i) { const int v = 32 * vb + (i & 3) + 8 * (i >> 2) + 4 * h2; *(LAS bf16*)(CI + v * PT + (32 * tb + r31) * 2) = (bf16)f2bf(accC[i]); }
                            if (wave < 2) { float s = 0.f;
#pragma unroll
                                for (int q8 = 0; q8 < 8; ++q8) { const u32x2 w = trd4(KW, PT, 32 * h2 + 4 * q8, 32 * wave, lane); s += (bflo(w.x) + bfhi(w.x)) + (bflo(w.y) + bfhi(w.y)); }
                                s += __shfl_xor(s, 32);
                                nreg = CR[0] * nreg + s; if (h2 == 0) NN[32 * wave + r31] = nreg; }
                            __syncthreads();
                        }
                    }
                }
            }
            if (rep_ == 0) {
                LAS unsigned* XB = (LAS unsigned*)(lds + 153088);
                unsigned* xc = (unsigned*)ctl + CW_FILL + 32 + l * 64;
                __syncthreads();
                if (tid_ph == 0) XB[0] = __hip_atomic_fetch_add(xc, 1u, RLX_AGENT);
                __syncthreads();
                int xi = __builtin_amdgcn_readfirstlane((int)XB[0]);
#pragma unroll 1
                while (xi < 128) {
                    const int idx = xi, bh = idx >> 1, half = idx & 1, b = bh >> 2, h = bh & 3;
                    _Pragma("unroll 1") for (int sr_ = 0; sr_ < NSUB(2); ++sr_) if ((SUBMASK>>2)&1) {
                        SUB_TID
                        constexpr int KST = 272, VST = 520;
                        LAS unsigned char* KI = lds; LAS unsigned char* VI = lds + 256 * KST;
                        const char* kvb = (const char*)(ws + WS_KV) + (((size_t)l * MROWS + (size_t)b * MEML) * D) * 2;
                        for (int p = tid; p < 4096; p += NTHR) { const int key = p >> 4, c16 = p & 15;
                            *(LAS u32x4*)(KI + key * KST + c16 * 16) = *(const u32x4*)(kvb + ((size_t)key * D + h * 128 + c16 * 8) * 2); }
                        for (int p = tid; p < 4096; p += NTHR) { const int key = p & 255, d8 = p >> 8;
                            const u32x4 w = *(const u32x4*)(kvb + ((size_t)key * D + 512 + h * 128 + d8 * 8) * 2);
                            LAS unsigned char* o = VI + (d8 * 8) * VST + key * 2;
                            *(LAS bf16*)(o) = (bf16)(w.x & 0xffff); *(LAS bf16*)(o + VST) = (bf16)(w.x >> 16); *(LAS bf16*)(o + 2 * VST) = (bf16)(w.y & 0xffff); *(LAS bf16*)(o + 3 * VST) = (bf16)(w.y >> 16);
                            *(LAS bf16*)(o + 4 * VST) = (bf16)(w.z & 0xffff); *(LAS bf16*)(o + 5 * VST) = (bf16)(w.z >> 16); *(LAS bf16*)(o + 6 * VST) = (bf16)(w.w & 0xffff); *(LAS bf16*)(o + 7 * VST) = (bf16)(w.w >> 16); }
                        __syncthreads();
                        const int r31 = lane & 31, h2 = lane >> 5;
                        constexpr float SC = 0.08838834764831845f * 1.4426950408889634f;
#pragma unroll 1
                        for (int rd = 0; rd < 8; ++rd) {
                            const size_t qrow = (size_t)b * SEQ + half * 2048 + rd * 256 + wave * 32 + r31;
                            bf16x8 qf[8];
#pragma unroll
                            for (int ks = 0; ks < 8; ++ks) qf[ks] = *(const bf16x8*)(Ub + (qrow * NU + UC_CAQ + h * 128 + 16 * ks + 8 * h2) * 2);
                            f32x16 O[4];
#pragma unroll
                            for (int db = 0; db < 4; ++db)
#pragma unroll
                                for (int i = 0; i < 16; ++i) O[db][i] = 0.f;
                            float mrun = -1e30f, lrun = 0.f;
#pragma unroll 1
                            for (int hf = 0; hf < 2; ++hf) {
                                f32x16 X[4];
#pragma unroll
                                for (int kb = 0; kb < 4; ++kb) {
                                    bf16x8 kf[8];
#pragma unroll
                                    for (int ks = 0; ks < 8; ++ks) kf[ks] = *(const LAS bf16x8*)(KI + (hf * 128 + kb * 32 + r31) * KST + (16 * ks + 8 * h2) * 2);
                                    __builtin_amdgcn_sched_barrier(0);
#pragma unroll
                                    for (int i = 0; i < 16; ++i) X[kb][i] = 0.f;
#pragma unroll
                                    for (int ks = 0; ks < 8; ++ks) X[kb] = __builtin_amdgcn_mfma_f32_32x32x16_bf16(kf[ks], qf[ks], X[kb], 0, 0, 0);
                                    __builtin_amdgcn_sched_barrier(0);
                                }
                                float mx = -1e30f;
#pragma unroll
                                for (int kb = 0; kb < 4; ++kb)
#pragma unroll
                                    for (int i = 0; i < 16; ++i) mx = fmaxf(mx, X[kb][i]);
                                mx = fmaxf(mx, __shfl_xor(mx, 32));
                                const float mnew = fmaxf(mrun, mx), alpha = __builtin_amdgcn_exp2f((mrun - mnew) * SC);
                                float ls = 0.f;
#pragma unroll
                                for (int kb = 0; kb < 4; ++kb)
#pragma unroll
                                    for (int i = 0; i < 16; ++i) { const float p = __builtin_amdgcn_exp2f((X[kb][i] - mnew) * SC); X[kb][i] = p; ls += p; }
                                ls += __shfl_xor(ls, 32);
                                lrun = lrun * alpha + ls; mrun = mnew;
#pragma unroll
                                for (int db = 0; db < 4; ++db)
#pragma unroll
                                    for (int i = 0; i < 16; ++i) O[db][i] *= alpha;
#pragma unroll
                                for (int kb = 0; kb < 4; ++kb) {
                                    bf16x8 vf[2][4], pf[2];
#pragma unroll
                                    for (int s = 0; s < 2; ++s) {
                                        u32x4 pw; pw.x = pk2(X[kb][8 * s], X[kb][8 * s + 1]); pw.y = pk2(X[kb][8 * s + 2], X[kb][8 * s + 3]); pw.z = pk2(X[kb][8 * s + 4], X[kb][8 * s + 5]); pw.w = pk2(X[kb][8 * s + 6], X[kb][8 * s + 7]);
                                        pf[s] = __builtin_bit_cast(bf16x8, pw);
#pragma unroll
                                        for (int db = 0; db < 4; ++db) {
                                            const LAS unsigned char* vp = VI + (db * 32 + r31) * VST + (hf * 128 + kb * 32 + 16 * s + 4 * h2) * 2;
                                            const u32x2 lo = *(const LAS u32x2*)vp, hi = *(const LAS u32x2*)(vp + 16);
                                            vf[s][db] = __builtin_bit_cast(bf16x8, (u32x4){lo.x, lo.y, hi.x, hi.y});
                                        }
                                    }
                                    __builtin_amdgcn_sched_barrier(0);
#pragma unroll
                                    for (int s = 0; s < 2; ++s)
#pragma unroll
                                        for (int db = 0; db < 4; ++db) O[db] = __builtin_amdgcn_mfma_f32_32x32x16_bf16(vf[s][db], pf[s], O[db], 0, 0, 0);
                                    __builtin_amdgcn_sched_barrier(0);
                                }
                            }
                            const float rl = 1.f / lrun;
                            char* op = HC + (qrow * 1536 + 1024 + h * 128) * 2;
#pragma unroll
                            for (int db = 0; db < 4; ++db)
#pragma unroll
                                for (int g4 = 0; g4 < 4; ++g4) { u32x2 w; w.x = pk2(O[db][4 * g4] * rl, O[db][4 * g4 + 1] * rl); w.y = pk2(O[db][4 * g4 + 2] * rl, O[db][4 * g4 + 3] * rl);
                                    *(u32x2*)(op + (db * 32 + 8 * g4 + 4 * h2) * 2) = w; }
                        }
                        __syncthreads();
                    }
                    if (tid_ph == 0) XB[0] = __hip_atomic_fetch_add(xc, 1u, RLX_AGENT);
                    __syncthreads();
                    xi = __builtin_amdgcn_readfirstlane((int)XB[0]);
                    __syncthreads();
                }
            }
            if (rep_ == 0) {
                unsigned zf_ = 0u; asm volatile("" : "+v"(zf_)); const int lane_f = (int)__builtin_amdgcn_mbcnt_hi(~0u, __builtin_amdgcn_mbcnt_lo(~0u, zf_));
                LAS float* scr = (LAS float*)(lds + wave * 8448);
                LAS unsigned* FB = (LAS unsigned*)(lds + 8 * 8448);
                unsigned* fc = (unsigned*)ctl + CW_FILL + l * 64;
                constexpr int IT_GU = 32 * 16 * 64, IT_ALL = 49152, CH = 32;
                const bool lead = (wave == 0) && (lane_f == 0);
                __syncthreads();
                if (lead) FB[0] = __hip_atomic_fetch_add(fc, (unsigned)CH, RLX_AGENT);
                __syncthreads();
                int fbase = __builtin_amdgcn_readfirstlane((int)FB[0]), slot = 1;
#pragma unroll 1
                while (fbase < IT_ALL) {
                    unsigned nb = 0u;
                    if (lead) nb = __hip_atomic_fetch_add(fc, (unsigned)CH, RLX_AGENT);
#pragma unroll 1
                    for (int kq = 0; kq < CH / NWAVES; ++kq) { const int it = fbase + wave + kq * NWAVES;
                        if (it < IT_GU) { const int e = it >> 10, q = it & 1023, kb = q >> 6, nb_ = q & 63;
                            transpose_item_f8(INP(I_WGU) + (((size_t)l * 32 + e) * D + 64 * kb) * 2048 + 32 * nb_, 2048, (unsigned char*)(ws + WS_WGU) + ((size_t)e * 2048 + 32 * nb_) * D + 64 * kb, D, F8_SWGU, scr, lane_f); }
                        else { const int r2 = it - IT_GU, e = r2 >> 9, q = r2 & 511, kb = q >> 5, nb_ = q & 31;
                            transpose_item_f8(INP(I_WDN) + (((size_t)l * 32 + e) * D + 64 * kb) * 1024 + 32 * nb_, 1024, (unsigned char*)(ws + WS_WDN) + ((size_t)e * 1024 + 32 * nb_) * D + 64 * kb, D, F8_SWDN, scr, lane_f); }
                    }
                    if (lead) FB[slot] = nb;
                    __syncthreads();
                    fbase = __builtin_amdgcn_readfirstlane((int)FB[slot]); slot ^= 1;
                }
            }
#undef UNP4
#undef DOT4
#undef SUB_TID
        }
        SEAM(pb + 3);
        _Pragma("unroll 1") for (int rep_ = 0; rep_ < NREP(5); ++rep_) if (((PHMASK>>5)&1) && IN(pb + 5)) {
            SchedPlain S; S.T.init(M / 256, 4); S.G = G; S.c = bx; S.A = (const char*)(ws + WS_R2 + R2_HCAT); S.B = (const char*)(ws + WS_WBR) + (size_t)l * 1024 * 1536 * 2; S.C = (char*)(ws + WS_R2 + R2_YPRE);
            S.lda = 1536; S.ldb = 1536; S.ldc = D;
            pg8::EpiMerge E; E.U = Ub; E.gate_b = INP(I_GATEB) + (size_t)l * 3072;
            pg8::gemm_phase<false, true>(lds, 1536 * 2, 1536 * 2, 1536 * 2, S, E, wave);
        }
        SEAM(pb + 5);
        _Pragma("unroll 1") for (int rep_ = 0; rep_ < NREP(6); ++rep_) if (((PHMASK>>6)&1) && IN(pb + 6)) {
            SchedPlain S; S.T.init(M / 256, 4); S.G = G; S.c = bx; S.A = (const char*)(ws + WS_R2 + R2_YPRE); S.B = (const char*)(ws + WS_WO) + (size_t)l * D * D * 2; S.C = (char*)(ws + WS_R2 + R2_Z);
            S.lda = D; S.ldb = D; S.ldc = D;
            pg8::EpiStore E;
            pg8::gemm_phase<false>(lds, D * 2, D * 2, D * 2, S, E, wave);
        }
        SEAM(pb + 6);
        _Pragma("unroll 1") for (int rep_ = 0; rep_ < NREP(7); ++rep_) if (((PHMASK>>7)&1) && IN(pb + 7)) { PHASE_TID
            constexpr int WP = 2064;
            LAS unsigned char* WRb = lds;
            LAS float* RB = (LAS float*)(lds + 66048);
            LAS unsigned char* XS = lds + 66560 + wave * 4608;
            for (int i = tid; i < 32768; i += NTHR) { const int k = i >> 5, e = i & 31; *(LAS bf16*)(WRb + e * WP + k * 2) = (bf16)f2bf(INP(I_RTW)[((size_t)l * D + k) * 32 + e]); }
            if (tid < 32) RB[tid] = INP(I_RTB)[l * 32 + tid];
            const char* Zb = (const char*)(ws + WS_R2 + R2_Z);
            int* TKE = (int*)(ws + WS_TKE); float* TKG = (float*)(ws + WS_TKG); int* TKP = (int*)(ws + WS_TKP); int* ROWTOK = (int*)(ws + WS_ROWTOK);
            LAS unsigned* LCNT = (LAS unsigned*)(lds + 131072);
            LAS unsigned* GBASE = LCNT + 32; LAS unsigned* LLEN = LCNT + 64; LAS unsigned* LIST = LCNT + 128;
            if (tid < 65) LCNT[tid] = 0u;
            {
                f32x4 g[4], bb[4];
#pragma unroll
                for (int j = 0; j < 4; ++j) { g[j] = *(const f32x4*)(INP(I_LN1G) + l * D + 256 * j + 4 * lane); bb[j] = *(const f32x4*)(INP(I_LN1B) + l * D + 256 * j + 4 * lane); }
#pragma unroll 1
                for (int pp = gw; pp < M / 2; pp += NGW) {
                    f32x4 y0[4], y1[4];
#pragma unroll
                    for (int j = 0; j < 4; ++j) { y0[j] = ld4bf(Zb + ((size_t)(2 * pp) * D + 256 * j + 4 * lane) * 2) + ld4bf(Xb + ((size_t)(2 * pp) * D + 256 * j + 4 * lane) * 2) * DN_ALPHA;
                        y1[j] = ld4bf(Zb + ((size_t)(2 * pp + 1) * D + 256 * j + 4 * lane) * 2) + ld4bf(Xb + ((size_t)(2 * pp + 1) * D + 256 * j + 4 * lane) * 2) * DN_ALPHA; }
                    ln16(y0, g, bb); ln16(y1, g, bb);
#pragma unroll
                    for (int j = 0; j < 4; ++j) { st4bf(Xb + ((size_t)(2 * pp) * D + 256 * j + 4 * lane) * 2, y0[j]); st4bf(Xb + ((size_t)(2 * pp + 1) * D + 256 * j + 4 * lane) * 2, y1[j]); }
                }
            }
            asm volatile("s_waitcnt vmcnt(0)" ::: "memory");
            __syncthreads();
            __builtin_amdgcn_fence(__ATOMIC_ACQUIRE, "agent");
            asm volatile("s_waitcnt vmcnt(0)" ::: "memory");
            if (rep_ == 0) {
                const int r31 = lane & 31, h2 = lane >> 5;
                const int mytok = 16 * (bx + (2 * wave + (r31 >> 4)) * G) + (r31 & 15);
                const char* sp[4];
#pragma unroll
                for (int q = 0; q < 4; ++q) { const int row = (lane >> 3) + 8 * q; const int tk = 16 * (bx + (2 * wave + (row >> 4)) * G) + (row & 15); sp[q] = Xb + ((size_t)tk * D + 8 * (lane & 7)) * 2; }
                f32x16 C;
#pragma unroll
                for (int i = 0; i < 16; ++i) C[i] = 0.f;
                u32x4 xr[4];
#pragma unroll
                for (int q = 0; q < 4; ++q) xr[q] = *(const u32x4*)(sp[q]);
#pragma unroll 1
                for (int sl = 0; sl < 16; ++sl) {
#pragma unroll
                    for (int q = 0; q < 4; ++q) *(LAS u32x4*)(XS + ((lane >> 3) + 8 * q) * 144 + (lane & 7) * 16) = xr[q];
                    if (sl + 1 < 16) {
#pragma unroll
                        for (int q = 0; q < 4; ++q) xr[q] = *(const u32x4*)(sp[q] + (sl + 1) * 128); }
#pragma unroll
                    for (int k2 = 0; k2 < 4; ++k2) C = __builtin_amdgcn_mfma_f32_32x32x16_bf16(*(const LAS bf16x8*)(WRb + r31 * WP + (64 * sl + 16 * k2 + 8 * h2) * 2), *(const LAS bf16x8*)(XS + r31 * 144 + (16 * k2 + 8 * h2) * 2), C, 0, 0, 0);
                }
                float v[16];
#pragma unroll
                for (int g4 = 0; g4 < 4; ++g4) { const f32x4 b4 = *(const LAS f32x4*)(RB + 8 * g4 + 4 * h2); v[4 * g4] = C[4 * g4] + b4.x; v[4 * g4 + 1] = C[4 * g4 + 1] + b4.y; v[4 * g4 + 2] = C[4 * g4 + 2] + b4.z; v[4 * g4 + 3] = C[4 * g4 + 3] + b4.w; }
                float lv[4]; int li_[4];
#pragma unroll
                for (int k = 0; k < 4; ++k) { float best = -3.0e38f; int bi = 0;
#pragma unroll
                    for (int i = 0; i < 16; ++i) { const int e = (i & 3) + 8 * (i >> 2) + 4 * h2; if (v[i] > best) { best = v[i]; bi = e; } }
#pragma unroll
                    for (int i = 0; i < 16; ++i) { const int e = (i & 3) + 8 * (i >> 2) + 4 * h2; v[i] = (e == bi) ? -3.0e38f : v[i]; }
                    lv[k] = best; li_[k] = bi; }
                float cv[8]; int ci[8];
#pragma unroll
                for (int k = 0; k < 4; ++k) { cv[k] = lv[k]; ci[k] = li_[k]; cv[4 + k] = __shfl_xor(lv[k], 32); ci[4 + k] = __shfl_xor(li_[k], 32); }
                float tv[4]; int te[4];
#pragma unroll
                for (int k = 0; k < 4; ++k) { float best = -3.0e38f; int bi = 64;
#pragma unroll
                    for (int i = 0; i < 8; ++i) { if (cv[i] > best || (cv[i] == best && ci[i] < bi)) { best = cv[i]; bi = ci[i]; } }
#pragma unroll
                    for (int i = 0; i < 8; ++i) cv[i] = (ci[i] == bi) ? -3.0e38f : cv[i];
                    tv[k] = best; te[k] = bi; }
                const float e1 = __expf(tv[1] - tv[0]), e2 = __expf(tv[2] - tv[0]), e3 = __expf(tv[3] - tv[0]), rs = 1.f / (1.f + e1 + e2 + e3);
                const float gt[4] = {rs, e1 * rs, e2 * rs, e3 * rs};
                if (h2 == 0) {
#pragma unroll
                    for (int k = 0; k < 4; ++k) {
                        const unsigned lpos = __hip_atomic_fetch_add(LCNT + te[k], 1u, __ATOMIC_RELAXED, __HIP_MEMORY_SCOPE_WORKGROUP);
                        const unsigned li = __hip_atomic_fetch_add(LLEN, 1u, __ATOMIC_RELAXED, __HIP_MEMORY_SCOPE_WORKGROUP);
                        LIST[2 * li] = (unsigned)(mytok * 4 + k); LIST[2 * li + 1] = (unsigned)te[k] | (lpos << 8);
                        TKE[mytok * 4 + k] = te[k]; TKG[mytok * 4 + k] = gt[k]; }
                }
            }
            __syncthreads();
            if (tid < 32 && rep_ == 0) GBASE[tid] = __hip_atomic_fetch_add((unsigned*)ctl + CW_CNT + (l * 32 + tid) * 64, LCNT[tid], RLX_AGENT);
            __syncthreads();
            if (rep_ == 0) { const unsigned n = LLEN[0];
                for (unsigned i = tid; i < n; i += NTHR) { const unsigned tk = LIST[2 * i], ev = LIST[2 * i + 1], e = ev & 255u, pos = GBASE[e] + (ev >> 8);
                    TKP[tk] = (int)pos; ROWTOK[(size_t)e * M + pos] = (int)(tk >> 2); } }
            __syncthreads();
        }
        SEAM(pb + 7);
        _Pragma("unroll 1") for (int rep_ = 0; rep_ < NREP(8); ++rep_) if (((PHMASK>>8)&1) && IN(pb + 8)) { PHASE_TID
            if (tid < 32) CNT[tid] = (int)__hip_atomic_load((unsigned*)ctl + CW_CNT + (l * 32 + tid) * 64, RLX_AGENT);
            __syncthreads();
            if (tid == 0) { int a = 0; for (int e = 0; e < 32; ++e) { PB[e] = a; a += (CNT[e] + 255) >> 8; } PB[32] = a; }
            __syncthreads();
            const int P = PB[32];
            const int* ROWTOK = (const int*)(ws + WS_ROWTOK);
            char* XD = (char*)(ws + WS_R1);
            for (int sb = gw * 64; sb < P * 256; sb += NGW * 64) {
                const int pm = sb >> 8; int e = 0;
#pragma unroll 1
                for (int j = 1; j < NEXP; ++j) e += (PB[j] <= pm) ? 1 : 0;
                const int pos0 = sb - PB[e] * 256, cnt = CNT[e];
                int nvalid = cnt - pos0; nvalid = nvalid > 64 ? 64 : nvalid;
                int tokv = -1; if (pos0 + lane < cnt) tokv = ROWTOK[(size_t)e * M + pos0 + lane];
#pragma unroll 1
                for (int j = 0; j < nvalid; j += 2) {
                    int t[2]; u32x4 a[2], b2[2];
#pragma unroll
                    for (int i = 0; i < 2; ++i) { t[i] = __builtin_amdgcn_readlane(tokv, j + i);
                        if (t[i] >= 0) { a[i] = *(const u32x4*)(Xb + (size_t)t[i] * 2048 + lane * 32); b2[i] = *(const u32x4*)(Xb + (size_t)t[i] * 2048 + lane * 32 + 16); } }
#pragma unroll
                    for (int i = 0; i < 2; ++i) if (t[i] >= 0) {
                        u32x4 o; o.x = pk4_f8(bflo(a[i].x) * F8_SX, bfhi(a[i].x) * F8_SX, bflo(a[i].y) * F8_SX, bfhi(a[i].y) * F8_SX); o.y = pk4_f8(bflo(a[i].z) * F8_SX, bfhi(a[i].z) * F8_SX, bflo(a[i].w) * F8_SX, bfhi(a[i].w) * F8_SX);
                        o.z = pk4_f8(bflo(b2[i].x) * F8_SX, bfhi(b2[i].x) * F8_SX, bflo(b2[i].y) * F8_SX, bfhi(b2[i].y) * F8_SX); o.w = pk4_f8(bflo(b2[i].z) * F8_SX, bfhi(b2[i].z) * F8_SX, bflo(b2[i].w) * F8_SX, bfhi(b2[i].w) * F8_SX);
                        *(u32x4*)(XD + (size_t)(sb + j + i) * 1024 + lane * 16) = o; }
                }
            }
            LAS float* scr = (LAS float*)(lds + wave * 8448);
            constexpr int IT_GU = 32 * 16 * 64, IT_DN = 32 * 16 * 32;
            for (int it = XW_SPLIT + gw; it < IT_GU + IT_DN; it += NGW) {
                if (it < IT_GU) { const int e = it >> 10, q = it & 1023, kb = q >> 6, nb = q & 63;
                    transpose_item_f8(INP(I_WGU) + (((size_t)l * 32 + e) * D + 64 * kb) * 2048 + 32 * nb, 2048, (unsigned char*)(ws + WS_WGU) + ((size_t)e * 2048 + 32 * nb) * D + 64 * kb, D, F8_SWGU, scr, lane); }
                else { const int r = it - IT_GU, e = r >> 9, q = r & 511, kb = q >> 5, nb = q & 31;
                    transpose_item_f8(INP(I_WDN) + (((size_t)l * 32 + e) * D + 64 * kb) * 1024 + 32 * nb, 1024, (unsigned char*)(ws + WS_WDN) + ((size_t)e * 1024 + 32 * nb) * D + 64 * kb, D, F8_SWDN, scr, lane); }
            }
            __syncthreads();
        }
        SEAM(pb + 8);
        if (IN(pb + 9) || IN(pb + 10)) { PHASE_TID
            if (tid < 32) CNT[tid] = (int)__hip_atomic_load((unsigned*)ctl + CW_CNT + (l * 32 + tid) * 64, RLX_AGENT);
            __syncthreads();
            if (tid == 0) { int a = 0; for (int e = 0; e < 32; ++e) { PB[e] = a; a += (CNT[e] + 255) >> 8; } PB[32] = a; }
            __syncthreads();
        }
        _Pragma("unroll 1") for (int rep_ = 0; rep_ < NREP(9); ++rep_) if (((PHMASK>>9)&1) && IN(pb + 9)) {
            SchedMoe S; S.T.init(PB[32], 8); S.G = G; S.c = bx; S.A = (const char*)(ws + WS_R1); S.W = (const char*)(ws + WS_WGU); S.C = (char*)(ws + WS_R2 + R2_HMID); S.PB = PB; S.wrows = 2048; S.ldc = 1024; S.cdiv = 2; S.osz = 1;
            pg8::EpiMoe1 E; E.bgu = INP(I_BGU) + (size_t)l * 32 * 2048;
            pg8::gemm_phase<true>(lds, D, D, D, S, E, wave);
        }
        SEAM(pb + 9);
        _Pragma("unroll 1") for (int rep_ = 0; rep_ < NREP(10); ++rep_) if (((PHMASK>>10)&1) && IN(pb + 10)) {
            SchedMoe S; S.T.init(PB[32], 4); S.G = G; S.c = bx; S.A = (const char*)(ws + WS_R2 + R2_HMID); S.W = (const char*)(ws + WS_WDN); S.C = (char*)(ws + WS_R1); S.PB = PB; S.wrows = 1024; S.ldc = 1024; S.cdiv = 1; S.osz = 2;
            pg8::EpiMoe2 E; E.bdn = INP(I_BDN) + (size_t)l * 32 * 1024;
            pg8::gemm_phase<true>(lds, D, D, D, S, E, wave);
        }
        SEAM(pb + 10);
        _Pragma("unroll 1") for (int rep_ = 0; rep_ < NREP(11); ++rep_) if (((PHMASK>>11)&1) && IN(pb + 11)) { PHASE_TID
            if (tid < 32) CNT[tid] = (int)__hip_atomic_load((unsigned*)ctl + CW_CNT + (l * 32 + tid) * 64, RLX_AGENT);
            LAS float* wgt = (LAS float*)(lds + 73728);
            const bool lastl = (l == DEPTH - 1);
            if (!lastl) load_gate_table(wgt, INP(I_WIN) + (size_t)(l + 1) * D * DIN, tid);
            __syncthreads();
            if (tid == 0) { int a = 0; for (int e = 0; e < 32; ++e) { PB[e] = a; a += (CNT[e] + 255) >> 8; } PB[32] = a; }
            __syncthreads();
            const int e0 = 8 * lane;
            f32x4 g[4], bb[4];
#pragma unroll
            for (int j = 0; j < 4; ++j) { const int o = (j >> 1) * 512 + e0 + (j & 1) * 4; g[j] = *(const f32x4*)(INP(I_LN2G) + l * D + o); bb[j] = *(const f32x4*)(INP(I_LN2B) + l * D + o); }
            const char* YA = (const char*)(ws + WS_R1);
            const bool dummy_ = (rep_ + 1 < NREP(11)); char* const Xo = dummy_ ? (char*)(ws + WS_R2) : Xb; float* const Fo = dummy_ ? (float*)(ws + WS_R2 + 256 * MiB) : args.out; float* const Go = dummy_ ? (float*)(ws + WS_R2 + 200 * MiB) : GIF;
            const int* TKE = (const int*)(ws + WS_TKE); const float* TKG = (const float*)(ws + WS_TKG); const int* TKP = (const int*)(ws + WS_TKP);
#pragma unroll 1
            for (int mb = gw * 16; mb < M; mb += NGW * 16) {
                const int ev = TKE[mb * 4 + lane], pv = TKP[mb * 4 + lane]; const float gv = TKG[mb * 4 + lane];
                const int rowv = PB[ev] * 256 + pv;
#pragma unroll 1
                for (int ti = 0; ti < 16; ti += 2) {
                    u32x4 xw[2][2], yw[2][4][2]; float gk[2][4];
#pragma unroll
                    for (int q = 0; q < 2; ++q) { const size_t m = (size_t)mb + ti + q;
                        xw[q][0] = *(const u32x4*)(Xb + (m * D + e0) * 2); xw[q][1] = *(const u32x4*)(Xb + (m * D + 512 + e0) * 2);
#pragma unroll
                        for (int k = 0; k < 4; ++k) { const size_t row = (size_t)__builtin_amdgcn_readlane(rowv, 4 * (ti + q) + k);
                            gk[q][k] = __builtin_bit_cast(float, __builtin_amdgcn_readlane(__builtin_bit_cast(int, gv), 4 * (ti + q) + k));
                            yw[q][k][0] = *(const u32x4*)(YA + (row * D + e0) * 2); yw[q][k][1] = *(const u32x4*)(YA + (row * D + 512 + e0) * 2); } }
#pragma unroll
                    for (int q = 0; q < 2; ++q) { const size_t m = (size_t)mb + ti + q;
                        f32x4 v[4];
#pragma unroll
                        for (int hh = 0; hh < 2; ++hh) { const u32x4 w = xw[q][hh];
                            v[2 * hh] = (f32x4){bflo(w.x), bfhi(w.x), bflo(w.y), bfhi(w.y)} * DN_ALPHA; v[2 * hh + 1] = (f32x4){bflo(w.z), bfhi(w.z), bflo(w.w), bfhi(w.w)} * DN_ALPHA; }
#pragma unroll
                        for (int k = 0; k < 4; ++k)
#pragma unroll
                            for (int hh = 0; hh < 2; ++hh) { const u32x4 w = yw[q][k][hh];
                                v[2 * hh] = v[2 * hh] + (f32x4){bflo(w.x), bfhi(w.x), bflo(w.y), bfhi(w.y)} * gk[q][k]; v[2 * hh + 1] = v[2 * hh + 1] + (f32x4){bflo(w.z), bfhi(w.z), bflo(w.w), bfhi(w.w)} * gk[q][k]; }
                        ln16(v, g, bb);
                        if (lastl) {
#pragma unroll
                            for (int j = 0; j < 4; ++j) *(f32x4*)(Fo + m * D + (j >> 1) * 512 + e0 + (j & 1) * 4) = v[j];
                        } else {
#pragma unroll
                            for (int hh = 0; hh < 2; ++hh) { *(u32x4*)(Xo + (m * D + hh * 512 + e0) * 2) = pg8::pack8(v[2 * hh], v[2 * hh + 1]);
                                u32x2 f8w; f8w.x = pk4_f8(v[2 * hh].x * F8_SX, v[2 * hh].y * F8_SX, v[2 * hh].z * F8_SX, v[2 * hh].w * F8_SX); f8w.y = pk4_f8(v[2 * hh + 1].x * F8_SX, v[2 * hh + 1].y * F8_SX, v[2 * hh + 1].z * F8_SX, v[2 * hh + 1].w * F8_SX);
                                if (!dummy_) *(u32x2*)((char*)(ws + WS_XF8) + m * D + hh * 512 + e0) = f8w; }
                            gates8b(v, wgt, Go + m * 8, lane);
                        }
                    }
                }
            }
            __syncthreads();
        }
        SEAM(pb + 11);
    }
#undef IN
#undef SEAM
}

extern "C" void kernel_launch(void* const* d_in, const int* in_sizes, int n_in, void* d_out, int out_size, void* d_ws, size_t ws_size, hipStream_t stream) {
    static int grid = 0;
    if (grid == 0) {
        if (n_in != N_IN || out_size != M * D || ws_size < WS_END) { fprintf(stderr, "kernel_launch: unexpected shapes (n_in %d, out %d, ws %zu)\n", n_in, out_size, ws_size); grid = -1; return; }
        int dev = 0, cus = 0, per_cu = 0;
        if (hipGetDevice(&dev) != hipSuccess || hipDeviceGetAttribute(&cus, hipDeviceAttributeMultiprocessorCount, dev) != hipSuccess) { grid = -1; return; }
        if (hipFuncSetAttribute((const void*)fwd_kernel, hipFuncAttributeMaxDynamicSharedMemorySize, LDS_BYTES) != hipSuccess) { fprintf(stderr, "kernel_launch: hipFuncSetAttribute failed\n"); grid = -1; return; }
        if (hipOccupancyMaxActiveBlocksPerMultiprocessor(&per_cu, (const void*)fwd_kernel, NTHR, LDS_BYTES) != hipSuccess || per_cu < 1) fprintf(stderr, "kernel_launch: occupancy query reports %d\n", per_cu);
        (void)hipGetLastError();
        grid = cus;
    }
    if (grid < 0) return;
    (void)hipMemsetAsync((char*)d_ws + WS_CTL, 0, CTL_ZERO_BYTES, stream);
    Args a{};
    for (int i = 0; i < N_IN; ++i) a.in[i] = (const float*)d_in[i];
    a.out = (float*)d_out; a.ws = (unsigned char*)d_ws;
#if MK_ONE_LAUNCH
    a.ph_lo = 0; a.ph_hi = NPH;
    hipLaunchKernelGGL(fwd_kernel, dim3(grid), dim3(NTHR), LDS_BYTES, stream, a);
#else
    for (int p = 0; p < NPH; ++p) { a.ph_lo = p; a.ph_hi = p + 1; hipLaunchKernelGGL(fwd_kernel, dim3(grid), dim3(NTHR), LDS_BYTES, stream, a); }
#endif
    const hipError_t le = hipPeekAtLastError();
    if (le != hipSuccess) fprintf(stderr, "kernel_launch: launch failed: %s\n", hipGetErrorName(le));
}
```

```cpp
#include <hip/hip_runtime.h>
#include <cstdio>
#include <cstdint>

#ifndef MK_ONE_LAUNCH
#define MK_ONE_LAUNCH 1
#endif

#define LAS __attribute__((address_space(3)))
#define GAS __attribute__((address_space(1)))
typedef unsigned short bf16;
typedef short bf16x8 __attribute__((ext_vector_type(8)));
typedef float f32x4 __attribute__((ext_vector_type(4)));
typedef float f32x2 __attribute__((ext_vector_type(2)));
typedef float f32x16 __attribute__((ext_vector_type(16)));
typedef unsigned u32x4 __attribute__((ext_vector_type(4)));
typedef unsigned u32x2 __attribute__((ext_vector_type(2)));
typedef __bf16 bf16x2_t __attribute__((ext_vector_type(2)));
typedef GAS unsigned gu32;
#define RLX_AGENT __ATOMIC_RELAXED, __HIP_MEMORY_SCOPE_AGENT
#define DI __device__ __forceinline__

constexpr int NWAVES = 8, NTHR = 512;
constexpr int D = 1024, BATCH = 16, SEQ = 4096, M = BATCH * SEQ, DEPTH = 2, MEML = 256, MROWS = BATCH * MEML;
constexpr int DIN = 6920, NU = 6912;
constexpr int UC_QK = 0, UC_RW = 512, UC_V = 2304, UC_OG = 2816, UC_CAQ = 3328, UC_GATE = 3840;
constexpr int UC_F8 = UC_V, NF8 = NU - UC_F8;
__host__ __device__ constexpr int ucol_src(int c) { return c < 512 ? c : (c < 2304 ? 1544 + (c - 512) : (c < 2816 ? 512 + (c - 2304) : (c < 3328 ? 1024 + (c - 2816) : (c < 3840 ? 3336 + (c - 3328) : 3848 + (c - 3840))))); }
constexpr int NEXP = 32, TOPK = 4;
constexpr int PMAX = M * TOPK / 256 + NEXP;
constexpr float LN_EPS = 1e-5f, RW_GN_EPS = 64e-5f, DN_ALPHA = 1.41421356237f;

enum { I_X = 0, I_MEM, I_LNIN_G, I_LNIN_B, I_MEMLN_G, I_MEMLN_B, I_WIN, I_CONVW, I_CONVB, I_IGB, I_FGB, I_MLNORMG, I_RWMU, I_RWW0, I_RWWUP, I_RWA0, I_RWAUP, I_RWGUP,
       I_RWKK, I_RWKA, I_RWRK, I_RWLNG, I_RWLNB, I_CAWKV, I_GATEB, I_WBRML, I_WBRRW, I_WBRCA, I_WO, I_LN1G, I_LN1B, I_RTW, I_RTB, I_WGU, I_BGU, I_WDN, I_BDN, I_LN2G, I_LN2B, N_IN };

constexpr size_t MiB = 1u << 20;
constexpr size_t WS_CTL = 0, CTL_ZERO_BYTES = 1 * MiB;
constexpr size_t WS_WIN = 1 * MiB;
constexpr size_t WS_WKV = 28 * MiB;
constexpr size_t WS_WBR = 32 * MiB;
constexpr size_t WS_WO = 38 * MiB;
constexpr size_t WS_WLORA = 42 * MiB;
constexpr size_t WS_WGU = 45 * MiB;
constexpr size_t WS_WDN = 173 * MiB;
constexpr size_t WS_X = 237 * MiB;
constexpr size_t WS_MEMN = 365 * MiB;
constexpr size_t WS_KV = 373 * MiB;
constexpr size_t WS_GIF = 389 * MiB;
constexpr size_t WS_TKE = 391 * MiB, WS_TKG = 392 * MiB, WS_TKP = 393 * MiB;
constexpr size_t WS_ROWTOK = 394 * MiB;
constexpr size_t WS_HML = 402 * MiB;
constexpr size_t WS_R1 = 466 * MiB;
constexpr size_t WS_R2 = 1330 * MiB;
constexpr size_t WS_XF8 = 1858 * MiB;
constexpr size_t WS_WING8 = 1922 * MiB;
constexpr size_t WS_END = 1932 * MiB;
constexpr size_t R2_LORA_OUT = 0, R2_HCAT = 192 * MiB, R2_LORA_IN = 384 * MiB, R2_YPRE = 0, R2_Z = 192 * MiB, R2_HMID = 0;
constexpr int CW_TMO = 0, CW_BAR = 4096, CW_CNT = 16384, CW_FILL = 32768;

constexpr int LDS_BYTES = 155648;
constexpr int LDSCTL_OFF = 153600;

DI unsigned pk2(float lo, float hi) { bf16x2_t b = __builtin_convertvector((f32x2){lo, hi}, bf16x2_t); return __builtin_bit_cast(unsigned, b); }
DI unsigned f2bf(float f) { return pk2(f, 0.f) & 0xffffu; }
DI float u2f_(unsigned u) { return __builtin_bit_cast(float, u); }
DI unsigned f2u_(float f) { return __builtin_bit_cast(unsigned, f); }
DI float bflo(unsigned u) { return __builtin_bit_cast(float, u << 16); }
DI float bfhi(unsigned u) { return __builtin_bit_cast(float, u & 0xffff0000u); }
DI unsigned pk4_f8(float a, float b, float c, float d) {
    a = __builtin_amdgcn_fmed3f(a, -448.f, 448.f); b = __builtin_amdgcn_fmed3f(b, -448.f, 448.f); c = __builtin_amdgcn_fmed3f(c, -448.f, 448.f); d = __builtin_amdgcn_fmed3f(d, -448.f, 448.f);
    int w = 0; w = __builtin_amdgcn_cvt_pk_fp8_f32(a, b, w, false); w = __builtin_amdgcn_cvt_pk_fp8_f32(c, d, w, true); return (unsigned)w; }
DI float sigmoidf_(float x) { return __builtin_amdgcn_rcpf(1.f + __builtin_amdgcn_exp2f(-1.4426950408889634f * x)); }
template <int CTRL> DI float dppf(float x) { return __builtin_bit_cast(float, __builtin_amdgcn_update_dpp(0, __builtin_bit_cast(int, x), CTRL, 0xF, 0xF, true)); }
DI float red4(float x) { x += dppf<0xB1>(x); x += dppf<0x4E>(x); return x; }
DI float red8(float x) { x = red4(x); x += dppf<0x141>(x); return x; }
DI float red16(float x) { x = red8(x); x += dppf<0x140>(x); return x; }
DI float red8o(float x) { x += dppf<0xB1>(x); asm("" : "+v"(x)); x += dppf<0x4E>(x); asm("" : "+v"(x)); x += dppf<0x141>(x); asm("" : "+v"(x)); return x; }
DI float red16o(float x) { x = red8o(x); x += dppf<0x140>(x); asm("" : "+v"(x)); return x; }
typedef short s16x4 __attribute__((ext_vector_type(4)));
DI u32x2 trd4(const LAS unsigned char* img, int PB, int rowbase, int colbase, int lane) {
    const LAS unsigned char* p = img + (rowbase + ((lane & 15) >> 2)) * PB + (colbase + 16 * ((lane >> 4) & 1) + 4 * (lane & 3)) * 2;
    return __builtin_bit_cast(u32x2, __builtin_amdgcn_ds_read_tr16_b64_v4i16((LAS s16x4*)p)); }
DI bf16x8 trd8(const LAS unsigned char* img, int PB, int rb0, int rb1, int colbase, int lane) { const u32x2 lo = trd4(img, PB, rb0, colbase, lane), hi = trd4(img, PB, rb1, colbase, lane); return __builtin_bit_cast(bf16x8, (u32x4){lo.x, lo.y, hi.x, hi.y}); }
template <int CTRL, int RM> DI float dpp_keep(float x, float ident) { return __builtin_bit_cast(float, __builtin_amdgcn_update_dpp(__builtin_bit_cast(int, ident), __builtin_bit_cast(int, x), CTRL, RM, 0xF, false)); }
DI float scan_add64(float x) { x += dpp_keep<0x111, 0xF>(x, 0.f); x += dpp_keep<0x112, 0xF>(x, 0.f); x += dpp_keep<0x114, 0xF>(x, 0.f); x += dpp_keep<0x118, 0xF>(x, 0.f); x += dpp_keep<0x142, 0xA>(x, 0.f); x += dpp_keep<0x143, 0xC>(x, 0.f); return x; }
DI float scan_max64(float x) { const float NI = -3.0e38f; x = fmaxf(x, dpp_keep<0x111, 0xF>(x, NI)); x = fmaxf(x, dpp_keep<0x112, 0xF>(x, NI)); x = fmaxf(x, dpp_keep<0x114, 0xF>(x, NI)); x = fmaxf(x, dpp_keep<0x118, 0xF>(x, NI));
    x = fmaxf(x, dpp_keep<0x142, 0xA>(x, NI)); x = fmaxf(x, dpp_keep<0x143, 0xC>(x, NI)); return x; }
DI float wave_sum(float v) {
    v = red16(v);
    const int vi = __builtin_bit_cast(int, v);
    const float a = __builtin_bit_cast(float, __builtin_amdgcn_readlane(vi, 0)), b = __builtin_bit_cast(float, __builtin_amdgcn_readlane(vi, 16));
    const float c = __builtin_bit_cast(float, __builtin_amdgcn_readlane(vi, 32)), d = __builtin_bit_cast(float, __builtin_amdgcn_readlane(vi, 48));
    return (a + b) + (c + d);
}
#define LDS_WAIT() asm volatile("s_waitcnt lgkmcnt(0)" ::: "memory")

constexpr float F8_SX = 8.f, F8_SWGU = 512.f, F8_SH = 4.f, F8_SWDN = 1024.f, F8_INV1 = 1.f / (F8_SX * F8_SWGU), F8_INV2 = 1.f / (F8_SH * F8_SWDN);
namespace pg8 {
constexpr int BM = 256, BK = 64, HALF = 128, HTB = HALF * BK * 2, STAGE_BYTES = 8 * HTB, NXCD = 8, WGM = 8;
__host__ __device__ __forceinline__ int lds_byte(int r, int c) { const int st = (r >> 4) * 2 + (c >> 5), rr = r & 15, cc = c & 31, ob = rr * 64 + cc * 2; return st * 1024 + (ob ^ (((ob >> 9) & 1) << 5)); }
__host__ __device__ __forceinline__ void stage_rc(int b, int& R, int& C) { const int st = b / 1024, sb = b % 1024, swz = sb ^ (((sb >> 9) & 1) << 5); R = (st >> 1) * 16 + swz / 64; C = (st & 1) * 32 + (swz % 64) / 2; }
__host__ __device__ __forceinline__ int perm32(int rho) { const int n = rho >> 4, i = rho & 15; return 8 * (i >> 2) + 4 * n + (i & 3); }

struct Unit { const char* a; const char* b; char* c; int ldc; int r0, c0, e, sub; };

struct TileOrder {
    int nM, nN, nwg;
    DI void init(int nM_, int nN_) { nM = nM_; nN = nN_; nwg = nM * nN; }
    DI bool tile(long L, int& pm, int& pn) const {
        if (L >= nwg) return false;
        int wgid = (int)L; { const int q = nwg / NXCD, r = nwg % NXCD, xcd = wgid % NXCD, off = wgid / NXCD; wgid = (xcd < r ? xcd * (q + 1) : r * (q + 1) + (xcd - r) * q) + off; }
        const int nig = WGM * nN, gid = wgid / nig, fm = gid * WGM, gsz = (nM - fm) < WGM ? (nM - fm) : WGM;
        pm = fm + ((wgid % nig) % gsz); pn = (wgid % nig) / gsz; return true;
    }
};

DI u32x4 pack8(const f32x4& v0, const f32x4& v1) { u32x4 w; w.x = pk2(v0[0], v0[1]); w.y = pk2(v0[2], v0[3]); w.z = pk2(v1[0], v1[1]); w.w = pk2(v1[2], v1[3]); return w; }

struct EpiStore {
    DI void operator()(const f32x4 (&acc)[2][2][4][2], const Unit& u, int wr, int wc, int fr, int fq) const {
#pragma unroll
        for (int ai = 0; ai < 2; ++ai)
#pragma unroll
            for (int m = 0; m < 4; ++m) { char* rowp = u.c + ((size_t)(ai * HALF + wr * 64 + m * 16 + fr) * u.ldc + wc * 32 + 8 * fq) * 2;
#pragma unroll
                for (int bj = 0; bj < 2; ++bj) *(u32x4*)(rowp + bj * 256) = pack8(acc[ai][bj][m][0], acc[ai][bj][m][1]); }
    }
};
struct EpiStoreS {
    float s; const float* gate_b; int gate_c0;
    DI void operator()(const f32x4 (&acc)[2][2][4][2], const Unit& u, int wr, int wc, int fr, int fq) const {
        const bool gate = u.c0 >= gate_c0;
        const float L2E = 1.4426950408889634f;
#pragma unroll
        for (int bj = 0; bj < 2; ++bj) {
            f32x4 g0 = (f32x4){0.f, 0.f, 0.f, 0.f}, g1 = g0;
            if (gate) { const float* g = gate_b + (u.c0 - gate_c0) + bj * HALF + wc * 32 + 8 * fq; g0 = *(const f32x4*)g; g1 = *(const f32x4*)(g + 4); }
#pragma unroll
            for (int ai = 0; ai < 2; ++ai)
#pragma unroll
                for (int m = 0; m < 4; ++m) { char* rowp = u.c + ((size_t)(ai * HALF + wr * 64 + m * 16 + fr) * u.ldc + wc * 32 + 8 * fq) * 2;
                    f32x4 v0 = acc[ai][bj][m][0] * s, v1 = acc[ai][bj][m][1] * s;
                    if (gate) {
#pragma unroll
                        for (int i = 0; i < 4; ++i) { v0[i] = __builtin_amdgcn_exp2f(-L2E * __builtin_amdgcn_fmed3f(v0[i] + g0[i], -30.f, 30.f)); v1[i] = __builtin_amdgcn_exp2f(-L2E * __builtin_amdgcn_fmed3f(v1[i] + g1[i], -30.f, 30.f)); } }
                    *(u32x4*)(rowp + bj * 256) = pack8(v0, v1); }
        }
    }
};
struct EpiMerge {
    static constexpr bool MIDK = true;
    const char* U; const float* gate_b;
    DI void mid(f32x4 (&acc)[2][2][4][2], const Unit& u, int which, int wr, int wc, int fr, int fq) const {
#pragma unroll
        for (int bj = 0; bj < 2; ++bj)
#pragma unroll
            for (int ai = 0; ai < 2; ++ai) {
                u32x4 wa[4], wn[4];
#pragma unroll
                for (int m = 0; m < 4; ++m) { const int lr = ai * HALF + wr * 64 + m * 16 + fr;
                    const char* gp = U + ((size_t)(u.r0 + lr) * NU + UC_GATE + which * 1024 + u.c0 + wc * 32 + 8 * fq) * 2 + bj * 256;
                    wa[m] = *(const u32x4*)gp; wn[m] = *(const u32x4*)(gp + 2048); }
#pragma unroll
                for (int m = 0; m < 4; ++m) {
                    const u32x4 a = wa[m], n = wn[m];
                    const float ea[8] = {bflo(a.x), bfhi(a.x), bflo(a.y), bfhi(a.y), bflo(a.z), bfhi(a.z), bflo(a.w), bfhi(a.w)};
                    const float en[8] = {bflo(n.x), bfhi(n.x), bflo(n.y), bfhi(n.y), bflo(n.z), bfhi(n.z), bflo(n.w), bfhi(n.w)};
#pragma unroll
                    for (int i = 0; i < 8; ++i) acc[ai][bj][m][i >> 2][i & 3] *= (1.f + en[i]) * __builtin_amdgcn_rcpf(1.f + ea[i]); }
                asm volatile("" ::: "memory"); }
    }
    DI void operator()(const f32x4 (&acc)[2][2][4][2], const Unit& u, int wr, int wc, int fr, int fq) const {
#pragma unroll
        for (int bj = 0; bj < 2; ++bj) {
            u32x4 gw[2][4];
#pragma unroll
            for (int ai = 0; ai < 2; ++ai)
#pragma unroll
                for (int m = 0; m < 4; ++m) { const int lr = ai * HALF + wr * 64 + m * 16 + fr; gw[ai][m] = *(const u32x4*)(U + ((size_t)(u.r0 + lr) * NU + UC_GATE + 2048 + u.c0 + wc * 32 + 8 * fq) * 2 + bj * 256); }
#pragma unroll
            for (int ai = 0; ai < 2; ++ai)
#pragma unroll
                for (int m = 0; m < 4; ++m) { const int lr = ai * HALF + wr * 64 + m * 16 + fr; char* rowp = u.c + ((size_t)lr * u.ldc + wc * 32 + 8 * fq) * 2; const u32x4 w = gw[ai][m];
                    f32x4 v0 = acc[ai][bj][m][0], v1 = acc[ai][bj][m][1];
                    v0[0] *= __builtin_amdgcn_rcpf(1.f + bflo(w.x)); v0[1] *= __builtin_amdgcn_rcpf(1.f + bfhi(w.x)); v0[2] *= __builtin_amdgcn_rcpf(1.f + bflo(w.y)); v0[3] *= __builtin_amdgcn_rcpf(1.f + bfhi(w.y));
                    v1[0] *= __builtin_amdgcn_rcpf(1.f + bflo(w.z)); v1[1] *= __builtin_amdgcn_rcpf(1.f + bfhi(w.z)); v1[2] *= __builtin_amdgcn_rcpf(1.f + bflo(w.w)); v1[3] *= __builtin_amdgcn_rcpf(1.f + bfhi(w.w));
                    *(u32x4*)(rowp + bj * 256) = pack8(v0, v1); }
            asm volatile("" ::: "memory");
        }
    }
};
struct EpiWo {
    const char* X;
    DI void operator()(const f32x4 (&acc)[2][2][4][2], const Unit& u, int wr, int wc, int fr, int fq) const {
#pragma unroll
        for (int ai = 0; ai < 2; ++ai)
#pragma unroll
            for (int m = 0; m < 4; ++m) { const int lr = ai * HALF + wr * 64 + m * 16 + fr; char* rowp = u.c + ((size_t)lr * u.ldc + wc * 32 + 8 * fq) * 2;
                const char* xp = X + ((size_t)(u.r0 + lr) * D + u.c0 + wc * 32 + 8 * fq) * 2;
#pragma unroll
                for (int bj = 0; bj < 2; ++bj) { const u32x4 xw = *(const u32x4*)(xp + bj * 256);
                    f32x4 v0 = acc[ai][bj][m][0], v1 = acc[ai][bj][m][1];
                    v0[0] += DN_ALPHA * bflo(xw.x); v0[1] += DN_ALPHA * bfhi(xw.x); v0[2] += DN_ALPHA * bflo(xw.y); v0[3] += DN_ALPHA * bfhi(xw.y);
                    v1[0] += DN_ALPHA * bflo(xw.z); v1[1] += DN_ALPHA * bfhi(xw.z); v1[2] += DN_ALPHA * bflo(xw.w); v1[3] += DN_ALPHA * bfhi(xw.w);
                    *(u32x4*)(rowp + bj * 256) = pack8(v0, v1); }
                asm volatile("" ::: "memory"); }
    }
};
DI float swiglu1(float a, float b) { const float g = fminf(a, 7.f), l = fminf(fmaxf(b, -7.f), 7.f); return g * sigmoidf_(1.702f * g) * (l + 1.f); }
struct EpiMoe1 {
    const float* bgu;
    DI void operator()(const f32x4 (&acc)[2][2][4][2], const Unit& u, int wr, int wc, int fr, int fq) const {
        f32x4 bv[2][2];
#pragma unroll
        for (int bj = 0; bj < 2; ++bj) { const float* b = bgu + u.e * 2048 + u.c0 + bj * HALF + wc * 32 + 8 * fq; bv[bj][0] = *(const f32x4*)b; bv[bj][1] = *(const f32x4*)(b + 4); }
#pragma unroll
        for (int ai = 0; ai < 2; ++ai)
#pragma unroll
            for (int m = 0; m < 4; ++m) { const int lr = ai * HALF + wr * 64 + m * 16 + fr; char* rowp = u.c + ((size_t)lr * u.ldc + wc * 16 + 4 * fq);
#pragma unroll
                for (int bj = 0; bj < 2; ++bj) { const f32x4 v0 = acc[ai][bj][m][0] * F8_INV1 + bv[bj][0], v1 = acc[ai][bj][m][1] * F8_INV1 + bv[bj][1];
                    *(unsigned*)(rowp + bj * 64) = pk4_f8(swiglu1(v0[0], v0[1]) * F8_SH, swiglu1(v0[2], v0[3]) * F8_SH, swiglu1(v1[0], v1[1]) * F8_SH, swiglu1(v1[2], v1[3]) * F8_SH); } }
    }
};
struct EpiMoe2 {
    const float* bdn;
    DI void operator()(const f32x4 (&acc)[2][2][4][2], const Unit& u, int wr, int wc, int fr, int fq) const {
        f32x4 bv[2][2];
#pragma unroll
        for (int bj = 0; bj < 2; ++bj) { const float* b = bdn + u.e * 1024 + u.c0 + bj * HALF + wc * 32 + 8 * fq; bv[bj][0] = *(const f32x4*)b; bv[bj][1] = *(const f32x4*)(b + 4); }
#pragma unroll
        for (int ai = 0; ai < 2; ++ai)
#pragma unroll
            for (int m = 0; m < 4; ++m) { char* rowp = u.c + ((size_t)(ai * HALF + wr * 64 + m * 16 + fr) * u.ldc + wc * 32 + 8 * fq) * 2;
#pragma unroll
                for (int bj = 0; bj < 2; ++bj) *(u32x4*)(rowp + bj * 256) = pack8(acc[ai][bj][m][0] * F8_INV2 + bv[bj][0], acc[ai][bj][m][1] * F8_INV2 + bv[bj][1]); }
    }
};

typedef int i32x8 __attribute__((ext_vector_type(8)));
typedef int i32x4 __attribute__((ext_vector_type(4)));
template <bool F8, bool MIDK = false, class Epi, class Sched>
DI void gemm_phase(LAS unsigned char* lds, const int KB  , const int ldaB, const int ldbB, const Sched& S, const Epi& E, const int wave_) {
    unsigned z_ = 0u; asm volatile("" : "+v"(z_)); const int tid = wave_ * 64 + (int)__builtin_amdgcn_mbcnt_hi(~0u, __builtin_amdgcn_mbcnt_lo(~0u, z_));
    const int wid = __builtin_amdgcn_readfirstlane(tid >> 6), lane = tid & 63, wr = wid >> 2, wc = wid & 3, fr = lane & 15, fq = lane >> 4;
    const int nt = KB / (BK * 2);
    unsigned voffA[2], voffB[2];
#pragma unroll
    for (int i = 0; i < 2; ++i) { int R, C; stage_rc(tid * 16 + i * 8192, R, C); const int Rb = (R & ~31) + perm32(R & 31);
        voffA[i] = (unsigned)(R * ldaB + C * 2); voffB[i] = (unsigned)(Rb * ldbB + C * 2); }
    asm volatile("" : "+v"(voffA[0]), "+v"(voffA[1]), "+v"(voffB[0]), "+v"(voffB[1]));
    const size_t kstep = (size_t)(BK * 2);
    const size_t hstepA = (size_t)HALF * ldaB, hstepB = (size_t)HALF * ldbB;
    const unsigned ldsw = (unsigned)wid * 1024u;
    const int aoff = lds_byte(wr * 64 + fr, fq * 8), boff = lds_byte(wc * 32 + fr, fq * 8);
#define PG8_SA(b, h) (((b) * 2 + (h)) * HTB)
#define PG8_SB(b, h) ((4 + (b) * 2 + (h)) * HTB)
#define PG8_STAGE(bufoff, gbase, voff) do { _Pragma("unroll") for (int _i = 0; _i < 2; ++_i) \
        __builtin_amdgcn_global_load_lds((const unsigned*)((const char*)(gbase) + (voff)[_i]), (LAS unsigned*)(lds + (bufoff) + ldsw + _i * 8192), 16, 0, 0); } while (0)
#define PG8_LD8(p) __builtin_shufflevector(*(const LAS i32x4*)(p), *(const LAS i32x4*)((p) + 1024), 0, 1, 2, 3, 4, 5, 6, 7)
#define PG8_LDA8(dst, b, h) do { _Pragma("unroll") for (int m = 0; m < 4; ++m) dst[m] = PG8_LD8(lds + PG8_SA(b, h) + aoff + m * 2048); } while (0)
#define PG8_LDB8(dst, b, h) do { _Pragma("unroll") for (int n = 0; n < 2; ++n) dst[n] = PG8_LD8(lds + PG8_SB(b, h) + boff + n * 2048); } while (0)
#define PG8_MMA8(ai, bj, A8, B8) do { __builtin_amdgcn_s_setprio(1); _Pragma("unroll") for (int m = 0; m < 4; ++m) _Pragma("unroll") for (int n = 0; n < 2; ++n) \
        asm volatile("v_mfma_f32_16x16x128_f8f6f4 %0, %1, %2, %0" : "+v"(acc[ai][bj][m][n]) : "v"(B8[n]), "v"(A8[m])); __builtin_amdgcn_s_setprio(0); } while (0)
#define PG8_LDA(dst, b, h) do { _Pragma("unroll") for (int m = 0; m < 4; ++m) _Pragma("unroll") for (int k = 0; k < 2; ++k) dst[m][k] = *(const LAS bf16x8*)(lds + PG8_SA(b, h) + aoff + m * 2048 + k * 1024); } while (0)
#define PG8_LDB(dst, b, h) do { _Pragma("unroll") for (int n = 0; n < 2; ++n) _Pragma("unroll") for (int k = 0; k < 2; ++k) dst[n][k] = *(const LAS bf16x8*)(lds + PG8_SB(b, h) + boff + n * 2048 + k * 1024); } while (0)
#define PG8_CAT(x) __builtin_shufflevector(__builtin_bit_cast(i32x4, (x)[0]), __builtin_bit_cast(i32x4, (x)[1]), 0, 1, 2, 3, 4, 5, 6, 7)
#define PG8_MMA(ai, bj, At, Bt) do { __builtin_amdgcn_s_setprio(1); _Pragma("unroll") for (int m = 0; m < 4; ++m) _Pragma("unroll") for (int n = 0; n < 2; ++n) _Pragma("unroll") for (int k = 0; k < 2; ++k) \
        acc[ai][bj][m][n] = __builtin_amdgcn_mfma_f32_16x16x32_bf16(Bt[n][k], At[m][k], acc[ai][bj][m][n], 0, 0, 0); __builtin_amdgcn_s_setprio(0); } while (0)
#define PG8_WAIT_V(n) asm volatile("s_waitcnt vmcnt(" #n ")" ::: "memory")
#define PG8_WAIT_L(n) asm volatile("s_waitcnt lgkmcnt(" #n ")" ::: "memory")
#define PG8_BAR __builtin_amdgcn_s_barrier()
#define PG8_SCHED __builtin_amdgcn_sched_barrier(0)
    Unit cur, nxt; int ui = 0;
    if (!S.next(0, cur)) return;
    f32x4 acc[2][2][4][2];
#pragma unroll
    for (int a = 0; a < 2; ++a)
#pragma unroll
        for (int b = 0; b < 2; ++b)
#pragma unroll
            for (int m = 0; m < 4; ++m)
#pragma unroll
                for (int n = 0; n < 2; ++n) acc[a][b][m][n] = (f32x4){0.f, 0.f, 0.f, 0.f};
    bf16x8 At[4][2], B0[2][2], B1[2][2]; i32x8 A8[4], B80[2], B81[2];
    const char* cA = cur.a; const char* cB = cur.b;
    PG8_STAGE(PG8_SB(0, 0), cB, voffB); PG8_STAGE(PG8_SB(0, 1), cB + hstepB, voffB); PG8_STAGE(PG8_SA(0, 0), cA, voffA); PG8_STAGE(PG8_SA(0, 1), cA + hstepA, voffA);
    if (wr == 1) PG8_BAR;
    PG8_WAIT_V(2); PG8_BAR;
    PG8_STAGE(PG8_SB(1, 0), cB + kstep, voffB); PG8_STAGE(PG8_SA(1, 0), cA + kstep, voffA); PG8_STAGE(PG8_SB(1, 1), cB + hstepB + kstep, voffB);
    PG8_WAIT_V(6); PG8_BAR;
    for (;;) {
        const bool has_next = S.next(ui + 1, nxt);
        const char* nA = has_next ? nxt.a : cA; const char* nB = has_next ? nxt.b : cB;
#pragma unroll 1
        for (int t = 0; t < nt; t += 2) {
            if constexpr (MIDK) { if (t == 8 || t == 16) { int fr_ = fr, fq_ = fq; asm volatile("" : "+v"(fr_), "+v"(fq_)); E.mid(acc, cur, t >> 4, wr, wc, fr_, fq_); } }
            const bool last = (t == nt - 2);
            const char* a1 = cA + (size_t)(t + 1) * kstep;
            const char* a2 = last ? nA : cA + (size_t)(t + 2) * kstep; const char* b2 = last ? nB : cB + (size_t)(t + 2) * kstep;
            const char* a3 = a2 + kstep; const char* b3 = b2 + kstep;
            if constexpr (F8) {
            PG8_LDB8(B80, 0, 0); PG8_LDB8(B81, 0, 1); PG8_SCHED; PG8_LDA8(A8, 0, 0); PG8_STAGE(PG8_SA(1, 1), a1 + hstepA, voffA);
            PG8_WAIT_V(8); PG8_WAIT_L(0); PG8_BAR; PG8_MMA8(0, 0, A8, B80); PG8_MMA8(0, 1, A8, B81); PG8_BAR; PG8_SCHED;
            PG8_LDA8(A8, 0, 1); PG8_STAGE(PG8_SB(0, 0), b2, voffB); PG8_STAGE(PG8_SB(0, 1), b2 + hstepB, voffB); PG8_STAGE(PG8_SA(0, 0), a2, voffA);
            PG8_WAIT_V(8); PG8_WAIT_L(0); PG8_BAR; PG8_MMA8(1, 0, A8, B80); PG8_MMA8(1, 1, A8, B81); PG8_BAR; PG8_SCHED;
            PG8_LDB8(B80, 1, 0); PG8_LDB8(B81, 1, 1); PG8_SCHED; PG8_LDA8(A8, 1, 0); PG8_STAGE(PG8_SA(0, 1), a2 + hstepA, voffA);
            PG8_WAIT_V(8); PG8_WAIT_L(0); PG8_BAR; PG8_MMA8(0, 0, A8, B80); PG8_MMA8(0, 1, A8, B81); PG8_BAR; PG8_SCHED;
            PG8_LDA8(A8, 1, 1); PG8_STAGE(PG8_SB(1, 0), b3, voffB); PG8_STAGE(PG8_SB(1, 1), b3 + hstepB, voffB); PG8_STAGE(PG8_SA(1, 0), a3, voffA);
            PG8_WAIT_V(8); PG8_WAIT_L(0); PG8_BAR; PG8_MMA8(1, 0, A8, B80); PG8_MMA8(1, 1, A8, B81); PG8_BAR; PG8_SCHED;
            } else {
            PG8_LDB(B0, 0, 0); PG8_LDB(B1, 0, 1); PG8_SCHED; PG8_LDA(At, 0, 0); PG8_STAGE(PG8_SA(1, 1), a1 + hstepA, voffA);
            PG8_WAIT_V(8); PG8_WAIT_L(0); PG8_BAR; PG8_MMA(0, 0, At, B0); PG8_MMA(0, 1, At, B1); PG8_BAR; PG8_SCHED;
            PG8_LDA(At, 0, 1); PG8_STAGE(PG8_SB(0, 0), b2, voffB); PG8_STAGE(PG8_SB(0, 1), b2 + hstepB, voffB); PG8_STAGE(PG8_SA(0, 0), a2, voffA);
            PG8_WAIT_V(8); PG8_WAIT_L(0); PG8_BAR; PG8_MMA(1, 0, At, B0); PG8_MMA(1, 1, At, B1); PG8_BAR; PG8_SCHED;
            PG8_LDB(B0, 1, 0); PG8_LDB(B1, 1, 1); PG8_SCHED; PG8_LDA(At, 1, 0); PG8_STAGE(PG8_SA(0, 1), a2 + hstepA, voffA);
            PG8_WAIT_V(8); PG8_WAIT_L(0); PG8_BAR; PG8_MMA(0, 0, At, B0); PG8_MMA(0, 1, At, B1); PG8_BAR; PG8_SCHED;
            PG8_LDA(At, 1, 1); PG8_STAGE(PG8_SB(1, 0), b3, voffB); PG8_STAGE(PG8_SB(1, 1), b3 + hstepB, voffB); PG8_STAGE(PG8_SA(1, 0), a3, voffA);
            PG8_WAIT_V(8); PG8_WAIT_L(0); PG8_BAR; PG8_MMA(1, 0, At, B0); PG8_MMA(1, 1, At, B1); PG8_BAR; PG8_SCHED;
            }
        }
        if (wr == 0) PG8_BAR;
        if constexpr (F8) asm volatile("s_nop 15\n\ts_nop 15" ::: "memory");
        { int fr_ = fr, fq_ = fq; asm volatile("" : "+v"(fr_), "+v"(fq_));
          E(acc, cur, wr, wc, fr_, fq_); }
        if (!has_next) break;
#pragma unroll
        for (int a = 0; a < 2; ++a)
#pragma unroll
            for (int b = 0; b < 2; ++b)
#pragma unroll
                for (int m = 0; m < 4; ++m)
#pragma unroll
                    for (int n = 0; n < 2; ++n) acc[a][b][m][n] = (f32x4){0.f, 0.f, 0.f, 0.f};
        cur = nxt; cA = nA; cB = nB; ++ui;
        if (wr == 1) PG8_BAR;
    }
    PG8_WAIT_V(0);
    PG8_BAR;
#undef PG8_SA
#undef PG8_SB
#undef PG8_STAGE
#undef PG8_LDA
#undef PG8_LDB
#undef PG8_MMA
#undef PG8_CAT
#undef PG8_LD8
#undef PG8_LDA8
#undef PG8_LDB8
#undef PG8_MMA8
#undef PG8_WAIT_V
#undef PG8_WAIT_L
#undef PG8_BAR
#undef PG8_SCHED
}
}

#define XB_TMO      128
#define XB_XCNT(j)  (256  + 64 * (j))
#define XB_XSUB(j)  (1280 + 64 * (j))
#define XB_XGEN(j)  (2304 + 64 * (j))
#define XB_TOP      3328
#define XB_TOPGEN   3392
#define XCD_BAR_WORDS 3456
#define XB_SPIN_CAP (1u << 22)
DI unsigned xb_ld(unsigned* p)              { return __hip_atomic_load(p, __ATOMIC_RELAXED, __HIP_MEMORY_SCOPE_AGENT); }
DI unsigned xb_add(unsigned* p, unsigned v) { return __hip_atomic_fetch_add(p, v, __ATOMIC_RELAXED, __HIP_MEMORY_SCOPE_AGENT); }
DI unsigned xb_xcc_id() { return (unsigned)__builtin_amdgcn_s_getreg((3 << 11) | 20) & 0xFu; }
#define XB_SPIN(cond, bar) do { unsigned _sp = 0; while (cond) { __builtin_amdgcn_s_sleep(1); \
    if ((++_sp & 255u) == 0u) { if (xb_ld(&(bar)[XB_TMO])) break; if (_sp > XB_SPIN_CAP) { atomicAdd(&(bar)[XB_TMO], 1u); break; } } } } while (0)
struct XcdBarrier { unsigned* bar; unsigned x; volatile LAS unsigned* st; };
DI XcdBarrier xcd_barrier_post(unsigned* bar, volatile LAS unsigned* st) {
    XcdBarrier b; b.bar = bar; b.x = xb_xcc_id(); b.st = st;
    if (threadIdx.x == 0) (void)xb_add(&bar[XB_XCNT(b.x)], 1u);
    return b;
}
DI void xcd_barrier_complete(unsigned* bar, unsigned x, unsigned& nloc, unsigned& nx) {
    const unsigned G = gridDim.x * gridDim.y * gridDim.z;
    unsigned sum, cnt, mine, sp = 0u;
    for (;;) {
        sum = 0u; cnt = 0u; mine = 0u;
#pragma unroll
        for (unsigned j = 0; j < 16; ++j) { const unsigned c = xb_ld(&bar[XB_XCNT(j)]); sum += c; cnt += (c > 0u) ? 1u : 0u; mine = (j == x) ? c : mine; }
        if (sum == G) break;
        __builtin_amdgcn_s_sleep(1);
        if ((++sp & 255u) == 0u) { if (xb_ld(&bar[XB_TMO])) break; if (sp > XB_SPIN_CAP) { atomicAdd(&bar[XB_TMO], 1u); break; } }
    }
    nloc = mine > 0u ? mine : 1u; nx = cnt > 0u ? cnt : 1u;
}
DI void xcd_barrier(const XcdBarrier& b) {
    asm volatile("s_waitcnt vmcnt(0)" ::: "memory");
    __syncthreads();
    if (threadIdx.x == 0) {
        unsigned* bar = b.bar;
        __builtin_amdgcn_s_waitcnt(0);
        unsigned nloc = b.st[0], nx = b.st[1];
        if (nloc == 0u) { xcd_barrier_complete(bar, b.x, nloc, nx); b.st[0] = nloc; b.st[1] = nx; }
        const unsigned old = xb_add(&bar[XB_XSUB(b.x)], 1u);
        const unsigned gen = old / nloc;
        if (old + 1u == (gen + 1u) * nloc) {
            __builtin_amdgcn_fence(__ATOMIC_RELEASE, "agent");
            asm volatile("s_waitcnt vmcnt(0)" ::: "memory");
            const unsigned og = xb_add(&bar[XB_TOP], 1u);
            const unsigned tg = og / nx;
            if (og + 1u == (tg + 1u) * nx) xb_add(&bar[XB_TOPGEN], 1u);
            else XB_SPIN(xb_ld(&bar[XB_TOPGEN]) == tg, bar);
            __builtin_amdgcn_fence(__ATOMIC_ACQUIRE, "agent");
            xb_add(&bar[XB_XGEN(b.x)], 1u);
            asm volatile("s_waitcnt vmcnt(0)" ::: "memory");
        } else {
            XB_SPIN(xb_ld(&bar[XB_XGEN(b.x)]) == gen, bar);
            __builtin_amdgcn_fence(__ATOMIC_ACQUIRE, "agent");
            asm volatile("s_waitcnt vmcnt(0)" ::: "memory");
        }
    }
    __syncthreads();
}

DI void transpose_item(const float* W, int ldw, bf16* WT, int ldt, LAS float* scr, int lane) {
    { const int kr = lane >> 3, c4 = (lane & 7) * 4; f32x4 v[8];
#pragma unroll
        for (int i = 0; i < 8; ++i) v[i] = *(const f32x4*)(W + (size_t)(8 * i + kr) * ldw + c4);
#pragma unroll
        for (int i = 0; i < 8; ++i) { LAS float* o = scr + (8 * i + kr) * 33 + c4; o[0] = v[i].x; o[1] = v[i].y; o[2] = v[i].z; o[3] = v[i].w; } }
    LDS_WAIT(); asm volatile("" ::: "memory");
    const int c = lane & 7;
#pragma unroll
    for (int j = 0; j < 4; ++j) { const int n = (lane >> 3) + 8 * j; const LAS float* s = scr + (8 * c) * 33 + n;
        u32x4 o; o.x = pk2(s[0 * 33], s[1 * 33]); o.y = pk2(s[2 * 33], s[3 * 33]); o.z = pk2(s[4 * 33], s[5 * 33]); o.w = pk2(s[6 * 33], s[7 * 33]);
        *(u32x4*)(WT + (size_t)n * ldt + 8 * c) = o; }
    LDS_WAIT(); asm volatile("" ::: "memory");
}
DI void transpose_item_f8(const float* W, int ldw, unsigned char* WT, int ldt, float scale, LAS float* scr, int lane) {
    { const int kr = lane >> 3, c4 = (lane & 7) * 4; f32x4 v[8];
#pragma unroll
        for (int i = 0; i < 8; ++i) v[i] = *(const f32x4*)(W + (size_t)(8 * i + kr) * ldw + c4);
#pragma unroll
        for (int i = 0; i < 8; ++i) { LAS float* o = scr + (8 * i + kr) * 33 + c4; o[0] = v[i].x; o[1] = v[i].y; o[2] = v[i].z; o[3] = v[i].w; } }
    LDS_WAIT(); asm volatile("" ::: "memory");
    const int c = lane & 3;
#pragma unroll
    for (int j = 0; j < 2; ++j) { const int n = (lane >> 2) + 16 * j; const LAS float* s = scr + (16 * c) * 33 + n;
        u32x4 o; o.x = pk4_f8(s[0 * 33] * scale, s[1 * 33] * scale, s[2 * 33] * scale, s[3 * 33] * scale); o.y = pk4_f8(s[4 * 33] * scale, s[5 * 33] * scale, s[6 * 33] * scale, s[7 * 33] * scale);
        o.z = pk4_f8(s[8 * 33] * scale, s[9 * 33] * scale, s[10 * 33] * scale, s[11 * 33] * scale); o.w = pk4_f8(s[12 * 33] * scale, s[13 * 33] * scale, s[14 * 33] * scale, s[15 * 33] * scale);
        *(u32x4*)(WT + (size_t)n * ldt + 16 * c) = o; }
    LDS_WAIT(); asm volatile("" ::: "memory");
}
DI void ln16(f32x4 (&v)[4], const f32x4 (&g)[4], const f32x4 (&b)[4]) {
    float s = 0.f;
#pragma unroll
    for (int j = 0; j < 4; ++j) s += (v[j].x + v[j].y) + (v[j].z + v[j].w);
    const float mean = wave_sum(s) * (1.f / D); float s2 = 0.f;
#pragma unroll
    for (int j = 0; j < 4; ++j) { v[j] = v[j] - mean; s2 += (v[j].x * v[j].x + v[j].y * v[j].y) + (v[j].z * v[j].z + v[j].w * v[j].w); }
    const float rstd = 1.f / sqrtf(wave_sum(s2) * (1.f / D) + LN_EPS);
#pragma unroll
    for (int j = 0; j < 4; ++j) v[j] = v[j] * rstd * g[j] + b[j];
}
DI void gates8(const f32x4 (&y)[4], const LAS float* wgt, float* gif_row, int lane) {
    float p[8];
#pragma unroll
    for (int j = 0; j < 8; ++j) { float s = 0.f;
#pragma unroll
        for (int jj = 0; jj < 4; ++jj) { const f32x4 w = *(const LAS f32x4*)(wgt + j * 1024 + 256 * jj + 4 * lane); s += (y[jj].x * w.x + y[jj].y * w.y) + (y[jj].z * w.z + y[jj].w * w.w); }
        p[j] = wave_sum(s); }
    if (lane == 0) { *(f32x4*)gif_row = (f32x4){p[0], p[1], p[2], p[3]}; *(f32x4*)(gif_row + 4) = (f32x4){p[4], p[5], p[6], p[7]}; }
}
DI void gates8b(const f32x4 (&y)[4], const LAS float* wgt, float* gif_row, int lane) {
    float p[8];
#pragma unroll
    for (int j = 0; j < 8; ++j) { float s = 0.f;
#pragma unroll
        for (int jj = 0; jj < 4; ++jj) { const f32x4 w = *(const LAS f32x4*)(wgt + j * 1024 + (jj >> 1) * 512 + 8 * lane + (jj & 1) * 4); s += (y[jj].x * w.x + y[jj].y * w.y) + (y[jj].z * w.z + y[jj].w * w.w); }
        p[j] = wave_sum(s); }
    if (lane == 0) { *(f32x4*)gif_row = (f32x4){p[0], p[1], p[2], p[3]}; *(f32x4*)(gif_row + 4) = (f32x4){p[4], p[5], p[6], p[7]}; }
}
DI void load_gate_table(LAS float* wgt, const float* win_l, int tid) {
    for (int i = tid; i < 8192; i += NTHR) { const int k = i >> 3, j = i & 7; wgt[j * 1024 + k] = win_l[(size_t)k * DIN + 1536 + j]; }
}
DI f32x4 ld4bf(const char* p) { const u32x2 w = *(const u32x2*)p; return (f32x4){bflo(w.x), bfhi(w.x), bflo(w.y), bfhi(w.y)}; }
DI void st4bf(char* p, const f32x4& v) { u32x2 w; w.x = pk2(v.x, v.y); w.y = pk2(v.z, v.w); *(u32x2*)p = w; }

struct Args { const float* in[N_IN]; float* out; unsigned char* ws; int ph_lo, ph_hi; };
constexpr int NP_LAYER = 12, NPH = 1 + DEPTH * NP_LAYER;
constexpr int XW_SPLIT = 49152;

struct SchedInproj {
    pg8::TileOrder T; int G, c; const char *X, *W; char* U; bool kv; const char *MEMN, *WKV; char* KV;
    DI bool next(int i, pg8::Unit& u) const {
        const long L = (long)i * G + c; int pm, pn;
        if (T.tile(L, pm, pn)) { u.a = X + (size_t)pm * 256 * D * 2; u.b = W + (size_t)pn * 256 * D * 2; u.r0 = pm * 256; u.c0 = pn * 256; u.c = U + ((size_t)u.r0 * NU + u.c0) * 2; u.ldc = NU; u.e = 0; u.sub = 0; return true; }
        if (!kv) return false;
        const long L2 = L - T.nwg; if (L2 < 0 || L2 >= 128) return false;
        const int l = (int)L2 >> 6, t = (int)L2 & 63; pm = t >> 2; pn = t & 3;
        u.a = MEMN + (size_t)pm * 256 * D * 2; u.b = WKV + ((size_t)l * 1024 + pn * 256) * D * 2; u.r0 = pm * 256; u.c0 = pn * 256; u.c = KV + (((size_t)l * MROWS + u.r0) * D + u.c0) * 2; u.ldc = D; u.e = 0; u.sub = 0; return true;
    }
};
struct SchedPlain {
    pg8::TileOrder T; int G, c; const char *A, *B; char* C; int lda, ldb, ldc;
    DI bool next(int i, pg8::Unit& u) const {
        const long L = (long)i * G + c; int pm, pn; if (!T.tile(L, pm, pn)) return false;
        u.a = A + (size_t)pm * 256 * lda * 2; u.b = B + (size_t)pn * 256 * ldb * 2; u.r0 = pm * 256; u.c0 = pn * 256; u.c = C + ((size_t)u.r0 * ldc + u.c0) * 2; u.ldc = ldc; u.e = 0; u.sub = 0; return true;
    }
};
struct SchedMerge {
    pg8::TileOrder T; int G, c; const char *H, *W; char* Y;
    DI bool next(int i, pg8::Unit& u) const {
        const int ti = i / 3, br = i - 3 * ti; const long L = (long)ti * G + c; int pm, pn; if (!T.tile(L, pm, pn)) return false;
        u.a = H + ((size_t)pm * 256 * 1536 + br * 512) * 2; u.b = W + ((size_t)br * 1024 + pn * 256) * 512 * 2; u.r0 = pm * 256; u.c0 = pn * 256; u.c = Y + ((size_t)u.r0 * D + u.c0) * 2; u.ldc = D; u.e = 0; u.sub = br; return true;
    }
};
struct SchedMoe {
    pg8::TileOrder T; int G, c; const char *A, *W; char* C; const LAS int* PB; int wrows  , ldc, cdiv, osz;
    DI bool next(int i, pg8::Unit& u) const {
        const long L = (long)i * G + c; int pm, pn; if (!T.tile(L, pm, pn)) return false;
        int e = 0;
#pragma unroll 1
        for (int j = 1; j < NEXP; ++j) e += (PB[j] <= pm) ? 1 : 0;
        u.a = A + (size_t)pm * 256 * 1024; u.b = W + ((size_t)e * wrows + pn * 256) * 1024; u.r0 = pm * 256; u.c0 = pn * 256; u.c = C + ((size_t)u.r0 * ldc + u.c0 / cdiv) * osz; u.ldc = ldc; u.e = e; u.sub = 0; return true;
    }
};

__global__ void __launch_bounds__(NTHR, 2) fwd_kernel(Args args) {
    extern __shared__ __attribute__((aligned(16))) unsigned char lds_raw[];
#define INP(i) ([&]() -> const float* { int ii_ = (i); asm volatile("" : "+s"(ii_)); return args.in[ii_]; }())
    LAS unsigned char* lds = (LAS unsigned char*)lds_raw;
    volatile LAS unsigned* LCTL = (volatile LAS unsigned*)(lds + LDSCTL_OFF);
    const int tid0 = threadIdx.x, wave = __builtin_amdgcn_readfirstlane(tid0 >> 6);
#define PHASE_TID unsigned z_ = 0u; asm volatile("" : "+v"(z_)); int tid = wave * 64 + (int)__builtin_amdgcn_mbcnt_hi(~0u, __builtin_amdgcn_mbcnt_lo(~0u, z_)); const int lane = tid & 63; (void)lane;
    const int G = gridDim.x, bx = blockIdx.x;
    const int gw = bx * NWAVES + wave, NGW = G * NWAVES;
    unsigned char* ws = args.ws;
    gu32* ctl = (gu32*)(ws + WS_CTL);
    for (int u = tid0; u < (LDS_BYTES - LDSCTL_OFF) / 4; u += NTHR) ((LAS unsigned*)(lds + LDSCTL_OFF))[u] = 0u;
    __syncthreads();
    XcdBarrier bar; bar.bar = (unsigned*)ctl + CW_BAR; bar.x = 0; bar.st = nullptr;
    if (MK_ONE_LAUNCH) bar = xcd_barrier_post((unsigned*)ctl + CW_BAR, LCTL);
    const int lo = args.ph_lo, hi = args.ph_hi;
#ifndef SUBMASK
#define SUBMASK 7
#endif
#ifndef LN2PROBE
#define LN2PROBE 0
#endif
#ifndef SUBDUP
#define SUBDUP 0
#endif
#define NSUB(k) ((((SUBDUP) >> (k)) & 1) ? 2 : 1)
#ifndef DUPMASK
#define DUPMASK 0
#endif
#define NREP(k) ((((DUPMASK) >> (k)) & 1) ? 2 : 1)
#ifndef PHMASK
#define PHMASK 0xFFFF
#endif
#define IN(k) (lo <= (k) && (k) < hi)
#define SEAM(k) do { if (IN(k) && IN((k) + 1)) xcd_barrier(bar); } while (0)

    char* const Xb = (char*)(ws + WS_X);
    char* const Ub = (char*)(ws + WS_R1);
    float* const GIF = (float*)(ws + WS_GIF);
    LAS int* const PB = (LAS int*)(lds + LDSCTL_OFF + 64);
    LAS int* const CNT = (LAS int*)(lds + LDSCTL_OFF + 256);

    _Pragma("unroll 1") for (int rep_ = 0; rep_ < NREP(12); ++rep_) if (((PHMASK>>12)&1) && IN(0)) { PHASE_TID
        LAS float* scr = (LAS float*)(lds + wave * 8448);
        LAS float* wgt = (LAS float*)(lds + 73728);
        load_gate_table(wgt, INP(I_WIN), tid);
        constexpr int IT_IN = 16 * 216, IT_KV = 16 * 32, IT_BR = 8 * 32, IT_O = 16 * 32, IT_L = IT_IN + IT_KV + 3 * IT_BR + IT_O;
        for (int it = gw; it < DEPTH * IT_L; it += NGW) {
            const int l = it / IT_L; int r = it - l * IT_L;
            if (r < IT_IN) { const int kb = r / 216, nb = r % 216, n0 = 32 * nb, sc = ucol_src(n0);
                if (n0 < UC_F8) transpose_item(INP(I_WIN) + ((size_t)l * D + 64 * kb) * DIN + sc, DIN, (bf16*)(ws + WS_WIN) + ((size_t)l * NU + n0) * D + 64 * kb, D, scr, lane);
                else transpose_item_f8(INP(I_WIN) + ((size_t)l * D + 64 * kb) * DIN + sc, DIN, (unsigned char*)(ws + WS_WING8) + ((size_t)l * NF8 + (n0 - UC_F8)) * D + 64 * kb, D, F8_SWGU, scr, lane);
                continue; }
            r -= IT_IN;
            if (r < IT_KV) { const int kb = r / 32, nb = r % 32;
                transpose_item(INP(I_CAWKV) + ((size_t)l * D + 64 * kb) * 1024 + 32 * nb, 1024, (bf16*)(ws + WS_WKV) + ((size_t)l * 1024 + 32 * nb) * D + 64 * kb, D, scr, lane); continue; }
            r -= IT_KV;
            if (r < 3 * IT_BR) { const int br = r / IT_BR, q = r % IT_BR, kb = q / 32, nb = q % 32;
                const float* src = INP(br == 0 ? I_WBRML : (br == 1 ? I_WBRRW : I_WBRCA));
                transpose_item(src + ((size_t)l * 512 + 64 * kb) * 1024 + 32 * nb, 1024, (bf16*)(ws + WS_WBR) + ((size_t)l * 1024 + 32 * nb) * 1536 + br * 512 + 64 * kb, 1536, scr, lane); continue; }
            r -= 3 * IT_BR;
            { const int kb = r / 32, nb = r % 32;
                transpose_item(INP(I_WO) + ((size_t)l * D + 64 * kb) * 1024 + 32 * nb, 1024, (bf16*)(ws + WS_WO) + ((size_t)l * 1024 + 32 * nb) * D + 64 * kb, D, scr, lane); }
        }
        for (int i = bx * NTHR + tid; i < DEPTH * 1536 * 256; i += G * NTHR) {
            const int l = i / (1536 * 256), r = i % (1536 * 256), n = r >> 8, k = r & 255; float v = 0.f;
            if (n < 512) { if (k < 64) v = INP(I_RWWUP)[((size_t)l * 64 + k) * 512 + n]; }
            else if (n < 1024) { if (k >= 64 && k < 128) v = INP(I_RWAUP)[((size_t)l * 64 + (k - 64)) * 512 + (n - 512)]; }
            else { if (k >= 128) v = INP(I_RWGUP)[((size_t)l * 128 + (k - 128)) * 512 + (n - 1024)]; }
            ((bf16*)(ws + WS_WLORA))[i] = (bf16)f2bf(v);
        }
        __syncthreads();
        {
            f32x4 g[4], b[4];
#pragma unroll
            for (int j = 0; j < 4; ++j) { g[j] = *(const f32x4*)(INP(I_LNIN_G) + 256 * j + 4 * lane); b[j] = *(const f32x4*)(INP(I_LNIN_B) + 256 * j + 4 * lane); }
            for (int m = gw; m < M; m += NGW) {
                f32x4 v[4]; const float* xr = INP(I_X) + (size_t)m * D;
#pragma unroll
                for (int j = 0; j < 4; ++j) v[j] = *(const f32x4*)(xr + 256 * j + 4 * lane);
                ln16(v, g, b);
#pragma unroll
                for (int j = 0; j < 4; ++j) { st4bf(Xb + ((size_t)m * D + 256 * j + 4 * lane) * 2, v[j]); *(unsigned*)((char*)(ws + WS_XF8) + (size_t)m * D + 256 * j + 4 * lane) = pk4_f8(v[j].x * F8_SX, v[j].y * F8_SX, v[j].z * F8_SX, v[j].w * F8_SX); }
                gates8(v, wgt, GIF + (size_t)m * 8, lane);
            }
#pragma unroll
            for (int j = 0; j < 4; ++j) { g[j] = *(const f32x4*)(INP(I_MEMLN_G) + 256 * j + 4 * lane); b[j] = *(const f32x4*)(INP(I_MEMLN_B) + 256 * j + 4 * lane); }
            for (int m = gw; m < MROWS; m += NGW) {
                f32x4 v[4]; const float* xr = INP(I_MEM) + (size_t)m * D;
#pragma unroll
                for (int j = 0; j < 4; ++j) v[j] = *(const f32x4*)(xr + 256 * j + 4 * lane);
                ln16(v, g, b);
#pragma unroll
                for (int j = 0; j < 4; ++j) st4bf((char*)(ws + WS_MEMN) + ((size_t)m * D + 256 * j + 4 * lane) * 2, v[j]);
            }
        }
        __syncthreads();
    }
    SEAM(0);

#pragma unroll 1
    for (int l = 0; l < DEPTH; ++l) {
        const int pb = 1 + l * NP_LAYER;
        _Pragma("unroll 1") for (int rep_ = 0; rep_ < NREP(0); ++rep_) if (((PHMASK>>0)&1) && IN(pb + 0)) {
            SchedInproj S; S.T.init(M / 256, UC_F8 / 256); S.G = G; S.c = bx; S.X = Xb; S.W = (const char*)(ws + WS_WIN) + (size_t)l * NU * D * 2; S.U = Ub;
            S.kv = (l == 0); S.MEMN = (const char*)(ws + WS_MEMN); S.WKV = (const char*)(ws + WS_WKV); S.KV = (char*)(ws + WS_KV);
            pg8::EpiStore E;
            pg8::gemm_phase<false>(lds, D * 2, D * 2, D * 2, S, E, wave);
            SchedPlain S8; S8.T.init(M / 256, NF8 / 256); S8.G = G; S8.c = bx; S8.A = (const char*)(ws + WS_XF8); S8.B = (const char*)(ws + WS_WING8) + (size_t)l * NF8 * D; S8.C = Ub + UC_F8 * 2;
            S8.lda = 512; S8.ldb = 512; S8.ldc = NU;
            pg8::EpiStoreS E8; E8.s = F8_INV1; E8.gate_b = INP(I_GATEB) + (size_t)l * 3072; E8.gate_c0 = UC_GATE - UC_F8;
            pg8::gemm_phase<true>(lds, D, D, D, S8, E8, wave);
        }
        SEAM(pb + 0);
        _Pragma("unroll 1") for (int rep_ = 0; rep_ < NREP(1); ++rep_) if (((PHMASK>>1)&1) && IN(pb + 1)) { PHASE_TID
            const float* mu = INP(I_RWMU) + (size_t)l * 1792 + 1536;
            char* LIN = (char*)(ws + WS_R2 + R2_LORA_IN);
            for (int it = bx * NTHR + tid; it < M * 32; it += G * NTHR) {
                const int row = it >> 5, c = (it & 31) * 8;
                const u32x4 cw = *(const u32x4*)(Ub + ((size_t)row * NU + UC_RW + 1536 + c) * 2);
                u32x4 pw = (u32x4){0u, 0u, 0u, 0u};
                if ((row & (SEQ - 1)) != 0) pw = *(const u32x4*)(Ub + ((size_t)(row - 1) * NU + UC_RW + 1536 + c) * 2);
                const f32x4 m0 = *(const f32x4*)(mu + c), m1 = *(const f32x4*)(mu + c + 4);
                float x[8] = {bflo(cw.x), bfhi(cw.x), bflo(cw.y), bfhi(cw.y), bflo(cw.z), bfhi(cw.z), bflo(cw.w), bfhi(cw.w)};
                const float p[8] = {bflo(pw.x), bfhi(pw.x), bflo(pw.y), bfhi(pw.y), bflo(pw.z), bfhi(pw.z), bflo(pw.w), bfhi(pw.w)};
                const float mm[8] = {m0.x, m0.y, m0.z, m0.w, m1.x, m1.y, m1.z, m1.w};
#pragma unroll
                for (int i = 0; i < 8; ++i) { float xs = x[i] + (p[i] - x[i]) * mm[i];
                    if (c < 64) xs = 1.f - 2.f * __builtin_amdgcn_rcpf(1.f + __builtin_amdgcn_exp2f(2.8853900817779268f * xs));
                    else if (c >= 128) xs = sigmoidf_(xs);
                    x[i] = xs; }
                u32x4 o; o.x = pk2(x[0], x[1]); o.y = pk2(x[2], x[3]); o.z = pk2(x[4], x[5]); o.w = pk2(x[6], x[7]);
                *(u32x4*)(LIN + ((size_t)row * 256 + c) * 2) = o;
            }
        }
        SEAM(pb + 1);
        _Pragma("unroll 1") for (int rep_ = 0; rep_ < NREP(2); ++rep_) if (((PHMASK>>2)&1) && IN(pb + 2)) {
            SchedPlain S; S.T.init(M / 256, 6); S.G = G; S.c = bx; S.A = (const char*)(ws + WS_R2 + R2_LORA_IN); S.B = (const char*)(ws + WS_WLORA) + (size_t)l * 1536 * 256 * 2; S.C = (char*)(ws + WS_R2 + R2_LORA_OUT);
            S.lda = 256; S.ldb = 256; S.ldc = 1536;
            pg8::EpiStore E;
            pg8::gemm_phase<false>(lds, 512, 512, 512, S, E, wave);
        }
        SEAM(pb + 2);
        _Pragma("unroll 1") for (int rep_ = 0; rep_ < NREP(3); ++rep_) if (((PHMASK>>3)&1) && IN(pb + 3)) { PHASE_TID
            const char* LO = (const char*)(ws + WS_R2 + R2_LORA_OUT);
            char* HC = (char*)(ws + WS_R2 + R2_HCAT);
            const int tid_ph = tid;
#define SUB_TID unsigned zs_ = 0u; asm volatile("" : "+v"(zs_)); int tid = wave * 64 + (int)__builtin_amdgcn_mbcnt_hi(~0u, __builtin_amdgcn_mbcnt_lo(~0u, zs_)); const int lane = tid & 63; (void)lane;
#pragma unroll 1
            for (int job = bx; job < 256; job += G) {
                if (job < 128) { _Pragma("unroll 1") for (int sr_ = 0; sr_ < NSUB(0); ++sr_) if ((SUBMASK>>0)&1) {
                    SUB_TID
                    const int b = job >> 3, h = job & 7;
                    constexpr int TC = 32, PT = 144, P16 = 48, IMG = 25856;
                    LAS float* OPS = (LAS float*)lds;
                    LAS float* OUTB = OPS + TC * 384;
                    LAS float* BON = OUTB + TC * 64;
                    LAS unsigned char* IM0 = lds + 57600;
                    LAS float* VEP = (LAS float*)(lds + 109312);
                    LAS unsigned char* GKB = (LAS unsigned char*)(VEP + 2 * TC * 64);
                    LAS float* PARF = (LAS float*)(lds + 142080);
                    const int pt = tid >> 4, cs = tid & 15, pc = cs * 4, hc = h * 64 + pc;
                    const int p1t = (tid >> 3) & 31, c8 = (tid & 7) * 8, hc8 = h * 64 + c8;
                    const int r31 = lane & 31, h2 = lane >> 5;
                    f32x16 Sreg[2];
#pragma unroll
                    for (int i = 0; i < 16; ++i) { Sreg[0][i] = 0.f; Sreg[1][i] = 0.f; }
#pragma unroll 1
                    for (int a = wave; a < 10; a += 8) {
                        const int ii = (a < 3) ? I_RWMU : (a == 3) ? I_RWW0 : (a == 4) ? I_RWA0 : (a == 5) ? I_RWKK : (a == 6) ? I_RWKA : (a == 7) ? I_RWRK : (a == 8) ? I_RWLNG : I_RWLNB;
                        const size_t po = (a < 3) ? ((size_t)l * 1792 + a * 512) : (size_t)l * 512;
                        PARF[a * 64 + lane] = (INP(ii) + po)[h * 64 + lane];
                    }
#define SETPU(j, q_) do { const u32x4 q__ = (q_); Sreg[(j) >> 2][((j) & 3) * 4] = u2f_(q__.x); Sreg[(j) >> 2][((j) & 3) * 4 + 1] = u2f_(q__.y); \
                          Sreg[(j) >> 2][((j) & 3) * 4 + 2] = u2f_(q__.z); Sreg[(j) >> 2][((j) & 3) * 4 + 3] = u2f_(q__.w); } while (0)
#define PUW(j, c) f2u_(Pc[(j) >> 2][((j) & 3) * 4 + (c)])
#define PUWS(j, c) f2u_(Sreg[(j) >> 2][((j) & 3) * 4 + (c)])
#define UNPJ(j, hh) ((f32x4){bflo(PUW(j, 2 * (hh))), bfhi(PUW(j, 2 * (hh))), bflo(PUW(j, 2 * (hh) + 1)), bfhi(PUW(j, 2 * (hh) + 1))})
#define UNPH(q_, hh) ((hh) ? (f32x4){bflo((q_).z), bfhi((q_).z), bflo((q_).w), bfhi((q_).w)} : (f32x4){bflo((q_).x), bfhi((q_).x), bflo((q_).y), bfhi((q_).y)})
                    auto LOADC = [&](int t0) {
                        const int t = t0 + p1t; const size_t row = (size_t)b * SEQ + t; const char* up = Ub + (row * NU + UC_RW + hc8) * 2;
                        SETPU(0, *(const u32x4*)up); SETPU(1, *(const u32x4*)(up + 1024)); SETPU(2, *(const u32x4*)(up + 2048));
                        if (t > 0) { const char* pp = up - (size_t)NU * 2; SETPU(3, *(const u32x4*)pp); SETPU(4, *(const u32x4*)(pp + 1024)); SETPU(5, *(const u32x4*)(pp + 2048)); }
                        else { const u32x4 z4 = (u32x4){0u, 0u, 0u, 0u}; SETPU(3, z4); SETPU(4, z4); SETPU(5, z4); }
                        const char* lp = LO + (row * 1536 + hc8) * 2; SETPU(6, *(const u32x4*)lp); SETPU(7, *(const u32x4*)(lp + 1024));
                    };
                    const int gq = tid - 128, gt = (gq >> 2) & 31, gp = (gq & 3) * 16;
                    auto LOADG = [&](int t0) {
                        const char* gp_ = LO + (((size_t)b * SEQ + t0 + gt) * 1536 + 1024 + h * 64 + gp) * 2;
                        SETPU(0, *(const u32x4*)gp_); SETPU(1, *(const u32x4*)(gp_ + 16));
                    };
                    auto PASS1 = [&](int t1, int par1, bool more) {
                        int hcv = hc8; asm volatile("" : "+v"(hcv));
                        const f32x16 Pc[2] = {Sreg[0], Sreg[1]};
                        if (more) LOADC(t1 + TC);
                        const LAS float* MU = PARF + c8;
                        const LAS float* W0 = PARF + 192 + c8; const LAS float* A0 = PARF + 256 + c8; const LAS float* KKW = PARF + 320 + c8;
                        const LAS float* KAW = PARF + 384 + c8; const LAS float* RKW = PARF + 448 + c8;
                        f32x4 dec[2], av[2], kkv[2], kp[2], xr[2], xv[2]; float ss = 0.f, bsum = 0.f;
#pragma unroll
                        for (int hh = 0; hh < 2; ++hh) {
                            const f32x4 mu_r = *(const LAS f32x4*)(MU + 4 * hh), mu_k = *(const LAS f32x4*)(MU + 64 + 4 * hh), mu_v = *(const LAS f32x4*)(MU + 128 + 4 * hh);
                            const f32x4 w0 = *(const LAS f32x4*)(W0 + 4 * hh), a0 = *(const LAS f32x4*)(A0 + 4 * hh), kkw = *(const LAS f32x4*)(KKW + 4 * hh), kaw = *(const LAS f32x4*)(KAW + 4 * hh), rkw = *(const LAS f32x4*)(RKW + 4 * hh);
                            const f32x4 ur = UNPJ(0, hh), uk = UNPJ(1, hh), uv = UNPJ(2, hh), urp = UNPJ(3, hh), ukp = UNPJ(4, hh), uvp = UNPJ(5, hh), lw = UNPJ(6, hh), la = UNPJ(7, hh);
                            xr[hh] = ur + (urp - ur) * mu_r; const f32x4 xk = uk + (ukp - uk) * mu_k; xv[hh] = uv + (uvp - uv) * mu_v;
#pragma unroll
                            for (int i = 0; i < 4; ++i) {
                                const float y = -(w0[i] + lw[i]);
                                const float sp = fmaxf(y, 0.f) + __logf(1.f + __expf(-fabsf(y)));
                                dec[hh][i] = __expf(-__expf(-sp - 0.5f));
                                av[hh][i] = sigmoidf_(a0[i] + la[i]);
                                kkv[hh][i] = xk[i] * kkw[i]; ss += kkv[hh][i] * kkv[hh][i];
                                kp[hh][i] = xk[i] * (1.f + (av[hh][i] - 1.f) * kaw[i]);
                                bsum += xr[hh][i] * kp[hh][i] * rkw[i];
                            }
                            __builtin_amdgcn_sched_barrier(0);
                        }
                        ss = red8(ss); bsum = red8(bsum);
                        const float inv = __builtin_amdgcn_rsqf(fmaxf(ss, 1e-24f));
#pragma unroll
                        for (int hh = 0; hh < 2; ++hh) {
                            const f32x4 kk = kkv[hh] * inv, kka = kk * av[hh];
                            LAS float* o = OPS + p1t * 384 + c8 + 4 * hh;
                            *(LAS f32x4*)(o) = dec[hh]; *(LAS f32x4*)(o + 64) = kk; *(LAS f32x4*)(o + 128) = kka; *(LAS f32x4*)(o + 192) = kp[hh]; *(LAS f32x4*)(o + 256) = xr[hh]; *(LAS f32x4*)(o + 320) = xv[hh];
                            *(LAS f32x4*)(VEP + par1 * 2048 + p1t * 64 + c8 + 4 * hh) = xv[hh];
                        }
                        if ((tid & 7) == 0) BON[par1 * 32 + p1t] = bsum;
                    };
#define UNP4(w) ((f32x4){bflo((w).x), bfhi((w).x), bflo((w).y), bfhi((w).y)})
#define DOT4(a, b) (((a).x * (b).x + (a).y * (b).y) + ((a).z * (b).z + (a).w * (b).w))
#define PACK8(x, s) __builtin_bit_cast(bf16x8, (u32x4){pk2((x)[8 * (s)], (x)[8 * (s) + 1]), pk2((x)[8 * (s) + 2], (x)[8 * (s) + 3]), pk2((x)[8 * (s) + 4], (x)[8 * (s) + 5]), pk2((x)[8 * (s) + 6], (x)[8 * (s) + 7])})
#define LD2x64(p) __builtin_bit_cast(bf16x8, (u32x4){(*(const LAS u32x2*)(p)).x, (*(const LAS u32x2*)(p)).y, (*(const LAS u32x2*)((p) + 16)).x, (*(const LAS u32x2*)((p) + 16)).y})
                    auto EPI = [&](int te, int pe) {
                        const int et = ((wave >> 2) * 2 + (wave & 1)) * 64 + lane, pce = (et & 15) * 4;
                        const f32x4 lng = *(const LAS f32x4*)(PARF + 512 + pce), lnb = *(const LAS f32x4*)(PARF + 576 + pce);
#pragma unroll
                        for (int it = 0; it < 2; ++it) {
                            const int pte = (et >> 4) + 16 * it;
                            const u32x2 gkw = *(const LAS u32x2*)(GKB + pe * 4096 + pte * 128 + pce * 2);
                            const f32x4 o4 = *(const LAS f32x4*)(OUTB + pte * 64 + pce), v4 = *(const LAS f32x4*)(VEP + pe * 2048 + pte * 64 + pce), gk = UNP4(gkw);
                            const float mean = red16((o4.x + o4.y) + (o4.z + o4.w)) * (1.f / 64.f);
                            const f32x4 dv = o4 - mean;
                            const float var = red16(DOT4(dv, dv)) * (1.f / 64.f);
                            const float rstd = __builtin_amdgcn_rsqf(var + RW_GN_EPS), bo = BON[pe * 32 + pte];
                            const f32x4 y = (dv * rstd * lng + lnb + v4 * bo) * gk;
                            st4bf(HC + (((size_t)b * SEQ + te + pte) * 1536 + 512 + h * 64 + pce) * 2, y);
                        }
                    };
                    if (wave >= 4) LOADC(0); else if (wave >= 2) LOADG(0);
#pragma unroll 1
                    for (int t0 = -TC; t0 < SEQ; t0 += TC) {
                        const int par = (t0 >> 5) & 1;
                        __syncthreads();
                        if (t0 >= 0)
                        {
                            const int sc = wave >> 2, wq = wave & 3;
                            LAS unsigned char* im = IM0 + sc * IMG;
                            LAS unsigned char* KR = im; LAS unsigned char* BGr = im + 4608; LAS unsigned char* VT = im + 15360;
                            LAS unsigned char* TT = im + 18432; LAS unsigned char* BB = im + 19968; LAS float* ZF = (LAS float*)(im + 21504); LAS float* PL = (LAS float*)(im + 25600);
                            {
                                float P = 1.f;
#pragma unroll 1
                                for (int t = 0; t < 4 * wq; ++t) P *= OPS[(16 * sc + t) * 384 + lane];
#pragma unroll
                                for (int q = 0; q < 4; ++q) { const int t = 4 * wq + q; const LAS float* o = OPS + (16 * sc + t) * 384 + lane;
                                    const float w = o[0], z = o[64], bb = o[128], kp = o[192], rr = o[256], vv = o[320];
                                    const float kap = z * P; P *= w; const float rho = rr * P, ip = __builtin_amdgcn_rcpf(P), bet = bb * ip, gam = kp * ip;
                                    *(LAS bf16*)(KR + t * PT + lane * 2) = (bf16)f2bf(kap); *(LAS bf16*)(KR + (16 + t) * PT + lane * 2) = (bf16)f2bf(rho);
                                    *(LAS bf16*)(BGr + t * PT + lane * 2) = (bf16)f2bf(bet); *(LAS bf16*)(BGr + (16 + t) * PT + lane * 2) = (bf16)f2bf(gam);
                                    *(LAS bf16*)(VT + t * PT + lane * 2) = (bf16)f2bf(vv); }
                                if (wq == 3) PL[lane] = P;
                            }
                            __syncthreads();
                            if (wq == 0) {
                                f32x16 Z;
#pragma unroll
                                for (int i = 0; i < 16; ++i) Z[i] = 0.f;
#pragma unroll
                                for (int ks = 0; ks < 4; ++ks) Z = __builtin_amdgcn_mfma_f32_32x32x16_bf16(*(const LAS bf16x8*)(KR + r31 * PT + (16 * ks + 8 * h2) * 2), *(const LAS bf16x8*)(BGr + r31 * PT + (16 * ks + 8 * h2) * 2), Z, 0, 0, 0);
                                const int cp = r31, jj = (r31 & 15) - 4 * h2;
#pragma unroll
                                for (int i = 0; i < 16; ++i) { const int tb = (i & 3) + 8 * ((i >> 2) & 1); const bool keep = (i >= 8) ? (jj <= tb) : (jj < tb);
                                    ZF[((i & 3) + 8 * (i >> 2) + 4 * h2) * 32 + cp] = keep ? Z[i] : 0.f; }
                            } else if (wq >= 2 && t0 >= TC) EPI(t0 - TC, par ^ 1);
                            __syncthreads();
                            if (wq == 0) {
                                const int c = lane & 15, g = lane >> 4; float x[16];
                                f32x4 R[16][4];
                                constexpr int TW = 5;
#pragma unroll
                                for (int t = 1; t <= TW; ++t)
#pragma unroll
                                    for (int k = 0; k < 4; ++k) if (4 * k < t) R[t][k] = *(const LAS f32x4*)(ZF + t * 32 + 4 * k);
                                __builtin_amdgcn_sched_barrier(0);
#pragma unroll
                                for (int t = 0; t < 16; ++t) {
                                    if (t >= 1 && t + TW < 16) {
#pragma unroll
                                        for (int k = 0; k < 4; ++k) if (4 * k < t + TW) R[t + TW][k] = *(const LAS f32x4*)(ZF + (t + TW) * 32 + 4 * k);
                                    }
                                    __builtin_amdgcn_sched_barrier(0);
                                    float s0 = 0.f, s1 = 0.f;
#pragma unroll
                                    for (int j = 0; j < t; ++j) { const float a = R[t][j >> 2][j & 3]; if (j & 1) s1 += a * x[j]; else s0 += a * x[j]; }
                                    x[t] = ((t == c) ? 1.f : 0.f) - (s0 + s1);
                                }
#pragma unroll
                                for (int j = 0; j < 16; ++j) *(LAS bf16*)(TT + j * P16 + c * 2) = (bf16)f2bf(-x[j]);
#pragma unroll
                                for (int qq = 0; qq < 4; qq += 2) {
                                    f32x4 a4[2][4];
#pragma unroll
                                    for (int q = 0; q < 2; ++q)
#pragma unroll
                                        for (int k = 0; k < 4; ++k) a4[q][k] = *(const LAS f32x4*)(ZF + (16 + 4 * g + qq + q) * 32 + 4 * k);
#pragma unroll
                                    for (int q = 0; q < 2; ++q) {
                                        const int tr = 4 * g + qq + q;
                                        float s0 = 0.f, s1 = 0.f;
#pragma unroll
                                        for (int j = 0; j < 16; ++j) { const float a = a4[q][j >> 2][j & 3]; if (j & 1) s1 += a * x[j]; else s0 += a * x[j]; }
                                        *(LAS bf16*)(TT + (16 + tr) * P16 + c * 2) = (bf16)f2bf(-(s0 + s1));
                                    }
                                }
                            } else if (wq == 1) {
                                const int row = lane >> 1, c0 = 8 * (lane & 1), tt = row & 15; const bool rho_row = row >= 16; float bv[8];
                                const f32x4 z0 = *(const LAS f32x4*)(ZF + row * 32 + 16 + c0), z1 = *(const LAS f32x4*)(ZF + row * 32 + 20 + c0);
#pragma unroll
                                for (int j = 0; j < 8; ++j) bv[j] = (j < 4) ? z0[j & 3] : z1[j & 3];
                                *(LAS u32x4*)(BB + row * P16 + c0 * 2) = (u32x4){pk2(bv[0], bv[1]), pk2(bv[2], bv[3]), pk2(bv[4], bv[5]), pk2(bv[6], bv[7])};
                            }
                        }
                        __syncthreads();
                        if (wave >= 4) { if (t0 + TC < SEQ) PASS1(t0 + TC, par ^ 1, t0 + 2 * TC < SEQ); }
                        else if (wave >= 2) { if (t0 + TC < SEQ) {
                            LAS unsigned char* gd = GKB + (par ^ 1) * 4096 + gt * 128 + gp * 2;
                            *(LAS u32x4*)gd = (u32x4){PUWS(0, 0), PUWS(0, 1), PUWS(0, 2), PUWS(0, 3)}; *(LAS u32x4*)(gd + 16) = (u32x4){PUWS(1, 0), PUWS(1, 1), PUWS(1, 2), PUWS(1, 3)};
                            if (t0 + 2 * TC < SEQ) LOADG(t0 + 2 * TC); } }
                        else if (wave < 2 && t0 >= 0) {
#pragma unroll 1
                            for (int sc = 0; sc < 2; ++sc) {
                                const LAS unsigned char* im = IM0 + sc * IMG;
                                const LAS unsigned char* KR = im; const LAS unsigned char* BT = im + 9216; const LAS unsigned char* GT = im + 12288; const LAS unsigned char* VT = im + 15360;
                                const LAS unsigned char* TT = im + 18432; const LAS unsigned char* BB = im + 19968; const LAS float* PL = (const LAS float*)(im + 25600);
                                const LAS unsigned char* BGr = im + 4608;
                                const bf16x8 vfr = trd8(VT, PT, 8 * h2, 8 * h2 + 4, 32 * wave, lane);
                                f32x16 t1;
#pragma unroll
                                for (int i = 0; i < 16; ++i) t1[i] = 0.f;
                                t1 = __builtin_amdgcn_mfma_f32_32x32x16_bf16(*(const LAS bf16x8*)(BB + r31 * P16 + 8 * h2 * 2), vfr, t1, 0, 0, 0);
#pragma unroll
                                for (int kb = 0; kb < 2; ++kb)
#pragma unroll
                                    for (int s = 0; s < 2; ++s) t1 = __builtin_amdgcn_mfma_f32_32x32x16_bf16(LD2x64(KR + r31 * PT + (32 * kb + 16 * s + 4 * h2) * 2), PACK8(Sreg[kb], s), t1, 0, 0, 0);
                                f32x16 t2;
#pragma unroll
                                for (int i = 0; i < 16; ++i) t2[i] = 0.f;
                                t2 = __builtin_amdgcn_mfma_f32_32x32x16_bf16(LD2x64(TT + r31 * P16 + (4 * h2) * 2), PACK8(t1, 0), t2, 0, 0, 0);
#pragma unroll
                                for (int i = 8; i < 16; ++i) OUTB[(16 * sc + (i & 3) + 8 * ((i >> 2) - 2) + 4 * h2) * 64 + 32 * wave + r31] = t2[i] + t1[i];
                                const bf16x8 uq = PACK8(t2, 0);
#pragma unroll
                                for (int kb = 0; kb < 2; ++kb) {
                                    f32x16 a = Sreg[kb];
                                    a = __builtin_amdgcn_mfma_f32_32x32x16_bf16(trd8(BGr, PT, 4 * h2, 8 + 4 * h2, 32 * kb, lane), uq, a, 0, 0, 0);
                                    a = __builtin_amdgcn_mfma_f32_32x32x16_bf16(trd8(BGr, PT, 16 + 8 * h2, 20 + 8 * h2, 32 * kb, lane), vfr, a, 0, 0, 0);
#pragma unroll
                                    for (int g4 = 0; g4 < 4; ++g4) { const f32x4 p4 = *(const LAS f32x4*)(PL + 32 * kb + 8 * g4 + 4 * h2);
                                        a[4 * g4] *= p4.x; a[4 * g4 + 1] *= p4.y; a[4 * g4 + 2] *= p4.z; a[4 * g4 + 3] *= p4.w; }
                                    Sreg[kb] = a;
                                }
                            }
                        }
                    }
                    __syncthreads();
                    if ((wave & 3) >= 2) EPI(SEQ - TC, ((SEQ - TC) >> 5) & 1);
                    __syncthreads();
#undef UNPH
#undef UNPJ
#undef PUW
#undef PUWS
#undef SETPU
#undef PACK8
#undef LD2x64
                } } else {
                    const int idx = job - 128, bh = idx >> 1, half = idx & 1, b = bh >> 2, h = bh & 3;
                    unsigned zl_ = 0u; asm volatile("" : "+v"(zl_)); const int lane_ml = (int)__builtin_amdgcn_mbcnt_hi(~0u, __builtin_amdgcn_mbcnt_lo(~0u, zl_));
                    _Pragma("unroll 1") for (int sr_ = 0; sr_ < NSUB(1); ++sr_) if (((SUBMASK>>1)&1) && idx < 64) {
                        SUB_TID
                        const int bm = idx >> 2, hm = idx & 3;
                        constexpr int PT = 144;
                        LAS unsigned char* QI = lds;
                        LAS unsigned char* KI = QI + 64 * PT;
                        constexpr int PV = 272;
                        LAS unsigned char* KW = KI + 64 * PT;
                        LAS unsigned char* VT = KW + 64 * PT;
                        LAS unsigned char* CI = VT + 64 * PV;
                        LAS float* AS = (LAS float*)(CI + 128 * PT);
                        LAS float* MX = AS + 64; LAS float* SI = AS + 128; LAS float* EM = AS + 192; LAS float* WG = AS + 256; LAS float* NN = AS + 320; LAS float* CR = AS + 384; LAS float* ST = AS + 448;
                        for (int i = tid; i < 128 * PT / 4; i += NTHR) ((LAS unsigned*)CI)[i] = 0u;
                        if (tid < 64) NN[tid] = 0.f;
                        const int pt = tid >> 4, cg = tid & 15;
                        const int ccol = (cg < 8) ? (hm * 64 + 8 * cg) : (256 + hm * 64 + 8 * (cg - 8));
                        const float qsc = (cg < 8) ? 0.125f : 1.f;
                        const float igb = INP(I_IGB)[l * 4 + hm], fgb = INP(I_FGB)[l * 4 + hm];
                        const int r31 = lane & 31, h2 = lane >> 5, vb = wave >> 1, tb = wave & 1;
                        f32x16 accC;
#pragma unroll
                        for (int i = 0; i < 16; ++i) accC[i] = 0.f;
                        float nreg = 0.f, mprev = 0.f;
                        u32x4 cu[2][4], vu[2]; float gi = 0.f, gf = 0.f;
                        auto LOADM = [&](int t0) {
#pragma unroll
                            for (int tt = 0; tt < 2; ++tt) { const int t = t0 + pt + 32 * tt; const size_t row = (size_t)bm * SEQ + t;
#pragma unroll
                                for (int j = 0; j < 4; ++j) { if (t - 3 + j >= 0) cu[tt][j] = *(const u32x4*)(Ub + ((row - 3 + j) * NU + UC_QK + ccol) * 2); else cu[tt][j] = (u32x4){0u, 0u, 0u, 0u}; }
                                const int p = tid + 512 * tt; vu[tt] = *(const u32x4*)(Ub + (((size_t)bm * SEQ + t0 + (p >> 4)) * NU + UC_V + hm * 128 + 8 * (p & 15)) * 2); }
                            if (wave == 0) { const size_t rg = (size_t)bm * SEQ + t0 + lane; gi = GIF[rg * 8 + hm]; gf = GIF[rg * 8 + 4 + hm]; }
                        };
                        LOADM(0);
                        __syncthreads();
#pragma unroll 1
                        for (int t0 = 0; t0 < SEQ; t0 += 64) {
                            int ccv = ccol; asm volatile("" : "+v"(ccv));
                            float cw[4][8], cb[8];
#pragma unroll
                        for (int j = 0; j < 4; ++j) { const f32x4 a = *(const f32x4*)(INP(I_CONVW) + ((size_t)l * 4 + j) * 512 + ccv), c2 = *(const f32x4*)(INP(I_CONVW) + ((size_t)l * 4 + j) * 512 + ccv + 4);
                            cw[j][0] = a.x; cw[j][1] = a.y; cw[j][2] = a.z; cw[j][3] = a.w; cw[j][4] = c2.x; cw[j][5] = c2.y; cw[j][6] = c2.z; cw[j][7] = c2.w; }
                        { const f32x4 a = *(const f32x4*)(INP(I_CONVB) + l * 512 + ccv), c2 = *(const f32x4*)(INP(I_CONVB) + l * 512 + ccv + 4);
                            cb[0] = a.x; cb[1] = a.y; cb[2] = a.z; cb[3] = a.w; cb[4] = c2.x; cb[5] = c2.y; cb[6] = c2.z; cb[7] = c2.w; }
                            float yq[2][8];
#pragma unroll
                            for (int tt = 0; tt < 2; ++tt) {
#pragma unroll
                                for (int i = 0; i < 8; ++i) yq[tt][i] = cb[i];
#pragma unroll
                                for (int j = 0; j < 4; ++j) { const u32x4 w = cu[tt][j]; const float x[8] = {bflo(w.x), bfhi(w.x), bflo(w.y), bfhi(w.y), bflo(w.z), bfhi(w.z), bflo(w.w), bfhi(w.w)};
#pragma unroll
                                    for (int i = 0; i < 8; ++i) yq[tt][i] += cw[j][i] * x[i]; }
#pragma unroll
                                for (int i = 0; i < 8; ++i) yq[tt][i] = yq[tt][i] * sigmoidf_(yq[tt][i]) * qsc;
                            }
                            const u32x4 vreg0 = vu[0], vreg1 = vu[1];
                            if (wave == 0) {
                                const float ig = gi + igb, fp = gf + fgb;
                                const float lf = -(fmaxf(-fp, 0.f) + __logf(1.f + __expf(-fabsf(fp))));
                                const float bc = scan_add64(lf);
                                const float as = ig - bc, pm = scan_max64(as);
                                const float mxv = fmaxf(mprev, pm), mx63 = __builtin_bit_cast(float, __builtin_amdgcn_readlane(__builtin_bit_cast(int, mxv), 63)), bl = __builtin_bit_cast(float, __builtin_amdgcn_readlane(__builtin_bit_cast(int, bc), 63));
                                AS[lane] = as; MX[lane] = mxv; SI[lane] = __expf(mprev - mxv); EM[lane] = __expf(-(bc + mxv)); WG[lane] = __expf(as - mx63);
                                if (lane == 0) CR[0] = __expf(mprev - mx63);
                                mprev = bl + mx63;
                            }
                            if (t0 + 64 < SEQ) LOADM(t0 + 64);
                            __syncthreads();
#pragma unroll
                            for (int tt = 0; tt < 2; ++tt) { const int tok = pt + 32 * tt;
                                u32x4 pw; pw.x = pk2(yq[tt][0], yq[tt][1]); pw.y = pk2(yq[tt][2], yq[tt][3]); pw.z = pk2(yq[tt][4], yq[tt][5]); pw.w = pk2(yq[tt][6], yq[tt][7]);
                                if (cg < 8) *(LAS u32x4*)(QI + tok * PT + cg * 16) = pw;
                                else { *(LAS u32x4*)(KI + tok * PT + (cg - 8) * 16) = pw; const float wgs = WG[tok];
                                    u32x4 kw; kw.x = pk2(yq[tt][0] * wgs, yq[tt][1] * wgs); kw.y = pk2(yq[tt][2] * wgs, yq[tt][3] * wgs); kw.z = pk2(yq[tt][4] * wgs, yq[tt][5] * wgs); kw.w = pk2(yq[tt][6] * wgs, yq[tt][7] * wgs);
                                    *(LAS u32x4*)(KW + tok * PT + (cg - 8) * 16) = kw; }
                                const u32x4 vw = tt ? vreg1 : vreg0; const int p = tid + 512 * tt, vtok = p >> 4, v8 = p & 15;
                                *(LAS u32x4*)(VT + vtok * PV + v8 * 16) = vw;
                            }
                            __syncthreads();
                            float hv[16];
                            {
                                constexpr float L2E = 1.4426950408889634f;
                                const int t = 32 * tb + r31;
                                bf16x8 qf[4];
#pragma unroll
                                for (int ks = 0; ks < 4; ++ks) qf[ks] = *(const LAS bf16x8*)(QI + t * PT + (16 * ks + 8 * h2) * 2);
                                const float mx = MX[t], si = SI[t], em = EM[t];
                                f32x16 O, I; float denI = 0.f;
#pragma unroll
                                for (int i = 0; i < 16; ++i) { O[i] = 0.f; I[i] = 0.f; }
#pragma unroll
                                for (int sb = 0; sb < 2; ++sb) if (sb <= tb) {
                                    f32x16 X;
#pragma unroll
                                    for (int i = 0; i < 16; ++i) X[i] = 0.f;
#pragma unroll
                                    for (int ks = 0; ks < 4; ++ks) { const bf16x8 kf = *(const LAS bf16x8*)(KI + (32 * sb + r31) * PT + (16 * ks + 8 * h2) * 2); X = __builtin_amdgcn_mfma_f32_32x32x16_bf16(kf, qf[ks], X, 0, 0, 0); }
#pragma unroll
                                    for (int g4 = 0; g4 < 4; ++g4) { const f32x4 a4 = *(const LAS f32x4*)(AS + 32 * sb + 8 * g4 + 4 * h2);
#pragma unroll
                                        for (int j = 0; j < 4; ++j) { const int s = 32 * sb + 8 * g4 + 4 * h2 + j; const float w = (s <= t) ? __builtin_amdgcn_exp2f((a4[j] - mx) * L2E) * X[4 * g4 + j] : 0.f; X[4 * g4 + j] = w; denI += w; } }
#pragma unroll
                                    for (int st = 0; st < 2; ++st) {
                                        u32x4 pw; pw.x = pk2(X[8 * st], X[8 * st + 1]); pw.y = pk2(X[8 * st + 2], X[8 * st + 3]); pw.z = pk2(X[8 * st + 4], X[8 * st + 5]); pw.w = pk2(X[8 * st + 6], X[8 * st + 7]);
                                        O = __builtin_amdgcn_mfma_f32_32x32x16_bf16(trd8(VT, PV, 32 * sb + 16 * st + 4 * h2, 32 * sb + 16 * st + 8 + 4 * h2, 32 * vb, lane), __builtin_bit_cast(bf16x8, pw), O, 0, 0, 0);
                                    }
                                }
                                float nq = 0.f;
#pragma unroll
                                for (int ks = 0; ks < 4; ++ks) { const bf16x8 cf = *(const LAS bf16x8*)(CI + (32 * vb + r31) * PT + (16 * ks + 8 * h2) * 2); I = __builtin_amdgcn_mfma_f32_32x32x16_bf16(cf, qf[ks], I, 0, 0, 0);
                                    const f32x4 n0 = *(const LAS f32x4*)(NN + 16 * ks + 8 * h2), n1 = *(const LAS f32x4*)(NN + 16 * ks + 8 * h2 + 4); const u32x4 qw = __builtin_bit_cast(u32x4, qf[ks]);
                                    nq += (bflo(qw.x) * n0.x + bfhi(qw.x) * n0.y) + (bflo(qw.y) * n0.z + bfhi(qw.y) * n0.w) + (bflo(qw.z) * n1.x + bfhi(qw.z) * n1.y) + (bflo(qw.w) * n1.z + bfhi(qw.w) * n1.w); }
                                nq += __shfl_xor(nq, 32); denI += __shfl_xor(denI, 32);
                                const float den = si * nq + denI, rdn = 1.f / fmaxf(fabsf(den), em);
                                float hsum = 0.f;
#pragma unroll
                                for (int i = 0; i < 16; ++i) { hv[i] = (O[i] + si * I[i]) * rdn; hsum += hv[i]; }
                                hsum += __shfl_xor(hsum, 32);
                                const float hmean = hsum * (1.f / 32.f); float hm2 = 0.f;
#pragma unroll
                                for (int i = 0; i < 16; ++i) { const float dlt = hv[i] - hmean; hm2 += dlt * dlt; }
                                hm2 += __shfl_xor(hm2, 32);
                                if (h2 == 0) *(LAS f32x2*)(ST + ((tb * 4 + vb) * 32 + r31) * 2) = (f32x2){hmean, hm2};
                                const float carry = CR[0];
#pragma unroll
                                for (int i = 0; i < 16; ++i) accC[i] *= carry;
#pragma unroll
                                for (int st = 0; st < 4; ++st) { const bf16x8 va = trd8(VT, PV, 16 * st + 8 * h2, 16 * st + 8 * h2 + 4, 32 * vb, lane), kw = trd8(KW, PT, 16 * st + 8 * h2, 16 * st + 8 * h2 + 4, 32 * tb, lane);
                                    accC = __builtin_amdgcn_mfma_f32_32x32x16_bf16(va, kw, accC, 0, 0, 0); }
                            }
                            __syncthreads();
                            {
                                const int t = 32 * tb + r31;
                                f32x2 s4[4];
#pragma unroll
                                for (int q = 0; q < 4; ++q) s4[q] = *(const LAS f32x2*)(ST + ((tb * 4 + q) * 32 + r31) * 2);
                                const float mt = (s4[0].x + s4[1].x + s4[2].x + s4[3].x) * 0.25f;
                                float m2 = 0.f;
#pragma unroll
                                for (int q = 0; q < 4; ++q) { const float dm = s4[q].x - mt; m2 += s4[q].y + 32.f * dm * dm; }
                                const float rstd = __builtin_amdgcn_rsqf(m2 * (1.f / 128.f) + LN_EPS);
                                const size_t row = (size_t)bm * SEQ + t0 + t;
                                const char* ogp = Ub + (row * NU + UC_OG + hm * 128 + 32 * vb) * 2; char* op = HC + (row * 1536 + hm * 128 + 32 * vb) * 2;
                                const float* ngp = INP(I_MLNORMG) + l * 512 + hm * 128 + 32 * vb;
#pragma unroll
                                for (int g4 = 0; g4 < 4; ++g4) { const int vo = 8 * g4 + 4 * h2; const f32x4 og = ld4bf(ogp + vo * 2), ng = *(const f32x4*)(ngp + vo);
                                    f32x4 y; y.x = sigmoidf_(og.x) * ((hv[4 * g4] - mt) * rstd * ng.x); y.y = sigmoidf_(og.y) * ((hv[4 * g4 + 1] - mt) * rstd * ng.y); y.z = sigmoidf_(og.z) * ((hv[4 * g4 + 2] - mt) * rstd * ng.z); y.w = sigmoidf_(og.w) * ((hv[4 * g4 + 3] - mt) * rstd * ng.w);
                                    st4bf(op + vo * 2, y); }
                            }
#pragma unroll
                            for (int i = 0; i < 16; ++i) { const int v = 32 * vb + (i & 3) + 8 * (i >> 2) + 4 * h2; *(LAS bf16*)(CI + v * PT + (32 * tb + r31) * 2) = (bf16)f2bf(accC[i]); }
                            if (wave < 2) { float s = 0.f;
#pragma unroll
                                for (int q8 = 0; q8 < 8; ++q8) { const u32x2 w = trd4(KW, PT, 32 * h2 + 4 * q8, 32 * wave, lane); s += (bflo(w.x) + bfhi(w.x)) + (bflo(w.y) + bfhi(w.y)); }
                                s += __shfl_xor(s, 32);
                                nreg = CR[0] * nreg + s; if (h2 == 0) NN[32 * wave + r31] = nreg; }
                            __syncthreads();
                        }
                    }
                }
            }
            if (rep_ == 0) {
                LAS unsigned* XB = (LAS unsigned*)(lds + 153088);
                unsigned* xc = (unsigned*)ctl + CW_FILL + 32 + l * 64;
                __syncthreads();
                if (tid_ph == 0) XB[0] = __hip_atomic_fetch_add(xc, 1u, RLX_AGENT);
                __syncthreads();
                int xi = __builtin_amdgcn_readfirstlane((int)XB[0]);
#pragma unroll 1
                while (xi < 128) {
                    const int idx = xi, bh = idx >> 1, half = idx & 1, b = bh >> 2, h = bh & 3;
                    _Pragma("unroll 1") for (int sr_ = 0; sr_ < NSUB(2); ++sr_) if ((SUBMASK>>2)&1) {
                        SUB_TID
                        constexpr int KST = 272, VST = 520;
                        LAS unsigned char* KI = lds; LAS unsigned char* VI = lds + 256 * KST;
                        const char* kvb = (const char*)(ws + WS_KV) + (((size_t)l * MROWS + (size_t)b * MEML) * D) * 2;
                        for (int p = tid; p < 4096; p += NTHR) { const int key = p >> 4, c16 = p & 15;
                            *(LAS u32x4*)(KI + key * KST + c16 * 16) = *(const u32x4*)(kvb + ((size_t)key * D + h * 128 + c16 * 8) * 2); }
                        for (int p = tid; p < 4096; p += NTHR) { const int key = p & 255, d8 = p >> 8;
                            const u32x4 w = *(const u32x4*)(kvb + ((size_t)key * D + 512 + h * 128 + d8 * 8) * 2);
                            LAS unsigned char* o = VI + (d8 * 8) * VST + key * 2;
                            *(LAS bf16*)(o) = (bf16)(w.x & 0xffff); *(LAS bf16*)(o + VST) = (bf16)(w.x >> 16); *(LAS bf16*)(o + 2 * VST) = (bf16)(w.y & 0xffff); *(LAS bf16*)(o + 3 * VST) = (bf16)(w.y >> 16);
                            *(LAS bf16*)(o + 4 * VST) = (bf16)(w.z & 0xffff); *(LAS bf16*)(o + 5 * VST) = (bf16)(w.z >> 16); *(LAS bf16*)(o + 6 * VST) = (bf16)(w.w & 0xffff); *(LAS bf16*)(o + 7 * VST) = (bf16)(w.w >> 16); }
                        __syncthreads();
                        const int r31 = lane & 31, h2 = lane >> 5;
                        constexpr float SC = 0.08838834764831845f * 1.4426950408889634f;
#pragma unroll 1
                        for (int rd = 0; rd < 8; ++rd) {
                            const size_t qrow = (size_t)b * SEQ + half * 2048 + rd * 256 + wave * 32 + r31;
                            bf16x8 qf[8];
#pragma unroll
                            for (int ks = 0; ks < 8; ++ks) qf[ks] = *(const bf16x8*)(Ub + (qrow * NU + UC_CAQ + h * 128 + 16 * ks + 8 * h2) * 2);
                            f32x16 O[4];
#pragma unroll
                            for (int db = 0; db < 4; ++db)
#pragma unroll
                                for (int i = 0; i < 16; ++i) O[db][i] = 0.f;
                            float mrun = -1e30f, lrun = 0.f;
#pragma unroll 1
                            for (int hf = 0; hf < 2; ++hf) {
                                f32x16 X[4];
#pragma unroll
                                for (int kb = 0; kb < 4; ++kb) {
                                    bf16x8 kf[8];
#pragma unroll
                                    for (int ks = 0; ks < 8; ++ks) kf[ks] = *(const LAS bf16x8*)(KI + (hf * 128 + kb * 32 + r31) * KST + (16 * ks + 8 * h2) * 2);
                                    __builtin_amdgcn_sched_barrier(0);
#pragma unroll
                                    for (int i = 0; i < 16; ++i) X[kb][i] = 0.f;
#pragma unroll
                                    for (int ks = 0; ks < 8; ++ks) X[kb] = __builtin_amdgcn_mfma_f32_32x32x16_bf16(kf[ks], qf[ks], X[kb], 0, 0, 0);
                                    __builtin_amdgcn_sched_barrier(0);
                                }
                                float mx = -1e30f;
#pragma unroll
                                for (int kb = 0; kb < 4; ++kb)
#pragma unroll
                                    for (int i = 0; i < 16; ++i) mx = fmaxf(mx, X[kb][i]);
                                mx = fmaxf(mx, __shfl_xor(mx, 32));
                                const float mnew = fmaxf(mrun, mx), alpha = __builtin_amdgcn_exp2f((mrun - mnew) * SC);
                                float ls = 0.f;
#pragma unroll
                                for (int kb = 0; kb < 4; ++kb)
#pragma unroll
                                    for (int i = 0; i < 16; ++i) { const float p = __builtin_amdgcn_exp2f((X[kb][i] - mnew) * SC); X[kb][i] = p; ls += p; }
                                ls += __shfl_xor(ls, 32);
                                lrun = lrun * alpha + ls; mrun = mnew;
#pragma unroll
                                for (int db = 0; db < 4; ++db)
#pragma unroll
                                    for (int i = 0; i < 16; ++i) O[db][i] *= alpha;
#pragma unroll
                                for (int kb = 0; kb < 4; ++kb) {
                                    bf16x8 vf[2][4], pf[2];
#pragma unroll
                                    for (int s = 0; s < 2; ++s) {
                                        u32x4 pw; pw.x = pk2(X[kb][8 * s], X[kb][8 * s + 1]); pw.y = pk2(X[kb][8 * s + 2], X[kb][8 * s + 3]); pw.z = pk2(X[kb][8 * s + 4], X[kb][8 * s + 5]); pw.w = pk2(X[kb][8 * s + 6], X[kb][8 * s + 7]);
                                        pf[s] = __builtin_bit_cast(bf16x8, pw);
#pragma unroll
                                        for (int db = 0; db < 4; ++db) {
                                            const LAS unsigned char* vp = VI + (db * 32 + r31) * VST + (hf * 128 + kb * 32 + 16 * s + 4 * h2) * 2;
                                            const u32x2 lo = *(const LAS u32x2*)vp, hi = *(const LAS u32x2*)(vp + 16);
                                            vf[s][db] = __builtin_bit_cast(bf16x8, (u32x4){lo.x, lo.y, hi.x, hi.y});
                                        }
                                    }
                                    __builtin_amdgcn_sched_barrier(0);
#pragma unroll
                                    for (int s = 0; s < 2; ++s)
#pragma unroll
                                        for (int db = 0; db < 4; ++db) O[db] = __builtin_amdgcn_mfma_f32_32x32x16_bf16(vf[s][db], pf[s], O[db], 0, 0, 0);
                                    __builtin_amdgcn_sched_barrier(0);
                                }
                            }
                            const float rl = 1.f / lrun;
                            char* op = HC + (qrow * 1536 + 1024 + h * 128) * 2;
#pragma unroll
                            for (int db = 0; db < 4; ++db)
#pragma unroll
                                for (int g4 = 0; g4 < 4; ++g4) { u32x2 w; w.x = pk2(O[db][4 * g4] * rl, O[db][4 * g4 + 1] * rl); w.y = pk2(O[db][4 * g4 + 2] * rl, O[db][4 * g4 + 3] * rl);
                                    *(u32x2*)(op + (db * 32 + 8 * g4 + 4 * h2) * 2) = w; }
                        }
                        __syncthreads();
                    }
                    if (tid_ph == 0) XB[0] = __hip_atomic_fetch_add(xc, 1u, RLX_AGENT);
                    __syncthreads();
                    xi = __builtin_amdgcn_readfirstlane((int)XB[0]);
                    __syncthreads();
                }
            }
            if (rep_ == 0) {
                unsigned zf_ = 0u; asm volatile("" : "+v"(zf_)); const int lane_f = (int)__builtin_amdgcn_mbcnt_hi(~0u, __builtin_amdgcn_mbcnt_lo(~0u, zf_));
                LAS float* scr = (LAS float*)(lds + wave * 8448);
                LAS unsigned* FB = (LAS unsigned*)(lds + 8 * 8448);
                unsigned* fc = (unsigned*)ctl + CW_FILL + l * 64;
                constexpr int IT_GU = 32 * 16 * 64, IT_ALL = 49152, CH = 32;
                const bool lead = (wave == 0) && (lane_f == 0);
                __syncthreads();
                if (lead) FB[0] = __hip_atomic_fetch_add(fc, (unsigned)CH, RLX_AGENT);
                __syncthreads();
                int fbase = __builtin_amdgcn_readfirstlane((int)FB[0]), slot = 1;
#pragma unroll 1
                while (fbase < IT_ALL) {
                    unsigned nb = 0u;
                    if (lead) nb = __hip_atomic_fetch_add(fc, (unsigned)CH, RLX_AGENT);
#pragma unroll 1
                    for (int kq = 0; kq < CH / NWAVES; ++kq) { const int it = fbase + wave + kq * NWAVES;
                        if (it < IT_GU) { const int e = it >> 10, q = it & 1023, kb = q >> 6, nb_ = q & 63;
                            transpose_item_f8(INP(I_WGU) + (((size_t)l * 32 + e) * D + 64 * kb) * 2048 + 32 * nb_, 2048, (unsigned char*)(ws + WS_WGU) + ((size_t)e * 2048 + 32 * nb_) * D + 64 * kb, D, F8_SWGU, scr, lane_f); }
                        else { const int r2 = it - IT_GU, e = r2 >> 9, q = r2 & 511, kb = q >> 5, nb_ = q & 31;
                            transpose_item_f8(INP(I_WDN) + (((size_t)l * 32 + e) * D + 64 * kb) * 1024 + 32 * nb_, 1024, (unsigned char*)(ws + WS_WDN) + ((size_t)e * 1024 + 32 * nb_) * D + 64 * kb, D, F8_SWDN, scr, lane_f); }
                    }
                    if (lead) FB[slot] = nb;
                    __syncthreads();
                    fbase = __builtin_amdgcn_readfirstlane((int)FB[slot]); slot ^= 1;
                }
            }
#undef UNP4
#undef DOT4
#undef SUB_TID
        }
        SEAM(pb + 3);
        _Pragma("unroll 1") for (int rep_ = 0; rep_ < NREP(5); ++rep_) if (((PHMASK>>5)&1) && IN(pb + 5)) {
            SchedPlain S; S.T.init(M / 256, 4); S.G = G; S.c = bx; S.A = (const char*)(ws + WS_R2 + R2_HCAT); S.B = (const char*)(ws + WS_WBR) + (size_t)l * 1024 * 1536 * 2; S.C = (char*)(ws + WS_R2 + R2_YPRE);
            S.lda = 1536; S.ldb = 1536; S.ldc = D;
            pg8::EpiMerge E; E.U = Ub; E.gate_b = INP(I_GATEB) + (size_t)l * 3072;
            pg8::gemm_phase<false, true>(lds, 1536 * 2, 1536 * 2, 1536 * 2, S, E, wave);
        }
        SEAM(pb + 5);
        _Pragma("unroll 1") for (int rep_ = 0; rep_ < NREP(6); ++rep_) if (((PHMASK>>6)&1) && IN(pb + 6)) {
            SchedPlain S; S.T.init(M / 256, 4); S.G = G; S.c = bx; S.A = (const char*)(ws + WS_R2 + R2_YPRE); S.B = (const char*)(ws + WS_WO) + (size_t)l * D * D * 2; S.C = (char*)(ws + WS_R2 + R2_Z);
            S.lda = D; S.ldb = D; S.ldc = D;
            pg8::EpiStore E;
            pg8::gemm_phase<false>(lds, D * 2, D * 2, D * 2, S, E, wave);
        }
        SEAM(pb + 6);
        _Pragma("unroll 1") for (int rep_ = 0; rep_ < NREP(7); ++rep_) if (((PHMASK>>7)&1) && IN(pb + 7)) { PHASE_TID
            constexpr int WP = 2064;
            LAS unsigned char* WRb = lds;
            LAS float* RB = (LAS float*)(lds + 66048);
            LAS unsigned char* XS = lds + 66560 + wave * 4608;
            for (int i = tid; i < 32768; i += NTHR) { const int k = i >> 5, e = i & 31; *(LAS bf16*)(WRb + e * WP + k * 2) = (bf16)f2bf(INP(I_RTW)[((size_t)l * D + k) * 32 + e]); }
            if (tid < 32) RB[tid] = INP(I_RTB)[l * 32 + tid];
            const char* Zb = (const char*)(ws + WS_R2 + R2_Z);
            int* TKE = (int*)(ws + WS_TKE); float* TKG = (float*)(ws + WS_TKG); int* TKP = (int*)(ws + WS_TKP); int* ROWTOK = (int*)(ws + WS_ROWTOK);
            LAS unsigned* LCNT = (LAS unsigned*)(lds + 131072);
            LAS unsigned* GBASE = LCNT + 32; LAS unsigned* LLEN = LCNT + 64; LAS unsigned* LIST = LCNT + 128;
            if (tid < 65) LCNT[tid] = 0u;
            {
                f32x4 g[4], bb[4];
#pragma unroll
                for (int j = 0; j < 4; ++j) { g[j] = *(const f32x4*)(INP(I_LN1G) + l * D + 256 * j + 4 * lane); bb[j] = *(const f32x4*)(INP(I_LN1B) + l * D + 256 * j + 4 * lane); }
#pragma unroll 1
                for (int pp = gw; pp < M / 2; pp += NGW) {
                    f32x4 y0[4], y1[4];
#pragma unroll
                    for (int j = 0; j < 4; ++j) { y0[j] = ld4bf(Zb + ((size_t)(2 * pp) * D + 256 * j + 4 * lane) * 2) + ld4bf(Xb + ((size_t)(2 * pp) * D + 256 * j + 4 * lane) * 2) * DN_ALPHA;
                        y1[j] = ld4bf(Zb + ((size_t)(2 * pp + 1) * D + 256 * j + 4 * lane) * 2) + ld4bf(Xb + ((size_t)(2 * pp + 1) * D + 256 * j + 4 * lane) * 2) * DN_ALPHA; }
                    ln16(y0, g, bb); ln16(y1, g, bb);
#pragma unroll
                    for (int j = 0; j < 4; ++j) { st4bf(Xb + ((size_t)(2 * pp) * D + 256 * j + 4 * lane) * 2, y0[j]); st4bf(Xb + ((size_t)(2 * pp + 1) * D + 256 * j + 4 * lane) * 2, y1[j]);
                        *(unsigned*)((char*)(ws + WS_XF8) + (size_t)(2 * pp) * D + 256 * j + 4 * lane) = pk4_f8(y0[j].x * F8_SX, y0[j].y * F8_SX, y0[j].z * F8_SX, y0[j].w * F8_SX);
                        *(unsigned*)((char*)(ws + WS_XF8) + (size_t)(2 * pp + 1) * D + 256 * j + 4 * lane) = pk4_f8(y1[j].x * F8_SX, y1[j].y * F8_SX, y1[j].z * F8_SX, y1[j].w * F8_SX); }
                }
            }
            asm volatile("s_waitcnt vmcnt(0)" ::: "memory");
            __syncthreads();
            __builtin_amdgcn_fence(__ATOMIC_ACQUIRE, "agent");
            asm volatile("s_waitcnt vmcnt(0)" ::: "memory");
            if (rep_ == 0) {
                const int r31 = lane & 31, h2 = lane >> 5;
                const int mytok = 16 * (bx + (2 * wave + (r31 >> 4)) * G) + (r31 & 15);
                const char* sp[4];
#pragma unroll
                for (int q = 0; q < 4; ++q) { const int row = (lane >> 3) + 8 * q; const int tk = 16 * (bx + (2 * wave + (row >> 4)) * G) + (row & 15); sp[q] = Xb + ((size_t)tk * D + 8 * (lane & 7)) * 2; }
                f32x16 C;
#pragma unroll
                for (int i = 0; i < 16; ++i) C[i] = 0.f;
                u32x4 xr[4];
#pragma unroll
                for (int q = 0; q < 4; ++q) xr[q] = *(const u32x4*)(sp[q]);
#pragma unroll 1
                for (int sl = 0; sl < 16; ++sl) {
#pragma unroll
                    for (int q = 0; q < 4; ++q) *(LAS u32x4*)(XS + ((lane >> 3) + 8 * q) * 144 + (lane & 7) * 16) = xr[q];
                    if (sl + 1 < 16) {
#pragma unroll
                        for (int q = 0; q < 4; ++q) xr[q] = *(const u32x4*)(sp[q] + (sl + 1) * 128); }
#pragma unroll
                    for (int k2 = 0; k2 < 4; ++k2) C = __builtin_amdgcn_mfma_f32_32x32x16_bf16(*(const LAS bf16x8*)(WRb + r31 * WP + (64 * sl + 16 * k2 + 8 * h2) * 2), *(const LAS bf16x8*)(XS + r31 * 144 + (16 * k2 + 8 * h2) * 2), C, 0, 0, 0);
                }
                float v[16];
#pragma unroll
                for (int g4 = 0; g4 < 4; ++g4) { const f32x4 b4 = *(const LAS f32x4*)(RB + 8 * g4 + 4 * h2); v[4 * g4] = C[4 * g4] + b4.x; v[4 * g4 + 1] = C[4 * g4 + 1] + b4.y; v[4 * g4 + 2] = C[4 * g4 + 2] + b4.z; v[4 * g4 + 3] = C[4 * g4 + 3] + b4.w; }
                float lv[4]; int li_[4];
#pragma unroll
                for (int k = 0; k < 4; ++k) { float best = -3.0e38f; int bi = 0;
#pragma unroll
                    for (int i = 0; i < 16; ++i) { const int e = (i & 3) + 8 * (i >> 2) + 4 * h2; if (v[i] > best) { best = v[i]; bi = e; } }
#pragma unroll
                    for (int i = 0; i < 16; ++i) { const int e = (i & 3) + 8 * (i >> 2) + 4 * h2; v[i] = (e == bi) ? -3.0e38f : v[i]; }
                    lv[k] = best; li_[k] = bi; }
                float cv[8]; int ci[8];
#pragma unroll
                for (int k = 0; k < 4; ++k) { cv[k] = lv[k]; ci[k] = li_[k]; cv[4 + k] = __shfl_xor(lv[k], 32); ci[4 + k] = __shfl_xor(li_[k], 32); }
                float tv[4]; int te[4];
#pragma unroll
                for (int k = 0; k < 4; ++k) { float best = -3.0e38f; int bi = 64;
#pragma unroll
                    for (int i = 0; i < 8; ++i) { if (cv[i] > best || (cv[i] == best && ci[i] < bi)) { best = cv[i]; bi = ci[i]; } }
#pragma unroll
                    for (int i = 0; i < 8; ++i) cv[i] = (ci[i] == bi) ? -3.0e38f : cv[i];
                    tv[k] = best; te[k] = bi; }
                const float e1 = __expf(tv[1] - tv[0]), e2 = __expf(tv[2] - tv[0]), e3 = __expf(tv[3] - tv[0]), rs = 1.f / (1.f + e1 + e2 + e3);
                const float gt[4] = {rs, e1 * rs, e2 * rs, e3 * rs};
                if (h2 == 0) {
#pragma unroll
                    for (int k = 0; k < 4; ++k) {
                        const unsigned lpos = __hip_atomic_fetch_add(LCNT + te[k], 1u, __ATOMIC_RELAXED, __HIP_MEMORY_SCOPE_WORKGROUP);
                        const unsigned li = __hip_atomic_fetch_add(LLEN, 1u, __ATOMIC_RELAXED, __HIP_MEMORY_SCOPE_WORKGROUP);
                        LIST[2 * li] = (unsigned)(mytok * 4 + k); LIST[2 * li + 1] = (unsigned)te[k] | (lpos << 8);
                        TKE[mytok * 4 + k] = te[k]; TKG[mytok * 4 + k] = gt[k]; }
                }
            }
            __syncthreads();
            if (tid < 32 && rep_ == 0) GBASE[tid] = __hip_atomic_fetch_add((unsigned*)ctl + CW_CNT + (l * 32 + tid) * 64, LCNT[tid], RLX_AGENT);
            __syncthreads();
            if (rep_ == 0) { const unsigned n = LLEN[0];
                for (unsigned i = tid; i < n; i += NTHR) { const unsigned tk = LIST[2 * i], ev = LIST[2 * i + 1], e = ev & 255u, pos = GBASE[e] + (ev >> 8);
                    TKP[tk] = (int)pos; ROWTOK[(size_t)e * M + pos] = (int)(tk >> 2); } }
            __syncthreads();
        }
        SEAM(pb + 7);
        _Pragma("unroll 1") for (int rep_ = 0; rep_ < NREP(8); ++rep_) if (((PHMASK>>8)&1) && IN(pb + 8)) { PHASE_TID
            if (tid < 32) CNT[tid] = (int)__hip_atomic_load((unsigned*)ctl + CW_CNT + (l * 32 + tid) * 64, RLX_AGENT);
            __syncthreads();
            if (tid == 0) { int a = 0; for (int e = 0; e < 32; ++e) { PB[e] = a; a += (CNT[e] + 255) >> 8; } PB[32] = a; }
            __syncthreads();
            const int P = PB[32];
            const int* ROWTOK = (const int*)(ws + WS_ROWTOK);
            char* XD = (char*)(ws + WS_R1); const char* XF = (const char*)(ws + WS_XF8);
            for (int sb = gw * 64; sb < P * 256; sb += NGW * 64) {
                const int pm = sb >> 8; int e = 0;
#pragma unroll 1
                for (int j = 1; j < NEXP; ++j) e += (PB[j] <= pm) ? 1 : 0;
                const int pos0 = sb - PB[e] * 256, cnt = CNT[e];
                int nvalid = cnt - pos0; nvalid = nvalid > 64 ? 64 : nvalid;
                int tokv = -1; if (pos0 + lane < cnt) tokv = ROWTOK[(size_t)e * M + pos0 + lane];
#pragma unroll 1
                for (int j = 0; j < nvalid; j += 4) {
                    int t[4]; u32x4 a[4];
#pragma unroll
                    for (int i = 0; i < 4; ++i) { t[i] = __builtin_amdgcn_readlane(tokv, j + i);
                        if (t[i] >= 0) a[i] = *(const u32x4*)(XF + (size_t)t[i] * 1024 + lane * 16); }
#pragma unroll
                    for (int i = 0; i < 4; ++i) if (t[i] >= 0) *(u32x4*)(XD + (size_t)(sb + j + i) * 1024 + lane * 16) = a[i];
                }
            }
            LAS float* scr = (LAS float*)(lds + wave * 8448);
            constexpr int IT_GU = 32 * 16 * 64, IT_DN = 32 * 16 * 32;
            for (int it = XW_SPLIT + gw; it < IT_GU + IT_DN; it += NGW) {
                if (it < IT_GU) { const int e = it >> 10, q = it & 1023, kb = q >> 6, nb = q & 63;
                    transpose_item_f8(INP(I_WGU) + (((size_t)l * 32 + e) * D + 64 * kb) * 2048 + 32 * nb, 2048, (unsigned char*)(ws + WS_WGU) + ((size_t)e * 2048 + 32 * nb) * D + 64 * kb, D, F8_SWGU, scr, lane); }
                else { const int r = it - IT_GU, e = r >> 9, q = r & 511, kb = q >> 5, nb = q & 31;
                    transpose_item_f8(INP(I_WDN) + (((size_t)l * 32 + e) * D + 64 * kb) * 1024 + 32 * nb, 1024, (unsigned char*)(ws + WS_WDN) + ((size_t)e * 1024 + 32 * nb) * D + 64 * kb, D, F8_SWDN, scr, lane); }
            }
            __syncthreads();
        }
        SEAM(pb + 8);
        if (IN(pb + 9) || IN(pb + 10)) { PHASE_TID
            if (tid < 32) CNT[tid] = (int)__hip_atomic_load((unsigned*)ctl + CW_CNT + (l * 32 + tid) * 64, RLX_AGENT);
            __syncthreads();
            if (tid == 0) { int a = 0; for (int e = 0; e < 32; ++e) { PB[e] = a; a += (CNT[e] + 255) >> 8; } PB[32] = a; }
            __syncthreads();
        }
        _Pragma("unroll 1") for (int rep_ = 0; rep_ < NREP(9); ++rep_) if (((PHMASK>>9)&1) && IN(pb + 9)) {
            SchedMoe S; S.T.init(PB[32], 8); S.G = G; S.c = bx; S.A = (const char*)(ws + WS_R1); S.W = (const char*)(ws + WS_WGU); S.C = (char*)(ws + WS_R2 + R2_HMID); S.PB = PB; S.wrows = 2048; S.ldc = 1024; S.cdiv = 2; S.osz = 1;
            pg8::EpiMoe1 E; E.bgu = INP(I_BGU) + (size_t)l * 32 * 2048;
            pg8::gemm_phase<true>(lds, D, D, D, S, E, wave);
        }
        SEAM(pb + 9);
        _Pragma("unroll 1") for (int rep_ = 0; rep_ < NREP(10); ++rep_) if (((PHMASK>>10)&1) && IN(pb + 10)) {
            SchedMoe S; S.T.init(PB[32], 4); S.G = G; S.c = bx; S.A = (const char*)(ws + WS_R2 + R2_HMID); S.W = (const char*)(ws + WS_WDN); S.C = (char*)(ws + WS_R1); S.PB = PB; S.wrows = 1024; S.ldc = 1024; S.cdiv = 1; S.osz = 2;
            pg8::EpiMoe2 E; E.bdn = INP(I_BDN) + (size_t)l * 32 * 1024;
            pg8::gemm_phase<true>(lds, D, D, D, S, E, wave);
        }
        SEAM(pb + 10);
        _Pragma("unroll 1") for (int rep_ = 0; rep_ < NREP(11); ++rep_) if (((PHMASK>>11)&1) && IN(pb + 11)) { PHASE_TID
            if (tid < 32) CNT[tid] = (int)__hip_atomic_load((unsigned*)ctl + CW_CNT + (l * 32 + tid) * 64, RLX_AGENT);
            LAS float* wgt = (LAS float*)(lds + 73728);
            const bool lastl = (l == DEPTH - 1);
            if (!lastl) load_gate_table(wgt, INP(I_WIN) + (size_t)(l + 1) * D * DIN, tid);
            __syncthreads();
            if (tid == 0) { int a = 0; for (int e = 0; e < 32; ++e) { PB[e] = a; a += (CNT[e] + 255) >> 8; } PB[32] = a; }
            __syncthreads();
            const int e0 = 8 * lane;
            f32x4 g[4], bb[4];
#pragma unroll
            for (int j = 0; j < 4; ++j) { const int o = (j >> 1) * 512 + e0 + (j & 1) * 4; g[j] = *(const f32x4*)(INP(I_LN2G) + l * D + o); bb[j] = *(const f32x4*)(INP(I_LN2B) + l * D + o); }
            const char* YA = (const char*)(ws + WS_R1);
            const bool dummy_ = (rep_ + 1 < NREP(11)); char* const Xo = dummy_ ? (char*)(ws + WS_R2) : Xb; float* const Fo = dummy_ ? (float*)(ws + WS_R2 + 256 * MiB) : args.out; float* const Go = dummy_ ? (float*)(ws + WS_R2 + 200 * MiB) : GIF;
            const int* TKE = (const int*)(ws + WS_TKE); const float* TKG = (const float*)(ws + WS_TKG); const int* TKP = (const int*)(ws + WS_TKP);
#pragma unroll 1
            for (int mb = gw * 16; mb < M; mb += NGW * 16) {
                const int ev = TKE[mb * 4 + lane], pv = TKP[mb * 4 + lane]; const float gv = TKG[mb * 4 + lane];
                const int rowv = PB[ev] * 256 + pv;
#pragma unroll 1
                for (int ti = 0; ti < 16; ti += 2) {
                    u32x4 xw[2][2], yw[2][4][2]; float gk[2][4];
#pragma unroll
                    for (int q = 0; q < 2; ++q) { const size_t m = (size_t)mb + ti + q;
                        xw[q][0] = *(const u32x4*)(Xb + (m * D + e0) * 2); xw[q][1] = *(const u32x4*)(Xb + (m * D + 512 + e0) * 2);
#pragma unroll
                        for (int k = 0; k < 4; ++k) { const size_t row = (size_t)__builtin_amdgcn_readlane(rowv, 4 * (ti + q) + k);
                            gk[q][k] = __builtin_bit_cast(float, __builtin_amdgcn_readlane(__builtin_bit_cast(int, gv), 4 * (ti + q) + k));
                            yw[q][k][0] = *(const u32x4*)(YA + (row * D + e0) * 2); yw[q][k][1] = *(const u32x4*)(YA + (row * D + 512 + e0) * 2); } }
#pragma unroll
                    for (int q = 0; q < 2; ++q) { const size_t m = (size_t)mb + ti + q;
                        f32x4 v[4];
#pragma unroll
                        for (int hh = 0; hh < 2; ++hh) { const u32x4 w = xw[q][hh];
                            v[2 * hh] = (f32x4){bflo(w.x), bfhi(w.x), bflo(w.y), bfhi(w.y)} * DN_ALPHA; v[2 * hh + 1] = (f32x4){bflo(w.z), bfhi(w.z), bflo(w.w), bfhi(w.w)} * DN_ALPHA; }
#pragma unroll
                        for (int k = 0; k < 4; ++k)
#pragma unroll
                            for (int hh = 0; hh < 2; ++hh) { const u32x4 w = yw[q][k][hh];
                                v[2 * hh] = v[2 * hh] + (f32x4){bflo(w.x), bfhi(w.x), bflo(w.y), bfhi(w.y)} * gk[q][k]; v[2 * hh + 1] = v[2 * hh + 1] + (f32x4){bflo(w.z), bfhi(w.z), bflo(w.w), bfhi(w.w)} * gk[q][k]; }
                        ln16(v, g, bb);
                        if (lastl) {
#pragma unroll
                            for (int j = 0; j < 4; ++j) *(f32x4*)(Fo + m * D + (j >> 1) * 512 + e0 + (j & 1) * 4) = v[j];
                        } else {
#pragma unroll
                            for (int hh = 0; hh < 2; ++hh) { *(u32x4*)(Xo + (m * D + hh * 512 + e0) * 2) = pg8::pack8(v[2 * hh], v[2 * hh + 1]);
                                u32x2 f8w; f8w.x = pk4_f8(v[2 * hh].x * F8_SX, v[2 * hh].y * F8_SX, v[2 * hh].z * F8_SX, v[2 * hh].w * F8_SX); f8w.y = pk4_f8(v[2 * hh + 1].x * F8_SX, v[2 * hh + 1].y * F8_SX, v[2 * hh + 1].z * F8_SX, v[2 * hh + 1].w * F8_SX);
                                if (!dummy_) *(u32x2*)((char*)(ws + WS_XF8) + m * D + hh * 512 + e0) = f8w; }
                            gates8b(v, wgt, Go + m * 8, lane);
                        }
                    }
                }
            }
            __syncthreads();
        }
        SEAM(pb + 11);
    }
#undef IN
#undef SEAM
}

extern "C" void kernel_launch(void* const* d_in, const int* in_sizes, int n_in, void* d_out, int out_size, void* d_ws, size_t ws_size, hipStream_t stream) {
    static int grid = 0;
    if (grid == 0) {
        if (n_in != N_IN || out_size != M * D || ws_size < WS_END) { fprintf(stderr, "kernel_launch: unexpected shapes (n_in %d, out %d, ws %zu)\n", n_in, out_size, ws_size); grid = -1; return; }
        int dev = 0, cus = 0, per_cu = 0;
        if (hipGetDevice(&dev) != hipSuccess || hipDeviceGetAttribute(&cus, hipDeviceAttributeMultiprocessorCount, dev) != hipSuccess) { grid = -1; return; }
        if (hipFuncSetAttribute((const void*)fwd_kernel, hipFuncAttributeMaxDynamicSharedMemorySize, LDS_BYTES) != hipSuccess) { fprintf(stderr, "kernel_launch: hipFuncSetAttribute failed\n"); grid = -1; return; }
        if (hipOccupancyMaxActiveBlocksPerMultiprocessor(&per_cu, (const void*)fwd_kernel, NTHR, LDS_BYTES) != hipSuccess || per_cu < 1) fprintf(stderr, "kernel_launch: occupancy query reports %d\n", per_cu);
        (void)hipGetLastError();
        grid = cus;
    }
    if (grid < 0) return;
    (void)hipMemsetAsync((char*)d_ws + WS_CTL, 0, CTL_ZERO_BYTES, stream);
    Args a{};
    for (int i = 0; i < N_IN; ++i) a.in[i] = (const float*)d_in[i];
    a.out = (float*)d_out; a.ws = (unsigned char*)d_ws;
#if MK_ONE_LAUNCH
    a.ph_lo = 0; a.ph_hi = NPH;
    hipLaunchKernelGGL(fwd_kernel, dim3(grid), dim3(NTHR), LDS_BYTES, stream, a);
#else
    for (int p = 0; p < NPH; ++p) { a.ph_lo = p; a.ph_hi = p + 1; hipLaunchKernelGGL(fwd_kernel, dim3(grid), dim3(NTHR), LDS_BYTES, stream, a); }
#endif
    const hipError_t le = hipPeekAtLastError();
    if (le != hipSuccess) fprintf(stderr, "kernel_launch: launch failed: %s\n", hipGetErrorName(le));
}
```

```cpp
#include <hip/hip_runtime.h>
#include <cstdio>
#include <cstdint>

#ifndef MK_ONE_LAUNCH
#define MK_ONE_LAUNCH 1
#endif

#define LAS __attribute__((address_space(3)))
#define GAS __attribute__((address_space(1)))
typedef unsigned short bf16;
typedef short bf16x8 __attribute__((ext_vector_type(8)));
typedef float f32x4 __attribute__((ext_vector_type(4)));
typedef float f32x2 __attribute__((ext_vector_type(2)));
typedef float f32x16 __attribute__((ext_vector_type(16)));
typedef unsigned u32x4 __attribute__((ext_vector_type(4)));
typedef unsigned u32x2 __attribute__((ext_vector_type(2)));
typedef __bf16 bf16x2_t __attribute__((ext_vector_type(2)));
typedef GAS unsigned gu32;
#define RLX_AGENT __ATOMIC_RELAXED, __HIP_MEMORY_SCOPE_AGENT
#define DI __device__ __forceinline__

constexpr int NWAVES = 8, NTHR = 512;
constexpr int D = 1024, BATCH = 16, SEQ = 4096, M = BATCH * SEQ, DEPTH = 2, MEML = 256, MROWS = BATCH * MEML;
constexpr int DIN = 6920, NU = 6912;
constexpr int UC_QK = 0, UC_RW = 512, UC_V = 2304, UC_OG = 2816, UC_CAQ = 3328, UC_GATE = 3840;
constexpr int UC_F8 = UC_V, NF8 = NU - UC_F8;
__host__ __device__ constexpr int ucol_src(int c) { return c < 512 ? c : (c < 2304 ? 1544 + (c - 512) : (c < 2816 ? 512 + (c - 2304) : (c < 3328 ? 1024 + (c - 2816) : (c < 3840 ? 3336 + (c - 3328) : 3848 + (c - 3840))))); }
constexpr int NEXP = 32, TOPK = 4;
constexpr int PMAX = M * TOPK / 256 + NEXP;
constexpr float LN_EPS = 1e-5f, RW_GN_EPS = 64e-5f, DN_ALPHA = 1.41421356237f;

enum { I_X = 0, I_MEM, I_LNIN_G, I_LNIN_B, I_MEMLN_G, I_MEMLN_B, I_WIN, I_CONVW, I_CONVB, I_IGB, I_FGB, I_MLNORMG, I_RWMU, I_RWW0, I_RWWUP, I_RWA0, I_RWAUP, I_RWGUP,
       I_RWKK, I_RWKA, I_RWRK, I_RWLNG, I_RWLNB, I_CAWKV, I_GATEB, I_WBRML, I_WBRRW, I_WBRCA, I_WO, I_LN1G, I_LN1B, I_RTW, I_RTB, I_WGU, I_BGU, I_WDN, I_BDN, I_LN2G, I_LN2B, N_IN };

constexpr size_t MiB = 1u << 20;
constexpr size_t WS_CTL = 0, CTL_ZERO_BYTES = 1 * MiB;
constexpr size_t WS_WIN = 1 * MiB;
constexpr size_t WS_WKV = 28 * MiB;
constexpr size_t WS_WBR = 32 * MiB;
constexpr size_t WS_WO = 38 * MiB;
constexpr size_t WS_WLORA = 42 * MiB;
constexpr size_t WS_WGU = 45 * MiB;
constexpr size_t WS_WDN = 173 * MiB;
constexpr size_t WS_X = 237 * MiB;
constexpr size_t WS_MEMN = 365 * MiB;
constexpr size_t WS_KV = 373 * MiB;
constexpr size_t WS_GIF = 389 * MiB;
constexpr size_t WS_TKE = 391 * MiB, WS_TKG = 392 * MiB, WS_TKP = 393 * MiB;
constexpr size_t WS_ROWTOK = 394 * MiB;
constexpr size_t WS_HML = 402 * MiB;
constexpr size_t WS_R1 = 466 * MiB;
constexpr size_t WS_R2 = 1330 * MiB;
constexpr size_t WS_XF8 = 1858 * MiB;
constexpr size_t WS_WING8 = 1922 * MiB;
constexpr size_t WS_END = 1932 * MiB;
constexpr size_t R2_LORA_OUT = 0, R2_HCAT = 192 * MiB, R2_LORA_IN = 384 * MiB, R2_YPRE = 0, R2_Z = 192 * MiB, R2_HMID = 0;
constexpr int CW_TMO = 0, CW_BAR = 4096, CW_CNT = 16384, CW_FILL = 32768;

constexpr int LDS_BYTES = 155648;
constexpr int LDSCTL_OFF = 153600;

DI unsigned pk2(float lo, float hi) { bf16x2_t b = __builtin_convertvector((f32x2){lo, hi}, bf16x2_t); return __builtin_bit_cast(unsigned, b); }
DI unsigned f2bf(float f) { return pk2(f, 0.f) & 0xffffu; }
DI float u2f_(unsigned u) { return __builtin_bit_cast(float, u); }
DI unsigned f2u_(float f) { return __builtin_bit_cast(unsigned, f); }
DI float bflo(unsigned u) { return __builtin_bit_cast(float, u << 16); }
DI float bfhi(unsigned u) { return __builtin_bit_cast(float, u & 0xffff0000u); }
DI unsigned pk4_f8(float a, float b, float c, float d) {
    a = __builtin_amdgcn_fmed3f(a, -448.f, 448.f); b = __builtin_amdgcn_fmed3f(b, -448.f, 448.f); c = __builtin_amdgcn_fmed3f(c, -448.f, 448.f); d = __builtin_amdgcn_fmed3f(d, -448.f, 448.f);
    int w = 0; w = __builtin_amdgcn_cvt_pk_fp8_f32(a, b, w, false); w = __builtin_amdgcn_cvt_pk_fp8_f32(c, d, w, true); return (unsigned)w; }
DI float sigmoidf_(float x) { return __builtin_amdgcn_rcpf(1.f + __builtin_amdgcn_exp2f(-1.4426950408889634f * x)); }
template <int CTRL> DI float dppf(float x) { return __builtin_bit_cast(float, __builtin_amdgcn_update_dpp(0, __builtin_bit_cast(int, x), CTRL, 0xF, 0xF, true)); }
DI float red4(float x) { x += dppf<0xB1>(x); x += dppf<0x4E>(x); return x; }
DI float red8(float x) { x = red4(x); x += dppf<0x141>(x); return x; }
DI float red16(float x) { x = red8(x); x += dppf<0x140>(x); return x; }
DI float red8o(float x) { x += dppf<0xB1>(x); asm("" : "+v"(x)); x += dppf<0x4E>(x); asm("" : "+v"(x)); x += dppf<0x141>(x); asm("" : "+v"(x)); return x; }
DI float red16o(float x) { x = red8o(x); x += dppf<0x140>(x); asm("" : "+v"(x)); return x; }
typedef short s16x4 __attribute__((ext_vector_type(4)));
DI u32x2 trd4(const LAS unsigned char* img, int PB, int rowbase, int colbase, int lane) {
    const LAS unsigned char* p = img + (rowbase + ((lane & 15) >> 2)) * PB + (colbase + 16 * ((lane >> 4) & 1) + 4 * (lane & 3)) * 2;
    return __builtin_bit_cast(u32x2, __builtin_amdgcn_ds_read_tr16_b64_v4i16((LAS s16x4*)p)); }
DI bf16x8 trd8(const LAS unsigned char* img, int PB, int rb0, int rb1, int colbase, int lane) { const u32x2 lo = trd4(img, PB, rb0, colbase, lane), hi = trd4(img, PB, rb1, colbase, lane); return __builtin_bit_cast(bf16x8, (u32x4){lo.x, lo.y, hi.x, hi.y}); }
template <int CTRL, int RM> DI float dpp_keep(float x, float ident) { return __builtin_bit_cast(float, __builtin_amdgcn_update_dpp(__builtin_bit_cast(int, ident), __builtin_bit_cast(int, x), CTRL, RM, 0xF, false)); }
DI float scan_add64(float x) { x += dpp_keep<0x111, 0xF>(x, 0.f); x += dpp_keep<0x112, 0xF>(x, 0.f); x += dpp_keep<0x114, 0xF>(x, 0.f); x += dpp_keep<0x118, 0xF>(x, 0.f); x += dpp_keep<0x142, 0xA>(x, 0.f); x += dpp_keep<0x143, 0xC>(x, 0.f); return x; }
DI float scan_max64(float x) { const float NI = -3.0e38f; x = fmaxf(x, dpp_keep<0x111, 0xF>(x, NI)); x = fmaxf(x, dpp_keep<0x112, 0xF>(x, NI)); x = fmaxf(x, dpp_keep<0x114, 0xF>(x, NI)); x = fmaxf(x, dpp_keep<0x118, 0xF>(x, NI));
    x = fmaxf(x, dpp_keep<0x142, 0xA>(x, NI)); x = fmaxf(x, dpp_keep<0x143, 0xC>(x, NI)); return x; }
DI float wave_sum(float v) {
    v = red16(v);
    const int vi = __builtin_bit_cast(int, v);
    const float a = __builtin_bit_cast(float, __builtin_amdgcn_readlane(vi, 0)), b = __builtin_bit_cast(float, __builtin_amdgcn_readlane(vi, 16));
    const float c = __builtin_bit_cast(float, __builtin_amdgcn_readlane(vi, 32)), d = __builtin_bit_cast(float, __builtin_amdgcn_readlane(vi, 48));
    return (a + b) + (c + d);
}
#define LDS_WAIT() asm volatile("s_waitcnt lgkmcnt(0)" ::: "memory")

constexpr float F8_SX = 8.f, F8_SWGU = 512.f, F8_SH = 4.f, F8_SWDN = 1024.f, F8_INV1 = 1.f / (F8_SX * F8_SWGU), F8_INV2 = 1.f / (F8_SH * F8_SWDN);
namespace pg8 {
constexpr int BM = 256, BK = 64, HALF = 128, HTB = HALF * BK * 2, STAGE_BYTES = 8 * HTB, NXCD = 8, WGM = 8;
__host__ __device__ __forceinline__ int lds_byte(int r, int c) { const int st = (r >> 4) * 2 + (c >> 5), rr = r & 15, cc = c & 31, ob = rr * 64 + cc * 2; return st * 1024 + (ob ^ (((ob >> 9) & 1) << 5)); }
__host__ __device__ __forceinline__ void stage_rc(int b, int& R, int& C) { const int st = b / 1024, sb = b % 1024, swz = sb ^ (((sb >> 9) & 1) << 5); R = (st >> 1) * 16 + swz / 64; C = (st & 1) * 32 + (swz % 64) / 2; }
__host__ __device__ __forceinline__ int perm32(int rho) { const int n = rho >> 4, i = rho & 15; return 8 * (i >> 2) + 4 * n + (i & 3); }

struct Unit { const char* a; const char* b; char* c; int ldc; int r0, c0, e, sub; };

struct TileOrder {
    int nM, nN, nwg;
    DI void init(int nM_, int nN_) { nM = nM_; nN = nN_; nwg = nM * nN; }
    DI bool tile(long L, int& pm, int& pn) const {
        if (L >= nwg) return false;
        int wgid = (int)L; { const int q = nwg / NXCD, r = nwg % NXCD, xcd = wgid % NXCD, off = wgid / NXCD; wgid = (xcd < r ? xcd * (q + 1) : r * (q + 1) + (xcd - r) * q) + off; }
        const int nig = WGM * nN, gid = wgid / nig, fm = gid * WGM, gsz = (nM - fm) < WGM ? (nM - fm) : WGM;
        pm = fm + ((wgid % nig) % gsz); pn = (wgid % nig) / gsz; return true;
    }
};

DI u32x4 pack8(const f32x4& v0, const f32x4& v1) { u32x4 w; w.x = pk2(v0[0], v0[1]); w.y = pk2(v0[2], v0[3]); w.z = pk2(v1[0], v1[1]); w.w = pk2(v1[2], v1[3]); return w; }

struct EpiStore {
    DI void operator()(const f32x4 (&acc)[2][2][4][2], const Unit& u, int wr, int wc, int fr, int fq) const {
#pragma unroll
        for (int ai = 0; ai < 2; ++ai)
#pragma unroll
            for (int m = 0; m < 4; ++m) { char* rowp = u.c + ((size_t)(ai * HALF + wr * 64 + m * 16 + fr) * u.ldc + wc * 32 + 8 * fq) * 2;
#pragma unroll
                for (int bj = 0; bj < 2; ++bj) *(u32x4*)(rowp + bj * 256) = pack8(acc[ai][bj][m][0], acc[ai][bj][m][1]); }
    }
};
struct EpiStoreS {
    float s; const float* gate_b; int gate_c0;
    DI void operator()(const f32x4 (&acc)[2][2][4][2], const Unit& u, int wr, int wc, int fr, int fq) const {
        const bool gate = u.c0 >= gate_c0;
        const float L2E = 1.4426950408889634f;
#pragma unroll
        for (int bj = 0; bj < 2; ++bj) {
            f32x4 g0 = (f32x4){0.f, 0.f, 0.f, 0.f}, g1 = g0;
            if (gate) { const float* g = gate_b + (u.c0 - gate_c0) + bj * HALF + wc * 32 + 8 * fq; g0 = *(const f32x4*)g; g1 = *(const f32x4*)(g + 4); }
#pragma unroll
            for (int ai = 0; ai < 2; ++ai)
#pragma unroll
                for (int m = 0; m < 4; ++m) { char* rowp = u.c + ((size_t)(ai * HALF + wr * 64 + m * 16 + fr) * u.ldc + wc * 32 + 8 * fq) * 2;
                    f32x4 v0 = acc[ai][bj][m][0] * s, v1 = acc[ai][bj][m][1] * s;
                    if (gate) {
#pragma unroll
                        for (int i = 0; i < 4; ++i) { v0[i] = __builtin_amdgcn_exp2f(-L2E * __builtin_amdgcn_fmed3f(v0[i] + g0[i], -30.f, 30.f)); v1[i] = __builtin_amdgcn_exp2f(-L2E * __builtin_amdgcn_fmed3f(v1[i] + g1[i], -30.f, 30.f)); } }
                    *(u32x4*)(rowp + bj * 256) = pack8(v0, v1); }
        }
    }
};
struct EpiMerge {
    static constexpr bool MIDK = true;
    const char* U; const float* gate_b;
    DI void mid(f32x4 (&acc)[2][2][4][2], const Unit& u, int which, int wr, int wc, int fr, int fq) const {
#pragma unroll
        for (int bj = 0; bj < 2; ++bj)
#pragma unroll
            for (int ai = 0; ai < 2; ++ai) {
                u32x4 wa[4], wn[4];
#pragma unroll
                for (int m = 0; m < 4; ++m) { const int lr = ai * HALF + wr * 64 + m * 16 + fr;
                    const char* gp = U + ((size_t)(u.r0 + lr) * NU + UC_GATE + which * 1024 + u.c0 + wc * 32 + 8 * fq) * 2 + bj * 256;
                    wa[m] = *(const u32x4*)gp; wn[m] = *(const u32x4*)(gp + 2048); }
#pragma unroll
                for (int m = 0; m < 4; ++m) {
                    const u32x4 a = wa[m], n = wn[m];
                    const float ea[8] = {bflo(a.x), bfhi(a.x), bflo(a.y), bfhi(a.y), bflo(a.z), bfhi(a.z), bflo(a.w), bfhi(a.w)};
                    const float en[8] = {bflo(n.x), bfhi(n.x), bflo(n.y), bfhi(n.y), bflo(n.z), bfhi(n.z), bflo(n.w), bfhi(n.w)};
#pragma unroll
                    for (int i = 0; i < 8; ++i) acc[ai][bj][m][i >> 2][i & 3] *= (1.f + en[i]) * __builtin_amdgcn_rcpf(1.f + ea[i]); }
                asm volatile("" ::: "memory"); }
    }
    DI void operator()(const f32x4 (&acc)[2][2][4][2], const Unit& u, int wr, int wc, int fr, int fq) const {
#pragma unroll
        for (int bj = 0; bj < 2; ++bj) {
            u32x4 gw[2][4];
#pragma unroll
            for (int ai = 0; ai < 2; ++ai)
#pragma unroll
                for (int m = 0; m < 4; ++m) { const int lr = ai * HALF + wr * 64 + m * 16 + fr; gw[ai][m] = *(const u32x4*)(U + ((size_t)(u.r0 + lr) * NU + UC_GATE + 2048 + u.c0 + wc * 32 + 8 * fq) * 2 + bj * 256); }
#pragma unroll
            for (int ai = 0; ai < 2; ++ai)
#pragma unroll
                for (int m = 0; m < 4; ++m) { const int lr = ai * HALF + wr * 64 + m * 16 + fr; char* rowp = u.c + ((size_t)lr * u.ldc + wc * 32 + 8 * fq) * 2; const u32x4 w = gw[ai][m];
                    f32x4 v0 = acc[ai][bj][m][0], v1 = acc[ai][bj][m][1];
                    v0[0] *= __builtin_amdgcn_rcpf(1.f + bflo(w.x)); v0[1] *= __builtin_amdgcn_rcpf(1.f + bfhi(w.x)); v0[2] *= __builtin_amdgcn_rcpf(1.f + bflo(w.y)); v0[3] *= __builtin_amdgcn_rcpf(1.f + bfhi(w.y));
                    v1[0] *= __builtin_amdgcn_rcpf(1.f + bflo(w.z)); v1[1] *= __builtin_amdgcn_rcpf(1.f + bfhi(w.z)); v1[2] *= __builtin_amdgcn_rcpf(1.f + bflo(w.w)); v1[3] *= __builtin_amdgcn_rcpf(1.f + bfhi(w.w));
                    *(u32x4*)(rowp + bj * 256) = pack8(v0, v1); }
            asm volatile("" ::: "memory");
        }
    }
};
struct EpiWo {
    const char* X;
    DI void operator()(const f32x4 (&acc)[2][2][4][2], const Unit& u, int wr, int wc, int fr, int fq) const {
#pragma unroll
        for (int ai = 0; ai < 2; ++ai)
#pragma unroll
            for (int m = 0; m < 4; ++m) { const int lr = ai * HALF + wr * 64 + m * 16 + fr; char* rowp = u.c + ((size_t)lr * u.ldc + wc * 32 + 8 * fq) * 2;
                const char* xp = X + ((size_t)(u.r0 + lr) * D + u.c0 + wc * 32 + 8 * fq) * 2;
#pragma unroll
                for (int bj = 0; bj < 2; ++bj) { const u32x4 xw = *(const u32x4*)(xp + bj * 256);
                    f32x4 v0 = acc[ai][bj][m][0], v1 = acc[ai][bj][m][1];
                    v0[0] += DN_ALPHA * bflo(xw.x); v0[1] += DN_ALPHA * bfhi(xw.x); v0[2] += DN_ALPHA * bflo(xw.y); v0[3] += DN_ALPHA * bfhi(xw.y);
                    v1[0] += DN_ALPHA * bflo(xw.z); v1[1] += DN_ALPHA * bfhi(xw.z); v1[2] += DN_ALPHA * bflo(xw.w); v1[3] += DN_ALPHA * bfhi(xw.w);
                    *(u32x4*)(rowp + bj * 256) = pack8(v0, v1); }
                asm volatile("" ::: "memory"); }
    }
};
DI float swiglu1(float a, float b) { const float g = fminf(a, 7.f), l = fminf(fmaxf(b, -7.f), 7.f); return g * sigmoidf_(1.702f * g) * (l + 1.f); }
struct EpiMoe1 {
    const float* bgu;
    DI void operator()(const f32x4 (&acc)[2][2][4][2], const Unit& u, int wr, int wc, int fr, int fq) const {
        f32x4 bv[2][2];
#pragma unroll
        for (int bj = 0; bj < 2; ++bj) { const float* b = bgu + u.e * 2048 + u.c0 + bj * HALF + wc * 32 + 8 * fq; bv[bj][0] = *(const f32x4*)b; bv[bj][1] = *(const f32x4*)(b + 4); }
#pragma unroll
        for (int ai = 0; ai < 2; ++ai)
#pragma unroll
            for (int m = 0; m < 4; ++m) { const int lr = ai * HALF + wr * 64 + m * 16 + fr; char* rowp = u.c + ((size_t)lr * u.ldc + wc * 16 + 4 * fq);
#pragma unroll
                for (int bj = 0; bj < 2; ++bj) { const f32x4 v0 = acc[ai][bj][m][0] * F8_INV1 + bv[bj][0], v1 = acc[ai][bj][m][1] * F8_INV1 + bv[bj][1];
                    *(unsigned*)(rowp + bj * 64) = pk4_f8(swiglu1(v0[0], v0[1]) * F8_SH, swiglu1(v0[2], v0[3]) * F8_SH, swiglu1(v1[0], v1[1]) * F8_SH, swiglu1(v1[2], v1[3]) * F8_SH); } }
    }
};
struct EpiMoe2 {
    const float* bdn;
    DI void operator()(const f32x4 (&acc)[2][2][4][2], const Unit& u, int wr, int wc, int fr, int fq) const {
        f32x4 bv[2][2];
#pragma unroll
        for (int bj = 0; bj < 2; ++bj) { const float* b = bdn + u.e * 1024 + u.c0 + bj * HALF + wc * 32 + 8 * fq; bv[bj][0] = *(const f32x4*)b; bv[bj][1] = *(const f32x4*)(b + 4); }
#pragma unroll
        for (int ai = 0; ai < 2; ++ai)
#pragma unroll
            for (int m = 0; m < 4; ++m) { char* rowp = u.c + ((size_t)(ai * HALF + wr * 64 + m * 16 + fr) * u.ldc + wc * 32 + 8 * fq) * 2;
#pragma unroll
                for (int bj = 0; bj < 2; ++bj) *(u32x4*)(rowp + bj * 256) = pack8(acc[ai][bj][m][0] * F8_INV2 + bv[bj][0], acc[ai][bj][m][1] * F8_INV2 + bv[bj][1]); }
    }
};

typedef int i32x8 __attribute__((ext_vector_type(8)));
typedef int i32x4 __attribute__((ext_vector_type(4)));
template <bool F8, bool MIDK = false, class Epi, class Sched>
DI void gemm_phase(LAS unsigned char* lds, const int KB  , const int ldaB, const int ldbB, const Sched& S, const Epi& E, const int wave_) {
    unsigned z_ = 0u; asm volatile("" : "+v"(z_)); const int tid = wave_ * 64 + (int)__builtin_amdgcn_mbcnt_hi(~0u, __builtin_amdgcn_mbcnt_lo(~0u, z_));
    const int wid = __builtin_amdgcn_readfirstlane(tid >> 6), lane = tid & 63, wr = wid >> 2, wc = wid & 3, fr = lane & 15, fq = lane >> 4;
    const int nt = KB / (BK * 2);
    unsigned voffA[2], voffB[2];
#pragma unroll
    for (int i = 0; i < 2; ++i) { int R, C; stage_rc(tid * 16 + i * 8192, R, C); const int Rb = (R & ~31) + perm32(R & 31);
        voffA[i] = (unsigned)(R * ldaB + C * 2); voffB[i] = (unsigned)(Rb * ldbB + C * 2); }
    asm volatile("" : "+v"(voffA[0]), "+v"(voffA[1]), "+v"(voffB[0]), "+v"(voffB[1]));
    const size_t kstep = (size_t)(BK * 2);
    const size_t hstepA = (size_t)HALF * ldaB, hstepB = (size_t)HALF * ldbB;
    const unsigned ldsw = (unsigned)wid * 1024u;
    const int aoff = lds_byte(wr * 64 + fr, fq * 8), boff = lds_byte(wc * 32 + fr, fq * 8);
#define PG8_SA(b, h) (((b) * 2 + (h)) * HTB)
#define PG8_SB(b, h) ((4 + (b) * 2 + (h)) * HTB)
#define PG8_STAGE(bufoff, gbase, voff) do { _Pragma("unroll") for (int _i = 0; _i < 2; ++_i) \
        __builtin_amdgcn_global_load_lds((const unsigned*)((const char*)(gbase) + (voff)[_i]), (LAS unsigned*)(lds + (bufoff) + ldsw + _i * 8192), 16, 0, 0); } while (0)
#define PG8_LD8(p) __builtin_shufflevector(*(const LAS i32x4*)(p), *(const LAS i32x4*)((p) + 1024), 0, 1, 2, 3, 4, 5, 6, 7)
#define PG8_LDA8(dst, b, h) do { _Pragma("unroll") for (int m = 0; m < 4; ++m) dst[m] = PG8_LD8(lds + PG8_SA(b, h) + aoff + m * 2048); } while (0)
#define PG8_LDB8(dst, b, h) do { _Pragma("unroll") for (int n = 0; n < 2; ++n) dst[n] = PG8_LD8(lds + PG8_SB(b, h) + boff + n * 2048); } while (0)
#define PG8_MMA8(ai, bj, A8, B8) do { __builtin_amdgcn_s_setprio(1); _Pragma("unroll") for (int m = 0; m < 4; ++m) _Pragma("unroll") for (int n = 0; n < 2; ++n) \
        asm volatile("v_mfma_f32_16x16x128_f8f6f4 %0, %1, %2, %0" : "+v"(acc[ai][bj][m][n]) : "v"(B8[n]), "v"(A8[m])); __builtin_amdgcn_s_setprio(0); } while (0)
#define PG8_LDA(dst, b, h) do { _Pragma("unroll") for (int m = 0; m < 4; ++m) _Pragma("unroll") for (int k = 0; k < 2; ++k) dst[m][k] = *(const LAS bf16x8*)(lds + PG8_SA(b, h) + aoff + m * 2048 + k * 1024); } while (0)
#define PG8_LDB(dst, b, h) do { _Pragma("unroll") for (int n = 0; n < 2; ++n) _Pragma("unroll") for (int k = 0; k < 2; ++k) dst[n][k] = *(const LAS bf16x8*)(lds + PG8_SB(b, h) + boff + n * 2048 + k * 1024); } while (0)
#define PG8_CAT(x) __builtin_shufflevector(__builtin_bit_cast(i32x4, (x)[0]), __builtin_bit_cast(i32x4, (x)[1]), 0, 1, 2, 3, 4, 5, 6, 7)
#define PG8_MMA(ai, bj, At, Bt) do { __builtin_amdgcn_s_setprio(1); _Pragma("unroll") for (int m = 0; m < 4; ++m) _Pragma("unroll") for (int n = 0; n < 2; ++n) _Pragma("unroll") for (int k = 0; k < 2; ++k) \
        acc[ai][bj][m][n] = __builtin_amdgcn_mfma_f32_16x16x32_bf16(Bt[n][k], At[m][k], acc[ai][bj][m][n], 0, 0, 0); __builtin_amdgcn_s_setprio(0); } while (0)
#define PG8_WAIT_V(n) asm volatile("s_waitcnt vmcnt(" #n ")" ::: "memory")
#define PG8_WAIT_L(n) asm volatile("s_waitcnt lgkmcnt(" #n ")" ::: "memory")
#define PG8_BAR __builtin_amdgcn_s_barrier()
#define PG8_SCHED __builtin_amdgcn_sched_barrier(0)
    Unit cur, nxt; int ui = 0;
    if (!S.next(0, cur)) return;
    f32x4 acc[2][2][4][2];
#pragma unroll
    for (int a = 0; a < 2; ++a)
#pragma unroll
        for (int b = 0; b < 2; ++b)
#pragma unroll
            for (int m = 0; m < 4; ++m)
#pragma unroll
                for (int n = 0; n < 2; ++n) acc[a][b][m][n] = (f32x4){0.f, 0.f, 0.f, 0.f};
    bf16x8 At[4][2], B0[2][2], B1[2][2]; i32x8 A8[4], B80[2], B81[2];
    const char* cA = cur.a; const char* cB = cur.b;
    PG8_STAGE(PG8_SB(0, 0), cB, voffB); PG8_STAGE(PG8_SB(0, 1), cB + hstepB, voffB); PG8_STAGE(PG8_SA(0, 0), cA, voffA); PG8_STAGE(PG8_SA(0, 1), cA + hstepA, voffA);
    if (wr == 1) PG8_BAR;
    PG8_WAIT_V(2); PG8_BAR;
    PG8_STAGE(PG8_SB(1, 0), cB + kstep, voffB); PG8_STAGE(PG8_SA(1, 0), cA + kstep, voffA); PG8_STAGE(PG8_SB(1, 1), cB + hstepB + kstep, voffB);
    PG8_WAIT_V(6); PG8_BAR;
    for (;;) {
        const bool has_next = S.next(ui + 1, nxt);
        const char* nA = has_next ? nxt.a : cA; const char* nB = has_next ? nxt.b : cB;
#pragma unroll 1
        for (int t = 0; t < nt; t += 2) {
            if constexpr (MIDK) { if (t == 8 || t == 16) { int fr_ = fr, fq_ = fq; asm volatile("" : "+v"(fr_), "+v"(fq_)); E.mid(acc, cur, t >> 4, wr, wc, fr_, fq_); } }
            const bool last = (t == nt - 2);
            const char* a1 = cA + (size_t)(t + 1) * kstep;
            const char* a2 = last ? nA : cA + (size_t)(t + 2) * kstep; const char* b2 = last ? nB : cB + (size_t)(t + 2) * kstep;
            const char* a3 = a2 + kstep; const char* b3 = b2 + kstep;
            if constexpr (F8) {
            PG8_LDB8(B80, 0, 0); PG8_LDB8(B81, 0, 1); PG8_SCHED; PG8_LDA8(A8, 0, 0); PG8_STAGE(PG8_SA(1, 1), a1 + hstepA, voffA);
            PG8_WAIT_V(8); PG8_WAIT_L(0); PG8_BAR; PG8_MMA8(0, 0, A8, B80); PG8_MMA8(0, 1, A8, B81); PG8_BAR; PG8_SCHED;
            PG8_LDA8(A8, 0, 1); PG8_STAGE(PG8_SB(0, 0), b2, voffB); PG8_STAGE(PG8_SB(0, 1), b2 + hstepB, voffB); PG8_STAGE(PG8_SA(0, 0), a2, voffA);
            PG8_WAIT_V(8); PG8_WAIT_L(0); PG8_BAR; PG8_MMA8(1, 0, A8, B80); PG8_MMA8(1, 1, A8, B81); PG8_BAR; PG8_SCHED;
            PG8_LDB8(B80, 1, 0); PG8_LDB8(B81, 1, 1); PG8_SCHED; PG8_LDA8(A8, 1, 0); PG8_STAGE(PG8_SA(0, 1), a2 + hstepA, voffA);
            PG8_WAIT_V(8); PG8_WAIT_L(0); PG8_BAR; PG8_MMA8(0, 0, A8, B80); PG8_MMA8(0, 1, A8, B81); PG8_BAR; PG8_SCHED;
            PG8_LDA8(A8, 1, 1); PG8_STAGE(PG8_SB(1, 0), b3, voffB); PG8_STAGE(PG8_SB(1, 1), b3 + hstepB, voffB); PG8_STAGE(PG8_SA(1, 0), a3, voffA);
            PG8_WAIT_V(8); PG8_WAIT_L(0); PG8_BAR; PG8_MMA8(1, 0, A8, B80); PG8_MMA8(1, 1, A8, B81); PG8_BAR; PG8_SCHED;
            } else {
            PG8_LDB(B0, 0, 0); PG8_LDB(B1, 0, 1); PG8_SCHED; PG8_LDA(At, 0, 0); PG8_STAGE(PG8_SA(1, 1), a1 + hstepA, voffA);
            PG8_WAIT_V(8); PG8_WAIT_L(0); PG8_BAR; PG8_MMA(0, 0, At, B0); PG8_MMA(0, 1, At, B1); PG8_BAR; PG8_SCHED;
            PG8_LDA(At, 0, 1); PG8_STAGE(PG8_SB(0, 0), b2, voffB); PG8_STAGE(PG8_SB(0, 1), b2 + hstepB, voffB); PG8_STAGE(PG8_SA(0, 0), a2, voffA);
            PG8_WAIT_V(8); PG8_WAIT_L(0); PG8_BAR; PG8_MMA(1, 0, At, B0); PG8_MMA(1, 1, At, B1); PG8_BAR; PG8_SCHED;
            PG8_LDB(B0, 1, 0); PG8_LDB(B1, 1, 1); PG8_SCHED; PG8_LDA(At, 1, 0); PG8_STAGE(PG8_SA(0, 1), a2 + hstepA, voffA);
            PG8_WAIT_V(8); PG8_WAIT_L(0); PG8_BAR; PG8_MMA(0, 0, At, B0); PG8_MMA(0, 1, At, B1); PG8_BAR; PG8_SCHED;
            PG8_LDA(At, 1, 1); PG8_STAGE(PG8_SB(1, 0), b3, voffB); PG8_STAGE(PG8_SB(1, 1), b3 + hstepB, voffB); PG8_STAGE(PG8_SA(1, 0), a3, voffA);
            PG8_WAIT_V(8); PG8_WAIT_L(0); PG8_BAR; PG8_MMA(1, 0, At, B0); PG8_MMA(1, 1, At, B1); PG8_BAR; PG8_SCHED;
            }
        }
        if (wr == 0) PG8_BAR;
        if constexpr (F8) asm volatile("s_nop 15\n\ts_nop 15" ::: "memory");
        { int fr_ = fr, fq_ = fq; asm volatile("" : "+v"(fr_), "+v"(fq_));
          E(acc, cur, wr, wc, fr_, fq_); }
        if (!has_next) break;
#pragma unroll
        for (int a = 0; a < 2; ++a)
#pragma unroll
            for (int b = 0; b < 2; ++b)
#pragma unroll
                for (int m = 0; m < 4; ++m)
#pragma unroll
                    for (int n = 0; n < 2; ++n) acc[a][b][m][n] = (f32x4){0.f, 0.f, 0.f, 0.f};
        cur = nxt; cA = nA; cB = nB; ++ui;
        if (wr == 1) PG8_BAR;
    }
    PG8_WAIT_V(0);
    PG8_BAR;
#undef PG8_SA
#undef PG8_SB
#undef PG8_STAGE
#undef PG8_LDA
#undef PG8_LDB
#undef PG8_MMA
#undef PG8_CAT
#undef PG8_LD8
#undef PG8_LDA8
#undef PG8_LDB8
#undef PG8_MMA8
#undef PG8_WAIT_V
#undef PG8_WAIT_L
#undef PG8_BAR
#undef PG8_SCHED
}
}

#define XB_TMO      128
#define XB_XCNT(j)  (256  + 64 * (j))
#define XB_XSUB(j)  (1280 + 64 * (j))
#define XB_XGEN(j)  (2304 + 64 * (j))
#define XB_TOP      3328
#define XB_TOPGEN   3392
#define XCD_BAR_WORDS 3456
#define XB_SPIN_CAP (1u << 22)
DI unsigned xb_ld(unsigned* p)              { return __hip_atomic_load(p, __ATOMIC_RELAXED, __HIP_MEMORY_SCOPE_AGENT); }
DI unsigned xb_add(unsigned* p, unsigned v) { return __hip_atomic_fetch_add(p, v, __ATOMIC_RELAXED, __HIP_MEMORY_SCOPE_AGENT); }
DI unsigned xb_xcc_id() { return (unsigned)__builtin_amdgcn_s_getreg((3 << 11) | 20) & 0xFu; }
#define XB_SPIN(cond, bar) do { unsigned _sp = 0; while (cond) { __builtin_amdgcn_s_sleep(1); \
    if ((++_sp & 255u) == 0u) { if (xb_ld(&(bar)[XB_TMO])) break; if (_sp > XB_SPIN_CAP) { atomicAdd(&(bar)[XB_TMO], 1u); break; } } } } while (0)
struct XcdBarrier { unsigned* bar; unsigned x; volatile LAS unsigned* st; };
DI XcdBarrier xcd_barrier_post(unsigned* bar, volatile LAS unsigned* st) {
    XcdBarrier b; b.bar = bar; b.x = xb_xcc_id(); b.st = st;
    if (threadIdx.x == 0) (void)xb_add(&bar[XB_XCNT(b.x)], 1u);
    return b;
}
DI void xcd_barrier_complete(unsigned* bar, unsigned x, unsigned& nloc, unsigned& nx) {
    const unsigned G = gridDim.x * gridDim.y * gridDim.z;
    unsigned sum, cnt, mine, sp = 0u;
    for (;;) {
        sum = 0u; cnt = 0u; mine = 0u;
#pragma unroll
        for (unsigned j = 0; j < 16; ++j) { const unsigned c = xb_ld(&bar[XB_XCNT(j)]); sum += c; cnt += (c > 0u) ? 1u : 0u; mine = (j == x) ? c : mine; }
        if (sum == G) break;
        __builtin_amdgcn_s_sleep(1);
        if ((++sp & 255u) == 0u) { if (xb_ld(&bar[XB_TMO])) break; if (sp > XB_SPIN_CAP) { atomicAdd(&bar[XB_TMO], 1u); break; } }
    }
    nloc = mine > 0u ? mine : 1u; nx = cnt > 0u ? cnt : 1u;
}
DI void xcd_barrier(const XcdBarrier& b) {
    asm volatile("s_waitcnt vmcnt(0)" ::: "memory");
    __syncthreads();
    if (threadIdx.x == 0) {
        unsigned* bar = b.bar;
        __builtin_amdgcn_s_waitcnt(0);
        unsigned nloc = b.st[0], nx = b.st[1];
        if (nloc == 0u) { xcd_barrier_complete(bar, b.x, nloc, nx); b.st[0] = nloc; b.st[1] = nx; }
        const unsigned old = xb_add(&bar[XB_XSUB(b.x)], 1u);
        const unsigned gen = old / nloc;
        if (old + 1u == (gen + 1u) * nloc) {
            __builtin_amdgcn_fence(__ATOMIC_RELEASE, "agent");
            asm volatile("s_waitcnt vmcnt(0)" ::: "memory");
            const unsigned og = xb_add(&bar[XB_TOP], 1u);
            const unsigned tg = og / nx;
            if (og + 1u == (tg + 1u) * nx) xb_add(&bar[XB_TOPGEN], 1u);
            else XB_SPIN(xb_ld(&bar[XB_TOPGEN]) == tg, bar);
            __builtin_amdgcn_fence(__ATOMIC_ACQUIRE, "agent");
            xb_add(&bar[XB_XGEN(b.x)], 1u);
            asm volatile("s_waitcnt vmcnt(0)" ::: "memory");
        } else {
            XB_SPIN(xb_ld(&bar[XB_XGEN(b.x)]) == gen, bar);
            __builtin_amdgcn_fence(__ATOMIC_ACQUIRE, "agent");
            asm volatile("s_waitcnt vmcnt(0)" ::: "memory");
        }
    }
    __syncthreads();
}

DI void transpose_item(const float* W, int ldw, bf16* WT, int ldt, LAS float* scr, int lane) {
    { const int kr = lane >> 3, c4 = (lane & 7) * 4; f32x4 v[8];
#pragma unroll
        for (int i = 0; i < 8; ++i) v[i] = *(const f32x4*)(W + (size_t)(8 * i + kr) * ldw + c4);
#pragma unroll
        for (int i = 0; i < 8; ++i) { LAS float* o = scr + (8 * i + kr) * 33 + c4; o[0] = v[i].x; o[1] = v[i].y; o[2] = v[i].z; o[3] = v[i].w; } }
    LDS_WAIT(); asm volatile("" ::: "memory");
    const int c = lane & 7;
#pragma unroll
    for (int j = 0; j < 4; ++j) { const int n = (lane >> 3) + 8 * j; const LAS float* s = scr + (8 * c) * 33 + n;
        u32x4 o; o.x = pk2(s[0 * 33], s[1 * 33]); o.y = pk2(s[2 * 33], s[3 * 33]); o.z = pk2(s[4 * 33], s[5 * 33]); o.w = pk2(s[6 * 33], s[7 * 33]);
        *(u32x4*)(WT + (size_t)n * ldt + 8 * c) = o; }
    LDS_WAIT(); asm volatile("" ::: "memory");
}
DI void transpose_item_f8(const float* W, int ldw, unsigned char* WT, int ldt, float scale, LAS float* scr, int lane) {
    { const int kr = lane >> 3, c4 = (lane & 7) * 4; f32x4 v[8];
#pragma unroll
        for (int i = 0; i < 8; ++i) v[i] = *(const f32x4*)(W + (size_t)(8 * i + kr) * ldw + c4);
#pragma unroll
        for (int i = 0; i < 8; ++i) { LAS float* o = scr + (8 * i + kr) * 33 + c4; o[0] = v[i].x; o[1] = v[i].y; o[2] = v[i].z; o[3] = v[i].w; } }
    LDS_WAIT(); asm volatile("" ::: "memory");
    const int c = lane & 3;
#pragma unroll
    for (int j = 0; j < 2; ++j) { const int n = (lane >> 2) + 16 * j; const LAS float* s = scr + (16 * c) * 33 + n;
        u32x4 o; o.x = pk4_f8(s[0 * 33] * scale, s[1 * 33] * scale, s[2 * 33] * scale, s[3 * 33] * scale); o.y = pk4_f8(s[4 * 33] * scale, s[5 * 33] * scale, s[6 * 33] * scale, s[7 * 33] * scale);
        o.z = pk4_f8(s[8 * 33] * scale, s[9 * 33] * scale, s[10 * 33] * scale, s[11 * 33] * scale); o.w = pk4_f8(s[12 * 33] * scale, s[13 * 33] * scale, s[14 * 33] * scale, s[15 * 33] * scale);
        *(u32x4*)(WT + (size_t)n * ldt + 16 * c) = o; }
    LDS_WAIT(); asm volatile("" ::: "memory");
}
DI void ti_load(const float* W, int ldw, int lane, f32x4 (&v)[8]) {
    const int kr = lane >> 3, c4 = (lane & 7) * 4;
#pragma unroll
    for (int i = 0; i < 8; ++i) v[i] = *(const f32x4*)(W + (size_t)(8 * i + kr) * ldw + c4);
}
DI void ti_store_f8(const f32x4 (&v)[8], unsigned char* WT, int ldt, float scale, LAS float* scr, int lane) {
    { const int kr = lane >> 3, c4 = (lane & 7) * 4;
#pragma unroll
        for (int i = 0; i < 8; ++i) { LAS float* o = scr + (8 * i + kr) * 33 + c4; o[0] = v[i].x; o[1] = v[i].y; o[2] = v[i].z; o[3] = v[i].w; } }
    LDS_WAIT(); asm volatile("" ::: "memory");
    const int c = lane & 3;
#pragma unroll
    for (int j = 0; j < 2; ++j) { const int n = (lane >> 2) + 16 * j; const LAS float* s = scr + (16 * c) * 33 + n;
        u32x4 o; o.x = pk4_f8(s[0 * 33] * scale, s[1 * 33] * scale, s[2 * 33] * scale, s[3 * 33] * scale); o.y = pk4_f8(s[4 * 33] * scale, s[5 * 33] * scale, s[6 * 33] * scale, s[7 * 33] * scale);
        o.z = pk4_f8(s[8 * 33] * scale, s[9 * 33] * scale, s[10 * 33] * scale, s[11 * 33] * scale); o.w = pk4_f8(s[12 * 33] * scale, s[13 * 33] * scale, s[14 * 33] * scale, s[15 * 33] * scale);
        *(u32x4*)(WT + (size_t)n * ldt + 16 * c) = o; }
    LDS_WAIT(); asm volatile("" ::: "memory");
}
DI void ti_load4(const float* W, int ldw, int lane, f32x4 (&v)[8]) {
    const int a = lane & 15, g = lane >> 4;
#pragma unroll
    for (int b = 0; b < 2; ++b)
#pragma unroll
        for (int j = 0; j < 4; ++j) v[4 * b + j] = *(const f32x4*)(W + (size_t)(4 * a + j) * ldw + 4 * (g + 4 * b));
}
DI void ti_store4_f8(const f32x4 (&v)[8], unsigned char* WT, int ldt, float scale, int lane) {
    const int a = lane & 15, g = lane >> 4;
#pragma unroll
    for (int b = 0; b < 2; ++b)
#pragma unroll
        for (int q = 0; q < 4; ++q)
            *(unsigned*)(WT + (size_t)(4 * (g + 4 * b) + q) * ldt + 4 * a) = pk4_f8(v[4 * b][q] * scale, v[4 * b + 1][q] * scale, v[4 * b + 2][q] * scale, v[4 * b + 3][q] * scale);
}
DI void ln16(f32x4 (&v)[4], const f32x4 (&g)[4], const f32x4 (&b)[4]) {
    float s = 0.f;
#pragma unroll
    for (int j = 0; j < 4; ++j) s += (v[j].x + v[j].y) + (v[j].z + v[j].w);
    const float mean = wave_sum(s) * (1.f / D); float s2 = 0.f;
#pragma unroll
    for (int j = 0; j < 4; ++j) { v[j] = v[j] - mean; s2 += (v[j].x * v[j].x + v[j].y * v[j].y) + (v[j].z * v[j].z + v[j].w * v[j].w); }
    const float rstd = 1.f / sqrtf(wave_sum(s2) * (1.f / D) + LN_EPS);
#pragma unroll
    for (int j = 0; j < 4; ++j) v[j] = v[j] * rstd * g[j] + b[j];
}
DI void gates8(const f32x4 (&y)[4], const LAS float* wgt, float* gif_row, int lane) {
    float p[8];
#pragma unroll
    for (int j = 0; j < 8; ++j) { float s = 0.f;
#pragma unroll
        for (int jj = 0; jj < 4; ++jj) { const f32x4 w = *(const LAS f32x4*)(wgt + j * 1024 + 256 * jj + 4 * lane); s += (y[jj].x * w.x + y[jj].y * w.y) + (y[jj].z * w.z + y[jj].w * w.w); }
        p[j] = wave_sum(s); }
    if (lane == 0) { *(f32x4*)gif_row = (f32x4){p[0], p[1], p[2], p[3]}; *(f32x4*)(gif_row + 4) = (f32x4){p[4], p[5], p[6], p[7]}; }
}
DI void gates8b(const f32x4 (&y)[4], const LAS float* wgt, float* gif_row, int lane) {
    float p[8];
#pragma unroll
    for (int j = 0; j < 8; ++j) { float s = 0.f;
#pragma unroll
        for (int jj = 0; jj < 4; ++jj) { const f32x4 w = *(const LAS f32x4*)(wgt + j * 1024 + (jj >> 1) * 512 + 8 * lane + (jj & 1) * 4); s += (y[jj].x * w.x + y[jj].y * w.y) + (y[jj].z * w.z + y[jj].w * w.w); }
        p[j] = wave_sum(s); }
    if (lane == 0) { *(f32x4*)gif_row = (f32x4){p[0], p[1], p[2], p[3]}; *(f32x4*)(gif_row + 4) = (f32x4){p[4], p[5], p[6], p[7]}; }
}
DI void load_gate_table(LAS float* wgt, const float* win_l, int tid) {
    for (int i = tid; i < 8192; i += NTHR) { const int k = i >> 3, j = i & 7; wgt[j * 1024 + k] = win_l[(size_t)k * DIN + 1536 + j]; }
}
DI f32x4 ld4bf(const char* p) { const u32x2 w = *(const u32x2*)p; return (f32x4){bflo(w.x), bfhi(w.x), bflo(w.y), bfhi(w.y)}; }
DI void st4bf(char* p, const f32x4& v) { u32x2 w; w.x = pk2(v.x, v.y); w.y = pk2(v.z, v.w); *(u32x2*)p = w; }

struct Args { const float* in[N_IN]; float* out; unsigned char* ws; int ph_lo, ph_hi; };
constexpr int NP_LAYER = 12, NPH = 1 + DEPTH * NP_LAYER;
constexpr int XW_SPLIT = 49152;

struct SchedInproj {
    pg8::TileOrder T; int G, c; const char *X, *W; char* U; bool kv; const char *MEMN, *WKV; char* KV;
    DI bool next(int i, pg8::Unit& u) const {
        const long L = (long)i * G + c; int pm, pn;
        if (T.tile(L, pm, pn)) { u.a = X + (size_t)pm * 256 * D * 2; u.b = W + (size_t)pn * 256 * D * 2; u.r0 = pm * 256; u.c0 = pn * 256; u.c = U + ((size_t)u.r0 * NU + u.c0) * 2; u.ldc = NU; u.e = 0; u.sub = 0; return true; }
        if (!kv) return false;
        const long L2 = L - T.nwg; if (L2 < 0 || L2 >= 128) return false;
        const int l = (int)L2 >> 6, t = (int)L2 & 63; pm = t >> 2; pn = t & 3;
        u.a = MEMN + (size_t)pm * 256 * D * 2; u.b = WKV + ((size_t)l * 1024 + pn * 256) * D * 2; u.r0 = pm * 256; u.c0 = pn * 256; u.c = KV + (((size_t)l * MROWS + u.r0) * D + u.c0) * 2; u.ldc = D; u.e = 0; u.sub = 0; return true;
    }
};
struct SchedPlain {
    pg8::TileOrder T; int G, c; const char *A, *B; char* C; int lda, ldb, ldc;
    DI bool next(int i, pg8::Unit& u) const {
        const long L = (long)i * G + c; int pm, pn; if (!T.tile(L, pm, pn)) return false;
        u.a = A + (size_t)pm * 256 * lda * 2; u.b = B + (size_t)pn * 256 * ldb * 2; u.r0 = pm * 256; u.c0 = pn * 256; u.c = C + ((size_t)u.r0 * ldc + u.c0) * 2; u.ldc = ldc; u.e = 0; u.sub = 0; return true;
    }
};
struct SchedMerge {
    pg8::TileOrder T; int G, c; const char *H, *W; char* Y;
    DI bool next(int i, pg8::Unit& u) const {
        const int ti = i / 3, br = i - 3 * ti; const long L = (long)ti * G + c; int pm, pn; if (!T.tile(L, pm, pn)) return false;
        u.a = H + ((size_t)pm * 256 * 1536 + br * 512) * 2; u.b = W + ((size_t)br * 1024 + pn * 256) * 512 * 2; u.r0 = pm * 256; u.c0 = pn * 256; u.c = Y + ((size_t)u.r0 * D + u.c0) * 2; u.ldc = D; u.e = 0; u.sub = br; return true;
    }
};
struct SchedMoe {
    pg8::TileOrder T; int G, c; const char *A, *W; char* C; const LAS int* PB; int wrows  , ldc, cdiv, osz;
    DI bool next(int i, pg8::Unit& u) const {
        const long L = (long)i * G + c; int pm, pn; if (!T.tile(L, pm, pn)) return false;
        int e = 0;
#pragma unroll 1
        for (int j = 1; j < NEXP; ++j) e += (PB[j] <= pm) ? 1 : 0;
        u.a = A + (size_t)pm * 256 * 1024; u.b = W + ((size_t)e * wrows + pn * 256) * 1024; u.r0 = pm * 256; u.c0 = pn * 256; u.c = C + ((size_t)u.r0 * ldc + u.c0 / cdiv) * osz; u.ldc = ldc; u.e = e; u.sub = 0; return true;
    }
};

__global__ void __launch_bounds__(NTHR, 2) fwd_kernel(Args args) {
    extern __shared__ __attribute__((aligned(16))) unsigned char lds_raw[];
#define INP(i) ([&]() -> const float* { int ii_ = (i); asm volatile("" : "+s"(ii_)); return args.in[ii_]; }())
    LAS unsigned char* lds = (LAS unsigned char*)lds_raw;
    volatile LAS unsigned* LCTL = (volatile LAS unsigned*)(lds + LDSCTL_OFF);
    const int tid0 = threadIdx.x, wave = __builtin_amdgcn_readfirstlane(tid0 >> 6);
#define PHASE_TID unsigned z_ = 0u; asm volatile("" : "+v"(z_)); int tid = wave * 64 + (int)__builtin_amdgcn_mbcnt_hi(~0u, __builtin_amdgcn_mbcnt_lo(~0u, z_)); const int lane = tid & 63; (void)lane;
    const int G = gridDim.x, bx = blockIdx.x;
    const int gw = bx * NWAVES + wave, NGW = G * NWAVES;
    unsigned char* ws = args.ws;
    gu32* ctl = (gu32*)(ws + WS_CTL);
    for (int u = tid0; u < (LDS_BYTES - LDSCTL_OFF) / 4; u += NTHR) ((LAS unsigned*)(lds + LDSCTL_OFF))[u] = 0u;
    __syncthreads();
    XcdBarrier bar; bar.bar = (unsigned*)ctl + CW_BAR; bar.x = 0; bar.st = nullptr;
    if (MK_ONE_LAUNCH) bar = xcd_barrier_post((unsigned*)ctl + CW_BAR, LCTL);
    const int lo = args.ph_lo, hi = args.ph_hi;
#ifndef SUBMASK
#define SUBMASK 7
#endif
#ifndef LN2PROBE
#define LN2PROBE 0
#endif
#ifndef SUBDUP
#define SUBDUP 0
#endif
#define NSUB(k) ((((SUBDUP) >> (k)) & 1) ? 2 : 1)
#ifndef DUPMASK
#define DUPMASK 0
#endif
#define NREP(k) ((((DUPMASK) >> (k)) & 1) ? 2 : 1)
#ifndef PHMASK
#define PHMASK 0xFFFF
#endif
#define IN(k) (lo <= (k) && (k) < hi)
#define SEAM(k) do { if (IN(k) && IN((k) + 1)) xcd_barrier(bar); } while (0)

    char* const Xb = (char*)(ws + WS_X);
    char* const Ub = (char*)(ws + WS_R1);
    float* const GIF = (float*)(ws + WS_GIF);
    LAS int* const PB = (LAS int*)(lds + LDSCTL_OFF + 64);
    LAS int* const CNT = (LAS int*)(lds + LDSCTL_OFF + 256);

    _Pragma("unroll 1") for (int rep_ = 0; rep_ < NREP(12); ++rep_) if (((PHMASK>>12)&1) && IN(0)) { PHASE_TID
        LAS float* scr = (LAS float*)(lds + wave * 8448);
        LAS float* wgt = (LAS float*)(lds + 73728);
        load_gate_table(wgt, INP(I_WIN), tid);
        constexpr int IT_IN = 16 * 216, IT_KV = 16 * 32, IT_BR = 8 * 32, IT_O = 16 * 32, IT_L = IT_IN + IT_KV + 3 * IT_BR + IT_O;
        for (int it = gw; it < DEPTH * IT_L; it += NGW) {
            const int l = it / IT_L; int r = it - l * IT_L;
            if (r < IT_IN) { const int kb = r / 216, nb = r % 216, n0 = 32 * nb, sc = ucol_src(n0);
                if (n0 < UC_F8) transpose_item(INP(I_WIN) + ((size_t)l * D + 64 * kb) * DIN + sc, DIN, (bf16*)(ws + WS_WIN) + ((size_t)l * NU + n0) * D + 64 * kb, D, scr, lane);
                else transpose_item_f8(INP(I_WIN) + ((size_t)l * D + 64 * kb) * DIN + sc, DIN, (unsigned char*)(ws + WS_WING8) + ((size_t)l * NF8 + (n0 - UC_F8)) * D + 64 * kb, D, F8_SWGU, scr, lane);
                continue; }
            r -= IT_IN;
            if (r < IT_KV) { const int kb = r / 32, nb = r % 32;
                transpose_item(INP(I_CAWKV) + ((size_t)l * D + 64 * kb) * 1024 + 32 * nb, 1024, (bf16*)(ws + WS_WKV) + ((size_t)l * 1024 + 32 * nb) * D + 64 * kb, D, scr, lane); continue; }
            r -= IT_KV;
            if (r < 3 * IT_BR) { const int br = r / IT_BR, q = r % IT_BR, kb = q / 32, nb = q % 32;
                const float* src = INP(br == 0 ? I_WBRML : (br == 1 ? I_WBRRW : I_WBRCA));
                transpose_item(src + ((size_t)l * 512 + 64 * kb) * 1024 + 32 * nb, 1024, (bf16*)(ws + WS_WBR) + ((size_t)l * 1024 + 32 * nb) * 1536 + br * 512 + 64 * kb, 1536, scr, lane); continue; }
            r -= 3 * IT_BR;
            { const int kb = r / 32, nb = r % 32;
                transpose_item(INP(I_WO) + ((size_t)l * D + 64 * kb) * 1024 + 32 * nb, 1024, (bf16*)(ws + WS_WO) + ((size_t)l * 1024 + 32 * nb) * D + 64 * kb, D, scr, lane); }
        }
        for (int i = bx * NTHR + tid; i < DEPTH * 1536 * 256; i += G * NTHR) {
            const int l = i / (1536 * 256), r = i % (1536 * 256), n = r >> 8, k = r & 255; float v = 0.f;
            if (n < 512) { if (k < 64) v = INP(I_RWWUP)[((size_t)l * 64 + k) * 512 + n]; }
            else if (n < 1024) { if (k >= 64 && k < 128) v = INP(I_RWAUP)[((size_t)l * 64 + (k - 64)) * 512 + (n - 512)]; }
            else { if (k >= 128) v = INP(I_RWGUP)[((size_t)l * 128 + (k - 128)) * 512 + (n - 1024)]; }
            ((bf16*)(ws + WS_WLORA))[i] = (bf16)f2bf(v);
        }
        __syncthreads();
        {
            f32x4 g[4], b[4];
#pragma unroll
            for (int j = 0; j < 4; ++j) { g[j] = *(const f32x4*)(INP(I_LNIN_G) + 256 * j + 4 * lane); b[j] = *(const f32x4*)(INP(I_LNIN_B) + 256 * j + 4 * lane); }
            for (int m = gw; m < M; m += NGW) {
                f32x4 v[4]; const float* xr = INP(I_X) + (size_t)m * D;
#pragma unroll
                for (int j = 0; j < 4; ++j) v[j] = *(const f32x4*)(xr + 256 * j + 4 * lane);
                ln16(v, g, b);
#pragma unroll
                for (int j = 0; j < 4; ++j) { st4bf(Xb + ((size_t)m * D + 256 * j + 4 * lane) * 2, v[j]); *(unsigned*)((char*)(ws + WS_XF8) + (size_t)m * D + 256 * j + 4 * lane) = pk4_f8(v[j].x * F8_SX, v[j].y * F8_SX, v[j].z * F8_SX, v[j].w * F8_SX); }
                gates8(v, wgt, GIF + (size_t)m * 8, lane);
            }
#pragma unroll
            for (int j = 0; j < 4; ++j) { g[j] = *(const f32x4*)(INP(I_MEMLN_G) + 256 * j + 4 * lane); b[j] = *(const f32x4*)(INP(I_MEMLN_B) + 256 * j + 4 * lane); }
            for (int m = gw; m < MROWS; m += NGW) {
                f32x4 v[4]; const float* xr = INP(I_MEM) + (size_t)m * D;
#pragma unroll
                for (int j = 0; j < 4; ++j) v[j] = *(const f32x4*)(xr + 256 * j + 4 * lane);
                ln16(v, g, b);
#pragma unroll
                for (int j = 0; j < 4; ++j) st4bf((char*)(ws + WS_MEMN) + ((size_t)m * D + 256 * j + 4 * lane) * 2, v[j]);
            }
        }
        __syncthreads();
    }
    SEAM(0);

#pragma unroll 1
    for (int l = 0; l < DEPTH; ++l) {
        const int pb = 1 + l * NP_LAYER;
        _Pragma("unroll 1") for (int rep_ = 0; rep_ < NREP(0); ++rep_) if (((PHMASK>>0)&1) && IN(pb + 0)) {
            SchedInproj S; S.T.init(M / 256, UC_F8 / 256); S.G = G; S.c = bx; S.X = Xb; S.W = (const char*)(ws + WS_WIN) + (size_t)l * NU * D * 2; S.U = Ub;
            S.kv = (l == 0); S.MEMN = (const char*)(ws + WS_MEMN); S.WKV = (const char*)(ws + WS_WKV); S.KV = (char*)(ws + WS_KV);
            pg8::EpiStore E;
            pg8::gemm_phase<false>(lds, D * 2, D * 2, D * 2, S, E, wave);
            SchedPlain S8; S8.T.init(M / 256, NF8 / 256); S8.G = G; S8.c = bx; S8.A = (const char*)(ws + WS_XF8); S8.B = (const char*)(ws + WS_WING8) + (size_t)l * NF8 * D; S8.C = Ub + UC_F8 * 2;
            S8.lda = 512; S8.ldb = 512; S8.ldc = NU;
            pg8::EpiStoreS E8; E8.s = F8_INV1; E8.gate_b = INP(I_GATEB) + (size_t)l * 3072; E8.gate_c0 = UC_GATE - UC_F8;
            pg8::gemm_phase<true>(lds, D, D, D, S8, E8, wave);
        }
        SEAM(pb + 0);
        _Pragma("unroll 1") for (int rep_ = 0; rep_ < NREP(1); ++rep_) if (((PHMASK>>1)&1) && IN(pb + 1)) { PHASE_TID
            const float* mu = INP(I_RWMU) + (size_t)l * 1792 + 1536;
            char* LIN = (char*)(ws + WS_R2 + R2_LORA_IN);
            for (int it = bx * NTHR + tid; it < M * 32; it += G * NTHR) {
                const int row = it >> 5, c = (it & 31) * 8;
                const u32x4 cw = *(const u32x4*)(Ub + ((size_t)row * NU + UC_RW + 1536 + c) * 2);
                u32x4 pw = (u32x4){0u, 0u, 0u, 0u};
                if ((row & (SEQ - 1)) != 0) pw = *(const u32x4*)(Ub + ((size_t)(row - 1) * NU + UC_RW + 1536 + c) * 2);
                const f32x4 m0 = *(const f32x4*)(mu + c), m1 = *(const f32x4*)(mu + c + 4);
                float x[8] = {bflo(cw.x), bfhi(cw.x), bflo(cw.y), bfhi(cw.y), bflo(cw.z), bfhi(cw.z), bflo(cw.w), bfhi(cw.w)};
                const float p[8] = {bflo(pw.x), bfhi(pw.x), bflo(pw.y), bfhi(pw.y), bflo(pw.z), bfhi(pw.z), bflo(pw.w), bfhi(pw.w)};
                const float mm[8] = {m0.x, m0.y, m0.z, m0.w, m1.x, m1.y, m1.z, m1.w};
#pragma unroll
                for (int i = 0; i < 8; ++i) { float xs = x[i] + (p[i] - x[i]) * mm[i];
                    if (c < 64) xs = 1.f - 2.f * __builtin_amdgcn_rcpf(1.f + __builtin_amdgcn_exp2f(2.8853900817779268f * xs));
                    else if (c >= 128) xs = sigmoidf_(xs);
                    x[i] = xs; }
                u32x4 o; o.x = pk2(x[0], x[1]); o.y = pk2(x[2], x[3]); o.z = pk2(x[4], x[5]); o.w = pk2(x[6], x[7]);
                *(u32x4*)(LIN + ((size_t)row * 256 + c) * 2) = o;
            }
        }
        SEAM(pb + 1);
        _Pragma("unroll 1") for (int rep_ = 0; rep_ < NREP(2); ++rep_) if (((PHMASK>>2)&1) && IN(pb + 2)) {
            SchedPlain S; S.T.init(M / 256, 6); S.G = G; S.c = bx; S.A = (const char*)(ws + WS_R2 + R2_LORA_IN); S.B = (const char*)(ws + WS_WLORA) + (size_t)l * 1536 * 256 * 2; S.C = (char*)(ws + WS_R2 + R2_LORA_OUT);
            S.lda = 256; S.ldb = 256; S.ldc = 1536;
            pg8::EpiStore E;
            pg8::gemm_phase<false>(lds, 512, 512, 512, S, E, wave);
        }
        SEAM(pb + 2);
        _Pragma("unroll 1") for (int rep_ = 0; rep_ < NREP(3); ++rep_) if (((PHMASK>>3)&1) && IN(pb + 3)) { PHASE_TID
            const char* LO = (const char*)(ws + WS_R2 + R2_LORA_OUT);
            char* HC = (char*)(ws + WS_R2 + R2_HCAT);
            const int tid_ph = tid;
#define SUB_TID unsigned zs_ = 0u; asm volatile("" : "+v"(zs_)); int tid = wave * 64 + (int)__builtin_amdgcn_mbcnt_hi(~0u, __builtin_amdgcn_mbcnt_lo(~0u, zs_)); const int lane = tid & 63; (void)lane;
#pragma unroll 1
            for (int job = bx; job < 256; job += G) {
                if (job < 128) { _Pragma("unroll 1") for (int sr_ = 0; sr_ < NSUB(0); ++sr_) if ((SUBMASK>>0)&1) {
                    SUB_TID
                    const int b = job >> 3, h = job & 7;
                    constexpr int TC = 32, PT = 144, P16 = 48, IMG = 25856;
                    LAS float* OPS = (LAS float*)lds;
                    LAS float* OUTB = OPS + TC * 384;
                    LAS float* BON = OUTB + TC * 64;
                    LAS unsigned char* IM0 = lds + 57600;
                    LAS float* VEP = (LAS float*)(lds + 109312);
                    LAS unsigned char* GKB = (LAS unsigned char*)(VEP + 2 * TC * 64);
                    LAS float* PARF = (LAS float*)(lds + 142080);
                    const int pt = tid >> 4, cs = tid & 15, pc = cs * 4, hc = h * 64 + pc;
                    const int p1t = (tid >> 3) & 31, c8 = (tid & 7) * 8, hc8 = h * 64 + c8;
                    const int r31 = lane & 31, h2 = lane >> 5;
                    f32x16 Sreg[2];
#pragma unroll
                    for (int i = 0; i < 16; ++i) { Sreg[0][i] = 0.f; Sreg[1][i] = 0.f; }
#pragma unroll 1
                    for (int a = wave; a < 10; a += 8) {
                        const int ii = (a < 3) ? I_RWMU : (a == 3) ? I_RWW0 : (a == 4) ? I_RWA0 : (a == 5) ? I_RWKK : (a == 6) ? I_RWKA : (a == 7) ? I_RWRK : (a == 8) ? I_RWLNG : I_RWLNB;
                        const size_t po = (a < 3) ? ((size_t)l * 1792 + a * 512) : (size_t)l * 512;
                        PARF[a * 64 + lane] = (INP(ii) + po)[h * 64 + lane];
                    }
#define SETPU(j, q_) do { const u32x4 q__ = (q_); Sreg[(j) >> 2][((j) & 3) * 4] = u2f_(q__.x); Sreg[(j) >> 2][((j) & 3) * 4 + 1] = u2f_(q__.y); \
                          Sreg[(j) >> 2][((j) & 3) * 4 + 2] = u2f_(q__.z); Sreg[(j) >> 2][((j) & 3) * 4 + 3] = u2f_(q__.w); } while (0)
#define PUW(j, c) f2u_(Pc[(j) >> 2][((j) & 3) * 4 + (c)])
#define PUWS(j, c) f2u_(Sreg[(j) >> 2][((j) & 3) * 4 + (c)])
#define UNPJ(j, hh) ((f32x4){bflo(PUW(j, 2 * (hh))), bfhi(PUW(j, 2 * (hh))), bflo(PUW(j, 2 * (hh) + 1)), bfhi(PUW(j, 2 * (hh) + 1))})
#define UNPH(q_, hh) ((hh) ? (f32x4){bflo((q_).z), bfhi((q_).z), bflo((q_).w), bfhi((q_).w)} : (f32x4){bflo((q_).x), bfhi((q_).x), bflo((q_).y), bfhi((q_).y)})
                    auto LOADC = [&](int t0) {
                        const int t = t0 + p1t; const size_t row = (size_t)b * SEQ + t; const char* up = Ub + (row * NU + UC_RW + hc8) * 2;
                        SETPU(0, *(const u32x4*)up); SETPU(1, *(const u32x4*)(up + 1024)); SETPU(2, *(const u32x4*)(up + 2048));
                        if (t > 0) { const char* pp = up - (size_t)NU * 2; SETPU(3, *(const u32x4*)pp); SETPU(4, *(const u32x4*)(pp + 1024)); SETPU(5, *(const u32x4*)(pp + 2048)); }
                        else { const u32x4 z4 = (u32x4){0u, 0u, 0u, 0u}; SETPU(3, z4); SETPU(4, z4); SETPU(5, z4); }
                        const char* lp = LO + (row * 1536 + hc8) * 2; SETPU(6, *(const u32x4*)lp); SETPU(7, *(const u32x4*)(lp + 1024));
                    };
                    const int gq = tid - 128, gt = (gq >> 2) & 31, gp = (gq & 3) * 16;
                    auto LOADG = [&](int t0) {
                        const char* gp_ = LO + (((size_t)b * SEQ + t0 + gt) * 1536 + 1024 + h * 64 + gp) * 2;
                        SETPU(0, *(const u32x4*)gp_); SETPU(1, *(const u32x4*)(gp_ + 16));
                    };
                    auto PASS1 = [&](int t1, int par1, bool more) {
                        int hcv = hc8; asm volatile("" : "+v"(hcv));
                        const f32x16 Pc[2] = {Sreg[0], Sreg[1]};
                        if (more) LOADC(t1 + TC);
                        const LAS float* MU = PARF + c8;
                        const LAS float* W0 = PARF + 192 + c8; const LAS float* A0 = PARF + 256 + c8; const LAS float* KKW = PARF + 320 + c8;
                        const LAS float* KAW = PARF + 384 + c8; const LAS float* RKW = PARF + 448 + c8;
                        f32x4 dec[2], av[2], kkv[2], kp[2], xr[2], xv[2]; float ss = 0.f, bsum = 0.f;
#pragma unroll
                        for (int hh = 0; hh < 2; ++hh) {
                            const f32x4 mu_r = *(const LAS f32x4*)(MU + 4 * hh), mu_k = *(const LAS f32x4*)(MU + 64 + 4 * hh), mu_v = *(const LAS f32x4*)(MU + 128 + 4 * hh);
                            const f32x4 w0 = *(const LAS f32x4*)(W0 + 4 * hh), a0 = *(const LAS f32x4*)(A0 + 4 * hh), kkw = *(const LAS f32x4*)(KKW + 4 * hh), kaw = *(const LAS f32x4*)(KAW + 4 * hh), rkw = *(const LAS f32x4*)(RKW + 4 * hh);
                            const f32x4 ur = UNPJ(0, hh), uk = UNPJ(1, hh), uv = UNPJ(2, hh), urp = UNPJ(3, hh), ukp = UNPJ(4, hh), uvp = UNPJ(5, hh), lw = UNPJ(6, hh), la = UNPJ(7, hh);
                            xr[hh] = ur + (urp - ur) * mu_r; const f32x4 xk = uk + (ukp - uk) * mu_k; xv[hh] = uv + (uvp - uv) * mu_v;
#pragma unroll
                            for (int i = 0; i < 4; ++i) {
                                const float y = -(w0[i] + lw[i]);
                                const float sp = fmaxf(y, 0.f) + __logf(1.f + __expf(-fabsf(y)));
                                dec[hh][i] = __expf(-__expf(-sp - 0.5f));
                                av[hh][i] = sigmoidf_(a0[i] + la[i]);
                                kkv[hh][i] = xk[i] * kkw[i]; ss += kkv[hh][i] * kkv[hh][i];
                                kp[hh][i] = xk[i] * (1.f + (av[hh][i] - 1.f) * kaw[i]);
                                bsum += xr[hh][i] * kp[hh][i] * rkw[i];
                            }
                            __builtin_amdgcn_sched_barrier(0);
                        }
                        ss = red8(ss); bsum = red8(bsum);
                        const float inv = __builtin_amdgcn_rsqf(fmaxf(ss, 1e-24f));
#pragma unroll
                        for (int hh = 0; hh < 2; ++hh) {
                            const f32x4 kk = kkv[hh] * inv, kka = kk * av[hh];
                            LAS float* o = OPS + p1t * 384 + c8 + 4 * hh;
                            *(LAS f32x4*)(o) = dec[hh]; *(LAS f32x4*)(o + 64) = kk; *(LAS f32x4*)(o + 128) = kka; *(LAS f32x4*)(o + 192) = kp[hh]; *(LAS f32x4*)(o + 256) = xr[hh]; *(LAS f32x4*)(o + 320) = xv[hh];
                            *(LAS f32x4*)(VEP + par1 * 2048 + p1t * 64 + c8 + 4 * hh) = xv[hh];
                        }
                        if ((tid & 7) == 0) BON[par1 * 32 + p1t] = bsum;
                    };
#define UNP4(w) ((f32x4){bflo((w).x), bfhi((w).x), bflo((w).y), bfhi((w).y)})
#define DOT4(a, b) (((a).x * (b).x + (a).y * (b).y) + ((a).z * (b).z + (a).w * (b).w))
#define PACK8(x, s) __builtin_bit_cast(bf16x8, (u32x4){pk2((x)[8 * (s)], (x)[8 * (s) + 1]), pk2((x)[8 * (s) + 2], (x)[8 * (s) + 3]), pk2((x)[8 * (s) + 4], (x)[8 * (s) + 5]), pk2((x)[8 * (s) + 6], (x)[8 * (s) + 7])})
#define LD2x64(p) __builtin_bit_cast(bf16x8, (u32x4){(*(const LAS u32x2*)(p)).x, (*(const LAS u32x2*)(p)).y, (*(const LAS u32x2*)((p) + 16)).x, (*(const LAS u32x2*)((p) + 16)).y})
                    auto EPI = [&](int te, int pe) {
                        const int et = ((wave >> 2) * 2 + (wave & 1)) * 64 + lane, pce = (et & 15) * 4;
                        const f32x4 lng = *(const LAS f32x4*)(PARF + 512 + pce), lnb = *(const LAS f32x4*)(PARF + 576 + pce);
#pragma unroll
                        for (int it = 0; it < 2; ++it) {
                            const int pte = (et >> 4) + 16 * it;
                            const u32x2 gkw = *(const LAS u32x2*)(GKB + pe * 4096 + pte * 128 + pce * 2);
                            const f32x4 o4 = *(const LAS f32x4*)(OUTB + pte * 64 + pce), v4 = *(const LAS f32x4*)(VEP + pe * 2048 + pte * 64 + pce), gk = UNP4(gkw);
                            const float mean = red16((o4.x + o4.y) + (o4.z + o4.w)) * (1.f / 64.f);
                            const f32x4 dv = o4 - mean;
                            const float var = red16(DOT4(dv, dv)) * (1.f / 64.f);
                            const float rstd = __builtin_amdgcn_rsqf(var + RW_GN_EPS), bo = BON[pe * 32 + pte];
                            const f32x4 y = (dv * rstd * lng + lnb + v4 * bo) * gk;
                            st4bf(HC + (((size_t)b * SEQ + te + pte) * 1536 + 512 + h * 64 + pce) * 2, y);
                        }
                    };
                    if (wave >= 4) LOADC(0); else if (wave >= 2) LOADG(0);
#pragma unroll 1
                    for (int t0 = -TC; t0 < SEQ; t0 += TC) {
                        const int par = (t0 >> 5) & 1;
                        __syncthreads();
                        if (t0 >= 0)
                        {
                            const int sc = wave >> 2, wq = wave & 3;
                            LAS unsigned char* im = IM0 + sc * IMG;
                            LAS unsigned char* KR = im; LAS unsigned char* BGr = im + 4608; LAS unsigned char* VT = im + 15360;
                            LAS unsigned char* TT = im + 18432; LAS unsigned char* BB = im + 19968; LAS float* ZF = (LAS float*)(im + 21504); LAS float* PL = (LAS float*)(im + 25600);
                            {
                                float P = 1.f;
#pragma unroll
                                for (int t = 0; t < 12; ++t) { const float wv = OPS[(16 * sc + t) * 384 + lane]; P *= (t < 4 * wq) ? wv : 1.f; }
#pragma unroll
                                for (int q = 0; q < 4; ++q) { const int t = 4 * wq + q; const LAS float* o = OPS + (16 * sc + t) * 384 + lane;
                                    const float w = o[0], z = o[64], bb = o[128], kp = o[192], rr = o[256], vv = o[320];
                                    const float kap = z * P; P *= w; const float rho = rr * P, ip = __builtin_amdgcn_rcpf(P), bet = bb * ip, gam = kp * ip;
                                    *(LAS bf16*)(KR + t * PT + lane * 2) = (bf16)f2bf(kap); *(LAS bf16*)(KR + (16 + t) * PT + lane * 2) = (bf16)f2bf(rho);
                                    *(LAS bf16*)(BGr + t * PT + lane * 2) = (bf16)f2bf(bet); *(LAS bf16*)(BGr + (16 + t) * PT + lane * 2) = (bf16)f2bf(gam);
                                    *(LAS bf16*)(VT + t * PT + lane * 2) = (bf16)f2bf(vv); }
                                if (wq == 3) PL[lane] = P;
                            }
                            __syncthreads();
                            if (wq <= 1) {
                                f32x16 Z;
#pragma unroll
                                for (int i = 0; i < 16; ++i) Z[i] = 0.f;
#pragma unroll
                                for (int ks = 0; ks < 4; ++ks) Z = __builtin_amdgcn_mfma_f32_32x32x16_bf16(*(const LAS bf16x8*)(KR + r31 * PT + (16 * ks + 8 * h2) * 2), *(const LAS bf16x8*)(BGr + r31 * PT + (16 * ks + 8 * h2) * 2), Z, 0, 0, 0);
                                const int jj = (r31 & 15) - 4 * h2;
#pragma unroll
                                for (int i = 0; i < 16; ++i) { const int tb = (i & 3) + 8 * ((i >> 2) & 1); const bool keep = (i >= 8) ? (jj <= tb) : (jj < tb); Z[i] = keep ? Z[i] : 0.f; }
                              if (wq == 1) {
                                if (r31 >= 16) {
#pragma unroll
                                    for (int i = 0; i < 16; ++i) *(LAS bf16*)(BB + ((i & 3) + 8 * (i >> 2) + 4 * h2) * P16 + (r31 - 16) * 2) = (bf16)f2bf(Z[i]);
                                }
                              } else {
                                if (r31 < 16) {
#pragma unroll
                                    for (int i = 0; i < 16; ++i) ZF[((i & 3) + 8 * (i >> 2) + 4 * h2) * 32 + r31] = Z[i];
                                }
                                LDS_WAIT(); asm volatile("" ::: "memory");
                                const int c = lane & 15, g = lane >> 4; float x[16];
                                f32x4 R[16][4];
                                constexpr int TW = 5;
#pragma unroll
                                for (int t = 1; t <= TW; ++t)
#pragma unroll
                                    for (int k = 0; k < 4; ++k) if (4 * k < t) R[t][k] = *(const LAS f32x4*)(ZF + t * 32 + 4 * k);
                                __builtin_amdgcn_sched_barrier(0);
#pragma unroll
                                for (int t = 0; t < 16; ++t) {
                                    if (t >= 1 && t + TW < 16) {
#pragma unroll
                                        for (int k = 0; k < 4; ++k) if (4 * k < t + TW) R[t + TW][k] = *(const LAS f32x4*)(ZF + (t + TW) * 32 + 4 * k);
                                    }
                                    __builtin_amdgcn_sched_barrier(0);
                                    float s0 = 0.f, s1 = 0.f;
#pragma unroll
                                    for (int j = 0; j < t; ++j) { const float a = R[t][j >> 2][j & 3]; if (j & 1) s1 += a * x[j]; else s0 += a * x[j]; }
                                    x[t] = ((t == c) ? 1.f : 0.f) - (s0 + s1);
                                }
#pragma unroll
                                for (int j = 0; j < 16; ++j) *(LAS bf16*)(TT + j * P16 + c * 2) = (bf16)f2bf(-x[j]);
#pragma unroll
                                for (int qq = 0; qq < 4; qq += 2) {
                                    f32x4 a4[2][4];
#pragma unroll
                                    for (int q = 0; q < 2; ++q)
#pragma unroll
                                        for (int k = 0; k < 4; ++k) a4[q][k] = *(const LAS f32x4*)(ZF + (16 + 4 * g + qq + q) * 32 + 4 * k);
#pragma unroll
                                    for (int q = 0; q < 2; ++q) {
                                        const int tr = 4 * g + qq + q;
                                        float s0 = 0.f, s1 = 0.f;
#pragma unroll
                                        for (int j = 0; j < 16; ++j) { const float a = a4[q][j >> 2][j & 3]; if (j & 1) s1 += a * x[j]; else s0 += a * x[j]; }
                                        *(LAS bf16*)(TT + (16 + tr) * P16 + c * 2) = (bf16)f2bf(-(s0 + s1));
                                    }
                                }
                              }
                            } else if (t0 >= TC) EPI(t0 - TC, par ^ 1);
                        }
                        __syncthreads();
                        if (wave >= 4) { if (t0 + TC < SEQ) PASS1(t0 + TC, par ^ 1, t0 + 2 * TC < SEQ); }
                        else if (wave >= 2) { if (t0 + TC < SEQ) {
                            LAS unsigned char* gd = GKB + (par ^ 1) * 4096 + gt * 128 + gp * 2;
                            *(LAS u32x4*)gd = (u32x4){PUWS(0, 0), PUWS(0, 1), PUWS(0, 2), PUWS(0, 3)}; *(LAS u32x4*)(gd + 16) = (u32x4){PUWS(1, 0), PUWS(1, 1), PUWS(1, 2), PUWS(1, 3)};
                            if (t0 + 2 * TC < SEQ) LOADG(t0 + 2 * TC); } }
                        else if (wave < 2 && t0 >= 0) {
#pragma unroll 1
                            for (int sc = 0; sc < 2; ++sc) {
                                const LAS unsigned char* im = IM0 + sc * IMG;
                                const LAS unsigned char* KR = im; const LAS unsigned char* BT = im + 9216; const LAS unsigned char* GT = im + 12288; const LAS unsigned char* VT = im + 15360;
                                const LAS unsigned char* TT = im + 18432; const LAS unsigned char* BB = im + 19968; const LAS float* PL = (const LAS float*)(im + 25600);
                                const LAS unsigned char* BGr = im + 4608;
                                const bf16x8 vfr = trd8(VT, PT, 8 * h2, 8 * h2 + 4, 32 * wave, lane);
                                f32x16 t1;
#pragma unroll
                                for (int i = 0; i < 16; ++i) t1[i] = 0.f;
                                t1 = __builtin_amdgcn_mfma_f32_32x32x16_bf16(*(const LAS bf16x8*)(BB + r31 * P16 + 8 * h2 * 2), vfr, t1, 0, 0, 0);
#pragma unroll
                                for (int kb = 0; kb < 2; ++kb)
#pragma unroll
                                    for (int s = 0; s < 2; ++s) t1 = __builtin_amdgcn_mfma_f32_32x32x16_bf16(LD2x64(KR + r31 * PT + (32 * kb + 16 * s + 4 * h2) * 2), PACK8(Sreg[kb], s), t1, 0, 0, 0);
                                f32x16 t2;
#pragma unroll
                                for (int i = 0; i < 16; ++i) t2[i] = 0.f;
                                t2 = __builtin_amdgcn_mfma_f32_32x32x16_bf16(LD2x64(TT + r31 * P16 + (4 * h2) * 2), PACK8(t1, 0), t2, 0, 0, 0);
#pragma unroll
                                for (int i = 8; i < 16; ++i) OUTB[(16 * sc + (i & 3) + 8 * ((i >> 2) - 2) + 4 * h2) * 64 + 32 * wave + r31] = t2[i] + t1[i];
                                const bf16x8 uq = PACK8(t2, 0);
#pragma unroll
                                for (int kb = 0; kb < 2; ++kb) {
                                    f32x16 a = Sreg[kb];
                                    a = __builtin_amdgcn_mfma_f32_32x32x16_bf16(trd8(BGr, PT, 4 * h2, 8 + 4 * h2, 32 * kb, lane), uq, a, 0, 0, 0);
                                    a = __builtin_amdgcn_mfma_f32_32x32x16_bf16(trd8(BGr, PT, 16 + 8 * h2, 20 + 8 * h2, 32 * kb, lane), vfr, a, 0, 0, 0);
#pragma unroll
                                    for (int g4 = 0; g4 < 4; ++g4) { const f32x4 p4 = *(const LAS f32x4*)(PL + 32 * kb + 8 * g4 + 4 * h2);
                                        a[4 * g4] *= p4.x; a[4 * g4 + 1] *= p4.y; a[4 * g4 + 2] *= p4.z; a[4 * g4 + 3] *= p4.w; }
                                    Sreg[kb] = a;
                                }
                            }
                        }
                    }
                    __syncthreads();
                    if ((wave & 3) >= 2) EPI(SEQ - TC, ((SEQ - TC) >> 5) & 1);
                    __syncthreads();
#undef UNPH
#undef UNPJ
#undef PUW
#undef PUWS
#undef SETPU
#undef PACK8
#undef LD2x64
                } } else {
                    const int idx = job - 128, bh = idx >> 1, half = idx & 1, b = bh >> 2, h = bh & 3;
                    unsigned zl_ = 0u; asm volatile("" : "+v"(zl_)); const int lane_ml = (int)__builtin_amdgcn_mbcnt_hi(~0u, __builtin_amdgcn_mbcnt_lo(~0u, zl_));
                    _Pragma("unroll 1") for (int sr_ = 0; sr_ < NSUB(1); ++sr_) if (((SUBMASK>>1)&1) && idx < 64) {
                        SUB_TID
                        const int bm = idx >> 2, hm = idx & 3;
                        constexpr int PT = 144;
                        LAS unsigned char* QI = lds;
                        LAS unsigned char* KI = QI + 64 * PT;
                        constexpr int PV = 272;
                        LAS unsigned char* KW = KI + 64 * PT;
                        LAS unsigned char* VT = KW + 64 * PT;
                        LAS unsigned char* CI = VT + 64 * PV;
                        LAS float* AS = (LAS float*)(CI + 128 * PT);
                        LAS float* MX = AS + 64; LAS float* SI = AS + 128; LAS float* EM = AS + 192; LAS float* WG = AS + 256; LAS float* NN = AS + 320; LAS float* CR = AS + 384; LAS float* ST = AS + 448;
                        for (int i = tid; i < 128 * PT / 4; i += NTHR) ((LAS unsigned*)CI)[i] = 0u;
                        if (tid < 64) NN[tid] = 0.f;
                        const int pt = tid >> 4, cg = tid & 15;
                        const int ccol = (cg < 8) ? (hm * 64 + 8 * cg) : (256 + hm * 64 + 8 * (cg - 8));
                        const float qsc = (cg < 8) ? 0.125f : 1.f;
                        const float igb = INP(I_IGB)[l * 4 + hm], fgb = INP(I_FGB)[l * 4 + hm];
                        const int r31 = lane & 31, h2 = lane >> 5, vb = wave >> 1, tb = wave & 1;
                        f32x16 accC;
#pragma unroll
                        for (int i = 0; i < 16; ++i) accC[i] = 0.f;
                        float nreg = 0.f, mprev = 0.f;
                        u32x4 cu[2][4], vu[2]; float gi = 0.f, gf = 0.f;
                        auto LOADM = [&](int t0) {
#pragma unroll
                            for (int tt = 0; tt < 2; ++tt) { const int t = t0 + pt + 32 * tt; const size_t row = (size_t)bm * SEQ + t;
#pragma unroll
                                for (int j = 0; j < 4; ++j) { if (t - 3 + j >= 0) cu[tt][j] = *(const u32x4*)(Ub + ((row - 3 + j) * NU + UC_QK + ccol) * 2); else cu[tt][j] = (u32x4){0u, 0u, 0u, 0u}; }
                                const int p = tid + 512 * tt; vu[tt] = *(const u32x4*)(Ub + (((size_t)bm * SEQ + t0 + (p >> 4)) * NU + UC_V + hm * 128 + 8 * (p & 15)) * 2); }
                            if (wave == 0) { const size_t rg = (size_t)bm * SEQ + t0 + lane; gi = GIF[rg * 8 + hm]; gf = GIF[rg * 8 + 4 + hm]; }
                        };
                        LOADM(0);
                        __syncthreads();
#pragma unroll 1
                        for (int t0 = 0; t0 < SEQ; t0 += 64) {
                            int ccv = ccol; asm volatile("" : "+v"(ccv));
                            float cw[4][8], cb[8];
#pragma unroll
                        for (int j = 0; j < 4; ++j) { const f32x4 a = *(const f32x4*)(INP(I_CONVW) + ((size_t)l * 4 + j) * 512 + ccv), c2 = *(const f32x4*)(INP(I_CONVW) + ((size_t)l * 4 + j) * 512 + ccv + 4);
                            cw[j][0] = a.x; cw[j][1] = a.y; cw[j][2] = a.z; cw[j][3] = a.w; cw[j][4] = c2.x; cw[j][5] = c2.y; cw[j][6] = c2.z; cw[j][7] = c2.w; }
                        { const f32x4 a = *(const f32x4*)(INP(I_CONVB) + l * 512 + ccv), c2 = *(const f32x4*)(INP(I_CONVB) + l * 512 + ccv + 4);
                            cb[0] = a.x; cb[1] = a.y; cb[2] = a.z; cb[3] = a.w; cb[4] = c2.x; cb[5] = c2.y; cb[6] = c2.z; cb[7] = c2.w; }
                            float yq[2][8];
#pragma unroll
                            for (int tt = 0; tt < 2; ++tt) {
#pragma unroll
                                for (int i = 0; i < 8; ++i) yq[tt][i] = cb[i];
#pragma unroll
                                for (int j = 0; j < 4; ++j) { const u32x4 w = cu[tt][j]; const float x[8] = {bflo(w.x), bfhi(w.x), bflo(w.y), bfhi(w.y), bflo(w.z), bfhi(w.z), bflo(w.w), bfhi(w.w)};
#pragma unroll
                                    for (int i = 0; i < 8; ++i) yq[tt][i] += cw[j][i] * x[i]; }
#pragma unroll
                                for (int i = 0; i < 8; ++i) yq[tt][i] = yq[tt][i] * sigmoidf_(yq[tt][i]) * qsc;
                            }
                            const u32x4 vreg0 = vu[0], vreg1 = vu[1];
                            if (wave == 0) {
                                const float ig = gi + igb, fp = gf + fgb;
                                const float lf = -(fmaxf(-fp, 0.f) + __logf(1.f + __expf(-fabsf(fp))));
                                const float bc = scan_add64(lf);
                                const float as = ig - bc, pm = scan_max64(as);
                                const float mxv = fmaxf(mprev, pm), mx63 = __builtin_bit_cast(float, __builtin_amdgcn_readlane(__builtin_bit_cast(int, mxv), 63)), bl = __builtin_bit_cast(float, __builtin_amdgcn_readlane(__builtin_bit_cast(int, bc), 63));
                                AS[lane] = as; MX[lane] = mxv; SI[lane] = __expf(mprev - mxv); EM[lane] = __expf(-(bc + mxv)); WG[lane] = __expf(as - mx63);
                                if (lane == 0) CR[0] = __expf(mprev - mx63);
                                mprev = bl + mx63;
                            }
                            if (t0 + 64 < SEQ) LOADM(t0 + 64);
                            __syncthreads();
#pragma unroll
                            for (int tt = 0; tt < 2; ++tt) { const int tok = pt + 32 * tt;
                                u32x4 pw; pw.x = pk2(yq[tt][0], yq[tt][1]); pw.y = pk2(yq[tt][2], yq[tt][3]); pw.z = pk2(yq[tt][4], yq[tt][5]); pw.w = pk2(yq[tt][6], yq[tt][7]);
                                if (cg < 8) *(LAS u32x4*)(QI + tok * PT + cg * 16) = pw;
                                else { *(LAS u32x4*)(KI + tok * PT + (cg - 8) * 16) = pw; const float wgs = WG[tok];
                                    u32x4 kw; kw.x = pk2(yq[tt][0] * wgs, yq[tt][1] * wgs); kw.y = pk2(yq[tt][2] * wgs, yq[tt][3] * wgs); kw.z = pk2(yq[tt][4] * wgs, yq[tt][5] * wgs); kw.w = pk2(yq[tt][6] * wgs, yq[tt][7] * wgs);
                                    *(LAS u32x4*)(KW + tok * PT + (cg - 8) * 16) = kw; }
                                const u32x4 vw = tt ? vreg1 : vreg0; const int p = tid + 512 * tt, vtok = p >> 4, v8 = p & 15;
                                *(LAS u32x4*)(VT + vtok * PV + v8 * 16) = vw;
                            }
                            __syncthreads();
                            float hv[16];
                            {
                                constexpr float L2E = 1.4426950408889634f;
                                const int t = 32 * tb + r31;
                                bf16x8 qf[4];
#pragma unroll
                                for (int ks = 0; ks < 4; ++ks) qf[ks] = *(const LAS bf16x8*)(QI + t * PT + (16 * ks + 8 * h2) * 2);
                                const float mx = MX[t], si = SI[t], em = EM[t];
                                f32x16 O, I; float denI = 0.f;
#pragma unroll
                                for (int i = 0; i < 16; ++i) { O[i] = 0.f; I[i] = 0.f; }
#pragma unroll
                                for (int sb = 0; sb < 2; ++sb) if (sb <= tb) {
                                    f32x16 X;
#pragma unroll
                                    for (int i = 0; i < 16; ++i) X[i] = 0.f;
#pragma unroll
                                    for (int ks = 0; ks < 4; ++ks) { const bf16x8 kf = *(const LAS bf16x8*)(KI + (32 * sb + r31) * PT + (16 * ks + 8 * h2) * 2); X = __builtin_amdgcn_mfma_f32_32x32x16_bf16(kf, qf[ks], X, 0, 0, 0); }
#pragma unroll
                                    for (int g4 = 0; g4 < 4; ++g4) { const f32x4 a4 = *(const LAS f32x4*)(AS + 32 * sb + 8 * g4 + 4 * h2);
#pragma unroll
                                        for (int j = 0; j < 4; ++j) { const int s = 32 * sb + 8 * g4 + 4 * h2 + j; const float w = (s <= t) ? __builtin_amdgcn_exp2f((a4[j] - mx) * L2E) * X[4 * g4 + j] : 0.f; X[4 * g4 + j] = w; denI += w; } }
#pragma unroll
                                    for (int st = 0; st < 2; ++st) {
                                        u32x4 pw; pw.x = pk2(X[8 * st], X[8 * st + 1]); pw.y = pk2(X[8 * st + 2], X[8 * st + 3]); pw.z = pk2(X[8 * st + 4], X[8 * st + 5]); pw.w = pk2(X[8 * st + 6], X[8 * st + 7]);
                                        O = __builtin_amdgcn_mfma_f32_32x32x16_bf16(trd8(VT, PV, 32 * sb + 16 * st + 4 * h2, 32 * sb + 16 * st + 8 + 4 * h2, 32 * vb, lane), __builtin_bit_cast(bf16x8, pw), O, 0, 0, 0);
                                    }
                                }
                                float nq = 0.f;
#pragma unroll
                                for (int ks = 0; ks < 4; ++ks) { const bf16x8 cf = *(const LAS bf16x8*)(CI + (32 * vb + r31) * PT + (16 * ks + 8 * h2) * 2); I = __builtin_amdgcn_mfma_f32_32x32x16_bf16(cf, qf[ks], I, 0, 0, 0);
                                    const f32x4 n0 = *(const LAS f32x4*)(NN + 16 * ks + 8 * h2), n1 = *(const LAS f32x4*)(NN + 16 * ks + 8 * h2 + 4); const u32x4 qw = __builtin_bit_cast(u32x4, qf[ks]);
                                    nq += (bflo(qw.x) * n0.x + bfhi(qw.x) * n0.y) + (bflo(qw.y) * n0.z + bfhi(qw.y) * n0.w) + (bflo(qw.z) * n1.x + bfhi(qw.z) * n1.y) + (bflo(qw.w) * n1.z + bfhi(qw.w) * n1.w); }
                                nq += __shfl_xor(nq, 32); denI += __shfl_xor(denI, 32);
                                const float den = si * nq + denI, rdn = 1.f / fmaxf(fabsf(den), em);
                                float hsum = 0.f;
#pragma unroll
                                for (int i = 0; i < 16; ++i) { hv[i] = (O[i] + si * I[i]) * rdn; hsum += hv[i]; }
                                hsum += __shfl_xor(hsum, 32);
                                const float hmean = hsum * (1.f / 32.f); float hm2 = 0.f;
#pragma unroll
                                for (int i = 0; i < 16; ++i) { const float dlt = hv[i] - hmean; hm2 += dlt * dlt; }
                                hm2 += __shfl_xor(hm2, 32);
                                if (h2 == 0) *(LAS f32x2*)(ST + ((tb * 4 + vb) * 32 + r31) * 2) = (f32x2){hmean, hm2};
                                const float carry = CR[0];
#pragma unroll
                                for (int i = 0; i < 16; ++i) accC[i] *= carry;
#pragma unroll
                                for (int st = 0; st < 4; ++st) { const bf16x8 va = trd8(VT, PV, 16 * st + 8 * h2, 16 * st + 8 * h2 + 4, 32 * vb, lane), kw = trd8(KW, PT, 16 * st + 8 * h2, 16 * st + 8 * h2 + 4, 32 * tb, lane);
                                    accC = __builtin_amdgcn_mfma_f32_32x32x16_bf16(va, kw, accC, 0, 0, 0); }
                            }
                            __syncthreads();
                            {
                                const int t = 32 * tb + r31;
                                f32x2 s4[4];
#pragma unroll
                                for (int q = 0; q < 4; ++q) s4[q] = *(const LAS f32x2*)(ST + ((tb * 4 + q) * 32 + r31) * 2);
                                const float mt = (s4[0].x + s4[1].x + s4[2].x + s4[3].x) * 0.25f;
                                float m2 = 0.f;
#pragma unroll
                                for (int q = 0; q < 4; ++q) { const float dm = s4[q].x - mt; m2 += s4[q].y + 32.f * dm * dm; }
                                const float rstd = __builtin_amdgcn_rsqf(m2 * (1.f / 128.f) + LN_EPS);
                                const size_t row = (size_t)bm * SEQ + t0 + t;
                                const char* ogp = Ub + (row * NU + UC_OG + hm * 128 + 32 * vb) * 2; char* op = HC + (row * 1536 + hm * 128 + 32 * vb) * 2;
                                const float* ngp = INP(I_MLNORMG) + l * 512 + hm * 128 + 32 * vb;
#pragma unroll
                                for (int g4 = 0; g4 < 4; ++g4) { const int vo = 8 * g4 + 4 * h2; const f32x4 og = ld4bf(ogp + vo * 2), ng = *(const f32x4*)(ngp + vo);
                                    f32x4 y; y.x = sigmoidf_(og.x) * ((hv[4 * g4] - mt) * rstd * ng.x); y.y = sigmoidf_(og.y) * ((hv[4 * g4 + 1] - mt) * rstd * ng.y); y.z = sigmoidf_(og.z) * ((hv[4 * g4 + 2] - mt) * rstd * ng.z); y.w = sigmoidf_(og.w) * ((hv[4 * g4 + 3] - mt) * rstd * ng.w);
                                    st4bf(op + vo * 2, y); }
                            }
#pragma unroll
                            for (int i = 0; i < 16; ++i) { const int v = 32 * vb + (i & 3) + 8 * (i >> 2) + 4 * h2; *(LAS bf16*)(CI + v * PT + (32 * tb + r31) * 2) = (bf16)f2bf(accC[i]); }
                            if (wave < 2) { float s = 0.f;
#pragma unroll
                                for (int q8 = 0; q8 < 8; ++q8) { const u32x2 w = trd4(KW, PT, 32 * h2 + 4 * q8, 32 * wave, lane); s += (bflo(w.x) + bfhi(w.x)) + (bflo(w.y) + bfhi(w.y)); }
                                s += __shfl_xor(s, 32);
                                nreg = CR[0] * nreg + s; if (h2 == 0) NN[32 * wave + r31] = nreg; }
                            __syncthreads();
                        }
                    }
                }
            }
            if (rep_ == 0) {
                LAS unsigned* XB = (LAS unsigned*)(lds + 153088);
                unsigned* xc = (unsigned*)ctl + CW_FILL + 32 + l * 64;
                __syncthreads();
                if (tid_ph == 0) XB[0] = __hip_atomic_fetch_add(xc, 1u, RLX_AGENT);
                __syncthreads();
                int xi = __builtin_amdgcn_readfirstlane((int)XB[0]);
#pragma unroll 1
                while (xi < 128) {
                    const int idx = xi, bh = idx >> 1, half = idx & 1, b = bh >> 2, h = bh & 3;
                    _Pragma("unroll 1") for (int sr_ = 0; sr_ < NSUB(2); ++sr_) if ((SUBMASK>>2)&1) {
                        SUB_TID
                        constexpr int KST = 272, VST = 520;
                        LAS unsigned char* KI = lds; LAS unsigned char* VI = lds + 256 * KST;
                        const char* kvb = (const char*)(ws + WS_KV) + (((size_t)l * MROWS + (size_t)b * MEML) * D) * 2;
                        for (int p = tid; p < 4096; p += NTHR) { const int key = p >> 4, c16 = p & 15;
                            *(LAS u32x4*)(KI + key * KST + c16 * 16) = *(const u32x4*)(kvb + ((size_t)key * D + h * 128 + c16 * 8) * 2); }
                        for (int p = tid; p < 4096; p += NTHR) { const int key = p & 255, d8 = p >> 8;
                            const u32x4 w = *(const u32x4*)(kvb + ((size_t)key * D + 512 + h * 128 + d8 * 8) * 2);
                            LAS unsigned char* o = VI + (d8 * 8) * VST + key * 2;
                            *(LAS bf16*)(o) = (bf16)(w.x & 0xffff); *(LAS bf16*)(o + VST) = (bf16)(w.x >> 16); *(LAS bf16*)(o + 2 * VST) = (bf16)(w.y & 0xffff); *(LAS bf16*)(o + 3 * VST) = (bf16)(w.y >> 16);
                            *(LAS bf16*)(o + 4 * VST) = (bf16)(w.z & 0xffff); *(LAS bf16*)(o + 5 * VST) = (bf16)(w.z >> 16); *(LAS bf16*)(o + 6 * VST) = (bf16)(w.w & 0xffff); *(LAS bf16*)(o + 7 * VST) = (bf16)(w.w >> 16); }
                        __syncthreads();
                        const int r31 = lane & 31, h2 = lane >> 5;
                        constexpr float SC = 0.08838834764831845f * 1.4426950408889634f;
#pragma unroll 1
                        for (int rd = 0; rd < 8; ++rd) {
                            const size_t qrow = (size_t)b * SEQ + half * 2048 + rd * 256 + wave * 32 + r31;
                            bf16x8 qf[8];
#pragma unroll
                            for (int ks = 0; ks < 8; ++ks) qf[ks] = *(const bf16x8*)(Ub + (qrow * NU + UC_CAQ + h * 128 + 16 * ks + 8 * h2) * 2);
                            f32x16 O[4];
#pragma unroll
                            for (int db = 0; db < 4; ++db)
#pragma unroll
                                for (int i = 0; i < 16; ++i) O[db][i] = 0.f;
                            float mrun = -1e30f, lrun = 0.f;
#pragma unroll 1
                            for (int hf = 0; hf < 2; ++hf) {
                                f32x16 X[4];
#pragma unroll
                                for (int kb = 0; kb < 4; ++kb) {
                                    bf16x8 kf[8];
#pragma unroll
                                    for (int ks = 0; ks < 8; ++ks) kf[ks] = *(const LAS bf16x8*)(KI + (hf * 128 + kb * 32 + r31) * KST + (16 * ks + 8 * h2) * 2);
                                    __builtin_amdgcn_sched_barrier(0);
#pragma unroll
                                    for (int i = 0; i < 16; ++i) X[kb][i] = 0.f;
#pragma unroll
                                    for (int ks = 0; ks < 8; ++ks) X[kb] = __builtin_amdgcn_mfma_f32_32x32x16_bf16(kf[ks], qf[ks], X[kb], 0, 0, 0);
                                    __builtin_amdgcn_sched_barrier(0);
                                }
                                float mx = -1e30f;
#pragma unroll
                                for (int kb = 0; kb < 4; ++kb)
#pragma unroll
                                    for (int i = 0; i < 16; ++i) mx = fmaxf(mx, X[kb][i]);
                                mx = fmaxf(mx, __shfl_xor(mx, 32));
                                const float mnew = fmaxf(mrun, mx), alpha = __builtin_amdgcn_exp2f((mrun - mnew) * SC);
                                float ls = 0.f;
#pragma unroll
                                for (int kb = 0; kb < 4; ++kb)
#pragma unroll
                                    for (int i = 0; i < 16; ++i) { const float p = __builtin_amdgcn_exp2f((X[kb][i] - mnew) * SC); X[kb][i] = p; ls += p; }
                                ls += __shfl_xor(ls, 32);
                                lrun = lrun * alpha + ls; mrun = mnew;
#pragma unroll
                                for (int db = 0; db < 4; ++db)
#pragma unroll
                                    for (int i = 0; i < 16; ++i) O[db][i] *= alpha;
#pragma unroll
                                for (int kb = 0; kb < 4; ++kb) {
                                    bf16x8 vf[2][4], pf[2];
#pragma unroll
                                    for (int s = 0; s < 2; ++s) {
                                        u32x4 pw; pw.x = pk2(X[kb][8 * s], X[kb][8 * s + 1]); pw.y = pk2(X[kb][8 * s + 2], X[kb][8 * s + 3]); pw.z = pk2(X[kb][8 * s + 4], X[kb][8 * s + 5]); pw.w = pk2(X[kb][8 * s + 6], X[kb][8 * s + 7]);
                                        pf[s] = __builtin_bit_cast(bf16x8, pw);
#pragma unroll
                                        for (int db = 0; db < 4; ++db) {
                                            const LAS unsigned char* vp = VI + (db * 32 + r31) * VST + (hf * 128 + kb * 32 + 16 * s + 4 * h2) * 2;
                                            const u32x2 lo = *(const LAS u32x2*)vp, hi = *(const LAS u32x2*)(vp + 16);
                                            vf[s][db] = __builtin_bit_cast(bf16x8, (u32x4){lo.x, lo.y, hi.x, hi.y});
                                        }
                                    }
                                    __builtin_amdgcn_sched_barrier(0);
#pragma unroll
                                    for (int s = 0; s < 2; ++s)
#pragma unroll
                                        for (int db = 0; db < 4; ++db) O[db] = __builtin_amdgcn_mfma_f32_32x32x16_bf16(vf[s][db], pf[s], O[db], 0, 0, 0);
                                    __builtin_amdgcn_sched_barrier(0);
                                }
                            }
                            const float rl = 1.f / lrun;
                            char* op = HC + (qrow * 1536 + 1024 + h * 128) * 2;
#pragma unroll
                            for (int db = 0; db < 4; ++db)
#pragma unroll
                                for (int g4 = 0; g4 < 4; ++g4) { u32x2 w; w.x = pk2(O[db][4 * g4] * rl, O[db][4 * g4 + 1] * rl); w.y = pk2(O[db][4 * g4 + 2] * rl, O[db][4 * g4 + 3] * rl);
                                    *(u32x2*)(op + (db * 32 + 8 * g4 + 4 * h2) * 2) = w; }
                        }
                        __syncthreads();
                    }
                    if (tid_ph == 0) XB[0] = __hip_atomic_fetch_add(xc, 1u, RLX_AGENT);
                    __syncthreads();
                    xi = __builtin_amdgcn_readfirstlane((int)XB[0]);
                    __syncthreads();
                }
            }
            if (rep_ == 0) {
                unsigned zf_ = 0u; asm volatile("" : "+v"(zf_)); const int lane_f = (int)__builtin_amdgcn_mbcnt_hi(~0u, __builtin_amdgcn_mbcnt_lo(~0u, zf_));
                LAS float* scr = (LAS float*)(lds + wave * 8448);
                LAS unsigned* FB = (LAS unsigned*)(lds + 8 * 8448);
                unsigned* fc = (unsigned*)ctl + CW_FILL + l * 64;
                constexpr int IT_GU = 32 * 16 * 64, IT_ALL = 49152, CH = 32;
                const bool lead = (wave == 0) && (lane_f == 0);
                __syncthreads();
                if (lead) FB[0] = __hip_atomic_fetch_add(fc, (unsigned)CH, RLX_AGENT);
                __syncthreads();
                int fbase = __builtin_amdgcn_readfirstlane((int)FB[0]), slot = 1;
#pragma unroll 1
                while (fbase < IT_ALL) {
                    unsigned nb = 0u;
                    if (lead) nb = __hip_atomic_fetch_add(fc, (unsigned)CH, RLX_AGENT);
                    {
                        struct FItem { const float* W; unsigned char* WT; int ldw; float sc; };
                        auto FI = [&](int it) -> FItem { FItem r;
                            if (it < IT_GU) { const int e = it >> 10, q = it & 1023, kb = q >> 6, nb_ = q & 63;
                                r.W = INP(I_WGU) + (((size_t)l * 32 + e) * D + 64 * kb) * 2048 + 32 * nb_; r.ldw = 2048; r.WT = (unsigned char*)(ws + WS_WGU) + ((size_t)e * 2048 + 32 * nb_) * D + 64 * kb; r.sc = F8_SWGU; }
                            else { const int r2 = it - IT_GU, e = r2 >> 9, q = r2 & 511, kb = q >> 5, nb_ = q & 31;
                                r.W = INP(I_WDN) + (((size_t)l * 32 + e) * D + 64 * kb) * 1024 + 32 * nb_; r.ldw = 1024; r.WT = (unsigned char*)(ws + WS_WDN) + ((size_t)e * 1024 + 32 * nb_) * D + 64 * kb; r.sc = F8_SWDN; }
                            return r; };
                        f32x4 va[8], vb[8];
                        FItem c0 = FI(fbase + wave), c1;
                        ti_load4(c0.W, c0.ldw, lane_f, va);
#pragma unroll 1
                        for (int kq = 0; kq < CH / NWAVES; kq += 2) {
                            c1 = FI(fbase + wave + (kq + 1) * NWAVES); ti_load4(c1.W, c1.ldw, lane_f, vb);
                            ti_store4_f8(va, c0.WT, D, c0.sc, lane_f);
                            if (kq + 2 < CH / NWAVES) { c0 = FI(fbase + wave + (kq + 2) * NWAVES); ti_load4(c0.W, c0.ldw, lane_f, va); }
                            ti_store4_f8(vb, c1.WT, D, c1.sc, lane_f);
                        }
                    }
                    if (lead) FB[slot] = nb;
                    __syncthreads();
                    fbase = __builtin_amdgcn_readfirstlane((int)FB[slot]); slot ^= 1;
                }
            }
#undef UNP4
#undef DOT4
#undef SUB_TID
        }
        SEAM(pb + 3);
        _Pragma("unroll 1") for (int rep_ = 0; rep_ < NREP(5); ++rep_) if (((PHMASK>>5)&1) && IN(pb + 5)) {
            SchedPlain S; S.T.init(M / 256, 4); S.G = G; S.c = bx; S.A = (const char*)(ws + WS_R2 + R2_HCAT); S.B = (const char*)(ws + WS_WBR) + (size_t)l * 1024 * 1536 * 2; S.C = (char*)(ws + WS_R2 + R2_YPRE);
            S.lda = 1536; S.ldb = 1536; S.ldc = D;
            pg8::EpiMerge E; E.U = Ub; E.gate_b = INP(I_GATEB) + (size_t)l * 3072;
            pg8::gemm_phase<false, true>(lds, 1536 * 2, 1536 * 2, 1536 * 2, S, E, wave);
        }
        SEAM(pb + 5);
        _Pragma("unroll 1") for (int rep_ = 0; rep_ < NREP(6); ++rep_) if (((PHMASK>>6)&1) && IN(pb + 6)) {
            SchedPlain S; S.T.init(M / 256, 4); S.G = G; S.c = bx; S.A = (const char*)(ws + WS_R2 + R2_YPRE); S.B = (const char*)(ws + WS_WO) + (size_t)l * D * D * 2; S.C = (char*)(ws + WS_R2 + R2_Z);
            S.lda = D; S.ldb = D; S.ldc = D;
            pg8::EpiStore E;
            pg8::gemm_phase<false>(lds, D * 2, D * 2, D * 2, S, E, wave);
        }
        SEAM(pb + 6);
        _Pragma("unroll 1") for (int rep_ = 0; rep_ < NREP(7); ++rep_) if (((PHMASK>>7)&1) && IN(pb + 7)) { PHASE_TID
            constexpr int WP = 2064;
            LAS unsigned char* WRb = lds;
            LAS float* RB = (LAS float*)(lds + 66048);
            LAS unsigned char* XS = lds + 66560 + wave * 4608;
            for (int i = tid; i < 32768; i += NTHR) { const int k = i >> 5, e = i & 31; *(LAS bf16*)(WRb + e * WP + k * 2) = (bf16)f2bf(INP(I_RTW)[((size_t)l * D + k) * 32 + e]); }
            if (tid < 32) RB[tid] = INP(I_RTB)[l * 32 + tid];
            const char* Zb = (const char*)(ws + WS_R2 + R2_Z);
            int* TKE = (int*)(ws + WS_TKE); float* TKG = (float*)(ws + WS_TKG); int* TKP = (int*)(ws + WS_TKP); int* ROWTOK = (int*)(ws + WS_ROWTOK);
            LAS unsigned* LCNT = (LAS unsigned*)(lds + 131072);
            LAS unsigned* GBASE = LCNT + 32; LAS unsigned* LLEN = LCNT + 64; LAS unsigned* LIST = LCNT + 128;
            if (tid < 65) LCNT[tid] = 0u;
            {
                f32x4 g[4], bb[4];
#pragma unroll
                for (int j = 0; j < 4; ++j) { g[j] = *(const f32x4*)(INP(I_LN1G) + l * D + 256 * j + 4 * lane); bb[j] = *(const f32x4*)(INP(I_LN1B) + l * D + 256 * j + 4 * lane); }
#pragma unroll 1
                for (int pp = gw; pp < M / 2; pp += NGW) {
                    f32x4 y0[4], y1[4];
#pragma unroll
                    for (int j = 0; j < 4; ++j) { y0[j] = ld4bf(Zb + ((size_t)(2 * pp) * D + 256 * j + 4 * lane) * 2) + ld4bf(Xb + ((size_t)(2 * pp) * D + 256 * j + 4 * lane) * 2) * DN_ALPHA;
                        y1[j] = ld4bf(Zb + ((size_t)(2 * pp + 1) * D + 256 * j + 4 * lane) * 2) + ld4bf(Xb + ((size_t)(2 * pp + 1) * D + 256 * j + 4 * lane) * 2) * DN_ALPHA; }
                    ln16(y0, g, bb); ln16(y1, g, bb);
#pragma unroll
                    for (int j = 0; j < 4; ++j) { st4bf(Xb + ((size_t)(2 * pp) * D + 256 * j + 4 * lane) * 2, y0[j]); st4bf(Xb + ((size_t)(2 * pp + 1) * D + 256 * j + 4 * lane) * 2, y1[j]);
                        *(unsigned*)((char*)(ws + WS_XF8) + (size_t)(2 * pp) * D + 256 * j + 4 * lane) = pk4_f8(y0[j].x * F8_SX, y0[j].y * F8_SX, y0[j].z * F8_SX, y0[j].w * F8_SX);
                        *(unsigned*)((char*)(ws + WS_XF8) + (size_t)(2 * pp + 1) * D + 256 * j + 4 * lane) = pk4_f8(y1[j].x * F8_SX, y1[j].y * F8_SX, y1[j].z * F8_SX, y1[j].w * F8_SX); }
                }
            }
            asm volatile("s_waitcnt vmcnt(0)" ::: "memory");
            __syncthreads();
            __builtin_amdgcn_fence(__ATOMIC_ACQUIRE, "agent");
            asm volatile("s_waitcnt vmcnt(0)" ::: "memory");
            if (rep_ == 0) {
                const int r31 = lane & 31, h2 = lane >> 5;
                const int mytok = 16 * (bx + (2 * wave + (r31 >> 4)) * G) + (r31 & 15);
                const char* sp[4];
#pragma unroll
                for (int q = 0; q < 4; ++q) { const int row = (lane >> 3) + 8 * q; const int tk = 16 * (bx + (2 * wave + (row >> 4)) * G) + (row & 15); sp[q] = Xb + ((size_t)tk * D + 8 * (lane & 7)) * 2; }
                f32x16 C;
#pragma unroll
                for (int i = 0; i < 16; ++i) C[i] = 0.f;
                u32x4 xr[4];
#pragma unroll
                for (int q = 0; q < 4; ++q) xr[q] = *(const u32x4*)(sp[q]);
#pragma unroll 1
                for (int sl = 0; sl < 16; ++sl) {
#pragma unroll
                    for (int q = 0; q < 4; ++q) *(LAS u32x4*)(XS + ((lane >> 3) + 8 * q) * 144 + (lane & 7) * 16) = xr[q];
                    if (sl + 1 < 16) {
#pragma unroll
                        for (int q = 0; q < 4; ++q) xr[q] = *(const u32x4*)(sp[q] + (sl + 1) * 128); }
#pragma unroll
                    for (int k2 = 0; k2 < 4; ++k2) C = __builtin_amdgcn_mfma_f32_32x32x16_bf16(*(const LAS bf16x8*)(WRb + r31 * WP + (64 * sl + 16 * k2 + 8 * h2) * 2), *(const LAS bf16x8*)(XS + r31 * 144 + (16 * k2 + 8 * h2) * 2), C, 0, 0, 0);
                }
                float v[16];
#pragma unroll
                for (int g4 = 0; g4 < 4; ++g4) { const f32x4 b4 = *(const LAS f32x4*)(RB + 8 * g4 + 4 * h2); v[4 * g4] = C[4 * g4] + b4.x; v[4 * g4 + 1] = C[4 * g4 + 1] + b4.y; v[4 * g4 + 2] = C[4 * g4 + 2] + b4.z; v[4 * g4 + 3] = C[4 * g4 + 3] + b4.w; }
                float lv[4]; int li_[4];
#pragma unroll
                for (int k = 0; k < 4; ++k) { float best = -3.0e38f; int bi = 0;
#pragma unroll
                    for (int i = 0; i < 16; ++i) { const int e = (i & 3) + 8 * (i >> 2) + 4 * h2; if (v[i] > best) { best = v[i]; bi = e; } }
#pragma unroll
                    for (int i = 0; i < 16; ++i) { const int e = (i & 3) + 8 * (i >> 2) + 4 * h2; v[i] = (e == bi) ? -3.0e38f : v[i]; }
                    lv[k] = best; li_[k] = bi; }
                float cv[8]; int ci[8];
#pragma unroll
                for (int k = 0; k < 4; ++k) { cv[k] = lv[k]; ci[k] = li_[k]; cv[4 + k] = __shfl_xor(lv[k], 32); ci[4 + k] = __shfl_xor(li_[k], 32); }
                float tv[4]; int te[4];
#pragma unroll
                for (int k = 0; k < 4; ++k) { float best = -3.0e38f; int bi = 64;
#pragma unroll
                    for (int i = 0; i < 8; ++i) { if (cv[i] > best || (cv[i] == best && ci[i] < bi)) { best = cv[i]; bi = ci[i]; } }
#pragma unroll
                    for (int i = 0; i < 8; ++i) cv[i] = (ci[i] == bi) ? -3.0e38f : cv[i];
                    tv[k] = best; te[k] = bi; }
                const float e1 = __expf(tv[1] - tv[0]), e2 = __expf(tv[2] - tv[0]), e3 = __expf(tv[3] - tv[0]), rs = 1.f / (1.f + e1 + e2 + e3);
                const float gt[4] = {rs, e1 * rs, e2 * rs, e3 * rs};
                if (h2 == 0) {
#pragma unroll
                    for (int k = 0; k < 4; ++k) {
                        const unsigned lpos = __hip_atomic_fetch_add(LCNT + te[k], 1u, __ATOMIC_RELAXED, __HIP_MEMORY_SCOPE_WORKGROUP);
                        const unsigned li = __hip_atomic_fetch_add(LLEN, 1u, __ATOMIC_RELAXED, __HIP_MEMORY_SCOPE_WORKGROUP);
                        LIST[2 * li] = (unsigned)(mytok * 4 + k); LIST[2 * li + 1] = (unsigned)te[k] | (lpos << 8);
                        TKE[mytok * 4 + k] = te[k]; TKG[mytok * 4 + k] = gt[k]; }
                }
            }
            __syncthreads();
            if (tid < 32 && rep_ == 0) GBASE[tid] = __hip_atomic_fetch_add((unsigned*)ctl + CW_CNT + (l * 32 + tid) * 64, LCNT[tid], RLX_AGENT);
            __syncthreads();
            if (rep_ == 0) { const unsigned n = LLEN[0];
                for (unsigned i = tid; i < n; i += NTHR) { const unsigned tk = LIST[2 * i], ev = LIST[2 * i + 1], e = ev & 255u, pos = GBASE[e] + (ev >> 8);
                    TKP[tk] = (int)pos; ROWTOK[(size_t)e * M + pos] = (int)(tk >> 2); } }
            __syncthreads();
        }
        SEAM(pb + 7);
        _Pragma("unroll 1") for (int rep_ = 0; rep_ < NREP(8); ++rep_) if (((PHMASK>>8)&1) && IN(pb + 8)) { PHASE_TID
            if (tid < 32) CNT[tid] = (int)__hip_atomic_load((unsigned*)ctl + CW_CNT + (l * 32 + tid) * 64, RLX_AGENT);
            __syncthreads();
            if (tid == 0) { int a = 0; for (int e = 0; e < 32; ++e) { PB[e] = a; a += (CNT[e] + 255) >> 8; } PB[32] = a; }
            __syncthreads();
            const int P = PB[32];
            const int* ROWTOK = (const int*)(ws + WS_ROWTOK);
            char* XD = (char*)(ws + WS_R1); const char* XF = (const char*)(ws + WS_XF8);
            for (int sb = gw * 64; sb < P * 256; sb += NGW * 64) {
                const int pm = sb >> 8; int e = 0;
#pragma unroll 1
                for (int j = 1; j < NEXP; ++j) e += (PB[j] <= pm) ? 1 : 0;
                const int pos0 = sb - PB[e] * 256, cnt = CNT[e];
                int nvalid = cnt - pos0; nvalid = nvalid > 64 ? 64 : nvalid;
                int tokv = -1; if (pos0 + lane < cnt) tokv = ROWTOK[(size_t)e * M + pos0 + lane];
#pragma unroll 1
                for (int j = 0; j < nvalid; j += 4) {
                    int t[4]; u32x4 a[4];
#pragma unroll
                    for (int i = 0; i < 4; ++i) { t[i] = __builtin_amdgcn_readlane(tokv, j + i);
                        if (t[i] >= 0) a[i] = *(const u32x4*)(XF + (size_t)t[i] * 1024 + lane * 16); }
#pragma unroll
                    for (int i = 0; i < 4; ++i) if (t[i] >= 0) *(u32x4*)(XD + (size_t)(sb + j + i) * 1024 + lane * 16) = a[i];
                }
            }
            LAS float* scr = (LAS float*)(lds + wave * 8448);
            constexpr int IT_GU = 32 * 16 * 64, IT_DN = 32 * 16 * 32;
            for (int it = XW_SPLIT + gw; it < IT_GU + IT_DN; it += NGW) {
                if (it < IT_GU) { const int e = it >> 10, q = it & 1023, kb = q >> 6, nb = q & 63;
                    transpose_item_f8(INP(I_WGU) + (((size_t)l * 32 + e) * D + 64 * kb) * 2048 + 32 * nb, 2048, (unsigned char*)(ws + WS_WGU) + ((size_t)e * 2048 + 32 * nb) * D + 64 * kb, D, F8_SWGU, scr, lane); }
                else { const int r = it - IT_GU, e = r >> 9, q = r & 511, kb = q >> 5, nb = q & 31;
                    transpose_item_f8(INP(I_WDN) + (((size_t)l * 32 + e) * D + 64 * kb) * 1024 + 32 * nb, 1024, (unsigned char*)(ws + WS_WDN) + ((size_t)e * 1024 + 32 * nb) * D + 64 * kb, D, F8_SWDN, scr, lane); }
            }
            __syncthreads();
        }
        SEAM(pb + 8);
        if (IN(pb + 9) || IN(pb + 10)) { PHASE_TID
            if (tid < 32) CNT[tid] = (int)__hip_atomic_load((unsigned*)ctl + CW_CNT + (l * 32 + tid) * 64, RLX_AGENT);
            __syncthreads();
            if (tid == 0) { int a = 0; for (int e = 0; e < 32; ++e) { PB[e] = a; a += (CNT[e] + 255) >> 8; } PB[32] = a; }
            __syncthreads();
        }
        _Pragma("unroll 1") for (int rep_ = 0; rep_ < NREP(9); ++rep_) if (((PHMASK>>9)&1) && IN(pb + 9)) {
            SchedMoe S; S.T.init(PB[32], 8); S.G = G; S.c = bx; S.A = (const char*)(ws + WS_R1); S.W = (const char*)(ws + WS_WGU); S.C = (char*)(ws + WS_R2 + R2_HMID); S.PB = PB; S.wrows = 2048; S.ldc = 1024; S.cdiv = 2; S.osz = 1;
            pg8::EpiMoe1 E; E.bgu = INP(I_BGU) + (size_t)l * 32 * 2048;
            pg8::gemm_phase<true>(lds, D, D, D, S, E, wave);
        }
        SEAM(pb + 9);
        _Pragma("unroll 1") for (int rep_ = 0; rep_ < NREP(10); ++rep_) if (((PHMASK>>10)&1) && IN(pb + 10)) {
            SchedMoe S; S.T.init(PB[32], 4); S.G = G; S.c = bx; S.A = (const char*)(ws + WS_R2 + R2_HMID); S.W = (const char*)(ws + WS_WDN); S.C = (char*)(ws + WS_R1); S.PB = PB; S.wrows = 1024; S.ldc = 1024; S.cdiv = 1; S.osz = 2;
            pg8::EpiMoe2 E; E.bdn = INP(I_BDN) + (size_t)l * 32 * 1024;
            pg8::gemm_phase<true>(lds, D, D, D, S, E, wave);
        }
        SEAM(pb + 10);
        _Pragma("unroll 1") for (int rep_ = 0; rep_ < NREP(11); ++rep_) if (((PHMASK>>11)&1) && IN(pb + 11)) { PHASE_TID
            if (tid < 32) CNT[tid] = (int)__hip_atomic_load((unsigned*)ctl + CW_CNT + (l * 32 + tid) * 64, RLX_AGENT);
            LAS float* wgt = (LAS float*)(lds + 73728);
            const bool lastl = (l == DEPTH - 1);
            if (!lastl) load_gate_table(wgt, INP(I_WIN) + (size_t)(l + 1) * D * DIN, tid);
            __syncthreads();
            if (tid == 0) { int a = 0; for (int e = 0; e < 32; ++e) { PB[e] = a; a += (CNT[e] + 255) >> 8; } PB[32] = a; }
            __syncthreads();
            const int e0 = 8 * lane;
            f32x4 g[4], bb[4];
#pragma unroll
            for (int j = 0; j < 4; ++j) { const int o = (j >> 1) * 512 + e0 + (j & 1) * 4; g[j] = *(const f32x4*)(INP(I_LN2G) + l * D + o); bb[j] = *(const f32x4*)(INP(I_LN2B) + l * D + o); }
            const char* YA = (const char*)(ws + WS_R1);
            const bool dummy_ = (rep_ + 1 < NREP(11)); char* const Xo = dummy_ ? (char*)(ws + WS_R2) : Xb; float* const Fo = dummy_ ? (float*)(ws + WS_R2 + 256 * MiB) : args.out; float* const Go = dummy_ ? (float*)(ws + WS_R2 + 200 * MiB) : GIF;
            const int* TKE = (const int*)(ws + WS_TKE); const float* TKG = (const float*)(ws + WS_TKG); const int* TKP = (const int*)(ws + WS_TKP);
#pragma unroll 1
            for (int mb = gw * 16; mb < M; mb += NGW * 16) {
                const int ev = TKE[mb * 4 + lane], pv = TKP[mb * 4 + lane]; const float gv = TKG[mb * 4 + lane];
                const int rowv = PB[ev] * 256 + pv;
#pragma unroll 1
                for (int ti = 0; ti < 16; ti += 2) {
                    u32x4 xw[2][2], yw[2][4][2]; float gk[2][4];
#pragma unroll
                    for (int q = 0; q < 2; ++q) { const size_t m = (size_t)mb + ti + q;
                        xw[q][0] = *(const u32x4*)(Xb + (m * D + e0) * 2); xw[q][1] = *(const u32x4*)(Xb + (m * D + 512 + e0) * 2);
#pragma unroll
                        for (int k = 0; k < 4; ++k) { const size_t row = (size_t)__builtin_amdgcn_readlane(rowv, 4 * (ti + q) + k);
                            gk[q][k] = __builtin_bit_cast(float, __builtin_amdgcn_readlane(__builtin_bit_cast(int, gv), 4 * (ti + q) + k));
                            yw[q][k][0] = *(const u32x4*)(YA + (row * D + e0) * 2); yw[q][k][1] = *(const u32x4*)(YA + (row * D + 512 + e0) * 2); } }
#pragma unroll
                    for (int q = 0; q < 2; ++q) { const size_t m = (size_t)mb + ti + q;
                        f32x4 v[4];
#pragma unroll
                        for (int hh = 0; hh < 2; ++hh) { const u32x4 w = xw[q][hh];
                            v[2 * hh] = (f32x4){bflo(w.x), bfhi(w.x), bflo(w.y), bfhi(w.y)} * DN_ALPHA; v[2 * hh + 1] = (f32x4){bflo(w.z), bfhi(w.z), bflo(w.w), bfhi(w.w)} * DN_ALPHA; }
#pragma unroll
                        for (int k = 0; k < 4; ++k)
#pragma unroll
                            for (int hh = 0; hh < 2; ++hh) { const u32x4 w = yw[q][k][hh];
                                v[2 * hh] = v[2 * hh] + (f32x4){bflo(w.x), bfhi(w.x), bflo(w.y), bfhi(w.y)} * gk[q][k]; v[2 * hh + 1] = v[2 * hh + 1] + (f32x4){bflo(w.z), bfhi(w.z), bflo(w.w), bfhi(w.w)} * gk[q][k]; }
                        ln16(v, g, bb);
                        if (lastl) {
#pragma unroll
                            for (int j = 0; j < 4; ++j) *(f32x4*)(Fo + m * D + (j >> 1) * 512 + e0 + (j & 1) * 4) = v[j];
                        } else {
#pragma unroll
                            for (int hh = 0; hh < 2; ++hh) { *(u32x4*)(Xo + (m * D + hh * 512 + e0) * 2) = pg8::pack8(v[2 * hh], v[2 * hh + 1]);
                                u32x2 f8w; f8w.x = pk4_f8(v[2 * hh].x * F8_SX, v[2 * hh].y * F8_SX, v[2 * hh].z * F8_SX, v[2 * hh].w * F8_SX); f8w.y = pk4_f8(v[2 * hh + 1].x * F8_SX, v[2 * hh + 1].y * F8_SX, v[2 * hh + 1].z * F8_SX, v[2 * hh + 1].w * F8_SX);
                                if (!dummy_) *(u32x2*)((char*)(ws + WS_XF8) + m * D + hh * 512 + e0) = f8w; }
                            gates8b(v, wgt, Go + m * 8, lane);
                        }
                    }
                }
            }
            __syncthreads();
        }
        SEAM(pb + 11);
    }
#undef IN
#undef SEAM
}

extern "C" void kernel_launch(void* const* d_in, const int* in_sizes, int n_in, void* d_out, int out_size, void* d_ws, size_t ws_size, hipStream_t stream) {
    static int grid = 0;
    if (grid == 0) {
        if (n_in != N_IN || out_size != M * D || ws_size < WS_END) { fprintf(stderr, "kernel_launch: unexpected shapes (n_in %d, out %d, ws %zu)\n", n_in, out_size, ws_size); grid = -1; return; }
        int dev = 0, cus = 0, per_cu = 0;
        if (hipGetDevice(&dev) != hipSuccess || hipDeviceGetAttribute(&cus, hipDeviceAttributeMultiprocessorCount, dev) != hipSuccess) { grid = -1; return; }
        if (hipFuncSetAttribute((const void*)fwd_kernel, hipFuncAttributeMaxDynamicSharedMemorySize, LDS_BYTES) != hipSuccess) { fprintf(stderr, "kernel_launch: hipFuncSetAttribute failed\n"); grid = -1; return; }
        if (hipOccupancyMaxActiveBlocksPerMultiprocessor(&per_cu, (const void*)fwd_kernel, NTHR, LDS_BYTES) != hipSuccess || per_cu < 1) fprintf(stderr, "kernel_launch: occupancy query reports %d\n", per_cu);
        (void)hipGetLastError();
        grid = cus;
    }
    if (grid < 0) return;
    (void)hipMemsetAsync((char*)d_ws + WS_CTL, 0, CTL_ZERO_BYTES, stream);
    Args a{};
    for (int i = 0; i < N_IN; ++i) a.in[i] = (const float*)d_in[i];
    a.out = (float*)d_out; a.ws = (unsigned char*)d_ws;
#if MK_ONE_LAUNCH
    a.ph_lo = 0; a.ph_hi = NPH;
    hipLaunchKernelGGL(fwd_kernel, dim3(grid), dim3(NTHR), LDS_BYTES, stream, a);
#else
    for (int p = 0; p < NPH; ++p) { a.ph_lo = p; a.ph_hi = p + 1; hipLaunchKernelGGL(fwd_kernel, dim3(grid), dim3(NTHR), LDS_BYTES, stream, a); }
#endif
    const hipError_t le = hipPeekAtLastError();
    if (le != hipSuccess) fprintf(stderr, "kernel_launch: launch failed: %s\n", hipGetErrorName(le));
}
```

```cpp
#include <hip/hip_runtime.h>
#include <cstdio>
#include <cstdint>

#ifndef MK_ONE_LAUNCH
#define MK_ONE_LAUNCH 1
#endif

#define LAS __attribute__((address_space(3)))
#define GAS __attribute__((address_space(1)))
typedef unsigned short bf16;
typedef short bf16x8 __attribute__((ext_vector_type(8)));
typedef float f32x4 __attribute__((ext_vector_type(4)));
typedef float f32x2 __attribute__((ext_vector_type(2)));
typedef float f32x16 __attribute__((ext_vector_type(16)));
typedef unsigned u32x4 __attribute__((ext_vector_type(4)));
typedef unsigned u32x2 __attribute__((ext_vector_type(2)));
typedef __bf16 bf16x2_t __attribute__((ext_vector_type(2)));
typedef GAS unsigned gu32;
#define RLX_AGENT __ATOMIC_RELAXED, __HIP_MEMORY_SCOPE_AGENT
#define DI __device__ __forceinline__

constexpr int NWAVES = 8, NTHR = 512;
constexpr int D = 1024, BATCH = 16, SEQ = 4096, M = BATCH * SEQ, DEPTH = 2, MEML = 256, MROWS = BATCH * MEML;
constexpr int DIN = 6920, NU = 6912;
constexpr int UC_QK = 0, UC_RW = 512, UC_V = 2304, UC_OG = 2816, UC_CAQ = 3328, UC_GATE = 3840;
constexpr int UC_F8 = UC_V, NF8 = NU - UC_F8;
__host__ __device__ constexpr int ucol_src(int c) { return c < 512 ? c : (c < 2304 ? 1544 + (c - 512) : (c < 2816 ? 512 + (c - 2304) : (c < 3328 ? 1024 + (c - 2816) : (c < 3840 ? 3336 + (c - 3328) : 3848 + (c - 3840))))); }
constexpr int NEXP = 32, TOPK = 4;
constexpr int PMAX = M * TOPK / 256 + NEXP;
constexpr float LN_EPS = 1e-5f, RW_GN_EPS = 64e-5f, DN_ALPHA = 1.41421356237f;

enum { I_X = 0, I_MEM, I_LNIN_G, I_LNIN_B, I_MEMLN_G, I_MEMLN_B, I_WIN, I_CONVW, I_CONVB, I_IGB, I_FGB, I_MLNORMG, I_RWMU, I_RWW0, I_RWWUP, I_RWA0, I_RWAUP, I_RWGUP,
       I_RWKK, I_RWKA, I_RWRK, I_RWLNG, I_RWLNB, I_CAWKV, I_GATEB, I_WBRML, I_WBRRW, I_WBRCA, I_WO, I_LN1G, I_LN1B, I_RTW, I_RTB, I_WGU, I_BGU, I_WDN, I_BDN, I_LN2G, I_LN2B, N_IN };

constexpr size_t MiB = 1u << 20;
constexpr size_t WS_CTL = 0, CTL_ZERO_BYTES = 1 * MiB;
constexpr size_t WS_WIN = 1 * MiB;
constexpr size_t WS_WKV = 28 * MiB;
constexpr size_t WS_WBR = 32 * MiB;
constexpr size_t WS_WO = 38 * MiB;
constexpr size_t WS_WLORA = 42 * MiB;
constexpr size_t WS_WGU = 45 * MiB;
constexpr size_t WS_WDN = 173 * MiB;
constexpr size_t WS_X = 237 * MiB;
constexpr size_t WS_MEMN = 365 * MiB;
constexpr size_t WS_KV = 373 * MiB;
constexpr size_t WS_GIF = 389 * MiB;
constexpr size_t WS_TKE = 391 * MiB, WS_TKG = 392 * MiB, WS_TKP = 393 * MiB;
constexpr size_t WS_ROWTOK = 394 * MiB;
constexpr size_t WS_HML = 402 * MiB;
constexpr size_t WS_R1 = 466 * MiB;
constexpr size_t WS_R2 = 1330 * MiB;
constexpr size_t WS_XF8 = 1858 * MiB;
constexpr size_t WS_WING8 = 1922 * MiB;
constexpr size_t WS_END = 1932 * MiB;
constexpr size_t R2_LORA_OUT = 0, R2_HCAT = 192 * MiB, R2_LORA_IN = 384 * MiB, R2_YPRE = 0, R2_Z = 192 * MiB, R2_HMID = 0;
constexpr int CW_TMO = 0, CW_BAR = 4096, CW_CNT = 16384, CW_FILL = 32768;

constexpr int LDS_BYTES = 155648;
constexpr int LDSCTL_OFF = 153600;

DI unsigned pk2(float lo, float hi) { bf16x2_t b = __builtin_convertvector((f32x2){lo, hi}, bf16x2_t); return __builtin_bit_cast(unsigned, b); }
DI unsigned f2bf(float f) { return pk2(f, 0.f) & 0xffffu; }
DI float u2f_(unsigned u) { return __builtin_bit_cast(float, u); }
DI unsigned f2u_(float f) { return __builtin_bit_cast(unsigned, f); }
DI float bflo(unsigned u) { return __builtin_bit_cast(float, u << 16); }
DI float bfhi(unsigned u) { return __builtin_bit_cast(float, u & 0xffff0000u); }
DI unsigned pk4_f8(float a, float b, float c, float d) {
    a = __builtin_amdgcn_fmed3f(a, -448.f, 448.f); b = __builtin_amdgcn_fmed3f(b, -448.f, 448.f); c = __builtin_amdgcn_fmed3f(c, -448.f, 448.f); d = __builtin_amdgcn_fmed3f(d, -448.f, 448.f);
    int w = 0; w = __builtin_amdgcn_cvt_pk_fp8_f32(a, b, w, false); w = __builtin_amdgcn_cvt_pk_fp8_f32(c, d, w, true); return (unsigned)w; }
DI float sigmoidf_(float x) { return __builtin_amdgcn_rcpf(1.f + __builtin_amdgcn_exp2f(-1.4426950408889634f * x)); }
template <int CTRL> DI float dppf(float x) { return __builtin_bit_cast(float, __builtin_amdgcn_update_dpp(0, __builtin_bit_cast(int, x), CTRL, 0xF, 0xF, true)); }
DI float red4(float x) { x += dppf<0xB1>(x); x += dppf<0x4E>(x); return x; }
DI float red8(float x) { x = red4(x); x += dppf<0x141>(x); return x; }
DI float red16(float x) { x = red8(x); x += dppf<0x140>(x); return x; }
DI float red8o(float x) { x += dppf<0xB1>(x); asm("" : "+v"(x)); x += dppf<0x4E>(x); asm("" : "+v"(x)); x += dppf<0x141>(x); asm("" : "+v"(x)); return x; }
DI float red16o(float x) { x = red8o(x); x += dppf<0x140>(x); asm("" : "+v"(x)); return x; }
typedef short s16x4 __attribute__((ext_vector_type(4)));
DI u32x2 trd4(const LAS unsigned char* img, int PB, int rowbase, int colbase, int lane) {
    const LAS unsigned char* p = img + (rowbase + ((lane & 15) >> 2)) * PB + (colbase + 16 * ((lane >> 4) & 1) + 4 * (lane & 3)) * 2;
    return __builtin_bit_cast(u32x2, __builtin_amdgcn_ds_read_tr16_b64_v4i16((LAS s16x4*)p)); }
DI bf16x8 trd8(const LAS unsigned char* img, int PB, int rb0, int rb1, int colbase, int lane) { const u32x2 lo = trd4(img, PB, rb0, colbase, lane), hi = trd4(img, PB, rb1, colbase, lane); return __builtin_bit_cast(bf16x8, (u32x4){lo.x, lo.y, hi.x, hi.y}); }
template <int CTRL, int RM> DI float dpp_keep(float x, float ident) { return __builtin_bit_cast(float, __builtin_amdgcn_update_dpp(__builtin_bit_cast(int, ident), __builtin_bit_cast(int, x), CTRL, RM, 0xF, false)); }
DI float scan_add64(float x) { x += dpp_keep<0x111, 0xF>(x, 0.f); x += dpp_keep<0x112, 0xF>(x, 0.f); x += dpp_keep<0x114, 0xF>(x, 0.f); x += dpp_keep<0x118, 0xF>(x, 0.f); x += dpp_keep<0x142, 0xA>(x, 0.f); x += dpp_keep<0x143, 0xC>(x, 0.f); return x; }
DI float scan_max64(float x) { const float NI = -3.0e38f; x = fmaxf(x, dpp_keep<0x111, 0xF>(x, NI)); x = fmaxf(x, dpp_keep<0x112, 0xF>(x, NI)); x = fmaxf(x, dpp_keep<0x114, 0xF>(x, NI)); x = fmaxf(x, dpp_keep<0x118, 0xF>(x, NI));
    x = fmaxf(x, dpp_keep<0x142, 0xA>(x, NI)); x = fmaxf(x, dpp_keep<0x143, 0xC>(x, NI)); return x; }
DI float wave_sum(float v) {
    v = red16(v);
    const int vi = __builtin_bit_cast(int, v);
    const float a = __builtin_bit_cast(float, __builtin_amdgcn_readlane(vi, 0)), b = __builtin_bit_cast(float, __builtin_amdgcn_readlane(vi, 16));
    const float c = __builtin_bit_cast(float, __builtin_amdgcn_readlane(vi, 32)), d = __builtin_bit_cast(float, __builtin_amdgcn_readlane(vi, 48));
    return (a + b) + (c + d);
}
#define LDS_WAIT() asm volatile("s_waitcnt lgkmcnt(0)" ::: "memory")

constexpr float F8_SX = 8.f, F8_SWGU = 512.f, F8_SH = 4.f, F8_SWDN = 1024.f, F8_INV1 = 1.f / (F8_SX * F8_SWGU), F8_INV2 = 1.f / (F8_SH * F8_SWDN);
namespace pg8 {
constexpr int BM = 256, BK = 64, HALF = 128, HTB = HALF * BK * 2, STAGE_BYTES = 8 * HTB, NXCD = 8, WGM = 8;
__host__ __device__ __forceinline__ int lds_byte(int r, int c) { const int st = (r >> 4) * 2 + (c >> 5), rr = r & 15, cc = c & 31, ob = rr * 64 + cc * 2; return st * 1024 + (ob ^ (((ob >> 9) & 1) << 5)); }
__host__ __device__ __forceinline__ void stage_rc(int b, int& R, int& C) { const int st = b / 1024, sb = b % 1024, swz = sb ^ (((sb >> 9) & 1) << 5); R = (st >> 1) * 16 + swz / 64; C = (st & 1) * 32 + (swz % 64) / 2; }
__host__ __device__ __forceinline__ int perm32(int rho) { const int n = rho >> 4, i = rho & 15; return 8 * (i >> 2) + 4 * n + (i & 3); }

struct Unit { const char* a; const char* b; char* c; int ldc; int r0, c0, e, sub; };

struct TileOrder {
    int nM, nN, nwg;
    DI void init(int nM_, int nN_) { nM = nM_; nN = nN_; nwg = nM * nN; }
    DI bool tile(long L, int& pm, int& pn) const {
        if (L >= nwg) return false;
        int wgid = (int)L; { const int q = nwg / NXCD, r = nwg % NXCD, xcd = wgid % NXCD, off = wgid / NXCD; wgid = (xcd < r ? xcd * (q + 1) : r * (q + 1) + (xcd - r) * q) + off; }
        const int nig = WGM * nN, gid = wgid / nig, fm = gid * WGM, gsz = (nM - fm) < WGM ? (nM - fm) : WGM;
        pm = fm + ((wgid % nig) % gsz); pn = (wgid % nig) / gsz; return true;
    }
};

DI u32x4 pack8(const f32x4& v0, const f32x4& v1) { u32x4 w; w.x = pk2(v0[0], v0[1]); w.y = pk2(v0[2], v0[3]); w.z = pk2(v1[0], v1[1]); w.w = pk2(v1[2], v1[3]); return w; }

struct EpiStore {
    DI void operator()(const f32x4 (&acc)[2][2][4][2], const Unit& u, int wr, int wc, int fr, int fq) const {
#pragma unroll
        for (int ai = 0; ai < 2; ++ai)
#pragma unroll
            for (int m = 0; m < 4; ++m) { char* rowp = u.c + ((size_t)(ai * HALF + wr * 64 + m * 16 + fr) * u.ldc + wc * 32 + 8 * fq) * 2;
#pragma unroll
                for (int bj = 0; bj < 2; ++bj) *(u32x4*)(rowp + bj * 256) = pack8(acc[ai][bj][m][0], acc[ai][bj][m][1]); }
    }
};
struct EpiStoreS {
    float s; const float* gate_b; int gate_c0;
    DI void operator()(const f32x4 (&acc)[2][2][4][2], const Unit& u, int wr, int wc, int fr, int fq) const {
        const bool gate = u.c0 >= gate_c0;
        const float L2E = 1.4426950408889634f;
#pragma unroll
        for (int bj = 0; bj < 2; ++bj) {
            f32x4 g0 = (f32x4){0.f, 0.f, 0.f, 0.f}, g1 = g0;
            if (gate) { const float* g = gate_b + (u.c0 - gate_c0) + bj * HALF + wc * 32 + 8 * fq; g0 = *(const f32x4*)g; g1 = *(const f32x4*)(g + 4); }
#pragma unroll
            for (int ai = 0; ai < 2; ++ai)
#pragma unroll
                for (int m = 0; m < 4; ++m) { char* rowp = u.c + ((size_t)(ai * HALF + wr * 64 + m * 16 + fr) * u.ldc + wc * 32 + 8 * fq) * 2;
                    f32x4 v0 = acc[ai][bj][m][0] * s, v1 = acc[ai][bj][m][1] * s;
                    if (gate) {
#pragma unroll
                        for (int i = 0; i < 4; ++i) { v0[i] = __builtin_amdgcn_exp2f(-L2E * __builtin_amdgcn_fmed3f(v0[i] + g0[i], -30.f, 30.f)); v1[i] = __builtin_amdgcn_exp2f(-L2E * __builtin_amdgcn_fmed3f(v1[i] + g1[i], -30.f, 30.f)); } }
                    *(u32x4*)(rowp + bj * 256) = pack8(v0, v1); }
        }
    }
};
struct EpiMerge {
    static constexpr bool MIDK = true;
    const char* U; const float* gate_b;
    DI void mid(f32x4 (&acc)[2][2][4][2], const Unit& u, int which, int wr, int wc, int fr, int fq) const {
#pragma unroll
        for (int bj = 0; bj < 2; ++bj)
#pragma unroll
            for (int ai = 0; ai < 2; ++ai) {
                u32x4 wa[4], wn[4];
#pragma unroll
                for (int m = 0; m < 4; ++m) { const int lr = ai * HALF + wr * 64 + m * 16 + fr;
                    const char* gp = U + ((size_t)(u.r0 + lr) * NU + UC_GATE + which * 1024 + u.c0 + wc * 32 + 8 * fq) * 2 + bj * 256;
                    wa[m] = *(const u32x4*)gp; wn[m] = *(const u32x4*)(gp + 2048); }
#pragma unroll
                for (int m = 0; m < 4; ++m) {
                    const u32x4 a = wa[m], n = wn[m];
                    const float ea[8] = {bflo(a.x), bfhi(a.x), bflo(a.y), bfhi(a.y), bflo(a.z), bfhi(a.z), bflo(a.w), bfhi(a.w)};
                    const float en[8] = {bflo(n.x), bfhi(n.x), bflo(n.y), bfhi(n.y), bflo(n.z), bfhi(n.z), bflo(n.w), bfhi(n.w)};
#pragma unroll
                    for (int i = 0; i < 8; ++i) acc[ai][bj][m][i >> 2][i & 3] *= (1.f + en[i]) * __builtin_amdgcn_rcpf(1.f + ea[i]); }
                asm volatile("" ::: "memory"); }
    }
    DI void operator()(const f32x4 (&acc)[2][2][4][2], const Unit& u, int wr, int wc, int fr, int fq) const {
#pragma unroll
        for (int bj = 0; bj < 2; ++bj) {
            u32x4 gw[2][4];
#pragma unroll
            for (int ai = 0; ai < 2; ++ai)
#pragma unroll
                for (int m = 0; m < 4; ++m) { const int lr = ai * HALF + wr * 64 + m * 16 + fr; gw[ai][m] = *(const u32x4*)(U + ((size_t)(u.r0 + lr) * NU + UC_GATE + 2048 + u.c0 + wc * 32 + 8 * fq) * 2 + bj * 256); }
#pragma unroll
            for (int ai = 0; ai < 2; ++ai)
#pragma unroll
                for (int m = 0; m < 4; ++m) { const int lr = ai * HALF + wr * 64 + m * 16 + fr; char* rowp = u.c + ((size_t)lr * u.ldc + wc * 32 + 8 * fq) * 2; const u32x4 w = gw[ai][m];
                    f32x4 v0 = acc[ai][bj][m][0], v1 = acc[ai][bj][m][1];
                    v0[0] *= __builtin_amdgcn_rcpf(1.f + bflo(w.x)); v0[1] *= __builtin_amdgcn_rcpf(1.f + bfhi(w.x)); v0[2] *= __builtin_amdgcn_rcpf(1.f + bflo(w.y)); v0[3] *= __builtin_amdgcn_rcpf(1.f + bfhi(w.y));
                    v1[0] *= __builtin_amdgcn_rcpf(1.f + bflo(w.z)); v1[1] *= __builtin_amdgcn_rcpf(1.f + bfhi(w.z)); v1[2] *= __builtin_amdgcn_rcpf(1.f + bflo(w.w)); v1[3] *= __builtin_amdgcn_rcpf(1.f + bfhi(w.w));
                    *(u32x4*)(rowp + bj * 256) = pack8(v0, v1); }
            asm volatile("" ::: "memory");
        }
    }
};
struct EpiWo {
    const char* X;
    DI void operator()(const f32x4 (&acc)[2][2][4][2], const Unit& u, int wr, int wc, int fr, int fq) const {
#pragma unroll
        for (int ai = 0; ai < 2; ++ai)
#pragma unroll
            for (int m = 0; m < 4; ++m) { const int lr = ai * HALF + wr * 64 + m * 16 + fr; char* rowp = u.c + ((size_t)lr * u.ldc + wc * 32 + 8 * fq) * 2;
                const char* xp = X + ((size_t)(u.r0 + lr) * D + u.c0 + wc * 32 + 8 * fq) * 2;
#pragma unroll
                for (int bj = 0; bj < 2; ++bj) { const u32x4 xw = *(const u32x4*)(xp + bj * 256);
                    f32x4 v0 = acc[ai][bj][m][0], v1 = acc[ai][bj][m][1];
                    v0[0] += DN_ALPHA * bflo(xw.x); v0[1] += DN_ALPHA * bfhi(xw.x); v0[2] += DN_ALPHA * bflo(xw.y); v0[3] += DN_ALPHA * bfhi(xw.y);
                    v1[0] += DN_ALPHA * bflo(xw.z); v1[1] += DN_ALPHA * bfhi(xw.z); v1[2] += DN_ALPHA * bflo(xw.w); v1[3] += DN_ALPHA * bfhi(xw.w);
                    *(u32x4*)(rowp + bj * 256) = pack8(v0, v1); }
                asm volatile("" ::: "memory"); }
    }
};
DI float swiglu1(float a, float b) { const float g = fminf(a, 7.f), l = fminf(fmaxf(b, -7.f), 7.f); return g * sigmoidf_(1.702f * g) * (l + 1.f); }
struct EpiMoe1 {
    const float* bgu;
    DI void operator()(const f32x4 (&acc)[2][2][4][2], const Unit& u, int wr, int wc, int fr, int fq) const {
        f32x4 bv[2][2];
#pragma unroll
        for (int bj = 0; bj < 2; ++bj) { const float* b = bgu + u.e * 2048 + u.c0 + bj * HALF + wc * 32 + 8 * fq; bv[bj][0] = *(const f32x4*)b; bv[bj][1] = *(const f32x4*)(b + 4); }
#pragma unroll
        for (int ai = 0; ai < 2; ++ai)
#pragma unroll
            for (int m = 0; m < 4; ++m) { const int lr = ai * HALF + wr * 64 + m * 16 + fr; char* rowp = u.c + ((size_t)lr * u.ldc + wc * 16 + 4 * fq);
#pragma unroll
                for (int bj = 0; bj < 2; ++bj) { const f32x4 v0 = acc[ai][bj][m][0] * F8_INV1 + bv[bj][0], v1 = acc[ai][bj][m][1] * F8_INV1 + bv[bj][1];
                    *(unsigned*)(rowp + bj * 64) = pk4_f8(swiglu1(v0[0], v0[1]) * F8_SH, swiglu1(v0[2], v0[3]) * F8_SH, swiglu1(v1[0], v1[1]) * F8_SH, swiglu1(v1[2], v1[3]) * F8_SH); } }
    }
};
struct EpiMoe2 {
    const float* bdn;
    DI void operator()(const f32x4 (&acc)[2][2][4][2], const Unit& u, int wr, int wc, int fr, int fq) const {
        f32x4 bv[2][2];
#pragma unroll
        for (int bj = 0; bj < 2; ++bj) { const float* b = bdn + u.e * 1024 + u.c0 + bj * HALF + wc * 32 + 8 * fq; bv[bj][0] = *(const f32x4*)b; bv[bj][1] = *(const f32x4*)(b + 4); }
#pragma unroll
        for (int ai = 0; ai < 2; ++ai)
#pragma unroll
            for (int m = 0; m < 4; ++m) { char* rowp = u.c + ((size_t)(ai * HALF + wr * 64 + m * 16 + fr) * u.ldc + wc * 32 + 8 * fq) * 2;
#pragma unroll
                for (int bj = 0; bj < 2; ++bj) *(u32x4*)(rowp + bj * 256) = pack8(acc[ai][bj][m][0] * F8_INV2 + bv[bj][0], acc[ai][bj][m][1] * F8_INV2 + bv[bj][1]); }
    }
};

typedef int i32x8 __attribute__((ext_vector_type(8)));
typedef int i32x4 __attribute__((ext_vector_type(4)));
template <bool F8, bool MIDK = false, class Epi, class Sched>
DI void gemm_phase(LAS unsigned char* lds, const int KB  , const int ldaB, const int ldbB, const Sched& S, const Epi& E, const int wave_) {
    unsigned z_ = 0u; asm volatile("" : "+v"(z_)); const int tid = wave_ * 64 + (int)__builtin_amdgcn_mbcnt_hi(~0u, __builtin_amdgcn_mbcnt_lo(~0u, z_));
    const int wid = __builtin_amdgcn_readfirstlane(tid >> 6), lane = tid & 63, wr = wid >> 2, wc = wid & 3, fr = lane & 15, fq = lane >> 4;
    const int nt = KB / (BK * 2);
    unsigned voffA[2], voffB[2];
#pragma unroll
    for (int i = 0; i < 2; ++i) { int R, C; stage_rc(tid * 16 + i * 8192, R, C); const int Rb = (R & ~31) + perm32(R & 31);
        voffA[i] = (unsigned)(R * ldaB + C * 2); voffB[i] = (unsigned)(Rb * ldbB + C * 2); }
    asm volatile("" : "+v"(voffA[0]), "+v"(voffA[1]), "+v"(voffB[0]), "+v"(voffB[1]));
    const size_t kstep = (size_t)(BK * 2);
    const size_t hstepA = (size_t)HALF * ldaB, hstepB = (size_t)HALF * ldbB;
    const unsigned ldsw = (unsigned)wid * 1024u;
    const int aoff = lds_byte(wr * 64 + fr, fq * 8), boff = lds_byte(wc * 32 + fr, fq * 8);
#define PG8_SA(b, h) (((b) * 2 + (h)) * HTB)
#define PG8_SB(b, h) ((4 + (b) * 2 + (h)) * HTB)
#define PG8_STAGE(bufoff, gbase, voff) do { _Pragma("unroll") for (int _i = 0; _i < 2; ++_i) \
        __builtin_amdgcn_global_load_lds((const unsigned*)((const char*)(gbase) + (voff)[_i]), (LAS unsigned*)(lds + (bufoff) + ldsw + _i * 8192), 16, 0, 0); } while (0)
#define PG8_LD8(p) __builtin_shufflevector(*(const LAS i32x4*)(p), *(const LAS i32x4*)((p) + 1024), 0, 1, 2, 3, 4, 5, 6, 7)
#define PG8_LDA8(dst, b, h) do { _Pragma("unroll") for (int m = 0; m < 4; ++m) dst[m] = PG8_LD8(lds + PG8_SA(b, h) + aoff + m * 2048); } while (0)
#define PG8_LDB8(dst, b, h) do { _Pragma("unroll") for (int n = 0; n < 2; ++n) dst[n] = PG8_LD8(lds + PG8_SB(b, h) + boff + n * 2048); } while (0)
#define PG8_MMA8(ai, bj, A8, B8) do { __builtin_amdgcn_s_setprio(1); _Pragma("unroll") for (int m = 0; m < 4; ++m) _Pragma("unroll") for (int n = 0; n < 2; ++n) \
        asm volatile("v_mfma_f32_16x16x128_f8f6f4 %0, %1, %2, %0" : "+v"(acc[ai][bj][m][n]) : "v"(B8[n]), "v"(A8[m])); __builtin_amdgcn_s_setprio(0); } while (0)
#define PG8_LDA(dst, b, h) do { _Pragma("unroll") for (int m = 0; m < 4; ++m) _Pragma("unroll") for (int k = 0; k < 2; ++k) dst[m][k] = *(const LAS bf16x8*)(lds + PG8_SA(b, h) + aoff + m * 2048 + k * 1024); } while (0)
#define PG8_LDB(dst, b, h) do { _Pragma("unroll") for (int n = 0; n < 2; ++n) _Pragma("unroll") for (int k = 0; k < 2; ++k) dst[n][k] = *(const LAS bf16x8*)(lds + PG8_SB(b, h) + boff + n * 2048 + k * 1024); } while (0)
#define PG8_CAT(x) __builtin_shufflevector(__builtin_bit_cast(i32x4, (x)[0]), __builtin_bit_cast(i32x4, (x)[1]), 0, 1, 2, 3, 4, 5, 6, 7)
#define PG8_MMA(ai, bj, At, Bt) do { __builtin_amdgcn_s_setprio(1); _Pragma("unroll") for (int m = 0; m < 4; ++m) _Pragma("unroll") for (int n = 0; n < 2; ++n) _Pragma("unroll") for (int k = 0; k < 2; ++k) \
        acc[ai][bj][m][n] = __builtin_amdgcn_mfma_f32_16x16x32_bf16(Bt[n][k], At[m][k], acc[ai][bj][m][n], 0, 0, 0); __builtin_amdgcn_s_setprio(0); } while (0)
#define PG8_WAIT_V(n) asm volatile("s_waitcnt vmcnt(" #n ")" ::: "memory")
#define PG8_WAIT_L(n) asm volatile("s_waitcnt lgkmcnt(" #n ")" ::: "memory")
#define PG8_BAR __builtin_amdgcn_s_barrier()
#define PG8_SCHED __builtin_amdgcn_sched_barrier(0)
    Unit cur, nxt; int ui = 0;
    if (!S.next(0, cur)) return;
    f32x4 acc[2][2][4][2];
#pragma unroll
    for (int a = 0; a < 2; ++a)
#pragma unroll
        for (int b = 0; b < 2; ++b)
#pragma unroll
            for (int m = 0; m < 4; ++m)
#pragma unroll
                for (int n = 0; n < 2; ++n) acc[a][b][m][n] = (f32x4){0.f, 0.f, 0.f, 0.f};
    bf16x8 At[4][2], B0[2][2], B1[2][2]; i32x8 A8[4], B80[2], B81[2];
    const char* cA = cur.a; const char* cB = cur.b;
    PG8_STAGE(PG8_SB(0, 0), cB, voffB); PG8_STAGE(PG8_SB(0, 1), cB + hstepB, voffB); PG8_STAGE(PG8_SA(0, 0), cA, voffA); PG8_STAGE(PG8_SA(0, 1), cA + hstepA, voffA);
    if (wr == 1) PG8_BAR;
    PG8_WAIT_V(2); PG8_BAR;
    PG8_STAGE(PG8_SB(1, 0), cB + kstep, voffB); PG8_STAGE(PG8_SA(1, 0), cA + kstep, voffA); PG8_STAGE(PG8_SB(1, 1), cB + hstepB + kstep, voffB);
    PG8_WAIT_V(6); PG8_BAR;
    for (;;) {
        const bool has_next = S.next(ui + 1, nxt);
        const char* nA = has_next ? nxt.a : cA; const char* nB = has_next ? nxt.b : cB;
#pragma unroll 1
        for (int t = 0; t < nt; t += 2) {
            if constexpr (MIDK) { if (t == 8 || t == 16) { int fr_ = fr, fq_ = fq; asm volatile("" : "+v"(fr_), "+v"(fq_)); E.mid(acc, cur, t >> 4, wr, wc, fr_, fq_); } }
            const bool last = (t == nt - 2);
            const char* a1 = cA + (size_t)(t + 1) * kstep;
            const char* a2 = last ? nA : cA + (size_t)(t + 2) * kstep; const char* b2 = last ? nB : cB + (size_t)(t + 2) * kstep;
            const char* a3 = a2 + kstep; const char* b3 = b2 + kstep;
            if constexpr (F8) {
            PG8_LDB8(B80, 0, 0); PG8_LDB8(B81, 0, 1); PG8_SCHED; PG8_LDA8(A8, 0, 0); PG8_STAGE(PG8_SA(1, 1), a1 + hstepA, voffA);
            PG8_WAIT_V(8); PG8_WAIT_L(0); PG8_BAR; PG8_MMA8(0, 0, A8, B80); PG8_MMA8(0, 1, A8, B81); PG8_BAR; PG8_SCHED;
            PG8_LDA8(A8, 0, 1); PG8_STAGE(PG8_SB(0, 0), b2, voffB); PG8_STAGE(PG8_SB(0, 1), b2 + hstepB, voffB); PG8_STAGE(PG8_SA(0, 0), a2, voffA);
            PG8_WAIT_V(8); PG8_WAIT_L(0); PG8_BAR; PG8_MMA8(1, 0, A8, B80); PG8_MMA8(1, 1, A8, B81); PG8_BAR; PG8_SCHED;
            PG8_LDB8(B80, 1, 0); PG8_LDB8(B81, 1, 1); PG8_SCHED; PG8_LDA8(A8, 1, 0); PG8_STAGE(PG8_SA(0, 1), a2 + hstepA, voffA);
            PG8_WAIT_V(8); PG8_WAIT_L(0); PG8_BAR; PG8_MMA8(0, 0, A8, B80); PG8_MMA8(0, 1, A8, B81); PG8_BAR; PG8_SCHED;
            PG8_LDA8(A8, 1, 1); PG8_STAGE(PG8_SB(1, 0), b3, voffB); PG8_STAGE(PG8_SB(1, 1), b3 + hstepB, voffB); PG8_STAGE(PG8_SA(1, 0), a3, voffA);
            PG8_WAIT_V(8); PG8_WAIT_L(0); PG8_BAR; PG8_MMA8(1, 0, A8, B80); PG8_MMA8(1, 1, A8, B81); PG8_BAR; PG8_SCHED;
            } else {
            PG8_LDB(B0, 0, 0); PG8_LDB(B1, 0, 1); PG8_SCHED; PG8_LDA(At, 0, 0); PG8_STAGE(PG8_SA(1, 1), a1 + hstepA, voffA);
            PG8_WAIT_V(8); PG8_WAIT_L(0); PG8_BAR; PG8_MMA(0, 0, At, B0); PG8_MMA(0, 1, At, B1); PG8_BAR; PG8_SCHED;
            PG8_LDA(At, 0, 1); PG8_STAGE(PG8_SB(0, 0), b2, voffB); PG8_STAGE(PG8_SB(0, 1), b2 + hstepB, voffB); PG8_STAGE(PG8_SA(0, 0), a2, voffA);
            PG8_WAIT_V(8); PG8_WAIT_L(0); PG8_BAR; PG8_MMA(1, 0, At, B0); PG8_MMA(1, 1, At, B1); PG8_BAR; PG8_SCHED;
            PG8_LDB(B0, 1, 0); PG8_LDB(B1, 1, 1); PG8_SCHED; PG8_LDA(At, 1, 0); PG8_STAGE(PG8_SA(0, 1), a2 + hstepA, voffA);
            PG8_WAIT_V(8); PG8_WAIT_L(0); PG8_BAR; PG8_MMA(0, 0, At, B0); PG8_MMA(0, 1, At, B1); PG8_BAR; PG8_SCHED;
            PG8_LDA(At, 1, 1); PG8_STAGE(PG8_SB(1, 0), b3, voffB); PG8_STAGE(PG8_SB(1, 1), b3 + hstepB, voffB); PG8_STAGE(PG8_SA(1, 0), a3, voffA);
            PG8_WAIT_V(8); PG8_WAIT_L(0); PG8_BAR; PG8_MMA(1, 0, At, B0); PG8_MMA(1, 1, At, B1); PG8_BAR; PG8_SCHED;
            }
        }
        if (wr == 0) PG8_BAR;
        if constexpr (F8) asm volatile("s_nop 15\n\ts_nop 15" ::: "memory");
        { int fr_ = fr, fq_ = fq; asm volatile("" : "+v"(fr_), "+v"(fq_));
          E(acc, cur, wr, wc, fr_, fq_); }
        if (!has_next) break;
#pragma unroll
        for (int a = 0; a < 2; ++a)
#pragma unroll
            for (int b = 0; b < 2; ++b)
#pragma unroll
                for (int m = 0; m < 4; ++m)
#pragma unroll
                    for (int n = 0; n < 2; ++n) acc[a][b][m][n] = (f32x4){0.f, 0.f, 0.f, 0.f};
        cur = nxt; cA = nA; cB = nB; ++ui;
        if (wr == 1) PG8_BAR;
    }
    PG8_WAIT_V(0);
    PG8_BAR;
#undef PG8_SA
#undef PG8_SB
#undef PG8_STAGE
#undef PG8_LDA
#undef PG8_LDB
#undef PG8_MMA
#undef PG8_CAT
#undef PG8_LD8
#undef PG8_LDA8
#undef PG8_LDB8
#undef PG8_MMA8
#undef PG8_WAIT_V
#undef PG8_WAIT_L
#undef PG8_BAR
#undef PG8_SCHED
}
}

#define XB_TMO      128
#define XB_XCNT(j)  (256  + 64 * (j))
#define XB_XSUB(j)  (1280 + 64 * (j))
#define XB_XGEN(j)  (2304 + 64 * (j))
#define XB_TOP      3328
#define XB_TOPGEN   3392
#define XCD_BAR_WORDS 3456
#define XB_SPIN_CAP (1u << 22)
DI unsigned xb_ld(unsigned* p)              { return __hip_atomic_load(p, __ATOMIC_RELAXED, __HIP_MEMORY_SCOPE_AGENT); }
DI unsigned xb_add(unsigned* p, unsigned v) { return __hip_atomic_fetch_add(p, v, __ATOMIC_RELAXED, __HIP_MEMORY_SCOPE_AGENT); }
DI unsigned xb_xcc_id() { return (unsigned)__builtin_amdgcn_s_getreg((3 << 11) | 20) & 0xFu; }
#define XB_SPIN(cond, bar) do { unsigned _sp = 0; while (cond) { __builtin_amdgcn_s_sleep(1); \
    if ((++_sp & 255u) == 0u) { if (xb_ld(&(bar)[XB_TMO])) break; if (_sp > XB_SPIN_CAP) { atomicAdd(&(bar)[XB_TMO], 1u); break; } } } } while (0)
struct XcdBarrier { unsigned* bar; unsigned x; volatile LAS unsigned* st; };
DI XcdBarrier xcd_barrier_post(unsigned* bar, volatile LAS unsigned* st) {
    XcdBarrier b; b.bar = bar; b.x = xb_xcc_id(); b.st = st;
    if (threadIdx.x == 0) (void)xb_add(&bar[XB_XCNT(b.x)], 1u);
    return b;
}
DI void xcd_barrier_complete(unsigned* bar, unsigned x, unsigned& nloc, unsigned& nx) {
    const unsigned G = gridDim.x * gridDim.y * gridDim.z;
    unsigned sum, cnt, mine, sp = 0u;
    for (;;) {
        sum = 0u; cnt = 0u; mine = 0u;
#pragma unroll
        for (unsigned j = 0; j < 16; ++j) { const unsigned c = xb_ld(&bar[XB_XCNT(j)]); sum += c; cnt += (c > 0u) ? 1u : 0u; mine = (j == x) ? c : mine; }
        if (sum == G) break;
        __builtin_amdgcn_s_sleep(1);
        if ((++sp & 255u) == 0u) { if (xb_ld(&bar[XB_TMO])) break; if (sp > XB_SPIN_CAP) { atomicAdd(&bar[XB_TMO], 1u); break; } }
    }
    nloc = mine > 0u ? mine : 1u; nx = cnt > 0u ? cnt : 1u;
}
DI void xcd_barrier(const XcdBarrier& b) {
    asm volatile("s_waitcnt vmcnt(0)" ::: "memory");
    __syncthreads();
    if (threadIdx.x == 0) {
        unsigned* bar = b.bar;
        __builtin_amdgcn_s_waitcnt(0);
        unsigned nloc = b.st[0], nx = b.st[1];
        if (nloc == 0u) { xcd_barrier_complete(bar, b.x, nloc, nx); b.st[0] = nloc; b.st[1] = nx; }
        const unsigned old = xb_add(&bar[XB_XSUB(b.x)], 1u);
        const unsigned gen = old / nloc;
        if (old + 1u == (gen + 1u) * nloc) {
            __builtin_amdgcn_fence(__ATOMIC_RELEASE, "agent");
            asm volatile("s_waitcnt vmcnt(0)" ::: "memory");
            const unsigned og = xb_add(&bar[XB_TOP], 1u);
            const unsigned tg = og / nx;
            if (og + 1u == (tg + 1u) * nx) xb_add(&bar[XB_TOPGEN], 1u);
            else XB_SPIN(xb_ld(&bar[XB_TOPGEN]) == tg, bar);
            __builtin_amdgcn_fence(__ATOMIC_ACQUIRE, "agent");
            xb_add(&bar[XB_XGEN(b.x)], 1u);
            asm volatile("s_waitcnt vmcnt(0)" ::: "memory");
        } else {
            XB_SPIN(xb_ld(&bar[XB_XGEN(b.x)]) == gen, bar);
            __builtin_amdgcn_fence(__ATOMIC_ACQUIRE, "agent");
            asm volatile("s_waitcnt vmcnt(0)" ::: "memory");
        }
    }
    __syncthreads();
}

DI void transpose_item(const float* W, int ldw, bf16* WT, int ldt, LAS float* scr, int lane) {
    { const int kr = lane >> 3, c4 = (lane & 7) * 4; f32x4 v[8];
#pragma unroll
        for (int i = 0; i < 8; ++i) v[i] = *(const f32x4*)(W + (size_t)(8 * i + kr) * ldw + c4);
#pragma unroll
        for (int i = 0; i < 8; ++i) { LAS float* o = scr + (8 * i + kr) * 33 + c4; o[0] = v[i].x; o[1] = v[i].y; o[2] = v[i].z; o[3] = v[i].w; } }
    LDS_WAIT(); asm volatile("" ::: "memory");
    const int c = lane & 7;
#pragma unroll
    for (int j = 0; j < 4; ++j) { const int n = (lane >> 3) + 8 * j; const LAS float* s = scr + (8 * c) * 33 + n;
        u32x4 o; o.x = pk2(s[0 * 33], s[1 * 33]); o.y = pk2(s[2 * 33], s[3 * 33]); o.z = pk2(s[4 * 33], s[5 * 33]); o.w = pk2(s[6 * 33], s[7 * 33]);
        *(u32x4*)(WT + (size_t)n * ldt + 8 * c) = o; }
    LDS_WAIT(); asm volatile("" ::: "memory");
}
DI void transpose_item_f8(const float* W, int ldw, unsigned char* WT, int ldt, float scale, LAS float* scr, int lane) {
    { const int kr = lane >> 3, c4 = (lane & 7) * 4; f32x4 v[8];
#pragma unroll
        for (int i = 0; i < 8; ++i) v[i] = *(const f32x4*)(W + (size_t)(8 * i + kr) * ldw + c4);
#pragma unroll
        for (int i = 0; i < 8; ++i) { LAS float* o = scr + (8 * i + kr) * 33 + c4; o[0] = v[i].x; o[1] = v[i].y; o[2] = v[i].z; o[3] = v[i].w; } }
    LDS_WAIT(); asm volatile("" ::: "memory");
    const int c = lane & 3;
#pragma unroll
    for (int j = 0; j < 2; ++j) { const int n = (lane >> 2) + 16 * j; const LAS float* s = scr + (16 * c) * 33 + n;
        u32x4 o; o.x = pk4_f8(s[0 * 33] * scale, s[1 * 33] * scale, s[2 * 33] * scale, s[3 * 33] * scale); o.y = pk4_f8(s[4 * 33] * scale, s[5 * 33] * scale, s[6 * 33] * scale, s[7 * 33] * scale);
        o.z = pk4_f8(s[8 * 33] * scale, s[9 * 33] * scale, s[10 * 33] * scale, s[11 * 33] * scale); o.w = pk4_f8(s[12 * 33] * scale, s[13 * 33] * scale, s[14 * 33] * scale, s[15 * 33] * scale);
        *(u32x4*)(WT + (size_t)n * ldt + 16 * c) = o; }
    LDS_WAIT(); asm volatile("" ::: "memory");
}
DI void ti_load(const float* W, int ldw, int lane, f32x4 (&v)[8]) {
    const int kr = lane >> 3, c4 = (lane & 7) * 4;
#pragma unroll
    for (int i = 0; i < 8; ++i) v[i] = *(const f32x4*)(W + (size_t)(8 * i + kr) * ldw + c4);
}
DI void ti_store_f8(const f32x4 (&v)[8], unsigned char* WT, int ldt, float scale, LAS float* scr, int lane) {
    { const int kr = lane >> 3, c4 = (lane & 7) * 4;
#pragma unroll
        for (int i = 0; i < 8; ++i) { LAS float* o = scr + (8 * i + kr) * 33 + c4; o[0] = v[i].x; o[1] = v[i].y; o[2] = v[i].z; o[3] = v[i].w; } }
    LDS_WAIT(); asm volatile("" ::: "memory");
    const int c = lane & 3;
#pragma unroll
    for (int j = 0; j < 2; ++j) { const int n = (lane >> 2) + 16 * j; const LAS float* s = scr + (16 * c) * 33 + n;
        u32x4 o; o.x = pk4_f8(s[0 * 33] * scale, s[1 * 33] * scale, s[2 * 33] * scale, s[3 * 33] * scale); o.y = pk4_f8(s[4 * 33] * scale, s[5 * 33] * scale, s[6 * 33] * scale, s[7 * 33] * scale);
        o.z = pk4_f8(s[8 * 33] * scale, s[9 * 33] * scale, s[10 * 33] * scale, s[11 * 33] * scale); o.w = pk4_f8(s[12 * 33] * scale, s[13 * 33] * scale, s[14 * 33] * scale, s[15 * 33] * scale);
        *(u32x4*)(WT + (size_t)n * ldt + 16 * c) = o; }
    LDS_WAIT(); asm volatile("" ::: "memory");
}
DI void ti_load4(const float* W, int ldw, int lane, f32x4 (&v)[8]) {
    const int a = lane & 15, g = lane >> 4;
#pragma unroll
    for (int b = 0; b < 2; ++b)
#pragma unroll
        for (int j = 0; j < 4; ++j) v[4 * b + j] = *(const f32x4*)(W + (size_t)(4 * a + j) * ldw + 4 * (g + 4 * b));
}
DI void ti_store4_f8(const f32x4 (&v)[8], unsigned char* WT, int ldt, float scale, int lane) {
    const int a = lane & 15, g = lane >> 4;
#pragma unroll
    for (int b = 0; b < 2; ++b)
#pragma unroll
        for (int q = 0; q < 4; ++q)
            *(unsigned*)(WT + (size_t)(4 * (g + 4 * b) + q) * ldt + 4 * a) = pk4_f8(v[4 * b][q] * scale, v[4 * b + 1][q] * scale, v[4 * b + 2][q] * scale, v[4 * b + 3][q] * scale);
}
DI void ln16(f32x4 (&v)[4], const f32x4 (&g)[4], const f32x4 (&b)[4]) {
    float s = 0.f;
#pragma unroll
    for (int j = 0; j < 4; ++j) s += (v[j].x + v[j].y) + (v[j].z + v[j].w);
    const float mean = wave_sum(s) * (1.f / D); float s2 = 0.f;
#pragma unroll
    for (int j = 0; j < 4; ++j) { v[j] = v[j] - mean; s2 += (v[j].x * v[j].x + v[j].y * v[j].y) + (v[j].z * v[j].z + v[j].w * v[j].w); }
    const float rstd = 1.f / sqrtf(wave_sum(s2) * (1.f / D) + LN_EPS);
#pragma unroll
    for (int j = 0; j < 4; ++j) v[j] = v[j] * rstd * g[j] + b[j];
}
DI void gates8(const f32x4 (&y)[4], const LAS float* wgt, float* gif_row, int lane) {
    float p[8];
#pragma unroll
    for (int j = 0; j < 8; ++j) { float s = 0.f;
#pragma unroll
        for (int jj = 0; jj < 4; ++jj) { const f32x4 w = *(const LAS f32x4*)(wgt + j * 1024 + 256 * jj + 4 * lane); s += (y[jj].x * w.x + y[jj].y * w.y) + (y[jj].z * w.z + y[jj].w * w.w); }
        p[j] = wave_sum(s); }
    if (lane == 0) { *(f32x4*)gif_row = (f32x4){p[0], p[1], p[2], p[3]}; *(f32x4*)(gif_row + 4) = (f32x4){p[4], p[5], p[6], p[7]}; }
}
DI void gates8b(const f32x4 (&y)[4], const LAS float* wgt, float* gif_row, int lane) {
    float p[8];
#pragma unroll
    for (int j = 0; j < 8; ++j) { float s = 0.f;
#pragma unroll
        for (int jj = 0; jj < 4; ++jj) { const f32x4 w = *(const LAS f32x4*)(wgt + j * 1024 + (jj >> 1) * 512 + 8 * lane + (jj & 1) * 4); s += (y[jj].x * w.x + y[jj].y * w.y) + (y[jj].z * w.z + y[jj].w * w.w); }
        p[j] = wave_sum(s); }
    if (lane == 0) { *(f32x4*)gif_row = (f32x4){p[0], p[1], p[2], p[3]}; *(f32x4*)(gif_row + 4) = (f32x4){p[4], p[5], p[6], p[7]}; }
}
DI void load_gate_table(LAS float* wgt, const float* win_l, int tid) {
    for (int i = tid; i < 8192; i += NTHR) { const int k = i >> 3, j = i & 7; wgt[j * 1024 + k] = win_l[(size_t)k * DIN + 1536 + j]; }
}
DI f32x4 ld4bf(const char* p) { const u32x2 w = *(const u32x2*)p; return (f32x4){bflo(w.x), bfhi(w.x), bflo(w.y), bfhi(w.y)}; }
DI void st4bf(char* p, const f32x4& v) { u32x2 w; w.x = pk2(v.x, v.y); w.y = pk2(v.z, v.w); *(u32x2*)p = w; }

struct Args { const float* in[N_IN]; float* out; unsigned char* ws; int ph_lo, ph_hi; };
constexpr int NP_LAYER = 12, NPH = 1 + DEPTH * NP_LAYER;
constexpr int XW_SPLIT = 49152;

struct SchedInproj {
    pg8::TileOrder T; int G, c; const char *X, *W; char* U; bool kv; const char *MEMN, *WKV; char* KV;
    DI bool next(int i, pg8::Unit& u) const {
        const long L = (long)i * G + c; int pm, pn;
        if (T.tile(L, pm, pn)) { u.a = X + (size_t)pm * 256 * D * 2; u.b = W + (size_t)pn * 256 * D * 2; u.r0 = pm * 256; u.c0 = pn * 256; u.c = U + ((size_t)u.r0 * NU + u.c0) * 2; u.ldc = NU; u.e = 0; u.sub = 0; return true; }
        if (!kv) return false;
        const long L2 = L - T.nwg; if (L2 < 0 || L2 >= 128) return false;
        const int l = (int)L2 >> 6, t = (int)L2 & 63; pm = t >> 2; pn = t & 3;
        u.a = MEMN + (size_t)pm * 256 * D * 2; u.b = WKV + ((size_t)l * 1024 + pn * 256) * D * 2; u.r0 = pm * 256; u.c0 = pn * 256; u.c = KV + (((size_t)l * MROWS + u.r0) * D + u.c0) * 2; u.ldc = D; u.e = 0; u.sub = 0; return true;
    }
};
struct SchedPlain {
    pg8::TileOrder T; int G, c; const char *A, *B; char* C; int lda, ldb, ldc;
    DI bool next(int i, pg8::Unit& u) const {
        const long L = (long)i * G + c; int pm, pn; if (!T.tile(L, pm, pn)) return false;
        u.a = A + (size_t)pm * 256 * lda * 2; u.b = B + (size_t)pn * 256 * ldb * 2; u.r0 = pm * 256; u.c0 = pn * 256; u.c = C + ((size_t)u.r0 * ldc + u.c0) * 2; u.ldc = ldc; u.e = 0; u.sub = 0; return true;
    }
};
struct SchedMerge {
    pg8::TileOrder T; int G, c; const char *H, *W; char* Y;
    DI bool next(int i, pg8::Unit& u) const {
        const int ti = i / 3, br = i - 3 * ti; const long L = (long)ti * G + c; int pm, pn; if (!T.tile(L, pm, pn)) return false;
        u.a = H + ((size_t)pm * 256 * 1536 + br * 512) * 2; u.b = W + ((size_t)br * 1024 + pn * 256) * 512 * 2; u.r0 = pm * 256; u.c0 = pn * 256; u.c = Y + ((size_t)u.r0 * D + u.c0) * 2; u.ldc = D; u.e = 0; u.sub = br; return true;
    }
};
struct SchedMoe {
    pg8::TileOrder T; int G, c; const char *A, *W; char* C; const LAS int* PB; int wrows  , ldc, cdiv, osz;
    DI bool next(int i, pg8::Unit& u) const {
        const long L = (long)i * G + c; int pm, pn; if (!T.tile(L, pm, pn)) return false;
        int e = 0;
#pragma unroll 1
        for (int j = 1; j < NEXP; ++j) e += (PB[j] <= pm) ? 1 : 0;
        u.a = A + (size_t)pm * 256 * 1024; u.b = W + ((size_t)e * wrows + pn * 256) * 1024; u.r0 = pm * 256; u.c0 = pn * 256; u.c = C + ((size_t)u.r0 * ldc + u.c0 / cdiv) * osz; u.ldc = ldc; u.e = e; u.sub = 0; return true;
    }
};

__global__ void __launch_bounds__(NTHR, 2) fwd_kernel(Args args) {
    extern __shared__ __attribute__((aligned(16))) unsigned char lds_raw[];
#define INP(i) ([&]() -> const float* { int ii_ = (i); asm volatile("" : "+s"(ii_)); return args.in[ii_]; }())
    LAS unsigned char* lds = (LAS unsigned char*)lds_raw;
    volatile LAS unsigned* LCTL = (volatile LAS unsigned*)(lds + LDSCTL_OFF);
    const int tid0 = threadIdx.x, wave = __builtin_amdgcn_readfirstlane(tid0 >> 6);
#define PHASE_TID unsigned z_ = 0u; asm volatile("" : "+v"(z_)); int tid = wave * 64 + (int)__builtin_amdgcn_mbcnt_hi(~0u, __builtin_amdgcn_mbcnt_lo(~0u, z_)); const int lane = tid & 63; (void)lane;
    const int G = gridDim.x, bx = blockIdx.x;
    const int gw = bx * NWAVES + wave, NGW = G * NWAVES;
    unsigned char* ws = args.ws;
    gu32* ctl = (gu32*)(ws + WS_CTL);
    for (int u = tid0; u < (LDS_BYTES - LDSCTL_OFF) / 4; u += NTHR) ((LAS unsigned*)(lds + LDSCTL_OFF))[u] = 0u;
    __syncthreads();
    XcdBarrier bar; bar.bar = (unsigned*)ctl + CW_BAR; bar.x = 0; bar.st = nullptr;
    if (MK_ONE_LAUNCH) bar = xcd_barrier_post((unsigned*)ctl + CW_BAR, LCTL);
    const int lo = args.ph_lo, hi = args.ph_hi;
#ifndef SUBMASK
#define SUBMASK 7
#endif
#ifndef LN2PROBE
#define LN2PROBE 0
#endif
#ifndef SUBDUP
#define SUBDUP 0
#endif
#define NSUB(k) ((((SUBDUP) >> (k)) & 1) ? 2 : 1)
#ifndef DUPMASK
#define DUPMASK 0
#endif
#define NREP(k) ((((DUPMASK) >> (k)) & 1) ? 2 : 1)
#ifndef PHMASK
#define PHMASK 0xFFFF
#endif
#define IN(k) (lo <= (k) && (k) < hi)
#define SEAM(k) do { if (IN(k) && IN((k) + 1)) xcd_barrier(bar); } while (0)

    char* const Xb = (char*)(ws + WS_X);
    char* const Ub = (char*)(ws + WS_R1);
    float* const GIF = (float*)(ws + WS_GIF);
    LAS int* const PB = (LAS int*)(lds + LDSCTL_OFF + 64);
    LAS int* const CNT = (LAS int*)(lds + LDSCTL_OFF + 256);

    _Pragma("unroll 1") for (int rep_ = 0; rep_ < NREP(12); ++rep_) if (((PHMASK>>12)&1) && IN(0)) { PHASE_TID
        LAS float* scr = (LAS float*)(lds + wave * 8448);
        LAS float* wgt = (LAS float*)(lds + 73728);
        load_gate_table(wgt, INP(I_WIN), tid);
        constexpr int IT_IN = 16 * 216, IT_KV = 16 * 32, IT_BR = 8 * 32, IT_O = 16 * 32, IT_L = IT_IN + IT_KV + 3 * IT_BR + IT_O;
        for (int it = gw; it < DEPTH * IT_L; it += NGW) {
            const int l = it / IT_L; int r = it - l * IT_L;
            if (r < IT_IN) { const int kb = r / 216, nb = r % 216, n0 = 32 * nb, sc = ucol_src(n0);
                if (n0 < UC_F8) transpose_item(INP(I_WIN) + ((size_t)l * D + 64 * kb) * DIN + sc, DIN, (bf16*)(ws + WS_WIN) + ((size_t)l * NU + n0) * D + 64 * kb, D, scr, lane);
                else transpose_item_f8(INP(I_WIN) + ((size_t)l * D + 64 * kb) * DIN + sc, DIN, (unsigned char*)(ws + WS_WING8) + ((size_t)l * NF8 + (n0 - UC_F8)) * D + 64 * kb, D, F8_SWGU, scr, lane);
                continue; }
            r -= IT_IN;
            if (r < IT_KV) { const int kb = r / 32, nb = r % 32;
                transpose_item(INP(I_CAWKV) + ((size_t)l * D + 64 * kb) * 1024 + 32 * nb, 1024, (bf16*)(ws + WS_WKV) + ((size_t)l * 1024 + 32 * nb) * D + 64 * kb, D, scr, lane); continue; }
            r -= IT_KV;
            if (r < 3 * IT_BR) { const int br = r / IT_BR, q = r % IT_BR, kb = q / 32, nb = q % 32;
                const float* src = INP(br == 0 ? I_WBRML : (br == 1 ? I_WBRRW : I_WBRCA));
                transpose_item(src + ((size_t)l * 512 + 64 * kb) * 1024 + 32 * nb, 1024, (bf16*)(ws + WS_WBR) + ((size_t)l * 1024 + 32 * nb) * 1536 + br * 512 + 64 * kb, 1536, scr, lane); continue; }
            r -= 3 * IT_BR;
            { const int kb = r / 32, nb = r % 32;
                transpose_item(INP(I_WO) + ((size_t)l * D + 64 * kb) * 1024 + 32 * nb, 1024, (bf16*)(ws + WS_WO) + ((size_t)l * 1024 + 32 * nb) * D + 64 * kb, D, scr, lane); }
        }
        for (int i = bx * NTHR + tid; i < DEPTH * 1536 * 256; i += G * NTHR) {
            const int l = i / (1536 * 256), r = i % (1536 * 256), n = r >> 8, k = r & 255; float v = 0.f;
            if (n < 512) { if (k < 64) v = INP(I_RWWUP)[((size_t)l * 64 + k) * 512 + n]; }
            else if (n < 1024) { if (k >= 64 && k < 128) v = INP(I_RWAUP)[((size_t)l * 64 + (k - 64)) * 512 + (n - 512)]; }
            else { if (k >= 128) v = INP(I_RWGUP)[((size_t)l * 128 + (k - 128)) * 512 + (n - 1024)]; }
            ((bf16*)(ws + WS_WLORA))[i] = (bf16)f2bf(v);
        }
        __syncthreads();
        {
            f32x4 g[4], b[4];
#pragma unroll
            for (int j = 0; j < 4; ++j) { g[j] = *(const f32x4*)(INP(I_LNIN_G) + 256 * j + 4 * lane); b[j] = *(const f32x4*)(INP(I_LNIN_B) + 256 * j + 4 * lane); }
            for (int m = gw; m < M; m += NGW) {
                f32x4 v[4]; const float* xr = INP(I_X) + (size_t)m * D;
#pragma unroll
                for (int j = 0; j < 4; ++j) v[j] = *(const f32x4*)(xr + 256 * j + 4 * lane);
                ln16(v, g, b);
#pragma unroll
                for (int j = 0; j < 4; ++j) { st4bf(Xb + ((size_t)m * D + 256 * j + 4 * lane) * 2, v[j]); *(unsigned*)((char*)(ws + WS_XF8) + (size_t)m * D + 256 * j + 4 * lane) = pk4_f8(v[j].x * F8_SX, v[j].y * F8_SX, v[j].z * F8_SX, v[j].w * F8_SX); }
                gates8(v, wgt, GIF + (size_t)m * 8, lane);
            }
#pragma unroll
            for (int j = 0; j < 4; ++j) { g[j] = *(const f32x4*)(INP(I_MEMLN_G) + 256 * j + 4 * lane); b[j] = *(const f32x4*)(INP(I_MEMLN_B) + 256 * j + 4 * lane); }
            for (int m = gw; m < MROWS; m += NGW) {
                f32x4 v[4]; const float* xr = INP(I_MEM) + (size_t)m * D;
#pragma unroll
                for (int j = 0; j < 4; ++j) v[j] = *(const f32x4*)(xr + 256 * j + 4 * lane);
                ln16(v, g, b);
#pragma unroll
                for (int j = 0; j < 4; ++j) st4bf((char*)(ws + WS_MEMN) + ((size_t)m * D + 256 * j + 4 * lane) * 2, v[j]);
            }
        }
        __syncthreads();
    }
    SEAM(0);

#pragma unroll 1
    for (int l = 0; l < DEPTH; ++l) {
        const int pb = 1 + l * NP_LAYER;
        _Pragma("unroll 1") for (int rep_ = 0; rep_ < NREP(0); ++rep_) if (((PHMASK>>0)&1) && IN(pb + 0)) {
            SchedInproj S; S.T.init(M / 256, UC_F8 / 256); S.G = G; S.c = bx; S.X = Xb; S.W = (const char*)(ws + WS_WIN) + (size_t)l * NU * D * 2; S.U = Ub;
            S.kv = (l == 0); S.MEMN = (const char*)(ws + WS_MEMN); S.WKV = (const char*)(ws + WS_WKV); S.KV = (char*)(ws + WS_KV);
            pg8::EpiStore E;
            pg8::gemm_phase<false>(lds, D * 2, D * 2, D * 2, S, E, wave);
            SchedPlain S8; S8.T.init(M / 256, NF8 / 256); S8.G = G; S8.c = bx; S8.A = (const char*)(ws + WS_XF8); S8.B = (const char*)(ws + WS_WING8) + (size_t)l * NF8 * D; S8.C = Ub + UC_F8 * 2;
            S8.lda = 512; S8.ldb = 512; S8.ldc = NU;
            pg8::EpiStoreS E8; E8.s = F8_INV1; E8.gate_b = INP(I_GATEB) + (size_t)l * 3072; E8.gate_c0 = UC_GATE - UC_F8;
            pg8::gemm_phase<true>(lds, D, D, D, S8, E8, wave);
        }
        SEAM(pb + 0);
        _Pragma("unroll 1") for (int rep_ = 0; rep_ < NREP(1); ++rep_) if (((PHMASK>>1)&1) && IN(pb + 1)) { PHASE_TID
            const float* mu = INP(I_RWMU) + (size_t)l * 1792 + 1536;
            char* LIN = (char*)(ws + WS_R2 + R2_LORA_IN);
            for (int it = bx * NTHR + tid; it < M * 32; it += G * NTHR) {
                const int row = it >> 5, c = (it & 31) * 8;
                const u32x4 cw = *(const u32x4*)(Ub + ((size_t)row * NU + UC_RW + 1536 + c) * 2);
                u32x4 pw = (u32x4){0u, 0u, 0u, 0u};
                if ((row & (SEQ - 1)) != 0) pw = *(const u32x4*)(Ub + ((size_t)(row - 1) * NU + UC_RW + 1536 + c) * 2);
                const f32x4 m0 = *(const f32x4*)(mu + c), m1 = *(const f32x4*)(mu + c + 4);
                float x[8] = {bflo(cw.x), bfhi(cw.x), bflo(cw.y), bfhi(cw.y), bflo(cw.z), bfhi(cw.z), bflo(cw.w), bfhi(cw.w)};
                const float p[8] = {bflo(pw.x), bfhi(pw.x), bflo(pw.y), bfhi(pw.y), bflo(pw.z), bfhi(pw.z), bflo(pw.w), bfhi(pw.w)};
                const float mm[8] = {m0.x, m0.y, m0.z, m0.w, m1.x, m1.y, m1.z, m1.w};
#pragma unroll
                for (int i = 0; i < 8; ++i) { float xs = x[i] + (p[i] - x[i]) * mm[i];
                    if (c < 64) xs = 1.f - 2.f * __builtin_amdgcn_rcpf(1.f + __builtin_amdgcn_exp2f(2.8853900817779268f * xs));
                    else if (c >= 128) xs = sigmoidf_(xs);
                    x[i] = xs; }
                u32x4 o; o.x = pk2(x[0], x[1]); o.y = pk2(x[2], x[3]); o.z = pk2(x[4], x[5]); o.w = pk2(x[6], x[7]);
                *(u32x4*)(LIN + ((size_t)row * 256 + c) * 2) = o;
            }
        }
        SEAM(pb + 1);
        _Pragma("unroll 1") for (int rep_ = 0; rep_ < NREP(2); ++rep_) if (((PHMASK>>2)&1) && IN(pb + 2)) {
            SchedPlain S; S.T.init(M / 256, 6); S.G = G; S.c = bx; S.A = (const char*)(ws + WS_R2 + R2_LORA_IN); S.B = (const char*)(ws + WS_WLORA) + (size_t)l * 1536 * 256 * 2; S.C = (char*)(ws + WS_R2 + R2_LORA_OUT);
            S.lda = 256; S.ldb = 256; S.ldc = 1536;
            pg8::EpiStore E;
            pg8::gemm_phase<false>(lds, 512, 512, 512, S, E, wave);
        }
        SEAM(pb + 2);
        _Pragma("unroll 1") for (int rep_ = 0; rep_ < NREP(3); ++rep_) if (((PHMASK>>3)&1) && IN(pb + 3)) { PHASE_TID
            const char* LO = (const char*)(ws + WS_R2 + R2_LORA_OUT);
            char* HC = (char*)(ws + WS_R2 + R2_HCAT);
            const int tid_ph = tid;
#define SUB_TID unsigned zs_ = 0u; asm volatile("" : "+v"(zs_)); int tid = wave * 64 + (int)__builtin_amdgcn_mbcnt_hi(~0u, __builtin_amdgcn_mbcnt_lo(~0u, zs_)); const int lane = tid & 63; (void)lane;
#pragma unroll 1
            for (int job = bx; job < 256; job += G) {
                if (job < 128) { _Pragma("unroll 1") for (int sr_ = 0; sr_ < NSUB(0); ++sr_) if ((SUBMASK>>0)&1) {
                    SUB_TID
                    const int b = job >> 3, h = job & 7;
                    constexpr int TC = 32, PT = 144, P16 = 48, IMG = 25856;
                    LAS float* OPS = (LAS float*)lds;
                    LAS float* OUTB = OPS + TC * 384;
                    LAS float* BON = OUTB + TC * 64;
                    LAS unsigned char* IM0 = lds + 57600;
                    LAS float* VEP = (LAS float*)(lds + 109312);
                    LAS unsigned char* GKB = (LAS unsigned char*)(VEP + 2 * TC * 64);
                    LAS float* PARF = (LAS float*)(lds + 142080);
                    const int pt = tid >> 4, cs = tid & 15, pc = cs * 4, hc = h * 64 + pc;
                    const int p1t = (tid >> 3) & 31, c8 = (tid & 7) * 8, hc8 = h * 64 + c8;
                    const int r31 = lane & 31, h2 = lane >> 5;
                    f32x16 Sreg[2];
#pragma unroll
                    for (int i = 0; i < 16; ++i) { Sreg[0][i] = 0.f; Sreg[1][i] = 0.f; }
#pragma unroll 1
                    for (int a = wave; a < 10; a += 8) {
                        const int ii = (a < 3) ? I_RWMU : (a == 3) ? I_RWW0 : (a == 4) ? I_RWA0 : (a == 5) ? I_RWKK : (a == 6) ? I_RWKA : (a == 7) ? I_RWRK : (a == 8) ? I_RWLNG : I_RWLNB;
                        const size_t po = (a < 3) ? ((size_t)l * 1792 + a * 512) : (size_t)l * 512;
                        PARF[a * 64 + lane] = (INP(ii) + po)[h * 64 + lane];
                    }
#define SETPU(j, q_) do { const u32x4 q__ = (q_); Sreg[(j) >> 2][((j) & 3) * 4] = u2f_(q__.x); Sreg[(j) >> 2][((j) & 3) * 4 + 1] = u2f_(q__.y); \
                          Sreg[(j) >> 2][((j) & 3) * 4 + 2] = u2f_(q__.z); Sreg[(j) >> 2][((j) & 3) * 4 + 3] = u2f_(q__.w); } while (0)
#define PUW(j, c) f2u_(Pc[(j) >> 2][((j) & 3) * 4 + (c)])
#define PUWS(j, c) f2u_(Sreg[(j) >> 2][((j) & 3) * 4 + (c)])
#define UNPJ(j, hh) ((f32x4){bflo(PUW(j, 2 * (hh))), bfhi(PUW(j, 2 * (hh))), bflo(PUW(j, 2 * (hh) + 1)), bfhi(PUW(j, 2 * (hh) + 1))})
#define UNPH(q_, hh) ((hh) ? (f32x4){bflo((q_).z), bfhi((q_).z), bflo((q_).w), bfhi((q_).w)} : (f32x4){bflo((q_).x), bfhi((q_).x), bflo((q_).y), bfhi((q_).y)})
                    auto LOADC = [&](int t0) {
                        const int t = t0 + p1t; const size_t row = (size_t)b * SEQ + t; const char* up = Ub + (row * NU + UC_RW + hc8) * 2;
                        SETPU(0, *(const u32x4*)up); SETPU(1, *(const u32x4*)(up + 1024)); SETPU(2, *(const u32x4*)(up + 2048));
                        if (t > 0) { const char* pp = up - (size_t)NU * 2; SETPU(3, *(const u32x4*)pp); SETPU(4, *(const u32x4*)(pp + 1024)); SETPU(5, *(const u32x4*)(pp + 2048)); }
                        else { const u32x4 z4 = (u32x4){0u, 0u, 0u, 0u}; SETPU(3, z4); SETPU(4, z4); SETPU(5, z4); }
                        const char* lp = LO + (row * 1536 + hc8) * 2; SETPU(6, *(const u32x4*)lp); SETPU(7, *(const u32x4*)(lp + 1024));
                    };
                    const int gq = tid - 128, gt = (gq >> 2) & 31, gp = (gq & 3) * 16;
                    auto LOADG = [&](int t0) {
                        const char* gp_ = LO + (((size_t)b * SEQ + t0 + gt) * 1536 + 1024 + h * 64 + gp) * 2;
                        SETPU(0, *(const u32x4*)gp_); SETPU(1, *(const u32x4*)(gp_ + 16));
                    };
                    auto PASS1 = [&](int t1, int par1, bool more) {
                        int hcv = hc8; asm volatile("" : "+v"(hcv));
                        const f32x16 Pc[2] = {Sreg[0], Sreg[1]};
                        if (more) LOADC(t1 + TC);
                        const LAS float* MU = PARF + c8;
                        const LAS float* W0 = PARF + 192 + c8; const LAS float* A0 = PARF + 256 + c8; const LAS float* KKW = PARF + 320 + c8;
                        const LAS float* KAW = PARF + 384 + c8; const LAS float* RKW = PARF + 448 + c8;
                        f32x4 dec[2], av[2], kkv[2], kp[2], xr[2], xv[2]; float ss = 0.f, bsum = 0.f;
#pragma unroll
                        for (int hh = 0; hh < 2; ++hh) {
                            const f32x4 mu_r = *(const LAS f32x4*)(MU + 4 * hh), mu_k = *(const LAS f32x4*)(MU + 64 + 4 * hh), mu_v = *(const LAS f32x4*)(MU + 128 + 4 * hh);
                            const f32x4 w0 = *(const LAS f32x4*)(W0 + 4 * hh), a0 = *(const LAS f32x4*)(A0 + 4 * hh), kkw = *(const LAS f32x4*)(KKW + 4 * hh), kaw = *(const LAS f32x4*)(KAW + 4 * hh), rkw = *(const LAS f32x4*)(RKW + 4 * hh);
                            const f32x4 ur = UNPJ(0, hh), uk = UNPJ(1, hh), uv = UNPJ(2, hh), urp = UNPJ(3, hh), ukp = UNPJ(4, hh), uvp = UNPJ(5, hh), lw = UNPJ(6, hh), la = UNPJ(7, hh);
                            xr[hh] = ur + (urp - ur) * mu_r; const f32x4 xk = uk + (ukp - uk) * mu_k; xv[hh] = uv + (uvp - uv) * mu_v;
#pragma unroll
                            for (int i = 0; i < 4; ++i) {
                                const float y = -(w0[i] + lw[i]);
                                const float sp = fmaxf(y, 0.f) + __logf(1.f + __expf(-fabsf(y)));
                                dec[hh][i] = __expf(-__expf(-sp - 0.5f));
                                av[hh][i] = sigmoidf_(a0[i] + la[i]);
                                kkv[hh][i] = xk[i] * kkw[i]; ss += kkv[hh][i] * kkv[hh][i];
                                kp[hh][i] = xk[i] * (1.f + (av[hh][i] - 1.f) * kaw[i]);
                                bsum += xr[hh][i] * kp[hh][i] * rkw[i];
                            }
                            __builtin_amdgcn_sched_barrier(0);
                        }
                        ss = red8(ss); bsum = red8(bsum);
                        const float inv = __builtin_amdgcn_rsqf(fmaxf(ss, 1e-24f));
#pragma unroll
                        for (int hh = 0; hh < 2; ++hh) {
                            const f32x4 kk = kkv[hh] * inv, kka = kk * av[hh];
                            LAS float* o = OPS + p1t * 384 + c8 + 4 * hh;
                            *(LAS f32x4*)(o) = dec[hh]; *(LAS f32x4*)(o + 64) = kk; *(LAS f32x4*)(o + 128) = kka; *(LAS f32x4*)(o + 192) = kp[hh]; *(LAS f32x4*)(o + 256) = xr[hh]; *(LAS f32x4*)(o + 320) = xv[hh];
                            *(LAS f32x4*)(VEP + par1 * 2048 + p1t * 64 + c8 + 4 * hh) = xv[hh];
                        }
                        if ((tid & 7) == 0) BON[par1 * 32 + p1t] = bsum;
                    };
#define UNP4(w) ((f32x4){bflo((w).x), bfhi((w).x), bflo((w).y), bfhi((w).y)})
#define DOT4(a, b) (((a).x * (b).x + (a).y * (b).y) + ((a).z * (b).z + (a).w * (b).w))
#define PACK8(x, s) __builtin_bit_cast(bf16x8, (u32x4){pk2((x)[8 * (s)], (x)[8 * (s) + 1]), pk2((x)[8 * (s) + 2], (x)[8 * (s) + 3]), pk2((x)[8 * (s) + 4], (x)[8 * (s) + 5]), pk2((x)[8 * (s) + 6], (x)[8 * (s) + 7])})
#define LD2x64(p) __builtin_bit_cast(bf16x8, (u32x4){(*(const LAS u32x2*)(p)).x, (*(const LAS u32x2*)(p)).y, (*(const LAS u32x2*)((p) + 16)).x, (*(const LAS u32x2*)((p) + 16)).y})
                    auto EPI = [&](int te, int pe) {
                        const int et = ((wave >> 2) * 2 + (wave & 1)) * 64 + lane, pce = (et & 15) * 4;
                        const f32x4 lng = *(const LAS f32x4*)(PARF + 512 + pce), lnb = *(const LAS f32x4*)(PARF + 576 + pce);
#pragma unroll
                        for (int it = 0; it < 2; ++it) {
                            const int pte = (et >> 4) + 16 * it;
                            const u32x2 gkw = *(const LAS u32x2*)(GKB + pe * 4096 + pte * 128 + pce * 2);
                            const f32x4 o4 = *(const LAS f32x4*)(OUTB + pte * 64 + pce), v4 = *(const LAS f32x4*)(VEP + pe * 2048 + pte * 64 + pce), gk = UNP4(gkw);
                            const float mean = red16((o4.x + o4.y) + (o4.z + o4.w)) * (1.f / 64.f);
                            const f32x4 dv = o4 - mean;
                            const float var = red16(DOT4(dv, dv)) * (1.f / 64.f);
                            const float rstd = __builtin_amdgcn_rsqf(var + RW_GN_EPS), bo = BON[pe * 32 + pte];
                            const f32x4 y = (dv * rstd * lng + lnb + v4 * bo) * gk;
                            st4bf(HC + (((size_t)b * SEQ + te + pte) * 1536 + 512 + h * 64 + pce) * 2, y);
                        }
                    };
                    if (wave >= 4) LOADC(0); else if (wave >= 2) LOADG(0);
#pragma unroll 1
                    for (int t0 = -TC; t0 < SEQ; t0 += TC) {
                        const int par = (t0 >> 5) & 1;
                        __syncthreads();
                        if (t0 >= 0)
                        {
                            const int sc = wave >> 2, wq = wave & 3;
                            LAS unsigned char* im = IM0 + sc * IMG;
                            LAS unsigned char* KR = im; LAS unsigned char* BGr = im + 4608; LAS unsigned char* VT = im + 15360;
                            LAS unsigned char* TT = im + 18432; LAS unsigned char* BB = im + 19968; LAS float* ZF = (LAS float*)(im + 21504); LAS float* PL = (LAS float*)(im + 25600);
                            {
                                float P = 1.f;
#pragma unroll
                                for (int t = 0; t < 12; ++t) { const float wv = OPS[(16 * sc + t) * 384 + lane]; P *= (t < 4 * wq) ? wv : 1.f; }
#pragma unroll
                                for (int q = 0; q < 4; ++q) { const int t = 4 * wq + q; const LAS float* o = OPS + (16 * sc + t) * 384 + lane;
                                    const float w = o[0], z = o[64], bb = o[128], kp = o[192], rr = o[256], vv = o[320];
                                    const float kap = z * P; P *= w; const float rho = rr * P, ip = __builtin_amdgcn_rcpf(P), bet = bb * ip, gam = kp * ip;
                                    *(LAS bf16*)(KR + t * PT + lane * 2) = (bf16)f2bf(kap); *(LAS bf16*)(KR + (16 + t) * PT + lane * 2) = (bf16)f2bf(rho);
                                    *(LAS bf16*)(BGr + t * PT + lane * 2) = (bf16)f2bf(bet); *(LAS bf16*)(BGr + (16 + t) * PT + lane * 2) = (bf16)f2bf(gam);
                                    *(LAS bf16*)(VT + t * PT + lane * 2) = (bf16)f2bf(vv); }
                                if (wq == 3) PL[lane] = P;
                            }
                            __syncthreads();
                            if (wq <= 1) {
                                f32x16 Z;
#pragma unroll
                                for (int i = 0; i < 16; ++i) Z[i] = 0.f;
#pragma unroll
                                for (int ks = 0; ks < 4; ++ks) Z = __builtin_amdgcn_mfma_f32_32x32x16_bf16(*(const LAS bf16x8*)(KR + r31 * PT + (16 * ks + 8 * h2) * 2), *(const LAS bf16x8*)(BGr + r31 * PT + (16 * ks + 8 * h2) * 2), Z, 0, 0, 0);
                                const int jj = (r31 & 15) - 4 * h2;
#pragma unroll
                                for (int i = 0; i < 16; ++i) { const int tb = (i & 3) + 8 * ((i >> 2) & 1); const bool keep = (i >= 8) ? (jj <= tb) : (jj < tb); Z[i] = keep ? Z[i] : 0.f; }
                              if (wq == 1) {
                                if (r31 >= 16) {
#pragma unroll
                                    for (int i = 0; i < 16; ++i) *(LAS bf16*)(BB + ((i & 3) + 8 * (i >> 2) + 4 * h2) * P16 + (r31 - 16) * 2) = (bf16)f2bf(Z[i]);
                                }
                              } else {
                                if (r31 < 16) {
#pragma unroll
                                    for (int i = 0; i < 16; ++i) ZF[((i & 3) + 8 * (i >> 2) + 4 * h2) * 32 + r31] = Z[i];
                                }
                                LDS_WAIT(); asm volatile("" ::: "memory");
                                const int c = lane & 15, g = lane >> 4; float x[16];
                                f32x4 R[16][4];
                                constexpr int TW = 5;
#pragma unroll
                                for (int t = 1; t <= TW; ++t)
#pragma unroll
                                    for (int k = 0; k < 4; ++k) if (4 * k < t) R[t][k] = *(const LAS f32x4*)(ZF + t * 32 + 4 * k);
                                __builtin_amdgcn_sched_barrier(0);
#pragma unroll
                                for (int t = 0; t < 16; ++t) {
                                    if (t >= 1 && t + TW < 16) {
#pragma unroll
                                        for (int k = 0; k < 4; ++k) if (4 * k < t + TW) R[t + TW][k] = *(const LAS f32x4*)(ZF + (t + TW) * 32 + 4 * k);
                                    }
                                    __builtin_amdgcn_sched_barrier(0);
                                    float s0 = 0.f, s1 = 0.f;
#pragma unroll
                                    for (int j = 0; j < t; ++j) { const float a = R[t][j >> 2][j & 3]; if (j & 1) s1 += a * x[j]; else s0 += a * x[j]; }
                                    x[t] = ((t == c) ? 1.f : 0.f) - (s0 + s1);
                                }
#pragma unroll
                                for (int j = 0; j < 16; ++j) *(LAS bf16*)(TT + j * P16 + c * 2) = (bf16)f2bf(-x[j]);
#pragma unroll
                                for (int qq = 0; qq < 4; qq += 2) {
                                    f32x4 a4[2][4];
#pragma unroll
                                    for (int q = 0; q < 2; ++q)
#pragma unroll
                                        for (int k = 0; k < 4; ++k) a4[q][k] = *(const LAS f32x4*)(ZF + (16 + 4 * g + qq + q) * 32 + 4 * k);
#pragma unroll
                                    for (int q = 0; q < 2; ++q) {
                                        const int tr = 4 * g + qq + q;
                                        float s0 = 0.f, s1 = 0.f;
#pragma unroll
                                        for (int j = 0; j < 16; ++j) { const float a = a4[q][j >> 2][j & 3]; if (j & 1) s1 += a * x[j]; else s0 += a * x[j]; }
                                        *(LAS bf16*)(TT + (16 + tr) * P16 + c * 2) = (bf16)f2bf(-(s0 + s1));
                                    }
                                }
                              }
                            } else if (t0 >= TC) EPI(t0 - TC, par ^ 1);
                        }
                        __syncthreads();
                        if (wave >= 4) { if (t0 + TC < SEQ) PASS1(t0 + TC, par ^ 1, t0 + 2 * TC < SEQ); }
                        else if (wave >= 2) { if (t0 + TC < SEQ) {
                            LAS unsigned char* gd = GKB + (par ^ 1) * 4096 + gt * 128 + gp * 2;
                            *(LAS u32x4*)gd = (u32x4){PUWS(0, 0), PUWS(0, 1), PUWS(0, 2), PUWS(0, 3)}; *(LAS u32x4*)(gd + 16) = (u32x4){PUWS(1, 0), PUWS(1, 1), PUWS(1, 2), PUWS(1, 3)};
                            if (t0 + 2 * TC < SEQ) LOADG(t0 + 2 * TC); } }
                        else if (wave < 2 && t0 >= 0) {
#pragma unroll 1
                            for (int sc = 0; sc < 2; ++sc) {
                                const LAS unsigned char* im = IM0 + sc * IMG;
                                const LAS unsigned char* KR = im; const LAS unsigned char* BT = im + 9216; const LAS unsigned char* GT = im + 12288; const LAS unsigned char* VT = im + 15360;
                                const LAS unsigned char* TT = im + 18432; const LAS unsigned char* BB = im + 19968; const LAS float* PL = (const LAS float*)(im + 25600);
                                const LAS unsigned char* BGr = im + 4608;
                                const bf16x8 vfr = trd8(VT, PT, 8 * h2, 8 * h2 + 4, 32 * wave, lane);
                                f32x16 t1;
#pragma unroll
                                for (int i = 0; i < 16; ++i) t1[i] = 0.f;
                                t1 = __builtin_amdgcn_mfma_f32_32x32x16_bf16(*(const LAS bf16x8*)(BB + r31 * P16 + 8 * h2 * 2), vfr, t1, 0, 0, 0);
#pragma unroll
                                for (int kb = 0; kb < 2; ++kb)
#pragma unroll
                                    for (int s = 0; s < 2; ++s) t1 = __builtin_amdgcn_mfma_f32_32x32x16_bf16(LD2x64(KR + r31 * PT + (32 * kb + 16 * s + 4 * h2) * 2), PACK8(Sreg[kb], s), t1, 0, 0, 0);
                                f32x16 t2;
#pragma unroll
                                for (int i = 0; i < 16; ++i) t2[i] = 0.f;
                                t2 = __builtin_amdgcn_mfma_f32_32x32x16_bf16(LD2x64(TT + r31 * P16 + (4 * h2) * 2), PACK8(t1, 0), t2, 0, 0, 0);
#pragma unroll
                                for (int i = 8; i < 16; ++i) OUTB[(16 * sc + (i & 3) + 8 * ((i >> 2) - 2) + 4 * h2) * 64 + 32 * wave + r31] = t2[i] + t1[i];
                                const bf16x8 uq = PACK8(t2, 0);
#pragma unroll
                                for (int kb = 0; kb < 2; ++kb) {
                                    f32x16 a = Sreg[kb];
                                    a = __builtin_amdgcn_mfma_f32_32x32x16_bf16(trd8(BGr, PT, 4 * h2, 8 + 4 * h2, 32 * kb, lane), uq, a, 0, 0, 0);
                                    a = __builtin_amdgcn_mfma_f32_32x32x16_bf16(trd8(BGr, PT, 16 + 8 * h2, 20 + 8 * h2, 32 * kb, lane), vfr, a, 0, 0, 0);
#pragma unroll
                                    for (int g4 = 0; g4 < 4; ++g4) { const f32x4 p4 = *(const LAS f32x4*)(PL + 32 * kb + 8 * g4 + 4 * h2);
                                        a[4 * g4] *= p4.x; a[4 * g4 + 1] *= p4.y; a[4 * g4 + 2] *= p4.z; a[4 * g4 + 3] *= p4.w; }
                                    Sreg[kb] = a;
                                }
                            }
                        }
                    }
                    __syncthreads();
                    if ((wave & 3) >= 2) EPI(SEQ - TC, ((SEQ - TC) >> 5) & 1);
                    __syncthreads();
#undef UNPH
#undef UNPJ
#undef PUW
#undef PUWS
#undef SETPU
#undef PACK8
#undef LD2x64
                } } else {
                    const int idx = job - 128, bh = idx >> 1, half = idx & 1, b = bh >> 2, h = bh & 3;
                    unsigned zl_ = 0u; asm volatile("" : "+v"(zl_)); const int lane_ml = (int)__builtin_amdgcn_mbcnt_hi(~0u, __builtin_amdgcn_mbcnt_lo(~0u, zl_));
                    _Pragma("unroll 1") for (int sr_ = 0; sr_ < NSUB(1); ++sr_) if (((SUBMASK>>1)&1) && idx < 64) {
                        SUB_TID
                        const int bm = idx >> 2, hm = idx & 3;
                        constexpr int PT = 144;
                        LAS unsigned char* QI = lds;
                        LAS unsigned char* KI = QI + 64 * PT;
                        constexpr int PV = 272;
                        LAS unsigned char* KW = KI + 64 * PT;
                        LAS unsigned char* VT = KW + 64 * PT;
                        LAS unsigned char* CI = VT + 64 * PV;
                        LAS float* AS = (LAS float*)(CI + 128 * PT);
                        LAS float* MX = AS + 64; LAS float* SI = AS + 128; LAS float* EM = AS + 192; LAS float* WG = AS + 256; LAS float* NN = AS + 320; LAS float* CR = AS + 384; LAS float* ST = AS + 448;
                        for (int i = tid; i < 128 * PT / 4; i += NTHR) ((LAS unsigned*)CI)[i] = 0u;
                        if (tid < 64) NN[tid] = 0.f;
                        LAS float* CWL = (LAS float*)(lds + 100352);
                        if (tid < 128) { const int colw = (tid < 64) ? (hm * 64 + tid) : (256 + hm * 64 + (tid - 64));
#pragma unroll
                            for (int j = 0; j < 4; ++j) CWL[j * 128 + tid] = INP(I_CONVW)[((size_t)l * 4 + j) * 512 + colw];
                            CWL[512 + tid] = INP(I_CONVB)[l * 512 + colw]; }
                        const int pt = tid >> 4, cg = tid & 15;
                        const int ccol = (cg < 8) ? (hm * 64 + 8 * cg) : (256 + hm * 64 + 8 * (cg - 8));
                        const float qsc = (cg < 8) ? 0.125f : 1.f;
                        const float igb = INP(I_IGB)[l * 4 + hm], fgb = INP(I_FGB)[l * 4 + hm];
                        const int r31 = lane & 31, h2 = lane >> 5, vb = wave >> 1, tb = wave & 1;
                        f32x16 accC;
#pragma unroll
                        for (int i = 0; i < 16; ++i) accC[i] = 0.f;
                        float nreg = 0.f, mprev = 0.f;
                        u32x4 cu[2][4], vu[2]; float gi = 0.f, gf = 0.f;
                        auto LOADM = [&](int t0) {
#pragma unroll
                            for (int tt = 0; tt < 2; ++tt) { const int t = t0 + pt + 32 * tt; const size_t row = (size_t)bm * SEQ + t;
#pragma unroll
                                for (int j = 0; j < 4; ++j) { if (t - 3 + j >= 0) cu[tt][j] = *(const u32x4*)(Ub + ((row - 3 + j) * NU + UC_QK + ccol) * 2); else cu[tt][j] = (u32x4){0u, 0u, 0u, 0u}; }
                                const int p = tid + 512 * tt; vu[tt] = *(const u32x4*)(Ub + (((size_t)bm * SEQ + t0 + (p >> 4)) * NU + UC_V + hm * 128 + 8 * (p & 15)) * 2); }
                            if (wave == 0) { const size_t rg = (size_t)bm * SEQ + t0 + lane; gi = GIF[rg * 8 + hm]; gf = GIF[rg * 8 + 4 + hm]; }
                        };
                        LOADM(0);
                        __syncthreads();
#pragma unroll 1
                        for (int t0 = 0; t0 < SEQ; t0 += 64) {
                            int cgv = cg * 8; asm volatile("" : "+v"(cgv));
                            float cw[4][8], cb[8];
#pragma unroll
                        for (int j = 0; j < 4; ++j) { const f32x4 a = *(const LAS f32x4*)(CWL + j * 128 + cgv), c2 = *(const LAS f32x4*)(CWL + j * 128 + cgv + 4);
                            cw[j][0] = a.x; cw[j][1] = a.y; cw[j][2] = a.z; cw[j][3] = a.w; cw[j][4] = c2.x; cw[j][5] = c2.y; cw[j][6] = c2.z; cw[j][7] = c2.w; }
                        { const f32x4 a = *(const LAS f32x4*)(CWL + 512 + cgv), c2 = *(const LAS f32x4*)(CWL + 512 + cgv + 4);
                            cb[0] = a.x; cb[1] = a.y; cb[2] = a.z; cb[3] = a.w; cb[4] = c2.x; cb[5] = c2.y; cb[6] = c2.z; cb[7] = c2.w; }
                            float yq[2][8];
#pragma unroll
                            for (int tt = 0; tt < 2; ++tt) {
#pragma unroll
                                for (int i = 0; i < 8; ++i) yq[tt][i] = cb[i];
#pragma unroll
                                for (int j = 0; j < 4; ++j) { const u32x4 w = cu[tt][j]; const float x[8] = {bflo(w.x), bfhi(w.x), bflo(w.y), bfhi(w.y), bflo(w.z), bfhi(w.z), bflo(w.w), bfhi(w.w)};
#pragma unroll
                                    for (int i = 0; i < 8; ++i) yq[tt][i] += cw[j][i] * x[i]; }
#pragma unroll
                                for (int i = 0; i < 8; ++i) yq[tt][i] = yq[tt][i] * sigmoidf_(yq[tt][i]) * qsc;
                            }
                            const u32x4 vreg0 = vu[0], vreg1 = vu[1];
                            if (wave == 0) {
                                const float ig = gi + igb, fp = gf + fgb;
                                const float lf = -(fmaxf(-fp, 0.f) + __logf(1.f + __expf(-fabsf(fp))));
                                const float bc = scan_add64(lf);
                                const float as = ig - bc, pm = scan_max64(as);
                                const float mxv = fmaxf(mprev, pm), mx63 = __builtin_bit_cast(float, __builtin_amdgcn_readlane(__builtin_bit_cast(int, mxv), 63)), bl = __builtin_bit_cast(float, __builtin_amdgcn_readlane(__builtin_bit_cast(int, bc), 63));
                                AS[lane] = as; MX[lane] = mxv; SI[lane] = __expf(mprev - mxv); EM[lane] = __expf(-(bc + mxv)); WG[lane] = __expf(as - mx63);
                                if (lane == 0) CR[0] = __expf(mprev - mx63);
                                mprev = bl + mx63;
                            }
                            if (t0 + 64 < SEQ) LOADM(t0 + 64);
                            __syncthreads();
#pragma unroll
                            for (int tt = 0; tt < 2; ++tt) { const int tok = pt + 32 * tt;
                                u32x4 pw; pw.x = pk2(yq[tt][0], yq[tt][1]); pw.y = pk2(yq[tt][2], yq[tt][3]); pw.z = pk2(yq[tt][4], yq[tt][5]); pw.w = pk2(yq[tt][6], yq[tt][7]);
                                if (cg < 8) *(LAS u32x4*)(QI + tok * PT + cg * 16) = pw;
                                else { *(LAS u32x4*)(KI + tok * PT + (cg - 8) * 16) = pw; const float wgs = WG[tok];
                                    u32x4 kw; kw.x = pk2(yq[tt][0] * wgs, yq[tt][1] * wgs); kw.y = pk2(yq[tt][2] * wgs, yq[tt][3] * wgs); kw.z = pk2(yq[tt][4] * wgs, yq[tt][5] * wgs); kw.w = pk2(yq[tt][6] * wgs, yq[tt][7] * wgs);
                                    *(LAS u32x4*)(KW + tok * PT + (cg - 8) * 16) = kw; }
                                const u32x4 vw = tt ? vreg1 : vreg0; const int p = tid + 512 * tt, vtok = p >> 4, v8 = p & 15;
                                *(LAS u32x4*)(VT + vtok * PV + v8 * 16) = vw;
                            }
                            __syncthreads();
                            float hv[16];
                            {
                                constexpr float L2E = 1.4426950408889634f;
                                const int t = 32 * tb + r31;
                                bf16x8 qf[4];
#pragma unroll
                                for (int ks = 0; ks < 4; ++ks) qf[ks] = *(const LAS bf16x8*)(QI + t * PT + (16 * ks + 8 * h2) * 2);
                                const float mx = MX[t], si = SI[t], em = EM[t];
                                f32x16 O, I; float denI = 0.f;
#pragma unroll
                                for (int i = 0; i < 16; ++i) { O[i] = 0.f; I[i] = 0.f; }
#pragma unroll
                                for (int sb = 0; sb < 2; ++sb) if (sb <= tb) {
                                    f32x16 X;
#pragma unroll
                                    for (int i = 0; i < 16; ++i) X[i] = 0.f;
#pragma unroll
                                    for (int ks = 0; ks < 4; ++ks) { const bf16x8 kf = *(const LAS bf16x8*)(KI + (32 * sb + r31) * PT + (16 * ks + 8 * h2) * 2); X = __builtin_amdgcn_mfma_f32_32x32x16_bf16(kf, qf[ks], X, 0, 0, 0); }
#pragma unroll
                                    for (int g4 = 0; g4 < 4; ++g4) { const f32x4 a4 = *(const LAS f32x4*)(AS + 32 * sb + 8 * g4 + 4 * h2);
#pragma unroll
                                        for (int j = 0; j < 4; ++j) { const int s = 32 * sb + 8 * g4 + 4 * h2 + j; const float w = (s <= t) ? __builtin_amdgcn_exp2f((a4[j] - mx) * L2E) * X[4 * g4 + j] : 0.f; X[4 * g4 + j] = w; denI += w; } }
#pragma unroll
                                    for (int st = 0; st < 2; ++st) {
                                        u32x4 pw; pw.x = pk2(X[8 * st], X[8 * st + 1]); pw.y = pk2(X[8 * st + 2], X[8 * st + 3]); pw.z = pk2(X[8 * st + 4], X[8 * st + 5]); pw.w = pk2(X[8 * st + 6], X[8 * st + 7]);
                                        O = __builtin_amdgcn_mfma_f32_32x32x16_bf16(trd8(VT, PV, 32 * sb + 16 * st + 4 * h2, 32 * sb + 16 * st + 8 + 4 * h2, 32 * vb, lane), __builtin_bit_cast(bf16x8, pw), O, 0, 0, 0);
                                    }
                                }
                                float nq = 0.f;
#pragma unroll
                                for (int ks = 0; ks < 4; ++ks) { const bf16x8 cf = *(const LAS bf16x8*)(CI + (32 * vb + r31) * PT + (16 * ks + 8 * h2) * 2); I = __builtin_amdgcn_mfma_f32_32x32x16_bf16(cf, qf[ks], I, 0, 0, 0);
                                    const f32x4 n0 = *(const LAS f32x4*)(NN + 16 * ks + 8 * h2), n1 = *(const LAS f32x4*)(NN + 16 * ks + 8 * h2 + 4); const u32x4 qw = __builtin_bit_cast(u32x4, qf[ks]);
                                    nq += (bflo(qw.x) * n0.x + bfhi(qw.x) * n0.y) + (bflo(qw.y) * n0.z + bfhi(qw.y) * n0.w) + (bflo(qw.z) * n1.x + bfhi(qw.z) * n1.y) + (bflo(qw.w) * n1.z + bfhi(qw.w) * n1.w); }
                                nq += __shfl_xor(nq, 32); denI += __shfl_xor(denI, 32);
                                const float den = si * nq + denI, rdn = 1.f / fmaxf(fabsf(den), em);
                                float hsum = 0.f;
#pragma unroll
                                for (int i = 0; i < 16; ++i) { hv[i] = (O[i] + si * I[i]) * rdn; hsum += hv[i]; }
                                hsum += __shfl_xor(hsum, 32);
                                const float hmean = hsum * (1.f / 32.f); float hm2 = 0.f;
#pragma unroll
                                for (int i = 0; i < 16; ++i) { const float dlt = hv[i] - hmean; hm2 += dlt * dlt; }
                                hm2 += __shfl_xor(hm2, 32);
                                if (h2 == 0) *(LAS f32x2*)(ST + ((tb * 4 + vb) * 32 + r31) * 2) = (f32x2){hmean, hm2};
                                const float carry = CR[0];
#pragma unroll
                                for (int i = 0; i < 16; ++i) accC[i] *= carry;
#pragma unroll
                                for (int st = 0; st < 4; ++st) { const bf16x8 va = trd8(VT, PV, 16 * st + 8 * h2, 16 * st + 8 * h2 + 4, 32 * vb, lane), kw = trd8(KW, PT, 16 * st + 8 * h2, 16 * st + 8 * h2 + 4, 32 * tb, lane);
                                    accC = __builtin_amdgcn_mfma_f32_32x32x16_bf16(va, kw, accC, 0, 0, 0); }
                            }
                            __syncthreads();
                            {
                                const int t = 32 * tb + r31;
                                f32x2 s4[4];
#pragma unroll
                                for (int q = 0; q < 4; ++q) s4[q] = *(const LAS f32x2*)(ST + ((tb * 4 + q) * 32 + r31) * 2);
                                const float mt = (s4[0].x + s4[1].x + s4[2].x + s4[3].x) * 0.25f;
                                float m2 = 0.f;
#pragma unroll
                                for (int q = 0; q < 4; ++q) { const float dm = s4[q].x - mt; m2 += s4[q].y + 32.f * dm * dm; }
                                const float rstd = __builtin_amdgcn_rsqf(m2 * (1.f / 128.f) + LN_EPS);
                                const size_t row = (size_t)bm * SEQ + t0 + t;
                                const char* ogp = Ub + (row * NU + UC_OG + hm * 128 + 32 * vb) * 2; char* op = HC + (row * 1536 + hm * 128 + 32 * vb) * 2;
                                const float* ngp = INP(I_MLNORMG) + l * 512 + hm * 128 + 32 * vb;
#pragma unroll
                                for (int g4 = 0; g4 < 4; ++g4) { const int vo = 8 * g4 + 4 * h2; const f32x4 og = ld4bf(ogp + vo * 2), ng = *(const f32x4*)(ngp + vo);
                                    f32x4 y; y.x = sigmoidf_(og.x) * ((hv[4 * g4] - mt) * rstd * ng.x); y.y = sigmoidf_(og.y) * ((hv[4 * g4 + 1] - mt) * rstd * ng.y); y.z = sigmoidf_(og.z) * ((hv[4 * g4 + 2] - mt) * rstd * ng.z); y.w = sigmoidf_(og.w) * ((hv[4 * g4 + 3] - mt) * rstd * ng.w);
                                    st4bf(op + vo * 2, y); }
                            }
#pragma unroll
                            for (int i = 0; i < 16; ++i) { const int v = 32 * vb + (i & 3) + 8 * (i >> 2) + 4 * h2; *(LAS bf16*)(CI + v * PT + (32 * tb + r31) * 2) = (bf16)f2bf(accC[i]); }
                            if (wave < 2) { float s = 0.f;
#pragma unroll
                                for (int q8 = 0; q8 < 8; ++q8) { const u32x2 w = trd4(KW, PT, 32 * h2 + 4 * q8, 32 * wave, lane); s += (bflo(w.x) + bfhi(w.x)) + (bflo(w.y) + bfhi(w.y)); }
                                s += __shfl_xor(s, 32);
                                nreg = CR[0] * nreg + s; if (h2 == 0) NN[32 * wave + r31] = nreg; }
                            __syncthreads();
                        }
                    }
                }
            }
            if (rep_ == 0) {
                LAS unsigned* XB = (LAS unsigned*)(lds + 153088);
                unsigned* xc = (unsigned*)ctl + CW_FILL + 32 + l * 64;
                __syncthreads();
                if (tid_ph == 0) XB[0] = __hip_atomic_fetch_add(xc, 1u, RLX_AGENT);
                __syncthreads();
                int xi = __builtin_amdgcn_readfirstlane((int)XB[0]);
#pragma unroll 1
                while (xi < 128) {
                    const int idx = xi, bh = idx >> 1, half = idx & 1, b = bh >> 2, h = bh & 3;
                    _Pragma("unroll 1") for (int sr_ = 0; sr_ < NSUB(2); ++sr_) if ((SUBMASK>>2)&1) {
                        SUB_TID
                        constexpr int KST = 272, VST = 520;
                        LAS unsigned char* KI = lds; LAS unsigned char* VI = lds + 256 * KST;
                        const char* kvb = (const char*)(ws + WS_KV) + (((size_t)l * MROWS + (size_t)b * MEML) * D) * 2;
                        for (int p = tid; p < 4096; p += NTHR) { const int key = p >> 4, c16 = p & 15;
                            *(LAS u32x4*)(KI + key * KST + c16 * 16) = *(const u32x4*)(kvb + ((size_t)key * D + h * 128 + c16 * 8) * 2); }
                        for (int p = tid; p < 4096; p += NTHR) { const int key = p & 255, d8 = p >> 8;
                            const u32x4 w = *(const u32x4*)(kvb + ((size_t)key * D + 512 + h * 128 + d8 * 8) * 2);
                            LAS unsigned char* o = VI + (d8 * 8) * VST + key * 2;
                            *(LAS bf16*)(o) = (bf16)(w.x & 0xffff); *(LAS bf16*)(o + VST) = (bf16)(w.x >> 16); *(LAS bf16*)(o + 2 * VST) = (bf16)(w.y & 0xffff); *(LAS bf16*)(o + 3 * VST) = (bf16)(w.y >> 16);
                            *(LAS bf16*)(o + 4 * VST) = (bf16)(w.z & 0xffff); *(LAS bf16*)(o + 5 * VST) = (bf16)(w.z >> 16); *(LAS bf16*)(o + 6 * VST) = (bf16)(w.w & 0xffff); *(LAS bf16*)(o + 7 * VST) = (bf16)(w.w >> 16); }
                        __syncthreads();
                        const int r31 = lane & 31, h2 = lane >> 5;
                        constexpr float SC = 0.08838834764831845f * 1.4426950408889634f;
#pragma unroll 1
                        for (int rd = 0; rd < 8; ++rd) {
                            const size_t qrow = (size_t)b * SEQ + half * 2048 + rd * 256 + wave * 32 + r31;
                            bf16x8 qf[8];
#pragma unroll
                            for (int ks = 0; ks < 8; ++ks) qf[ks] = *(const bf16x8*)(Ub + (qrow * NU + UC_CAQ + h * 128 + 16 * ks + 8 * h2) * 2);
                            f32x16 O[4];
#pragma unroll
                            for (int db = 0; db < 4; ++db)
#pragma unroll
                                for (int i = 0; i < 16; ++i) O[db][i] = 0.f;
                            float mrun = -1e30f, lrun = 0.f;
#pragma unroll 1
                            for (int hf = 0; hf < 2; ++hf) {
                                f32x16 X[4];
#pragma unroll
                                for (int kb = 0; kb < 4; ++kb) {
                                    bf16x8 kf[8];
#pragma unroll
                                    for (int ks = 0; ks < 8; ++ks) kf[ks] = *(const LAS bf16x8*)(KI + (hf * 128 + kb * 32 + r31) * KST + (16 * ks + 8 * h2) * 2);
                                    __builtin_amdgcn_sched_barrier(0);
#pragma unroll
                                    for (int i = 0; i < 16; ++i) X[kb][i] = 0.f;
#pragma unroll
                                    for (int ks = 0; ks < 8; ++ks) X[kb] = __builtin_amdgcn_mfma_f32_32x32x16_bf16(kf[ks], qf[ks], X[kb], 0, 0, 0);
                                    __builtin_amdgcn_sched_barrier(0);
                                }
                                float mx = -1e30f;
#pragma unroll
                                for (int kb = 0; kb < 4; ++kb)
#pragma unroll
                                    for (int i = 0; i < 16; ++i) mx = fmaxf(mx, X[kb][i]);
                                mx = fmaxf(mx, __shfl_xor(mx, 32));
                                const float mnew = fmaxf(mrun, mx), alpha = __builtin_amdgcn_exp2f((mrun - mnew) * SC);
                                float ls = 0.f;
#pragma unroll
                                for (int kb = 0; kb < 4; ++kb)
#pragma unroll
                                    for (int i = 0; i < 16; ++i) { const float p = __builtin_amdgcn_exp2f((X[kb][i] - mnew) * SC); X[kb][i] = p; ls += p; }
                                ls += __shfl_xor(ls, 32);
                                lrun = lrun * alpha + ls; mrun = mnew;
#pragma unroll
                                for (int db = 0; db < 4; ++db)
#pragma unroll
                                    for (int i = 0; i < 16; ++i) O[db][i] *= alpha;
#pragma unroll
                                for (int kb = 0; kb < 4; ++kb) {
                                    bf16x8 vf[2][4], pf[2];
#pragma unroll
                                    for (int s = 0; s < 2; ++s) {
                                        u32x4 pw; pw.x = pk2(X[kb][8 * s], X[kb][8 * s + 1]); pw.y = pk2(X[kb][8 * s + 2], X[kb][8 * s + 3]); pw.z = pk2(X[kb][8 * s + 4], X[kb][8 * s + 5]); pw.w = pk2(X[kb][8 * s + 6], X[kb][8 * s + 7]);
                                        pf[s] = __builtin_bit_cast(bf16x8, pw);
#pragma unroll
                                        for (int db = 0; db < 4; ++db) {
                                            const LAS unsigned char* vp = VI + (db * 32 + r31) * VST + (hf * 128 + kb * 32 + 16 * s + 4 * h2) * 2;
                                            const u32x2 lo = *(const LAS u32x2*)vp, hi = *(const LAS u32x2*)(vp + 16);
                                            vf[s][db] = __builtin_bit_cast(bf16x8, (u32x4){lo.x, lo.y, hi.x, hi.y});
                                        }
                                    }
                                    __builtin_amdgcn_sched_barrier(0);
#pragma unroll
                                    for (int s = 0; s < 2; ++s)
#pragma unroll
                                        for (int db = 0; db < 4; ++db) O[db] = __builtin_amdgcn_mfma_f32_32x32x16_bf16(vf[s][db], pf[s], O[db], 0, 0, 0);
                                    __builtin_amdgcn_sched_barrier(0);
                                }
                            }
                            const float rl = 1.f / lrun;
                            char* op = HC + (qrow * 1536 + 1024 + h * 128) * 2;
#pragma unroll
                            for (int db = 0; db < 4; ++db)
#pragma unroll
                                for (int g4 = 0; g4 < 4; ++g4) { u32x2 w; w.x = pk2(O[db][4 * g4] * rl, O[db][4 * g4 + 1] * rl); w.y = pk2(O[db][4 * g4 + 2] * rl, O[db][4 * g4 + 3] * rl);
                                    *(u32x2*)(op + (db * 32 + 8 * g4 + 4 * h2) * 2) = w; }
                        }
                        __syncthreads();
                    }
                    if (tid_ph == 0) XB[0] = __hip_atomic_fetch_add(xc, 1u, RLX_AGENT);
                    __syncthreads();
                    xi = __builtin_amdgcn_readfirstlane((int)XB[0]);
                    __syncthreads();
                }
            }
            if (rep_ == 0) {
                unsigned zf_ = 0u; asm volatile("" : "+v"(zf_)); const int lane_f = (int)__builtin_amdgcn_mbcnt_hi(~0u, __builtin_amdgcn_mbcnt_lo(~0u, zf_));
                LAS float* scr = (LAS float*)(lds + wave * 8448);
                LAS unsigned* FB = (LAS unsigned*)(lds + 8 * 8448);
                unsigned* fc = (unsigned*)ctl + CW_FILL + l * 64;
                constexpr int IT_GU = 32 * 16 * 64, IT_ALL = 49152, CH = 32;
                const bool lead = (wave == 0) && (lane_f == 0);
                __syncthreads();
                if (lead) FB[0] = __hip_atomic_fetch_add(fc, (unsigned)CH, RLX_AGENT);
                __syncthreads();
                int fbase = __builtin_amdgcn_readfirstlane((int)FB[0]), slot = 1;
#pragma unroll 1
                while (fbase < IT_ALL) {
                    unsigned nb = 0u;
                    if (lead) nb = __hip_atomic_fetch_add(fc, (unsigned)CH, RLX_AGENT);
                    {
                        struct FItem { const float* W; unsigned char* WT; int ldw; float sc; };
                        auto FI = [&](int it) -> FItem { FItem r;
                            if (it < IT_GU) { const int e = it >> 10, q = it & 1023, kb = q >> 6, nb_ = q & 63;
                                r.W = INP(I_WGU) + (((size_t)l * 32 + e) * D + 64 * kb) * 2048 + 32 * nb_; r.ldw = 2048; r.WT = (unsigned char*)(ws + WS_WGU) + ((size_t)e * 2048 + 32 * nb_) * D + 64 * kb; r.sc = F8_SWGU; }
                            else { const int r2 = it - IT_GU, e = r2 >> 9, q = r2 & 511, kb = q >> 5, nb_ = q & 31;
                                r.W = INP(I_WDN) + (((size_t)l * 32 + e) * D + 64 * kb) * 1024 + 32 * nb_; r.ldw = 1024; r.WT = (unsigned char*)(ws + WS_WDN) + ((size_t)e * 1024 + 32 * nb_) * D + 64 * kb; r.sc = F8_SWDN; }
                            return r; };
                        f32x4 va[8], vb[8];
                        FItem c0 = FI(fbase + wave), c1;
                        ti_load4(c0.W, c0.ldw, lane_f, va);
#pragma unroll 1
                        for (int kq = 0; kq < CH / NWAVES; kq += 2) {
                            c1 = FI(fbase + wave + (kq + 1) * NWAVES); ti_load4(c1.W, c1.ldw, lane_f, vb);
                            ti_store4_f8(va, c0.WT, D, c0.sc, lane_f);
                            if (kq + 2 < CH / NWAVES) { c0 = FI(fbase + wave + (kq + 2) * NWAVES); ti_load4(c0.W, c0.ldw, lane_f, va); }
                            ti_store4_f8(vb, c1.WT, D, c1.sc, lane_f);
                        }
                    }
                    if (lead) FB[slot] = nb;
                    __syncthreads();
                    fbase = __builtin_amdgcn_readfirstlane((int)FB[slot]); slot ^= 1;
                }
            }
#undef UNP4
#undef DOT4
#undef SUB_TID
        }
        SEAM(pb + 3);
        _Pragma("unroll 1") for (int rep_ = 0; rep_ < NREP(5); ++rep_) if (((PHMASK>>5)&1) && IN(pb + 5)) {
            SchedPlain S; S.T.init(M / 256, 4); S.G = G; S.c = bx; S.A = (const char*)(ws + WS_R2 + R2_HCAT); S.B = (const char*)(ws + WS_WBR) + (size_t)l * 1024 * 1536 * 2; S.C = (char*)(ws + WS_R2 + R2_YPRE);
            S.lda = 1536; S.ldb = 1536; S.ldc = D;
            pg8::EpiMerge E; E.U = Ub; E.gate_b = INP(I_GATEB) + (size_t)l * 3072;
            pg8::gemm_phase<false, true>(lds, 1536 * 2, 1536 * 2, 1536 * 2, S, E, wave);
        }
        SEAM(pb + 5);
        _Pragma("unroll 1") for (int rep_ = 0; rep_ < NREP(6); ++rep_) if (((PHMASK>>6)&1) && IN(pb + 6)) {
            SchedPlain S; S.T.init(M / 256, 4); S.G = G; S.c = bx; S.A = (const char*)(ws + WS_R2 + R2_YPRE); S.B = (const char*)(ws + WS_WO) + (size_t)l * D * D * 2; S.C = (char*)(ws + WS_R2 + R2_Z);
            S.lda = D; S.ldb = D; S.ldc = D;
            pg8::EpiStore E;
            pg8::gemm_phase<false>(lds, D * 2, D * 2, D * 2, S, E, wave);
        }
        SEAM(pb + 6);
        _Pragma("unroll 1") for (int rep_ = 0; rep_ < NREP(7); ++rep_) if (((PHMASK>>7)&1) && IN(pb + 7)) { PHASE_TID
            constexpr int WP = 2064;
            LAS unsigned char* WRb = lds;
            LAS float* RB = (LAS float*)(lds + 66048);
            LAS unsigned char* XS = lds + 66560 + wave * 4608;
            for (int i = tid; i < 32768; i += NTHR) { const int k = i >> 5, e = i & 31; *(LAS bf16*)(WRb + e * WP + k * 2) = (bf16)f2bf(INP(I_RTW)[((size_t)l * D + k) * 32 + e]); }
            if (tid < 32) RB[tid] = INP(I_RTB)[l * 32 + tid];
            const char* Zb = (const char*)(ws + WS_R2 + R2_Z);
            int* TKE = (int*)(ws + WS_TKE); float* TKG = (float*)(ws + WS_TKG); int* TKP = (int*)(ws + WS_TKP); int* ROWTOK = (int*)(ws + WS_ROWTOK);
            LAS unsigned* LCNT = (LAS unsigned*)(lds + 131072);
            LAS unsigned* GBASE = LCNT + 32; LAS unsigned* LLEN = LCNT + 64; LAS unsigned* LIST = LCNT + 128;
            if (tid < 65) LCNT[tid] = 0u;
            {
                f32x4 g[4], bb[4];
#pragma unroll
                for (int j = 0; j < 4; ++j) { g[j] = *(const f32x4*)(INP(I_LN1G) + l * D + 256 * j + 4 * lane); bb[j] = *(const f32x4*)(INP(I_LN1B) + l * D + 256 * j + 4 * lane); }
#pragma unroll 1
                for (int pp = gw; pp < M / 2; pp += NGW) {
                    f32x4 y0[4], y1[4];
#pragma unroll
                    for (int j = 0; j < 4; ++j) { y0[j] = ld4bf(Zb + ((size_t)(2 * pp) * D + 256 * j + 4 * lane) * 2) + ld4bf(Xb + ((size_t)(2 * pp) * D + 256 * j + 4 * lane) * 2) * DN_ALPHA;
                        y1[j] = ld4bf(Zb + ((size_t)(2 * pp + 1) * D + 256 * j + 4 * lane) * 2) + ld4bf(Xb + ((size_t)(2 * pp + 1) * D + 256 * j + 4 * lane) * 2) * DN_ALPHA; }
                    ln16(y0, g, bb); ln16(y1, g, bb);
#pragma unroll
                    for (int j = 0; j < 4; ++j) { st4bf(Xb + ((size_t)(2 * pp) * D + 256 * j + 4 * lane) * 2, y0[j]); st4bf(Xb + ((size_t)(2 * pp + 1) * D + 256 * j + 4 * lane) * 2, y1[j]);
                        *(unsigned*)((char*)(ws + WS_XF8) + (size_t)(2 * pp) * D + 256 * j + 4 * lane) = pk4_f8(y0[j].x * F8_SX, y0[j].y * F8_SX, y0[j].z * F8_SX, y0[j].w * F8_SX);
                        *(unsigned*)((char*)(ws + WS_XF8) + (size_t)(2 * pp + 1) * D + 256 * j + 4 * lane) = pk4_f8(y1[j].x * F8_SX, y1[j].y * F8_SX, y1[j].z * F8_SX, y1[j].w * F8_SX); }
                }
            }
            asm volatile("s_waitcnt vmcnt(0)" ::: "memory");
            __syncthreads();
            __builtin_amdgcn_fence(__ATOMIC_ACQUIRE, "agent");
            asm volatile("s_waitcnt vmcnt(0)" ::: "memory");
            if (rep_ == 0) {
                const int r31 = lane & 31, h2 = lane >> 5;
                const int mytok = 16 * (bx + (2 * wave + (r31 >> 4)) * G) + (r31 & 15);
                const char* sp[4];
#pragma unroll
                for (int q = 0; q < 4; ++q) { const int row = (lane >> 3) + 8 * q; const int tk = 16 * (bx + (2 * wave + (row >> 4)) * G) + (row & 15); sp[q] = Xb + ((size_t)tk * D + 8 * (lane & 7)) * 2; }
                f32x16 C;
#pragma unroll
                for (int i = 0; i < 16; ++i) C[i] = 0.f;
                u32x4 xr[4];
#pragma unroll
                for (int q = 0; q < 4; ++q) xr[q] = *(const u32x4*)(sp[q]);
#pragma unroll 1
                for (int sl = 0; sl < 16; ++sl) {
#pragma unroll
                    for (int q = 0; q < 4; ++q) *(LAS u32x4*)(XS + ((lane >> 3) + 8 * q) * 144 + (lane & 7) * 16) = xr[q];
                    if (sl + 1 < 16) {
#pragma unroll
                        for (int q = 0; q < 4; ++q) xr[q] = *(const u32x4*)(sp[q] + (sl + 1) * 128); }
#pragma unroll
                    for (int k2 = 0; k2 < 4; ++k2) C = __builtin_amdgcn_mfma_f32_32x32x16_bf16(*(const LAS bf16x8*)(WRb + r31 * WP + (64 * sl + 16 * k2 + 8 * h2) * 2), *(const LAS bf16x8*)(XS + r31 * 144 + (16 * k2 + 8 * h2) * 2), C, 0, 0, 0);
                }
                float v[16];
#pragma unroll
                for (int g4 = 0; g4 < 4; ++g4) { const f32x4 b4 = *(const LAS f32x4*)(RB + 8 * g4 + 4 * h2); v[4 * g4] = C[4 * g4] + b4.x; v[4 * g4 + 1] = C[4 * g4 + 1] + b4.y; v[4 * g4 + 2] = C[4 * g4 + 2] + b4.z; v[4 * g4 + 3] = C[4 * g4 + 3] + b4.w; }
                float lv[4]; int li_[4];
#pragma unroll
                for (int k = 0; k < 4; ++k) { float best = -3.0e38f; int bi = 0;
#pragma unroll
                    for (int i = 0; i < 16; ++i) { const int e = (i & 3) + 8 * (i >> 2) + 4 * h2; if (v[i] > best) { best = v[i]; bi = e; } }
#pragma unroll
                    for (int i = 0; i < 16; ++i) { const int e = (i & 3) + 8 * (i >> 2) + 4 * h2; v[i] = (e == bi) ? -3.0e38f : v[i]; }
                    lv[k] = best; li_[k] = bi; }
                float cv[8]; int ci[8];
#pragma unroll
                for (int k = 0; k < 4; ++k) { cv[k] = lv[k]; ci[k] = li_[k]; cv[4 + k] = __shfl_xor(lv[k], 32); ci[4 + k] = __shfl_xor(li_[k], 32); }
                float tv[4]; int te[4];
#pragma unroll
                for (int k = 0; k < 4; ++k) { float best = -3.0e38f; int bi = 64;
#pragma unroll
                    for (int i = 0; i < 8; ++i) { if (cv[i] > best || (cv[i] == best && ci[i] < bi)) { best = cv[i]; bi = ci[i]; } }
#pragma unroll
                    for (int i = 0; i < 8; ++i) cv[i] = (ci[i] == bi) ? -3.0e38f : cv[i];
                    tv[k] = best; te[k] = bi; }
                const float e1 = __expf(tv[1] - tv[0]), e2 = __expf(tv[2] - tv[0]), e3 = __expf(tv[3] - tv[0]), rs = 1.f / (1.f + e1 + e2 + e3);
                const float gt[4] = {rs, e1 * rs, e2 * rs, e3 * rs};
                if (h2 == 0) {
#pragma unroll
                    for (int k = 0; k < 4; ++k) {
                        const unsigned lpos = __hip_atomic_fetch_add(LCNT + te[k], 1u, __ATOMIC_RELAXED, __HIP_MEMORY_SCOPE_WORKGROUP);
                        const unsigned li = __hip_atomic_fetch_add(LLEN, 1u, __ATOMIC_RELAXED, __HIP_MEMORY_SCOPE_WORKGROUP);
                        LIST[2 * li] = (unsigned)(mytok * 4 + k); LIST[2 * li + 1] = (unsigned)te[k] | (lpos << 8);
                        TKE[mytok * 4 + k] = te[k]; TKG[mytok * 4 + k] = gt[k]; }
                }
            }
            __syncthreads();
            if (tid < 32 && rep_ == 0) GBASE[tid] = __hip_atomic_fetch_add((unsigned*)ctl + CW_CNT + (l * 32 + tid) * 64, LCNT[tid], RLX_AGENT);
            __syncthreads();
            if (rep_ == 0) { const unsigned n = LLEN[0];
                for (unsigned i = tid; i < n; i += NTHR) { const unsigned tk = LIST[2 * i], ev = LIST[2 * i + 1], e = ev & 255u, pos = GBASE[e] + (ev >> 8);
                    TKP[tk] = (int)pos; ROWTOK[(size_t)e * M + pos] = (int)(tk >> 2); } }
            __syncthreads();
        }
        SEAM(pb + 7);
        _Pragma("unroll 1") for (int rep_ = 0; rep_ < NREP(8); ++rep_) if (((PHMASK>>8)&1) && IN(pb + 8)) { PHASE_TID
            if (tid < 32) CNT[tid] = (int)__hip_atomic_load((unsigned*)ctl + CW_CNT + (l * 32 + tid) * 64, RLX_AGENT);
            __syncthreads();
            if (tid == 0) { int a = 0; for (int e = 0; e < 32; ++e) { PB[e] = a; a += (CNT[e] + 255) >> 8; } PB[32] = a; }
            __syncthreads();
            const int P = PB[32];
            const int* ROWTOK = (const int*)(ws + WS_ROWTOK);
            char* XD = (char*)(ws + WS_R1); const char* XF = (const char*)(ws + WS_XF8);
            for (int sb = gw * 64; sb < P * 256; sb += NGW * 64) {
                const int pm = sb >> 8; int e = 0;
#pragma unroll 1
                for (int j = 1; j < NEXP; ++j) e += (PB[j] <= pm) ? 1 : 0;
                const int pos0 = sb - PB[e] * 256, cnt = CNT[e];
                int nvalid = cnt - pos0; nvalid = nvalid > 64 ? 64 : nvalid;
                int tokv = -1; if (pos0 + lane < cnt) tokv = ROWTOK[(size_t)e * M + pos0 + lane];
#pragma unroll 1
                for (int j = 0; j < nvalid; j += 4) {
                    int t[4]; u32x4 a[4];
#pragma unroll
                    for (int i = 0; i < 4; ++i) { t[i] = __builtin_amdgcn_readlane(tokv, j + i);
                        if (t[i] >= 0) a[i] = *(const u32x4*)(XF + (size_t)t[i] * 1024 + lane * 16); }
#pragma unroll
                    for (int i = 0; i < 4; ++i) if (t[i] >= 0) *(u32x4*)(XD + (size_t)(sb + j + i) * 1024 + lane * 16) = a[i];
                }
            }
            LAS float* scr = (LAS float*)(lds + wave * 8448);
            constexpr int IT_GU = 32 * 16 * 64, IT_DN = 32 * 16 * 32;
            for (int it = XW_SPLIT + gw; it < IT_GU + IT_DN; it += NGW) {
                if (it < IT_GU) { const int e = it >> 10, q = it & 1023, kb = q >> 6, nb = q & 63;
                    transpose_item_f8(INP(I_WGU) + (((size_t)l * 32 + e) * D + 64 * kb) * 2048 + 32 * nb, 2048, (unsigned char*)(ws + WS_WGU) + ((size_t)e * 2048 + 32 * nb) * D + 64 * kb, D, F8_SWGU, scr, lane); }
                else { const int r = it - IT_GU, e = r >> 9, q = r & 511, kb = q >> 5, nb = q & 31;
                    transpose_item_f8(INP(I_WDN) + (((size_t)l * 32 + e) * D + 64 * kb) * 1024 + 32 * nb, 1024, (unsigned char*)(ws + WS_WDN) + ((size_t)e * 1024 + 32 * nb) * D + 64 * kb, D, F8_SWDN, scr, lane); }
            }
            __syncthreads();
        }
        SEAM(pb + 8);
        if (IN(pb + 9) || IN(pb + 10)) { PHASE_TID
            if (tid < 32) CNT[tid] = (int)__hip_atomic_load((unsigned*)ctl + CW_CNT + (l * 32 + tid) * 64, RLX_AGENT);
            __syncthreads();
            if (tid == 0) { int a = 0; for (int e = 0; e < 32; ++e) { PB[e] = a; a += (CNT[e] + 255) >> 8; } PB[32] = a; }
            __syncthreads();
        }
        _Pragma("unroll 1") for (int rep_ = 0; rep_ < NREP(9); ++rep_) if (((PHMASK>>9)&1) && IN(pb + 9)) {
            SchedMoe S; S.T.init(PB[32], 8); S.G = G; S.c = bx; S.A = (const char*)(ws + WS_R1); S.W = (const char*)(ws + WS_WGU); S.C = (char*)(ws + WS_R2 + R2_HMID); S.PB = PB; S.wrows = 2048; S.ldc = 1024; S.cdiv = 2; S.osz = 1;
            pg8::EpiMoe1 E; E.bgu = INP(I_BGU) + (size_t)l * 32 * 2048;
            pg8::gemm_phase<true>(lds, D, D, D, S, E, wave);
        }
        SEAM(pb + 9);
        _Pragma("unroll 1") for (int rep_ = 0; rep_ < NREP(10); ++rep_) if (((PHMASK>>10)&1) && IN(pb + 10)) {
            SchedMoe S; S.T.init(PB[32], 4); S.G = G; S.c = bx; S.A = (const char*)(ws + WS_R2 + R2_HMID); S.W = (const char*)(ws + WS_WDN); S.C = (char*)(ws + WS_R1); S.PB = PB; S.wrows = 1024; S.ldc = 1024; S.cdiv = 1; S.osz = 2;
            pg8::EpiMoe2 E; E.bdn = INP(I_BDN) + (size_t)l * 32 * 1024;
            pg8::gemm_phase<true>(lds, D, D, D, S, E, wave);
        }
        SEAM(pb + 10);
        _Pragma("unroll 1") for (int rep_ = 0; rep_ < NREP(11); ++rep_) if (((PHMASK>>11)&1) && IN(pb + 11)) { PHASE_TID
            if (tid < 32) CNT[tid] = (int)__hip_atomic_load((unsigned*)ctl + CW_CNT + (l * 32 + tid) * 64, RLX_AGENT);
            LAS float* wgt = (LAS float*)(lds + 73728);
            const bool lastl = (l == DEPTH - 1);
            if (!lastl) load_gate_table(wgt, INP(I_WIN) + (size_t)(l + 1) * D * DIN, tid);
            __syncthreads();
            if (tid == 0) { int a = 0; for (int e = 0; e < 32; ++e) { PB[e] = a; a += (CNT[e] + 255) >> 8; } PB[32] = a; }
            __syncthreads();
            const int e0 = 8 * lane;
            f32x4 g[4], bb[4];
#pragma unroll
            for (int j = 0; j < 4; ++j) { const int o = (j >> 1) * 512 + e0 + (j & 1) * 4; g[j] = *(const f32x4*)(INP(I_LN2G) + l * D + o); bb[j] = *(const f32x4*)(INP(I_LN2B) + l * D + o); }
            const char* YA = (const char*)(ws + WS_R1);
            const bool dummy_ = (rep_ + 1 < NREP(11)); char* const Xo = dummy_ ? (char*)(ws + WS_R2) : Xb; float* const Fo = dummy_ ? (float*)(ws + WS_R2 + 256 * MiB) : args.out; float* const Go = dummy_ ? (float*)(ws + WS_R2 + 200 * MiB) : GIF;
            const int* TKE = (const int*)(ws + WS_TKE); const float* TKG = (const float*)(ws + WS_TKG); const int* TKP = (const int*)(ws + WS_TKP);
#pragma unroll 1
            for (int mb = gw * 16; mb < M; mb += NGW * 16) {
                const int ev = TKE[mb * 4 + lane], pv = TKP[mb * 4 + lane]; const float gv = TKG[mb * 4 + lane];
                const int rowv = PB[ev] * 256 + pv;
#pragma unroll 1
                for (int ti = 0; ti < 16; ti += 2) {
                    u32x4 xw[2][2], yw[2][4][2]; float gk[2][4];
#pragma unroll
                    for (int q = 0; q < 2; ++q) { const size_t m = (size_t)mb + ti + q;
                        xw[q][0] = *(const u32x4*)(Xb + (m * D + e0) * 2); xw[q][1] = *(const u32x4*)(Xb + (m * D + 512 + e0) * 2);
#pragma unroll
                        for (int k = 0; k < 4; ++k) { const size_t row = (size_t)__builtin_amdgcn_readlane(rowv, 4 * (ti + q) + k);
                            gk[q][k] = __builtin_bit_cast(float, __builtin_amdgcn_readlane(__builtin_bit_cast(int, gv), 4 * (ti + q) + k));
                            yw[q][k][0] = *(const u32x4*)(YA + (row * D + e0) * 2); yw[q][k][1] = *(const u32x4*)(YA + (row * D + 512 + e0) * 2); } }
#pragma unroll
                    for (int q = 0; q < 2; ++q) { const size_t m = (size_t)mb + ti + q;
                        f32x4 v[4];
#pragma unroll
                        for (int hh = 0; hh < 2; ++hh) { const u32x4 w = xw[q][hh];
                            v[2 * hh] = (f32x4){bflo(w.x), bfhi(w.x), bflo(w.y), bfhi(w.y)} * DN_ALPHA; v[2 * hh + 1] = (f32x4){bflo(w.z), bfhi(w.z), bflo(w.w), bfhi(w.w)} * DN_ALPHA; }
#pragma unroll
                        for (int k = 0; k < 4; ++k)
#pragma unroll
                            for (int hh = 0; hh < 2; ++hh) { const u32x4 w = yw[q][k][hh];
                                v[2 * hh] = v[2 * hh] + (f32x4){bflo(w.x), bfhi(w.x), bflo(w.y), bfhi(w.y)} * gk[q][k]; v[2 * hh + 1] = v[2 * hh + 1] + (f32x4){bflo(w.z), bfhi(w.z), bflo(w.w), bfhi(w.w)} * gk[q][k]; }
                        ln16(v, g, bb);
                        if (lastl) {
#pragma unroll
                            for (int j = 0; j < 4; ++j) *(f32x4*)(Fo + m * D + (j >> 1) * 512 + e0 + (j & 1) * 4) = v[j];
                        } else {
#pragma unroll
                            for (int hh = 0; hh < 2; ++hh) { *(u32x4*)(Xo + (m * D + hh * 512 + e0) * 2) = pg8::pack8(v[2 * hh], v[2 * hh + 1]);
                                u32x2 f8w; f8w.x = pk4_f8(v[2 * hh].x * F8_SX, v[2 * hh].y * F8_SX, v[2 * hh].z * F8_SX, v[2 * hh].w * F8_SX); f8w.y = pk4_f8(v[2 * hh + 1].x * F8_SX, v[2 * hh + 1].y * F8_SX, v[2 * hh + 1].z * F8_SX, v[2 * hh + 1].w * F8_SX);
                                if (!dummy_) *(u32x2*)((char*)(ws + WS_XF8) + m * D + hh * 512 + e0) = f8w; }
                            gates8b(v, wgt, Go + m * 8, lane);
                        }
                    }
                }
            }
            __syncthreads();
        }
        SEAM(pb + 11);
    }
#undef IN
#undef SEAM
}

extern "C" void kernel_launch(void* const* d_in, const int* in_sizes, int n_in, void* d_out, int out_size, void* d_ws, size_t ws_size, hipStream_t stream) {
    static int grid = 0;
    if (grid == 0) {
        if (n_in != N_IN || out_size != M * D || ws_size < WS_END) { fprintf(stderr, "kernel_launch: unexpected shapes (n_in %d, out %d, ws %zu)\n", n_in, out_size, ws_size); grid = -1; return; }
        int dev = 0, cus = 0, per_cu = 0;
        if (hipGetDevice(&dev) != hipSuccess || hipDeviceGetAttribute(&cus, hipDeviceAttributeMultiprocessorCount, dev) != hipSuccess) { grid = -1; return; }
        if (hipFuncSetAttribute((const void*)fwd_kernel, hipFuncAttributeMaxDynamicSharedMemorySize, LDS_BYTES) != hipSuccess) { fprintf(stderr, "kernel_launch: hipFuncSetAttribute failed\n"); grid = -1; return; }
        if (hipOccupancyMaxActiveBlocksPerMultiprocessor(&per_cu, (const void*)fwd_kernel, NTHR, LDS_BYTES) != hipSuccess || per_cu < 1) fprintf(stderr, "kernel_launch: occupancy query reports %d\n", per_cu);
        (void)hipGetLastError();
        grid = cus;
    }
    if (grid < 0) return;
    (void)hipMemsetAsync((char*)d_ws + WS_CTL, 0, CTL_ZERO_BYTES, stream);
    Args a{};
    for (int i = 0; i < N_IN; ++i) a.in[i] = (const float*)d_in[i];
    a.out = (float*)d_out; a.ws = (unsigned char*)d_ws;
#if MK_ONE_LAUNCH
    a.ph_lo = 0; a.ph_hi = NPH;
    hipLaunchKernelGGL(fwd_kernel, dim3(grid), dim3(NTHR), LDS_BYTES, stream, a);
#else
    for (int p = 0; p < NPH; ++p) { a.ph_lo = p; a.ph_hi = p + 1; hipLaunchKernelGGL(fwd_kernel, dim3(grid), dim3(NTHR), LDS_BYTES, stream, a); }
#endif
    const hipError_t le = hipPeekAtLastError();
    if (le != hipSuccess) fprintf(stderr, "kernel_launch: launch failed: %s\n", hipGetErrorName(le));
}
```

```cpp
#include <hip/hip_runtime.h>
#include <cstdio>
#include <cstdint>

#ifndef MK_ONE_LAUNCH
#define MK_ONE_LAUNCH 1
#endif

#define LAS __attribute__((address_space(3)))
#define GAS __attribute__((address_space(1)))
typedef unsigned short bf16;
typedef short bf16x8 __attribute__((ext_vector_type(8)));
typedef float f32x4 __attribute__((ext_vector_type(4)));
typedef float f32x2 __attribute__((ext_vector_type(2)));
typedef float f32x16 __attribute__((ext_vector_type(16)));
typedef unsigned u32x4 __attribute__((ext_vector_type(4)));
typedef unsigned u32x2 __attribute__((ext_vector_type(2)));
typedef __bf16 bf16x2_t __attribute__((ext_vector_type(2)));
typedef GAS unsigned gu32;
#define RLX_AGENT __ATOMIC_RELAXED, __HIP_MEMORY_SCOPE_AGENT
#define DI __device__ __forceinline__

constexpr int NWAVES = 8, NTHR = 512;
constexpr int D = 1024, BATCH = 16, SEQ = 4096, M = BATCH * SEQ, DEPTH = 2, MEML = 256, MROWS = BATCH * MEML;
constexpr int DIN = 6920, NU = 6912;
constexpr int UC_QK = 0, UC_RW = 512, UC_V = 2304, UC_OG = 2816, UC_CAQ = 3328, UC_GATE = 3840;
constexpr int UC_F8 = UC_V, NF8 = NU - UC_F8;
__host__ __device__ constexpr int ucol_src(int c) { return c < 512 ? c : (c < 2304 ? 1544 + (c - 512) : (c < 2816 ? 512 + (c - 2304) : (c < 3328 ? 1024 + (c - 2816) : (c < 3840 ? 3336 + (c - 3328) : 3848 + (c - 3840))))); }
constexpr int NEXP = 32, TOPK = 4;
constexpr int PMAX = M * TOPK / 256 + NEXP;
constexpr float LN_EPS = 1e-5f, RW_GN_EPS = 64e-5f, DN_ALPHA = 1.41421356237f;

enum { I_X = 0, I_MEM, I_LNIN_G, I_LNIN_B, I_MEMLN_G, I_MEMLN_B, I_WIN, I_CONVW, I_CONVB, I_IGB, I_FGB, I_MLNORMG, I_RWMU, I_RWW0, I_RWWUP, I_RWA0, I_RWAUP, I_RWGUP,
       I_RWKK, I_RWKA, I_RWRK, I_RWLNG, I_RWLNB, I_CAWKV, I_GATEB, I_WBRML, I_WBRRW, I_WBRCA, I_WO, I_LN1G, I_LN1B, I_RTW, I_RTB, I_WGU, I_BGU, I_WDN, I_BDN, I_LN2G, I_LN2B, N_IN };

constexpr size_t MiB = 1u << 20;
constexpr size_t WS_CTL = 0, CTL_ZERO_BYTES = 1 * MiB;
constexpr size_t WS_WIN = 1 * MiB;
constexpr size_t WS_WKV = 28 * MiB;
constexpr size_t WS_WBR = 32 * MiB;
constexpr size_t WS_WO = 38 * MiB;
constexpr size_t WS_WLORA = 42 * MiB;
constexpr size_t WS_WGU = 45 * MiB;
constexpr size_t WS_WDN = 173 * MiB;
constexpr size_t WS_X = 237 * MiB;
constexpr size_t WS_MEMN = 365 * MiB;
constexpr size_t WS_KV = 373 * MiB;
constexpr size_t WS_GIF = 389 * MiB;
constexpr size_t WS_TKE = 391 * MiB, WS_TKG = 392 * MiB, WS_TKP = 393 * MiB;
constexpr size_t WS_ROWTOK = 394 * MiB;
constexpr size_t WS_HML = 402 * MiB;
constexpr size_t WS_R1 = 466 * MiB;
constexpr size_t WS_R2 = 1330 * MiB;
constexpr size_t WS_XF8 = 1858 * MiB;
constexpr size_t WS_WING8 = 1922 * MiB;
constexpr size_t WS_END = 1932 * MiB;
constexpr size_t R2_LORA_OUT = 0, R2_HCAT = 192 * MiB, R2_LORA_IN = 384 * MiB, R2_YPRE = 0, R2_Z = 192 * MiB, R2_HMID = 0;
constexpr int CW_TMO = 0, CW_BAR = 4096, CW_CNT = 16384, CW_FILL = 32768;

constexpr int LDS_BYTES = 155648;
constexpr int LDSCTL_OFF = 153600;

DI unsigned pk2(float lo, float hi) { bf16x2_t b = __builtin_convertvector((f32x2){lo, hi}, bf16x2_t); return __builtin_bit_cast(unsigned, b); }
DI unsigned f2bf(float f) { return pk2(f, 0.f) & 0xffffu; }
DI float u2f_(unsigned u) { return __builtin_bit_cast(float, u); }
DI unsigned f2u_(float f) { return __builtin_bit_cast(unsigned, f); }
DI float bflo(unsigned u) { return __builtin_bit_cast(float, u << 16); }
DI float bfhi(unsigned u) { return __builtin_bit_cast(float, u & 0xffff0000u); }
DI unsigned pk4_f8(float a, float b, float c, float d) {
    a = __builtin_amdgcn_fmed3f(a, -448.f, 448.f); b = __builtin_amdgcn_fmed3f(b, -448.f, 448.f); c = __builtin_amdgcn_fmed3f(c, -448.f, 448.f); d = __builtin_amdgcn_fmed3f(d, -448.f, 448.f);
    int w = 0; w = __builtin_amdgcn_cvt_pk_fp8_f32(a, b, w, false); w = __builtin_amdgcn_cvt_pk_fp8_f32(c, d, w, true); return (unsigned)w; }
DI float sigmoidf_(float x) { return __builtin_amdgcn_rcpf(1.f + __builtin_amdgcn_exp2f(-1.4426950408889634f * x)); }
template <int CTRL> DI float dppf(float x) { return __builtin_bit_cast(float, __builtin_amdgcn_update_dpp(0, __builtin_bit_cast(int, x), CTRL, 0xF, 0xF, true)); }
DI float red4(float x) { x += dppf<0xB1>(x); x += dppf<0x4E>(x); return x; }
DI float red8(float x) { x = red4(x); x += dppf<0x141>(x); return x; }
DI float red16(float x) { x = red8(x); x += dppf<0x140>(x); return x; }
DI float red8o(float x) { x += dppf<0xB1>(x); asm("" : "+v"(x)); x += dppf<0x4E>(x); asm("" : "+v"(x)); x += dppf<0x141>(x); asm("" : "+v"(x)); return x; }
DI float red16o(float x) { x = red8o(x); x += dppf<0x140>(x); asm("" : "+v"(x)); return x; }
typedef short s16x4 __attribute__((ext_vector_type(4)));
DI u32x2 trd4(const LAS unsigned char* img, int PB, int rowbase, int colbase, int lane) {
    const LAS unsigned char* p = img + (rowbase + ((lane & 15) >> 2)) * PB + (colbase + 16 * ((lane >> 4) & 1) + 4 * (lane & 3)) * 2;
    return __builtin_bit_cast(u32x2, __builtin_amdgcn_ds_read_tr16_b64_v4i16((LAS s16x4*)p)); }
DI bf16x8 trd8(const LAS unsigned char* img, int PB, int rb0, int rb1, int colbase, int lane) { const u32x2 lo = trd4(img, PB, rb0, colbase, lane), hi = trd4(img, PB, rb1, colbase, lane); return __builtin_bit_cast(bf16x8, (u32x4){lo.x, lo.y, hi.x, hi.y}); }
template <int CTRL, int RM> DI float dpp_keep(float x, float ident) { return __builtin_bit_cast(float, __builtin_amdgcn_update_dpp(__builtin_bit_cast(int, ident), __builtin_bit_cast(int, x), CTRL, RM, 0xF, false)); }
DI float scan_add64(float x) { x += dpp_keep<0x111, 0xF>(x, 0.f); x += dpp_keep<0x112, 0xF>(x, 0.f); x += dpp_keep<0x114, 0xF>(x, 0.f); x += dpp_keep<0x118, 0xF>(x, 0.f); x += dpp_keep<0x142, 0xA>(x, 0.f); x += dpp_keep<0x143, 0xC>(x, 0.f); return x; }
DI float scan_max64(float x) { const float NI = -3.0e38f; x = fmaxf(x, dpp_keep<0x111, 0xF>(x, NI)); x = fmaxf(x, dpp_keep<0x112, 0xF>(x, NI)); x = fmaxf(x, dpp_keep<0x114, 0xF>(x, NI)); x = fmaxf(x, dpp_keep<0x118, 0xF>(x, NI));
    x = fmaxf(x, dpp_keep<0x142, 0xA>(x, NI)); x = fmaxf(x, dpp_keep<0x143, 0xC>(x, NI)); return x; }
DI float wave_sum(float v) {
    v = red16(v);
    const int vi = __builtin_bit_cast(int, v);
    const float a = __builtin_bit_cast(float, __builtin_amdgcn_readlane(vi, 0)), b = __builtin_bit_cast(float, __builtin_amdgcn_readlane(vi, 16));
    const float c = __builtin_bit_cast(float, __builtin_amdgcn_readlane(vi, 32)), d = __builtin_bit_cast(float, __builtin_amdgcn_readlane(vi, 48));
    return (a + b) + (c + d);
}
#define LDS_WAIT() asm volatile("s_waitcnt lgkmcnt(0)" ::: "memory")

constexpr float F8_SX = 8.f, F8_SWGU = 512.f, F8_SH = 4.f, F8_SWDN = 1024.f, F8_INV1 = 1.f / (F8_SX * F8_SWGU), F8_INV2 = 1.f / (F8_SH * F8_SWDN);
namespace pg8 {
constexpr int BM = 256, BK = 64, HALF = 128, HTB = HALF * BK * 2, STAGE_BYTES = 8 * HTB, NXCD = 8, WGM = 8;
__host__ __device__ __forceinline__ int lds_byte(int r, int c) { const int st = (r >> 4) * 2 + (c >> 5), rr = r & 15, cc = c & 31, ob = rr * 64 + cc * 2; return st * 1024 + (ob ^ (((ob >> 9) & 1) << 5)); }
__host__ __device__ __forceinline__ void stage_rc(int b, int& R, int& C) { const int st = b / 1024, sb = b % 1024, swz = sb ^ (((sb >> 9) & 1) << 5); R = (st >> 1) * 16 + swz / 64; C = (st & 1) * 32 + (swz % 64) / 2; }
__host__ __device__ __forceinline__ int perm32(int rho) { const int n = rho >> 4, i = rho & 15; return 8 * (i >> 2) + 4 * n + (i & 3); }

struct Unit { const char* a; const char* b; char* c; int ldc; int r0, c0, e, sub; };

struct TileOrder {
    int nM, nN, nwg;
    DI void init(int nM_, int nN_) { nM = nM_; nN = nN_; nwg = nM * nN; }
    DI bool tile(long L, int& pm, int& pn) const {
        if (L >= nwg) return false;
        int wgid = (int)L; { const int q = nwg / NXCD, r = nwg % NXCD, xcd = wgid % NXCD, off = wgid / NXCD; wgid = (xcd < r ? xcd * (q + 1) : r * (q + 1) + (xcd - r) * q) + off; }
        const int nig = WGM * nN, gid = wgid / nig, fm = gid * WGM, gsz = (nM - fm) < WGM ? (nM - fm) : WGM;
        pm = fm + ((wgid % nig) % gsz); pn = (wgid % nig) / gsz; return true;
    }
};

DI u32x4 pack8(const f32x4& v0, const f32x4& v1) { u32x4 w; w.x = pk2(v0[0], v0[1]); w.y = pk2(v0[2], v0[3]); w.z = pk2(v1[0], v1[1]); w.w = pk2(v1[2], v1[3]); return w; }

struct EpiStore {
    DI void operator()(const f32x4 (&acc)[2][2][4][2], const Unit& u, int wr, int wc, int fr, int fq) const {
#pragma unroll
        for (int ai = 0; ai < 2; ++ai)
#pragma unroll
            for (int m = 0; m < 4; ++m) { char* rowp = u.c + ((size_t)(ai * HALF + wr * 64 + m * 16 + fr) * u.ldc + wc * 32 + 8 * fq) * 2;
#pragma unroll
                for (int bj = 0; bj < 2; ++bj) *(u32x4*)(rowp + bj * 256) = pack8(acc[ai][bj][m][0], acc[ai][bj][m][1]); }
    }
};
struct EpiStoreS {
    float s; const float* gate_b; int gate_c0;
    DI void operator()(const f32x4 (&acc)[2][2][4][2], const Unit& u, int wr, int wc, int fr, int fq) const {
        const bool gate = u.c0 >= gate_c0;
        const float L2E = 1.4426950408889634f;
#pragma unroll
        for (int bj = 0; bj < 2; ++bj) {
            f32x4 g0 = (f32x4){0.f, 0.f, 0.f, 0.f}, g1 = g0;
            if (gate) { const float* g = gate_b + (u.c0 - gate_c0) + bj * HALF + wc * 32 + 8 * fq; g0 = *(const f32x4*)g; g1 = *(const f32x4*)(g + 4); }
#pragma unroll
            for (int ai = 0; ai < 2; ++ai)
#pragma unroll
                for (int m = 0; m < 4; ++m) { char* rowp = u.c + ((size_t)(ai * HALF + wr * 64 + m * 16 + fr) * u.ldc + wc * 32 + 8 * fq) * 2;
                    f32x4 v0 = acc[ai][bj][m][0] * s, v1 = acc[ai][bj][m][1] * s;
                    if (gate) {
#pragma unroll
                        for (int i = 0; i < 4; ++i) { v0[i] = __builtin_amdgcn_exp2f(-L2E * __builtin_amdgcn_fmed3f(v0[i] + g0[i], -30.f, 30.f)); v1[i] = __builtin_amdgcn_exp2f(-L2E * __builtin_amdgcn_fmed3f(v1[i] + g1[i], -30.f, 30.f)); } }
                    *(u32x4*)(rowp + bj * 256) = pack8(v0, v1); }
        }
    }
};
struct EpiMerge {
    static constexpr bool MIDK = true;
    const char* U; const float* gate_b;
    DI void mid(f32x4 (&acc)[2][2][4][2], const Unit& u, int which, int wr, int wc, int fr, int fq) const {
#pragma unroll
        for (int bj = 0; bj < 2; ++bj)
#pragma unroll
            for (int ai = 0; ai < 2; ++ai) {
                u32x4 wa[4], wn[4];
#pragma unroll
                for (int m = 0; m < 4; ++m) { const int lr = ai * HALF + wr * 64 + m * 16 + fr;
                    const char* gp = U + ((size_t)(u.r0 + lr) * NU + UC_GATE + which * 1024 + u.c0 + wc * 32 + 8 * fq) * 2 + bj * 256;
                    wa[m] = *(const u32x4*)gp; wn[m] = *(const u32x4*)(gp + 2048); }
#pragma unroll
                for (int m = 0; m < 4; ++m) {
                    const u32x4 a = wa[m], n = wn[m];
                    const float ea[8] = {bflo(a.x), bfhi(a.x), bflo(a.y), bfhi(a.y), bflo(a.z), bfhi(a.z), bflo(a.w), bfhi(a.w)};
                    const float en[8] = {bflo(n.x), bfhi(n.x), bflo(n.y), bfhi(n.y), bflo(n.z), bfhi(n.z), bflo(n.w), bfhi(n.w)};
#pragma unroll
                    for (int i = 0; i < 8; ++i) acc[ai][bj][m][i >> 2][i & 3] *= (1.f + en[i]) * __builtin_amdgcn_rcpf(1.f + ea[i]); }
                asm volatile("" ::: "memory"); }
    }
    DI void operator()(const f32x4 (&acc)[2][2][4][2], const Unit& u, int wr, int wc, int fr, int fq) const {
#pragma unroll
        for (int bj = 0; bj < 2; ++bj) {
            u32x4 gw[2][4];
#pragma unroll
            for (int ai = 0; ai < 2; ++ai)
#pragma unroll
                for (int m = 0; m < 4; ++m) { const int lr = ai * HALF + wr * 64 + m * 16 + fr; gw[ai][m] = *(const u32x4*)(U + ((size_t)(u.r0 + lr) * NU + UC_GATE + 2048 + u.c0 + wc * 32 + 8 * fq) * 2 + bj * 256); }
#pragma unroll
            for (int ai = 0; ai < 2; ++ai)
#pragma unroll
                for (int m = 0; m < 4; ++m) { const int lr = ai * HALF + wr * 64 + m * 16 + fr; char* rowp = u.c + ((size_t)lr * u.ldc + wc * 32 + 8 * fq) * 2; const u32x4 w = gw[ai][m];
                    f32x4 v0 = acc[ai][bj][m][0], v1 = acc[ai][bj][m][1];
                    v0[0] *= __builtin_amdgcn_rcpf(1.f + bflo(w.x)); v0[1] *= __builtin_amdgcn_rcpf(1.f + bfhi(w.x)); v0[2] *= __builtin_amdgcn_rcpf(1.f + bflo(w.y)); v0[3] *= __builtin_amdgcn_rcpf(1.f + bfhi(w.y));
                    v1[0] *= __builtin_amdgcn_rcpf(1.f + bflo(w.z)); v1[1] *= __builtin_amdgcn_rcpf(1.f + bfhi(w.z)); v1[2] *= __builtin_amdgcn_rcpf(1.f + bflo(w.w)); v1[3] *= __builtin_amdgcn_rcpf(1.f + bfhi(w.w));
                    *(u32x4*)(rowp + bj * 256) = pack8(v0, v1); }
            asm volatile("" ::: "memory");
        }
    }
};
struct EpiWo {
    const char* X;
    DI void operator()(const f32x4 (&acc)[2][2][4][2], const Unit& u, int wr, int wc, int fr, int fq) const {
#pragma unroll
        for (int ai = 0; ai < 2; ++ai)
#pragma unroll
            for (int m = 0; m < 4; ++m) { const int lr = ai * HALF + wr * 64 + m * 16 + fr; char* rowp = u.c + ((size_t)lr * u.ldc + wc * 32 + 8 * fq) * 2;
                const char* xp = X + ((size_t)(u.r0 + lr) * D + u.c0 + wc * 32 + 8 * fq) * 2;
#pragma unroll
                for (int bj = 0; bj < 2; ++bj) { const u32x4 xw = *(const u32x4*)(xp + bj * 256);
                    f32x4 v0 = acc[ai][bj][m][0], v1 = acc[ai][bj][m][1];
                    v0[0] += DN_ALPHA * bflo(xw.x); v0[1] += DN_ALPHA * bfhi(xw.x); v0[2] += DN_ALPHA * bflo(xw.y); v0[3] += DN_ALPHA * bfhi(xw.y);
                    v1[0] += DN_ALPHA * bflo(xw.z); v1[1] += DN_ALPHA * bfhi(xw.z); v1[2] += DN_ALPHA * bflo(xw.w); v1[3] += DN_ALPHA * bfhi(xw.w);
                    *(u32x4*)(rowp + bj * 256) = pack8(v0, v1); }
                asm volatile("" ::: "memory"); }
    }
};
DI float swiglu1(float a, float b) { const float g = fminf(a, 7.f), l = fminf(fmaxf(b, -7.f), 7.f); return g * sigmoidf_(1.702f * g) * (l + 1.f); }
struct EpiMoe1 {
    const float* bgu;
    DI void operator()(const f32x4 (&acc)[2][2][4][2], const Unit& u, int wr, int wc, int fr, int fq) const {
        f32x4 bv[2][2];
#pragma unroll
        for (int bj = 0; bj < 2; ++bj) { const float* b = bgu + u.e * 2048 + u.c0 + bj * HALF + wc * 32 + 8 * fq; bv[bj][0] = *(const f32x4*)b; bv[bj][1] = *(const f32x4*)(b + 4); }
#pragma unroll
        for (int ai = 0; ai < 2; ++ai)
#pragma unroll
            for (int m = 0; m < 4; ++m) { const int lr = ai * HALF + wr * 64 + m * 16 + fr; char* rowp = u.c + ((size_t)lr * u.ldc + wc * 16 + 4 * fq);
#pragma unroll
                for (int bj = 0; bj < 2; ++bj) { const f32x4 v0 = acc[ai][bj][m][0] * F8_INV1 + bv[bj][0], v1 = acc[ai][bj][m][1] * F8_INV1 + bv[bj][1];
                    *(unsigned*)(rowp + bj * 64) = pk4_f8(swiglu1(v0[0], v0[1]) * F8_SH, swiglu1(v0[2], v0[3]) * F8_SH, swiglu1(v1[0], v1[1]) * F8_SH, swiglu1(v1[2], v1[3]) * F8_SH); } }
    }
};
struct EpiMoe2 {
    const float* bdn;
    DI void operator()(const f32x4 (&acc)[2][2][4][2], const Unit& u, int wr, int wc, int fr, int fq) const {
        f32x4 bv[2][2];
#pragma unroll
        for (int bj = 0; bj < 2; ++bj) { const float* b = bdn + u.e * 1024 + u.c0 + bj * HALF + wc * 32 + 8 * fq; bv[bj][0] = *(const f32x4*)b; bv[bj][1] = *(const f32x4*)(b + 4); }
#pragma unroll
        for (int ai = 0; ai < 2; ++ai)
#pragma unroll
            for (int m = 0; m < 4; ++m) { char* rowp = u.c + ((size_t)(ai * HALF + wr * 64 + m * 16 + fr) * u.ldc + wc * 32 + 8 * fq) * 2;
#pragma unroll
                for (int bj = 0; bj < 2; ++bj) *(u32x4*)(rowp + bj * 256) = pack8(acc[ai][bj][m][0] * F8_INV2 + bv[bj][0], acc[ai][bj][m][1] * F8_INV2 + bv[bj][1]); }
    }
};

typedef int i32x8 __attribute__((ext_vector_type(8)));
typedef int i32x4 __attribute__((ext_vector_type(4)));
template <bool F8, bool MIDK = false, class Epi, class Sched>
DI void gemm_phase(LAS unsigned char* lds, const int KB  , const int ldaB, const int ldbB, const Sched& S, const Epi& E, const int wave_) {
    unsigned z_ = 0u; asm volatile("" : "+v"(z_)); const int tid = wave_ * 64 + (int)__builtin_amdgcn_mbcnt_hi(~0u, __builtin_amdgcn_mbcnt_lo(~0u, z_));
    const int wid = __builtin_amdgcn_readfirstlane(tid >> 6), lane = tid & 63, wr = wid >> 2, wc = wid & 3, fr = lane & 15, fq = lane >> 4;
    const int nt = KB / (BK * 2);
    unsigned voffA[2], voffB[2];
#pragma unroll
    for (int i = 0; i < 2; ++i) { int R, C; stage_rc(tid * 16 + i * 8192, R, C); const int Rb = (R & ~31) + perm32(R & 31);
        voffA[i] = (unsigned)(R * ldaB + C * 2); voffB[i] = (unsigned)(Rb * ldbB + C * 2); }
    asm volatile("" : "+v"(voffA[0]), "+v"(voffA[1]), "+v"(voffB[0]), "+v"(voffB[1]));
    const size_t kstep = (size_t)(BK * 2);
    const size_t hstepA = (size_t)HALF * ldaB, hstepB = (size_t)HALF * ldbB;
    const unsigned ldsw = (unsigned)wid * 1024u;
    const int aoff = lds_byte(wr * 64 + fr, fq * 8), boff = lds_byte(wc * 32 + fr, fq * 8);
#define PG8_SA(b, h) (((b) * 2 + (h)) * HTB)
#define PG8_SB(b, h) ((4 + (b) * 2 + (h)) * HTB)
#define PG8_STAGE(bufoff, gbase, voff) do { _Pragma("unroll") for (int _i = 0; _i < 2; ++_i) \
        __builtin_amdgcn_global_load_lds((const unsigned*)((const char*)(gbase) + (voff)[_i]), (LAS unsigned*)(lds + (bufoff) + ldsw + _i * 8192), 16, 0, 0); } while (0)
#define PG8_LD8(p) __builtin_shufflevector(*(const LAS i32x4*)(p), *(const LAS i32x4*)((p) + 1024), 0, 1, 2, 3, 4, 5, 6, 7)
#define PG8_LDA8(dst, b, h) do { _Pragma("unroll") for (int m = 0; m < 4; ++m) dst[m] = PG8_LD8(lds + PG8_SA(b, h) + aoff + m * 2048); } while (0)
#define PG8_LDB8(dst, b, h) do { _Pragma("unroll") for (int n = 0; n < 2; ++n) dst[n] = PG8_LD8(lds + PG8_SB(b, h) + boff + n * 2048); } while (0)
#define PG8_MMA8(ai, bj, A8, B8) do { __builtin_amdgcn_s_setprio(1); _Pragma("unroll") for (int m = 0; m < 4; ++m) _Pragma("unroll") for (int n = 0; n < 2; ++n) \
        asm volatile("v_mfma_f32_16x16x128_f8f6f4 %0, %1, %2, %0" : "+v"(acc[ai][bj][m][n]) : "v"(B8[n]), "v"(A8[m])); __builtin_amdgcn_s_setprio(0); } while (0)
#define PG8_LDA(dst, b, h) do { _Pragma("unroll") for (int m = 0; m < 4; ++m) _Pragma("unroll") for (int k = 0; k < 2; ++k) dst[m][k] = *(const LAS bf16x8*)(lds + PG8_SA(b, h) + aoff + m * 2048 + k * 1024); } while (0)
#define PG8_LDB(dst, b, h) do { _Pragma("unroll") for (int n = 0; n < 2; ++n) _Pragma("unroll") for (int k = 0; k < 2; ++k) dst[n][k] = *(const LAS bf16x8*)(lds + PG8_SB(b, h) + boff + n * 2048 + k * 1024); } while (0)
#define PG8_CAT(x) __builtin_shufflevector(__builtin_bit_cast(i32x4, (x)[0]), __builtin_bit_cast(i32x4, (x)[1]), 0, 1, 2, 3, 4, 5, 6, 7)
#define PG8_MMA(ai, bj, At, Bt) do { __builtin_amdgcn_s_setprio(1); _Pragma("unroll") for (int m = 0; m < 4; ++m) _Pragma("unroll") for (int n = 0; n < 2; ++n) _Pragma("unroll") for (int k = 0; k < 2; ++k) \
        acc[ai][bj][m][n] = __builtin_amdgcn_mfma_f32_16x16x32_bf16(Bt[n][k], At[m][k], acc[ai][bj][m][n], 0, 0, 0); __builtin_amdgcn_s_setprio(0); } while (0)
#define PG8_WAIT_V(n) asm volatile("s_waitcnt vmcnt(" #n ")" ::: "memory")
#define PG8_WAIT_L(n) asm volatile("s_waitcnt lgkmcnt(" #n ")" ::: "memory")
#define PG8_BAR __builtin_amdgcn_s_barrier()
#define PG8_SCHED __builtin_amdgcn_sched_barrier(0)
    Unit cur, nxt; int ui = 0;
    if (!S.next(0, cur)) return;
    f32x4 acc[2][2][4][2];
#pragma unroll
    for (int a = 0; a < 2; ++a)
#pragma unroll
        for (int b = 0; b < 2; ++b)
#pragma unroll
            for (int m = 0; m < 4; ++m)
#pragma unroll
                for (int n = 0; n < 2; ++n) acc[a][b][m][n] = (f32x4){0.f, 0.f, 0.f, 0.f};
    bf16x8 At[4][2], B0[2][2], B1[2][2]; i32x8 A8[4], B80[2], B81[2];
    const char* cA = cur.a; const char* cB = cur.b;
    PG8_STAGE(PG8_SB(0, 0), cB, voffB); PG8_STAGE(PG8_SB(0, 1), cB + hstepB, voffB); PG8_STAGE(PG8_SA(0, 0), cA, voffA); PG8_STAGE(PG8_SA(0, 1), cA + hstepA, voffA);
    if (wr == 1) PG8_BAR;
    PG8_WAIT_V(2); PG8_BAR;
    PG8_STAGE(PG8_SB(1, 0), cB + kstep, voffB); PG8_STAGE(PG8_SA(1, 0), cA + kstep, voffA); PG8_STAGE(PG8_SB(1, 1), cB + hstepB + kstep, voffB);
    PG8_WAIT_V(6); PG8_BAR;
    for (;;) {
        const bool has_next = S.next(ui + 1, nxt);
        const char* nA = has_next ? nxt.a : cA; const char* nB = has_next ? nxt.b : cB;
#pragma unroll 1
        for (int t = 0; t < nt; t += 2) {
            if constexpr (MIDK) { if (t == 8 || t == 16) { int fr_ = fr, fq_ = fq; asm volatile("" : "+v"(fr_), "+v"(fq_)); E.mid(acc, cur, t >> 4, wr, wc, fr_, fq_); } }
            const bool last = (t == nt - 2);
            const char* a1 = cA + (size_t)(t + 1) * kstep;
            const char* a2 = last ? nA : cA + (size_t)(t + 2) * kstep; const char* b2 = last ? nB : cB + (size_t)(t + 2) * kstep;
            const char* a3 = a2 + kstep; const char* b3 = b2 + kstep;
            if constexpr (F8) {
            PG8_LDB8(B80, 0, 0); PG8_LDB8(B81, 0, 1); PG8_SCHED; PG8_LDA8(A8, 0, 0); PG8_STAGE(PG8_SA(1, 1), a1 + hstepA, voffA);
            PG8_WAIT_V(8); PG8_WAIT_L(0); PG8_BAR; PG8_MMA8(0, 0, A8, B80); PG8_MMA8(0, 1, A8, B81); PG8_BAR; PG8_SCHED;
            PG8_LDA8(A8, 0, 1); PG8_STAGE(PG8_SB(0, 0), b2, voffB); PG8_STAGE(PG8_SB(0, 1), b2 + hstepB, voffB); PG8_STAGE(PG8_SA(0, 0), a2, voffA);
            PG8_WAIT_V(8); PG8_WAIT_L(0); PG8_BAR; PG8_MMA8(1, 0, A8, B80); PG8_MMA8(1, 1, A8, B81); PG8_BAR; PG8_SCHED;
            PG8_LDB8(B80, 1, 0); PG8_LDB8(B81, 1, 1); PG8_SCHED; PG8_LDA8(A8, 1, 0); PG8_STAGE(PG8_SA(0, 1), a2 + hstepA, voffA);
            PG8_WAIT_V(8); PG8_WAIT_L(0); PG8_BAR; PG8_MMA8(0, 0, A8, B80); PG8_MMA8(0, 1, A8, B81); PG8_BAR; PG8_SCHED;
            PG8_LDA8(A8, 1, 1); PG8_STAGE(PG8_SB(1, 0), b3, voffB); PG8_STAGE(PG8_SB(1, 1), b3 + hstepB, voffB); PG8_STAGE(PG8_SA(1, 0), a3, voffA);
            PG8_WAIT_V(8); PG8_WAIT_L(0); PG8_BAR; PG8_MMA8(1, 0, A8, B80); PG8_MMA8(1, 1, A8, B81); PG8_BAR; PG8_SCHED;
            } else {
            PG8_LDB(B0, 0, 0); PG8_LDB(B1, 0, 1); PG8_SCHED; PG8_LDA(At, 0, 0); PG8_STAGE(PG8_SA(1, 1), a1 + hstepA, voffA);
            PG8_WAIT_V(8); PG8_WAIT_L(0); PG8_BAR; PG8_MMA(0, 0, At, B0); PG8_MMA(0, 1, At, B1); PG8_BAR; PG8_SCHED;
            PG8_LDA(At, 0, 1); PG8_STAGE(PG8_SB(0, 0), b2, voffB); PG8_STAGE(PG8_SB(0, 1), b2 + hstepB, voffB); PG8_STAGE(PG8_SA(0, 0), a2, voffA);
            PG8_WAIT_V(8); PG8_WAIT_L(0); PG8_BAR; PG8_MMA(1, 0, At, B0); PG8_MMA(1, 1, At, B1); PG8_BAR; PG8_SCHED;
            PG8_LDB(B0, 1, 0); PG8_LDB(B1, 1, 1); PG8_SCHED; PG8_LDA(At, 1, 0); PG8_STAGE(PG8_SA(0, 1), a2 + hstepA, voffA);
            PG8_WAIT_V(8); PG8_WAIT_L(0); PG8_BAR; PG8_MMA(0, 0, At, B0); PG8_MMA(0, 1, At, B1); PG8_BAR; PG8_SCHED;
            PG8_LDA(At, 1, 1); PG8_STAGE(PG8_SB(1, 0), b3, voffB); PG8_STAGE(PG8_SB(1, 1), b3 + hstepB, voffB); PG8_STAGE(PG8_SA(1, 0), a3, voffA);
            PG8_WAIT_V(8); PG8_WAIT_L(0); PG8_BAR; PG8_MMA(1, 0, At, B0); PG8_MMA(1, 1, At, B1); PG8_BAR; PG8_SCHED;
            }
        }
        if (wr == 0) PG8_BAR;
        if constexpr (F8) asm volatile("s_nop 15\n\ts_nop 15" ::: "memory");
        { int fr_ = fr, fq_ = fq; asm volatile("" : "+v"(fr_), "+v"(fq_));
          E(acc, cur, wr, wc, fr_, fq_); }
        if (!has_next) break;
#pragma unroll
        for (int a = 0; a < 2; ++a)
#pragma unroll
            for (int b = 0; b < 2; ++b)
#pragma unroll
                for (int m = 0; m < 4; ++m)
#pragma unroll
                    for (int n = 0; n < 2; ++n) acc[a][b][m][n] = (f32x4){0.f, 0.f, 0.f, 0.f};
        cur = nxt; cA = nA; cB = nB; ++ui;
        if (wr == 1) PG8_BAR;
    }
    PG8_WAIT_V(0);
    PG8_BAR;
#undef PG8_SA
#undef PG8_SB
#undef PG8_STAGE
#undef PG8_LDA
#undef PG8_LDB
#undef PG8_MMA
#undef PG8_CAT
#undef PG8_LD8
#undef PG8_LDA8
#undef PG8_LDB8
#undef PG8_MMA8
#undef PG8_WAIT_V
#undef PG8_WAIT_L
#undef PG8_BAR
#undef PG8_SCHED
}
}

#define XB_TMO      128
#define XB_XCNT(j)  (256  + 64 * (j))
#define XB_XSUB(j)  (1280 + 64 * (j))
#define XB_XGEN(j)  (2304 + 64 * (j))
#define XB_TOP      3328
#define XB_TOPGEN   3392
#define XCD_BAR_WORDS 3456
#define XB_SPIN_CAP (1u << 22)
DI unsigned xb_ld(unsigned* p)              { return __hip_atomic_load(p, __ATOMIC_RELAXED, __HIP_MEMORY_SCOPE_AGENT); }
DI unsigned xb_add(unsigned* p, unsigned v) { return __hip_atomic_fetch_add(p, v, __ATOMIC_RELAXED, __HIP_MEMORY_SCOPE_AGENT); }
DI unsigned xb_xcc_id() { return (unsigned)__builtin_amdgcn_s_getreg((3 << 11) | 20) & 0xFu; }
#define XB_SPIN(cond, bar) do { unsigned _sp = 0; while (cond) { __builtin_amdgcn_s_sleep(1); \
    if ((++_sp & 255u) == 0u) { if (xb_ld(&(bar)[XB_TMO])) break; if (_sp > XB_SPIN_CAP) { atomicAdd(&(bar)[XB_TMO], 1u); break; } } } } while (0)
struct XcdBarrier { unsigned* bar; unsigned x; volatile LAS unsigned* st; };
DI XcdBarrier xcd_barrier_post(unsigned* bar, volatile LAS unsigned* st) {
    XcdBarrier b; b.bar = bar; b.x = xb_xcc_id(); b.st = st;
    if (threadIdx.x == 0) (void)xb_add(&bar[XB_XCNT(b.x)], 1u);
    return b;
}
DI void xcd_barrier_complete(unsigned* bar, unsigned x, unsigned& nloc, unsigned& nx) {
    const unsigned G = gridDim.x * gridDim.y * gridDim.z;
    unsigned sum, cnt, mine, sp = 0u;
    for (;;) {
        sum = 0u; cnt = 0u; mine = 0u;
#pragma unroll
        for (unsigned j = 0; j < 16; ++j) { const unsigned c = xb_ld(&bar[XB_XCNT(j)]); sum += c; cnt += (c > 0u) ? 1u : 0u; mine = (j == x) ? c : mine; }
        if (sum == G) break;
        __builtin_amdgcn_s_sleep(1);
        if ((++sp & 255u) == 0u) { if (xb_ld(&bar[XB_TMO])) break; if (sp > XB_SPIN_CAP) { atomicAdd(&bar[XB_TMO], 1u); break; } }
    }
    nloc = mine > 0u ? mine : 1u; nx = cnt > 0u ? cnt : 1u;
}
DI void xcd_barrier(const XcdBarrier& b) {
    asm volatile("s_waitcnt vmcnt(0)" ::: "memory");
    __syncthreads();
    if (threadIdx.x == 0) {
        unsigned* bar = b.bar;
        __builtin_amdgcn_s_waitcnt(0);
        unsigned nloc = b.st[0], nx = b.st[1];
        if (nloc == 0u) { xcd_barrier_complete(bar, b.x, nloc, nx); b.st[0] = nloc; b.st[1] = nx; }
        const unsigned old = xb_add(&bar[XB_XSUB(b.x)], 1u);
        const unsigned gen = old / nloc;
        if (old + 1u == (gen + 1u) * nloc) {
            __builtin_amdgcn_fence(__ATOMIC_RELEASE, "agent");
            asm volatile("s_waitcnt vmcnt(0)" ::: "memory");
            const unsigned og = xb_add(&bar[XB_TOP], 1u);
            const unsigned tg = og / nx;
            if (og + 1u == (tg + 1u) * nx) xb_add(&bar[XB_TOPGEN], 1u);
            else XB_SPIN(xb_ld(&bar[XB_TOPGEN]) == tg, bar);
            __builtin_amdgcn_fence(__ATOMIC_ACQUIRE, "agent");
            xb_add(&bar[XB_XGEN(b.x)], 1u);
            asm volatile("s_waitcnt vmcnt(0)" ::: "memory");
        } else {
            XB_SPIN(xb_ld(&bar[XB_XGEN(b.x)]) == gen, bar);
            __builtin_amdgcn_fence(__ATOMIC_ACQUIRE, "agent");
            asm volatile("s_waitcnt vmcnt(0)" ::: "memory");
        }
    }
    __syncthreads();
}

DI void transpose_item(const float* W, int ldw, bf16* WT, int ldt, LAS float* scr, int lane) {
    { const int kr = lane >> 3, c4 = (lane & 7) * 4; f32x4 v[8];
#pragma unroll
        for (int i = 0; i < 8; ++i) v[i] = *(const f32x4*)(W + (size_t)(8 * i + kr) * ldw + c4);
#pragma unroll
        for (int i = 0; i < 8; ++i) { LAS float* o = scr + (8 * i + kr) * 33 + c4; o[0] = v[i].x; o[1] = v[i].y; o[2] = v[i].z; o[3] = v[i].w; } }
    LDS_WAIT(); asm volatile("" ::: "memory");
    const int c = lane & 7;
#pragma unroll
    for (int j = 0; j < 4; ++j) { const int n = (lane >> 3) + 8 * j; const LAS float* s = scr + (8 * c) * 33 + n;
        u32x4 o; o.x = pk2(s[0 * 33], s[1 * 33]); o.y = pk2(s[2 * 33], s[3 * 33]); o.z = pk2(s[4 * 33], s[5 * 33]); o.w = pk2(s[6 * 33], s[7 * 33]);
        *(u32x4*)(WT + (size_t)n * ldt + 8 * c) = o; }
    LDS_WAIT(); asm volatile("" ::: "memory");
}
DI void transpose_item_f8(const float* W, int ldw, unsigned char* WT, int ldt, float scale, LAS float* scr, int lane) {
    { const int kr = lane >> 3, c4 = (lane & 7) * 4; f32x4 v[8];
#pragma unroll
        for (int i = 0; i < 8; ++i) v[i] = *(const f32x4*)(W + (size_t)(8 * i + kr) * ldw + c4);
#pragma unroll
        for (int i = 0; i < 8; ++i) { LAS float* o = scr + (8 * i + kr) * 33 + c4; o[0] = v[i].x; o[1] = v[i].y; o[2] = v[i].z; o[3] = v[i].w; } }
    LDS_WAIT(); asm volatile("" ::: "memory");
    const int c = lane & 3;
#pragma unroll
    for (int j = 0; j < 2; ++j) { const int n = (lane >> 2) + 16 * j; const LAS float* s = scr + (16 * c) * 33 + n;
        u32x4 o; o.x = pk4_f8(s[0 * 33] * scale, s[1 * 33] * scale, s[2 * 33] * scale, s[3 * 33] * scale); o.y = pk4_f8(s[4 * 33] * scale, s[5 * 33] * scale, s[6 * 33] * scale, s[7 * 33] * scale);
        o.z = pk4_f8(s[8 * 33] * scale, s[9 * 33] * scale, s[10 * 33] * scale, s[11 * 33] * scale); o.w = pk4_f8(s[12 * 33] * scale, s[13 * 33] * scale, s[14 * 33] * scale, s[15 * 33] * scale);
        *(u32x4*)(WT + (size_t)n * ldt + 16 * c) = o; }
    LDS_WAIT(); asm volatile("" ::: "memory");
}
DI void ti_load(const float* W, int ldw, int lane, f32x4 (&v)[8]) {
    const int kr = lane >> 3, c4 = (lane & 7) * 4;
#pragma unroll
    for (int i = 0; i < 8; ++i) v[i] = *(const f32x4*)(W + (size_t)(8 * i + kr) * ldw + c4);
}
DI void ti_store_f8(const f32x4 (&v)[8], unsigned char* WT, int ldt, float scale, LAS float* scr, int lane) {
    { const int kr = lane >> 3, c4 = (lane & 7) * 4;
#pragma unroll
        for (int i = 0; i < 8; ++i) { LAS float* o = scr + (8 * i + kr) * 33 + c4; o[0] = v[i].x; o[1] = v[i].y; o[2] = v[i].z; o[3] = v[i].w; } }
    LDS_WAIT(); asm volatile("" ::: "memory");
    const int c = lane & 3;
#pragma unroll
    for (int j = 0; j < 2; ++j) { const int n = (lane >> 2) + 16 * j; const LAS float* s = scr + (16 * c) * 33 + n;
        u32x4 o; o.x = pk4_f8(s[0 * 33] * scale, s[1 * 33] * scale, s[2 * 33] * scale, s[3 * 33] * scale); o.y = pk4_f8(s[4 * 33] * scale, s[5 * 33] * scale, s[6 * 33] * scale, s[7 * 33] * scale);
        o.z = pk4_f8(s[8 * 33] * scale, s[9 * 33] * scale, s[10 * 33] * scale, s[11 * 33] * scale); o.w = pk4_f8(s[12 * 33] * scale, s[13 * 33] * scale, s[14 * 33] * scale, s[15 * 33] * scale);
        *(u32x4*)(WT + (size_t)n * ldt + 16 * c) = o; }
    LDS_WAIT(); asm volatile("" ::: "memory");
}
DI void ti_load4(const float* W, int ldw, int lane, f32x4 (&v)[8]) {
    const int a = lane & 15, g = lane >> 4;
#pragma unroll
    for (int b = 0; b < 2; ++b)
#pragma unroll
        for (int j = 0; j < 4; ++j) v[4 * b + j] = *(const f32x4*)(W + (size_t)(4 * a + j) * ldw + 4 * (g + 4 * b));
}
DI void ti_store4_f8(const f32x4 (&v)[8], unsigned char* WT, int ldt, float scale, int lane) {
    const int a = lane & 15, g = lane >> 4;
#pragma unroll
    for (int b = 0; b < 2; ++b)
#pragma unroll
        for (int q = 0; q < 4; ++q)
            *(unsigned*)(WT + (size_t)(4 * (g + 4 * b) + q) * ldt + 4 * a) = pk4_f8(v[4 * b][q] * scale, v[4 * b + 1][q] * scale, v[4 * b + 2][q] * scale, v[4 * b + 3][q] * scale);
}
DI void ln16(f32x4 (&v)[4], const f32x4 (&g)[4], const f32x4 (&b)[4]) {
    float s = 0.f;
#pragma unroll
    for (int j = 0; j < 4; ++j) s += (v[j].x + v[j].y) + (v[j].z + v[j].w);
    const float mean = wave_sum(s) * (1.f / D); float s2 = 0.f;
#pragma unroll
    for (int j = 0; j < 4; ++j) { v[j] = v[j] - mean; s2 += (v[j].x * v[j].x + v[j].y * v[j].y) + (v[j].z * v[j].z + v[j].w * v[j].w); }
    const float rstd = 1.f / sqrtf(wave_sum(s2) * (1.f / D) + LN_EPS);
#pragma unroll
    for (int j = 0; j < 4; ++j) v[j] = v[j] * rstd * g[j] + b[j];
}
DI void gates8(const f32x4 (&y)[4], const LAS float* wgt, float* gif_row, int lane) {
    float p[8];
#pragma unroll
    for (int j = 0; j < 8; ++j) { float s = 0.f;
#pragma unroll
        for (int jj = 0; jj < 4; ++jj) { const f32x4 w = *(const LAS f32x4*)(wgt + j * 1024 + 256 * jj + 4 * lane); s += (y[jj].x * w.x + y[jj].y * w.y) + (y[jj].z * w.z + y[jj].w * w.w); }
        p[j] = wave_sum(s); }
    if (lane == 0) { *(f32x4*)gif_row = (f32x4){p[0], p[1], p[2], p[3]}; *(f32x4*)(gif_row + 4) = (f32x4){p[4], p[5], p[6], p[7]}; }
}
DI void gates8b(const f32x4 (&y)[4], const LAS float* wgt, float* gif_row, int lane) {
    float p[8];
#pragma unroll
    for (int j = 0; j < 8; ++j) { float s = 0.f;
#pragma unroll
        for (int jj = 0; jj < 4; ++jj) { const f32x4 w = *(const LAS f32x4*)(wgt + j * 1024 + (jj >> 1) * 512 + 8 * lane + (jj & 1) * 4); s += (y[jj].x * w.x + y[jj].y * w.y) + (y[jj].z * w.z + y[jj].w * w.w); }
        p[j] = wave_sum(s); }
    if (lane == 0) { *(f32x4*)gif_row = (f32x4){p[0], p[1], p[2], p[3]}; *(f32x4*)(gif_row + 4) = (f32x4){p[4], p[5], p[6], p[7]}; }
}
DI void load_gate_table(LAS float* wgt, const float* win_l, int tid) {
    for (int i = tid; i < 8192; i += NTHR) { const int k = i >> 3, j = i & 7; wgt[j * 1024 + k] = win_l[(size_t)k * DIN + 1536 + j]; }
}
DI f32x4 ld4bf(const char* p) { const u32x2 w = *(const u32x2*)p; return (f32x4){bflo(w.x), bfhi(w.x), bflo(w.y), bfhi(w.y)}; }
DI void st4bf(char* p, const f32x4& v) { u32x2 w; w.x = pk2(v.x, v.y); w.y = pk2(v.z, v.w); *(u32x2*)p = w; }

struct Args { const float* in[N_IN]; float* out; unsigned char* ws; int ph_lo, ph_hi; };
constexpr int NP_LAYER = 12, NPH = 1 + DEPTH * NP_LAYER;
constexpr int XW_SPLIT = 49152;

struct SchedInproj {
    pg8::TileOrder T; int G, c; const char *X, *W; char* U; bool kv; const char *MEMN, *WKV; char* KV;
    DI bool next(int i, pg8::Unit& u) const {
        const long L = (long)i * G + c; int pm, pn;
        if (T.tile(L, pm, pn)) { u.a = X + (size_t)pm * 256 * D * 2; u.b = W + (size_t)pn * 256 * D * 2; u.r0 = pm * 256; u.c0 = pn * 256; u.c = U + ((size_t)u.r0 * NU + u.c0) * 2; u.ldc = NU; u.e = 0; u.sub = 0; return true; }
        if (!kv) return false;
        const long L2 = L - T.nwg; if (L2 < 0 || L2 >= 128) return false;
        const int l = (int)L2 >> 6, t = (int)L2 & 63; pm = t >> 2; pn = t & 3;
        u.a = MEMN + (size_t)pm * 256 * D * 2; u.b = WKV + ((size_t)l * 1024 + pn * 256) * D * 2; u.r0 = pm * 256; u.c0 = pn * 256; u.c = KV + (((size_t)l * MROWS + u.r0) * D + u.c0) * 2; u.ldc = D; u.e = 0; u.sub = 0; return true;
    }
};
struct SchedPlain {
    pg8::TileOrder T; int G, c; const char *A, *B; char* C; int lda, ldb, ldc;
    DI bool next(int i, pg8::Unit& u) const {
        const long L = (long)i * G + c; int pm, pn; if (!T.tile(L, pm, pn)) return false;
        u.a = A + (size_t)pm * 256 * lda * 2; u.b = B + (size_t)pn * 256 * ldb * 2; u.r0 = pm * 256; u.c0 = pn * 256; u.c = C + ((size_t)u.r0 * ldc + u.c0) * 2; u.ldc = ldc; u.e = 0; u.sub = 0; return true;
    }
};
struct SchedMerge {
    pg8::TileOrder T; int G, c; const char *H, *W; char* Y;
    DI bool next(int i, pg8::Unit& u) const {
        const int ti = i / 3, br = i - 3 * ti; const long L = (long)ti * G + c; int pm, pn; if (!T.tile(L, pm, pn)) return false;
        u.a = H + ((size_t)pm * 256 * 1536 + br * 512) * 2; u.b = W + ((size_t)br * 1024 + pn * 256) * 512 * 2; u.r0 = pm * 256; u.c0 = pn * 256; u.c = Y + ((size_t)u.r0 * D + u.c0) * 2; u.ldc = D; u.e = 0; u.sub = br; return true;
    }
};
struct SchedMoe {
    pg8::TileOrder T; int G, c; const char *A, *W; char* C; const LAS int* PB; int wrows  , ldc, cdiv, osz;
    DI bool next(int i, pg8::Unit& u) const {
        const long L = (long)i * G + c; int pm, pn; if (!T.tile(L, pm, pn)) return false;
        int e = 0;
#pragma unroll 1
        for (int j = 1; j < NEXP; ++j) e += (PB[j] <= pm) ? 1 : 0;
        u.a = A + (size_t)pm * 256 * 1024; u.b = W + ((size_t)e * wrows + pn * 256) * 1024; u.r0 = pm * 256; u.c0 = pn * 256; u.c = C + ((size_t)u.r0 * ldc + u.c0 / cdiv) * osz; u.ldc = ldc; u.e = e; u.sub = 0; return true;
    }
};

__global__ void __launch_bounds__(NTHR, 2) fwd_kernel(Args args) {
    extern __shared__ __attribute__((aligned(16))) unsigned char lds_raw[];
#define INP(i) ([&]() -> const float* { int ii_ = (i); asm volatile("" : "+s"(ii_)); return args.in[ii_]; }())
    LAS unsigned char* lds = (LAS unsigned char*)lds_raw;
    volatile LAS unsigned* LCTL = (volatile LAS unsigned*)(lds + LDSCTL_OFF);
    const int tid0 = threadIdx.x, wave = __builtin_amdgcn_readfirstlane(tid0 >> 6);
#define PHASE_TID unsigned z_ = 0u; asm volatile("" : "+v"(z_)); int tid = wave * 64 + (int)__builtin_amdgcn_mbcnt_hi(~0u, __builtin_amdgcn_mbcnt_lo(~0u, z_)); const int lane = tid & 63; (void)lane;
    const int G = gridDim.x, bx = blockIdx.x;
    const int gw = bx * NWAVES + wave, NGW = G * NWAVES;
    unsigned char* ws = args.ws;
    gu32* ctl = (gu32*)(ws + WS_CTL);
    for (int u = tid0; u < (LDS_BYTES - LDSCTL_OFF) / 4; u += NTHR) ((LAS unsigned*)(lds + LDSCTL_OFF))[u] = 0u;
    __syncthreads();
    XcdBarrier bar; bar.bar = (unsigned*)ctl + CW_BAR; bar.x = 0; bar.st = nullptr;
    if (MK_ONE_LAUNCH) bar = xcd_barrier_post((unsigned*)ctl + CW_BAR, LCTL);
    const int lo = args.ph_lo, hi = args.ph_hi;
#ifndef SUBMASK
#define SUBMASK 7
#endif
#ifndef LN2PROBE
#define LN2PROBE 0
#endif
#ifndef SUBDUP
#define SUBDUP 0
#endif
#define NSUB(k) ((((SUBDUP) >> (k)) & 1) ? 2 : 1)
#ifndef DUPMASK
#define DUPMASK 0
#endif
#define NREP(k) ((((DUPMASK) >> (k)) & 1) ? 2 : 1)
#ifndef PHMASK
#define PHMASK 0xFFFF
#endif
#define IN(k) (lo <= (k) && (k) < hi)
#define SEAM(k) do { if (IN(k) && IN((k) + 1)) xcd_barrier(bar); } while (0)

    char* const Xb = (char*)(ws + WS_X);
    char* const Ub = (char*)(ws + WS_R1);
    float* const GIF = (float*)(ws + WS_GIF);
    LAS int* const PB = (LAS int*)(lds + LDSCTL_OFF + 64);
    LAS int* const CNT = (LAS int*)(lds + LDSCTL_OFF + 256);

    _Pragma("unroll 1") for (int rep_ = 0; rep_ < NREP(12); ++rep_) if (((PHMASK>>12)&1) && IN(0)) { PHASE_TID
        LAS float* scr = (LAS float*)(lds + wave * 8448);
        LAS float* wgt = (LAS float*)(lds + 73728);
        load_gate_table(wgt, INP(I_WIN), tid);
        constexpr int IT_IN = 16 * 216, IT_KV = 16 * 32, IT_BR = 8 * 32, IT_O = 16 * 32, IT_L = IT_IN + IT_KV + 3 * IT_BR + IT_O;
        for (int it = gw; it < DEPTH * IT_L; it += NGW) {
            const int l = it / IT_L; int r = it - l * IT_L;
            if (r < IT_IN) { const int kb = r / 216, nb = r % 216, n0 = 32 * nb, sc = ucol_src(n0);
                if (n0 < UC_F8) transpose_item(INP(I_WIN) + ((size_t)l * D + 64 * kb) * DIN + sc, DIN, (bf16*)(ws + WS_WIN) + ((size_t)l * NU + n0) * D + 64 * kb, D, scr, lane);
                else transpose_item_f8(INP(I_WIN) + ((size_t)l * D + 64 * kb) * DIN + sc, DIN, (unsigned char*)(ws + WS_WING8) + ((size_t)l * NF8 + (n0 - UC_F8)) * D + 64 * kb, D, F8_SWGU, scr, lane);
                continue; }
            r -= IT_IN;
            if (r < IT_KV) { const int kb = r / 32, nb = r % 32;
                transpose_item(INP(I_CAWKV) + ((size_t)l * D + 64 * kb) * 1024 + 32 * nb, 1024, (bf16*)(ws + WS_WKV) + ((size_t)l * 1024 + 32 * nb) * D + 64 * kb, D, scr, lane); continue; }
            r -= IT_KV;
            if (r < 3 * IT_BR) { const int br = r / IT_BR, q = r % IT_BR, kb = q / 32, nb = q % 32;
                const float* src = INP(br == 0 ? I_WBRML : (br == 1 ? I_WBRRW : I_WBRCA));
                transpose_item(src + ((size_t)l * 512 + 64 * kb) * 1024 + 32 * nb, 1024, (bf16*)(ws + WS_WBR) + ((size_t)l * 1024 + 32 * nb) * 1536 + br * 512 + 64 * kb, 1536, scr, lane); continue; }
            r -= 3 * IT_BR;
            { const int kb = r / 32, nb = r % 32;
                transpose_item(INP(I_WO) + ((size_t)l * D + 64 * kb) * 1024 + 32 * nb, 1024, (bf16*)(ws + WS_WO) + ((size_t)l * 1024 + 32 * nb) * D + 64 * kb, D, scr, lane); }
        }
        for (int i = bx * NTHR + tid; i < DEPTH * 1536 * 256; i += G * NTHR) {
            const int l = i / (1536 * 256), r = i % (1536 * 256), n = r >> 8, k = r & 255; float v = 0.f;
            if (n < 512) { if (k < 64) v = INP(I_RWWUP)[((size_t)l * 64 + k) * 512 + n]; }
            else if (n < 1024) { if (k >= 64 && k < 128) v = INP(I_RWAUP)[((size_t)l * 64 + (k - 64)) * 512 + (n - 512)]; }
            else { if (k >= 128) v = INP(I_RWGUP)[((size_t)l * 128 + (k - 128)) * 512 + (n - 1024)]; }
            ((bf16*)(ws + WS_WLORA))[i] = (bf16)f2bf(v);
        }
        __syncthreads();
        {
            f32x4 g[4], b[4];
#pragma unroll
            for (int j = 0; j < 4; ++j) { g[j] = *(const f32x4*)(INP(I_LNIN_G) + 256 * j + 4 * lane); b[j] = *(const f32x4*)(INP(I_LNIN_B) + 256 * j + 4 * lane); }
            for (int m = gw; m < M; m += NGW) {
                f32x4 v[4]; const float* xr = INP(I_X) + (size_t)m * D;
#pragma unroll
                for (int j = 0; j < 4; ++j) v[j] = *(const f32x4*)(xr + 256 * j + 4 * lane);
                ln16(v, g, b);
#pragma unroll
                for (int j = 0; j < 4; ++j) { st4bf(Xb + ((size_t)m * D + 256 * j + 4 * lane) * 2, v[j]); *(unsigned*)((char*)(ws + WS_XF8) + (size_t)m * D + 256 * j + 4 * lane) = pk4_f8(v[j].x * F8_SX, v[j].y * F8_SX, v[j].z * F8_SX, v[j].w * F8_SX); }
                gates8(v, wgt, GIF + (size_t)m * 8, lane);
            }
#pragma unroll
            for (int j = 0; j < 4; ++j) { g[j] = *(const f32x4*)(INP(I_MEMLN_G) + 256 * j + 4 * lane); b[j] = *(const f32x4*)(INP(I_MEMLN_B) + 256 * j + 4 * lane); }
            for (int m = gw; m < MROWS; m += NGW) {
                f32x4 v[4]; const float* xr = INP(I_MEM) + (size_t)m * D;
#pragma unroll
                for (int j = 0; j < 4; ++j) v[j] = *(const f32x4*)(xr + 256 * j + 4 * lane);
                ln16(v, g, b);
#pragma unroll
                for (int j = 0; j < 4; ++j) st4bf((char*)(ws + WS_MEMN) + ((size_t)m * D + 256 * j + 4 * lane) * 2, v[j]);
            }
        }
        __syncthreads();
    }
    SEAM(0);

#pragma unroll 1
    for (int l = 0; l < DEPTH; ++l) {
        const int pb = 1 + l * NP_LAYER;
        _Pragma("unroll 1") for (int rep_ = 0; rep_ < NREP(0); ++rep_) if (((PHMASK>>0)&1) && IN(pb + 0)) {
            SchedInproj S; S.T.init(M / 256, UC_F8 / 256); S.G = G; S.c = bx; S.X = Xb; S.W = (const char*)(ws + WS_WIN) + (size_t)l * NU * D * 2; S.U = Ub;
            S.kv = (l == 0); S.MEMN = (const char*)(ws + WS_MEMN); S.WKV = (const char*)(ws + WS_WKV); S.KV = (char*)(ws + WS_KV);
            pg8::EpiStore E;
            pg8::gemm_phase<false>(lds, D * 2, D * 2, D * 2, S, E, wave);
            SchedPlain S8; S8.T.init(M / 256, NF8 / 256); S8.G = G; S8.c = bx; S8.A = (const char*)(ws + WS_XF8); S8.B = (const char*)(ws + WS_WING8) + (size_t)l * NF8 * D; S8.C = Ub + UC_F8 * 2;
            S8.lda = 512; S8.ldb = 512; S8.ldc = NU;
            pg8::EpiStoreS E8; E8.s = F8_INV1; E8.gate_b = INP(I_GATEB) + (size_t)l * 3072; E8.gate_c0 = UC_GATE - UC_F8;
            pg8::gemm_phase<true>(lds, D, D, D, S8, E8, wave);
        }
        SEAM(pb + 0);
        _Pragma("unroll 1") for (int rep_ = 0; rep_ < NREP(1); ++rep_) if (((PHMASK>>1)&1) && IN(pb + 1)) { PHASE_TID
            const float* mu = INP(I_RWMU) + (size_t)l * 1792 + 1536;
            char* LIN = (char*)(ws + WS_R2 + R2_LORA_IN);
            for (int it = bx * NTHR + tid; it < M * 32; it += G * NTHR) {
                const int row = it >> 5, c = (it & 31) * 8;
                const u32x4 cw = *(const u32x4*)(Ub + ((size_t)row * NU + UC_RW + 1536 + c) * 2);
                u32x4 pw = (u32x4){0u, 0u, 0u, 0u};
                if ((row & (SEQ - 1)) != 0) pw = *(const u32x4*)(Ub + ((size_t)(row - 1) * NU + UC_RW + 1536 + c) * 2);
                const f32x4 m0 = *(const f32x4*)(mu + c), m1 = *(const f32x4*)(mu + c + 4);
                float x[8] = {bflo(cw.x), bfhi(cw.x), bflo(cw.y), bfhi(cw.y), bflo(cw.z), bfhi(cw.z), bflo(cw.w), bfhi(cw.w)};
                const float p[8] = {bflo(pw.x), bfhi(pw.x), bflo(pw.y), bfhi(pw.y), bflo(pw.z), bfhi(pw.z), bflo(pw.w), bfhi(pw.w)};
                const float mm[8] = {m0.x, m0.y, m0.z, m0.w, m1.x, m1.y, m1.z, m1.w};
#pragma unroll
                for (int i = 0; i < 8; ++i) { float xs = x[i] + (p[i] - x[i]) * mm[i];
                    if (c < 64) xs = 1.f - 2.f * __builtin_amdgcn_rcpf(1.f + __builtin_amdgcn_exp2f(2.8853900817779268f * xs));
                    else if (c >= 128) xs = sigmoidf_(xs);
                    x[i] = xs; }
                u32x4 o; o.x = pk2(x[0], x[1]); o.y = pk2(x[2], x[3]); o.z = pk2(x[4], x[5]); o.w = pk2(x[6], x[7]);
                *(u32x4*)(LIN + ((size_t)row * 256 + c) * 2) = o;
            }
        }
        SEAM(pb + 1);
        _Pragma("unroll 1") for (int rep_ = 0; rep_ < NREP(2); ++rep_) if (((PHMASK>>2)&1) && IN(pb + 2)) {
            SchedPlain S; S.T.init(M / 256, 6); S.G = G; S.c = bx; S.A = (const char*)(ws + WS_R2 + R2_LORA_IN); S.B = (const char*)(ws + WS_WLORA) + (size_t)l * 1536 * 256 * 2; S.C = (char*)(ws + WS_R2 + R2_LORA_OUT);
            S.lda = 256; S.ldb = 256; S.ldc = 1536;
            pg8::EpiStore E;
            pg8::gemm_phase<false>(lds, 512, 512, 512, S, E, wave);
        }
        SEAM(pb + 2);
        _Pragma("unroll 1") for (int rep_ = 0; rep_ < NREP(3); ++rep_) if (((PHMASK>>3)&1) && IN(pb + 3)) { PHASE_TID
            const char* LO = (const char*)(ws + WS_R2 + R2_LORA_OUT);
            char* HC = (char*)(ws + WS_R2 + R2_HCAT);
            const int tid_ph = tid;
#define SUB_TID unsigned zs_ = 0u; asm volatile("" : "+v"(zs_)); int tid = wave * 64 + (int)__builtin_amdgcn_mbcnt_hi(~0u, __builtin_amdgcn_mbcnt_lo(~0u, zs_)); const int lane = tid & 63; (void)lane;
#pragma unroll 1
            for (int job = bx; job < 256; job += G) {
                if (job < 128) { _Pragma("unroll 1") for (int sr_ = 0; sr_ < NSUB(0); ++sr_) if ((SUBMASK>>0)&1) {
                    SUB_TID
                    const int b = job >> 3, h = job & 7;
                    constexpr int TC = 32, PT = 144, P16 = 48, IMG = 25856;
                    LAS float* OPS = (LAS float*)lds;
                    LAS float* OUTB = OPS + TC * 384;
                    LAS float* BON = OUTB + TC * 64;
                    LAS unsigned char* IM0 = lds + 57600;
                    LAS float* VEP = (LAS float*)(lds + 109312);
                    LAS unsigned char* GKB = (LAS unsigned char*)(VEP + 2 * TC * 64);
                    LAS float* PARF = (LAS float*)(lds + 142080);
                    const int pt = tid >> 4, cs = tid & 15, pc = cs * 4, hc = h * 64 + pc;
                    const int p1t = (tid >> 3) & 31, c8 = (tid & 7) * 8, hc8 = h * 64 + c8;
                    const int r31 = lane & 31, h2 = lane >> 5;
                    f32x16 Sreg[2];
#pragma unroll
                    for (int i = 0; i < 16; ++i) { Sreg[0][i] = 0.f; Sreg[1][i] = 0.f; }
#pragma unroll 1
                    for (int a = wave; a < 10; a += 8) {
                        const int ii = (a < 3) ? I_RWMU : (a == 3) ? I_RWW0 : (a == 4) ? I_RWA0 : (a == 5) ? I_RWKK : (a == 6) ? I_RWKA : (a == 7) ? I_RWRK : (a == 8) ? I_RWLNG : I_RWLNB;
                        const size_t po = (a < 3) ? ((size_t)l * 1792 + a * 512) : (size_t)l * 512;
                        PARF[a * 64 + lane] = (INP(ii) + po)[h * 64 + lane];
                    }
#define SETPU(j, q_) do { const u32x4 q__ = (q_); Sreg[(j) >> 2][((j) & 3) * 4] = u2f_(q__.x); Sreg[(j) >> 2][((j) & 3) * 4 + 1] = u2f_(q__.y); \
                          Sreg[(j) >> 2][((j) & 3) * 4 + 2] = u2f_(q__.z); Sreg[(j) >> 2][((j) & 3) * 4 + 3] = u2f_(q__.w); } while (0)
#define PUW(j, c) f2u_(Pc[(j) >> 2][((j) & 3) * 4 + (c)])
#define PUWS(j, c) f2u_(Sreg[(j) >> 2][((j) & 3) * 4 + (c)])
#define UNPJ(j, hh) ((f32x4){bflo(PUW(j, 2 * (hh))), bfhi(PUW(j, 2 * (hh))), bflo(PUW(j, 2 * (hh) + 1)), bfhi(PUW(j, 2 * (hh) + 1))})
#define UNPH(q_, hh) ((hh) ? (f32x4){bflo((q_).z), bfhi((q_).z), bflo((q_).w), bfhi((q_).w)} : (f32x4){bflo((q_).x), bfhi((q_).x), bflo((q_).y), bfhi((q_).y)})
                    auto LOADC = [&](int t0) {
                        const int t = t0 + p1t; const size_t row = (size_t)b * SEQ + t; const char* up = Ub + (row * NU + UC_RW + hc8) * 2;
                        SETPU(0, *(const u32x4*)up); SETPU(1, *(const u32x4*)(up + 1024)); SETPU(2, *(const u32x4*)(up + 2048));
                        if (t > 0) { const char* pp = up - (size_t)NU * 2; SETPU(3, *(const u32x4*)pp); SETPU(4, *(const u32x4*)(pp + 1024)); SETPU(5, *(const u32x4*)(pp + 2048)); }
                        else { const u32x4 z4 = (u32x4){0u, 0u, 0u, 0u}; SETPU(3, z4); SETPU(4, z4); SETPU(5, z4); }
                        const char* lp = LO + (row * 1536 + hc8) * 2; SETPU(6, *(const u32x4*)lp); SETPU(7, *(const u32x4*)(lp + 1024));
                    };
                    const int gq = tid - 128, gt = (gq >> 2) & 31, gp = (gq & 3) * 16;
                    auto LOADG = [&](int t0) {
                        const char* gp_ = LO + (((size_t)b * SEQ + t0 + gt) * 1536 + 1024 + h * 64 + gp) * 2;
                        SETPU(0, *(const u32x4*)gp_); SETPU(1, *(const u32x4*)(gp_ + 16));
                    };
                    auto PASS1 = [&](int t1, int par1, bool more) {
                        int hcv = hc8; asm volatile("" : "+v"(hcv));
                        const f32x16 Pc[2] = {Sreg[0], Sreg[1]};
                        if (more) LOADC(t1 + TC);
                        const LAS float* MU = PARF + c8;
                        const LAS float* W0 = PARF + 192 + c8; const LAS float* A0 = PARF + 256 + c8; const LAS float* KKW = PARF + 320 + c8;
                        const LAS float* KAW = PARF + 384 + c8; const LAS float* RKW = PARF + 448 + c8;
                        f32x4 dec[2], av[2], kkv[2], kp[2], xr[2], xv[2]; float ss = 0.f, bsum = 0.f;
#pragma unroll
                        for (int hh = 0; hh < 2; ++hh) {
                            const f32x4 mu_r = *(const LAS f32x4*)(MU + 4 * hh), mu_k = *(const LAS f32x4*)(MU + 64 + 4 * hh), mu_v = *(const LAS f32x4*)(MU + 128 + 4 * hh);
                            const f32x4 w0 = *(const LAS f32x4*)(W0 + 4 * hh), a0 = *(const LAS f32x4*)(A0 + 4 * hh), kkw = *(const LAS f32x4*)(KKW + 4 * hh), kaw = *(const LAS f32x4*)(KAW + 4 * hh), rkw = *(const LAS f32x4*)(RKW + 4 * hh);
                            const f32x4 ur = UNPJ(0, hh), uk = UNPJ(1, hh), uv = UNPJ(2, hh), urp = UNPJ(3, hh), ukp = UNPJ(4, hh), uvp = UNPJ(5, hh), lw = UNPJ(6, hh), la = UNPJ(7, hh);
                            xr[hh] = ur + (urp - ur) * mu_r; const f32x4 xk = uk + (ukp - uk) * mu_k; xv[hh] = uv + (uvp - uv) * mu_v;
#pragma unroll
                            for (int i = 0; i < 4; ++i) {
                                const float y = -(w0[i] + lw[i]);
                                const float sp = fmaxf(y, 0.f) + __logf(1.f + __expf(-fabsf(y)));
                                dec[hh][i] = __expf(-__expf(-sp - 0.5f));
                                av[hh][i] = sigmoidf_(a0[i] + la[i]);
                                kkv[hh][i] = xk[i] * kkw[i]; ss += kkv[hh][i] * kkv[hh][i];
                                kp[hh][i] = xk[i] * (1.f + (av[hh][i] - 1.f) * kaw[i]);
                                bsum += xr[hh][i] * kp[hh][i] * rkw[i];
                            }
                            __builtin_amdgcn_sched_barrier(0);
                        }
                        ss = red8(ss); bsum = red8(bsum);
                        const float inv = __builtin_amdgcn_rsqf(fmaxf(ss, 1e-24f));
#pragma unroll
                        for (int hh = 0; hh < 2; ++hh) {
                            const f32x4 kk = kkv[hh] * inv, kka = kk * av[hh];
                            LAS float* o = OPS + p1t * 384 + c8 + 4 * hh;
                            *(LAS f32x4*)(o) = dec[hh]; *(LAS f32x4*)(o + 64) = kk; *(LAS f32x4*)(o + 128) = kka; *(LAS f32x4*)(o + 192) = kp[hh]; *(LAS f32x4*)(o + 256) = xr[hh]; *(LAS f32x4*)(o + 320) = xv[hh];
                            *(LAS f32x4*)(VEP + par1 * 2048 + p1t * 64 + c8 + 4 * hh) = xv[hh];
                        }
                        if ((tid & 7) == 0) BON[par1 * 32 + p1t] = bsum;
                    };
#define UNP4(w) ((f32x4){bflo((w).x), bfhi((w).x), bflo((w).y), bfhi((w).y)})
#define DOT4(a, b) (((a).x * (b).x + (a).y * (b).y) + ((a).z * (b).z + (a).w * (b).w))
#define PACK8(x, s) __builtin_bit_cast(bf16x8, (u32x4){pk2((x)[8 * (s)], (x)[8 * (s) + 1]), pk2((x)[8 * (s) + 2], (x)[8 * (s) + 3]), pk2((x)[8 * (s) + 4], (x)[8 * (s) + 5]), pk2((x)[8 * (s) + 6], (x)[8 * (s) + 7])})
#define LD2x64(p) __builtin_bit_cast(bf16x8, (u32x4){(*(const LAS u32x2*)(p)).x, (*(const LAS u32x2*)(p)).y, (*(const LAS u32x2*)((p) + 16)).x, (*(const LAS u32x2*)((p) + 16)).y})
                    auto EPI = [&](int te, int pe) {
                        const int et = ((wave >> 2) * 2 + (wave & 1)) * 64 + lane, pce = (et & 15) * 4;
                        const f32x4 lng = *(const LAS f32x4*)(PARF + 512 + pce), lnb = *(const LAS f32x4*)(PARF + 576 + pce);
#pragma unroll
                        for (int it = 0; it < 2; ++it) {
                            const int pte = (et >> 4) + 16 * it;
                            const u32x2 gkw = *(const LAS u32x2*)(GKB + pe * 4096 + pte * 128 + pce * 2);
                            const f32x4 o4 = *(const LAS f32x4*)(OUTB + pte * 64 + pce), v4 = *(const LAS f32x4*)(VEP + pe * 2048 + pte * 64 + pce), gk = UNP4(gkw);
                            const float mean = red16((o4.x + o4.y) + (o4.z + o4.w)) * (1.f / 64.f);
                            const f32x4 dv = o4 - mean;
                            const float var = red16(DOT4(dv, dv)) * (1.f / 64.f);
                            const float rstd = __builtin_amdgcn_rsqf(var + RW_GN_EPS), bo = BON[pe * 32 + pte];
                            const f32x4 y = (dv * rstd * lng + lnb + v4 * bo) * gk;
                            st4bf(HC + (((size_t)b * SEQ + te + pte) * 1536 + 512 + h * 64 + pce) * 2, y);
                        }
                    };
                    if (wave >= 4) LOADC(0); else if (wave >= 2) LOADG(0);
#pragma unroll 1
                    for (int t0 = -TC; t0 < SEQ; t0 += TC) {
                        const int par = (t0 >> 5) & 1;
                        __syncthreads();
                        if (t0 >= 0)
                        {
                            const int sc = wave >> 2, wq = wave & 3;
                            LAS unsigned char* im = IM0 + sc * IMG;
                            LAS unsigned char* KR = im; LAS unsigned char* BGr = im + 4608; LAS unsigned char* VT = im + 15360;
                            LAS unsigned char* TT = im + 18432; LAS unsigned char* BB = im + 19968; LAS float* ZF = (LAS float*)(im + 21504); LAS float* PL = (LAS float*)(im + 25600);
                            {
                                float P = 1.f;
#pragma unroll
                                for (int t = 0; t < 12; ++t) { const float wv = OPS[(16 * sc + t) * 384 + lane]; P *= (t < 4 * wq) ? wv : 1.f; }
#pragma unroll
                                for (int q = 0; q < 4; ++q) { const int t = 4 * wq + q; const LAS float* o = OPS + (16 * sc + t) * 384 + lane;
                                    const float w = o[0], z = o[64], bb = o[128], kp = o[192], rr = o[256], vv = o[320];
                                    const float kap = z * P; P *= w; const float rho = rr * P, ip = __builtin_amdgcn_rcpf(P), bet = bb * ip, gam = kp * ip;
                                    *(LAS bf16*)(KR + t * PT + lane * 2) = (bf16)f2bf(kap); *(LAS bf16*)(KR + (16 + t) * PT + lane * 2) = (bf16)f2bf(rho);
                                    *(LAS bf16*)(BGr + t * PT + lane * 2) = (bf16)f2bf(bet); *(LAS bf16*)(BGr + (16 + t) * PT + lane * 2) = (bf16)f2bf(gam);
                                    *(LAS bf16*)(VT + t * PT + lane * 2) = (bf16)f2bf(vv); }
                                if (wq == 3) PL[lane] = P;
                            }
                            __syncthreads();
                            if (wq <= 1) {
                                f32x16 Z;
#pragma unroll
                                for (int i = 0; i < 16; ++i) Z[i] = 0.f;
#pragma unroll
                                for (int ks = 0; ks < 4; ++ks) Z = __builtin_amdgcn_mfma_f32_32x32x16_bf16(*(const LAS bf16x8*)(KR + r31 * PT + (16 * ks + 8 * h2) * 2), *(const LAS bf16x8*)(BGr + r31 * PT + (16 * ks + 8 * h2) * 2), Z, 0, 0, 0);
                                const int jj = (r31 & 15) - 4 * h2;
#pragma unroll
                                for (int i = 0; i < 16; ++i) { const int tb = (i & 3) + 8 * ((i >> 2) & 1); const bool keep = (i >= 8) ? (jj <= tb) : (jj < tb); Z[i] = keep ? Z[i] : 0.f; }
                              if (wq == 1) {
                                if (r31 >= 16) {
#pragma unroll
                                    for (int i = 0; i < 16; ++i) *(LAS bf16*)(BB + ((i & 3) + 8 * (i >> 2) + 4 * h2) * P16 + (r31 - 16) * 2) = (bf16)f2bf(Z[i]);
                                }
                              } else {
                                if (r31 < 16) {
#pragma unroll
                                    for (int i = 0; i < 16; ++i) ZF[((i & 3) + 8 * (i >> 2) + 4 * h2) * 32 + r31] = Z[i];
                                }
                                LDS_WAIT(); asm volatile("" ::: "memory");
                                const int c = lane & 15, g = lane >> 4; float x[16];
                                f32x4 R[16][4];
                                constexpr int TW = 5;
#pragma unroll
                                for (int t = 1; t <= TW; ++t)
#pragma unroll
                                    for (int k = 0; k < 4; ++k) if (4 * k < t) R[t][k] = *(const LAS f32x4*)(ZF + t * 32 + 4 * k);
                                __builtin_amdgcn_sched_barrier(0);
#pragma unroll
                                for (int t = 0; t < 16; ++t) {
                                    if (t >= 1 && t + TW < 16) {
#pragma unroll
                                        for (int k = 0; k < 4; ++k) if (4 * k < t + TW) R[t + TW][k] = *(const LAS f32x4*)(ZF + (t + TW) * 32 + 4 * k);
                                    }
                                    __builtin_amdgcn_sched_barrier(0);
                                    float s0 = 0.f, s1 = 0.f;
#pragma unroll
                                    for (int j = 0; j < t; ++j) { const float a = R[t][j >> 2][j & 3]; if (j & 1) s1 += a * x[j]; else s0 += a * x[j]; }
                                    x[t] = ((t == c) ? 1.f : 0.f) - (s0 + s1);
                                }
#pragma unroll
                                for (int j = 0; j < 16; ++j) *(LAS bf16*)(TT + j * P16 + c * 2) = (bf16)f2bf(-x[j]);
#pragma unroll
                                for (int qq = 0; qq < 4; qq += 2) {
                                    f32x4 a4[2][4];
#pragma unroll
                                    for (int q = 0; q < 2; ++q)
#pragma unroll
                                        for (int k = 0; k < 4; ++k) a4[q][k] = *(const LAS f32x4*)(ZF + (16 + 4 * g + qq + q) * 32 + 4 * k);
#pragma unroll
                                    for (int q = 0; q < 2; ++q) {
                                        const int tr = 4 * g + qq + q;
                                        float s0 = 0.f, s1 = 0.f;
#pragma unroll
                                        for (int j = 0; j < 16; ++j) { const float a = a4[q][j >> 2][j & 3]; if (j & 1) s1 += a * x[j]; else s0 += a * x[j]; }
                                        *(LAS bf16*)(TT + (16 + tr) * P16 + c * 2) = (bf16)f2bf(-(s0 + s1));
                                    }
                                }
                              }
                            } else if (t0 >= TC) EPI(t0 - TC, par ^ 1);
                        }
                        __syncthreads();
                        if (wave >= 4) { if (t0 + TC < SEQ) PASS1(t0 + TC, par ^ 1, t0 + 2 * TC < SEQ); }
                        else if (wave >= 2) { if (t0 + TC < SEQ) {
                            LAS unsigned char* gd = GKB + (par ^ 1) * 4096 + gt * 128 + gp * 2;
                            *(LAS u32x4*)gd = (u32x4){PUWS(0, 0), PUWS(0, 1), PUWS(0, 2), PUWS(0, 3)}; *(LAS u32x4*)(gd + 16) = (u32x4){PUWS(1, 0), PUWS(1, 1), PUWS(1, 2), PUWS(1, 3)};
                            if (t0 + 2 * TC < SEQ) LOADG(t0 + 2 * TC); } }
                        else if (wave < 2 && t0 >= 0) {
#pragma unroll 1
                            for (int sc = 0; sc < 2; ++sc) {
                                const LAS unsigned char* im = IM0 + sc * IMG;
                                const LAS unsigned char* KR = im; const LAS unsigned char* BT = im + 9216; const LAS unsigned char* GT = im + 12288; const LAS unsigned char* VT = im + 15360;
                                const LAS unsigned char* TT = im + 18432; const LAS unsigned char* BB = im + 19968; const LAS float* PL = (const LAS float*)(im + 25600);
                                const LAS unsigned char* BGr = im + 4608;
                                const bf16x8 vfr = trd8(VT, PT, 8 * h2, 8 * h2 + 4, 32 * wave, lane);
                                f32x16 t1;
#pragma unroll
                                for (int i = 0; i < 16; ++i) t1[i] = 0.f;
                                t1 = __builtin_amdgcn_mfma_f32_32x32x16_bf16(*(const LAS bf16x8*)(BB + r31 * P16 + 8 * h2 * 2), vfr, t1, 0, 0, 0);
#pragma unroll
                                for (int kb = 0; kb < 2; ++kb)
#pragma unroll
                                    for (int s = 0; s < 2; ++s) t1 = __builtin_amdgcn_mfma_f32_32x32x16_bf16(LD2x64(KR + r31 * PT + (32 * kb + 16 * s + 4 * h2) * 2), PACK8(Sreg[kb], s), t1, 0, 0, 0);
                                f32x16 t2;
#pragma unroll
                                for (int i = 0; i < 16; ++i) t2[i] = 0.f;
                                t2 = __builtin_amdgcn_mfma_f32_32x32x16_bf16(LD2x64(TT + r31 * P16 + (4 * h2) * 2), PACK8(t1, 0), t2, 0, 0, 0);
#pragma unroll
                                for (int i = 8; i < 16; ++i) OUTB[(16 * sc + (i & 3) + 8 * ((i >> 2) - 2) + 4 * h2) * 64 + 32 * wave + r31] = t2[i] + t1[i];
                                const bf16x8 uq = PACK8(t2, 0);
#pragma unroll
                                for (int kb = 0; kb < 2; ++kb) {
                                    f32x16 a = Sreg[kb];
                                    a = __builtin_amdgcn_mfma_f32_32x32x16_bf16(trd8(BGr, PT, 4 * h2, 8 + 4 * h2, 32 * kb, lane), uq, a, 0, 0, 0);
                                    a = __builtin_amdgcn_mfma_f32_32x32x16_bf16(trd8(BGr, PT, 16 + 8 * h2, 20 + 8 * h2, 32 * kb, lane), vfr, a, 0, 0, 0);
#pragma unroll
                                    for (int g4 = 0; g4 < 4; ++g4) { const f32x4 p4 = *(const LAS f32x4*)(PL + 32 * kb + 8 * g4 + 4 * h2);
                                        a[4 * g4] *= p4.x; a[4 * g4 + 1] *= p4.y; a[4 * g4 + 2] *= p4.z; a[4 * g4 + 3] *= p4.w; }
                                    Sreg[kb] = a;
                                }
                            }
                        }
                    }
                    __syncthreads();
                    if ((wave & 3) >= 2) EPI(SEQ - TC, ((SEQ - TC) >> 5) & 1);
                    __syncthreads();
#undef UNPH
#undef UNPJ
#undef PUW
#undef PUWS
#undef SETPU
#undef PACK8
#undef LD2x64
                } } else {
                    const int idx = job - 128, bh = idx >> 1, half = idx & 1, b = bh >> 2, h = bh & 3;
                    unsigned zl_ = 0u; asm volatile("" : "+v"(zl_)); const int lane_ml = (int)__builtin_amdgcn_mbcnt_hi(~0u, __builtin_amdgcn_mbcnt_lo(~0u, zl_));
                    _Pragma("unroll 1") for (int sr_ = 0; sr_ < NSUB(1); ++sr_) if (((SUBMASK>>1)&1) && idx < 64) {
                        SUB_TID
                        const int bm = idx >> 2, hm = idx & 3;
                        constexpr int PT = 144;
                        LAS unsigned char* QI = lds;
                        LAS unsigned char* KI = QI + 64 * PT;
                        constexpr int PV = 272;
                        LAS unsigned char* KW = KI + 64 * PT;
                        LAS unsigned char* VT = KW + 64 * PT;
                        LAS unsigned char* CI = VT + 64 * PV;
                        LAS float* AS = (LAS float*)(CI + 128 * PT);
                        LAS float* MX = AS + 64; LAS float* SI = AS + 128; LAS float* EM = AS + 192; LAS float* WG = AS + 256; LAS float* NN = AS + 320; LAS float* CR = AS + 384; LAS float* ST = AS + 448;
                        for (int i = tid; i < 128 * PT / 4; i += NTHR) ((LAS unsigned*)CI)[i] = 0u;
                        if (tid < 64) NN[tid] = 0.f;
                        LAS float* CWL = (LAS float*)(lds + 100352);
                        if (tid < 128) { const int colw = (tid < 64) ? (hm * 64 + tid) : (256 + hm * 64 + (tid - 64));
#pragma unroll
                            for (int j = 0; j < 4; ++j) CWL[j * 128 + tid] = INP(I_CONVW)[((size_t)l * 4 + j) * 512 + colw];
                            CWL[512 + tid] = INP(I_CONVB)[l * 512 + colw];
                            CWL[640 + tid] = INP(I_MLNORMG)[l * 512 + hm * 128 + tid]; }
                        const int pt = tid >> 4, cg = tid & 15;
                        const int ccol = (cg < 8) ? (hm * 64 + 8 * cg) : (256 + hm * 64 + 8 * (cg - 8));
                        const float qsc = (cg < 8) ? 0.125f : 1.f;
                        const float igb = INP(I_IGB)[l * 4 + hm], fgb = INP(I_FGB)[l * 4 + hm];
                        const int r31 = lane & 31, h2 = lane >> 5, vb = wave >> 1, tb = wave & 1;
                        f32x16 accC;
#pragma unroll
                        for (int i = 0; i < 16; ++i) accC[i] = 0.f;
                        float nreg = 0.f, mprev = 0.f;
                        u32x4 cu[2][4], vu[2]; float gi = 0.f, gf = 0.f;
                        auto LOADM = [&](int t0) {
#pragma unroll
                            for (int tt = 0; tt < 2; ++tt) { const int t = t0 + pt + 32 * tt; const size_t row = (size_t)bm * SEQ + t;
#pragma unroll
                                for (int j = 0; j < 4; ++j) { if (t - 3 + j >= 0) cu[tt][j] = *(const u32x4*)(Ub + ((row - 3 + j) * NU + UC_QK + ccol) * 2); else cu[tt][j] = (u32x4){0u, 0u, 0u, 0u}; }
                                const int p = tid + 512 * tt; vu[tt] = *(const u32x4*)(Ub + (((size_t)bm * SEQ + t0 + (p >> 4)) * NU + UC_V + hm * 128 + 8 * (p & 15)) * 2); }
                            if (wave == 0) { const size_t rg = (size_t)bm * SEQ + t0 + lane; gi = GIF[rg * 8 + hm]; gf = GIF[rg * 8 + 4 + hm]; }
                        };
                        LOADM(0);
                        __syncthreads();
#pragma unroll 1
                        for (int t0 = 0; t0 < SEQ; t0 += 64) {
                            int cgv = cg * 8; asm volatile("" : "+v"(cgv));
                            float cw[4][8], cb[8];
#pragma unroll
                        for (int j = 0; j < 4; ++j) { const f32x4 a = *(const LAS f32x4*)(CWL + j * 128 + cgv), c2 = *(const LAS f32x4*)(CWL + j * 128 + cgv + 4);
                            cw[j][0] = a.x; cw[j][1] = a.y; cw[j][2] = a.z; cw[j][3] = a.w; cw[j][4] = c2.x; cw[j][5] = c2.y; cw[j][6] = c2.z; cw[j][7] = c2.w; }
                        { const f32x4 a = *(const LAS f32x4*)(CWL + 512 + cgv), c2 = *(const LAS f32x4*)(CWL + 512 + cgv + 4);
                            cb[0] = a.x; cb[1] = a.y; cb[2] = a.z; cb[3] = a.w; cb[4] = c2.x; cb[5] = c2.y; cb[6] = c2.z; cb[7] = c2.w; }
                            float yq[2][8];
#pragma unroll
                            for (int tt = 0; tt < 2; ++tt) {
#pragma unroll
                                for (int i = 0; i < 8; ++i) yq[tt][i] = cb[i];
#pragma unroll
                                for (int j = 0; j < 4; ++j) { const u32x4 w = cu[tt][j]; const float x[8] = {bflo(w.x), bfhi(w.x), bflo(w.y), bfhi(w.y), bflo(w.z), bfhi(w.z), bflo(w.w), bfhi(w.w)};
#pragma unroll
                                    for (int i = 0; i < 8; ++i) yq[tt][i] += cw[j][i] * x[i]; }
#pragma unroll
                                for (int i = 0; i < 8; ++i) yq[tt][i] = yq[tt][i] * sigmoidf_(yq[tt][i]) * qsc;
                            }
                            const u32x4 vreg0 = vu[0], vreg1 = vu[1];
                            if (wave == 0) {
                                const float ig = gi + igb, fp = gf + fgb;
                                const float lf = -(fmaxf(-fp, 0.f) + __logf(1.f + __expf(-fabsf(fp))));
                                const float bc = scan_add64(lf);
                                const float as = ig - bc, pm = scan_max64(as);
                                const float mxv = fmaxf(mprev, pm), mx63 = __builtin_bit_cast(float, __builtin_amdgcn_readlane(__builtin_bit_cast(int, mxv), 63)), bl = __builtin_bit_cast(float, __builtin_amdgcn_readlane(__builtin_bit_cast(int, bc), 63));
                                AS[lane] = as; MX[lane] = mxv; SI[lane] = __expf(mprev - mxv); EM[lane] = __expf(-(bc + mxv)); WG[lane] = __expf(as - mx63);
                                if (lane == 0) CR[0] = __expf(mprev - mx63);
                                mprev = bl + mx63;
                            }
                            if (t0 + 64 < SEQ) LOADM(t0 + 64);
                            __syncthreads();
#pragma unroll
                            for (int tt = 0; tt < 2; ++tt) { const int tok = pt + 32 * tt;
                                u32x4 pw; pw.x = pk2(yq[tt][0], yq[tt][1]); pw.y = pk2(yq[tt][2], yq[tt][3]); pw.z = pk2(yq[tt][4], yq[tt][5]); pw.w = pk2(yq[tt][6], yq[tt][7]);
                                if (cg < 8) *(LAS u32x4*)(QI + tok * PT + cg * 16) = pw;
                                else { *(LAS u32x4*)(KI + tok * PT + (cg - 8) * 16) = pw; const float wgs = WG[tok];
                                    u32x4 kw; kw.x = pk2(yq[tt][0] * wgs, yq[tt][1] * wgs); kw.y = pk2(yq[tt][2] * wgs, yq[tt][3] * wgs); kw.z = pk2(yq[tt][4] * wgs, yq[tt][5] * wgs); kw.w = pk2(yq[tt][6] * wgs, yq[tt][7] * wgs);
                                    *(LAS u32x4*)(KW + tok * PT + (cg - 8) * 16) = kw; }
                                const u32x4 vw = tt ? vreg1 : vreg0; const int p = tid + 512 * tt, vtok = p >> 4, v8 = p & 15;
                                *(LAS u32x4*)(VT + vtok * PV + v8 * 16) = vw;
                            }
                            __syncthreads();
                            float hv[16];
                            u32x2 ogw[4];
                            { const size_t rowg = (size_t)bm * SEQ + t0 + 32 * tb + r31; const char* ogp = Ub + (rowg * NU + UC_OG + hm * 128 + 32 * vb) * 2;
#pragma unroll
                                for (int g4 = 0; g4 < 4; ++g4) ogw[g4] = *(const u32x2*)(ogp + (8 * g4 + 4 * h2) * 2); }
                            {
                                constexpr float L2E = 1.4426950408889634f;
                                const int t = 32 * tb + r31;
                                bf16x8 qf[4];
#pragma unroll
                                for (int ks = 0; ks < 4; ++ks) qf[ks] = *(const LAS bf16x8*)(QI + t * PT + (16 * ks + 8 * h2) * 2);
                                const float mx = MX[t], si = SI[t], em = EM[t];
                                f32x16 O, I; float denI = 0.f;
#pragma unroll
                                for (int i = 0; i < 16; ++i) { O[i] = 0.f; I[i] = 0.f; }
#pragma unroll
                                for (int sb = 0; sb < 2; ++sb) if (sb <= tb) {
                                    f32x16 X;
#pragma unroll
                                    for (int i = 0; i < 16; ++i) X[i] = 0.f;
#pragma unroll
                                    for (int ks = 0; ks < 4; ++ks) { const bf16x8 kf = *(const LAS bf16x8*)(KI + (32 * sb + r31) * PT + (16 * ks + 8 * h2) * 2); X = __builtin_amdgcn_mfma_f32_32x32x16_bf16(kf, qf[ks], X, 0, 0, 0); }
#pragma unroll
                                    for (int g4 = 0; g4 < 4; ++g4) { const f32x4 a4 = *(const LAS f32x4*)(AS + 32 * sb + 8 * g4 + 4 * h2);
#pragma unroll
                                        for (int j = 0; j < 4; ++j) { const int s = 32 * sb + 8 * g4 + 4 * h2 + j; const float w = (s <= t) ? __builtin_amdgcn_exp2f((a4[j] - mx) * L2E) * X[4 * g4 + j] : 0.f; X[4 * g4 + j] = w; denI += w; } }
#pragma unroll
                                    for (int st = 0; st < 2; ++st) {
                                        u32x4 pw; pw.x = pk2(X[8 * st], X[8 * st + 1]); pw.y = pk2(X[8 * st + 2], X[8 * st + 3]); pw.z = pk2(X[8 * st + 4], X[8 * st + 5]); pw.w = pk2(X[8 * st + 6], X[8 * st + 7]);
                                        O = __builtin_amdgcn_mfma_f32_32x32x16_bf16(trd8(VT, PV, 32 * sb + 16 * st + 4 * h2, 32 * sb + 16 * st + 8 + 4 * h2, 32 * vb, lane), __builtin_bit_cast(bf16x8, pw), O, 0, 0, 0);
                                    }
                                }
                                float nq = 0.f;
#pragma unroll
                                for (int ks = 0; ks < 4; ++ks) { const bf16x8 cf = *(const LAS bf16x8*)(CI + (32 * vb + r31) * PT + (16 * ks + 8 * h2) * 2); I = __builtin_amdgcn_mfma_f32_32x32x16_bf16(cf, qf[ks], I, 0, 0, 0);
                                    const f32x4 n0 = *(const LAS f32x4*)(NN + 16 * ks + 8 * h2), n1 = *(const LAS f32x4*)(NN + 16 * ks + 8 * h2 + 4); const u32x4 qw = __builtin_bit_cast(u32x4, qf[ks]);
                                    nq += (bflo(qw.x) * n0.x + bfhi(qw.x) * n0.y) + (bflo(qw.y) * n0.z + bfhi(qw.y) * n0.w) + (bflo(qw.z) * n1.x + bfhi(qw.z) * n1.y) + (bflo(qw.w) * n1.z + bfhi(qw.w) * n1.w); }
                                nq += __shfl_xor(nq, 32); denI += __shfl_xor(denI, 32);
                                const float den = si * nq + denI, rdn = 1.f / fmaxf(fabsf(den), em);
                                float hsum = 0.f;
#pragma unroll
                                for (int i = 0; i < 16; ++i) { hv[i] = (O[i] + si * I[i]) * rdn; hsum += hv[i]; }
                                hsum += __shfl_xor(hsum, 32);
                                const float hmean = hsum * (1.f / 32.f); float hm2 = 0.f;
#pragma unroll
                                for (int i = 0; i < 16; ++i) { const float dlt = hv[i] - hmean; hm2 += dlt * dlt; }
                                hm2 += __shfl_xor(hm2, 32);
                                if (h2 == 0) *(LAS f32x2*)(ST + ((tb * 4 + vb) * 32 + r31) * 2) = (f32x2){hmean, hm2};
                                const float carry = CR[0];
#pragma unroll
                                for (int i = 0; i < 16; ++i) accC[i] *= carry;
#pragma unroll
                                for (int st = 0; st < 4; ++st) { const bf16x8 va = trd8(VT, PV, 16 * st + 8 * h2, 16 * st + 8 * h2 + 4, 32 * vb, lane), kw = trd8(KW, PT, 16 * st + 8 * h2, 16 * st + 8 * h2 + 4, 32 * tb, lane);
                                    accC = __builtin_amdgcn_mfma_f32_32x32x16_bf16(va, kw, accC, 0, 0, 0); }
                            }
                            __syncthreads();
                            {
                                const int t = 32 * tb + r31;
                                f32x2 s4[4];
#pragma unroll
                                for (int q = 0; q < 4; ++q) s4[q] = *(const LAS f32x2*)(ST + ((tb * 4 + q) * 32 + r31) * 2);
                                const float mt = (s4[0].x + s4[1].x + s4[2].x + s4[3].x) * 0.25f;
                                float m2 = 0.f;
#pragma unroll
                                for (int q = 0; q < 4; ++q) { const float dm = s4[q].x - mt; m2 += s4[q].y + 32.f * dm * dm; }
                                const float rstd = __builtin_amdgcn_rsqf(m2 * (1.f / 128.f) + LN_EPS);
                                const size_t row = (size_t)bm * SEQ + t0 + t;
                                char* op = HC + (row * 1536 + hm * 128 + 32 * vb) * 2;
                                const LAS float* ngp = CWL + 640 + 32 * vb;
#pragma unroll
                                for (int g4 = 0; g4 < 4; ++g4) { const int vo = 8 * g4 + 4 * h2; const f32x4 og = UNP4(ogw[g4]), ng = *(const LAS f32x4*)(ngp + vo);
                                    f32x4 y; y.x = sigmoidf_(og.x) * ((hv[4 * g4] - mt) * rstd * ng.x); y.y = sigmoidf_(og.y) * ((hv[4 * g4 + 1] - mt) * rstd * ng.y); y.z = sigmoidf_(og.z) * ((hv[4 * g4 + 2] - mt) * rstd * ng.z); y.w = sigmoidf_(og.w) * ((hv[4 * g4 + 3] - mt) * rstd * ng.w);
                                    st4bf(op + vo * 2, y); }
                            }
#pragma unroll
                            for (int i = 0; i < 16; ++i) { const int v = 32 * vb + (i & 3) + 8 * (i >> 2) + 4 * h2; *(LAS bf16*)(CI + v * PT + (32 * tb + r31) * 2) = (bf16)f2bf(accC[i]); }
                            if (wave < 2) { float s = 0.f;
#pragma unroll
                                for (int q8 = 0; q8 < 8; ++q8) { const u32x2 w = trd4(KW, PT, 32 * h2 + 4 * q8, 32 * wave, lane); s += (bflo(w.x) + bfhi(w.x)) + (bflo(w.y) + bfhi(w.y)); }
                                s += __shfl_xor(s, 32);
                                nreg = CR[0] * nreg + s; if (h2 == 0) NN[32 * wave + r31] = nreg; }
                            __syncthreads();
                        }
                    }
                }
            }
            if (rep_ == 0) {
                LAS unsigned* XB = (LAS unsigned*)(lds + 153088);
                unsigned* xc = (unsigned*)ctl + CW_FILL + 32 + l * 64;
                __syncthreads();
                if (tid_ph == 0) XB[0] = __hip_atomic_fetch_add(xc, 1u, RLX_AGENT);
                __syncthreads();
                int xi = __builtin_amdgcn_readfirstlane((int)XB[0]);
#pragma unroll 1
                while (xi < 128) {
                    const int idx = xi, bh = idx >> 1, half = idx & 1, b = bh >> 2, h = bh & 3;
                    _Pragma("unroll 1") for (int sr_ = 0; sr_ < NSUB(2); ++sr_) if ((SUBMASK>>2)&1) {
                        SUB_TID
                        constexpr int KST = 272, VST = 520;
                        LAS unsigned char* KI = lds; LAS unsigned char* VI = lds + 256 * KST;
                        const char* kvb = (const char*)(ws + WS_KV) + (((size_t)l * MROWS + (size_t)b * MEML) * D) * 2;
                        for (int p = tid; p < 4096; p += NTHR) { const int key = p >> 4, c16 = p & 15;
                            *(LAS u32x4*)(KI + key * KST + c16 * 16) = *(const u32x4*)(kvb + ((size_t)key * D + h * 128 + c16 * 8) * 2); }
                        for (int p = tid; p < 4096; p += NTHR) { const int key = p & 255, d8 = p >> 8;
                            const u32x4 w = *(const u32x4*)(kvb + ((size_t)key * D + 512 + h * 128 + d8 * 8) * 2);
                            LAS unsigned char* o = VI + (d8 * 8) * VST + key * 2;
                            *(LAS bf16*)(o) = (bf16)(w.x & 0xffff); *(LAS bf16*)(o + VST) = (bf16)(w.x >> 16); *(LAS bf16*)(o + 2 * VST) = (bf16)(w.y & 0xffff); *(LAS bf16*)(o + 3 * VST) = (bf16)(w.y >> 16);
                            *(LAS bf16*)(o + 4 * VST) = (bf16)(w.z & 0xffff); *(LAS bf16*)(o + 5 * VST) = (bf16)(w.z >> 16); *(LAS bf16*)(o + 6 * VST) = (bf16)(w.w & 0xffff); *(LAS bf16*)(o + 7 * VST) = (bf16)(w.w >> 16); }
                        __syncthreads();
                        const int r31 = lane & 31, h2 = lane >> 5;
                        constexpr float SC = 0.08838834764831845f * 1.4426950408889634f;
#pragma unroll 1
                        for (int rd = 0; rd < 8; ++rd) {
                            const size_t qrow = (size_t)b * SEQ + half * 2048 + rd * 256 + wave * 32 + r31;
                            bf16x8 qf[8];
#pragma unroll
                            for (int ks = 0; ks < 8; ++ks) qf[ks] = *(const bf16x8*)(Ub + (qrow * NU + UC_CAQ + h * 128 + 16 * ks + 8 * h2) * 2);
                            f32x16 O[4];
#pragma unroll
                            for (int db = 0; db < 4; ++db)
#pragma unroll
                                for (int i = 0; i < 16; ++i) O[db][i] = 0.f;
                            float mrun = -1e30f, lrun = 0.f;
#pragma unroll 1
                            for (int hf = 0; hf < 2; ++hf) {
                                f32x16 X[4];
#pragma unroll
                                for (int kb = 0; kb < 4; ++kb) {
                                    bf16x8 kf[8];
#pragma unroll
                                    for (int ks = 0; ks < 8; ++ks) kf[ks] = *(const LAS bf16x8*)(KI + (hf * 128 + kb * 32 + r31) * KST + (16 * ks + 8 * h2) * 2);
                                    __builtin_amdgcn_sched_barrier(0);
#pragma unroll
                                    for (int i = 0; i < 16; ++i) X[kb][i] = 0.f;
#pragma unroll
                                    for (int ks = 0; ks < 8; ++ks) X[kb] = __builtin_amdgcn_mfma_f32_32x32x16_bf16(kf[ks], qf[ks], X[kb], 0, 0, 0);
                                    __builtin_amdgcn_sched_barrier(0);
                                }
                                float mx = -1e30f;
#pragma unroll
                                for (int kb = 0; kb < 4; ++kb)
#pragma unroll
                                    for (int i = 0; i < 16; ++i) mx = fmaxf(mx, X[kb][i]);
                                mx = fmaxf(mx, __shfl_xor(mx, 32));
                                const float mnew = fmaxf(mrun, mx), alpha = __builtin_amdgcn_exp2f((mrun - mnew) * SC);
                                float ls = 0.f;
#pragma unroll
                                for (int kb = 0; kb < 4; ++kb)
#pragma unroll
                                    for (int i = 0; i < 16; ++i) { const float p = __builtin_amdgcn_exp2f((X[kb][i] - mnew) * SC); X[kb][i] = p; ls += p; }
                                ls += __shfl_xor(ls, 32);
                                lrun = lrun * alpha + ls; mrun = mnew;
#pragma unroll
                                for (int db = 0; db < 4; ++db)
#pragma unroll
                                    for (int i = 0; i < 16; ++i) O[db][i] *= alpha;
#pragma unroll
                                for (int kb = 0; kb < 4; ++kb) {
                                    bf16x8 vf[2][4], pf[2];
#pragma unroll
                                    for (int s = 0; s < 2; ++s) {
                                        u32x4 pw; pw.x = pk2(X[kb][8 * s], X[kb][8 * s + 1]); pw.y = pk2(X[kb][8 * s + 2], X[kb][8 * s + 3]); pw.z = pk2(X[kb][8 * s + 4], X[kb][8 * s + 5]); pw.w = pk2(X[kb][8 * s + 6], X[kb][8 * s + 7]);
                                        pf[s] = __builtin_bit_cast(bf16x8, pw);
#pragma unroll
                                        for (int db = 0; db < 4; ++db) {
                                            const LAS unsigned char* vp = VI + (db * 32 + r31) * VST + (hf * 128 + kb * 32 + 16 * s + 4 * h2) * 2;
                                            const u32x2 lo = *(const LAS u32x2*)vp, hi = *(const LAS u32x2*)(vp + 16);
                                            vf[s][db] = __builtin_bit_cast(bf16x8, (u32x4){lo.x, lo.y, hi.x, hi.y});
                                        }
                                    }
                                    __builtin_amdgcn_sched_barrier(0);
#pragma unroll
                                    for (int s = 0; s < 2; ++s)
#pragma unroll
                                        for (int db = 0; db < 4; ++db) O[db] = __builtin_amdgcn_mfma_f32_32x32x16_bf16(vf[s][db], pf[s], O[db], 0, 0, 0);
                                    __builtin_amdgcn_sched_barrier(0);
                                }
                            }
                            const float rl = 1.f / lrun;
                            char* op = HC + (qrow * 1536 + 1024 + h * 128) * 2;
#pragma unroll
                            for (int db = 0; db < 4; ++db)
#pragma unroll
                                for (int g4 = 0; g4 < 4; ++g4) { u32x2 w; w.x = pk2(O[db][4 * g4] * rl, O[db][4 * g4 + 1] * rl); w.y = pk2(O[db][4 * g4 + 2] * rl, O[db][4 * g4 + 3] * rl);
                                    *(u32x2*)(op + (db * 32 + 8 * g4 + 4 * h2) * 2) = w; }
                        }
                        __syncthreads();
                    }
                    if (tid_ph == 0) XB[0] = __hip_atomic_fetch_add(xc, 1u, RLX_AGENT);
                    __syncthreads();
                    xi = __builtin_amdgcn_readfirstlane((int)XB[0]);
                    __syncthreads();
                }
            }
            if (rep_ == 0) {
                unsigned zf_ = 0u; asm volatile("" : "+v"(zf_)); const int lane_f = (int)__builtin_amdgcn_mbcnt_hi(~0u, __builtin_amdgcn_mbcnt_lo(~0u, zf_));
                LAS float* scr = (LAS float*)(lds + wave * 8448);
                LAS unsigned* FB = (LAS unsigned*)(lds + 8 * 8448);
                unsigned* fc = (unsigned*)ctl + CW_FILL + l * 64;
                constexpr int IT_GU = 32 * 16 * 64, IT_ALL = 49152, CH = 32;
                const bool lead = (wave == 0) && (lane_f == 0);
                __syncthreads();
                if (lead) FB[0] = __hip_atomic_fetch_add(fc, (unsigned)CH, RLX_AGENT);
                __syncthreads();
                int fbase = __builtin_amdgcn_readfirstlane((int)FB[0]), slot = 1;
#pragma unroll 1
                while (fbase < IT_ALL) {
                    unsigned nb = 0u;
                    if (lead) nb = __hip_atomic_fetch_add(fc, (unsigned)CH, RLX_AGENT);
                    {
                        struct FItem { const float* W; unsigned char* WT; int ldw; float sc; };
                        auto FI = [&](int it) -> FItem { FItem r;
                            if (it < IT_GU) { const int e = it >> 10, q = it & 1023, kb = q >> 6, nb_ = q & 63;
                                r.W = INP(I_WGU) + (((size_t)l * 32 + e) * D + 64 * kb) * 2048 + 32 * nb_; r.ldw = 2048; r.WT = (unsigned char*)(ws + WS_WGU) + ((size_t)e * 2048 + 32 * nb_) * D + 64 * kb; r.sc = F8_SWGU; }
                            else { const int r2 = it - IT_GU, e = r2 >> 9, q = r2 & 511, kb = q >> 5, nb_ = q & 31;
                                r.W = INP(I_WDN) + (((size_t)l * 32 + e) * D + 64 * kb) * 1024 + 32 * nb_; r.ldw = 1024; r.WT = (unsigned char*)(ws + WS_WDN) + ((size_t)e * 1024 + 32 * nb_) * D + 64 * kb; r.sc = F8_SWDN; }
                            return r; };
                        f32x4 va[8], vb[8];
                        FItem c0 = FI(fbase + wave), c1;
                        ti_load4(c0.W, c0.ldw, lane_f, va);
#pragma unroll 1
                        for (int kq = 0; kq < CH / NWAVES; kq += 2) {
                            c1 = FI(fbase + wave + (kq + 1) * NWAVES); ti_load4(c1.W, c1.ldw, lane_f, vb);
                            ti_store4_f8(va, c0.WT, D, c0.sc, lane_f);
                            if (kq + 2 < CH / NWAVES) { c0 = FI(fbase + wave + (kq + 2) * NWAVES); ti_load4(c0.W, c0.ldw, lane_f, va); }
                            ti_store4_f8(vb, c1.WT, D, c1.sc, lane_f);
                        }
                    }
                    if (lead) FB[slot] = nb;
                    __syncthreads();
                    fbase = __builtin_amdgcn_readfirstlane((int)FB[slot]); slot ^= 1;
                }
            }
#undef UNP4
#undef DOT4
#undef SUB_TID
        }
        SEAM(pb + 3);
        _Pragma("unroll 1") for (int rep_ = 0; rep_ < NREP(5); ++rep_) if (((PHMASK>>5)&1) && IN(pb + 5)) {
            SchedPlain S; S.T.init(M / 256, 4); S.G = G; S.c = bx; S.A = (const char*)(ws + WS_R2 + R2_HCAT); S.B = (const char*)(ws + WS_WBR) + (size_t)l * 1024 * 1536 * 2; S.C = (char*)(ws + WS_R2 + R2_YPRE);
            S.lda = 1536; S.ldb = 1536; S.ldc = D;
            pg8::EpiMerge E; E.U = Ub; E.gate_b = INP(I_GATEB) + (size_t)l * 3072;
            pg8::gemm_phase<false, true>(lds, 1536 * 2, 1536 * 2, 1536 * 2, S, E, wave);
        }
        SEAM(pb + 5);
        _Pragma("unroll 1") for (int rep_ = 0; rep_ < NREP(6); ++rep_) if (((PHMASK>>6)&1) && IN(pb + 6)) {
            SchedPlain S; S.T.init(M / 256, 4); S.G = G; S.c = bx; S.A = (const char*)(ws + WS_R2 + R2_YPRE); S.B = (const char*)(ws + WS_WO) + (size_t)l * D * D * 2; S.C = (char*)(ws + WS_R2 + R2_Z);
            S.lda = D; S.ldb = D; S.ldc = D;
            pg8::EpiStore E;
            pg8::gemm_phase<false>(lds, D * 2, D * 2, D * 2, S, E, wave);
        }
        SEAM(pb + 6);
        _Pragma("unroll 1") for (int rep_ = 0; rep_ < NREP(7); ++rep_) if (((PHMASK>>7)&1) && IN(pb + 7)) { PHASE_TID
            constexpr int WP = 2064;
            LAS unsigned char* WRb = lds;
            LAS float* RB = (LAS float*)(lds + 66048);
            LAS unsigned char* XS = lds + 66560 + wave * 4608;
            for (int i = tid; i < 32768; i += NTHR) { const int k = i >> 5, e = i & 31; *(LAS bf16*)(WRb + e * WP + k * 2) = (bf16)f2bf(INP(I_RTW)[((size_t)l * D + k) * 32 + e]); }
            if (tid < 32) RB[tid] = INP(I_RTB)[l * 32 + tid];
            const char* Zb = (const char*)(ws + WS_R2 + R2_Z);
            int* TKE = (int*)(ws + WS_TKE); float* TKG = (float*)(ws + WS_TKG); int* TKP = (int*)(ws + WS_TKP); int* ROWTOK = (int*)(ws + WS_ROWTOK);
            LAS unsigned* LCNT = (LAS unsigned*)(lds + 131072);
            LAS unsigned* GBASE = LCNT + 32; LAS unsigned* LLEN = LCNT + 64; LAS unsigned* LIST = LCNT + 128;
            if (tid < 65) LCNT[tid] = 0u;
            {
                f32x4 g[4], bb[4];
#pragma unroll
                for (int j = 0; j < 4; ++j) { g[j] = *(const f32x4*)(INP(I_LN1G) + l * D + 256 * j + 4 * lane); bb[j] = *(const f32x4*)(INP(I_LN1B) + l * D + 256 * j + 4 * lane); }
#pragma unroll 1
                for (int pp = gw; pp < M / 2; pp += NGW) {
                    f32x4 y0[4], y1[4];
#pragma unroll
                    for (int j = 0; j < 4; ++j) { y0[j] = ld4bf(Zb + ((size_t)(2 * pp) * D + 256 * j + 4 * lane) * 2) + ld4bf(Xb + ((size_t)(2 * pp) * D + 256 * j + 4 * lane) * 2) * DN_ALPHA;
                        y1[j] = ld4bf(Zb + ((size_t)(2 * pp + 1) * D + 256 * j + 4 * lane) * 2) + ld4bf(Xb + ((size_t)(2 * pp + 1) * D + 256 * j + 4 * lane) * 2) * DN_ALPHA; }
                    ln16(y0, g, bb); ln16(y1, g, bb);
#pragma unroll
                    for (int j = 0; j < 4; ++j) { st4bf(Xb + ((size_t)(2 * pp) * D + 256 * j + 4 * lane) * 2, y0[j]); st4bf(Xb + ((size_t)(2 * pp + 1) * D + 256 * j + 4 * lane) * 2, y1[j]);
                        *(unsigned*)((char*)(ws + WS_XF8) + (size_t)(2 * pp) * D + 256 * j + 4 * lane) = pk4_f8(y0[j].x * F8_SX, y0[j].y * F8_SX, y0[j].z * F8_SX, y0[j].w * F8_SX);
                        *(unsigned*)((char*)(ws + WS_XF8) + (size_t)(2 * pp + 1) * D + 256 * j + 4 * lane) = pk4_f8(y1[j].x * F8_SX, y1[j].y * F8_SX, y1[j].z * F8_SX, y1[j].w * F8_SX); }
                }
            }
            asm volatile("s_waitcnt vmcnt(0)" ::: "memory");
            __syncthreads();
            __builtin_amdgcn_fence(__ATOMIC_ACQUIRE, "agent");
            asm volatile("s_waitcnt vmcnt(0)" ::: "memory");
            if (rep_ == 0) {
                const int r31 = lane & 31, h2 = lane >> 5;
                const int mytok = 16 * (bx + (2 * wave + (r31 >> 4)) * G) + (r31 & 15);
                const char* sp[4];
#pragma unroll
                for (int q = 0; q < 4; ++q) { const int row = (lane >> 3) + 8 * q; const int tk = 16 * (bx + (2 * wave + (row >> 4)) * G) + (row & 15); sp[q] = Xb + ((size_t)tk * D + 8 * (lane & 7)) * 2; }
                f32x16 C;
#pragma unroll
                for (int i = 0; i < 16; ++i) C[i] = 0.f;
                u32x4 xr[4];
#pragma unroll
                for (int q = 0; q < 4; ++q) xr[q] = *(const u32x4*)(sp[q]);
#pragma unroll 1
                for (int sl = 0; sl < 16; ++sl) {
#pragma unroll
                    for (int q = 0; q < 4; ++q) *(LAS u32x4*)(XS + ((lane >> 3) + 8 * q) * 144 + (lane & 7) * 16) = xr[q];
                    if (sl + 1 < 16) {
#pragma unroll
                        for (int q = 0; q < 4; ++q) xr[q] = *(const u32x4*)(sp[q] + (sl + 1) * 128); }
#pragma unroll
                    for (int k2 = 0; k2 < 4; ++k2) C = __builtin_amdgcn_mfma_f32_32x32x16_bf16(*(const LAS bf16x8*)(WRb + r31 * WP + (64 * sl + 16 * k2 + 8 * h2) * 2), *(const LAS bf16x8*)(XS + r31 * 144 + (16 * k2 + 8 * h2) * 2), C, 0, 0, 0);
                }
                float v[16];
#pragma unroll
                for (int g4 = 0; g4 < 4; ++g4) { const f32x4 b4 = *(const LAS f32x4*)(RB + 8 * g4 + 4 * h2); v[4 * g4] = C[4 * g4] + b4.x; v[4 * g4 + 1] = C[4 * g4 + 1] + b4.y; v[4 * g4 + 2] = C[4 * g4 + 2] + b4.z; v[4 * g4 + 3] = C[4 * g4 + 3] + b4.w; }
                float lv[4]; int li_[4];
#pragma unroll
                for (int k = 0; k < 4; ++k) { float best = -3.0e38f; int bi = 0;
#pragma unroll
                    for (int i = 0; i < 16; ++i) { const int e = (i & 3) + 8 * (i >> 2) + 4 * h2; if (v[i] > best) { best = v[i]; bi = e; } }
#pragma unroll
                    for (int i = 0; i < 16; ++i) { const int e = (i & 3) + 8 * (i >> 2) + 4 * h2; v[i] = (e == bi) ? -3.0e38f : v[i]; }
                    lv[k] = best; li_[k] = bi; }
                float cv[8]; int ci[8];
#pragma unroll
                for (int k = 0; k < 4; ++k) { cv[k] = lv[k]; ci[k] = li_[k]; cv[4 + k] = __shfl_xor(lv[k], 32); ci[4 + k] = __shfl_xor(li_[k], 32); }
                float tv[4]; int te[4];
#pragma unroll
                for (int k = 0; k < 4; ++k) { float best = -3.0e38f; int bi = 64;
#pragma unroll
                    for (int i = 0; i < 8; ++i) { if (cv[i] > best || (cv[i] == best && ci[i] < bi)) { best = cv[i]; bi = ci[i]; } }
#pragma unroll
                    for (int i = 0; i < 8; ++i) cv[i] = (ci[i] == bi) ? -3.0e38f : cv[i];
                    tv[k] = best; te[k] = bi; }
                const float e1 = __expf(tv[1] - tv[0]), e2 = __expf(tv[2] - tv[0]), e3 = __expf(tv[3] - tv[0]), rs = 1.f / (1.f + e1 + e2 + e3);
                const float gt[4] = {rs, e1 * rs, e2 * rs, e3 * rs};
                if (h2 == 0) {
#pragma unroll
                    for (int k = 0; k < 4; ++k) {
                        const unsigned lpos = __hip_atomic_fetch_add(LCNT + te[k], 1u, __ATOMIC_RELAXED, __HIP_MEMORY_SCOPE_WORKGROUP);
                        const unsigned li = __hip_atomic_fetch_add(LLEN, 1u, __ATOMIC_RELAXED, __HIP_MEMORY_SCOPE_WORKGROUP);
                        LIST[2 * li] = (unsigned)(mytok * 4 + k); LIST[2 * li + 1] = (unsigned)te[k] | (lpos << 8);
                        TKE[mytok * 4 + k] = te[k]; TKG[mytok * 4 + k] = gt[k]; }
                }
            }
            __syncthreads();
            if (tid < 32 && rep_ == 0) GBASE[tid] = __hip_atomic_fetch_add((unsigned*)ctl + CW_CNT + (l * 32 + tid) * 64, LCNT[tid], RLX_AGENT);
            __syncthreads();
            if (rep_ == 0) { const unsigned n = LLEN[0];
                for (unsigned i = tid; i < n; i += NTHR) { const unsigned tk = LIST[2 * i], ev = LIST[2 * i + 1], e = ev & 255u, pos = GBASE[e] + (ev >> 8);
                    TKP[tk] = (int)pos; ROWTOK[(size_t)e * M + pos] = (int)(tk >> 2); } }
            __syncthreads();
        }
        SEAM(pb + 7);
        _Pragma("unroll 1") for (int rep_ = 0; rep_ < NREP(8); ++rep_) if (((PHMASK>>8)&1) && IN(pb + 8)) { PHASE_TID
            if (tid < 32) CNT[tid] = (int)__hip_atomic_load((unsigned*)ctl + CW_CNT + (l * 32 + tid) * 64, RLX_AGENT);
            __syncthreads();
            if (tid == 0) { int a = 0; for (int e = 0; e < 32; ++e) { PB[e] = a; a += (CNT[e] + 255) >> 8; } PB[32] = a; }
            __syncthreads();
            const int P = PB[32];
            const int* ROWTOK = (const int*)(ws + WS_ROWTOK);
            char* XD = (char*)(ws + WS_R1); const char* XF = (const char*)(ws + WS_XF8);
            for (int sb = gw * 64; sb < P * 256; sb += NGW * 64) {
                const int pm = sb >> 8; int e = 0;
#pragma unroll 1
                for (int j = 1; j < NEXP; ++j) e += (PB[j] <= pm) ? 1 : 0;
                const int pos0 = sb - PB[e] * 256, cnt = CNT[e];
                int nvalid = cnt - pos0; nvalid = nvalid > 64 ? 64 : nvalid;
                int tokv = -1; if (pos0 + lane < cnt) tokv = ROWTOK[(size_t)e * M + pos0 + lane];
#pragma unroll 1
                for (int j = 0; j < nvalid; j += 4) {
                    int t[4]; u32x4 a[4];
#pragma unroll
                    for (int i = 0; i < 4; ++i) { t[i] = __builtin_amdgcn_readlane(tokv, j + i);
                        if (t[i] >= 0) a[i] = *(const u32x4*)(XF + (size_t)t[i] * 1024 + lane * 16); }
#pragma unroll
                    for (int i = 0; i < 4; ++i) if (t[i] >= 0) *(u32x4*)(XD + (size_t)(sb + j + i) * 1024 + lane * 16) = a[i];
                }
            }
            LAS float* scr = (LAS float*)(lds + wave * 8448);
            constexpr int IT_GU = 32 * 16 * 64, IT_DN = 32 * 16 * 32;
            for (int it = XW_SPLIT + gw; it < IT_GU + IT_DN; it += NGW) {
                if (it < IT_GU) { const int e = it >> 10, q = it & 1023, kb = q >> 6, nb = q & 63;
                    transpose_item_f8(INP(I_WGU) + (((size_t)l * 32 + e) * D + 64 * kb) * 2048 + 32 * nb, 2048, (unsigned char*)(ws + WS_WGU) + ((size_t)e * 2048 + 32 * nb) * D + 64 * kb, D, F8_SWGU, scr, lane); }
                else { const int r = it - IT_GU, e = r >> 9, q = r & 511, kb = q >> 5, nb = q & 31;
                    transpose_item_f8(INP(I_WDN) + (((size_t)l * 32 + e) * D + 64 * kb) * 1024 + 32 * nb, 1024, (unsigned char*)(ws + WS_WDN) + ((size_t)e * 1024 + 32 * nb) * D + 64 * kb, D, F8_SWDN, scr, lane); }
            }
            __syncthreads();
        }
        SEAM(pb + 8);
        if (IN(pb + 9) || IN(pb + 10)) { PHASE_TID
            if (tid < 32) CNT[tid] = (int)__hip_atomic_load((unsigned*)ctl + CW_CNT + (l * 32 + tid) * 64, RLX_AGENT);
            __syncthreads();
            if (tid == 0) { int a = 0; for (int e = 0; e < 32; ++e) { PB[e] = a; a += (CNT[e] + 255) >> 8; } PB[32] = a; }
            __syncthreads();
        }
        _Pragma("unroll 1") for (int rep_ = 0; rep_ < NREP(9); ++rep_) if (((PHMASK>>9)&1) && IN(pb + 9)) {
            SchedMoe S; S.T.init(PB[32], 8); S.G = G; S.c = bx; S.A = (const char*)(ws + WS_R1); S.W = (const char*)(ws + WS_WGU); S.C = (char*)(ws + WS_R2 + R2_HMID); S.PB = PB; S.wrows = 2048; S.ldc = 1024; S.cdiv = 2; S.osz = 1;
            pg8::EpiMoe1 E; E.bgu = INP(I_BGU) + (size_t)l * 32 * 2048;
            pg8::gemm_phase<true>(lds, D, D, D, S, E, wave);
        }
        SEAM(pb + 9);
        _Pragma("unroll 1") for (int rep_ = 0; rep_ < NREP(10); ++rep_) if (((PHMASK>>10)&1) && IN(pb + 10)) {
            SchedMoe S; S.T.init(PB[32], 4); S.G = G; S.c = bx; S.A = (const char*)(ws + WS_R2 + R2_HMID); S.W = (const char*)(ws + WS_WDN); S.C = (char*)(ws + WS_R1); S.PB = PB; S.wrows = 1024; S.ldc = 1024; S.cdiv = 1; S.osz = 2;
            pg8::EpiMoe2 E; E.bdn = INP(I_BDN) + (size_t)l * 32 * 1024;
            pg8::gemm_phase<true>(lds, D, D, D, S, E, wave);
        }
        SEAM(pb + 10);
        _Pragma("unroll 1") for (int rep_ = 0; rep_ < NREP(11); ++rep_) if (((PHMASK>>11)&1) && IN(pb + 11)) { PHASE_TID
            if (tid < 32) CNT[tid] = (int)__hip_atomic_load((unsigned*)ctl + CW_CNT + (l * 32 + tid) * 64, RLX_AGENT);
            LAS float* wgt = (LAS float*)(lds + 73728);
            const bool lastl = (l == DEPTH - 1);
            if (!lastl) load_gate_table(wgt, INP(I_WIN) + (size_t)(l + 1) * D * DIN, tid);
            __syncthreads();
            if (tid == 0) { int a = 0; for (int e = 0; e < 32; ++e) { PB[e] = a; a += (CNT[e] + 255) >> 8; } PB[32] = a; }
            __syncthreads();
            const int e0 = 8 * lane;
            f32x4 g[4], bb[4];
#pragma unroll
            for (int j = 0; j < 4; ++j) { const int o = (j >> 1) * 512 + e0 + (j & 1) * 4; g[j] = *(const f32x4*)(INP(I_LN2G) + l * D + o); bb[j] = *(const f32x4*)(INP(I_LN2B) + l * D + o); }
            const char* YA = (const char*)(ws + WS_R1);
            const bool dummy_ = (rep_ + 1 < NREP(11)); char* const Xo = dummy_ ? (char*)(ws + WS_R2) : Xb; float* const Fo = dummy_ ? (float*)(ws + WS_R2 + 256 * MiB) : args.out; float* const Go = dummy_ ? (float*)(ws + WS_R2 + 200 * MiB) : GIF;
            const int* TKE = (const int*)(ws + WS_TKE); const float* TKG = (const float*)(ws + WS_TKG); const int* TKP = (const int*)(ws + WS_TKP);
#pragma unroll 1
            for (int mb = gw * 16; mb < M; mb += NGW * 16) {
                const int ev = TKE[mb * 4 + lane], pv = TKP[mb * 4 + lane]; const float gv = TKG[mb * 4 + lane];
                const int rowv = PB[ev] * 256 + pv;
#pragma unroll 1
                for (int ti = 0; ti < 16; ti += 2) {
                    u32x4 xw[2][2], yw[2][4][2]; float gk[2][4];
#pragma unroll
                    for (int q = 0; q < 2; ++q) { const size_t m = (size_t)mb + ti + q;
                        xw[q][0] = *(const u32x4*)(Xb + (m * D + e0) * 2); xw[q][1] = *(const u32x4*)(Xb + (m * D + 512 + e0) * 2);
#pragma unroll
                        for (int k = 0; k < 4; ++k) { const size_t row = (size_t)__builtin_amdgcn_readlane(rowv, 4 * (ti + q) + k);
                            gk[q][k] = __builtin_bit_cast(float, __builtin_amdgcn_readlane(__builtin_bit_cast(int, gv), 4 * (ti + q) + k));
                            yw[q][k][0] = *(const u32x4*)(YA + (row * D + e0) * 2); yw[q][k][1] = *(const u32x4*)(YA + (row * D + 512 + e0) * 2); } }
#pragma unroll
                    for (int q = 0; q < 2; ++q) { const size_t m = (size_t)mb + ti + q;
                        f32x4 v[4];
#pragma unroll
                        for (int hh = 0; hh < 2; ++hh) { const u32x4 w = xw[q][hh];
                            v[2 * hh] = (f32x4){bflo(w.x), bfhi(w.x), bflo(w.y), bfhi(w.y)} * DN_ALPHA; v[2 * hh + 1] = (f32x4){bflo(w.z), bfhi(w.z), bflo(w.w), bfhi(w.w)} * DN_ALPHA; }
#pragma unroll
                        for (int k = 0; k < 4; ++k)
#pragma unroll
                            for (int hh = 0; hh < 2; ++hh) { const u32x4 w = yw[q][k][hh];
                                v[2 * hh] = v[2 * hh] + (f32x4){bflo(w.x), bfhi(w.x), bflo(w.y), bfhi(w.y)} * gk[q][k]; v[2 * hh + 1] = v[2 * hh + 1] + (f32x4){bflo(w.z), bfhi(w.z), bflo(w.w), bfhi(w.w)} * gk[q][k]; }
                        ln16(v, g, bb);
                        if (lastl) {
#pragma unroll
                            for (int j = 0; j < 4; ++j) *(f32x4*)(Fo + m * D + (j >> 1) * 512 + e0 + (j & 1) * 4) = v[j];
                        } else {
#pragma unroll
                            for (int hh = 0; hh < 2; ++hh) { *(u32x4*)(Xo + (m * D + hh * 512 + e0) * 2) = pg8::pack8(v[2 * hh], v[2 * hh + 1]);
                                u32x2 f8w; f8w.x = pk4_f8(v[2 * hh].x * F8_SX, v[2 * hh].y * F8_SX, v[2 * hh].z * F8_SX, v[2 * hh].w * F8_SX); f8w.y = pk4_f8(v[2 * hh + 1].x * F8_SX, v[2 * hh + 1].y * F8_SX, v[2 * hh + 1].z * F8_SX, v[2 * hh + 1].w * F8_SX);
                                if (!dummy_) *(u32x2*)((char*)(ws + WS_XF8) + m * D + hh * 512 + e0) = f8w; }
                            gates8b(v, wgt, Go + m * 8, lane);
                        }
                    }
                }
            }
            __syncthreads();
        }
        SEAM(pb + 11);
    }
#undef IN
#undef SEAM
}

extern "C" void kernel_launch(void* const* d_in, const int* in_sizes, int n_in, void* d_out, int out_size, void* d_ws, size_t ws_size, hipStream_t stream) {
    static int grid = 0;
    if (grid == 0) {
        if (n_in != N_IN || out_size != M * D || ws_size < WS_END) { fprintf(stderr, "kernel_launch: unexpected shapes (n_in %d, out %d, ws %zu)\n", n_in, out_size, ws_size); grid = -1; return; }
        int dev = 0, cus = 0, per_cu = 0;
        if (hipGetDevice(&dev) != hipSuccess || hipDeviceGetAttribute(&cus, hipDeviceAttributeMultiprocessorCount, dev) != hipSuccess) { grid = -1; return; }
        if (hipFuncSetAttribute((const void*)fwd_kernel, hipFuncAttributeMaxDynamicSharedMemorySize, LDS_BYTES) != hipSuccess) { fprintf(stderr, "kernel_launch: hipFuncSetAttribute failed\n"); grid = -1; return; }
        if (hipOccupancyMaxActiveBlocksPerMultiprocessor(&per_cu, (const void*)fwd_kernel, NTHR, LDS_BYTES) != hipSuccess || per_cu < 1) fprintf(stderr, "kernel_launch: occupancy query reports %d\n", per_cu);
        (void)hipGetLastError();
        grid = cus;
    }
    if (grid < 0) return;
    (void)hipMemsetAsync((char*)d_ws + WS_CTL, 0, CTL_ZERO_BYTES, stream);
    Args a{};
    for (int i = 0; i < N_IN; ++i) a.in[i] = (const float*)d_in[i];
    a.out = (float*)d_out; a.ws = (unsigned char*)d_ws;
#if MK_ONE_LAUNCH
    a.ph_lo = 0; a.ph_hi = NPH;
    hipLaunchKernelGGL(fwd_kernel, dim3(grid), dim3(NTHR), LDS_BYTES, stream, a);
#else
    for (int p = 0; p < NPH; ++p) { a.ph_lo = p; a.ph_hi = p + 1; hipLaunchKernelGGL(fwd_kernel, dim3(grid), dim3(NTHR), LDS_BYTES, stream, a); }
#endif
    const hipError_t le = hipPeekAtLastError();
    if (le != hipSuccess) fprintf(stderr, "kernel_launch: launch failed: %s\n", hipGetErrorName(le));
}
```

```cpp
#include <hip/hip_runtime.h>
#include <cstdio>
#include <cstdint>

#ifndef MK_ONE_LAUNCH
#define MK_ONE_LAUNCH 1
#endif

#define LAS __attribute__((address_space(3)))
#define GAS __attribute__((address_space(1)))
typedef unsigned short bf16;
typedef short bf16x8 __attribute__((ext_vector_type(8)));
typedef float f32x4 __attribute__((ext_vector_type(4)));
typedef float f32x2 __attribute__((ext_vector_type(2)));
typedef float f32x16 __attribute__((ext_vector_type(16)));
typedef unsigned u32x4 __attribute__((ext_vector_type(4)));
typedef unsigned u32x2 __attribute__((ext_vector_type(2)));
typedef __bf16 bf16x2_t __attribute__((ext_vector_type(2)));
typedef GAS unsigned gu32;
#define RLX_AGENT __ATOMIC_RELAXED, __HIP_MEMORY_SCOPE_AGENT
#define DI __device__ __forceinline__

constexpr int NWAVES = 8, NTHR = 512;
constexpr int D = 1024, BATCH = 16, SEQ = 4096, M = BATCH * SEQ, DEPTH = 2, MEML = 256, MROWS = BATCH * MEML;
constexpr int DIN = 6920, NU = 6912;
constexpr int UC_QK = 0, UC_RW = 512, UC_V = 2304, UC_OG = 2816, UC_CAQ = 3328, UC_GATE = 3840;
constexpr int UC_F8 = UC_V, NF8 = NU - UC_F8;
__host__ __device__ constexpr int ucol_src(int c) { return c < 512 ? c : (c < 2304 ? 1544 + (c - 512) : (c < 2816 ? 512 + (c - 2304) : (c < 3328 ? 1024 + (c - 2816) : (c < 3840 ? 3336 + (c - 3328) : 3848 + (c - 3840))))); }
constexpr int NEXP = 32, TOPK = 4;
constexpr int PMAX = M * TOPK / 256 + NEXP;
constexpr float LN_EPS = 1e-5f, RW_GN_EPS = 64e-5f, DN_ALPHA = 1.41421356237f;

enum { I_X = 0, I_MEM, I_LNIN_G, I_LNIN_B, I_MEMLN_G, I_MEMLN_B, I_WIN, I_CONVW, I_CONVB, I_IGB, I_FGB, I_MLNORMG, I_RWMU, I_RWW0, I_RWWUP, I_RWA0, I_RWAUP, I_RWGUP,
       I_RWKK, I_RWKA, I_RWRK, I_RWLNG, I_RWLNB, I_CAWKV, I_GATEB, I_WBRML, I_WBRRW, I_WBRCA, I_WO, I_LN1G, I_LN1B, I_RTW, I_RTB, I_WGU, I_BGU, I_WDN, I_BDN, I_LN2G, I_LN2B, N_IN };

constexpr size_t MiB = 1u << 20;
constexpr size_t WS_CTL = 0, CTL_ZERO_BYTES = 1 * MiB;
constexpr size_t WS_WIN = 1 * MiB;
constexpr size_t WS_WKV = 28 * MiB;
constexpr size_t WS_WBR = 32 * MiB;
constexpr size_t WS_WO = 38 * MiB;
constexpr size_t WS_WLORA = 42 * MiB;
constexpr size_t WS_WGU = 45 * MiB;
constexpr size_t WS_WDN = 173 * MiB;
constexpr size_t WS_X = 237 * MiB;
constexpr size_t WS_MEMN = 365 * MiB;
constexpr size_t WS_KV = 373 * MiB;
constexpr size_t WS_GIF = 389 * MiB;
constexpr size_t WS_TKE = 391 * MiB, WS_TKG = 392 * MiB, WS_TKP = 393 * MiB;
constexpr size_t WS_ROWTOK = 394 * MiB;
constexpr size_t WS_HML = 402 * MiB;
constexpr size_t WS_R1 = 466 * MiB;
constexpr size_t WS_R2 = 1330 * MiB;
constexpr size_t WS_XF8 = 1858 * MiB;
constexpr size_t WS_WING8 = 1922 * MiB;
constexpr size_t WS_END = 1932 * MiB;
constexpr size_t R2_LORA_OUT = 0, R2_HCAT = 192 * MiB, R2_LORA_IN = 384 * MiB, R2_YPRE = 0, R2_Z = 192 * MiB, R2_HMID = 0;
constexpr int CW_TMO = 0, CW_BAR = 4096, CW_CNT = 16384, CW_FILL = 32768;

constexpr int LDS_BYTES = 155648;
constexpr int LDSCTL_OFF = 153600;

DI unsigned pk2(float lo, float hi) { bf16x2_t b = __builtin_convertvector((f32x2){lo, hi}, bf16x2_t); return __builtin_bit_cast(unsigned, b); }
DI unsigned f2bf(float f) { return pk2(f, 0.f) & 0xffffu; }
DI float u2f_(unsigned u) { return __builtin_bit_cast(float, u); }
DI unsigned f2u_(float f) { return __builtin_bit_cast(unsigned, f); }
DI float bflo(unsigned u) { return __builtin_bit_cast(float, u << 16); }
DI float bfhi(unsigned u) { return __builtin_bit_cast(float, u & 0xffff0000u); }
DI unsigned pk4_f8(float a, float b, float c, float d) {
    a = __builtin_amdgcn_fmed3f(a, -448.f, 448.f); b = __builtin_amdgcn_fmed3f(b, -448.f, 448.f); c = __builtin_amdgcn_fmed3f(c, -448.f, 448.f); d = __builtin_amdgcn_fmed3f(d, -448.f, 448.f);
    int w = 0; w = __builtin_amdgcn_cvt_pk_fp8_f32(a, b, w, false); w = __builtin_amdgcn_cvt_pk_fp8_f32(c, d, w, true); return (unsigned)w; }
DI float sigmoidf_(float x) { return __builtin_amdgcn_rcpf(1.f + __builtin_amdgcn_exp2f(-1.4426950408889634f * x)); }
template <int CTRL> DI float dppf(float x) { return __builtin_bit_cast(float, __builtin_amdgcn_update_dpp(0, __builtin_bit_cast(int, x), CTRL, 0xF, 0xF, true)); }
DI float red4(float x) { x += dppf<0xB1>(x); x += dppf<0x4E>(x); return x; }
DI float red8(float x) { x = red4(x); x += dppf<0x141>(x); return x; }
DI float red16(float x) { x = red8(x); x += dppf<0x140>(x); return x; }
DI float red8o(float x) { x += dppf<0xB1>(x); asm("" : "+v"(x)); x += dppf<0x4E>(x); asm("" : "+v"(x)); x += dppf<0x141>(x); asm("" : "+v"(x)); return x; }
DI float red16o(float x) { x = red8o(x); x += dppf<0x140>(x); asm("" : "+v"(x)); return x; }
typedef short s16x4 __attribute__((ext_vector_type(4)));
DI u32x2 trd4(const LAS unsigned char* img, int PB, int rowbase, int colbase, int lane) {
    const LAS unsigned char* p = img + (rowbase + ((lane & 15) >> 2)) * PB + (colbase + 16 * ((lane >> 4) & 1) + 4 * (lane & 3)) * 2;
    return __builtin_bit_cast(u32x2, __builtin_amdgcn_ds_read_tr16_b64_v4i16((LAS s16x4*)p)); }
DI bf16x8 trd8(const LAS unsigned char* img, int PB, int rb0, int rb1, int colbase, int lane) { const u32x2 lo = trd4(img, PB, rb0, colbase, lane), hi = trd4(img, PB, rb1, colbase, lane); return __builtin_bit_cast(bf16x8, (u32x4){lo.x, lo.y, hi.x, hi.y}); }
template <int CTRL, int RM> DI float dpp_keep(float x, float ident) { return __builtin_bit_cast(float, __builtin_amdgcn_update_dpp(__builtin_bit_cast(int, ident), __builtin_bit_cast(int, x), CTRL, RM, 0xF, false)); }
DI float scan_add64(float x) { x += dpp_keep<0x111, 0xF>(x, 0.f); x += dpp_keep<0x112, 0xF>(x, 0.f); x += dpp_keep<0x114, 0xF>(x, 0.f); x += dpp_keep<0x118, 0xF>(x, 0.f); x += dpp_keep<0x142, 0xA>(x, 0.f); x += dpp_keep<0x143, 0xC>(x, 0.f); return x; }
DI float scan_max64(float x) { const float NI = -3.0e38f; x = fmaxf(x, dpp_keep<0x111, 0xF>(x, NI)); x = fmaxf(x, dpp_keep<0x112, 0xF>(x, NI)); x = fmaxf(x, dpp_keep<0x114, 0xF>(x, NI)); x = fmaxf(x, dpp_keep<0x118, 0xF>(x, NI));
    x = fmaxf(x, dpp_keep<0x142, 0xA>(x, NI)); x = fmaxf(x, dpp_keep<0x143, 0xC>(x, NI)); return x; }
DI float wave_sum(float v) {
    v = red16(v);
    const int vi = __builtin_bit_cast(int, v);
    const float a = __builtin_bit_cast(float, __builtin_amdgcn_readlane(vi, 0)), b = __builtin_bit_cast(float, __builtin_amdgcn_readlane(vi, 16));
    const float c = __builtin_bit_cast(float, __builtin_amdgcn_readlane(vi, 32)), d = __builtin_bit_cast(float, __builtin_amdgcn_readlane(vi, 48));
    return (a + b) + (c + d);
}
#define LDS_WAIT() asm volatile("s_waitcnt lgkmcnt(0)" ::: "memory")

constexpr float F8_SX = 8.f, F8_SWGU = 512.f, F8_SH = 4.f, F8_SWDN = 1024.f, F8_INV1 = 1.f / (F8_SX * F8_SWGU), F8_INV2 = 1.f / (F8_SH * F8_SWDN);
namespace pg8 {
constexpr int BM = 256, BK = 64, HALF = 128, HTB = HALF * BK * 2, STAGE_BYTES = 8 * HTB, NXCD = 8, WGM = 8;
__host__ __device__ __forceinline__ int lds_byte(int r, int c) { const int st = (r >> 4) * 2 + (c >> 5), rr = r & 15, cc = c & 31, ob = rr * 64 + cc * 2; return st * 1024 + (ob ^ (((ob >> 9) & 1) << 5)); }
__host__ __device__ __forceinline__ void stage_rc(int b, int& R, int& C) { const int st = b / 1024, sb = b % 1024, swz = sb ^ (((sb >> 9) & 1) << 5); R = (st >> 1) * 16 + swz / 64; C = (st & 1) * 32 + (swz % 64) / 2; }
__host__ __device__ __forceinline__ int perm32(int rho) { const int n = rho >> 4, i = rho & 15; return 8 * (i >> 2) + 4 * n + (i & 3); }

struct Unit { const char* a; const char* b; char* c; int ldc; int r0, c0, e, sub; };

struct TileOrder {
    int nM, nN, nwg;
    DI void init(int nM_, int nN_) { nM = nM_; nN = nN_; nwg = nM * nN; }
    DI bool tile(long L, int& pm, int& pn) const {
        if (L >= nwg) return false;
        int wgid = (int)L; { const int q = nwg / NXCD, r = nwg % NXCD, xcd = wgid % NXCD, off = wgid / NXCD; wgid = (xcd < r ? xcd * (q + 1) : r * (q + 1) + (xcd - r) * q) + off; }
        const int nig = WGM * nN, gid = wgid / nig, fm = gid * WGM, gsz = (nM - fm) < WGM ? (nM - fm) : WGM;
        pm = fm + ((wgid % nig) % gsz); pn = (wgid % nig) / gsz; return true;
    }
};

DI u32x4 pack8(const f32x4& v0, const f32x4& v1) { u32x4 w; w.x = pk2(v0[0], v0[1]); w.y = pk2(v0[2], v0[3]); w.z = pk2(v1[0], v1[1]); w.w = pk2(v1[2], v1[3]); return w; }

struct EpiStore {
    DI void operator()(const f32x4 (&acc)[2][2][4][2], const Unit& u, int wr, int wc, int fr, int fq) const {
#pragma unroll
        for (int ai = 0; ai < 2; ++ai)
#pragma unroll
            for (int m = 0; m < 4; ++m) { char* rowp = u.c + ((size_t)(ai * HALF + wr * 64 + m * 16 + fr) * u.ldc + wc * 32 + 8 * fq) * 2;
#pragma unroll
                for (int bj = 0; bj < 2; ++bj) *(u32x4*)(rowp + bj * 256) = pack8(acc[ai][bj][m][0], acc[ai][bj][m][1]); }
    }
};
struct EpiStoreS {
    float s; const float* gate_b; int gate_c0;
    DI void operator()(const f32x4 (&acc)[2][2][4][2], const Unit& u, int wr, int wc, int fr, int fq) const {
        const bool gate = u.c0 >= gate_c0;
        const float L2E = 1.4426950408889634f;
#pragma unroll
        for (int bj = 0; bj < 2; ++bj) {
            f32x4 g0 = (f32x4){0.f, 0.f, 0.f, 0.f}, g1 = g0;
            if (gate) { const float* g = gate_b + (u.c0 - gate_c0) + bj * HALF + wc * 32 + 8 * fq; g0 = *(const f32x4*)g; g1 = *(const f32x4*)(g + 4); }
#pragma unroll
            for (int ai = 0; ai < 2; ++ai)
#pragma unroll
                for (int m = 0; m < 4; ++m) { char* rowp = u.c + ((size_t)(ai * HALF + wr * 64 + m * 16 + fr) * u.ldc + wc * 32 + 8 * fq) * 2;
                    f32x4 v0 = acc[ai][bj][m][0] * s, v1 = acc[ai][bj][m][1] * s;
                    if (gate) {
#pragma unroll
                        for (int i = 0; i < 4; ++i) { v0[i] = __builtin_amdgcn_exp2f(-L2E * __builtin_amdgcn_fmed3f(v0[i] + g0[i], -30.f, 30.f)); v1[i] = __builtin_amdgcn_exp2f(-L2E * __builtin_amdgcn_fmed3f(v1[i] + g1[i], -30.f, 30.f)); } }
                    *(u32x4*)(rowp + bj * 256) = pack8(v0, v1); }
        }
    }
};
struct EpiMerge {
    static constexpr bool MIDK = true;
    const char* U; const float* gate_b;
    DI void mid(f32x4 (&acc)[2][2][4][2], const Unit& u, int which, int wr, int wc, int fr, int fq) const {
#pragma unroll
        for (int bj = 0; bj < 2; ++bj)
#pragma unroll
            for (int ai = 0; ai < 2; ++ai) {
                u32x4 wa[4], wn[4];
#pragma unroll
                for (int m = 0; m < 4; ++m) { const int lr = ai * HALF + wr * 64 + m * 16 + fr;
                    const char* gp = U + ((size_t)(u.r0 + lr) * NU + UC_GATE + which * 1024 + u.c0 + wc * 32 + 8 * fq) * 2 + bj * 256;
                    wa[m] = *(const u32x4*)gp; wn[m] = *(const u32x4*)(gp + 2048); }
#pragma unroll
                for (int m = 0; m < 4; ++m) {
                    const u32x4 a = wa[m], n = wn[m];
                    const float ea[8] = {bflo(a.x), bfhi(a.x), bflo(a.y), bfhi(a.y), bflo(a.z), bfhi(a.z), bflo(a.w), bfhi(a.w)};
                    const float en[8] = {bflo(n.x), bfhi(n.x), bflo(n.y), bfhi(n.y), bflo(n.z), bfhi(n.z), bflo(n.w), bfhi(n.w)};
#pragma unroll
                    for (int i = 0; i < 8; ++i) acc[ai][bj][m][i >> 2][i & 3] *= (1.f + en[i]) * __builtin_amdgcn_rcpf(1.f + ea[i]); }
                asm volatile("" ::: "memory"); }
    }
    DI void operator()(const f32x4 (&acc)[2][2][4][2], const Unit& u, int wr, int wc, int fr, int fq) const {
#pragma unroll
        for (int bj = 0; bj < 2; ++bj) {
            u32x4 gw[2][4];
#pragma unroll
            for (int ai = 0; ai < 2; ++ai)
#pragma unroll
                for (int m = 0; m < 4; ++m) { const int lr = ai * HALF + wr * 64 + m * 16 + fr; gw[ai][m] = *(const u32x4*)(U + ((size_t)(u.r0 + lr) * NU + UC_GATE + 2048 + u.c0 + wc * 32 + 8 * fq) * 2 + bj * 256); }
#pragma unroll
            for (int ai = 0; ai < 2; ++ai)
#pragma unroll
                for (int m = 0; m < 4; ++m) { const int lr = ai * HALF + wr * 64 + m * 16 + fr; char* rowp = u.c + ((size_t)lr * u.ldc + wc * 32 + 8 * fq) * 2; const u32x4 w = gw[ai][m];
                    f32x4 v0 = acc[ai][bj][m][0], v1 = acc[ai][bj][m][1];
                    v0[0] *= __builtin_amdgcn_rcpf(1.f + bflo(w.x)); v0[1] *= __builtin_amdgcn_rcpf(1.f + bfhi(w.x)); v0[2] *= __builtin_amdgcn_rcpf(1.f + bflo(w.y)); v0[3] *= __builtin_amdgcn_rcpf(1.f + bfhi(w.y));
                    v1[0] *= __builtin_amdgcn_rcpf(1.f + bflo(w.z)); v1[1] *= __builtin_amdgcn_rcpf(1.f + bfhi(w.z)); v1[2] *= __builtin_amdgcn_rcpf(1.f + bflo(w.w)); v1[3] *= __builtin_amdgcn_rcpf(1.f + bfhi(w.w));
                    *(u32x4*)(rowp + bj * 256) = pack8(v0, v1); }
            asm volatile("" ::: "memory");
        }
    }
};
struct EpiWo {
    const char* X;
    DI void operator()(const f32x4 (&acc)[2][2][4][2], const Unit& u, int wr, int wc, int fr, int fq) const {
#pragma unroll
        for (int ai = 0; ai < 2; ++ai)
#pragma unroll
            for (int m = 0; m < 4; ++m) { const int lr = ai * HALF + wr * 64 + m * 16 + fr; char* rowp = u.c + ((size_t)lr * u.ldc + wc * 32 + 8 * fq) * 2;
                const char* xp = X + ((size_t)(u.r0 + lr) * D + u.c0 + wc * 32 + 8 * fq) * 2;
#pragma unroll
                for (int bj = 0; bj < 2; ++bj) { const u32x4 xw = *(const u32x4*)(xp + bj * 256);
                    f32x4 v0 = acc[ai][bj][m][0], v1 = acc[ai][bj][m][1];
                    v0[0] += DN_ALPHA * bflo(xw.x); v0[1] += DN_ALPHA * bfhi(xw.x); v0[2] += DN_ALPHA * bflo(xw.y); v0[3] += DN_ALPHA * bfhi(xw.y);
                    v1[0] += DN_ALPHA * bflo(xw.z); v1[1] += DN_ALPHA * bfhi(xw.z); v1[2] += DN_ALPHA * bflo(xw.w); v1[3] += DN_ALPHA * bfhi(xw.w);
                    *(u32x4*)(rowp + bj * 256) = pack8(v0, v1); }
                asm volatile("" ::: "memory"); }
    }
};
DI float swiglu1(float a, float b) { const float g = fminf(a, 7.f), l = fminf(fmaxf(b, -7.f), 7.f); return g * sigmoidf_(1.702f * g) * (l + 1.f); }
struct EpiMoe1 {
    const float* bgu;
    DI void operator()(const f32x4 (&acc)[2][2][4][2], const Unit& u, int wr, int wc, int fr, int fq) const {
        f32x4 bv[2][2];
#pragma unroll
        for (int bj = 0; bj < 2; ++bj) { const float* b = bgu + u.e * 2048 + u.c0 + bj * HALF + wc * 32 + 8 * fq; bv[bj][0] = *(const f32x4*)b; bv[bj][1] = *(const f32x4*)(b + 4); }
#pragma unroll
        for (int ai = 0; ai < 2; ++ai)
#pragma unroll
            for (int m = 0; m < 4; ++m) { const int lr = ai * HALF + wr * 64 + m * 16 + fr; char* rowp = u.c + ((size_t)lr * u.ldc + wc * 16 + 4 * fq);
#pragma unroll
                for (int bj = 0; bj < 2; ++bj) { const f32x4 v0 = acc[ai][bj][m][0] * F8_INV1 + bv[bj][0], v1 = acc[ai][bj][m][1] * F8_INV1 + bv[bj][1];
                    *(unsigned*)(rowp + bj * 64) = pk4_f8(swiglu1(v0[0], v0[1]) * F8_SH, swiglu1(v0[2], v0[3]) * F8_SH, swiglu1(v1[0], v1[1]) * F8_SH, swiglu1(v1[2], v1[3]) * F8_SH); } }
    }
};
struct EpiMoe2 {
    const float* bdn;
    DI void operator()(const f32x4 (&acc)[2][2][4][2], const Unit& u, int wr, int wc, int fr, int fq) const {
        f32x4 bv[2][2];
#pragma unroll
        for (int bj = 0; bj < 2; ++bj) { const float* b = bdn + u.e * 1024 + u.c0 + bj * HALF + wc * 32 + 8 * fq; bv[bj][0] = *(const f32x4*)b; bv[bj][1] = *(const f32x4*)(b + 4); }
#pragma unroll
        for (int ai = 0; ai < 2; ++ai)
#pragma unroll
            for (int m = 0; m < 4; ++m) { char* rowp = u.c + ((size_t)(ai * HALF + wr * 64 + m * 16 + fr) * u.ldc + wc * 32 + 8 * fq) * 2;
#pragma unroll
                for (int bj = 0; bj < 2; ++bj) *(u32x4*)(rowp + bj * 256) = pack8(acc[ai][bj][m][0] * F8_INV2 + bv[bj][0], acc[ai][bj][m][1] * F8_INV2 + bv[bj][1]); }
    }
};

typedef int i32x8 __attribute__((ext_vector_type(8)));
typedef int i32x4 __attribute__((ext_vector_type(4)));
template <bool F8, bool MIDK = false, class Epi, class Sched>
DI void gemm_phase(LAS unsigned char* lds, const int KB  , const int ldaB, const int ldbB, const Sched& S, const Epi& E, const int wave_) {
    unsigned z_ = 0u; asm volatile("" : "+v"(z_)); const int tid = wave_ * 64 + (int)__builtin_amdgcn_mbcnt_hi(~0u, __builtin_amdgcn_mbcnt_lo(~0u, z_));
    const int wid = __builtin_amdgcn_readfirstlane(tid >> 6), lane = tid & 63, wr = wid >> 2, wc = wid & 3, fr = lane & 15, fq = lane >> 4;
    const int nt = KB / (BK * 2);
    unsigned voffA[2], voffB[2];
#pragma unroll
    for (int i = 0; i < 2; ++i) { int R, C; stage_rc(tid * 16 + i * 8192, R, C); const int Rb = (R & ~31) + perm32(R & 31);
        voffA[i] = (unsigned)(R * ldaB + C * 2); voffB[i] = (unsigned)(Rb * ldbB + C * 2); }
    asm volatile("" : "+v"(voffA[0]), "+v"(voffA[1]), "+v"(voffB[0]), "+v"(voffB[1]));
    const size_t kstep = (size_t)(BK * 2);
    const size_t hstepA = (size_t)HALF * ldaB, hstepB = (size_t)HALF * ldbB;
    const unsigned ldsw = (unsigned)wid * 1024u;
    const int aoff = lds_byte(wr * 64 + fr, fq * 8), boff = lds_byte(wc * 32 + fr, fq * 8);
#define PG8_SA(b, h) (((b) * 2 + (h)) * HTB)
#define PG8_SB(b, h) ((4 + (b) * 2 + (h)) * HTB)
#define PG8_STAGE(bufoff, gbase, voff) do { _Pragma("unroll") for (int _i = 0; _i < 2; ++_i) \
        __builtin_amdgcn_global_load_lds((const unsigned*)((const char*)(gbase) + (voff)[_i]), (LAS unsigned*)(lds + (bufoff) + ldsw + _i * 8192), 16, 0, 0); } while (0)
#define PG8_LD8(p) __builtin_shufflevector(*(const LAS i32x4*)(p), *(const LAS i32x4*)((p) + 1024), 0, 1, 2, 3, 4, 5, 6, 7)
#define PG8_LDA8(dst, b, h) do { _Pragma("unroll") for (int m = 0; m < 4; ++m) dst[m] = PG8_LD8(lds + PG8_SA(b, h) + aoff + m * 2048); } while (0)
#define PG8_LDB8(dst, b, h) do { _Pragma("unroll") for (int n = 0; n < 2; ++n) dst[n] = PG8_LD8(lds + PG8_SB(b, h) + boff + n * 2048); } while (0)
#define PG8_MMA8(ai, bj, A8, B8) do { __builtin_amdgcn_s_setprio(1); _Pragma("unroll") for (int m = 0; m < 4; ++m) _Pragma("unroll") for (int n = 0; n < 2; ++n) \
        asm volatile("v_mfma_f32_16x16x128_f8f6f4 %0, %1, %2, %0" : "+v"(acc[ai][bj][m][n]) : "v"(B8[n]), "v"(A8[m])); __builtin_amdgcn_s_setprio(0); } while (0)
#define PG8_LDA(dst, b, h) do { _Pragma("unroll") for (int m = 0; m < 4; ++m) _Pragma("unroll") for (int k = 0; k < 2; ++k) dst[m][k] = *(const LAS bf16x8*)(lds + PG8_SA(b, h) + aoff + m * 2048 + k * 1024); } while (0)
#define PG8_LDB(dst, b, h) do { _Pragma("unroll") for (int n = 0; n < 2; ++n) _Pragma("unroll") for (int k = 0; k < 2; ++k) dst[n][k] = *(const LAS bf16x8*)(lds + PG8_SB(b, h) + boff + n * 2048 + k * 1024); } while (0)
#define PG8_CAT(x) __builtin_shufflevector(__builtin_bit_cast(i32x4, (x)[0]), __builtin_bit_cast(i32x4, (x)[1]), 0, 1, 2, 3, 4, 5, 6, 7)
#define PG8_MMA(ai, bj, At, Bt) do { __builtin_amdgcn_s_setprio(1); _Pragma("unroll") for (int m = 0; m < 4; ++m) _Pragma("unroll") for (int n = 0; n < 2; ++n) _Pragma("unroll") for (int k = 0; k < 2; ++k) \
        acc[ai][bj][m][n] = __builtin_amdgcn_mfma_f32_16x16x32_bf16(Bt[n][k], At[m][k], acc[ai][bj][m][n], 0, 0, 0); __builtin_amdgcn_s_setprio(0); } while (0)
#define PG8_WAIT_V(n) asm volatile("s_waitcnt vmcnt(" #n ")" ::: "memory")
#define PG8_WAIT_L(n) asm volatile("s_waitcnt lgkmcnt(" #n ")" ::: "memory")
#define PG8_BAR __builtin_amdgcn_s_barrier()
#define PG8_SCHED __builtin_amdgcn_sched_barrier(0)
    Unit cur, nxt; int ui = 0;
    if (!S.next(0, cur)) return;
    f32x4 acc[2][2][4][2];
#pragma unroll
    for (int a = 0; a < 2; ++a)
#pragma unroll
        for (int b = 0; b < 2; ++b)
#pragma unroll
            for (int m = 0; m < 4; ++m)
#pragma unroll
                for (int n = 0; n < 2; ++n) acc[a][b][m][n] = (f32x4){0.f, 0.f, 0.f, 0.f};
    bf16x8 At[4][2], B0[2][2], B1[2][2]; i32x8 A8[4], B80[2], B81[2];
    const char* cA = cur.a; const char* cB = cur.b;
    PG8_STAGE(PG8_SB(0, 0), cB, voffB); PG8_STAGE(PG8_SB(0, 1), cB + hstepB, voffB); PG8_STAGE(PG8_SA(0, 0), cA, voffA); PG8_STAGE(PG8_SA(0, 1), cA + hstepA, voffA);
    if (wr == 1) PG8_BAR;
    PG8_WAIT_V(2); PG8_BAR;
    PG8_STAGE(PG8_SB(1, 0), cB + kstep, voffB); PG8_STAGE(PG8_SA(1, 0), cA + kstep, voffA); PG8_STAGE(PG8_SB(1, 1), cB + hstepB + kstep, voffB);
    PG8_WAIT_V(6); PG8_BAR;
    for (;;) {
        const bool has_next = S.next(ui + 1, nxt);
        const char* nA = has_next ? nxt.a : cA; const char* nB = has_next ? nxt.b : cB;
#pragma unroll 1
        for (int t = 0; t < nt; t += 2) {
            if constexpr (MIDK) { if (t == 8 || t == 16) { int fr_ = fr, fq_ = fq; asm volatile("" : "+v"(fr_), "+v"(fq_)); E.mid(acc, cur, t >> 4, wr, wc, fr_, fq_); } }
            const bool last = (t == nt - 2);
            const char* a1 = cA + (size_t)(t + 1) * kstep;
            const char* a2 = last ? nA : cA + (size_t)(t + 2) * kstep; const char* b2 = last ? nB : cB + (size_t)(t + 2) * kstep;
            const char* a3 = a2 + kstep; const char* b3 = b2 + kstep;
            if constexpr (F8) {
            PG8_LDB8(B80, 0, 0); PG8_LDB8(B81, 0, 1); PG8_SCHED; PG8_LDA8(A8, 0, 0); PG8_STAGE(PG8_SA(1, 1), a1 + hstepA, voffA);
            PG8_WAIT_V(8); PG8_WAIT_L(0); PG8_BAR; PG8_MMA8(0, 0, A8, B80); PG8_MMA8(0, 1, A8, B81); PG8_BAR; PG8_SCHED;
            PG8_LDA8(A8, 0, 1); PG8_STAGE(PG8_SB(0, 0), b2, voffB); PG8_STAGE(PG8_SB(0, 1), b2 + hstepB, voffB); PG8_STAGE(PG8_SA(0, 0), a2, voffA);
            PG8_WAIT_V(8); PG8_WAIT_L(0); PG8_BAR; PG8_MMA8(1, 0, A8, B80); PG8_MMA8(1, 1, A8, B81); PG8_BAR; PG8_SCHED;
            PG8_LDB8(B80, 1, 0); PG8_LDB8(B81, 1, 1); PG8_SCHED; PG8_LDA8(A8, 1, 0); PG8_STAGE(PG8_SA(0, 1), a2 + hstepA, voffA);
            PG8_WAIT_V(8); PG8_WAIT_L(0); PG8_BAR; PG8_MMA8(0, 0, A8, B80); PG8_MMA8(0, 1, A8, B81); PG8_BAR; PG8_SCHED;
            PG8_LDA8(A8, 1, 1); PG8_STAGE(PG8_SB(1, 0), b3, voffB); PG8_STAGE(PG8_SB(1, 1), b3 + hstepB, voffB); PG8_STAGE(PG8_SA(1, 0), a3, voffA);
            PG8_WAIT_V(8); PG8_WAIT_L(0); PG8_BAR; PG8_MMA8(1, 0, A8, B80); PG8_MMA8(1, 1, A8, B81); PG8_BAR; PG8_SCHED;
            } else {
            PG8_LDB(B0, 0, 0); PG8_LDB(B1, 0, 1); PG8_SCHED; PG8_LDA(At, 0, 0); PG8_STAGE(PG8_SA(1, 1), a1 + hstepA, voffA);
            PG8_WAIT_V(8); PG8_WAIT_L(0); PG8_BAR; PG8_MMA(0, 0, At, B0); PG8_MMA(0, 1, At, B1); PG8_BAR; PG8_SCHED;
            PG8_LDA(At, 0, 1); PG8_STAGE(PG8_SB(0, 0), b2, voffB); PG8_STAGE(PG8_SB(0, 1), b2 + hstepB, voffB); PG8_STAGE(PG8_SA(0, 0), a2, voffA);
            PG8_WAIT_V(8); PG8_WAIT_L(0); PG8_BAR; PG8_MMA(1, 0, At, B0); PG8_MMA(1, 1, At, B1); PG8_BAR; PG8_SCHED;
            PG8_LDB(B0, 1, 0); PG8_LDB(B1, 1, 1); PG8_SCHED; PG8_LDA(At, 1, 0); PG8_STAGE(PG8_SA(0, 1), a2 + hstepA, voffA);
            PG8_WAIT_V(8); PG8_WAIT_L(0); PG8_BAR; PG8_MMA(0, 0, At, B0); PG8_MMA(0, 1, At, B1); PG8_BAR; PG8_SCHED;
            PG8_LDA(At, 1, 1); PG8_STAGE(PG8_SB(1, 0), b3, voffB); PG8_STAGE(PG8_SB(1, 1), b3 + hstepB, voffB); PG8_STAGE(PG8_SA(1, 0), a3, voffA);
            PG8_WAIT_V(8); PG8_WAIT_L(0); PG8_BAR; PG8_MMA(1, 0, At, B0); PG8_MMA(1, 1, At, B1); PG8_BAR; PG8_SCHED;
            }
        }
        if (wr == 0) PG8_BAR;
        if constexpr (F8) asm volatile("s_nop 15\n\ts_nop 15" ::: "memory");
        { int fr_ = fr, fq_ = fq; asm volatile("" : "+v"(fr_), "+v"(fq_));
          E(acc, cur, wr, wc, fr_, fq_); }
        if (!has_next) break;
#pragma unroll
        for (int a = 0; a < 2; ++a)
#pragma unroll
            for (int b = 0; b < 2; ++b)
#pragma unroll
                for (int m = 0; m < 4; ++m)
#pragma unroll
                    for (int n = 0; n < 2; ++n) acc[a][b][m][n] = (f32x4){0.f, 0.f, 0.f, 0.f};
        cur = nxt; cA = nA; cB = nB; ++ui;
        if (wr == 1) PG8_BAR;
    }
    PG8_WAIT_V(0);
    PG8_BAR;
#undef PG8_SA
#undef PG8_SB
#undef PG8_STAGE
#undef PG8_LDA
#undef PG8_LDB
#undef PG8_MMA
#undef PG8_CAT
#undef PG8_LD8
#undef PG8_LDA8
#undef PG8_LDB8
#undef PG8_MMA8
#undef PG8_WAIT_V
#undef PG8_WAIT_L
#undef PG8_BAR
#undef PG8_SCHED
}
}

#define XB_TMO      128
#define XB_XCNT(j)  (256  + 64 * (j))
#define XB_XSUB(j)  (1280 + 64 * (j))
#define XB_XGEN(j)  (2304 + 64 * (j))
#define XB_TOP      3328
#define XB_TOPGEN   3392
#define XCD_BAR_WORDS 3456
#define XB_SPIN_CAP (1u << 22)
DI unsigned xb_ld(unsigned* p)              { return __hip_atomic_load(p, __ATOMIC_RELAXED, __HIP_MEMORY_SCOPE_AGENT); }
DI unsigned xb_add(unsigned* p, unsigned v) { return __hip_atomic_fetch_add(p, v, __ATOMIC_RELAXED, __HIP_MEMORY_SCOPE_AGENT); }
DI unsigned xb_xcc_id() { return (unsigned)__builtin_amdgcn_s_getreg((3 << 11) | 20) & 0xFu; }
#define XB_SPIN(cond, bar) do { unsigned _sp = 0; while (cond) { __builtin_amdgcn_s_sleep(1); \
    if ((++_sp & 255u) == 0u) { if (xb_ld(&(bar)[XB_TMO])) break; if (_sp > XB_SPIN_CAP) { atomicAdd(&(bar)[XB_TMO], 1u); break; } } } } while (0)
struct XcdBarrier { unsigned* bar; unsigned x; volatile LAS unsigned* st; };
DI XcdBarrier xcd_barrier_post(unsigned* bar, volatile LAS unsigned* st) {
    XcdBarrier b; b.bar = bar; b.x = xb_xcc_id(); b.st = st;
    if (threadIdx.x == 0) (void)xb_add(&bar[XB_XCNT(b.x)], 1u);
    return b;
}
DI void xcd_barrier_complete(unsigned* bar, unsigned x, unsigned& nloc, unsigned& nx) {
    const unsigned G = gridDim.x * gridDim.y * gridDim.z;
    unsigned sum, cnt, mine, sp = 0u;
    for (;;) {
        sum = 0u; cnt = 0u; mine = 0u;
#pragma unroll
        for (unsigned j = 0; j < 16; ++j) { const unsigned c = xb_ld(&bar[XB_XCNT(j)]); sum += c; cnt += (c > 0u) ? 1u : 0u; mine = (j == x) ? c : mine; }
        if (sum == G) break;
        __builtin_amdgcn_s_sleep(1);
        if ((++sp & 255u) == 0u) { if (xb_ld(&bar[XB_TMO])) break; if (sp > XB_SPIN_CAP) { atomicAdd(&bar[XB_TMO], 1u); break; } }
    }
    nloc = mine > 0u ? mine : 1u; nx = cnt > 0u ? cnt : 1u;
}
DI void xcd_barrier(const XcdBarrier& b) {
    asm volatile("s_waitcnt vmcnt(0)" ::: "memory");
    __syncthreads();
    if (threadIdx.x == 0) {
        unsigned* bar = b.bar;
        __builtin_amdgcn_s_waitcnt(0);
        unsigned nloc = b.st[0], nx = b.st[1];
        if (nloc == 0u) { xcd_barrier_complete(bar, b.x, nloc, nx); b.st[0] = nloc; b.st[1] = nx; }
        const unsigned old = xb_add(&bar[XB_XSUB(b.x)], 1u);
        const unsigned gen = old / nloc;
        if (old + 1u == (gen + 1u) * nloc) {
            __builtin_amdgcn_fence(__ATOMIC_RELEASE, "agent");
            asm volatile("s_waitcnt vmcnt(0)" ::: "memory");
            const unsigned og = xb_add(&bar[XB_TOP], 1u);
            const unsigned tg = og / nx;
            if (og + 1u == (tg + 1u) * nx) xb_add(&bar[XB_TOPGEN], 1u);
            else XB_SPIN(xb_ld(&bar[XB_TOPGEN]) == tg, bar);
            __builtin_amdgcn_fence(__ATOMIC_ACQUIRE, "agent");
            xb_add(&bar[XB_XGEN(b.x)], 1u);
            asm volatile("s_waitcnt vmcnt(0)" ::: "memory");
        } else {
            XB_SPIN(xb_ld(&bar[XB_XGEN(b.x)]) == gen, bar);
            __builtin_amdgcn_fence(__ATOMIC_ACQUIRE, "agent");
            asm volatile("s_waitcnt vmcnt(0)" ::: "memory");
        }
    }
    __syncthreads();
}

DI void transpose_item(const float* W, int ldw, bf16* WT, int ldt, LAS float* scr, int lane) {
    { const int kr = lane >> 3, c4 = (lane & 7) * 4; f32x4 v[8];
#pragma unroll
        for (int i = 0; i < 8; ++i) v[i] = *(const f32x4*)(W + (size_t)(8 * i + kr) * ldw + c4);
#pragma unroll
        for (int i = 0; i < 8; ++i) { LAS float* o = scr + (8 * i + kr) * 33 + c4; o[0] = v[i].x; o[1] = v[i].y; o[2] = v[i].z; o[3] = v[i].w; } }
    LDS_WAIT(); asm volatile("" ::: "memory");
    const int c = lane & 7;
#pragma unroll
    for (int j = 0; j < 4; ++j) { const int n = (lane >> 3) + 8 * j; const LAS float* s = scr + (8 * c) * 33 + n;
        u32x4 o; o.x = pk2(s[0 * 33], s[1 * 33]); o.y = pk2(s[2 * 33], s[3 * 33]); o.z = pk2(s[4 * 33], s[5 * 33]); o.w = pk2(s[6 * 33], s[7 * 33]);
        *(u32x4*)(WT + (size_t)n * ldt + 8 * c) = o; }
    LDS_WAIT(); asm volatile("" ::: "memory");
}
DI void transpose_item_f8(const float* W, int ldw, unsigned char* WT, int ldt, float scale, LAS float* scr, int lane) {
    { const int kr = lane >> 3, c4 = (lane & 7) * 4; f32x4 v[8];
#pragma unroll
        for (int i = 0; i < 8; ++i) v[i] = *(const f32x4*)(W + (size_t)(8 * i + kr) * ldw + c4);
#pragma unroll
        for (int i = 0; i < 8; ++i) { LAS float* o = scr + (8 * i + kr) * 33 + c4; o[0] = v[i].x; o[1] = v[i].y; o[2] = v[i].z; o[3] = v[i].w; } }
    LDS_WAIT(); asm volatile("" ::: "memory");
    const int c = lane & 3;
#pragma unroll
    for (int j = 0; j < 2; ++j) { const int n = (lane >> 2) + 16 * j; const LAS float* s = scr + (16 * c) * 33 + n;
        u32x4 o; o.x = pk4_f8(s[0 * 33] * scale, s[1 * 33] * scale, s[2 * 33] * scale, s[3 * 33] * scale); o.y = pk4_f8(s[4 * 33] * scale, s[5 * 33] * scale, s[6 * 33] * scale, s[7 * 33] * scale);
        o.z = pk4_f8(s[8 * 33] * scale, s[9 * 33] * scale, s[10 * 33] * scale, s[11 * 33] * scale); o.w = pk4_f8(s[12 * 33] * scale, s[13 * 33] * scale, s[14 * 33] * scale, s[15 * 33] * scale);
        *(u32x4*)(WT + (size_t)n * ldt + 16 * c) = o; }
    LDS_WAIT(); asm volatile("" ::: "memory");
}
DI void ti_load(const float* W, int ldw, int lane, f32x4 (&v)[8]) {
    const int kr = lane >> 3, c4 = (lane & 7) * 4;
#pragma unroll
    for (int i = 0; i < 8; ++i) v[i] = *(const f32x4*)(W + (size_t)(8 * i + kr) * ldw + c4);
}
DI void ti_store_f8(const f32x4 (&v)[8], unsigned char* WT, int ldt, float scale, LAS float* scr, int lane) {
    { const int kr = lane >> 3, c4 = (lane & 7) * 4;
#pragma unroll
        for (int i = 0; i < 8; ++i) { LAS float* o = scr + (8 * i + kr) * 33 + c4; o[0] = v[i].x; o[1] = v[i].y; o[2] = v[i].z; o[3] = v[i].w; } }
    LDS_WAIT(); asm volatile("" ::: "memory");
    const int c = lane & 3;
#pragma unroll
    for (int j = 0; j < 2; ++j) { const int n = (lane >> 2) + 16 * j; const LAS float* s = scr + (16 * c) * 33 + n;
        u32x4 o; o.x = pk4_f8(s[0 * 33] * scale, s[1 * 33] * scale, s[2 * 33] * scale, s[3 * 33] * scale); o.y = pk4_f8(s[4 * 33] * scale, s[5 * 33] * scale, s[6 * 33] * scale, s[7 * 33] * scale);
        o.z = pk4_f8(s[8 * 33] * scale, s[9 * 33] * scale, s[10 * 33] * scale, s[11 * 33] * scale); o.w = pk4_f8(s[12 * 33] * scale, s[13 * 33] * scale, s[14 * 33] * scale, s[15 * 33] * scale);
        *(u32x4*)(WT + (size_t)n * ldt + 16 * c) = o; }
    LDS_WAIT(); asm volatile("" ::: "memory");
}
DI void ti_load4(const float* W, int ldw, int lane, f32x4 (&v)[8]) {
    const int a = lane & 15, g = lane >> 4;
#pragma unroll
    for (int b = 0; b < 2; ++b)
#pragma unroll
        for (int j = 0; j < 4; ++j) v[4 * b + j] = *(const f32x4*)(W + (size_t)(4 * a + j) * ldw + 4 * (g + 4 * b));
}
DI void ti_store4_f8(const f32x4 (&v)[8], unsigned char* WT, int ldt, float scale, int lane) {
    const int a = lane & 15, g = lane >> 4;
#pragma unroll
    for (int b = 0; b < 2; ++b)
#pragma unroll
        for (int q = 0; q < 4; ++q)
            *(unsigned*)(WT + (size_t)(4 * (g + 4 * b) + q) * ldt + 4 * a) = pk4_f8(v[4 * b][q] * scale, v[4 * b + 1][q] * scale, v[4 * b + 2][q] * scale, v[4 * b + 3][q] * scale);
}
DI void ln16(f32x4 (&v)[4], const f32x4 (&g)[4], const f32x4 (&b)[4]) {
    float s = 0.f;
#pragma unroll
    for (int j = 0; j < 4; ++j) s += (v[j].x + v[j].y) + (v[j].z + v[j].w);
    const float mean = wave_sum(s) * (1.f / D); float s2 = 0.f;
#pragma unroll
    for (int j = 0; j < 4; ++j) { v[j] = v[j] - mean; s2 += (v[j].x * v[j].x + v[j].y * v[j].y) + (v[j].z * v[j].z + v[j].w * v[j].w); }
    const float rstd = 1.f / sqrtf(wave_sum(s2) * (1.f / D) + LN_EPS);
#pragma unroll
    for (int j = 0; j < 4; ++j) v[j] = v[j] * rstd * g[j] + b[j];
}
DI void gates8(const f32x4 (&y)[4], const LAS float* wgt, float* gif_row, int lane) {
    float p[8];
#pragma unroll
    for (int j = 0; j < 8; ++j) { float s = 0.f;
#pragma unroll
        for (int jj = 0; jj < 4; ++jj) { const f32x4 w = *(const LAS f32x4*)(wgt + j * 1024 + 256 * jj + 4 * lane); s += (y[jj].x * w.x + y[jj].y * w.y) + (y[jj].z * w.z + y[jj].w * w.w); }
        p[j] = wave_sum(s); }
    if (lane == 0) { *(f32x4*)gif_row = (f32x4){p[0], p[1], p[2], p[3]}; *(f32x4*)(gif_row + 4) = (f32x4){p[4], p[5], p[6], p[7]}; }
}
DI void gates8b(const f32x4 (&y)[4], const LAS float* wgt, float* gif_row, int lane) {
    float p[8];
#pragma unroll
    for (int j = 0; j < 8; ++j) { float s = 0.f;
#pragma unroll
        for (int jj = 0; jj < 4; ++jj) { const f32x4 w = *(const LAS f32x4*)(wgt + j * 1024 + (jj >> 1) * 512 + 8 * lane + (jj & 1) * 4); s += (y[jj].x * w.x + y[jj].y * w.y) + (y[jj].z * w.z + y[jj].w * w.w); }
        p[j] = wave_sum(s); }
    if (lane == 0) { *(f32x4*)gif_row = (f32x4){p[0], p[1], p[2], p[3]}; *(f32x4*)(gif_row + 4) = (f32x4){p[4], p[5], p[6], p[7]}; }
}
DI void load_gate_table(LAS float* wgt, const float* win_l, int tid) {
    for (int i = tid; i < 8192; i += NTHR) { const int k = i >> 3, j = i & 7; wgt[j * 1024 + k] = win_l[(size_t)k * DIN + 1536 + j]; }
}
DI f32x4 ld4bf(const char* p) { const u32x2 w = *(const u32x2*)p; return (f32x4){bflo(w.x), bfhi(w.x), bflo(w.y), bfhi(w.y)}; }
DI void st4bf(char* p, const f32x4& v) { u32x2 w; w.x = pk2(v.x, v.y); w.y = pk2(v.z, v.w); *(u32x2*)p = w; }

struct Args { const float* in[N_IN]; float* out; unsigned char* ws; int ph_lo, ph_hi; };
constexpr int NP_LAYER = 12, NPH = 1 + DEPTH * NP_LAYER;
constexpr int XW_SPLIT = 49152;

struct SchedInproj {
    pg8::TileOrder T; int G, c; const char *X, *W; char* U; bool kv; const char *MEMN, *WKV; char* KV;
    DI bool next(int i, pg8::Unit& u) const {
        const long L = (long)i * G + c; int pm, pn;
        if (T.tile(L, pm, pn)) { u.a = X + (size_t)pm * 256 * D * 2; u.b = W + (size_t)pn * 256 * D * 2; u.r0 = pm * 256; u.c0 = pn * 256; u.c = U + ((size_t)u.r0 * NU + u.c0) * 2; u.ldc = NU; u.e = 0; u.sub = 0; return true; }
        if (!kv) return false;
        const long L2 = L - T.nwg; if (L2 < 0 || L2 >= 128) return false;
        const int l = (int)L2 >> 6, t = (int)L2 & 63; pm = t >> 2; pn = t & 3;
        u.a = MEMN + (size_t)pm * 256 * D * 2; u.b = WKV + ((size_t)l * 1024 + pn * 256) * D * 2; u.r0 = pm * 256; u.c0 = pn * 256; u.c = KV + (((size_t)l * MROWS + u.r0) * D + u.c0) * 2; u.ldc = D; u.e = 0; u.sub = 0; return true;
    }
};
struct SchedPlain {
    pg8::TileOrder T; int G, c; const char *A, *B; char* C; int lda, ldb, ldc;
    DI bool next(int i, pg8::Unit& u) const {
        const long L = (long)i * G + c; int pm, pn; if (!T.tile(L, pm, pn)) return false;
        u.a = A + (size_t)pm * 256 * lda * 2; u.b = B + (size_t)pn * 256 * ldb * 2; u.r0 = pm * 256; u.c0 = pn * 256; u.c = C + ((size_t)u.r0 * ldc + u.c0) * 2; u.ldc = ldc; u.e = 0; u.sub = 0; return true;
    }
};
struct SchedMerge {
    pg8::TileOrder T; int G, c; const char *H, *W; char* Y;
    DI bool next(int i, pg8::Unit& u) const {
        const int ti = i / 3, br = i - 3 * ti; const long L = (long)ti * G + c; int pm, pn; if (!T.tile(L, pm, pn)) return false;
        u.a = H + ((size_t)pm * 256 * 1536 + br * 512) * 2; u.b = W + ((size_t)br * 1024 + pn * 256) * 512 * 2; u.r0 = pm * 256; u.c0 = pn * 256; u.c = Y + ((size_t)u.r0 * D + u.c0) * 2; u.ldc = D; u.e = 0; u.sub = br; return true;
    }
};
struct SchedMoe {
    pg8::TileOrder T; int G, c; const char *A, *W; char* C; const LAS int* PB; int wrows  , ldc, cdiv, osz;
    DI bool next(int i, pg8::Unit& u) const {
        const long L = (long)i * G + c; int pm, pn; if (!T.tile(L, pm, pn)) return false;
        int e = 0;
#pragma unroll 1
        for (int j = 1; j < NEXP; ++j) e += (PB[j] <= pm) ? 1 : 0;
        u.a = A + (size_t)pm * 256 * 1024; u.b = W + ((size_t)e * wrows + pn * 256) * 1024; u.r0 = pm * 256; u.c0 = pn * 256; u.c = C + ((size_t)u.r0 * ldc + u.c0 / cdiv) * osz; u.ldc = ldc; u.e = e; u.sub = 0; return true;
    }
};

__global__ void __launch_bounds__(NTHR, 2) fwd_kernel(Args args) {
    extern __shared__ __attribute__((aligned(16))) unsigned char lds_raw[];
#define INP(i) ([&]() -> const float* { int ii_ = (i); asm volatile("" : "+s"(ii_)); return args.in[ii_]; }())
    LAS unsigned char* lds = (LAS unsigned char*)lds_raw;
    volatile LAS unsigned* LCTL = (volatile LAS unsigned*)(lds + LDSCTL_OFF);
    const int tid0 = threadIdx.x, wave = __builtin_amdgcn_readfirstlane(tid0 >> 6);
#define PHASE_TID unsigned z_ = 0u; asm volatile("" : "+v"(z_)); int tid = wave * 64 + (int)__builtin_amdgcn_mbcnt_hi(~0u, __builtin_amdgcn_mbcnt_lo(~0u, z_)); const int lane = tid & 63; (void)lane;
    const int G = gridDim.x, bx = blockIdx.x;
    const int gw = bx * NWAVES + wave, NGW = G * NWAVES;
    unsigned char* ws = args.ws;
    gu32* ctl = (gu32*)(ws + WS_CTL);
    for (int u = tid0; u < (LDS_BYTES - LDSCTL_OFF) / 4; u += NTHR) ((LAS unsigned*)(lds + LDSCTL_OFF))[u] = 0u;
    __syncthreads();
    XcdBarrier bar; bar.bar = (unsigned*)ctl + CW_BAR; bar.x = 0; bar.st = nullptr;
    if (MK_ONE_LAUNCH) bar = xcd_barrier_post((unsigned*)ctl + CW_BAR, LCTL);
    const int lo = args.ph_lo, hi = args.ph_hi;
#ifndef SUBMASK
#define SUBMASK 7
#endif
#ifndef LN2PROBE
#define LN2PROBE 0
#endif
#ifndef SUBDUP
#define SUBDUP 0
#endif
#define NSUB(k) ((((SUBDUP) >> (k)) & 1) ? 2 : 1)
#ifndef DUPMASK
#define DUPMASK 0
#endif
#define NREP(k) ((((DUPMASK) >> (k)) & 1) ? 2 : 1)
#ifndef PHMASK
#define PHMASK 0xFFFF
#endif
#define IN(k) (lo <= (k) && (k) < hi)
#define SEAM(k) do { if (IN(k) && IN((k) + 1)) xcd_barrier(bar); } while (0)

    char* const Xb = (char*)(ws + WS_X);
    char* const Ub = (char*)(ws + WS_R1);
    float* const GIF = (float*)(ws + WS_GIF);
    LAS int* const PB = (LAS int*)(lds + LDSCTL_OFF + 64);
    LAS int* const CNT = (LAS int*)(lds + LDSCTL_OFF + 256);

    _Pragma("unroll 1") for (int rep_ = 0; rep_ < NREP(12); ++rep_) if (((PHMASK>>12)&1) && IN(0)) { PHASE_TID
        LAS float* scr = (LAS float*)(lds + wave * 8448);
        LAS float* wgt = (LAS float*)(lds + 73728);
        load_gate_table(wgt, INP(I_WIN), tid);
        constexpr int IT_IN = 16 * 216, IT_KV = 16 * 32, IT_BR = 8 * 32, IT_O = 16 * 32, IT_L = IT_IN + IT_KV + 3 * IT_BR + IT_O;
        for (int it = gw; it < DEPTH * IT_L; it += NGW) {
            const int l = it / IT_L; int r = it - l * IT_L;
            if (r < IT_IN) { const int kb = r / 216, nb = r % 216, n0 = 32 * nb, sc = ucol_src(n0);
                if (n0 < UC_F8) transpose_item(INP(I_WIN) + ((size_t)l * D + 64 * kb) * DIN + sc, DIN, (bf16*)(ws + WS_WIN) + ((size_t)l * NU + n0) * D + 64 * kb, D, scr, lane);
                else transpose_item_f8(INP(I_WIN) + ((size_t)l * D + 64 * kb) * DIN + sc, DIN, (unsigned char*)(ws + WS_WING8) + ((size_t)l * NF8 + (n0 - UC_F8)) * D + 64 * kb, D, F8_SWGU, scr, lane);
                continue; }
            r -= IT_IN;
            if (r < IT_KV) { const int kb = r / 32, nb = r % 32;
                transpose_item(INP(I_CAWKV) + ((size_t)l * D + 64 * kb) * 1024 + 32 * nb, 1024, (bf16*)(ws + WS_WKV) + ((size_t)l * 1024 + 32 * nb) * D + 64 * kb, D, scr, lane); continue; }
            r -= IT_KV;
            if (r < 3 * IT_BR) { const int br = r / IT_BR, q = r % IT_BR, kb = q / 32, nb = q % 32;
                const float* src = INP(br == 0 ? I_WBRML : (br == 1 ? I_WBRRW : I_WBRCA));
                transpose_item(src + ((size_t)l * 512 + 64 * kb) * 1024 + 32 * nb, 1024, (bf16*)(ws + WS_WBR) + ((size_t)l * 1024 + 32 * nb) * 1536 + br * 512 + 64 * kb, 1536, scr, lane); continue; }
            r -= 3 * IT_BR;
            { const int kb = r / 32, nb = r % 32;
                transpose_item(INP(I_WO) + ((size_t)l * D + 64 * kb) * 1024 + 32 * nb, 1024, (bf16*)(ws + WS_WO) + ((size_t)l * 1024 + 32 * nb) * D + 64 * kb, D, scr, lane); }
        }
        for (int i = bx * NTHR + tid; i < DEPTH * 1536 * 256; i += G * NTHR) {
            const int l = i / (1536 * 256), r = i % (1536 * 256), n = r >> 8, k = r & 255; float v = 0.f;
            if (n < 512) { if (k < 64) v = INP(I_RWWUP)[((size_t)l * 64 + k) * 512 + n]; }
            else if (n < 1024) { if (k >= 64 && k < 128) v = INP(I_RWAUP)[((size_t)l * 64 + (k - 64)) * 512 + (n - 512)]; }
            else { if (k >= 128) v = INP(I_RWGUP)[((size_t)l * 128 + (k - 128)) * 512 + (n - 1024)]; }
            ((bf16*)(ws + WS_WLORA))[i] = (bf16)f2bf(v);
        }
        __syncthreads();
        {
            f32x4 g[4], b[4];
#pragma unroll
            for (int j = 0; j < 4; ++j) { g[j] = *(const f32x4*)(INP(I_LNIN_G) + 256 * j + 4 * lane); b[j] = *(const f32x4*)(INP(I_LNIN_B) + 256 * j + 4 * lane); }
            for (int m = gw; m < M; m += NGW) {
                f32x4 v[4]; const float* xr = INP(I_X) + (size_t)m * D;
#pragma unroll
                for (int j = 0; j < 4; ++j) v[j] = *(const f32x4*)(xr + 256 * j + 4 * lane);
                ln16(v, g, b);
#pragma unroll
                for (int j = 0; j < 4; ++j) { st4bf(Xb + ((size_t)m * D + 256 * j + 4 * lane) * 2, v[j]); *(unsigned*)((char*)(ws + WS_XF8) + (size_t)m * D + 256 * j + 4 * lane) = pk4_f8(v[j].x * F8_SX, v[j].y * F8_SX, v[j].z * F8_SX, v[j].w * F8_SX); }
                gates8(v, wgt, GIF + (size_t)m * 8, lane);
            }
#pragma unroll
            for (int j = 0; j < 4; ++j) { g[j] = *(const f32x4*)(INP(I_MEMLN_G) + 256 * j + 4 * lane); b[j] = *(const f32x4*)(INP(I_MEMLN_B) + 256 * j + 4 * lane); }
            for (int m = gw; m < MROWS; m += NGW) {
                f32x4 v[4]; const float* xr = INP(I_MEM) + (size_t)m * D;
#pragma unroll
                for (int j = 0; j < 4; ++j) v[j] = *(const f32x4*)(xr + 256 * j + 4 * lane);
                ln16(v, g, b);
#pragma unroll
                for (int j = 0; j < 4; ++j) st4bf((char*)(ws + WS_MEMN) + ((size_t)m * D + 256 * j + 4 * lane) * 2, v[j]);
            }
        }
        __syncthreads();
    }
    SEAM(0);

#pragma unroll 1
    for (int l = 0; l < DEPTH; ++l) {
        const int pb = 1 + l * NP_LAYER;
        _Pragma("unroll 1") for (int rep_ = 0; rep_ < NREP(0); ++rep_) if (((PHMASK>>0)&1) && IN(pb + 0)) {
            SchedInproj S; S.T.init(M / 256, UC_F8 / 256); S.G = G; S.c = bx; S.X = Xb; S.W = (const char*)(ws + WS_WIN) + (size_t)l * NU * D * 2; S.U = Ub;
            S.kv = (l == 0); S.MEMN = (const char*)(ws + WS_MEMN); S.WKV = (const char*)(ws + WS_WKV); S.KV = (char*)(ws + WS_KV);
            pg8::EpiStore E;
            pg8::gemm_phase<false>(lds, D * 2, D * 2, D * 2, S, E, wave);
            SchedPlain S8; S8.T.init(M / 256, NF8 / 256); S8.G = G; S8.c = bx; S8.A = (const char*)(ws + WS_XF8); S8.B = (const char*)(ws + WS_WING8) + (size_t)l * NF8 * D; S8.C = Ub + UC_F8 * 2;
            S8.lda = 512; S8.ldb = 512; S8.ldc = NU;
            pg8::EpiStoreS E8; E8.s = F8_INV1; E8.gate_b = INP(I_GATEB) + (size_t)l * 3072; E8.gate_c0 = UC_GATE - UC_F8;
            pg8::gemm_phase<true>(lds, D, D, D, S8, E8, wave);
        }
        SEAM(pb + 0);
        _Pragma("unroll 1") for (int rep_ = 0; rep_ < NREP(1); ++rep_) if (((PHMASK>>1)&1) && IN(pb + 1)) { PHASE_TID
            const float* mu = INP(I_RWMU) + (size_t)l * 1792 + 1536;
            char* LIN = (char*)(ws + WS_R2 + R2_LORA_IN);
            for (int it = bx * NTHR + tid; it < M * 32; it += G * NTHR) {
                const int row = it >> 5, c = (it & 31) * 8;
                const u32x4 cw = *(const u32x4*)(Ub + ((size_t)row * NU + UC_RW + 1536 + c) * 2);
                u32x4 pw = (u32x4){0u, 0u, 0u, 0u};
                if ((row & (SEQ - 1)) != 0) pw = *(const u32x4*)(Ub + ((size_t)(row - 1) * NU + UC_RW + 1536 + c) * 2);
                const f32x4 m0 = *(const f32x4*)(mu + c), m1 = *(const f32x4*)(mu + c + 4);
                float x[8] = {bflo(cw.x), bfhi(cw.x), bflo(cw.y), bfhi(cw.y), bflo(cw.z), bfhi(cw.z), bflo(cw.w), bfhi(cw.w)};
                const float p[8] = {bflo(pw.x), bfhi(pw.x), bflo(pw.y), bfhi(pw.y), bflo(pw.z), bfhi(pw.z), bflo(pw.w), bfhi(pw.w)};
                const float mm[8] = {m0.x, m0.y, m0.z, m0.w, m1.x, m1.y, m1.z, m1.w};
#pragma unroll
                for (int i = 0; i < 8; ++i) { float xs = x[i] + (p[i] - x[i]) * mm[i];
                    if (c < 64) xs = 1.f - 2.f * __builtin_amdgcn_rcpf(1.f + __builtin_amdgcn_exp2f(2.8853900817779268f * xs));
                    else if (c >= 128) xs = sigmoidf_(xs);
                    x[i] = xs; }
                u32x4 o; o.x = pk2(x[0], x[1]); o.y = pk2(x[2], x[3]); o.z = pk2(x[4], x[5]); o.w = pk2(x[6], x[7]);
                *(u32x4*)(LIN + ((size_t)row * 256 + c) * 2) = o;
            }
        }
        SEAM(pb + 1);
        _Pragma("unroll 1") for (int rep_ = 0; rep_ < NREP(2); ++rep_) if (((PHMASK>>2)&1) && IN(pb + 2)) {
            SchedPlain S; S.T.init(M / 256, 6); S.G = G; S.c = bx; S.A = (const char*)(ws + WS_R2 + R2_LORA_IN); S.B = (const char*)(ws + WS_WLORA) + (size_t)l * 1536 * 256 * 2; S.C = (char*)(ws + WS_R2 + R2_LORA_OUT);
            S.lda = 256; S.ldb = 256; S.ldc = 1536;
            pg8::EpiStore E;
            pg8::gemm_phase<false>(lds, 512, 512, 512, S, E, wave);
        }
        SEAM(pb + 2);
        _Pragma("unroll 1") for (int rep_ = 0; rep_ < NREP(3); ++rep_) if (((PHMASK>>3)&1) && IN(pb + 3)) { PHASE_TID
            const char* LO = (const char*)(ws + WS_R2 + R2_LORA_OUT);
            char* HC = (char*)(ws + WS_R2 + R2_HCAT);
            const int tid_ph = tid;
#define SUB_TID unsigned zs_ = 0u; asm volatile("" : "+v"(zs_)); int tid = wave * 64 + (int)__builtin_amdgcn_mbcnt_hi(~0u, __builtin_amdgcn_mbcnt_lo(~0u, zs_)); const int lane = tid & 63; (void)lane;
#pragma unroll 1
            for (int job = bx; job < 256; job += G) {
                if (job < 128) { _Pragma("unroll 1") for (int sr_ = 0; sr_ < NSUB(0); ++sr_) if ((SUBMASK>>0)&1) {
                    SUB_TID
                    const int b = job >> 3, h = job & 7;
                    constexpr int TC = 32, PT = 144, P16 = 48, IMG = 25856;
                    LAS float* OPS = (LAS float*)lds;
                    LAS float* OUTB = OPS + TC * 384;
                    LAS float* BON = OUTB + TC * 64;
                    LAS unsigned char* IM0 = lds + 57600;
                    LAS float* VEP = (LAS float*)(lds + 109312);
                    LAS unsigned char* GKB = (LAS unsigned char*)(VEP + 2 * TC * 64);
                    LAS float* PARF = (LAS float*)(lds + 142080);
                    const int pt = tid >> 4, cs = tid & 15, pc = cs * 4, hc = h * 64 + pc;
                    const int p1t = (tid >> 3) & 31, c8 = (tid & 7) * 8, hc8 = h * 64 + c8;
                    const int r31 = lane & 31, h2 = lane >> 5;
                    f32x16 Sreg[2];
#pragma unroll
                    for (int i = 0; i < 16; ++i) { Sreg[0][i] = 0.f; Sreg[1][i] = 0.f; }
#pragma unroll 1
                    for (int a = wave; a < 10; a += 8) {
                        const int ii = (a < 3) ? I_RWMU : (a == 3) ? I_RWW0 : (a == 4) ? I_RWA0 : (a == 5) ? I_RWKK : (a == 6) ? I_RWKA : (a == 7) ? I_RWRK : (a == 8) ? I_RWLNG : I_RWLNB;
                        const size_t po = (a < 3) ? ((size_t)l * 1792 + a * 512) : (size_t)l * 512;
                        PARF[a * 64 + lane] = (INP(ii) + po)[h * 64 + lane];
                    }
#define SETPU(j, q_) do { const u32x4 q__ = (q_); Sreg[(j) >> 2][((j) & 3) * 4] = u2f_(q__.x); Sreg[(j) >> 2][((j) & 3) * 4 + 1] = u2f_(q__.y); \
                          Sreg[(j) >> 2][((j) & 3) * 4 + 2] = u2f_(q__.z); Sreg[(j) >> 2][((j) & 3) * 4 + 3] = u2f_(q__.w); } while (0)
#define PUW(j, c) f2u_(Pc[(j) >> 2][((j) & 3) * 4 + (c)])
#define PUWS(j, c) f2u_(Sreg[(j) >> 2][((j) & 3) * 4 + (c)])
#define UNPJ(j, hh) ((f32x4){bflo(PUW(j, 2 * (hh))), bfhi(PUW(j, 2 * (hh))), bflo(PUW(j, 2 * (hh) + 1)), bfhi(PUW(j, 2 * (hh) + 1))})
#define UNPH(q_, hh) ((hh) ? (f32x4){bflo((q_).z), bfhi((q_).z), bflo((q_).w), bfhi((q_).w)} : (f32x4){bflo((q_).x), bfhi((q_).x), bflo((q_).y), bfhi((q_).y)})
                    auto LOADC = [&](int t0) {
                        const int t = t0 + p1t; const size_t row = (size_t)b * SEQ + t; const char* up = Ub + (row * NU + UC_RW + hc8) * 2;
                        SETPU(0, *(const u32x4*)up); SETPU(1, *(const u32x4*)(up + 1024)); SETPU(2, *(const u32x4*)(up + 2048));
                        if (t > 0) { const char* pp = up - (size_t)NU * 2; SETPU(3, *(const u32x4*)pp); SETPU(4, *(const u32x4*)(pp + 1024)); SETPU(5, *(const u32x4*)(pp + 2048)); }
                        else { const u32x4 z4 = (u32x4){0u, 0u, 0u, 0u}; SETPU(3, z4); SETPU(4, z4); SETPU(5, z4); }
                        const char* lp = LO + (row * 1536 + hc8) * 2; SETPU(6, *(const u32x4*)lp); SETPU(7, *(const u32x4*)(lp + 1024));
                    };
                    const int gq = tid - 128, gt = (gq >> 2) & 31, gp = (gq & 3) * 16;
                    auto LOADG = [&](int t0) {
                        const char* gp_ = LO + (((size_t)b * SEQ + t0 + gt) * 1536 + 1024 + h * 64 + gp) * 2;
                        SETPU(0, *(const u32x4*)gp_); SETPU(1, *(const u32x4*)(gp_ + 16));
                    };
                    auto PASS1 = [&](int t1, int par1, bool more) {
                        int hcv = hc8; asm volatile("" : "+v"(hcv));
                        const f32x16 Pc[2] = {Sreg[0], Sreg[1]};
                        if (more) LOADC(t1 + TC);
                        const LAS float* MU = PARF + c8;
                        const LAS float* W0 = PARF + 192 + c8; const LAS float* A0 = PARF + 256 + c8; const LAS float* KKW = PARF + 320 + c8;
                        const LAS float* KAW = PARF + 384 + c8; const LAS float* RKW = PARF + 448 + c8;
                        f32x4 dec[2], av[2], kkv[2], kp[2], xr[2], xv[2]; float ss = 0.f, bsum = 0.f;
#pragma unroll
                        for (int hh = 0; hh < 2; ++hh) {
                            const f32x4 mu_r = *(const LAS f32x4*)(MU + 4 * hh), mu_k = *(const LAS f32x4*)(MU + 64 + 4 * hh), mu_v = *(const LAS f32x4*)(MU + 128 + 4 * hh);
                            const f32x4 w0 = *(const LAS f32x4*)(W0 + 4 * hh), a0 = *(const LAS f32x4*)(A0 + 4 * hh), kkw = *(const LAS f32x4*)(KKW + 4 * hh), kaw = *(const LAS f32x4*)(KAW + 4 * hh), rkw = *(const LAS f32x4*)(RKW + 4 * hh);
                            const f32x4 ur = UNPJ(0, hh), uk = UNPJ(1, hh), uv = UNPJ(2, hh), urp = UNPJ(3, hh), ukp = UNPJ(4, hh), uvp = UNPJ(5, hh), lw = UNPJ(6, hh), la = UNPJ(7, hh);
                            xr[hh] = ur + (urp - ur) * mu_r; const f32x4 xk = uk + (ukp - uk) * mu_k; xv[hh] = uv + (uvp - uv) * mu_v;
#pragma unroll
                            for (int i = 0; i < 4; ++i) {
                                const float y = -(w0[i] + lw[i]);
                                const float sp = fmaxf(y, 0.f) + __logf(1.f + __expf(-fabsf(y)));
                                dec[hh][i] = __expf(-__expf(-sp - 0.5f));
                                av[hh][i] = sigmoidf_(a0[i] + la[i]);
                                kkv[hh][i] = xk[i] * kkw[i]; ss += kkv[hh][i] * kkv[hh][i];
                                kp[hh][i] = xk[i] * (1.f + (av[hh][i] - 1.f) * kaw[i]);
                                bsum += xr[hh][i] * kp[hh][i] * rkw[i];
                            }
                            __builtin_amdgcn_sched_barrier(0);
                        }
                        ss = red8(ss); bsum = red8(bsum);
                        const float inv = __builtin_amdgcn_rsqf(fmaxf(ss, 1e-24f));
#pragma unroll
                        for (int hh = 0; hh < 2; ++hh) {
                            const f32x4 kk = kkv[hh] * inv, kka = kk * av[hh];
                            LAS float* o = OPS + p1t * 384 + c8 + 4 * hh;
                            *(LAS f32x4*)(o) = dec[hh]; *(LAS f32x4*)(o + 64) = kk; *(LAS f32x4*)(o + 128) = kka; *(LAS f32x4*)(o + 192) = kp[hh]; *(LAS f32x4*)(o + 256) = xr[hh]; *(LAS f32x4*)(o + 320) = xv[hh];
                            *(LAS f32x4*)(VEP + par1 * 2048 + p1t * 64 + c8 + 4 * hh) = xv[hh];
                        }
                        if ((tid & 7) == 0) BON[par1 * 32 + p1t] = bsum;
                    };
#define UNP4(w) ((f32x4){bflo((w).x), bfhi((w).x), bflo((w).y), bfhi((w).y)})
#define DOT4(a, b) (((a).x * (b).x + (a).y * (b).y) + ((a).z * (b).z + (a).w * (b).w))
#define PACK8(x, s) __builtin_bit_cast(bf16x8, (u32x4){pk2((x)[8 * (s)], (x)[8 * (s) + 1]), pk2((x)[8 * (s) + 2], (x)[8 * (s) + 3]), pk2((x)[8 * (s) + 4], (x)[8 * (s) + 5]), pk2((x)[8 * (s) + 6], (x)[8 * (s) + 7])})
#define LD2x64(p) __builtin_bit_cast(bf16x8, (u32x4){(*(const LAS u32x2*)(p)).x, (*(const LAS u32x2*)(p)).y, (*(const LAS u32x2*)((p) + 16)).x, (*(const LAS u32x2*)((p) + 16)).y})
                    auto EPI = [&](int te, int pe) {
                        const int et = ((wave >> 2) * 2 + (wave & 1)) * 64 + lane, pce = (et & 15) * 4;
                        const f32x4 lng = *(const LAS f32x4*)(PARF + 512 + pce), lnb = *(const LAS f32x4*)(PARF + 576 + pce);
#pragma unroll
                        for (int it = 0; it < 2; ++it) {
                            const int pte = (et >> 4) + 16 * it;
                            const u32x2 gkw = *(const LAS u32x2*)(GKB + pe * 4096 + pte * 128 + pce * 2);
                            const f32x4 o4 = *(const LAS f32x4*)(OUTB + pte * 64 + pce), v4 = *(const LAS f32x4*)(VEP + pe * 2048 + pte * 64 + pce), gk = UNP4(gkw);
                            const float mean = red16((o4.x + o4.y) + (o4.z + o4.w)) * (1.f / 64.f);
                            const f32x4 dv = o4 - mean;
                            const float var = red16(DOT4(dv, dv)) * (1.f / 64.f);
                            const float rstd = __builtin_amdgcn_rsqf(var + RW_GN_EPS), bo = BON[pe * 32 + pte];
                            const f32x4 y = (dv * rstd * lng + lnb + v4 * bo) * gk;
                            st4bf(HC + (((size_t)b * SEQ + te + pte) * 1536 + 512 + h * 64 + pce) * 2, y);
                        }
                    };
                    if (wave >= 4) LOADC(0); else if (wave >= 2) LOADG(0);
#pragma unroll 1
                    for (int t0 = -TC; t0 < SEQ; t0 += TC) {
                        const int par = (t0 >> 5) & 1;
                        __syncthreads();
                        if (t0 >= 0)
                        {
                            const int sc = wave >> 2, wq = wave & 3;
                            LAS unsigned char* im = IM0 + sc * IMG;
                            LAS unsigned char* KR = im; LAS unsigned char* BGr = im + 4608; LAS unsigned char* VT = im + 15360;
                            LAS unsigned char* TT = im + 18432; LAS unsigned char* BB = im + 19968; LAS float* ZF = (LAS float*)(im + 21504); LAS float* PL = (LAS float*)(im + 25600);
                            {
                                float P = 1.f;
#pragma unroll
                                for (int t = 0; t < 12; ++t) { const float wv = OPS[(16 * sc + t) * 384 + lane]; P *= (t < 4 * wq) ? wv : 1.f; }
#pragma unroll
                                for (int q = 0; q < 4; ++q) { const int t = 4 * wq + q; const LAS float* o = OPS + (16 * sc + t) * 384 + lane;
                                    const float w = o[0], z = o[64], bb = o[128], kp = o[192], rr = o[256], vv = o[320];
                                    const float kap = z * P; P *= w; const float rho = rr * P, ip = __builtin_amdgcn_rcpf(P), bet = bb * ip, gam = kp * ip;
                                    *(LAS bf16*)(KR + t * PT + lane * 2) = (bf16)f2bf(kap); *(LAS bf16*)(KR + (16 + t) * PT + lane * 2) = (bf16)f2bf(rho);
                                    *(LAS bf16*)(BGr + t * PT + lane * 2) = (bf16)f2bf(bet); *(LAS bf16*)(BGr + (16 + t) * PT + lane * 2) = (bf16)f2bf(gam);
                                    *(LAS bf16*)(VT + t * PT + lane * 2) = (bf16)f2bf(vv); }
                                if (wq == 3) PL[lane] = P;
                            }
                            __syncthreads();
                            if (wq <= 1) {
                                f32x16 Z;
#pragma unroll
                                for (int i = 0; i < 16; ++i) Z[i] = 0.f;
#pragma unroll
                                for (int ks = 0; ks < 4; ++ks) Z = __builtin_amdgcn_mfma_f32_32x32x16_bf16(*(const LAS bf16x8*)(KR + r31 * PT + (16 * ks + 8 * h2) * 2), *(const LAS bf16x8*)(BGr + r31 * PT + (16 * ks + 8 * h2) * 2), Z, 0, 0, 0);
                                const int jj = (r31 & 15) - 4 * h2;
#pragma unroll
                                for (int i = 0; i < 16; ++i) { const int tb = (i & 3) + 8 * ((i >> 2) & 1); const bool keep = (i >= 8) ? (jj <= tb) : (jj < tb); Z[i] = keep ? Z[i] : 0.f; }
                              if (wq == 1) {
                                if (r31 >= 16) {
#pragma unroll
                                    for (int i = 0; i < 16; ++i) *(LAS bf16*)(BB + ((i & 3) + 8 * (i >> 2) + 4 * h2) * P16 + (r31 - 16) * 2) = (bf16)f2bf(Z[i]);
                                }
                              } else {
                                if (r31 < 16) {
#pragma unroll
                                    for (int i = 0; i < 16; ++i) ZF[((i & 3) + 8 * (i >> 2) + 4 * h2) * 32 + r31] = Z[i];
                                }
                                LDS_WAIT(); asm volatile("" ::: "memory");
                                const int c = lane & 15, g = lane >> 4; float x[16];
                                f32x4 R[16][4];
                                constexpr int TW = 5;
#pragma unroll
                                for (int t = 1; t <= TW; ++t)
#pragma unroll
                                    for (int k = 0; k < 4; ++k) if (4 * k < t) R[t][k] = *(const LAS f32x4*)(ZF + t * 32 + 4 * k);
                                __builtin_amdgcn_sched_barrier(0);
#pragma unroll
                                for (int t = 0; t < 16; ++t) {
                                    if (t >= 1 && t + TW < 16) {
#pragma unroll
                                        for (int k = 0; k < 4; ++k) if (4 * k < t + TW) R[t + TW][k] = *(const LAS f32x4*)(ZF + (t + TW) * 32 + 4 * k);
                                    }
                                    __builtin_amdgcn_sched_barrier(0);
                                    float s0 = 0.f, s1 = 0.f;
#pragma unroll
                                    for (int j = 0; j < t; ++j) { const float a = R[t][j >> 2][j & 3]; if (j & 1) s1 += a * x[j]; else s0 += a * x[j]; }
                                    x[t] = ((t == c) ? 1.f : 0.f) - (s0 + s1);
                                }
#pragma unroll
                                for (int j = 0; j < 16; ++j) *(LAS bf16*)(TT + j * P16 + c * 2) = (bf16)f2bf(-x[j]);
#pragma unroll
                                for (int qq = 0; qq < 4; qq += 2) {
                                    f32x4 a4[2][4];
#pragma unroll
                                    for (int q = 0; q < 2; ++q)
#pragma unroll
                                        for (int k = 0; k < 4; ++k) a4[q][k] = *(const LAS f32x4*)(ZF + (16 + 4 * g + qq + q) * 32 + 4 * k);
#pragma unroll
                                    for (int q = 0; q < 2; ++q) {
                                        const int tr = 4 * g + qq + q;
                                        float s0 = 0.f, s1 = 0.f;
#pragma unroll
                                        for (int j = 0; j < 16; ++j) { const float a = a4[q][j >> 2][j & 3]; if (j & 1) s1 += a * x[j]; else s0 += a * x[j]; }
                                        *(LAS bf16*)(TT + (16 + tr) * P16 + c * 2) = (bf16)f2bf(-(s0 + s1));
                                    }
                                }
                              }
                            } else if (t0 >= TC) EPI(t0 - TC, par ^ 1);
                        }
                        __syncthreads();
                        if (wave >= 4) { if (t0 + TC < SEQ) PASS1(t0 + TC, par ^ 1, t0 + 2 * TC < SEQ); }
                        else if (wave >= 2) { if (t0 + TC < SEQ) {
                            LAS unsigned char* gd = GKB + (par ^ 1) * 4096 + gt * 128 + gp * 2;
                            *(LAS u32x4*)gd = (u32x4){PUWS(0, 0), PUWS(0, 1), PUWS(0, 2), PUWS(0, 3)}; *(LAS u32x4*)(gd + 16) = (u32x4){PUWS(1, 0), PUWS(1, 1), PUWS(1, 2), PUWS(1, 3)};
                            if (t0 + 2 * TC < SEQ) LOADG(t0 + 2 * TC); } }
                        else if (wave < 2 && t0 >= 0) {
#pragma unroll 1
                            for (int sc = 0; sc < 2; ++sc) {
                                const LAS unsigned char* im = IM0 + sc * IMG;
                                const LAS unsigned char* KR = im; const LAS unsigned char* BT = im + 9216; const LAS unsigned char* GT = im + 12288; const LAS unsigned char* VT = im + 15360;
                                const LAS unsigned char* TT = im + 18432; const LAS unsigned char* BB = im + 19968; const LAS float* PL = (const LAS float*)(im + 25600);
                                const LAS unsigned char* BGr = im + 4608;
                                const bf16x8 vfr = trd8(VT, PT, 8 * h2, 8 * h2 + 4, 32 * wave, lane);
                                const bf16x8 bbf = *(const LAS bf16x8*)(BB + r31 * P16 + 8 * h2 * 2);
                                bf16x8 krf[2][2], betf[2], gamf[2]; f32x4 pl[2][4];
#pragma unroll
                                for (int kb = 0; kb < 2; ++kb)
#pragma unroll
                                    for (int s = 0; s < 2; ++s) krf[kb][s] = LD2x64(KR + r31 * PT + (32 * kb + 16 * s + 4 * h2) * 2);
                                const bf16x8 ttf = LD2x64(TT + r31 * P16 + (4 * h2) * 2);
#pragma unroll
                                for (int kb = 0; kb < 2; ++kb) { betf[kb] = trd8(BGr, PT, 4 * h2, 8 + 4 * h2, 32 * kb, lane);
                                    gamf[kb] = trd8(BGr, PT, 16 + 8 * h2, 20 + 8 * h2, 32 * kb, lane); }
                                __builtin_amdgcn_sched_barrier(0);
                                f32x16 t1;
#pragma unroll
                                for (int i = 0; i < 16; ++i) t1[i] = 0.f;
                                t1 = __builtin_amdgcn_mfma_f32_32x32x16_bf16(bbf, vfr, t1, 0, 0, 0);
#pragma unroll
                                for (int kb = 0; kb < 2; ++kb)
#pragma unroll
                                    for (int s = 0; s < 2; ++s) t1 = __builtin_amdgcn_mfma_f32_32x32x16_bf16(krf[kb][s], PACK8(Sreg[kb], s), t1, 0, 0, 0);
                                f32x16 ag[2];
#pragma unroll
                                for (int kb = 0; kb < 2; ++kb) ag[kb] = __builtin_amdgcn_mfma_f32_32x32x16_bf16(gamf[kb], vfr, Sreg[kb], 0, 0, 0);
                                f32x16 t2;
#pragma unroll
                                for (int i = 0; i < 16; ++i) t2[i] = 0.f;
                                t2 = __builtin_amdgcn_mfma_f32_32x32x16_bf16(ttf, PACK8(t1, 0), t2, 0, 0, 0);
#pragma unroll
                                for (int i = 8; i < 16; ++i) OUTB[(16 * sc + (i & 3) + 8 * ((i >> 2) - 2) + 4 * h2) * 64 + 32 * wave + r31] = t2[i] + t1[i];
#pragma unroll
                                for (int kb = 0; kb < 2; ++kb)
#pragma unroll
                                    for (int g4 = 0; g4 < 4; ++g4) pl[kb][g4] = *(const LAS f32x4*)(PL + 32 * kb + 8 * g4 + 4 * h2);
                                const bf16x8 uq = PACK8(t2, 0);
#pragma unroll
                                for (int kb = 0; kb < 2; ++kb) {
                                    f32x16 a = __builtin_amdgcn_mfma_f32_32x32x16_bf16(betf[kb], uq, ag[kb], 0, 0, 0);
#pragma unroll
                                    for (int g4 = 0; g4 < 4; ++g4) { const f32x4 p4 = pl[kb][g4];
                                        a[4 * g4] *= p4.x; a[4 * g4 + 1] *= p4.y; a[4 * g4 + 2] *= p4.z; a[4 * g4 + 3] *= p4.w; }
                                    Sreg[kb] = a;
                                }
                            }
                        }
                    }
                    __syncthreads();
                    if ((wave & 3) >= 2) EPI(SEQ - TC, ((SEQ - TC) >> 5) & 1);
                    __syncthreads();
#undef UNPH
#undef UNPJ
#undef PUW
#undef PUWS
#undef SETPU
#undef PACK8
#undef LD2x64
                } } else {
                    const int idx = job - 128, bh = idx >> 1, half = idx & 1, b = bh >> 2, h = bh & 3;
                    unsigned zl_ = 0u; asm volatile("" : "+v"(zl_)); const int lane_ml = (int)__builtin_amdgcn_mbcnt_hi(~0u, __builtin_amdgcn_mbcnt_lo(~0u, zl_));
                    _Pragma("unroll 1") for (int sr_ = 0; sr_ < NSUB(1); ++sr_) if (((SUBMASK>>1)&1) && idx < 64) {
                        SUB_TID
                        const int bm = idx >> 2, hm = idx & 3;
                        constexpr int PT = 144;
                        LAS unsigned char* QI = lds;
                        LAS unsigned char* KI = QI + 64 * PT;
                        constexpr int PV = 272;
                        LAS unsigned char* KW = KI + 64 * PT;
                        LAS unsigned char* VT = KW + 64 * PT;
                        LAS unsigned char* CI = VT + 64 * PV;
                        LAS float* AS = (LAS float*)(CI + 128 * PT);
                        LAS float* MX = AS + 64; LAS float* SI = AS + 128; LAS float* EM = AS + 192; LAS float* WG = AS + 256; LAS float* NN = AS + 320; LAS float* CR = AS + 384; LAS float* ST = AS + 448;
                        for (int i = tid; i < 128 * PT / 4; i += NTHR) ((LAS unsigned*)CI)[i] = 0u;
                        if (tid < 64) NN[tid] = 0.f;
                        LAS float* CWL = (LAS float*)(lds + 100352);
                        if (tid < 128) { const int colw = (tid < 64) ? (hm * 64 + tid) : (256 + hm * 64 + (tid - 64));
#pragma unroll
                            for (int j = 0; j < 4; ++j) CWL[j * 128 + tid] = INP(I_CONVW)[((size_t)l * 4 + j) * 512 + colw];
                            CWL[512 + tid] = INP(I_CONVB)[l * 512 + colw];
                            CWL[640 + tid] = INP(I_MLNORMG)[l * 512 + hm * 128 + tid]; }
                        const int pt = tid >> 4, cg = tid & 15;
                        const int ccol = (cg < 8) ? (hm * 64 + 8 * cg) : (256 + hm * 64 + 8 * (cg - 8));
                        const float qsc = (cg < 8) ? 0.125f : 1.f;
                        const float igb = INP(I_IGB)[l * 4 + hm], fgb = INP(I_FGB)[l * 4 + hm];
                        const int r31 = lane & 31, h2 = lane >> 5, vb = wave >> 1, tb = wave & 1;
                        f32x16 accC;
#pragma unroll
                        for (int i = 0; i < 16; ++i) accC[i] = 0.f;
                        float nreg = 0.f, mprev = 0.f;
                        u32x4 cu[2][4], vu[2]; float gi = 0.f, gf = 0.f;
                        auto LOADM = [&](int t0) {
#pragma unroll
                            for (int tt = 0; tt < 2; ++tt) { const int t = t0 + pt + 32 * tt; const size_t row = (size_t)bm * SEQ + t;
#pragma unroll
                                for (int j = 0; j < 4; ++j) { if (t - 3 + j >= 0) cu[tt][j] = *(const u32x4*)(Ub + ((row - 3 + j) * NU + UC_QK + ccol) * 2); else cu[tt][j] = (u32x4){0u, 0u, 0u, 0u}; }
                                const int p = tid + 512 * tt; vu[tt] = *(const u32x4*)(Ub + (((size_t)bm * SEQ + t0 + (p >> 4)) * NU + UC_V + hm * 128 + 8 * (p & 15)) * 2); }
                            if (wave == 0) { const size_t rg = (size_t)bm * SEQ + t0 + lane; gi = GIF[rg * 8 + hm]; gf = GIF[rg * 8 + 4 + hm]; }
                        };
                        LOADM(0);
                        __syncthreads();
#pragma unroll 1
                        for (int t0 = 0; t0 < SEQ; t0 += 64) {
                            int cgv = cg * 8; asm volatile("" : "+v"(cgv));
                            float cw[4][8], cb[8];
#pragma unroll
                        for (int j = 0; j < 4; ++j) { const f32x4 a = *(const LAS f32x4*)(CWL + j * 128 + cgv), c2 = *(const LAS f32x4*)(CWL + j * 128 + cgv + 4);
                            cw[j][0] = a.x; cw[j][1] = a.y; cw[j][2] = a.z; cw[j][3] = a.w; cw[j][4] = c2.x; cw[j][5] = c2.y; cw[j][6] = c2.z; cw[j][7] = c2.w; }
                        { const f32x4 a = *(const LAS f32x4*)(CWL + 512 + cgv), c2 = *(const LAS f32x4*)(CWL + 512 + cgv + 4);
                            cb[0] = a.x; cb[1] = a.y; cb[2] = a.z; cb[3] = a.w; cb[4] = c2.x; cb[5] = c2.y; cb[6] = c2.z; cb[7] = c2.w; }
                            float yq[2][8];
#pragma unroll
                            for (int tt = 0; tt < 2; ++tt) {
#pragma unroll
                                for (int i = 0; i < 8; ++i) yq[tt][i] = cb[i];
#pragma unroll
                                for (int j = 0; j < 4; ++j) { const u32x4 w = cu[tt][j]; const float x[8] = {bflo(w.x), bfhi(w.x), bflo(w.y), bfhi(w.y), bflo(w.z), bfhi(w.z), bflo(w.w), bfhi(w.w)};
#pragma unroll
                                    for (int i = 0; i < 8; ++i) yq[tt][i] += cw[j][i] * x[i]; }
#pragma unroll
                                for (int i = 0; i < 8; ++i) yq[tt][i] = yq[tt][i] * sigmoidf_(yq[tt][i]) * qsc;
                            }
                            const u32x4 vreg0 = vu[0], vreg1 = vu[1];
                            if (wave == 0) {
                                const float ig = gi + igb, fp = gf + fgb;
                                const float lf = -(fmaxf(-fp, 0.f) + __logf(1.f + __expf(-fabsf(fp))));
                                const float bc = scan_add64(lf);
                                const float as = ig - bc, pm = scan_max64(as);
                                const float mxv = fmaxf(mprev, pm), mx63 = __builtin_bit_cast(float, __builtin_amdgcn_readlane(__builtin_bit_cast(int, mxv), 63)), bl = __builtin_bit_cast(float, __builtin_amdgcn_readlane(__builtin_bit_cast(int, bc), 63));
                                AS[lane] = as; MX[lane] = mxv; SI[lane] = __expf(mprev - mxv); EM[lane] = __expf(-(bc + mxv)); WG[lane] = __expf(as - mx63);
                                if (lane == 0) CR[0] = __expf(mprev - mx63);
                                mprev = bl + mx63;
                            }
                            if (t0 + 64 < SEQ) LOADM(t0 + 64);
                            __syncthreads();
#pragma unroll
                            for (int tt = 0; tt < 2; ++tt) { const int tok = pt + 32 * tt;
                                u32x4 pw; pw.x = pk2(yq[tt][0], yq[tt][1]); pw.y = pk2(yq[tt][2], yq[tt][3]); pw.z = pk2(yq[tt][4], yq[tt][5]); pw.w = pk2(yq[tt][6], yq[tt][7]);
                                if (cg < 8) *(LAS u32x4*)(QI + tok * PT + cg * 16) = pw;
                                else { *(LAS u32x4*)(KI + tok * PT + (cg - 8) * 16) = pw; const float wgs = WG[tok];
                                    u32x4 kw; kw.x = pk2(yq[tt][0] * wgs, yq[tt][1] * wgs); kw.y = pk2(yq[tt][2] * wgs, yq[tt][3] * wgs); kw.z = pk2(yq[tt][4] * wgs, yq[tt][5] * wgs); kw.w = pk2(yq[tt][6] * wgs, yq[tt][7] * wgs);
                                    *(LAS u32x4*)(KW + tok * PT + (cg - 8) * 16) = kw; }
                                const u32x4 vw = tt ? vreg1 : vreg0; const int p = tid + 512 * tt, vtok = p >> 4, v8 = p & 15;
                                *(LAS u32x4*)(VT + vtok * PV + v8 * 16) = vw;
                            }
                            __syncthreads();
                            float hv[16];
                            u32x2 ogw[4];
                            { const size_t rowg = (size_t)bm * SEQ + t0 + 32 * tb + r31; const char* ogp = Ub + (rowg * NU + UC_OG + hm * 128 + 32 * vb) * 2;
#pragma unroll
                                for (int g4 = 0; g4 < 4; ++g4) ogw[g4] = *(const u32x2*)(ogp + (8 * g4 + 4 * h2) * 2); }
                            {
                                constexpr float L2E = 1.4426950408889634f;
                                const int t = 32 * tb + r31;
                                bf16x8 qf[4];
#pragma unroll
                                for (int ks = 0; ks < 4; ++ks) qf[ks] = *(const LAS bf16x8*)(QI + t * PT + (16 * ks + 8 * h2) * 2);
                                const float mx = MX[t], si = SI[t], em = EM[t];
                                f32x16 O, I; float denI = 0.f;
#pragma unroll
                                for (int i = 0; i < 16; ++i) { O[i] = 0.f; I[i] = 0.f; }
#pragma unroll
                                for (int sb = 0; sb < 2; ++sb) if (sb <= tb) {
                                    f32x16 X;
#pragma unroll
                                    for (int i = 0; i < 16; ++i) X[i] = 0.f;
#pragma unroll
                                    for (int ks = 0; ks < 4; ++ks) { const bf16x8 kf = *(const LAS bf16x8*)(KI + (32 * sb + r31) * PT + (16 * ks + 8 * h2) * 2); X = __builtin_amdgcn_mfma_f32_32x32x16_bf16(kf, qf[ks], X, 0, 0, 0); }
#pragma unroll
                                    for (int g4 = 0; g4 < 4; ++g4) { const f32x4 a4 = *(const LAS f32x4*)(AS + 32 * sb + 8 * g4 + 4 * h2);
#pragma unroll
                                        for (int j = 0; j < 4; ++j) { const int s = 32 * sb + 8 * g4 + 4 * h2 + j; const float w = (s <= t) ? __builtin_amdgcn_exp2f((a4[j] - mx) * L2E) * X[4 * g4 + j] : 0.f; X[4 * g4 + j] = w; denI += w; } }
#pragma unroll
                                    for (int st = 0; st < 2; ++st) {
                                        u32x4 pw; pw.x = pk2(X[8 * st], X[8 * st + 1]); pw.y = pk2(X[8 * st + 2], X[8 * st + 3]); pw.z = pk2(X[8 * st + 4], X[8 * st + 5]); pw.w = pk2(X[8 * st + 6], X[8 * st + 7]);
                                        O = __builtin_amdgcn_mfma_f32_32x32x16_bf16(trd8(VT, PV, 32 * sb + 16 * st + 4 * h2, 32 * sb + 16 * st + 8 + 4 * h2, 32 * vb, lane), __builtin_bit_cast(bf16x8, pw), O, 0, 0, 0);
                                    }
                                }
                                float nq = 0.f;
#pragma unroll
                                for (int ks = 0; ks < 4; ++ks) { const bf16x8 cf = *(const LAS bf16x8*)(CI + (32 * vb + r31) * PT + (16 * ks + 8 * h2) * 2); I = __builtin_amdgcn_mfma_f32_32x32x16_bf16(cf, qf[ks], I, 0, 0, 0);
                                    const f32x4 n0 = *(const LAS f32x4*)(NN + 16 * ks + 8 * h2), n1 = *(const LAS f32x4*)(NN + 16 * ks + 8 * h2 + 4); const u32x4 qw = __builtin_bit_cast(u32x4, qf[ks]);
                                    nq += (bflo(qw.x) * n0.x + bfhi(qw.x) * n0.y) + (bflo(qw.y) * n0.z + bfhi(qw.y) * n0.w) + (bflo(qw.z) * n1.x + bfhi(qw.z) * n1.y) + (bflo(qw.w) * n1.z + bfhi(qw.w) * n1.w); }
                                nq += __shfl_xor(nq, 32); denI += __shfl_xor(denI, 32);
                                const float den = si * nq + denI, rdn = 1.f / fmaxf(fabsf(den), em);
                                float hsum = 0.f;
#pragma unroll
                                for (int i = 0; i < 16; ++i) { hv[i] = (O[i] + si * I[i]) * rdn; hsum += hv[i]; }
                                hsum += __shfl_xor(hsum, 32);
                                const float hmean = hsum * (1.f / 32.f); float hm2 = 0.f;
#pragma unroll
                                for (int i = 0; i < 16; ++i) { const float dlt = hv[i] - hmean; hm2 += dlt * dlt; }
                                hm2 += __shfl_xor(hm2, 32);
                                if (h2 == 0) *(LAS f32x2*)(ST + ((tb * 4 + vb) * 32 + r31) * 2) = (f32x2){hmean, hm2};
                                const float carry = CR[0];
#pragma unroll
                                for (int i = 0; i < 16; ++i) accC[i] *= carry;
#pragma unroll
                                for (int st = 0; st < 4; ++st) { const bf16x8 va = trd8(VT, PV, 16 * st + 8 * h2, 16 * st + 8 * h2 + 4, 32 * vb, lane), kw = trd8(KW, PT, 16 * st + 8 * h2, 16 * st + 8 * h2 + 4, 32 * tb, lane);
                                    accC = __builtin_amdgcn_mfma_f32_32x32x16_bf16(va, kw, accC, 0, 0, 0); }
                            }
                            __syncthreads();
                            {
                                const int t = 32 * tb + r31;
                                f32x2 s4[4];
#pragma unroll
                                for (int q = 0; q < 4; ++q) s4[q] = *(const LAS f32x2*)(ST + ((tb * 4 + q) * 32 + r31) * 2);
                                const float mt = (s4[0].x + s4[1].x + s4[2].x + s4[3].x) * 0.25f;
                                float m2 = 0.f;
#pragma unroll
                                for (int q = 0; q < 4; ++q) { const float dm = s4[q].x - mt; m2 += s4[q].y + 32.f * dm * dm; }
                                const float rstd = __builtin_amdgcn_rsqf(m2 * (1.f / 128.f) + LN_EPS);
                                const size_t row = (size_t)bm * SEQ + t0 + t;
                                char* op = HC + (row * 1536 + hm * 128 + 32 * vb) * 2;
                                const LAS float* ngp = CWL + 640 + 32 * vb;
#pragma unroll
                                for (int g4 = 0; g4 < 4; ++g4) { const int vo = 8 * g4 + 4 * h2; const f32x4 og = UNP4(ogw[g4]), ng = *(const LAS f32x4*)(ngp + vo);
                                    f32x4 y; y.x = sigmoidf_(og.x) * ((hv[4 * g4] - mt) * rstd * ng.x); y.y = sigmoidf_(og.y) * ((hv[4 * g4 + 1] - mt) * rstd * ng.y); y.z = sigmoidf_(og.z) * ((hv[4 * g4 + 2] - mt) * rstd * ng.z); y.w = sigmoidf_(og.w) * ((hv[4 * g4 + 3] - mt) * rstd * ng.w);
                                    st4bf(op + vo * 2, y); }
                            }
#pragma unroll
                            for (int i = 0; i < 16; ++i) { const int v = 32 * vb + (i & 3) + 8 * (i >> 2) + 4 * h2; *(LAS bf16*)(CI + v * PT + (32 * tb + r31) * 2) = (bf16)f2bf(accC[i]); }
                            if (wave < 2) { float s = 0.f;
#pragma unroll
                                for (int q8 = 0; q8 < 8; ++q8) { const u32x2 w = trd4(KW, PT, 32 * h2 + 4 * q8, 32 * wave, lane); s += (bflo(w.x) + bfhi(w.x)) + (bflo(w.y) + bfhi(w.y)); }
                                s += __shfl_xor(s, 32);
                                nreg = CR[0] * nreg + s; if (h2 == 0) NN[32 * wave + r31] = nreg; }
                            __syncthreads();
                        }
                    }
                }
            }
            if (rep_ == 0) {
                LAS unsigned* XB = (LAS unsigned*)(lds + 153088);
                unsigned* xc = (unsigned*)ctl + CW_FILL + 32 + l * 64;
                __syncthreads();
                if (tid_ph == 0) XB[0] = __hip_atomic_fetch_add(xc, 1u, RLX_AGENT);
                __syncthreads();
                int xi = __builtin_amdgcn_readfirstlane((int)XB[0]);
#pragma unroll 1
                while (xi < 128) {
                    const int idx = xi, bh = idx >> 1, half = idx & 1, b = bh >> 2, h = bh & 3;
                    _Pragma("unroll 1") for (int sr_ = 0; sr_ < NSUB(2); ++sr_) if ((SUBMASK>>2)&1) {
                        SUB_TID
                        constexpr int KST = 272, VST = 520;
                        LAS unsigned char* KI = lds; LAS unsigned char* VI = lds + 256 * KST;
                        const char* kvb = (const char*)(ws + WS_KV) + (((size_t)l * MROWS + (size_t)b * MEML) * D) * 2;
                        for (int p = tid; p < 4096; p += NTHR) { const int key = p >> 4, c16 = p & 15;
                            *(LAS u32x4*)(KI + key * KST + c16 * 16) = *(const u32x4*)(kvb + ((size_t)key * D + h * 128 + c16 * 8) * 2); }
                        for (int p = tid; p < 4096; p += NTHR) { const int key = p & 255, d8 = p >> 8;
                            const u32x4 w = *(const u32x4*)(kvb + ((size_t)key * D + 512 + h * 128 + d8 * 8) * 2);
                            LAS unsigned char* o = VI + (d8 * 8) * VST + key * 2;
                            *(LAS bf16*)(o) = (bf16)(w.x & 0xffff); *(LAS bf16*)(o + VST) = (bf16)(w.x >> 16); *(LAS bf16*)(o + 2 * VST) = (bf16)(w.y & 0xffff); *(LAS bf16*)(o + 3 * VST) = (bf16)(w.y >> 16);
                            *(LAS bf16*)(o + 4 * VST) = (bf16)(w.z & 0xffff); *(LAS bf16*)(o + 5 * VST) = (bf16)(w.z >> 16); *(LAS bf16*)(o + 6 * VST) = (bf16)(w.w & 0xffff); *(LAS bf16*)(o + 7 * VST) = (bf16)(w.w >> 16); }
                        __syncthreads();
                        const int r31 = lane & 31, h2 = lane >> 5;
                        constexpr float SC = 0.08838834764831845f * 1.4426950408889634f;
#pragma unroll 1
                        for (int rd = 0; rd < 8; ++rd) {
                            const size_t qrow = (size_t)b * SEQ + half * 2048 + rd * 256 + wave * 32 + r31;
                            bf16x8 qf[8];
#pragma unroll
                            for (int ks = 0; ks < 8; ++ks) qf[ks] = *(const bf16x8*)(Ub + (qrow * NU + UC_CAQ + h * 128 + 16 * ks + 8 * h2) * 2);
                            f32x16 O[4];
#pragma unroll
                            for (int db = 0; db < 4; ++db)
#pragma unroll
                                for (int i = 0; i < 16; ++i) O[db][i] = 0.f;
                            float mrun = -1e30f, lrun = 0.f;
#pragma unroll 1
                            for (int hf = 0; hf < 2; ++hf) {
                                f32x16 X[4];
#pragma unroll
                                for (int kb = 0; kb < 4; ++kb) {
                                    bf16x8 kf[8];
#pragma unroll
                                    for (int ks = 0; ks < 8; ++ks) kf[ks] = *(const LAS bf16x8*)(KI + (hf * 128 + kb * 32 + r31) * KST + (16 * ks + 8 * h2) * 2);
                                    __builtin_amdgcn_sched_barrier(0);
#pragma unroll
                                    for (int i = 0; i < 16; ++i) X[kb][i] = 0.f;
#pragma unroll
                                    for (int ks = 0; ks < 8; ++ks) X[kb] = __builtin_amdgcn_mfma_f32_32x32x16_bf16(kf[ks], qf[ks], X[kb], 0, 0, 0);
                                    __builtin_amdgcn_sched_barrier(0);
                                }
                                float mx = -1e30f;
#pragma unroll
                                for (int kb = 0; kb < 4; ++kb)
#pragma unroll
                                    for (int i = 0; i < 16; ++i) mx = fmaxf(mx, X[kb][i]);
                                mx = fmaxf(mx, __shfl_xor(mx, 32));
                                const float mnew = fmaxf(mrun, mx), alpha = __builtin_amdgcn_exp2f((mrun - mnew) * SC);
                                float ls = 0.f;
#pragma unroll
                                for (int kb = 0; kb < 4; ++kb)
#pragma unroll
                                    for (int i = 0; i < 16; ++i) { const float p = __builtin_amdgcn_exp2f((X[kb][i] - mnew) * SC); X[kb][i] = p; ls += p; }
                                ls += __shfl_xor(ls, 32);
                                lrun = lrun * alpha + ls; mrun = mnew;
#pragma unroll
                                for (int db = 0; db < 4; ++db)
#pragma unroll
                                    for (int i = 0; i < 16; ++i) O[db][i] *= alpha;
#pragma unroll
                                for (int kb = 0; kb < 4; ++kb) {
                                    bf16x8 vf[2][4], pf[2];
#pragma unroll
                                    for (int s = 0; s < 2; ++s) {
                                        u32x4 pw; pw.x = pk2(X[kb][8 * s], X[kb][8 * s + 1]); pw.y = pk2(X[kb][8 * s + 2], X[kb][8 * s + 3]); pw.z = pk2(X[kb][8 * s + 4], X[kb][8 * s + 5]); pw.w = pk2(X[kb][8 * s + 6], X[kb][8 * s + 7]);
                                        pf[s] = __builtin_bit_cast(bf16x8, pw);
#pragma unroll
                                        for (int db = 0; db < 4; ++db) {
                                            const LAS unsigned char* vp = VI + (db * 32 + r31) * VST + (hf * 128 + kb * 32 + 16 * s + 4 * h2) * 2;
                                            const u32x2 lo = *(const LAS u32x2*)vp, hi = *(const LAS u32x2*)(vp + 16);
                                            vf[s][db] = __builtin_bit_cast(bf16x8, (u32x4){lo.x, lo.y, hi.x, hi.y});
                                        }
                                    }
                                    __builtin_amdgcn_sched_barrier(0);
#pragma unroll
                                    for (int s = 0; s < 2; ++s)
#pragma unroll
                                        for (int db = 0; db < 4; ++db) O[db] = __builtin_amdgcn_mfma_f32_32x32x16_bf16(vf[s][db], pf[s], O[db], 0, 0, 0);
                                    __builtin_amdgcn_sched_barrier(0);
                                }
                            }
                            const float rl = 1.f / lrun;
                            char* op = HC + (qrow * 1536 + 1024 + h * 128) * 2;
#pragma unroll
                            for (int db = 0; db < 4; ++db)
#pragma unroll
                                for (int g4 = 0; g4 < 4; ++g4) { u32x2 w; w.x = pk2(O[db][4 * g4] * rl, O[db][4 * g4 + 1] * rl); w.y = pk2(O[db][4 * g4 + 2] * rl, O[db][4 * g4 + 3] * rl);
                                    *(u32x2*)(op + (db * 32 + 8 * g4 + 4 * h2) * 2) = w; }
                        }
                        __syncthreads();
                    }
                    if (tid_ph == 0) XB[0] = __hip_atomic_fetch_add(xc, 1u, RLX_AGENT);
                    __syncthreads();
                    xi = __builtin_amdgcn_readfirstlane((int)XB[0]);
                    __syncthreads();
                }
            }
            if (rep_ == 0) {
                unsigned zf_ = 0u; asm volatile("" : "+v"(zf_)); const int lane_f = (int)__builtin_amdgcn_mbcnt_hi(~0u, __builtin_amdgcn_mbcnt_lo(~0u, zf_));
                LAS float* scr = (LAS float*)(lds + wave * 8448);
                LAS unsigned* FB = (LAS unsigned*)(lds + 8 * 8448);
                unsigned* fc = (unsigned*)ctl + CW_FILL + l * 64;
                constexpr int IT_GU = 32 * 16 * 64, IT_ALL = 49152, CH = 32;
                const bool lead = (wave == 0) && (lane_f == 0);
                __syncthreads();
                if (lead) FB[0] = __hip_atomic_fetch_add(fc, (unsigned)CH, RLX_AGENT);
                __syncthreads();
                int fbase = __builtin_amdgcn_readfirstlane((int)FB[0]), slot = 1;
#pragma unroll 1
                while (fbase < IT_ALL) {
                    unsigned nb = 0u;
                    if (lead) nb = __hip_atomic_fetch_add(fc, (unsigned)CH, RLX_AGENT);
                    {
                        struct FItem { const float* W; unsigned char* WT; int ldw; float sc; };
                        auto FI = [&](int it) -> FItem { FItem r;
                            if (it < IT_GU) { const int e = it >> 10, q = it & 1023, kb = q >> 6, nb_ = q & 63;
                                r.W = INP(I_WGU) + (((size_t)l * 32 + e) * D + 64 * kb) * 2048 + 32 * nb_; r.ldw = 2048; r.WT = (unsigned char*)(ws + WS_WGU) + ((size_t)e * 2048 + 32 * nb_) * D + 64 * kb; r.sc = F8_SWGU; }
                            else { const int r2 = it - IT_GU, e = r2 >> 9, q = r2 & 511, kb = q >> 5, nb_ = q & 31;
                                r.W = INP(I_WDN) + (((size_t)l * 32 + e) * D + 64 * kb) * 1024 + 32 * nb_; r.ldw = 1024; r.WT = (unsigned char*)(ws + WS_WDN) + ((size_t)e * 1024 + 32 * nb_) * D + 64 * kb; r.sc = F8_SWDN; }
                            return r; };
                        f32x4 va[8], vb[8];
                        FItem c0 = FI(fbase + wave), c1;
                        ti_load4(c0.W, c0.ldw, lane_f, va);
#pragma unroll 1
                        for (int kq = 0; kq < CH / NWAVES; kq += 2) {
                            c1 = FI(fbase + wave + (kq + 1) * NWAVES); ti_load4(c1.W, c1.ldw, lane_f, vb);
                            ti_store4_f8(va, c0.WT, D, c0.sc, lane_f);
                            if (kq + 2 < CH / NWAVES) { c0 = FI(fbase + wave + (kq + 2) * NWAVES); ti_load4(c0.W, c0.ldw, lane_f, va); }
                            ti_store4_f8(vb, c1.WT, D, c1.sc, lane_f);
                        }
                    }
                    if (lead) FB[slot] = nb;
                    __syncthreads();
                    fbase = __builtin_amdgcn_readfirstlane((int)FB[slot]); slot ^= 1;
                }
            }
#undef UNP4
#undef DOT4
#undef SUB_TID
        }
        SEAM(pb + 3);
        _Pragma("unroll 1") for (int rep_ = 0; rep_ < NREP(5); ++rep_) if (((PHMASK>>5)&1) && IN(pb + 5)) {
            SchedPlain S; S.T.init(M / 256, 4); S.G = G; S.c = bx; S.A = (const char*)(ws + WS_R2 + R2_HCAT); S.B = (const char*)(ws + WS_WBR) + (size_t)l * 1024 * 1536 * 2; S.C = (char*)(ws + WS_R2 + R2_YPRE);
            S.lda = 1536; S.ldb = 1536; S.ldc = D;
            pg8::EpiMerge E; E.U = Ub; E.gate_b = INP(I_GATEB) + (size_t)l * 3072;
            pg8::gemm_phase<false, true>(lds, 1536 * 2, 1536 * 2, 1536 * 2, S, E, wave);
        }
        SEAM(pb + 5);
        _Pragma("unroll 1") for (int rep_ = 0; rep_ < NREP(6); ++rep_) if (((PHMASK>>6)&1) && IN(pb + 6)) {
            SchedPlain S; S.T.init(M / 256, 4); S.G = G; S.c = bx; S.A = (const char*)(ws + WS_R2 + R2_YPRE); S.B = (const char*)(ws + WS_WO) + (size_t)l * D * D * 2; S.C = (char*)(ws + WS_R2 + R2_Z);
            S.lda = D; S.ldb = D; S.ldc = D;
            pg8::EpiStore E;
            pg8::gemm_phase<false>(lds, D * 2, D * 2, D * 2, S, E, wave);
        }
        SEAM(pb + 6);
        _Pragma("unroll 1") for (int rep_ = 0; rep_ < NREP(7); ++rep_) if (((PHMASK>>7)&1) && IN(pb + 7)) { PHASE_TID
            constexpr int WP = 2064;
            LAS unsigned char* WRb = lds;
            LAS float* RB = (LAS float*)(lds + 66048);
            LAS unsigned char* XS = lds + 66560 + wave * 4608;
            for (int i = tid; i < 32768; i += NTHR) { const int k = i >> 5, e = i & 31; *(LAS bf16*)(WRb + e * WP + k * 2) = (bf16)f2bf(INP(I_RTW)[((size_t)l * D + k) * 32 + e]); }
            if (tid < 32) RB[tid] = INP(I_RTB)[l * 32 + tid];
            const char* Zb = (const char*)(ws + WS_R2 + R2_Z);
            int* TKE = (int*)(ws + WS_TKE); float* TKG = (float*)(ws + WS_TKG); int* TKP = (int*)(ws + WS_TKP); int* ROWTOK = (int*)(ws + WS_ROWTOK);
            LAS unsigned* LCNT = (LAS unsigned*)(lds + 131072);
            LAS unsigned* GBASE = LCNT + 32; LAS unsigned* LLEN = LCNT + 64; LAS unsigned* LIST = LCNT + 128;
            if (tid < 65) LCNT[tid] = 0u;
            {
                f32x4 g[4], bb[4];
#pragma unroll
                for (int j = 0; j < 4; ++j) { g[j] = *(const f32x4*)(INP(I_LN1G) + l * D + 256 * j + 4 * lane); bb[j] = *(const f32x4*)(INP(I_LN1B) + l * D + 256 * j + 4 * lane); }
#pragma unroll 1
                for (int pp = gw; pp < M / 2; pp += NGW) {
                    f32x4 y0[4], y1[4];
#pragma unroll
                    for (int j = 0; j < 4; ++j) { y0[j] = ld4bf(Zb + ((size_t)(2 * pp) * D + 256 * j + 4 * lane) * 2) + ld4bf(Xb + ((size_t)(2 * pp) * D + 256 * j + 4 * lane) * 2) * DN_ALPHA;
                        y1[j] = ld4bf(Zb + ((size_t)(2 * pp + 1) * D + 256 * j + 4 * lane) * 2) + ld4bf(Xb + ((size_t)(2 * pp + 1) * D + 256 * j + 4 * lane) * 2) * DN_ALPHA; }
                    ln16(y0, g, bb); ln16(y1, g, bb);
#pragma unroll
                    for (int j = 0; j < 4; ++j) { st4bf(Xb + ((size_t)(2 * pp) * D + 256 * j + 4 * lane) * 2, y0[j]); st4bf(Xb + ((size_t)(2 * pp + 1) * D + 256 * j + 4 * lane) * 2, y1[j]);
                        *(unsigned*)((char*)(ws + WS_XF8) + (size_t)(2 * pp) * D + 256 * j + 4 * lane) = pk4_f8(y0[j].x * F8_SX, y0[j].y * F8_SX, y0[j].z * F8_SX, y0[j].w * F8_SX);
                        *(unsigned*)((char*)(ws + WS_XF8) + (size_t)(2 * pp + 1) * D + 256 * j + 4 * lane) = pk4_f8(y1[j].x * F8_SX, y1[j].y * F8_SX, y1[j].z * F8_SX, y1[j].w * F8_SX); }
                }
            }
            asm volatile("s_waitcnt vmcnt(0)" ::: "memory");
            __syncthreads();
            __builtin_amdgcn_fence(__ATOMIC_ACQUIRE, "agent");
            asm volatile("s_waitcnt vmcnt(0)" ::: "memory");
            if (rep_ == 0) {
                const int r31 = lane & 31, h2 = lane >> 5;
                const int mytok = 16 * (bx + (2 * wave + (r31 >> 4)) * G) + (r31 & 15);
                const char* sp[4];
#pragma unroll
                for (int q = 0; q < 4; ++q) { const int row = (lane >> 3) + 8 * q; const int tk = 16 * (bx + (2 * wave + (row >> 4)) * G) + (row & 15); sp[q] = Xb + ((size_t)tk * D + 8 * (lane & 7)) * 2; }
                f32x16 C;
#pragma unroll
                for (int i = 0; i < 16; ++i) C[i] = 0.f;
                u32x4 xr[4];
#pragma unroll
                for (int q = 0; q < 4; ++q) xr[q] = *(const u32x4*)(sp[q]);
#pragma unroll 1
                for (int sl = 0; sl < 16; ++sl) {
#pragma unroll
                    for (int q = 0; q < 4; ++q) *(LAS u32x4*)(XS + ((lane >> 3) + 8 * q) * 144 + (lane & 7) * 16) = xr[q];
                    if (sl + 1 < 16) {
#pragma unroll
                        for (int q = 0; q < 4; ++q) xr[q] = *(const u32x4*)(sp[q] + (sl + 1) * 128); }
#pragma unroll
                    for (int k2 = 0; k2 < 4; ++k2) C = __builtin_amdgcn_mfma_f32_32x32x16_bf16(*(const LAS bf16x8*)(WRb + r31 * WP + (64 * sl + 16 * k2 + 8 * h2) * 2), *(const LAS bf16x8*)(XS + r31 * 144 + (16 * k2 + 8 * h2) * 2), C, 0, 0, 0);
                }
                float v[16];
#pragma unroll
                for (int g4 = 0; g4 < 4; ++g4) { const f32x4 b4 = *(const LAS f32x4*)(RB + 8 * g4 + 4 * h2); v[4 * g4] = C[4 * g4] + b4.x; v[4 * g4 + 1] = C[4 * g4 + 1] + b4.y; v[4 * g4 + 2] = C[4 * g4 + 2] + b4.z; v[4 * g4 + 3] = C[4 * g4 + 3] + b4.w; }
                float lv[4]; int li_[4];
#pragma unroll
                for (int k = 0; k < 4; ++k) { float best = -3.0e38f; int bi = 0;
#pragma unroll
                    for (int i = 0; i < 16; ++i) { const int e = (i & 3) + 8 * (i >> 2) + 4 * h2; if (v[i] > best) { best = v[i]; bi = e; } }
#pragma unroll
                    for (int i = 0; i < 16; ++i) { const int e = (i & 3) + 8 * (i >> 2) + 4 * h2; v[i] = (e == bi) ? -3.0e38f : v[i]; }
                    lv[k] = best; li_[k] = bi; }
                float cv[8]; int ci[8];
#pragma unroll
                for (int k = 0; k < 4; ++k) { cv[k] = lv[k]; ci[k] = li_[k]; cv[4 + k] = __shfl_xor(lv[k], 32); ci[4 + k] = __shfl_xor(li_[k], 32); }
                float tv[4]; int te[4];
#pragma unroll
                for (int k = 0; k < 4; ++k) { float best = -3.0e38f; int bi = 64;
#pragma unroll
                    for (int i = 0; i < 8; ++i) { if (cv[i] > best || (cv[i] == best && ci[i] < bi)) { best = cv[i]; bi = ci[i]; } }
#pragma unroll
                    for (int i = 0; i < 8; ++i) cv[i] = (ci[i] == bi) ? -3.0e38f : cv[i];
                    tv[k] = best; te[k] = bi; }
                const float e1 = __expf(tv[1] - tv[0]), e2 = __expf(tv[2] - tv[0]), e3 = __expf(tv[3] - tv[0]), rs = 1.f / (1.f + e1 + e2 + e3);
                const float gt[4] = {rs, e1 * rs, e2 * rs, e3 * rs};
                if (h2 == 0) {
#pragma unroll
                    for (int k = 0; k < 4; ++k) {
                        const unsigned lpos = __hip_atomic_fetch_add(LCNT + te[k], 1u, __ATOMIC_RELAXED, __HIP_MEMORY_SCOPE_WORKGROUP);
                        const unsigned li = __hip_atomic_fetch_add(LLEN, 1u, __ATOMIC_RELAXED, __HIP_MEMORY_SCOPE_WORKGROUP);
                        LIST[2 * li] = (unsigned)(mytok * 4 + k); LIST[2 * li + 1] = (unsigned)te[k] | (lpos << 8);
                        TKE[mytok * 4 + k] = te[k]; TKG[mytok * 4 + k] = gt[k]; }
                }
            }
            __syncthreads();
            if (tid < 32 && rep_ == 0) GBASE[tid] = __hip_atomic_fetch_add((unsigned*)ctl + CW_CNT + (l * 32 + tid) * 64, LCNT[tid], RLX_AGENT);
            __syncthreads();
            if (rep_ == 0) { const unsigned n = LLEN[0];
                for (unsigned i = tid; i < n; i += NTHR) { const unsigned tk = LIST[2 * i], ev = LIST[2 * i + 1], e = ev & 255u, pos = GBASE[e] + (ev >> 8);
                    TKP[tk] = (int)pos; ROWTOK[(size_t)e * M + pos] = (int)(tk >> 2); } }
            __syncthreads();
        }
        SEAM(pb + 7);
        _Pragma("unroll 1") for (int rep_ = 0; rep_ < NREP(8); ++rep_) if (((PHMASK>>8)&1) && IN(pb + 8)) { PHASE_TID
            if (tid < 32) CNT[tid] = (int)__hip_atomic_load((unsigned*)ctl + CW_CNT + (l * 32 + tid) * 64, RLX_AGENT);
            __syncthreads();
            if (tid == 0) { int a = 0; for (int e = 0; e < 32; ++e) { PB[e] = a; a += (CNT[e] + 255) >> 8; } PB[32] = a; }
            __syncthreads();
            const int P = PB[32];
            const int* ROWTOK = (const int*)(ws + WS_ROWTOK);
            char* XD = (char*)(ws + WS_R1); const char* XF = (const char*)(ws + WS_XF8);
            for (int sb = gw * 64; sb < P * 256; sb += NGW * 64) {
                const int pm = sb >> 8; int e = 0;
#pragma unroll 1
                for (int j = 1; j < NEXP; ++j) e += (PB[j] <= pm) ? 1 : 0;
                const int pos0 = sb - PB[e] * 256, cnt = CNT[e];
                int nvalid = cnt - pos0; nvalid = nvalid > 64 ? 64 : nvalid;
                int tokv = -1; if (pos0 + lane < cnt) tokv = ROWTOK[(size_t)e * M + pos0 + lane];
#pragma unroll 1
                for (int j = 0; j < nvalid; j += 4) {
                    int t[4]; u32x4 a[4];
#pragma unroll
                    for (int i = 0; i < 4; ++i) { t[i] = __builtin_amdgcn_readlane(tokv, j + i);
                        if (t[i] >= 0) a[i] = *(const u32x4*)(XF + (size_t)t[i] * 1024 + lane * 16); }
#pragma unroll
                    for (int i = 0; i < 4; ++i) if (t[i] >= 0) *(u32x4*)(XD + (size_t)(sb + j + i) * 1024 + lane * 16) = a[i];
                }
            }
            LAS float* scr = (LAS float*)(lds + wave * 8448);
            constexpr int IT_GU = 32 * 16 * 64, IT_DN = 32 * 16 * 32;
            for (int it = XW_SPLIT + gw; it < IT_GU + IT_DN; it += NGW) {
                if (it < IT_GU) { const int e = it >> 10, q = it & 1023, kb = q >> 6, nb = q & 63;
                    transpose_item_f8(INP(I_WGU) + (((size_t)l * 32 + e) * D + 64 * kb) * 2048 + 32 * nb, 2048, (unsigned char*)(ws + WS_WGU) + ((size_t)e * 2048 + 32 * nb) * D + 64 * kb, D, F8_SWGU, scr, lane); }
                else { const int r = it - IT_GU, e = r >> 9, q = r & 511, kb = q >> 5, nb = q & 31;
                    transpose_item_f8(INP(I_WDN) + (((size_t)l * 32 + e) * D + 64 * kb) * 1024 + 32 * nb, 1024, (unsigned char*)(ws + WS_WDN) + ((size_t)e * 1024 + 32 * nb) * D + 64 * kb, D, F8_SWDN, scr, lane); }
            }
            __syncthreads();
        }
        SEAM(pb + 8);
        if (IN(pb + 9) || IN(pb + 10)) { PHASE_TID
            if (tid < 32) CNT[tid] = (int)__hip_atomic_load((unsigned*)ctl + CW_CNT + (l * 32 + tid) * 64, RLX_AGENT);
            __syncthreads();
            if (tid == 0) { int a = 0; for (int e = 0; e < 32; ++e) { PB[e] = a; a += (CNT[e] + 255) >> 8; } PB[32] = a; }
            __syncthreads();
        }
        _Pragma("unroll 1") for (int rep_ = 0; rep_ < NREP(9); ++rep_) if (((PHMASK>>9)&1) && IN(pb + 9)) {
            SchedMoe S; S.T.init(PB[32], 8); S.G = G; S.c = bx; S.A = (const char*)(ws + WS_R1); S.W = (const char*)(ws + WS_WGU); S.C = (char*)(ws + WS_R2 + R2_HMID); S.PB = PB; S.wrows = 2048; S.ldc = 1024; S.cdiv = 2; S.osz = 1;
            pg8::EpiMoe1 E; E.bgu = INP(I_BGU) + (size_t)l * 32 * 2048;
            pg8::gemm_phase<true>(lds, D, D, D, S, E, wave);
        }
        SEAM(pb + 9);
        _Pragma("unroll 1") for (int rep_ = 0; rep_ < NREP(10); ++rep_) if (((PHMASK>>10)&1) && IN(pb + 10)) {
            SchedMoe S; S.T.init(PB[32], 4); S.G = G; S.c = bx; S.A = (const char*)(ws + WS_R2 + R2_HMID); S.W = (const char*)(ws + WS_WDN); S.C = (char*)(ws + WS_R1); S.PB = PB; S.wrows = 1024; S.ldc = 1024; S.cdiv = 1; S.osz = 2;
            pg8::EpiMoe2 E; E.bdn = INP(I_BDN) + (size_t)l * 32 * 1024;
            pg8::gemm_phase<true>(lds, D, D, D, S, E, wave);
        }
        SEAM(pb + 10);
        _Pragma("unroll 1") for (int rep_ = 0; rep_ < NREP(11); ++rep_) if (((PHMASK>>11)&1) && IN(pb + 11)) { PHASE_TID
            if (tid < 32) CNT[tid] = (int)__hip_atomic_load((unsigned*)ctl + CW_CNT + (l * 32 + tid) * 64, RLX_AGENT);
            LAS float* wgt = (LAS float*)(lds + 73728);
            const bool lastl = (l == DEPTH - 1);
            if (!lastl) load_gate_table(wgt, INP(I_WIN) + (size_t)(l + 1) * D * DIN, tid);
            __syncthreads();
            if (tid == 0) { int a = 0; for (int e = 0; e < 32; ++e) { PB[e] = a; a += (CNT[e] + 255) >> 8; } PB[32] = a; }
            __syncthreads();
            const int e0 = 8 * lane;
            f32x4 g[4], bb[4];
#pragma unroll
            for (int j = 0; j < 4; ++j) { const int o = (j >> 1) * 512 + e0 + (j & 1) * 4; g[j] = *(const f32x4*)(INP(I_LN2G) + l * D + o); bb[j] = *(const f32x4*)(INP(I_LN2B) + l * D + o); }
            const char* YA = (const char*)(ws + WS_R1);
            const bool dummy_ = (rep_ + 1 < NREP(11)); char* const Xo = dummy_ ? (char*)(ws + WS_R2) : Xb; float* const Fo = dummy_ ? (float*)(ws + WS_R2 + 256 * MiB) : args.out; float* const Go = dummy_ ? (float*)(ws + WS_R2 + 200 * MiB) : GIF;
            const int* TKE = (const int*)(ws + WS_TKE); const float* TKG = (const float*)(ws + WS_TKG); const int* TKP = (const int*)(ws + WS_TKP);
#pragma unroll 1
            for (int mb = gw * 16; mb < M; mb += NGW * 16) {
                const int ev = TKE[mb * 4 + lane], pv = TKP[mb * 4 + lane]; const float gv = TKG[mb * 4 + lane];
                const int rowv = PB[ev] * 256 + pv;
#pragma unroll 1
                for (int ti = 0; ti < 16; ti += 2) {
                    u32x4 xw[2][2], yw[2][4][2]; float gk[2][4];
#pragma unroll
                    for (int q = 0; q < 2; ++q) { const size_t m = (size_t)mb + ti + q;
                        xw[q][0] = *(const u32x4*)(Xb + (m * D + e0) * 2); xw[q][1] = *(const u32x4*)(Xb + (m * D + 512 + e0) * 2);
#pragma unroll
                        for (int k = 0; k < 4; ++k) { const size_t row = (size_t)__builtin_amdgcn_readlane(rowv, 4 * (ti + q) + k);
                            gk[q][k] = __builtin_bit_cast(float, __builtin_amdgcn_readlane(__builtin_bit_cast(int, gv), 4 * (ti + q) + k));
                            yw[q][k][0] = *(const u32x4*)(YA + (row * D + e0) * 2); yw[q][k][1] = *(const u32x4*)(YA + (row * D + 512 + e0) * 2); } }
#pragma unroll
                    for (int q = 0; q < 2; ++q) { const size_t m = (size_t)mb + ti + q;
                        f32x4 v[4];
#pragma unroll
                        for (int hh = 0; hh < 2; ++hh) { const u32x4 w = xw[q][hh];
                            v[2 * hh] = (f32x4){bflo(w.x), bfhi(w.x), bflo(w.y), bfhi(w.y)} * DN_ALPHA; v[2 * hh + 1] = (f32x4){bflo(w.z), bfhi(w.z), bflo(w.w), bfhi(w.w)} * DN_ALPHA; }
#pragma unroll
                        for (int k = 0; k < 4; ++k)
#pragma unroll
                            for (int hh = 0; hh < 2; ++hh) { const u32x4 w = yw[q][k][hh];
                                v[2 * hh] = v[2 * hh] + (f32x4){bflo(w.x), bfhi(w.x), bflo(w.y), bfhi(w.y)} * gk[q][k]; v[2 * hh + 1] = v[2 * hh + 1] + (f32x4){bflo(w.z), bfhi(w.z), bflo(w.w), bfhi(w.w)} * gk[q][k]; }
                        ln16(v, g, bb);
                        if (lastl) {
#pragma unroll
                            for (int j = 0; j < 4; ++j) *(f32x4*)(Fo + m * D + (j >> 1) * 512 + e0 + (j & 1) * 4) = v[j];
                        } else {
#pragma unroll
                            for (int hh = 0; hh < 2; ++hh) { *(u32x4*)(Xo + (m * D + hh * 512 + e0) * 2) = pg8::pack8(v[2 * hh], v[2 * hh + 1]);
                                u32x2 f8w; f8w.x = pk4_f8(v[2 * hh].x * F8_SX, v[2 * hh].y * F8_SX, v[2 * hh].z * F8_SX, v[2 * hh].w * F8_SX); f8w.y = pk4_f8(v[2 * hh + 1].x * F8_SX, v[2 * hh + 1].y * F8_SX, v[2 * hh + 1].z * F8_SX, v[2 * hh + 1].w * F8_SX);
                                if (!dummy_) *(u32x2*)((char*)(ws + WS_XF8) + m * D + hh * 512 + e0) = f8w; }
                            gates8b(v, wgt, Go + m * 8, lane);
                        }
                    }
                }
            }
            __syncthreads();
        }
        SEAM(pb + 11);
    }
#undef IN
#undef SEAM
}

extern "C" void kernel_launch(void* const* d_in, const int* in_sizes, int n_in, void* d_out, int out_size, void* d_ws, size_t ws_size, hipStream_t stream) {
    static int grid = 0;
    if (grid == 0) {
        if (n_in != N_IN || out_size != M * D || ws_size < WS_END) { fprintf(stderr, "kernel_launch: unexpected shapes (n_in %d, out %d, ws %zu)\n", n_in, out_size, ws_size); grid = -1; return; }
        int dev = 0, cus = 0, per_cu = 0;
        if (hipGetDevice(&dev) != hipSuccess || hipDeviceGetAttribute(&cus, hipDeviceAttributeMultiprocessorCount, dev) != hipSuccess) { grid = -1; return; }
        if (hipFuncSetAttribute((const void*)fwd_kernel, hipFuncAttributeMaxDynamicSharedMemorySize, LDS_BYTES) != hipSuccess) { fprintf(stderr, "kernel_launch: hipFuncSetAttribute failed\n"); grid = -1; return; }
        if (hipOccupancyMaxActiveBlocksPerMultiprocessor(&per_cu, (const void*)fwd_kernel, NTHR, LDS_BYTES) != hipSuccess || per_cu < 1) fprintf(stderr, "kernel_launch: occupancy query reports %d\n", per_cu);
        (void)hipGetLastError();
        grid = cus;
    }
    if (grid < 0) return;
    (void)hipMemsetAsync((char*)d_ws + WS_CTL, 0, CTL_ZERO_BYTES, stream);
    Args a{};
    for (int i = 0; i < N_IN; ++i) a.in[i] = (const float*)d_in[i];
    a.out = (float*)d_out; a.ws = (unsigned char*)d_ws;
#if MK_ONE_LAUNCH
    a.ph_lo = 0; a.ph_hi = NPH;
    hipLaunchKernelGGL(fwd_kernel, dim3(grid), dim3(NTHR), LDS_BYTES, stream, a);
#else
    for (int p = 0; p < NPH; ++p) { a.ph_lo = p; a.ph_hi = p + 1; hipLaunchKernelGGL(fwd_kernel, dim3(grid), dim3(NTHR), LDS_BYTES, stream, a); }
#endif
    const hipError_t le = hipPeekAtLastError();
    if (le != hipSuccess) fprintf(stderr, "kernel_launch: launch failed: %s\n", hipGetErrorName(le));
}
```

```cpp
#include <hip/hip_runtime.h>
#include <cstdio>
#include <cstdint>

#ifndef MK_ONE_LAUNCH
#define MK_ONE_LAUNCH 1
#endif

#define LAS __attribute__((address_space(3)))
#define GAS __attribute__((address_space(1)))
typedef unsigned short bf16;
typedef short bf16x8 __attribute__((ext_vector_type(8)));
typedef float f32x4 __attribute__((ext_vector_type(4)));
typedef float f32x2 __attribute__((ext_vector_type(2)));
typedef float f32x16 __attribute__((ext_vector_type(16)));
typedef unsigned u32x4 __attribute__((ext_vector_type(4)));
typedef unsigned u32x2 __attribute__((ext_vector_type(2)));
typedef __bf16 bf16x2_t __attribute__((ext_vector_type(2)));
typedef GAS unsigned gu32;
#define RLX_AGENT __ATOMIC_RELAXED, __HIP_MEMORY_SCOPE_AGENT
#define DI __device__ __forceinline__

constexpr int NWAVES = 8, NTHR = 512;
constexpr int D = 1024, BATCH = 16, SEQ = 4096, M = BATCH * SEQ, DEPTH = 2, MEML = 256, MROWS = BATCH * MEML;
constexpr int DIN = 6920, NU = 6912;
constexpr int UC_QK = 0, UC_RW = 512, UC_V = 2304, UC_OG = 2816, UC_CAQ = 3328, UC_GATE = 3840;
constexpr int UC_F8 = UC_V, NF8 = NU - UC_F8;
__host__ __device__ constexpr int ucol_src(int c) { return c < 512 ? c : (c < 2304 ? 1544 + (c - 512) : (c < 2816 ? 512 + (c - 2304) : (c < 3328 ? 1024 + (c - 2816) : (c < 3840 ? 3336 + (c - 3328) : 3848 + (c - 3840))))); }
constexpr int NEXP = 32, TOPK = 4;
constexpr int PMAX = M * TOPK / 256 + NEXP;
constexpr float LN_EPS = 1e-5f, RW_GN_EPS = 64e-5f, DN_ALPHA = 1.41421356237f;

enum { I_X = 0, I_MEM, I_LNIN_G, I_LNIN_B, I_MEMLN_G, I_MEMLN_B, I_WIN, I_CONVW, I_CONVB, I_IGB, I_FGB, I_MLNORMG, I_RWMU, I_RWW0, I_RWWUP, I_RWA0, I_RWAUP, I_RWGUP,
       I_RWKK, I_RWKA, I_RWRK, I_RWLNG, I_RWLNB, I_CAWKV, I_GATEB, I_WBRML, I_WBRRW, I_WBRCA, I_WO, I_LN1G, I_LN1B, I_RTW, I_RTB, I_WGU, I_BGU, I_WDN, I_BDN, I_LN2G, I_LN2B, N_IN };

constexpr size_t MiB = 1u << 20;
constexpr size_t WS_CTL = 0, CTL_ZERO_BYTES = 1 * MiB;
constexpr size_t WS_WIN = 1 * MiB;
constexpr size_t WS_WKV = 28 * MiB;
constexpr size_t WS_WBR = 32 * MiB;
constexpr size_t WS_WO = 38 * MiB;
constexpr size_t WS_WLORA = 42 * MiB;
constexpr size_t WS_WGU = 45 * MiB;
constexpr size_t WS_WDN = 173 * MiB;
constexpr size_t WS_X = 237 * MiB;
constexpr size_t WS_MEMN = 365 * MiB;
constexpr size_t WS_KV = 373 * MiB;
constexpr size_t WS_GIF = 389 * MiB;
constexpr size_t WS_TKE = 391 * MiB, WS_TKG = 392 * MiB, WS_TKP = 393 * MiB;
constexpr size_t WS_ROWTOK = 394 * MiB;
constexpr size_t WS_HML = 402 * MiB;
constexpr size_t WS_R1 = 466 * MiB;
constexpr size_t WS_R2 = 1330 * MiB;
constexpr size_t WS_XF8 = 1858 * MiB;
constexpr size_t WS_WING8 = 1922 * MiB;
constexpr size_t WS_END = 1932 * MiB;
constexpr size_t R2_LORA_OUT = 0, R2_HCAT = 192 * MiB, R2_LORA_IN = 384 * MiB, R2_YPRE = 0, R2_Z = 192 * MiB, R2_HMID = 0;
constexpr int CW_TMO = 0, CW_BAR = 4096, CW_CNT = 16384, CW_FILL = 32768;

constexpr int LDS_BYTES = 155648;
constexpr int LDSCTL_OFF = 153600;

DI unsigned pk2(float lo, float hi) { bf16x2_t b = __builtin_convertvector((f32x2){lo, hi}, bf16x2_t); return __builtin_bit_cast(unsigned, b); }
DI unsigned f2bf(float f) { return pk2(f, 0.f) & 0xffffu; }
DI float u2f_(unsigned u) { return __builtin_bit_cast(float, u); }
DI unsigned f2u_(float f) { return __builtin_bit_cast(unsigned, f); }
DI float bflo(unsigned u) { return __builtin_bit_cast(float, u << 16); }
DI float bfhi(unsigned u) { return __builtin_bit_cast(float, u & 0xffff0000u); }
DI unsigned pk4_f8(float a, float b, float c, float d) {
    a = __builtin_amdgcn_fmed3f(a, -448.f, 448.f); b = __builtin_amdgcn_fmed3f(b, -448.f, 448.f); c = __builtin_amdgcn_fmed3f(c, -448.f, 448.f); d = __builtin_amdgcn_fmed3f(d, -448.f, 448.f);
    int w = 0; w = __builtin_amdgcn_cvt_pk_fp8_f32(a, b, w, false); w = __builtin_amdgcn_cvt_pk_fp8_f32(c, d, w, true); return (unsigned)w; }
DI float sigmoidf_(float x) { return __builtin_amdgcn_rcpf(1.f + __builtin_amdgcn_exp2f(-1.4426950408889634f * x)); }
template <int CTRL> DI float dppf(float x) { return __builtin_bit_cast(float, __builtin_amdgcn_update_dpp(0, __builtin_bit_cast(int, x), CTRL, 0xF, 0xF, true)); }
DI float red4(float x) { x += dppf<0xB1>(x); x += dppf<0x4E>(x); return x; }
DI float red8(float x) { x = red4(x); x += dppf<0x141>(x); return x; }
DI float red16(float x) { x = red8(x); x += dppf<0x140>(x); return x; }
DI float red8o(float x) { x += dppf<0xB1>(x); asm("" : "+v"(x)); x += dppf<0x4E>(x); asm("" : "+v"(x)); x += dppf<0x141>(x); asm("" : "+v"(x)); return x; }
DI float red16o(float x) { x = red8o(x); x += dppf<0x140>(x); asm("" : "+v"(x)); return x; }
typedef short s16x4 __attribute__((ext_vector_type(4)));
DI u32x2 trd4(const LAS unsigned char* img, int PB, int rowbase, int colbase, int lane) {
    const LAS unsigned char* p = img + (rowbase + ((lane & 15) >> 2)) * PB + (colbase + 16 * ((lane >> 4) & 1) + 4 * (lane & 3)) * 2;
    return __builtin_bit_cast(u32x2, __builtin_amdgcn_ds_read_tr16_b64_v4i16((LAS s16x4*)p)); }
DI bf16x8 trd8(const LAS unsigned char* img, int PB, int rb0, int rb1, int colbase, int lane) { const u32x2 lo = trd4(img, PB, rb0, colbase, lane), hi = trd4(img, PB, rb1, colbase, lane); return __builtin_bit_cast(bf16x8, (u32x4){lo.x, lo.y, hi.x, hi.y}); }
template <int CTRL, int RM> DI float dpp_keep(float x, float ident) { return __builtin_bit_cast(float, __builtin_amdgcn_update_dpp(__builtin_bit_cast(int, ident), __builtin_bit_cast(int, x), CTRL, RM, 0xF, false)); }
DI float scan_add64(float x) { x += dpp_keep<0x111, 0xF>(x, 0.f); x += dpp_keep<0x112, 0xF>(x, 0.f); x += dpp_keep<0x114, 0xF>(x, 0.f); x += dpp_keep<0x118, 0xF>(x, 0.f); x += dpp_keep<0x142, 0xA>(x, 0.f); x += dpp_keep<0x143, 0xC>(x, 0.f); return x; }
DI float scan_max64(float x) { const float NI = -3.0e38f; x = fmaxf(x, dpp_keep<0x111, 0xF>(x, NI)); x = fmaxf(x, dpp_keep<0x112, 0xF>(x, NI)); x = fmaxf(x, dpp_keep<0x114, 0xF>(x, NI)); x = fmaxf(x, dpp_keep<0x118, 0xF>(x, NI));
    x = fmaxf(x, dpp_keep<0x142, 0xA>(x, NI)); x = fmaxf(x, dpp_keep<0x143, 0xC>(x, NI)); return x; }
DI float wave_sum(float v) {
    v = red16(v);
    const int vi = __builtin_bit_cast(int, v);
    const float a = __builtin_bit_cast(float, __builtin_amdgcn_readlane(vi, 0)), b = __builtin_bit_cast(float, __builtin_amdgcn_readlane(vi, 16));
    const float c = __builtin_bit_cast(float, __builtin_amdgcn_readlane(vi, 32)), d = __builtin_bit_cast(float, __builtin_amdgcn_readlane(vi, 48));
    return (a + b) + (c + d);
}
#define LDS_WAIT() asm volatile("s_waitcnt lgkmcnt(0)" ::: "memory")

constexpr float F8_SX = 8.f, F8_SWGU = 512.f, F8_SH = 4.f, F8_SWDN = 1024.f, F8_INV1 = 1.f / (F8_SX * F8_SWGU), F8_INV2 = 1.f / (F8_SH * F8_SWDN);
namespace pg8 {
constexpr int BM = 256, BK = 64, HALF = 128, HTB = HALF * BK * 2, STAGE_BYTES = 8 * HTB, NXCD = 8, WGM = 8;
__host__ __device__ __forceinline__ int lds_byte(int r, int c) { const int st = (r >> 4) * 2 + (c >> 5), rr = r & 15, cc = c & 31, ob = rr * 64 + cc * 2; return st * 1024 + (ob ^ (((ob >> 9) & 1) << 5)); }
__host__ __device__ __forceinline__ void stage_rc(int b, int& R, int& C) { const int st = b / 1024, sb = b % 1024, swz = sb ^ (((sb >> 9) & 1) << 5); R = (st >> 1) * 16 + swz / 64; C = (st & 1) * 32 + (swz % 64) / 2; }
__host__ __device__ __forceinline__ int perm32(int rho) { const int n = rho >> 4, i = rho & 15; return 8 * (i >> 2) + 4 * n + (i & 3); }

struct Unit { const char* a; const char* b; char* c; int ldc; int r0, c0, e, sub; };

struct TileOrder {
    int nM, nN, nwg;
    DI void init(int nM_, int nN_) { nM = nM_; nN = nN_; nwg = nM * nN; }
    DI bool tile(long L, int& pm, int& pn) const {
        if (L >= nwg) return false;
        int wgid = (int)L; { const int q = nwg / NXCD, r = nwg % NXCD, xcd = wgid % NXCD, off = wgid / NXCD; wgid = (xcd < r ? xcd * (q + 1) : r * (q + 1) + (xcd - r) * q) + off; }
        const int nig = WGM * nN, gid = wgid / nig, fm = gid * WGM, gsz = (nM - fm) < WGM ? (nM - fm) : WGM;
        pm = fm + ((wgid % nig) % gsz); pn = (wgid % nig) / gsz; return true;
    }
};

DI u32x4 pack8(const f32x4& v0, const f32x4& v1) { u32x4 w; w.x = pk2(v0[0], v0[1]); w.y = pk2(v0[2], v0[3]); w.z = pk2(v1[0], v1[1]); w.w = pk2(v1[2], v1[3]); return w; }

struct EpiStore {
    DI void operator()(const f32x4 (&acc)[2][2][4][2], const Unit& u, int wr, int wc, int fr, int fq) const {
#pragma unroll
        for (int ai = 0; ai < 2; ++ai)
#pragma unroll
            for (int m = 0; m < 4; ++m) { char* rowp = u.c + ((size_t)(ai * HALF + wr * 64 + m * 16 + fr) * u.ldc + wc * 32 + 8 * fq) * 2;
#pragma unroll
                for (int bj = 0; bj < 2; ++bj) *(u32x4*)(rowp + bj * 256) = pack8(acc[ai][bj][m][0], acc[ai][bj][m][1]); }
    }
};
struct EpiStoreS {
    float s; const float* gate_b; int gate_c0;
    DI void operator()(const f32x4 (&acc)[2][2][4][2], const Unit& u, int wr, int wc, int fr, int fq) const {
        const bool gate = u.c0 >= gate_c0;
        const float L2E = 1.4426950408889634f;
#pragma unroll
        for (int bj = 0; bj < 2; ++bj) {
            f32x4 g0 = (f32x4){0.f, 0.f, 0.f, 0.f}, g1 = g0;
            if (gate) { const float* g = gate_b + (u.c0 - gate_c0) + bj * HALF + wc * 32 + 8 * fq; g0 = *(const f32x4*)g; g1 = *(const f32x4*)(g + 4); }
#pragma unroll
            for (int ai = 0; ai < 2; ++ai)
#pragma unroll
                for (int m = 0; m < 4; ++m) { char* rowp = u.c + ((size_t)(ai * HALF + wr * 64 + m * 16 + fr) * u.ldc + wc * 32 + 8 * fq) * 2;
                    f32x4 v0 = acc[ai][bj][m][0] * s, v1 = acc[ai][bj][m][1] * s;
                    if (gate) {
#pragma unroll
                        for (int i = 0; i < 4; ++i) { v0[i] = __builtin_amdgcn_exp2f(-L2E * __builtin_amdgcn_fmed3f(v0[i] + g0[i], -30.f, 30.f)); v1[i] = __builtin_amdgcn_exp2f(-L2E * __builtin_amdgcn_fmed3f(v1[i] + g1[i], -30.f, 30.f)); } }
                    *(u32x4*)(rowp + bj * 256) = pack8(v0, v1); }
        }
    }
};
struct EpiMerge {
    static constexpr bool MIDK = true;
    const char* U; const float* gate_b;
    DI void mid(f32x4 (&acc)[2][2][4][2], const Unit& u, int which, int wr, int wc, int fr, int fq) const {
        u32x4 wa[3][2], wn[3][2];
        const char* g0 = U + ((size_t)(u.r0 + wr * 64 + fr) * NU + UC_GATE + which * 1024 + u.c0 + wc * 32 + 8 * fq) * 2;
#define MID_LD(j, buf) do { _Pragma("unroll") for (int mm = 0; mm < 2; ++mm) { const char* gp = g0 + (size_t)((((j) >> 1) & 1) * HALF + (2 * ((j) & 1) + mm) * 16) * NU * 2 + ((j) >> 2) * 256; \
            wa[buf][mm] = *(const u32x4*)gp; wn[buf][mm] = *(const u32x4*)(gp + 2048); } } while (0)
        MID_LD(0, 0); MID_LD(1, 1); MID_LD(2, 2);
#pragma unroll
        for (int j = 0; j < 8; ++j) {
            const int bj = j >> 2, ai = (j >> 1) & 1, buf = j % 3;
#pragma unroll
            for (int mm = 0; mm < 2; ++mm) { const int m = 2 * (j & 1) + mm;
                const u32x4 a = wa[buf][mm], n = wn[buf][mm];
                const float ea[8] = {bflo(a.x), bfhi(a.x), bflo(a.y), bfhi(a.y), bflo(a.z), bfhi(a.z), bflo(a.w), bfhi(a.w)};
                const float en[8] = {bflo(n.x), bfhi(n.x), bflo(n.y), bfhi(n.y), bflo(n.z), bfhi(n.z), bflo(n.w), bfhi(n.w)};
#pragma unroll
                for (int i = 0; i < 8; ++i) acc[ai][bj][m][i >> 2][i & 3] *= (1.f + en[i]) * __builtin_amdgcn_rcpf(1.f + ea[i]); }
            if (j == 0) MID_LD(3, 0); else if (j == 1) MID_LD(4, 1); else if (j == 2) MID_LD(5, 2); else if (j == 3) MID_LD(6, 0); else if (j == 4) MID_LD(7, 1);
        }
#undef MID_LD
    }
    DI void operator()(const f32x4 (&acc)[2][2][4][2], const Unit& u, int wr, int wc, int fr, int fq) const {
#pragma unroll
        for (int bj = 0; bj < 2; ++bj) {
            u32x4 gw[2][4];
#pragma unroll
            for (int ai = 0; ai < 2; ++ai)
#pragma unroll
                for (int m = 0; m < 4; ++m) { const int lr = ai * HALF + wr * 64 + m * 16 + fr; gw[ai][m] = *(const u32x4*)(U + ((size_t)(u.r0 + lr) * NU + UC_GATE + 2048 + u.c0 + wc * 32 + 8 * fq) * 2 + bj * 256); }
#pragma unroll
            for (int ai = 0; ai < 2; ++ai)
#pragma unroll
                for (int m = 0; m < 4; ++m) { const int lr = ai * HALF + wr * 64 + m * 16 + fr; char* rowp = u.c + ((size_t)lr * u.ldc + wc * 32 + 8 * fq) * 2; const u32x4 w = gw[ai][m];
                    f32x4 v0 = acc[ai][bj][m][0], v1 = acc[ai][bj][m][1];
                    v0[0] *= __builtin_amdgcn_rcpf(1.f + bflo(w.x)); v0[1] *= __builtin_amdgcn_rcpf(1.f + bfhi(w.x)); v0[2] *= __builtin_amdgcn_rcpf(1.f + bflo(w.y)); v0[3] *= __builtin_amdgcn_rcpf(1.f + bfhi(w.y));
                    v1[0] *= __builtin_amdgcn_rcpf(1.f + bflo(w.z)); v1[1] *= __builtin_amdgcn_rcpf(1.f + bfhi(w.z)); v1[2] *= __builtin_amdgcn_rcpf(1.f + bflo(w.w)); v1[3] *= __builtin_amdgcn_rcpf(1.f + bfhi(w.w));
                    *(u32x4*)(rowp + bj * 256) = pack8(v0, v1); }
            asm volatile("" ::: "memory");
        }
    }
};
struct EpiWo {
    const char* X;
    DI void operator()(const f32x4 (&acc)[2][2][4][2], const Unit& u, int wr, int wc, int fr, int fq) const {
#pragma unroll
        for (int ai = 0; ai < 2; ++ai)
#pragma unroll
            for (int m = 0; m < 4; ++m) { const int lr = ai * HALF + wr * 64 + m * 16 + fr; char* rowp = u.c + ((size_t)lr * u.ldc + wc * 32 + 8 * fq) * 2;
                const char* xp = X + ((size_t)(u.r0 + lr) * D + u.c0 + wc * 32 + 8 * fq) * 2;
#pragma unroll
                for (int bj = 0; bj < 2; ++bj) { const u32x4 xw = *(const u32x4*)(xp + bj * 256);
                    f32x4 v0 = acc[ai][bj][m][0], v1 = acc[ai][bj][m][1];
                    v0[0] += DN_ALPHA * bflo(xw.x); v0[1] += DN_ALPHA * bfhi(xw.x); v0[2] += DN_ALPHA * bflo(xw.y); v0[3] += DN_ALPHA * bfhi(xw.y);
                    v1[0] += DN_ALPHA * bflo(xw.z); v1[1] += DN_ALPHA * bfhi(xw.z); v1[2] += DN_ALPHA * bflo(xw.w); v1[3] += DN_ALPHA * bfhi(xw.w);
                    *(u32x4*)(rowp + bj * 256) = pack8(v0, v1); }
                asm volatile("" ::: "memory"); }
    }
};
DI float swiglu1(float a, float b) { const float g = fminf(a, 7.f), l = fminf(fmaxf(b, -7.f), 7.f); return g * sigmoidf_(1.702f * g) * (l + 1.f); }
struct EpiMoe1 {
    const float* bgu;
    DI void operator()(const f32x4 (&acc)[2][2][4][2], const Unit& u, int wr, int wc, int fr, int fq) const {
        f32x4 bv[2][2];
#pragma unroll
        for (int bj = 0; bj < 2; ++bj) { const float* b = bgu + u.e * 2048 + u.c0 + bj * HALF + wc * 32 + 8 * fq; bv[bj][0] = *(const f32x4*)b; bv[bj][1] = *(const f32x4*)(b + 4); }
#pragma unroll
        for (int ai = 0; ai < 2; ++ai)
#pragma unroll
            for (int m = 0; m < 4; ++m) { const int lr = ai * HALF + wr * 64 + m * 16 + fr; char* rowp = u.c + ((size_t)lr * u.ldc + wc * 16 + 4 * fq);
#pragma unroll
                for (int bj = 0; bj < 2; ++bj) { const f32x4 v0 = acc[ai][bj][m][0] * F8_INV1 + bv[bj][0], v1 = acc[ai][bj][m][1] * F8_INV1 + bv[bj][1];
                    *(unsigned*)(rowp + bj * 64) = pk4_f8(swiglu1(v0[0], v0[1]) * F8_SH, swiglu1(v0[2], v0[3]) * F8_SH, swiglu1(v1[0], v1[1]) * F8_SH, swiglu1(v1[2], v1[3]) * F8_SH); } }
    }
};
struct EpiMoe2 {
    const float* bdn;
    DI void operator()(const f32x4 (&acc)[2][2][4][2], const Unit& u, int wr, int wc, int fr, int fq) const {
        f32x4 bv[2][2];
#pragma unroll
        for (int bj = 0; bj < 2; ++bj) { const float* b = bdn + u.e * 1024 + u.c0 + bj * HALF + wc * 32 + 8 * fq; bv[bj][0] = *(const f32x4*)b; bv[bj][1] = *(const f32x4*)(b + 4); }
#pragma unroll
        for (int ai = 0; ai < 2; ++ai)
#pragma unroll
            for (int m = 0; m < 4; ++m) { char* rowp = u.c + ((size_t)(ai * HALF + wr * 64 + m * 16 + fr) * u.ldc + wc * 32 + 8 * fq) * 2;
#pragma unroll
                for (int bj = 0; bj < 2; ++bj) *(u32x4*)(rowp + bj * 256) = pack8(acc[ai][bj][m][0] * F8_INV2 + bv[bj][0], acc[ai][bj][m][1] * F8_INV2 + bv[bj][1]); }
    }
};

typedef int i32x8 __attribute__((ext_vector_type(8)));
typedef int i32x4 __attribute__((ext_vector_type(4)));
template <bool F8, bool MIDK = false, class Epi, class Sched>
DI void gemm_phase(LAS unsigned char* lds, const int KB  , const int ldaB, const int ldbB, const Sched& S, const Epi& E, const int wave_) {
    unsigned z_ = 0u; asm volatile("" : "+v"(z_)); const int tid = wave_ * 64 + (int)__builtin_amdgcn_mbcnt_hi(~0u, __builtin_amdgcn_mbcnt_lo(~0u, z_));
    const int wid = __builtin_amdgcn_readfirstlane(tid >> 6), lane = tid & 63, wr = wid >> 2, wc = wid & 3, fr = lane & 15, fq = lane >> 4;
    const int nt = KB / (BK * 2);
    unsigned voffA[2], voffB[2];
#pragma unroll
    for (int i = 0; i < 2; ++i) { int R, C; stage_rc(tid * 16 + i * 8192, R, C); const int Rb = (R & ~31) + perm32(R & 31);
        voffA[i] = (unsigned)(R * ldaB + C * 2); voffB[i] = (unsigned)(Rb * ldbB + C * 2); }
    asm volatile("" : "+v"(voffA[0]), "+v"(voffA[1]), "+v"(voffB[0]), "+v"(voffB[1]));
    const size_t kstep = (size_t)(BK * 2);
    const size_t hstepA = (size_t)HALF * ldaB, hstepB = (size_t)HALF * ldbB;
    const unsigned ldsw = (unsigned)wid * 1024u;
    const int aoff = lds_byte(wr * 64 + fr, fq * 8), boff = lds_byte(wc * 32 + fr, fq * 8);
#define PG8_SA(b, h) (((b) * 2 + (h)) * HTB)
#define PG8_SB(b, h) ((4 + (b) * 2 + (h)) * HTB)
#define PG8_STAGE(bufoff, gbase, voff) do { _Pragma("unroll") for (int _i = 0; _i < 2; ++_i) \
        __builtin_amdgcn_global_load_lds((const unsigned*)((const char*)(gbase) + (voff)[_i]), (LAS unsigned*)(lds + (bufoff) + ldsw + _i * 8192), 16, 0, 0); } while (0)
#define PG8_LD8(p) __builtin_shufflevector(*(const LAS i32x4*)(p), *(const LAS i32x4*)((p) + 1024), 0, 1, 2, 3, 4, 5, 6, 7)
#define PG8_LDA8(dst, b, h) do { _Pragma("unroll") for (int m = 0; m < 4; ++m) dst[m] = PG8_LD8(lds + PG8_SA(b, h) + aoff + m * 2048); } while (0)
#define PG8_LDB8(dst, b, h) do { _Pragma("unroll") for (int n = 0; n < 2; ++n) dst[n] = PG8_LD8(lds + PG8_SB(b, h) + boff + n * 2048); } while (0)
#define PG8_MMA8(ai, bj, A8, B8) do { __builtin_amdgcn_s_setprio(1); _Pragma("unroll") for (int m = 0; m < 4; ++m) _Pragma("unroll") for (int n = 0; n < 2; ++n) \
        asm volatile("v_mfma_f32_16x16x128_f8f6f4 %0, %1, %2, %0" : "+v"(acc[ai][bj][m][n]) : "v"(B8[n]), "v"(A8[m])); __builtin_amdgcn_s_setprio(0); } while (0)
#define PG8_LDA(dst, b, h) do { _Pragma("unroll") for (int m = 0; m < 4; ++m) _Pragma("unroll") for (int k = 0; k < 2; ++k) dst[m][k] = *(const LAS bf16x8*)(lds + PG8_SA(b, h) + aoff + m * 2048 + k * 1024); } while (0)
#define PG8_LDB(dst, b, h) do { _Pragma("unroll") for (int n = 0; n < 2; ++n) _Pragma("unroll") for (int k = 0; k < 2; ++k) dst[n][k] = *(const LAS bf16x8*)(lds + PG8_SB(b, h) + boff + n * 2048 + k * 1024); } while (0)
#define PG8_CAT(x) __builtin_shufflevector(__builtin_bit_cast(i32x4, (x)[0]), __builtin_bit_cast(i32x4, (x)[1]), 0, 1, 2, 3, 4, 5, 6, 7)
#define PG8_MMA(ai, bj, At, Bt) do { __builtin_amdgcn_s_setprio(1); _Pragma("unroll") for (int m = 0; m < 4; ++m) _Pragma("unroll") for (int n = 0; n < 2; ++n) _Pragma("unroll") for (int k = 0; k < 2; ++k) \
        acc[ai][bj][m][n] = __builtin_amdgcn_mfma_f32_16x16x32_bf16(Bt[n][k], At[m][k], acc[ai][bj][m][n], 0, 0, 0); __builtin_amdgcn_s_setprio(0); } while (0)
#define PG8_WAIT_V(n) asm volatile("s_waitcnt vmcnt(" #n ")" ::: "memory")
#define PG8_WAIT_L(n) asm volatile("s_waitcnt lgkmcnt(" #n ")" ::: "memory")
#define PG8_BAR __builtin_amdgcn_s_barrier()
#define PG8_SCHED __builtin_amdgcn_sched_barrier(0)
    Unit cur, nxt; int ui = 0;
    if (!S.next(0, cur)) return;
    f32x4 acc[2][2][4][2];
#pragma unroll
    for (int a = 0; a < 2; ++a)
#pragma unroll
        for (int b = 0; b < 2; ++b)
#pragma unroll
            for (int m = 0; m < 4; ++m)
#pragma unroll
                for (int n = 0; n < 2; ++n) acc[a][b][m][n] = (f32x4){0.f, 0.f, 0.f, 0.f};
    bf16x8 At[4][2], B0[2][2], B1[2][2]; i32x8 A8[4], B80[2], B81[2];
    const char* cA = cur.a; const char* cB = cur.b;
    PG8_STAGE(PG8_SB(0, 0), cB, voffB); PG8_STAGE(PG8_SB(0, 1), cB + hstepB, voffB); PG8_STAGE(PG8_SA(0, 0), cA, voffA); PG8_STAGE(PG8_SA(0, 1), cA + hstepA, voffA);
    if (wr == 1) PG8_BAR;
    PG8_WAIT_V(2); PG8_BAR;
    PG8_STAGE(PG8_SB(1, 0), cB + kstep, voffB); PG8_STAGE(PG8_SA(1, 0), cA + kstep, voffA); PG8_STAGE(PG8_SB(1, 1), cB + hstepB + kstep, voffB);
    PG8_WAIT_V(6); PG8_BAR;
    for (;;) {
        const bool has_next = S.next(ui + 1, nxt);
        const char* nA = has_next ? nxt.a : cA; const char* nB = has_next ? nxt.b : cB;
#pragma unroll 1
        for (int t = 0; t < nt; t += 2) {
            if constexpr (MIDK) { if (t == 8 || t == 16) { int fr_ = fr, fq_ = fq; asm volatile("" : "+v"(fr_), "+v"(fq_)); E.mid(acc, cur, t >> 4, wr, wc, fr_, fq_); } }
            const bool last = (t == nt - 2);
            const char* a1 = cA + (size_t)(t + 1) * kstep;
            const char* a2 = last ? nA : cA + (size_t)(t + 2) * kstep; const char* b2 = last ? nB : cB + (size_t)(t + 2) * kstep;
            const char* a3 = a2 + kstep; const char* b3 = b2 + kstep;
            if constexpr (F8) {
            PG8_LDB8(B80, 0, 0); PG8_LDB8(B81, 0, 1); PG8_SCHED; PG8_LDA8(A8, 0, 0); PG8_STAGE(PG8_SA(1, 1), a1 + hstepA, voffA);
            PG8_WAIT_V(8); PG8_WAIT_L(0); PG8_BAR; PG8_MMA8(0, 0, A8, B80); PG8_MMA8(0, 1, A8, B81); PG8_BAR; PG8_SCHED;
            PG8_LDA8(A8, 0, 1); PG8_STAGE(PG8_SB(0, 0), b2, voffB); PG8_STAGE(PG8_SB(0, 1), b2 + hstepB, voffB); PG8_STAGE(PG8_SA(0, 0), a2, voffA);
            PG8_WAIT_V(8); PG8_WAIT_L(0); PG8_BAR; PG8_MMA8(1, 0, A8, B80); PG8_MMA8(1, 1, A8, B81); PG8_BAR; PG8_SCHED;
            PG8_LDB8(B80, 1, 0); PG8_LDB8(B81, 1, 1); PG8_SCHED; PG8_LDA8(A8, 1, 0); PG8_STAGE(PG8_SA(0, 1), a2 + hstepA, voffA);
            PG8_WAIT_V(8); PG8_WAIT_L(0); PG8_BAR; PG8_MMA8(0, 0, A8, B80); PG8_MMA8(0, 1, A8, B81); PG8_BAR; PG8_SCHED;
            PG8_LDA8(A8, 1, 1); PG8_STAGE(PG8_SB(1, 0), b3, voffB); PG8_STAGE(PG8_SB(1, 1), b3 + hstepB, voffB); PG8_STAGE(PG8_SA(1, 0), a3, voffA);
            PG8_WAIT_V(8); PG8_WAIT_L(0); PG8_BAR; PG8_MMA8(1, 0, A8, B80); PG8_MMA8(1, 1, A8, B81); PG8_BAR; PG8_SCHED;
            } else {
            PG8_LDB(B0, 0, 0); PG8_LDB(B1, 0, 1); PG8_SCHED; PG8_LDA(At, 0, 0); PG8_STAGE(PG8_SA(1, 1), a1 + hstepA, voffA);
            PG8_WAIT_V(8); PG8_WAIT_L(0); PG8_BAR; PG8_MMA(0, 0, At, B0); PG8_MMA(0, 1, At, B1); PG8_BAR; PG8_SCHED;
            PG8_LDA(At, 0, 1); PG8_STAGE(PG8_SB(0, 0), b2, voffB); PG8_STAGE(PG8_SB(0, 1), b2 + hstepB, voffB); PG8_STAGE(PG8_SA(0, 0), a2, voffA);
            PG8_WAIT_V(8); PG8_WAIT_L(0); PG8_BAR; PG8_MMA(1, 0, At, B0); PG8_MMA(1, 1, At, B1); PG8_BAR; PG8_SCHED;
            PG8_LDB(B0, 1, 0); PG8_LDB(B1, 1, 1); PG8_SCHED; PG8_LDA(At, 1, 0); PG8_STAGE(PG8_SA(0, 1), a2 + hstepA, voffA);
            PG8_WAIT_V(8); PG8_WAIT_L(0); PG8_BAR; PG8_MMA(0, 0, At, B0); PG8_MMA(0, 1, At, B1); PG8_BAR; PG8_SCHED;
            PG8_LDA(At, 1, 1); PG8_STAGE(PG8_SB(1, 0), b3, voffB); PG8_STAGE(PG8_SB(1, 1), b3 + hstepB, voffB); PG8_STAGE(PG8_SA(1, 0), a3, voffA);
            PG8_WAIT_V(8); PG8_WAIT_L(0); PG8_BAR; PG8_MMA(1, 0, At, B0); PG8_MMA(1, 1, At, B1); PG8_BAR; PG8_SCHED;
            }
        }
        if (wr == 0) PG8_BAR;
        if constexpr (F8) asm volatile("s_nop 15\n\ts_nop 15" ::: "memory");
        { int fr_ = fr, fq_ = fq; asm volatile("" : "+v"(fr_), "+v"(fq_));
          E(acc, cur, wr, wc, fr_, fq_); }
        if (!has_next) break;
#pragma unroll
        for (int a = 0; a < 2; ++a)
#pragma unroll
            for (int b = 0; b < 2; ++b)
#pragma unroll
                for (int m = 0; m < 4; ++m)
#pragma unroll
                    for (int n = 0; n < 2; ++n) acc[a][b][m][n] = (f32x4){0.f, 0.f, 0.f, 0.f};
        cur = nxt; cA = nA; cB = nB; ++ui;
        if (wr == 1) PG8_BAR;
    }
    PG8_WAIT_V(0);
    PG8_BAR;
#undef PG8_SA
#undef PG8_SB
#undef PG8_STAGE
#undef PG8_LDA
#undef PG8_LDB
#undef PG8_MMA
#undef PG8_CAT
#undef PG8_LD8
#undef PG8_LDA8
#undef PG8_LDB8
#undef PG8_MMA8
#undef PG8_WAIT_V
#undef PG8_WAIT_L
#undef PG8_BAR
#undef PG8_SCHED
}
}

#define XB_TMO      128
#define XB_XCNT(j)  (256  + 64 * (j))
#define XB_XSUB(j)  (1280 + 64 * (j))
#define XB_XGEN(j)  (2304 + 64 * (j))
#define XB_TOP      3328
#define XB_TOPGEN   3392
#define XCD_BAR_WORDS 3456
#define XB_SPIN_CAP (1u << 22)
DI unsigned xb_ld(unsigned* p)              { return __hip_atomic_load(p, __ATOMIC_RELAXED, __HIP_MEMORY_SCOPE_AGENT); }
DI unsigned xb_add(unsigned* p, unsigned v) { return __hip_atomic_fetch_add(p, v, __ATOMIC_RELAXED, __HIP_MEMORY_SCOPE_AGENT); }
DI unsigned xb_xcc_id() { return (unsigned)__builtin_amdgcn_s_getreg((3 << 11) | 20) & 0xFu; }
#define XB_SPIN(cond, bar) do { unsigned _sp = 0; while (cond) { __builtin_amdgcn_s_sleep(1); \
    if ((++_sp & 255u) == 0u) { if (xb_ld(&(bar)[XB_TMO])) break; if (_sp > XB_SPIN_CAP) { atomicAdd(&(bar)[XB_TMO], 1u); break; } } } } while (0)
struct XcdBarrier { unsigned* bar; unsigned x; volatile LAS unsigned* st; };
DI XcdBarrier xcd_barrier_post(unsigned* bar, volatile LAS unsigned* st) {
    XcdBarrier b; b.bar = bar; b.x = xb_xcc_id(); b.st = st;
    if (threadIdx.x == 0) (void)xb_add(&bar[XB_XCNT(b.x)], 1u);
    return b;
}
DI void xcd_barrier_complete(unsigned* bar, unsigned x, unsigned& nloc, unsigned& nx) {
    const unsigned G = gridDim.x * gridDim.y * gridDim.z;
    unsigned sum, cnt, mine, sp = 0u;
    for (;;) {
        sum = 0u; cnt = 0u; mine = 0u;
#pragma unroll
        for (unsigned j = 0; j < 16; ++j) { const unsigned c = xb_ld(&bar[XB_XCNT(j)]); sum += c; cnt += (c > 0u) ? 1u : 0u; mine = (j == x) ? c : mine; }
        if (sum == G) break;
        __builtin_amdgcn_s_sleep(1);
        if ((++sp & 255u) == 0u) { if (xb_ld(&bar[XB_TMO])) break; if (sp > XB_SPIN_CAP) { atomicAdd(&bar[XB_TMO], 1u); break; } }
    }
    nloc = mine > 0u ? mine : 1u; nx = cnt > 0u ? cnt : 1u;
}
DI void xcd_barrier(const XcdBarrier& b) {
    asm volatile("s_waitcnt vmcnt(0)" ::: "memory");
    __syncthreads();
    if (threadIdx.x == 0) {
        unsigned* bar = b.bar;
        __builtin_amdgcn_s_waitcnt(0);
        unsigned nloc = b.st[0], nx = b.st[1];
        if (nloc == 0u) { xcd_barrier_complete(bar, b.x, nloc, nx); b.st[0] = nloc; b.st[1] = nx; }
        const unsigned old = xb_add(&bar[XB_XSUB(b.x)], 1u);
        const unsigned gen = old / nloc;
        if (old + 1u == (gen + 1u) * nloc) {
            __builtin_amdgcn_fence(__ATOMIC_RELEASE, "agent");
            asm volatile("s_waitcnt vmcnt(0)" ::: "memory");
            const unsigned og = xb_add(&bar[XB_TOP], 1u);
            const unsigned tg = og / nx;
            if (og + 1u == (tg + 1u) * nx) xb_add(&bar[XB_TOPGEN], 1u);
            else XB_SPIN(xb_ld(&bar[XB_TOPGEN]) == tg, bar);
            __builtin_amdgcn_fence(__ATOMIC_ACQUIRE, "agent");
            xb_add(&bar[XB_XGEN(b.x)], 1u);
            asm volatile("s_waitcnt vmcnt(0)" ::: "memory");
        } else {
            XB_SPIN(xb_ld(&bar[XB_XGEN(b.x)]) == gen, bar);
            __builtin_amdgcn_fence(__ATOMIC_ACQUIRE, "agent");
            asm volatile("s_waitcnt vmcnt(0)" ::: "memory");
        }
    }
    __syncthreads();
}

DI void transpose_item(const float* W, int ldw, bf16* WT, int ldt, LAS float* scr, int lane) {
    { const int kr = lane >> 3, c4 = (lane & 7) * 4; f32x4 v[8];
#pragma unroll
        for (int i = 0; i < 8; ++i) v[i] = *(const f32x4*)(W + (size_t)(8 * i + kr) * ldw + c4);
#pragma unroll
        for (int i = 0; i < 8; ++i) { LAS float* o = scr + (8 * i + kr) * 33 + c4; o[0] = v[i].x; o[1] = v[i].y; o[2] = v[i].z; o[3] = v[i].w; } }
    LDS_WAIT(); asm volatile("" ::: "memory");
    const int c = lane & 7;
#pragma unroll
    for (int j = 0; j < 4; ++j) { const int n = (lane >> 3) + 8 * j; const LAS float* s = scr + (8 * c) * 33 + n;
        u32x4 o; o.x = pk2(s[0 * 33], s[1 * 33]); o.y = pk2(s[2 * 33], s[3 * 33]); o.z = pk2(s[4 * 33], s[5 * 33]); o.w = pk2(s[6 * 33], s[7 * 33]);
        *(u32x4*)(WT + (size_t)n * ldt + 8 * c) = o; }
    LDS_WAIT(); asm volatile("" ::: "memory");
}
DI void transpose_item_f8(const float* W, int ldw, unsigned char* WT, int ldt, float scale, LAS float* scr, int lane) {
    { const int kr = lane >> 3, c4 = (lane & 7) * 4; f32x4 v[8];
#pragma unroll
        for (int i = 0; i < 8; ++i) v[i] = *(const f32x4*)(W + (size_t)(8 * i + kr) * ldw + c4);
#pragma unroll
        for (int i = 0; i < 8; ++i) { LAS float* o = scr + (8 * i + kr) * 33 + c4; o[0] = v[i].x; o[1] = v[i].y; o[2] = v[i].z; o[3] = v[i].w; } }
    LDS_WAIT(); asm volatile("" ::: "memory");
    const int c = lane & 3;
#pragma unroll
    for (int j = 0; j < 2; ++j) { const int n = (lane >> 2) + 16 * j; const LAS float* s = scr + (16 * c) * 33 + n;
        u32x4 o; o.x = pk4_f8(s[0 * 33] * scale, s[1 * 33] * scale, s[2 * 33] * scale, s[3 * 33] * scale); o.y = pk4_f8(s[4 * 33] * scale, s[5 * 33] * scale, s[6 * 33] * scale, s[7 * 33] * scale);
        o.z = pk4_f8(s[8 * 33] * scale, s[9 * 33] * scale, s[10 * 33] * scale, s[11 * 33] * scale); o.w = pk4_f8(s[12 * 33] * scale, s[13 * 33] * scale, s[14 * 33] * scale, s[15 * 33] * scale);
        *(u32x4*)(WT + (size_t)n * ldt + 16 * c) = o; }
    LDS_WAIT(); asm volatile("" ::: "memory");
}
DI void ti_load(const float* W, int ldw, int lane, f32x4 (&v)[8]) {
    const int kr = lane >> 3, c4 = (lane & 7) * 4;
#pragma unroll
    for (int i = 0; i < 8; ++i) v[i] = *(const f32x4*)(W + (size_t)(8 * i + kr) * ldw + c4);
}
DI void ti_store_f8(const f32x4 (&v)[8], unsigned char* WT, int ldt, float scale, LAS float* scr, int lane) {
    { const int kr = lane >> 3, c4 = (lane & 7) * 4;
#pragma unroll
        for (int i = 0; i < 8; ++i) { LAS float* o = scr + (8 * i + kr) * 33 + c4; o[0] = v[i].x; o[1] = v[i].y; o[2] = v[i].z; o[3] = v[i].w; } }
    LDS_WAIT(); asm volatile("" ::: "memory");
    const int c = lane & 3;
#pragma unroll
    for (int j = 0; j < 2; ++j) { const int n = (lane >> 2) + 16 * j; const LAS float* s = scr + (16 * c) * 33 + n;
        u32x4 o; o.x = pk4_f8(s[0 * 33] * scale, s[1 * 33] * scale, s[2 * 33] * scale, s[3 * 33] * scale); o.y = pk4_f8(s[4 * 33] * scale, s[5 * 33] * scale, s[6 * 33] * scale, s[7 * 33] * scale);
        o.z = pk4_f8(s[8 * 33] * scale, s[9 * 33] * scale, s[10 * 33] * scale, s[11 * 33] * scale); o.w = pk4_f8(s[12 * 33] * scale, s[13 * 33] * scale, s[14 * 33] * scale, s[15 * 33] * scale);
        *(u32x4*)(WT + (size_t)n * ldt + 16 * c) = o; }
    LDS_WAIT(); asm volatile("" ::: "memory");
}
DI void ti_load4(const float* W, int ldw, int lane, f32x4 (&v)[8]) {
    const int a = lane & 15, g = lane >> 4;
#pragma unroll
    for (int b = 0; b < 2; ++b)
#pragma unroll
        for (int j = 0; j < 4; ++j) v[4 * b + j] = *(const f32x4*)(W + (size_t)(4 * a + j) * ldw + 4 * (g + 4 * b));
}
DI void ti_store4_f8(const f32x4 (&v)[8], unsigned char* WT, int ldt, float scale, int lane) {
    const int a = lane & 15, g = lane >> 4;
#pragma unroll
    for (int b = 0; b < 2; ++b)
#pragma unroll
        for (int q = 0; q < 4; ++q)
            *(unsigned*)(WT + (size_t)(4 * (g + 4 * b) + q) * ldt + 4 * a) = pk4_f8(v[4 * b][q] * scale, v[4 * b + 1][q] * scale, v[4 * b + 2][q] * scale, v[4 * b + 3][q] * scale);
}
DI void ln16(f32x4 (&v)[4], const f32x4 (&g)[4], const f32x4 (&b)[4]) {
    float s = 0.f;
#pragma unroll
    for (int j = 0; j < 4; ++j) s += (v[j].x + v[j].y) + (v[j].z + v[j].w);
    const float mean = wave_sum(s) * (1.f / D); float s2 = 0.f;
#pragma unroll
    for (int j = 0; j < 4; ++j) { v[j] = v[j] - mean; s2 += (v[j].x * v[j].x + v[j].y * v[j].y) + (v[j].z * v[j].z + v[j].w * v[j].w); }
    const float rstd = 1.f / sqrtf(wave_sum(s2) * (1.f / D) + LN_EPS);
#pragma unroll
    for (int j = 0; j < 4; ++j) v[j] = v[j] * rstd * g[j] + b[j];
}
DI void gates8(const f32x4 (&y)[4], const LAS float* wgt, float* gif_row, int lane) {
    float p[8];
#pragma unroll
    for (int j = 0; j < 8; ++j) { float s = 0.f;
#pragma unroll
        for (int jj = 0; jj < 4; ++jj) { const f32x4 w = *(const LAS f32x4*)(wgt + j * 1024 + 256 * jj + 4 * lane); s += (y[jj].x * w.x + y[jj].y * w.y) + (y[jj].z * w.z + y[jj].w * w.w); }
        p[j] = wave_sum(s); }
    if (lane == 0) { *(f32x4*)gif_row = (f32x4){p[0], p[1], p[2], p[3]}; *(f32x4*)(gif_row + 4) = (f32x4){p[4], p[5], p[6], p[7]}; }
}
DI void gates8b(const f32x4 (&y)[4], const LAS float* wgt, float* gif_row, int lane) {
    float p[8];
#pragma unroll
    for (int j = 0; j < 8; ++j) { float s = 0.f;
#pragma unroll
        for (int jj = 0; jj < 4; ++jj) { const f32x4 w = *(const LAS f32x4*)(wgt + j * 1024 + (jj >> 1) * 512 + 8 * lane + (jj & 1) * 4); s += (y[jj].x * w.x + y[jj].y * w.y) + (y[jj].z * w.z + y[jj].w * w.w); }
        p[j] = wave_sum(s); }
    if (lane == 0) { *(f32x4*)gif_row = (f32x4){p[0], p[1], p[2], p[3]}; *(f32x4*)(gif_row + 4) = (f32x4){p[4], p[5], p[6], p[7]}; }
}
DI void load_gate_table(LAS float* wgt, const float* win_l, int tid) {
    for (int i = tid; i < 8192; i += NTHR) { const int k = i >> 3, j = i & 7; wgt[j * 1024 + k] = win_l[(size_t)k * DIN + 1536 + j]; }
}
DI f32x4 ld4bf(const char* p) { const u32x2 w = *(const u32x2*)p; return (f32x4){bflo(w.x), bfhi(w.x), bflo(w.y), bfhi(w.y)}; }
DI void st4bf(char* p, const f32x4& v) { u32x2 w; w.x = pk2(v.x, v.y); w.y = pk2(v.z, v.w); *(u32x2*)p = w; }

struct Args { const float* in[N_IN]; float* out; unsigned char* ws; int ph_lo, ph_hi; };
constexpr int NP_LAYER = 12, NPH = 1 + DEPTH * NP_LAYER;
constexpr int XW_SPLIT = 49152;

struct SchedInproj {
    pg8::TileOrder T; int G, c; const char *X, *W; char* U; bool kv; const char *MEMN, *WKV; char* KV;
    DI bool next(int i, pg8::Unit& u) const {
        const long L = (long)i * G + c; int pm, pn;
        if (T.tile(L, pm, pn)) { u.a = X + (size_t)pm * 256 * D * 2; u.b = W + (size_t)pn * 256 * D * 2; u.r0 = pm * 256; u.c0 = pn * 256; u.c = U + ((size_t)u.r0 * NU + u.c0) * 2; u.ldc = NU; u.e = 0; u.sub = 0; return true; }
        if (!kv) return false;
        const long L2 = L - T.nwg; if (L2 < 0 || L2 >= 128) return false;
        const int l = (int)L2 >> 6, t = (int)L2 & 63; pm = t >> 2; pn = t & 3;
        u.a = MEMN + (size_t)pm * 256 * D * 2; u.b = WKV + ((size_t)l * 1024 + pn * 256) * D * 2; u.r0 = pm * 256; u.c0 = pn * 256; u.c = KV + (((size_t)l * MROWS + u.r0) * D + u.c0) * 2; u.ldc = D; u.e = 0; u.sub = 0; return true;
    }
};
struct SchedPlain {
    pg8::TileOrder T; int G, c; const char *A, *B; char* C; int lda, ldb, ldc;
    DI bool next(int i, pg8::Unit& u) const {
        const long L = (long)i * G + c; int pm, pn; if (!T.tile(L, pm, pn)) return false;
        u.a = A + (size_t)pm * 256 * lda * 2; u.b = B + (size_t)pn * 256 * ldb * 2; u.r0 = pm * 256; u.c0 = pn * 256; u.c = C + ((size_t)u.r0 * ldc + u.c0) * 2; u.ldc = ldc; u.e = 0; u.sub = 0; return true;
    }
};
struct SchedMerge {
    pg8::TileOrder T; int G, c; const char *H, *W; char* Y;
    DI bool next(int i, pg8::Unit& u) const {
        const int ti = i / 3, br = i - 3 * ti; const long L = (long)ti * G + c; int pm, pn; if (!T.tile(L, pm, pn)) return false;
        u.a = H + ((size_t)pm * 256 * 1536 + br * 512) * 2; u.b = W + ((size_t)br * 1024 + pn * 256) * 512 * 2; u.r0 = pm * 256; u.c0 = pn * 256; u.c = Y + ((size_t)u.r0 * D + u.c0) * 2; u.ldc = D; u.e = 0; u.sub = br; return true;
    }
};
struct SchedMoe {
    pg8::TileOrder T; int G, c; const char *A, *W; char* C; const LAS int* PB; int wrows  , ldc, cdiv, osz;
    DI bool next(int i, pg8::Unit& u) const {
        const long L = (long)i * G + c; int pm, pn; if (!T.tile(L, pm, pn)) return false;
        int e = 0;
#pragma unroll 1
        for (int j = 1; j < NEXP; ++j) e += (PB[j] <= pm) ? 1 : 0;
        u.a = A + (size_t)pm * 256 * 1024; u.b = W + ((size_t)e * wrows + pn * 256) * 1024; u.r0 = pm * 256; u.c0 = pn * 256; u.c = C + ((size_t)u.r0 * ldc + u.c0 / cdiv) * osz; u.ldc = ldc; u.e = e; u.sub = 0; return true;
    }
};

__global__ void __launch_bounds__(NTHR, 2) fwd_kernel(Args args) {
    extern __shared__ __attribute__((aligned(16))) unsigned char lds_raw[];
#define INP(i) ([&]() -> const float* { int ii_ = (i); asm volatile("" : "+s"(ii_)); return args.in[ii_]; }())
    LAS unsigned char* lds = (LAS unsigned char*)lds_raw;
    volatile LAS unsigned* LCTL = (volatile LAS unsigned*)(lds + LDSCTL_OFF);
    const int tid0 = threadIdx.x, wave = __builtin_amdgcn_readfirstlane(tid0 >> 6);
#define PHASE_TID unsigned z_ = 0u; asm volatile("" : "+v"(z_)); int tid = wave * 64 + (int)__builtin_amdgcn_mbcnt_hi(~0u, __builtin_amdgcn_mbcnt_lo(~0u, z_)); const int lane = tid & 63; (void)lane;
    const int G = gridDim.x, bx = blockIdx.x;
    const int gw = bx * NWAVES + wave, NGW = G * NWAVES;
    unsigned char* ws = args.ws;
    gu32* ctl = (gu32*)(ws + WS_CTL);
    for (int u = tid0; u < (LDS_BYTES - LDSCTL_OFF) / 4; u += NTHR) ((LAS unsigned*)(lds + LDSCTL_OFF))[u] = 0u;
    __syncthreads();
    XcdBarrier bar; bar.bar = (unsigned*)ctl + CW_BAR; bar.x = 0; bar.st = nullptr;
    if (MK_ONE_LAUNCH) bar = xcd_barrier_post((unsigned*)ctl + CW_BAR, LCTL);
    const int lo = args.ph_lo, hi = args.ph_hi;
#ifndef SUBMASK
#define SUBMASK 7
#endif
#ifndef LN2PROBE
#define LN2PROBE 0
#endif
#ifndef SUBDUP
#define SUBDUP 0
#endif
#define NSUB(k) ((((SUBDUP) >> (k)) & 1) ? 2 : 1)
#ifndef DUPMASK
#define DUPMASK 0
#endif
#define NREP(k) ((((DUPMASK) >> (k)) & 1) ? 2 : 1)
#ifndef PHMASK
#define PHMASK 0xFFFF
#endif
#define IN(k) (lo <= (k) && (k) < hi)
#define SEAM(k) do { if (IN(k) && IN((k) + 1)) xcd_barrier(bar); } while (0)

    char* const Xb = (char*)(ws + WS_X);
    char* const Ub = (char*)(ws + WS_R1);
    float* const GIF = (float*)(ws + WS_GIF);
    LAS int* const PB = (LAS int*)(lds + LDSCTL_OFF + 64);
    LAS int* const CNT = (LAS int*)(lds + LDSCTL_OFF + 256);

    _Pragma("unroll 1") for (int rep_ = 0; rep_ < NREP(12); ++rep_) if (((PHMASK>>12)&1) && IN(0)) { PHASE_TID
        LAS float* scr = (LAS float*)(lds + wave * 8448);
        LAS float* wgt = (LAS float*)(lds + 73728);
        load_gate_table(wgt, INP(I_WIN), tid);
        constexpr int IT_IN = 16 * 216, IT_KV = 16 * 32, IT_BR = 8 * 32, IT_O = 16 * 32, IT_L = IT_IN + IT_KV + 3 * IT_BR + IT_O;
        for (int it = gw; it < DEPTH * IT_L; it += NGW) {
            const int l = it / IT_L; int r = it - l * IT_L;
            if (r < IT_IN) { const int kb = r / 216, nb = r % 216, n0 = 32 * nb, sc = ucol_src(n0);
                if (n0 < UC_F8) transpose_item(INP(I_WIN) + ((size_t)l * D + 64 * kb) * DIN + sc, DIN, (bf16*)(ws + WS_WIN) + ((size_t)l * NU + n0) * D + 64 * kb, D, scr, lane);
                else transpose_item_f8(INP(I_WIN) + ((size_t)l * D + 64 * kb) * DIN + sc, DIN, (unsigned char*)(ws + WS_WING8) + ((size_t)l * NF8 + (n0 - UC_F8)) * D + 64 * kb, D, F8_SWGU, scr, lane);
                continue; }
            r -= IT_IN;
            if (r < IT_KV) { const int kb = r / 32, nb = r % 32;
                transpose_item(INP(I_CAWKV) + ((size_t)l * D + 64 * kb) * 1024 + 32 * nb, 1024, (bf16*)(ws + WS_WKV) + ((size_t)l * 1024 + 32 * nb) * D + 64 * kb, D, scr, lane); continue; }
            r -= IT_KV;
            if (r < 3 * IT_BR) { const int br = r / IT_BR, q = r % IT_BR, kb = q / 32, nb = q % 32;
                const float* src = INP(br == 0 ? I_WBRML : (br == 1 ? I_WBRRW : I_WBRCA));
                transpose_item(src + ((size_t)l * 512 + 64 * kb) * 1024 + 32 * nb, 1024, (bf16*)(ws + WS_WBR) + ((size_t)l * 1024 + 32 * nb) * 1536 + br * 512 + 64 * kb, 1536, scr, lane); continue; }
            r -= 3 * IT_BR;
            { const int kb = r / 32, nb = r % 32;
                transpose_item(INP(I_WO) + ((size_t)l * D + 64 * kb) * 1024 + 32 * nb, 1024, (bf16*)(ws + WS_WO) + ((size_t)l * 1024 + 32 * nb) * D + 64 * kb, D, scr, lane); }
        }
        for (int i = bx * NTHR + tid; i < DEPTH * 1536 * 256; i += G * NTHR) {
            const int l = i / (1536 * 256), r = i % (1536 * 256), n = r >> 8, k = r & 255; float v = 0.f;
            if (n < 512) { if (k < 64) v = INP(I_RWWUP)[((size_t)l * 64 + k) * 512 + n]; }
            else if (n < 1024) { if (k >= 64 && k < 128) v = INP(I_RWAUP)[((size_t)l * 64 + (k - 64)) * 512 + (n - 512)]; }
            else { if (k >= 128) v = INP(I_RWGUP)[((size_t)l * 128 + (k - 128)) * 512 + (n - 1024)]; }
            ((bf16*)(ws + WS_WLORA))[i] = (bf16)f2bf(v);
        }
        __syncthreads();
        {
            f32x4 g[4], b[4];
#pragma unroll
            for (int j = 0; j < 4; ++j) { g[j] = *(const f32x4*)(INP(I_LNIN_G) + 256 * j + 4 * lane); b[j] = *(const f32x4*)(INP(I_LNIN_B) + 256 * j + 4 * lane); }
            for (int m = gw; m < M; m += NGW) {
                f32x4 v[4]; const float* xr = INP(I_X) + (size_t)m * D;
#pragma unroll
                for (int j = 0; j < 4; ++j) v[j] = *(const f32x4*)(xr + 256 * j + 4 * lane);
                ln16(v, g, b);
#pragma unroll
                for (int j = 0; j < 4; ++j) { st4bf(Xb + ((size_t)m * D + 256 * j + 4 * lane) * 2, v[j]); *(unsigned*)((char*)(ws + WS_XF8) + (size_t)m * D + 256 * j + 4 * lane) = pk4_f8(v[j].x * F8_SX, v[j].y * F8_SX, v[j].z * F8_SX, v[j].w * F8_SX); }
                gates8(v, wgt, GIF + (size_t)m * 8, lane);
            }
#pragma unroll
            for (int j = 0; j < 4; ++j) { g[j] = *(const f32x4*)(INP(I_MEMLN_G) + 256 * j + 4 * lane); b[j] = *(const f32x4*)(INP(I_MEMLN_B) + 256 * j + 4 * lane); }
            for (int m = gw; m < MROWS; m += NGW) {
                f32x4 v[4]; const float* xr = INP(I_MEM) + (size_t)m * D;
#pragma unroll
                for (int j = 0; j < 4; ++j) v[j] = *(const f32x4*)(xr + 256 * j + 4 * lane);
                ln16(v, g, b);
#pragma unroll
                for (int j = 0; j < 4; ++j) st4bf((char*)(ws + WS_MEMN) + ((size_t)m * D + 256 * j + 4 * lane) * 2, v[j]);
            }
        }
        __syncthreads();
    }
    SEAM(0);

#pragma unroll 1
    for (int l = 0; l < DEPTH; ++l) {
        const int pb = 1 + l * NP_LAYER;
        _Pragma("unroll 1") for (int rep_ = 0; rep_ < NREP(0); ++rep_) if (((PHMASK>>0)&1) && IN(pb + 0)) {
            SchedInproj S; S.T.init(M / 256, UC_F8 / 256); S.G = G; S.c = bx; S.X = Xb; S.W = (const char*)(ws + WS_WIN) + (size_t)l * NU * D * 2; S.U = Ub;
            S.kv = (l == 0); S.MEMN = (const char*)(ws + WS_MEMN); S.WKV = (const char*)(ws + WS_WKV); S.KV = (char*)(ws + WS_KV);
            pg8::EpiStore E;
            pg8::gemm_phase<false>(lds, D * 2, D * 2, D * 2, S, E, wave);
            SchedPlain S8; S8.T.init(M / 256, NF8 / 256); S8.G = G; S8.c = bx; S8.A = (const char*)(ws + WS_XF8); S8.B = (const char*)(ws + WS_WING8) + (size_t)l * NF8 * D; S8.C = Ub + UC_F8 * 2;
            S8.lda = 512; S8.ldb = 512; S8.ldc = NU;
            pg8::EpiStoreS E8; E8.s = F8_INV1; E8.gate_b = INP(I_GATEB) + (size_t)l * 3072; E8.gate_c0 = UC_GATE - UC_F8;
            pg8::gemm_phase<true>(lds, D, D, D, S8, E8, wave);
        }
        SEAM(pb + 0);
        _Pragma("unroll 1") for (int rep_ = 0; rep_ < NREP(1); ++rep_) if (((PHMASK>>1)&1) && IN(pb + 1)) { PHASE_TID
            const float* mu = INP(I_RWMU) + (size_t)l * 1792 + 1536;
            char* LIN = (char*)(ws + WS_R2 + R2_LORA_IN);
            for (int it = bx * NTHR + tid; it < M * 32; it += G * NTHR) {
                const int row = it >> 5, c = (it & 31) * 8;
                const u32x4 cw = *(const u32x4*)(Ub + ((size_t)row * NU + UC_RW + 1536 + c) * 2);
                u32x4 pw = (u32x4){0u, 0u, 0u, 0u};
                if ((row & (SEQ - 1)) != 0) pw = *(const u32x4*)(Ub + ((size_t)(row - 1) * NU + UC_RW + 1536 + c) * 2);
                const f32x4 m0 = *(const f32x4*)(mu + c), m1 = *(const f32x4*)(mu + c + 4);
                float x[8] = {bflo(cw.x), bfhi(cw.x), bflo(cw.y), bfhi(cw.y), bflo(cw.z), bfhi(cw.z), bflo(cw.w), bfhi(cw.w)};
                const float p[8] = {bflo(pw.x), bfhi(pw.x), bflo(pw.y), bfhi(pw.y), bflo(pw.z), bfhi(pw.z), bflo(pw.w), bfhi(pw.w)};
                const float mm[8] = {m0.x, m0.y, m0.z, m0.w, m1.x, m1.y, m1.z, m1.w};
#pragma unroll
                for (int i = 0; i < 8; ++i) { float xs = x[i] + (p[i] - x[i]) * mm[i];
                    if (c < 64) xs = 1.f - 2.f * __builtin_amdgcn_rcpf(1.f + __builtin_amdgcn_exp2f(2.8853900817779268f * xs));
                    else if (c >= 128) xs = sigmoidf_(xs);
                    x[i] = xs; }
                u32x4 o; o.x = pk2(x[0], x[1]); o.y = pk2(x[2], x[3]); o.z = pk2(x[4], x[5]); o.w = pk2(x[6], x[7]);
                *(u32x4*)(LIN + ((size_t)row * 256 + c) * 2) = o;
            }
        }
        SEAM(pb + 1);
        _Pragma("unroll 1") for (int rep_ = 0; rep_ < NREP(2); ++rep_) if (((PHMASK>>2)&1) && IN(pb + 2)) {
            SchedPlain S; S.T.init(M / 256, 6); S.G = G; S.c = bx; S.A = (const char*)(ws + WS_R2 + R2_LORA_IN); S.B = (const char*)(ws + WS_WLORA) + (size_t)l * 1536 * 256 * 2; S.C = (char*)(ws + WS_R2 + R2_LORA_OUT);
            S.lda = 256; S.ldb = 256; S.ldc = 1536;
            pg8::EpiStore E;
            pg8::gemm_phase<false>(lds, 512, 512, 512, S, E, wave);
        }
        SEAM(pb + 2);
        _Pragma("unroll 1") for (int rep_ = 0; rep_ < NREP(3); ++rep_) if (((PHMASK>>3)&1) && IN(pb + 3)) { PHASE_TID
            const char* LO = (const char*)(ws + WS_R2 + R2_LORA_OUT);
            char* HC = (char*)(ws + WS_R2 + R2_HCAT);
            const int tid_ph = tid;
#define SUB_TID unsigned zs_ = 0u; asm volatile("" : "+v"(zs_)); int tid = wave * 64 + (int)__builtin_amdgcn_mbcnt_hi(~0u, __builtin_amdgcn_mbcnt_lo(~0u, zs_)); const int lane = tid & 63; (void)lane;
#pragma unroll 1
            for (int job = bx; job < 256; job += G) {
                if (job < 128) { _Pragma("unroll 1") for (int sr_ = 0; sr_ < NSUB(0); ++sr_) if ((SUBMASK>>0)&1) {
                    SUB_TID
                    const int b = job >> 3, h = job & 7;
                    constexpr int TC = 32, PT = 144, P16 = 48, IMG = 25856;
                    LAS float* OPS = (LAS float*)lds;
                    LAS float* OUTB = OPS + TC * 384;
                    LAS float* BON = OUTB + TC * 64;
                    LAS unsigned char* IM0 = lds + 57600;
                    LAS float* VEP = (LAS float*)(lds + 109312);
                    LAS unsigned char* GKB = (LAS unsigned char*)(VEP + 2 * TC * 64);
                    LAS float* PARF = (LAS float*)(lds + 142080);
                    const int pt = tid >> 4, cs = tid & 15, pc = cs * 4, hc = h * 64 + pc;
                    const int p1t = (tid >> 3) & 31, c8 = (tid & 7) * 8, hc8 = h * 64 + c8;
                    const int r31 = lane & 31, h2 = lane >> 5;
                    f32x16 Sreg[2];
#pragma unroll
                    for (int i = 0; i < 16; ++i) { Sreg[0][i] = 0.f; Sreg[1][i] = 0.f; }
#pragma unroll 1
                    for (int a = wave; a < 10; a += 8) {
                        const int ii = (a < 3) ? I_RWMU : (a == 3) ? I_RWW0 : (a == 4) ? I_RWA0 : (a == 5) ? I_RWKK : (a == 6) ? I_RWKA : (a == 7) ? I_RWRK : (a == 8) ? I_RWLNG : I_RWLNB;
                        const size_t po = (a < 3) ? ((size_t)l * 1792 + a * 512) : (size_t)l * 512;
                        PARF[a * 64 + lane] = (INP(ii) + po)[h * 64 + lane];
                    }
#define SETPU(j, q_) do { const u32x4 q__ = (q_); Sreg[(j) >> 2][((j) & 3) * 4] = u2f_(q__.x); Sreg[(j) >> 2][((j) & 3) * 4 + 1] = u2f_(q__.y); \
                          Sreg[(j) >> 2][((j) & 3) * 4 + 2] = u2f_(q__.z); Sreg[(j) >> 2][((j) & 3) * 4 + 3] = u2f_(q__.w); } while (0)
#define PUW(j, c) f2u_(Pc[(j) >> 2][((j) & 3) * 4 + (c)])
#define PUWS(j, c) f2u_(Sreg[(j) >> 2][((j) & 3) * 4 + (c)])
#define UNPJ(j, hh) ((f32x4){bflo(PUW(j, 2 * (hh))), bfhi(PUW(j, 2 * (hh))), bflo(PUW(j, 2 * (hh) + 1)), bfhi(PUW(j, 2 * (hh) + 1))})
#define UNPH(q_, hh) ((hh) ? (f32x4){bflo((q_).z), bfhi((q_).z), bflo((q_).w), bfhi((q_).w)} : (f32x4){bflo((q_).x), bfhi((q_).x), bflo((q_).y), bfhi((q_).y)})
                    auto LOADC = [&](int t0) {
                        const int t = t0 + p1t; const size_t row = (size_t)b * SEQ + t; const char* up = Ub + (row * NU + UC_RW + hc8) * 2;
                        SETPU(0, *(const u32x4*)up); SETPU(1, *(const u32x4*)(up + 1024)); SETPU(2, *(const u32x4*)(up + 2048));
                        if (t > 0) { const char* pp = up - (size_t)NU * 2; SETPU(3, *(const u32x4*)pp); SETPU(4, *(const u32x4*)(pp + 1024)); SETPU(5, *(const u32x4*)(pp + 2048)); }
                        else { const u32x4 z4 = (u32x4){0u, 0u, 0u, 0u}; SETPU(3, z4); SETPU(4, z4); SETPU(5, z4); }
                        const char* lp = LO + (row * 1536 + hc8) * 2; SETPU(6, *(const u32x4*)lp); SETPU(7, *(const u32x4*)(lp + 1024));
                    };
                    const int gq = tid - 128, gt = (gq >> 2) & 31, gp = (gq & 3) * 16;
                    auto LOADG = [&](int t0) {
                        const char* gp_ = LO + (((size_t)b * SEQ + t0 + gt) * 1536 + 1024 + h * 64 + gp) * 2;
                        SETPU(0, *(const u32x4*)gp_); SETPU(1, *(const u32x4*)(gp_ + 16));
                    };
                    auto PASS1 = [&](int t1, int par1, bool more) {
                        int hcv = hc8; asm volatile("" : "+v"(hcv));
                        const f32x16 Pc[2] = {Sreg[0], Sreg[1]};
                        if (more) LOADC(t1 + TC);
                        const LAS float* MU = PARF + c8;
                        const LAS float* W0 = PARF + 192 + c8; const LAS float* A0 = PARF + 256 + c8; const LAS float* KKW = PARF + 320 + c8;
                        const LAS float* KAW = PARF + 384 + c8; const LAS float* RKW = PARF + 448 + c8;
                        f32x4 dec[2], av[2], kkv[2], kp[2], xr[2], xv[2]; float ss = 0.f, bsum = 0.f;
#pragma unroll
                        for (int hh = 0; hh < 2; ++hh) {
                            const f32x4 mu_r = *(const LAS f32x4*)(MU + 4 * hh), mu_k = *(const LAS f32x4*)(MU + 64 + 4 * hh), mu_v = *(const LAS f32x4*)(MU + 128 + 4 * hh);
                            const f32x4 w0 = *(const LAS f32x4*)(W0 + 4 * hh), a0 = *(const LAS f32x4*)(A0 + 4 * hh), kkw = *(const LAS f32x4*)(KKW + 4 * hh), kaw = *(const LAS f32x4*)(KAW + 4 * hh), rkw = *(const LAS f32x4*)(RKW + 4 * hh);
                            const f32x4 ur = UNPJ(0, hh), uk = UNPJ(1, hh), uv = UNPJ(2, hh), urp = UNPJ(3, hh), ukp = UNPJ(4, hh), uvp = UNPJ(5, hh), lw = UNPJ(6, hh), la = UNPJ(7, hh);
                            xr[hh] = ur + (urp - ur) * mu_r; const f32x4 xk = uk + (ukp - uk) * mu_k; xv[hh] = uv + (uvp - uv) * mu_v;
#pragma unroll
                            for (int i = 0; i < 4; ++i) {
                                const float y = -(w0[i] + lw[i]);
                                dec[hh][i] = __expf(-0.6065306597126334f * __builtin_amdgcn_rcpf(1.f + __expf(y)));
                                av[hh][i] = sigmoidf_(a0[i] + la[i]);
                                kkv[hh][i] = xk[i] * kkw[i]; ss += kkv[hh][i] * kkv[hh][i];
                                kp[hh][i] = xk[i] * (1.f + (av[hh][i] - 1.f) * kaw[i]);
                                bsum += xr[hh][i] * kp[hh][i] * rkw[i];
                            }
                            __builtin_amdgcn_sched_barrier(0);
                        }
                        ss = red8(ss); bsum = red8(bsum);
                        const float inv = __builtin_amdgcn_rsqf(fmaxf(ss, 1e-24f));
#pragma unroll
                        for (int hh = 0; hh < 2; ++hh) {
                            const f32x4 kk = kkv[hh] * inv, kka = kk * av[hh];
                            LAS float* o = OPS + p1t * 384 + c8 + 4 * hh;
                            *(LAS f32x4*)(o) = dec[hh]; *(LAS f32x4*)(o + 64) = kk; *(LAS f32x4*)(o + 128) = kka; *(LAS f32x4*)(o + 192) = kp[hh]; *(LAS f32x4*)(o + 256) = xr[hh]; *(LAS f32x4*)(o + 320) = xv[hh];
                            *(LAS f32x4*)(VEP + par1 * 2048 + p1t * 64 + c8 + 4 * hh) = xv[hh];
                        }
                        if ((tid & 7) == 0) BON[par1 * 32 + p1t] = bsum;
                    };
#define UNP4(w) ((f32x4){bflo((w).x), bfhi((w).x), bflo((w).y), bfhi((w).y)})
#define DOT4(a, b) (((a).x * (b).x + (a).y * (b).y) + ((a).z * (b).z + (a).w * (b).w))
#define PACK8(x, s) __builtin_bit_cast(bf16x8, (u32x4){pk2((x)[8 * (s)], (x)[8 * (s) + 1]), pk2((x)[8 * (s) + 2], (x)[8 * (s) + 3]), pk2((x)[8 * (s) + 4], (x)[8 * (s) + 5]), pk2((x)[8 * (s) + 6], (x)[8 * (s) + 7])})
#define LD2x64(p) __builtin_bit_cast(bf16x8, (u32x4){(*(const LAS u32x2*)(p)).x, (*(const LAS u32x2*)(p)).y, (*(const LAS u32x2*)((p) + 16)).x, (*(const LAS u32x2*)((p) + 16)).y})
                    auto EPI = [&](int te, int pe) {
                        const int et = ((wave >> 2) * 2 + (wave & 1)) * 64 + lane, pce = (et & 15) * 4;
                        const f32x4 lng = *(const LAS f32x4*)(PARF + 512 + pce), lnb = *(const LAS f32x4*)(PARF + 576 + pce);
#pragma unroll
                        for (int it = 0; it < 2; ++it) {
                            const int pte = (et >> 4) + 16 * it;
                            const u32x2 gkw = *(const LAS u32x2*)(GKB + pe * 4096 + pte * 128 + pce * 2);
                            const f32x4 o4 = *(const LAS f32x4*)(OUTB + pte * 64 + pce), v4 = *(const LAS f32x4*)(VEP + pe * 2048 + pte * 64 + pce), gk = UNP4(gkw);
                            const float mean = red16((o4.x + o4.y) + (o4.z + o4.w)) * (1.f / 64.f);
                            const f32x4 dv = o4 - mean;
                            const float var = red16(DOT4(dv, dv)) * (1.f / 64.f);
                            const float rstd = __builtin_amdgcn_rsqf(var + RW_GN_EPS), bo = BON[pe * 32 + pte];
                            const f32x4 y = (dv * rstd * lng + lnb + v4 * bo) * gk;
                            st4bf(HC + (((size_t)b * SEQ + te + pte) * 1536 + 512 + h * 64 + pce) * 2, y);
                        }
                    };
                    if (wave >= 4) LOADC(0); else if (wave >= 2) LOADG(0);
#pragma unroll 1
                    for (int t0 = -TC; t0 < SEQ; t0 += TC) {
                        const int par = (t0 >> 5) & 1;
                        __syncthreads();
                        if (t0 >= 0)
                        {
                            const int sc = wave >> 2, wq = wave & 3;
                            LAS unsigned char* im = IM0 + sc * IMG;
                            LAS unsigned char* KR = im; LAS unsigned char* BGr = im + 4608; LAS unsigned char* VT = im + 15360;
                            LAS unsigned char* TT = im + 18432; LAS unsigned char* BB = im + 19968; LAS float* ZF = (LAS float*)(im + 21504); LAS float* PL = (LAS float*)(im + 25600);
                            {
                                float P = 1.f;
#pragma unroll
                                for (int t = 0; t < 12; ++t) { const float wv = OPS[(16 * sc + t) * 384 + lane]; P *= (t < 4 * wq) ? wv : 1.f; }
#pragma unroll
                                for (int q = 0; q < 4; ++q) { const int t = 4 * wq + q; const LAS float* o = OPS + (16 * sc + t) * 384 + lane;
                                    const float w = o[0], z = o[64], bb = o[128], kp = o[192], rr = o[256], vv = o[320];
                                    const float kap = z * P; P *= w; const float rho = rr * P, ip = __builtin_amdgcn_rcpf(P), bet = bb * ip, gam = kp * ip;
                                    *(LAS bf16*)(KR + t * PT + lane * 2) = (bf16)f2bf(kap); *(LAS bf16*)(KR + (16 + t) * PT + lane * 2) = (bf16)f2bf(rho);
                                    *(LAS bf16*)(BGr + t * PT + lane * 2) = (bf16)f2bf(bet); *(LAS bf16*)(BGr + (16 + t) * PT + lane * 2) = (bf16)f2bf(gam);
                                    *(LAS bf16*)(VT + t * PT + lane * 2) = (bf16)f2bf(vv); }
                                if (wq == 3) PL[lane] = P;
                            }
                            __syncthreads();
                            if (wq <= 1) {
                                f32x16 Z;
#pragma unroll
                                for (int i = 0; i < 16; ++i) Z[i] = 0.f;
                                bf16x8 zk[4], zb[4];
#pragma unroll
                                for (int ks = 0; ks < 4; ++ks) { zk[ks] = *(const LAS bf16x8*)(KR + r31 * PT + (16 * ks + 8 * h2) * 2); zb[ks] = *(const LAS bf16x8*)(BGr + r31 * PT + (16 * ks + 8 * h2) * 2); }
                                __builtin_amdgcn_sched_barrier(0);
#pragma unroll
                                for (int ks = 0; ks < 4; ++ks) Z = __builtin_amdgcn_mfma_f32_32x32x16_bf16(zk[ks], zb[ks], Z, 0, 0, 0);
                                const int jj = (r31 & 15) - 4 * h2;
#pragma unroll
                                for (int i = 0; i < 16; ++i) { const int tb = (i & 3) + 8 * ((i >> 2) & 1); const bool keep = (i >= 8) ? (jj <= tb) : (jj < tb); Z[i] = keep ? Z[i] : 0.f; }
                              if (wq == 1) {
                                if (r31 >= 16) {
#pragma unroll
                                    for (int i = 0; i < 16; ++i) *(LAS bf16*)(BB + ((i & 3) + 8 * (i >> 2) + 4 * h2) * P16 + (r31 - 16) * 2) = (bf16)f2bf(Z[i]);
                                }
                              } else {
                                if (r31 < 16) {
#pragma unroll
                                    for (int i = 0; i < 16; ++i) ZF[((i & 3) + 8 * (i >> 2) + 4 * h2) * 32 + r31] = Z[i];
                                }
                                LDS_WAIT(); asm volatile("" ::: "memory");
                                const int c = lane & 15, g = lane >> 4; float x[16];
                                f32x4 R[16][4];
                                constexpr int TW = 5;
#pragma unroll
                                for (int t = 1; t <= TW; ++t)
#pragma unroll
                                    for (int k = 0; k < 4; ++k) if (4 * k < t) R[t][k] = *(const LAS f32x4*)(ZF + t * 32 + 4 * k);
                                __builtin_amdgcn_sched_barrier(0);
#pragma unroll
                                for (int t = 0; t < 16; ++t) {
                                    if (t >= 1 && t + TW < 16) {
#pragma unroll
                                        for (int k = 0; k < 4; ++k) if (4 * k < t + TW) R[t + TW][k] = *(const LAS f32x4*)(ZF + (t + TW) * 32 + 4 * k);
                                    }
                                    __builtin_amdgcn_sched_barrier(0);
                                    float s0 = 0.f, s1 = 0.f;
#pragma unroll
                                    for (int j = 0; j < t; ++j) { const float a = R[t][j >> 2][j & 3]; if (j & 1) s1 += a * x[j]; else s0 += a * x[j]; }
                                    x[t] = ((t == c) ? 1.f : 0.f) - (s0 + s1);
                                }
#pragma unroll
                                for (int j = 0; j < 16; ++j) *(LAS bf16*)(TT + j * P16 + c * 2) = (bf16)f2bf(-x[j]);
#pragma unroll
                                for (int qq = 0; qq < 4; qq += 2) {
                                    f32x4 a4[2][4];
#pragma unroll
                                    for (int q = 0; q < 2; ++q)
#pragma unroll
                                        for (int k = 0; k < 4; ++k) a4[q][k] = *(const LAS f32x4*)(ZF + (16 + 4 * g + qq + q) * 32 + 4 * k);
#pragma unroll
                                    for (int q = 0; q < 2; ++q) {
                                        const int tr = 4 * g + qq + q;
                                        float s0 = 0.f, s1 = 0.f;
#pragma unroll
                                        for (int j = 0; j < 16; ++j) { const float a = a4[q][j >> 2][j & 3]; if (j & 1) s1 += a * x[j]; else s0 += a * x[j]; }
                                        *(LAS bf16*)(TT + (16 + tr) * P16 + c * 2) = (bf16)f2bf(-(s0 + s1));
                                    }
                                }
                              }
                            } else if (t0 >= TC) EPI(t0 - TC, par ^ 1);
                        }
                        __syncthreads();
                        if (wave >= 4) { if (t0 + TC < SEQ) PASS1(t0 + TC, par ^ 1, t0 + 2 * TC < SEQ); }
                        else if (wave >= 2) { if (t0 + TC < SEQ) {
                            LAS unsigned char* gd = GKB + (par ^ 1) * 4096 + gt * 128 + gp * 2;
                            *(LAS u32x4*)gd = (u32x4){PUWS(0, 0), PUWS(0, 1), PUWS(0, 2), PUWS(0, 3)}; *(LAS u32x4*)(gd + 16) = (u32x4){PUWS(1, 0), PUWS(1, 1), PUWS(1, 2), PUWS(1, 3)};
                            if (t0 + 2 * TC < SEQ) LOADG(t0 + 2 * TC); } }
                        else if (wave < 2 && t0 >= 0) {
#pragma unroll 1
                            for (int sc = 0; sc < 2; ++sc) {
                                const LAS unsigned char* im = IM0 + sc * IMG;
                                const LAS unsigned char* KR = im; const LAS unsigned char* BT = im + 9216; const LAS unsigned char* GT = im + 12288; const LAS unsigned char* VT = im + 15360;
                                const LAS unsigned char* TT = im + 18432; const LAS unsigned char* BB = im + 19968; const LAS float* PL = (const LAS float*)(im + 25600);
                                const LAS unsigned char* BGr = im + 4608;
                                const bf16x8 vfr = trd8(VT, PT, 8 * h2, 8 * h2 + 4, 32 * wave, lane);
                                const bf16x8 bbf = *(const LAS bf16x8*)(BB + r31 * P16 + 8 * h2 * 2);
                                bf16x8 krf[2][2], betf[2], gamf[2]; f32x4 pl[2][4];
#pragma unroll
                                for (int kb = 0; kb < 2; ++kb)
#pragma unroll
                                    for (int s = 0; s < 2; ++s) krf[kb][s] = LD2x64(KR + r31 * PT + (32 * kb + 16 * s + 4 * h2) * 2);
                                const bf16x8 ttf = LD2x64(TT + r31 * P16 + (4 * h2) * 2);
#pragma unroll
                                for (int kb = 0; kb < 2; ++kb) { betf[kb] = trd8(BGr, PT, 4 * h2, 8 + 4 * h2, 32 * kb, lane);
                                    gamf[kb] = trd8(BGr, PT, 16 + 8 * h2, 20 + 8 * h2, 32 * kb, lane); }
                                __builtin_amdgcn_sched_barrier(0);
                                f32x16 t1;
#pragma unroll
                                for (int i = 0; i < 16; ++i) t1[i] = 0.f;
                                t1 = __builtin_amdgcn_mfma_f32_32x32x16_bf16(bbf, vfr, t1, 0, 0, 0);
#pragma unroll
                                for (int kb = 0; kb < 2; ++kb)
#pragma unroll
                                    for (int s = 0; s < 2; ++s) t1 = __builtin_amdgcn_mfma_f32_32x32x16_bf16(krf[kb][s], PACK8(Sreg[kb], s), t1, 0, 0, 0);
                                f32x16 ag[2];
#pragma unroll
                                for (int kb = 0; kb < 2; ++kb) ag[kb] = __builtin_amdgcn_mfma_f32_32x32x16_bf16(gamf[kb], vfr, Sreg[kb], 0, 0, 0);
                                f32x16 t2;
#pragma unroll
                                for (int i = 0; i < 16; ++i) t2[i] = 0.f;
                                t2 = __builtin_amdgcn_mfma_f32_32x32x16_bf16(ttf, PACK8(t1, 0), t2, 0, 0, 0);
#pragma unroll
                                for (int i = 8; i < 16; ++i) OUTB[(16 * sc + (i & 3) + 8 * ((i >> 2) - 2) + 4 * h2) * 64 + 32 * wave + r31] = t2[i] + t1[i];
#pragma unroll
                                for (int kb = 0; kb < 2; ++kb)
#pragma unroll
                                    for (int g4 = 0; g4 < 4; ++g4) pl[kb][g4] = *(const LAS f32x4*)(PL + 32 * kb + 8 * g4 + 4 * h2);
                                const bf16x8 uq = PACK8(t2, 0);
#pragma unroll
                                for (int kb = 0; kb < 2; ++kb) {
                                    f32x16 a = __builtin_amdgcn_mfma_f32_32x32x16_bf16(betf[kb], uq, ag[kb], 0, 0, 0);
#pragma unroll
                                    for (int g4 = 0; g4 < 4; ++g4) { const f32x4 p4 = pl[kb][g4];
                                        a[4 * g4] *= p4.x; a[4 * g4 + 1] *= p4.y; a[4 * g4 + 2] *= p4.z; a[4 * g4 + 3] *= p4.w; }
                                    Sreg[kb] = a;
                                }
                            }
                        }
                    }
                    __syncthreads();
                    if ((wave & 3) >= 2) EPI(SEQ - TC, ((SEQ - TC) >> 5) & 1);
                    __syncthreads();
#undef UNPH
#undef UNPJ
#undef PUW
#undef PUWS
#undef SETPU
#undef PACK8
#undef LD2x64
                } } else {
                    const int idx = job - 128, bh = idx >> 1, half = idx & 1, b = bh >> 2, h = bh & 3;
                    unsigned zl_ = 0u; asm volatile("" : "+v"(zl_)); const int lane_ml = (int)__builtin_amdgcn_mbcnt_hi(~0u, __builtin_amdgcn_mbcnt_lo(~0u, zl_));
                    _Pragma("unroll 1") for (int sr_ = 0; sr_ < NSUB(1); ++sr_) if (((SUBMASK>>1)&1) && idx < 64) {
                        SUB_TID
                        const int bm = idx >> 2, hm = idx & 3;
                        constexpr int PT = 144;
                        LAS unsigned char* QI = lds;
                        LAS unsigned char* KI = QI + 64 * PT;
                        constexpr int PV = 272;
                        LAS unsigned char* KW = KI + 64 * PT;
                        LAS unsigned char* VT = KW + 64 * PT;
                        LAS unsigned char* CI = VT + 64 * PV;
                        LAS float* AS = (LAS float*)(CI + 128 * PT);
                        LAS float* MX = AS + 64; LAS float* SI = AS + 128; LAS float* EM = AS + 192; LAS float* WG = AS + 256; LAS float* NN = AS + 320; LAS float* CR = AS + 384; LAS float* ST = AS + 448;
                        for (int i = tid; i < 128 * PT / 4; i += NTHR) ((LAS unsigned*)CI)[i] = 0u;
                        if (tid < 64) NN[tid] = 0.f;
                        LAS float* CWL = (LAS float*)(lds + 100352);
                        if (tid < 128) { const int colw = (tid < 64) ? (hm * 64 + tid) : (256 + hm * 64 + (tid - 64));
#pragma unroll
                            for (int j = 0; j < 4; ++j) CWL[j * 128 + tid] = INP(I_CONVW)[((size_t)l * 4 + j) * 512 + colw];
                            CWL[512 + tid] = INP(I_CONVB)[l * 512 + colw];
                            CWL[640 + tid] = INP(I_MLNORMG)[l * 512 + hm * 128 + tid]; }
                        const int pt = tid >> 4, cg = tid & 15;
                        const int ccol = (cg < 8) ? (hm * 64 + 8 * cg) : (256 + hm * 64 + 8 * (cg - 8));
                        const float qsc = (cg < 8) ? 0.125f : 1.f;
                        const float igb = INP(I_IGB)[l * 4 + hm], fgb = INP(I_FGB)[l * 4 + hm];
                        const int r31 = lane & 31, h2 = lane >> 5, vb = wave >> 1, tb = wave & 1;
                        f32x16 accC;
#pragma unroll
                        for (int i = 0; i < 16; ++i) accC[i] = 0.f;
                        float nreg = 0.f, mprev = 0.f;
                        u32x4 cu[2][4], vu[2]; float gi = 0.f, gf = 0.f;
                        auto LOADM = [&](int t0) {
#pragma unroll
                            for (int tt = 0; tt < 2; ++tt) { const int t = t0 + pt + 32 * tt; const size_t row = (size_t)bm * SEQ + t;
#pragma unroll
                                for (int j = 0; j < 4; ++j) { if (t - 3 + j >= 0) cu[tt][j] = *(const u32x4*)(Ub + ((row - 3 + j) * NU + UC_QK + ccol) * 2); else cu[tt][j] = (u32x4){0u, 0u, 0u, 0u}; }
                                const int p = tid + 512 * tt; vu[tt] = *(const u32x4*)(Ub + (((size_t)bm * SEQ + t0 + (p >> 4)) * NU + UC_V + hm * 128 + 8 * (p & 15)) * 2); }
                            if (wave == 0) { const size_t rg = (size_t)bm * SEQ + t0 + lane; gi = GIF[rg * 8 + hm]; gf = GIF[rg * 8 + 4 + hm]; }
                        };
                        LOADM(0);
                        __syncthreads();
#pragma unroll 1
                        for (int t0 = 0; t0 < SEQ; t0 += 64) {
                            int cgv = cg * 8; asm volatile("" : "+v"(cgv));
                            float cw[4][8], cb[8];
#pragma unroll
                        for (int j = 0; j < 4; ++j) { const f32x4 a = *(const LAS f32x4*)(CWL + j * 128 + cgv), c2 = *(const LAS f32x4*)(CWL + j * 128 + cgv + 4);
                            cw[j][0] = a.x; cw[j][1] = a.y; cw[j][2] = a.z; cw[j][3] = a.w; cw[j][4] = c2.x; cw[j][5] = c2.y; cw[j][6] = c2.z; cw[j][7] = c2.w; }
                        { const f32x4 a = *(const LAS f32x4*)(CWL + 512 + cgv), c2 = *(const LAS f32x4*)(CWL + 512 + cgv + 4);
                            cb[0] = a.x; cb[1] = a.y; cb[2] = a.z; cb[3] = a.w; cb[4] = c2.x; cb[5] = c2.y; cb[6] = c2.z; cb[7] = c2.w; }
                            float yq[2][8];
#pragma unroll
                            for (int tt = 0; tt < 2; ++tt) {
#pragma unroll
                                for (int i = 0; i < 8; ++i) yq[tt][i] = cb[i];
#pragma unroll
                                for (int j = 0; j < 4; ++j) { const u32x4 w = cu[tt][j]; const float x[8] = {bflo(w.x), bfhi(w.x), bflo(w.y), bfhi(w.y), bflo(w.z), bfhi(w.z), bflo(w.w), bfhi(w.w)};
#pragma unroll
                                    for (int i = 0; i < 8; ++i) yq[tt][i] += cw[j][i] * x[i]; }
#pragma unroll
                                for (int i = 0; i < 8; ++i) yq[tt][i] = yq[tt][i] * sigmoidf_(yq[tt][i]) * qsc;
                            }
                            const u32x4 vreg0 = vu[0], vreg1 = vu[1];
                            if (wave == 0) {
                                const float ig = gi + igb, fp = gf + fgb;
                                const float lf = -(fmaxf(-fp, 0.f) + __logf(1.f + __expf(-fabsf(fp))));
                                const float bc = scan_add64(lf);
                                const float as = ig - bc, pm = scan_max64(as);
                                const float mxv = fmaxf(mprev, pm), mx63 = __builtin_bit_cast(float, __builtin_amdgcn_readlane(__builtin_bit_cast(int, mxv), 63)), bl = __builtin_bit_cast(float, __builtin_amdgcn_readlane(__builtin_bit_cast(int, bc), 63));
                                AS[lane] = as; MX[lane] = mxv; SI[lane] = __expf(mprev - mxv); EM[lane] = __expf(-(bc + mxv)); WG[lane] = __expf(as - mx63);
                                if (lane == 0) CR[0] = __expf(mprev - mx63);
                                mprev = bl + mx63;
                            }
                            if (t0 + 64 < SEQ) LOADM(t0 + 64);
                            __syncthreads();
#pragma unroll
                            for (int tt = 0; tt < 2; ++tt) { const int tok = pt + 32 * tt;
                                u32x4 pw; pw.x = pk2(yq[tt][0], yq[tt][1]); pw.y = pk2(yq[tt][2], yq[tt][3]); pw.z = pk2(yq[tt][4], yq[tt][5]); pw.w = pk2(yq[tt][6], yq[tt][7]);
                                if (cg < 8) *(LAS u32x4*)(QI + tok * PT + cg * 16) = pw;
                                else { *(LAS u32x4*)(KI + tok * PT + (cg - 8) * 16) = pw; const float wgs = WG[tok];
                                    u32x4 kw; kw.x = pk2(yq[tt][0] * wgs, yq[tt][1] * wgs); kw.y = pk2(yq[tt][2] * wgs, yq[tt][3] * wgs); kw.z = pk2(yq[tt][4] * wgs, yq[tt][5] * wgs); kw.w = pk2(yq[tt][6] * wgs, yq[tt][7] * wgs);
                                    *(LAS u32x4*)(KW + tok * PT + (cg - 8) * 16) = kw; }
                                const u32x4 vw = tt ? vreg1 : vreg0; const int p = tid + 512 * tt, vtok = p >> 4, v8 = p & 15;
                                *(LAS u32x4*)(VT + vtok * PV + v8 * 16) = vw;
                            }
                            __syncthreads();
                            float hv[16];
                            u32x2 ogw[4];
                            { const size_t rowg = (size_t)bm * SEQ + t0 + 32 * tb + r31; const char* ogp = Ub + (rowg * NU + UC_OG + hm * 128 + 32 * vb) * 2;
#pragma unroll
                                for (int g4 = 0; g4 < 4; ++g4) ogw[g4] = *(const u32x2*)(ogp + (8 * g4 + 4 * h2) * 2); }
                            {
                                constexpr float L2E = 1.4426950408889634f;
                                const int t = 32 * tb + r31;
                                bf16x8 qf[4];
#pragma unroll
                                for (int ks = 0; ks < 4; ++ks) qf[ks] = *(const LAS bf16x8*)(QI + t * PT + (16 * ks + 8 * h2) * 2);
                                const float mx = MX[t], si = SI[t], em = EM[t];
                                f32x16 O, I; float denI = 0.f;
#pragma unroll
                                for (int i = 0; i < 16; ++i) { O[i] = 0.f; I[i] = 0.f; }
#pragma unroll
                                for (int sb = 0; sb < 2; ++sb) if (sb <= tb) {
                                    f32x16 X;
#pragma unroll
                                    for (int i = 0; i < 16; ++i) X[i] = 0.f;
#pragma unroll
                                    for (int ks = 0; ks < 4; ++ks) { const bf16x8 kf = *(const LAS bf16x8*)(KI + (32 * sb + r31) * PT + (16 * ks + 8 * h2) * 2); X = __builtin_amdgcn_mfma_f32_32x32x16_bf16(kf, qf[ks], X, 0, 0, 0); }
#pragma unroll
                                    for (int g4 = 0; g4 < 4; ++g4) { const f32x4 a4 = *(const LAS f32x4*)(AS + 32 * sb + 8 * g4 + 4 * h2);
#pragma unroll
                                        for (int j = 0; j < 4; ++j) { const int s = 32 * sb + 8 * g4 + 4 * h2 + j; const float w = (s <= t) ? __builtin_amdgcn_exp2f((a4[j] - mx) * L2E) * X[4 * g4 + j] : 0.f; X[4 * g4 + j] = w; denI += w; } }
#pragma unroll
                                    for (int st = 0; st < 2; ++st) {
                                        u32x4 pw; pw.x = pk2(X[8 * st], X[8 * st + 1]); pw.y = pk2(X[8 * st + 2], X[8 * st + 3]); pw.z = pk2(X[8 * st + 4], X[8 * st + 5]); pw.w = pk2(X[8 * st + 6], X[8 * st + 7]);
                                        O = __builtin_amdgcn_mfma_f32_32x32x16_bf16(trd8(VT, PV, 32 * sb + 16 * st + 4 * h2, 32 * sb + 16 * st + 8 + 4 * h2, 32 * vb, lane), __builtin_bit_cast(bf16x8, pw), O, 0, 0, 0);
                                    }
                                }
                                float nq = 0.f;
#pragma unroll
                                for (int ks = 0; ks < 4; ++ks) { const bf16x8 cf = *(const LAS bf16x8*)(CI + (32 * vb + r31) * PT + (16 * ks + 8 * h2) * 2); I = __builtin_amdgcn_mfma_f32_32x32x16_bf16(cf, qf[ks], I, 0, 0, 0);
                                    const f32x4 n0 = *(const LAS f32x4*)(NN + 16 * ks + 8 * h2), n1 = *(const LAS f32x4*)(NN + 16 * ks + 8 * h2 + 4); const u32x4 qw = __builtin_bit_cast(u32x4, qf[ks]);
                                    nq += (bflo(qw.x) * n0.x + bfhi(qw.x) * n0.y) + (bflo(qw.y) * n0.z + bfhi(qw.y) * n0.w) + (bflo(qw.z) * n1.x + bfhi(qw.z) * n1.y) + (bflo(qw.w) * n1.z + bfhi(qw.w) * n1.w); }
                                nq += __shfl_xor(nq, 32); denI += __shfl_xor(denI, 32);
                                const float den = si * nq + denI, rdn = 1.f / fmaxf(fabsf(den), em);
                                float hsum = 0.f;
#pragma unroll
                                for (int i = 0; i < 16; ++i) { hv[i] = (O[i] + si * I[i]) * rdn; hsum += hv[i]; }
                                hsum += __shfl_xor(hsum, 32);
                                const float hmean = hsum * (1.f / 32.f); float hm2 = 0.f;
#pragma unroll
                                for (int i = 0; i < 16; ++i) { const float dlt = hv[i] - hmean; hm2 += dlt * dlt; }
                                hm2 += __shfl_xor(hm2, 32);
                                if (h2 == 0) *(LAS f32x2*)(ST + ((tb * 4 + vb) * 32 + r31) * 2) = (f32x2){hmean, hm2};
                                const float carry = CR[0];
#pragma unroll
                                for (int i = 0; i < 16; ++i) accC[i] *= carry;
#pragma unroll
                                for (int st = 0; st < 4; ++st) { const bf16x8 va = trd8(VT, PV, 16 * st + 8 * h2, 16 * st + 8 * h2 + 4, 32 * vb, lane), kw = trd8(KW, PT, 16 * st + 8 * h2, 16 * st + 8 * h2 + 4, 32 * tb, lane);
                                    accC = __builtin_amdgcn_mfma_f32_32x32x16_bf16(va, kw, accC, 0, 0, 0); }
                            }
                            __syncthreads();
                            {
                                const int t = 32 * tb + r31;
                                f32x2 s4[4];
#pragma unroll
                                for (int q = 0; q < 4; ++q) s4[q] = *(const LAS f32x2*)(ST + ((tb * 4 + q) * 32 + r31) * 2);
                                const float mt = (s4[0].x + s4[1].x + s4[2].x + s4[3].x) * 0.25f;
                                float m2 = 0.f;
#pragma unroll
                                for (int q = 0; q < 4; ++q) { const float dm = s4[q].x - mt; m2 += s4[q].y + 32.f * dm * dm; }
                                const float rstd = __builtin_amdgcn_rsqf(m2 * (1.f / 128.f) + LN_EPS);
                                const size_t row = (size_t)bm * SEQ + t0 + t;
                                char* op = HC + (row * 1536 + hm * 128 + 32 * vb) * 2;
                                const LAS float* ngp = CWL + 640 + 32 * vb;
#pragma unroll
                                for (int g4 = 0; g4 < 4; ++g4) { const int vo = 8 * g4 + 4 * h2; const f32x4 og = UNP4(ogw[g4]), ng = *(const LAS f32x4*)(ngp + vo);
                                    f32x4 y; y.x = sigmoidf_(og.x) * ((hv[4 * g4] - mt) * rstd * ng.x); y.y = sigmoidf_(og.y) * ((hv[4 * g4 + 1] - mt) * rstd * ng.y); y.z = sigmoidf_(og.z) * ((hv[4 * g4 + 2] - mt) * rstd * ng.z); y.w = sigmoidf_(og.w) * ((hv[4 * g4 + 3] - mt) * rstd * ng.w);
                                    st4bf(op + vo * 2, y); }
                            }
#pragma unroll
                            for (int i = 0; i < 16; ++i) { const int v = 32 * vb + (i & 3) + 8 * (i >> 2) + 4 * h2; *(LAS bf16*)(CI + v * PT + (32 * tb + r31) * 2) = (bf16)f2bf(accC[i]); }
                            if (wave < 2) { float s = 0.f;
#pragma unroll
                                for (int q8 = 0; q8 < 8; ++q8) { const u32x2 w = trd4(KW, PT, 32 * h2 + 4 * q8, 32 * wave, lane); s += (bflo(w.x) + bfhi(w.x)) + (bflo(w.y) + bfhi(w.y)); }
                                s += __shfl_xor(s, 32);
                                nreg = CR[0] * nreg + s; if (h2 == 0) NN[32 * wave + r31] = nreg; }
                            __syncthreads();
                        }
                    }
                }
            }
            if (rep_ == 0) {
                LAS unsigned* XB = (LAS unsigned*)(lds + 153088);
                unsigned* xc = (unsigned*)ctl + CW_FILL + 32 + l * 64;
                __syncthreads();
                if (tid_ph == 0) XB[0] = __hip_atomic_fetch_add(xc, 1u, RLX_AGENT);
                __syncthreads();
                int xi = __builtin_amdgcn_readfirstlane((int)XB[0]);
#pragma unroll 1
                while (xi < 128) {
                    const int idx = xi, bh = idx >> 1, half = idx & 1, b = bh >> 2, h = bh & 3;
                    _Pragma("unroll 1") for (int sr_ = 0; sr_ < NSUB(2); ++sr_) if ((SUBMASK>>2)&1) {
                        SUB_TID
                        constexpr int KST = 272, VST = 520;
                        LAS unsigned char* KI = lds; LAS unsigned char* VI = lds + 256 * KST;
                        const char* kvb = (const char*)(ws + WS_KV) + (((size_t)l * MROWS + (size_t)b * MEML) * D) * 2;
                        for (int p = tid; p < 4096; p += NTHR) { const int key = p >> 4, c16 = p & 15;
                            *(LAS u32x4*)(KI + key * KST + c16 * 16) = *(const u32x4*)(kvb + ((size_t)key * D + h * 128 + c16 * 8) * 2); }
                        for (int p = tid; p < 4096; p += NTHR) { const int key = p & 255, d8 = p >> 8;
                            const u32x4 w = *(const u32x4*)(kvb + ((size_t)key * D + 512 + h * 128 + d8 * 8) * 2);
                            LAS unsigned char* o = VI + (d8 * 8) * VST + key * 2;
                            *(LAS bf16*)(o) = (bf16)(w.x & 0xffff); *(LAS bf16*)(o + VST) = (bf16)(w.x >> 16); *(LAS bf16*)(o + 2 * VST) = (bf16)(w.y & 0xffff); *(LAS bf16*)(o + 3 * VST) = (bf16)(w.y >> 16);
                            *(LAS bf16*)(o + 4 * VST) = (bf16)(w.z & 0xffff); *(LAS bf16*)(o + 5 * VST) = (bf16)(w.z >> 16); *(LAS bf16*)(o + 6 * VST) = (bf16)(w.w & 0xffff); *(LAS bf16*)(o + 7 * VST) = (bf16)(w.w >> 16); }
                        __syncthreads();
                        const int r31 = lane & 31, h2 = lane >> 5;
                        constexpr float SC = 0.08838834764831845f * 1.4426950408889634f;
#pragma unroll 1
                        for (int rd = 0; rd < 8; ++rd) {
                            const size_t qrow = (size_t)b * SEQ + half * 2048 + rd * 256 + wave * 32 + r31;
                            bf16x8 qf[8];
#pragma unroll
                            for (int ks = 0; ks < 8; ++ks) qf[ks] = *(const bf16x8*)(Ub + (qrow * NU + UC_CAQ + h * 128 + 16 * ks + 8 * h2) * 2);
                            f32x16 O[4];
#pragma unroll
                            for (int db = 0; db < 4; ++db)
#pragma unroll
                                for (int i = 0; i < 16; ++i) O[db][i] = 0.f;
                            float mrun = -1e30f, lrun = 0.f;
#pragma unroll 1
                            for (int hf = 0; hf < 2; ++hf) {
                                f32x16 X[4];
#pragma unroll
                                for (int kb = 0; kb < 4; ++kb) {
                                    bf16x8 kf[8];
#pragma unroll
                                    for (int ks = 0; ks < 8; ++ks) kf[ks] = *(const LAS bf16x8*)(KI + (hf * 128 + kb * 32 + r31) * KST + (16 * ks + 8 * h2) * 2);
                                    __builtin_amdgcn_sched_barrier(0);
#pragma unroll
                                    for (int i = 0; i < 16; ++i) X[kb][i] = 0.f;
#pragma unroll
                                    for (int ks = 0; ks < 8; ++ks) X[kb] = __builtin_amdgcn_mfma_f32_32x32x16_bf16(kf[ks], qf[ks], X[kb], 0, 0, 0);
                                    __builtin_amdgcn_sched_barrier(0);
                                }
                                float mx = -1e30f;
#pragma unroll
                                for (int kb = 0; kb < 4; ++kb)
#pragma unroll
                                    for (int i = 0; i < 16; ++i) mx = fmaxf(mx, X[kb][i]);
                                mx = fmaxf(mx, __shfl_xor(mx, 32));
                                const float mnew = fmaxf(mrun, mx), alpha = __builtin_amdgcn_exp2f((mrun - mnew) * SC);
                                float ls = 0.f;
#pragma unroll
                                for (int kb = 0; kb < 4; ++kb)
#pragma unroll
                                    for (int i = 0; i < 16; ++i) { const float p = __builtin_amdgcn_exp2f((X[kb][i] - mnew) * SC); X[kb][i] = p; ls += p; }
                                ls += __shfl_xor(ls, 32);
                                lrun = lrun * alpha + ls; mrun = mnew;
#pragma unroll
                                for (int db = 0; db < 4; ++db)
#pragma unroll
                                    for (int i = 0; i < 16; ++i) O[db][i] *= alpha;
#pragma unroll
                                for (int kb = 0; kb < 4; ++kb) {
                                    bf16x8 vf[2][4], pf[2];
#pragma unroll
                                    for (int s = 0; s < 2; ++s) {
                                        u32x4 pw; pw.x = pk2(X[kb][8 * s], X[kb][8 * s + 1]); pw.y = pk2(X[kb][8 * s + 2], X[kb][8 * s + 3]); pw.z = pk2(X[kb][8 * s + 4], X[kb][8 * s + 5]); pw.w = pk2(X[kb][8 * s + 6], X[kb][8 * s + 7]);
                                        pf[s] = __builtin_bit_cast(bf16x8, pw);
#pragma unroll
                                        for (int db = 0; db < 4; ++db) {
                                            const LAS unsigned char* vp = VI + (db * 32 + r31) * VST + (hf * 128 + kb * 32 + 16 * s + 4 * h2) * 2;
                                            const u32x2 lo = *(const LAS u32x2*)vp, hi = *(const LAS u32x2*)(vp + 16);
                                            vf[s][db] = __builtin_bit_cast(bf16x8, (u32x4){lo.x, lo.y, hi.x, hi.y});
                                        }
                                    }
                                    __builtin_amdgcn_sched_barrier(0);
#pragma unroll
                                    for (int s = 0; s < 2; ++s)
#pragma unroll
                                        for (int db = 0; db < 4; ++db) O[db] = __builtin_amdgcn_mfma_f32_32x32x16_bf16(vf[s][db], pf[s], O[db], 0, 0, 0);
                                    __builtin_amdgcn_sched_barrier(0);
                                }
                            }
                            const float rl = 1.f / lrun;
                            char* op = HC + (qrow * 1536 + 1024 + h * 128) * 2;
#pragma unroll
                            for (int db = 0; db < 4; ++db)
#pragma unroll
                                for (int g4 = 0; g4 < 4; ++g4) { u32x2 w; w.x = pk2(O[db][4 * g4] * rl, O[db][4 * g4 + 1] * rl); w.y = pk2(O[db][4 * g4 + 2] * rl, O[db][4 * g4 + 3] * rl);
                                    *(u32x2*)(op + (db * 32 + 8 * g4 + 4 * h2) * 2) = w; }
                        }
                        __syncthreads();
                    }
                    if (tid_ph == 0) XB[0] = __hip_atomic_fetch_add(xc, 1u, RLX_AGENT);
                    __syncthreads();
                    xi = __builtin_amdgcn_readfirstlane((int)XB[0]);
                    __syncthreads();
                }
            }
            if (rep_ == 0) {
                unsigned zf_ = 0u; asm volatile("" : "+v"(zf_)); const int lane_f = (int)__builtin_amdgcn_mbcnt_hi(~0u, __builtin_amdgcn_mbcnt_lo(~0u, zf_));
                LAS float* scr = (LAS float*)(lds + wave * 8448);
                LAS unsigned* FB = (LAS unsigned*)(lds + 8 * 8448);
                unsigned* fc = (unsigned*)ctl + CW_FILL + l * 64;
                constexpr int IT_GU = 32 * 16 * 64, IT_ALL = 49152, CH = 32;
                const bool lead = (wave == 0) && (lane_f == 0);
                __syncthreads();
                if (lead) FB[0] = __hip_atomic_fetch_add(fc, (unsigned)CH, RLX_AGENT);
                __syncthreads();
                int fbase = __builtin_amdgcn_readfirstlane((int)FB[0]), slot = 1;
#pragma unroll 1
                while (fbase < IT_ALL) {
                    unsigned nb = 0u;
                    if (lead) nb = __hip_atomic_fetch_add(fc, (unsigned)CH, RLX_AGENT);
                    {
                        struct FItem { const float* W; unsigned char* WT; int ldw; float sc; };
                        auto FI = [&](int it) -> FItem { FItem r;
                            if (it < IT_GU) { const int e = it >> 10, q = it & 1023, kb = q >> 6, nb_ = q & 63;
                                r.W = INP(I_WGU) + (((size_t)l * 32 + e) * D + 64 * kb) * 2048 + 32 * nb_; r.ldw = 2048; r.WT = (unsigned char*)(ws + WS_WGU) + ((size_t)e * 2048 + 32 * nb_) * D + 64 * kb; r.sc = F8_SWGU; }
                            else { const int r2 = it - IT_GU, e = r2 >> 9, q = r2 & 511, kb = q >> 5, nb_ = q & 31;
                                r.W = INP(I_WDN) + (((size_t)l * 32 + e) * D + 64 * kb) * 1024 + 32 * nb_; r.ldw = 1024; r.WT = (unsigned char*)(ws + WS_WDN) + ((size_t)e * 1024 + 32 * nb_) * D + 64 * kb; r.sc = F8_SWDN; }
                            return r; };
                        f32x4 va[8], vb[8];
                        FItem c0 = FI(fbase + wave), c1;
                        ti_load4(c0.W, c0.ldw, lane_f, va);
#pragma unroll 1
                        for (int kq = 0; kq < CH / NWAVES; kq += 2) {
                            c1 = FI(fbase + wave + (kq + 1) * NWAVES); ti_load4(c1.W, c1.ldw, lane_f, vb);
                            ti_store4_f8(va, c0.WT, D, c0.sc, lane_f);
                            if (kq + 2 < CH / NWAVES) { c0 = FI(fbase + wave + (kq + 2) * NWAVES); ti_load4(c0.W, c0.ldw, lane_f, va); }
                            ti_store4_f8(vb, c1.WT, D, c1.sc, lane_f);
                        }
                    }
                    if (lead) FB[slot] = nb;
                    __syncthreads();
                    fbase = __builtin_amdgcn_readfirstlane((int)FB[slot]); slot ^= 1;
                }
            }
#undef UNP4
#undef DOT4
#undef SUB_TID
        }
        SEAM(pb + 3);
        _Pragma("unroll 1") for (int rep_ = 0; rep_ < NREP(5); ++rep_) if (((PHMASK>>5)&1) && IN(pb + 5)) {
            SchedPlain S; S.T.init(M / 256, 4); S.G = G; S.c = bx; S.A = (const char*)(ws + WS_R2 + R2_HCAT); S.B = (const char*)(ws + WS_WBR) + (size_t)l * 1024 * 1536 * 2; S.C = (char*)(ws + WS_R2 + R2_YPRE);
            S.lda = 1536; S.ldb = 1536; S.ldc = D;
            pg8::EpiMerge E; E.U = Ub; E.gate_b = INP(I_GATEB) + (size_t)l * 3072;
            pg8::gemm_phase<false, true>(lds, 1536 * 2, 1536 * 2, 1536 * 2, S, E, wave);
        }
        SEAM(pb + 5);
        _Pragma("unroll 1") for (int rep_ = 0; rep_ < NREP(6); ++rep_) if (((PHMASK>>6)&1) && IN(pb + 6)) {
            SchedPlain S; S.T.init(M / 256, 4); S.G = G; S.c = bx; S.A = (const char*)(ws + WS_R2 + R2_YPRE); S.B = (const char*)(ws + WS_WO) + (size_t)l * D * D * 2; S.C = (char*)(ws + WS_R2 + R2_Z);
            S.lda = D; S.ldb = D; S.ldc = D;
            pg8::EpiStore E;
            pg8::gemm_phase<false>(lds, D * 2, D * 2, D * 2, S, E, wave);
        }
        SEAM(pb + 6);
        _Pragma("unroll 1") for (int rep_ = 0; rep_ < NREP(7); ++rep_) if (((PHMASK>>7)&1) && IN(pb + 7)) { PHASE_TID
            constexpr int WP = 2064;
            LAS unsigned char* WRb = lds;
            LAS float* RB = (LAS float*)(lds + 66048);
            LAS unsigned char* XS = lds + 66560 + wave * 4608;
            for (int i = tid; i < 32768; i += NTHR) { const int k = i >> 5, e = i & 31; *(LAS bf16*)(WRb + e * WP + k * 2) = (bf16)f2bf(INP(I_RTW)[((size_t)l * D + k) * 32 + e]); }
            if (tid < 32) RB[tid] = INP(I_RTB)[l * 32 + tid];
            const char* Zb = (const char*)(ws + WS_R2 + R2_Z);
            int* TKE = (int*)(ws + WS_TKE); float* TKG = (float*)(ws + WS_TKG); int* TKP = (int*)(ws + WS_TKP); int* ROWTOK = (int*)(ws + WS_ROWTOK);
            LAS unsigned* LCNT = (LAS unsigned*)(lds + 131072);
            LAS unsigned* GBASE = LCNT + 32; LAS unsigned* LLEN = LCNT + 64; LAS unsigned* LIST = LCNT + 128;
            if (tid < 65) LCNT[tid] = 0u;
            {
                f32x4 g[4], bb[4];
#pragma unroll
                for (int j = 0; j < 4; ++j) { g[j] = *(const f32x4*)(INP(I_LN1G) + l * D + 256 * j + 4 * lane); bb[j] = *(const f32x4*)(INP(I_LN1B) + l * D + 256 * j + 4 * lane); }
#pragma unroll 1
                for (int pp = gw; pp < M / 2; pp += NGW) {
                    f32x4 y0[4], y1[4];
#pragma unroll
                    for (int j = 0; j < 4; ++j) { y0[j] = ld4bf(Zb + ((size_t)(2 * pp) * D + 256 * j + 4 * lane) * 2) + ld4bf(Xb + ((size_t)(2 * pp) * D + 256 * j + 4 * lane) * 2) * DN_ALPHA;
                        y1[j] = ld4bf(Zb + ((size_t)(2 * pp + 1) * D + 256 * j + 4 * lane) * 2) + ld4bf(Xb + ((size_t)(2 * pp + 1) * D + 256 * j + 4 * lane) * 2) * DN_ALPHA; }
                    ln16(y0, g, bb); ln16(y1, g, bb);
#pragma unroll
                    for (int j = 0; j < 4; ++j) { st4bf(Xb + ((size_t)(2 * pp) * D + 256 * j + 4 * lane) * 2, y0[j]); st4bf(Xb + ((size_t)(2 * pp + 1) * D + 256 * j + 4 * lane) * 2, y1[j]);
                        *(unsigned*)((char*)(ws + WS_XF8) + (size_t)(2 * pp) * D + 256 * j + 4 * lane) = pk4_f8(y0[j].x * F8_SX, y0[j].y * F8_SX, y0[j].z * F8_SX, y0[j].w * F8_SX);
                        *(unsigned*)((char*)(ws + WS_XF8) + (size_t)(2 * pp + 1) * D + 256 * j + 4 * lane) = pk4_f8(y1[j].x * F8_SX, y1[j].y * F8_SX, y1[j].z * F8_SX, y1[j].w * F8_SX); }
                }
            }
            asm volatile("s_waitcnt vmcnt(0)" ::: "memory");
            __syncthreads();
            __builtin_amdgcn_fence(__ATOMIC_ACQUIRE, "agent");
            asm volatile("s_waitcnt vmcnt(0)" ::: "memory");
            if (rep_ == 0) {
                const int r31 = lane & 31, h2 = lane >> 5;
                const int mytok = 16 * (bx + (2 * wave + (r31 >> 4)) * G) + (r31 & 15);
                const char* sp[4];
#pragma unroll
                for (int q = 0; q < 4; ++q) { const int row = (lane >> 3) + 8 * q; const int tk = 16 * (bx + (2 * wave + (row >> 4)) * G) + (row & 15); sp[q] = Xb + ((size_t)tk * D + 8 * (lane & 7)) * 2; }
                f32x16 C;
#pragma unroll
                for (int i = 0; i < 16; ++i) C[i] = 0.f;
                u32x4 xr[4];
#pragma unroll
                for (int q = 0; q < 4; ++q) xr[q] = *(const u32x4*)(sp[q]);
#pragma unroll 1
                for (int sl = 0; sl < 16; ++sl) {
#pragma unroll
                    for (int q = 0; q < 4; ++q) *(LAS u32x4*)(XS + ((lane >> 3) + 8 * q) * 144 + (lane & 7) * 16) = xr[q];
                    if (sl + 1 < 16) {
#pragma unroll
                        for (int q = 0; q < 4; ++q) xr[q] = *(const u32x4*)(sp[q] + (sl + 1) * 128); }
#pragma unroll
                    for (int k2 = 0; k2 < 4; ++k2) C = __builtin_amdgcn_mfma_f32_32x32x16_bf16(*(const LAS bf16x8*)(WRb + r31 * WP + (64 * sl + 16 * k2 + 8 * h2) * 2), *(const LAS bf16x8*)(XS + r31 * 144 + (16 * k2 + 8 * h2) * 2), C, 0, 0, 0);
                }
                float v[16];
#pragma unroll
                for (int g4 = 0; g4 < 4; ++g4) { const f32x4 b4 = *(const LAS f32x4*)(RB + 8 * g4 + 4 * h2); v[4 * g4] = C[4 * g4] + b4.x; v[4 * g4 + 1] = C[4 * g4 + 1] + b4.y; v[4 * g4 + 2] = C[4 * g4 + 2] + b4.z; v[4 * g4 + 3] = C[4 * g4 + 3] + b4.w; }
                float lv[4]; int li_[4];
#pragma unroll
                for (int k = 0; k < 4; ++k) { float best = -3.0e38f; int bi = 0;
#pragma unroll
                    for (int i = 0; i < 16; ++i) { const int e = (i & 3) + 8 * (i >> 2) + 4 * h2; if (v[i] > best) { best = v[i]; bi = e; } }
#pragma unroll
                    for (int i = 0; i < 16; ++i) { const int e = (i & 3) + 8 * (i >> 2) + 4 * h2; v[i] = (e == bi) ? -3.0e38f : v[i]; }
                    lv[k] = best; li_[k] = bi; }
                float cv[8]; int ci[8];
#pragma unroll
                for (int k = 0; k < 4; ++k) { cv[k] = lv[k]; ci[k] = li_[k]; cv[4 + k] = __shfl_xor(lv[k], 32); ci[4 + k] = __shfl_xor(li_[k], 32); }
                float tv[4]; int te[4];
#pragma unroll
                for (int k = 0; k < 4; ++k) { float best = -3.0e38f; int bi = 64;
#pragma unroll
                    for (int i = 0; i < 8; ++i) { if (cv[i] > best || (cv[i] == best && ci[i] < bi)) { best = cv[i]; bi = ci[i]; } }
#pragma unroll
                    for (int i = 0; i < 8; ++i) cv[i] = (ci[i] == bi) ? -3.0e38f : cv[i];
                    tv[k] = best; te[k] = bi; }
                const float e1 = __expf(tv[1] - tv[0]), e2 = __expf(tv[2] - tv[0]), e3 = __expf(tv[3] - tv[0]), rs = 1.f / (1.f + e1 + e2 + e3);
                const float gt[4] = {rs, e1 * rs, e2 * rs, e3 * rs};
                if (h2 == 0) {
#pragma unroll
                    for (int k = 0; k < 4; ++k) {
                        const unsigned lpos = __hip_atomic_fetch_add(LCNT + te[k], 1u, __ATOMIC_RELAXED, __HIP_MEMORY_SCOPE_WORKGROUP);
                        const unsigned li = __hip_atomic_fetch_add(LLEN, 1u, __ATOMIC_RELAXED, __HIP_MEMORY_SCOPE_WORKGROUP);
                        LIST[2 * li] = (unsigned)(mytok * 4 + k); LIST[2 * li + 1] = (unsigned)te[k] | (lpos << 8);
                        TKE[mytok * 4 + k] = te[k]; TKG[mytok * 4 + k] = gt[k]; }
                }
            }
            __syncthreads();
            if (tid < 32 && rep_ == 0) GBASE[tid] = __hip_atomic_fetch_add((unsigned*)ctl + CW_CNT + (l * 32 + tid) * 64, LCNT[tid], RLX_AGENT);
            __syncthreads();
            if (rep_ == 0) { const unsigned n = LLEN[0];
                for (unsigned i = tid; i < n; i += NTHR) { const unsigned tk = LIST[2 * i], ev = LIST[2 * i + 1], e = ev & 255u, pos = GBASE[e] + (ev >> 8);
                    TKP[tk] = (int)pos; ROWTOK[(size_t)e * M + pos] = (int)(tk >> 2); } }
            __syncthreads();
        }
        SEAM(pb + 7);
        _Pragma("unroll 1") for (int rep_ = 0; rep_ < NREP(8); ++rep_) if (((PHMASK>>8)&1) && IN(pb + 8)) { PHASE_TID
            if (tid < 32) CNT[tid] = (int)__hip_atomic_load((unsigned*)ctl + CW_CNT + (l * 32 + tid) * 64, RLX_AGENT);
            __syncthreads();
            if (tid == 0) { int a = 0; for (int e = 0; e < 32; ++e) { PB[e] = a; a += (CNT[e] + 255) >> 8; } PB[32] = a; }
            __syncthreads();
            const int P = PB[32];
            const int* ROWTOK = (const int*)(ws + WS_ROWTOK);
            char* XD = (char*)(ws + WS_R1); const char* XF = (const char*)(ws + WS_XF8);
            for (int sb = gw * 64; sb < P * 256; sb += NGW * 64) {
                const int pm = sb >> 8; int e = 0;
#pragma unroll 1
                for (int j = 1; j < NEXP; ++j) e += (PB[j] <= pm) ? 1 : 0;
                const int pos0 = sb - PB[e] * 256, cnt = CNT[e];
                int nvalid = cnt - pos0; nvalid = nvalid > 64 ? 64 : nvalid;
                int tokv = -1; if (pos0 + lane < cnt) tokv = ROWTOK[(size_t)e * M + pos0 + lane];
#pragma unroll 1
                for (int j = 0; j < nvalid; j += 4) {
                    int t[4]; u32x4 a[4];
#pragma unroll
                    for (int i = 0; i < 4; ++i) { t[i] = __builtin_amdgcn_readlane(tokv, j + i);
                        if (t[i] >= 0) a[i] = *(const u32x4*)(XF + (size_t)t[i] * 1024 + lane * 16); }
#pragma unroll
                    for (int i = 0; i < 4; ++i) if (t[i] >= 0) *(u32x4*)(XD + (size_t)(sb + j + i) * 1024 + lane * 16) = a[i];
                }
            }
            LAS float* scr = (LAS float*)(lds + wave * 8448);
            constexpr int IT_GU = 32 * 16 * 64, IT_DN = 32 * 16 * 32;
            for (int it = XW_SPLIT + gw; it < IT_GU + IT_DN; it += NGW) {
                if (it < IT_GU) { const int e = it >> 10, q = it & 1023, kb = q >> 6, nb = q & 63;
                    transpose_item_f8(INP(I_WGU) + (((size_t)l * 32 + e) * D + 64 * kb) * 2048 + 32 * nb, 2048, (unsigned char*)(ws + WS_WGU) + ((size_t)e * 2048 + 32 * nb) * D + 64 * kb, D, F8_SWGU, scr, lane); }
                else { const int r = it - IT_GU, e = r >> 9, q = r & 511, kb = q >> 5, nb = q & 31;
                    transpose_item_f8(INP(I_WDN) + (((size_t)l * 32 + e) * D + 64 * kb) * 1024 + 32 * nb, 1024, (unsigned char*)(ws + WS_WDN) + ((size_t)e * 1024 + 32 * nb) * D + 64 * kb, D, F8_SWDN, scr, lane); }
            }
            __syncthreads();
        }
        SEAM(pb + 8);
        if (IN(pb + 9) || IN(pb + 10)) { PHASE_TID
            if (tid < 32) CNT[tid] = (int)__hip_atomic_load((unsigned*)ctl + CW_CNT + (l * 32 + tid) * 64, RLX_AGENT);
            __syncthreads();
            if (tid == 0) { int a = 0; for (int e = 0; e < 32; ++e) { PB[e] = a; a += (CNT[e] + 255) >> 8; } PB[32] = a; }
            __syncthreads();
        }
        _Pragma("unroll 1") for (int rep_ = 0; rep_ < NREP(9); ++rep_) if (((PHMASK>>9)&1) && IN(pb + 9)) {
            SchedMoe S; S.T.init(PB[32], 8); S.G = G; S.c = bx; S.A = (const char*)(ws + WS_R1); S.W = (const char*)(ws + WS_WGU); S.C = (char*)(ws + WS_R2 + R2_HMID); S.PB = PB; S.wrows = 2048; S.ldc = 1024; S.cdiv = 2; S.osz = 1;
            pg8::EpiMoe1 E; E.bgu = INP(I_BGU) + (size_t)l * 32 * 2048;
            pg8::gemm_phase<true>(lds, D, D, D, S, E, wave);
        }
        SEAM(pb + 9);
        _Pragma("unroll 1") for (int rep_ = 0; rep_ < NREP(10); ++rep_) if (((PHMASK>>10)&1) && IN(pb + 10)) {
            SchedMoe S; S.T.init(PB[32], 4); S.G = G; S.c = bx; S.A = (const char*)(ws + WS_R2 + R2_HMID); S.W = (const char*)(ws + WS_WDN); S.C = (char*)(ws + WS_R1); S.PB = PB; S.wrows = 1024; S.ldc = 1024; S.cdiv = 1; S.osz = 2;
            pg8::EpiMoe2 E; E.bdn = INP(I_BDN) + (size_t)l * 32 * 1024;
            pg8::gemm_phase<true>(lds, D, D, D, S, E, wave);
        }
        SEAM(pb + 10);
        _Pragma("unroll 1") for (int rep_ = 0; rep_ < NREP(11); ++rep_) if (((PHMASK>>11)&1) && IN(pb + 11)) { PHASE_TID
            if (tid < 32) CNT[tid] = (int)__hip_atomic_load((unsigned*)ctl + CW_CNT + (l * 32 + tid) * 64, RLX_AGENT);
            LAS float* wgt = (LAS float*)(lds + 73728);
            const bool lastl = (l == DEPTH - 1);
            if (!lastl) load_gate_table(wgt, INP(I_WIN) + (size_t)(l + 1) * D * DIN, tid);
            __syncthreads();
            if (tid == 0) { int a = 0; for (int e = 0; e < 32; ++e) { PB[e] = a; a += (CNT[e] + 255) >> 8; } PB[32] = a; }
            __syncthreads();
            const int e0 = 8 * lane;
            f32x4 g[4], bb[4];
#pragma unroll
            for (int j = 0; j < 4; ++j) { const int o = (j >> 1) * 512 + e0 + (j & 1) * 4; g[j] = *(const f32x4*)(INP(I_LN2G) + l * D + o); bb[j] = *(const f32x4*)(INP(I_LN2B) + l * D + o); }
            const char* YA = (const char*)(ws + WS_R1);
            const bool dummy_ = (rep_ + 1 < NREP(11)); char* const Xo = dummy_ ? (char*)(ws + WS_R2) : Xb; float* const Fo = dummy_ ? (float*)(ws + WS_R2 + 256 * MiB) : args.out; float* const Go = dummy_ ? (float*)(ws + WS_R2 + 200 * MiB) : GIF;
            const int* TKE = (const int*)(ws + WS_TKE); const float* TKG = (const float*)(ws + WS_TKG); const int* TKP = (const int*)(ws + WS_TKP);
#pragma unroll 1
            for (int mb = gw * 16; mb < M; mb += NGW * 16) {
                const int ev = TKE[mb * 4 + lane], pv = TKP[mb * 4 + lane]; const float gv = TKG[mb * 4 + lane];
                const int rowv = PB[ev] * 256 + pv;
#pragma unroll 1
                for (int ti = 0; ti < 16; ti += 2) {
                    u32x4 xw[2][2], yw[2][4][2]; float gk[2][4];
#pragma unroll
                    for (int q = 0; q < 2; ++q) { const size_t m = (size_t)mb + ti + q;
                        xw[q][0] = *(const u32x4*)(Xb + (m * D + e0) * 2); xw[q][1] = *(const u32x4*)(Xb + (m * D + 512 + e0) * 2);
#pragma unroll
                        for (int k = 0; k < 4; ++k) { const size_t row = (size_t)__builtin_amdgcn_readlane(rowv, 4 * (ti + q) + k);
                            gk[q][k] = __builtin_bit_cast(float, __builtin_amdgcn_readlane(__builtin_bit_cast(int, gv), 4 * (ti + q) + k));
                            yw[q][k][0] = *(const u32x4*)(YA + (row * D + e0) * 2); yw[q][k][1] = *(const u32x4*)(YA + (row * D + 512 + e0) * 2); } }
#pragma unroll
                    for (int q = 0; q < 2; ++q) { const size_t m = (size_t)mb + ti + q;
                        f32x4 v[4];
#pragma unroll
                        for (int hh = 0; hh < 2; ++hh) { const u32x4 w = xw[q][hh];
                            v[2 * hh] = (f32x4){bflo(w.x), bfhi(w.x), bflo(w.y), bfhi(w.y)} * DN_ALPHA; v[2 * hh + 1] = (f32x4){bflo(w.z), bfhi(w.z), bflo(w.w), bfhi(w.w)} * DN_ALPHA; }
#pragma unroll
                        for (int k = 0; k < 4; ++k)
#pragma unroll
                            for (int hh = 0; hh < 2; ++hh) { const u32x4 w = yw[q][k][hh];
                                v[2 * hh] = v[2 * hh] + (f32x4){bflo(w.x), bfhi(w.x), bflo(w.y), bfhi(w.y)} * gk[q][k]; v[2 * hh + 1] = v[2 * hh + 1] + (f32x4){bflo(w.z), bfhi(w.z), bflo(w.w), bfhi(w.w)} * gk[q][k]; }
                        ln16(v, g, bb);
                        if (lastl) {
#pragma unroll
                            for (int j = 0; j < 4; ++j) *(f32x4*)(Fo + m * D + (j >> 1) * 512 + e0 + (j & 1) * 4) = v[j];
                        } else {
#pragma unroll
                            for (int hh = 0; hh < 2; ++hh) { *(u32x4*)(Xo + (m * D + hh * 512 + e0) * 2) = pg8::pack8(v[2 * hh], v[2 * hh + 1]);
                                u32x2 f8w; f8w.x = pk4_f8(v[2 * hh].x * F8_SX, v[2 * hh].y * F8_SX, v[2 * hh].z * F8_SX, v[2 * hh].w * F8_SX); f8w.y = pk4_f8(v[2 * hh + 1].x * F8_SX, v[2 * hh + 1].y * F8_SX, v[2 * hh + 1].z * F8_SX, v[2 * hh + 1].w * F8_SX);
                                if (!dummy_) *(u32x2*)((char*)(ws + WS_XF8) + m * D + hh * 512 + e0) = f8w; }
                            gates8b(v, wgt, Go + m * 8, lane);
                        }
                    }
                }
            }
            __syncthreads();
        }
        SEAM(pb + 11);
    }
#undef IN
#undef SEAM
}

extern "C" void kernel_launch(void* const* d_in, const int* in_sizes, int n_in, void* d_out, int out_size, void* d_ws, size_t ws_size, hipStream_t stream) {
    static int grid = 0;
    if (grid == 0) {
        if (n_in != N_IN || out_size != M * D || ws_size < WS_END) { fprintf(stderr, "kernel_launch: unexpected shapes (n_in %d, out %d, ws %zu)\n", n_in, out_size, ws_size); grid = -1; return; }
        int dev = 0, cus = 0, per_cu = 0;
        if (hipGetDevice(&dev) != hipSuccess || hipDeviceGetAttribute(&cus, hipDeviceAttributeMultiprocessorCount, dev) != hipSuccess) { grid = -1; return; }
        if (hipFuncSetAttribute((const void*)fwd_kernel, hipFuncAttributeMaxDynamicSharedMemorySize, LDS_BYTES) != hipSuccess) { fprintf(stderr, "kernel_launch: hipFuncSetAttribute failed\n"); grid = -1; return; }
        if (hipOccupancyMaxActiveBlocksPerMultiprocessor(&per_cu, (const void*)fwd_kernel, NTHR, LDS_BYTES) != hipSuccess || per_cu < 1) fprintf(stderr, "kernel_launch: occupancy query reports %d\n", per_cu);
        (void)hipGetLastError();
        grid = cus;
    }
    if (grid < 0) return;
    (void)hipMemsetAsync((char*)d_ws + WS_CTL, 0, CTL_ZERO_BYTES, stream);
    Args a{};
    for (int i = 0; i < N_IN; ++i) a.in[i] = (const float*)d_in[i];
    a.out = (float*)d_out; a.ws = (unsigned char*)d_ws;
#if MK_ONE_LAUNCH
    a.ph_lo = 0; a.ph_hi = NPH;
    hipLaunchKernelGGL(fwd_kernel, dim3(grid), dim3(NTHR), LDS_BYTES, stream, a);
#else
    for (int p = 0; p < NPH; ++p) { a.ph_lo = p; a.ph_hi = p + 1; hipLaunchKernelGGL(fwd_kernel, dim3(grid), dim3(NTHR), LDS_BYTES, stream, a); }
#endif
    const hipError_t le = hipPeekAtLastError();
    if (le != hipSuccess) fprintf(stderr, "kernel_launch: launch failed: %s\n", hipGetErrorName(le));
}
```

```cpp
#include <hip/hip_runtime.h>
#include <cstdio>
#include <cstdint>

#ifndef MK_ONE_LAUNCH
#define MK_ONE_LAUNCH 1
#endif

#define LAS __attribute__((address_space(3)))
#define GAS __attribute__((address_space(1)))
typedef unsigned short bf16;
typedef short bf16x8 __attribute__((ext_vector_type(8)));
typedef float f32x4 __attribute__((ext_vector_type(4)));
typedef float f32x2 __attribute__((ext_vector_type(2)));
typedef float f32x16 __attribute__((ext_vector_type(16)));
typedef unsigned u32x4 __attribute__((ext_vector_type(4)));
typedef unsigned u32x2 __attribute__((ext_vector_type(2)));
typedef __bf16 bf16x2_t __attribute__((ext_vector_type(2)));
typedef GAS unsigned gu32;
#define RLX_AGENT __ATOMIC_RELAXED, __HIP_MEMORY_SCOPE_AGENT
#define DI __device__ __forceinline__

constexpr int NWAVES = 8, NTHR = 512;
constexpr int D = 1024, BATCH = 16, SEQ = 4096, M = BATCH * SEQ, DEPTH = 2, MEML = 256, MROWS = BATCH * MEML;
constexpr int DIN = 6920, NU = 6912;
constexpr int UC_QK = 0, UC_RW = 512, UC_V = 2304, UC_OG = 2816, UC_CAQ = 3328, UC_GATE = 3840;
constexpr int UC_F8 = UC_V, NF8 = NU - UC_F8;
__host__ __device__ constexpr int ucol_src(int c) { return c < 512 ? c : (c < 2304 ? 1544 + (c - 512) : (c < 2816 ? 512 + (c - 2304) : (c < 3328 ? 1024 + (c - 2816) : (c < 3840 ? 3336 + (c - 3328) : 3848 + (c - 3840))))); }
constexpr int NEXP = 32, TOPK = 4;
constexpr int PMAX = M * TOPK / 256 + NEXP;
constexpr float LN_EPS = 1e-5f, RW_GN_EPS = 64e-5f, DN_ALPHA = 1.41421356237f;

enum { I_X = 0, I_MEM, I_LNIN_G, I_LNIN_B, I_MEMLN_G, I_MEMLN_B, I_WIN, I_CONVW, I_CONVB, I_IGB, I_FGB, I_MLNORMG, I_RWMU, I_RWW0, I_RWWUP, I_RWA0, I_RWAUP, I_RWGUP,
       I_RWKK, I_RWKA, I_RWRK, I_RWLNG, I_RWLNB, I_CAWKV, I_GATEB, I_WBRML, I_WBRRW, I_WBRCA, I_WO, I_LN1G, I_LN1B, I_RTW, I_RTB, I_WGU, I_BGU, I_WDN, I_BDN, I_LN2G, I_LN2B, N_IN };

constexpr size_t MiB = 1u << 20;
constexpr size_t WS_CTL = 0, CTL_ZERO_BYTES = 1 * MiB;
constexpr size_t WS_WIN = 1 * MiB;
constexpr size_t WS_WKV = 28 * MiB;
constexpr size_t WS_WBR = 32 * MiB;
constexpr size_t WS_WO = 38 * MiB;
constexpr size_t WS_WLORA = 42 * MiB;
constexpr size_t WS_WGU = 45 * MiB;
constexpr size_t WS_WDN = 173 * MiB;
constexpr size_t WS_X = 237 * MiB;
constexpr size_t WS_MEMN = 365 * MiB;
constexpr size_t WS_KV = 373 * MiB;
constexpr size_t WS_GIF = 389 * MiB;
constexpr size_t WS_TKE = 391 * MiB, WS_TKG = 392 * MiB, WS_TKP = 393 * MiB;
constexpr size_t WS_ROWTOK = 394 * MiB;
constexpr size_t WS_HML = 402 * MiB;
constexpr size_t WS_R1 = 466 * MiB;
constexpr size_t WS_R2 = 1330 * MiB;
constexpr size_t WS_XF8 = 1858 * MiB;
constexpr size_t WS_WING8 = 1922 * MiB;
constexpr size_t WS_END = 1932 * MiB;
constexpr size_t R2_LORA_OUT = 0, R2_HCAT = 192 * MiB, R2_LORA_IN = 384 * MiB, R2_YPRE = 0, R2_Z = 192 * MiB, R2_HMID = 0;
constexpr int CW_TMO = 0, CW_BAR = 4096, CW_CNT = 16384, CW_FILL = 32768;

constexpr int LDS_BYTES = 155648;
constexpr int LDSCTL_OFF = 153600;

DI unsigned pk2(float lo, float hi) { bf16x2_t b = __builtin_convertvector((f32x2){lo, hi}, bf16x2_t); return __builtin_bit_cast(unsigned, b); }
DI unsigned f2bf(float f) { return pk2(f, 0.f) & 0xffffu; }
DI float u2f_(unsigned u) { return __builtin_bit_cast(float, u); }
DI unsigned f2u_(float f) { return __builtin_bit_cast(unsigned, f); }
DI float bflo(unsigned u) { return __builtin_bit_cast(float, u << 16); }
DI float bfhi(unsigned u) { return __builtin_bit_cast(float, u & 0xffff0000u); }
DI unsigned pk4_f8(float a, float b, float c, float d) {
    a = __builtin_amdgcn_fmed3f(a, -448.f, 448.f); b = __builtin_amdgcn_fmed3f(b, -448.f, 448.f); c = __builtin_amdgcn_fmed3f(c, -448.f, 448.f); d = __builtin_amdgcn_fmed3f(d, -448.f, 448.f);
    int w = 0; w = __builtin_amdgcn_cvt_pk_fp8_f32(a, b, w, false); w = __builtin_amdgcn_cvt_pk_fp8_f32(c, d, w, true); return (unsigned)w; }
DI float sigmoidf_(float x) { return __builtin_amdgcn_rcpf(1.f + __builtin_amdgcn_exp2f(-1.4426950408889634f * x)); }
template <int CTRL> DI float dppf(float x) { return __builtin_bit_cast(float, __builtin_amdgcn_update_dpp(0, __builtin_bit_cast(int, x), CTRL, 0xF, 0xF, true)); }
DI float red4(float x) { x += dppf<0xB1>(x); x += dppf<0x4E>(x); return x; }
DI float red8(float x) { x = red4(x); x += dppf<0x141>(x); return x; }
DI float red16(float x) { x = red8(x); x += dppf<0x140>(x); return x; }
DI float red8o(float x) { x += dppf<0xB1>(x); asm("" : "+v"(x)); x += dppf<0x4E>(x); asm("" : "+v"(x)); x += dppf<0x141>(x); asm("" : "+v"(x)); return x; }
DI float red16o(float x) { x = red8o(x); x += dppf<0x140>(x); asm("" : "+v"(x)); return x; }
typedef short s16x4 __attribute__((ext_vector_type(4)));
DI u32x2 trd4(const LAS unsigned char* img, int PB, int rowbase, int colbase, int lane) {
    const LAS unsigned char* p = img + (rowbase + ((lane & 15) >> 2)) * PB + (colbase + 16 * ((lane >> 4) & 1) + 4 * (lane & 3)) * 2;
    return __builtin_bit_cast(u32x2, __builtin_amdgcn_ds_read_tr16_b64_v4i16((LAS s16x4*)p)); }
DI bf16x8 trd8(const LAS unsigned char* img, int PB, int rb0, int rb1, int colbase, int lane) { const u32x2 lo = trd4(img, PB, rb0, colbase, lane), hi = trd4(img, PB, rb1, colbase, lane); return __builtin_bit_cast(bf16x8, (u32x4){lo.x, lo.y, hi.x, hi.y}); }
template <int CTRL, int RM> DI float dpp_keep(float x, float ident) { return __builtin_bit_cast(float, __builtin_amdgcn_update_dpp(__builtin_bit_cast(int, ident), __builtin_bit_cast(int, x), CTRL, RM, 0xF, false)); }
DI float scan_add64(float x) { x += dpp_keep<0x111, 0xF>(x, 0.f); x += dpp_keep<0x112, 0xF>(x, 0.f); x += dpp_keep<0x114, 0xF>(x, 0.f); x += dpp_keep<0x118, 0xF>(x, 0.f); x += dpp_keep<0x142, 0xA>(x, 0.f); x += dpp_keep<0x143, 0xC>(x, 0.f); return x; }
DI float scan_max64(float x) { const float NI = -3.0e38f; x = fmaxf(x, dpp_keep<0x111, 0xF>(x, NI)); x = fmaxf(x, dpp_keep<0x112, 0xF>(x, NI)); x = fmaxf(x, dpp_keep<0x114, 0xF>(x, NI)); x = fmaxf(x, dpp_keep<0x118, 0xF>(x, NI));
    x = fmaxf(x, dpp_keep<0x142, 0xA>(x, NI)); x = fmaxf(x, dpp_keep<0x143, 0xC>(x, NI)); return x; }
DI float wave_sum(float v) {
    v = red16(v);
    const int vi = __builtin_bit_cast(int, v);
    const float a = __builtin_bit_cast(float, __builtin_amdgcn_readlane(vi, 0)), b = __builtin_bit_cast(float, __builtin_amdgcn_readlane(vi, 16));
    const float c = __builtin_bit_cast(float, __builtin_amdgcn_readlane(vi, 32)), d = __builtin_bit_cast(float, __builtin_amdgcn_readlane(vi, 48));
    return (a + b) + (c + d);
}
#define LDS_WAIT() asm volatile("s_waitcnt lgkmcnt(0)" ::: "memory")

constexpr float F8_SX = 8.f, F8_SWGU = 512.f, F8_SH = 4.f, F8_SWDN = 1024.f, F8_INV1 = 1.f / (F8_SX * F8_SWGU), F8_INV2 = 1.f / (F8_SH * F8_SWDN);
namespace pg8 {
constexpr int BM = 256, BK = 64, HALF = 128, HTB = HALF * BK * 2, STAGE_BYTES = 8 * HTB, NXCD = 8, WGM = 8;
__host__ __device__ __forceinline__ int lds_byte(int r, int c) { const int st = (r >> 4) * 2 + (c >> 5), rr = r & 15, cc = c & 31, ob = rr * 64 + cc * 2; return st * 1024 + (ob ^ (((ob >> 9) & 1) << 5)); }
__host__ __device__ __forceinline__ void stage_rc(int b, int& R, int& C) { const int st = b / 1024, sb = b % 1024, swz = sb ^ (((sb >> 9) & 1) << 5); R = (st >> 1) * 16 + swz / 64; C = (st & 1) * 32 + (swz % 64) / 2; }
__host__ __device__ __forceinline__ int perm32(int rho) { const int n = rho >> 4, i = rho & 15; return 8 * (i >> 2) + 4 * n + (i & 3); }

struct Unit { const char* a; const char* b; char* c; const int* gi; int ldc; int r0, c0, e, sub; };

struct TileOrder {
    int nM, nN, nwg;
    DI void init(int nM_, int nN_) { nM = nM_; nN = nN_; nwg = nM * nN; }
    DI bool tile(long L, int& pm, int& pn) const {
        if (L >= nwg) return false;
        int wgid = (int)L; { const int q = nwg / NXCD, r = nwg % NXCD, xcd = wgid % NXCD, off = wgid / NXCD; wgid = (xcd < r ? xcd * (q + 1) : r * (q + 1) + (xcd - r) * q) + off; }
        const int nig = WGM * nN, gid = wgid / nig, fm = gid * WGM, gsz = (nM - fm) < WGM ? (nM - fm) : WGM;
        pm = fm + ((wgid % nig) % gsz); pn = (wgid % nig) / gsz; return true;
    }
};

DI u32x4 pack8(const f32x4& v0, const f32x4& v1) { u32x4 w; w.x = pk2(v0[0], v0[1]); w.y = pk2(v0[2], v0[3]); w.z = pk2(v1[0], v1[1]); w.w = pk2(v1[2], v1[3]); return w; }

struct EpiStore {
    DI void operator()(const f32x4 (&acc)[2][2][4][2], const Unit& u, int wr, int wc, int fr, int fq) const {
#pragma unroll
        for (int ai = 0; ai < 2; ++ai)
#pragma unroll
            for (int m = 0; m < 4; ++m) { char* rowp = u.c + ((size_t)(ai * HALF + wr * 64 + m * 16 + fr) * u.ldc + wc * 32 + 8 * fq) * 2;
#pragma unroll
                for (int bj = 0; bj < 2; ++bj) *(u32x4*)(rowp + bj * 256) = pack8(acc[ai][bj][m][0], acc[ai][bj][m][1]); }
    }
};
struct EpiStoreS {
    float s; const float* gate_b; int gate_c0;
    DI void operator()(const f32x4 (&acc)[2][2][4][2], const Unit& u, int wr, int wc, int fr, int fq) const {
        const bool gate = u.c0 >= gate_c0;
        const float L2E = 1.4426950408889634f;
#pragma unroll
        for (int bj = 0; bj < 2; ++bj) {
            f32x4 g0 = (f32x4){0.f, 0.f, 0.f, 0.f}, g1 = g0;
            if (gate) { const float* g = gate_b + (u.c0 - gate_c0) + bj * HALF + wc * 32 + 8 * fq; g0 = *(const f32x4*)g * (-L2E); g1 = *(const f32x4*)(g + 4) * (-L2E); }
            const float sv = gate ? -L2E * s : s;
#pragma unroll
            for (int ai = 0; ai < 2; ++ai)
#pragma unroll
                for (int m = 0; m < 4; ++m) { char* rowp = u.c + ((size_t)(ai * HALF + wr * 64 + m * 16 + fr) * u.ldc + wc * 32 + 8 * fq) * 2;
                    f32x4 v0 = acc[ai][bj][m][0] * sv + g0, v1 = acc[ai][bj][m][1] * sv + g1;
                    if (gate) {
#pragma unroll
                        for (int i = 0; i < 4; ++i) { v0[i] = __builtin_amdgcn_exp2f(__builtin_amdgcn_fmed3f(v0[i], -30.f * L2E, 30.f * L2E)); v1[i] = __builtin_amdgcn_exp2f(__builtin_amdgcn_fmed3f(v1[i], -30.f * L2E, 30.f * L2E)); } }
                    *(u32x4*)(rowp + bj * 256) = pack8(v0, v1); }
        }
    }
};
struct EpiMerge {
    static constexpr bool MIDK = true;
    const char* U; const float* gate_b;
    DI void mid(f32x4 (&acc)[2][2][4][2], const Unit& u, int which, int wr, int wc, int fr, int fq) const {
        u32x4 wa[3][2], wn[3][2];
        const char* g0 = U + ((size_t)(u.r0 + wr * 64 + fr) * NU + UC_GATE + which * 1024 + u.c0 + wc * 32 + 8 * fq) * 2;
#define MID_LD(j, buf) do { _Pragma("unroll") for (int mm = 0; mm < 2; ++mm) { const char* gp = g0 + (size_t)((((j) >> 1) & 1) * HALF + (2 * ((j) & 1) + mm) * 16) * NU * 2 + ((j) >> 2) * 256; \
            wa[buf][mm] = *(const u32x4*)gp; wn[buf][mm] = *(const u32x4*)(gp + 2048); } } while (0)
        MID_LD(0, 0); MID_LD(1, 1); MID_LD(2, 2);
#pragma unroll
        for (int j = 0; j < 8; ++j) {
            const int bj = j >> 2, ai = (j >> 1) & 1, buf = j % 3;
#pragma unroll
            for (int mm = 0; mm < 2; ++mm) { const int m = 2 * (j & 1) + mm;
                const u32x4 a = wa[buf][mm], n = wn[buf][mm];
                const float ea[8] = {bflo(a.x), bfhi(a.x), bflo(a.y), bfhi(a.y), bflo(a.z), bfhi(a.z), bflo(a.w), bfhi(a.w)};
                const float en[8] = {bflo(n.x), bfhi(n.x), bflo(n.y), bfhi(n.y), bflo(n.z), bfhi(n.z), bflo(n.w), bfhi(n.w)};
#pragma unroll
                for (int i = 0; i < 8; ++i) acc[ai][bj][m][i >> 2][i & 3] *= (1.f + en[i]) * __builtin_amdgcn_rcpf(1.f + ea[i]); }
            if (j == 0) MID_LD(3, 0); else if (j == 1) MID_LD(4, 1); else if (j == 2) MID_LD(5, 2); else if (j == 3) MID_LD(6, 0); else if (j == 4) MID_LD(7, 1);
        }
#undef MID_LD
    }
    DI void operator()(const f32x4 (&acc)[2][2][4][2], const Unit& u, int wr, int wc, int fr, int fq) const {
#pragma unroll
        for (int bj = 0; bj < 2; ++bj) {
            u32x4 gw[2][4];
#pragma unroll
            for (int ai = 0; ai < 2; ++ai)
#pragma unroll
                for (int m = 0; m < 4; ++m) { const int lr = ai * HALF + wr * 64 + m * 16 + fr; gw[ai][m] = *(const u32x4*)(U + ((size_t)(u.r0 + lr) * NU + UC_GATE + 2048 + u.c0 + wc * 32 + 8 * fq) * 2 + bj * 256); }
#pragma unroll
            for (int ai = 0; ai < 2; ++ai)
#pragma unroll
                for (int m = 0; m < 4; ++m) { const int lr = ai * HALF + wr * 64 + m * 16 + fr; char* rowp = u.c + ((size_t)lr * u.ldc + wc * 32 + 8 * fq) * 2; const u32x4 w = gw[ai][m];
                    f32x4 v0 = acc[ai][bj][m][0], v1 = acc[ai][bj][m][1];
                    v0[0] *= __builtin_amdgcn_rcpf(1.f + bflo(w.x)); v0[1] *= __builtin_amdgcn_rcpf(1.f + bfhi(w.x)); v0[2] *= __builtin_amdgcn_rcpf(1.f + bflo(w.y)); v0[3] *= __builtin_amdgcn_rcpf(1.f + bfhi(w.y));
                    v1[0] *= __builtin_amdgcn_rcpf(1.f + bflo(w.z)); v1[1] *= __builtin_amdgcn_rcpf(1.f + bfhi(w.z)); v1[2] *= __builtin_amdgcn_rcpf(1.f + bflo(w.w)); v1[3] *= __builtin_amdgcn_rcpf(1.f + bfhi(w.w));
                    *(u32x4*)(rowp + bj * 256) = pack8(v0, v1); }
            asm volatile("" ::: "memory");
        }
    }
};
struct EpiWo {
    const char* X;
    DI void operator()(const f32x4 (&acc)[2][2][4][2], const Unit& u, int wr, int wc, int fr, int fq) const {
        const char* x0 = X + ((size_t)(u.r0 + wr * 64 + fr) * D + u.c0 + wc * 32 + 8 * fq) * 2;
        char* c0p = u.c + ((size_t)(wr * 64 + fr) * u.ldc + wc * 32 + 8 * fq) * 2;
        u32x4 xw[16];
#define WO_LD(p, s) xw[s] = *(const u32x4*)(x0 + (size_t)((((p) >> 3) & 1) * HALF + (((p) >> 1) & 3) * 16) * D * 2 + ((p) & 1) * 256)
#pragma unroll
        for (int p = 0; p < 16; ++p) WO_LD(p, p);
#pragma unroll
        for (int p = 0; p < 16; ++p) { const int ai = p >> 3, m = (p >> 1) & 3, bj = p & 1; const u32x4 w = xw[p];
            f32x4 v0 = acc[ai][bj][m][0], v1 = acc[ai][bj][m][1];
            v0[0] += DN_ALPHA * bflo(w.x); v0[1] += DN_ALPHA * bfhi(w.x); v0[2] += DN_ALPHA * bflo(w.y); v0[3] += DN_ALPHA * bfhi(w.y);
            v1[0] += DN_ALPHA * bflo(w.z); v1[1] += DN_ALPHA * bfhi(w.z); v1[2] += DN_ALPHA * bflo(w.w); v1[3] += DN_ALPHA * bfhi(w.w);
            *(u32x4*)(c0p + (size_t)(ai * HALF + m * 16) * u.ldc * 2 + bj * 256) = pack8(v0, v1);
        }
#undef WO_LD
    }
};
DI float swiglu1(float a, float b) { const float g = fminf(a, 7.f), l = fminf(fmaxf(b, -7.f), 7.f); return g * sigmoidf_(1.702f * g) * (l + 1.f); }
DI unsigned swiglu4_f8(const f32x4& v0, const f32x4& v1) {
    constexpr float KE = -1.702f * 1.4426950408889634f;
    const f32x2 ga = {fminf(v0[0], 7.f), fminf(v0[2], 7.f)}, gb = {fminf(v1[0], 7.f), fminf(v1[2], 7.f)};
    const f32x2 la = {__builtin_amdgcn_fmed3f(v0[1], -7.f, 7.f), __builtin_amdgcn_fmed3f(v0[3], -7.f, 7.f)}, lb = {__builtin_amdgcn_fmed3f(v1[1], -7.f, 7.f), __builtin_amdgcn_fmed3f(v1[3], -7.f, 7.f)};
    f32x2 ea = ga * KE, eb = gb * KE;
    ea = (f32x2){__builtin_amdgcn_exp2f(ea.x), __builtin_amdgcn_exp2f(ea.y)} + 1.f; eb = (f32x2){__builtin_amdgcn_exp2f(eb.x), __builtin_amdgcn_exp2f(eb.y)} + 1.f;
    const f32x2 ra = {__builtin_amdgcn_rcpf(ea.x), __builtin_amdgcn_rcpf(ea.y)}, rb = {__builtin_amdgcn_rcpf(eb.x), __builtin_amdgcn_rcpf(eb.y)};
    const f32x2 oa = (ga * ra) * (la * F8_SH + F8_SH), ob = (gb * rb) * (lb * F8_SH + F8_SH);
    int w = 0; w = __builtin_amdgcn_cvt_pk_fp8_f32(oa.x, oa.y, w, false); w = __builtin_amdgcn_cvt_pk_fp8_f32(ob.x, ob.y, w, true); return (unsigned)w;
}
struct EpiMoe1 {
    const float* bgu;
    DI void operator()(const f32x4 (&acc)[2][2][4][2], const Unit& u, int wr, int wc, int fr, int fq) const {
        f32x4 bv[2][2];
#pragma unroll
        for (int bj = 0; bj < 2; ++bj) { const float* b = bgu + u.e * 2048 + u.c0 + bj * HALF + wc * 32 + 8 * fq; bv[bj][0] = *(const f32x4*)b; bv[bj][1] = *(const f32x4*)(b + 4); }
#pragma unroll
        for (int ai = 0; ai < 2; ++ai)
#pragma unroll
            for (int m = 0; m < 4; ++m) { const int lr = ai * HALF + wr * 64 + m * 16 + fr; char* rowp = u.c + ((size_t)lr * u.ldc + wc * 16 + 4 * fq);
#pragma unroll
                for (int bj = 0; bj < 2; ++bj) { const f32x4 v0 = acc[ai][bj][m][0] * F8_INV1 + bv[bj][0], v1 = acc[ai][bj][m][1] * F8_INV1 + bv[bj][1];
                    *(unsigned*)(rowp + bj * 64) = swiglu4_f8(v0, v1); } }
    }
};
struct EpiMoe2 {
    const float* bdn;
    DI void operator()(const f32x4 (&acc)[2][2][4][2], const Unit& u, int wr, int wc, int fr, int fq) const {
        f32x4 bv[2][2];
#pragma unroll
        for (int bj = 0; bj < 2; ++bj) { const float* b = bdn + u.e * 1024 + u.c0 + bj * HALF + wc * 32 + 8 * fq; bv[bj][0] = *(const f32x4*)b; bv[bj][1] = *(const f32x4*)(b + 4); }
#pragma unroll
        for (int ai = 0; ai < 2; ++ai)
#pragma unroll
            for (int m = 0; m < 4; ++m) { char* rowp = u.c + ((size_t)(ai * HALF + wr * 64 + m * 16 + fr) * u.ldc + wc * 32 + 8 * fq) * 2;
#pragma unroll
                for (int bj = 0; bj < 2; ++bj) *(u32x4*)(rowp + bj * 256) = pack8(acc[ai][bj][m][0] * F8_INV2 + bv[bj][0], acc[ai][bj][m][1] * F8_INV2 + bv[bj][1]); }
    }
};

typedef int i32x8 __attribute__((ext_vector_type(8)));
typedef int i32x4 __attribute__((ext_vector_type(4)));
template <bool F8, bool MIDK = false, bool GATHER = false, class Epi, class Sched>
DI void gemm_phase(LAS unsigned char* lds, const int KB  , const int ldaB, const int ldbB, const Sched& S, const Epi& E, const int wave_) {
    unsigned z_ = 0u; asm volatile("" : "+v"(z_)); const int tid = wave_ * 64 + (int)__builtin_amdgcn_mbcnt_hi(~0u, __builtin_amdgcn_mbcnt_lo(~0u, z_));
    const int wid = __builtin_amdgcn_readfirstlane(tid >> 6), lane = tid & 63, wr = wid >> 2, wc = wid & 3, fr = lane & 15, fq = lane >> 4;
    const int nt = KB / (BK * 2);
    unsigned voffA[2], voffB[2];
#pragma unroll
    for (int i = 0; i < 2; ++i) { int R, C; stage_rc(tid * 16 + i * 8192, R, C); const int Rb = (R & ~31) + perm32(R & 31);
        voffA[i] = (unsigned)(R * ldaB + C * 2); voffB[i] = (unsigned)(Rb * ldbB + C * 2); }
    asm volatile("" : "+v"(voffA[0]), "+v"(voffA[1]), "+v"(voffB[0]), "+v"(voffB[1]));
    const size_t kstep = (size_t)(BK * 2);
    const size_t hstepA = (size_t)HALF * ldaB, hstepB = (size_t)HALF * ldbB;
    const unsigned ldsw = (unsigned)wid * 1024u;
    const int aoff = lds_byte(wr * 64 + fr, fq * 8), boff = lds_byte(wc * 32 + fr, fq * 8);
    unsigned gc0 = 0u, gc1 = 0u, gn0 = 0u, gn1 = 0u, cofs = 0u; int gR0 = 0;
    LAS int* GIL = (LAS int*)(lds + 135168);
    if constexpr (GATHER) { int R, C; stage_rc(tid * 16, R, C); cofs = (unsigned)(C * 2); gR0 = R; asm volatile("" : "+v"(cofs), "+v"(gR0)); }
#define PG8_GI_DMA(u, p) do { if (wid == 0) __builtin_amdgcn_global_load_lds((const unsigned*)((u).gi + 4 * lane), (LAS unsigned*)(GIL + (p) * 256), 16, 0, 0); } while (0)
#define PG8_GI_READ(p, g0, g1) do { const LAS int* q_ = GIL + (p) * 256 + gR0; g0 = (unsigned)q_[0] | ((unsigned)q_[64] << 16); g1 = (unsigned)q_[128] | ((unsigned)q_[192] << 16); } while (0)
#define PG8_STAGE_G(bufoff, gbase, koff, pk) do { const unsigned vo_[2] = {((pk) & 0xffffu) * 1024u + cofs, ((pk) >> 16) * 1024u + cofs}; _Pragma("unroll") for (int _i = 0; _i < 2; ++_i) \
        __builtin_amdgcn_global_load_lds((const unsigned*)((const char*)(gbase) + (koff) + vo_[_i]), (LAS unsigned*)(lds + (bufoff) + ldsw + _i * 8192), 16, 0, 0); } while (0)
#define PG8_SA(b, h) (((b) * 2 + (h)) * HTB)
#define PG8_SB(b, h) ((4 + (b) * 2 + (h)) * HTB)
#define PG8_STAGE(bufoff, gbase, voff) do { _Pragma("unroll") for (int _i = 0; _i < 2; ++_i) \
        __builtin_amdgcn_global_load_lds((const unsigned*)((const char*)(gbase) + (voff)[_i]), (LAS unsigned*)(lds + (bufoff) + ldsw + _i * 8192), 16, 0, 0); } while (0)
#define PG8_LD8(p) __builtin_shufflevector(*(const LAS i32x4*)(p), *(const LAS i32x4*)((p) + 1024), 0, 1, 2, 3, 4, 5, 6, 7)
#define PG8_LDA8(dst, b, h) do { _Pragma("unroll") for (int m = 0; m < 4; ++m) dst[m] = PG8_LD8(lds + PG8_SA(b, h) + aoff + m * 2048); } while (0)
#define PG8_LDB8(dst, b, h) do { _Pragma("unroll") for (int n = 0; n < 2; ++n) dst[n] = PG8_LD8(lds + PG8_SB(b, h) + boff + n * 2048); } while (0)
#define PG8_MMA8(ai, bj, A8, B8) do { __builtin_amdgcn_s_setprio(1); _Pragma("unroll") for (int m = 0; m < 4; ++m) _Pragma("unroll") for (int n = 0; n < 2; ++n) \
        asm volatile("v_mfma_f32_16x16x128_f8f6f4 %0, %1, %2, %0" : "+v"(acc[ai][bj][m][n]) : "v"(B8[n]), "v"(A8[m])); __builtin_amdgcn_s_setprio(0); } while (0)
#define PG8_LDA(dst, b, h) do { _Pragma("unroll") for (int m = 0; m < 4; ++m) _Pragma("unroll") for (int k = 0; k < 2; ++k) dst[m][k] = *(const LAS bf16x8*)(lds + PG8_SA(b, h) + aoff + m * 2048 + k * 1024); } while (0)
#define PG8_LDB(dst, b, h) do { _Pragma("unroll") for (int n = 0; n < 2; ++n) _Pragma("unroll") for (int k = 0; k < 2; ++k) dst[n][k] = *(const LAS bf16x8*)(lds + PG8_SB(b, h) + boff + n * 2048 + k * 1024); } while (0)
#define PG8_CAT(x) __builtin_shufflevector(__builtin_bit_cast(i32x4, (x)[0]), __builtin_bit_cast(i32x4, (x)[1]), 0, 1, 2, 3, 4, 5, 6, 7)
#define PG8_MMA(ai, bj, At, Bt) do { __builtin_amdgcn_s_setprio(1); _Pragma("unroll") for (int m = 0; m < 4; ++m) _Pragma("unroll") for (int n = 0; n < 2; ++n) _Pragma("unroll") for (int k = 0; k < 2; ++k) \
        acc[ai][bj][m][n] = __builtin_amdgcn_mfma_f32_16x16x32_bf16(Bt[n][k], At[m][k], acc[ai][bj][m][n], 0, 0, 0); __builtin_amdgcn_s_setprio(0); } while (0)
#define PG8_WAIT_V(n) asm volatile("s_waitcnt vmcnt(" #n ")" ::: "memory")
#define PG8_WAIT_L(n) asm volatile("s_waitcnt lgkmcnt(" #n ")" ::: "memory")
#define PG8_BAR __builtin_amdgcn_s_barrier()
#define PG8_SCHED __builtin_amdgcn_sched_barrier(0)
    Unit cur, nxt; int ui = 0;
    if (!S.next(0, cur)) return;
    f32x4 acc[2][2][4][2];
#pragma unroll
    for (int a = 0; a < 2; ++a)
#pragma unroll
        for (int b = 0; b < 2; ++b)
#pragma unroll
            for (int m = 0; m < 4; ++m)
#pragma unroll
                for (int n = 0; n < 2; ++n) acc[a][b][m][n] = (f32x4){0.f, 0.f, 0.f, 0.f};
    bf16x8 At[4][2], B0[2][2], B1[2][2]; i32x8 A8[4], B80[2], B81[2];
    const char* cA = cur.a; const char* cB = cur.b;
    if constexpr (GATHER) { PG8_GI_DMA(cur, 0); PG8_WAIT_V(0); PG8_BAR; PG8_GI_READ(0, gc0, gc1); gn0 = gc0; gn1 = gc1; }
    PG8_STAGE(PG8_SB(0, 0), cB, voffB); PG8_STAGE(PG8_SB(0, 1), cB + hstepB, voffB);
    if constexpr (GATHER) { PG8_STAGE_G(PG8_SA(0, 0), cA, (size_t)0, gc0); PG8_STAGE_G(PG8_SA(0, 1), cA, (size_t)0, gc1); }
    else { PG8_STAGE(PG8_SA(0, 0), cA, voffA); PG8_STAGE(PG8_SA(0, 1), cA + hstepA, voffA); }
    if (wr == 1) PG8_BAR;
    PG8_WAIT_V(2); PG8_BAR;
    PG8_STAGE(PG8_SB(1, 0), cB + kstep, voffB);
    if constexpr (GATHER) PG8_STAGE_G(PG8_SA(1, 0), cA, kstep, gc0); else PG8_STAGE(PG8_SA(1, 0), cA + kstep, voffA);
    PG8_STAGE(PG8_SB(1, 1), cB + hstepB + kstep, voffB);
    PG8_WAIT_V(6); PG8_BAR;
    for (;;) {
        const bool has_next = S.next(ui + 1, nxt);
        const char* nA = has_next ? nxt.a : cA; const char* nB = has_next ? nxt.b : cB;
        if constexpr (GATHER) { if (has_next) PG8_GI_DMA(nxt, (ui + 1) & 1); }
#pragma unroll 1
        for (int t = 0; t < nt; t += 2) {
            if constexpr (MIDK) { if (t == 8 || t == 16) { int fr_ = fr, fq_ = fq; asm volatile("" : "+v"(fr_), "+v"(fq_)); E.mid(acc, cur, t >> 4, wr, wc, fr_, fq_); } }
            const bool last = (t == nt - 2);
            const char* a1 = cA + (size_t)(t + 1) * kstep;
            const char* a2 = last ? nA : cA + (size_t)(t + 2) * kstep; const char* b2 = last ? nB : cB + (size_t)(t + 2) * kstep;
            const char* a3 = a2 + kstep; const char* b3 = b2 + kstep;
            if constexpr (F8) {
            size_t gk2 = 0; unsigned g20 = 0u, g21 = 0u;
            if constexpr (GATHER) { if (last) { if (has_next) PG8_GI_READ((ui + 1) & 1, gn0, gn1); else { gn0 = gc0; gn1 = gc1; } } gk2 = last ? (size_t)0 : (size_t)(t + 2) * kstep; g20 = last ? gn0 : gc0; g21 = last ? gn1 : gc1; }
            PG8_LDB8(B80, 0, 0); PG8_LDB8(B81, 0, 1); PG8_SCHED; PG8_LDA8(A8, 0, 0);
            if constexpr (GATHER) PG8_STAGE_G(PG8_SA(1, 1), cur.a, (size_t)(t + 1) * kstep, gc1); else PG8_STAGE(PG8_SA(1, 1), a1 + hstepA, voffA);
            PG8_WAIT_V(8); PG8_WAIT_L(0); PG8_BAR; PG8_MMA8(0, 0, A8, B80); PG8_MMA8(0, 1, A8, B81); PG8_BAR; PG8_SCHED;
            PG8_LDA8(A8, 0, 1); PG8_STAGE(PG8_SB(0, 0), b2, voffB); PG8_STAGE(PG8_SB(0, 1), b2 + hstepB, voffB);
            if constexpr (GATHER) PG8_STAGE_G(PG8_SA(0, 0), cur.a, gk2, g20); else PG8_STAGE(PG8_SA(0, 0), a2, voffA);
            PG8_WAIT_V(8); PG8_WAIT_L(0); PG8_BAR; PG8_MMA8(1, 0, A8, B80); PG8_MMA8(1, 1, A8, B81); PG8_BAR; PG8_SCHED;
            PG8_LDB8(B80, 1, 0); PG8_LDB8(B81, 1, 1); PG8_SCHED; PG8_LDA8(A8, 1, 0);
            if constexpr (GATHER) PG8_STAGE_G(PG8_SA(0, 1), cur.a, gk2, g21); else PG8_STAGE(PG8_SA(0, 1), a2 + hstepA, voffA);
            PG8_WAIT_V(8); PG8_WAIT_L(0); PG8_BAR; PG8_MMA8(0, 0, A8, B80); PG8_MMA8(0, 1, A8, B81); PG8_BAR; PG8_SCHED;
            PG8_LDA8(A8, 1, 1); PG8_STAGE(PG8_SB(1, 0), b3, voffB); PG8_STAGE(PG8_SB(1, 1), b3 + hstepB, voffB);
            if constexpr (GATHER) PG8_STAGE_G(PG8_SA(1, 0), cur.a, gk2 + kstep, g20); else PG8_STAGE(PG8_SA(1, 0), a3, voffA);
            PG8_WAIT_V(8); PG8_WAIT_L(0); PG8_BAR; PG8_MMA8(1, 0, A8, B80); PG8_MMA8(1, 1, A8, B81); PG8_BAR; PG8_SCHED;
            } else {
            PG8_LDB(B0, 0, 0); PG8_LDB(B1, 0, 1); PG8_SCHED; PG8_LDA(At, 0, 0); PG8_STAGE(PG8_SA(1, 1), a1 + hstepA, voffA);
            PG8_WAIT_V(8); PG8_WAIT_L(0); PG8_BAR; PG8_MMA(0, 0, At, B0); PG8_MMA(0, 1, At, B1); PG8_BAR; PG8_SCHED;
            PG8_LDA(At, 0, 1); PG8_STAGE(PG8_SB(0, 0), b2, voffB); PG8_STAGE(PG8_SB(0, 1), b2 + hstepB, voffB); PG8_STAGE(PG8_SA(0, 0), a2, voffA);
            PG8_WAIT_V(8); PG8_WAIT_L(0); PG8_BAR; PG8_MMA(1, 0, At, B0); PG8_MMA(1, 1, At, B1); PG8_BAR; PG8_SCHED;
            PG8_LDB(B0, 1, 0); PG8_LDB(B1, 1, 1); PG8_SCHED; PG8_LDA(At, 1, 0); PG8_STAGE(PG8_SA(0, 1), a2 + hstepA, voffA);
            PG8_WAIT_V(8); PG8_WAIT_L(0); PG8_BAR; PG8_MMA(0, 0, At, B0); PG8_MMA(0, 1, At, B1); PG8_BAR; PG8_SCHED;
            PG8_LDA(At, 1, 1); PG8_STAGE(PG8_SB(1, 0), b3, voffB); PG8_STAGE(PG8_SB(1, 1), b3 + hstepB, voffB); PG8_STAGE(PG8_SA(1, 0), a3, voffA);
            PG8_WAIT_V(8); PG8_WAIT_L(0); PG8_BAR; PG8_MMA(1, 0, At, B0); PG8_MMA(1, 1, At, B1); PG8_BAR; PG8_SCHED;
            }
        }
        if (wr == 0) PG8_BAR;
        if constexpr (F8) asm volatile("s_nop 15\n\ts_nop 15" ::: "memory");
        { int fr_ = fr, fq_ = fq; asm volatile("" : "+v"(fr_), "+v"(fq_));
          E(acc, cur, wr, wc, fr_, fq_); }
        if (!has_next) break;
#pragma unroll
        for (int a = 0; a < 2; ++a)
#pragma unroll
            for (int b = 0; b < 2; ++b)
#pragma unroll
                for (int m = 0; m < 4; ++m)
#pragma unroll
                    for (int n = 0; n < 2; ++n) acc[a][b][m][n] = (f32x4){0.f, 0.f, 0.f, 0.f};
        cur = nxt; cA = nA; cB = nB; ++ui;
        if constexpr (GATHER) { gc0 = gn0; gc1 = gn1; }
        if (wr == 1) PG8_BAR;
    }
    PG8_WAIT_V(0);
    PG8_BAR;
#undef PG8_SA
#undef PG8_SB
#undef PG8_STAGE
#undef PG8_STAGE_G
#undef PG8_GI_DMA
#undef PG8_GI_READ
#undef PG8_LDA
#undef PG8_LDB
#undef PG8_MMA
#undef PG8_CAT
#undef PG8_LD8
#undef PG8_LDA8
#undef PG8_LDB8
#undef PG8_MMA8
#undef PG8_WAIT_V
#undef PG8_WAIT_L
#undef PG8_BAR
#undef PG8_SCHED
}
}

#define XB_TMO      128
#define XB_XCNT(j)  (256  + 64 * (j))
#define XB_XSUB(j)  (1280 + 64 * (j))
#define XB_XGEN(j)  (2304 + 64 * (j))
#define XB_TOP      3328
#define XB_TOPGEN   3392
#define XCD_BAR_WORDS 3456
#define XB_SPIN_CAP (1u << 22)
DI unsigned xb_ld(unsigned* p)              { return __hip_atomic_load(p, __ATOMIC_RELAXED, __HIP_MEMORY_SCOPE_AGENT); }
DI unsigned xb_add(unsigned* p, unsigned v) { return __hip_atomic_fetch_add(p, v, __ATOMIC_RELAXED, __HIP_MEMORY_SCOPE_AGENT); }
DI unsigned xb_xcc_id() { return (unsigned)__builtin_amdgcn_s_getreg((3 << 11) | 20) & 0xFu; }
#define XB_SPIN(cond, bar) do { unsigned _sp = 0; while (cond) { __builtin_amdgcn_s_sleep(1); \
    if ((++_sp & 255u) == 0u) { if (xb_ld(&(bar)[XB_TMO])) break; if (_sp > XB_SPIN_CAP) { atomicAdd(&(bar)[XB_TMO], 1u); break; } } } } while (0)
struct XcdBarrier { unsigned* bar; unsigned x; volatile LAS unsigned* st; };
DI XcdBarrier xcd_barrier_post(unsigned* bar, volatile LAS unsigned* st) {
    XcdBarrier b; b.bar = bar; b.x = xb_xcc_id(); b.st = st;
    if (threadIdx.x == 0) (void)xb_add(&bar[XB_XCNT(b.x)], 1u);
    return b;
}
DI void xcd_barrier_complete(unsigned* bar, unsigned x, unsigned& nloc, unsigned& nx) {
    const unsigned G = gridDim.x * gridDim.y * gridDim.z;
    unsigned sum, cnt, mine, sp = 0u;
    for (;;) {
        sum = 0u; cnt = 0u; mine = 0u;
#pragma unroll
        for (unsigned j = 0; j < 16; ++j) { const unsigned c = xb_ld(&bar[XB_XCNT(j)]); sum += c; cnt += (c > 0u) ? 1u : 0u; mine = (j == x) ? c : mine; }
        if (sum == G) break;
        __builtin_amdgcn_s_sleep(1);
        if ((++sp & 255u) == 0u) { if (xb_ld(&bar[XB_TMO])) break; if (sp > XB_SPIN_CAP) { atomicAdd(&bar[XB_TMO], 1u); break; } }
    }
    nloc = mine > 0u ? mine : 1u; nx = cnt > 0u ? cnt : 1u;
}
DI void xcd_barrier(const XcdBarrier& b) {
    asm volatile("s_waitcnt vmcnt(0)" ::: "memory");
    __syncthreads();
    if (threadIdx.x == 0) {
        unsigned* bar = b.bar;
        __builtin_amdgcn_s_waitcnt(0);
        unsigned nloc = b.st[0], nx = b.st[1];
        if (nloc == 0u) { xcd_barrier_complete(bar, b.x, nloc, nx); b.st[0] = nloc; b.st[1] = nx; }
        const unsigned old = xb_add(&bar[XB_XSUB(b.x)], 1u);
        const unsigned gen = old / nloc;
        if (old + 1u == (gen + 1u) * nloc) {
            __builtin_amdgcn_fence(__ATOMIC_RELEASE, "agent");
            asm volatile("s_waitcnt vmcnt(0)" ::: "memory");
            const unsigned og = xb_add(&bar[XB_TOP], 1u);
            const unsigned tg = og / nx;
            if (og + 1u == (tg + 1u) * nx) xb_add(&bar[XB_TOPGEN], 1u);
            else XB_SPIN(xb_ld(&bar[XB_TOPGEN]) == tg, bar);
            __builtin_amdgcn_fence(__ATOMIC_ACQUIRE, "agent");
            xb_add(&bar[XB_XGEN(b.x)], 1u);
            asm volatile("s_waitcnt vmcnt(0)" ::: "memory");
        } else {
            XB_SPIN(xb_ld(&bar[XB_XGEN(b.x)]) == gen, bar);
            __builtin_amdgcn_fence(__ATOMIC_ACQUIRE, "agent");
            asm volatile("s_waitcnt vmcnt(0)" ::: "memory");
        }
    }
    __syncthreads();
}

DI void transpose_item(const float* W, int ldw, bf16* WT, int ldt, LAS float* scr, int lane) {
    { const int kr = lane >> 3, c4 = (lane & 7) * 4; f32x4 v[8];
#pragma unroll
        for (int i = 0; i < 8; ++i) v[i] = *(const f32x4*)(W + (size_t)(8 * i + kr) * ldw + c4);
#pragma unroll
        for (int i = 0; i < 8; ++i) { LAS float* o = scr + (8 * i + kr) * 33 + c4; o[0] = v[i].x; o[1] = v[i].y; o[2] = v[i].z; o[3] = v[i].w; } }
    LDS_WAIT(); asm volatile("" ::: "memory");
    const int c = lane & 7;
#pragma unroll
    for (int j = 0; j < 4; ++j) { const int n = (lane >> 3) + 8 * j; const LAS float* s = scr + (8 * c) * 33 + n;
        u32x4 o; o.x = pk2(s[0 * 33], s[1 * 33]); o.y = pk2(s[2 * 33], s[3 * 33]); o.z = pk2(s[4 * 33], s[5 * 33]); o.w = pk2(s[6 * 33], s[7 * 33]);
        *(u32x4*)(WT + (size_t)n * ldt + 8 * c) = o; }
    LDS_WAIT(); asm volatile("" ::: "memory");
}
DI void transpose_item_f8(const float* W, int ldw, unsigned char* WT, int ldt, float scale, LAS float* scr, int lane) {
    { const int kr = lane >> 3, c4 = (lane & 7) * 4; f32x4 v[8];
#pragma unroll
        for (int i = 0; i < 8; ++i) v[i] = *(const f32x4*)(W + (size_t)(8 * i + kr) * ldw + c4);
#pragma unroll
        for (int i = 0; i < 8; ++i) { LAS float* o = scr + (8 * i + kr) * 33 + c4; o[0] = v[i].x; o[1] = v[i].y; o[2] = v[i].z; o[3] = v[i].w; } }
    LDS_WAIT(); asm volatile("" ::: "memory");
    const int c = lane & 3;
#pragma unroll
    for (int j = 0; j < 2; ++j) { const int n = (lane >> 2) + 16 * j; const LAS float* s = scr + (16 * c) * 33 + n;
        u32x4 o; o.x = pk4_f8(s[0 * 33] * scale, s[1 * 33] * scale, s[2 * 33] * scale, s[3 * 33] * scale); o.y = pk4_f8(s[4 * 33] * scale, s[5 * 33] * scale, s[6 * 33] * scale, s[7 * 33] * scale);
        o.z = pk4_f8(s[8 * 33] * scale, s[9 * 33] * scale, s[10 * 33] * scale, s[11 * 33] * scale); o.w = pk4_f8(s[12 * 33] * scale, s[13 * 33] * scale, s[14 * 33] * scale, s[15 * 33] * scale);
        *(u32x4*)(WT + (size_t)n * ldt + 16 * c) = o; }
    LDS_WAIT(); asm volatile("" ::: "memory");
}
DI void ti_load(const float* W, int ldw, int lane, f32x4 (&v)[8]) {
    const int kr = lane >> 3, c4 = (lane & 7) * 4;
#pragma unroll
    for (int i = 0; i < 8; ++i) v[i] = *(const f32x4*)(W + (size_t)(8 * i + kr) * ldw + c4);
}
DI void ti_store_f8(const f32x4 (&v)[8], unsigned char* WT, int ldt, float scale, LAS float* scr, int lane) {
    { const int kr = lane >> 3, c4 = (lane & 7) * 4;
#pragma unroll
        for (int i = 0; i < 8; ++i) { LAS float* o = scr + (8 * i + kr) * 33 + c4; o[0] = v[i].x; o[1] = v[i].y; o[2] = v[i].z; o[3] = v[i].w; } }
    LDS_WAIT(); asm volatile("" ::: "memory");
    const int c = lane & 3;
#pragma unroll
    for (int j = 0; j < 2; ++j) { const int n = (lane >> 2) + 16 * j; const LAS float* s = scr + (16 * c) * 33 + n;
        u32x4 o; o.x = pk4_f8(s[0 * 33] * scale, s[1 * 33] * scale, s[2 * 33] * scale, s[3 * 33] * scale); o.y = pk4_f8(s[4 * 33] * scale, s[5 * 33] * scale, s[6 * 33] * scale, s[7 * 33] * scale);
        o.z = pk4_f8(s[8 * 33] * scale, s[9 * 33] * scale, s[10 * 33] * scale, s[11 * 33] * scale); o.w = pk4_f8(s[12 * 33] * scale, s[13 * 33] * scale, s[14 * 33] * scale, s[15 * 33] * scale);
        *(u32x4*)(WT + (size_t)n * ldt + 16 * c) = o; }
    LDS_WAIT(); asm volatile("" ::: "memory");
}
DI void ti_load4(const float* W, int ldw, int lane, f32x4 (&v)[8]) {
    const int a = lane & 15, g = lane >> 4;
#pragma unroll
    for (int b = 0; b < 2; ++b)
#pragma unroll
        for (int j = 0; j < 4; ++j) v[4 * b + j] = *(const f32x4*)(W + (size_t)(4 * a + j) * ldw + 4 * (g + 4 * b));
}
DI void ti_store4_f8(const f32x4 (&v)[8], unsigned char* WT, int ldt, float scale, int lane) {
    const int a = lane & 15, g = lane >> 4;
#pragma unroll
    for (int b = 0; b < 2; ++b)
#pragma unroll
        for (int q = 0; q < 4; ++q)
            *(unsigned*)(WT + (size_t)(4 * (g + 4 * b) + q) * ldt + 4 * a) = pk4_f8(v[4 * b][q] * scale, v[4 * b + 1][q] * scale, v[4 * b + 2][q] * scale, v[4 * b + 3][q] * scale);
}
DI void ln16(f32x4 (&v)[4], const f32x4 (&g)[4], const f32x4 (&b)[4]) {
    float s = 0.f;
#pragma unroll
    for (int j = 0; j < 4; ++j) s += (v[j].x + v[j].y) + (v[j].z + v[j].w);
    const float mean = wave_sum(s) * (1.f / D); float s2 = 0.f;
#pragma unroll
    for (int j = 0; j < 4; ++j) { v[j] = v[j] - mean; s2 += (v[j].x * v[j].x + v[j].y * v[j].y) + (v[j].z * v[j].z + v[j].w * v[j].w); }
    const float rstd = 1.f / sqrtf(wave_sum(s2) * (1.f / D) + LN_EPS);
#pragma unroll
    for (int j = 0; j < 4; ++j) v[j] = v[j] * rstd * g[j] + b[j];
}
DI void gates8(const f32x4 (&y)[4], const LAS float* wgt, float* gif_row, int lane) {
    float p[8];
#pragma unroll
    for (int j = 0; j < 8; ++j) { float s = 0.f;
#pragma unroll
        for (int jj = 0; jj < 4; ++jj) { const f32x4 w = *(const LAS f32x4*)(wgt + j * 1024 + 256 * jj + 4 * lane); s += (y[jj].x * w.x + y[jj].y * w.y) + (y[jj].z * w.z + y[jj].w * w.w); }
        p[j] = wave_sum(s); }
    if (lane == 0) { *(f32x4*)gif_row = (f32x4){p[0], p[1], p[2], p[3]}; *(f32x4*)(gif_row + 4) = (f32x4){p[4], p[5], p[6], p[7]}; }
}
DI void gates8b(const f32x4 (&y)[4], const LAS float* wgt, float* gif_row, int lane) {
    float p[8];
#pragma unroll
    for (int j = 0; j < 8; ++j) { float s = 0.f;
#pragma unroll
        for (int jj = 0; jj < 4; ++jj) { const f32x4 w = *(const LAS f32x4*)(wgt + j * 1024 + (jj >> 1) * 512 + 8 * lane + (jj & 1) * 4); s += (y[jj].x * w.x + y[jj].y * w.y) + (y[jj].z * w.z + y[jj].w * w.w); }
        p[j] = wave_sum(s); }
    if (lane == 0) { *(f32x4*)gif_row = (f32x4){p[0], p[1], p[2], p[3]}; *(f32x4*)(gif_row + 4) = (f32x4){p[4], p[5], p[6], p[7]}; }
}
DI void load_gate_table(LAS float* wgt, const float* win_l, int tid) {
    for (int i = tid; i < 8192; i += NTHR) { const int k = i >> 3, j = i & 7; wgt[j * 1024 + k] = win_l[(size_t)k * DIN + 1536 + j]; }
}
DI f32x4 ld4bf(const char* p) { const u32x2 w = *(const u32x2*)p; return (f32x4){bflo(w.x), bfhi(w.x), bflo(w.y), bfhi(w.y)}; }
DI void st4bf(char* p, const f32x4& v) { u32x2 w; w.x = pk2(v.x, v.y); w.y = pk2(v.z, v.w); *(u32x2*)p = w; }

struct Args { const float* in[N_IN]; float* out; unsigned char* ws; int ph_lo, ph_hi; };
constexpr int NP_LAYER = 12, NPH = 1 + DEPTH * NP_LAYER;
constexpr int XW_SPLIT = 49152;

struct SchedInproj {
    pg8::TileOrder T; int G, c; const char *X, *W; char* U; bool kv; const char *MEMN, *WKV; char* KV;
    DI bool next(int i, pg8::Unit& u) const {
        const long L = (long)i * G + c; int pm, pn;
        if (T.tile(L, pm, pn)) { u.a = X + (size_t)pm * 256 * D * 2; u.b = W + (size_t)pn * 256 * D * 2; u.r0 = pm * 256; u.c0 = pn * 256; u.c = U + ((size_t)u.r0 * NU + u.c0) * 2; u.ldc = NU; u.e = 0; u.sub = 0; return true; }
        if (!kv) return false;
        const long L2 = L - T.nwg; if (L2 < 0 || L2 >= 128) return false;
        const int l = (int)L2 >> 6, t = (int)L2 & 63; pm = t >> 2; pn = t & 3;
        u.a = MEMN + (size_t)pm * 256 * D * 2; u.b = WKV + ((size_t)l * 1024 + pn * 256) * D * 2; u.r0 = pm * 256; u.c0 = pn * 256; u.c = KV + (((size_t)l * MROWS + u.r0) * D + u.c0) * 2; u.ldc = D; u.e = 0; u.sub = 0; return true;
    }
};
struct SchedPlain {
    pg8::TileOrder T; int G, c; const char *A, *B; char* C; int lda, ldb, ldc;
    DI bool next(int i, pg8::Unit& u) const {
        const long L = (long)i * G + c; int pm, pn; if (!T.tile(L, pm, pn)) return false;
        u.a = A + (size_t)pm * 256 * lda * 2; u.b = B + (size_t)pn * 256 * ldb * 2; u.r0 = pm * 256; u.c0 = pn * 256; u.c = C + ((size_t)u.r0 * ldc + u.c0) * 2; u.ldc = ldc; u.e = 0; u.sub = 0; return true;
    }
};
struct SchedMerge {
    pg8::TileOrder T; int G, c; const char *H, *W; char* Y;
    DI bool next(int i, pg8::Unit& u) const {
        const int ti = i / 3, br = i - 3 * ti; const long L = (long)ti * G + c; int pm, pn; if (!T.tile(L, pm, pn)) return false;
        u.a = H + ((size_t)pm * 256 * 1536 + br * 512) * 2; u.b = W + ((size_t)br * 1024 + pn * 256) * 512 * 2; u.r0 = pm * 256; u.c0 = pn * 256; u.c = Y + ((size_t)u.r0 * D + u.c0) * 2; u.ldc = D; u.e = 0; u.sub = br; return true;
    }
};
struct SchedMoe {
    pg8::TileOrder T; int G, c; const char *A, *W; char* C; const LAS int* PB; const int* GI = nullptr; int wrows  , ldc, cdiv, osz;
    DI bool next(int i, pg8::Unit& u) const {
        const long L = (long)i * G + c; int pm, pn; if (!T.tile(L, pm, pn)) return false;
        int e = 0;
#pragma unroll 1
        for (int j = 1; j < NEXP; ++j) e += (PB[j] <= pm) ? 1 : 0;
        u.a = GI ? A : A + (size_t)pm * 256 * 1024; u.gi = GI ? GI + (size_t)e * M + (size_t)(pm - PB[e]) * 256 : nullptr; u.b = W + ((size_t)e * wrows + pn * 256) * 1024; u.r0 = pm * 256; u.c0 = pn * 256; u.c = C + ((size_t)u.r0 * ldc + u.c0 / cdiv) * osz; u.ldc = ldc; u.e = e; u.sub = 0; return true;
    }
};

__global__ void __launch_bounds__(NTHR, 2) fwd_kernel(Args args) {
    extern __shared__ __attribute__((aligned(16))) unsigned char lds_raw[];
#define INP(i) ([&]() -> const float* { int ii_ = (i); asm volatile("" : "+s"(ii_)); return args.in[ii_]; }())
    LAS unsigned char* lds = (LAS unsigned char*)lds_raw;
    volatile LAS unsigned* LCTL = (volatile LAS unsigned*)(lds + LDSCTL_OFF);
    const int tid0 = threadIdx.x, wave = __builtin_amdgcn_readfirstlane(tid0 >> 6);
#define PHASE_TID unsigned z_ = 0u; asm volatile("" : "+v"(z_)); int tid = wave * 64 + (int)__builtin_amdgcn_mbcnt_hi(~0u, __builtin_amdgcn_mbcnt_lo(~0u, z_)); const int lane = tid & 63; (void)lane;
    const int G = gridDim.x, bx = blockIdx.x;
    const int gw = bx * NWAVES + wave, NGW = G * NWAVES;
    unsigned char* ws = args.ws;
    gu32* ctl = (gu32*)(ws + WS_CTL);
    for (int u = tid0; u < (LDS_BYTES - LDSCTL_OFF) / 4; u += NTHR) ((LAS unsigned*)(lds + LDSCTL_OFF))[u] = 0u;
    __syncthreads();
    XcdBarrier bar; bar.bar = (unsigned*)ctl + CW_BAR; bar.x = 0; bar.st = nullptr;
    if (MK_ONE_LAUNCH) bar = xcd_barrier_post((unsigned*)ctl + CW_BAR, LCTL);
    const int lo = args.ph_lo, hi = args.ph_hi;
#ifndef SUBMASK
#define SUBMASK 7
#endif
#ifndef LN2PROBE
#define LN2PROBE 0
#endif
#ifndef SUBDUP
#define SUBDUP 0
#endif
#define NSUB(k) ((((SUBDUP) >> (k)) & 1) ? 2 : 1)
#ifndef DUPMASK
#define DUPMASK 0
#endif
#define NREP(k) ((((DUPMASK) >> (k)) & 1) ? 2 : 1)
#ifndef PHMASK
#define PHMASK 0xFFFF
#endif
#define IN(k) (lo <= (k) && (k) < hi)
#define SEAM(k) do { if (IN(k) && IN((k) + 1)) xcd_barrier(bar); } while (0)

    char* const Xb = (char*)(ws + WS_X);
    char* const Ub = (char*)(ws + WS_R1);
    float* const GIF = (float*)(ws + WS_GIF);
    LAS int* const PB = (LAS int*)(lds + LDSCTL_OFF + 64);
    LAS int* const CNT = (LAS int*)(lds + LDSCTL_OFF + 256);

    _Pragma("unroll 1") for (int rep_ = 0; rep_ < NREP(12); ++rep_) if (((PHMASK>>12)&1) && IN(0)) { PHASE_TID
        LAS float* scr = (LAS float*)(lds + wave * 8448);
        LAS float* wgt = (LAS float*)(lds + 73728);
        load_gate_table(wgt, INP(I_WIN), tid);
        constexpr int IT_IN = 16 * 216, IT_KV = 16 * 32, IT_BR = 8 * 32, IT_O = 16 * 32, IT_L = IT_IN + IT_KV + 3 * IT_BR + IT_O;
        for (int it = gw; it < DEPTH * IT_L; it += NGW) {
            const int l = it / IT_L; int r = it - l * IT_L;
            if (r < IT_IN) { const int kb = r / 216, nb = r % 216, n0 = 32 * nb, sc = ucol_src(n0);
                if (n0 < UC_F8) transpose_item(INP(I_WIN) + ((size_t)l * D + 64 * kb) * DIN + sc, DIN, (bf16*)(ws + WS_WIN) + ((size_t)l * NU + n0) * D + 64 * kb, D, scr, lane);
                else transpose_item_f8(INP(I_WIN) + ((size_t)l * D + 64 * kb) * DIN + sc, DIN, (unsigned char*)(ws + WS_WING8) + ((size_t)l * NF8 + (n0 - UC_F8)) * D + 64 * kb, D, F8_SWGU, scr, lane);
                continue; }
            r -= IT_IN;
            if (r < IT_KV) { const int kb = r / 32, nb = r % 32;
                transpose_item(INP(I_CAWKV) + ((size_t)l * D + 64 * kb) * 1024 + 32 * nb, 1024, (bf16*)(ws + WS_WKV) + ((size_t)l * 1024 + 32 * nb) * D + 64 * kb, D, scr, lane); continue; }
            r -= IT_KV;
            if (r < 3 * IT_BR) { const int br = r / IT_BR, q = r % IT_BR, kb = q / 32, nb = q % 32;
                const float* src = INP(br == 0 ? I_WBRML : (br == 1 ? I_WBRRW : I_WBRCA));
                transpose_item(src + ((size_t)l * 512 + 64 * kb) * 1024 + 32 * nb, 1024, (bf16*)(ws + WS_WBR) + ((size_t)l * 1024 + 32 * nb) * 1536 + br * 512 + 64 * kb, 1536, scr, lane); continue; }
            r -= 3 * IT_BR;
            { const int kb = r / 32, nb = r % 32;
                transpose_item(INP(I_WO) + ((size_t)l * D + 64 * kb) * 1024 + 32 * nb, 1024, (bf16*)(ws + WS_WO) + ((size_t)l * 1024 + 32 * nb) * D + 64 * kb, D, scr, lane); }
        }
        for (int i = bx * NTHR + tid; i < DEPTH * 1536 * 256; i += G * NTHR) {
            const int l = i / (1536 * 256), r = i % (1536 * 256), n = r >> 8, k = r & 255; float v = 0.f;
            if (n < 512) { if (k < 64) v = INP(I_RWWUP)[((size_t)l * 64 + k) * 512 + n]; }
            else if (n < 1024) { if (k >= 64 && k < 128) v = INP(I_RWAUP)[((size_t)l * 64 + (k - 64)) * 512 + (n - 512)]; }
            else { if (k >= 128) v = INP(I_RWGUP)[((size_t)l * 128 + (k - 128)) * 512 + (n - 1024)]; }
            ((bf16*)(ws + WS_WLORA))[i] = (bf16)f2bf(v);
        }
        __syncthreads();
        {
            f32x4 g[4], b[4];
#pragma unroll
            for (int j = 0; j < 4; ++j) { g[j] = *(const f32x4*)(INP(I_LNIN_G) + 256 * j + 4 * lane); b[j] = *(const f32x4*)(INP(I_LNIN_B) + 256 * j + 4 * lane); }
            for (int m = gw; m < M; m += 2 * NGW) {
                f32x4 v[4], v2[4]; const int m2 = m + NGW; const float* xr = INP(I_X) + (size_t)m * D; const float* xr2 = xr + (size_t)NGW * D;
#pragma unroll
                for (int j = 0; j < 4; ++j) { v[j] = *(const f32x4*)(xr + 256 * j + 4 * lane); v2[j] = *(const f32x4*)(xr2 + 256 * j + 4 * lane); }
                ln16(v, g, b); ln16(v2, g, b);
#pragma unroll
                for (int j = 0; j < 4; ++j) { st4bf(Xb + ((size_t)m * D + 256 * j + 4 * lane) * 2, v[j]); *(unsigned*)((char*)(ws + WS_XF8) + (size_t)m * D + 256 * j + 4 * lane) = pk4_f8(v[j].x * F8_SX, v[j].y * F8_SX, v[j].z * F8_SX, v[j].w * F8_SX);
                    st4bf(Xb + ((size_t)m2 * D + 256 * j + 4 * lane) * 2, v2[j]); *(unsigned*)((char*)(ws + WS_XF8) + (size_t)m2 * D + 256 * j + 4 * lane) = pk4_f8(v2[j].x * F8_SX, v2[j].y * F8_SX, v2[j].z * F8_SX, v2[j].w * F8_SX); }
                gates8(v, wgt, GIF + (size_t)m * 8, lane); gates8(v2, wgt, GIF + (size_t)m2 * 8, lane);
            }
#pragma unroll
            for (int j = 0; j < 4; ++j) { g[j] = *(const f32x4*)(INP(I_MEMLN_G) + 256 * j + 4 * lane); b[j] = *(const f32x4*)(INP(I_MEMLN_B) + 256 * j + 4 * lane); }
            for (int m = gw; m < MROWS; m += NGW) {
                f32x4 v[4]; const float* xr = INP(I_MEM) + (size_t)m * D;
#pragma unroll
                for (int j = 0; j < 4; ++j) v[j] = *(const f32x4*)(xr + 256 * j + 4 * lane);
                ln16(v, g, b);
#pragma unroll
                for (int j = 0; j < 4; ++j) st4bf((char*)(ws + WS_MEMN) + ((size_t)m * D + 256 * j + 4 * lane) * 2, v[j]);
            }
        }
        __syncthreads();
    }
    SEAM(0);

#pragma unroll 1
    for (int l = 0; l < DEPTH; ++l) {
        const int pb = 1 + l * NP_LAYER;
        _Pragma("unroll 1") for (int rep_ = 0; rep_ < NREP(0); ++rep_) if (((PHMASK>>0)&1) && IN(pb + 0)) {
            SchedInproj S; S.T.init(M / 256, UC_F8 / 256); S.G = G; S.c = bx; S.X = Xb; S.W = (const char*)(ws + WS_WIN) + (size_t)l * NU * D * 2; S.U = Ub;
            S.kv = (l == 0); S.MEMN = (const char*)(ws + WS_MEMN); S.WKV = (const char*)(ws + WS_WKV); S.KV = (char*)(ws + WS_KV);
            pg8::EpiStore E;
            pg8::gemm_phase<false>(lds, D * 2, D * 2, D * 2, S, E, wave);
            SchedPlain S8; S8.T.init(M / 256, NF8 / 256); S8.G = G; S8.c = bx; S8.A = (const char*)(ws + WS_XF8); S8.B = (const char*)(ws + WS_WING8) + (size_t)l * NF8 * D; S8.C = Ub + UC_F8 * 2;
            S8.lda = 512; S8.ldb = 512; S8.ldc = NU;
            pg8::EpiStoreS E8; E8.s = F8_INV1; E8.gate_b = INP(I_GATEB) + (size_t)l * 3072; E8.gate_c0 = UC_GATE - UC_F8;
            pg8::gemm_phase<true>(lds, D, D, D, S8, E8, wave);
        }
        SEAM(pb + 0);
        _Pragma("unroll 1") for (int rep_ = 0; rep_ < NREP(1); ++rep_) if (((PHMASK>>1)&1) && IN(pb + 1)) { PHASE_TID
            const float* mu = INP(I_RWMU) + (size_t)l * 1792 + 1536;
            char* LIN = (char*)(ws + WS_R2 + R2_LORA_IN);
            for (int it = bx * NTHR + tid; it < M * 32; it += G * NTHR) {
                const int row = it >> 5, c = (it & 31) * 8;
                const u32x4 cw = *(const u32x4*)(Ub + ((size_t)row * NU + UC_RW + 1536 + c) * 2);
                u32x4 pw = (u32x4){0u, 0u, 0u, 0u};
                if ((row & (SEQ - 1)) != 0) pw = *(const u32x4*)(Ub + ((size_t)(row - 1) * NU + UC_RW + 1536 + c) * 2);
                const f32x4 m0 = *(const f32x4*)(mu + c), m1 = *(const f32x4*)(mu + c + 4);
                float x[8] = {bflo(cw.x), bfhi(cw.x), bflo(cw.y), bfhi(cw.y), bflo(cw.z), bfhi(cw.z), bflo(cw.w), bfhi(cw.w)};
                const float p[8] = {bflo(pw.x), bfhi(pw.x), bflo(pw.y), bfhi(pw.y), bflo(pw.z), bfhi(pw.z), bflo(pw.w), bfhi(pw.w)};
                const float mm[8] = {m0.x, m0.y, m0.z, m0.w, m1.x, m1.y, m1.z, m1.w};
#pragma unroll
                for (int i = 0; i < 8; ++i) { float xs = x[i] + (p[i] - x[i]) * mm[i];
                    if (c < 64) xs = 1.f - 2.f * __builtin_amdgcn_rcpf(1.f + __builtin_amdgcn_exp2f(2.8853900817779268f * xs));
                    else if (c >= 128) xs = sigmoidf_(xs);
                    x[i] = xs; }
                u32x4 o; o.x = pk2(x[0], x[1]); o.y = pk2(x[2], x[3]); o.z = pk2(x[4], x[5]); o.w = pk2(x[6], x[7]);
                *(u32x4*)(LIN + ((size_t)row * 256 + c) * 2) = o;
            }
        }
        SEAM(pb + 1);
        _Pragma("unroll 1") for (int rep_ = 0; rep_ < NREP(2); ++rep_) if (((PHMASK>>2)&1) && IN(pb + 2)) {
            SchedPlain S; S.T.init(M / 256, 6); S.G = G; S.c = bx; S.A = (const char*)(ws + WS_R2 + R2_LORA_IN); S.B = (const char*)(ws + WS_WLORA) + (size_t)l * 1536 * 256 * 2; S.C = (char*)(ws + WS_R2 + R2_LORA_OUT);
            S.lda = 256; S.ldb = 256; S.ldc = 1536;
            pg8::EpiStore E;
            pg8::gemm_phase<false>(lds, 512, 512, 512, S, E, wave);
        }
        SEAM(pb + 2);
        _Pragma("unroll 1") for (int rep_ = 0; rep_ < NREP(3); ++rep_) if (((PHMASK>>3)&1) && IN(pb + 3)) { PHASE_TID
            const char* LO = (const char*)(ws + WS_R2 + R2_LORA_OUT);
            char* HC = (char*)(ws + WS_R2 + R2_HCAT);
            const int tid_ph = tid;
            if (rep_ == 0) { u32x4* rz = (u32x4*)(ws + WS_ROWTOK); for (int i = bx * NTHR + tid_ph; i < NEXP * M / 4; i += G * NTHR) rz[i] = (u32x4){0u, 0u, 0u, 0u}; }
#define SUB_TID unsigned zs_ = 0u; asm volatile("" : "+v"(zs_)); int tid = wave * 64 + (int)__builtin_amdgcn_mbcnt_hi(~0u, __builtin_amdgcn_mbcnt_lo(~0u, zs_)); const int lane = tid & 63; (void)lane;
#pragma unroll 1
            for (int job = bx; job < 256; job += G) {
                if (job < 128) { _Pragma("unroll 1") for (int sr_ = 0; sr_ < NSUB(0); ++sr_) if ((SUBMASK>>0)&1) {
                    SUB_TID
                    const int b = job >> 3, h = job & 7;
                    constexpr int TC = 32, PT = 144, P16 = 48, OPP = 320, IMGB = 11776, IMGS = 7168;
                    LAS float* OPS = (LAS float*)lds;
                    LAS float* OUTB = (LAS float*)(lds + 40960);
                    LAS float* BON = (LAS float*)(lds + 49152);
                    LAS unsigned char* IMB = lds + 49664;
                    LAS unsigned char* IMS = lds + 96768;
                    LAS float* VEP = (LAS float*)(lds + 111104);
                    LAS unsigned char* GKB = lds + 135680;
                    LAS float* PARF = (LAS float*)(lds + 147968);
                    const int pt = tid >> 4, cs = tid & 15, pc = cs * 4, hc = h * 64 + pc;
                    const int p1t = (tid >> 3) & 31, c8 = (tid & 7) * 8, hc8 = h * 64 + c8;
                    const int r31 = lane & 31, h2 = lane >> 5;
                    f32x16 Sreg[2];
#pragma unroll
                    for (int i = 0; i < 16; ++i) { Sreg[0][i] = 0.f; Sreg[1][i] = 0.f; }
#pragma unroll 1
                    for (int a = wave; a < 10; a += 8) {
                        const int ii = (a < 3) ? I_RWMU : (a == 3) ? I_RWW0 : (a == 4) ? I_RWA0 : (a == 5) ? I_RWKK : (a == 6) ? I_RWKA : (a == 7) ? I_RWRK : (a == 8) ? I_RWLNG : I_RWLNB;
                        const size_t po = (a < 3) ? ((size_t)l * 1792 + a * 512) : (size_t)l * 512;
                        PARF[a * 64 + lane] = (INP(ii) + po)[h * 64 + lane];
                    }
#define SETPU(j, q_) do { const u32x4 q__ = (q_); Sreg[(j) >> 2][((j) & 3) * 4] = u2f_(q__.x); Sreg[(j) >> 2][((j) & 3) * 4 + 1] = u2f_(q__.y); \
                          Sreg[(j) >> 2][((j) & 3) * 4 + 2] = u2f_(q__.z); Sreg[(j) >> 2][((j) & 3) * 4 + 3] = u2f_(q__.w); } while (0)
#define PUW(j, c) f2u_(Pc[(j) >> 2][((j) & 3) * 4 + (c)])
#define PUWS(j, c) f2u_(Sreg[(j) >> 2][((j) & 3) * 4 + (c)])
#define UNPJ(j, hh) ((f32x4){bflo(PUW(j, 2 * (hh))), bfhi(PUW(j, 2 * (hh))), bflo(PUW(j, 2 * (hh) + 1)), bfhi(PUW(j, 2 * (hh) + 1))})
#define UNPH(q_, hh) ((hh) ? (f32x4){bflo((q_).z), bfhi((q_).z), bflo((q_).w), bfhi((q_).w)} : (f32x4){bflo((q_).x), bfhi((q_).x), bflo((q_).y), bfhi((q_).y)})
                    auto LOADC = [&](int t0) {
                        const int t = t0 + p1t; const size_t row = (size_t)b * SEQ + t; const char* up = Ub + (row * NU + UC_RW + hc8) * 2;
                        SETPU(0, *(const u32x4*)up); SETPU(1, *(const u32x4*)(up + 1024)); SETPU(2, *(const u32x4*)(up + 2048));
                        if (t > 0) { const char* pp = up - (size_t)NU * 2; SETPU(3, *(const u32x4*)pp); SETPU(4, *(const u32x4*)(pp + 1024)); SETPU(5, *(const u32x4*)(pp + 2048)); }
                        else { const u32x4 z4 = (u32x4){0u, 0u, 0u, 0u}; SETPU(3, z4); SETPU(4, z4); SETPU(5, z4); }
                        const char* lp = LO + (row * 1536 + hc8) * 2; SETPU(6, *(const u32x4*)lp); SETPU(7, *(const u32x4*)(lp + 1024));
                    };
                    const int gq = tid - 128, gt = (gq >> 2) & 31, gp = (gq & 3) * 16;
                    auto LOADG = [&](int t0) {
                        const char* gp_ = LO + (((size_t)b * SEQ + t0 + gt) * 1536 + 1024 + h * 64 + gp) * 2;
                        SETPU(0, *(const u32x4*)gp_); SETPU(1, *(const u32x4*)(gp_ + 16));
                    };
                    auto PASS1 = [&](int t1, int par1, bool more) {
                        int hcv = hc8; asm volatile("" : "+v"(hcv));
                        const f32x16 Pc[2] = {Sreg[0], Sreg[1]};
                        if (more) LOADC(t1 + TC);
                        const LAS float* MU = PARF + c8;
                        const LAS float* W0 = PARF + 192 + c8; const LAS float* A0 = PARF + 256 + c8; const LAS float* KKW = PARF + 320 + c8;
                        const LAS float* KAW = PARF + 384 + c8; const LAS float* RKW = PARF + 448 + c8;
                        f32x4 dec[2], av[2], kkv[2], kp[2], xr[2], xv[2]; float ss = 0.f, bsum = 0.f;
#pragma unroll
                        for (int hh = 0; hh < 2; ++hh) {
                            const f32x4 mu_r = *(const LAS f32x4*)(MU + 4 * hh), mu_k = *(const LAS f32x4*)(MU + 64 + 4 * hh), mu_v = *(const LAS f32x4*)(MU + 128 + 4 * hh);
                            const f32x4 w0 = *(const LAS f32x4*)(W0 + 4 * hh), a0 = *(const LAS f32x4*)(A0 + 4 * hh), kkw = *(const LAS f32x4*)(KKW + 4 * hh), kaw = *(const LAS f32x4*)(KAW + 4 * hh), rkw = *(const LAS f32x4*)(RKW + 4 * hh);
                            const f32x4 ur = UNPJ(0, hh), uk = UNPJ(1, hh), uv = UNPJ(2, hh), urp = UNPJ(3, hh), ukp = UNPJ(4, hh), uvp = UNPJ(5, hh), lw = UNPJ(6, hh), la = UNPJ(7, hh);
                            xr[hh] = ur + (urp - ur) * mu_r; const f32x4 xk = uk + (ukp - uk) * mu_k; xv[hh] = uv + (uvp - uv) * mu_v;
#pragma unroll
                            for (int i = 0; i < 4; ++i) {
                                const float y = -(w0[i] + lw[i]);
                                dec[hh][i] = __expf(-0.6065306597126334f * __builtin_amdgcn_rcpf(1.f + __expf(y)));
                                av[hh][i] = sigmoidf_(a0[i] + la[i]);
                                kkv[hh][i] = xk[i] * kkw[i]; ss += kkv[hh][i] * kkv[hh][i];
                                kp[hh][i] = xk[i] * (1.f + (av[hh][i] - 1.f) * kaw[i]);
                                bsum += xr[hh][i] * kp[hh][i] * rkw[i];
                            }
                            __builtin_amdgcn_sched_barrier(0);
                        }
                        ss = red8(ss); bsum = red8(bsum);
                        const float inv = __builtin_amdgcn_rsqf(fmaxf(ss, 1e-24f));
#pragma unroll
                        for (int hh = 0; hh < 2; ++hh) {
                            const f32x4 kk = kkv[hh] * inv, kka = kk * av[hh];
                            LAS float* o = OPS + p1t * OPP + c8 + 4 * hh;
                            *(LAS f32x4*)(o) = dec[hh]; *(LAS f32x4*)(o + 64) = kk; *(LAS f32x4*)(o + 128) = kka; *(LAS f32x4*)(o + 192) = kp[hh]; *(LAS f32x4*)(o + 256) = xr[hh];
                            *(LAS f32x4*)(VEP + par1 * 2048 + p1t * 64 + c8 + 4 * hh) = xv[hh];
                        }
                        if ((tid & 7) == 0) BON[par1 * 32 + p1t] = bsum;
                    };
#define UNP4(w) ((f32x4){bflo((w).x), bfhi((w).x), bflo((w).y), bfhi((w).y)})
#define DOT4(a, b) (((a).x * (b).x + (a).y * (b).y) + ((a).z * (b).z + (a).w * (b).w))
#define PACK8(x, s) __builtin_bit_cast(bf16x8, (u32x4){pk2((x)[8 * (s)], (x)[8 * (s) + 1]), pk2((x)[8 * (s) + 2], (x)[8 * (s) + 3]), pk2((x)[8 * (s) + 4], (x)[8 * (s) + 5]), pk2((x)[8 * (s) + 6], (x)[8 * (s) + 7])})
#define LD2x64(p) __builtin_bit_cast(bf16x8, (u32x4){(*(const LAS u32x2*)(p)).x, (*(const LAS u32x2*)(p)).y, (*(const LAS u32x2*)((p) + 16)).x, (*(const LAS u32x2*)((p) + 16)).y})
                    auto EPIT = [&](int te, int pe, int pte, int pce) {
                        const f32x4 lng = *(const LAS f32x4*)(PARF + 512 + pce), lnb = *(const LAS f32x4*)(PARF + 576 + pce);
                        const u32x2 gkw = *(const LAS u32x2*)(GKB + pe * 4096 + pte * 128 + pce * 2);
                        const f32x4 o4 = *(const LAS f32x4*)(OUTB + pte * 64 + pce), v4 = *(const LAS f32x4*)(VEP + pe * 2048 + pte * 64 + pce), gk = UNP4(gkw);
                        const float mean = red16((o4.x + o4.y) + (o4.z + o4.w)) * (1.f / 64.f);
                        const f32x4 dv = o4 - mean;
                        const float var = red16(DOT4(dv, dv)) * (1.f / 64.f);
                        const float rstd = __builtin_amdgcn_rsqf(var + RW_GN_EPS), bo = BON[pe * 32 + pte];
                        const f32x4 y = (dv * rstd * lng + lnb + v4 * bo) * gk;
                        st4bf(HC + (((size_t)b * SEQ + te + pte) * 1536 + 512 + h * 64 + pce) * 2, y);
                    };
                    auto EPI_A = [&](int te, int pe) { const int et = ((wave >> 2) * 2 + (wave & 1)) * 64 + lane; EPIT(te, pe, et >> 4, (et & 15) * 4); };
                    auto EPI_B = [&](int te, int pe) { const int e2 = (wave >> 2) * 64 + lane;
#pragma unroll 1
                        for (int it = 0; it < 2; ++it) EPIT(te, pe, 16 + 8 * it + (e2 >> 4), (e2 & 15) * 4); };
                    auto EPI = [&](int te, int pe) { const int et = ((wave >> 2) * 2 + (wave & 1)) * 64 + lane;
#pragma unroll 1
                        for (int it = 0; it < 2; ++it) EPIT(te, pe, (et >> 4) + 16 * it, (et & 15) * 4); };
                    auto STAGE1 = [&](int bufn, int m3n) {
                        const int sc = wave >> 2, hq = wave & 1;
                        LAS unsigned char* ib = IMB + (sc * 2 + bufn) * IMGB;
                        LAS unsigned char* KR = ib; LAS unsigned char* BGr = ib + 4608; LAS unsigned char* VT = ib + 9216; LAS float* PL = (LAS float*)(ib + 11520);
                        float P = 1.f;
#pragma unroll
                        for (int t = 0; t < 8; ++t) { const float wv = OPS[(16 * sc + t) * OPP + lane]; P *= (hq == 1) ? wv : 1.f; }
#pragma unroll
                        for (int q = 0; q < 8; ++q) { const int t = 8 * hq + q; const LAS float* o = OPS + (16 * sc + t) * OPP + lane;
                            const float w = o[0], z = o[64], bb = o[128], kp = o[192], rr = o[256], vv = VEP[m3n * 2048 + (16 * sc + t) * 64 + lane];
                            const float kap = z * P; P *= w; const float rho = rr * P, ip = __builtin_amdgcn_rcpf(P), bet = bb * ip, gam = kp * ip;
                            *(LAS bf16*)(KR + t * PT + lane * 2) = (bf16)f2bf(kap); *(LAS bf16*)(KR + (16 + t) * PT + lane * 2) = (bf16)f2bf(rho);
                            *(LAS bf16*)(BGr + t * PT + lane * 2) = (bf16)f2bf(bet); *(LAS bf16*)(BGr + (16 + t) * PT + lane * 2) = (bf16)f2bf(gam);
                            *(LAS bf16*)(VT + t * PT + lane * 2) = (bf16)f2bf(vv); }
                        if (hq == 1) PL[lane] = P;
                    };
                    if (wave >= 4) LOADC(0); else if (wave >= 2) LOADG(0);
                    int rm = 1;
#pragma unroll 1
                    for (int t0 = -2 * TC; t0 < SEQ; t0 += TC) {
                        const int buf = (t0 >> 5) & 1, rm1 = (rm == 2) ? 0 : rm + 1, rm2 = (rm == 0) ? 2 : rm - 1;
                        __syncthreads();
                        {
                            const int sc = wave >> 2, wq = wave & 3;
                            LAS unsigned char* ib = IMB + (sc * 2 + buf) * IMGB; LAS unsigned char* is_ = IMS + sc * IMGS;
                            LAS unsigned char* KR = ib; LAS unsigned char* BGr = ib + 4608;
                            LAS unsigned char* TT = is_; LAS unsigned char* BB = is_ + 1536; LAS float* ZF = (LAS float*)(is_ + 3072);
                            if (wq <= 1) { if (t0 >= 0) {
                                f32x16 Z;
#pragma unroll
                                for (int i = 0; i < 16; ++i) Z[i] = 0.f;
                                bf16x8 zk[4], zb[4];
#pragma unroll
                                for (int ks = 0; ks < 4; ++ks) { zk[ks] = *(const LAS bf16x8*)(KR + r31 * PT + (16 * ks + 8 * h2) * 2); zb[ks] = *(const LAS bf16x8*)(BGr + r31 * PT + (16 * ks + 8 * h2) * 2); }
                                __builtin_amdgcn_sched_barrier(0);
#pragma unroll
                                for (int ks = 0; ks < 4; ++ks) Z = __builtin_amdgcn_mfma_f32_32x32x16_bf16(zk[ks], zb[ks], Z, 0, 0, 0);
                                const int jj = (r31 & 15) - 4 * h2;
#pragma unroll
                                for (int i = 0; i < 16; ++i) { const int tb = (i & 3) + 8 * ((i >> 2) & 1); const bool keep = (i >= 8) ? (jj <= tb) : (jj < tb); Z[i] = keep ? Z[i] : 0.f; }
                              if (wq == 1) {
                                if (r31 >= 16) {
#pragma unroll
                                    for (int i = 0; i < 16; ++i) *(LAS bf16*)(BB + ((i & 3) + 8 * (i >> 2) + 4 * h2) * P16 + (r31 - 16) * 2) = (bf16)f2bf(Z[i]);
                                }
                                if (t0 >= TC) EPI_B(t0 - TC, rm2);
                              } else {
                                if (r31 < 16) {
#pragma unroll
                                    for (int i = 0; i < 16; ++i) ZF[((i & 3) + 8 * (i >> 2) + 4 * h2) * 32 + r31] = Z[i];
                                }
                                LDS_WAIT(); asm volatile("" ::: "memory");
                                const int c = lane & 15, g = lane >> 4; float x[16];
                                f32x4 R[16][4];
                                constexpr int TW = 5;
#pragma unroll
                                for (int t = 1; t <= TW; ++t)
#pragma unroll
                                    for (int k = 0; k < 4; ++k) if (4 * k < t) R[t][k] = *(const LAS f32x4*)(ZF + t * 32 + 4 * k);
                                __builtin_amdgcn_sched_barrier(0);
#pragma unroll
                                for (int t = 0; t < 16; ++t) {
                                    if (t >= 1 && t + TW < 16) {
#pragma unroll
                                        for (int k = 0; k < 4; ++k) if (4 * k < t + TW) R[t + TW][k] = *(const LAS f32x4*)(ZF + (t + TW) * 32 + 4 * k);
                                    }
                                    __builtin_amdgcn_sched_barrier(0);
                                    float s0 = 0.f, s1 = 0.f;
#pragma unroll
                                    for (int j = 0; j < t; ++j) { const float a = R[t][j >> 2][j & 3]; if (j & 1) s1 += a * x[j]; else s0 += a * x[j]; }
                                    x[t] = ((t == c) ? 1.f : 0.f) - (s0 + s1);
                                }
#pragma unroll
                                for (int j = 0; j < 16; ++j) *(LAS bf16*)(TT + j * P16 + c * 2) = (bf16)f2bf(-x[j]);
#pragma unroll
                                for (int qq = 0; qq < 4; qq += 2) {
                                    f32x4 a4[2][4];
#pragma unroll
                                    for (int q = 0; q < 2; ++q)
#pragma unroll
                                        for (int k = 0; k < 4; ++k) a4[q][k] = *(const LAS f32x4*)(ZF + (16 + 4 * g + qq + q) * 32 + 4 * k);
#pragma unroll
                                    for (int q = 0; q < 2; ++q) {
                                        const int tr = 4 * g + qq + q;
                                        float s0 = 0.f, s1 = 0.f;
#pragma unroll
                                        for (int j = 0; j < 16; ++j) { const float a = a4[q][j >> 2][j & 3]; if (j & 1) s1 += a * x[j]; else s0 += a * x[j]; }
                                        *(LAS bf16*)(TT + (16 + tr) * P16 + c * 2) = (bf16)f2bf(-(s0 + s1));
                                    }
                                }
                              }
                            } } else {
                                if (t0 >= TC) EPI_A(t0 - TC, rm2);
                                if (t0 + TC >= 0 && t0 + TC < SEQ) STAGE1(buf ^ 1, rm1);
                            }
                        }
                        __syncthreads();
                        if (wave >= 4) { if (t0 + 2 * TC < SEQ) PASS1(t0 + 2 * TC, rm2, t0 + 3 * TC < SEQ); }
                        else if (wave >= 2) { if (t0 + 2 * TC < SEQ) {
                            LAS unsigned char* gd = GKB + rm2 * 4096 + gt * 128 + gp * 2;
                            *(LAS u32x4*)gd = (u32x4){PUWS(0, 0), PUWS(0, 1), PUWS(0, 2), PUWS(0, 3)}; *(LAS u32x4*)(gd + 16) = (u32x4){PUWS(1, 0), PUWS(1, 1), PUWS(1, 2), PUWS(1, 3)};
                            if (t0 + 3 * TC < SEQ) LOADG(t0 + 3 * TC); } }
                        else if (t0 >= 0) {
#pragma unroll 1
                            for (int sc = 0; sc < 2; ++sc) {
                                const LAS unsigned char* ib = IMB + (sc * 2 + buf) * IMGB; const LAS unsigned char* is_ = IMS + sc * IMGS;
                                const LAS unsigned char* KR = ib; const LAS unsigned char* BGr = ib + 4608; const LAS unsigned char* VT = ib + 9216; const LAS float* PL = (const LAS float*)(ib + 11520);
                                const LAS unsigned char* TT = is_; const LAS unsigned char* BB = is_ + 1536;
                                const bf16x8 vfr = trd8(VT, PT, 8 * h2, 8 * h2 + 4, 32 * wave, lane);
                                const bf16x8 bbf = *(const LAS bf16x8*)(BB + r31 * P16 + 8 * h2 * 2);
                                bf16x8 krf[2][2], betf[2], gamf[2]; f32x4 pl[2][4];
#pragma unroll
                                for (int kb = 0; kb < 2; ++kb)
#pragma unroll
                                    for (int s = 0; s < 2; ++s) krf[kb][s] = LD2x64(KR + r31 * PT + (32 * kb + 16 * s + 4 * h2) * 2);
                                const bf16x8 ttf = LD2x64(TT + r31 * P16 + (4 * h2) * 2);
#pragma unroll
                                for (int kb = 0; kb < 2; ++kb) { betf[kb] = trd8(BGr, PT, 4 * h2, 8 + 4 * h2, 32 * kb, lane);
                                    gamf[kb] = trd8(BGr, PT, 16 + 8 * h2, 20 + 8 * h2, 32 * kb, lane); }
                                __builtin_amdgcn_sched_barrier(0);
                                f32x16 t1;
#pragma unroll
                                for (int i = 0; i < 16; ++i) t1[i] = 0.f;
                                t1 = __builtin_amdgcn_mfma_f32_32x32x16_bf16(bbf, vfr, t1, 0, 0, 0);
#pragma unroll
                                for (int kb = 0; kb < 2; ++kb)
#pragma unroll
                                    for (int s = 0; s < 2; ++s) t1 = __builtin_amdgcn_mfma_f32_32x32x16_bf16(krf[kb][s], PACK8(Sreg[kb], s), t1, 0, 0, 0);
                                f32x16 ag[2];
#pragma unroll
                                for (int kb = 0; kb < 2; ++kb) ag[kb] = __builtin_amdgcn_mfma_f32_32x32x16_bf16(gamf[kb], vfr, Sreg[kb], 0, 0, 0);
                                f32x16 t2;
#pragma unroll
                                for (int i = 0; i < 16; ++i) t2[i] = 0.f;
                                t2 = __builtin_amdgcn_mfma_f32_32x32x16_bf16(ttf, PACK8(t1, 0), t2, 0, 0, 0);
#pragma unroll
                                for (int i = 8; i < 16; ++i) OUTB[(16 * sc + (i & 3) + 8 * ((i >> 2) - 2) + 4 * h2) * 64 + 32 * wave + r31] = t2[i] + t1[i];
#pragma unroll
                                for (int kb = 0; kb < 2; ++kb)
#pragma unroll
                                    for (int g4 = 0; g4 < 4; ++g4) pl[kb][g4] = *(const LAS f32x4*)(PL + 32 * kb + 8 * g4 + 4 * h2);
                                const bf16x8 uq = PACK8(t2, 0);
#pragma unroll
                                for (int kb = 0; kb < 2; ++kb) {
                                    f32x16 a = __builtin_amdgcn_mfma_f32_32x32x16_bf16(betf[kb], uq, ag[kb], 0, 0, 0);
#pragma unroll
                                    for (int g4 = 0; g4 < 4; ++g4) { const f32x4 p4 = pl[kb][g4];
                                        a[4 * g4] *= p4.x; a[4 * g4 + 1] *= p4.y; a[4 * g4 + 2] *= p4.z; a[4 * g4 + 3] *= p4.w; }
                                    Sreg[kb] = a;
                                }
                            }
                        }
                        rm = rm1;
                    }
                    __syncthreads();
                    if ((wave & 3) >= 2) EPI(SEQ - TC, (SEQ / TC - 1) % 3);
                    __syncthreads();
#undef UNPH
#undef UNPJ
#undef PUW
#undef PUWS
#undef SETPU
#undef PACK8
#undef LD2x64
                } } else {
                    const int idx = job - 128, bh = idx >> 1, half = idx & 1, b = bh >> 2, h = bh & 3;
                    unsigned zl_ = 0u; asm volatile("" : "+v"(zl_)); const int lane_ml = (int)__builtin_amdgcn_mbcnt_hi(~0u, __builtin_amdgcn_mbcnt_lo(~0u, zl_));
                    _Pragma("unroll 1") for (int sr_ = 0; sr_ < NSUB(1); ++sr_) if (((SUBMASK>>1)&1) && idx < 64) {
                        SUB_TID
                        const int bm = idx >> 2, hm = idx & 3;
                        constexpr int PT = 144;
                        LAS unsigned char* QI = lds;
                        LAS unsigned char* KI = QI + 64 * PT;
                        constexpr int PV = 272;
                        LAS unsigned char* KW = KI + 64 * PT;
                        LAS unsigned char* VT = KW + 64 * PT;
                        LAS unsigned char* CI = VT + 64 * PV;
                        LAS float* AS = (LAS float*)(CI + 128 * PT);
                        LAS float* MX = AS + 64; LAS float* SI = AS + 128; LAS float* EM = AS + 192; LAS float* WG = AS + 256; LAS float* NN = AS + 320; LAS float* CR = AS + 384; LAS float* ST = AS + 448;
                        for (int i = tid; i < 128 * PT / 4; i += NTHR) ((LAS unsigned*)CI)[i] = 0u;
                        if (tid < 64) NN[tid] = 0.f;
                        LAS float* CWL = (LAS float*)(lds + 100352);
                        if (tid < 128) { const int colw = (tid < 64) ? (hm * 64 + tid) : (256 + hm * 64 + (tid - 64));
#pragma unroll
                            for (int j = 0; j < 4; ++j) CWL[j * 128 + tid] = INP(I_CONVW)[((size_t)l * 4 + j) * 512 + colw];
                            CWL[512 + tid] = INP(I_CONVB)[l * 512 + colw];
                            CWL[640 + tid] = INP(I_MLNORMG)[l * 512 + hm * 128 + tid]; }
                        const int pt = tid >> 4, cg = tid & 15;
                        const int ccol = (cg < 8) ? (hm * 64 + 8 * cg) : (256 + hm * 64 + 8 * (cg - 8));
                        const float qsc = (cg < 8) ? 0.125f : 1.f;
                        const float igb = INP(I_IGB)[l * 4 + hm], fgb = INP(I_FGB)[l * 4 + hm];
                        const int r31 = lane & 31, h2 = lane >> 5, vb = wave >> 1, tb = wave & 1;
                        f32x16 accC;
#pragma unroll
                        for (int i = 0; i < 16; ++i) accC[i] = 0.f;
                        float nreg = 0.f, mprev = 0.f;
                        u32x4 cu[2][4], vu[2]; float gi = 0.f, gf = 0.f;
                        auto LOADM = [&](int t0) {
#pragma unroll
                            for (int tt = 0; tt < 2; ++tt) { const int t = t0 + pt + 32 * tt; const size_t row = (size_t)bm * SEQ + t;
#pragma unroll
                                for (int j = 0; j < 4; ++j) { if (t - 3 + j >= 0) cu[tt][j] = *(const u32x4*)(Ub + ((row - 3 + j) * NU + UC_QK + ccol) * 2); else cu[tt][j] = (u32x4){0u, 0u, 0u, 0u}; }
                                const int p = tid + 512 * tt; vu[tt] = *(const u32x4*)(Ub + (((size_t)bm * SEQ + t0 + (p >> 4)) * NU + UC_V + hm * 128 + 8 * (p & 15)) * 2); }
                            if (wave == 7) { const size_t rg = (size_t)bm * SEQ + t0 + lane; gi = GIF[rg * 8 + hm]; gf = GIF[rg * 8 + 4 + hm]; }
                        };
                        auto GATES = [&](int gso) {
                            const float ig = gi + igb, fp = gf + fgb;
                            const float lf = -(fmaxf(-fp, 0.f) + __logf(1.f + __expf(-fabsf(fp))));
                            const float bc = scan_add64(lf);
                            const float as = ig - bc, pm = scan_max64(as);
                            const float mxv = fmaxf(mprev, pm), mx63 = __builtin_bit_cast(float, __builtin_amdgcn_readlane(__builtin_bit_cast(int, mxv), 63)), bl = __builtin_bit_cast(float, __builtin_amdgcn_readlane(__builtin_bit_cast(int, bc), 63));
                            AS[gso + lane] = as; MX[gso + lane] = mxv; SI[gso + lane] = __expf(mprev - mxv); EM[gso + lane] = __expf(-(bc + mxv)); WG[gso + lane] = __expf(as - mx63);
                            if (lane == 0) CR[gso] = __expf(mprev - mx63);
                            mprev = bl + mx63;
                        };
                        LOADM(0);
                        if (wave == 7) GATES(0);
                        __syncthreads();
#pragma unroll 1
                        for (int t0 = 0; t0 < SEQ; t0 += 64) {
                            int cgv = cg * 8; asm volatile("" : "+v"(cgv));
                            float cw[4][8], cb[8];
#pragma unroll
                        for (int j = 0; j < 4; ++j) { const f32x4 a = *(const LAS f32x4*)(CWL + j * 128 + cgv), c2 = *(const LAS f32x4*)(CWL + j * 128 + cgv + 4);
                            cw[j][0] = a.x; cw[j][1] = a.y; cw[j][2] = a.z; cw[j][3] = a.w; cw[j][4] = c2.x; cw[j][5] = c2.y; cw[j][6] = c2.z; cw[j][7] = c2.w; }
                        { const f32x4 a = *(const LAS f32x4*)(CWL + 512 + cgv), c2 = *(const LAS f32x4*)(CWL + 512 + cgv + 4);
                            cb[0] = a.x; cb[1] = a.y; cb[2] = a.z; cb[3] = a.w; cb[4] = c2.x; cb[5] = c2.y; cb[6] = c2.z; cb[7] = c2.w; }
                            float yq[2][8];
#pragma unroll
                            for (int tt = 0; tt < 2; ++tt) {
#pragma unroll
                                for (int i = 0; i < 8; ++i) yq[tt][i] = cb[i];
#pragma unroll
                                for (int j = 0; j < 4; ++j) { const u32x4 w = cu[tt][j]; const float x[8] = {bflo(w.x), bfhi(w.x), bflo(w.y), bfhi(w.y), bflo(w.z), bfhi(w.z), bflo(w.w), bfhi(w.w)};
#pragma unroll
                                    for (int i = 0; i < 8; ++i) yq[tt][i] += cw[j][i] * x[i]; }
#pragma unroll
                                for (int i = 0; i < 8; ++i) yq[tt][i] = yq[tt][i] * sigmoidf_(yq[tt][i]) * qsc;
                            }
                            const u32x4 vreg0 = vu[0], vreg1 = vu[1];
                            const int go = ((t0 >> 6) & 1) * 1024;
                            if (t0 + 64 < SEQ) LOADM(t0 + 64);
                            __syncthreads();
#pragma unroll
                            for (int tt = 0; tt < 2; ++tt) { const int tok = pt + 32 * tt;
                                u32x4 pw; pw.x = pk2(yq[tt][0], yq[tt][1]); pw.y = pk2(yq[tt][2], yq[tt][3]); pw.z = pk2(yq[tt][4], yq[tt][5]); pw.w = pk2(yq[tt][6], yq[tt][7]);
                                if (cg < 8) *(LAS u32x4*)(QI + tok * PT + cg * 16) = pw;
                                else { *(LAS u32x4*)(KI + tok * PT + (cg - 8) * 16) = pw; const float wgs = WG[go + tok];
                                    u32x4 kw; kw.x = pk2(yq[tt][0] * wgs, yq[tt][1] * wgs); kw.y = pk2(yq[tt][2] * wgs, yq[tt][3] * wgs); kw.z = pk2(yq[tt][4] * wgs, yq[tt][5] * wgs); kw.w = pk2(yq[tt][6] * wgs, yq[tt][7] * wgs);
                                    *(LAS u32x4*)(KW + tok * PT + (cg - 8) * 16) = kw; }
                                const u32x4 vw = tt ? vreg1 : vreg0; const int p = tid + 512 * tt, vtok = p >> 4, v8 = p & 15;
                                *(LAS u32x4*)(VT + vtok * PV + v8 * 16) = vw;
                            }
                            __syncthreads();
                            float hv[16];
                            u32x2 ogw[4];
                            { const size_t rowg = (size_t)bm * SEQ + t0 + 32 * tb + r31; const char* ogp = Ub + (rowg * NU + UC_OG + hm * 128 + 32 * vb) * 2;
#pragma unroll
                                for (int g4 = 0; g4 < 4; ++g4) ogw[g4] = *(const u32x2*)(ogp + (8 * g4 + 4 * h2) * 2); }
                            {
                                constexpr float L2E = 1.4426950408889634f;
                                const int t = 32 * tb + r31;
                                bf16x8 qf[4];
#pragma unroll
                                for (int ks = 0; ks < 4; ++ks) qf[ks] = *(const LAS bf16x8*)(QI + t * PT + (16 * ks + 8 * h2) * 2);
                                const float mx = MX[go + t], si = SI[go + t], em = EM[go + t];
                                f32x16 O, I; float denI = 0.f;
#pragma unroll
                                for (int i = 0; i < 16; ++i) { O[i] = 0.f; I[i] = 0.f; }
#pragma unroll
                                for (int sb = 0; sb < 2; ++sb) if (sb <= tb) {
                                    f32x16 X;
#pragma unroll
                                    for (int i = 0; i < 16; ++i) X[i] = 0.f;
                                    bf16x8 kf[4];
#pragma unroll
                                    for (int ks = 0; ks < 4; ++ks) kf[ks] = *(const LAS bf16x8*)(KI + (32 * sb + r31) * PT + (16 * ks + 8 * h2) * 2);
                                    __builtin_amdgcn_sched_barrier(0);
#pragma unroll
                                    for (int ks = 0; ks < 4; ++ks) X = __builtin_amdgcn_mfma_f32_32x32x16_bf16(kf[ks], qf[ks], X, 0, 0, 0);
#pragma unroll
                                    for (int g4 = 0; g4 < 4; ++g4) { const f32x4 a4 = *(const LAS f32x4*)(AS + go + 32 * sb + 8 * g4 + 4 * h2);
#pragma unroll
                                        for (int j = 0; j < 4; ++j) { const int s = 32 * sb + 8 * g4 + 4 * h2 + j; const float w = (s <= t) ? __builtin_amdgcn_exp2f((a4[j] - mx) * L2E) * X[4 * g4 + j] : 0.f; X[4 * g4 + j] = w; denI += w; } }
#pragma unroll
                                    for (int st = 0; st < 2; ++st) {
                                        u32x4 pw; pw.x = pk2(X[8 * st], X[8 * st + 1]); pw.y = pk2(X[8 * st + 2], X[8 * st + 3]); pw.z = pk2(X[8 * st + 4], X[8 * st + 5]); pw.w = pk2(X[8 * st + 6], X[8 * st + 7]);
                                        O = __builtin_amdgcn_mfma_f32_32x32x16_bf16(trd8(VT, PV, 32 * sb + 16 * st + 4 * h2, 32 * sb + 16 * st + 8 + 4 * h2, 32 * vb, lane), __builtin_bit_cast(bf16x8, pw), O, 0, 0, 0);
                                    }
                                }
                                float nq = 0.f;
#pragma unroll
                                for (int ks = 0; ks < 4; ++ks) { const bf16x8 cf = *(const LAS bf16x8*)(CI + (32 * vb + r31) * PT + (16 * ks + 8 * h2) * 2); I = __builtin_amdgcn_mfma_f32_32x32x16_bf16(cf, qf[ks], I, 0, 0, 0);
                                    const f32x4 n0 = *(const LAS f32x4*)(NN + 16 * ks + 8 * h2), n1 = *(const LAS f32x4*)(NN + 16 * ks + 8 * h2 + 4); const u32x4 qw = __builtin_bit_cast(u32x4, qf[ks]);
                                    nq += (bflo(qw.x) * n0.x + bfhi(qw.x) * n0.y) + (bflo(qw.y) * n0.z + bfhi(qw.y) * n0.w) + (bflo(qw.z) * n1.x + bfhi(qw.z) * n1.y) + (bflo(qw.w) * n1.z + bfhi(qw.w) * n1.w); }
                                nq += __shfl_xor(nq, 32); denI += __shfl_xor(denI, 32);
                                const float den = si * nq + denI, rdn = 1.f / fmaxf(fabsf(den), em);
                                float hsum = 0.f;
#pragma unroll
                                for (int i = 0; i < 16; ++i) { hv[i] = (O[i] + si * I[i]) * rdn; hsum += hv[i]; }
                                hsum += __shfl_xor(hsum, 32);
                                const float hmean = hsum * (1.f / 32.f); float hm2 = 0.f;
#pragma unroll
                                for (int i = 0; i < 16; ++i) { const float dlt = hv[i] - hmean; hm2 += dlt * dlt; }
                                hm2 += __shfl_xor(hm2, 32);
                                if (h2 == 0) *(LAS f32x2*)(ST + ((tb * 4 + vb) * 32 + r31) * 2) = (f32x2){hmean, hm2};
                                const float carry = CR[go];
#pragma unroll
                                for (int i = 0; i < 16; ++i) accC[i] *= carry;
#pragma unroll
                                for (int st = 0; st < 4; ++st) { const bf16x8 va = trd8(VT, PV, 16 * st + 8 * h2, 16 * st + 8 * h2 + 4, 32 * vb, lane), kw = trd8(KW, PT, 16 * st + 8 * h2, 16 * st + 8 * h2 + 4, 32 * tb, lane);
                                    accC = __builtin_amdgcn_mfma_f32_32x32x16_bf16(va, kw, accC, 0, 0, 0); }
                            }
                            __syncthreads();
                            {
                                const int t = 32 * tb + r31;
                                f32x2 s4[4];
#pragma unroll
                                for (int q = 0; q < 4; ++q) s4[q] = *(const LAS f32x2*)(ST + ((tb * 4 + q) * 32 + r31) * 2);
                                const float mt = (s4[0].x + s4[1].x + s4[2].x + s4[3].x) * 0.25f;
                                float m2 = 0.f;
#pragma unroll
                                for (int q = 0; q < 4; ++q) { const float dm = s4[q].x - mt; m2 += s4[q].y + 32.f * dm * dm; }
                                const float rstd = __builtin_amdgcn_rsqf(m2 * (1.f / 128.f) + LN_EPS);
                                const size_t row = (size_t)bm * SEQ + t0 + t;
                                char* op = HC + (row * 1536 + hm * 128 + 32 * vb) * 2;
                                const LAS float* ngp = CWL + 640 + 32 * vb;
#pragma unroll
                                for (int g4 = 0; g4 < 4; ++g4) { const int vo = 8 * g4 + 4 * h2; const f32x4 og = UNP4(ogw[g4]), ng = *(const LAS f32x4*)(ngp + vo);
                                    f32x4 y; y.x = sigmoidf_(og.x) * ((hv[4 * g4] - mt) * rstd * ng.x); y.y = sigmoidf_(og.y) * ((hv[4 * g4 + 1] - mt) * rstd * ng.y); y.z = sigmoidf_(og.z) * ((hv[4 * g4 + 2] - mt) * rstd * ng.z); y.w = sigmoidf_(og.w) * ((hv[4 * g4 + 3] - mt) * rstd * ng.w);
                                    st4bf(op + vo * 2, y); }
                            }
#pragma unroll
                            for (int i = 0; i < 16; ++i) { const int v = 32 * vb + (i & 3) + 8 * (i >> 2) + 4 * h2; *(LAS bf16*)(CI + v * PT + (32 * tb + r31) * 2) = (bf16)f2bf(accC[i]); }
                            if (wave < 2) { float s = 0.f;
#pragma unroll
                                for (int q8 = 0; q8 < 8; ++q8) { const u32x2 w = trd4(KW, PT, 32 * h2 + 4 * q8, 32 * wave, lane); s += (bflo(w.x) + bfhi(w.x)) + (bflo(w.y) + bfhi(w.y)); }
                                s += __shfl_xor(s, 32);
                                nreg = CR[go] * nreg + s; if (h2 == 0) NN[32 * wave + r31] = nreg; }
                            if (wave == 7 && t0 + 64 < SEQ) GATES(go ^ 1024);
                            __syncthreads();
                        }
                    }
                }
            }
            if (rep_ == 0) {
                LAS unsigned* XB = (LAS unsigned*)(lds + 153088);
                unsigned* xc = (unsigned*)ctl + CW_FILL + 32 + l * 64;
                __syncthreads();
                if (tid_ph == 0) XB[0] = __hip_atomic_fetch_add(xc, 1u, RLX_AGENT);
                __syncthreads();
                int xi = __builtin_amdgcn_readfirstlane((int)XB[0]);
#pragma unroll 1
                while (xi < 128) {
                    const int idx = xi, bh = idx >> 1, half = idx & 1, b = bh >> 2, h = bh & 3;
                    _Pragma("unroll 1") for (int sr_ = 0; sr_ < NSUB(2); ++sr_) if ((SUBMASK>>2)&1) {
                        SUB_TID
                        constexpr int KST = 272, VST = 520;
                        LAS unsigned char* KI = lds; LAS unsigned char* VI = lds + 256 * KST;
                        const char* kvb = (const char*)(ws + WS_KV) + (((size_t)l * MROWS + (size_t)b * MEML) * D) * 2;
                        for (int p = tid; p < 4096; p += NTHR) { const int key = p >> 4, c16 = p & 15;
                            *(LAS u32x4*)(KI + key * KST + c16 * 16) = *(const u32x4*)(kvb + ((size_t)key * D + h * 128 + c16 * 8) * 2); }
                        for (int p = tid; p < 4096; p += NTHR) { const int key = p & 255, d8 = p >> 8;
                            const u32x4 w = *(const u32x4*)(kvb + ((size_t)key * D + 512 + h * 128 + d8 * 8) * 2);
                            LAS unsigned char* o = VI + (d8 * 8) * VST + key * 2;
                            *(LAS bf16*)(o) = (bf16)(w.x & 0xffff); *(LAS bf16*)(o + VST) = (bf16)(w.x >> 16); *(LAS bf16*)(o + 2 * VST) = (bf16)(w.y & 0xffff); *(LAS bf16*)(o + 3 * VST) = (bf16)(w.y >> 16);
                            *(LAS bf16*)(o + 4 * VST) = (bf16)(w.z & 0xffff); *(LAS bf16*)(o + 5 * VST) = (bf16)(w.z >> 16); *(LAS bf16*)(o + 6 * VST) = (bf16)(w.w & 0xffff); *(LAS bf16*)(o + 7 * VST) = (bf16)(w.w >> 16); }
                        __syncthreads();
                        const int r31 = lane & 31, h2 = lane >> 5;
                        constexpr float SC = 0.08838834764831845f * 1.4426950408889634f;
#pragma unroll 1
                        for (int rd = 0; rd < 8; ++rd) {
                            const size_t qrow = (size_t)b * SEQ + half * 2048 + rd * 256 + wave * 32 + r31;
                            bf16x8 qf[8];
#pragma unroll
                            for (int ks = 0; ks < 8; ++ks) qf[ks] = *(const bf16x8*)(Ub + (qrow * NU + UC_CAQ + h * 128 + 16 * ks + 8 * h2) * 2);
                            f32x16 O[4];
#pragma unroll
                            for (int db = 0; db < 4; ++db)
#pragma unroll
                                for (int i = 0; i < 16; ++i) O[db][i] = 0.f;
                            float mrun = -1e30f, lrun = 0.f;
#pragma unroll 1
                            for (int hf = 0; hf < 2; ++hf) {
                                f32x16 X[4];
#pragma unroll
                                for (int kb = 0; kb < 4; ++kb) {
                                    bf16x8 kf[8];
#pragma unroll
                                    for (int ks = 0; ks < 8; ++ks) kf[ks] = *(const LAS bf16x8*)(KI + (hf * 128 + kb * 32 + r31) * KST + (16 * ks + 8 * h2) * 2);
                                    __builtin_amdgcn_sched_barrier(0);
#pragma unroll
                                    for (int i = 0; i < 16; ++i) X[kb][i] = 0.f;
#pragma unroll
                                    for (int ks = 0; ks < 8; ++ks) X[kb] = __builtin_amdgcn_mfma_f32_32x32x16_bf16(kf[ks], qf[ks], X[kb], 0, 0, 0);
                                    __builtin_amdgcn_sched_barrier(0);
                                }
                                float mx = -1e30f;
#pragma unroll
                                for (int kb = 0; kb < 4; ++kb)
#pragma unroll
                                    for (int i = 0; i < 16; ++i) mx = fmaxf(mx, X[kb][i]);
                                mx = fmaxf(mx, __shfl_xor(mx, 32));
                                const float mnew = fmaxf(mrun, mx), alpha = __builtin_amdgcn_exp2f((mrun - mnew) * SC);
                                float ls = 0.f;
#pragma unroll
                                for (int kb = 0; kb < 4; ++kb)
#pragma unroll
                                    for (int i = 0; i < 16; ++i) { const float p = __builtin_amdgcn_exp2f((X[kb][i] - mnew) * SC); X[kb][i] = p; ls += p; }
                                ls += __shfl_xor(ls, 32);
                                lrun = lrun * alpha + ls; mrun = mnew;
#pragma unroll
                                for (int db = 0; db < 4; ++db)
#pragma unroll
                                    for (int i = 0; i < 16; ++i) O[db][i] *= alpha;
#pragma unroll
                                for (int kb = 0; kb < 4; ++kb) {
                                    bf16x8 vf[2][4], pf[2];
#pragma unroll
                                    for (int s = 0; s < 2; ++s) {
                                        u32x4 pw; pw.x = pk2(X[kb][8 * s], X[kb][8 * s + 1]); pw.y = pk2(X[kb][8 * s + 2], X[kb][8 * s + 3]); pw.z = pk2(X[kb][8 * s + 4], X[kb][8 * s + 5]); pw.w = pk2(X[kb][8 * s + 6], X[kb][8 * s + 7]);
                                        pf[s] = __builtin_bit_cast(bf16x8, pw);
#pragma unroll
                                        for (int db = 0; db < 4; ++db) {
                                            const LAS unsigned char* vp = VI + (db * 32 + r31) * VST + (hf * 128 + kb * 32 + 16 * s + 4 * h2) * 2;
                                            const u32x2 lo = *(const LAS u32x2*)vp, hi = *(const LAS u32x2*)(vp + 16);
                                            vf[s][db] = __builtin_bit_cast(bf16x8, (u32x4){lo.x, lo.y, hi.x, hi.y});
                                        }
                                    }
                                    __builtin_amdgcn_sched_barrier(0);
#pragma unroll
                                    for (int s = 0; s < 2; ++s)
#pragma unroll
                                        for (int db = 0; db < 4; ++db) O[db] = __builtin_amdgcn_mfma_f32_32x32x16_bf16(vf[s][db], pf[s], O[db], 0, 0, 0);
                                    __builtin_amdgcn_sched_barrier(0);
                                }
                            }
                            const float rl = 1.f / lrun;
                            char* op = HC + (qrow * 1536 + 1024 + h * 128) * 2;
#pragma unroll
                            for (int db = 0; db < 4; ++db)
#pragma unroll
                                for (int g4 = 0; g4 < 4; ++g4) { u32x2 w; w.x = pk2(O[db][4 * g4] * rl, O[db][4 * g4 + 1] * rl); w.y = pk2(O[db][4 * g4 + 2] * rl, O[db][4 * g4 + 3] * rl);
                                    *(u32x2*)(op + (db * 32 + 8 * g4 + 4 * h2) * 2) = w; }
                        }
                        __syncthreads();
                    }
                    if (tid_ph == 0) XB[0] = __hip_atomic_fetch_add(xc, 1u, RLX_AGENT);
                    __syncthreads();
                    xi = __builtin_amdgcn_readfirstlane((int)XB[0]);
                    __syncthreads();
                }
            }
            if (rep_ == 0) {
                unsigned zf_ = 0u; asm volatile("" : "+v"(zf_)); const int lane_f = (int)__builtin_amdgcn_mbcnt_hi(~0u, __builtin_amdgcn_mbcnt_lo(~0u, zf_));
                LAS float* scr = (LAS float*)(lds + wave * 8448);
                LAS unsigned* FB = (LAS unsigned*)(lds + 8 * 8448);
                unsigned* fc = (unsigned*)ctl + CW_FILL + l * 64;
                constexpr int IT_GU = 32 * 16 * 64, IT_ALL = 49152, CH = 32;
                const bool lead = (wave == 0) && (lane_f == 0);
                __syncthreads();
                if (lead) FB[0] = __hip_atomic_fetch_add(fc, (unsigned)CH, RLX_AGENT);
                __syncthreads();
                int fbase = __builtin_amdgcn_readfirstlane((int)FB[0]), slot = 1;
#pragma unroll 1
                while (fbase < IT_ALL) {
                    unsigned nb = 0u;
                    if (lead) nb = __hip_atomic_fetch_add(fc, (unsigned)CH, RLX_AGENT);
                    {
                        struct FItem { const float* W; unsigned char* WT; int ldw; float sc; };
                        auto FI = [&](int it) -> FItem { FItem r;
                            if (it < IT_GU) { const int e = it >> 10, q = it & 1023, kb = q >> 6, nb_ = q & 63;
                                r.W = INP(I_WGU) + (((size_t)l * 32 + e) * D + 64 * kb) * 2048 + 32 * nb_; r.ldw = 2048; r.WT = (unsigned char*)(ws + WS_WGU) + ((size_t)e * 2048 + 32 * nb_) * D + 64 * kb; r.sc = F8_SWGU; }
                            else { const int r2 = it - IT_GU, e = r2 >> 9, q = r2 & 511, kb = q >> 5, nb_ = q & 31;
                                r.W = INP(I_WDN) + (((size_t)l * 32 + e) * D + 64 * kb) * 1024 + 32 * nb_; r.ldw = 1024; r.WT = (unsigned char*)(ws + WS_WDN) + ((size_t)e * 1024 + 32 * nb_) * D + 64 * kb; r.sc = F8_SWDN; }
                            return r; };
                        f32x4 va[8], vb[8];
                        FItem c0 = FI(fbase + wave), c1;
                        ti_load4(c0.W, c0.ldw, lane_f, va);
#pragma unroll 1
                        for (int kq = 0; kq < CH / NWAVES; kq += 2) {
                            c1 = FI(fbase + wave + (kq + 1) * NWAVES); ti_load4(c1.W, c1.ldw, lane_f, vb);
                            ti_store4_f8(va, c0.WT, D, c0.sc, lane_f);
                            if (kq + 2 < CH / NWAVES) { c0 = FI(fbase + wave + (kq + 2) * NWAVES); ti_load4(c0.W, c0.ldw, lane_f, va); }
                            ti_store4_f8(vb, c1.WT, D, c1.sc, lane_f);
                        }
                    }
                    if (lead) FB[slot] = nb;
                    __syncthreads();
                    fbase = __builtin_amdgcn_readfirstlane((int)FB[slot]); slot ^= 1;
                }
            }
#undef UNP4
#undef DOT4
#undef SUB_TID
        }
        SEAM(pb + 3);
        _Pragma("unroll 1") for (int rep_ = 0; rep_ < NREP(5); ++rep_) if (((PHMASK>>5)&1) && IN(pb + 5)) {
            SchedPlain S; S.T.init(M / 256, 4); S.G = G; S.c = bx; S.A = (const char*)(ws + WS_R2 + R2_HCAT); S.B = (const char*)(ws + WS_WBR) + (size_t)l * 1024 * 1536 * 2; S.C = (char*)(ws + WS_R2 + R2_YPRE);
            S.lda = 1536; S.ldb = 1536; S.ldc = D;
            pg8::EpiMerge E; E.U = Ub; E.gate_b = INP(I_GATEB) + (size_t)l * 3072;
            pg8::gemm_phase<false, true>(lds, 1536 * 2, 1536 * 2, 1536 * 2, S, E, wave);
        }
        SEAM(pb + 5);
        _Pragma("unroll 1") for (int rep_ = 0; rep_ < NREP(6); ++rep_) if (((PHMASK>>6)&1) && IN(pb + 6)) {
            SchedPlain S; S.T.init(M / 256, 4); S.G = G; S.c = bx; S.A = (const char*)(ws + WS_R2 + R2_YPRE); S.B = (const char*)(ws + WS_WO) + (size_t)l * D * D * 2; S.C = (char*)(ws + WS_R2 + R2_Z);
            S.lda = D; S.ldb = D; S.ldc = D;
            pg8::EpiWo E; E.X = Xb;
            pg8::gemm_phase<false>(lds, D * 2, D * 2, D * 2, S, E, wave);
        }
        SEAM(pb + 6);
        _Pragma("unroll 1") for (int rep_ = 0; rep_ < NREP(7); ++rep_) if (((PHMASK>>7)&1) && IN(pb + 7)) { PHASE_TID
            constexpr int WP = 2064;
            LAS unsigned char* WRb = lds;
            LAS float* RB = (LAS float*)(lds + 66048);
            LAS unsigned char* XS = lds + 66560 + wave * 4608;
            for (int i = tid; i < 32768; i += NTHR) { const int k = i >> 5, e = i & 31; *(LAS bf16*)(WRb + e * WP + k * 2) = (bf16)f2bf(INP(I_RTW)[((size_t)l * D + k) * 32 + e]); }
            if (tid < 32) RB[tid] = INP(I_RTB)[l * 32 + tid];
            const char* Zb = (const char*)(ws + WS_R2 + R2_Z);
            int* TKE = (int*)(ws + WS_TKE); float* TKG = (float*)(ws + WS_TKG); int* TKP = (int*)(ws + WS_TKP); int* ROWTOK = (int*)(ws + WS_ROWTOK);
            LAS unsigned* LCNT = (LAS unsigned*)(lds + 131072);
            LAS unsigned* GBASE = LCNT + 32; LAS unsigned* LLEN = LCNT + 64; LAS unsigned* LIST = LCNT + 128;
            if (tid < 65) LCNT[tid] = 0u;
            {
                f32x4 g[4], bb[4];
#pragma unroll
                for (int j = 0; j < 4; ++j) { g[j] = *(const f32x4*)(INP(I_LN1G) + l * D + 256 * j + 4 * lane); bb[j] = *(const f32x4*)(INP(I_LN1B) + l * D + 256 * j + 4 * lane); }
#pragma unroll 1
                for (int pq = gw; pq < M / 2; pq += 2 * NGW) {
                    f32x4 y0[4], y1[4], y2[4], y3[4]; const int pp = pq, p2 = pq + NGW;
#pragma unroll
                    for (int j = 0; j < 4; ++j) { y0[j] = ld4bf(Zb + ((size_t)(2 * pp) * D + 256 * j + 4 * lane) * 2);
                        y1[j] = ld4bf(Zb + ((size_t)(2 * pp + 1) * D + 256 * j + 4 * lane) * 2);
                        y2[j] = ld4bf(Zb + ((size_t)(2 * p2) * D + 256 * j + 4 * lane) * 2); y3[j] = ld4bf(Zb + ((size_t)(2 * p2 + 1) * D + 256 * j + 4 * lane) * 2); }
                    ln16(y0, g, bb); ln16(y1, g, bb); ln16(y2, g, bb); ln16(y3, g, bb);
#pragma unroll
                    for (int j = 0; j < 4; ++j) { st4bf(Xb + ((size_t)(2 * pp) * D + 256 * j + 4 * lane) * 2, y0[j]); st4bf(Xb + ((size_t)(2 * pp + 1) * D + 256 * j + 4 * lane) * 2, y1[j]);
                        st4bf(Xb + ((size_t)(2 * p2) * D + 256 * j + 4 * lane) * 2, y2[j]); st4bf(Xb + ((size_t)(2 * p2 + 1) * D + 256 * j + 4 * lane) * 2, y3[j]);
                        *(unsigned*)((char*)(ws + WS_XF8) + (size_t)(2 * pp) * D + 256 * j + 4 * lane) = pk4_f8(y0[j].x * F8_SX, y0[j].y * F8_SX, y0[j].z * F8_SX, y0[j].w * F8_SX);
                        *(unsigned*)((char*)(ws + WS_XF8) + (size_t)(2 * pp + 1) * D + 256 * j + 4 * lane) = pk4_f8(y1[j].x * F8_SX, y1[j].y * F8_SX, y1[j].z * F8_SX, y1[j].w * F8_SX);
                        *(unsigned*)((char*)(ws + WS_XF8) + (size_t)(2 * p2) * D + 256 * j + 4 * lane) = pk4_f8(y2[j].x * F8_SX, y2[j].y * F8_SX, y2[j].z * F8_SX, y2[j].w * F8_SX);
                        *(unsigned*)((char*)(ws + WS_XF8) + (size_t)(2 * p2 + 1) * D + 256 * j + 4 * lane) = pk4_f8(y3[j].x * F8_SX, y3[j].y * F8_SX, y3[j].z * F8_SX, y3[j].w * F8_SX); }
                }
            }
            asm volatile("s_waitcnt vmcnt(0)" ::: "memory");
            __syncthreads();
            __builtin_amdgcn_fence(__ATOMIC_ACQUIRE, "agent");
            asm volatile("s_waitcnt vmcnt(0)" ::: "memory");
            if (rep_ == 0) {
                const int r31 = lane & 31, h2 = lane >> 5;
                const int mytok = 16 * (bx + (2 * wave + (r31 >> 4)) * G) + (r31 & 15);
                const char* sp[4];
#pragma unroll
                for (int q = 0; q < 4; ++q) { const int row = (lane >> 3) + 8 * q; const int tk = 16 * (bx + (2 * wave + (row >> 4)) * G) + (row & 15); sp[q] = Xb + ((size_t)tk * D + 8 * (lane & 7)) * 2; }
                f32x16 C;
#pragma unroll
                for (int i = 0; i < 16; ++i) C[i] = 0.f;
                u32x4 xr[4];
#pragma unroll
                for (int q = 0; q < 4; ++q) xr[q] = *(const u32x4*)(sp[q]);
#pragma unroll 1
                for (int sl = 0; sl < 16; ++sl) {
#pragma unroll
                    for (int q = 0; q < 4; ++q) *(LAS u32x4*)(XS + ((lane >> 3) + 8 * q) * 144 + (lane & 7) * 16) = xr[q];
                    if (sl + 1 < 16) {
#pragma unroll
                        for (int q = 0; q < 4; ++q) xr[q] = *(const u32x4*)(sp[q] + (sl + 1) * 128); }
#pragma unroll
                    for (int k2 = 0; k2 < 4; ++k2) C = __builtin_amdgcn_mfma_f32_32x32x16_bf16(*(const LAS bf16x8*)(WRb + r31 * WP + (64 * sl + 16 * k2 + 8 * h2) * 2), *(const LAS bf16x8*)(XS + r31 * 144 + (16 * k2 + 8 * h2) * 2), C, 0, 0, 0);
                }
                float v[16];
#pragma unroll
                for (int g4 = 0; g4 < 4; ++g4) { const f32x4 b4 = *(const LAS f32x4*)(RB + 8 * g4 + 4 * h2); v[4 * g4] = C[4 * g4] + b4.x; v[4 * g4 + 1] = C[4 * g4 + 1] + b4.y; v[4 * g4 + 2] = C[4 * g4 + 2] + b4.z; v[4 * g4 + 3] = C[4 * g4 + 3] + b4.w; }
                float lv[4]; int li_[4];
#pragma unroll
                for (int k = 0; k < 4; ++k) { float best = -3.0e38f; int bi = 0;
#pragma unroll
                    for (int i = 0; i < 16; ++i) { const int e = (i & 3) + 8 * (i >> 2) + 4 * h2; if (v[i] > best) { best = v[i]; bi = e; } }
#pragma unroll
                    for (int i = 0; i < 16; ++i) { const int e = (i & 3) + 8 * (i >> 2) + 4 * h2; v[i] = (e == bi) ? -3.0e38f : v[i]; }
                    lv[k] = best; li_[k] = bi; }
                float cv[8]; int ci[8];
#pragma unroll
                for (int k = 0; k < 4; ++k) { cv[k] = lv[k]; ci[k] = li_[k]; cv[4 + k] = __shfl_xor(lv[k], 32); ci[4 + k] = __shfl_xor(li_[k], 32); }
                float tv[4]; int te[4];
#pragma unroll
                for (int k = 0; k < 4; ++k) { float best = -3.0e38f; int bi = 64;
#pragma unroll
                    for (int i = 0; i < 8; ++i) { if (cv[i] > best || (cv[i] == best && ci[i] < bi)) { best = cv[i]; bi = ci[i]; } }
#pragma unroll
                    for (int i = 0; i < 8; ++i) cv[i] = (ci[i] == bi) ? -3.0e38f : cv[i];
                    tv[k] = best; te[k] = bi; }
                const float e1 = __expf(tv[1] - tv[0]), e2 = __expf(tv[2] - tv[0]), e3 = __expf(tv[3] - tv[0]), rs = 1.f / (1.f + e1 + e2 + e3);
                const float gt[4] = {rs, e1 * rs, e2 * rs, e3 * rs};
                if (h2 == 0) {
#pragma unroll
                    for (int k = 0; k < 4; ++k) {
                        const unsigned lpos = __hip_atomic_fetch_add(LCNT + te[k], 1u, __ATOMIC_RELAXED, __HIP_MEMORY_SCOPE_WORKGROUP);
                        const unsigned li = __hip_atomic_fetch_add(LLEN, 1u, __ATOMIC_RELAXED, __HIP_MEMORY_SCOPE_WORKGROUP);
                        LIST[2 * li] = (unsigned)(mytok * 4 + k); LIST[2 * li + 1] = (unsigned)te[k] | (lpos << 8);
                        TKE[mytok * 4 + k] = te[k]; TKG[mytok * 4 + k] = gt[k]; }
                }
            }
            __syncthreads();
            if (tid < 32 && rep_ == 0) GBASE[tid] = __hip_atomic_fetch_add((unsigned*)ctl + CW_CNT + (l * 32 + tid) * 64, LCNT[tid], RLX_AGENT);
            __syncthreads();
            if (rep_ == 0) { const unsigned n = LLEN[0];
                for (unsigned i = tid; i < n; i += NTHR) { const unsigned tk = LIST[2 * i], ev = LIST[2 * i + 1], e = ev & 255u, pos = GBASE[e] + (ev >> 8);
                    TKP[tk] = (int)pos; ROWTOK[(size_t)e * M + pos] = (int)(tk >> 2); } }
            __syncthreads();
        }
        SEAM(pb + 7);
        if (IN(pb + 9) || IN(pb + 10)) { PHASE_TID
            if (tid < 32) CNT[tid] = (int)__hip_atomic_load((unsigned*)ctl + CW_CNT + (l * 32 + tid) * 64, RLX_AGENT);
            __syncthreads();
            if (tid == 0) { int a = 0; for (int e = 0; e < 32; ++e) { PB[e] = a; a += (CNT[e] + 255) >> 8; } PB[32] = a; }
            __syncthreads();
        }
        _Pragma("unroll 1") for (int rep_ = 0; rep_ < NREP(9); ++rep_) if (((PHMASK>>9)&1) && IN(pb + 9)) {
            SchedMoe S; S.T.init(PB[32], 8); S.G = G; S.c = bx; S.A = (const char*)(ws + WS_XF8); S.GI = (const int*)(ws + WS_ROWTOK); S.W = (const char*)(ws + WS_WGU); S.C = (char*)(ws + WS_R2 + R2_HMID); S.PB = PB; S.wrows = 2048; S.ldc = 1024; S.cdiv = 2; S.osz = 1;
            pg8::EpiMoe1 E; E.bgu = INP(I_BGU) + (size_t)l * 32 * 2048;
            pg8::gemm_phase<true, false, true>(lds, D, D, D, S, E, wave);
        }
        SEAM(pb + 9);
        _Pragma("unroll 1") for (int rep_ = 0; rep_ < NREP(10); ++rep_) if (((PHMASK>>10)&1) && IN(pb + 10)) {
            SchedMoe S; S.T.init(PB[32], 4); S.G = G; S.c = bx; S.A = (const char*)(ws + WS_R2 + R2_HMID); S.W = (const char*)(ws + WS_WDN); S.C = (char*)(ws + WS_R1); S.PB = PB; S.wrows = 1024; S.ldc = 1024; S.cdiv = 1; S.osz = 2;
            pg8::EpiMoe2 E; E.bdn = INP(I_BDN) + (size_t)l * 32 * 1024;
            pg8::gemm_phase<true>(lds, D, D, D, S, E, wave);
        }
        SEAM(pb + 10);
        _Pragma("unroll 1") for (int rep_ = 0; rep_ < NREP(11); ++rep_) if (((PHMASK>>11)&1) && IN(pb + 11)) { PHASE_TID
            if (tid < 32) CNT[tid] = (int)__hip_atomic_load((unsigned*)ctl + CW_CNT + (l * 32 + tid) * 64, RLX_AGENT);
            LAS float* wgt = (LAS float*)(lds + 73728);
            const bool lastl = (l == DEPTH - 1);
            if (!lastl) load_gate_table(wgt, INP(I_WIN) + (size_t)(l + 1) * D * DIN, tid);
            __syncthreads();
            if (tid == 0) { int a = 0; for (int e = 0; e < 32; ++e) { PB[e] = a; a += (CNT[e] + 255) >> 8; } PB[32] = a; }
            __syncthreads();
            const int e0 = 8 * lane;
            f32x4 g[4], bb[4];
#pragma unroll
            for (int j = 0; j < 4; ++j) { const int o = (j >> 1) * 512 + e0 + (j & 1) * 4; g[j] = *(const f32x4*)(INP(I_LN2G) + l * D + o); bb[j] = *(const f32x4*)(INP(I_LN2B) + l * D + o); }
            const char* YA = (const char*)(ws + WS_R1);
            const bool dummy_ = (rep_ + 1 < NREP(11)); char* const Xo = dummy_ ? (char*)(ws + WS_R2) : Xb; float* const Fo = dummy_ ? (float*)(ws + WS_R2 + 256 * MiB) : args.out; float* const Go = dummy_ ? (float*)(ws + WS_R2 + 200 * MiB) : GIF;
            const int* TKE = (const int*)(ws + WS_TKE); const float* TKG = (const float*)(ws + WS_TKG); const int* TKP = (const int*)(ws + WS_TKP);
#pragma unroll 1
            for (int mb = gw * 16; mb < M; mb += NGW * 16) {
                const int ev = TKE[mb * 4 + lane], pv = TKP[mb * 4 + lane]; const float gv = TKG[mb * 4 + lane];
                const int rowv = PB[ev] * 256 + pv;
#pragma unroll 1
                for (int ti = 0; ti < 16; ti += 2) {
                    u32x4 xw[2][2], yw[2][4][2]; float gk[2][4];
#pragma unroll
                    for (int q = 0; q < 2; ++q) { const size_t m = (size_t)mb + ti + q;
                        xw[q][0] = *(const u32x4*)(Xb + (m * D + e0) * 2); xw[q][1] = *(const u32x4*)(Xb + (m * D + 512 + e0) * 2);
#pragma unroll
                        for (int k = 0; k < 4; ++k) { const size_t row = (size_t)__builtin_amdgcn_readlane(rowv, 4 * (ti + q) + k);
                            gk[q][k] = __builtin_bit_cast(float, __builtin_amdgcn_readlane(__builtin_bit_cast(int, gv), 4 * (ti + q) + k));
                            yw[q][k][0] = *(const u32x4*)(YA + (row * D + e0) * 2); yw[q][k][1] = *(const u32x4*)(YA + (row * D + 512 + e0) * 2); } }
#pragma unroll
                    for (int q = 0; q < 2; ++q) { const size_t m = (size_t)mb + ti + q;
                        f32x4 v[4];
#pragma unroll
                        for (int hh = 0; hh < 2; ++hh) { const u32x4 w = xw[q][hh];
                            v[2 * hh] = (f32x4){bflo(w.x), bfhi(w.x), bflo(w.y), bfhi(w.y)} * DN_ALPHA; v[2 * hh + 1] = (f32x4){bflo(w.z), bfhi(w.z), bflo(w.w), bfhi(w.w)} * DN_ALPHA; }
#pragma unroll
                        for (int k = 0; k < 4; ++k)
#pragma unroll
                            for (int hh = 0; hh < 2; ++hh) { const u32x4 w = yw[q][k][hh];
                                v[2 * hh] = v[2 * hh] + (f32x4){bflo(w.x), bfhi(w.x), bflo(w.y), bfhi(w.y)} * gk[q][k]; v[2 * hh + 1] = v[2 * hh + 1] + (f32x4){bflo(w.z), bfhi(w.z), bflo(w.w), bfhi(w.w)} * gk[q][k]; }
                        ln16(v, g, bb);
                        if (lastl) {
#pragma unroll
                            for (int j = 0; j < 4; ++j) *(f32x4*)(Fo + m * D + (j >> 1) * 512 + e0 + (j & 1) * 4) = v[j];
                        } else {
#pragma unroll
                            for (int hh = 0; hh < 2; ++hh) { *(u32x4*)(Xo + (m * D + hh * 512 + e0) * 2) = pg8::pack8(v[2 * hh], v[2 * hh + 1]);
                                u32x2 f8w; f8w.x = pk4_f8(v[2 * hh].x * F8_SX, v[2 * hh].y * F8_SX, v[2 * hh].z * F8_SX, v[2 * hh].w * F8_SX); f8w.y = pk4_f8(v[2 * hh + 1].x * F8_SX, v[2 * hh + 1].y * F8_SX, v[2 * hh + 1].z * F8_SX, v[2 * hh + 1].w * F8_SX);
                                if (!dummy_) *(u32x2*)((char*)(ws + WS_XF8) + m * D + hh * 512 + e0) = f8w; }
                            gates8b(v, wgt, Go + m * 8, lane);
                        }
                    }
                }
            }
            __syncthreads();
        }
        SEAM(pb + 11);
    }
#undef IN
#undef SEAM
}

extern "C" void kernel_launch(void* const* d_in, const int* in_sizes, int n_in, void* d_out, int out_size, void* d_ws, size_t ws_size, hipStream_t stream) {
    static int grid = 0;
    if (grid == 0) {
        if (n_in != N_IN || out_size != M * D || ws_size < WS_END) { fprintf(stderr, "kernel_launch: unexpected shapes (n_in %d, out %d, ws %zu)\n", n_in, out_size, ws_size); grid = -1; return; }
        int dev = 0, cus = 0, per_cu = 0;
        if (hipGetDevice(&dev) != hipSuccess || hipDeviceGetAttribute(&cus, hipDeviceAttributeMultiprocessorCount, dev) != hipSuccess) { grid = -1; return; }
        if (hipFuncSetAttribute((const void*)fwd_kernel, hipFuncAttributeMaxDynamicSharedMemorySize, LDS_BYTES) != hipSuccess) { fprintf(stderr, "kernel_launch: hipFuncSetAttribute failed\n"); grid = -1; return; }
        if (hipOccupancyMaxActiveBlocksPerMultiprocessor(&per_cu, (const void*)fwd_kernel, NTHR, LDS_BYTES) != hipSuccess || per_cu < 1) fprintf(stderr, "kernel_launch: occupancy query reports %d\n", per_cu);
        (void)hipGetLastError();
        grid = cus;
    }
    if (grid < 0) return;
    (void)hipMemsetAsync((char*)d_ws + WS_CTL, 0, CTL_ZERO_BYTES, stream);
    Args a{};
    for (int i = 0; i < N_IN; ++i) a.in[i] = (const float*)d_in[i];
    a.out = (float*)d_out; a.ws = (unsigned char*)d_ws;
#if MK_ONE_LAUNCH
    a.ph_lo = 0; a.ph_hi = NPH;
    hipLaunchKernelGGL(fwd_kernel, dim3(grid), dim3(NTHR), LDS_BYTES, stream, a);
#else
    for (int p = 0; p < NPH; ++p) { a.ph_lo = p; a.ph_hi = p + 1; hipLaunchKernelGGL(fwd_kernel, dim3(grid), dim3(NTHR), LDS_BYTES, stream, a); }
#endif
    const hipError_t le = hipPeekAtLastError();
    if (le != hipSuccess) fprintf(stderr, "kernel_launch: launch failed: %s\n", hipGetErrorName(le));
}
```
